# Optimizing an MI355X kernel written in HIP

```python
import math
import jax
import jax.numpy as jnp
from jax import lax
import numpy as np

D_MODEL = 1024
BATCH = 8
SEQ = 4096
DEPTH = 2

F32 = jnp.float32
NORM_EPS = 1e-6
ROPE_THETA = 10000.0
HEAD_DIM = 64
ATTN_BLOCK = 128
A_HEADS = 8
A_KV_HEADS = 2
IDX_HEADS = 8
IDX_DIM = 64
A_TOPK_MAX = 256
B_WIDTH = 512
B_GROUP = 16
B_GROUPS = B_WIDTH // B_GROUP
B_STATE = 64
C_HEADS = 8
C_KV_HEADS = 2
CMP_LEN = 32
CMP_STRIDE = 16
CMP_HIDDEN = 256
SLC_LEN = 64
SLC_TOPN = 16
WIN = 512
C_BLOCK = 64
FORCE_SCORE = 1e9
D_HEADS = 4
D_KDIM = 64
D_VDIM = 128
GATE_RANK = 16
GATE_TAU = 16.0
GLA_CHUNK = 32
PEER_HEADS = 8
PEER_KEYS = 128
PEER_EXPERTS = PEER_KEYS * PEER_KEYS
PEER_QDIM = 256
PEER_TOPK = 16
PEER_BLOCK = 128

MIX_WIDTH = A_HEADS * HEAD_DIM + B_WIDTH
EVEN_COLS = (A_HEADS * HEAD_DIM, A_KV_HEADS * HEAD_DIM, A_KV_HEADS * HEAD_DIM,
             IDX_HEADS * IDX_DIM, IDX_DIM, IDX_HEADS, B_WIDTH)
ODD_COLS = (C_HEADS * HEAD_DIM,) + (C_KV_HEADS * HEAD_DIM,) * 6 + (
    C_HEADS * 3, D_HEADS * D_KDIM, D_HEADS * D_KDIM, D_HEADS * D_VDIM, GATE_RANK, D_HEADS * D_VDIM)

kernel_name = 'hybrid_dsa_s5_nsa_gla_peer'


def rms_norm(x, gain):
    xf = x.astype(F32)
    y = xf * lax.rsqrt(jnp.mean(xf * xf, axis=-1, keepdims=True) + NORM_EPS)
    return (y * gain.astype(F32)).astype(x.dtype)


def rope(x, pos):
    half = x.shape[-1] // 2
    inv_freq = ROPE_THETA ** (-jnp.arange(half, dtype=F32) / half)
    ang = pos.astype(F32)[:, None] * inv_freq[None, :]
    cos = jnp.cos(ang)[:, None, :]
    sin = jnp.sin(ang)[:, None, :]
    xf = x.astype(F32)
    x1, x2 = xf[..., :half], xf[..., half:]
    return jnp.concatenate([x1 * cos - x2 * sin, x1 * sin + x2 * cos], axis=-1).astype(x.dtype)


def masked_softmax(s, mask):
    s = jnp.where(mask, s.astype(F32), -1e30)
    m = jnp.max(s, axis=-1, keepdims=True)
    p = jnp.exp(s - m) * mask
    return p / jnp.maximum(jnp.sum(p, axis=-1, keepdims=True), 1e-30)


def split_cols(h, sizes):
    return jnp.split(h, np.cumsum(sizes)[:-1].tolist(), axis=-1)


def to_blocks(t, blk):
    return t.reshape(t.shape[0], t.shape[1] // blk, blk, *t.shape[2:]).swapaxes(0, 1)


def dsa_attention(q, k, v, iq, ik, iw, q_gain, k_gain, pos):
    bsz, seq = q.shape[:2]
    topk = min(A_TOPK_MAX, seq // 4)
    rep = A_HEADS // A_KV_HEADS
    q = rope(rms_norm(q, q_gain), pos).astype(F32) * HEAD_DIM ** -0.5
    k = rope(rms_norm(k, k_gain), pos).astype(F32)
    v = v.astype(F32)
    iq = rope(iq, pos).astype(F32) * IDX_DIM ** -0.5
    ik = rope(ik[:, :, None, :], pos)[:, :, 0, :].astype(F32)
    iw = iw.astype(F32) * IDX_HEADS ** -0.5
    key_pos = jnp.arange(seq)
    gather = jax.vmap(lambda t, idx: t[idx])

    def block(args):
        qb, iqb, iwb, start = args
        tq = start + jnp.arange(ATTN_BLOCK)
        rel = jax.nn.relu(jnp.einsum('bqhd,bsd->bqhs', iqb, ik))
        score = jnp.einsum('bqh,bqhs->bqs', iwb, rel)
        causal = key_pos[None, :] <= tq[:, None]
        score = jnp.where(causal[None], score, -jnp.inf)
        _, sel = lax.top_k(score, topk)
        valid = sel <= tq[None, :, None]
        k_sel = gather(k, sel)
        v_sel = gather(v, sel)
        qg = qb.reshape(bsz, ATTN_BLOCK, A_KV_HEADS, rep, HEAD_DIM)
        s = jnp.einsum('bqgrd,bqkgd->bqgrk', qg, k_sel)
        p = masked_softmax(s, valid[:, :, None, None, :])
        o = jnp.einsum('bqgrk,bqkgd->bqgrd', p, v_sel)
        return o.reshape(bsz, ATTN_BLOCK, A_HEADS * HEAD_DIM)

    starts = jnp.arange(seq // ATTN_BLOCK) * ATTN_BLOCK
    out = lax.map(block, (to_blocks(q, ATTN_BLOCK), to_blocks(iq, ATTN_BLOCK),
                          to_blocks(iw, ATTN_BLOCK), starts))
    return out.swapaxes(0, 1).reshape(bsz, seq, A_HEADS * HEAD_DIM)


def s5_ssm(u, log_dt, a_re, a_im, b_re, b_im, c_re, c_im, d_skip, w_glu, b_glu):
    bsz, seq = u.shape[:2]
    uf = u.astype(F32).reshape(bsz, seq, B_GROUPS, B_GROUP)
    dt = jnp.exp(log_dt.astype(F32))[:, None]
    lr, li = a_re.astype(F32), a_im.astype(F32)
    mag = jnp.exp(dt * lr)
    ab_re = mag * jnp.cos(dt * li)
    ab_im = mag * jnp.sin(dt * li)
    den = lr * lr + li * li
    f_re = ((ab_re - 1.0) * lr + ab_im * li) / den
    f_im = (ab_im * lr - (ab_re - 1.0) * li) / den
    br, bi = b_re.astype(F32), b_im.astype(F32)
    bb_re = f_re[..., None] * br - f_im[..., None] * bi
    bb_im = f_re[..., None] * bi + f_im[..., None] * br
    x_re = jnp.einsum('gpc,bsgc->bsgp', bb_re, uf)
    x_im = jnp.einsum('gpc,bsgc->bsgp', bb_im, uf)
    a_re_t = jnp.broadcast_to(ab_re, x_re.shape)
    a_im_t = jnp.broadcast_to(ab_im, x_im.shape)

    def combine(e1, e2):
        a1r, a1i, b1r, b1i = e1
        a2r, a2i, b2r, b2i = e2
        return (a1r * a2r - a1i * a2i, a1r * a2i + a1i * a2r,
                a2r * b1r - a2i * b1i + b2r, a2r * b1i + a2i * b1r + b2i)

    _, _, h_re, h_im = lax.associative_scan(combine, (a_re_t, a_im_t, x_re, x_im), axis=1)
    y = (jnp.einsum('gcp,bsgp->bsgc', c_re.astype(F32), h_re)
         - jnp.einsum('gcp,bsgp->bsgc', c_im.astype(F32), h_im)
         + d_skip.astype(F32) * uf)
    y = jax.nn.gelu(y.reshape(bsz, seq, B_WIDTH))
    return y * jax.nn.sigmoid(y @ w_glu.astype(F32) + b_glu.astype(F32))


def compress_blocks(t, cmp_pos, w1, w2):
    bsz, seq, groups, dh = t.shape
    n_cmp = (seq - CMP_LEN) // CMP_STRIDE + 1
    idx = jnp.arange(n_cmp)[:, None] * CMP_STRIDE + jnp.arange(CMP_LEN)[None, :]
    blocks = t.astype(F32)[:, idx] + cmp_pos.astype(F32)[:, None, :]
    blocks = blocks.transpose(0, 1, 3, 2, 4).reshape(bsz, n_cmp, groups, CMP_LEN * dh)
    return jax.nn.gelu(blocks @ w1.astype(F32)) @ w2.astype(F32)


def nsa_attention(q, k_cmp, v_cmp, k_slc, v_slc, k_win, v_win, gate_logits,
                  q_gain, k_gain, cmp_pos, k_w1, k_w2, v_w1, v_w2, pos):
    bsz, seq = q.shape[:2]
    rep = C_HEADS // C_KV_HEADS
    n_cmp = (seq - CMP_LEN) // CMP_STRIDE + 1
    n_slc = seq // SLC_LEN
    top_n = min(SLC_TOPN, n_slc)
    q = rope(rms_norm(q, q_gain), pos).astype(F32) * HEAD_DIM ** -0.5
    cmp_end = jnp.arange(n_cmp) * CMP_STRIDE + (CMP_LEN - 1)
    kc = rope(rms_norm(compress_blocks(k_cmp, cmp_pos, k_w1, k_w2), k_gain), cmp_end)
    vc = compress_blocks(v_cmp, cmp_pos, v_w1, v_w2)
    ks = rope(rms_norm(k_slc, k_gain), pos).astype(F32)
    ks = ks.reshape(bsz, n_slc, SLC_LEN, C_KV_HEADS, HEAD_DIM).transpose(0, 3, 1, 2, 4)
    vs = v_slc.astype(F32).reshape(bsz, n_slc, SLC_LEN, C_KV_HEADS, HEAD_DIM).transpose(0, 3, 1, 2, 4)
    pad = ((0, 0), (WIN, 0), (0, 0), (0, 0))
    kw = jnp.pad(rope(rms_norm(k_win, k_gain), pos).astype(F32), pad)
    vw = jnp.pad(v_win.astype(F32), pad)
    gates = jax.nn.sigmoid(gate_logits.astype(F32))
    ratio = SLC_LEN // CMP_STRIDE
    span = CMP_LEN // CMP_STRIDE
    off = jnp.arange(n_cmp)[:, None] - ratio * jnp.arange(n_slc)[None, :]
    cmp_to_slc = jnp.maximum(
        jnp.minimum(ratio - 1, off) - jnp.maximum(0, off - span + 1) + 1, 0).astype(F32)
    slc_ids = jnp.arange(n_slc)
    tok_off = jnp.arange(SLC_LEN)
    win_off = jnp.arange(WIN + C_BLOCK)
    gather = jax.vmap(jax.vmap(lambda t, idx: t[idx]))

    def block(args):
        qb, gb, start = args
        tq = start + jnp.arange(C_BLOCK)
        qg = qb.reshape(bsz, C_BLOCK, C_KV_HEADS, rep, HEAD_DIM)
        gb = gb.reshape(bsz, C_BLOCK, C_KV_HEADS, rep, 3)
        s_c = jnp.einsum('bqgrd,bcgd->bqgrc', qg, kc)
        p_c = masked_softmax(s_c, (cmp_end[None, :] <= tq[:, None])[None, :, None, None, :])
        o_c = jnp.einsum('bqgrc,bcgd->bqgrd', p_c, vc)
        imp = jnp.einsum('bqgrc,cj->bqgj', p_c, cmp_to_slc)
        cur = tq // SLC_LEN
        forced = (slc_ids[None, :] == cur[:, None]) | (slc_ids[None, :] == 0)
        admissible = slc_ids[None, :] <= cur[:, None]
        imp = jnp.where(forced[None, :, None, :], FORCE_SCORE, imp)
        imp = jnp.where(admissible[None, :, None, :], imp, -jnp.inf)
        _, sel = lax.top_k(imp, top_n)
        sel_g = sel.transpose(0, 2, 1, 3)
        k_sel = gather(ks, sel_g)
        v_sel = gather(vs, sel_g)
        s_s = jnp.einsum('bqgrd,bgqnld->bqgrnl', qg, k_sel)
        kpos = sel[..., None] * SLC_LEN + tok_off
        smask = (kpos <= tq[None, :, None, None, None]).reshape(bsz, C_BLOCK, C_KV_HEADS, 1, -1)
        p_s = masked_softmax(s_s.reshape(bsz, C_BLOCK, C_KV_HEADS, rep, -1), smask)
        o_s = jnp.einsum('bqgrnl,bgqnld->bqgrd', p_s.reshape(s_s.shape), v_sel)
        kwb = lax.dynamic_slice_in_dim(kw, start, WIN + C_BLOCK, axis=1)
        vwb = lax.dynamic_slice_in_dim(vw, start, WIN + C_BLOCK, axis=1)
        wpos = start - WIN + win_off
        wmask = ((wpos[None, :] <= tq[:, None]) & (wpos[None, :] > tq[:, None] - WIN)
                 & (wpos[None, :] >= 0))
        s_w = jnp.einsum('bqgrd,bkgd->bqgrk', qg, kwb)
        p_w = masked_softmax(s_w, wmask[None, :, None, None, :])
        o_w = jnp.einsum('bqgrk,bkgd->bqgrd', p_w, vwb)
        o = gb[..., 0:1] * o_c + gb[..., 1:2] * o_s + gb[..., 2:3] * o_w
        return o.reshape(bsz, C_BLOCK, C_HEADS * HEAD_DIM)

    starts = jnp.arange(seq // C_BLOCK) * C_BLOCK
    out = lax.map(block, (to_blocks(q, C_BLOCK), to_blocks(gates, C_BLOCK), starts))
    return out.swapaxes(0, 1).reshape(bsz, seq, C_HEADS * HEAD_DIM)


def gla_attention(q, k, v, g_low, r, w_gate, b_gate, o_gain):
    bsz, seq = q.shape[:2]
    n_chunk = seq // GLA_CHUNK
    logit = g_low.astype(F32) @ w_gate.astype(F32) + b_gate.astype(F32)
    log_a = jax.nn.log_sigmoid(logit) / GATE_TAU

    def chunks(t):
        return t.astype(F32).reshape(bsz, n_chunk, GLA_CHUNK, D_HEADS, -1).transpose(0, 3, 1, 2, 4)

    qc = chunks(q) * D_KDIM ** -0.5
    kc, vc, gc = chunks(k), chunks(v), chunks(log_a)
    bcum = jnp.cumsum(gc, axis=3)
    blast = bcum[:, :, :, -1:, :]
    q_dec = qc * jnp.exp(bcum)
    k_inv = kc * jnp.exp(-bcum)
    causal = jnp.tril(jnp.ones((GLA_CHUNK, GLA_CHUNK), dtype=bool))
    att = jnp.where(causal, jnp.einsum('bhncd,bhnsd->bhncs', q_dec, k_inv), 0.0)
    o_intra = jnp.einsum('bhncs,bhnse->bhnce', att, vc)
    upd = jnp.einsum('bhncd,bhnce->bhnde', kc * jnp.exp(blast - bcum), vc)
    decay = jnp.exp(blast[:, :, :, 0, :])

    def step(state, inp):
        dec, u = inp
        return dec[..., None] * state + u, state

    init = jnp.zeros((bsz, D_HEADS, D_KDIM, D_VDIM), F32)
    _, prev = lax.scan(step, init, (jnp.moveaxis(decay, 2, 0), jnp.moveaxis(upd, 2, 0)))
    o_inter = jnp.einsum('bhncd,nbhde->bhnce', q_dec, prev)
    o = (o_intra + o_inter).transpose(0, 2, 3, 1, 4).reshape(bsz, seq, D_HEADS, D_VDIM)
    o = rms_norm(o, o_gain).reshape(bsz, seq, D_HEADS * D_VDIM)
    return o * jax.nn.silu(r.astype(F32))


def peer_ffn(x, wq, subkeys, u_tab, v_tab):
    bsz, seq, dm = x.shape
    xt = x.reshape(bsz * seq // PEER_BLOCK, PEER_BLOCK, dm)
    half = PEER_QDIM // 2

    def block(xb):
        q = (xb @ wq).reshape(PEER_BLOCK, PEER_HEADS, 2, half)
        s = jnp.einsum('thpc,hpkc->thpk', q, subkeys).astype(F32)
        s1, i1 = lax.top_k(s[:, :, 0], PEER_TOPK)
        s2, i2 = lax.top_k(s[:, :, 1], PEER_TOPK)
        cand = (s1[..., :, None] + s2[..., None, :]).reshape(PEER_BLOCK, PEER_HEADS, -1)
        cand_id = (i1[..., :, None] * PEER_KEYS + i2[..., None, :]).reshape(PEER_BLOCK, PEER_HEADS, -1)
        top_s, top_pos = lax.top_k(cand, PEER_TOPK)
        expert = jnp.take_along_axis(cand_id, top_pos, axis=-1).reshape(PEER_BLOCK, -1)
        gate = jax.nn.softmax(top_s, axis=-1).reshape(PEER_BLOCK, -1)
        h = jax.nn.gelu(jnp.einsum('td,ted->te', xb, u_tab[expert]).astype(F32))
        return jnp.einsum('te,ted->td', gate * h, v_tab[expert].astype(F32))

    return lax.map(block, xt).reshape(bsz, seq, dm)


def even_mixer(h, pos, w_in, q_gain, k_gain, log_dt, a_re, a_im, b_re, b_im,
               c_re, c_im, d_skip, w_glu, b_glu, w_out):
    bsz, seq = h.shape[:2]
    q, k, v, iq, ik, iw, u = split_cols(h @ w_in, EVEN_COLS)
    heads = lambda t, n: t.reshape(bsz, seq, n, -1)
    o_a = dsa_attention(heads(q, A_HEADS), heads(k, A_KV_HEADS), heads(v, A_KV_HEADS),
                        heads(iq, IDX_HEADS), ik, iw, q_gain, k_gain, pos)
    o_b = s5_ssm(u, log_dt, a_re, a_im, b_re, b_im, c_re, c_im, d_skip, w_glu, b_glu)
    return jnp.concatenate([o_a, o_b], axis=-1) @ w_out.astype(F32)


def odd_mixer(h, pos, w_in, q_gain, k_gain, cmp_pos, k_w1, k_w2, v_w1, v_w2,
              w_gate, b_gate, o_gain, w_out):
    bsz, seq = h.shape[:2]
    (q, kc, vc, ks, vs, kw, vw, gl, gq, gk, gv, glow, gr) = split_cols(h @ w_in, ODD_COLS)
    heads = lambda t, n: t.reshape(bsz, seq, n, -1)
    o_c = nsa_attention(heads(q, C_HEADS), heads(kc, C_KV_HEADS), heads(vc, C_KV_HEADS),
                        heads(ks, C_KV_HEADS), heads(vs, C_KV_HEADS), heads(kw, C_KV_HEADS),
                        heads(vw, C_KV_HEADS), heads(gl, C_HEADS), q_gain, k_gain,
                        cmp_pos, k_w1, k_w2, v_w1, v_w2, pos)
    o_d = gla_attention(gq, gk, gv, glow, gr, w_gate, b_gate, o_gain)
    return jnp.concatenate([o_c, o_d], axis=-1) @ w_out.astype(F32)


def setup_inputs(seed: int = 0) -> dict:
    key = jax.random.key(seed)
    keys = iter(list(jax.random.split(key, 64)))

    def normal(shape, scale):
        return jax.random.normal(next(keys), shape, F32) * scale

    def gain(n):
        return 1.0 + normal((n,), 0.02)

    def peer_params():
        return (normal((D_MODEL, PEER_HEADS * PEER_QDIM), D_MODEL ** -0.5),
                normal((PEER_HEADS, 2, PEER_KEYS, PEER_QDIM // 2), (PEER_QDIM // 2) ** -0.5),
                normal((PEER_EXPERTS, D_MODEL), D_MODEL ** -0.5),
                normal((PEER_EXPERTS, D_MODEL), PEER_TOPK ** -0.5))

    x = normal((BATCH, SEQ, D_MODEL), 1.0)
    l0_mix_norm = gain(D_MODEL)
    l0_w_in = normal((D_MODEL, sum(EVEN_COLS)), D_MODEL ** -0.5)
    l0_a_q_gain = gain(HEAD_DIM)
    l0_a_k_gain = gain(HEAD_DIM)
    l0_s5_log_dt = jax.random.uniform(next(keys), (B_GROUPS,), F32, math.log(1e-3), math.log(1e-1))
    l0_s5_a_re = -0.5 + normal((B_GROUPS, B_STATE), 0.01)
    l0_s5_a_im = math.pi * jnp.arange(B_STATE, dtype=F32)[None, :] + normal((B_GROUPS, B_STATE), 0.01)
    l0_s5_b_re = normal((B_GROUPS, B_STATE, B_GROUP), (2 * B_GROUP) ** -0.5)
    l0_s5_b_im = normal((B_GROUPS, B_STATE, B_GROUP), (2 * B_GROUP) ** -0.5)
    l0_s5_c_re = normal((B_GROUPS, B_GROUP, B_STATE), 0.5)
    l0_s5_c_im = normal((B_GROUPS, B_GROUP, B_STATE), 0.5)
    l0_s5_d = normal((B_GROUPS, B_GROUP), 0.5)
    l0_s5_w_glu = normal((B_WIDTH, B_WIDTH), B_WIDTH ** -0.5)
    l0_s5_b_glu = normal((B_WIDTH,), 0.01)
    l0_w_out = normal((MIX_WIDTH, D_MODEL), MIX_WIDTH ** -0.5)
    l0_ffn_norm = gain(D_MODEL)
    l0_peer_wq, l0_peer_subkeys, l0_peer_u, l0_peer_v = peer_params()
    l1_mix_norm = gain(D_MODEL)
    l1_w_in = normal((D_MODEL, sum(ODD_COLS)), D_MODEL ** -0.5)
    l1_c_q_gain = gain(HEAD_DIM)
    l1_c_k_gain = gain(HEAD_DIM)
    l1_nsa_cmp_pos = normal((CMP_LEN, HEAD_DIM), 0.02)
    l1_nsa_k_w1 = normal((CMP_LEN * HEAD_DIM, CMP_HIDDEN), (CMP_LEN * HEAD_DIM) ** -0.5)
    l1_nsa_k_w2 = normal((CMP_HIDDEN, HEAD_DIM), CMP_HIDDEN ** -0.5)
    l1_nsa_v_w1 = normal((CMP_LEN * HEAD_DIM, CMP_HIDDEN), (CMP_LEN * HEAD_DIM) ** -0.5)
    l1_nsa_v_w2 = normal((CMP_HIDDEN, HEAD_DIM), CMP_HIDDEN ** -0.5)
    l1_gla_w_gate = normal((GATE_RANK, D_HEADS * D_KDIM), GATE_RANK ** -0.5)
    l1_gla_b_gate = normal((D_HEADS * D_KDIM,), 0.01)
    l1_gla_o_gain = gain(D_VDIM)
    l1_w_out = normal((MIX_WIDTH, D_MODEL), MIX_WIDTH ** -0.5)
    l1_ffn_norm = gain(D_MODEL)
    l1_peer_wq, l1_peer_subkeys, l1_peer_u, l1_peer_v = peer_params()
    return {
        'x': x,
        'l0_mix_norm': l0_mix_norm, 'l0_w_in': l0_w_in,
        'l0_a_q_gain': l0_a_q_gain, 'l0_a_k_gain': l0_a_k_gain,
        'l0_s5_log_dt': l0_s5_log_dt, 'l0_s5_a_re': l0_s5_a_re, 'l0_s5_a_im': l0_s5_a_im,
        'l0_s5_b_re': l0_s5_b_re, 'l0_s5_b_im': l0_s5_b_im,
        'l0_s5_c_re': l0_s5_c_re, 'l0_s5_c_im': l0_s5_c_im, 'l0_s5_d': l0_s5_d,
        'l0_s5_w_glu': l0_s5_w_glu, 'l0_s5_b_glu': l0_s5_b_glu, 'l0_w_out': l0_w_out,
        'l0_ffn_norm': l0_ffn_norm, 'l0_peer_wq': l0_peer_wq, 'l0_peer_subkeys': l0_peer_subkeys,
        'l0_peer_u': l0_peer_u, 'l0_peer_v': l0_peer_v,
        'l1_mix_norm': l1_mix_norm, 'l1_w_in': l1_w_in,
        'l1_c_q_gain': l1_c_q_gain, 'l1_c_k_gain': l1_c_k_gain,
        'l1_nsa_cmp_pos': l1_nsa_cmp_pos, 'l1_nsa_k_w1': l1_nsa_k_w1, 'l1_nsa_k_w2': l1_nsa_k_w2,
        'l1_nsa_v_w1': l1_nsa_v_w1, 'l1_nsa_v_w2': l1_nsa_v_w2,
        'l1_gla_w_gate': l1_gla_w_gate, 'l1_gla_b_gate': l1_gla_b_gate, 'l1_gla_o_gain': l1_gla_o_gain,
        'l1_w_out': l1_w_out,
        'l1_ffn_norm': l1_ffn_norm, 'l1_peer_wq': l1_peer_wq, 'l1_peer_subkeys': l1_peer_subkeys,
        'l1_peer_u': l1_peer_u, 'l1_peer_v': l1_peer_v,
    }


def reference(x, l0_mix_norm, l0_w_in, l0_a_q_gain, l0_a_k_gain, l0_s5_log_dt, l0_s5_a_re,
              l0_s5_a_im, l0_s5_b_re, l0_s5_b_im, l0_s5_c_re, l0_s5_c_im, l0_s5_d, l0_s5_w_glu,
              l0_s5_b_glu, l0_w_out, l0_ffn_norm, l0_peer_wq, l0_peer_subkeys, l0_peer_u, l0_peer_v,
              l1_mix_norm, l1_w_in, l1_c_q_gain, l1_c_k_gain, l1_nsa_cmp_pos, l1_nsa_k_w1,
              l1_nsa_k_w2, l1_nsa_v_w1, l1_nsa_v_w2, l1_gla_w_gate, l1_gla_b_gate, l1_gla_o_gain,
              l1_w_out, l1_ffn_norm, l1_peer_wq, l1_peer_subkeys, l1_peer_u, l1_peer_v):
    seq = x.shape[1]
    pos = jnp.arange(seq, dtype=jnp.int32)
    mix_norms = (l0_mix_norm, l1_mix_norm)
    mix_params = (
        (l0_w_in, l0_a_q_gain, l0_a_k_gain, l0_s5_log_dt, l0_s5_a_re, l0_s5_a_im, l0_s5_b_re,
         l0_s5_b_im, l0_s5_c_re, l0_s5_c_im, l0_s5_d, l0_s5_w_glu, l0_s5_b_glu, l0_w_out),
        (l1_w_in, l1_c_q_gain, l1_c_k_gain, l1_nsa_cmp_pos, l1_nsa_k_w1, l1_nsa_k_w2,
         l1_nsa_v_w1, l1_nsa_v_w2, l1_gla_w_gate, l1_gla_b_gate, l1_gla_o_gain, l1_w_out),
    )
    ffn_params = (
        (l0_ffn_norm, l0_peer_wq, l0_peer_subkeys, l0_peer_u, l0_peer_v),
        (l1_ffn_norm, l1_peer_wq, l1_peer_subkeys, l1_peer_u, l1_peer_v),
    )
    for layer in range(DEPTH):
        mixer = even_mixer if layer % 2 == 0 else odd_mixer
        x = x + mixer(rms_norm(x, mix_norms[layer]), pos, *mix_params[layer]).astype(x.dtype)
        g_ffn, wq, subkeys, u_tab, v_tab = ffn_params[layer]
        x = x + peer_ffn(rms_norm(x, g_ffn), wq, subkeys, u_tab, v_tab).astype(x.dtype)
    return x
```

```cpp
#include <hip/hip_runtime.h>
#include <hip/hip_cooperative_groups.h>
#include <cstdio>
#include <cstdint>
namespace cg = cooperative_groups;

#define LAS __attribute__((address_space(3)))
typedef unsigned short bf16_t;
typedef short bf16x8 __attribute__((ext_vector_type(8)));
typedef float f32x4 __attribute__((ext_vector_type(4)));
typedef float f32x2 __attribute__((ext_vector_type(2)));
typedef float f32x16 __attribute__((ext_vector_type(16)));
typedef unsigned u32x4 __attribute__((ext_vector_type(4)));
typedef unsigned u32x2 __attribute__((ext_vector_type(2)));
typedef unsigned long long u64;

constexpr int NB = 8, SEQ = 4096, DM = 1024, T = NB * SEQ;
constexpr int NTHREADS = 512, NWAVES = 8;
constexpr int LDS_BYTES = 147456;
constexpr int N_IN0 = 2048, N_IN1 = 3072;
constexpr int C0_Q = 0, C0_K = 512, C0_V = 640, C0_IQ = 768, C0_U = 1280, C0_IK = 1792, C0_IW = 1856;
constexpr int C1_Q = 0, C1_KC = 512, C1_VC = 640, C1_KS = 768, C1_VS = 896, C1_KW = 1024, C1_VW = 1152, C1_GQ = 1280, C1_GK = 1536, C1_GV = 1792, C1_GR = 2304, C1_GL = 2816, C1_GLOW = 2840;

constexpr size_t MiB = 1u << 20;
constexpr size_t WS_CTL = 0;
constexpr size_t WS_ROPE = 1 * MiB;
constexpr size_t WS_W_IN0 = 2 * MiB;
constexpr size_t WS_W_GLU = 6 * MiB;
constexpr size_t WS_SK0 = 6 * MiB + 512 * 1024;
constexpr size_t WS_W_OUT0 = 7 * MiB;
constexpr size_t WS_WQ0 = 9 * MiB;
constexpr size_t WS_W_IN1 = 13 * MiB;
constexpr size_t WS_KW1 = 19 * MiB;
constexpr size_t WS_VW1 = 20 * MiB;
constexpr size_t WS_KW2 = 21 * MiB;
constexpr size_t WS_VW2 = 21 * MiB + 128 * 1024;
constexpr size_t WS_SK1 = 21 * MiB + 512 * 1024;
constexpr size_t WS_W_OUT1 = 22 * MiB;
constexpr size_t WS_WQ1 = 24 * MiB;
constexpr size_t WS_S5B1 = 28 * MiB;
constexpr size_t WS_S5B2 = 32 * MiB;
constexpr size_t WS_CMPB = 38 * MiB;
constexpr size_t WS_TABU = 48 * MiB;
constexpr size_t WS_TABV = 80 * MiB;
constexpr size_t WS_XN = 112 * MiB;
constexpr size_t WS_PROJ = 176 * MiB;
constexpr size_t WS_R3 = 368 * MiB;
constexpr size_t WS_END = 506 * MiB;

__device__ __forceinline__ unsigned f2bf(float f) { unsigned u = __builtin_bit_cast(unsigned, f); return (u + 0x7fffu + ((u >> 16) & 1u)) >> 16; }
__device__ __forceinline__ unsigned pk2(float lo, float hi) { return f2bf(lo) | (f2bf(hi) << 16); }
__device__ __forceinline__ float bf_lo(unsigned u) { return __builtin_bit_cast(float, u << 16); }
__device__ __forceinline__ float bf_hi(unsigned u) { return __builtin_bit_cast(float, u & 0xffff0000u); }
__device__ __forceinline__ float bf2f(bf16_t b) { return __builtin_bit_cast(float, ((unsigned)b) << 16); }
__device__ __forceinline__ float wave_sum(float v) {
#pragma unroll
    for (int o = 1; o < 64; o <<= 1) v += __shfl_xor(v, o);
    return v;
}
__device__ __forceinline__ float gelu_tanh(float x) {
    const float y = 0.7978845608028654f * (x + 0.044715f * x * x * x);
    const float e = __expf(2.0f * y);
    const float th = 1.0f - 2.0f / (e + 1.0f);
    return 0.5f * x * (1.0f + th);
}
__device__ __forceinline__ float sigmoidf_(float x) { return 1.0f / (1.0f + __expf(-x)); }
#define LDS_WAIT() asm volatile("s_waitcnt lgkmcnt(0)" ::: "memory")
#define VM_WAIT() asm volatile("s_waitcnt vmcnt(0)" ::: "memory")

#define XB_TMO      128
#define XB_XCNT(j)  (256  + 64 * (j))
#define XB_XSUB(j)  (1280 + 64 * (j))
#define XB_XGEN(j)  (2304 + 64 * (j))
#define XB_TOP      3328
#define XB_TOPGEN   3392
#define XCD_BAR_WORDS 3456
#define XB_SPIN_CAP (1u << 22)
__device__ __forceinline__ unsigned xb_ld(unsigned* p)              { return __hip_atomic_load(p, __ATOMIC_RELAXED, __HIP_MEMORY_SCOPE_AGENT); }
__device__ __forceinline__ unsigned xb_add(unsigned* p, unsigned v) { return __hip_atomic_fetch_add(p, v, __ATOMIC_RELAXED, __HIP_MEMORY_SCOPE_AGENT); }
__device__ __forceinline__ unsigned xb_xcc_id() { return (unsigned)__builtin_amdgcn_s_getreg((3 << 11) | 20) & 0xFu; }
#define XB_SPIN(cond, bar) do { unsigned _sp = 0; while (cond) { __builtin_amdgcn_s_sleep(1); \
    if ((++_sp & 255u) == 0u) { if (xb_ld(&(bar)[XB_TMO])) break; if (_sp > XB_SPIN_CAP) { atomicAdd(&(bar)[XB_TMO], 1u); break; } } } } while (0)
struct XcdBarrier { unsigned* bar; unsigned x; volatile LAS unsigned* st; };
__device__ __forceinline__ XcdBarrier xcd_barrier_post(unsigned* bar, volatile LAS unsigned* st) {
    XcdBarrier b; b.bar = bar; b.x = xb_xcc_id(); b.st = st;
    if (threadIdx.x == 0) (void)xb_add(&bar[XB_XCNT(b.x)], 1u);
    return b;
}
__device__ __forceinline__ void xcd_barrier_complete(unsigned* bar, unsigned x, unsigned& nloc, unsigned& nx) {
    const unsigned G = gridDim.x * gridDim.y * gridDim.z;
    unsigned sum, cnt, mine, sp = 0u;
    for (;;) {
        sum = 0u; cnt = 0u; mine = 0u;
#pragma unroll
        for (unsigned j = 0; j < 16; ++j) { const unsigned c = xb_ld(&bar[XB_XCNT(j)]); sum += c; cnt += (c > 0u) ? 1u : 0u; mine = (j == x) ? c : mine; }
        if (sum == G) break;
        __builtin_amdgcn_s_sleep(1);
        if ((++sp & 255u) == 0u) { if (xb_ld(&bar[XB_TMO])) break; if (sp > XB_SPIN_CAP) { atomicAdd(&bar[XB_TMO], 1u); break; } }
    }
    nloc = mine > 0u ? mine : 1u; nx = cnt > 0u ? cnt : 1u;
}
__device__ __forceinline__ void xcd_barrier(const XcdBarrier& b) {
    asm volatile("s_waitcnt vmcnt(0)" ::: "memory");
    __syncthreads();
    if (threadIdx.x == 0) {
        unsigned* bar = b.bar;
        __builtin_amdgcn_s_waitcnt(0);
        unsigned nloc = b.st[0], nx = b.st[1];
        if (nloc == 0u) { xcd_barrier_complete(bar, b.x, nloc, nx); b.st[0] = nloc; b.st[1] = nx; }
        const unsigned old = xb_add(&bar[XB_XSUB(b.x)], 1u);
        const unsigned gen = old / nloc;
        if (old + 1u == (gen + 1u) * nloc) {
            __builtin_amdgcn_fence(__ATOMIC_RELEASE, "agent");
            asm volatile("s_waitcnt vmcnt(0)" ::: "memory");
            const unsigned og = xb_add(&bar[XB_TOP], 1u);
            const unsigned tg = og / nx;
            if (og + 1u == (tg + 1u) * nx) xb_add(&bar[XB_TOPGEN], 1u);
            else XB_SPIN(xb_ld(&bar[XB_TOPGEN]) == tg, bar);
            __builtin_amdgcn_fence(__ATOMIC_ACQUIRE, "agent");
            xb_add(&bar[XB_XGEN(b.x)], 1u);
            asm volatile("s_waitcnt vmcnt(0)" ::: "memory");
        } else {
            XB_SPIN(xb_ld(&bar[XB_XGEN(b.x)]) == gen, bar);
            __builtin_amdgcn_fence(__ATOMIC_ACQUIRE, "agent");
            asm volatile("s_waitcnt vmcnt(0)" ::: "memory");
        }
    }
    __syncthreads();
}

namespace pg8 {
constexpr int BM = 256, BK = 64, HALF = 128, HTB = HALF * BK * 2, STAGE_BYTES = 8 * HTB, NXCD = 8, WGM = 8;
__device__ __forceinline__ int lds_byte(int r, int c) { const int st = (r >> 4) * 2 + (c >> 5), rr = r & 15, cc = c & 31, ob = rr * 64 + cc * 2; return st * 1024 + (ob ^ (((ob >> 9) & 1) << 5)); }
__device__ __forceinline__ void stage_rc(int b, int& R, int& C) { const int st = b / 1024, sb = b % 1024, swz = sb ^ (((sb >> 9) & 1) << 5); R = (st >> 1) * 16 + swz / 64; C = (st & 1) * 32 + (swz % 64) / 2; }
__device__ __forceinline__ int perm32(int rho) { const int n = rho >> 4, i = rho & 15; return 8 * (i >> 2) + 4 * n + (i & 3); }
struct Unit { int pm, pn; };
struct Gemm { const bf16_t* A; const bf16_t* Bt; int M, N, K, lda, ldb; };
struct StaticOrder {
    int nM, nN, nwg, G, c;
    __device__ void init(int M, int N, int G_, int c_) { nM = M / BM; nN = N / BM; nwg = nM * nN; G = G_; c = c_; }
    __device__ bool next(int i, Unit& u) const {
        const long L = (long)i * G + c; if (L >= nwg) return false;
        int wgid = (int)L; { const int q = nwg / NXCD, r = nwg % NXCD, xcd = wgid % NXCD, off = wgid / NXCD; wgid = (xcd < r ? xcd * (q + 1) : r * (q + 1) + (xcd - r) * q) + off; }
        const int nig = WGM * nN, gid = wgid / nig, fm = gid * WGM, gsz = (nM - fm) < WGM ? (nM - fm) : WGM;
        u.pm = fm + ((wgid % nig) % gsz); u.pn = (wgid % nig) / gsz; return true;
    }
};
struct GroupedOrder {
    int nwg, G, c, tpg;
    __device__ void init(int ntiles, int tiles_per_group, int G_, int c_) { nwg = ntiles; tpg = tiles_per_group; G = G_; c = c_; }
    __device__ bool next(int i, Unit& u) const { const long L = (long)i * G + c; if (L >= nwg) return false; u.pm = (int)L; u.pn = (int)L / tpg; return true; }
};
__device__ __forceinline__ unsigned cvt_pk_bf16(float lo, float hi) { unsigned r; asm volatile("v_cvt_pk_bf16_f32 %0, %1, %2" : "=v"(r) : "v"(lo), "v"(hi)); return r; }

template <class Epi, class Sched>
__device__ __forceinline__ void gemm_phase(LAS unsigned char* lds, const Gemm g, const Sched& S, const Epi& E) {
    const int tid = threadIdx.x, wid = __builtin_amdgcn_readfirstlane(tid >> 6), lane = tid & 63, wr = wid >> 2, wc = wid & 3, fr = lane & 15, fq = lane >> 4;
    int K = g.K; asm volatile("" : "+s"(K));
    const int nt = K / BK;
    unsigned voffA[2], voffB[2];
#pragma unroll
    for (int i = 0; i < 2; ++i) { int R, C; stage_rc(tid * 16 + i * 8192, R, C); const int Rb = Epi::PERM ? ((R & ~31) + perm32(R & 31)) : R;
        voffA[i] = (unsigned)(R * g.lda + C) * 2u; voffB[i] = (unsigned)(Rb * g.ldb + C) * 2u; }
    const size_t kstep = (size_t)(BK * 2);
    const size_t hstepA = (size_t)HALF * g.lda * 2, hstepB = (size_t)HALF * g.ldb * 2;
    const size_t tstepA = 2 * hstepA, tstepB = 2 * hstepB;
    const unsigned ldsw = (unsigned)wid * 1024u;
    const int aoff = lds_byte(wr * 64 + fr, fq * 8), boff = lds_byte(wc * 32 + fr, fq * 8);
#define PG8_SA(b, h) (((b) * 2 + (h)) * HTB)
#define PG8_SB(b, h) ((4 + (b) * 2 + (h)) * HTB)
#define PG8_STAGE(bufoff, gbase, voff) do { _Pragma("unroll") for (int _i = 0; _i < 2; ++_i) \
        __builtin_amdgcn_global_load_lds((const unsigned*)((const char*)(gbase) + (voff)[_i]), (LAS unsigned*)(lds + (bufoff) + ldsw + _i * 8192), 16, 0, 0); } while (0)
#define PG8_LDA(dst, b, h) do { _Pragma("unroll") for (int m = 0; m < 4; ++m) _Pragma("unroll") for (int k = 0; k < 2; ++k) dst[m][k] = *(const LAS bf16x8*)(lds + PG8_SA(b, h) + aoff + m * 2048 + k * 1024); } while (0)
#define PG8_LDB(dst, b, h) do { _Pragma("unroll") for (int n = 0; n < 2; ++n) _Pragma("unroll") for (int k = 0; k < 2; ++k) dst[n][k] = *(const LAS bf16x8*)(lds + PG8_SB(b, h) + boff + n * 2048 + k * 1024); } while (0)
#define PG8_MMA(ai, bj, At, Bt) do { __builtin_amdgcn_s_setprio(1); _Pragma("unroll") for (int m = 0; m < 4; ++m) _Pragma("unroll") for (int n = 0; n < 2; ++n) _Pragma("unroll") for (int k = 0; k < 2; ++k) \
        acc[ai][bj][m][n] = __builtin_amdgcn_mfma_f32_16x16x32_bf16(Bt[n][k], At[m][k], acc[ai][bj][m][n], 0, 0, 0); __builtin_amdgcn_s_setprio(0); } while (0)
#define PG8_WAIT_V(n) asm volatile("s_waitcnt vmcnt(" #n ")" ::: "memory")
#define PG8_WAIT_L(n) asm volatile("s_waitcnt lgkmcnt(" #n ")" ::: "memory")
#define PG8_BAR __builtin_amdgcn_s_barrier()
#define PG8_SCHED __builtin_amdgcn_sched_barrier(0)
    Unit cur, nxt; int ui = 0;
    if (!S.next(0, cur)) return;
    f32x4 acc[2][2][4][2];
#pragma unroll
    for (int a = 0; a < 2; ++a)
#pragma unroll
        for (int b = 0; b < 2; ++b)
#pragma unroll
            for (int m = 0; m < 4; ++m)
#pragma unroll
                for (int n = 0; n < 2; ++n) acc[a][b][m][n] = (f32x4){0.f, 0.f, 0.f, 0.f};
    bf16x8 At[4][2], B0[2][2], B1[2][2];
    const char* cA = (const char*)g.A + (size_t)cur.pm * tstepA; const char* cB = (const char*)g.Bt + (size_t)cur.pn * tstepB;
    PG8_STAGE(PG8_SB(0, 0), cB, voffB); PG8_STAGE(PG8_SA(0, 0), cA, voffA); PG8_STAGE(PG8_SB(0, 1), cB + hstepB, voffB); PG8_STAGE(PG8_SA(0, 1), cA + hstepA, voffA);
    if (wr == 1) PG8_BAR;
    PG8_WAIT_V(4); PG8_BAR;
    PG8_STAGE(PG8_SB(1, 0), cB + kstep, voffB); PG8_STAGE(PG8_SA(1, 0), cA + kstep, voffA); PG8_STAGE(PG8_SB(1, 1), cB + hstepB + kstep, voffB);
    PG8_WAIT_V(6); PG8_BAR;
    for (;;) {
        const bool has_next = S.next(ui + 1, nxt);
        const char* nA = has_next ? (const char*)g.A + (size_t)nxt.pm * tstepA : cA; const char* nB = has_next ? (const char*)g.Bt + (size_t)nxt.pn * tstepB : cB;
        for (int t = 0; t < nt; t += 2) {
            const bool last = (t == nt - 2);
            const char* a1 = cA + (size_t)(t + 1) * kstep;
            const char* a2 = last ? nA : cA + (size_t)(t + 2) * kstep; const char* b2 = last ? nB : cB + (size_t)(t + 2) * kstep;
            const char* a3 = a2 + kstep; const char* b3 = b2 + kstep;
            PG8_LDB(B0, 0, 0); PG8_SCHED; PG8_LDA(At, 0, 0); PG8_STAGE(PG8_SA(1, 1), a1 + hstepA, voffA);
            PG8_WAIT_L(8); PG8_BAR; PG8_WAIT_L(0); PG8_MMA(0, 0, At, B0); PG8_BAR; PG8_SCHED;
            PG8_LDB(B1, 0, 1); PG8_STAGE(PG8_SB(0, 0), b2, voffB);
            PG8_BAR; PG8_WAIT_L(0); PG8_MMA(0, 1, At, B1); PG8_BAR;
            PG8_LDA(At, 0, 1); PG8_STAGE(PG8_SA(0, 0), a2, voffA);
            PG8_BAR; PG8_WAIT_L(0); PG8_MMA(1, 0, At, B0); PG8_BAR; PG8_SCHED;
            PG8_STAGE(PG8_SB(0, 1), b2 + hstepB, voffB);
            PG8_WAIT_V(6); PG8_BAR; PG8_MMA(1, 1, At, B1); PG8_BAR;
            PG8_LDB(B0, 1, 0); PG8_SCHED; PG8_LDA(At, 1, 0); PG8_STAGE(PG8_SA(0, 1), a2 + hstepA, voffA);
            PG8_WAIT_L(8); PG8_BAR; PG8_WAIT_L(0); PG8_MMA(0, 0, At, B0); PG8_BAR; PG8_SCHED;
            PG8_LDB(B1, 1, 1); PG8_STAGE(PG8_SB(1, 0), b3, voffB);
            PG8_BAR; PG8_WAIT_L(0); PG8_MMA(0, 1, At, B1); PG8_BAR;
            PG8_LDA(At, 1, 1); PG8_STAGE(PG8_SA(1, 0), a3, voffA);
            PG8_BAR; PG8_WAIT_L(0); PG8_MMA(1, 0, At, B0); PG8_BAR; PG8_SCHED;
            PG8_STAGE(PG8_SB(1, 1), b3 + hstepB, voffB);
            PG8_WAIT_V(6); PG8_BAR; PG8_MMA(1, 1, At, B1); PG8_BAR;
        }
        E(acc, cur, wr, wc, fr, fq);
        if (!has_next) break;
#pragma unroll
        for (int a = 0; a < 2; ++a)
#pragma unroll
            for (int b = 0; b < 2; ++b)
#pragma unroll
                for (int m = 0; m < 4; ++m)
#pragma unroll
                    for (int n = 0; n < 2; ++n) acc[a][b][m][n] = (f32x4){0.f, 0.f, 0.f, 0.f};
        cur = nxt; cA = nA; cB = nB; ++ui;
    }
    PG8_WAIT_V(0);
    if (wr == 0) PG8_BAR;
    PG8_BAR;
#undef PG8_SA
#undef PG8_SB
#undef PG8_STAGE
#undef PG8_LDA
#undef PG8_LDB
#undef PG8_MMA
#undef PG8_WAIT_V
#undef PG8_WAIT_L
#undef PG8_BAR
#undef PG8_SCHED
}

struct EpiStoreBf16 {
    static constexpr bool PERM = true;
    bf16_t* O; int ldc;
    __device__ __forceinline__ void operator()(const f32x4 (&acc)[2][2][4][2], const Unit& u, int wr, int wc, int fr, int fq) const {
        const int row0 = u.pm * BM + wr * 64 + fr, col0 = u.pn * BM + wc * 32 + 8 * fq;
#pragma unroll
        for (int ai = 0; ai < 2; ++ai)
#pragma unroll
            for (int m = 0; m < 4; ++m) { bf16_t* rowp = O + (size_t)(row0 + ai * HALF + m * 16) * ldc + col0;
#pragma unroll
                for (int bj = 0; bj < 2; ++bj) { const f32x4 v0 = acc[ai][bj][m][0], v1 = acc[ai][bj][m][1];
                    u32x4 w; w.x = cvt_pk_bf16(v0[0], v0[1]); w.y = cvt_pk_bf16(v0[2], v0[3]); w.z = cvt_pk_bf16(v1[0], v1[1]); w.w = cvt_pk_bf16(v1[2], v1[3]);
                    *(u32x4*)(rowp + bj * HALF) = w; } }
    }
};
struct EpiResidF32 {
    static constexpr bool PERM = false;
    const float* R; float* C; int ldc;
    __device__ __forceinline__ void operator()(const f32x4 (&acc)[2][2][4][2], const Unit& u, int wr, int wc, int fr, int fq) const {
        const int row0 = u.pm * BM + wr * 64 + fr, col0 = u.pn * BM + wc * 32 + 4 * fq;
#pragma unroll
        for (int ai = 0; ai < 2; ++ai)
#pragma unroll
            for (int m = 0; m < 4; ++m) { const size_t off = (size_t)(row0 + ai * HALF + m * 16) * ldc + col0;
#pragma unroll
                for (int bj = 0; bj < 2; ++bj)
#pragma unroll
                    for (int n = 0; n < 2; ++n) { const f32x4 r = *(const f32x4*)(R + off + bj * HALF + n * 16); *(f32x4*)(C + off + bj * HALF + n * 16) = r + acc[ai][bj][m][n]; } }
    }
};
}

struct Args {
    const float* in[39];
    float* out;
    unsigned char* ws;
    int ph_lo, ph_hi;
};
enum { I_X = 0, I_L0_MIXN, I_L0_WIN, I_L0_QG, I_L0_KG, I_L0_LOGDT, I_L0_ARE, I_L0_AIM, I_L0_BRE, I_L0_BIM, I_L0_CRE, I_L0_CIM, I_L0_D, I_L0_WGLU, I_L0_BGLU, I_L0_WOUT,
       I_L0_FFNN, I_L0_WQ, I_L0_SK, I_L0_U, I_L0_V,
       I_L1_MIXN, I_L1_WIN, I_L1_QG, I_L1_KG, I_L1_CMPPOS, I_L1_KW1, I_L1_KW2, I_L1_VW1, I_L1_VW2, I_L1_WGATE, I_L1_BGATE, I_L1_OGAIN, I_L1_WOUT,
       I_L1_FFNN, I_L1_WQ, I_L1_SK, I_L1_U, I_L1_V };

struct Frame {
    LAS unsigned char* lds;
    int tid, lane, wave, G, bid;
};

constexpr size_t L0_QA = WS_R3;
constexpr size_t L0_IQ = WS_R3 + 32 * MiB;
constexpr size_t L0_KA = WS_R3 + 64 * MiB;
constexpr size_t L0_VAT = WS_R3 + 72 * MiB;
constexpr size_t L0_IK = WS_R3 + 80 * MiB;
constexpr size_t L0_IW = WS_R3 + 84 * MiB;
constexpr size_t L0_UA = WS_R3 + 88 * MiB;
constexpr size_t L0_SELT = WS_PROJ;
constexpr size_t L0_CAT = WS_PROJ + 16 * MiB;
constexpr size_t L0_SLOC = WS_PROJ + 80 * MiB;
constexpr size_t L0_YB = WS_PROJ + 112 * MiB;
constexpr size_t PE_Q2 = WS_PROJ;
constexpr size_t PE_EID = WS_PROJ + 128 * MiB;
constexpr size_t PE_GATE = WS_PROJ + 136 * MiB;

template <class Map>
__device__ __forceinline__ void transpose_item(const float* W, int K, int N, bf16_t* WT, int ldk, LAS float* scr, int item, int lane, const Map& map) {
    const int nblk = (N + 31) / 32, kb = item / nblk, nb = item % nblk, k0 = 64 * kb, n0 = 32 * nb;
    const int ncol = n0 + (lane & 31);
#pragma unroll 8
    for (int i = 0; i < 32; ++i) { const int kk = 2 * i + (lane >> 5); scr[kk * 33 + (lane & 31)] = (ncol < N) ? W[(size_t)(k0 + kk) * N + ncol] : 0.f; }
    LDS_WAIT(); asm volatile("" ::: "memory");
    const int c = lane & 7;
#pragma unroll
    for (int j = 0; j < 4; ++j) { const int n = (lane >> 3) + 8 * j; const LAS float* s = scr + (8 * c) * 33 + n;
        u32x4 o; o.x = pk2(s[0 * 33], s[1 * 33]); o.y = pk2(s[2 * 33], s[3 * 33]); o.z = pk2(s[4 * 33], s[5 * 33]); o.w = pk2(s[6 * 33], s[7 * 33]);
        if (n0 + n < N) *(u32x4*)(WT + (size_t)map(n0 + n) * ldk + k0 + 8 * c) = o; }
    LDS_WAIT(); asm volatile("" ::: "memory");
}
struct MapId { __device__ __forceinline__ int operator()(int n) const { return n; } };
struct MapIn0 { __device__ __forceinline__ int operator()(int n) const { return n < 1280 ? n : (n < 1344 ? n - 1280 + C0_IK : (n < 1352 ? n - 1344 + C0_IW : n - 1352 + C0_U)); } };
struct MapIn1 { __device__ __forceinline__ int operator()(int n) const {
    if (n < 1280) return n; if (n < 1304) return n - 1280 + C1_GL; if (n < 1560) return n - 1304 + C1_GQ; if (n < 1816) return n - 1560 + C1_GK;
    if (n < 2328) return n - 1816 + C1_GV; if (n < 2344) return n - 2328 + C1_GLOW; return n - 2344 + C1_GR; } };

template <class Map>
__device__ __forceinline__ void transpose_all(const Frame& F, int& base, const float* W, int K, int N, bf16_t* WT, int ldk, const Map& map) {
    LAS float* scr = (LAS float*)(F.lds + F.wave * 16384);
    const int gw = F.bid * NWAVES + F.wave, NGW = F.G * NWAVES;
    const int nit = (K / 64) * ((N + 31) / 32);
    for (int it = (gw + NGW - (base % NGW)) % NGW; it < nit; it += NGW) transpose_item(W, K, N, WT, ldk, scr, it, F.lane, map);
    base += nit;
}
__device__ __forceinline__ void zero_bytes(const Frame& F, unsigned char* p, size_t nbytes) {
    const size_t n16 = nbytes / 16;
    for (size_t i = (size_t)F.bid * NTHREADS + F.tid; i < n16; i += (size_t)F.G * NTHREADS) ((u32x4*)p)[i] = (u32x4){0u, 0u, 0u, 0u};
}
__device__ __forceinline__ void cvt_f32_bf16(const Frame& F, const float* src, bf16_t* dst, size_t n) {
    const size_t n8 = n / 8;
    for (size_t i = (size_t)F.bid * NTHREADS + F.tid; i < n8; i += (size_t)F.G * NTHREADS) {
        const f32x4 a = ((const f32x4*)src)[2 * i], b = ((const f32x4*)src)[2 * i + 1];
        u32x4 o; o.x = pk2(a.x, a.y); o.y = pk2(a.z, a.w); o.z = pk2(b.x, b.y); o.w = pk2(b.z, b.w);
        ((u32x4*)dst)[i] = o;
    }
}

__device__ __forceinline__ void rms_row_to_bf16(const float* xrow, const float* gain, bf16_t* orow, int lane) {
    const f32x4* xr = (const f32x4*)xrow + lane; const f32x4* gr = (const f32x4*)gain + lane;
    f32x4 v[4]; float s = 0.f;
#pragma unroll
    for (int j = 0; j < 4; ++j) { v[j] = xr[64 * j]; s += (v[j].x * v[j].x + v[j].y * v[j].y) + (v[j].z * v[j].z + v[j].w * v[j].w); }
    const float rstd = 1.0f / sqrtf(wave_sum(s) * (1.f / DM) + 1e-6f);
    u64* o8 = (u64*)orow + lane;
#pragma unroll
    for (int j = 0; j < 4; ++j) { const f32x4 g4 = gr[64 * j]; o8[64 * j] = (u64)pk2(v[j].x * rstd * g4.x, v[j].y * rstd * g4.y) | ((u64)pk2(v[j].z * rstd * g4.z, v[j].w * rstd * g4.w) << 32); }
}
__device__ __forceinline__ void p_rmsnorm(const Frame& F, const float* x, const float* gain, bf16_t* XN) {
    const int gw = F.bid * NWAVES + F.wave, NGW = F.G * NWAVES;
    for (int m = gw; m < T; m += NGW) rms_row_to_bf16(x + (size_t)m * DM, gain, XN + (size_t)m * DM, F.lane);
}

__device__ __forceinline__ void p_rope_table(const Frame& F, f32x2* rope) {
    for (int i = F.bid * NTHREADS + F.tid; i < SEQ * 32; i += F.G * NTHREADS) {
        const int pos = i >> 5, k = i & 31;
        const float inv = powf(10000.0f, -(float)k / 32.0f);
        const float ang = (float)pos * inv;
        float s, c; sincosf(ang, &s, &c);
        rope[i] = (f32x2){c, s};
    }
}

__device__ __forceinline__ void s5_build_group(const Frame& F, const Args& a, unsigned char* ws, int g) {
    LAS f32x2* abp = (LAS f32x2*)F.lds;
    LAS f32x2* bb = abp + 17 * 64;
    LAS f32x2* Cc = bb + 64 * 16;
    LAS float* KT = (LAS float*)(Cc + 16 * 64);
    const float dt = expf(a.in[I_L0_LOGDT][g]);
    for (int idx = F.tid; idx < 17 * 64; idx += NTHREADS) {
        const int tau = idx >> 6, p = idx & 63;
        const float lr = a.in[I_L0_ARE][g * 64 + p], li = a.in[I_L0_AIM][g * 64 + p];
        const float mag = expf((float)tau * dt * lr); float s, c; sincosf((float)tau * dt * li, &s, &c);
        abp[idx] = (f32x2){mag * c, mag * s};
    }
    for (int idx = F.tid; idx < 64 * 16; idx += NTHREADS) {
        const int p = idx >> 4, c = idx & 15;
        const float lr = a.in[I_L0_ARE][g * 64 + p], li = a.in[I_L0_AIM][g * 64 + p];
        const float mag = expf(dt * lr); float s, co; sincosf(dt * li, &s, &co);
        const float abr = mag * co, abi = mag * s, den = lr * lr + li * li;
        const float fr = ((abr - 1.0f) * lr + abi * li) / den, fi = (abi * lr - (abr - 1.0f) * li) / den;
        const float br = a.in[I_L0_BRE][(size_t)(g * 64 + p) * 16 + c], bi = a.in[I_L0_BIM][(size_t)(g * 64 + p) * 16 + c];
        bb[idx] = (f32x2){fr * br - fi * bi, fr * bi + fi * br};
    }
    for (int idx = F.tid; idx < 16 * 64; idx += NTHREADS) Cc[idx] = (f32x2){a.in[I_L0_CRE][(size_t)g * 1024 + idx], a.in[I_L0_CIM][(size_t)g * 1024 + idx]};
    __syncthreads();
    for (int idx = F.tid; idx < 16 * 256; idx += NTHREADS) {
        const int tau = idx >> 8, co = (idx >> 4) & 15, ci = idx & 15;
        float acc = 0.f;
        for (int p = 0; p < 64; ++p) {
            const f32x2 c = Cc[co * 64 + p], e = abp[tau * 64 + p], b = bb[p * 16 + ci];
            const float er = c.x * e.x - c.y * e.y, ei = c.x * e.y + c.y * e.x;
            acc += er * b.x - ei * b.y;
        }
        if (tau == 0 && co == ci) acc += a.in[I_L0_D][g * 16 + co];
        KT[idx] = acc;
    }
    __syncthreads();
    bf16_t* B1 = (bf16_t*)(ws + WS_S5B1) + (size_t)g * 256 * 256;
    bf16_t* B2 = (bf16_t*)(ws + WS_S5B2) + (size_t)g * 256 * 384;
    for (int idx = F.tid; idx < 256 * 128; idx += NTHREADS) {
        const int n = idx >> 7, k = (idx & 127) * 2;
        float v0 = 0.f, v1 = 0.f;
        if (n < 128) { const int p = n & 63, j = k >> 4, ci = k & 15; const f32x2 e = abp[(15 - j) * 64 + p], b0 = bb[p * 16 + ci], b1 = bb[p * 16 + ci + 1];
            if (n < 64) { v0 = e.x * b0.x - e.y * b0.y; v1 = e.x * b1.x - e.y * b1.y; } else { v0 = e.x * b0.y + e.y * b0.x; v1 = e.x * b1.y + e.y * b1.x; } }
        *(unsigned*)(B1 + (size_t)n * 256 + k) = pk2(v0, v1);
    }
    for (int idx = F.tid; idx < 256 * 192; idx += NTHREADS) {
        const int n = idx / 192, k = (idx % 192) * 2, i = n >> 4, co = n & 15;
        float v0 = 0.f, v1 = 0.f;
        if (k < 256) { const int j = k >> 4, ci = k & 15; if (j <= i) { v0 = KT[((i - j) * 16 + co) * 16 + ci]; v1 = KT[((i - j) * 16 + co) * 16 + ci + 1]; } }
        else { const int p = (k - 256) & 63; const bool im = k >= 320;
            const f32x2 c0 = Cc[co * 64 + p], e0 = abp[(i + 1) * 64 + p], c1 = Cc[co * 64 + p + 1], e1 = abp[(i + 1) * 64 + p + 1];
            if (!im) { v0 = c0.x * e0.x - c0.y * e0.y; v1 = c1.x * e1.x - c1.y * e1.y; } else { v0 = -(c0.x * e0.y + c0.y * e0.x); v1 = -(c1.x * e1.y + c1.y * e1.x); } }
        *(unsigned*)(B2 + (size_t)n * 384 + k) = pk2(v0, v1);
    }
    __syncthreads();
}

__device__ __forceinline__ void cmp_bias(const Frame& F, const Args& a, float* out) {
    const int n = F.tid & 255, w = F.tid >> 8;
    const float* w1 = a.in[w ? I_L1_VW1 : I_L1_KW1]; const float* pos = a.in[I_L1_CMPPOS];
    float acc = 0.f;
    for (int k = 0; k < 2048; ++k) acc += pos[k] * w1[(size_t)k * 256 + n];
    out[w * 256 + n] = acc;
}

__device__ __forceinline__ float rope_apply(float v, const f32x2 cs, int lane) {
    const float partner = __shfl_xor(v, 32);
    return lane < 32 ? v * cs.x - partner * cs.y : partner * cs.y + v * cs.x;
}
__device__ __forceinline__ void p_l0_prep(const Frame& F, const Args& a, unsigned char* ws) {
    const bf16_t* P = (const bf16_t*)(ws + WS_PROJ);
    const f32x2* rope = (const f32x2*)(ws + WS_ROPE);
    bf16_t* QA = (bf16_t*)(ws + L0_QA); bf16_t* IQ = (bf16_t*)(ws + L0_IQ); bf16_t* KA = (bf16_t*)(ws + L0_KA); bf16_t* VAT = (bf16_t*)(ws + L0_VAT);
    bf16_t* IK = (bf16_t*)(ws + L0_IK); float* IW = (float*)(ws + L0_IW); bf16_t* UA = (bf16_t*)(ws + L0_UA);
    const int gw = F.bid * NWAVES + F.wave, NGW = F.G * NWAVES, lane = F.lane;
    const float qg = a.in[I_L0_QG][lane], kg = a.in[I_L0_KG][lane];
    for (int m = gw; m < T; m += NGW) {
        const int b = m >> 12, t = m & 4095;
        const bf16_t* row = P + (size_t)m * N_IN0;
        const f32x2 cs = rope[t * 32 + (lane & 31)];
#pragma unroll
        for (int h = 0; h < 8; ++h) {
            float v = bf2f(row[C0_Q + h * 64 + lane]);
            const float ss = wave_sum(v * v);
            v = v * (1.0f / sqrtf(ss * (1.f / 64.f) + 1e-6f)) * qg;
            v = rope_apply(v, cs, lane) * 0.125f;
            QA[(size_t)m * 512 + h * 64 + lane] = (bf16_t)f2bf(v);
        }
#pragma unroll
        for (int g = 0; g < 2; ++g) {
            float v = bf2f(row[C0_K + g * 64 + lane]);
            const float ss = wave_sum(v * v);
            v = v * (1.0f / sqrtf(ss * (1.f / 64.f) + 1e-6f)) * kg;
            v = rope_apply(v, cs, lane);
            KA[((size_t)(b * 2 + g) * 4096 + t) * 64 + lane] = (bf16_t)f2bf(v);
        }
#pragma unroll
        for (int h = 0; h < 8; ++h) {
            float v = bf2f(row[C0_IQ + h * 64 + lane]);
            v = rope_apply(v, cs, lane) * 0.125f;
            IQ[(size_t)m * 512 + h * 64 + lane] = (bf16_t)f2bf(v);
        }
        { float v = bf2f(row[C0_IK + lane]); v = rope_apply(v, cs, lane); IK[(size_t)m * 64 + lane] = (bf16_t)f2bf(v); }
        if (lane < 8) IW[(size_t)m * 8 + lane] = bf2f(row[C0_IW + lane]) * 0.35355339059327373f;
        { const u32x4 uv = *(const u32x4*)(row + C0_U + lane * 8); const int g = lane >> 1;
          *(u32x4*)(UA + ((size_t)g * 2048 + (m >> 4)) * 384 + (m & 15) * 16 + (lane & 1) * 8) = uv; }
    }
    for (int it = gw; it < NB * 2 * 64; it += NGW) {
        const int tb = it & 63, g = (it >> 6) & 1, b = it >> 7;
        const size_t m = (size_t)b * 4096 + tb * 64 + lane;
        unsigned r[32];
#pragma unroll
        for (int j = 0; j < 8; ++j) { const u32x4 q = *(const u32x4*)(P + m * N_IN0 + C0_V + g * 64 + j * 8); r[4 * j] = q.x; r[4 * j + 1] = q.y; r[4 * j + 2] = q.z; r[4 * j + 3] = q.w; }
        bf16_t* dst = VAT + ((size_t)(b * 2 + g) * 64) * 4096 + tb * 64 + lane;
#pragma unroll
        for (int d = 0; d < 64; ++d) dst[(size_t)d * 4096] = (bf16_t)((d & 1) ? (r[d >> 1] >> 16) : (r[d >> 1] & 0xffffu));
    }
}

__device__ __forceinline__ unsigned f16key(unsigned raw) { return (raw & 0x8000u) ? (~raw & 0xFFFFu) : (raw | 0x8000u); }
__device__ __forceinline__ void p_dsa_index(const Frame& F, unsigned char* ws) {
    const bf16_t* IQ = (const bf16_t*)(ws + L0_IQ); const bf16_t* IK = (const bf16_t*)(ws + L0_IK); const float* IW = (const float*)(ws + L0_IW);
    u64* SELT = (u64*)(ws + L0_SELT);
    LAS _Float16* sc = (LAS _Float16*)F.lds;
    LAS unsigned short* scu = (LAS unsigned short*)F.lds;
    LAS u64* mk = (LAS u64*)(F.lds + 131072);
    LAS float* wl = (LAS float*)(F.lds + 131072 + 8192);
    const int lane = F.lane, wave = F.wave, h = lane >> 5, r = lane & 31;
    const int rq = ((r >> 4) & 1) + 2 * ((r >> 2) & 1), rh = 4 * ((r >> 3) & 1) + (r & 3);
    for (int u = F.bid; u < 2048; u += F.G) {
        const int idx = u & 255, b = u >> 8;
        const int j = (b & 1) ? 255 - idx : idx;
        const int t0 = j * 16; const size_t mb = (size_t)b * 4096;
        if (F.tid < 128) wl[F.tid] = IW[(mb + t0) * 8 + F.tid];
        const int nkb = (t0 + 15) / 32 + 1;
        bf16x8 Af[4][4];
#pragma unroll
        for (int rt = 0; rt < 4; ++rt)
#pragma unroll
            for (int ks = 0; ks < 4; ++ks) Af[rt][ks] = *(const bf16x8*)(IQ + (mb + t0 + 4 * rt + rq) * 512 + rh * 64 + ks * 16 + 8 * h);
        __syncthreads();
        for (int kb = wave; kb < nkb; kb += NWAVES) {
            bf16x8 Bf[4];
#pragma unroll
            for (int ks = 0; ks < 4; ++ks) Bf[ks] = *(const bf16x8*)(IK + (mb + kb * 32 + r) * 64 + ks * 16 + 8 * h);
#pragma unroll
            for (int rt = 0; rt < 4; ++rt) {
                f32x16 acc = {0.f, 0.f, 0.f, 0.f, 0.f, 0.f, 0.f, 0.f, 0.f, 0.f, 0.f, 0.f, 0.f, 0.f, 0.f, 0.f};
#pragma unroll
                for (int ks = 0; ks < 4; ++ks) acc = __builtin_amdgcn_mfma_f32_32x32x16_bf16(Af[rt][ks], Bf[ks], acc, 0, 0, 0);
                const int qa = 4 * rt + 2 * h;
                const f32x4 wa0 = *(const LAS f32x4*)(wl + qa * 8), wa1 = *(const LAS f32x4*)(wl + qa * 8 + 4), wb0 = *(const LAS f32x4*)(wl + qa * 8 + 8), wb1 = *(const LAS f32x4*)(wl + qa * 8 + 12);
                float sa = 0.f, sb = 0.f;
#pragma unroll
                for (int i = 0; i < 4; ++i) { sa += wa0[i] * fmaxf(acc[i], 0.f); sa += wa1[i] * fmaxf(acc[4 + i], 0.f); sb += wb0[i] * fmaxf(acc[8 + i], 0.f); sb += wb1[i] * fmaxf(acc[12 + i], 0.f); }
                sc[qa * 4096 + kb * 32 + r] = (_Float16)sa;
                sc[(qa + 1) * 4096 + kb * 32 + r] = (_Float16)sb;
            }
        }
        __syncthreads();
#pragma unroll 1
        for (int qq = 0; qq < 2; ++qq) {
            const int q = wave * 2 + qq, t = t0 + q, n = t + 1;
            unsigned mylo = 0u, myhi = 0u;
            if (n <= 256) {
                const int base = lane * 64;
                const u64 word = (base + 63 <= t) ? ~0ull : (base > t ? 0ull : ((1ull << (t - base + 1)) - 1ull));
                mylo = (unsigned)word; myhi = (unsigned)(word >> 32);
            } else {
                const int nw = (n + 63) >> 6;
                unsigned kk[32];
#pragma unroll
                for (int jj = 0; jj < 32; ++jj) {
                    unsigned lo16 = 0u, hi16 = 0u;
                    if (2 * jj < nw) { const int e = (2 * jj) * 64 + lane; const unsigned raw = scu[q * 4096 + e]; lo16 = (e <= t) ? f16key(raw) : 0u; }
                    if (2 * jj + 1 < nw) { const int e = (2 * jj + 1) * 64 + lane; const unsigned raw = scu[q * 4096 + e]; hi16 = (e <= t) ? f16key(raw) : 0u; }
                    kk[jj] = lo16 | (hi16 << 16);
                }
                unsigned prefix = 0u;
#pragma unroll 1
                for (int bit = 15; bit >= 0; --bit) {
                    const unsigned cand = prefix | (1u << bit), candhi = cand << 16;
                    int cnt = 0;
#pragma unroll
                    for (int jj = 0; jj < 32; ++jj) if (2 * jj < nw) {
                        cnt += __builtin_popcountll(__ballot((kk[jj] & 0xffffu) >= cand));
                        cnt += __builtin_popcountll(__ballot(kk[jj] >= candhi));
                    }
                    if (cnt >= 256) prefix = cand;
                }
                const unsigned Tk = prefix;
                int cgt = 0;
#pragma unroll
                for (int jj = 0; jj < 32; ++jj) if (2 * jj < nw) {
                    cgt += __builtin_popcountll(__ballot((kk[jj] & 0xffffu) > Tk));
                    cgt += __builtin_popcountll(__ballot((kk[jj] >> 16) > Tk));
                }
                const int need = 256 - cgt;
                int run = 0;
#pragma unroll
                for (int i = 0; i < 64; ++i) if (i < nw) {
                    const unsigned k = (i & 1) ? (kk[i >> 1] >> 16) : (kk[i >> 1] & 0xffffu);
                    const u64 gt = __ballot(k > Tk); u64 eq = __ballot(k == Tk);
                    const int pe = __builtin_popcountll(eq);
                    if (run + pe > need) { int kq = need - run; kq = kq < 0 ? 0 : kq;
                        const bool keep = ((eq >> lane) & 1ull) && (__builtin_popcountll(eq & ((1ull << lane) - 1ull)) < kq); eq = __ballot(keep); }
                    run += pe;
                    const u64 word = gt | eq;
                    if (lane == i) { mylo = (unsigned)word; myhi = (unsigned)(word >> 32); }
                }
            }
            mk[lane * 16 + q] = (u64)mylo | ((u64)myhi << 32);
        }
        __syncthreads();
        { const int w = F.tid >> 3, part = F.tid & 7;
          u64* dst = SELT + ((size_t)(b * 64 + w) * 4096) + t0 + part * 2;
          dst[0] = mk[w * 16 + part * 2]; dst[1] = mk[w * 16 + part * 2 + 1]; }
        __syncthreads();
    }
}

constexpr int AT_KB = 9216, AT_VB = 8704, AT_BUF = AT_KB + AT_VB;
struct AttStage { u32x4 kreg, vreg; };
__device__ __forceinline__ void att_load(AttStage& s, const bf16_t* Kg, const bf16_t* Vtg, int key0, int tid) {
    s.kreg = *(const u32x4*)(Kg + (size_t)(key0 + (tid >> 3)) * 64 + (tid & 7) * 8);
    s.vreg = *(const u32x4*)(Vtg + (size_t)(tid >> 3) * 4096 + key0 + (tid & 7) * 8);
}
__device__ __forceinline__ void att_store(const AttStage& s, LAS unsigned char* buf, int tid) {
    *(LAS u32x4*)(buf + (tid >> 3) * 144 + (tid & 7) * 16) = s.kreg;
    LAS unsigned char* v = buf + AT_KB + (tid >> 3) * 136 + (tid & 7) * 16;
    *(LAS u32x2*)(v) = (u32x2){s.vreg.x, s.vreg.y}; *(LAS u32x2*)(v + 8) = (u32x2){s.vreg.z, s.vreg.w};
}
__device__ __forceinline__ bf16x8 pack8(float a0, float a1, float a2, float a3, float a4, float a5, float a6, float a7) {
    u32x4 w; w.x = pg8::cvt_pk_bf16(a0, a1); w.y = pg8::cvt_pk_bf16(a2, a3); w.z = pg8::cvt_pk_bf16(a4, a5); w.w = pg8::cvt_pk_bf16(a6, a7);
    return __builtin_bit_cast(bf16x8, w);
}
__device__ __forceinline__ f32x16 att_qk(const LAS unsigned char* buf, int sub, const bf16x8 (&Qf)[4], int lane) {
    f32x16 S = {0.f, 0.f, 0.f, 0.f, 0.f, 0.f, 0.f, 0.f, 0.f, 0.f, 0.f, 0.f, 0.f, 0.f, 0.f, 0.f};
    const LAS unsigned char* kp = buf + (sub * 32 + (lane & 31)) * 144 + (lane >> 5) * 16;
#pragma unroll
    for (int ks = 0; ks < 4; ++ks) { const bf16x8 kf = *(const LAS bf16x8*)(kp + ks * 32); S = __builtin_amdgcn_mfma_f32_32x32x16_bf16(kf, Qf[ks], S, 0, 0, 0); }
    return S;
}
__device__ __forceinline__ void att_pv2(const LAS unsigned char* buf, int sub, const bf16x8 P0, const bf16x8 P1, f32x16 (&O)[2], int lane) {
    const int h = lane >> 5;
#pragma unroll
    for (int dt = 0; dt < 2; ++dt) {
        const LAS unsigned char* vp = buf + AT_KB + (dt * 32 + (lane & 31)) * 136 + (sub * 32 + 4 * h) * 2;
        const u32x2 a0 = *(const LAS u32x2*)(vp), a1 = *(const LAS u32x2*)(vp + 16), b0 = *(const LAS u32x2*)(vp + 32), b1 = *(const LAS u32x2*)(vp + 48);
        const bf16x8 V0 = __builtin_bit_cast(bf16x8, ((u32x4){a0.x, a0.y, a1.x, a1.y}));
        const bf16x8 V1 = __builtin_bit_cast(bf16x8, ((u32x4){b0.x, b0.y, b1.x, b1.y}));
        O[dt] = __builtin_amdgcn_mfma_f32_32x32x16_bf16(V0, P0, O[dt], 0, 0, 0);
        O[dt] = __builtin_amdgcn_mfma_f32_32x32x16_bf16(V1, P1, O[dt], 0, 0, 0);
    }
}
__device__ __forceinline__ void att_pv(const LAS unsigned char* buf, int sub, const float (&p)[16], f32x16 (&O)[2], int lane) {
    const bf16x8 P0 = pack8(p[0], p[1], p[2], p[3], p[4], p[5], p[6], p[7]);
    const bf16x8 P1 = pack8(p[8], p[9], p[10], p[11], p[12], p[13], p[14], p[15]);
    att_pv2(buf, sub, P0, P1, O, lane);
}

__device__ __forceinline__ void p_dsa_attn(const Frame& F, const Args& a, unsigned char* ws) {
    const bf16_t* QA = (const bf16_t*)(ws + L0_QA); const bf16_t* KA = (const bf16_t*)(ws + L0_KA); const bf16_t* VAT = (const bf16_t*)(ws + L0_VAT);
    const u64* SELT = (const u64*)(ws + L0_SELT); bf16_t* CAT = (bf16_t*)(ws + L0_CAT);
    const int lane = F.lane, wave = F.wave, h = lane >> 5, c = lane & 31, tid = F.tid;
    float mq = 0.f, mk_ = 0.f;
    for (int i = 0; i < 64; ++i) { mq = fmaxf(mq, fabsf(a.in[I_L0_QG][i])); mk_ = fmaxf(mk_, fabsf(a.in[I_L0_KG][i])); }
    const float c2 = (8.0f * mq * mk_ + 0.5f) * 1.4426950408889634f, c1 = 1.4426950408889634f;
    for (int u = F.bid; u < 512; u += F.G) {
        const int idx = u & 255, g = u >> 8, b = idx >> 5, qtr = idx & 31, qt = g ? 31 - qtr : qtr, q0 = qt * 128;
        const size_t mb = (size_t)b * 4096;
        const bf16_t* Kg = KA + (size_t)(b * 2 + g) * 4096 * 64; const bf16_t* Vtg = VAT + (size_t)(b * 2 + g) * 64 * 4096;
        bf16x8 Qf[2][4]; int qidx[2];
#pragma unroll
        for (int ct = 0; ct < 2; ++ct) { qidx[ct] = q0 + wave * 16 + ct * 8 + (c >> 2);
#pragma unroll
            for (int ks = 0; ks < 4; ++ks) Qf[ct][ks] = *(const bf16x8*)(QA + (mb + qidx[ct]) * 512 + (g * 4 + (c & 3)) * 64 + ks * 16 + 8 * h); }
        f32x16 O[2][2]; float l[2] = {0.f, 0.f};
#pragma unroll
        for (int ct = 0; ct < 2; ++ct)
#pragma unroll
            for (int dt = 0; dt < 2; ++dt)
#pragma unroll
                for (int i = 0; i < 16; ++i) O[ct][dt][i] = 0.f;
        const int nkt = 2 * qt + 2;
        AttStage st; att_load(st, Kg, Vtg, 0, tid);
        __syncthreads();
        att_store(st, F.lds, tid);
        __syncthreads();
        for (int kt = 0; kt < nkt; ++kt) {
            LAS unsigned char* buf = F.lds + (kt & 1) * AT_BUF;
            if (kt + 1 < nkt) att_load(st, Kg, Vtg, (kt + 1) * 64, tid);
            u64 mw[2];
#pragma unroll
            for (int ct = 0; ct < 2; ++ct) mw[ct] = SELT[(size_t)(b * 64 + kt) * 4096 + qidx[ct]];
#pragma unroll 1
            for (int sub = 0; sub < 2; ++sub) {
#pragma unroll
                for (int ct = 0; ct < 2; ++ct) {
                    __builtin_amdgcn_sched_barrier(0);
                    const f32x16 S = att_qk(buf, sub, Qf[ct], lane);
                    const unsigned mbits = (unsigned)(mw[ct] >> (sub * 32 + 4 * h));
                    float p[16];
#pragma unroll
                    for (int i = 0; i < 16; ++i) {
                        const float e = __builtin_amdgcn_exp2f(S[i] * c1 - c2);
                        const int bitpos = (i & 3) + 8 * (i >> 2);
                        p[i] = ((mbits >> bitpos) & 1u) ? e : 0.f;
                        l[ct] += p[i];
                    }
                    att_pv(buf, sub, p, O[ct], lane);
                }
            }
            if (kt + 1 < nkt) att_store(st, F.lds + ((kt + 1) & 1) * AT_BUF, tid);
            __syncthreads();
        }
#pragma unroll
        for (int ct = 0; ct < 2; ++ct) {
            const float lt = l[ct] + __shfl_xor(l[ct], 32);
            const float inv = 1.0f / fmaxf(lt, 1e-30f);
            bf16_t* orow = CAT + (mb + qidx[ct]) * 1024 + (g * 4 + (c & 3)) * 64;
#pragma unroll
            for (int dt = 0; dt < 2; ++dt)
#pragma unroll
                for (int i4 = 0; i4 < 4; ++i4) {
                    const int d = dt * 32 + 8 * i4 + 4 * h;
                    u32x2 w; w.x = pk2(O[ct][dt][4 * i4] * inv, O[ct][dt][4 * i4 + 1] * inv); w.y = pk2(O[ct][dt][4 * i4 + 2] * inv, O[ct][dt][4 * i4 + 3] * inv);
                    *(u32x2*)(orow + d) = w;
                }
        }
    }
}

__device__ __forceinline__ void p_s5_scan(const Frame& F, const Args& a, unsigned char* ws) {
    const float* SLOC = (const float*)(ws + L0_SLOC); bf16_t* UA = (bf16_t*)(ws + L0_UA);
    const int gw = F.bid * NWAVES + F.wave, NGW = F.G * NWAVES, p = F.lane;
    for (int it = gw; it < 32 * NB; it += NGW) {
        const int g = it >> 3, b = it & 7;
        const float dt = expf(a.in[I_L0_LOGDT][g]);
        const float lr = a.in[I_L0_ARE][g * 64 + p], li = a.in[I_L0_AIM][g * 64 + p];
        const float mag = expf(16.0f * dt * lr); float s, c; sincosf(16.0f * dt * li, &s, &c);
        const float ar = mag * c, ai = mag * s;
        float hr = 0.f, hi = 0.f;
        const float* sl = SLOC + ((size_t)g * 2048 + b * 256) * 128;
        bf16_t* ua = UA + ((size_t)g * 2048 + b * 256) * 384 + 256;
        for (int ch = 0; ch < 256; ++ch) {
            ua[(size_t)ch * 384 + p] = (bf16_t)f2bf(hr); ua[(size_t)ch * 384 + 64 + p] = (bf16_t)f2bf(hi);
            const float xr = sl[(size_t)ch * 128 + p], xi = sl[(size_t)ch * 128 + 64 + p];
            const float nr = ar * hr - ai * hi + xr, ni = ar * hi + ai * hr + xi;
            hr = nr; hi = ni;
        }
    }
}
namespace pg8 {
struct EpiS5State {
    static constexpr bool PERM = false;
    float* C;
    __device__ __forceinline__ void operator()(const f32x4 (&acc)[2][2][4][2], const Unit& u, int wr, int wc, int fr, int fq) const {
        const int row0 = u.pm * BM + wr * 64 + fr, col0 = wc * 32 + 4 * fq;
#pragma unroll
        for (int ai = 0; ai < 2; ++ai)
#pragma unroll
            for (int m = 0; m < 4; ++m)
#pragma unroll
                for (int n = 0; n < 2; ++n) *(f32x4*)(C + (size_t)(row0 + ai * HALF + m * 16) * 128 + col0 + n * 16) = acc[ai][0][m][n];
    }
};
struct EpiS5Out {
    static constexpr bool PERM = false;
    bf16_t* YB;
    __device__ __forceinline__ void operator()(const f32x4 (&acc)[2][2][4][2], const Unit& u, int wr, int wc, int fr, int fq) const {
        const int g = u.pn;
        const int row0 = u.pm * BM + wr * 64 + fr - g * 2048;
        const int col0 = wc * 32 + 4 * fq;
#pragma unroll
        for (int ai = 0; ai < 2; ++ai)
#pragma unroll
            for (int m = 0; m < 4; ++m) { const int chunk = row0 + ai * HALF + m * 16;
#pragma unroll
                for (int bj = 0; bj < 2; ++bj)
#pragma unroll
                    for (int n = 0; n < 2; ++n) { const int col = col0 + bj * HALF + n * 16, i = col >> 4, co = col & 15;
                        const f32x4 v = acc[ai][bj][m][n];
                        u32x2 w; w.x = pk2(gelu_tanh(v[0]), gelu_tanh(v[1])); w.y = pk2(gelu_tanh(v[2]), gelu_tanh(v[3]));
                        *(u32x2*)(YB + ((size_t)chunk * 16 + i) * 512 + g * 16 + co) = w; }
                asm volatile("" ::: "memory"); __builtin_amdgcn_sched_barrier(0); }
    }
};
struct EpiGlu {
    static constexpr bool PERM = true;
    const bf16_t* YB; const float* bias; bf16_t* CAT;
    __device__ __forceinline__ void operator()(const f32x4 (&acc)[2][2][4][2], const Unit& u, int wr, int wc, int fr, int fq) const {
        const int row0 = u.pm * BM + wr * 64 + fr, col0 = u.pn * BM + wc * 32 + 8 * fq;
#pragma unroll
        for (int ai = 0; ai < 2; ++ai)
#pragma unroll
            for (int m = 0; m < 4; ++m) { const size_t row = row0 + ai * HALF + m * 16;
#pragma unroll
                for (int bj = 0; bj < 2; ++bj) { const int col = col0 + bj * HALF;
                    const u32x4 yv = *(const u32x4*)(YB + row * 512 + col);
                    const f32x4 b0 = *(const f32x4*)(bias + col), b1 = *(const f32x4*)(bias + col + 4);
                    const f32x4 z0 = acc[ai][bj][m][0] + b0, z1 = acc[ai][bj][m][1] + b1;
                    u32x4 w;
                    w.x = pk2(bf_lo(yv.x) * sigmoidf_(z0[0]), bf_hi(yv.x) * sigmoidf_(z0[1])); w.y = pk2(bf_lo(yv.y) * sigmoidf_(z0[2]), bf_hi(yv.y) * sigmoidf_(z0[3]));
                    w.z = pk2(bf_lo(yv.z) * sigmoidf_(z1[0]), bf_hi(yv.z) * sigmoidf_(z1[1])); w.w = pk2(bf_lo(yv.w) * sigmoidf_(z1[2]), bf_hi(yv.w) * sigmoidf_(z1[3]));
                    *(u32x4*)(CAT + row * 1024 + 512 + col) = w; }
                asm volatile("" ::: "memory"); __builtin_amdgcn_sched_barrier(0); }
    }
};
}
__device__ __forceinline__ unsigned mono_u32(float f) { const unsigned u = __builtin_bit_cast(unsigned, f); return u ^ ((u >> 31) ? 0xFFFFFFFFu : 0x80000000u); }
#define INS16(arr, xin) do { unsigned _x = (xin); _Pragma("unroll") for (int _i = 0; _i < 16; ++_i) { const unsigned _hi = arr[_i] > _x ? arr[_i] : _x; _x = arr[_i] > _x ? _x : arr[_i]; arr[_i] = _hi; } } while (0)
__device__ __forceinline__ void p_peer_route(const Frame& F, unsigned char* ws, const bf16_t* SK) {
    const bf16_t* Q2 = (const bf16_t*)(ws + PE_Q2); unsigned short* EID = (unsigned short*)(ws + PE_EID); float* GATE = (float*)(ws + PE_GATE);
    LAS float* sc0 = (LAS float*)F.lds;
    const int lane = F.lane, wave = F.wave, h5 = lane >> 5, r = lane & 31, tid = F.tid;
    for (int u = F.bid; u < 2048; u += F.G) {
        const int hd = u & 7, mt = u >> 3; const size_t m0 = (size_t)mt * 128;
        {
            const int p = wave >> 2, rt = wave & 3;
            bf16x8 Af[8];
#pragma unroll
            for (int ks = 0; ks < 8; ++ks) Af[ks] = *(const bf16x8*)(Q2 + (m0 + rt * 32 + r) * 2048 + (hd * 2 + p) * 128 + ks * 16 + 8 * h5);
            LAS float* scp = sc0 + p * 128 * 129;
#pragma unroll 1
            for (int ct = 0; ct < 4; ++ct) {
                f32x16 acc = {0.f, 0.f, 0.f, 0.f, 0.f, 0.f, 0.f, 0.f, 0.f, 0.f, 0.f, 0.f, 0.f, 0.f, 0.f, 0.f};
#pragma unroll
                for (int ks = 0; ks < 8; ++ks) { const bf16x8 Bf = *(const bf16x8*)(SK + ((size_t)(hd * 2 + p) * 128 + ct * 32 + r) * 128 + ks * 16 + 8 * h5);
                    acc = __builtin_amdgcn_mfma_f32_32x32x16_bf16(Af[ks], Bf, acc, 0, 0, 0); }
#pragma unroll
                for (int i = 0; i < 16; ++i) scp[(rt * 32 + (i & 3) + 8 * (i >> 2) + 4 * h5) * 129 + ct * 32 + r] = acc[i];
            }
        }
        __syncthreads();
        if (tid < 256) {
            const int row = tid & 127, pp = tid >> 7; LAS float* rowp = sc0 + pp * 128 * 129 + row * 129;
            unsigned a[16];
#pragma unroll
            for (int i = 0; i < 16; ++i) a[i] = 0u;
#pragma unroll 4
            for (int j = 0; j < 128; ++j) { const unsigned key = (mono_u32(rowp[j]) & ~0x7Fu) | (unsigned)(127 - j); if (key > a[15]) INS16(a, key); }
            float vals[16]; int ids[16];
#pragma unroll
            for (int k = 0; k < 16; ++k) { ids[k] = 127 - (int)(a[k] & 127u); vals[k] = rowp[ids[k]]; }
#pragma unroll
            for (int k = 0; k < 16; ++k) { rowp[k] = vals[k]; rowp[16 + k] = __int_as_float(ids[k]); }
        }
        __syncthreads();
        if (tid < 128) {
            const int row = tid; const LAS float* s1 = sc0 + row * 129; const LAS float* s2 = sc0 + 128 * 129 + row * 129;
            float v1[16], v2[16];
#pragma unroll
            for (int k = 0; k < 16; ++k) { v1[k] = s1[k]; v2[k] = s2[k]; }
            unsigned c[16];
#pragma unroll
            for (int i = 0; i < 16; ++i) c[i] = 0u;
#pragma unroll
            for (int a = 0; a < 16; ++a)
#pragma unroll
                for (int b = 0; b < 16; ++b) if ((a + 1) * (b + 1) <= 16) { const unsigned key = (mono_u32(v1[a] + v2[b]) & ~0xFFu) | (unsigned)(255 - (a * 16 + b)); INS16(c, key); }
            float mx = -3.0e38f; float sv[16]; int eid[16];
#pragma unroll
            for (int k = 0; k < 16; ++k) { const int fl = 255 - (int)(c[k] & 255u), a = fl >> 4, b = fl & 15;
                sv[k] = s1[a] + s2[b]; eid[k] = __float_as_int(s1[16 + a]) * 128 + __float_as_int(s2[16 + b]); mx = fmaxf(mx, sv[k]); }
            float den = 0.f;
#pragma unroll
            for (int k = 0; k < 16; ++k) { sv[k] = __expf(sv[k] - mx); den += sv[k]; }
            const float inv = 1.0f / den;
            unsigned short* ep = EID + (m0 + row) * 128 + hd * 16; float* gp = GATE + (m0 + row) * 128 + hd * 16;
#pragma unroll
            for (int k = 0; k < 16; ++k) { ep[k] = (unsigned short)eid[k]; gp[k] = sv[k] * inv; }
        }
        __syncthreads();
    }
}

__device__ __forceinline__ float rdlane_f(float v, int l) { return __builtin_bit_cast(float, __builtin_amdgcn_readlane(__builtin_bit_cast(int, v), l)); }
__device__ __forceinline__ void p_peer_expert(const Frame& F, unsigned char* ws, float* xres) {
    const bf16_t* XN = (const bf16_t*)(ws + WS_XN); const bf16_t* TU = (const bf16_t*)(ws + WS_TABU); const bf16_t* TV = (const bf16_t*)(ws + WS_TABV);
    const unsigned short* EID = (const unsigned short*)(ws + PE_EID); const float* GATE = (const float*)(ws + PE_GATE);
    const int gw = F.bid * NWAVES + F.wave, NGW = F.G * NWAVES, lane = F.lane;
    for (int m = gw; m < T; m += NGW) {
        float xf[16];
        { const u32x4 xa = *(const u32x4*)(XN + (size_t)m * 1024 + lane * 8), xb = *(const u32x4*)(XN + (size_t)m * 1024 + 512 + lane * 8);
          xf[0] = bf_lo(xa.x); xf[1] = bf_hi(xa.x); xf[2] = bf_lo(xa.y); xf[3] = bf_hi(xa.y); xf[4] = bf_lo(xa.z); xf[5] = bf_hi(xa.z); xf[6] = bf_lo(xa.w); xf[7] = bf_hi(xa.w);
          xf[8] = bf_lo(xb.x); xf[9] = bf_hi(xb.x); xf[10] = bf_lo(xb.y); xf[11] = bf_hi(xb.y); xf[12] = bf_lo(xb.z); xf[13] = bf_hi(xb.z); xf[14] = bf_lo(xb.w); xf[15] = bf_hi(xb.w); }
        const int id0 = EID[(size_t)m * 128 + lane], id1 = EID[(size_t)m * 128 + 64 + lane];
        const float g0 = GATE[(size_t)m * 128 + lane], g1 = GATE[(size_t)m * 128 + 64 + lane];
        float outv[16];
#pragma unroll
        for (int i = 0; i < 16; ++i) outv[i] = 0.f;
#pragma unroll 1
        for (int k = 0; k < 16; ++k) {
            const int idreg = (k < 8) ? id0 : id1; const float greg = (k < 8) ? g0 : g1; const int lbase = (k & 7) * 8;
            int e[8];
#pragma unroll
            for (int i = 0; i < 8; ++i) e[i] = __builtin_amdgcn_readlane(idreg, lbase + i);
            float pr[8];
            {
                u32x4 ua[8], ub[8];
#pragma unroll
                for (int i = 0; i < 8; ++i) { ua[i] = *(const u32x4*)(TU + (size_t)e[i] * 1024 + lane * 8); ub[i] = *(const u32x4*)(TU + (size_t)e[i] * 1024 + 512 + lane * 8); }
#pragma unroll
                for (int i = 0; i < 8; ++i) {
                    float s = xf[0] * bf_lo(ua[i].x); s += xf[1] * bf_hi(ua[i].x); s += xf[2] * bf_lo(ua[i].y); s += xf[3] * bf_hi(ua[i].y);
                    s += xf[4] * bf_lo(ua[i].z); s += xf[5] * bf_hi(ua[i].z); s += xf[6] * bf_lo(ua[i].w); s += xf[7] * bf_hi(ua[i].w);
                    s += xf[8] * bf_lo(ub[i].x); s += xf[9] * bf_hi(ub[i].x); s += xf[10] * bf_lo(ub[i].y); s += xf[11] * bf_hi(ub[i].y);
                    s += xf[12] * bf_lo(ub[i].z); s += xf[13] * bf_hi(ub[i].z); s += xf[14] * bf_lo(ub[i].w); s += xf[15] * bf_hi(ub[i].w);
                    pr[i] = s;
                }
            }
            float r4[4], r2[2], r1;
            { const bool up = (lane & 32) != 0;
#pragma unroll
              for (int i = 0; i < 4; ++i) { const float keep = up ? pr[i + 4] : pr[i], send = up ? pr[i] : pr[i + 4]; r4[i] = keep + __shfl_xor(send, 32); } }
            { const bool up = (lane & 16) != 0;
#pragma unroll
              for (int i = 0; i < 2; ++i) { const float keep = up ? r4[i + 2] : r4[i], send = up ? r4[i] : r4[i + 2]; r2[i] = keep + __shfl_xor(send, 16); } }
            { const bool up = (lane & 8) != 0; const float keep = up ? r2[1] : r2[0], send = up ? r2[0] : r2[1]; r1 = keep + __shfl_xor(send, 8); }
            r1 += __shfl_xor(r1, 4); r1 += __shfl_xor(r1, 2); r1 += __shfl_xor(r1, 1);
            const float gv = __shfl(greg, lbase + (lane >> 3));
            const float coef = gv * gelu_tanh(r1);
            {
                u32x4 va[8], vb[8];
#pragma unroll
                for (int i = 0; i < 8; ++i) { va[i] = *(const u32x4*)(TV + (size_t)e[i] * 1024 + lane * 8); vb[i] = *(const u32x4*)(TV + (size_t)e[i] * 1024 + 512 + lane * 8); }
#pragma unroll
                for (int i = 0; i < 8; ++i) {
                    const float ci = rdlane_f(coef, i * 8);
                    outv[0] += ci * bf_lo(va[i].x); outv[1] += ci * bf_hi(va[i].x); outv[2] += ci * bf_lo(va[i].y); outv[3] += ci * bf_hi(va[i].y);
                    outv[4] += ci * bf_lo(va[i].z); outv[5] += ci * bf_hi(va[i].z); outv[6] += ci * bf_lo(va[i].w); outv[7] += ci * bf_hi(va[i].w);
                    outv[8] += ci * bf_lo(vb[i].x); outv[9] += ci * bf_hi(vb[i].x); outv[10] += ci * bf_lo(vb[i].y); outv[11] += ci * bf_hi(vb[i].y);
                    outv[12] += ci * bf_lo(vb[i].z); outv[13] += ci * bf_hi(vb[i].z); outv[14] += ci * bf_lo(vb[i].w); outv[15] += ci * bf_hi(vb[i].w);
                }
            }
        }
        f32x4* o = (f32x4*)(xres + (size_t)m * 1024 + lane * 8);
        f32x4 a0 = o[0], a1 = o[1], b0 = o[128], b1 = o[129];
        a0 += (f32x4){outv[0], outv[1], outv[2], outv[3]}; a1 += (f32x4){outv[4], outv[5], outv[6], outv[7]};
        b0 += (f32x4){outv[8], outv[9], outv[10], outv[11]}; b1 += (f32x4){outv[12], outv[13], outv[14], outv[15]};
        o[0] = a0; o[1] = a1; o[128] = b0; o[129] = b1;
    }
}
constexpr size_t L1_QN = WS_R3;
constexpr size_t L1_KS = WS_R3 + 32 * MiB;
constexpr size_t L1_KW = WS_R3 + 40 * MiB;
constexpr size_t L1_VST = WS_R3 + 48 * MiB;
constexpr size_t L1_VWT = WS_R3 + 56 * MiB;
constexpr size_t L1_KCR = WS_R3 + 64 * MiB;
constexpr size_t L1_VCR = WS_R3 + 72 * MiB;
constexpr size_t L1_GATES = WS_R3 + 81 * MiB;
constexpr size_t L1_H1 = WS_R3 + 84 * MiB;
constexpr size_t L1_CMPO = WS_R3 + 88 * MiB;
constexpr size_t L1_KC = WS_R3 + 90 * MiB;
constexpr size_t L1_VCT = WS_R3 + 91 * MiB;
constexpr size_t L1_SELB = WS_R3 + 92 * MiB;
constexpr size_t L1_OC = WS_TABU;
constexpr size_t L1_CAT = WS_XN;
constexpr size_t L1_UPD = WS_R3;
constexpr size_t L1_DECAY = WS_R3 + 128 * MiB;

__device__ __forceinline__ void p_l1_prep(const Frame& F, const Args& a, unsigned char* ws) {
    const bf16_t* P = (const bf16_t*)(ws + WS_PROJ);
    const f32x2* rope = (const f32x2*)(ws + WS_ROPE);
    bf16_t* QN = (bf16_t*)(ws + L1_QN); bf16_t* KS = (bf16_t*)(ws + L1_KS); bf16_t* KW = (bf16_t*)(ws + L1_KW);
    bf16_t* KCR = (bf16_t*)(ws + L1_KCR); bf16_t* VCR = (bf16_t*)(ws + L1_VCR); float* GATES = (float*)(ws + L1_GATES);
    const int gw = F.bid * NWAVES + F.wave, NGW = F.G * NWAVES, lane = F.lane;
    const float qg = a.in[I_L1_QG][lane], kg = a.in[I_L1_KG][lane];
    for (int m = gw; m < T; m += NGW) {
        const int b = m >> 12, t = m & 4095;
        const bf16_t* row = P + (size_t)m * N_IN1;
        const f32x2 cs = rope[t * 32 + (lane & 31)];
#pragma unroll
        for (int h = 0; h < 8; ++h) {
            float v = bf2f(row[C1_Q + h * 64 + lane]);
            const float ss = wave_sum(v * v);
            v = v * (1.0f / sqrtf(ss * (1.f / 64.f) + 1e-6f)) * qg;
            v = rope_apply(v, cs, lane) * 0.125f;
            QN[(size_t)m * 512 + h * 64 + lane] = (bf16_t)f2bf(v);
        }
#pragma unroll
        for (int w = 0; w < 2; ++w)
#pragma unroll
            for (int g = 0; g < 2; ++g) {
                float v = bf2f(row[(w ? C1_KW : C1_KS) + g * 64 + lane]);
                const float ss = wave_sum(v * v);
                v = v * (1.0f / sqrtf(ss * (1.f / 64.f) + 1e-6f)) * kg;
                v = rope_apply(v, cs, lane);
                (w ? KW : KS)[((size_t)(b * 2 + g) * 4096 + t) * 64 + lane] = (bf16_t)f2bf(v);
            }
#pragma unroll
        for (int g = 0; g < 2; ++g) {
            KCR[((size_t)(b * 2 + g) * 4096 + t) * 64 + lane] = row[C1_KC + g * 64 + lane];
            VCR[((size_t)(b * 2 + g) * 4096 + t) * 64 + lane] = row[C1_VC + g * 64 + lane];
        }
        if (lane < 24) GATES[(size_t)m * 24 + lane] = sigmoidf_(bf2f(row[C1_GL + lane]));
    }
    for (int it = gw; it < 2 * NB * 2 * 64; it += NGW) {
        const int tb = it & 63, g = (it >> 6) & 1, b = (it >> 7) & 7, w = it >> 10;
        const size_t m = (size_t)b * 4096 + tb * 64 + lane;
        unsigned r[32];
#pragma unroll
        for (int j = 0; j < 8; ++j) { const u32x4 q = *(const u32x4*)(P + m * N_IN1 + (w ? C1_VW : C1_VS) + g * 64 + j * 8); r[4 * j] = q.x; r[4 * j + 1] = q.y; r[4 * j + 2] = q.z; r[4 * j + 3] = q.w; }
        bf16_t* dst = (bf16_t*)(ws + (w ? L1_VWT : L1_VST)) + ((size_t)(b * 2 + g) * 64) * 4096 + tb * 64 + lane;
#pragma unroll
        for (int d = 0; d < 64; ++d) dst[(size_t)d * 4096] = (bf16_t)((d & 1) ? (r[d >> 1] >> 16) : (r[d >> 1] & 0xffffu));
    }
}

namespace pg8 {
struct EpiCmp1 {
    static constexpr bool PERM = true;
    bf16_t* O; const float* bias;
    __device__ __forceinline__ void operator()(const f32x4 (&acc)[2][2][4][2], const Unit& u, int wr, int wc, int fr, int fq) const {
        const int row0 = u.pm * BM + wr * 64 + fr, col0 = wc * 32 + 8 * fq;
#pragma unroll
        for (int ai = 0; ai < 2; ++ai)
#pragma unroll
            for (int m = 0; m < 4; ++m) { bf16_t* rowp = O + (size_t)(row0 + ai * HALF + m * 16) * 256 + col0;
#pragma unroll
                for (int bj = 0; bj < 2; ++bj) { const float* bp = bias + u.pn * 256 + col0 + bj * HALF;
                    const f32x4 v0 = acc[ai][bj][m][0] + *(const f32x4*)bp, v1 = acc[ai][bj][m][1] + *(const f32x4*)(bp + 4);
                    u32x4 w; w.x = pk2(gelu_tanh(v0[0]), gelu_tanh(v0[1])); w.y = pk2(gelu_tanh(v0[2]), gelu_tanh(v0[3]));
                    w.z = pk2(gelu_tanh(v1[0]), gelu_tanh(v1[1])); w.w = pk2(gelu_tanh(v1[2]), gelu_tanh(v1[3]));
                    *(u32x4*)(rowp + bj * HALF) = w; }
                asm volatile("" ::: "memory"); __builtin_amdgcn_sched_barrier(0); }
    }
};
struct EpiCmp2 {
    static constexpr bool PERM = false;
    float* C;
    __device__ __forceinline__ void operator()(const f32x4 (&acc)[2][2][4][2], const Unit& u, int wr, int wc, int fr, int fq) const {
        if (wc >= 2) return;
        const int row0 = u.pm * BM + wr * 64 + fr, col0 = wc * 32 + 4 * fq;
#pragma unroll
        for (int ai = 0; ai < 2; ++ai)
#pragma unroll
            for (int m = 0; m < 4; ++m)
#pragma unroll
                for (int n = 0; n < 2; ++n) *(f32x4*)(C + (size_t)(row0 + ai * HALF + m * 16) * 64 + col0 + n * 16) = acc[ai][0][m][n];
    }
};
}

__device__ __forceinline__ void p_cmp_final(const Frame& F, const Args& a, unsigned char* ws) {
    const float* CMPO = (const float*)(ws + L1_CMPO); const f32x2* rope = (const f32x2*)(ws + WS_ROPE);
    bf16_t* KC = (bf16_t*)(ws + L1_KC); bf16_t* VCT = (bf16_t*)(ws + L1_VCT);
    const int gw = F.bid * NWAVES + F.wave, NGW = F.G * NWAVES, lane = F.lane;
    const float kg = a.in[I_L1_KG][lane];
    for (int r = gw; r < 8192; r += NGW) {
        float v = CMPO[(size_t)r * 64 + lane];
        const int rr = r & 4095, bg = rr >> 8, c = rr & 255;
        if (r < 4096) {
            const float ss = wave_sum(v * v);
            v = v * (1.0f / sqrtf(ss * (1.f / 64.f) + 1e-6f)) * kg;
            const int pos = (c < 255) ? 16 * c + 31 : 0;
            v = rope_apply(v, rope[pos * 32 + (lane & 31)], lane);
            KC[((size_t)bg * 256 + c) * 64 + lane] = (c < 255) ? (bf16_t)f2bf(v) : (bf16_t)0;
        } else {
            VCT[((size_t)bg * 64 + lane) * 256 + c] = (c < 255) ? (bf16_t)f2bf(v) : (bf16_t)0;
        }
    }
}

__device__ __forceinline__ void att_load2(AttStage& s, const bf16_t* Kg, const bf16_t* Vtg, int vstride, int key0, int tid) {
    s.kreg = *(const u32x4*)(Kg + (size_t)(key0 + (tid >> 3)) * 64 + (tid & 7) * 8);
    s.vreg = *(const u32x4*)(Vtg + (size_t)(tid >> 3) * vstride + key0 + (tid & 7) * 8);
}
__device__ __forceinline__ float score_bound_c2(const float* qg, const float* kg) {
    float mq = 0.f, mk_ = 0.f;
    for (int i = 0; i < 64; ++i) { mq = fmaxf(mq, fabsf(qg[i])); mk_ = fmaxf(mk_, fabsf(kg[i])); }
    return (8.0f * mq * mk_ + 0.5f) * 1.4426950408889634f;
}

__device__ __forceinline__ void p_cmp_attn(const Frame& F, const Args& a, unsigned char* ws) {
    const bf16_t* QN = (const bf16_t*)(ws + L1_QN); const bf16_t* KC = (const bf16_t*)(ws + L1_KC); const bf16_t* VCT = (const bf16_t*)(ws + L1_VCT);
    float* OC = (float*)(ws + L1_OC); u64* SELB = (u64*)(ws + L1_SELB);
    LAS float* impL = (LAS float*)(F.lds + 36864);
    const int lane = F.lane, wave = F.wave, h = lane >> 5, c = lane & 31, tid = F.tid;
    const float c2 = score_bound_c2(a.in[I_L1_QG], a.in[I_L1_KG]), c1 = 1.4426950408889634f;
    for (int u = F.bid; u < 1024; u += F.G) {
        const int b = (u >> 7) & 7, g = (u >> 6) & 1, rnd = u >> 8, qt = (rnd & 1) ? 63 - (u & 63) : (u & 63), q0 = qt * 64;
        const int bg = b * 2 + g; const size_t mb = (size_t)b * 4096;
        const int t = q0 + wave * 8 + (c >> 2), head = g * 4 + (c & 3);
        bf16x8 Qf[4];
#pragma unroll
        for (int ks = 0; ks < 4; ++ks) Qf[ks] = *(const bf16x8*)(QN + (mb + t) * 512 + head * 64 + ks * 16 + 8 * h);
        const int L = (t >= 31) ? (((t - 31) >> 4) < 254 ? ((t - 31) >> 4) : 254) : -1;
        const int tmax = q0 + 63; const int Lmax = (tmax >= 31) ? (((tmax - 31) >> 4) < 254 ? ((tmax - 31) >> 4) : 254) : -1;
        const int nkt = (Lmax >= 0) ? (Lmax >> 6) + 1 : 0;
        f32x16 O[2], IMP[2]; float l = 0.f;
#pragma unroll
        for (int i = 0; i < 16; ++i) { O[0][i] = 0.f; O[1][i] = 0.f; IMP[0][i] = 0.f; IMP[1][i] = 0.f; }
        const bf16_t* Kg = KC + (size_t)bg * 256 * 64; const bf16_t* Vtg = VCT + (size_t)bg * 64 * 256;
        __syncthreads();
        for (int kt = 0; kt < nkt; ++kt) {
            AttStage st; att_load2(st, Kg, Vtg, 256, kt * 64, tid);
            __syncthreads();
            att_store(st, F.lds, tid);
            __syncthreads();
#pragma unroll 1
            for (int sub = 0; sub < 2; ++sub) {
                const f32x16 S = att_qk(F.lds, sub, Qf, lane);
                float p[16];
#pragma unroll
                for (int i = 0; i < 16; ++i) {
                    const int cidx = kt * 64 + sub * 32 + (i & 3) + 8 * (i >> 2) + 4 * h;
                    const float e = __builtin_amdgcn_exp2f(S[i] * c1 - c2);
                    p[i] = (cidx <= L) ? e : 0.f; l += p[i];
                }
                const bf16x8 P0 = pack8(p[0], p[1], p[2], p[3], p[4], p[5], p[6], p[7]);
                const bf16x8 P1 = pack8(p[8], p[9], p[10], p[11], p[12], p[13], p[14], p[15]);
                att_pv2(F.lds, sub, P0, P1, O, lane);
#pragma unroll
                for (int jt = 0; jt < 2; ++jt)
#pragma unroll
                    for (int s = 0; s < 2; ++s) {
                        unsigned wv[4];
#pragma unroll
                        for (int e2 = 0; e2 < 4; ++e2) {
                            unsigned pr = 0u;
#pragma unroll
                            for (int q = 0; q < 2; ++q) { const int jj = 2 * e2 + q; const int kap = 16 * s + 8 * (jj >> 2) + 4 * h + (jj & 3);
                                const int off = kt * 64 + sub * 32 + kap - 4 * (32 * jt + c);
                                const unsigned wbits = (off == 0 || off == 4) ? 0x3F80u : ((off >= 1 && off <= 3) ? 0x4000u : 0u);
                                pr |= wbits << (16 * q); }
                            wv[e2] = pr;
                        }
                        const bf16x8 Wf = __builtin_bit_cast(bf16x8, ((u32x4){wv[0], wv[1], wv[2], wv[3]}));
                        IMP[jt] = __builtin_amdgcn_mfma_f32_32x32x16_bf16(Wf, s ? P1 : P0, IMP[jt], 0, 0, 0);
                    }
            }
        }
        const float lt = l + __shfl_xor(l, 32);
        const float inv = 1.0f / fmaxf(lt, 1e-30f);
        { float* orow = OC + (mb + t) * 512 + head * 64;
#pragma unroll
          for (int dt = 0; dt < 2; ++dt)
#pragma unroll
            for (int i4 = 0; i4 < 4; ++i4) { const int d = dt * 32 + 8 * i4 + 4 * h;
                *(f32x4*)(orow + d) = (f32x4){O[dt][4 * i4] * inv, O[dt][4 * i4 + 1] * inv, O[dt][4 * i4 + 2] * inv, O[dt][4 * i4 + 3] * inv}; } }
#pragma unroll
        for (int jt = 0; jt < 2; ++jt)
#pragma unroll
            for (int i = 0; i < 16; ++i) {
                float v = IMP[jt][i] * inv; v += __shfl_xor(v, 1); v += __shfl_xor(v, 2);
                if ((c & 3) == 0) impL[(wave * 8 + (c >> 2)) * 65 + 32 * jt + (i & 3) + 8 * (i >> 2) + 4 * h] = v;
            }
        __syncthreads();
        if (tid < 64) {
            const int tq = q0 + tid, cur = tq >> 6;
            u64 mask;
            if (cur + 1 <= 16) mask = (1ull << (cur + 1)) - 1ull;
            else {
                float v[64];
#pragma unroll
                for (int j = 0; j < 64; ++j) { const float x = impL[tid * 65 + j]; v[j] = (j > cur) ? -3.0e38f : ((j == 0 || j == cur) ? 1.0e9f : x); }
                mask = 0ull;
#pragma unroll 1
                for (int k = 0; k < 16; ++k) {
                    float best = -3.0e38f; int bi = 0;
#pragma unroll
                    for (int j = 0; j < 64; ++j) { const bool taken = (mask >> j) & 1ull; if (!taken && v[j] > best) { best = v[j]; bi = j; } }
                    mask |= 1ull << bi;
                }
            }
            SELB[(size_t)bg * 4096 + tq] = mask;
        }
        __syncthreads();
    }
}

__device__ __forceinline__ void p_nsa_attn(const Frame& F, const Args& a, unsigned char* ws) {
    const bf16_t* QN = (const bf16_t*)(ws + L1_QN);
    const u64* SELB = (const u64*)(ws + L1_SELB); float* OC = (float*)(ws + L1_OC); const float* GATES = (const float*)(ws + L1_GATES);
    bf16_t* CAT = (bf16_t*)(ws + L1_CAT);
    const int lane = F.lane, wave = F.wave, h = lane >> 5, c = lane & 31, tid = F.tid;
    const float c2 = score_bound_c2(a.in[I_L1_QG], a.in[I_L1_KG]), c1 = 1.4426950408889634f;
    for (int u = F.bid; u < 512; u += F.G) {
        const int idx = u & 255, g = u >> 8, b = idx >> 5, qtr = idx & 31, qt = g ? 31 - qtr : qtr, q0 = qt * 128;
        const int bg = b * 2 + g; const size_t mb = (size_t)b * 4096;
        bf16x8 Qf[2][4]; int qidx[2];
#pragma unroll
        for (int ct = 0; ct < 2; ++ct) { qidx[ct] = q0 + wave * 16 + ct * 8 + (c >> 2);
#pragma unroll
            for (int ks = 0; ks < 4; ++ks) Qf[ct][ks] = *(const bf16x8*)(QN + (mb + qidx[ct]) * 512 + (g * 4 + (c & 3)) * 64 + ks * 16 + 8 * h); }
        const int head = g * 4 + (c & 3);
#pragma unroll 1
        for (int pass = 0; pass < 2; ++pass) {
            const bf16_t* Kg = (const bf16_t*)(ws + (pass ? L1_KW : L1_KS)) + (size_t)bg * 4096 * 64;
            const bf16_t* Vtg = (const bf16_t*)(ws + (pass ? L1_VWT : L1_VST)) + (size_t)bg * 64 * 4096;
            u64 selw[2];
#pragma unroll
            for (int ct = 0; ct < 2; ++ct) selw[ct] = pass ? ~0ull : SELB[(size_t)bg * 4096 + qidx[ct]];
            const int wlen = pass ? 512 : 1000000;
            f32x16 O[2][2]; float l[2] = {0.f, 0.f};
#pragma unroll
            for (int ct = 0; ct < 2; ++ct)
#pragma unroll
                for (int dt = 0; dt < 2; ++dt)
#pragma unroll
                    for (int i = 0; i < 16; ++i) O[ct][dt][i] = 0.f;
            const int kt_lo = pass ? ((2 * qt - 8) > 0 ? 2 * qt - 8 : 0) : 0, kt_hi = 2 * qt + 2;
            AttStage st; att_load(st, Kg, Vtg, kt_lo * 64, tid);
            __syncthreads();
            att_store(st, F.lds + (kt_lo & 1) * AT_BUF, tid);
            __syncthreads();
            for (int kt = kt_lo; kt < kt_hi; ++kt) {
                LAS unsigned char* buf = F.lds + (kt & 1) * AT_BUF;
                if (kt + 1 < kt_hi) att_load(st, Kg, Vtg, (kt + 1) * 64, tid);
#pragma unroll 1
                for (int sub = 0; sub < 2; ++sub) {
#pragma unroll
                    for (int ct = 0; ct < 2; ++ct) {
                        __builtin_amdgcn_sched_barrier(0);
                        const f32x16 S = att_qk(buf, sub, Qf[ct], lane);
                        const bool flag = (selw[ct] >> kt) & 1ull;
                        const int tq = qidx[ct];
                        float p[16];
#pragma unroll
                        for (int i = 0; i < 16; ++i) {
                            const int key = kt * 64 + sub * 32 + (i & 3) + 8 * (i >> 2) + 4 * h;
                            const float e = __builtin_amdgcn_exp2f(S[i] * c1 - c2);
                            p[i] = (flag && key <= tq && key + wlen > tq) ? e : 0.f; l[ct] += p[i];
                        }
                        const bf16x8 P0 = pack8(p[0], p[1], p[2], p[3], p[4], p[5], p[6], p[7]);
                        const bf16x8 P1 = pack8(p[8], p[9], p[10], p[11], p[12], p[13], p[14], p[15]);
                        att_pv2(buf, sub, P0, P1, O[ct], lane);
                    }
                }
                if (kt + 1 < kt_hi) att_store(st, F.lds + ((kt + 1) & 1) * AT_BUF, tid);
                __syncthreads();
            }
#pragma unroll
            for (int ct = 0; ct < 2; ++ct) {
                const float lt = l[ct] + __shfl_xor(l[ct], 32);
                const float inv = 1.0f / fmaxf(lt, 1e-30f);
                const size_t m = mb + qidx[ct];
                const float gcv = GATES[m * 24 + head * 3 + 0], gsv = GATES[m * 24 + head * 3 + 1], gwv = GATES[m * 24 + head * 3 + 2];
                float* orow = OC + m * 512 + head * 64; bf16_t* crow = CAT + m * 1024 + head * 64;
#pragma unroll
                for (int dt = 0; dt < 2; ++dt)
#pragma unroll
                    for (int i4 = 0; i4 < 4; ++i4) {
                        const int d = dt * 32 + 8 * i4 + 4 * h;
                        const f32x4 prev = *(const f32x4*)(orow + d);
                        const f32x4 ov = (f32x4){O[ct][dt][4 * i4] * inv, O[ct][dt][4 * i4 + 1] * inv, O[ct][dt][4 * i4 + 2] * inv, O[ct][dt][4 * i4 + 3] * inv};
                        if (pass == 0) *(f32x4*)(orow + d) = prev * gcv + ov * gsv;
                        else { const f32x4 r = prev + ov * gwv; u32x2 w; w.x = pk2(r[0], r[1]); w.y = pk2(r[2], r[3]); *(u32x2*)(crow + d) = w; }
                    }
            }
        }
    }
}

__device__ __forceinline__ float logsigmoidf_(float x) { return fminf(x, 0.f) - log1pf(__expf(-fabsf(x))); }
__device__ __forceinline__ void gla_bcum(const Frame& F, const Args& a, const bf16_t* P, size_t m0, int hh, LAS float* la) {
    const int tid = F.tid, cc = tid >> 4, dk0 = (tid & 15) * 4;
    {
        const bf16_t* grow = P + (m0 + cc) * N_IN1 + C1_GLOW;
        const u32x4 ga = *(const u32x4*)grow, gb = *(const u32x4*)(grow + 8);
        float gl[16] = {bf_lo(ga.x), bf_hi(ga.x), bf_lo(ga.y), bf_hi(ga.y), bf_lo(ga.z), bf_hi(ga.z), bf_lo(ga.w), bf_hi(ga.w),
                        bf_lo(gb.x), bf_hi(gb.x), bf_lo(gb.y), bf_hi(gb.y), bf_lo(gb.z), bf_hi(gb.z), bf_lo(gb.w), bf_hi(gb.w)};
        f32x4 acc = *(const f32x4*)(a.in[I_L1_BGATE] + hh * 64 + dk0);
#pragma unroll
        for (int r = 0; r < 16; ++r) { const f32x4 w = *(const f32x4*)(a.in[I_L1_WGATE] + r * 256 + hh * 64 + dk0); acc += w * gl[r]; }
        *(LAS f32x4*)(la + cc * 64 + dk0) = (f32x4){logsigmoidf_(acc[0]) * 0.0625f, logsigmoidf_(acc[1]) * 0.0625f, logsigmoidf_(acc[2]) * 0.0625f, logsigmoidf_(acc[3]) * 0.0625f};
    }
    __syncthreads();
    if (tid < 64) { float run = 0.f;
#pragma unroll 8
        for (int c = 0; c < 32; ++c) { run += la[c * 64 + tid]; la[c * 64 + tid] = run; } }
    __syncthreads();
}
__device__ __forceinline__ void p_gla_a(const Frame& F, const Args& a, unsigned char* ws) {
    const bf16_t* P = (const bf16_t*)(ws + WS_PROJ); float* UPD = (float*)(ws + L1_UPD); float* DECAY = (float*)(ws + L1_DECAY);
    LAS float* la = (LAS float*)F.lds; LAS float* kd = la + 2048; LAS float* vv = kd + 2048;
    const int tid = F.tid;
    for (int u = F.bid; u < 4096; u += F.G) {
        const int b = u >> 9, hh = (u >> 7) & 3, n = u & 127; const size_t m0 = (size_t)b * 4096 + n * 32;
        gla_bcum(F, a, P, m0, hh, la);
        { const int cc = tid >> 4, dk0 = (tid & 15) * 4;
          const u32x2 kq = *(const u32x2*)(P + (m0 + cc) * N_IN1 + C1_GK + hh * 64 + dk0);
          const f32x4 bc = *(const LAS f32x4*)(la + cc * 64 + dk0), bl = *(const LAS f32x4*)(la + 31 * 64 + dk0);
          *(LAS f32x4*)(kd + cc * 64 + dk0) = (f32x4){bf_lo(kq.x) * __expf(bl[0] - bc[0]), bf_hi(kq.x) * __expf(bl[1] - bc[1]), bf_lo(kq.y) * __expf(bl[2] - bc[2]), bf_hi(kq.y) * __expf(bl[3] - bc[3])};
          const int dv0 = (tid & 15) * 8;
          const u32x4 vq = *(const u32x4*)(P + (m0 + cc) * N_IN1 + C1_GV + hh * 128 + dv0);
          *(LAS f32x4*)(vv + cc * 128 + dv0) = (f32x4){bf_lo(vq.x), bf_hi(vq.x), bf_lo(vq.y), bf_hi(vq.y)};
          *(LAS f32x4*)(vv + cc * 128 + dv0 + 4) = (f32x4){bf_lo(vq.z), bf_hi(vq.z), bf_lo(vq.w), bf_hi(vq.w)};
          if (tid < 64) DECAY[(size_t)u * 64 + tid] = __expf(la[31 * 64 + tid]); }
        __syncthreads();
        { const int dv = tid & 127, dkb = tid >> 7;
          float acc[16];
#pragma unroll
          for (int j = 0; j < 16; ++j) acc[j] = 0.f;
#pragma unroll 4
          for (int c = 0; c < 32; ++c) { const float v = vv[c * 128 + dv];
#pragma unroll
              for (int j4 = 0; j4 < 4; ++j4) { const f32x4 k4 = *(const LAS f32x4*)(kd + c * 64 + dkb * 16 + j4 * 4);
                  acc[j4 * 4] += k4[0] * v; acc[j4 * 4 + 1] += k4[1] * v; acc[j4 * 4 + 2] += k4[2] * v; acc[j4 * 4 + 3] += k4[3] * v; } }
#pragma unroll
          for (int j = 0; j < 16; ++j) UPD[((size_t)u * 64 + dkb * 16 + j) * 128 + dv] = acc[j]; }
        __syncthreads();
    }
}
__device__ __forceinline__ void p_gla_b(const Frame& F, unsigned char* ws) {
    float* UPD = (float*)(ws + L1_UPD); const float* DECAY = (const float*)(ws + L1_DECAY);
    for (int e = F.bid * NTHREADS + F.tid; e < 32 * 8192; e += F.G * NTHREADS) {
        const int bh = e >> 13, rem = e & 8191, dk = rem >> 7;
        float state = 0.f;
        float* up = UPD + (size_t)bh * 128 * 8192 + rem; const float* dp = DECAY + (size_t)bh * 128 * 64 + dk;
#pragma unroll 4
        for (int n = 0; n < 128; ++n) { const float uv = up[(size_t)n * 8192], dc = dp[n * 64]; up[(size_t)n * 8192] = state; state = dc * state + uv; }
    }
}
__device__ __forceinline__ void p_gla_c(const Frame& F, const Args& a, unsigned char* ws) {
    const bf16_t* P = (const bf16_t*)(ws + WS_PROJ); const float* PREV = (const float*)(ws + L1_UPD); bf16_t* CAT = (bf16_t*)(ws + L1_CAT);
    LAS float* la = (LAS float*)F.lds; LAS float* qd = la + 2048; LAS float* ki = qd + 2048; LAS float* vv = ki + 2048; LAS float* att = vv + 4096; LAS float* red = att + 32 * 33;
    const int tid = F.tid, lane = F.lane, wave = F.wave;
    for (int u = F.bid; u < 4096; u += F.G) {
        const int b = u >> 9, hh = (u >> 7) & 3, n = u & 127; const size_t m0 = (size_t)b * 4096 + n * 32;
        gla_bcum(F, a, P, m0, hh, la);
        { const int cc = tid >> 4, dk0 = (tid & 15) * 4;
          const u32x2 kq = *(const u32x2*)(P + (m0 + cc) * N_IN1 + C1_GK + hh * 64 + dk0);
          const u32x2 qq = *(const u32x2*)(P + (m0 + cc) * N_IN1 + C1_GQ + hh * 64 + dk0);
          const f32x4 bc = *(const LAS f32x4*)(la + cc * 64 + dk0);
          *(LAS f32x4*)(ki + cc * 64 + dk0) = (f32x4){bf_lo(kq.x) * __expf(-bc[0]), bf_hi(kq.x) * __expf(-bc[1]), bf_lo(kq.y) * __expf(-bc[2]), bf_hi(kq.y) * __expf(-bc[3])};
          *(LAS f32x4*)(qd + cc * 64 + dk0) = (f32x4){bf_lo(qq.x) * 0.125f * __expf(bc[0]), bf_hi(qq.x) * 0.125f * __expf(bc[1]), bf_lo(qq.y) * 0.125f * __expf(bc[2]), bf_hi(qq.y) * 0.125f * __expf(bc[3])};
          const int dv0 = (tid & 15) * 8;
          const u32x4 vq = *(const u32x4*)(P + (m0 + cc) * N_IN1 + C1_GV + hh * 128 + dv0);
          *(LAS f32x4*)(vv + cc * 128 + dv0) = (f32x4){bf_lo(vq.x), bf_hi(vq.x), bf_lo(vq.y), bf_hi(vq.y)};
          *(LAS f32x4*)(vv + cc * 128 + dv0 + 4) = (f32x4){bf_lo(vq.z), bf_hi(vq.z), bf_lo(vq.w), bf_hi(vq.w)}; }
        __syncthreads();
        { const int cc = tid >> 4, s0 = (tid & 15) * 2;
          float a0 = 0.f, a1 = 0.f;
#pragma unroll 4
          for (int d4 = 0; d4 < 16; ++d4) { const f32x4 q4 = *(const LAS f32x4*)(qd + cc * 64 + d4 * 4), k0 = *(const LAS f32x4*)(ki + s0 * 64 + d4 * 4), k1 = *(const LAS f32x4*)(ki + (s0 + 1) * 64 + d4 * 4);
              a0 += q4[0] * k0[0] + q4[1] * k0[1] + q4[2] * k0[2] + q4[3] * k0[3]; a1 += q4[0] * k1[0] + q4[1] * k1[1] + q4[2] * k1[2] + q4[3] * k1[3]; }
          att[cc * 33 + s0] = (s0 <= cc) ? a0 : 0.f; att[cc * 33 + s0 + 1] = (s0 + 1 <= cc) ? a1 : 0.f; }
        __syncthreads();
        { const int dv = tid & 127, cb = tid >> 7;
          float acc[8];
#pragma unroll
          for (int j = 0; j < 8; ++j) acc[j] = 0.f;
          const float* pp = PREV + (size_t)u * 8192 + dv;
#pragma unroll 8
          for (int dk = 0; dk < 64; ++dk) { const float pv = pp[dk * 128];
#pragma unroll
              for (int j = 0; j < 8; ++j) acc[j] += qd[(cb * 8 + j) * 64 + dk] * pv; }
#pragma unroll 4
          for (int s = 0; s < 32; ++s) { const float v = vv[s * 128 + dv];
#pragma unroll
              for (int j = 0; j < 8; ++j) acc[j] += att[(cb * 8 + j) * 33 + s] * v; }
#pragma unroll
          for (int j = 0; j < 8; ++j) { const float ss = wave_sum(acc[j] * acc[j]); if (lane == 0) red[wave * 8 + j] = ss; }
          __syncthreads();
          const float og = a.in[I_L1_OGAIN][dv];
#pragma unroll
          for (int j = 0; j < 8; ++j) { const float tot = red[(2 * cb) * 8 + j] + red[(2 * cb + 1) * 8 + j];
              const float rstd = 1.0f / sqrtf(tot * (1.f / 128.f) + 1e-6f);
              const size_t m = m0 + cb * 8 + j;
              const float r = bf2f(P[m * N_IN1 + C1_GR + hh * 128 + dv]);
              const float sil = r * sigmoidf_(r);
              CAT[m * 1024 + 512 + hh * 128 + dv] = (bf16_t)f2bf(acc[j] * rstd * og * sil); } }
        __syncthreads();
    }
}
__global__ void __launch_bounds__(NTHREADS, 2) mk_fwd(Args args) {
    extern __shared__ __attribute__((aligned(16))) unsigned char lds_raw[];
    cg::grid_group grid = cg::this_grid();
    Frame F; F.lds = (LAS unsigned char*)lds_raw; F.tid = threadIdx.x; F.lane = F.tid & 63; F.wave = __builtin_amdgcn_readfirstlane(F.tid >> 6); F.G = gridDim.x; F.bid = blockIdx.x;
    unsigned char* ws = args.ws;
    const int lo = args.ph_lo, hi = args.ph_hi;
#ifndef KEEPMASK
#define KEEPMASK 0xFFFFFFFFu
#endif
#define IN(k) (((KEEPMASK >> (k)) & 1u) && lo <= (k) && (k) < hi)
#define BOTH(k) (IN(k) && IN((k) + 1))
#define GRID_BAR(k) do { if (BOTH(k)) grid.sync(); } while (0)
    const float* x = args.in[I_X];
    float* out = args.out;

    if (IN(0)) {
        int base = 0;
        transpose_all(F, base, args.in[I_L0_WIN], 1024, 1864, (bf16_t*)(ws + WS_W_IN0), 1024, MapIn0());
        transpose_all(F, base, args.in[I_L0_WGLU], 512, 512, (bf16_t*)(ws + WS_W_GLU), 512, MapId());
        transpose_all(F, base, args.in[I_L0_WOUT], 1024, 1024, (bf16_t*)(ws + WS_W_OUT0), 1024, MapId());
        transpose_all(F, base, args.in[I_L0_WQ], 1024, 2048, (bf16_t*)(ws + WS_WQ0), 1024, MapId());
        transpose_all(F, base, args.in[I_L1_WIN], 1024, 2856, (bf16_t*)(ws + WS_W_IN1), 1024, MapIn1());
        transpose_all(F, base, args.in[I_L1_KW1], 2048, 256, (bf16_t*)(ws + WS_KW1), 2048, MapId());
        transpose_all(F, base, args.in[I_L1_VW1], 2048, 256, (bf16_t*)(ws + WS_VW1), 2048, MapId());
        transpose_all(F, base, args.in[I_L1_KW2], 256, 64, (bf16_t*)(ws + WS_KW2), 256, MapId());
        transpose_all(F, base, args.in[I_L1_VW2], 256, 64, (bf16_t*)(ws + WS_VW2), 256, MapId());
        transpose_all(F, base, args.in[I_L1_WOUT], 1024, 1024, (bf16_t*)(ws + WS_W_OUT1), 1024, MapId());
        transpose_all(F, base, args.in[I_L1_WQ], 1024, 2048, (bf16_t*)(ws + WS_WQ1), 1024, MapId());
        zero_bytes(F, ws + WS_W_IN0 + (size_t)1864 * 1024 * 2, (size_t)(2048 - 1864) * 1024 * 2);
        zero_bytes(F, ws + WS_W_IN1 + (size_t)2856 * 1024 * 2, (size_t)(3072 - 2856) * 1024 * 2);
        zero_bytes(F, ws + WS_KW2 + (size_t)64 * 256 * 2, (size_t)192 * 256 * 2);
        zero_bytes(F, ws + WS_VW2 + (size_t)64 * 256 * 2, (size_t)192 * 256 * 2);
        cvt_f32_bf16(F, args.in[I_L0_SK], (bf16_t*)(ws + WS_SK0), (size_t)16 * 128 * 128);
        cvt_f32_bf16(F, args.in[I_L1_SK], (bf16_t*)(ws + WS_SK1), (size_t)16 * 128 * 128);
        cvt_f32_bf16(F, args.in[I_L0_U], (bf16_t*)(ws + WS_TABU), (size_t)16384 * 1024);
        cvt_f32_bf16(F, args.in[I_L0_V], (bf16_t*)(ws + WS_TABV), (size_t)16384 * 1024);
        p_rope_table(F, (f32x2*)(ws + WS_ROPE));
        __syncthreads();
        for (int g = F.bid; g < 32; g += F.G) s5_build_group(F, args, ws, g);
        if (F.bid == (F.G > 40 ? 40 : 0)) cmp_bias(F, args, (float*)(ws + WS_CMPB));
        p_rmsnorm(F, x, args.in[I_L0_MIXN], (bf16_t*)(ws + WS_XN));
    }
    GRID_BAR(0);
    if (IN(1)) {
        pg8::Gemm g{(const bf16_t*)(ws + WS_XN), (const bf16_t*)(ws + WS_W_IN0), T, N_IN0, 1024, 1024, 1024};
        pg8::StaticOrder S; S.init(T, N_IN0, F.G, F.bid);
        pg8::EpiStoreBf16 E{(bf16_t*)(ws + WS_PROJ), N_IN0};
        pg8::gemm_phase(F.lds, g, S, E);
    }
    GRID_BAR(1);
    if (IN(2)) p_l0_prep(F, args, ws);
    GRID_BAR(2);
    if (IN(3)) p_dsa_index(F, ws);
    GRID_BAR(3);
    if (IN(4)) p_dsa_attn(F, args, ws);
    GRID_BAR(4);
    if (IN(5)) {
        pg8::Gemm g{(const bf16_t*)(ws + L0_UA), (const bf16_t*)(ws + WS_S5B1), 65536, 8192, 256, 384, 256};
        pg8::GroupedOrder S; S.init(256, 8, F.G, F.bid);
        pg8::EpiS5State E{(float*)(ws + L0_SLOC)};
        pg8::gemm_phase(F.lds, g, S, E);
    }
    GRID_BAR(5);
    if (IN(6)) p_s5_scan(F, args, ws);
    GRID_BAR(6);
    if (IN(7)) {
        pg8::Gemm g{(const bf16_t*)(ws + L0_UA), (const bf16_t*)(ws + WS_S5B2), 65536, 8192, 384, 384, 384};
        pg8::GroupedOrder S; S.init(256, 8, F.G, F.bid);
        pg8::EpiS5Out E{(bf16_t*)(ws + L0_YB)};
        pg8::gemm_phase(F.lds, g, S, E);
    }
    GRID_BAR(7);
    if (IN(8)) {
        pg8::Gemm g{(const bf16_t*)(ws + L0_YB), (const bf16_t*)(ws + WS_W_GLU), T, 512, 512, 512, 512};
        pg8::StaticOrder S; S.init(T, 512, F.G, F.bid);
        pg8::EpiGlu E{(const bf16_t*)(ws + L0_YB), args.in[I_L0_BGLU], (bf16_t*)(ws + L0_CAT)};
        pg8::gemm_phase(F.lds, g, S, E);
    }
    GRID_BAR(8);
    if (IN(9)) {
        pg8::Gemm g{(const bf16_t*)(ws + L0_CAT), (const bf16_t*)(ws + WS_W_OUT0), T, 1024, 1024, 1024, 1024};
        pg8::StaticOrder S; S.init(T, 1024, F.G, F.bid);
        pg8::EpiResidF32 E{x, out, 1024};
        pg8::gemm_phase(F.lds, g, S, E);
    }
    GRID_BAR(9);
    if (IN(10)) p_rmsnorm(F, out, args.in[I_L0_FFNN], (bf16_t*)(ws + WS_XN));
    GRID_BAR(10);
    if (IN(11)) {
        pg8::Gemm g{(const bf16_t*)(ws + WS_XN), (const bf16_t*)(ws + WS_WQ0), T, 2048, 1024, 1024, 1024};
        pg8::StaticOrder S; S.init(T, 2048, F.G, F.bid);
        pg8::EpiStoreBf16 E{(bf16_t*)(ws + PE_Q2), 2048};
        pg8::gemm_phase(F.lds, g, S, E);
    }
    GRID_BAR(11);
    if (IN(12)) p_peer_route(F, ws, (const bf16_t*)(ws + WS_SK0));
    GRID_BAR(12);
    if (IN(13)) p_peer_expert(F, ws, out);
    GRID_BAR(13);
    if (IN(14)) p_rmsnorm(F, out, args.in[I_L1_MIXN], (bf16_t*)(ws + WS_XN));
    GRID_BAR(14);
    if (IN(15)) {
        pg8::Gemm g{(const bf16_t*)(ws + WS_XN), (const bf16_t*)(ws + WS_W_IN1), T, N_IN1, 1024, 1024, 1024};
        pg8::StaticOrder S; S.init(T, N_IN1, F.G, F.bid);
        pg8::EpiStoreBf16 E{(bf16_t*)(ws + WS_PROJ), N_IN1};
        pg8::gemm_phase(F.lds, g, S, E);
    }
    GRID_BAR(15);
    if (IN(16)) p_l1_prep(F, args, ws);
    GRID_BAR(16);
    if (IN(17)) {
        pg8::Gemm g{(const bf16_t*)(ws + L1_KCR), (const bf16_t*)(ws + WS_KW1), 8192, 512, 2048, 1024, 2048};
        pg8::GroupedOrder S; S.init(32, 16, F.G, F.bid);
        pg8::EpiCmp1 E{(bf16_t*)(ws + L1_H1), (const float*)(ws + WS_CMPB)};
        pg8::gemm_phase(F.lds, g, S, E);
    }
    GRID_BAR(17);
    if (IN(18)) {
        pg8::Gemm g{(const bf16_t*)(ws + L1_H1), (const bf16_t*)(ws + WS_KW2), 8192, 512, 256, 256, 256};
        pg8::GroupedOrder S; S.init(32, 16, F.G, F.bid);
        pg8::EpiCmp2 E{(float*)(ws + L1_CMPO)};
        pg8::gemm_phase(F.lds, g, S, E);
    }
    GRID_BAR(18);
    if (IN(19)) p_cmp_final(F, args, ws);
    GRID_BAR(19);
    if (IN(20)) p_cmp_attn(F, args, ws);
    GRID_BAR(20);
    if (IN(21)) p_nsa_attn(F, args, ws);
    GRID_BAR(21);
    if (IN(22)) {
        p_gla_a(F, args, ws);
        cvt_f32_bf16(F, args.in[I_L1_U], (bf16_t*)(ws + WS_TABU), (size_t)16384 * 1024);
        cvt_f32_bf16(F, args.in[I_L1_V], (bf16_t*)(ws + WS_TABV), (size_t)16384 * 1024);
    }
    GRID_BAR(22);
    if (IN(23)) p_gla_b(F, ws);
    GRID_BAR(23);
    if (IN(24)) p_gla_c(F, args, ws);
    GRID_BAR(24);
    if (IN(25)) {
        pg8::Gemm g{(const bf16_t*)(ws + L1_CAT), (const bf16_t*)(ws + WS_W_OUT1), T, 1024, 1024, 1024, 1024};
        pg8::StaticOrder S; S.init(T, 1024, F.G, F.bid);
        pg8::EpiResidF32 E{out, out, 1024};
        pg8::gemm_phase(F.lds, g, S, E);
    }
    GRID_BAR(25);
    if (IN(26)) p_rmsnorm(F, out, args.in[I_L1_FFNN], (bf16_t*)(ws + WS_XN));
    GRID_BAR(26);
    if (IN(27)) {
        pg8::Gemm g{(const bf16_t*)(ws + WS_XN), (const bf16_t*)(ws + WS_WQ1), T, 2048, 1024, 1024, 1024};
        pg8::StaticOrder S; S.init(T, 2048, F.G, F.bid);
        pg8::EpiStoreBf16 E{(bf16_t*)(ws + PE_Q2), 2048};
        pg8::gemm_phase(F.lds, g, S, E);
    }
    GRID_BAR(27);
    if (IN(28)) p_peer_route(F, ws, (const bf16_t*)(ws + WS_SK1));
    GRID_BAR(28);
    if (IN(29)) p_peer_expert(F, ws, out);
#undef IN
#undef BOTH
}

extern "C" void kernel_launch(void* const* d_in, const int* in_sizes, int n_in, void* d_out, int out_size, void* d_ws, size_t ws_size, hipStream_t stream) {
    static int grid = 0;
    if (grid == 0) {
        if (n_in != 39 || ws_size < WS_END) { fprintf(stderr, "kernel_launch: unexpected n_in %d or ws_size %zu (< %zu)\n", n_in, ws_size, (size_t)WS_END); grid = -1; return; }
        int dev = 0, cus = 0, per_cu = 0;
        (void)hipGetDevice(&dev); (void)hipDeviceGetAttribute(&cus, hipDeviceAttributeMultiprocessorCount, dev);
        if (hipFuncSetAttribute((const void*)mk_fwd, hipFuncAttributeMaxDynamicSharedMemorySize, LDS_BYTES) != hipSuccess) { fprintf(stderr, "kernel_launch: hipFuncSetAttribute failed\n"); grid = -1; return; }
        if (hipOccupancyMaxActiveBlocksPerMultiprocessor(&per_cu, (const void*)mk_fwd, NTHREADS, LDS_BYTES) != hipSuccess || per_cu < 1) { fprintf(stderr, "kernel_launch: occupancy query failed (%d)\n", per_cu); (void)hipGetLastError(); grid = -1; return; }
        grid = cus;
    }
    if (grid < 0) return;
    (void)hipMemsetAsync((char*)d_ws + WS_CTL, 0, 1 * MiB, stream);
    Args a{};
    for (int i = 0; i < 39; ++i) a.in[i] = (const float*)d_in[i];
    a.out = (float*)d_out; a.ws = (unsigned char*)d_ws; a.ph_lo = 0; a.ph_hi = 1000;
    void* kargs[] = {&a};
    hipError_t e = hipLaunchCooperativeKernel((const void*)mk_fwd, dim3(grid), dim3(NTHREADS), kargs, LDS_BYTES, stream);
    if (e != hipSuccess) fprintf(stderr, "kernel_launch: cooperative launch failed: %s\n", hipGetErrorString(e));
}
```

```cpp
#define REPMASK 0x0u
#include <hip/hip_runtime.h>
#include <hip/hip_cooperative_groups.h>
#include <cstdio>
#include <cstdint>
namespace cg = cooperative_groups;

#define LAS __attribute__((address_space(3)))
typedef unsigned short bf16_t;
typedef short bf16x8 __attribute__((ext_vector_type(8)));
typedef float f32x4 __attribute__((ext_vector_type(4)));
typedef float f32x2 __attribute__((ext_vector_type(2)));
typedef float f32x16 __attribute__((ext_vector_type(16)));
typedef unsigned u32x4 __attribute__((ext_vector_type(4)));
typedef unsigned u32x2 __attribute__((ext_vector_type(2)));
typedef unsigned long long u64;

constexpr int NB = 8, SEQ = 4096, DM = 1024, T = NB * SEQ;
constexpr int NTHREADS = 512, NWAVES = 8;
constexpr int LDS_BYTES = 147456;
constexpr int N_IN0 = 2048, N_IN1 = 3072;
constexpr int C0_Q = 0, C0_K = 512, C0_V = 640, C0_IQ = 768, C0_U = 1280, C0_IK = 1792, C0_IW = 1856;
constexpr int C1_Q = 0, C1_KC = 512, C1_VC = 640, C1_KS = 768, C1_VS = 896, C1_KW = 1024, C1_VW = 1152, C1_GQ = 1280, C1_GK = 1536, C1_GV = 1792, C1_GR = 2304, C1_GL = 2816, C1_GLOW = 2840;

constexpr size_t MiB = 1u << 20;
constexpr size_t WS_CTL = 0;
constexpr size_t WS_ROPE = 1 * MiB;
constexpr size_t WS_W_IN0 = 2 * MiB;
constexpr size_t WS_W_GLU = 6 * MiB;
constexpr size_t WS_SK0 = 6 * MiB + 512 * 1024;
constexpr size_t WS_W_OUT0 = 7 * MiB;
constexpr size_t WS_WQ0 = 9 * MiB;
constexpr size_t WS_W_IN1 = 13 * MiB;
constexpr size_t WS_KW1 = 19 * MiB;
constexpr size_t WS_VW1 = 20 * MiB;
constexpr size_t WS_KW2 = 21 * MiB;
constexpr size_t WS_VW2 = 21 * MiB + 128 * 1024;
constexpr size_t WS_SK1 = 21 * MiB + 512 * 1024;
constexpr size_t WS_W_OUT1 = 22 * MiB;
constexpr size_t WS_WQ1 = 24 * MiB;
constexpr size_t WS_S5B1 = 28 * MiB;
constexpr size_t WS_S5B2 = 32 * MiB;
constexpr size_t WS_CMPB = 38 * MiB;
constexpr size_t WS_TABU = 48 * MiB;
constexpr size_t WS_TABV = 80 * MiB;
constexpr size_t WS_XN = 112 * MiB;
constexpr size_t WS_PROJ = 176 * MiB;
constexpr size_t WS_R3 = 368 * MiB;
constexpr size_t WS_END = 506 * MiB;

__device__ __forceinline__ unsigned f2bf(float f) { unsigned u = __builtin_bit_cast(unsigned, f); return (u + 0x7fffu + ((u >> 16) & 1u)) >> 16; }
__device__ __forceinline__ unsigned pk2(float lo, float hi) { return f2bf(lo) | (f2bf(hi) << 16); }
__device__ __forceinline__ float bf_lo(unsigned u) { return __builtin_bit_cast(float, u << 16); }
__device__ __forceinline__ float bf_hi(unsigned u) { return __builtin_bit_cast(float, u & 0xffff0000u); }
__device__ __forceinline__ float bf2f(bf16_t b) { return __builtin_bit_cast(float, ((unsigned)b) << 16); }
__device__ __forceinline__ float wave_sum(float v) {
#pragma unroll
    for (int o = 1; o < 64; o <<= 1) v += __shfl_xor(v, o);
    return v;
}
__device__ __forceinline__ float gelu_tanh(float x) {
    const float y = 0.7978845608028654f * (x + 0.044715f * x * x * x);
    const float e = __expf(2.0f * y);
    const float th = 1.0f - 2.0f / (e + 1.0f);
    return 0.5f * x * (1.0f + th);
}
__device__ __forceinline__ float sigmoidf_(float x) { return 1.0f / (1.0f + __expf(-x)); }
#define LDS_WAIT() asm volatile("s_waitcnt lgkmcnt(0)" ::: "memory")
#define VM_WAIT() asm volatile("s_waitcnt vmcnt(0)" ::: "memory")

#define XB_TMO      128
#define XB_XCNT(j)  (256  + 64 * (j))
#define XB_XSUB(j)  (1280 + 64 * (j))
#define XB_XGEN(j)  (2304 + 64 * (j))
#define XB_TOP      3328
#define XB_TOPGEN   3392
#define XCD_BAR_WORDS 3456
#define XB_SPIN_CAP (1u << 22)
__device__ __forceinline__ unsigned xb_ld(unsigned* p)              { return __hip_atomic_load(p, __ATOMIC_RELAXED, __HIP_MEMORY_SCOPE_AGENT); }
__device__ __forceinline__ unsigned xb_add(unsigned* p, unsigned v) { return __hip_atomic_fetch_add(p, v, __ATOMIC_RELAXED, __HIP_MEMORY_SCOPE_AGENT); }
__device__ __forceinline__ unsigned xb_xcc_id() { return (unsigned)__builtin_amdgcn_s_getreg((3 << 11) | 20) & 0xFu; }
#define XB_SPIN(cond, bar) do { unsigned _sp = 0; while (cond) { __builtin_amdgcn_s_sleep(1); \
    if ((++_sp & 255u) == 0u) { if (xb_ld(&(bar)[XB_TMO])) break; if (_sp > XB_SPIN_CAP) { atomicAdd(&(bar)[XB_TMO], 1u); break; } } } } while (0)
struct XcdBarrier { unsigned* bar; unsigned x; volatile LAS unsigned* st; };
__device__ __forceinline__ XcdBarrier xcd_barrier_post(unsigned* bar, volatile LAS unsigned* st) {
    XcdBarrier b; b.bar = bar; b.x = xb_xcc_id(); b.st = st;
    if (threadIdx.x == 0) (void)xb_add(&bar[XB_XCNT(b.x)], 1u);
    return b;
}
__device__ __forceinline__ void xcd_barrier_complete(unsigned* bar, unsigned x, unsigned& nloc, unsigned& nx) {
    const unsigned G = gridDim.x * gridDim.y * gridDim.z;
    unsigned sum, cnt, mine, sp = 0u;
    for (;;) {
        sum = 0u; cnt = 0u; mine = 0u;
#pragma unroll
        for (unsigned j = 0; j < 16; ++j) { const unsigned c = xb_ld(&bar[XB_XCNT(j)]); sum += c; cnt += (c > 0u) ? 1u : 0u; mine = (j == x) ? c : mine; }
        if (sum == G) break;
        __builtin_amdgcn_s_sleep(1);
        if ((++sp & 255u) == 0u) { if (xb_ld(&bar[XB_TMO])) break; if (sp > XB_SPIN_CAP) { atomicAdd(&bar[XB_TMO], 1u); break; } }
    }
    nloc = mine > 0u ? mine : 1u; nx = cnt > 0u ? cnt : 1u;
}
__device__ __forceinline__ void xcd_barrier(const XcdBarrier& b) {
    asm volatile("s_waitcnt vmcnt(0)" ::: "memory");
    __syncthreads();
    if (threadIdx.x == 0) {
        unsigned* bar = b.bar;
        __builtin_amdgcn_s_waitcnt(0);
        unsigned nloc = b.st[0], nx = b.st[1];
        if (nloc == 0u) { xcd_barrier_complete(bar, b.x, nloc, nx); b.st[0] = nloc; b.st[1] = nx; }
        const unsigned old = xb_add(&bar[XB_XSUB(b.x)], 1u);
        const unsigned gen = old / nloc;
        if (old + 1u == (gen + 1u) * nloc) {
            __builtin_amdgcn_fence(__ATOMIC_RELEASE, "agent");
            asm volatile("s_waitcnt vmcnt(0)" ::: "memory");
            const unsigned og = xb_add(&bar[XB_TOP], 1u);
            const unsigned tg = og / nx;
            if (og + 1u == (tg + 1u) * nx) xb_add(&bar[XB_TOPGEN], 1u);
            else XB_SPIN(xb_ld(&bar[XB_TOPGEN]) == tg, bar);
            __builtin_amdgcn_fence(__ATOMIC_ACQUIRE, "agent");
            xb_add(&bar[XB_XGEN(b.x)], 1u);
            asm volatile("s_waitcnt vmcnt(0)" ::: "memory");
        } else {
            XB_SPIN(xb_ld(&bar[XB_XGEN(b.x)]) == gen, bar);
            __builtin_amdgcn_fence(__ATOMIC_ACQUIRE, "agent");
            asm volatile("s_waitcnt vmcnt(0)" ::: "memory");
        }
    }
    __syncthreads();
}

namespace pg8 {
constexpr int BM = 256, BK = 64, HALF = 128, HTB = HALF * BK * 2, STAGE_BYTES = 8 * HTB, NXCD = 8, WGM = 8;
__device__ __forceinline__ int lds_byte(int r, int c) { const int st = (r >> 4) * 2 + (c >> 5), rr = r & 15, cc = c & 31, ob = rr * 64 + cc * 2; return st * 1024 + (ob ^ (((ob >> 9) & 1) << 5)); }
__device__ __forceinline__ void stage_rc(int b, int& R, int& C) { const int st = b / 1024, sb = b % 1024, swz = sb ^ (((sb >> 9) & 1) << 5); R = (st >> 1) * 16 + swz / 64; C = (st & 1) * 32 + (swz % 64) / 2; }
__device__ __forceinline__ int perm32(int rho) { const int n = rho >> 4, i = rho & 15; return 8 * (i >> 2) + 4 * n + (i & 3); }
struct Unit { int pm, pn; };
struct Gemm { const bf16_t* A; const bf16_t* Bt; int M, N, K, lda, ldb; };
struct StaticOrder {
    int nM, nN, nwg, G, c;
    __device__ void init(int M, int N, int G_, int c_) { nM = M / BM; nN = N / BM; nwg = nM * nN; G = G_; c = c_; }
    __device__ bool next(int i, Unit& u) const {
        const long L = (long)i * G + c; if (L >= nwg) return false;
        int wgid = (int)L; { const int q = nwg / NXCD, r = nwg % NXCD, xcd = wgid % NXCD, off = wgid / NXCD; wgid = (xcd < r ? xcd * (q + 1) : r * (q + 1) + (xcd - r) * q) + off; }
        const int nig = WGM * nN, gid = wgid / nig, fm = gid * WGM, gsz = (nM - fm) < WGM ? (nM - fm) : WGM;
        u.pm = fm + ((wgid % nig) % gsz); u.pn = (wgid % nig) / gsz; return true;
    }
};
struct GroupedOrder {
    int nwg, G, c, tpg;
    __device__ void init(int ntiles, int tiles_per_group, int G_, int c_) { nwg = ntiles; tpg = tiles_per_group; G = G_; c = c_; }
    __device__ bool next(int i, Unit& u) const { const long L = (long)i * G + c; if (L >= nwg) return false; u.pm = (int)L; u.pn = (int)L / tpg; return true; }
};
__device__ __forceinline__ unsigned cvt_pk_bf16(float lo, float hi) { unsigned r; asm volatile("v_cvt_pk_bf16_f32 %0, %1, %2" : "=v"(r) : "v"(lo), "v"(hi)); return r; }

template <class Epi, class Sched>
__device__ __forceinline__ void gemm_phase(LAS unsigned char* lds, const Gemm g, const Sched& S, const Epi& E) {
    const int tid = threadIdx.x, wid = __builtin_amdgcn_readfirstlane(tid >> 6), lane = tid & 63, wr = wid >> 2, wc = wid & 3, fr = lane & 15, fq = lane >> 4;
    int K = g.K; asm volatile("" : "+s"(K));
    const int nt = K / BK;
    unsigned voffA[2], voffB[2];
#pragma unroll
    for (int i = 0; i < 2; ++i) { int R, C; stage_rc(tid * 16 + i * 8192, R, C); const int Rb = Epi::PERM ? ((R & ~31) + perm32(R & 31)) : R;
        voffA[i] = (unsigned)(R * g.lda + C) * 2u; voffB[i] = (unsigned)(Rb * g.ldb + C) * 2u; }
    const size_t kstep = (size_t)(BK * 2);
    const size_t hstepA = (size_t)HALF * g.lda * 2, hstepB = (size_t)HALF * g.ldb * 2;
    const size_t tstepA = 2 * hstepA, tstepB = 2 * hstepB;
    const unsigned ldsw = (unsigned)wid * 1024u;
    const int aoff = lds_byte(wr * 64 + fr, fq * 8), boff = lds_byte(wc * 32 + fr, fq * 8);
#define PG8_SA(b, h) (((b) * 2 + (h)) * HTB)
#define PG8_SB(b, h) ((4 + (b) * 2 + (h)) * HTB)
#define PG8_STAGE(bufoff, gbase, voff) do { _Pragma("unroll") for (int _i = 0; _i < 2; ++_i) \
        __builtin_amdgcn_global_load_lds((const unsigned*)((const char*)(gbase) + (voff)[_i]), (LAS unsigned*)(lds + (bufoff) + ldsw + _i * 8192), 16, 0, 0); } while (0)
#define PG8_LDA(dst, b, h) do { _Pragma("unroll") for (int m = 0; m < 4; ++m) _Pragma("unroll") for (int k = 0; k < 2; ++k) dst[m][k] = *(const LAS bf16x8*)(lds + PG8_SA(b, h) + aoff + m * 2048 + k * 1024); } while (0)
#define PG8_LDB(dst, b, h) do { _Pragma("unroll") for (int n = 0; n < 2; ++n) _Pragma("unroll") for (int k = 0; k < 2; ++k) dst[n][k] = *(const LAS bf16x8*)(lds + PG8_SB(b, h) + boff + n * 2048 + k * 1024); } while (0)
#define PG8_MMA(ai, bj, At, Bt) do { __builtin_amdgcn_s_setprio(1); _Pragma("unroll") for (int m = 0; m < 4; ++m) _Pragma("unroll") for (int n = 0; n < 2; ++n) _Pragma("unroll") for (int k = 0; k < 2; ++k) \
        acc[ai][bj][m][n] = __builtin_amdgcn_mfma_f32_16x16x32_bf16(Bt[n][k], At[m][k], acc[ai][bj][m][n], 0, 0, 0); __builtin_amdgcn_s_setprio(0); } while (0)
#define PG8_WAIT_V(n) asm volatile("s_waitcnt vmcnt(" #n ")" ::: "memory")
#define PG8_WAIT_L(n) asm volatile("s_waitcnt lgkmcnt(" #n ")" ::: "memory")
#define PG8_BAR __builtin_amdgcn_s_barrier()
#define PG8_SCHED __builtin_amdgcn_sched_barrier(0)
    Unit cur, nxt; int ui = 0;
    if (!S.next(0, cur)) return;
    f32x4 acc[2][2][4][2];
#pragma unroll
    for (int a = 0; a < 2; ++a)
#pragma unroll
        for (int b = 0; b < 2; ++b)
#pragma unroll
            for (int m = 0; m < 4; ++m)
#pragma unroll
                for (int n = 0; n < 2; ++n) acc[a][b][m][n] = (f32x4){0.f, 0.f, 0.f, 0.f};
    bf16x8 At[4][2], B0[2][2], B1[2][2];
    const char* cA = (const char*)g.A + (size_t)cur.pm * tstepA; const char* cB = (const char*)g.Bt + (size_t)cur.pn * tstepB;
    PG8_STAGE(PG8_SB(0, 0), cB, voffB); PG8_STAGE(PG8_SA(0, 0), cA, voffA); PG8_STAGE(PG8_SB(0, 1), cB + hstepB, voffB); PG8_STAGE(PG8_SA(0, 1), cA + hstepA, voffA);
    if (wr == 1) PG8_BAR;
    PG8_WAIT_V(4); PG8_BAR;
    PG8_STAGE(PG8_SB(1, 0), cB + kstep, voffB); PG8_STAGE(PG8_SA(1, 0), cA + kstep, voffA); PG8_STAGE(PG8_SB(1, 1), cB + hstepB + kstep, voffB);
    PG8_WAIT_V(6); PG8_BAR;
    for (;;) {
        const bool has_next = S.next(ui + 1, nxt);
        const char* nA = has_next ? (const char*)g.A + (size_t)nxt.pm * tstepA : cA; const char* nB = has_next ? (const char*)g.Bt + (size_t)nxt.pn * tstepB : cB;
        for (int t = 0; t < nt; t += 2) {
            const bool last = (t == nt - 2);
            const char* a1 = cA + (size_t)(t + 1) * kstep;
            const char* a2 = last ? nA : cA + (size_t)(t + 2) * kstep; const char* b2 = last ? nB : cB + (size_t)(t + 2) * kstep;
            const char* a3 = a2 + kstep; const char* b3 = b2 + kstep;
            PG8_LDB(B0, 0, 0); PG8_SCHED; PG8_LDA(At, 0, 0); PG8_STAGE(PG8_SA(1, 1), a1 + hstepA, voffA);
            PG8_WAIT_L(8); PG8_BAR; PG8_WAIT_L(0); PG8_MMA(0, 0, At, B0); PG8_BAR; PG8_SCHED;
            PG8_LDB(B1, 0, 1); PG8_STAGE(PG8_SB(0, 0), b2, voffB);
            PG8_BAR; PG8_WAIT_L(0); PG8_MMA(0, 1, At, B1); PG8_BAR;
            PG8_LDA(At, 0, 1); PG8_STAGE(PG8_SA(0, 0), a2, voffA);
            PG8_BAR; PG8_WAIT_L(0); PG8_MMA(1, 0, At, B0); PG8_BAR; PG8_SCHED;
            PG8_STAGE(PG8_SB(0, 1), b2 + hstepB, voffB);
            PG8_WAIT_V(6); PG8_BAR; PG8_MMA(1, 1, At, B1); PG8_BAR;
            PG8_LDB(B0, 1, 0); PG8_SCHED; PG8_LDA(At, 1, 0); PG8_STAGE(PG8_SA(0, 1), a2 + hstepA, voffA);
            PG8_WAIT_L(8); PG8_BAR; PG8_WAIT_L(0); PG8_MMA(0, 0, At, B0); PG8_BAR; PG8_SCHED;
            PG8_LDB(B1, 1, 1); PG8_STAGE(PG8_SB(1, 0), b3, voffB);
            PG8_BAR; PG8_WAIT_L(0); PG8_MMA(0, 1, At, B1); PG8_BAR;
            PG8_LDA(At, 1, 1); PG8_STAGE(PG8_SA(1, 0), a3, voffA);
            PG8_BAR; PG8_WAIT_L(0); PG8_MMA(1, 0, At, B0); PG8_BAR; PG8_SCHED;
            PG8_STAGE(PG8_SB(1, 1), b3 + hstepB, voffB);
            PG8_WAIT_V(6); PG8_BAR; PG8_MMA(1, 1, At, B1); PG8_BAR;
        }
        E(acc, cur, wr, wc, fr, fq);
        if (!has_next) break;
#pragma unroll
        for (int a = 0; a < 2; ++a)
#pragma unroll
            for (int b = 0; b < 2; ++b)
#pragma unroll
                for (int m = 0; m < 4; ++m)
#pragma unroll
                    for (int n = 0; n < 2; ++n) acc[a][b][m][n] = (f32x4){0.f, 0.f, 0.f, 0.f};
        cur = nxt; cA = nA; cB = nB; ++ui;
    }
    PG8_WAIT_V(0);
    if (wr == 0) PG8_BAR;
    PG8_BAR;
#undef PG8_SA
#undef PG8_SB
#undef PG8_STAGE
#undef PG8_LDA
#undef PG8_LDB
#undef PG8_MMA
#undef PG8_WAIT_V
#undef PG8_WAIT_L
#undef PG8_BAR
#undef PG8_SCHED
}

struct EpiStoreBf16 {
    static constexpr bool PERM = true;
    bf16_t* O; int ldc;
    __device__ __forceinline__ void operator()(const f32x4 (&acc)[2][2][4][2], const Unit& u, int wr, int wc, int fr, int fq) const {
        const int row0 = u.pm * BM + wr * 64 + fr, col0 = u.pn * BM + wc * 32 + 8 * fq;
#pragma unroll
        for (int ai = 0; ai < 2; ++ai)
#pragma unroll
            for (int m = 0; m < 4; ++m) { bf16_t* rowp = O + (size_t)(row0 + ai * HALF + m * 16) * ldc + col0;
#pragma unroll
                for (int bj = 0; bj < 2; ++bj) { const f32x4 v0 = acc[ai][bj][m][0], v1 = acc[ai][bj][m][1];
                    u32x4 w; w.x = cvt_pk_bf16(v0[0], v0[1]); w.y = cvt_pk_bf16(v0[2], v0[3]); w.z = cvt_pk_bf16(v1[0], v1[1]); w.w = cvt_pk_bf16(v1[2], v1[3]);
                    *(u32x4*)(rowp + bj * HALF) = w; } }
    }
};
struct EpiResidF32 {
    static constexpr bool PERM = false;
    const float* R; float* C; int ldc;
    __device__ __forceinline__ void operator()(const f32x4 (&acc)[2][2][4][2], const Unit& u, int wr, int wc, int fr, int fq) const {
        const int row0 = u.pm * BM + wr * 64 + fr, col0 = u.pn * BM + wc * 32 + 4 * fq;
#pragma unroll
        for (int ai = 0; ai < 2; ++ai)
#pragma unroll
            for (int m = 0; m < 4; ++m) { const size_t off = (size_t)(row0 + ai * HALF + m * 16) * ldc + col0;
#pragma unroll
                for (int bj = 0; bj < 2; ++bj)
#pragma unroll
                    for (int n = 0; n < 2; ++n) { const f32x4 r = *(const f32x4*)(R + off + bj * HALF + n * 16); *(f32x4*)(C + off + bj * HALF + n * 16) = r + acc[ai][bj][m][n]; } }
    }
};
}

struct Args {
    const float* in[39];
    float* out;
    unsigned char* ws;
    int ph_lo, ph_hi;
};
enum { I_X = 0, I_L0_MIXN, I_L0_WIN, I_L0_QG, I_L0_KG, I_L0_LOGDT, I_L0_ARE, I_L0_AIM, I_L0_BRE, I_L0_BIM, I_L0_CRE, I_L0_CIM, I_L0_D, I_L0_WGLU, I_L0_BGLU, I_L0_WOUT,
       I_L0_FFNN, I_L0_WQ, I_L0_SK, I_L0_U, I_L0_V,
       I_L1_MIXN, I_L1_WIN, I_L1_QG, I_L1_KG, I_L1_CMPPOS, I_L1_KW1, I_L1_KW2, I_L1_VW1, I_L1_VW2, I_L1_WGATE, I_L1_BGATE, I_L1_OGAIN, I_L1_WOUT,
       I_L1_FFNN, I_L1_WQ, I_L1_SK, I_L1_U, I_L1_V };

struct Frame {
    LAS unsigned char* lds;
    int tid, lane, wave, G, bid;
};

constexpr size_t L0_QA = WS_R3;
constexpr size_t L0_IQ = WS_R3 + 32 * MiB;
constexpr size_t L0_KA = WS_R3 + 64 * MiB;
constexpr size_t L0_VAT = WS_R3 + 72 * MiB;
constexpr size_t L0_IK = WS_R3 + 80 * MiB;
constexpr size_t L0_IW = WS_R3 + 84 * MiB;
constexpr size_t L0_UA = WS_R3 + 88 * MiB;
constexpr size_t L0_SELT = WS_PROJ;
constexpr size_t L0_CAT = WS_PROJ + 16 * MiB;
constexpr size_t L0_SLOC = WS_PROJ + 80 * MiB;
constexpr size_t L0_YB = WS_PROJ + 112 * MiB;
constexpr size_t PE_Q2 = WS_PROJ;
constexpr size_t PE_EID = WS_PROJ + 128 * MiB;
constexpr size_t PE_GATE = WS_PROJ + 136 * MiB;

template <class Map>
__device__ __forceinline__ void transpose_item(const float* W, int K, int N, bf16_t* WT, int ldk, LAS float* scr, int item, int lane, const Map& map) {
    const int nblk = (N + 31) / 32, kb = item / nblk, nb = item % nblk, k0 = 64 * kb, n0 = 32 * nb;
    const int ncol = n0 + (lane & 31);
#pragma unroll 8
    for (int i = 0; i < 32; ++i) { const int kk = 2 * i + (lane >> 5); scr[kk * 33 + (lane & 31)] = (ncol < N) ? W[(size_t)(k0 + kk) * N + ncol] : 0.f; }
    LDS_WAIT(); asm volatile("" ::: "memory");
    const int c = lane & 7;
#pragma unroll
    for (int j = 0; j < 4; ++j) { const int n = (lane >> 3) + 8 * j; const LAS float* s = scr + (8 * c) * 33 + n;
        u32x4 o; o.x = pk2(s[0 * 33], s[1 * 33]); o.y = pk2(s[2 * 33], s[3 * 33]); o.z = pk2(s[4 * 33], s[5 * 33]); o.w = pk2(s[6 * 33], s[7 * 33]);
        if (n0 + n < N) *(u32x4*)(WT + (size_t)map(n0 + n) * ldk + k0 + 8 * c) = o; }
    LDS_WAIT(); asm volatile("" ::: "memory");
}
struct MapId { __device__ __forceinline__ int operator()(int n) const { return n; } };
struct MapIn0 { __device__ __forceinline__ int operator()(int n) const { return n < 1280 ? n : (n < 1344 ? n - 1280 + C0_IK : (n < 1352 ? n - 1344 + C0_IW : n - 1352 + C0_U)); } };
struct MapIn1 { __device__ __forceinline__ int operator()(int n) const {
    if (n < 1280) return n; if (n < 1304) return n - 1280 + C1_GL; if (n < 1560) return n - 1304 + C1_GQ; if (n < 1816) return n - 1560 + C1_GK;
    if (n < 2328) return n - 1816 + C1_GV; if (n < 2344) return n - 2328 + C1_GLOW; return n - 2344 + C1_GR; } };

template <class Map>
__device__ __forceinline__ void transpose_all(const Frame& F, int& base, const float* W, int K, int N, bf16_t* WT, int ldk, const Map& map) {
    LAS float* scr = (LAS float*)(F.lds + F.wave * 16384);
    const int gw = F.bid * NWAVES + F.wave, NGW = F.G * NWAVES;
    const int nit = (K / 64) * ((N + 31) / 32);
    for (int it = (gw + NGW - (base % NGW)) % NGW; it < nit; it += NGW) transpose_item(W, K, N, WT, ldk, scr, it, F.lane, map);
    base += nit;
}
__device__ __forceinline__ void zero_bytes(const Frame& F, unsigned char* p, size_t nbytes) {
    const size_t n16 = nbytes / 16;
    for (size_t i = (size_t)F.bid * NTHREADS + F.tid; i < n16; i += (size_t)F.G * NTHREADS) ((u32x4*)p)[i] = (u32x4){0u, 0u, 0u, 0u};
}
__device__ __forceinline__ void cvt_f32_bf16(const Frame& F, const float* src, bf16_t* dst, size_t n) {
    const size_t n8 = n / 8;
    for (size_t i = (size_t)F.bid * NTHREADS + F.tid; i < n8; i += (size_t)F.G * NTHREADS) {
        const f32x4 a = ((const f32x4*)src)[2 * i], b = ((const f32x4*)src)[2 * i + 1];
        u32x4 o; o.x = pk2(a.x, a.y); o.y = pk2(a.z, a.w); o.z = pk2(b.x, b.y); o.w = pk2(b.z, b.w);
        ((u32x4*)dst)[i] = o;
    }
}

__device__ __forceinline__ void rms_row_to_bf16(const float* xrow, const float* gain, bf16_t* orow, int lane) {
    const f32x4* xr = (const f32x4*)xrow + lane; const f32x4* gr = (const f32x4*)gain + lane;
    f32x4 v[4]; float s = 0.f;
#pragma unroll
    for (int j = 0; j < 4; ++j) { v[j] = xr[64 * j]; s += (v[j].x * v[j].x + v[j].y * v[j].y) + (v[j].z * v[j].z + v[j].w * v[j].w); }
    const float rstd = 1.0f / sqrtf(wave_sum(s) * (1.f / DM) + 1e-6f);
    u64* o8 = (u64*)orow + lane;
#pragma unroll
    for (int j = 0; j < 4; ++j) { const f32x4 g4 = gr[64 * j]; o8[64 * j] = (u64)pk2(v[j].x * rstd * g4.x, v[j].y * rstd * g4.y) | ((u64)pk2(v[j].z * rstd * g4.z, v[j].w * rstd * g4.w) << 32); }
}
__device__ __forceinline__ void p_rmsnorm(const Frame& F, const float* x, const float* gain, bf16_t* XN) {
    const int gw = F.bid * NWAVES + F.wave, NGW = F.G * NWAVES;
    for (int m = gw; m < T; m += NGW) rms_row_to_bf16(x + (size_t)m * DM, gain, XN + (size_t)m * DM, F.lane);
}

__device__ __forceinline__ void p_rope_table(const Frame& F, f32x2* rope) {
    for (int i = F.bid * NTHREADS + F.tid; i < SEQ * 32; i += F.G * NTHREADS) {
        const int pos = i >> 5, k = i & 31;
        const float inv = powf(10000.0f, -(float)k / 32.0f);
        const float ang = (float)pos * inv;
        float s, c; sincosf(ang, &s, &c);
        rope[i] = (f32x2){c, s};
    }
}

__device__ __forceinline__ void s5_build_group(const Frame& F, const Args& a, unsigned char* ws, int g) {
    LAS f32x2* abp = (LAS f32x2*)F.lds;
    LAS f32x2* bb = abp + 17 * 64;
    LAS f32x2* Cc = bb + 64 * 16;
    LAS float* KT = (LAS float*)(Cc + 16 * 64);
    const float dt = expf(a.in[I_L0_LOGDT][g]);
    for (int idx = F.tid; idx < 17 * 64; idx += NTHREADS) {
        const int tau = idx >> 6, p = idx & 63;
        const float lr = a.in[I_L0_ARE][g * 64 + p], li = a.in[I_L0_AIM][g * 64 + p];
        const float mag = expf((float)tau * dt * lr); float s, c; sincosf((float)tau * dt * li, &s, &c);
        abp[idx] = (f32x2){mag * c, mag * s};
    }
    for (int idx = F.tid; idx < 64 * 16; idx += NTHREADS) {
        const int p = idx >> 4, c = idx & 15;
        const float lr = a.in[I_L0_ARE][g * 64 + p], li = a.in[I_L0_AIM][g * 64 + p];
        const float mag = expf(dt * lr); float s, co; sincosf(dt * li, &s, &co);
        const float abr = mag * co, abi = mag * s, den = lr * lr + li * li;
        const float fr = ((abr - 1.0f) * lr + abi * li) / den, fi = (abi * lr - (abr - 1.0f) * li) / den;
        const float br = a.in[I_L0_BRE][(size_t)(g * 64 + p) * 16 + c], bi = a.in[I_L0_BIM][(size_t)(g * 64 + p) * 16 + c];
        bb[idx] = (f32x2){fr * br - fi * bi, fr * bi + fi * br};
    }
    for (int idx = F.tid; idx < 16 * 64; idx += NTHREADS) Cc[idx] = (f32x2){a.in[I_L0_CRE][(size_t)g * 1024 + idx], a.in[I_L0_CIM][(size_t)g * 1024 + idx]};
    __syncthreads();
    for (int idx = F.tid; idx < 16 * 256; idx += NTHREADS) {
        const int tau = idx >> 8, co = (idx >> 4) & 15, ci = idx & 15;
        float acc = 0.f;
        for (int p = 0; p < 64; ++p) {
            const f32x2 c = Cc[co * 64 + p], e = abp[tau * 64 + p], b = bb[p * 16 + ci];
            const float er = c.x * e.x - c.y * e.y, ei = c.x * e.y + c.y * e.x;
            acc += er * b.x - ei * b.y;
        }
        if (tau == 0 && co == ci) acc += a.in[I_L0_D][g * 16 + co];
        KT[idx] = acc;
    }
    __syncthreads();
    bf16_t* B1 = (bf16_t*)(ws + WS_S5B1) + (size_t)g * 256 * 256;
    bf16_t* B2 = (bf16_t*)(ws + WS_S5B2) + (size_t)g * 256 * 384;
    for (int idx = F.tid; idx < 256 * 128; idx += NTHREADS) {
        const int n = idx >> 7, k = (idx & 127) * 2;
        float v0 = 0.f, v1 = 0.f;
        if (n < 128) { const int p = n & 63, j = k >> 4, ci = k & 15; const f32x2 e = abp[(15 - j) * 64 + p], b0 = bb[p * 16 + ci], b1 = bb[p * 16 + ci + 1];
            if (n < 64) { v0 = e.x * b0.x - e.y * b0.y; v1 = e.x * b1.x - e.y * b1.y; } else { v0 = e.x * b0.y + e.y * b0.x; v1 = e.x * b1.y + e.y * b1.x; } }
        *(unsigned*)(B1 + (size_t)n * 256 + k) = pk2(v0, v1);
    }
    for (int idx = F.tid; idx < 256 * 192; idx += NTHREADS) {
        const int n = idx / 192, k = (idx % 192) * 2, i = n >> 4, co = n & 15;
        float v0 = 0.f, v1 = 0.f;
        if (k < 256) { const int j = k >> 4, ci = k & 15; if (j <= i) { v0 = KT[((i - j) * 16 + co) * 16 + ci]; v1 = KT[((i - j) * 16 + co) * 16 + ci + 1]; } }
        else { const int p = (k - 256) & 63; const bool im = k >= 320;
            const f32x2 c0 = Cc[co * 64 + p], e0 = abp[(i + 1) * 64 + p], c1 = Cc[co * 64 + p + 1], e1 = abp[(i + 1) * 64 + p + 1];
            if (!im) { v0 = c0.x * e0.x - c0.y * e0.y; v1 = c1.x * e1.x - c1.y * e1.y; } else { v0 = -(c0.x * e0.y + c0.y * e0.x); v1 = -(c1.x * e1.y + c1.y * e1.x); } }
        *(unsigned*)(B2 + (size_t)n * 384 + k) = pk2(v0, v1);
    }
    __syncthreads();
}

__device__ __forceinline__ void cmp_bias(const Frame& F, const Args& a, float* out) {
    const int n = F.tid & 255, w = F.tid >> 8;
    const float* w1 = a.in[w ? I_L1_VW1 : I_L1_KW1]; const float* pos = a.in[I_L1_CMPPOS];
    float acc = 0.f;
    for (int k = 0; k < 2048; ++k) acc += pos[k] * w1[(size_t)k * 256 + n];
    out[w * 256 + n] = acc;
}

__device__ __forceinline__ float rope_apply(float v, const f32x2 cs, int lane) {
    const float partner = __shfl_xor(v, 32);
    return lane < 32 ? v * cs.x - partner * cs.y : partner * cs.y + v * cs.x;
}
__device__ __forceinline__ void p_l0_prep(const Frame& F, const Args& a, unsigned char* ws) {
    const bf16_t* P = (const bf16_t*)(ws + WS_PROJ);
    const f32x2* rope = (const f32x2*)(ws + WS_ROPE);
    bf16_t* QA = (bf16_t*)(ws + L0_QA); bf16_t* IQ = (bf16_t*)(ws + L0_IQ); bf16_t* KA = (bf16_t*)(ws + L0_KA); bf16_t* VAT = (bf16_t*)(ws + L0_VAT);
    bf16_t* IK = (bf16_t*)(ws + L0_IK); float* IW = (float*)(ws + L0_IW); bf16_t* UA = (bf16_t*)(ws + L0_UA);
    const int gw = F.bid * NWAVES + F.wave, NGW = F.G * NWAVES, lane = F.lane;
    const float qg = a.in[I_L0_QG][lane], kg = a.in[I_L0_KG][lane];
    for (int m = gw; m < T; m += NGW) {
        const int b = m >> 12, t = m & 4095;
        const bf16_t* row = P + (size_t)m * N_IN0;
        const f32x2 cs = rope[t * 32 + (lane & 31)];
#pragma unroll
        for (int h = 0; h < 8; ++h) {
            float v = bf2f(row[C0_Q + h * 64 + lane]);
            const float ss = wave_sum(v * v);
            v = v * (1.0f / sqrtf(ss * (1.f / 64.f) + 1e-6f)) * qg;
            v = rope_apply(v, cs, lane) * 0.125f;
            QA[(size_t)m * 512 + h * 64 + lane] = (bf16_t)f2bf(v);
        }
#pragma unroll
        for (int g = 0; g < 2; ++g) {
            float v = bf2f(row[C0_K + g * 64 + lane]);
            const float ss = wave_sum(v * v);
            v = v * (1.0f / sqrtf(ss * (1.f / 64.f) + 1e-6f)) * kg;
            v = rope_apply(v, cs, lane);
            KA[((size_t)(b * 2 + g) * 4096 + t) * 64 + lane] = (bf16_t)f2bf(v);
        }
#pragma unroll
        for (int h = 0; h < 8; ++h) {
            float v = bf2f(row[C0_IQ + h * 64 + lane]);
            v = rope_apply(v, cs, lane) * 0.125f;
            IQ[(size_t)m * 512 + h * 64 + lane] = (bf16_t)f2bf(v);
        }
        { float v = bf2f(row[C0_IK + lane]); v = rope_apply(v, cs, lane); IK[(size_t)m * 64 + lane] = (bf16_t)f2bf(v); }
        if (lane < 8) IW[(size_t)m * 8 + lane] = bf2f(row[C0_IW + lane]) * 0.35355339059327373f;
        { const u32x4 uv = *(const u32x4*)(row + C0_U + lane * 8); const int g = lane >> 1;
          *(u32x4*)(UA + ((size_t)g * 2048 + (m >> 4)) * 384 + (m & 15) * 16 + (lane & 1) * 8) = uv; }
    }
    for (int it = gw; it < NB * 2 * 64; it += NGW) {
        const int tb = it & 63, g = (it >> 6) & 1, b = it >> 7;
        const size_t m = (size_t)b * 4096 + tb * 64 + lane;
        unsigned r[32];
#pragma unroll
        for (int j = 0; j < 8; ++j) { const u32x4 q = *(const u32x4*)(P + m * N_IN0 + C0_V + g * 64 + j * 8); r[4 * j] = q.x; r[4 * j + 1] = q.y; r[4 * j + 2] = q.z; r[4 * j + 3] = q.w; }
        bf16_t* dst = VAT + ((size_t)(b * 2 + g) * 64) * 4096 + tb * 64 + lane;
#pragma unroll
        for (int d = 0; d < 64; ++d) dst[(size_t)d * 4096] = (bf16_t)((d & 1) ? (r[d >> 1] >> 16) : (r[d >> 1] & 0xffffu));
    }
}

__device__ __forceinline__ unsigned f16key(unsigned raw) { return (raw & 0x8000u) ? (~raw & 0xFFFFu) : (raw | 0x8000u); }
__device__ __forceinline__ void p_dsa_index(const Frame& F, unsigned char* ws) {
    const bf16_t* IQ = (const bf16_t*)(ws + L0_IQ); const bf16_t* IK = (const bf16_t*)(ws + L0_IK); const float* IW = (const float*)(ws + L0_IW);
    u64* SELT = (u64*)(ws + L0_SELT);
    LAS _Float16* sc = (LAS _Float16*)F.lds;
    LAS unsigned short* scu = (LAS unsigned short*)F.lds;
    LAS u64* mk = (LAS u64*)(F.lds + 131072);
    LAS float* wl = (LAS float*)(F.lds + 131072 + 8192);
    const int lane = F.lane, wave = F.wave, h = lane >> 5, r = lane & 31;
    const int rq = ((r >> 4) & 1) + 2 * ((r >> 2) & 1), rh = 4 * ((r >> 3) & 1) + (r & 3);
    for (int u = F.bid; u < 2048; u += F.G) {
        const int idx = u & 255, b = u >> 8;
        const int j = (b & 1) ? 255 - idx : idx;
        const int t0 = j * 16; const size_t mb = (size_t)b * 4096;
        if (F.tid < 128) wl[F.tid] = IW[(mb + t0) * 8 + F.tid];
        const int nkb = (t0 + 15) / 32 + 1;
        bf16x8 Af[4][4];
#pragma unroll
        for (int rt = 0; rt < 4; ++rt)
#pragma unroll
            for (int ks = 0; ks < 4; ++ks) Af[rt][ks] = *(const bf16x8*)(IQ + (mb + t0 + 4 * rt + rq) * 512 + rh * 64 + ks * 16 + 8 * h);
        __syncthreads();
        for (int kb = wave; kb < nkb; kb += NWAVES) {
            bf16x8 Bf[4];
#pragma unroll
            for (int ks = 0; ks < 4; ++ks) Bf[ks] = *(const bf16x8*)(IK + (mb + kb * 32 + r) * 64 + ks * 16 + 8 * h);
#pragma unroll
            for (int rt = 0; rt < 4; ++rt) {
                f32x16 acc = {0.f, 0.f, 0.f, 0.f, 0.f, 0.f, 0.f, 0.f, 0.f, 0.f, 0.f, 0.f, 0.f, 0.f, 0.f, 0.f};
#pragma unroll
                for (int ks = 0; ks < 4; ++ks) acc = __builtin_amdgcn_mfma_f32_32x32x16_bf16(Af[rt][ks], Bf[ks], acc, 0, 0, 0);
                const int qa = 4 * rt + 2 * h;
                const f32x4 wa0 = *(const LAS f32x4*)(wl + qa * 8), wa1 = *(const LAS f32x4*)(wl + qa * 8 + 4), wb0 = *(const LAS f32x4*)(wl + qa * 8 + 8), wb1 = *(const LAS f32x4*)(wl + qa * 8 + 12);
                float sa = 0.f, sb = 0.f;
#pragma unroll
                for (int i = 0; i < 4; ++i) { sa += wa0[i] * fmaxf(acc[i], 0.f); sa += wa1[i] * fmaxf(acc[4 + i], 0.f); sb += wb0[i] * fmaxf(acc[8 + i], 0.f); sb += wb1[i] * fmaxf(acc[12 + i], 0.f); }
                sc[qa * 4096 + kb * 32 + r] = (_Float16)sa;
                sc[(qa + 1) * 4096 + kb * 32 + r] = (_Float16)sb;
            }
        }
        __syncthreads();
#pragma unroll 1
        for (int qq = 0; qq < 2; ++qq) {
            const int q = wave * 2 + qq, t = t0 + q, n = t + 1;
            unsigned mylo = 0u, myhi = 0u;
            if (n <= 256) {
                const int base = lane * 64;
                const u64 word = (base + 63 <= t) ? ~0ull : (base > t ? 0ull : ((1ull << (t - base + 1)) - 1ull));
                mylo = (unsigned)word; myhi = (unsigned)(word >> 32);
            } else {
                const int nw = (n + 63) >> 6;
                unsigned kk[32];
#pragma unroll
                for (int jj = 0; jj < 32; ++jj) {
                    unsigned lo16 = 0u, hi16 = 0u;
                    if (2 * jj < nw) { const int e = (2 * jj) * 64 + lane; const unsigned raw = scu[q * 4096 + e]; lo16 = (e <= t) ? f16key(raw) : 0u; }
                    if (2 * jj + 1 < nw) { const int e = (2 * jj + 1) * 64 + lane; const unsigned raw = scu[q * 4096 + e]; hi16 = (e <= t) ? f16key(raw) : 0u; }
                    kk[jj] = lo16 | (hi16 << 16);
                }
                unsigned prefix = 0u;
#pragma unroll 1
                for (int bit = 15; bit >= 0; --bit) {
                    const unsigned cand = prefix | (1u << bit), candhi = cand << 16;
                    int cnt = 0;
#pragma unroll
                    for (int jj = 0; jj < 32; ++jj) if (2 * jj < nw) {
                        cnt += __builtin_popcountll(__ballot((kk[jj] & 0xffffu) >= cand));
                        cnt += __builtin_popcountll(__ballot(kk[jj] >= candhi));
                    }
                    if (cnt >= 256) prefix = cand;
                }
                const unsigned Tk = prefix;
                int cgt = 0;
#pragma unroll
                for (int jj = 0; jj < 32; ++jj) if (2 * jj < nw) {
                    cgt += __builtin_popcountll(__ballot((kk[jj] & 0xffffu) > Tk));
                    cgt += __builtin_popcountll(__ballot((kk[jj] >> 16) > Tk));
                }
                const int need = 256 - cgt;
                int run = 0;
#pragma unroll
                for (int i = 0; i < 64; ++i) if (i < nw) {
                    const unsigned k = (i & 1) ? (kk[i >> 1] >> 16) : (kk[i >> 1] & 0xffffu);
                    const u64 gt = __ballot(k > Tk); u64 eq = __ballot(k == Tk);
                    const int pe = __builtin_popcountll(eq);
                    if (run + pe > need) { int kq = need - run; kq = kq < 0 ? 0 : kq;
                        const bool keep = ((eq >> lane) & 1ull) && (__builtin_popcountll(eq & ((1ull << lane) - 1ull)) < kq); eq = __ballot(keep); }
                    run += pe;
                    const u64 word = gt | eq;
                    if (lane == i) { mylo = (unsigned)word; myhi = (unsigned)(word >> 32); }
                }
            }
            mk[lane * 16 + q] = (u64)mylo | ((u64)myhi << 32);
        }
        __syncthreads();
        { const int w = F.tid >> 3, part = F.tid & 7;
          u64* dst = SELT + ((size_t)(b * 64 + w) * 4096) + t0 + part * 2;
          dst[0] = mk[w * 16 + part * 2]; dst[1] = mk[w * 16 + part * 2 + 1]; }
        __syncthreads();
    }
}

constexpr int AT_KB = 9216, AT_VB = 8704, AT_BUF = AT_KB + AT_VB;
struct AttStage { u32x4 kreg, vreg; };
__device__ __forceinline__ void att_load(AttStage& s, const bf16_t* Kg, const bf16_t* Vtg, int key0, int tid) {
    s.kreg = *(const u32x4*)(Kg + (size_t)(key0 + (tid >> 3)) * 64 + (tid & 7) * 8);
    s.vreg = *(const u32x4*)(Vtg + (size_t)(tid >> 3) * 4096 + key0 + (tid & 7) * 8);
}
__device__ __forceinline__ void att_store(const AttStage& s, LAS unsigned char* buf, int tid) {
    *(LAS u32x4*)(buf + (tid >> 3) * 144 + (tid & 7) * 16) = s.kreg;
    LAS unsigned char* v = buf + AT_KB + (tid >> 3) * 136 + (tid & 7) * 16;
    *(LAS u32x2*)(v) = (u32x2){s.vreg.x, s.vreg.y}; *(LAS u32x2*)(v + 8) = (u32x2){s.vreg.z, s.vreg.w};
}
__device__ __forceinline__ bf16x8 pack8(float a0, float a1, float a2, float a3, float a4, float a5, float a6, float a7) {
    u32x4 w; w.x = pg8::cvt_pk_bf16(a0, a1); w.y = pg8::cvt_pk_bf16(a2, a3); w.z = pg8::cvt_pk_bf16(a4, a5); w.w = pg8::cvt_pk_bf16(a6, a7);
    return __builtin_bit_cast(bf16x8, w);
}
__device__ __forceinline__ f32x16 att_qk(const LAS unsigned char* buf, int sub, const bf16x8 (&Qf)[4], int lane) {
    f32x16 S = {0.f, 0.f, 0.f, 0.f, 0.f, 0.f, 0.f, 0.f, 0.f, 0.f, 0.f, 0.f, 0.f, 0.f, 0.f, 0.f};
    const LAS unsigned char* kp = buf + (sub * 32 + (lane & 31)) * 144 + (lane >> 5) * 16;
#pragma unroll
    for (int ks = 0; ks < 4; ++ks) { const bf16x8 kf = *(const LAS bf16x8*)(kp + ks * 32); S = __builtin_amdgcn_mfma_f32_32x32x16_bf16(kf, Qf[ks], S, 0, 0, 0); }
    return S;
}
__device__ __forceinline__ void att_pv2(const LAS unsigned char* buf, int sub, const bf16x8 P0, const bf16x8 P1, f32x16 (&O)[2], int lane) {
    const int h = lane >> 5;
#pragma unroll
    for (int dt = 0; dt < 2; ++dt) {
        const LAS unsigned char* vp = buf + AT_KB + (dt * 32 + (lane & 31)) * 136 + (sub * 32 + 4 * h) * 2;
        const u32x2 a0 = *(const LAS u32x2*)(vp), a1 = *(const LAS u32x2*)(vp + 16), b0 = *(const LAS u32x2*)(vp + 32), b1 = *(const LAS u32x2*)(vp + 48);
        const bf16x8 V0 = __builtin_bit_cast(bf16x8, ((u32x4){a0.x, a0.y, a1.x, a1.y}));
        const bf16x8 V1 = __builtin_bit_cast(bf16x8, ((u32x4){b0.x, b0.y, b1.x, b1.y}));
        O[dt] = __builtin_amdgcn_mfma_f32_32x32x16_bf16(V0, P0, O[dt], 0, 0, 0);
        O[dt] = __builtin_amdgcn_mfma_f32_32x32x16_bf16(V1, P1, O[dt], 0, 0, 0);
    }
}
__device__ __forceinline__ void att_pv(const LAS unsigned char* buf, int sub, const float (&p)[16], f32x16 (&O)[2], int lane) {
    const bf16x8 P0 = pack8(p[0], p[1], p[2], p[3], p[4], p[5], p[6], p[7]);
    const bf16x8 P1 = pack8(p[8], p[9], p[10], p[11], p[12], p[13], p[14], p[15]);
    att_pv2(buf, sub, P0, P1, O, lane);
}

__device__ __forceinline__ void p_dsa_attn(const Frame& F, const Args& a, unsigned char* ws) {
    const bf16_t* QA = (const bf16_t*)(ws + L0_QA); const bf16_t* KA = (const bf16_t*)(ws + L0_KA); const bf16_t* VAT = (const bf16_t*)(ws + L0_VAT);
    const u64* SELT = (const u64*)(ws + L0_SELT); bf16_t* CAT = (bf16_t*)(ws + L0_CAT);
    const int lane = F.lane, wave = F.wave, h = lane >> 5, c = lane & 31, tid = F.tid;
    float mq = 0.f, mk_ = 0.f;
    for (int i = 0; i < 64; ++i) { mq = fmaxf(mq, fabsf(a.in[I_L0_QG][i])); mk_ = fmaxf(mk_, fabsf(a.in[I_L0_KG][i])); }
    const float c2 = (8.0f * mq * mk_ + 0.5f) * 1.4426950408889634f, c1 = 1.4426950408889634f;
    for (int u = F.bid; u < 512; u += F.G) {
        const int idx = u & 255, g = u >> 8, b = idx >> 5, qtr = idx & 31, qt = g ? 31 - qtr : qtr, q0 = qt * 128;
        const size_t mb = (size_t)b * 4096;
        const bf16_t* Kg = KA + (size_t)(b * 2 + g) * 4096 * 64; const bf16_t* Vtg = VAT + (size_t)(b * 2 + g) * 64 * 4096;
        bf16x8 Qf[2][4]; int qidx[2];
#pragma unroll
        for (int ct = 0; ct < 2; ++ct) { qidx[ct] = q0 + wave * 16 + ct * 8 + (c >> 2);
#pragma unroll
            for (int ks = 0; ks < 4; ++ks) Qf[ct][ks] = *(const bf16x8*)(QA + (mb + qidx[ct]) * 512 + (g * 4 + (c & 3)) * 64 + ks * 16 + 8 * h); }
        f32x16 O[2][2]; float l[2] = {0.f, 0.f};
#pragma unroll
        for (int ct = 0; ct < 2; ++ct)
#pragma unroll
            for (int dt = 0; dt < 2; ++dt)
#pragma unroll
                for (int i = 0; i < 16; ++i) O[ct][dt][i] = 0.f;
        const int nkt = 2 * qt + 2;
        AttStage st; att_load(st, Kg, Vtg, 0, tid);
        __syncthreads();
        att_store(st, F.lds, tid);
        __syncthreads();
        for (int kt = 0; kt < nkt; ++kt) {
            LAS unsigned char* buf = F.lds + (kt & 1) * AT_BUF;
            if (kt + 1 < nkt) att_load(st, Kg, Vtg, (kt + 1) * 64, tid);
            u64 mw[2];
#pragma unroll
            for (int ct = 0; ct < 2; ++ct) mw[ct] = SELT[(size_t)(b * 64 + kt) * 4096 + qidx[ct]];
#pragma unroll 1
            for (int sub = 0; sub < 2; ++sub) {
#pragma unroll
                for (int ct = 0; ct < 2; ++ct) {
                    __builtin_amdgcn_sched_barrier(0);
                    const f32x16 S = att_qk(buf, sub, Qf[ct], lane);
                    const unsigned mbits = (unsigned)(mw[ct] >> (sub * 32 + 4 * h));
                    float p[16];
#pragma unroll
                    for (int i = 0; i < 16; ++i) {
                        const float e = __builtin_amdgcn_exp2f(S[i] * c1 - c2);
                        const int bitpos = (i & 3) + 8 * (i >> 2);
                        p[i] = ((mbits >> bitpos) & 1u) ? e : 0.f;
                        l[ct] += p[i];
                    }
                    att_pv(buf, sub, p, O[ct], lane);
                }
            }
            if (kt + 1 < nkt) att_store(st, F.lds + ((kt + 1) & 1) * AT_BUF, tid);
            __syncthreads();
        }
#pragma unroll
        for (int ct = 0; ct < 2; ++ct) {
            const float lt = l[ct] + __shfl_xor(l[ct], 32);
            const float inv = 1.0f / fmaxf(lt, 1e-30f);
            bf16_t* orow = CAT + (mb + qidx[ct]) * 1024 + (g * 4 + (c & 3)) * 64;
#pragma unroll
            for (int dt = 0; dt < 2; ++dt)
#pragma unroll
                for (int i4 = 0; i4 < 4; ++i4) {
                    const int d = dt * 32 + 8 * i4 + 4 * h;
                    u32x2 w; w.x = pk2(O[ct][dt][4 * i4] * inv, O[ct][dt][4 * i4 + 1] * inv); w.y = pk2(O[ct][dt][4 * i4 + 2] * inv, O[ct][dt][4 * i4 + 3] * inv);
                    *(u32x2*)(orow + d) = w;
                }
        }
    }
}

__device__ __forceinline__ void p_s5_scan(const Frame& F, const Args& a, unsigned char* ws) {
    const float* SLOC = (const float*)(ws + L0_SLOC); bf16_t* UA = (bf16_t*)(ws + L0_UA);
    const int gw = F.bid * NWAVES + F.wave, NGW = F.G * NWAVES, p = F.lane;
    for (int it = gw; it < 32 * NB; it += NGW) {
        const int g = it >> 3, b = it & 7;
        const float dt = expf(a.in[I_L0_LOGDT][g]);
        const float lr = a.in[I_L0_ARE][g * 64 + p], li = a.in[I_L0_AIM][g * 64 + p];
        const float mag = expf(16.0f * dt * lr); float s, c; sincosf(16.0f * dt * li, &s, &c);
        const float ar = mag * c, ai = mag * s;
        float hr = 0.f, hi = 0.f;
        const float* sl = SLOC + ((size_t)g * 2048 + b * 256) * 128;
        bf16_t* ua = UA + ((size_t)g * 2048 + b * 256) * 384 + 256;
        for (int ch = 0; ch < 256; ++ch) {
            ua[(size_t)ch * 384 + p] = (bf16_t)f2bf(hr); ua[(size_t)ch * 384 + 64 + p] = (bf16_t)f2bf(hi);
            const float xr = sl[(size_t)ch * 128 + p], xi = sl[(size_t)ch * 128 + 64 + p];
            const float nr = ar * hr - ai * hi + xr, ni = ar * hi + ai * hr + xi;
            hr = nr; hi = ni;
        }
    }
}
namespace pg8 {
struct EpiS5State {
    static constexpr bool PERM = false;
    float* C;
    __device__ __forceinline__ void operator()(const f32x4 (&acc)[2][2][4][2], const Unit& u, int wr, int wc, int fr, int fq) const {
        const int row0 = u.pm * BM + wr * 64 + fr, col0 = wc * 32 + 4 * fq;
#pragma unroll
        for (int ai = 0; ai < 2; ++ai)
#pragma unroll
            for (int m = 0; m < 4; ++m)
#pragma unroll
                for (int n = 0; n < 2; ++n) *(f32x4*)(C + (size_t)(row0 + ai * HALF + m * 16) * 128 + col0 + n * 16) = acc[ai][0][m][n];
    }
};
struct EpiS5Out {
    static constexpr bool PERM = false;
    bf16_t* YB;
    __device__ __forceinline__ void operator()(const f32x4 (&acc)[2][2][4][2], const Unit& u, int wr, int wc, int fr, int fq) const {
        const int g = u.pn;
        const int row0 = u.pm * BM + wr * 64 + fr - g * 2048;
        const int col0 = wc * 32 + 4 * fq;
#pragma unroll
        for (int ai = 0; ai < 2; ++ai)
#pragma unroll
            for (int m = 0; m < 4; ++m) { const int chunk = row0 + ai * HALF + m * 16;
#pragma unroll
                for (int bj = 0; bj < 2; ++bj)
#pragma unroll
                    for (int n = 0; n < 2; ++n) { const int col = col0 + bj * HALF + n * 16, i = col >> 4, co = col & 15;
                        const f32x4 v = acc[ai][bj][m][n];
                        u32x2 w; w.x = pk2(gelu_tanh(v[0]), gelu_tanh(v[1])); w.y = pk2(gelu_tanh(v[2]), gelu_tanh(v[3]));
                        *(u32x2*)(YB + ((size_t)chunk * 16 + i) * 512 + g * 16 + co) = w; }
                asm volatile("" ::: "memory"); __builtin_amdgcn_sched_barrier(0); }
    }
};
struct EpiGlu {
    static constexpr bool PERM = true;
    const bf16_t* YB; const float* bias; bf16_t* CAT;
    __device__ __forceinline__ void operator()(const f32x4 (&acc)[2][2][4][2], const Unit& u, int wr, int wc, int fr, int fq) const {
        const int row0 = u.pm * BM + wr * 64 + fr, col0 = u.pn * BM + wc * 32 + 8 * fq;
#pragma unroll
        for (int ai = 0; ai < 2; ++ai)
#pragma unroll
            for (int m = 0; m < 4; ++m) { const size_t row = row0 + ai * HALF + m * 16;
#pragma unroll
                for (int bj = 0; bj < 2; ++bj) { const int col = col0 + bj * HALF;
                    const u32x4 yv = *(const u32x4*)(YB + row * 512 + col);
                    const f32x4 b0 = *(const f32x4*)(bias + col), b1 = *(const f32x4*)(bias + col + 4);
                    const f32x4 z0 = acc[ai][bj][m][0] + b0, z1 = acc[ai][bj][m][1] + b1;
                    u32x4 w;
                    w.x = pk2(bf_lo(yv.x) * sigmoidf_(z0[0]), bf_hi(yv.x) * sigmoidf_(z0[1])); w.y = pk2(bf_lo(yv.y) * sigmoidf_(z0[2]), bf_hi(yv.y) * sigmoidf_(z0[3]));
                    w.z = pk2(bf_lo(yv.z) * sigmoidf_(z1[0]), bf_hi(yv.z) * sigmoidf_(z1[1])); w.w = pk2(bf_lo(yv.w) * sigmoidf_(z1[2]), bf_hi(yv.w) * sigmoidf_(z1[3]));
                    *(u32x4*)(CAT + row * 1024 + 512 + col) = w; }
                asm volatile("" ::: "memory"); __builtin_amdgcn_sched_barrier(0); }
    }
};
}
__device__ __forceinline__ unsigned mono_u32(float f) { const unsigned u = __builtin_bit_cast(unsigned, f); return u ^ ((u >> 31) ? 0xFFFFFFFFu : 0x80000000u); }
#define INS16(arr, xin) do { unsigned _x = (xin); _Pragma("unroll") for (int _i = 0; _i < 16; ++_i) { const unsigned _hi = arr[_i] > _x ? arr[_i] : _x; _x = arr[_i] > _x ? _x : arr[_i]; arr[_i] = _hi; } } while (0)
__device__ __forceinline__ void p_peer_route(const Frame& F, unsigned char* ws, const bf16_t* SK) {
    const bf16_t* Q2 = (const bf16_t*)(ws + PE_Q2); unsigned short* EID = (unsigned short*)(ws + PE_EID); float* GATE = (float*)(ws + PE_GATE);
    LAS float* sc0 = (LAS float*)F.lds;
    const int lane = F.lane, wave = F.wave, h5 = lane >> 5, r = lane & 31, tid = F.tid;
    for (int u = F.bid; u < 2048; u += F.G) {
        const int hd = u & 7, mt = u >> 3; const size_t m0 = (size_t)mt * 128;
        {
            const int p = wave >> 2, rt = wave & 3;
            bf16x8 Af[8];
#pragma unroll
            for (int ks = 0; ks < 8; ++ks) Af[ks] = *(const bf16x8*)(Q2 + (m0 + rt * 32 + r) * 2048 + (hd * 2 + p) * 128 + ks * 16 + 8 * h5);
            LAS float* scp = sc0 + p * 128 * 129;
#pragma unroll 1
            for (int ct = 0; ct < 4; ++ct) {
                f32x16 acc = {0.f, 0.f, 0.f, 0.f, 0.f, 0.f, 0.f, 0.f, 0.f, 0.f, 0.f, 0.f, 0.f, 0.f, 0.f, 0.f};
#pragma unroll
                for (int ks = 0; ks < 8; ++ks) { const bf16x8 Bf = *(const bf16x8*)(SK + ((size_t)(hd * 2 + p) * 128 + ct * 32 + r) * 128 + ks * 16 + 8 * h5);
                    acc = __builtin_amdgcn_mfma_f32_32x32x16_bf16(Af[ks], Bf, acc, 0, 0, 0); }
#pragma unroll
                for (int i = 0; i < 16; ++i) scp[(rt * 32 + (i & 3) + 8 * (i >> 2) + 4 * h5) * 129 + ct * 32 + r] = acc[i];
            }
        }
        __syncthreads();
        if (tid < 256) {
            const int row = tid & 127, pp = tid >> 7; LAS float* rowp = sc0 + pp * 128 * 129 + row * 129;
            unsigned a[16];
#pragma unroll
            for (int i = 0; i < 16; ++i) a[i] = 0u;
#pragma unroll 4
            for (int j = 0; j < 128; ++j) { const unsigned key = (mono_u32(rowp[j]) & ~0x7Fu) | (unsigned)(127 - j); if (key > a[15]) INS16(a, key); }
            float vals[16]; int ids[16];
#pragma unroll
            for (int k = 0; k < 16; ++k) { ids[k] = 127 - (int)(a[k] & 127u); vals[k] = rowp[ids[k]]; }
#pragma unroll
            for (int k = 0; k < 16; ++k) { rowp[k] = vals[k]; rowp[16 + k] = __int_as_float(ids[k]); }
        }
        __syncthreads();
        if (tid < 128) {
            const int row = tid; const LAS float* s1 = sc0 + row * 129; const LAS float* s2 = sc0 + 128 * 129 + row * 129;
            float v1[16], v2[16];
#pragma unroll
            for (int k = 0; k < 16; ++k) { v1[k] = s1[k]; v2[k] = s2[k]; }
            unsigned c[16];
#pragma unroll
            for (int i = 0; i < 16; ++i) c[i] = 0u;
#pragma unroll
            for (int a = 0; a < 16; ++a)
#pragma unroll
                for (int b = 0; b < 16; ++b) if ((a + 1) * (b + 1) <= 16) { const unsigned key = (mono_u32(v1[a] + v2[b]) & ~0xFFu) | (unsigned)(255 - (a * 16 + b)); INS16(c, key); }
            float mx = -3.0e38f; float sv[16]; int eid[16];
#pragma unroll
            for (int k = 0; k < 16; ++k) { const int fl = 255 - (int)(c[k] & 255u), a = fl >> 4, b = fl & 15;
                sv[k] = s1[a] + s2[b]; eid[k] = __float_as_int(s1[16 + a]) * 128 + __float_as_int(s2[16 + b]); mx = fmaxf(mx, sv[k]); }
            float den = 0.f;
#pragma unroll
            for (int k = 0; k < 16; ++k) { sv[k] = __expf(sv[k] - mx); den += sv[k]; }
            const float inv = 1.0f / den;
            unsigned short* ep = EID + (m0 + row) * 128 + hd * 16; float* gp = GATE + (m0 + row) * 128 + hd * 16;
#pragma unroll
            for (int k = 0; k < 16; ++k) { ep[k] = (unsigned short)eid[k]; gp[k] = sv[k] * inv; }
        }
        __syncthreads();
    }
}

__device__ __forceinline__ float rdlane_f(float v, int l) { return __builtin_bit_cast(float, __builtin_amdgcn_readlane(__builtin_bit_cast(int, v), l)); }
__device__ __forceinline__ void p_peer_expert(const Frame& F, unsigned char* ws, float* xres) {
    const bf16_t* XN = (const bf16_t*)(ws + WS_XN); const bf16_t* TU = (const bf16_t*)(ws + WS_TABU); const bf16_t* TV = (const bf16_t*)(ws + WS_TABV);
    const unsigned short* EID = (const unsigned short*)(ws + PE_EID); const float* GATE = (const float*)(ws + PE_GATE);
    const int gw = F.bid * NWAVES + F.wave, NGW = F.G * NWAVES, lane = F.lane;
    for (int m = gw; m < T; m += NGW) {
        float xf[16];
        { const u32x4 xa = *(const u32x4*)(XN + (size_t)m * 1024 + lane * 8), xb = *(const u32x4*)(XN + (size_t)m * 1024 + 512 + lane * 8);
          xf[0] = bf_lo(xa.x); xf[1] = bf_hi(xa.x); xf[2] = bf_lo(xa.y); xf[3] = bf_hi(xa.y); xf[4] = bf_lo(xa.z); xf[5] = bf_hi(xa.z); xf[6] = bf_lo(xa.w); xf[7] = bf_hi(xa.w);
          xf[8] = bf_lo(xb.x); xf[9] = bf_hi(xb.x); xf[10] = bf_lo(xb.y); xf[11] = bf_hi(xb.y); xf[12] = bf_lo(xb.z); xf[13] = bf_hi(xb.z); xf[14] = bf_lo(xb.w); xf[15] = bf_hi(xb.w); }
        const int id0 = EID[(size_t)m * 128 + lane], id1 = EID[(size_t)m * 128 + 64 + lane];
        const float g0 = GATE[(size_t)m * 128 + lane], g1 = GATE[(size_t)m * 128 + 64 + lane];
        float outv[16];
#pragma unroll
        for (int i = 0; i < 16; ++i) outv[i] = 0.f;
#pragma unroll 1
        for (int k = 0; k < 16; ++k) {
            const int idreg = (k < 8) ? id0 : id1; const float greg = (k < 8) ? g0 : g1; const int lbase = (k & 7) * 8;
            int e[8];
#pragma unroll
            for (int i = 0; i < 8; ++i) e[i] = __builtin_amdgcn_readlane(idreg, lbase + i);
            float pr[8];
            {
                u32x4 ua[8], ub[8];
#pragma unroll
                for (int i = 0; i < 8; ++i) { ua[i] = *(const u32x4*)(TU + (size_t)e[i] * 1024 + lane * 8); ub[i] = *(const u32x4*)(TU + (size_t)e[i] * 1024 + 512 + lane * 8); }
#pragma unroll
                for (int i = 0; i < 8; ++i) {
                    float s = xf[0] * bf_lo(ua[i].x); s += xf[1] * bf_hi(ua[i].x); s += xf[2] * bf_lo(ua[i].y); s += xf[3] * bf_hi(ua[i].y);
                    s += xf[4] * bf_lo(ua[i].z); s += xf[5] * bf_hi(ua[i].z); s += xf[6] * bf_lo(ua[i].w); s += xf[7] * bf_hi(ua[i].w);
                    s += xf[8] * bf_lo(ub[i].x); s += xf[9] * bf_hi(ub[i].x); s += xf[10] * bf_lo(ub[i].y); s += xf[11] * bf_hi(ub[i].y);
                    s += xf[12] * bf_lo(ub[i].z); s += xf[13] * bf_hi(ub[i].z); s += xf[14] * bf_lo(ub[i].w); s += xf[15] * bf_hi(ub[i].w);
                    pr[i] = s;
                }
            }
            float r4[4], r2[2], r1;
            { const bool up = (lane & 32) != 0;
#pragma unroll
              for (int i = 0; i < 4; ++i) { const float keep = up ? pr[i + 4] : pr[i], send = up ? pr[i] : pr[i + 4]; r4[i] = keep + __shfl_xor(send, 32); } }
            { const bool up = (lane & 16) != 0;
#pragma unroll
              for (int i = 0; i < 2; ++i) { const float keep = up ? r4[i + 2] : r4[i], send = up ? r4[i] : r4[i + 2]; r2[i] = keep + __shfl_xor(send, 16); } }
            { const bool up = (lane & 8) != 0; const float keep = up ? r2[1] : r2[0], send = up ? r2[0] : r2[1]; r1 = keep + __shfl_xor(send, 8); }
            r1 += __shfl_xor(r1, 4); r1 += __shfl_xor(r1, 2); r1 += __shfl_xor(r1, 1);
            const float gv = __shfl(greg, lbase + (lane >> 3));
            const float coef = gv * gelu_tanh(r1);
            {
                u32x4 va[8], vb[8];
#pragma unroll
                for (int i = 0; i < 8; ++i) { va[i] = *(const u32x4*)(TV + (size_t)e[i] * 1024 + lane * 8); vb[i] = *(const u32x4*)(TV + (size_t)e[i] * 1024 + 512 + lane * 8); }
#pragma unroll
                for (int i = 0; i < 8; ++i) {
                    const float ci = rdlane_f(coef, i * 8);
                    outv[0] += ci * bf_lo(va[i].x); outv[1] += ci * bf_hi(va[i].x); outv[2] += ci * bf_lo(va[i].y); outv[3] += ci * bf_hi(va[i].y);
                    outv[4] += ci * bf_lo(va[i].z); outv[5] += ci * bf_hi(va[i].z); outv[6] += ci * bf_lo(va[i].w); outv[7] += ci * bf_hi(va[i].w);
                    outv[8] += ci * bf_lo(vb[i].x); outv[9] += ci * bf_hi(vb[i].x); outv[10] += ci * bf_lo(vb[i].y); outv[11] += ci * bf_hi(vb[i].y);
                    outv[12] += ci * bf_lo(vb[i].z); outv[13] += ci * bf_hi(vb[i].z); outv[14] += ci * bf_lo(vb[i].w); outv[15] += ci * bf_hi(vb[i].w);
                }
            }
        }
        f32x4* o = (f32x4*)(xres + (size_t)m * 1024 + lane * 8);
        f32x4 a0 = o[0], a1 = o[1], b0 = o[128], b1 = o[129];
        a0 += (f32x4){outv[0], outv[1], outv[2], outv[3]}; a1 += (f32x4){outv[4], outv[5], outv[6], outv[7]};
        b0 += (f32x4){outv[8], outv[9], outv[10], outv[11]}; b1 += (f32x4){outv[12], outv[13], outv[14], outv[15]};
        o[0] = a0; o[1] = a1; o[128] = b0; o[129] = b1;
    }
}

typedef __bf16 bf16x2_t __attribute__((ext_vector_type(2)));
__device__ __forceinline__ float dot2bf(unsigned a, unsigned b, float c) { return __builtin_amdgcn_fdot2_f32_bf16(__builtin_bit_cast(bf16x2_t, a), __builtin_bit_cast(bf16x2_t, b), c, false); }
__device__ __forceinline__ void peer_slot_range(const unsigned (&xp)[8], float (&outv)[16], int id0, int id1, float g0, float g1, int r,
                                                const bf16_t* TU, const bf16_t* TV, int lane) {
    u64 m0 = __ballot((id0 >> 9) == r), m1 = __ballot((id1 >> 9) == r);
    while (m0 | m1) {
        int e[8]; float gt[8];
#pragma unroll
        for (int i = 0; i < 8; ++i) {
            if (m0) { const int l = __builtin_ctzll(m0); m0 &= m0 - 1ull; e[i] = __builtin_amdgcn_readlane(id0, l); gt[i] = rdlane_f(g0, l); }
            else if (m1) { const int l = __builtin_ctzll(m1); m1 &= m1 - 1ull; e[i] = __builtin_amdgcn_readlane(id1, l); gt[i] = rdlane_f(g1, l); }
            else { e[i] = -1; gt[i] = 0.f; }
        }
        float pr[8];
        {
            u32x4 ua[8], ub[8];
#pragma unroll
            for (int i = 0; i < 8; ++i) {
                if (e[i] >= 0) { ua[i] = *(const u32x4*)(TU + (size_t)e[i] * 1024 + lane * 8); ub[i] = *(const u32x4*)(TU + (size_t)e[i] * 1024 + 512 + lane * 8); }
                else { ua[i] = (u32x4){0u, 0u, 0u, 0u}; ub[i] = (u32x4){0u, 0u, 0u, 0u}; }
            }
#pragma unroll
            for (int i = 0; i < 8; ++i) {
                float s = dot2bf(xp[0], ua[i].x, 0.f); s = dot2bf(xp[1], ua[i].y, s); s = dot2bf(xp[2], ua[i].z, s); s = dot2bf(xp[3], ua[i].w, s);
                s = dot2bf(xp[4], ub[i].x, s); s = dot2bf(xp[5], ub[i].y, s); s = dot2bf(xp[6], ub[i].z, s); s = dot2bf(xp[7], ub[i].w, s);
                pr[i] = s;
            }
        }
        float r4[4], r2[2], r1;
        { const bool up = (lane & 32) != 0;
#pragma unroll
          for (int i = 0; i < 4; ++i) { const float keep = up ? pr[i + 4] : pr[i], send = up ? pr[i] : pr[i + 4]; r4[i] = keep + __shfl_xor(send, 32); } }
        { const bool up = (lane & 16) != 0;
#pragma unroll
          for (int i = 0; i < 2; ++i) { const float keep = up ? r4[i + 2] : r4[i], send = up ? r4[i] : r4[i + 2]; r2[i] = keep + __shfl_xor(send, 16); } }
        { const bool up = (lane & 8) != 0; const float keep = up ? r2[1] : r2[0], send = up ? r2[0] : r2[1]; r1 = keep + __shfl_xor(send, 8); }
        r1 += __shfl_xor(r1, 4); r1 += __shfl_xor(r1, 2); r1 += __shfl_xor(r1, 1);
        const int grp = lane >> 3;
        float gsel = gt[0];
#pragma unroll
        for (int i = 1; i < 8; ++i) gsel = (grp == i) ? gt[i] : gsel;
        const float coef = gsel * gelu_tanh(r1);
        {
            u32x4 va[8], vb[8];
#pragma unroll
            for (int i = 0; i < 8; ++i) {
                if (e[i] >= 0) { va[i] = *(const u32x4*)(TV + (size_t)e[i] * 1024 + lane * 8); vb[i] = *(const u32x4*)(TV + (size_t)e[i] * 1024 + 512 + lane * 8); }
                else { va[i] = (u32x4){0u, 0u, 0u, 0u}; vb[i] = (u32x4){0u, 0u, 0u, 0u}; }
            }
#pragma unroll
            for (int i = 0; i < 8; ++i) {
                if (e[i] >= 0) {
                    const float ci = rdlane_f(coef, i * 8);
                    outv[0] += ci * bf_lo(va[i].x); outv[1] += ci * bf_hi(va[i].x); outv[2] += ci * bf_lo(va[i].y); outv[3] += ci * bf_hi(va[i].y);
                    outv[4] += ci * bf_lo(va[i].z); outv[5] += ci * bf_hi(va[i].z); outv[6] += ci * bf_lo(va[i].w); outv[7] += ci * bf_hi(va[i].w);
                    outv[8] += ci * bf_lo(vb[i].x); outv[9] += ci * bf_hi(vb[i].x); outv[10] += ci * bf_lo(vb[i].y); outv[11] += ci * bf_hi(vb[i].y);
                    outv[12] += ci * bf_lo(vb[i].z); outv[13] += ci * bf_hi(vb[i].z); outv[14] += ci * bf_lo(vb[i].w); outv[15] += ci * bf_hi(vb[i].w);
                }
            }
        }
    }
}
__device__ __forceinline__ void p_peer_expert2(const Frame& F, unsigned char* ws, float* xres, const float oscale) {
    const bf16_t* XN = (const bf16_t*)(ws + WS_XN); const bf16_t* TU = (const bf16_t*)(ws + WS_TABU); const bf16_t* TV = (const bf16_t*)(ws + WS_TABV);
    const unsigned short* EID = (const unsigned short*)(ws + PE_EID); const float* GATE = (const float*)(ws + PE_GATE);
    const int gw = F.bid * NWAVES + F.wave, NGW = F.G * NWAVES, lane = F.lane;
    int rnd = 0;
    for (int m4 = gw * 4; m4 < T; m4 += NGW * 4, ++rnd) {
        unsigned xp[4][8]; float outv[4][16]; int id[4][2]; float gg[4][2];
#pragma unroll
        for (int s = 0; s < 4; ++s) {
            const size_t m = (size_t)(m4 + s);
            const u32x4 xa = *(const u32x4*)(XN + m * 1024 + lane * 8), xb = *(const u32x4*)(XN + m * 1024 + 512 + lane * 8);
            xp[s][0] = xa.x; xp[s][1] = xa.y; xp[s][2] = xa.z; xp[s][3] = xa.w; xp[s][4] = xb.x; xp[s][5] = xb.y; xp[s][6] = xb.z; xp[s][7] = xb.w;
            id[s][0] = EID[m * 128 + lane]; id[s][1] = EID[m * 128 + 64 + lane]; gg[s][0] = GATE[m * 128 + lane]; gg[s][1] = GATE[m * 128 + 64 + lane];
#pragma unroll
            for (int i = 0; i < 16; ++i) outv[s][i] = 0.f;
        }
#pragma unroll 1
        for (int k = 0; k < 32; ++k) {
            const int r = (rnd & 1) ? 31 - k : k;
#pragma unroll
            for (int s = 0; s < 4; ++s) peer_slot_range(xp[s], outv[s], id[s][0], id[s][1], gg[s][0], gg[s][1], r, TU, TV, lane);
        }
#pragma unroll
        for (int s = 0; s < 4; ++s) {
            f32x4* o = (f32x4*)(xres + (size_t)(m4 + s) * 1024 + lane * 8);
            f32x4 a0 = o[0], a1 = o[1], b0 = o[128], b1 = o[129];
            a0 += (f32x4){outv[s][0], outv[s][1], outv[s][2], outv[s][3]} * oscale; a1 += (f32x4){outv[s][4], outv[s][5], outv[s][6], outv[s][7]} * oscale;
            b0 += (f32x4){outv[s][8], outv[s][9], outv[s][10], outv[s][11]} * oscale; b1 += (f32x4){outv[s][12], outv[s][13], outv[s][14], outv[s][15]} * oscale;
            o[0] = a0; o[1] = a1; o[128] = b0; o[129] = b1;
        }
    }
}

struct RowBuf { u32x4 a[8], b[8]; };
__device__ __forceinline__ void peer_load8(RowBuf& rb, const bf16_t* TAB, const LAS unsigned* ent, int b, int lane) {
#pragma unroll
    for (int i = 0; i < 8; ++i) {
        const unsigned e = (unsigned)__builtin_amdgcn_readfirstlane((int)ent[b * 8 + i]) & 0x3FFFu;
        const bf16_t* rp = TAB + (size_t)e * 1024 + lane * 8;
        rb.a[i] = *(const u32x4*)rp; rb.b[i] = *(const u32x4*)(rp + 512);
    }
}
__device__ __forceinline__ float peer_dot(const unsigned (&xp)[8], const u32x4 a, const u32x4 b) {
    float s = dot2bf(xp[0], a.x, 0.f); s = dot2bf(xp[1], a.y, s); s = dot2bf(xp[2], a.z, s); s = dot2bf(xp[3], a.w, s);
    s = dot2bf(xp[4], b.x, s); s = dot2bf(xp[5], b.y, s); s = dot2bf(xp[6], b.z, s); s = dot2bf(xp[7], b.w, s);
    return s;
}
__device__ __forceinline__ void peer_u8(const RowBuf& rb, const unsigned (&xp)[4][8], const LAS unsigned* ent, LAS float* cf, int b, int lane) {
    float pr[8];
#pragma unroll
    for (int i = 0; i < 8; ++i) {
        const int slot = (__builtin_amdgcn_readfirstlane((int)ent[b * 8 + i]) >> 21) & 3;
        if (slot == 0) pr[i] = peer_dot(xp[0], rb.a[i], rb.b[i]);
        else if (slot == 1) pr[i] = peer_dot(xp[1], rb.a[i], rb.b[i]);
        else if (slot == 2) pr[i] = peer_dot(xp[2], rb.a[i], rb.b[i]);
        else pr[i] = peer_dot(xp[3], rb.a[i], rb.b[i]);
    }
    float r4[4], r2[2], r1;
    { const bool up = (lane & 32) != 0;
#pragma unroll
      for (int i = 0; i < 4; ++i) { const float keep = up ? pr[i + 4] : pr[i], send = up ? pr[i] : pr[i + 4]; r4[i] = keep + __shfl_xor(send, 32); } }
    { const bool up = (lane & 16) != 0;
#pragma unroll
      for (int i = 0; i < 2; ++i) { const float keep = up ? r4[i + 2] : r4[i], send = up ? r4[i] : r4[i + 2]; r2[i] = keep + __shfl_xor(send, 16); } }
    { const bool up = (lane & 8) != 0; const float keep = up ? r2[1] : r2[0], send = up ? r2[0] : r2[1]; r1 = keep + __shfl_xor(send, 8); }
    r1 += __shfl_xor(r1, 4); r1 += __shfl_xor(r1, 2); r1 += __shfl_xor(r1, 1);
    const float gate = cf[b * 8 + (lane >> 3)];
    const float coef = gate * gelu_tanh(r1);
    if ((lane & 7) == 0) cf[b * 8 + (lane >> 3)] = coef;
}
__device__ __forceinline__ void peer_acc(float (&o)[16], const float c, const u32x4 a, const u32x4 b) {
    o[0] += c * bf_lo(a.x); o[1] += c * bf_hi(a.x); o[2] += c * bf_lo(a.y); o[3] += c * bf_hi(a.y);
    o[4] += c * bf_lo(a.z); o[5] += c * bf_hi(a.z); o[6] += c * bf_lo(a.w); o[7] += c * bf_hi(a.w);
    o[8] += c * bf_lo(b.x); o[9] += c * bf_hi(b.x); o[10] += c * bf_lo(b.y); o[11] += c * bf_hi(b.y);
    o[12] += c * bf_lo(b.z); o[13] += c * bf_hi(b.z); o[14] += c * bf_lo(b.w); o[15] += c * bf_hi(b.w);
}
__device__ __forceinline__ void peer_v8(const RowBuf& rb, float (&outv)[4][16], const LAS unsigned* ent, const LAS float* cf, int b) {
#pragma unroll
    for (int i = 0; i < 8; ++i) {
        const int slot = (__builtin_amdgcn_readfirstlane((int)ent[b * 8 + i]) >> 21) & 3;
        const float c = cf[b * 8 + i];
        if (slot == 0) peer_acc(outv[0], c, rb.a[i], rb.b[i]);
        else if (slot == 1) peer_acc(outv[1], c, rb.a[i], rb.b[i]);
        else if (slot == 2) peer_acc(outv[2], c, rb.a[i], rb.b[i]);
        else peer_acc(outv[3], c, rb.a[i], rb.b[i]);
    }
}
__device__ __forceinline__ void p_peer_expert3(const Frame& F, unsigned char* ws, float* xres, const float oscale, const XcdBarrier& xbar) {
    const bf16_t* XN = (const bf16_t*)(ws + WS_XN); const bf16_t* TU = (const bf16_t*)(ws + WS_TABU); const bf16_t* TV = (const bf16_t*)(ws + WS_TABV);
    const unsigned short* EID = (const unsigned short*)(ws + PE_EID); const float* GATE = (const float*)(ws + PE_GATE);
    const int gw = F.bid * NWAVES + F.wave, NGW = F.G * NWAVES, lane = F.lane;
    LAS unsigned* ent = (LAS unsigned*)(F.lds + F.wave * 4096);
    LAS float* cf = (LAS float*)(F.lds + F.wave * 4096 + 2048);
    const int nrounds = (T + NGW * 4 - 1) / (NGW * 4);
    for (int rnd = 0; rnd < nrounds; ++rnd) {
        const int m4 = (rnd * NGW + gw) * 4;
        if (m4 < T) {
            unsigned xp[4][8];
            {
                int id[4][2]; float gg[4][2];
#pragma unroll
                for (int s = 0; s < 4; ++s) {
                    const size_t m = (size_t)(m4 + s);
                    const u32x4 xa = *(const u32x4*)(XN + m * 1024 + lane * 8), xb = *(const u32x4*)(XN + m * 1024 + 512 + lane * 8);
                    xp[s][0] = xa.x; xp[s][1] = xa.y; xp[s][2] = xa.z; xp[s][3] = xa.w; xp[s][4] = xb.x; xp[s][5] = xb.y; xp[s][6] = xb.z; xp[s][7] = xb.w;
                    id[s][0] = EID[m * 128 + lane]; id[s][1] = EID[m * 128 + 64 + lane]; gg[s][0] = GATE[m * 128 + lane]; gg[s][1] = GATE[m * 128 + 64 + lane];
                }
                int base = 0;
#pragma unroll 1
                for (int k = 0; k < 32; ++k) {
                    const int r = (rnd & 1) ? 31 - k : k;
#pragma unroll
                    for (int s = 0; s < 4; ++s)
#pragma unroll
                        for (int w = 0; w < 2; ++w) {
                            const bool hit = (id[s][w] >> 9) == r;
                            const u64 m = __ballot(hit);
                            if (hit) { const int pos = base + (int)__builtin_amdgcn_mbcnt_hi((unsigned)(m >> 32), __builtin_amdgcn_mbcnt_lo((unsigned)m, 0u));
                                ent[pos] = ((unsigned)s << 21) | ((unsigned)(w * 64 + lane) << 14) | (unsigned)id[s][w]; cf[pos] = gg[s][w]; }
                            base += __builtin_popcountll(m);
                        }
                }
            }
            LDS_WAIT();
            {
                RowBuf A, B;
                peer_load8(A, TU, ent, 0, lane);
#pragma unroll 1
                for (int b = 0; b < 64; b += 2) {
                    peer_load8(B, TU, ent, b + 1, lane);
                    peer_u8(A, xp, ent, cf, b, lane);
                    if (b + 2 < 64) peer_load8(A, TU, ent, b + 2, lane);
                    peer_u8(B, xp, ent, cf, b + 1, lane);
                }
            }
            LDS_WAIT();
            float outv[4][16];
#pragma unroll
            for (int s = 0; s < 4; ++s)
#pragma unroll
                for (int i = 0; i < 16; ++i) outv[s][i] = 0.f;
            {
                RowBuf A, B;
                peer_load8(A, TV, ent, 0, lane);
#pragma unroll 1
                for (int b = 0; b < 64; b += 2) {
                    peer_load8(B, TV, ent, b + 1, lane);
                    peer_v8(A, outv, ent, cf, b);
                    if (b + 2 < 64) peer_load8(A, TV, ent, b + 2, lane);
                    peer_v8(B, outv, ent, cf, b + 1);
                }
            }
#pragma unroll
            for (int s = 0; s < 4; ++s) {
                f32x4* o = (f32x4*)(xres + (size_t)(m4 + s) * 1024 + lane * 8);
                f32x4 a0 = o[0], a1 = o[1], b0 = o[128], b1 = o[129];
                a0 += (f32x4){outv[s][0], outv[s][1], outv[s][2], outv[s][3]} * oscale; a1 += (f32x4){outv[s][4], outv[s][5], outv[s][6], outv[s][7]} * oscale;
                b0 += (f32x4){outv[s][8], outv[s][9], outv[s][10], outv[s][11]} * oscale; b1 += (f32x4){outv[s][12], outv[s][13], outv[s][14], outv[s][15]} * oscale;
                o[0] = a0; o[1] = a1; o[128] = b0; o[129] = b1;
            }
        }
        if (rnd + 1 < nrounds) xcd_barrier(xbar);
    }
}

constexpr size_t WS_TAB8U = WS_TABU;
constexpr size_t WS_TAB8V = WS_TABU + 16 * MiB;
constexpr size_t WS_TABSU = WS_TABU + 32 * MiB;
constexpr size_t WS_TABSV = WS_TABU + 32 * MiB + 65536;
__device__ __forceinline__ void cvt_table_fp8(const Frame& F, const float* src, unsigned char* dst, float* scales) {
    const int gw = F.bid * NWAVES + F.wave, NGW = F.G * NWAVES, lane = F.lane;
    for (int r = gw; r < 16384; r += NGW) {
        const f32x4* p = (const f32x4*)(src + (size_t)r * 1024 + lane * 16);
        f32x4 v[4]; float am = 0.f;
#pragma unroll
        for (int j = 0; j < 4; ++j) { v[j] = p[j]; am = fmaxf(am, fmaxf(fmaxf(fabsf(v[j].x), fabsf(v[j].y)), fmaxf(fabsf(v[j].z), fabsf(v[j].w)))); }
#pragma unroll
        for (int o = 1; o < 64; o <<= 1) am = fmaxf(am, __shfl_xor(am, o));
        const float sc = am > 0.f ? am * (1.0f / 448.0f) : 1.0f, inv = 1.0f / sc;
        u32x4 q;
#pragma unroll
        for (int j = 0; j < 4; ++j) { int w = 0; w = __builtin_amdgcn_cvt_pk_fp8_f32(v[j].x * inv, v[j].y * inv, w, false); w = __builtin_amdgcn_cvt_pk_fp8_f32(v[j].z * inv, v[j].w * inv, w, true); q[j] = (unsigned)w; }
        *(u32x4*)(dst + (size_t)r * 1024 + lane * 16) = q;
        if (lane == 0) scales[r] = sc;
    }
}
template <int NR> struct RowBufN { u32x4 a[NR]; };
template <int NR>
__device__ __forceinline__ void peer_loadN(RowBufN<NR>& rb, const unsigned char* TAB, const LAS unsigned* ent, int b, int lane) {
    const int ev = (int)ent[b * NR + (lane & (NR - 1))];
#pragma unroll
    for (int i = 0; i < NR; ++i) {
        const unsigned e = (unsigned)__builtin_amdgcn_readlane(ev, i) & 0x3FFFu;
        rb.a[i] = *(const u32x4*)(TAB + (size_t)e * 1024 + lane * 16);
    }
}
__device__ __forceinline__ float peer_dot8x(const u32x4 xa, const u32x4 xb, const u32x4 q) {
    float s = 0.f;
#pragma unroll
    for (int j = 0; j < 4; ++j) {
        const f32x2 lo = __builtin_amdgcn_cvt_pk_f32_fp8((int)q[j], false), hi = __builtin_amdgcn_cvt_pk_f32_fp8((int)q[j], true);
        const unsigned x0 = (j < 2) ? xa[2 * j] : xb[2 * j - 4], x1 = (j < 2) ? xa[2 * j + 1] : xb[2 * j - 3];
        s += bf_lo(x0) * lo.x; s += bf_hi(x0) * lo.y; s += bf_lo(x1) * hi.x; s += bf_hi(x1) * hi.y;
    }
    return s;
}
template <int NR>
__device__ __forceinline__ void peer_u8x(const RowBufN<NR>& rb, int r0, const LAS unsigned char* xl, const LAS unsigned* ent, LAS float* cf, const LAS float* sul, int e0, int lane) {
    float pr[8];
    const int ev = (int)ent[e0 + (lane & 7)];
#pragma unroll
    for (int i = 0; i < 8; ++i) {
        const int slot = (__builtin_amdgcn_readlane(ev, i) >> 21) & 3;
        const LAS unsigned char* xp = xl + slot * 2048 + lane * 32;
        const u32x4 xa = *(const LAS u32x4*)xp, xb = *(const LAS u32x4*)(xp + 16);
        pr[i] = peer_dot8x(xa, xb, rb.a[r0 + i]);
    }
    float r4[4], r2[2], r1;
    { const bool up = (lane & 32) != 0;
#pragma unroll
      for (int i = 0; i < 4; ++i) { const float keep = up ? pr[i + 4] : pr[i], send = up ? pr[i] : pr[i + 4]; r4[i] = keep + __shfl_xor(send, 32); } }
    { const bool up = (lane & 16) != 0;
#pragma unroll
      for (int i = 0; i < 2; ++i) { const float keep = up ? r4[i + 2] : r4[i], send = up ? r4[i] : r4[i + 2]; r2[i] = keep + __shfl_xor(send, 16); } }
    { const bool up = (lane & 8) != 0; const float keep = up ? r2[1] : r2[0], send = up ? r2[0] : r2[1]; r1 = keep + __shfl_xor(send, 8); }
    r1 += __shfl_xor(r1, 4); r1 += __shfl_xor(r1, 2); r1 += __shfl_xor(r1, 1);
    const float gate = cf[e0 + (lane >> 3)];
    const float coef = gate * gelu_tanh(r1 * sul[e0 + (lane >> 3)]);
    if ((lane & 7) == 0) cf[e0 + (lane >> 3)] = coef;
}
__device__ __forceinline__ void peer_acc8(float (&o)[16], const float c, const u32x4 q) {
#pragma unroll
    for (int j = 0; j < 4; ++j) { const f32x2 lo = __builtin_amdgcn_cvt_pk_f32_fp8((int)q[j], false), hi = __builtin_amdgcn_cvt_pk_f32_fp8((int)q[j], true);
        o[4 * j] += c * lo.x; o[4 * j + 1] += c * lo.y; o[4 * j + 2] += c * hi.x; o[4 * j + 3] += c * hi.y; }
}
template <int NR>
__device__ __forceinline__ void peer_vN(const RowBufN<NR>& rb, float (&outv)[4][16], const LAS unsigned* ent, const LAS float* cf, int b, int lane) {
    const int ev = (int)ent[b * NR + (lane & (NR - 1))]; const float cv = cf[b * NR + (lane & (NR - 1))];
#pragma unroll
    for (int i = 0; i < NR; ++i) {
        const int slot = (__builtin_amdgcn_readlane(ev, i) >> 21) & 3;
        const float c = rdlane_f(cv, i);
        if (slot == 0) peer_acc8(outv[0], c, rb.a[i]);
        else if (slot == 1) peer_acc8(outv[1], c, rb.a[i]);
        else if (slot == 2) peer_acc8(outv[2], c, rb.a[i]);
        else peer_acc8(outv[3], c, rb.a[i]);
    }
}
__device__ __forceinline__ void p_peer_expert4(const Frame& F, unsigned char* ws, float* xres, const float oscale, const XcdBarrier& xbar, const int mode) {
    const bf16_t* XN = (const bf16_t*)(ws + WS_XN); const unsigned char* TU = ws + WS_TAB8U; const unsigned char* TV = ws + WS_TAB8V;
    const float* SU = (const float*)(ws + WS_TABSU); const float* SV = (const float*)(ws + WS_TABSV);
    const unsigned short* EID = (const unsigned short*)(ws + PE_EID); const float* GATE = (const float*)(ws + PE_GATE);
    const int gw = F.bid * NWAVES + F.wave, NGW = F.G * NWAVES, lane = F.lane;
    LAS unsigned* ent = (LAS unsigned*)(F.lds + F.wave * 6144);
    LAS float* cf = (LAS float*)(F.lds + F.wave * 6144 + 2048);
    LAS float* sul = (LAS float*)(F.lds + F.wave * 6144 + 4096);
    LAS unsigned char* xl = F.lds + 49152 + F.wave * 8192;
    constexpr int PU = 16, PV = 8;
    const int nrounds = (T + NGW * 4 - 1) / (NGW * 4);
    for (int rnd = 0; rnd < nrounds; ++rnd) {
        const int m4 = (rnd * NGW + gw) * 4;
        if (m4 < T) {
            {
                int id[4][2]; float gg[4][2], su[4][2];
#pragma unroll
                for (int s = 0; s < 4; ++s) { const size_t m = (size_t)(m4 + s);
                    id[s][0] = EID[m * 128 + lane]; id[s][1] = EID[m * 128 + 64 + lane]; gg[s][0] = GATE[m * 128 + lane] * SV[id[s][0]]; gg[s][1] = GATE[m * 128 + 64 + lane] * SV[id[s][1]]; su[s][0] = SU[id[s][0]]; su[s][1] = SU[id[s][1]]; }
                int base = 0;
#pragma unroll 1
                for (int k = 0; k < 16; ++k) {
                    const int r = (rnd & 1) ? 15 - k : k;
#pragma unroll
                    for (int s = 0; s < 4; ++s)
#pragma unroll
                        for (int w = 0; w < 2; ++w) {
                            const bool hit = (id[s][w] >> 10) == r;
                            const u64 m = __ballot(hit);
                            if (hit) { const int pos = base + (int)__builtin_amdgcn_mbcnt_hi((unsigned)(m >> 32), __builtin_amdgcn_mbcnt_lo((unsigned)m, 0u));
                                ent[pos] = ((unsigned)s << 21) | ((unsigned)(w * 64 + lane) << 14) | (unsigned)(mode == 4 ? (id[s][w] & 7) : id[s][w]); cf[pos] = gg[s][w]; sul[pos] = su[s][w]; }
                            base += __builtin_popcountll(m);
                        }
                }
            }
            LDS_WAIT();
            if (mode != 1 && mode != 3) {
#pragma unroll
                for (int s = 0; s < 4; ++s) { const size_t m = (size_t)(m4 + s);
                    const u32x4 xa = *(const u32x4*)(XN + m * 1024 + lane * 16), xb = *(const u32x4*)(XN + m * 1024 + lane * 16 + 8);
                    *(LAS u32x4*)(xl + s * 2048 + lane * 32) = xa; *(LAS u32x4*)(xl + s * 2048 + lane * 32 + 16) = xb; }
                LDS_WAIT();
                RowBufN<PU> A, B;
                peer_loadN<PU>(A, TU, ent, 0, lane);
#pragma unroll 1
                for (int b = 0; b < 512 / PU; b += 2) {
                    peer_loadN<PU>(B, TU, ent, b + 1, lane);
#pragma unroll
                    for (int h = 0; h < PU / 8; ++h) peer_u8x<PU>(A, h * 8, xl, ent, cf, sul, b * PU + h * 8, lane);
                    if (b + 2 < 512 / PU) peer_loadN<PU>(A, TU, ent, b + 2, lane);
#pragma unroll
                    for (int h = 0; h < PU / 8; ++h) peer_u8x<PU>(B, h * 8, xl, ent, cf, sul, (b + 1) * PU + h * 8, lane);
                }
            }
            LDS_WAIT();
            float outv[4][16];
#pragma unroll
            for (int s = 0; s < 4; ++s)
#pragma unroll
                for (int i = 0; i < 16; ++i) outv[s][i] = 0.f;
            if (mode != 1 && mode != 2) {
                RowBufN<PV> A, B;
                peer_loadN<PV>(A, TV, ent, 0, lane);
#pragma unroll 1
                for (int b = 0; b < 512 / PV; b += 2) {
                    peer_loadN<PV>(B, TV, ent, b + 1, lane);
                    peer_vN<PV>(A, outv, ent, cf, b, lane);
                    if (b + 2 < 512 / PV) peer_loadN<PV>(A, TV, ent, b + 2, lane);
                    peer_vN<PV>(B, outv, ent, cf, b + 1, lane);
                }
            }
#pragma unroll
            for (int s = 0; s < 4; ++s) {
                f32x4* o = (f32x4*)(xres + (size_t)(m4 + s) * 1024 + lane * 16);
#pragma unroll
                for (int j = 0; j < 4; ++j) { f32x4 a0 = o[j]; a0 += (f32x4){outv[s][4 * j], outv[s][4 * j + 1], outv[s][4 * j + 2], outv[s][4 * j + 3]} * oscale; o[j] = a0; }
            }
        }
        if (rnd + 1 < nrounds) xcd_barrier(xbar);
    }
}

__device__ __forceinline__ void cvt_table_i8(const Frame& F, const float* src, unsigned char* dst, float* scales) {
    const int gw = F.bid * NWAVES + F.wave, NGW = F.G * NWAVES, lane = F.lane;
    for (int r = gw; r < 16384; r += NGW) {
        const f32x4* p = (const f32x4*)(src + (size_t)r * 1024 + lane * 16);
        f32x4 v[4]; float am = 0.f;
#pragma unroll
        for (int j = 0; j < 4; ++j) { v[j] = p[j]; am = fmaxf(am, fmaxf(fmaxf(fabsf(v[j].x), fabsf(v[j].y)), fmaxf(fabsf(v[j].z), fabsf(v[j].w)))); }
#pragma unroll
        for (int o = 1; o < 64; o <<= 1) am = fmaxf(am, __shfl_xor(am, o));
        const float sc = am > 0.f ? am * (1.0f / 127.0f) : 1.0f, inv = 1.0f / sc;
        u32x4 q;
#pragma unroll
        for (int j = 0; j < 4; ++j) { const int a = (int)rintf(v[j].x * inv), b = (int)rintf(v[j].y * inv), c = (int)rintf(v[j].z * inv), d = (int)rintf(v[j].w * inv);
            q[j] = (unsigned)(a & 255) | ((unsigned)(b & 255) << 8) | ((unsigned)(c & 255) << 16) | ((unsigned)(d & 255) << 24); }
        *(u32x4*)(dst + (size_t)r * 1024 + lane * 16) = q;
        if (lane == 0) scales[r] = sc;
    }
}
template <int NR>
__device__ __forceinline__ void peer_u8i(const RowBufN<NR>& rb, int r0, const LAS unsigned char* xq, const LAS unsigned* ent, LAS float* cf, const LAS float* sul, int e0, int lane) {
    int pr[8];
    const int ev = (int)ent[e0 + (lane & 7)];
#pragma unroll
    for (int i = 0; i < 8; ++i) {
        const int slot = (__builtin_amdgcn_readlane(ev, i) >> 21) & 3;
        const u32x4 xv = *(const LAS u32x4*)(xq + slot * 1024 + lane * 16);
        const u32x4 q = rb.a[r0 + i];
        int s = __builtin_amdgcn_sdot4((int)xv.x, (int)q.x, 0, false); s = __builtin_amdgcn_sdot4((int)xv.y, (int)q.y, s, false);
        s = __builtin_amdgcn_sdot4((int)xv.z, (int)q.z, s, false); s = __builtin_amdgcn_sdot4((int)xv.w, (int)q.w, s, false);
        pr[i] = s;
    }
    int r4[4], r2[2], r1;
    { const bool up = (lane & 32) != 0;
#pragma unroll
      for (int i = 0; i < 4; ++i) { const int keep = up ? pr[i + 4] : pr[i], send = up ? pr[i] : pr[i + 4]; r4[i] = keep + __shfl_xor(send, 32); } }
    { const bool up = (lane & 16) != 0;
#pragma unroll
      for (int i = 0; i < 2; ++i) { const int keep = up ? r4[i + 2] : r4[i], send = up ? r4[i] : r4[i + 2]; r2[i] = keep + __shfl_xor(send, 16); } }
    { const bool up = (lane & 8) != 0; const int keep = up ? r2[1] : r2[0], send = up ? r2[0] : r2[1]; r1 = keep + __shfl_xor(send, 8); }
    r1 += __shfl_xor(r1, 4); r1 += __shfl_xor(r1, 2); r1 += __shfl_xor(r1, 1);
    const float gate = cf[e0 + (lane >> 3)];
    const float coef = gate * gelu_tanh((float)r1 * sul[e0 + (lane >> 3)]);
    if ((lane & 7) == 0) cf[e0 + (lane >> 3)] = coef;
}
template <bool FAKE>
__device__ __forceinline__ f32x2 cvt8(unsigned w, bool hi) {
    if (FAKE) { const unsigned t = hi ? (w >> 16) : w; return (f32x2){__builtin_bit_cast(float, (t << 23) | 0x30000000u), __builtin_bit_cast(float, ((t >> 8) << 23) | 0x30000000u)}; }
    return hi ? __builtin_amdgcn_cvt_pk_f32_fp8((int)w, true) : __builtin_amdgcn_cvt_pk_f32_fp8((int)w, false);
}
template <bool FAKE = false>
__device__ __forceinline__ void peer_acc8p(f32x2 (&o)[8], const float c, const u32x4 q) {
    const f32x2 c2 = {c, c};
#pragma unroll
    for (int j = 0; j < 4; ++j) { const f32x2 lo = cvt8<FAKE>(q[j], false), hi = cvt8<FAKE>(q[j], true);
        o[2 * j] += c2 * lo; o[2 * j + 1] += c2 * hi; }
}
template <int NR, bool FAKE>
__device__ __forceinline__ void peer_vNp(const RowBufN<NR>& rb, f32x2 (&outv)[4][8], const LAS unsigned* ent, const LAS float* cf, int b, int lane) {
    const int ev = (int)ent[b * NR + (lane & (NR - 1))]; const float cv = cf[b * NR + (lane & (NR - 1))];
#pragma unroll
    for (int i = 0; i < NR; ++i) {
        const int slot = (__builtin_amdgcn_readlane(ev, i) >> 21) & 3;
        const float c = rdlane_f(cv, i);
        if (slot == 0) peer_acc8p<FAKE>(outv[0], c, rb.a[i]);
        if (slot == 1) peer_acc8p<FAKE>(outv[1], c, rb.a[i]);
        if (slot == 2) peer_acc8p<FAKE>(outv[2], c, rb.a[i]);
        if (slot == 3) peer_acc8p<FAKE>(outv[3], c, rb.a[i]);
    }
}
template <int PV, bool FAKE>
__device__ __forceinline__ void peer_passv(f32x2 (&outv)[4][8], const unsigned char* TV, const LAS unsigned* ent, const LAS float* cf, int lane) {
    RowBufN<PV> A, B, C;
    constexpr int NBV = 512 / PV;
    peer_loadN<PV>(A, TV, ent, 0, lane); peer_loadN<PV>(B, TV, ent, 1, lane);
#pragma unroll 1
    for (int b = 0; b + 2 < NBV; b += 3) {
        peer_loadN<PV>(C, TV, ent, b + 2, lane);
        peer_vNp<PV, FAKE>(A, outv, ent, cf, b, lane);
        if (b + 3 < NBV) peer_loadN<PV>(A, TV, ent, b + 3, lane);
        peer_vNp<PV, FAKE>(B, outv, ent, cf, b + 1, lane);
        if (b + 4 < NBV) peer_loadN<PV>(B, TV, ent, b + 4, lane);
        peer_vNp<PV, FAKE>(C, outv, ent, cf, b + 2, lane);
    }
    peer_vNp<PV, FAKE>(A, outv, ent, cf, NBV - 1, lane);
}
__device__ __forceinline__ void p_peer_expert5(const Frame& F, unsigned char* ws, float* xres, const float oscale, const XcdBarrier& xbar, const int mode) {
    const bf16_t* XN = (const bf16_t*)(ws + WS_XN); const unsigned char* TU = ws + WS_TAB8U; const unsigned char* TV = ws + WS_TAB8V;
    const float* SU = (const float*)(ws + WS_TABSU); const float* SV = (const float*)(ws + WS_TABSV);
    const unsigned short* EID = (const unsigned short*)(ws + PE_EID); const float* GATE = (const float*)(ws + PE_GATE);
    const int gw = F.bid * NWAVES + F.wave, NGW = F.G * NWAVES, lane = F.lane;
    LAS unsigned* ent = (LAS unsigned*)(F.lds + F.wave * 6144);
    LAS float* cf = (LAS float*)(F.lds + F.wave * 6144 + 2048);
    LAS float* sul = (LAS float*)(F.lds + F.wave * 6144 + 4096);
    LAS unsigned char* xq = F.lds + 49152 + F.wave * 4096;
    constexpr int PU = 16, PV = 8;
    const int nrounds = (T + NGW * 4 - 1) / (NGW * 4);
    for (int rnd = 0; rnd < nrounds; ++rnd) {
        const int m4 = (rnd * NGW + gw) * 4;
        if (m4 < T) {
            {
                float sx[4];
#pragma unroll
                for (int s = 0; s < 4; ++s) { const size_t m = (size_t)(m4 + s);
                    const u32x4 xa = *(const u32x4*)(XN + m * 1024 + lane * 16), xb = *(const u32x4*)(XN + m * 1024 + lane * 16 + 8);
                    float xf[16] = {bf_lo(xa.x), bf_hi(xa.x), bf_lo(xa.y), bf_hi(xa.y), bf_lo(xa.z), bf_hi(xa.z), bf_lo(xa.w), bf_hi(xa.w),
                                    bf_lo(xb.x), bf_hi(xb.x), bf_lo(xb.y), bf_hi(xb.y), bf_lo(xb.z), bf_hi(xb.z), bf_lo(xb.w), bf_hi(xb.w)};
                    float am = 0.f;
#pragma unroll
                    for (int i = 0; i < 16; ++i) am = fmaxf(am, fabsf(xf[i]));
#pragma unroll
                    for (int o = 1; o < 64; o <<= 1) am = fmaxf(am, __shfl_xor(am, o));
                    sx[s] = am > 0.f ? am * (1.0f / 127.0f) : 1.0f; const float inv = 1.0f / sx[s];
                    u32x4 q;
#pragma unroll
                    for (int j = 0; j < 4; ++j) { const int a = (int)rintf(xf[4 * j] * inv), b = (int)rintf(xf[4 * j + 1] * inv), c = (int)rintf(xf[4 * j + 2] * inv), d = (int)rintf(xf[4 * j + 3] * inv);
                        q[j] = (unsigned)(a & 255) | ((unsigned)(b & 255) << 8) | ((unsigned)(c & 255) << 16) | ((unsigned)(d & 255) << 24); }
                    *(LAS u32x4*)(xq + s * 1024 + lane * 16) = q; }
                int id[4][2]; float gg[4][2], su[4][2];
#pragma unroll
                for (int s = 0; s < 4; ++s) { const size_t m = (size_t)(m4 + s);
                    id[s][0] = EID[m * 128 + lane]; id[s][1] = EID[m * 128 + 64 + lane];
                    gg[s][0] = GATE[m * 128 + lane] * SV[id[s][0]]; gg[s][1] = GATE[m * 128 + 64 + lane] * SV[id[s][1]];
                    su[s][0] = SU[id[s][0]] * sx[s]; su[s][1] = SU[id[s][1]] * sx[s]; }
                int base = 0;
#pragma unroll 1
                for (int k = 0; k < 16; ++k) {
                    const int r = (rnd & 1) ? 15 - k : k;
#pragma unroll
                    for (int s = 0; s < 4; ++s)
#pragma unroll
                        for (int w = 0; w < 2; ++w) {
                            const bool hit = (id[s][w] >> 10) == r;
                            const u64 m = __ballot(hit);
                            if (hit) { const int pos = base + (int)__builtin_amdgcn_mbcnt_hi((unsigned)(m >> 32), __builtin_amdgcn_mbcnt_lo((unsigned)m, 0u));
                                ent[pos] = ((unsigned)s << 21) | ((unsigned)(w * 64 + lane) << 14) | (unsigned)(mode == 4 ? (id[s][w] & 7) : id[s][w]); cf[pos] = gg[s][w]; sul[pos] = su[s][w]; }
                            base += __builtin_popcountll(m);
                        }
                }
            }
            LDS_WAIT();
            if (mode != 1 && mode != 3) {
                RowBufN<PU> A, B;
                peer_loadN<PU>(A, TU, ent, 0, lane);
#pragma unroll 1
                for (int b = 0; b < 512 / PU; b += 2) {
                    peer_loadN<PU>(B, TU, ent, b + 1, lane);
#pragma unroll
                    for (int h = 0; h < PU / 8; ++h) peer_u8i<PU>(A, h * 8, xq, ent, cf, sul, b * PU + h * 8, lane);
                    if (b + 2 < 512 / PU) peer_loadN<PU>(A, TU, ent, b + 2, lane);
#pragma unroll
                    for (int h = 0; h < PU / 8; ++h) peer_u8i<PU>(B, h * 8, xq, ent, cf, sul, (b + 1) * PU + h * 8, lane);
                }
            }
            LDS_WAIT();
            f32x2 outv[4][8];
#pragma unroll
            for (int s = 0; s < 4; ++s)
#pragma unroll
                for (int i = 0; i < 8; ++i) outv[s][i] = (f32x2){0.f, 0.f};
            if (mode != 1 && mode != 2) {
                if (mode == 5) peer_passv<PV, true>(outv, TV, ent, cf, lane); else peer_passv<PV, false>(outv, TV, ent, cf, lane);
            }
#pragma unroll
            for (int s = 0; s < 4; ++s) {
                f32x4* o = (f32x4*)(xres + (size_t)(m4 + s) * 1024 + lane * 16);
#pragma unroll
                for (int j = 0; j < 4; ++j) { f32x4 a0 = o[j]; const f32x4 add = (f32x4){outv[s][2 * j].x, outv[s][2 * j].y, outv[s][2 * j + 1].x, outv[s][2 * j + 1].y};
                    if (oscale != 0.f) a0 += add; else asm volatile("" :: "v"(add)); o[j] = a0; }
            }
        }
        if (rnd + 1 < nrounds) xcd_barrier(xbar);
    }
}

struct GBuf { u32x4 a[8]; };
__device__ __forceinline__ void grp_load(GBuf& rb, const unsigned char* TAB, const LAS unsigned* ent, unsigned ginfo, int j, int lane) {
    const int start = (int)(ginfo & 0xFFFFu) + 8 * j, n = (int)(ginfo >> 16) - 8 * j;
    if (n > 0) {
        const int ev = (int)ent[start + (lane & 7)];
#pragma unroll
        for (int i = 0; i < 8; ++i) if (i < n) {
            const unsigned e = (unsigned)__builtin_amdgcn_readlane(ev, i) & 0x3FFFu;
            rb.a[i] = *(const u32x4*)(TAB + (size_t)e * 1024 + lane * 16);
        }
    }
}
__device__ __forceinline__ int dot16i(const u32x4 x, const u32x4 q) {
    int s = __builtin_amdgcn_sdot4((int)x.x, (int)q.x, 0, false); s = __builtin_amdgcn_sdot4((int)x.y, (int)q.y, s, false);
    s = __builtin_amdgcn_sdot4((int)x.z, (int)q.z, s, false); return __builtin_amdgcn_sdot4((int)x.w, (int)q.w, s, false);
}
__device__ __forceinline__ void grp_u(const GBuf& rb, const u32x4 xq, LAS float* cf, const LAS float* sul, unsigned ginfo, int j, int lane) {
    const int start = (int)(ginfo & 0xFFFFu) + 8 * j, n = (int)(ginfo >> 16) - 8 * j;
    if (n > 0) {
        int pr[8];
#pragma unroll
        for (int i = 0; i < 8; ++i) { pr[i] = 0; if (i < n) pr[i] = dot16i(xq, rb.a[i]); }
        int r4[4], r2[2], r1;
        { const bool up = (lane & 32) != 0;
#pragma unroll
          for (int i = 0; i < 4; ++i) { const int keep = up ? pr[i + 4] : pr[i], send = up ? pr[i] : pr[i + 4]; r4[i] = keep + __shfl_xor(send, 32); } }
        { const bool up = (lane & 16) != 0;
#pragma unroll
          for (int i = 0; i < 2; ++i) { const int keep = up ? r4[i + 2] : r4[i], send = up ? r4[i] : r4[i + 2]; r2[i] = keep + __shfl_xor(send, 16); } }
        { const bool up = (lane & 8) != 0; const int keep = up ? r2[1] : r2[0], send = up ? r2[0] : r2[1]; r1 = keep + __shfl_xor(send, 8); }
        r1 += __shfl_xor(r1, 4); r1 += __shfl_xor(r1, 2); r1 += __shfl_xor(r1, 1);
        const int i = lane >> 3;
        if (i < n) { const float coef = cf[start + i] * gelu_tanh((float)r1 * sul[start + i]); if ((lane & 7) == 0) cf[start + i] = coef; }
    }
}
__device__ __forceinline__ void grp_u_over(const u32x4 xq, const unsigned char* TU, const LAS unsigned* ent, LAS float* cf, const LAS float* sul, unsigned ginfo, int lane) {
    const int start = (int)(ginfo & 0xFFFFu), n = (int)(ginfo >> 16);
    for (int i = 16; i < n; ++i) {
        const unsigned e = (unsigned)__builtin_amdgcn_readfirstlane((int)ent[start + i]) & 0x3FFFu;
        const u32x4 q = *(const u32x4*)(TU + (size_t)e * 1024 + lane * 16);
        int r1 = dot16i(xq, q);
#pragma unroll
        for (int o = 32; o >= 1; o >>= 1) r1 += __shfl_xor(r1, o);
        const float coef = cf[start + i] * gelu_tanh((float)r1 * sul[start + i]);
        LDS_WAIT();
        if (lane == 0) cf[start + i] = coef;
        LDS_WAIT();
    }
}
__device__ __forceinline__ void grp_v(const GBuf& rb, f32x2 (&o)[8], const LAS float* cf, unsigned ginfo, int j, int lane) {
    const int start = (int)(ginfo & 0xFFFFu) + 8 * j, n = (int)(ginfo >> 16) - 8 * j;
    if (n > 0) {
        const float cv = cf[start + (lane & 7)];
#pragma unroll
        for (int i = 0; i < 8; ++i) if (i < n) peer_acc8p(o, rdlane_f(cv, i), rb.a[i]);
    }
}
__device__ __forceinline__ void grp_v_over(f32x2 (&o)[8], const unsigned char* TV, const LAS unsigned* ent, const LAS float* cf, unsigned ginfo, int lane) {
    const int start = (int)(ginfo & 0xFFFFu), n = (int)(ginfo >> 16);
    for (int i = 16; i < n; ++i) {
        const unsigned e = (unsigned)__builtin_amdgcn_readfirstlane((int)ent[start + i]) & 0x3FFFu;
        const u32x4 q = *(const u32x4*)(TV + (size_t)e * 1024 + lane * 16);
        peer_acc8p(o, cf[start + i], q);
    }
}
__device__ __forceinline__ void p_peer_expert6(const Frame& F, unsigned char* ws, float* xres, const float oscale, const XcdBarrier& xbar, const int mode) {
    const bf16_t* XN = (const bf16_t*)(ws + WS_XN); const unsigned char* TU = ws + WS_TAB8U; const unsigned char* TV = ws + WS_TAB8V;
    const float* SU = (const float*)(ws + WS_TABSU); const float* SV = (const float*)(ws + WS_TABSV);
    const unsigned short* EID = (const unsigned short*)(ws + PE_EID); const float* GATE = (const float*)(ws + PE_GATE);
    const int gw = F.bid * NWAVES + F.wave, NGW = F.G * NWAVES, lane = F.lane;
    LAS unsigned* ent = (LAS unsigned*)(F.lds + F.wave * 8192);
    LAS float* cf = (LAS float*)(F.lds + F.wave * 8192 + 2304);
    LAS float* sul = (LAS float*)(F.lds + F.wave * 8192 + 4608);
    LAS unsigned* gi = (LAS unsigned*)(F.lds + F.wave * 8192 + 6912);
    const int nrounds = (T + NGW * 4 - 1) / (NGW * 4);
    if (lane < 4) gi[64 + lane] = 0u;
    for (int rnd = 0; rnd < nrounds; ++rnd) {
        const int m4 = (rnd * NGW + gw) * 4;
        if (m4 < T) {
            u32x4 xq[4];
            {
                float sx[4];
#pragma unroll
                for (int s = 0; s < 4; ++s) { const size_t m = (size_t)(m4 + s);
                    const u32x4 xa = *(const u32x4*)(XN + m * 1024 + lane * 16), xb = *(const u32x4*)(XN + m * 1024 + lane * 16 + 8);
                    float xf[16] = {bf_lo(xa.x), bf_hi(xa.x), bf_lo(xa.y), bf_hi(xa.y), bf_lo(xa.z), bf_hi(xa.z), bf_lo(xa.w), bf_hi(xa.w),
                                    bf_lo(xb.x), bf_hi(xb.x), bf_lo(xb.y), bf_hi(xb.y), bf_lo(xb.z), bf_hi(xb.z), bf_lo(xb.w), bf_hi(xb.w)};
                    float am = 0.f;
#pragma unroll
                    for (int i = 0; i < 16; ++i) am = fmaxf(am, fabsf(xf[i]));
#pragma unroll
                    for (int o = 1; o < 64; o <<= 1) am = fmaxf(am, __shfl_xor(am, o));
                    sx[s] = am > 0.f ? am * (1.0f / 127.0f) : 1.0f; const float inv = 1.0f / sx[s];
#pragma unroll
                    for (int j = 0; j < 4; ++j) { const int a = (int)rintf(xf[4 * j] * inv), b = (int)rintf(xf[4 * j + 1] * inv), c = (int)rintf(xf[4 * j + 2] * inv), d = (int)rintf(xf[4 * j + 3] * inv);
                        xq[s][j] = (unsigned)(a & 255) | ((unsigned)(b & 255) << 8) | ((unsigned)(c & 255) << 16) | ((unsigned)(d & 255) << 24); } }
                int id[4][2]; float gg[4][2], su[4][2];
#pragma unroll
                for (int s = 0; s < 4; ++s) { const size_t m = (size_t)(m4 + s);
                    id[s][0] = EID[m * 128 + lane]; id[s][1] = EID[m * 128 + 64 + lane];
                    gg[s][0] = GATE[m * 128 + lane] * SV[id[s][0]]; gg[s][1] = GATE[m * 128 + 64 + lane] * SV[id[s][1]];
                    su[s][0] = SU[id[s][0]] * sx[s]; su[s][1] = SU[id[s][1]] * sx[s]; }
                int base = 0;
#pragma unroll 1
                for (int k = 0; k < 16; ++k) {
                    const int r = (rnd & 1) ? 15 - k : k;
#pragma unroll
                    for (int s = 0; s < 4; ++s) {
                        const int gstart = base;
#pragma unroll
                        for (int w = 0; w < 2; ++w) {
                            const bool hit = (id[s][w] >> 10) == r;
                            const u64 m = __ballot(hit);
                            if (hit) { const int pos = base + (int)__builtin_amdgcn_mbcnt_hi((unsigned)(m >> 32), __builtin_amdgcn_mbcnt_lo((unsigned)m, 0u));
                                ent[pos] = (unsigned)(mode == 4 ? (id[s][w] & 7) : id[s][w]); cf[pos] = gg[s][w]; sul[pos] = su[s][w]; }
                            base += __builtin_popcountll(m);
                        }
                        if (lane == 0) gi[k * 4 + s] = (unsigned)gstart | ((unsigned)(base - gstart) << 16);
                    }
                }
            }
            LDS_WAIT();
#define GI(g) ((unsigned)__builtin_amdgcn_readfirstlane((int)gi[(g)]))
#define SB() __builtin_amdgcn_sched_barrier(0)
            if (mode != 1 && mode != 3) {
                GBuf A, B;
                { const unsigned g0 = GI(0); grp_load(A, TU, ent, g0, 0, lane); grp_load(B, TU, ent, g0, 1, lane); }
#pragma unroll 1
                for (int k = 0; k < 16; ++k) {
                    const unsigned g0 = GI(k * 4), g1 = GI(k * 4 + 1), g2 = GI(k * 4 + 2), g3 = GI(k * 4 + 3), g4 = GI(k * 4 + 4);
                    grp_u(A, xq[0], cf, sul, g0, 0, lane); SB(); grp_load(A, TU, ent, g1, 0, lane); SB(); grp_u(B, xq[0], cf, sul, g0, 1, lane); SB(); grp_load(B, TU, ent, g1, 1, lane); SB();
                    grp_u(A, xq[1], cf, sul, g1, 0, lane); SB(); grp_load(A, TU, ent, g2, 0, lane); SB(); grp_u(B, xq[1], cf, sul, g1, 1, lane); SB(); grp_load(B, TU, ent, g2, 1, lane); SB();
                    grp_u(A, xq[2], cf, sul, g2, 0, lane); SB(); grp_load(A, TU, ent, g3, 0, lane); SB(); grp_u(B, xq[2], cf, sul, g2, 1, lane); SB(); grp_load(B, TU, ent, g3, 1, lane); SB();
                    grp_u(A, xq[3], cf, sul, g3, 0, lane); SB(); grp_load(A, TU, ent, g4, 0, lane); SB(); grp_u(B, xq[3], cf, sul, g3, 1, lane); SB(); grp_load(B, TU, ent, g4, 1, lane); SB();
                    grp_u_over(xq[0], TU, ent, cf, sul, g0, lane); grp_u_over(xq[1], TU, ent, cf, sul, g1, lane); grp_u_over(xq[2], TU, ent, cf, sul, g2, lane); grp_u_over(xq[3], TU, ent, cf, sul, g3, lane);
                }
            }
            LDS_WAIT();
            f32x2 outv[4][8];
#pragma unroll
            for (int s = 0; s < 4; ++s)
#pragma unroll
                for (int i = 0; i < 8; ++i) outv[s][i] = (f32x2){0.f, 0.f};
            if (mode != 1 && mode != 2) {
                GBuf A, B;
                { const unsigned g0 = GI(0); grp_load(A, TV, ent, g0, 0, lane); grp_load(B, TV, ent, g0, 1, lane); }
#pragma unroll 1
                for (int k = 0; k < 16; ++k) {
                    const unsigned g0 = GI(k * 4), g1 = GI(k * 4 + 1), g2 = GI(k * 4 + 2), g3 = GI(k * 4 + 3), g4 = GI(k * 4 + 4);
                    grp_v(A, outv[0], cf, g0, 0, lane); SB(); grp_load(A, TV, ent, g1, 0, lane); SB(); grp_v(B, outv[0], cf, g0, 1, lane); SB(); grp_load(B, TV, ent, g1, 1, lane); SB();
                    grp_v(A, outv[1], cf, g1, 0, lane); SB(); grp_load(A, TV, ent, g2, 0, lane); SB(); grp_v(B, outv[1], cf, g1, 1, lane); SB(); grp_load(B, TV, ent, g2, 1, lane); SB();
                    grp_v(A, outv[2], cf, g2, 0, lane); SB(); grp_load(A, TV, ent, g3, 0, lane); SB(); grp_v(B, outv[2], cf, g2, 1, lane); SB(); grp_load(B, TV, ent, g3, 1, lane); SB();
                    grp_v(A, outv[3], cf, g3, 0, lane); SB(); grp_load(A, TV, ent, g4, 0, lane); SB(); grp_v(B, outv[3], cf, g3, 1, lane); SB(); grp_load(B, TV, ent, g4, 1, lane); SB();
                    grp_v_over(outv[0], TV, ent, cf, g0, lane); grp_v_over(outv[1], TV, ent, cf, g1, lane); grp_v_over(outv[2], TV, ent, cf, g2, lane); grp_v_over(outv[3], TV, ent, cf, g3, lane);
                }
            }
#undef GI
#undef SB
#pragma unroll
            for (int s = 0; s < 4; ++s) {
                f32x4* o = (f32x4*)(xres + (size_t)(m4 + s) * 1024 + lane * 16);
#pragma unroll
                for (int j = 0; j < 4; ++j) { f32x4 a0 = o[j]; const f32x4 add = (f32x4){outv[s][2 * j].x, outv[s][2 * j].y, outv[s][2 * j + 1].x, outv[s][2 * j + 1].y};
                    if (oscale != 0.f) a0 += add; else asm volatile("" :: "v"(add)); o[j] = a0; }
            }
        }
        if (rnd + 1 < nrounds) xcd_barrier(xbar);
    }
}
constexpr size_t L1_QN = WS_R3;
constexpr size_t L1_KS = WS_R3 + 32 * MiB;
constexpr size_t L1_KW = WS_R3 + 40 * MiB;
constexpr size_t L1_VST = WS_R3 + 48 * MiB;
constexpr size_t L1_VWT = WS_R3 + 56 * MiB;
constexpr size_t L1_KCR = WS_R3 + 64 * MiB;
constexpr size_t L1_VCR = WS_R3 + 72 * MiB;
constexpr size_t L1_GATES = WS_R3 + 81 * MiB;
constexpr size_t L1_H1 = WS_R3 + 84 * MiB;
constexpr size_t L1_CMPO = WS_R3 + 88 * MiB;
constexpr size_t L1_KC = WS_R3 + 90 * MiB;
constexpr size_t L1_VCT = WS_R3 + 91 * MiB;
constexpr size_t L1_SELB = WS_R3 + 92 * MiB;
constexpr size_t L1_OC = WS_TABU;
constexpr size_t L1_CAT = WS_XN;
constexpr size_t L1_UPD = WS_R3;
constexpr size_t L1_DECAY = WS_R3 + 128 * MiB;

__device__ __forceinline__ void p_l1_prep(const Frame& F, const Args& a, unsigned char* ws) {
    const bf16_t* P = (const bf16_t*)(ws + WS_PROJ);
    const f32x2* rope = (const f32x2*)(ws + WS_ROPE);
    bf16_t* QN = (bf16_t*)(ws + L1_QN); bf16_t* KS = (bf16_t*)(ws + L1_KS); bf16_t* KW = (bf16_t*)(ws + L1_KW);
    bf16_t* KCR = (bf16_t*)(ws + L1_KCR); bf16_t* VCR = (bf16_t*)(ws + L1_VCR); float* GATES = (float*)(ws + L1_GATES);
    const int gw = F.bid * NWAVES + F.wave, NGW = F.G * NWAVES, lane = F.lane;
    const float qg = a.in[I_L1_QG][lane], kg = a.in[I_L1_KG][lane];
    for (int m = gw; m < T; m += NGW) {
        const int b = m >> 12, t = m & 4095;
        const bf16_t* row = P + (size_t)m * N_IN1;
        const f32x2 cs = rope[t * 32 + (lane & 31)];
#pragma unroll
        for (int h = 0; h < 8; ++h) {
            float v = bf2f(row[C1_Q + h * 64 + lane]);
            const float ss = wave_sum(v * v);
            v = v * (1.0f / sqrtf(ss * (1.f / 64.f) + 1e-6f)) * qg;
            v = rope_apply(v, cs, lane) * 0.125f;
            QN[(size_t)m * 512 + h * 64 + lane] = (bf16_t)f2bf(v);
        }
#pragma unroll
        for (int w = 0; w < 2; ++w)
#pragma unroll
            for (int g = 0; g < 2; ++g) {
                float v = bf2f(row[(w ? C1_KW : C1_KS) + g * 64 + lane]);
                const float ss = wave_sum(v * v);
                v = v * (1.0f / sqrtf(ss * (1.f / 64.f) + 1e-6f)) * kg;
                v = rope_apply(v, cs, lane);
                (w ? KW : KS)[((size_t)(b * 2 + g) * 4096 + t) * 64 + lane] = (bf16_t)f2bf(v);
            }
#pragma unroll
        for (int g = 0; g < 2; ++g) {
            KCR[((size_t)(b * 2 + g) * 4096 + t) * 64 + lane] = row[C1_KC + g * 64 + lane];
            VCR[((size_t)(b * 2 + g) * 4096 + t) * 64 + lane] = row[C1_VC + g * 64 + lane];
        }
        if (lane < 24) GATES[(size_t)m * 24 + lane] = sigmoidf_(bf2f(row[C1_GL + lane]));
    }
    for (int it = gw; it < 2 * NB * 2 * 64; it += NGW) {
        const int tb = it & 63, g = (it >> 6) & 1, b = (it >> 7) & 7, w = it >> 10;
        const size_t m = (size_t)b * 4096 + tb * 64 + lane;
        unsigned r[32];
#pragma unroll
        for (int j = 0; j < 8; ++j) { const u32x4 q = *(const u32x4*)(P + m * N_IN1 + (w ? C1_VW : C1_VS) + g * 64 + j * 8); r[4 * j] = q.x; r[4 * j + 1] = q.y; r[4 * j + 2] = q.z; r[4 * j + 3] = q.w; }
        bf16_t* dst = (bf16_t*)(ws + (w ? L1_VWT : L1_VST)) + ((size_t)(b * 2 + g) * 64) * 4096 + tb * 64 + lane;
#pragma unroll
        for (int d = 0; d < 64; ++d) dst[(size_t)d * 4096] = (bf16_t)((d & 1) ? (r[d >> 1] >> 16) : (r[d >> 1] & 0xffffu));
    }
}

namespace pg8 {
struct EpiCmp1 {
    static constexpr bool PERM = true;
    bf16_t* O; const float* bias;
    __device__ __forceinline__ void operator()(const f32x4 (&acc)[2][2][4][2], const Unit& u, int wr, int wc, int fr, int fq) const {
        const int row0 = u.pm * BM + wr * 64 + fr, col0 = wc * 32 + 8 * fq;
#pragma unroll
        for (int ai = 0; ai < 2; ++ai)
#pragma unroll
            for (int m = 0; m < 4; ++m) { bf16_t* rowp = O + (size_t)(row0 + ai * HALF + m * 16) * 256 + col0;
#pragma unroll
                for (int bj = 0; bj < 2; ++bj) { const float* bp = bias + u.pn * 256 + col0 + bj * HALF;
                    const f32x4 v0 = acc[ai][bj][m][0] + *(const f32x4*)bp, v1 = acc[ai][bj][m][1] + *(const f32x4*)(bp + 4);
                    u32x4 w; w.x = pk2(gelu_tanh(v0[0]), gelu_tanh(v0[1])); w.y = pk2(gelu_tanh(v0[2]), gelu_tanh(v0[3]));
                    w.z = pk2(gelu_tanh(v1[0]), gelu_tanh(v1[1])); w.w = pk2(gelu_tanh(v1[2]), gelu_tanh(v1[3]));
                    *(u32x4*)(rowp + bj * HALF) = w; }
                asm volatile("" ::: "memory"); __builtin_amdgcn_sched_barrier(0); }
    }
};
struct EpiCmp2 {
    static constexpr bool PERM = false;
    float* C;
    __device__ __forceinline__ void operator()(const f32x4 (&acc)[2][2][4][2], const Unit& u, int wr, int wc, int fr, int fq) const {
        if (wc >= 2) return;
        const int row0 = u.pm * BM + wr * 64 + fr, col0 = wc * 32 + 4 * fq;
#pragma unroll
        for (int ai = 0; ai < 2; ++ai)
#pragma unroll
            for (int m = 0; m < 4; ++m)
#pragma unroll
                for (int n = 0; n < 2; ++n) *(f32x4*)(C + (size_t)(row0 + ai * HALF + m * 16) * 64 + col0 + n * 16) = acc[ai][0][m][n];
    }
};
}

__device__ __forceinline__ void p_cmp_final(const Frame& F, const Args& a, unsigned char* ws) {
    const float* CMPO = (const float*)(ws + L1_CMPO); const f32x2* rope = (const f32x2*)(ws + WS_ROPE);
    bf16_t* KC = (bf16_t*)(ws + L1_KC); bf16_t* VCT = (bf16_t*)(ws + L1_VCT);
    const int gw = F.bid * NWAVES + F.wave, NGW = F.G * NWAVES, lane = F.lane;
    const float kg = a.in[I_L1_KG][lane];
    for (int r = gw; r < 8192; r += NGW) {
        float v = CMPO[(size_t)r * 64 + lane];
        const int rr = r & 4095, bg = rr >> 8, c = rr & 255;
        if (r < 4096) {
            const float ss = wave_sum(v * v);
            v = v * (1.0f / sqrtf(ss * (1.f / 64.f) + 1e-6f)) * kg;
            const int pos = (c < 255) ? 16 * c + 31 : 0;
            v = rope_apply(v, rope[pos * 32 + (lane & 31)], lane);
            KC[((size_t)bg * 256 + c) * 64 + lane] = (c < 255) ? (bf16_t)f2bf(v) : (bf16_t)0;
        } else {
            VCT[((size_t)bg * 64 + lane) * 256 + c] = (c < 255) ? (bf16_t)f2bf(v) : (bf16_t)0;
        }
    }
}

__device__ __forceinline__ void att_load2(AttStage& s, const bf16_t* Kg, const bf16_t* Vtg, int vstride, int key0, int tid) {
    s.kreg = *(const u32x4*)(Kg + (size_t)(key0 + (tid >> 3)) * 64 + (tid & 7) * 8);
    s.vreg = *(const u32x4*)(Vtg + (size_t)(tid >> 3) * vstride + key0 + (tid & 7) * 8);
}
__device__ __forceinline__ float score_bound_c2(const float* qg, const float* kg) {
    float mq = 0.f, mk_ = 0.f;
    for (int i = 0; i < 64; ++i) { mq = fmaxf(mq, fabsf(qg[i])); mk_ = fmaxf(mk_, fabsf(kg[i])); }
    return (8.0f * mq * mk_ + 0.5f) * 1.4426950408889634f;
}

__device__ __forceinline__ void p_cmp_attn(const Frame& F, const Args& a, unsigned char* ws) {
    const bf16_t* QN = (const bf16_t*)(ws + L1_QN); const bf16_t* KC = (const bf16_t*)(ws + L1_KC); const bf16_t* VCT = (const bf16_t*)(ws + L1_VCT);
    float* OC = (float*)(ws + L1_OC); u64* SELB = (u64*)(ws + L1_SELB);
    LAS float* impL = (LAS float*)(F.lds + 36864);
    const int lane = F.lane, wave = F.wave, h = lane >> 5, c = lane & 31, tid = F.tid;
    const float c2 = score_bound_c2(a.in[I_L1_QG], a.in[I_L1_KG]), c1 = 1.4426950408889634f;
    for (int u = F.bid; u < 1024; u += F.G) {
        const int b = (u >> 7) & 7, g = (u >> 6) & 1, rnd = u >> 8, qt = (rnd & 1) ? 63 - (u & 63) : (u & 63), q0 = qt * 64;
        const int bg = b * 2 + g; const size_t mb = (size_t)b * 4096;
        const int t = q0 + wave * 8 + (c >> 2), head = g * 4 + (c & 3);
        bf16x8 Qf[4];
#pragma unroll
        for (int ks = 0; ks < 4; ++ks) Qf[ks] = *(const bf16x8*)(QN + (mb + t) * 512 + head * 64 + ks * 16 + 8 * h);
        const int L = (t >= 31) ? (((t - 31) >> 4) < 254 ? ((t - 31) >> 4) : 254) : -1;
        const int tmax = q0 + 63; const int Lmax = (tmax >= 31) ? (((tmax - 31) >> 4) < 254 ? ((tmax - 31) >> 4) : 254) : -1;
        const int nkt = (Lmax >= 0) ? (Lmax >> 6) + 1 : 0;
        f32x16 O[2], IMP[2]; float l = 0.f;
#pragma unroll
        for (int i = 0; i < 16; ++i) { O[0][i] = 0.f; O[1][i] = 0.f; IMP[0][i] = 0.f; IMP[1][i] = 0.f; }
        const bf16_t* Kg = KC + (size_t)bg * 256 * 64; const bf16_t* Vtg = VCT + (size_t)bg * 64 * 256;
        __syncthreads();
        for (int kt = 0; kt < nkt; ++kt) {
            AttStage st; att_load2(st, Kg, Vtg, 256, kt * 64, tid);
            __syncthreads();
            att_store(st, F.lds, tid);
            __syncthreads();
#pragma unroll 1
            for (int sub = 0; sub < 2; ++sub) {
                const f32x16 S = att_qk(F.lds, sub, Qf, lane);
                float p[16];
#pragma unroll
                for (int i = 0; i < 16; ++i) {
                    const int cidx = kt * 64 + sub * 32 + (i & 3) + 8 * (i >> 2) + 4 * h;
                    const float e = __builtin_amdgcn_exp2f(S[i] * c1 - c2);
                    p[i] = (cidx <= L) ? e : 0.f; l += p[i];
                }
                const bf16x8 P0 = pack8(p[0], p[1], p[2], p[3], p[4], p[5], p[6], p[7]);
                const bf16x8 P1 = pack8(p[8], p[9], p[10], p[11], p[12], p[13], p[14], p[15]);
                att_pv2(F.lds, sub, P0, P1, O, lane);
#pragma unroll
                for (int jt = 0; jt < 2; ++jt)
#pragma unroll
                    for (int s = 0; s < 2; ++s) {
                        unsigned wv[4];
#pragma unroll
                        for (int e2 = 0; e2 < 4; ++e2) {
                            unsigned pr = 0u;
#pragma unroll
                            for (int q = 0; q < 2; ++q) { const int jj = 2 * e2 + q; const int kap = 16 * s + 8 * (jj >> 2) + 4 * h + (jj & 3);
                                const int off = kt * 64 + sub * 32 + kap - 4 * (32 * jt + c);
                                const unsigned wbits = (off == 0 || off == 4) ? 0x3F80u : ((off >= 1 && off <= 3) ? 0x4000u : 0u);
                                pr |= wbits << (16 * q); }
                            wv[e2] = pr;
                        }
                        const bf16x8 Wf = __builtin_bit_cast(bf16x8, ((u32x4){wv[0], wv[1], wv[2], wv[3]}));
                        IMP[jt] = __builtin_amdgcn_mfma_f32_32x32x16_bf16(Wf, s ? P1 : P0, IMP[jt], 0, 0, 0);
                    }
            }
        }
        const float lt = l + __shfl_xor(l, 32);
        const float inv = 1.0f / fmaxf(lt, 1e-30f);
        { float* orow = OC + (mb + t) * 512 + head * 64;
#pragma unroll
          for (int dt = 0; dt < 2; ++dt)
#pragma unroll
            for (int i4 = 0; i4 < 4; ++i4) { const int d = dt * 32 + 8 * i4 + 4 * h;
                *(f32x4*)(orow + d) = (f32x4){O[dt][4 * i4] * inv, O[dt][4 * i4 + 1] * inv, O[dt][4 * i4 + 2] * inv, O[dt][4 * i4 + 3] * inv}; } }
#pragma unroll
        for (int jt = 0; jt < 2; ++jt)
#pragma unroll
            for (int i = 0; i < 16; ++i) {
                float v = IMP[jt][i] * inv; v += __shfl_xor(v, 1); v += __shfl_xor(v, 2);
                if ((c & 3) == 0) impL[(wave * 8 + (c >> 2)) * 65 + 32 * jt + (i & 3) + 8 * (i >> 2) + 4 * h] = v;
            }
        __syncthreads();
        if (tid < 64) {
            const int tq = q0 + tid, cur = tq >> 6;
            u64 mask;
            if (cur + 1 <= 16) mask = (1ull << (cur + 1)) - 1ull;
            else {
                float v[64];
#pragma unroll
                for (int j = 0; j < 64; ++j) { const float x = impL[tid * 65 + j]; v[j] = (j > cur) ? -3.0e38f : ((j == 0 || j == cur) ? 1.0e9f : x); }
                mask = 0ull;
#pragma unroll 1
                for (int k = 0; k < 16; ++k) {
                    float best = -3.0e38f; int bi = 0;
#pragma unroll
                    for (int j = 0; j < 64; ++j) { const bool taken = (mask >> j) & 1ull; if (!taken && v[j] > best) { best = v[j]; bi = j; } }
                    mask |= 1ull << bi;
                }
            }
            SELB[(size_t)bg * 4096 + tq] = mask;
        }
        __syncthreads();
    }
}

__device__ __forceinline__ void p_nsa_attn(const Frame& F, const Args& a, unsigned char* ws) {
    const bf16_t* QN = (const bf16_t*)(ws + L1_QN);
    const u64* SELB = (const u64*)(ws + L1_SELB); float* OC = (float*)(ws + L1_OC); const float* GATES = (const float*)(ws + L1_GATES);
    bf16_t* CAT = (bf16_t*)(ws + L1_CAT);
    const int lane = F.lane, wave = F.wave, h = lane >> 5, c = lane & 31, tid = F.tid;
    const float c2 = score_bound_c2(a.in[I_L1_QG], a.in[I_L1_KG]), c1 = 1.4426950408889634f;
    for (int u = F.bid; u < 512; u += F.G) {
        const int idx = u & 255, g = u >> 8, b = idx >> 5, qtr = idx & 31, qt = g ? 31 - qtr : qtr, q0 = qt * 128;
        const int bg = b * 2 + g; const size_t mb = (size_t)b * 4096;
        bf16x8 Qf[2][4]; int qidx[2];
#pragma unroll
        for (int ct = 0; ct < 2; ++ct) { qidx[ct] = q0 + wave * 16 + ct * 8 + (c >> 2);
#pragma unroll
            for (int ks = 0; ks < 4; ++ks) Qf[ct][ks] = *(const bf16x8*)(QN + (mb + qidx[ct]) * 512 + (g * 4 + (c & 3)) * 64 + ks * 16 + 8 * h); }
        const int head = g * 4 + (c & 3);
#pragma unroll 1
        for (int pass = 0; pass < 2; ++pass) {
            const bf16_t* Kg = (const bf16_t*)(ws + (pass ? L1_KW : L1_KS)) + (size_t)bg * 4096 * 64;
            const bf16_t* Vtg = (const bf16_t*)(ws + (pass ? L1_VWT : L1_VST)) + (size_t)bg * 64 * 4096;
            u64 selw[2];
#pragma unroll
            for (int ct = 0; ct < 2; ++ct) selw[ct] = pass ? ~0ull : SELB[(size_t)bg * 4096 + qidx[ct]];
            const int wlen = pass ? 512 : 1000000;
            f32x16 O[2][2]; float l[2] = {0.f, 0.f};
#pragma unroll
            for (int ct = 0; ct < 2; ++ct)
#pragma unroll
                for (int dt = 0; dt < 2; ++dt)
#pragma unroll
                    for (int i = 0; i < 16; ++i) O[ct][dt][i] = 0.f;
            const int kt_lo = pass ? ((2 * qt - 8) > 0 ? 2 * qt - 8 : 0) : 0, kt_hi = 2 * qt + 2;
            AttStage st; att_load(st, Kg, Vtg, kt_lo * 64, tid);
            __syncthreads();
            att_store(st, F.lds + (kt_lo & 1) * AT_BUF, tid);
            __syncthreads();
            for (int kt = kt_lo; kt < kt_hi; ++kt) {
                LAS unsigned char* buf = F.lds + (kt & 1) * AT_BUF;
                if (kt + 1 < kt_hi) att_load(st, Kg, Vtg, (kt + 1) * 64, tid);
#pragma unroll 1
                for (int sub = 0; sub < 2; ++sub) {
#pragma unroll
                    for (int ct = 0; ct < 2; ++ct) {
                        __builtin_amdgcn_sched_barrier(0);
                        const f32x16 S = att_qk(buf, sub, Qf[ct], lane);
                        const bool flag = (selw[ct] >> kt) & 1ull;
                        const int tq = qidx[ct];
                        float p[16];
#pragma unroll
                        for (int i = 0; i < 16; ++i) {
                            const int key = kt * 64 + sub * 32 + (i & 3) + 8 * (i >> 2) + 4 * h;
                            const float e = __builtin_amdgcn_exp2f(S[i] * c1 - c2);
                            p[i] = (flag && key <= tq && key + wlen > tq) ? e : 0.f; l[ct] += p[i];
                        }
                        const bf16x8 P0 = pack8(p[0], p[1], p[2], p[3], p[4], p[5], p[6], p[7]);
                        const bf16x8 P1 = pack8(p[8], p[9], p[10], p[11], p[12], p[13], p[14], p[15]);
                        att_pv2(buf, sub, P0, P1, O[ct], lane);
                    }
                }
                if (kt + 1 < kt_hi) att_store(st, F.lds + ((kt + 1) & 1) * AT_BUF, tid);
                __syncthreads();
            }
#pragma unroll
            for (int ct = 0; ct < 2; ++ct) {
                const float lt = l[ct] + __shfl_xor(l[ct], 32);
                const float inv = 1.0f / fmaxf(lt, 1e-30f);
                const size_t m = mb + qidx[ct];
                const float gcv = GATES[m * 24 + head * 3 + 0], gsv = GATES[m * 24 + head * 3 + 1], gwv = GATES[m * 24 + head * 3 + 2];
                float* orow = OC + m * 512 + head * 64; bf16_t* crow = CAT + m * 1024 + head * 64;
#pragma unroll
                for (int dt = 0; dt < 2; ++dt)
#pragma unroll
                    for (int i4 = 0; i4 < 4; ++i4) {
                        const int d = dt * 32 + 8 * i4 + 4 * h;
                        const f32x4 prev = *(const f32x4*)(orow + d);
                        const f32x4 ov = (f32x4){O[ct][dt][4 * i4] * inv, O[ct][dt][4 * i4 + 1] * inv, O[ct][dt][4 * i4 + 2] * inv, O[ct][dt][4 * i4 + 3] * inv};
                        if (pass == 0) *(f32x4*)(orow + d) = prev * gcv + ov * gsv;
                        else { const f32x4 r = prev + ov * gwv; u32x2 w; w.x = pk2(r[0], r[1]); w.y = pk2(r[2], r[3]); *(u32x2*)(crow + d) = w; }
                    }
            }
        }
    }
}

__device__ __forceinline__ float logsigmoidf_(float x) { return fminf(x, 0.f) - log1pf(__expf(-fabsf(x))); }
__device__ __forceinline__ void gla_bcum(const Frame& F, const Args& a, const bf16_t* P, size_t m0, int hh, LAS float* la) {
    const int tid = F.tid, cc = tid >> 4, dk0 = (tid & 15) * 4;
    {
        const bf16_t* grow = P + (m0 + cc) * N_IN1 + C1_GLOW;
        const u32x4 ga = *(const u32x4*)grow, gb = *(const u32x4*)(grow + 8);
        float gl[16] = {bf_lo(ga.x), bf_hi(ga.x), bf_lo(ga.y), bf_hi(ga.y), bf_lo(ga.z), bf_hi(ga.z), bf_lo(ga.w), bf_hi(ga.w),
                        bf_lo(gb.x), bf_hi(gb.x), bf_lo(gb.y), bf_hi(gb.y), bf_lo(gb.z), bf_hi(gb.z), bf_lo(gb.w), bf_hi(gb.w)};
        f32x4 acc = *(const f32x4*)(a.in[I_L1_BGATE] + hh * 64 + dk0);
#pragma unroll
        for (int r = 0; r < 16; ++r) { const f32x4 w = *(const f32x4*)(a.in[I_L1_WGATE] + r * 256 + hh * 64 + dk0); acc += w * gl[r]; }
        *(LAS f32x4*)(la + cc * 64 + dk0) = (f32x4){logsigmoidf_(acc[0]) * 0.0625f, logsigmoidf_(acc[1]) * 0.0625f, logsigmoidf_(acc[2]) * 0.0625f, logsigmoidf_(acc[3]) * 0.0625f};
    }
    __syncthreads();
    if (tid < 64) { float run = 0.f;
#pragma unroll 8
        for (int c = 0; c < 32; ++c) { run += la[c * 64 + tid]; la[c * 64 + tid] = run; } }
    __syncthreads();
}
__device__ __forceinline__ void p_gla_a(const Frame& F, const Args& a, unsigned char* ws) {
    const bf16_t* P = (const bf16_t*)(ws + WS_PROJ); float* UPD = (float*)(ws + L1_UPD); float* DECAY = (float*)(ws + L1_DECAY);
    LAS float* la = (LAS float*)F.lds; LAS float* kd = la + 2048; LAS float* vv = kd + 2048;
    const int tid = F.tid;
    for (int u = F.bid; u < 4096; u += F.G) {
        const int b = u >> 9, hh = (u >> 7) & 3, n = u & 127; const size_t m0 = (size_t)b * 4096 + n * 32;
        gla_bcum(F, a, P, m0, hh, la);
        { const int cc = tid >> 4, dk0 = (tid & 15) * 4;
          const u32x2 kq = *(const u32x2*)(P + (m0 + cc) * N_IN1 + C1_GK + hh * 64 + dk0);
          const f32x4 bc = *(const LAS f32x4*)(la + cc * 64 + dk0), bl = *(const LAS f32x4*)(la + 31 * 64 + dk0);
          *(LAS f32x4*)(kd + cc * 64 + dk0) = (f32x4){bf_lo(kq.x) * __expf(bl[0] - bc[0]), bf_hi(kq.x) * __expf(bl[1] - bc[1]), bf_lo(kq.y) * __expf(bl[2] - bc[2]), bf_hi(kq.y) * __expf(bl[3] - bc[3])};
          const int dv0 = (tid & 15) * 8;
          const u32x4 vq = *(const u32x4*)(P + (m0 + cc) * N_IN1 + C1_GV + hh * 128 + dv0);
          *(LAS f32x4*)(vv + cc * 128 + dv0) = (f32x4){bf_lo(vq.x), bf_hi(vq.x), bf_lo(vq.y), bf_hi(vq.y)};
          *(LAS f32x4*)(vv + cc * 128 + dv0 + 4) = (f32x4){bf_lo(vq.z), bf_hi(vq.z), bf_lo(vq.w), bf_hi(vq.w)};
          if (tid < 64) DECAY[(size_t)u * 64 + tid] = __expf(la[31 * 64 + tid]); }
        __syncthreads();
        { const int dv = tid & 127, dkb = tid >> 7;
          float acc[16];
#pragma unroll
          for (int j = 0; j < 16; ++j) acc[j] = 0.f;
#pragma unroll 4
          for (int c = 0; c < 32; ++c) { const float v = vv[c * 128 + dv];
#pragma unroll
              for (int j4 = 0; j4 < 4; ++j4) { const f32x4 k4 = *(const LAS f32x4*)(kd + c * 64 + dkb * 16 + j4 * 4);
                  acc[j4 * 4] += k4[0] * v; acc[j4 * 4 + 1] += k4[1] * v; acc[j4 * 4 + 2] += k4[2] * v; acc[j4 * 4 + 3] += k4[3] * v; } }
#pragma unroll
          for (int j = 0; j < 16; ++j) UPD[((size_t)u * 64 + dkb * 16 + j) * 128 + dv] = acc[j]; }
        __syncthreads();
    }
}
__device__ __forceinline__ void p_gla_b(const Frame& F, unsigned char* ws) {
    float* UPD = (float*)(ws + L1_UPD); const float* DECAY = (const float*)(ws + L1_DECAY);
    for (int e = F.bid * NTHREADS + F.tid; e < 32 * 8192; e += F.G * NTHREADS) {
        const int bh = e >> 13, rem = e & 8191, dk = rem >> 7;
        float state = 0.f;
        float* up = UPD + (size_t)bh * 128 * 8192 + rem; const float* dp = DECAY + (size_t)bh * 128 * 64 + dk;
#pragma unroll 4
        for (int n = 0; n < 128; ++n) { const float uv = up[(size_t)n * 8192], dc = dp[n * 64]; up[(size_t)n * 8192] = state; state = dc * state + uv; }
    }
}
__device__ __forceinline__ void p_gla_c(const Frame& F, const Args& a, unsigned char* ws) {
    const bf16_t* P = (const bf16_t*)(ws + WS_PROJ); const float* PREV = (const float*)(ws + L1_UPD); bf16_t* CAT = (bf16_t*)(ws + L1_CAT);
    LAS float* la = (LAS float*)F.lds; LAS float* qd = la + 2048; LAS float* ki = qd + 2048; LAS float* vv = ki + 2048; LAS float* att = vv + 4096; LAS float* red = att + 32 * 33;
    const int tid = F.tid, lane = F.lane, wave = F.wave;
    for (int u = F.bid; u < 4096; u += F.G) {
        const int b = u >> 9, hh = (u >> 7) & 3, n = u & 127; const size_t m0 = (size_t)b * 4096 + n * 32;
        gla_bcum(F, a, P, m0, hh, la);
        { const int cc = tid >> 4, dk0 = (tid & 15) * 4;
          const u32x2 kq = *(const u32x2*)(P + (m0 + cc) * N_IN1 + C1_GK + hh * 64 + dk0);
          const u32x2 qq = *(const u32x2*)(P + (m0 + cc) * N_IN1 + C1_GQ + hh * 64 + dk0);
          const f32x4 bc = *(const LAS f32x4*)(la + cc * 64 + dk0);
          *(LAS f32x4*)(ki + cc * 64 + dk0) = (f32x4){bf_lo(kq.x) * __expf(-bc[0]), bf_hi(kq.x) * __expf(-bc[1]), bf_lo(kq.y) * __expf(-bc[2]), bf_hi(kq.y) * __expf(-bc[3])};
          *(LAS f32x4*)(qd + cc * 64 + dk0) = (f32x4){bf_lo(qq.x) * 0.125f * __expf(bc[0]), bf_hi(qq.x) * 0.125f * __expf(bc[1]), bf_lo(qq.y) * 0.125f * __expf(bc[2]), bf_hi(qq.y) * 0.125f * __expf(bc[3])};
          const int dv0 = (tid & 15) * 8;
          const u32x4 vq = *(const u32x4*)(P + (m0 + cc) * N_IN1 + C1_GV + hh * 128 + dv0);
          *(LAS f32x4*)(vv + cc * 128 + dv0) = (f32x4){bf_lo(vq.x), bf_hi(vq.x), bf_lo(vq.y), bf_hi(vq.y)};
          *(LAS f32x4*)(vv + cc * 128 + dv0 + 4) = (f32x4){bf_lo(vq.z), bf_hi(vq.z), bf_lo(vq.w), bf_hi(vq.w)}; }
        __syncthreads();
        { const int cc = tid >> 4, s0 = (tid & 15) * 2;
          float a0 = 0.f, a1 = 0.f;
#pragma unroll 4
          for (int d4 = 0; d4 < 16; ++d4) { const f32x4 q4 = *(const LAS f32x4*)(qd + cc * 64 + d4 * 4), k0 = *(const LAS f32x4*)(ki + s0 * 64 + d4 * 4), k1 = *(const LAS f32x4*)(ki + (s0 + 1) * 64 + d4 * 4);
              a0 += q4[0] * k0[0] + q4[1] * k0[1] + q4[2] * k0[2] + q4[3] * k0[3]; a1 += q4[0] * k1[0] + q4[1] * k1[1] + q4[2] * k1[2] + q4[3] * k1[3]; }
          att[cc * 33 + s0] = (s0 <= cc) ? a0 : 0.f; att[cc * 33 + s0 + 1] = (s0 + 1 <= cc) ? a1 : 0.f; }
        __syncthreads();
        { const int dv = tid & 127, cb = tid >> 7;
          float acc[8];
#pragma unroll
          for (int j = 0; j < 8; ++j) acc[j] = 0.f;
          const float* pp = PREV + (size_t)u * 8192 + dv;
#pragma unroll 8
          for (int dk = 0; dk < 64; ++dk) { const float pv = pp[dk * 128];
#pragma unroll
              for (int j = 0; j < 8; ++j) acc[j] += qd[(cb * 8 + j) * 64 + dk] * pv; }
#pragma unroll 4
          for (int s = 0; s < 32; ++s) { const float v = vv[s * 128 + dv];
#pragma unroll
              for (int j = 0; j < 8; ++j) acc[j] += att[(cb * 8 + j) * 33 + s] * v; }
#pragma unroll
          for (int j = 0; j < 8; ++j) { const float ss = wave_sum(acc[j] * acc[j]); if (lane == 0) red[wave * 8 + j] = ss; }
          __syncthreads();
          const float og = a.in[I_L1_OGAIN][dv];
#pragma unroll
          for (int j = 0; j < 8; ++j) { const float tot = red[(2 * cb) * 8 + j] + red[(2 * cb + 1) * 8 + j];
              const float rstd = 1.0f / sqrtf(tot * (1.f / 128.f) + 1e-6f);
              const size_t m = m0 + cb * 8 + j;
              const float r = bf2f(P[m * N_IN1 + C1_GR + hh * 128 + dv]);
              const float sil = r * sigmoidf_(r);
              CAT[m * 1024 + 512 + hh * 128 + dv] = (bf16_t)f2bf(acc[j] * rstd * og * sil); } }
        __syncthreads();
    }
}
__global__ void __launch_bounds__(NTHREADS, 2) mk_fwd(Args args) {
    extern __shared__ __attribute__((aligned(16))) unsigned char lds_raw[];
    cg::grid_group grid = cg::this_grid();
    Frame F; F.lds = (LAS unsigned char*)lds_raw; F.tid = threadIdx.x; F.lane = F.tid & 63; F.wave = __builtin_amdgcn_readfirstlane(F.tid >> 6); F.G = gridDim.x; F.bid = blockIdx.x;
    unsigned char* ws = args.ws;
    const int lo = args.ph_lo, hi = args.ph_hi;
#ifndef KEEPMASK
#define KEEPMASK 0xFFFFFFFFu
#endif
#define IN(k) (((KEEPMASK >> (k)) & 1u) && lo <= (k) && (k) < hi)
#define BOTH(k) (IN(k) && IN((k) + 1))
#ifndef TMODE
#define TMODE 0
#endif
#ifndef REPMASK
#define REPMASK 0u
#endif
#define PH(k, ...) if (IN(k)) { { const int rep = 0; (void)rep; __VA_ARGS__; } if ((REPMASK >> (k)) & 1u) { xcd_barrier(xbar); { const int rep = 1; (void)rep; __VA_ARGS__; } } }
#ifdef TS_A
#define STAMP(k) do { if (F.bid == 0 && F.tid == 0) ((unsigned long long*)(ws + WS_CTL + 65536))[(k)] = __builtin_amdgcn_s_memrealtime(); } while (0)
#else
#define STAMP(k) do { } while (0)
#endif
#define GRID_BAR(k) do { if (BOTH(k)) { if ((k) == 0) grid.sync(); else xcd_barrier(xbar); } STAMP((k) + 1); } while (0)
    const float* x = args.in[I_X];
    float* out = args.out;
    volatile LAS unsigned* xst = (volatile LAS unsigned*)(F.lds + LDS_BYTES - 64);
    if (F.tid < 16) xst[F.tid] = 0u;
    __syncthreads();
    XcdBarrier xbar = xcd_barrier_post((unsigned*)(ws + WS_CTL) + 4096, xst);

    STAMP(0);
    PH(0, int base = 0; transpose_all(F, base, args.in[I_L0_WIN], 1024, 1864, (bf16_t*)(ws + WS_W_IN0), 1024, MapIn0()); transpose_all(F, base, args.in[I_L0_WGLU], 512, 512, (bf16_t*)(ws + WS_W_GLU), 512, MapId()); transpose_all(F, base, args.in[I_L0_WOUT], 1024, 1024, (bf16_t*)(ws + WS_W_OUT0), 1024, MapId()); transpose_all(F, base, args.in[I_L0_WQ], 1024, 2048, (bf16_t*)(ws + WS_WQ0), 1024, MapId()); transpose_all(F, base, args.in[I_L1_WIN], 1024, 2856, (bf16_t*)(ws + WS_W_IN1), 1024, MapIn1()); transpose_all(F, base, args.in[I_L1_KW1], 2048, 256, (bf16_t*)(ws + WS_KW1), 2048, MapId()); transpose_all(F, base, args.in[I_L1_VW1], 2048, 256, (bf16_t*)(ws + WS_VW1), 2048, MapId()); transpose_all(F, base, args.in[I_L1_KW2], 256, 64, (bf16_t*)(ws + WS_KW2), 256, MapId()); transpose_all(F, base, args.in[I_L1_VW2], 256, 64, (bf16_t*)(ws + WS_VW2), 256, MapId()); transpose_all(F, base, args.in[I_L1_WOUT], 1024, 1024, (bf16_t*)(ws + WS_W_OUT1), 1024, MapId()); transpose_all(F, base, args.in[I_L1_WQ], 1024, 2048, (bf16_t*)(ws + WS_WQ1), 1024, MapId()); zero_bytes(F, ws + WS_W_IN0 + (size_t)1864 * 1024 * 2, (size_t)(2048 - 1864) * 1024 * 2); zero_bytes(F, ws + WS_W_IN1 + (size_t)2856 * 1024 * 2, (size_t)(3072 - 2856) * 1024 * 2); zero_bytes(F, ws + WS_KW2 + (size_t)64 * 256 * 2, (size_t)192 * 256 * 2); zero_bytes(F, ws + WS_VW2 + (size_t)64 * 256 * 2, (size_t)192 * 256 * 2); cvt_f32_bf16(F, args.in[I_L0_SK], (bf16_t*)(ws + WS_SK0), (size_t)16 * 128 * 128); cvt_f32_bf16(F, args.in[I_L1_SK], (bf16_t*)(ws + WS_SK1), (size_t)16 * 128 * 128); cvt_table_i8(F, args.in[I_L0_U], ws + WS_TAB8U, (float*)(ws + WS_TABSU)); cvt_table_fp8(F, args.in[I_L0_V], ws + WS_TAB8V, (float*)(ws + WS_TABSV)); p_rope_table(F, (f32x2*)(ws + WS_ROPE)); __syncthreads(); for (int g = F.bid; g < 32; g += F.G) s5_build_group(F, args, ws, g); if (F.bid == (F.G > 40 ? 40 : 0)) cmp_bias(F, args, (float*)(ws + WS_CMPB)); p_rmsnorm(F, x, args.in[I_L0_MIXN], (bf16_t*)(ws + WS_XN));)
    GRID_BAR(0);
    PH(1, pg8::Gemm g{(const bf16_t*)(ws + WS_XN), (const bf16_t*)(ws + WS_W_IN0), T, N_IN0, 1024, 1024, 1024}; pg8::StaticOrder S; S.init(T, N_IN0, F.G, F.bid); pg8::EpiStoreBf16 E{(bf16_t*)(ws + WS_PROJ), N_IN0}; pg8::gemm_phase(F.lds, g, S, E);)
    GRID_BAR(1);
    PH(2, p_l0_prep(F, args, ws);)
    GRID_BAR(2);
    PH(3, p_dsa_index(F, ws);)
    GRID_BAR(3);
    PH(4, p_dsa_attn(F, args, ws);)
    GRID_BAR(4);
    PH(5, pg8::Gemm g{(const bf16_t*)(ws + L0_UA), (const bf16_t*)(ws + WS_S5B1), 65536, 8192, 256, 384, 256}; pg8::GroupedOrder S; S.init(256, 8, F.G, F.bid); pg8::EpiS5State E{(float*)(ws + L0_SLOC)}; pg8::gemm_phase(F.lds, g, S, E);)
    GRID_BAR(5);
    PH(6, p_s5_scan(F, args, ws);)
    GRID_BAR(6);
    PH(7, pg8::Gemm g{(const bf16_t*)(ws + L0_UA), (const bf16_t*)(ws + WS_S5B2), 65536, 8192, 384, 384, 384}; pg8::GroupedOrder S; S.init(256, 8, F.G, F.bid); pg8::EpiS5Out E{(bf16_t*)(ws + L0_YB)}; pg8::gemm_phase(F.lds, g, S, E);)
    GRID_BAR(7);
    PH(8, pg8::Gemm g{(const bf16_t*)(ws + L0_YB), (const bf16_t*)(ws + WS_W_GLU), T, 512, 512, 512, 512}; pg8::StaticOrder S; S.init(T, 512, F.G, F.bid); pg8::EpiGlu E{(const bf16_t*)(ws + L0_YB), args.in[I_L0_BGLU], (bf16_t*)(ws + L0_CAT)}; pg8::gemm_phase(F.lds, g, S, E);)
    GRID_BAR(8);
    PH(9, pg8::Gemm g{(const bf16_t*)(ws + L0_CAT), (const bf16_t*)(ws + WS_W_OUT0), T, 1024, 1024, 1024, 1024}; pg8::StaticOrder S; S.init(T, 1024, F.G, F.bid); pg8::EpiResidF32 E{x, out, 1024}; pg8::gemm_phase(F.lds, g, S, E);)
    GRID_BAR(9);
    PH(10, p_rmsnorm(F, out, args.in[I_L0_FFNN], (bf16_t*)(ws + WS_XN));)
    GRID_BAR(10);
    PH(11, pg8::Gemm g{(const bf16_t*)(ws + WS_XN), (const bf16_t*)(ws + WS_WQ0), T, 2048, 1024, 1024, 1024}; pg8::StaticOrder S; S.init(T, 2048, F.G, F.bid); pg8::EpiStoreBf16 E{(bf16_t*)(ws + PE_Q2), 2048}; pg8::gemm_phase(F.lds, g, S, E);)
    GRID_BAR(11);
    PH(12, p_peer_route(F, ws, (const bf16_t*)(ws + WS_SK0));)
    GRID_BAR(12);
    PH(13, p_peer_expert5(F, ws, out, rep ? 0.f : 1.f, xbar, rep ? TMODE : 0);)
    GRID_BAR(13);
    PH(14, p_rmsnorm(F, out, args.in[I_L1_MIXN], (bf16_t*)(ws + WS_XN));)
    GRID_BAR(14);
    PH(15, pg8::Gemm g{(const bf16_t*)(ws + WS_XN), (const bf16_t*)(ws + WS_W_IN1), T, N_IN1, 1024, 1024, 1024}; pg8::StaticOrder S; S.init(T, N_IN1, F.G, F.bid); pg8::EpiStoreBf16 E{(bf16_t*)(ws + WS_PROJ), N_IN1}; pg8::gemm_phase(F.lds, g, S, E);)
    GRID_BAR(15);
    PH(16, p_l1_prep(F, args, ws);)
    GRID_BAR(16);
    PH(17, pg8::Gemm g{(const bf16_t*)(ws + L1_KCR), (const bf16_t*)(ws + WS_KW1), 8192, 512, 2048, 1024, 2048}; pg8::GroupedOrder S; S.init(32, 16, F.G, F.bid); pg8::EpiCmp1 E{(bf16_t*)(ws + L1_H1), (const float*)(ws + WS_CMPB)}; pg8::gemm_phase(F.lds, g, S, E);)
    GRID_BAR(17);
    PH(18, pg8::Gemm g{(const bf16_t*)(ws + L1_H1), (const bf16_t*)(ws + WS_KW2), 8192, 512, 256, 256, 256}; pg8::GroupedOrder S; S.init(32, 16, F.G, F.bid); pg8::EpiCmp2 E{(float*)(ws + L1_CMPO)}; pg8::gemm_phase(F.lds, g, S, E);)
    GRID_BAR(18);
    PH(19, p_cmp_final(F, args, ws);)
    GRID_BAR(19);
    PH(20, p_cmp_attn(F, args, ws);)
    GRID_BAR(20);
    PH(21, if (rep) { p_cmp_attn(F, args, ws); xcd_barrier(xbar); } p_nsa_attn(F, args, ws);)
    GRID_BAR(21);
    PH(22, p_gla_a(F, args, ws); cvt_table_i8(F, args.in[I_L1_U], ws + WS_TAB8U, (float*)(ws + WS_TABSU)); cvt_table_fp8(F, args.in[I_L1_V], ws + WS_TAB8V, (float*)(ws + WS_TABSV));)
    GRID_BAR(22);
    PH(23, if (rep) { p_gla_a(F, args, ws); xcd_barrier(xbar); } p_gla_b(F, ws);)
    GRID_BAR(23);
    PH(24, p_gla_c(F, args, ws);)
    GRID_BAR(24);
    PH(25, pg8::Gemm g{(const bf16_t*)(ws + L1_CAT), (const bf16_t*)(ws + WS_W_OUT1), T, 1024, 1024, 1024, 1024}; pg8::StaticOrder S; S.init(T, 1024, F.G, F.bid); pg8::EpiResidF32 E{out, out, 1024}; pg8::gemm_phase(F.lds, g, S, E);)
    GRID_BAR(25);
    PH(26, p_rmsnorm(F, out, args.in[I_L1_FFNN], (bf16_t*)(ws + WS_XN));)
    GRID_BAR(26);
    PH(27, pg8::Gemm g{(const bf16_t*)(ws + WS_XN), (const bf16_t*)(ws + WS_WQ1), T, 2048, 1024, 1024, 1024}; pg8::StaticOrder S; S.init(T, 2048, F.G, F.bid); pg8::EpiStoreBf16 E{(bf16_t*)(ws + PE_Q2), 2048}; pg8::gemm_phase(F.lds, g, S, E);)
    GRID_BAR(27);
    PH(28, p_peer_route(F, ws, (const bf16_t*)(ws + WS_SK1));)
    GRID_BAR(28);
    PH(29, p_peer_expert5(F, ws, out, rep ? 0.f : 1.f, xbar, rep ? TMODE : 0);)
#undef IN
#undef BOTH
}

extern "C" void kernel_launch(void* const* d_in, const int* in_sizes, int n_in, void* d_out, int out_size, void* d_ws, size_t ws_size, hipStream_t stream) {
    static int grid = 0;
    if (grid == 0) {
        if (n_in != 39 || ws_size < WS_END) { fprintf(stderr, "kernel_launch: unexpected n_in %d or ws_size %zu (< %zu)\n", n_in, ws_size, (size_t)WS_END); grid = -1; return; }
        int dev = 0, cus = 0, per_cu = 0;
        (void)hipGetDevice(&dev); (void)hipDeviceGetAttribute(&cus, hipDeviceAttributeMultiprocessorCount, dev);
        if (hipFuncSetAttribute((const void*)mk_fwd, hipFuncAttributeMaxDynamicSharedMemorySize, LDS_BYTES) != hipSuccess) { fprintf(stderr, "kernel_launch: hipFuncSetAttribute failed\n"); grid = -1; return; }
        if (hipOccupancyMaxActiveBlocksPerMultiprocessor(&per_cu, (const void*)mk_fwd, NTHREADS, LDS_BYTES) != hipSuccess || per_cu < 1) { fprintf(stderr, "kernel_launch: occupancy query failed (%d)\n", per_cu); (void)hipGetLastError(); grid = -1; return; }
        grid = cus;
    }
    if (grid < 0) return;
    (void)hipMemsetAsync((char*)d_ws + WS_CTL, 0, 1 * MiB, stream);
    Args a{};
    for (int i = 0; i < 39; ++i) a.in[i] = (const float*)d_in[i];
    a.out = (float*)d_out; a.ws = (unsigned char*)d_ws; a.ph_lo = 0; a.ph_hi = 1000;
    void* kargs[] = {&a};
    hipError_t e = hipLaunchCooperativeKernel((const void*)mk_fwd, dim3(grid), dim3(NTHREADS), kargs, LDS_BYTES, stream);
    if (e != hipSuccess) fprintf(stderr, "kernel_launch: cooperative launch failed: %s\n", hipGetErrorString(e));
}
```

```cpp
#include <hip/hip_runtime.h>
#include <hip/hip_cooperative_groups.h>
#include <cstdio>
#include <cstdint>
namespace cg = cooperative_groups;

#define LAS __attribute__((address_space(3)))
typedef unsigned short bf16_t;
typedef short bf16x8 __attribute__((ext_vector_type(8)));
typedef float f32x4 __attribute__((ext_vector_type(4)));
typedef float f32x2 __attribute__((ext_vector_type(2)));
typedef float f32x16 __attribute__((ext_vector_type(16)));
typedef unsigned u32x4 __attribute__((ext_vector_type(4)));
typedef unsigned u32x2 __attribute__((ext_vector_type(2)));
typedef unsigned long long u64;

constexpr int NB = 8, SEQ = 4096, DM = 1024, T = NB * SEQ;
constexpr int NTHREADS = 512, NWAVES = 8;
constexpr int LDS_BYTES = 147456;
constexpr int N_IN0 = 2048, N_IN1 = 3072;
constexpr int C0_Q = 0, C0_K = 512, C0_V = 640, C0_IQ = 768, C0_U = 1280, C0_IK = 1792, C0_IW = 1856;
constexpr int C1_Q = 0, C1_KC = 512, C1_VC = 640, C1_KS = 768, C1_VS = 896, C1_KW = 1024, C1_VW = 1152, C1_GQ = 1280, C1_GK = 1536, C1_GV = 1792, C1_GR = 2304, C1_GL = 2816, C1_GLOW = 2840;

constexpr size_t MiB = 1u << 20;
constexpr size_t WS_CTL = 0;
constexpr size_t WS_ROPE = 1 * MiB;
constexpr size_t WS_W_IN0 = 2 * MiB;
constexpr size_t WS_W_GLU = 6 * MiB;
constexpr size_t WS_SK0 = 6 * MiB + 512 * 1024;
constexpr size_t WS_W_OUT0 = 7 * MiB;
constexpr size_t WS_WQ0 = 9 * MiB;
constexpr size_t WS_W_IN1 = 13 * MiB;
constexpr size_t WS_KW1 = 19 * MiB;
constexpr size_t WS_VW1 = 20 * MiB;
constexpr size_t WS_KW2 = 21 * MiB;
constexpr size_t WS_VW2 = 21 * MiB + 128 * 1024;
constexpr size_t WS_SK1 = 21 * MiB + 512 * 1024;
constexpr size_t WS_W_OUT1 = 22 * MiB;
constexpr size_t WS_WQ1 = 24 * MiB;
constexpr size_t WS_S5B1 = 28 * MiB;
constexpr size_t WS_S5B2 = 32 * MiB;
constexpr size_t WS_CMPB = 38 * MiB;
constexpr size_t WS_TABU = 48 * MiB;
constexpr size_t WS_TABV = 80 * MiB;
constexpr size_t WS_XN = 112 * MiB;
constexpr size_t WS_PROJ = 176 * MiB;
constexpr size_t WS_R3 = 368 * MiB;
constexpr size_t WS_END = 506 * MiB;

__device__ __forceinline__ unsigned f2bf(float f) { unsigned u = __builtin_bit_cast(unsigned, f); return (u + 0x7fffu + ((u >> 16) & 1u)) >> 16; }
__device__ __forceinline__ unsigned pk2(float lo, float hi) { return f2bf(lo) | (f2bf(hi) << 16); }
__device__ __forceinline__ float bf_lo(unsigned u) { return __builtin_bit_cast(float, u << 16); }
__device__ __forceinline__ float bf_hi(unsigned u) { return __builtin_bit_cast(float, u & 0xffff0000u); }
__device__ __forceinline__ float bf2f(bf16_t b) { return __builtin_bit_cast(float, ((unsigned)b) << 16); }
__device__ __forceinline__ float wave_sum(float v) {
#pragma unroll
    for (int o = 1; o < 64; o <<= 1) v += __shfl_xor(v, o);
    return v;
}
__device__ __forceinline__ float gelu_tanh(float x) {
    const float y = 0.7978845608028654f * (x + 0.044715f * x * x * x);
    const float e = __expf(2.0f * y);
    const float th = 1.0f - 2.0f / (e + 1.0f);
    return 0.5f * x * (1.0f + th);
}
__device__ __forceinline__ float sigmoidf_(float x) { return 1.0f / (1.0f + __expf(-x)); }
#define LDS_WAIT() asm volatile("s_waitcnt lgkmcnt(0)" ::: "memory")
#define VM_WAIT() asm volatile("s_waitcnt vmcnt(0)" ::: "memory")

#define XB_TMO      128
#define XB_XCNT(j)  (256  + 64 * (j))
#define XB_XSUB(j)  (1280 + 64 * (j))
#define XB_XGEN(j)  (2304 + 64 * (j))
#define XB_TOP      3328
#define XB_TOPGEN   3392
#define XCD_BAR_WORDS 3456
#define XB_SPIN_CAP (1u << 22)
__device__ __forceinline__ unsigned xb_ld(unsigned* p)              { return __hip_atomic_load(p, __ATOMIC_RELAXED, __HIP_MEMORY_SCOPE_AGENT); }
__device__ __forceinline__ unsigned xb_add(unsigned* p, unsigned v) { return __hip_atomic_fetch_add(p, v, __ATOMIC_RELAXED, __HIP_MEMORY_SCOPE_AGENT); }
__device__ __forceinline__ unsigned xb_xcc_id() { return (unsigned)__builtin_amdgcn_s_getreg((3 << 11) | 20) & 0xFu; }
#define XB_SPIN(cond, bar) do { unsigned _sp = 0; while (cond) { __builtin_amdgcn_s_sleep(1); \
    if ((++_sp & 255u) == 0u) { if (xb_ld(&(bar)[XB_TMO])) break; if (_sp > XB_SPIN_CAP) { atomicAdd(&(bar)[XB_TMO], 1u); break; } } } } while (0)
struct XcdBarrier { unsigned* bar; unsigned x; volatile LAS unsigned* st; };
__device__ __forceinline__ XcdBarrier xcd_barrier_post(unsigned* bar, volatile LAS unsigned* st) {
    XcdBarrier b; b.bar = bar; b.x = xb_xcc_id(); b.st = st;
    if (threadIdx.x == 0) (void)xb_add(&bar[XB_XCNT(b.x)], 1u);
    return b;
}
__device__ __forceinline__ void xcd_barrier_complete(unsigned* bar, unsigned x, unsigned& nloc, unsigned& nx) {
    const unsigned G = gridDim.x * gridDim.y * gridDim.z;
    unsigned sum, cnt, mine, sp = 0u;
    for (;;) {
        sum = 0u; cnt = 0u; mine = 0u;
#pragma unroll
        for (unsigned j = 0; j < 16; ++j) { const unsigned c = xb_ld(&bar[XB_XCNT(j)]); sum += c; cnt += (c > 0u) ? 1u : 0u; mine = (j == x) ? c : mine; }
        if (sum == G) break;
        __builtin_amdgcn_s_sleep(1);
        if ((++sp & 255u) == 0u) { if (xb_ld(&bar[XB_TMO])) break; if (sp > XB_SPIN_CAP) { atomicAdd(&bar[XB_TMO], 1u); break; } }
    }
    nloc = mine > 0u ? mine : 1u; nx = cnt > 0u ? cnt : 1u;
}
__device__ __forceinline__ void xcd_barrier(const XcdBarrier& b) {
    asm volatile("s_waitcnt vmcnt(0)" ::: "memory");
    __syncthreads();
    if (threadIdx.x == 0) {
        unsigned* bar = b.bar;
        __builtin_amdgcn_s_waitcnt(0);
        unsigned nloc = b.st[0], nx = b.st[1];
        if (nloc == 0u) { xcd_barrier_complete(bar, b.x, nloc, nx); b.st[0] = nloc; b.st[1] = nx; }
        const unsigned old = xb_add(&bar[XB_XSUB(b.x)], 1u);
        const unsigned gen = old / nloc;
        if (old + 1u == (gen + 1u) * nloc) {
            __builtin_amdgcn_fence(__ATOMIC_RELEASE, "agent");
            asm volatile("s_waitcnt vmcnt(0)" ::: "memory");
            const unsigned og = xb_add(&bar[XB_TOP], 1u);
            const unsigned tg = og / nx;
            if (og + 1u == (tg + 1u) * nx) xb_add(&bar[XB_TOPGEN], 1u);
            else XB_SPIN(xb_ld(&bar[XB_TOPGEN]) == tg, bar);
            __builtin_amdgcn_fence(__ATOMIC_ACQUIRE, "agent");
            xb_add(&bar[XB_XGEN(b.x)], 1u);
            asm volatile("s_waitcnt vmcnt(0)" ::: "memory");
        } else {
            XB_SPIN(xb_ld(&bar[XB_XGEN(b.x)]) == gen, bar);
            __builtin_amdgcn_fence(__ATOMIC_ACQUIRE, "agent");
            asm volatile("s_waitcnt vmcnt(0)" ::: "memory");
        }
    }
    __syncthreads();
}

namespace pg8 {
constexpr int BM = 256, BK = 64, HALF = 128, HTB = HALF * BK * 2, STAGE_BYTES = 8 * HTB, NXCD = 8, WGM = 8;
__device__ __forceinline__ int lds_byte(int r, int c) { const int st = (r >> 4) * 2 + (c >> 5), rr = r & 15, cc = c & 31, ob = rr * 64 + cc * 2; return st * 1024 + (ob ^ (((ob >> 9) & 1) << 5)); }
__device__ __forceinline__ void stage_rc(int b, int& R, int& C) { const int st = b / 1024, sb = b % 1024, swz = sb ^ (((sb >> 9) & 1) << 5); R = (st >> 1) * 16 + swz / 64; C = (st & 1) * 32 + (swz % 64) / 2; }
__device__ __forceinline__ int perm32(int rho) { const int n = rho >> 4, i = rho & 15; return 8 * (i >> 2) + 4 * n + (i & 3); }
struct Unit { int pm, pn; };
struct Gemm { const bf16_t* A; const bf16_t* Bt; int M, N, K, lda, ldb; };
struct StaticOrder {
    int nM, nN, nwg, G, c;
    __device__ void init(int M, int N, int G_, int c_) { nM = M / BM; nN = N / BM; nwg = nM * nN; G = G_; c = c_; }
    __device__ bool next(int i, Unit& u) const {
        const long L = (long)i * G + c; if (L >= nwg) return false;
        int wgid = (int)L; { const int q = nwg / NXCD, r = nwg % NXCD, xcd = wgid % NXCD, off = wgid / NXCD; wgid = (xcd < r ? xcd * (q + 1) : r * (q + 1) + (xcd - r) * q) + off; }
        const int nig = WGM * nN, gid = wgid / nig, fm = gid * WGM, gsz = (nM - fm) < WGM ? (nM - fm) : WGM;
        u.pm = fm + ((wgid % nig) % gsz); u.pn = (wgid % nig) / gsz; return true;
    }
};
struct GroupedOrder {
    int nwg, G, c, tpg;
    __device__ void init(int ntiles, int tiles_per_group, int G_, int c_) { nwg = ntiles; tpg = tiles_per_group; G = G_; c = c_; }
    __device__ bool next(int i, Unit& u) const { const long L = (long)i * G + c; if (L >= nwg) return false; u.pm = (int)L; u.pn = (int)L / tpg; return true; }
};
__device__ __forceinline__ unsigned cvt_pk_bf16(float lo, float hi) { unsigned r; asm volatile("v_cvt_pk_bf16_f32 %0, %1, %2" : "=v"(r) : "v"(lo), "v"(hi)); return r; }

template <class Epi, class Sched>
__device__ __forceinline__ void gemm_phase(LAS unsigned char* lds, const Gemm g, const Sched& S, const Epi& E) {
    const int tid = threadIdx.x, wid = __builtin_amdgcn_readfirstlane(tid >> 6), lane = tid & 63, wr = wid >> 2, wc = wid & 3, fr = lane & 15, fq = lane >> 4;
    int K = g.K; asm volatile("" : "+s"(K));
    const int nt = K / BK;
    unsigned voffA[2], voffB[2];
#pragma unroll
    for (int i = 0; i < 2; ++i) { int R, C; stage_rc(tid * 16 + i * 8192, R, C); const int Rb = Epi::PERM ? ((R & ~31) + perm32(R & 31)) : R;
        voffA[i] = (unsigned)(R * g.lda + C) * 2u; voffB[i] = (unsigned)(Rb * g.ldb + C) * 2u; }
    const size_t kstep = (size_t)(BK * 2);
    const size_t hstepA = (size_t)HALF * g.lda * 2, hstepB = (size_t)HALF * g.ldb * 2;
    const size_t tstepA = 2 * hstepA, tstepB = 2 * hstepB;
    const unsigned ldsw = (unsigned)wid * 1024u;
    const int aoff = lds_byte(wr * 64 + fr, fq * 8), boff = lds_byte(wc * 32 + fr, fq * 8);
#define PG8_SA(b, h) (((b) * 2 + (h)) * HTB)
#define PG8_SB(b, h) ((4 + (b) * 2 + (h)) * HTB)
#define PG8_STAGE(bufoff, gbase, voff) do { _Pragma("unroll") for (int _i = 0; _i < 2; ++_i) \
        __builtin_amdgcn_global_load_lds((const unsigned*)((const char*)(gbase) + (voff)[_i]), (LAS unsigned*)(lds + (bufoff) + ldsw + _i * 8192), 16, 0, 0); } while (0)
#define PG8_LDA(dst, b, h) do { _Pragma("unroll") for (int m = 0; m < 4; ++m) _Pragma("unroll") for (int k = 0; k < 2; ++k) dst[m][k] = *(const LAS bf16x8*)(lds + PG8_SA(b, h) + aoff + m * 2048 + k * 1024); } while (0)
#define PG8_LDB(dst, b, h) do { _Pragma("unroll") for (int n = 0; n < 2; ++n) _Pragma("unroll") for (int k = 0; k < 2; ++k) dst[n][k] = *(const LAS bf16x8*)(lds + PG8_SB(b, h) + boff + n * 2048 + k * 1024); } while (0)
#define PG8_MMA(ai, bj, At, Bt) do { __builtin_amdgcn_s_setprio(1); _Pragma("unroll") for (int m = 0; m < 4; ++m) _Pragma("unroll") for (int n = 0; n < 2; ++n) _Pragma("unroll") for (int k = 0; k < 2; ++k) \
        acc[ai][bj][m][n] = __builtin_amdgcn_mfma_f32_16x16x32_bf16(Bt[n][k], At[m][k], acc[ai][bj][m][n], 0, 0, 0); __builtin_amdgcn_s_setprio(0); } while (0)
#define PG8_WAIT_V(n) asm volatile("s_waitcnt vmcnt(" #n ")" ::: "memory")
#define PG8_WAIT_L(n) asm volatile("s_waitcnt lgkmcnt(" #n ")" ::: "memory")
#define PG8_BAR __builtin_amdgcn_s_barrier()
#define PG8_SCHED __builtin_amdgcn_sched_barrier(0)
    Unit cur, nxt; int ui = 0;
    if (!S.next(0, cur)) return;
    f32x4 acc[2][2][4][2];
#pragma unroll
    for (int a = 0; a < 2; ++a)
#pragma unroll
        for (int b = 0; b < 2; ++b)
#pragma unroll
            for (int m = 0; m < 4; ++m)
#pragma unroll
                for (int n = 0; n < 2; ++n) acc[a][b][m][n] = (f32x4){0.f, 0.f, 0.f, 0.f};
    bf16x8 At[4][2], B0[2][2], B1[2][2];
    const char* cA = (const char*)g.A + (size_t)cur.pm * tstepA; const char* cB = (const char*)g.Bt + (size_t)cur.pn * tstepB;
    PG8_STAGE(PG8_SB(0, 0), cB, voffB); PG8_STAGE(PG8_SA(0, 0), cA, voffA); PG8_STAGE(PG8_SB(0, 1), cB + hstepB, voffB); PG8_STAGE(PG8_SA(0, 1), cA + hstepA, voffA);
    if (wr == 1) PG8_BAR;
    PG8_WAIT_V(4); PG8_BAR;
    PG8_STAGE(PG8_SB(1, 0), cB + kstep, voffB); PG8_STAGE(PG8_SA(1, 0), cA + kstep, voffA); PG8_STAGE(PG8_SB(1, 1), cB + hstepB + kstep, voffB);
    PG8_WAIT_V(6); PG8_BAR;
    for (;;) {
        const bool has_next = S.next(ui + 1, nxt);
        const char* nA = has_next ? (const char*)g.A + (size_t)nxt.pm * tstepA : cA; const char* nB = has_next ? (const char*)g.Bt + (size_t)nxt.pn * tstepB : cB;
        for (int t = 0; t < nt; t += 2) {
            const bool last = (t == nt - 2);
            const char* a1 = cA + (size_t)(t + 1) * kstep;
            const char* a2 = last ? nA : cA + (size_t)(t + 2) * kstep; const char* b2 = last ? nB : cB + (size_t)(t + 2) * kstep;
            const char* a3 = a2 + kstep; const char* b3 = b2 + kstep;
            PG8_LDB(B0, 0, 0); PG8_SCHED; PG8_LDA(At, 0, 0); PG8_STAGE(PG8_SA(1, 1), a1 + hstepA, voffA);
            PG8_WAIT_L(8); PG8_BAR; PG8_WAIT_L(0); PG8_MMA(0, 0, At, B0); PG8_BAR; PG8_SCHED;
            PG8_LDB(B1, 0, 1); PG8_STAGE(PG8_SB(0, 0), b2, voffB);
            PG8_BAR; PG8_WAIT_L(0); PG8_MMA(0, 1, At, B1); PG8_BAR;
            PG8_LDA(At, 0, 1); PG8_STAGE(PG8_SA(0, 0), a2, voffA);
            PG8_BAR; PG8_WAIT_L(0); PG8_MMA(1, 0, At, B0); PG8_BAR; PG8_SCHED;
            PG8_STAGE(PG8_SB(0, 1), b2 + hstepB, voffB);
            PG8_WAIT_V(6); PG8_BAR; PG8_MMA(1, 1, At, B1); PG8_BAR;
            PG8_LDB(B0, 1, 0); PG8_SCHED; PG8_LDA(At, 1, 0); PG8_STAGE(PG8_SA(0, 1), a2 + hstepA, voffA);
            PG8_WAIT_L(8); PG8_BAR; PG8_WAIT_L(0); PG8_MMA(0, 0, At, B0); PG8_BAR; PG8_SCHED;
            PG8_LDB(B1, 1, 1); PG8_STAGE(PG8_SB(1, 0), b3, voffB);
            PG8_BAR; PG8_WAIT_L(0); PG8_MMA(0, 1, At, B1); PG8_BAR;
            PG8_LDA(At, 1, 1); PG8_STAGE(PG8_SA(1, 0), a3, voffA);
            PG8_BAR; PG8_WAIT_L(0); PG8_MMA(1, 0, At, B0); PG8_BAR; PG8_SCHED;
            PG8_STAGE(PG8_SB(1, 1), b3 + hstepB, voffB);
            PG8_WAIT_V(6); PG8_BAR; PG8_MMA(1, 1, At, B1); PG8_BAR;
        }
        E(acc, cur, wr, wc, fr, fq);
        if (!has_next) break;
#pragma unroll
        for (int a = 0; a < 2; ++a)
#pragma unroll
            for (int b = 0; b < 2; ++b)
#pragma unroll
                for (int m = 0; m < 4; ++m)
#pragma unroll
                    for (int n = 0; n < 2; ++n) acc[a][b][m][n] = (f32x4){0.f, 0.f, 0.f, 0.f};
        cur = nxt; cA = nA; cB = nB; ++ui;
    }
    PG8_WAIT_V(0);
    if (wr == 0) PG8_BAR;
    PG8_BAR;
#undef PG8_SA
#undef PG8_SB
#undef PG8_STAGE
#undef PG8_LDA
#undef PG8_LDB
#undef PG8_MMA
#undef PG8_WAIT_V
#undef PG8_WAIT_L
#undef PG8_BAR
#undef PG8_SCHED
}

struct EpiStoreBf16 {
    static constexpr bool PERM = true;
    bf16_t* O; int ldc;
    __device__ __forceinline__ void operator()(const f32x4 (&acc)[2][2][4][2], const Unit& u, int wr, int wc, int fr, int fq) const {
        const int row0 = u.pm * BM + wr * 64 + fr, col0 = u.pn * BM + wc * 32 + 8 * fq;
#pragma unroll
        for (int ai = 0; ai < 2; ++ai)
#pragma unroll
            for (int m = 0; m < 4; ++m) { bf16_t* rowp = O + (size_t)(row0 + ai * HALF + m * 16) * ldc + col0;
#pragma unroll
                for (int bj = 0; bj < 2; ++bj) { const f32x4 v0 = acc[ai][bj][m][0], v1 = acc[ai][bj][m][1];
                    u32x4 w; w.x = cvt_pk_bf16(v0[0], v0[1]); w.y = cvt_pk_bf16(v0[2], v0[3]); w.z = cvt_pk_bf16(v1[0], v1[1]); w.w = cvt_pk_bf16(v1[2], v1[3]);
                    *(u32x4*)(rowp + bj * HALF) = w; } }
    }
};
struct EpiResidF32 {
    static constexpr bool PERM = false;
    const float* R; float* C; int ldc;
    __device__ __forceinline__ void operator()(const f32x4 (&acc)[2][2][4][2], const Unit& u, int wr, int wc, int fr, int fq) const {
        const int row0 = u.pm * BM + wr * 64 + fr, col0 = u.pn * BM + wc * 32 + 4 * fq;
#pragma unroll
        for (int ai = 0; ai < 2; ++ai)
#pragma unroll
            for (int m = 0; m < 4; ++m) { const size_t off = (size_t)(row0 + ai * HALF + m * 16) * ldc + col0;
#pragma unroll
                for (int bj = 0; bj < 2; ++bj)
#pragma unroll
                    for (int n = 0; n < 2; ++n) { const f32x4 r = *(const f32x4*)(R + off + bj * HALF + n * 16); *(f32x4*)(C + off + bj * HALF + n * 16) = r + acc[ai][bj][m][n]; } }
    }
};
}

struct Args {
    const float* in[39];
    float* out;
    unsigned char* ws;
    int ph_lo, ph_hi;
};
enum { I_X = 0, I_L0_MIXN, I_L0_WIN, I_L0_QG, I_L0_KG, I_L0_LOGDT, I_L0_ARE, I_L0_AIM, I_L0_BRE, I_L0_BIM, I_L0_CRE, I_L0_CIM, I_L0_D, I_L0_WGLU, I_L0_BGLU, I_L0_WOUT,
       I_L0_FFNN, I_L0_WQ, I_L0_SK, I_L0_U, I_L0_V,
       I_L1_MIXN, I_L1_WIN, I_L1_QG, I_L1_KG, I_L1_CMPPOS, I_L1_KW1, I_L1_KW2, I_L1_VW1, I_L1_VW2, I_L1_WGATE, I_L1_BGATE, I_L1_OGAIN, I_L1_WOUT,
       I_L1_FFNN, I_L1_WQ, I_L1_SK, I_L1_U, I_L1_V };

struct Frame {
    LAS unsigned char* lds;
    int tid, lane, wave, G, bid;
};

constexpr size_t L0_QA = WS_R3;
constexpr size_t L0_IQ = WS_R3 + 32 * MiB;
constexpr size_t L0_KA = WS_R3 + 64 * MiB;
constexpr size_t L0_VAT = WS_R3 + 72 * MiB;
constexpr size_t L0_IK = WS_R3 + 80 * MiB;
constexpr size_t L0_IW = WS_R3 + 84 * MiB;
constexpr size_t L0_UA = WS_R3 + 88 * MiB;
constexpr size_t L0_SELT = WS_PROJ;
constexpr size_t L0_CAT = WS_PROJ + 16 * MiB;
constexpr size_t L0_SLOC = WS_PROJ + 80 * MiB;
constexpr size_t L0_YB = WS_PROJ + 112 * MiB;
constexpr size_t PE_Q2 = WS_PROJ;
constexpr size_t PE_EID = WS_PROJ + 128 * MiB;
constexpr size_t PE_GATE = WS_PROJ + 136 * MiB;

template <class Map>
__device__ __forceinline__ void transpose_item(const float* W, int K, int N, bf16_t* WT, int ldk, LAS float* scr, int item, int lane, const Map& map) {
    const int nblk = (N + 31) / 32, kb = item / nblk, nb = item % nblk, k0 = 64 * kb, n0 = 32 * nb;
    const int ncol = n0 + (lane & 31);
#pragma unroll 8
    for (int i = 0; i < 32; ++i) { const int kk = 2 * i + (lane >> 5); scr[kk * 33 + (lane & 31)] = (ncol < N) ? W[(size_t)(k0 + kk) * N + ncol] : 0.f; }
    LDS_WAIT(); asm volatile("" ::: "memory");
    const int c = lane & 7;
#pragma unroll
    for (int j = 0; j < 4; ++j) { const int n = (lane >> 3) + 8 * j; const LAS float* s = scr + (8 * c) * 33 + n;
        u32x4 o; o.x = pk2(s[0 * 33], s[1 * 33]); o.y = pk2(s[2 * 33], s[3 * 33]); o.z = pk2(s[4 * 33], s[5 * 33]); o.w = pk2(s[6 * 33], s[7 * 33]);
        if (n0 + n < N) *(u32x4*)(WT + (size_t)map(n0 + n) * ldk + k0 + 8 * c) = o; }
    LDS_WAIT(); asm volatile("" ::: "memory");
}
struct MapId { __device__ __forceinline__ int operator()(int n) const { return n; } };
struct MapIn0 { __device__ __forceinline__ int operator()(int n) const { return n < 1280 ? n : (n < 1344 ? n - 1280 + C0_IK : (n < 1352 ? n - 1344 + C0_IW : n - 1352 + C0_U)); } };
struct MapIn1 { __device__ __forceinline__ int operator()(int n) const {
    if (n < 1280) return n; if (n < 1304) return n - 1280 + C1_GL; if (n < 1560) return n - 1304 + C1_GQ; if (n < 1816) return n - 1560 + C1_GK;
    if (n < 2328) return n - 1816 + C1_GV; if (n < 2344) return n - 2328 + C1_GLOW; return n - 2344 + C1_GR; } };

template <class Map>
__device__ __forceinline__ void transpose_all(const Frame& F, int& base, const float* W, int K, int N, bf16_t* WT, int ldk, const Map& map) {
    LAS float* scr = (LAS float*)(F.lds + F.wave * 16384);
    const int gw = F.bid * NWAVES + F.wave, NGW = F.G * NWAVES;
    const int nit = (K / 64) * ((N + 31) / 32);
    for (int it = (gw + NGW - (base % NGW)) % NGW; it < nit; it += NGW) transpose_item(W, K, N, WT, ldk, scr, it, F.lane, map);
    base += nit;
}
__device__ __forceinline__ void zero_bytes(const Frame& F, unsigned char* p, size_t nbytes) {
    const size_t n16 = nbytes / 16;
    for (size_t i = (size_t)F.bid * NTHREADS + F.tid; i < n16; i += (size_t)F.G * NTHREADS) ((u32x4*)p)[i] = (u32x4){0u, 0u, 0u, 0u};
}
__device__ __forceinline__ void cvt_f32_bf16(const Frame& F, const float* src, bf16_t* dst, size_t n) {
    const size_t n8 = n / 8;
    for (size_t i = (size_t)F.bid * NTHREADS + F.tid; i < n8; i += (size_t)F.G * NTHREADS) {
        const f32x4 a = ((const f32x4*)src)[2 * i], b = ((const f32x4*)src)[2 * i + 1];
        u32x4 o; o.x = pk2(a.x, a.y); o.y = pk2(a.z, a.w); o.z = pk2(b.x, b.y); o.w = pk2(b.z, b.w);
        ((u32x4*)dst)[i] = o;
    }
}

__device__ __forceinline__ void rms_row_to_bf16(const float* xrow, const float* gain, bf16_t* orow, int lane) {
    const f32x4* xr = (const f32x4*)xrow + lane; const f32x4* gr = (const f32x4*)gain + lane;
    f32x4 v[4]; float s = 0.f;
#pragma unroll
    for (int j = 0; j < 4; ++j) { v[j] = xr[64 * j]; s += (v[j].x * v[j].x + v[j].y * v[j].y) + (v[j].z * v[j].z + v[j].w * v[j].w); }
    const float rstd = 1.0f / sqrtf(wave_sum(s) * (1.f / DM) + 1e-6f);
    u64* o8 = (u64*)orow + lane;
#pragma unroll
    for (int j = 0; j < 4; ++j) { const f32x4 g4 = gr[64 * j]; o8[64 * j] = (u64)pk2(v[j].x * rstd * g4.x, v[j].y * rstd * g4.y) | ((u64)pk2(v[j].z * rstd * g4.z, v[j].w * rstd * g4.w) << 32); }
}
__device__ __forceinline__ void p_rmsnorm(const Frame& F, const float* x, const float* gain, bf16_t* XN) {
    const int gw = F.bid * NWAVES + F.wave, NGW = F.G * NWAVES;
    for (int m = gw; m < T; m += NGW) rms_row_to_bf16(x + (size_t)m * DM, gain, XN + (size_t)m * DM, F.lane);
}

__device__ __forceinline__ void p_rope_table(const Frame& F, f32x2* rope) {
    for (int i = F.bid * NTHREADS + F.tid; i < SEQ * 32; i += F.G * NTHREADS) {
        const int pos = i >> 5, k = i & 31;
        const float inv = powf(10000.0f, -(float)k / 32.0f);
        const float ang = (float)pos * inv;
        float s, c; sincosf(ang, &s, &c);
        rope[i] = (f32x2){c, s};
    }
}

__device__ __forceinline__ void s5_build_group(const Frame& F, const Args& a, unsigned char* ws, int g) {
    LAS f32x2* abp = (LAS f32x2*)F.lds;
    LAS f32x2* bb = abp + 17 * 64;
    LAS f32x2* Cc = bb + 64 * 16;
    LAS float* KT = (LAS float*)(Cc + 16 * 64);
    const float dt = expf(a.in[I_L0_LOGDT][g]);
    for (int idx = F.tid; idx < 17 * 64; idx += NTHREADS) {
        const int tau = idx >> 6, p = idx & 63;
        const float lr = a.in[I_L0_ARE][g * 64 + p], li = a.in[I_L0_AIM][g * 64 + p];
        const float mag = expf((float)tau * dt * lr); float s, c; sincosf((float)tau * dt * li, &s, &c);
        abp[idx] = (f32x2){mag * c, mag * s};
    }
    for (int idx = F.tid; idx < 64 * 16; idx += NTHREADS) {
        const int p = idx >> 4, c = idx & 15;
        const float lr = a.in[I_L0_ARE][g * 64 + p], li = a.in[I_L0_AIM][g * 64 + p];
        const float mag = expf(dt * lr); float s, co; sincosf(dt * li, &s, &co);
        const float abr = mag * co, abi = mag * s, den = lr * lr + li * li;
        const float fr = ((abr - 1.0f) * lr + abi * li) / den, fi = (abi * lr - (abr - 1.0f) * li) / den;
        const float br = a.in[I_L0_BRE][(size_t)(g * 64 + p) * 16 + c], bi = a.in[I_L0_BIM][(size_t)(g * 64 + p) * 16 + c];
        bb[idx] = (f32x2){fr * br - fi * bi, fr * bi + fi * br};
    }
    for (int idx = F.tid; idx < 16 * 64; idx += NTHREADS) Cc[idx] = (f32x2){a.in[I_L0_CRE][(size_t)g * 1024 + idx], a.in[I_L0_CIM][(size_t)g * 1024 + idx]};
    __syncthreads();
    for (int idx = F.tid; idx < 16 * 256; idx += NTHREADS) {
        const int tau = idx >> 8, co = (idx >> 4) & 15, ci = idx & 15;
        float acc = 0.f;
        for (int p = 0; p < 64; ++p) {
            const f32x2 c = Cc[co * 64 + p], e = abp[tau * 64 + p], b = bb[p * 16 + ci];
            const float er = c.x * e.x - c.y * e.y, ei = c.x * e.y + c.y * e.x;
            acc += er * b.x - ei * b.y;
        }
        if (tau == 0 && co == ci) acc += a.in[I_L0_D][g * 16 + co];
        KT[idx] = acc;
    }
    __syncthreads();
    bf16_t* B1 = (bf16_t*)(ws + WS_S5B1) + (size_t)g * 256 * 256;
    bf16_t* B2 = (bf16_t*)(ws + WS_S5B2) + (size_t)g * 256 * 384;
    for (int idx = F.tid; idx < 256 * 128; idx += NTHREADS) {
        const int n = idx >> 7, k = (idx & 127) * 2;
        float v0 = 0.f, v1 = 0.f;
        if (n < 128) { const int p = n & 63, j = k >> 4, ci = k & 15; const f32x2 e = abp[(15 - j) * 64 + p], b0 = bb[p * 16 + ci], b1 = bb[p * 16 + ci + 1];
            if (n < 64) { v0 = e.x * b0.x - e.y * b0.y; v1 = e.x * b1.x - e.y * b1.y; } else { v0 = e.x * b0.y + e.y * b0.x; v1 = e.x * b1.y + e.y * b1.x; } }
        *(unsigned*)(B1 + (size_t)n * 256 + k) = pk2(v0, v1);
    }
    for (int idx = F.tid; idx < 256 * 192; idx += NTHREADS) {
        const int n = idx / 192, k = (idx % 192) * 2, i = n >> 4, co = n & 15;
        float v0 = 0.f, v1 = 0.f;
        if (k < 256) { const int j = k >> 4, ci = k & 15; if (j <= i) { v0 = KT[((i - j) * 16 + co) * 16 + ci]; v1 = KT[((i - j) * 16 + co) * 16 + ci + 1]; } }
        else { const int p = (k - 256) & 63; const bool im = k >= 320;
            const f32x2 c0 = Cc[co * 64 + p], e0 = abp[(i + 1) * 64 + p], c1 = Cc[co * 64 + p + 1], e1 = abp[(i + 1) * 64 + p + 1];
            if (!im) { v0 = c0.x * e0.x - c0.y * e0.y; v1 = c1.x * e1.x - c1.y * e1.y; } else { v0 = -(c0.x * e0.y + c0.y * e0.x); v1 = -(c1.x * e1.y + c1.y * e1.x); } }
        *(unsigned*)(B2 + (size_t)n * 384 + k) = pk2(v0, v1);
    }
    __syncthreads();
}

__device__ __forceinline__ void cmp_bias(const Frame& F, const Args& a, float* out, int j) {
    const int w = j >> 5, n0 = (j & 31) * 8;
    const float* w1 = a.in[w ? I_L1_VW1 : I_L1_KW1]; const float* pos = a.in[I_L1_CMPPOS];
    LAS float* red = (LAS float*)(F.lds + 65536);
    float acc[8];
#pragma unroll
    for (int i = 0; i < 8; ++i) acc[i] = 0.f;
#pragma unroll
    for (int kk = 0; kk < 4; ++kk) { const int k = F.tid * 4 + kk; const float p = pos[k];
        const f32x4 wa = *(const f32x4*)(w1 + (size_t)k * 256 + n0), wb = *(const f32x4*)(w1 + (size_t)k * 256 + n0 + 4);
        acc[0] += p * wa.x; acc[1] += p * wa.y; acc[2] += p * wa.z; acc[3] += p * wa.w; acc[4] += p * wb.x; acc[5] += p * wb.y; acc[6] += p * wb.z; acc[7] += p * wb.w; }
#pragma unroll
    for (int i = 0; i < 8; ++i) { const float sv = wave_sum(acc[i]); if (F.lane == 0) red[F.wave * 8 + i] = sv; }
    __syncthreads();
    if (F.tid < 8) { float t = 0.f; for (int wv = 0; wv < 8; ++wv) t += red[wv * 8 + F.tid]; out[w * 256 + n0 + F.tid] = t; }
    __syncthreads();
}

__device__ __forceinline__ float rope_apply(float v, const f32x2 cs, int lane) {
    const float partner = __shfl_xor(v, 32);
    return lane < 32 ? v * cs.x - partner * cs.y : partner * cs.y + v * cs.x;
}
__device__ __forceinline__ void head8_load(const bf16_t* p, float (&v)[8]) {
    const u32x4 q = *(const u32x4*)p;
    v[0] = bf_lo(q.x); v[1] = bf_hi(q.x); v[2] = bf_lo(q.y); v[3] = bf_hi(q.y); v[4] = bf_lo(q.z); v[5] = bf_hi(q.z); v[6] = bf_lo(q.w); v[7] = bf_hi(q.w);
}
__device__ __forceinline__ void head8_store(bf16_t* p, const float (&v)[8], const float sc) {
    u32x4 q; q.x = pk2(v[0] * sc, v[1] * sc); q.y = pk2(v[2] * sc, v[3] * sc); q.z = pk2(v[4] * sc, v[5] * sc); q.w = pk2(v[6] * sc, v[7] * sc);
    *(u32x4*)p = q;
}
__device__ __forceinline__ void head8_norm(float (&v)[8], const float (&g)[8]) {
    float ss = 0.f;
#pragma unroll
    for (int j = 0; j < 8; ++j) ss += v[j] * v[j];
    ss += __shfl_xor(ss, 1); ss += __shfl_xor(ss, 2); ss += __shfl_xor(ss, 4);
    const float r = 1.0f / sqrtf(ss * (1.f / 64.f) + 1e-6f);
#pragma unroll
    for (int j = 0; j < 8; ++j) v[j] = v[j] * r * g[j];
}
__device__ __forceinline__ void head8_rope(float (&v)[8], const f32x2 (&cs)[8], const bool upper) {
#pragma unroll
    for (int j = 0; j < 8; ++j) { const float partner = __shfl_xor(v[j], 4); v[j] = upper ? partner * cs[j].y + v[j] * cs[j].x : v[j] * cs[j].x - partner * cs[j].y; }
}
__device__ __forceinline__ void p_l0_prep(const Frame& F, const Args& a, unsigned char* ws) {
    const bf16_t* P = (const bf16_t*)(ws + WS_PROJ);
    const f32x2* rope = (const f32x2*)(ws + WS_ROPE);
    bf16_t* QA = (bf16_t*)(ws + L0_QA); bf16_t* IQ = (bf16_t*)(ws + L0_IQ); bf16_t* KA = (bf16_t*)(ws + L0_KA); bf16_t* VAT = (bf16_t*)(ws + L0_VAT);
    bf16_t* IK = (bf16_t*)(ws + L0_IK); float* IW = (float*)(ws + L0_IW); bf16_t* UA = (bf16_t*)(ws + L0_UA);
    const int gw = F.bid * NWAVES + F.wave, NGW = F.G * NWAVES, lane = F.lane, hs = lane >> 3, sub = lane & 7;
    float qg[8], kg[8];
#pragma unroll
    for (int j = 0; j < 8; ++j) { qg[j] = a.in[I_L0_QG][sub * 8 + j]; kg[j] = a.in[I_L0_KG][sub * 8 + j]; }
    for (int m = gw; m < T; m += NGW) {
        const int b = m >> 12, t = m & 4095;
        const bf16_t* row = P + (size_t)m * N_IN0;
        f32x2 cs[8];
#pragma unroll
        for (int j = 0; j < 4; ++j) { const f32x4 c4 = *(const f32x4*)(rope + t * 32 + (sub & 3) * 8 + 2 * j); cs[2 * j] = (f32x2){c4.x, c4.y}; cs[2 * j + 1] = (f32x2){c4.z, c4.w}; }
        float v[8];
        head8_load(row + C0_Q + lane * 8, v); head8_norm(v, qg); head8_rope(v, cs, sub >= 4); head8_store(QA + (size_t)m * 512 + lane * 8, v, 0.125f);
        head8_load(row + C0_IQ + lane * 8, v); head8_rope(v, cs, sub >= 4); head8_store(IQ + (size_t)m * 512 + lane * 8, v, 0.125f);
        {
            const int hh = hs < 3 ? hs : 2;
            head8_load(row + (hh < 2 ? C0_K + hh * 64 : C0_IK) + sub * 8, v);
            float vn[8];
#pragma unroll
            for (int j = 0; j < 8; ++j) vn[j] = v[j];
            head8_norm(vn, kg);
#pragma unroll
            for (int j = 0; j < 8; ++j) v[j] = (hh < 2) ? vn[j] : v[j];
            head8_rope(v, cs, sub >= 4);
            if (hs < 2) head8_store(KA + ((size_t)(b * 2 + hs) * 4096 + t) * 64 + sub * 8, v, 1.0f);
            else if (hs == 2) head8_store(IK + (size_t)m * 64 + sub * 8, v, 1.0f);
        }
        if (lane < 8) IW[(size_t)m * 8 + lane] = bf2f(row[C0_IW + lane]) * 0.35355339059327373f;
        { const u32x4 uv = *(const u32x4*)(row + C0_U + lane * 8); const int g = lane >> 1;
          *(u32x4*)(UA + ((size_t)g * 2048 + (m >> 4)) * 384 + (m & 15) * 16 + (lane & 1) * 8) = uv; }
    }
    for (int it = gw; it < NB * 2 * 64; it += NGW) {
        const int tb = it & 63, g = (it >> 6) & 1, b = it >> 7;
        const size_t m = (size_t)b * 4096 + tb * 64 + lane;
        unsigned r[32];
#pragma unroll
        for (int j = 0; j < 8; ++j) { const u32x4 q = *(const u32x4*)(P + m * N_IN0 + C0_V + g * 64 + j * 8); r[4 * j] = q.x; r[4 * j + 1] = q.y; r[4 * j + 2] = q.z; r[4 * j + 3] = q.w; }
        bf16_t* dst = VAT + ((size_t)(b * 2 + g) * 64) * 4096 + tb * 64 + lane;
#pragma unroll
        for (int d = 0; d < 64; ++d) dst[(size_t)d * 4096] = (bf16_t)((d & 1) ? (r[d >> 1] >> 16) : (r[d >> 1] & 0xffffu));
    }
}

__device__ __forceinline__ unsigned f16key(unsigned raw) { return (raw & 0x8000u) ? (~raw & 0xFFFFu) : (raw | 0x8000u); }
__device__ __forceinline__ void p_dsa_index(const Frame& F, unsigned char* ws) {
    const bf16_t* IQ = (const bf16_t*)(ws + L0_IQ); const bf16_t* IK = (const bf16_t*)(ws + L0_IK); const float* IW = (const float*)(ws + L0_IW);
    u64* SELT = (u64*)(ws + L0_SELT);
    LAS _Float16* sc = (LAS _Float16*)F.lds;
    LAS unsigned short* scu = (LAS unsigned short*)F.lds;
    LAS u64* mk = (LAS u64*)(F.lds + 131072);
    LAS float* wl = (LAS float*)(F.lds + 131072 + 8192);
    const int lane = F.lane, wave = F.wave, h = lane >> 5, r = lane & 31;
    const int rq = ((r >> 4) & 1) + 2 * ((r >> 2) & 1), rh = 4 * ((r >> 3) & 1) + (r & 3);
    for (int u = F.bid; u < 2048; u += F.G) {
        const int idx = u & 255, b = u >> 8;
        const int j = (b & 1) ? 255 - idx : idx;
        const int t0 = j * 16; const size_t mb = (size_t)b * 4096;
        if (F.tid < 128) wl[F.tid] = IW[(mb + t0) * 8 + F.tid];
        const int nkb = (t0 + 15) / 32 + 1;
        bf16x8 Af[4][4];
#pragma unroll
        for (int rt = 0; rt < 4; ++rt)
#pragma unroll
            for (int ks = 0; ks < 4; ++ks) Af[rt][ks] = *(const bf16x8*)(IQ + (mb + t0 + 4 * rt + rq) * 512 + rh * 64 + ks * 16 + 8 * h);
        __syncthreads();
        for (int kb = wave; kb < nkb; kb += NWAVES) {
            bf16x8 Bf[4];
#pragma unroll
            for (int ks = 0; ks < 4; ++ks) Bf[ks] = *(const bf16x8*)(IK + (mb + kb * 32 + r) * 64 + ks * 16 + 8 * h);
#pragma unroll
            for (int rt = 0; rt < 4; ++rt) {
                f32x16 acc = {0.f, 0.f, 0.f, 0.f, 0.f, 0.f, 0.f, 0.f, 0.f, 0.f, 0.f, 0.f, 0.f, 0.f, 0.f, 0.f};
#pragma unroll
                for (int ks = 0; ks < 4; ++ks) acc = __builtin_amdgcn_mfma_f32_32x32x16_bf16(Af[rt][ks], Bf[ks], acc, 0, 0, 0);
                const int qa = 4 * rt + 2 * h;
                const f32x4 wa0 = *(const LAS f32x4*)(wl + qa * 8), wa1 = *(const LAS f32x4*)(wl + qa * 8 + 4), wb0 = *(const LAS f32x4*)(wl + qa * 8 + 8), wb1 = *(const LAS f32x4*)(wl + qa * 8 + 12);
                float sa = 0.f, sb = 0.f;
#pragma unroll
                for (int i = 0; i < 4; ++i) { sa += wa0[i] * fmaxf(acc[i], 0.f); sa += wa1[i] * fmaxf(acc[4 + i], 0.f); sb += wb0[i] * fmaxf(acc[8 + i], 0.f); sb += wb1[i] * fmaxf(acc[12 + i], 0.f); }
                sc[qa * 4096 + kb * 32 + r] = (_Float16)sa;
                sc[(qa + 1) * 4096 + kb * 32 + r] = (_Float16)sb;
            }
        }
        __syncthreads();
#pragma unroll 1
        for (int qq = 0; qq < 2; ++qq) {
            const int q = wave * 2 + qq, t = t0 + q, n = t + 1;
            unsigned mylo = 0u, myhi = 0u;
            if (n <= 256) {
                const int base = lane * 64;
                const u64 word = (base + 63 <= t) ? ~0ull : (base > t ? 0ull : ((1ull << (t - base + 1)) - 1ull));
                mylo = (unsigned)word; myhi = (unsigned)(word >> 32);
            } else {
                const int nw = (n + 63) >> 6;
                unsigned kk[32];
#pragma unroll
                for (int jj = 0; jj < 32; ++jj) {
                    unsigned lo16 = 0u, hi16 = 0u;
                    if (2 * jj < nw) { const int e = (2 * jj) * 64 + lane; const unsigned raw = scu[q * 4096 + e]; lo16 = (e <= t) ? f16key(raw) : 0u; }
                    if (2 * jj + 1 < nw) { const int e = (2 * jj + 1) * 64 + lane; const unsigned raw = scu[q * 4096 + e]; hi16 = (e <= t) ? f16key(raw) : 0u; }
                    kk[jj] = lo16 | (hi16 << 16);
                }
                unsigned prefix = 0u;
#pragma unroll 1
                for (int bit = 15; bit >= 0; --bit) {
                    const unsigned cand = prefix | (1u << bit), candhi = cand << 16;
                    int cnt = 0;
#pragma unroll
                    for (int jj = 0; jj < 32; ++jj) if (2 * jj < nw) {
                        cnt += __builtin_popcountll(__ballot((kk[jj] & 0xffffu) >= cand));
                        cnt += __builtin_popcountll(__ballot(kk[jj] >= candhi));
                    }
                    if (cnt >= 256) prefix = cand;
                }
                const unsigned Tk = prefix;
                int cgt = 0;
#pragma unroll
                for (int jj = 0; jj < 32; ++jj) if (2 * jj < nw) {
                    cgt += __builtin_popcountll(__ballot((kk[jj] & 0xffffu) > Tk));
                    cgt += __builtin_popcountll(__ballot((kk[jj] >> 16) > Tk));
                }
                const int need = 256 - cgt;
                int run = 0;
#pragma unroll
                for (int i = 0; i < 64; ++i) if (i < nw) {
                    const unsigned k = (i & 1) ? (kk[i >> 1] >> 16) : (kk[i >> 1] & 0xffffu);
                    const u64 gt = __ballot(k > Tk); u64 eq = __ballot(k == Tk);
                    const int pe = __builtin_popcountll(eq);
                    if (run + pe > need) { int kq = need - run; kq = kq < 0 ? 0 : kq;
                        const bool keep = ((eq >> lane) & 1ull) && (__builtin_popcountll(eq & ((1ull << lane) - 1ull)) < kq); eq = __ballot(keep); }
                    run += pe;
                    const u64 word = gt | eq;
                    if (lane == i) { mylo = (unsigned)word; myhi = (unsigned)(word >> 32); }
                }
            }
            mk[lane * 16 + q] = (u64)mylo | ((u64)myhi << 32);
        }
        __syncthreads();
        { const int w = F.tid >> 3, part = F.tid & 7;
          u64* dst = SELT + ((size_t)(b * 64 + w) * 4096) + t0 + part * 2;
          dst[0] = mk[w * 16 + part * 2]; dst[1] = mk[w * 16 + part * 2 + 1]; }
        __syncthreads();
    }
}

constexpr int AT_KB = 9216, AT_VB = 8704, AT_BUF = AT_KB + AT_VB;
struct AttStage { u32x4 kreg, vreg; };
__device__ __forceinline__ void att_load(AttStage& s, const bf16_t* Kg, const bf16_t* Vtg, int key0, int tid) {
    s.kreg = *(const u32x4*)(Kg + (size_t)(key0 + (tid >> 3)) * 64 + (tid & 7) * 8);
    s.vreg = *(const u32x4*)(Vtg + (size_t)(tid >> 3) * 4096 + key0 + (tid & 7) * 8);
}
__device__ __forceinline__ void att_store(const AttStage& s, LAS unsigned char* buf, int tid) {
    *(LAS u32x4*)(buf + (tid >> 3) * 144 + (tid & 7) * 16) = s.kreg;
    LAS unsigned char* v = buf + AT_KB + (tid >> 3) * 136 + (tid & 7) * 16;
    *(LAS u32x2*)(v) = (u32x2){s.vreg.x, s.vreg.y}; *(LAS u32x2*)(v + 8) = (u32x2){s.vreg.z, s.vreg.w};
}
__device__ __forceinline__ bf16x8 pack8(float a0, float a1, float a2, float a3, float a4, float a5, float a6, float a7) {
    u32x4 w; w.x = pg8::cvt_pk_bf16(a0, a1); w.y = pg8::cvt_pk_bf16(a2, a3); w.z = pg8::cvt_pk_bf16(a4, a5); w.w = pg8::cvt_pk_bf16(a6, a7);
    return __builtin_bit_cast(bf16x8, w);
}
__device__ __forceinline__ f32x16 att_qk(const LAS unsigned char* buf, int sub, const bf16x8 (&Qf)[4], int lane) {
    f32x16 S = {0.f, 0.f, 0.f, 0.f, 0.f, 0.f, 0.f, 0.f, 0.f, 0.f, 0.f, 0.f, 0.f, 0.f, 0.f, 0.f};
    const LAS unsigned char* kp = buf + (sub * 32 + (lane & 31)) * 144 + (lane >> 5) * 16;
#pragma unroll
    for (int ks = 0; ks < 4; ++ks) { const bf16x8 kf = *(const LAS bf16x8*)(kp + ks * 32); S = __builtin_amdgcn_mfma_f32_32x32x16_bf16(kf, Qf[ks], S, 0, 0, 0); }
    return S;
}
__device__ __forceinline__ void att_pv2(const LAS unsigned char* buf, int sub, const bf16x8 P0, const bf16x8 P1, f32x16 (&O)[2], int lane) {
    const int h = lane >> 5;
#pragma unroll
    for (int dt = 0; dt < 2; ++dt) {
        const LAS unsigned char* vp = buf + AT_KB + (dt * 32 + (lane & 31)) * 136 + (sub * 32 + 4 * h) * 2;
        const u32x2 a0 = *(const LAS u32x2*)(vp), a1 = *(const LAS u32x2*)(vp + 16), b0 = *(const LAS u32x2*)(vp + 32), b1 = *(const LAS u32x2*)(vp + 48);
        const bf16x8 V0 = __builtin_bit_cast(bf16x8, ((u32x4){a0.x, a0.y, a1.x, a1.y}));
        const bf16x8 V1 = __builtin_bit_cast(bf16x8, ((u32x4){b0.x, b0.y, b1.x, b1.y}));
        O[dt] = __builtin_amdgcn_mfma_f32_32x32x16_bf16(V0, P0, O[dt], 0, 0, 0);
        O[dt] = __builtin_amdgcn_mfma_f32_32x32x16_bf16(V1, P1, O[dt], 0, 0, 0);
    }
}
__device__ __forceinline__ void att_pv(const LAS unsigned char* buf, int sub, const float (&p)[16], f32x16 (&O)[2], int lane) {
    const bf16x8 P0 = pack8(p[0], p[1], p[2], p[3], p[4], p[5], p[6], p[7]);
    const bf16x8 P1 = pack8(p[8], p[9], p[10], p[11], p[12], p[13], p[14], p[15]);
    att_pv2(buf, sub, P0, P1, O, lane);
}

__device__ __forceinline__ void p_dsa_attn(const Frame& F, const Args& a, unsigned char* ws) {
    const bf16_t* QA = (const bf16_t*)(ws + L0_QA); const bf16_t* KA = (const bf16_t*)(ws + L0_KA); const bf16_t* VAT = (const bf16_t*)(ws + L0_VAT);
    const u64* SELT = (const u64*)(ws + L0_SELT); bf16_t* CAT = (bf16_t*)(ws + L0_CAT);
    const int lane = F.lane, wave = F.wave, h = lane >> 5, c = lane & 31, tid = F.tid;
    float mq = 0.f, mk_ = 0.f;
    for (int i = 0; i < 64; ++i) { mq = fmaxf(mq, fabsf(a.in[I_L0_QG][i])); mk_ = fmaxf(mk_, fabsf(a.in[I_L0_KG][i])); }
    const float c2 = (8.0f * mq * mk_ + 0.5f) * 1.4426950408889634f, c1 = 1.4426950408889634f;
    for (int u = F.bid; u < 512; u += F.G) {
        const int idx = u & 255, g = u >> 8, b = idx >> 5, qtr = idx & 31, qt = g ? 31 - qtr : qtr, q0 = qt * 128;
        const size_t mb = (size_t)b * 4096;
        const bf16_t* Kg = KA + (size_t)(b * 2 + g) * 4096 * 64; const bf16_t* Vtg = VAT + (size_t)(b * 2 + g) * 64 * 4096;
        bf16x8 Qf[2][4]; int qidx[2];
#pragma unroll
        for (int ct = 0; ct < 2; ++ct) { qidx[ct] = q0 + wave * 16 + ct * 8 + (c >> 2);
#pragma unroll
            for (int ks = 0; ks < 4; ++ks) Qf[ct][ks] = *(const bf16x8*)(QA + (mb + qidx[ct]) * 512 + (g * 4 + (c & 3)) * 64 + ks * 16 + 8 * h); }
        f32x16 O[2][2]; float l[2] = {0.f, 0.f};
#pragma unroll
        for (int ct = 0; ct < 2; ++ct)
#pragma unroll
            for (int dt = 0; dt < 2; ++dt)
#pragma unroll
                for (int i = 0; i < 16; ++i) O[ct][dt][i] = 0.f;
        const int nkt = 2 * qt + 2;
        AttStage st; att_load(st, Kg, Vtg, 0, tid);
        __syncthreads();
        att_store(st, F.lds, tid);
        __syncthreads();
        for (int kt = 0; kt < nkt; ++kt) {
            LAS unsigned char* buf = F.lds + (kt & 1) * AT_BUF;
            if (kt + 1 < nkt) att_load(st, Kg, Vtg, (kt + 1) * 64, tid);
            u64 mw[2];
#pragma unroll
            for (int ct = 0; ct < 2; ++ct) mw[ct] = SELT[(size_t)(b * 64 + kt) * 4096 + qidx[ct]];
#pragma unroll 1
            for (int sub = 0; sub < 2; ++sub) {
#pragma unroll
                for (int ct = 0; ct < 2; ++ct) {
                    __builtin_amdgcn_sched_barrier(0);
                    const f32x16 S = att_qk(buf, sub, Qf[ct], lane);
                    const unsigned mbits = (unsigned)(mw[ct] >> (sub * 32 + 4 * h));
                    float p[16];
#pragma unroll
                    for (int i = 0; i < 16; ++i) {
                        const float e = __builtin_amdgcn_exp2f(S[i] * c1 - c2);
                        const int bitpos = (i & 3) + 8 * (i >> 2);
                        p[i] = __builtin_bit_cast(float, __builtin_bit_cast(int, e) & __builtin_amdgcn_sbfe((int)mbits, bitpos, 1));
                        l[ct] += p[i];
                    }
                    att_pv(buf, sub, p, O[ct], lane);
                }
            }
            if (kt + 1 < nkt) att_store(st, F.lds + ((kt + 1) & 1) * AT_BUF, tid);
            __syncthreads();
        }
#pragma unroll
        for (int ct = 0; ct < 2; ++ct) {
            const float lt = l[ct] + __shfl_xor(l[ct], 32);
            const float inv = 1.0f / fmaxf(lt, 1e-30f);
            bf16_t* orow = CAT + (mb + qidx[ct]) * 1024 + (g * 4 + (c & 3)) * 64;
#pragma unroll
            for (int dt = 0; dt < 2; ++dt)
#pragma unroll
                for (int i4 = 0; i4 < 4; ++i4) {
                    const int d = dt * 32 + 8 * i4 + 4 * h;
                    u32x2 w; w.x = pk2(O[ct][dt][4 * i4] * inv, O[ct][dt][4 * i4 + 1] * inv); w.y = pk2(O[ct][dt][4 * i4 + 2] * inv, O[ct][dt][4 * i4 + 3] * inv);
                    *(u32x2*)(orow + d) = w;
                }
        }
    }
}

__device__ __forceinline__ void p_s5_scan(const Frame& F, const Args& a, unsigned char* ws) {
    const float* SLOC = (const float*)(ws + L0_SLOC); bf16_t* UA = (bf16_t*)(ws + L0_UA);
    const int gw = F.bid * NWAVES + F.wave, NGW = F.G * NWAVES, p = F.lane;
    for (int it = gw; it < 32 * NB; it += NGW) {
        const int g = it >> 3, b = it & 7;
        const float dt = expf(a.in[I_L0_LOGDT][g]);
        const float lr = a.in[I_L0_ARE][g * 64 + p], li = a.in[I_L0_AIM][g * 64 + p];
        const float mag = expf(16.0f * dt * lr); float s, c; sincosf(16.0f * dt * li, &s, &c);
        const float ar = mag * c, ai = mag * s;
        float hr = 0.f, hi = 0.f;
        const float* sl = SLOC + ((size_t)g * 2048 + b * 256) * 128;
        bf16_t* ua = UA + ((size_t)g * 2048 + b * 256) * 384 + 256;
        for (int ch = 0; ch < 256; ++ch) {
            ua[(size_t)ch * 384 + p] = (bf16_t)f2bf(hr); ua[(size_t)ch * 384 + 64 + p] = (bf16_t)f2bf(hi);
            const float xr = sl[(size_t)ch * 128 + p], xi = sl[(size_t)ch * 128 + 64 + p];
            const float nr = ar * hr - ai * hi + xr, ni = ar * hi + ai * hr + xi;
            hr = nr; hi = ni;
        }
    }
}
namespace pg8 {
struct EpiS5State {
    static constexpr bool PERM = false;
    float* C;
    __device__ __forceinline__ void operator()(const f32x4 (&acc)[2][2][4][2], const Unit& u, int wr, int wc, int fr, int fq) const {
        const int row0 = u.pm * BM + wr * 64 + fr, col0 = wc * 32 + 4 * fq;
#pragma unroll
        for (int ai = 0; ai < 2; ++ai)
#pragma unroll
            for (int m = 0; m < 4; ++m)
#pragma unroll
                for (int n = 0; n < 2; ++n) *(f32x4*)(C + (size_t)(row0 + ai * HALF + m * 16) * 128 + col0 + n * 16) = acc[ai][0][m][n];
    }
};
struct EpiS5Out {
    static constexpr bool PERM = false;
    bf16_t* YB;
    __device__ __forceinline__ void operator()(const f32x4 (&acc)[2][2][4][2], const Unit& u, int wr, int wc, int fr, int fq) const {
        const int g = u.pn;
        const int row0 = u.pm * BM + wr * 64 + fr - g * 2048;
        const int col0 = wc * 32 + 4 * fq;
#pragma unroll
        for (int ai = 0; ai < 2; ++ai)
#pragma unroll
            for (int m = 0; m < 4; ++m) { const int chunk = row0 + ai * HALF + m * 16;
#pragma unroll
                for (int bj = 0; bj < 2; ++bj)
#pragma unroll
                    for (int n = 0; n < 2; ++n) { const int col = col0 + bj * HALF + n * 16, i = col >> 4, co = col & 15;
                        const f32x4 v = acc[ai][bj][m][n];
                        u32x2 w; w.x = pk2(gelu_tanh(v[0]), gelu_tanh(v[1])); w.y = pk2(gelu_tanh(v[2]), gelu_tanh(v[3]));
                        *(u32x2*)(YB + ((size_t)chunk * 16 + i) * 512 + g * 16 + co) = w; }
                asm volatile("" ::: "memory"); __builtin_amdgcn_sched_barrier(0); }
    }
};
struct EpiGlu {
    static constexpr bool PERM = true;
    const bf16_t* YB; const float* bias; bf16_t* CAT;
    __device__ __forceinline__ void operator()(const f32x4 (&acc)[2][2][4][2], const Unit& u, int wr, int wc, int fr, int fq) const {
        const int row0 = u.pm * BM + wr * 64 + fr, col0 = u.pn * BM + wc * 32 + 8 * fq;
#pragma unroll
        for (int ai = 0; ai < 2; ++ai)
#pragma unroll
            for (int m = 0; m < 4; ++m) { const size_t row = row0 + ai * HALF + m * 16;
#pragma unroll
                for (int bj = 0; bj < 2; ++bj) { const int col = col0 + bj * HALF;
                    const u32x4 yv = *(const u32x4*)(YB + row * 512 + col);
                    const f32x4 b0 = *(const f32x4*)(bias + col), b1 = *(const f32x4*)(bias + col + 4);
                    const f32x4 z0 = acc[ai][bj][m][0] + b0, z1 = acc[ai][bj][m][1] + b1;
                    u32x4 w;
                    w.x = pk2(bf_lo(yv.x) * sigmoidf_(z0[0]), bf_hi(yv.x) * sigmoidf_(z0[1])); w.y = pk2(bf_lo(yv.y) * sigmoidf_(z0[2]), bf_hi(yv.y) * sigmoidf_(z0[3]));
                    w.z = pk2(bf_lo(yv.z) * sigmoidf_(z1[0]), bf_hi(yv.z) * sigmoidf_(z1[1])); w.w = pk2(bf_lo(yv.w) * sigmoidf_(z1[2]), bf_hi(yv.w) * sigmoidf_(z1[3]));
                    *(u32x4*)(CAT + row * 1024 + 512 + col) = w; }
                asm volatile("" ::: "memory"); __builtin_amdgcn_sched_barrier(0); }
    }
};
}
__device__ __forceinline__ unsigned mono_u32(float f) { const unsigned u = __builtin_bit_cast(unsigned, f); return u ^ ((u >> 31) ? 0xFFFFFFFFu : 0x80000000u); }
#define INS16(arr, xin) do { unsigned _x = (xin); _Pragma("unroll") for (int _i = 0; _i < 16; ++_i) { const unsigned _hi = arr[_i] > _x ? arr[_i] : _x; _x = arr[_i] > _x ? _x : arr[_i]; arr[_i] = _hi; } } while (0)
__device__ __forceinline__ void p_peer_route(const Frame& F, unsigned char* ws, const bf16_t* SK) {
    const bf16_t* Q2 = (const bf16_t*)(ws + PE_Q2); unsigned short* EID = (unsigned short*)(ws + PE_EID); float* GATE = (float*)(ws + PE_GATE);
    LAS float* sc0 = (LAS float*)F.lds;
    const int lane = F.lane, wave = F.wave, h5 = lane >> 5, r = lane & 31, tid = F.tid;
    for (int u = F.bid; u < 2048; u += F.G) {
        const int hd = u & 7, mt = u >> 3; const size_t m0 = (size_t)mt * 128;
        {
            const int p = wave >> 2, rt = wave & 3;
            bf16x8 Af[8];
#pragma unroll
            for (int ks = 0; ks < 8; ++ks) Af[ks] = *(const bf16x8*)(Q2 + (m0 + rt * 32 + r) * 2048 + (hd * 2 + p) * 128 + ks * 16 + 8 * h5);
            LAS float* scp = sc0 + p * 128 * 129;
#pragma unroll 1
            for (int ct = 0; ct < 4; ++ct) {
                f32x16 acc = {0.f, 0.f, 0.f, 0.f, 0.f, 0.f, 0.f, 0.f, 0.f, 0.f, 0.f, 0.f, 0.f, 0.f, 0.f, 0.f};
#pragma unroll
                for (int ks = 0; ks < 8; ++ks) { const bf16x8 Bf = *(const bf16x8*)(SK + ((size_t)(hd * 2 + p) * 128 + ct * 32 + r) * 128 + ks * 16 + 8 * h5);
                    acc = __builtin_amdgcn_mfma_f32_32x32x16_bf16(Af[ks], Bf, acc, 0, 0, 0); }
#pragma unroll
                for (int i = 0; i < 16; ++i) scp[(rt * 32 + (i & 3) + 8 * (i >> 2) + 4 * h5) * 129 + ct * 32 + r] = acc[i];
            }
        }
        __syncthreads();
        if (tid < 256) {
            const int row = tid & 127, pp = tid >> 7; LAS float* rowp = sc0 + pp * 128 * 129 + row * 129;
            unsigned a[16];
#pragma unroll
            for (int i = 0; i < 16; ++i) a[i] = 0u;
#pragma unroll 4
            for (int j = 0; j < 128; ++j) { const unsigned key = (mono_u32(rowp[j]) & ~0x7Fu) | (unsigned)(127 - j); if (key > a[15]) INS16(a, key); }
            float vals[16]; int ids[16];
#pragma unroll
            for (int k = 0; k < 16; ++k) { ids[k] = 127 - (int)(a[k] & 127u); vals[k] = rowp[ids[k]]; }
#pragma unroll
            for (int k = 0; k < 16; ++k) { rowp[k] = vals[k]; rowp[16 + k] = __int_as_float(ids[k]); }
        }
        __syncthreads();
        if (tid < 128) {
            const int row = tid; const LAS float* s1 = sc0 + row * 129; const LAS float* s2 = sc0 + 128 * 129 + row * 129;
            float v1[16], v2[16];
#pragma unroll
            for (int k = 0; k < 16; ++k) { v1[k] = s1[k]; v2[k] = s2[k]; }
            unsigned c[16];
#pragma unroll
            for (int i = 0; i < 16; ++i) c[i] = 0u;
#pragma unroll
            for (int a = 0; a < 16; ++a)
#pragma unroll
                for (int b = 0; b < 16; ++b) if ((a + 1) * (b + 1) <= 16) { const unsigned key = (mono_u32(v1[a] + v2[b]) & ~0xFFu) | (unsigned)(255 - (a * 16 + b)); INS16(c, key); }
            float mx = -3.0e38f; float sv[16]; int eid[16];
#pragma unroll
            for (int k = 0; k < 16; ++k) { const int fl = 255 - (int)(c[k] & 255u), a = fl >> 4, b = fl & 15;
                sv[k] = s1[a] + s2[b]; eid[k] = __float_as_int(s1[16 + a]) * 128 + __float_as_int(s2[16 + b]); mx = fmaxf(mx, sv[k]); }
            float den = 0.f;
#pragma unroll
            for (int k = 0; k < 16; ++k) { sv[k] = __expf(sv[k] - mx); den += sv[k]; }
            const float inv = 1.0f / den;
            unsigned short* ep = EID + (m0 + row) * 128 + hd * 16; float* gp = GATE + (m0 + row) * 128 + hd * 16;
#pragma unroll
            for (int k = 0; k < 16; ++k) { ep[k] = (unsigned short)eid[k]; gp[k] = sv[k] * inv; }
        }
        __syncthreads();
    }
}

__device__ __forceinline__ float rdlane_f(float v, int l) { return __builtin_bit_cast(float, __builtin_amdgcn_readlane(__builtin_bit_cast(int, v), l)); }
__device__ __forceinline__ void p_peer_expert(const Frame& F, unsigned char* ws, float* xres) {
    const bf16_t* XN = (const bf16_t*)(ws + WS_XN); const bf16_t* TU = (const bf16_t*)(ws + WS_TABU); const bf16_t* TV = (const bf16_t*)(ws + WS_TABV);
    const unsigned short* EID = (const unsigned short*)(ws + PE_EID); const float* GATE = (const float*)(ws + PE_GATE);
    const int gw = F.bid * NWAVES + F.wave, NGW = F.G * NWAVES, lane = F.lane;
    for (int m = gw; m < T; m += NGW) {
        float xf[16];
        { const u32x4 xa = *(const u32x4*)(XN + (size_t)m * 1024 + lane * 8), xb = *(const u32x4*)(XN + (size_t)m * 1024 + 512 + lane * 8);
          xf[0] = bf_lo(xa.x); xf[1] = bf_hi(xa.x); xf[2] = bf_lo(xa.y); xf[3] = bf_hi(xa.y); xf[4] = bf_lo(xa.z); xf[5] = bf_hi(xa.z); xf[6] = bf_lo(xa.w); xf[7] = bf_hi(xa.w);
          xf[8] = bf_lo(xb.x); xf[9] = bf_hi(xb.x); xf[10] = bf_lo(xb.y); xf[11] = bf_hi(xb.y); xf[12] = bf_lo(xb.z); xf[13] = bf_hi(xb.z); xf[14] = bf_lo(xb.w); xf[15] = bf_hi(xb.w); }
        const int id0 = EID[(size_t)m * 128 + lane], id1 = EID[(size_t)m * 128 + 64 + lane];
        const float g0 = GATE[(size_t)m * 128 + lane], g1 = GATE[(size_t)m * 128 + 64 + lane];
        float outv[16];
#pragma unroll
        for (int i = 0; i < 16; ++i) outv[i] = 0.f;
#pragma unroll 1
        for (int k = 0; k < 16; ++k) {
            const int idreg = (k < 8) ? id0 : id1; const float greg = (k < 8) ? g0 : g1; const int lbase = (k & 7) * 8;
            int e[8];
#pragma unroll
            for (int i = 0; i < 8; ++i) e[i] = __builtin_amdgcn_readlane(idreg, lbase + i);
            float pr[8];
            {
                u32x4 ua[8], ub[8];
#pragma unroll
                for (int i = 0; i < 8; ++i) { ua[i] = *(const u32x4*)(TU + (size_t)e[i] * 1024 + lane * 8); ub[i] = *(const u32x4*)(TU + (size_t)e[i] * 1024 + 512 + lane * 8); }
#pragma unroll
                for (int i = 0; i < 8; ++i) {
                    float s = xf[0] * bf_lo(ua[i].x); s += xf[1] * bf_hi(ua[i].x); s += xf[2] * bf_lo(ua[i].y); s += xf[3] * bf_hi(ua[i].y);
                    s += xf[4] * bf_lo(ua[i].z); s += xf[5] * bf_hi(ua[i].z); s += xf[6] * bf_lo(ua[i].w); s += xf[7] * bf_hi(ua[i].w);
                    s += xf[8] * bf_lo(ub[i].x); s += xf[9] * bf_hi(ub[i].x); s += xf[10] * bf_lo(ub[i].y); s += xf[11] * bf_hi(ub[i].y);
                    s += xf[12] * bf_lo(ub[i].z); s += xf[13] * bf_hi(ub[i].z); s += xf[14] * bf_lo(ub[i].w); s += xf[15] * bf_hi(ub[i].w);
                    pr[i] = s;
                }
            }
            float r4[4], r2[2], r1;
            { const bool up = (lane & 32) != 0;
#pragma unroll
              for (int i = 0; i < 4; ++i) { const float keep = up ? pr[i + 4] : pr[i], send = up ? pr[i] : pr[i + 4]; r4[i] = keep + __shfl_xor(send, 32); } }
            { const bool up = (lane & 16) != 0;
#pragma unroll
              for (int i = 0; i < 2; ++i) { const float keep = up ? r4[i + 2] : r4[i], send = up ? r4[i] : r4[i + 2]; r2[i] = keep + __shfl_xor(send, 16); } }
            { const bool up = (lane & 8) != 0; const float keep = up ? r2[1] : r2[0], send = up ? r2[0] : r2[1]; r1 = keep + __shfl_xor(send, 8); }
            r1 += __shfl_xor(r1, 4); r1 += __shfl_xor(r1, 2); r1 += __shfl_xor(r1, 1);
            const float gv = __shfl(greg, lbase + (lane >> 3));
            const float coef = gv * gelu_tanh(r1);
            {
                u32x4 va[8], vb[8];
#pragma unroll
                for (int i = 0; i < 8; ++i) { va[i] = *(const u32x4*)(TV + (size_t)e[i] * 1024 + lane * 8); vb[i] = *(const u32x4*)(TV + (size_t)e[i] * 1024 + 512 + lane * 8); }
#pragma unroll
                for (int i = 0; i < 8; ++i) {
                    const float ci = rdlane_f(coef, i * 8);
                    outv[0] += ci * bf_lo(va[i].x); outv[1] += ci * bf_hi(va[i].x); outv[2] += ci * bf_lo(va[i].y); outv[3] += ci * bf_hi(va[i].y);
                    outv[4] += ci * bf_lo(va[i].z); outv[5] += ci * bf_hi(va[i].z); outv[6] += ci * bf_lo(va[i].w); outv[7] += ci * bf_hi(va[i].w);
                    outv[8] += ci * bf_lo(vb[i].x); outv[9] += ci * bf_hi(vb[i].x); outv[10] += ci * bf_lo(vb[i].y); outv[11] += ci * bf_hi(vb[i].y);
                    outv[12] += ci * bf_lo(vb[i].z); outv[13] += ci * bf_hi(vb[i].z); outv[14] += ci * bf_lo(vb[i].w); outv[15] += ci * bf_hi(vb[i].w);
                }
            }
        }
        f32x4* o = (f32x4*)(xres + (size_t)m * 1024 + lane * 8);
        f32x4 a0 = o[0], a1 = o[1], b0 = o[128], b1 = o[129];
        a0 += (f32x4){outv[0], outv[1], outv[2], outv[3]}; a1 += (f32x4){outv[4], outv[5], outv[6], outv[7]};
        b0 += (f32x4){outv[8], outv[9], outv[10], outv[11]}; b1 += (f32x4){outv[12], outv[13], outv[14], outv[15]};
        o[0] = a0; o[1] = a1; o[128] = b0; o[129] = b1;
    }
}

typedef __bf16 bf16x2_t __attribute__((ext_vector_type(2)));
__device__ __forceinline__ float dot2bf(unsigned a, unsigned b, float c) { return __builtin_amdgcn_fdot2_f32_bf16(__builtin_bit_cast(bf16x2_t, a), __builtin_bit_cast(bf16x2_t, b), c, false); }
__device__ __forceinline__ void peer_slot_range(const unsigned (&xp)[8], float (&outv)[16], int id0, int id1, float g0, float g1, int r,
                                                const bf16_t* TU, const bf16_t* TV, int lane) {
    u64 m0 = __ballot((id0 >> 9) == r), m1 = __ballot((id1 >> 9) == r);
    while (m0 | m1) {
        int e[8]; float gt[8];
#pragma unroll
        for (int i = 0; i < 8; ++i) {
            if (m0) { const int l = __builtin_ctzll(m0); m0 &= m0 - 1ull; e[i] = __builtin_amdgcn_readlane(id0, l); gt[i] = rdlane_f(g0, l); }
            else if (m1) { const int l = __builtin_ctzll(m1); m1 &= m1 - 1ull; e[i] = __builtin_amdgcn_readlane(id1, l); gt[i] = rdlane_f(g1, l); }
            else { e[i] = -1; gt[i] = 0.f; }
        }
        float pr[8];
        {
            u32x4 ua[8], ub[8];
#pragma unroll
            for (int i = 0; i < 8; ++i) {
                if (e[i] >= 0) { ua[i] = *(const u32x4*)(TU + (size_t)e[i] * 1024 + lane * 8); ub[i] = *(const u32x4*)(TU + (size_t)e[i] * 1024 + 512 + lane * 8); }
                else { ua[i] = (u32x4){0u, 0u, 0u, 0u}; ub[i] = (u32x4){0u, 0u, 0u, 0u}; }
            }
#pragma unroll
            for (int i = 0; i < 8; ++i) {
                float s = dot2bf(xp[0], ua[i].x, 0.f); s = dot2bf(xp[1], ua[i].y, s); s = dot2bf(xp[2], ua[i].z, s); s = dot2bf(xp[3], ua[i].w, s);
                s = dot2bf(xp[4], ub[i].x, s); s = dot2bf(xp[5], ub[i].y, s); s = dot2bf(xp[6], ub[i].z, s); s = dot2bf(xp[7], ub[i].w, s);
                pr[i] = s;
            }
        }
        float r4[4], r2[2], r1;
        { const bool up = (lane & 32) != 0;
#pragma unroll
          for (int i = 0; i < 4; ++i) { const float keep = up ? pr[i + 4] : pr[i], send = up ? pr[i] : pr[i + 4]; r4[i] = keep + __shfl_xor(send, 32); } }
        { const bool up = (lane & 16) != 0;
#pragma unroll
          for (int i = 0; i < 2; ++i) { const float keep = up ? r4[i + 2] : r4[i], send = up ? r4[i] : r4[i + 2]; r2[i] = keep + __shfl_xor(send, 16); } }
        { const bool up = (lane & 8) != 0; const float keep = up ? r2[1] : r2[0], send = up ? r2[0] : r2[1]; r1 = keep + __shfl_xor(send, 8); }
        r1 += __shfl_xor(r1, 4); r1 += __shfl_xor(r1, 2); r1 += __shfl_xor(r1, 1);
        const int grp = lane >> 3;
        float gsel = gt[0];
#pragma unroll
        for (int i = 1; i < 8; ++i) gsel = (grp == i) ? gt[i] : gsel;
        const float coef = gsel * gelu_tanh(r1);
        {
            u32x4 va[8], vb[8];
#pragma unroll
            for (int i = 0; i < 8; ++i) {
                if (e[i] >= 0) { va[i] = *(const u32x4*)(TV + (size_t)e[i] * 1024 + lane * 8); vb[i] = *(const u32x4*)(TV + (size_t)e[i] * 1024 + 512 + lane * 8); }
                else { va[i] = (u32x4){0u, 0u, 0u, 0u}; vb[i] = (u32x4){0u, 0u, 0u, 0u}; }
            }
#pragma unroll
            for (int i = 0; i < 8; ++i) {
                if (e[i] >= 0) {
                    const float ci = rdlane_f(coef, i * 8);
                    outv[0] += ci * bf_lo(va[i].x); outv[1] += ci * bf_hi(va[i].x); outv[2] += ci * bf_lo(va[i].y); outv[3] += ci * bf_hi(va[i].y);
                    outv[4] += ci * bf_lo(va[i].z); outv[5] += ci * bf_hi(va[i].z); outv[6] += ci * bf_lo(va[i].w); outv[7] += ci * bf_hi(va[i].w);
                    outv[8] += ci * bf_lo(vb[i].x); outv[9] += ci * bf_hi(vb[i].x); outv[10] += ci * bf_lo(vb[i].y); outv[11] += ci * bf_hi(vb[i].y);
                    outv[12] += ci * bf_lo(vb[i].z); outv[13] += ci * bf_hi(vb[i].z); outv[14] += ci * bf_lo(vb[i].w); outv[15] += ci * bf_hi(vb[i].w);
                }
            }
        }
    }
}
__device__ __forceinline__ void p_peer_expert2(const Frame& F, unsigned char* ws, float* xres, const float oscale) {
    const bf16_t* XN = (const bf16_t*)(ws + WS_XN); const bf16_t* TU = (const bf16_t*)(ws + WS_TABU); const bf16_t* TV = (const bf16_t*)(ws + WS_TABV);
    const unsigned short* EID = (const unsigned short*)(ws + PE_EID); const float* GATE = (const float*)(ws + PE_GATE);
    const int gw = F.bid * NWAVES + F.wave, NGW = F.G * NWAVES, lane = F.lane;
    int rnd = 0;
    for (int m4 = gw * 4; m4 < T; m4 += NGW * 4, ++rnd) {
        unsigned xp[4][8]; float outv[4][16]; int id[4][2]; float gg[4][2];
#pragma unroll
        for (int s = 0; s < 4; ++s) {
            const size_t m = (size_t)(m4 + s);
            const u32x4 xa = *(const u32x4*)(XN + m * 1024 + lane * 8), xb = *(const u32x4*)(XN + m * 1024 + 512 + lane * 8);
            xp[s][0] = xa.x; xp[s][1] = xa.y; xp[s][2] = xa.z; xp[s][3] = xa.w; xp[s][4] = xb.x; xp[s][5] = xb.y; xp[s][6] = xb.z; xp[s][7] = xb.w;
            id[s][0] = EID[m * 128 + lane]; id[s][1] = EID[m * 128 + 64 + lane]; gg[s][0] = GATE[m * 128 + lane]; gg[s][1] = GATE[m * 128 + 64 + lane];
#pragma unroll
            for (int i = 0; i < 16; ++i) outv[s][i] = 0.f;
        }
#pragma unroll 1
        for (int k = 0; k < 32; ++k) {
            const int r = (rnd & 1) ? 31 - k : k;
#pragma unroll
            for (int s = 0; s < 4; ++s) peer_slot_range(xp[s], outv[s], id[s][0], id[s][1], gg[s][0], gg[s][1], r, TU, TV, lane);
        }
#pragma unroll
        for (int s = 0; s < 4; ++s) {
            f32x4* o = (f32x4*)(xres + (size_t)(m4 + s) * 1024 + lane * 8);
            f32x4 a0 = o[0], a1 = o[1], b0 = o[128], b1 = o[129];
            a0 += (f32x4){outv[s][0], outv[s][1], outv[s][2], outv[s][3]} * oscale; a1 += (f32x4){outv[s][4], outv[s][5], outv[s][6], outv[s][7]} * oscale;
            b0 += (f32x4){outv[s][8], outv[s][9], outv[s][10], outv[s][11]} * oscale; b1 += (f32x4){outv[s][12], outv[s][13], outv[s][14], outv[s][15]} * oscale;
            o[0] = a0; o[1] = a1; o[128] = b0; o[129] = b1;
        }
    }
}

struct RowBuf { u32x4 a[8], b[8]; };
__device__ __forceinline__ void peer_load8(RowBuf& rb, const bf16_t* TAB, const LAS unsigned* ent, int b, int lane) {
#pragma unroll
    for (int i = 0; i < 8; ++i) {
        const unsigned e = (unsigned)__builtin_amdgcn_readfirstlane((int)ent[b * 8 + i]) & 0x3FFFu;
        const bf16_t* rp = TAB + (size_t)e * 1024 + lane * 8;
        rb.a[i] = *(const u32x4*)rp; rb.b[i] = *(const u32x4*)(rp + 512);
    }
}
__device__ __forceinline__ float peer_dot(const unsigned (&xp)[8], const u32x4 a, const u32x4 b) {
    float s = dot2bf(xp[0], a.x, 0.f); s = dot2bf(xp[1], a.y, s); s = dot2bf(xp[2], a.z, s); s = dot2bf(xp[3], a.w, s);
    s = dot2bf(xp[4], b.x, s); s = dot2bf(xp[5], b.y, s); s = dot2bf(xp[6], b.z, s); s = dot2bf(xp[7], b.w, s);
    return s;
}
__device__ __forceinline__ void peer_u8(const RowBuf& rb, const unsigned (&xp)[4][8], const LAS unsigned* ent, LAS float* cf, int b, int lane) {
    float pr[8];
#pragma unroll
    for (int i = 0; i < 8; ++i) {
        const int slot = (__builtin_amdgcn_readfirstlane((int)ent[b * 8 + i]) >> 21) & 3;
        if (slot == 0) pr[i] = peer_dot(xp[0], rb.a[i], rb.b[i]);
        else if (slot == 1) pr[i] = peer_dot(xp[1], rb.a[i], rb.b[i]);
        else if (slot == 2) pr[i] = peer_dot(xp[2], rb.a[i], rb.b[i]);
        else pr[i] = peer_dot(xp[3], rb.a[i], rb.b[i]);
    }
    float r4[4], r2[2], r1;
    { const bool up = (lane & 32) != 0;
#pragma unroll
      for (int i = 0; i < 4; ++i) { const float keep = up ? pr[i + 4] : pr[i], send = up ? pr[i] : pr[i + 4]; r4[i] = keep + __shfl_xor(send, 32); } }
    { const bool up = (lane & 16) != 0;
#pragma unroll
      for (int i = 0; i < 2; ++i) { const float keep = up ? r4[i + 2] : r4[i], send = up ? r4[i] : r4[i + 2]; r2[i] = keep + __shfl_xor(send, 16); } }
    { const bool up = (lane & 8) != 0; const float keep = up ? r2[1] : r2[0], send = up ? r2[0] : r2[1]; r1 = keep + __shfl_xor(send, 8); }
    r1 += __shfl_xor(r1, 4); r1 += __shfl_xor(r1, 2); r1 += __shfl_xor(r1, 1);
    const float gate = cf[b * 8 + (lane >> 3)];
    const float coef = gate * gelu_tanh(r1);
    if ((lane & 7) == 0) cf[b * 8 + (lane >> 3)] = coef;
}
__device__ __forceinline__ void peer_acc(float (&o)[16], const float c, const u32x4 a, const u32x4 b) {
    o[0] += c * bf_lo(a.x); o[1] += c * bf_hi(a.x); o[2] += c * bf_lo(a.y); o[3] += c * bf_hi(a.y);
    o[4] += c * bf_lo(a.z); o[5] += c * bf_hi(a.z); o[6] += c * bf_lo(a.w); o[7] += c * bf_hi(a.w);
    o[8] += c * bf_lo(b.x); o[9] += c * bf_hi(b.x); o[10] += c * bf_lo(b.y); o[11] += c * bf_hi(b.y);
    o[12] += c * bf_lo(b.z); o[13] += c * bf_hi(b.z); o[14] += c * bf_lo(b.w); o[15] += c * bf_hi(b.w);
}
__device__ __forceinline__ void peer_v8(const RowBuf& rb, float (&outv)[4][16], const LAS unsigned* ent, const LAS float* cf, int b) {
#pragma unroll
    for (int i = 0; i < 8; ++i) {
        const int slot = (__builtin_amdgcn_readfirstlane((int)ent[b * 8 + i]) >> 21) & 3;
        const float c = cf[b * 8 + i];
        if (slot == 0) peer_acc(outv[0], c, rb.a[i], rb.b[i]);
        else if (slot == 1) peer_acc(outv[1], c, rb.a[i], rb.b[i]);
        else if (slot == 2) peer_acc(outv[2], c, rb.a[i], rb.b[i]);
        else peer_acc(outv[3], c, rb.a[i], rb.b[i]);
    }
}
__device__ __forceinline__ void p_peer_expert3(const Frame& F, unsigned char* ws, float* xres, const float oscale, const XcdBarrier& xbar) {
    const bf16_t* XN = (const bf16_t*)(ws + WS_XN); const bf16_t* TU = (const bf16_t*)(ws + WS_TABU); const bf16_t* TV = (const bf16_t*)(ws + WS_TABV);
    const unsigned short* EID = (const unsigned short*)(ws + PE_EID); const float* GATE = (const float*)(ws + PE_GATE);
    const int gw = F.bid * NWAVES + F.wave, NGW = F.G * NWAVES, lane = F.lane;
    LAS unsigned* ent = (LAS unsigned*)(F.lds + F.wave * 4096);
    LAS float* cf = (LAS float*)(F.lds + F.wave * 4096 + 2048);
    const int nrounds = (T + NGW * 4 - 1) / (NGW * 4);
    for (int rnd = 0; rnd < nrounds; ++rnd) {
        const int m4 = (rnd * NGW + gw) * 4;
        if (m4 < T) {
            unsigned xp[4][8];
            {
                int id[4][2]; float gg[4][2];
#pragma unroll
                for (int s = 0; s < 4; ++s) {
                    const size_t m = (size_t)(m4 + s);
                    const u32x4 xa = *(const u32x4*)(XN + m * 1024 + lane * 8), xb = *(const u32x4*)(XN + m * 1024 + 512 + lane * 8);
                    xp[s][0] = xa.x; xp[s][1] = xa.y; xp[s][2] = xa.z; xp[s][3] = xa.w; xp[s][4] = xb.x; xp[s][5] = xb.y; xp[s][6] = xb.z; xp[s][7] = xb.w;
                    id[s][0] = EID[m * 128 + lane]; id[s][1] = EID[m * 128 + 64 + lane]; gg[s][0] = GATE[m * 128 + lane]; gg[s][1] = GATE[m * 128 + 64 + lane];
                }
                int base = 0;
#pragma unroll 1
                for (int k = 0; k < 32; ++k) {
                    const int r = (rnd & 1) ? 31 - k : k;
#pragma unroll
                    for (int s = 0; s < 4; ++s)
#pragma unroll
                        for (int w = 0; w < 2; ++w) {
                            const bool hit = (id[s][w] >> 9) == r;
                            const u64 m = __ballot(hit);
                            if (hit) { const int pos = base + (int)__builtin_amdgcn_mbcnt_hi((unsigned)(m >> 32), __builtin_amdgcn_mbcnt_lo((unsigned)m, 0u));
                                ent[pos] = ((unsigned)s << 21) | ((unsigned)(w * 64 + lane) << 14) | (unsigned)id[s][w]; cf[pos] = gg[s][w]; }
                            base += __builtin_popcountll(m);
                        }
                }
            }
            LDS_WAIT();
            {
                RowBuf A, B;
                peer_load8(A, TU, ent, 0, lane);
#pragma unroll 1
                for (int b = 0; b < 64; b += 2) {
                    peer_load8(B, TU, ent, b + 1, lane);
                    peer_u8(A, xp, ent, cf, b, lane);
                    if (b + 2 < 64) peer_load8(A, TU, ent, b + 2, lane);
                    peer_u8(B, xp, ent, cf, b + 1, lane);
                }
            }
            LDS_WAIT();
            float outv[4][16];
#pragma unroll
            for (int s = 0; s < 4; ++s)
#pragma unroll
                for (int i = 0; i < 16; ++i) outv[s][i] = 0.f;
            {
                RowBuf A, B;
                peer_load8(A, TV, ent, 0, lane);
#pragma unroll 1
                for (int b = 0; b < 64; b += 2) {
                    peer_load8(B, TV, ent, b + 1, lane);
                    peer_v8(A, outv, ent, cf, b);
                    if (b + 2 < 64) peer_load8(A, TV, ent, b + 2, lane);
                    peer_v8(B, outv, ent, cf, b + 1);
                }
            }
#pragma unroll
            for (int s = 0; s < 4; ++s) {
                f32x4* o = (f32x4*)(xres + (size_t)(m4 + s) * 1024 + lane * 8);
                f32x4 a0 = o[0], a1 = o[1], b0 = o[128], b1 = o[129];
                a0 += (f32x4){outv[s][0], outv[s][1], outv[s][2], outv[s][3]} * oscale; a1 += (f32x4){outv[s][4], outv[s][5], outv[s][6], outv[s][7]} * oscale;
                b0 += (f32x4){outv[s][8], outv[s][9], outv[s][10], outv[s][11]} * oscale; b1 += (f32x4){outv[s][12], outv[s][13], outv[s][14], outv[s][15]} * oscale;
                o[0] = a0; o[1] = a1; o[128] = b0; o[129] = b1;
            }
        }
        if (rnd + 1 < nrounds) xcd_barrier(xbar);
    }
}

constexpr size_t WS_TAB8U = WS_TABU;
constexpr size_t WS_TAB8V = WS_TABU + 16 * MiB;
constexpr size_t WS_TABSU = WS_TABU + 32 * MiB;
constexpr size_t WS_TABSV = WS_TABU + 32 * MiB + 65536;
__device__ __forceinline__ void cvt_table_fp8(const Frame& F, const float* src, unsigned char* dst, float* scales) {
    const int gw = F.bid * NWAVES + F.wave, NGW = F.G * NWAVES, lane = F.lane;
    for (int r = gw; r < 16384; r += NGW) {
        const f32x4* p = (const f32x4*)(src + (size_t)r * 1024 + lane * 16);
        f32x4 v[4]; float am = 0.f;
#pragma unroll
        for (int j = 0; j < 4; ++j) { v[j] = p[j]; am = fmaxf(am, fmaxf(fmaxf(fabsf(v[j].x), fabsf(v[j].y)), fmaxf(fabsf(v[j].z), fabsf(v[j].w)))); }
#pragma unroll
        for (int o = 1; o < 64; o <<= 1) am = fmaxf(am, __shfl_xor(am, o));
        const float sc = am > 0.f ? am * (1.0f / 448.0f) : 1.0f, inv = 1.0f / sc;
        u32x4 q;
#pragma unroll
        for (int j = 0; j < 4; ++j) { int w = 0; w = __builtin_amdgcn_cvt_pk_fp8_f32(v[j].x * inv, v[j].y * inv, w, false); w = __builtin_amdgcn_cvt_pk_fp8_f32(v[j].z * inv, v[j].w * inv, w, true); q[j] = (unsigned)w; }
        *(u32x4*)(dst + (size_t)r * 1024 + lane * 16) = q;
        if (lane == 0) scales[r] = sc;
    }
}
template <int NR> struct RowBufN { u32x4 a[NR]; };
template <int NR>
__device__ __forceinline__ void peer_loadN(RowBufN<NR>& rb, const unsigned char* TAB, const LAS unsigned* ent, int b, int lane) {
    const int ev = (int)ent[b * NR + (lane & (NR - 1))];
#pragma unroll
    for (int i = 0; i < NR; ++i) {
        const unsigned e = (unsigned)__builtin_amdgcn_readlane(ev, i) & 0x3FFFu;
        rb.a[i] = *(const u32x4*)(TAB + (size_t)e * 1024 + lane * 16);
    }
}
__device__ __forceinline__ float peer_dot8x(const u32x4 xa, const u32x4 xb, const u32x4 q) {
    float s = 0.f;
#pragma unroll
    for (int j = 0; j < 4; ++j) {
        const f32x2 lo = __builtin_amdgcn_cvt_pk_f32_fp8((int)q[j], false), hi = __builtin_amdgcn_cvt_pk_f32_fp8((int)q[j], true);
        const unsigned x0 = (j < 2) ? xa[2 * j] : xb[2 * j - 4], x1 = (j < 2) ? xa[2 * j + 1] : xb[2 * j - 3];
        s += bf_lo(x0) * lo.x; s += bf_hi(x0) * lo.y; s += bf_lo(x1) * hi.x; s += bf_hi(x1) * hi.y;
    }
    return s;
}
template <int NR>
__device__ __forceinline__ void peer_u8x(const RowBufN<NR>& rb, int r0, const LAS unsigned char* xl, const LAS unsigned* ent, LAS float* cf, const LAS float* sul, int e0, int lane) {
    float pr[8];
    const int ev = (int)ent[e0 + (lane & 7)];
#pragma unroll
    for (int i = 0; i < 8; ++i) {
        const int slot = (__builtin_amdgcn_readlane(ev, i) >> 21) & 3;
        const LAS unsigned char* xp = xl + slot * 2048 + lane * 32;
        const u32x4 xa = *(const LAS u32x4*)xp, xb = *(const LAS u32x4*)(xp + 16);
        pr[i] = peer_dot8x(xa, xb, rb.a[r0 + i]);
    }
    float r4[4], r2[2], r1;
    { const bool up = (lane & 32) != 0;
#pragma unroll
      for (int i = 0; i < 4; ++i) { const float keep = up ? pr[i + 4] : pr[i], send = up ? pr[i] : pr[i + 4]; r4[i] = keep + __shfl_xor(send, 32); } }
    { const bool up = (lane & 16) != 0;
#pragma unroll
      for (int i = 0; i < 2; ++i) { const float keep = up ? r4[i + 2] : r4[i], send = up ? r4[i] : r4[i + 2]; r2[i] = keep + __shfl_xor(send, 16); } }
    { const bool up = (lane & 8) != 0; const float keep = up ? r2[1] : r2[0], send = up ? r2[0] : r2[1]; r1 = keep + __shfl_xor(send, 8); }
    r1 += __shfl_xor(r1, 4); r1 += __shfl_xor(r1, 2); r1 += __shfl_xor(r1, 1);
    const float gate = cf[e0 + (lane >> 3)];
    const float coef = gate * gelu_tanh(r1 * sul[e0 + (lane >> 3)]);
    if ((lane & 7) == 0) cf[e0 + (lane >> 3)] = coef;
}
__device__ __forceinline__ void peer_acc8(float (&o)[16], const float c, const u32x4 q) {
#pragma unroll
    for (int j = 0; j < 4; ++j) { const f32x2 lo = __builtin_amdgcn_cvt_pk_f32_fp8((int)q[j], false), hi = __builtin_amdgcn_cvt_pk_f32_fp8((int)q[j], true);
        o[4 * j] += c * lo.x; o[4 * j + 1] += c * lo.y; o[4 * j + 2] += c * hi.x; o[4 * j + 3] += c * hi.y; }
}
template <int NR>
__device__ __forceinline__ void peer_vN(const RowBufN<NR>& rb, float (&outv)[4][16], const LAS unsigned* ent, const LAS float* cf, int b, int lane) {
    const int ev = (int)ent[b * NR + (lane & (NR - 1))]; const float cv = cf[b * NR + (lane & (NR - 1))];
#pragma unroll
    for (int i = 0; i < NR; ++i) {
        const int slot = (__builtin_amdgcn_readlane(ev, i) >> 21) & 3;
        const float c = rdlane_f(cv, i);
        if (slot == 0) peer_acc8(outv[0], c, rb.a[i]);
        else if (slot == 1) peer_acc8(outv[1], c, rb.a[i]);
        else if (slot == 2) peer_acc8(outv[2], c, rb.a[i]);
        else peer_acc8(outv[3], c, rb.a[i]);
    }
}
__device__ __forceinline__ void p_peer_expert4(const Frame& F, unsigned char* ws, float* xres, const float oscale, const XcdBarrier& xbar, const int mode) {
    const bf16_t* XN = (const bf16_t*)(ws + WS_XN); const unsigned char* TU = ws + WS_TAB8U; const unsigned char* TV = ws + WS_TAB8V;
    const float* SU = (const float*)(ws + WS_TABSU); const float* SV = (const float*)(ws + WS_TABSV);
    const unsigned short* EID = (const unsigned short*)(ws + PE_EID); const float* GATE = (const float*)(ws + PE_GATE);
    const int gw = F.bid * NWAVES + F.wave, NGW = F.G * NWAVES, lane = F.lane;
    LAS unsigned* ent = (LAS unsigned*)(F.lds + F.wave * 6144);
    LAS float* cf = (LAS float*)(F.lds + F.wave * 6144 + 2048);
    LAS float* sul = (LAS float*)(F.lds + F.wave * 6144 + 4096);
    LAS unsigned char* xl = F.lds + 49152 + F.wave * 8192;
    constexpr int PU = 16, PV = 8;
    const int nrounds = (T + NGW * 4 - 1) / (NGW * 4);
    for (int rnd = 0; rnd < nrounds; ++rnd) {
        const int m4 = (rnd * NGW + gw) * 4;
        if (m4 < T) {
            {
                int id[4][2]; float gg[4][2], su[4][2];
#pragma unroll
                for (int s = 0; s < 4; ++s) { const size_t m = (size_t)(m4 + s);
                    id[s][0] = EID[m * 128 + lane]; id[s][1] = EID[m * 128 + 64 + lane]; gg[s][0] = GATE[m * 128 + lane] * SV[id[s][0]]; gg[s][1] = GATE[m * 128 + 64 + lane] * SV[id[s][1]]; su[s][0] = SU[id[s][0]]; su[s][1] = SU[id[s][1]]; }
                int base = 0;
#pragma unroll 1
                for (int k = 0; k < 16; ++k) {
                    const int r = (rnd & 1) ? 15 - k : k;
#pragma unroll
                    for (int s = 0; s < 4; ++s)
#pragma unroll
                        for (int w = 0; w < 2; ++w) {
                            const bool hit = (id[s][w] >> 10) == r;
                            const u64 m = __ballot(hit);
                            if (hit) { const int pos = base + (int)__builtin_amdgcn_mbcnt_hi((unsigned)(m >> 32), __builtin_amdgcn_mbcnt_lo((unsigned)m, 0u));
                                ent[pos] = ((unsigned)s << 21) | ((unsigned)(w * 64 + lane) << 14) | (unsigned)(mode == 4 ? (id[s][w] & 7) : id[s][w]); cf[pos] = gg[s][w]; sul[pos] = su[s][w]; }
                            base += __builtin_popcountll(m);
                        }
                }
            }
            LDS_WAIT();
            if (mode != 1 && mode != 3) {
#pragma unroll
                for (int s = 0; s < 4; ++s) { const size_t m = (size_t)(m4 + s);
                    const u32x4 xa = *(const u32x4*)(XN + m * 1024 + lane * 16), xb = *(const u32x4*)(XN + m * 1024 + lane * 16 + 8);
                    *(LAS u32x4*)(xl + s * 2048 + lane * 32) = xa; *(LAS u32x4*)(xl + s * 2048 + lane * 32 + 16) = xb; }
                LDS_WAIT();
                RowBufN<PU> A, B;
                peer_loadN<PU>(A, TU, ent, 0, lane);
#pragma unroll 1
                for (int b = 0; b < 512 / PU; b += 2) {
                    peer_loadN<PU>(B, TU, ent, b + 1, lane);
#pragma unroll
                    for (int h = 0; h < PU / 8; ++h) peer_u8x<PU>(A, h * 8, xl, ent, cf, sul, b * PU + h * 8, lane);
                    if (b + 2 < 512 / PU) peer_loadN<PU>(A, TU, ent, b + 2, lane);
#pragma unroll
                    for (int h = 0; h < PU / 8; ++h) peer_u8x<PU>(B, h * 8, xl, ent, cf, sul, (b + 1) * PU + h * 8, lane);
                }
            }
            LDS_WAIT();
            float outv[4][16];
#pragma unroll
            for (int s = 0; s < 4; ++s)
#pragma unroll
                for (int i = 0; i < 16; ++i) outv[s][i] = 0.f;
            if (mode != 1 && mode != 2) {
                RowBufN<PV> A, B;
                peer_loadN<PV>(A, TV, ent, 0, lane);
#pragma unroll 1
                for (int b = 0; b < 512 / PV; b += 2) {
                    peer_loadN<PV>(B, TV, ent, b + 1, lane);
                    peer_vN<PV>(A, outv, ent, cf, b, lane);
                    if (b + 2 < 512 / PV) peer_loadN<PV>(A, TV, ent, b + 2, lane);
                    peer_vN<PV>(B, outv, ent, cf, b + 1, lane);
                }
            }
#pragma unroll
            for (int s = 0; s < 4; ++s) {
                f32x4* o = (f32x4*)(xres + (size_t)(m4 + s) * 1024 + lane * 16);
#pragma unroll
                for (int j = 0; j < 4; ++j) { f32x4 a0 = o[j]; a0 += (f32x4){outv[s][4 * j], outv[s][4 * j + 1], outv[s][4 * j + 2], outv[s][4 * j + 3]} * oscale; o[j] = a0; }
            }
        }
        if (rnd + 1 < nrounds) xcd_barrier(xbar);
    }
}

__device__ __forceinline__ void cvt_table_i8(const Frame& F, const float* src, unsigned char* dst, float* scales) {
    const int gw = F.bid * NWAVES + F.wave, NGW = F.G * NWAVES, lane = F.lane;
    for (int r = gw; r < 16384; r += NGW) {
        const f32x4* p = (const f32x4*)(src + (size_t)r * 1024 + lane * 16);
        f32x4 v[4]; float am = 0.f;
#pragma unroll
        for (int j = 0; j < 4; ++j) { v[j] = p[j]; am = fmaxf(am, fmaxf(fmaxf(fabsf(v[j].x), fabsf(v[j].y)), fmaxf(fabsf(v[j].z), fabsf(v[j].w)))); }
#pragma unroll
        for (int o = 1; o < 64; o <<= 1) am = fmaxf(am, __shfl_xor(am, o));
        const float sc = am > 0.f ? am * (1.0f / 127.0f) : 1.0f, inv = 1.0f / sc;
        u32x4 q;
#pragma unroll
        for (int j = 0; j < 4; ++j) { const int a = (int)rintf(v[j].x * inv), b = (int)rintf(v[j].y * inv), c = (int)rintf(v[j].z * inv), d = (int)rintf(v[j].w * inv);
            q[j] = (unsigned)(a & 255) | ((unsigned)(b & 255) << 8) | ((unsigned)(c & 255) << 16) | ((unsigned)(d & 255) << 24); }
        *(u32x4*)(dst + (size_t)r * 1024 + lane * 16) = q;
        if (lane == 0) scales[r] = sc;
    }
}
template <int NR>
__device__ __forceinline__ void peer_u8i(const RowBufN<NR>& rb, int r0, const LAS unsigned char* xq, const LAS unsigned* ent, LAS float* cf, const LAS float* sul, int e0, int lane) {
    int pr[8];
    const int ev = (int)ent[e0 + (lane & 7)];
#pragma unroll
    for (int i = 0; i < 8; ++i) {
        const int slot = (__builtin_amdgcn_readlane(ev, i) >> 21) & 3;
        const u32x4 xv = *(const LAS u32x4*)(xq + slot * 1024 + lane * 16);
        const u32x4 q = rb.a[r0 + i];
        int s = __builtin_amdgcn_sdot4((int)xv.x, (int)q.x, 0, false); s = __builtin_amdgcn_sdot4((int)xv.y, (int)q.y, s, false);
        s = __builtin_amdgcn_sdot4((int)xv.z, (int)q.z, s, false); s = __builtin_amdgcn_sdot4((int)xv.w, (int)q.w, s, false);
        pr[i] = s;
    }
    int r4[4], r2[2], r1;
    { const bool up = (lane & 32) != 0;
#pragma unroll
      for (int i = 0; i < 4; ++i) { const int keep = up ? pr[i + 4] : pr[i], send = up ? pr[i] : pr[i + 4]; r4[i] = keep + __shfl_xor(send, 32); } }
    { const bool up = (lane & 16) != 0;
#pragma unroll
      for (int i = 0; i < 2; ++i) { const int keep = up ? r4[i + 2] : r4[i], send = up ? r4[i] : r4[i + 2]; r2[i] = keep + __shfl_xor(send, 16); } }
    { const bool up = (lane & 8) != 0; const int keep = up ? r2[1] : r2[0], send = up ? r2[0] : r2[1]; r1 = keep + __shfl_xor(send, 8); }
    r1 += __shfl_xor(r1, 4); r1 += __shfl_xor(r1, 2); r1 += __shfl_xor(r1, 1);
    const float gate = cf[e0 + (lane >> 3)];
    const float coef = gate * gelu_tanh((float)r1 * sul[e0 + (lane >> 3)]);
    if ((lane & 7) == 0) cf[e0 + (lane >> 3)] = coef;
}
template <bool FAKE>
__device__ __forceinline__ f32x2 cvt8(unsigned w, bool hi) {
    if (FAKE) { const unsigned t = hi ? (w >> 16) : w; return (f32x2){__builtin_bit_cast(float, (t << 23) | 0x30000000u), __builtin_bit_cast(float, ((t >> 8) << 23) | 0x30000000u)}; }
    return hi ? __builtin_amdgcn_cvt_pk_f32_fp8((int)w, true) : __builtin_amdgcn_cvt_pk_f32_fp8((int)w, false);
}
template <bool FAKE = false>
__device__ __forceinline__ void peer_acc8p(f32x2 (&o)[8], const float c, const u32x4 q) {
    const f32x2 c2 = {c, c};
#pragma unroll
    for (int j = 0; j < 4; ++j) { const f32x2 lo = cvt8<FAKE>(q[j], false), hi = cvt8<FAKE>(q[j], true);
        o[2 * j] += c2 * lo; o[2 * j + 1] += c2 * hi; }
}
template <int NR, bool FAKE>
__device__ __forceinline__ void peer_vNp(const RowBufN<NR>& rb, f32x2 (&outv)[4][8], const LAS unsigned* ent, const LAS float* cf, int b, int lane) {
    const int ev = (int)ent[b * NR + (lane & (NR - 1))]; const float cv = cf[b * NR + (lane & (NR - 1))];
#pragma unroll
    for (int i = 0; i < NR; ++i) {
        const int slot = (__builtin_amdgcn_readlane(ev, i) >> 21) & 3;
        const float c = rdlane_f(cv, i);
        if (slot == 0) peer_acc8p<FAKE>(outv[0], c, rb.a[i]);
        if (slot == 1) peer_acc8p<FAKE>(outv[1], c, rb.a[i]);
        if (slot == 2) peer_acc8p<FAKE>(outv[2], c, rb.a[i]);
        if (slot == 3) peer_acc8p<FAKE>(outv[3], c, rb.a[i]);
    }
}
template <int PV, bool FAKE>
__device__ __forceinline__ void peer_passv(f32x2 (&outv)[4][8], const unsigned char* TV, const LAS unsigned* ent, const LAS float* cf, int lane) {
    RowBufN<PV> A, B, C;
    constexpr int NBV = 512 / PV;
    peer_loadN<PV>(A, TV, ent, 0, lane); peer_loadN<PV>(B, TV, ent, 1, lane);
#pragma unroll 1
    for (int b = 0; b + 2 < NBV; b += 3) {
        peer_loadN<PV>(C, TV, ent, b + 2, lane);
        peer_vNp<PV, FAKE>(A, outv, ent, cf, b, lane);
        if (b + 3 < NBV) peer_loadN<PV>(A, TV, ent, b + 3, lane);
        peer_vNp<PV, FAKE>(B, outv, ent, cf, b + 1, lane);
        if (b + 4 < NBV) peer_loadN<PV>(B, TV, ent, b + 4, lane);
        peer_vNp<PV, FAKE>(C, outv, ent, cf, b + 2, lane);
    }
    peer_vNp<PV, FAKE>(A, outv, ent, cf, NBV - 1, lane);
}
__device__ __forceinline__ void p_peer_expert5(const Frame& F, unsigned char* ws, float* xres, const float oscale, const XcdBarrier& xbar, const int mode) {
    const bf16_t* XN = (const bf16_t*)(ws + WS_XN); const unsigned char* TU = ws + WS_TAB8U; const unsigned char* TV = ws + WS_TAB8V;
    const float* SU = (const float*)(ws + WS_TABSU); const float* SV = (const float*)(ws + WS_TABSV);
    const unsigned short* EID = (const unsigned short*)(ws + PE_EID); const float* GATE = (const float*)(ws + PE_GATE);
    const int gw = F.bid * NWAVES + F.wave, NGW = F.G * NWAVES, lane = F.lane;
    LAS unsigned* ent = (LAS unsigned*)(F.lds + F.wave * 6144);
    LAS float* cf = (LAS float*)(F.lds + F.wave * 6144 + 2048);
    LAS float* sul = (LAS float*)(F.lds + F.wave * 6144 + 4096);
    LAS unsigned char* xq = F.lds + 49152 + F.wave * 4096;
    constexpr int PU = 16, PV = 8;
    const int nrounds = (T + NGW * 4 - 1) / (NGW * 4);
    for (int rnd = 0; rnd < nrounds; ++rnd) {
        const int m4 = (rnd * NGW + gw) * 4;
        if (m4 < T) {
            {
                float sx[4];
#pragma unroll
                for (int s = 0; s < 4; ++s) { const size_t m = (size_t)(m4 + s);
                    const u32x4 xa = *(const u32x4*)(XN + m * 1024 + lane * 16), xb = *(const u32x4*)(XN + m * 1024 + lane * 16 + 8);
                    float xf[16] = {bf_lo(xa.x), bf_hi(xa.x), bf_lo(xa.y), bf_hi(xa.y), bf_lo(xa.z), bf_hi(xa.z), bf_lo(xa.w), bf_hi(xa.w),
                                    bf_lo(xb.x), bf_hi(xb.x), bf_lo(xb.y), bf_hi(xb.y), bf_lo(xb.z), bf_hi(xb.z), bf_lo(xb.w), bf_hi(xb.w)};
                    float am = 0.f;
#pragma unroll
                    for (int i = 0; i < 16; ++i) am = fmaxf(am, fabsf(xf[i]));
#pragma unroll
                    for (int o = 1; o < 64; o <<= 1) am = fmaxf(am, __shfl_xor(am, o));
                    sx[s] = am > 0.f ? am * (1.0f / 127.0f) : 1.0f; const float inv = 1.0f / sx[s];
                    u32x4 q;
#pragma unroll
                    for (int j = 0; j < 4; ++j) { const int a = (int)rintf(xf[4 * j] * inv), b = (int)rintf(xf[4 * j + 1] * inv), c = (int)rintf(xf[4 * j + 2] * inv), d = (int)rintf(xf[4 * j + 3] * inv);
                        q[j] = (unsigned)(a & 255) | ((unsigned)(b & 255) << 8) | ((unsigned)(c & 255) << 16) | ((unsigned)(d & 255) << 24); }
                    *(LAS u32x4*)(xq + s * 1024 + lane * 16) = q; }
                int id[4][2]; float gg[4][2], su[4][2];
#pragma unroll
                for (int s = 0; s < 4; ++s) { const size_t m = (size_t)(m4 + s);
                    id[s][0] = EID[m * 128 + lane]; id[s][1] = EID[m * 128 + 64 + lane];
                    gg[s][0] = GATE[m * 128 + lane] * SV[id[s][0]]; gg[s][1] = GATE[m * 128 + 64 + lane] * SV[id[s][1]];
                    su[s][0] = SU[id[s][0]] * sx[s]; su[s][1] = SU[id[s][1]] * sx[s]; }
                int base = 0;
#pragma unroll 1
                for (int k = 0; k < 16; ++k) {
                    const int r = (rnd & 1) ? 15 - k : k;
#pragma unroll
                    for (int s = 0; s < 4; ++s)
#pragma unroll
                        for (int w = 0; w < 2; ++w) {
                            const bool hit = (id[s][w] >> 10) == r;
                            const u64 m = __ballot(hit);
                            if (hit) { const int pos = base + (int)__builtin_amdgcn_mbcnt_hi((unsigned)(m >> 32), __builtin_amdgcn_mbcnt_lo((unsigned)m, 0u));
                                ent[pos] = ((unsigned)s << 21) | ((unsigned)(w * 64 + lane) << 14) | (unsigned)(mode == 4 ? (id[s][w] & 7) : id[s][w]); cf[pos] = gg[s][w]; sul[pos] = su[s][w]; }
                            base += __builtin_popcountll(m);
                        }
                }
            }
            LDS_WAIT();
            if (mode != 1 && mode != 3) {
                RowBufN<PU> A, B;
                peer_loadN<PU>(A, TU, ent, 0, lane);
#pragma unroll 1
                for (int b = 0; b < 512 / PU; b += 2) {
                    peer_loadN<PU>(B, TU, ent, b + 1, lane);
#pragma unroll
                    for (int h = 0; h < PU / 8; ++h) peer_u8i<PU>(A, h * 8, xq, ent, cf, sul, b * PU + h * 8, lane);
                    if (b + 2 < 512 / PU) peer_loadN<PU>(A, TU, ent, b + 2, lane);
#pragma unroll
                    for (int h = 0; h < PU / 8; ++h) peer_u8i<PU>(B, h * 8, xq, ent, cf, sul, (b + 1) * PU + h * 8, lane);
                }
            }
            LDS_WAIT();
            f32x2 outv[4][8];
#pragma unroll
            for (int s = 0; s < 4; ++s)
#pragma unroll
                for (int i = 0; i < 8; ++i) outv[s][i] = (f32x2){0.f, 0.f};
            if (mode != 1 && mode != 2) {
                if (mode == 5) peer_passv<PV, true>(outv, TV, ent, cf, lane); else peer_passv<PV, false>(outv, TV, ent, cf, lane);
            }
#pragma unroll
            for (int s = 0; s < 4; ++s) {
                f32x4* o = (f32x4*)(xres + (size_t)(m4 + s) * 1024 + lane * 16);
#pragma unroll
                for (int j = 0; j < 4; ++j) { f32x4 a0 = o[j]; const f32x4 add = (f32x4){outv[s][2 * j].x, outv[s][2 * j].y, outv[s][2 * j + 1].x, outv[s][2 * j + 1].y};
                    if (oscale != 0.f) a0 += add; else asm volatile("" :: "v"(add)); o[j] = a0; }
            }
        }
        if (rnd + 1 < nrounds) xcd_barrier(xbar);
    }
}

struct GBuf { u32x4 a[8]; };
__device__ __forceinline__ void grp_load(GBuf& rb, const unsigned char* TAB, const LAS unsigned* ent, unsigned ginfo, int j, int lane) {
    const int start = (int)(ginfo & 0xFFFFu) + 8 * j, n = (int)(ginfo >> 16) - 8 * j;
    if (n > 0) {
        const int ev = (int)ent[start + (lane & 7)];
#pragma unroll
        for (int i = 0; i < 8; ++i) if (i < n) {
            const unsigned e = (unsigned)__builtin_amdgcn_readlane(ev, i) & 0x3FFFu;
            rb.a[i] = *(const u32x4*)(TAB + (size_t)e * 1024 + lane * 16);
        }
    }
}
__device__ __forceinline__ int dot16i(const u32x4 x, const u32x4 q) {
    int s = __builtin_amdgcn_sdot4((int)x.x, (int)q.x, 0, false); s = __builtin_amdgcn_sdot4((int)x.y, (int)q.y, s, false);
    s = __builtin_amdgcn_sdot4((int)x.z, (int)q.z, s, false); return __builtin_amdgcn_sdot4((int)x.w, (int)q.w, s, false);
}
__device__ __forceinline__ void grp_u(const GBuf& rb, const u32x4 xq, LAS float* cf, const LAS float* sul, unsigned ginfo, int j, int lane) {
    const int start = (int)(ginfo & 0xFFFFu) + 8 * j, n = (int)(ginfo >> 16) - 8 * j;
    if (n > 0) {
        int pr[8];
#pragma unroll
        for (int i = 0; i < 8; ++i) { pr[i] = 0; if (i < n) pr[i] = dot16i(xq, rb.a[i]); }
        int r4[4], r2[2], r1;
        { const bool up = (lane & 32) != 0;
#pragma unroll
          for (int i = 0; i < 4; ++i) { const int keep = up ? pr[i + 4] : pr[i], send = up ? pr[i] : pr[i + 4]; r4[i] = keep + __shfl_xor(send, 32); } }
        { const bool up = (lane & 16) != 0;
#pragma unroll
          for (int i = 0; i < 2; ++i) { const int keep = up ? r4[i + 2] : r4[i], send = up ? r4[i] : r4[i + 2]; r2[i] = keep + __shfl_xor(send, 16); } }
        { const bool up = (lane & 8) != 0; const int keep = up ? r2[1] : r2[0], send = up ? r2[0] : r2[1]; r1 = keep + __shfl_xor(send, 8); }
        r1 += __shfl_xor(r1, 4); r1 += __shfl_xor(r1, 2); r1 += __shfl_xor(r1, 1);
        const int i = lane >> 3;
        if (i < n) { const float coef = cf[start + i] * gelu_tanh((float)r1 * sul[start + i]); if ((lane & 7) == 0) cf[start + i] = coef; }
    }
}
__device__ __forceinline__ void grp_u_over(const u32x4 xq, const unsigned char* TU, const LAS unsigned* ent, LAS float* cf, const LAS float* sul, unsigned ginfo, int lane) {
    const int start = (int)(ginfo & 0xFFFFu), n = (int)(ginfo >> 16);
    for (int i = 16; i < n; ++i) {
        const unsigned e = (unsigned)__builtin_amdgcn_readfirstlane((int)ent[start + i]) & 0x3FFFu;
        const u32x4 q = *(const u32x4*)(TU + (size_t)e * 1024 + lane * 16);
        int r1 = dot16i(xq, q);
#pragma unroll
        for (int o = 32; o >= 1; o >>= 1) r1 += __shfl_xor(r1, o);
        const float coef = cf[start + i] * gelu_tanh((float)r1 * sul[start + i]);
        LDS_WAIT();
        if (lane == 0) cf[start + i] = coef;
        LDS_WAIT();
    }
}
__device__ __forceinline__ void grp_v(const GBuf& rb, f32x2 (&o)[8], const LAS float* cf, unsigned ginfo, int j, int lane) {
    const int start = (int)(ginfo & 0xFFFFu) + 8 * j, n = (int)(ginfo >> 16) - 8 * j;
    if (n > 0) {
        const float cv = cf[start + (lane & 7)];
#pragma unroll
        for (int i = 0; i < 8; ++i) if (i < n) peer_acc8p(o, rdlane_f(cv, i), rb.a[i]);
    }
}
__device__ __forceinline__ void grp_v_over(f32x2 (&o)[8], const unsigned char* TV, const LAS unsigned* ent, const LAS float* cf, unsigned ginfo, int lane) {
    const int start = (int)(ginfo & 0xFFFFu), n = (int)(ginfo >> 16);
    for (int i = 16; i < n; ++i) {
        const unsigned e = (unsigned)__builtin_amdgcn_readfirstlane((int)ent[start + i]) & 0x3FFFu;
        const u32x4 q = *(const u32x4*)(TV + (size_t)e * 1024 + lane * 16);
        peer_acc8p(o, cf[start + i], q);
    }
}
__device__ __forceinline__ void p_peer_expert6(const Frame& F, unsigned char* ws, float* xres, const float oscale, const XcdBarrier& xbar, const int mode) {
    const bf16_t* XN = (const bf16_t*)(ws + WS_XN); const unsigned char* TU = ws + WS_TAB8U; const unsigned char* TV = ws + WS_TAB8V;
    const float* SU = (const float*)(ws + WS_TABSU); const float* SV = (const float*)(ws + WS_TABSV);
    const unsigned short* EID = (const unsigned short*)(ws + PE_EID); const float* GATE = (const float*)(ws + PE_GATE);
    const int gw = F.bid * NWAVES + F.wave, NGW = F.G * NWAVES, lane = F.lane;
    LAS unsigned* ent = (LAS unsigned*)(F.lds + F.wave * 8192);
    LAS float* cf = (LAS float*)(F.lds + F.wave * 8192 + 2304);
    LAS float* sul = (LAS float*)(F.lds + F.wave * 8192 + 4608);
    LAS unsigned* gi = (LAS unsigned*)(F.lds + F.wave * 8192 + 6912);
    const int nrounds = (T + NGW * 4 - 1) / (NGW * 4);
    if (lane < 4) gi[64 + lane] = 0u;
    for (int rnd = 0; rnd < nrounds; ++rnd) {
        const int m4 = (rnd * NGW + gw) * 4;
        if (m4 < T) {
            u32x4 xq[4];
            {
                float sx[4];
#pragma unroll
                for (int s = 0; s < 4; ++s) { const size_t m = (size_t)(m4 + s);
                    const u32x4 xa = *(const u32x4*)(XN + m * 1024 + lane * 16), xb = *(const u32x4*)(XN + m * 1024 + lane * 16 + 8);
                    float xf[16] = {bf_lo(xa.x), bf_hi(xa.x), bf_lo(xa.y), bf_hi(xa.y), bf_lo(xa.z), bf_hi(xa.z), bf_lo(xa.w), bf_hi(xa.w),
                                    bf_lo(xb.x), bf_hi(xb.x), bf_lo(xb.y), bf_hi(xb.y), bf_lo(xb.z), bf_hi(xb.z), bf_lo(xb.w), bf_hi(xb.w)};
                    float am = 0.f;
#pragma unroll
                    for (int i = 0; i < 16; ++i) am = fmaxf(am, fabsf(xf[i]));
#pragma unroll
                    for (int o = 1; o < 64; o <<= 1) am = fmaxf(am, __shfl_xor(am, o));
                    sx[s] = am > 0.f ? am * (1.0f / 127.0f) : 1.0f; const float inv = 1.0f / sx[s];
#pragma unroll
                    for (int j = 0; j < 4; ++j) { const int a = (int)rintf(xf[4 * j] * inv), b = (int)rintf(xf[4 * j + 1] * inv), c = (int)rintf(xf[4 * j + 2] * inv), d = (int)rintf(xf[4 * j + 3] * inv);
                        xq[s][j] = (unsigned)(a & 255) | ((unsigned)(b & 255) << 8) | ((unsigned)(c & 255) << 16) | ((unsigned)(d & 255) << 24); } }
                int id[4][2]; float gg[4][2], su[4][2];
#pragma unroll
                for (int s = 0; s < 4; ++s) { const size_t m = (size_t)(m4 + s);
                    id[s][0] = EID[m * 128 + lane]; id[s][1] = EID[m * 128 + 64 + lane];
                    gg[s][0] = GATE[m * 128 + lane] * SV[id[s][0]]; gg[s][1] = GATE[m * 128 + 64 + lane] * SV[id[s][1]];
                    su[s][0] = SU[id[s][0]] * sx[s]; su[s][1] = SU[id[s][1]] * sx[s]; }
                int base = 0;
#pragma unroll 1
                for (int k = 0; k < 16; ++k) {
                    const int r = (rnd & 1) ? 15 - k : k;
#pragma unroll
                    for (int s = 0; s < 4; ++s) {
                        const int gstart = base;
#pragma unroll
                        for (int w = 0; w < 2; ++w) {
                            const bool hit = (id[s][w] >> 10) == r;
                            const u64 m = __ballot(hit);
                            if (hit) { const int pos = base + (int)__builtin_amdgcn_mbcnt_hi((unsigned)(m >> 32), __builtin_amdgcn_mbcnt_lo((unsigned)m, 0u));
                                ent[pos] = (unsigned)(mode == 4 ? (id[s][w] & 7) : id[s][w]); cf[pos] = gg[s][w]; sul[pos] = su[s][w]; }
                            base += __builtin_popcountll(m);
                        }
                        if (lane == 0) gi[k * 4 + s] = (unsigned)gstart | ((unsigned)(base - gstart) << 16);
                    }
                }
            }
            LDS_WAIT();
#define GI(g) ((unsigned)__builtin_amdgcn_readfirstlane((int)gi[(g)]))
#define SB() __builtin_amdgcn_sched_barrier(0)
            if (mode != 1 && mode != 3) {
                GBuf A, B;
                { const unsigned g0 = GI(0); grp_load(A, TU, ent, g0, 0, lane); grp_load(B, TU, ent, g0, 1, lane); }
#pragma unroll 1
                for (int k = 0; k < 16; ++k) {
                    const unsigned g0 = GI(k * 4), g1 = GI(k * 4 + 1), g2 = GI(k * 4 + 2), g3 = GI(k * 4 + 3), g4 = GI(k * 4 + 4);
                    grp_u(A, xq[0], cf, sul, g0, 0, lane); SB(); grp_load(A, TU, ent, g1, 0, lane); SB(); grp_u(B, xq[0], cf, sul, g0, 1, lane); SB(); grp_load(B, TU, ent, g1, 1, lane); SB();
                    grp_u(A, xq[1], cf, sul, g1, 0, lane); SB(); grp_load(A, TU, ent, g2, 0, lane); SB(); grp_u(B, xq[1], cf, sul, g1, 1, lane); SB(); grp_load(B, TU, ent, g2, 1, lane); SB();
                    grp_u(A, xq[2], cf, sul, g2, 0, lane); SB(); grp_load(A, TU, ent, g3, 0, lane); SB(); grp_u(B, xq[2], cf, sul, g2, 1, lane); SB(); grp_load(B, TU, ent, g3, 1, lane); SB();
                    grp_u(A, xq[3], cf, sul, g3, 0, lane); SB(); grp_load(A, TU, ent, g4, 0, lane); SB(); grp_u(B, xq[3], cf, sul, g3, 1, lane); SB(); grp_load(B, TU, ent, g4, 1, lane); SB();
                    grp_u_over(xq[0], TU, ent, cf, sul, g0, lane); grp_u_over(xq[1], TU, ent, cf, sul, g1, lane); grp_u_over(xq[2], TU, ent, cf, sul, g2, lane); grp_u_over(xq[3], TU, ent, cf, sul, g3, lane);
                }
            }
            LDS_WAIT();
            f32x2 outv[4][8];
#pragma unroll
            for (int s = 0; s < 4; ++s)
#pragma unroll
                for (int i = 0; i < 8; ++i) outv[s][i] = (f32x2){0.f, 0.f};
            if (mode != 1 && mode != 2) {
                GBuf A, B;
                { const unsigned g0 = GI(0); grp_load(A, TV, ent, g0, 0, lane); grp_load(B, TV, ent, g0, 1, lane); }
#pragma unroll 1
                for (int k = 0; k < 16; ++k) {
                    const unsigned g0 = GI(k * 4), g1 = GI(k * 4 + 1), g2 = GI(k * 4 + 2), g3 = GI(k * 4 + 3), g4 = GI(k * 4 + 4);
                    grp_v(A, outv[0], cf, g0, 0, lane); SB(); grp_load(A, TV, ent, g1, 0, lane); SB(); grp_v(B, outv[0], cf, g0, 1, lane); SB(); grp_load(B, TV, ent, g1, 1, lane); SB();
                    grp_v(A, outv[1], cf, g1, 0, lane); SB(); grp_load(A, TV, ent, g2, 0, lane); SB(); grp_v(B, outv[1], cf, g1, 1, lane); SB(); grp_load(B, TV, ent, g2, 1, lane); SB();
                    grp_v(A, outv[2], cf, g2, 0, lane); SB(); grp_load(A, TV, ent, g3, 0, lane); SB(); grp_v(B, outv[2], cf, g2, 1, lane); SB(); grp_load(B, TV, ent, g3, 1, lane); SB();
                    grp_v(A, outv[3], cf, g3, 0, lane); SB(); grp_load(A, TV, ent, g4, 0, lane); SB(); grp_v(B, outv[3], cf, g3, 1, lane); SB(); grp_load(B, TV, ent, g4, 1, lane); SB();
                    grp_v_over(outv[0], TV, ent, cf, g0, lane); grp_v_over(outv[1], TV, ent, cf, g1, lane); grp_v_over(outv[2], TV, ent, cf, g2, lane); grp_v_over(outv[3], TV, ent, cf, g3, lane);
                }
            }
#undef GI
#undef SB
#pragma unroll
            for (int s = 0; s < 4; ++s) {
                f32x4* o = (f32x4*)(xres + (size_t)(m4 + s) * 1024 + lane * 16);
#pragma unroll
                for (int j = 0; j < 4; ++j) { f32x4 a0 = o[j]; const f32x4 add = (f32x4){outv[s][2 * j].x, outv[s][2 * j].y, outv[s][2 * j + 1].x, outv[s][2 * j + 1].y};
                    if (oscale != 0.f) a0 += add; else asm volatile("" :: "v"(add)); o[j] = a0; }
            }
        }
        if (rnd + 1 < nrounds) xcd_barrier(xbar);
    }
}
constexpr size_t L1_QN = WS_R3;
constexpr size_t L1_KS = WS_R3 + 32 * MiB;
constexpr size_t L1_KW = WS_R3 + 40 * MiB;
constexpr size_t L1_VST = WS_R3 + 48 * MiB;
constexpr size_t L1_VWT = WS_R3 + 56 * MiB;
constexpr size_t L1_KCR = WS_R3 + 64 * MiB;
constexpr size_t L1_VCR = WS_R3 + 72 * MiB;
constexpr size_t L1_GATES = WS_R3 + 81 * MiB;
constexpr size_t L1_H1 = WS_R3 + 84 * MiB;
constexpr size_t L1_CMPO = WS_R3 + 88 * MiB;
constexpr size_t L1_KC = WS_R3 + 90 * MiB;
constexpr size_t L1_VCT = WS_R3 + 91 * MiB;
constexpr size_t L1_SELB = WS_R3 + 92 * MiB;
constexpr size_t L1_OC = WS_TABU;
constexpr size_t L1_CAT = WS_XN;
constexpr size_t L1_UPD = WS_R3;
constexpr size_t L1_DECAY = WS_R3 + 128 * MiB;

__device__ __forceinline__ void p_l1_prep(const Frame& F, const Args& a, unsigned char* ws) {
    const bf16_t* P = (const bf16_t*)(ws + WS_PROJ);
    const f32x2* rope = (const f32x2*)(ws + WS_ROPE);
    bf16_t* QN = (bf16_t*)(ws + L1_QN); bf16_t* KS = (bf16_t*)(ws + L1_KS); bf16_t* KW = (bf16_t*)(ws + L1_KW);
    bf16_t* KCR = (bf16_t*)(ws + L1_KCR); bf16_t* VCR = (bf16_t*)(ws + L1_VCR); float* GATES = (float*)(ws + L1_GATES);
    const int gw = F.bid * NWAVES + F.wave, NGW = F.G * NWAVES, lane = F.lane, hs = lane >> 3, sub = lane & 7;
    float qg[8], kg[8];
#pragma unroll
    for (int j = 0; j < 8; ++j) { qg[j] = a.in[I_L1_QG][sub * 8 + j]; kg[j] = a.in[I_L1_KG][sub * 8 + j]; }
    const int srccol = (hs < 2) ? C1_KS + hs * 64 : (hs < 4) ? C1_KW + (hs - 2) * 64 : (hs < 6) ? C1_KC + (hs - 4) * 64 : C1_VC + (hs - 6) * 64;
    bf16_t* dstbuf = (hs < 2) ? KS : (hs < 4) ? KW : (hs < 6) ? KCR : VCR;
    const int g2 = hs & 1;
    for (int m = gw; m < T; m += NGW) {
        const int b = m >> 12, t = m & 4095;
        const bf16_t* row = P + (size_t)m * N_IN1;
        f32x2 cs[8];
#pragma unroll
        for (int j = 0; j < 4; ++j) { const f32x4 c4 = *(const f32x4*)(rope + t * 32 + (sub & 3) * 8 + 2 * j); cs[2 * j] = (f32x2){c4.x, c4.y}; cs[2 * j + 1] = (f32x2){c4.z, c4.w}; }
        float v[8];
        head8_load(row + C1_Q + lane * 8, v); head8_norm(v, qg); head8_rope(v, cs, sub >= 4); head8_store(QN + (size_t)m * 512 + lane * 8, v, 0.125f);
        {
            const u32x4 raw = *(const u32x4*)(row + srccol + sub * 8);
            v[0] = bf_lo(raw.x); v[1] = bf_hi(raw.x); v[2] = bf_lo(raw.y); v[3] = bf_hi(raw.y); v[4] = bf_lo(raw.z); v[5] = bf_hi(raw.z); v[6] = bf_lo(raw.w); v[7] = bf_hi(raw.w);
            head8_norm(v, kg); head8_rope(v, cs, sub >= 4);
            u32x4 q; q.x = pk2(v[0], v[1]); q.y = pk2(v[2], v[3]); q.z = pk2(v[4], v[5]); q.w = pk2(v[6], v[7]);
            if (hs >= 4) q = raw;
            *(u32x4*)(dstbuf + ((size_t)(b * 2 + g2) * 4096 + t) * 64 + sub * 8) = q;
        }
        if (lane < 24) GATES[(size_t)m * 24 + lane] = sigmoidf_(bf2f(row[C1_GL + lane]));
    }
    for (int it = gw; it < 2 * NB * 2 * 64; it += NGW) {
        const int tb = it & 63, g = (it >> 6) & 1, b = (it >> 7) & 7, w = it >> 10;
        const size_t m = (size_t)b * 4096 + tb * 64 + lane;
        unsigned r[32];
#pragma unroll
        for (int j = 0; j < 8; ++j) { const u32x4 q = *(const u32x4*)(P + m * N_IN1 + (w ? C1_VW : C1_VS) + g * 64 + j * 8); r[4 * j] = q.x; r[4 * j + 1] = q.y; r[4 * j + 2] = q.z; r[4 * j + 3] = q.w; }
        bf16_t* dst = (bf16_t*)(ws + (w ? L1_VWT : L1_VST)) + ((size_t)(b * 2 + g) * 64) * 4096 + tb * 64 + lane;
#pragma unroll
        for (int d = 0; d < 64; ++d) dst[(size_t)d * 4096] = (bf16_t)((d & 1) ? (r[d >> 1] >> 16) : (r[d >> 1] & 0xffffu));
    }
}

namespace pg8 {
struct EpiCmp1 {
    static constexpr bool PERM = true;
    bf16_t* O; const float* bias;
    __device__ __forceinline__ void operator()(const f32x4 (&acc)[2][2][4][2], const Unit& u, int wr, int wc, int fr, int fq) const {
        const int row0 = u.pm * BM + wr * 64 + fr, col0 = wc * 32 + 8 * fq;
#pragma unroll
        for (int ai = 0; ai < 2; ++ai)
#pragma unroll
            for (int m = 0; m < 4; ++m) { bf16_t* rowp = O + (size_t)(row0 + ai * HALF + m * 16) * 256 + col0;
#pragma unroll
                for (int bj = 0; bj < 2; ++bj) { const float* bp = bias + u.pn * 256 + col0 + bj * HALF;
                    const f32x4 v0 = acc[ai][bj][m][0] + *(const f32x4*)bp, v1 = acc[ai][bj][m][1] + *(const f32x4*)(bp + 4);
                    u32x4 w; w.x = pk2(gelu_tanh(v0[0]), gelu_tanh(v0[1])); w.y = pk2(gelu_tanh(v0[2]), gelu_tanh(v0[3]));
                    w.z = pk2(gelu_tanh(v1[0]), gelu_tanh(v1[1])); w.w = pk2(gelu_tanh(v1[2]), gelu_tanh(v1[3]));
                    *(u32x4*)(rowp + bj * HALF) = w; }
                asm volatile("" ::: "memory"); __builtin_amdgcn_sched_barrier(0); }
    }
};
struct EpiCmp2 {
    static constexpr bool PERM = false;
    float* C;
    __device__ __forceinline__ void operator()(const f32x4 (&acc)[2][2][4][2], const Unit& u, int wr, int wc, int fr, int fq) const {
        if (wc >= 2) return;
        const int row0 = u.pm * BM + wr * 64 + fr, col0 = wc * 32 + 4 * fq;
#pragma unroll
        for (int ai = 0; ai < 2; ++ai)
#pragma unroll
            for (int m = 0; m < 4; ++m)
#pragma unroll
                for (int n = 0; n < 2; ++n) *(f32x4*)(C + (size_t)(row0 + ai * HALF + m * 16) * 64 + col0 + n * 16) = acc[ai][0][m][n];
    }
};
}

__device__ __forceinline__ void p_cmp_final(const Frame& F, const Args& a, unsigned char* ws) {
    const float* CMPO = (const float*)(ws + L1_CMPO); const f32x2* rope = (const f32x2*)(ws + WS_ROPE);
    bf16_t* KC = (bf16_t*)(ws + L1_KC); bf16_t* VCT = (bf16_t*)(ws + L1_VCT);
    const int gw = F.bid * NWAVES + F.wave, NGW = F.G * NWAVES, lane = F.lane;
    const float kg = a.in[I_L1_KG][lane];
    for (int r = gw; r < 8192; r += NGW) {
        float v = CMPO[(size_t)r * 64 + lane];
        const int rr = r & 4095, bg = rr >> 8, c = rr & 255;
        if (r < 4096) {
            const float ss = wave_sum(v * v);
            v = v * (1.0f / sqrtf(ss * (1.f / 64.f) + 1e-6f)) * kg;
            const int pos = (c < 255) ? 16 * c + 31 : 0;
            v = rope_apply(v, rope[pos * 32 + (lane & 31)], lane);
            KC[((size_t)bg * 256 + c) * 64 + lane] = (c < 255) ? (bf16_t)f2bf(v) : (bf16_t)0;
        } else {
            VCT[((size_t)bg * 64 + lane) * 256 + c] = (c < 255) ? (bf16_t)f2bf(v) : (bf16_t)0;
        }
    }
}

__device__ __forceinline__ void att_load2(AttStage& s, const bf16_t* Kg, const bf16_t* Vtg, int vstride, int key0, int tid) {
    s.kreg = *(const u32x4*)(Kg + (size_t)(key0 + (tid >> 3)) * 64 + (tid & 7) * 8);
    s.vreg = *(const u32x4*)(Vtg + (size_t)(tid >> 3) * vstride + key0 + (tid & 7) * 8);
}
__device__ __forceinline__ float score_bound_c2(const float* qg, const float* kg) {
    float mq = 0.f, mk_ = 0.f;
    for (int i = 0; i < 64; ++i) { mq = fmaxf(mq, fabsf(qg[i])); mk_ = fmaxf(mk_, fabsf(kg[i])); }
    return (8.0f * mq * mk_ + 0.5f) * 1.4426950408889634f;
}

__device__ __forceinline__ void p_cmp_attn(const Frame& F, const Args& a, unsigned char* ws) {
    const bf16_t* QN = (const bf16_t*)(ws + L1_QN); const bf16_t* KC = (const bf16_t*)(ws + L1_KC); const bf16_t* VCT = (const bf16_t*)(ws + L1_VCT);
    float* OC = (float*)(ws + L1_OC); u64* SELB = (u64*)(ws + L1_SELB);
    LAS float* impL = (LAS float*)(F.lds + 36864);
    const int lane = F.lane, wave = F.wave, h = lane >> 5, c = lane & 31, tid = F.tid;
    const float c2 = score_bound_c2(a.in[I_L1_QG], a.in[I_L1_KG]), c1 = 1.4426950408889634f;
    for (int u = F.bid; u < 1024; u += F.G) {
        const int b = (u >> 7) & 7, g = (u >> 6) & 1, rnd = u >> 8, qt = (rnd & 1) ? 63 - (u & 63) : (u & 63), q0 = qt * 64;
        const int bg = b * 2 + g; const size_t mb = (size_t)b * 4096;
        const int t = q0 + wave * 8 + (c >> 2), head = g * 4 + (c & 3);
        bf16x8 Qf[4];
#pragma unroll
        for (int ks = 0; ks < 4; ++ks) Qf[ks] = *(const bf16x8*)(QN + (mb + t) * 512 + head * 64 + ks * 16 + 8 * h);
        const int L = (t >= 31) ? (((t - 31) >> 4) < 254 ? ((t - 31) >> 4) : 254) : -1;
        const int tmax = q0 + 63; const int Lmax = (tmax >= 31) ? (((tmax - 31) >> 4) < 254 ? ((tmax - 31) >> 4) : 254) : -1;
        const int nkt = (Lmax >= 0) ? (Lmax >> 6) + 1 : 0;
        f32x16 O[2], IMP[2]; float l = 0.f;
#pragma unroll
        for (int i = 0; i < 16; ++i) { O[0][i] = 0.f; O[1][i] = 0.f; IMP[0][i] = 0.f; IMP[1][i] = 0.f; }
        const bf16_t* Kg = KC + (size_t)bg * 256 * 64; const bf16_t* Vtg = VCT + (size_t)bg * 64 * 256;
        __syncthreads();
        for (int kt = 0; kt < nkt; ++kt) {
            AttStage st; att_load2(st, Kg, Vtg, 256, kt * 64, tid);
            __syncthreads();
            att_store(st, F.lds, tid);
            __syncthreads();
#pragma unroll 1
            for (int sub = 0; sub < 2; ++sub) {
                const f32x16 S = att_qk(F.lds, sub, Qf, lane);
                float p[16];
#pragma unroll
                for (int i = 0; i < 16; ++i) {
                    const int cidx = kt * 64 + sub * 32 + (i & 3) + 8 * (i >> 2) + 4 * h;
                    const float e = __builtin_amdgcn_exp2f(S[i] * c1 - c2);
                    p[i] = (cidx <= L) ? e : 0.f; l += p[i];
                }
                const bf16x8 P0 = pack8(p[0], p[1], p[2], p[3], p[4], p[5], p[6], p[7]);
                const bf16x8 P1 = pack8(p[8], p[9], p[10], p[11], p[12], p[13], p[14], p[15]);
                att_pv2(F.lds, sub, P0, P1, O, lane);
#pragma unroll
                for (int jt = 0; jt < 2; ++jt)
#pragma unroll
                    for (int s = 0; s < 2; ++s) {
                        unsigned wv[4];
#pragma unroll
                        for (int e2 = 0; e2 < 4; ++e2) {
                            unsigned pr = 0u;
#pragma unroll
                            for (int q = 0; q < 2; ++q) { const int jj = 2 * e2 + q; const int kap = 16 * s + 8 * (jj >> 2) + 4 * h + (jj & 3);
                                const int off = kt * 64 + sub * 32 + kap - 4 * (32 * jt + c);
                                const unsigned wbits = (off == 0 || off == 4) ? 0x3F80u : ((off >= 1 && off <= 3) ? 0x4000u : 0u);
                                pr |= wbits << (16 * q); }
                            wv[e2] = pr;
                        }
                        const bf16x8 Wf = __builtin_bit_cast(bf16x8, ((u32x4){wv[0], wv[1], wv[2], wv[3]}));
                        IMP[jt] = __builtin_amdgcn_mfma_f32_32x32x16_bf16(Wf, s ? P1 : P0, IMP[jt], 0, 0, 0);
                    }
            }
        }
        const float lt = l + __shfl_xor(l, 32);
        const float inv = 1.0f / fmaxf(lt, 1e-30f);
        { float* orow = OC + (mb + t) * 512 + head * 64;
#pragma unroll
          for (int dt = 0; dt < 2; ++dt)
#pragma unroll
            for (int i4 = 0; i4 < 4; ++i4) { const int d = dt * 32 + 8 * i4 + 4 * h;
                *(f32x4*)(orow + d) = (f32x4){O[dt][4 * i4] * inv, O[dt][4 * i4 + 1] * inv, O[dt][4 * i4 + 2] * inv, O[dt][4 * i4 + 3] * inv}; } }
#pragma unroll
        for (int jt = 0; jt < 2; ++jt)
#pragma unroll
            for (int i = 0; i < 16; ++i) {
                float v = IMP[jt][i] * inv; v += __shfl_xor(v, 1); v += __shfl_xor(v, 2);
                if ((c & 3) == 0) impL[(wave * 8 + (c >> 2)) * 65 + 32 * jt + (i & 3) + 8 * (i >> 2) + 4 * h] = v;
            }
        __syncthreads();
        if (tid < 64) {
            const int tq = q0 + tid, cur = tq >> 6;
            u64 mask;
            if (cur + 1 <= 16) mask = (1ull << (cur + 1)) - 1ull;
            else {
                float v[64];
#pragma unroll
                for (int j = 0; j < 64; ++j) { const float x = impL[tid * 65 + j]; v[j] = (j > cur) ? -3.0e38f : ((j == 0 || j == cur) ? 1.0e9f : x); }
                mask = 0ull;
#pragma unroll 1
                for (int k = 0; k < 16; ++k) {
                    float best = -3.0e38f; int bi = 0;
#pragma unroll
                    for (int j = 0; j < 64; ++j) { const bool taken = (mask >> j) & 1ull; if (!taken && v[j] > best) { best = v[j]; bi = j; } }
                    mask |= 1ull << bi;
                }
            }
            SELB[(size_t)bg * 4096 + tq] = mask;
        }
        __syncthreads();
    }
}

__device__ __forceinline__ void p_nsa_attn(const Frame& F, const Args& a, unsigned char* ws) {
    const bf16_t* QN = (const bf16_t*)(ws + L1_QN);
    const u64* SELB = (const u64*)(ws + L1_SELB); float* OC = (float*)(ws + L1_OC); const float* GATES = (const float*)(ws + L1_GATES);
    bf16_t* CAT = (bf16_t*)(ws + L1_CAT);
    const int lane = F.lane, wave = F.wave, h = lane >> 5, c = lane & 31, tid = F.tid;
    const float c2 = score_bound_c2(a.in[I_L1_QG], a.in[I_L1_KG]), c1 = 1.4426950408889634f;
    for (int u = F.bid; u < 512; u += F.G) {
        const int idx = u & 255, g = u >> 8, b = idx >> 5, qtr = idx & 31, qt = g ? 31 - qtr : qtr, q0 = qt * 128;
        const int bg = b * 2 + g; const size_t mb = (size_t)b * 4096;
        bf16x8 Qf[2][4]; int qidx[2];
#pragma unroll
        for (int ct = 0; ct < 2; ++ct) { qidx[ct] = q0 + wave * 16 + ct * 8 + (c >> 2);
#pragma unroll
            for (int ks = 0; ks < 4; ++ks) Qf[ct][ks] = *(const bf16x8*)(QN + (mb + qidx[ct]) * 512 + (g * 4 + (c & 3)) * 64 + ks * 16 + 8 * h); }
        const int head = g * 4 + (c & 3);
#pragma unroll 1
        for (int pass = 0; pass < 2; ++pass) {
            const bf16_t* Kg = (const bf16_t*)(ws + (pass ? L1_KW : L1_KS)) + (size_t)bg * 4096 * 64;
            const bf16_t* Vtg = (const bf16_t*)(ws + (pass ? L1_VWT : L1_VST)) + (size_t)bg * 64 * 4096;
            u64 selw[2];
#pragma unroll
            for (int ct = 0; ct < 2; ++ct) selw[ct] = pass ? ~0ull : SELB[(size_t)bg * 4096 + qidx[ct]];
            const int wlen = pass ? 512 : 0x7fffffff;
            f32x16 O[2][2]; float l[2] = {0.f, 0.f};
#pragma unroll
            for (int ct = 0; ct < 2; ++ct)
#pragma unroll
                for (int dt = 0; dt < 2; ++dt)
#pragma unroll
                    for (int i = 0; i < 16; ++i) O[ct][dt][i] = 0.f;
            const int kt_lo = pass ? ((2 * qt - 8) > 0 ? 2 * qt - 8 : 0) : 0, kt_hi = 2 * qt + 2;
            AttStage st; att_load(st, Kg, Vtg, kt_lo * 64, tid);
            __syncthreads();
            att_store(st, F.lds + (kt_lo & 1) * AT_BUF, tid);
            __syncthreads();
            for (int kt = kt_lo; kt < kt_hi; ++kt) {
                LAS unsigned char* buf = F.lds + (kt & 1) * AT_BUF;
                if (kt + 1 < kt_hi) att_load(st, Kg, Vtg, (kt + 1) * 64, tid);
#pragma unroll 1
                for (int sub = 0; sub < 2; ++sub) {
#pragma unroll
                    for (int ct = 0; ct < 2; ++ct) {
                        __builtin_amdgcn_sched_barrier(0);
                        const f32x16 S = att_qk(buf, sub, Qf[ct], lane);
                        const bool flag = (selw[ct] >> kt) & 1ull;
                        const int tq = qidx[ct];
                        const float c2e = flag ? c2 : 3.0e30f;
                        float p[16];
                        const int dbase = tq - (kt * 64 + sub * 32 + 4 * h);
#pragma unroll
                        for (int i = 0; i < 16; ++i) {
                            const float e = __builtin_amdgcn_exp2f(S[i] * c1 - c2e);
                            p[i] = ((unsigned)(dbase - ((i & 3) + 8 * (i >> 2))) < (unsigned)wlen) ? e : 0.f; l[ct] += p[i];
                        }
                        const bf16x8 P0 = pack8(p[0], p[1], p[2], p[3], p[4], p[5], p[6], p[7]);
                        const bf16x8 P1 = pack8(p[8], p[9], p[10], p[11], p[12], p[13], p[14], p[15]);
                        att_pv2(buf, sub, P0, P1, O[ct], lane);
                    }
                }
                if (kt + 1 < kt_hi) att_store(st, F.lds + ((kt + 1) & 1) * AT_BUF, tid);
                __syncthreads();
            }
#pragma unroll
            for (int ct = 0; ct < 2; ++ct) {
                const float lt = l[ct] + __shfl_xor(l[ct], 32);
                const float inv = 1.0f / fmaxf(lt, 1e-30f);
                const size_t m = mb + qidx[ct];
                const float gcv = GATES[m * 24 + head * 3 + 0], gsv = GATES[m * 24 + head * 3 + 1], gwv = GATES[m * 24 + head * 3 + 2];
                float* orow = OC + m * 512 + head * 64; bf16_t* crow = CAT + m * 1024 + head * 64;
#pragma unroll
                for (int dt = 0; dt < 2; ++dt)
#pragma unroll
                    for (int i4 = 0; i4 < 4; ++i4) {
                        const int d = dt * 32 + 8 * i4 + 4 * h;
                        const f32x4 prev = *(const f32x4*)(orow + d);
                        const f32x4 ov = (f32x4){O[ct][dt][4 * i4] * inv, O[ct][dt][4 * i4 + 1] * inv, O[ct][dt][4 * i4 + 2] * inv, O[ct][dt][4 * i4 + 3] * inv};
                        if (pass == 0) *(f32x4*)(orow + d) = prev * gcv + ov * gsv;
                        else { const f32x4 r = prev + ov * gwv; u32x2 w; w.x = pk2(r[0], r[1]); w.y = pk2(r[2], r[3]); *(u32x2*)(crow + d) = w; }
                    }
            }
        }
    }
}

__device__ __forceinline__ float logsigmoidf_(float x) { return fminf(x, 0.f) - log1pf(__expf(-fabsf(x))); }
__device__ __forceinline__ bf16x8 frag_lds(const LAS float* p) { const f32x4 a = *(const LAS f32x4*)p, b = *(const LAS f32x4*)(p + 4); return pack8(a[0], a[1], a[2], a[3], b[0], b[1], b[2], b[3]); }
__device__ __forceinline__ bf16x8 frag_glb(const float* p) { const f32x4 a = *(const f32x4*)p, b = *(const f32x4*)(p + 4); return pack8(a[0], a[1], a[2], a[3], b[0], b[1], b[2], b[3]); }
struct GlaRaw { u32x4 ga[4], gb[4]; unsigned short k[4], q[4], v8[8]; };
template <bool WITHQ>
__device__ __forceinline__ void gla_fetch(GlaRaw& R, const Frame& F, const bf16_t* P, size_t m0, int hh) {
    const int dk = F.tid & 63, cq = F.tid >> 6, dv = F.tid & 127, cv = F.tid >> 7;
#pragma unroll
    for (int i = 0; i < 4; ++i) { const bf16_t* row = P + (m0 + 4 * cq + i) * N_IN1;
        R.ga[i] = *(const u32x4*)(row + C1_GLOW); R.gb[i] = *(const u32x4*)(row + C1_GLOW + 8);
        R.k[i] = row[C1_GK + hh * 64 + dk]; if (WITHQ) R.q[i] = row[C1_GQ + hh * 64 + dk]; }
#pragma unroll
    for (int i = 0; i < 8; ++i) R.v8[i] = P[(m0 + 8 * cv + i) * N_IN1 + C1_GV + hh * 128 + dv];
}
__device__ __forceinline__ void gla_bcum3(const Frame& F, const GlaRaw& R, const float (&wg)[16], const float bgv, LAS float* seg, float (&bc)[4], float& blast) {
    const int dk = F.tid & 63, cq = F.tid >> 6;
    float run = 0.f;
#pragma unroll
    for (int i = 0; i < 4; ++i) {
        const u32x4 ga = R.ga[i], gb = R.gb[i];
        float acc = bgv;
        acc += wg[0] * bf_lo(ga.x); acc += wg[1] * bf_hi(ga.x); acc += wg[2] * bf_lo(ga.y); acc += wg[3] * bf_hi(ga.y); acc += wg[4] * bf_lo(ga.z); acc += wg[5] * bf_hi(ga.z); acc += wg[6] * bf_lo(ga.w); acc += wg[7] * bf_hi(ga.w);
        acc += wg[8] * bf_lo(gb.x); acc += wg[9] * bf_hi(gb.x); acc += wg[10] * bf_lo(gb.y); acc += wg[11] * bf_hi(gb.y); acc += wg[12] * bf_lo(gb.z); acc += wg[13] * bf_hi(gb.z); acc += wg[14] * bf_lo(gb.w); acc += wg[15] * bf_hi(gb.w);
        run += logsigmoidf_(acc) * 0.0625f; bc[i] = run;
    }
    seg[cq * 64 + dk] = run;
    __syncthreads();
    float off = 0.f, tot = 0.f;
#pragma unroll
    for (int q = 0; q < 8; ++q) { const float sv = seg[q * 64 + dk]; tot += sv; off += (q < cq) ? sv : 0.f; }
#pragma unroll
    for (int i = 0; i < 4; ++i) bc[i] += off;
    blast = tot;
}
__device__ __forceinline__ void gla_put_vT(const Frame& F, const GlaRaw& R, LAS float* vT) {
    const int dv = F.tid & 127, cv = F.tid >> 7;
    *(LAS f32x4*)(vT + dv * 36 + 8 * cv) = (f32x4){bf2f(R.v8[0]), bf2f(R.v8[1]), bf2f(R.v8[2]), bf2f(R.v8[3])};
    *(LAS f32x4*)(vT + dv * 36 + 8 * cv + 4) = (f32x4){bf2f(R.v8[4]), bf2f(R.v8[5]), bf2f(R.v8[6]), bf2f(R.v8[7])};
}
__device__ __forceinline__ void p_gla_a(const Frame& F, const Args& a, unsigned char* ws) {
    const bf16_t* P = (const bf16_t*)(ws + WS_PROJ); float* UPD = (float*)(ws + L1_UPD); float* DECAY = (float*)(ws + L1_DECAY);
    LAS float* seg = (LAS float*)F.lds; LAS float* kdT = seg + 512; LAS float* vT = kdT + 64 * 36;
    const int tid = F.tid, lane = F.lane, wave = F.wave, r = lane & 31, h = lane >> 5;
    const int UPW = (4096 + F.G - 1) / F.G, u0 = F.bid * UPW, u1 = (u0 + UPW < 4096) ? u0 + UPW : 4096;
    if (u0 >= u1) return;
    GlaRaw R; gla_fetch<false>(R, F, P, (size_t)(u0 >> 9) * 4096 + (u0 & 127) * 32, (u0 >> 7) & 3);
    for (int u = u0; u < u1; ++u) {
        const int hh = (u >> 7) & 3;
        float wg[16];
#pragma unroll
        for (int q = 0; q < 16; ++q) wg[q] = a.in[I_L1_WGATE][q * 256 + hh * 64 + (tid & 63)];
        const float bgv = a.in[I_L1_BGATE][hh * 64 + (tid & 63)];
        float bc[4], blast;
        gla_bcum3(F, R, wg, bgv, seg, bc, blast);
        { const int dk = tid & 63, cq = tid >> 6;
          *(LAS f32x4*)(kdT + dk * 36 + 4 * cq) = (f32x4){bf2f(R.k[0]) * __expf(blast - bc[0]), bf2f(R.k[1]) * __expf(blast - bc[1]), bf2f(R.k[2]) * __expf(blast - bc[2]), bf2f(R.k[3]) * __expf(blast - bc[3])};
          if (cq == 0) DECAY[(size_t)u * 64 + dk] = __expf(blast); }
        gla_put_vT(F, R, vT);
        if (u + 1 < u1) { const int un = u + 1; gla_fetch<false>(R, F, P, (size_t)(un >> 9) * 4096 + (un & 127) * 32, (un >> 7) & 3); }
        __syncthreads();
        {
            const int mt = wave >> 1, nt = wave & 1;
            f32x16 acc = {0.f, 0.f, 0.f, 0.f, 0.f, 0.f, 0.f, 0.f, 0.f, 0.f, 0.f, 0.f, 0.f, 0.f, 0.f, 0.f};
#pragma unroll
            for (int ks = 0; ks < 2; ++ks) acc = __builtin_amdgcn_mfma_f32_32x32x16_bf16(frag_lds(vT + (32 * mt + r) * 36 + 16 * ks + 8 * h), frag_lds(kdT + (32 * nt + r) * 36 + 16 * ks + 8 * h), acc, 0, 0, 0);
            float* up = UPD + (size_t)u * 8192 + 32 * nt + r;
#pragma unroll
            for (int i = 0; i < 16; ++i) up[(size_t)(32 * mt + (i & 3) + 8 * (i >> 2) + 4 * h) * 64] = acc[i];
        }
        __syncthreads();
    }
}
__device__ __forceinline__ void p_gla_b(const Frame& F, unsigned char* ws) {
    float* UPD = (float*)(ws + L1_UPD); const float* DECAY = (const float*)(ws + L1_DECAY);
    for (int e = F.bid * NTHREADS + F.tid; e < 32 * 8192; e += F.G * NTHREADS) {
        const int bh = e >> 13, rem = e & 8191, dk = rem & 63;
        float state = 0.f;
        float* up = UPD + (size_t)bh * 128 * 8192 + rem; const float* dp = DECAY + (size_t)bh * 128 * 64 + dk;
#pragma unroll 8
        for (int n = 0; n < 128; ++n) { const float uv = up[(size_t)n * 8192], dc = dp[n * 64]; up[(size_t)n * 8192] = state; state = dc * state + uv; }
    }
}
__device__ __forceinline__ void p_gla_c(const Frame& F, const Args& a, unsigned char* ws) {
    const bf16_t* P = (const bf16_t*)(ws + WS_PROJ); const float* PREV = (const float*)(ws + L1_UPD); bf16_t* CAT = (bf16_t*)(ws + L1_CAT);
    LAS float* seg = (LAS float*)F.lds; LAS float* qd = seg + 512; LAS float* ki = qd + 32 * 68; LAS float* vT = ki + 32 * 68; LAS float* att = vT + 128 * 36; LAS float* red = att + 32 * 36;
    const int tid = F.tid, lane = F.lane, wave = F.wave, r = lane & 31, h = lane >> 5;
    const int UPW = (4096 + F.G - 1) / F.G, u0 = F.bid * UPW, u1 = (u0 + UPW < 4096) ? u0 + UPW : 4096;
    if (u0 >= u1) return;
    GlaRaw R; gla_fetch<true>(R, F, P, (size_t)(u0 >> 9) * 4096 + (u0 & 127) * 32, (u0 >> 7) & 3);
    for (int u = u0; u < u1; ++u) {
        const int b = u >> 9, hh = (u >> 7) & 3, n = u & 127; const size_t m0 = (size_t)b * 4096 + n * 32;
        bf16x8 pf[4]; unsigned short rv16[16];
        if (wave < 4) {
            const float* pp = PREV + (size_t)u * 8192 + (size_t)(32 * wave + r) * 64;
#pragma unroll
            for (int ks = 0; ks < 4; ++ks) pf[ks] = frag_glb(pp + 16 * ks + 8 * h);
#pragma unroll
            for (int i = 0; i < 16; ++i) rv16[i] = P[(m0 + (i & 3) + 8 * (i >> 2) + 4 * h) * N_IN1 + C1_GR + hh * 128 + 32 * wave + r];
        }
        float wg[16];
#pragma unroll
        for (int q = 0; q < 16; ++q) wg[q] = a.in[I_L1_WGATE][q * 256 + hh * 64 + (tid & 63)];
        const float bgv = a.in[I_L1_BGATE][hh * 64 + (tid & 63)];
        float bc[4], blast;
        gla_bcum3(F, R, wg, bgv, seg, bc, blast);
        { const int dk = tid & 63, cq = tid >> 6;
#pragma unroll
          for (int i = 0; i < 4; ++i) { ki[(4 * cq + i) * 68 + dk] = bf2f(R.k[i]) * __expf(-bc[i]); qd[(4 * cq + i) * 68 + dk] = bf2f(R.q[i]) * 0.125f * __expf(bc[i]); } }
        gla_put_vT(F, R, vT);
        if (u + 1 < u1) { const int un = u + 1; gla_fetch<true>(R, F, P, (size_t)(un >> 9) * 4096 + (un & 127) * 32, (un >> 7) & 3); }
        __syncthreads();
        f32x16 acc = {0.f, 0.f, 0.f, 0.f, 0.f, 0.f, 0.f, 0.f, 0.f, 0.f, 0.f, 0.f, 0.f, 0.f, 0.f, 0.f};
        if (wave == 4) {
            f32x16 at = {0.f, 0.f, 0.f, 0.f, 0.f, 0.f, 0.f, 0.f, 0.f, 0.f, 0.f, 0.f, 0.f, 0.f, 0.f, 0.f};
#pragma unroll
            for (int ks = 0; ks < 4; ++ks) at = __builtin_amdgcn_mfma_f32_32x32x16_bf16(frag_lds(qd + r * 68 + 16 * ks + 8 * h), frag_lds(ki + r * 68 + 16 * ks + 8 * h), at, 0, 0, 0);
#pragma unroll
            for (int i = 0; i < 16; ++i) { const int c = (i & 3) + 8 * (i >> 2) + 4 * h; att[c * 36 + r] = (r <= c) ? at[i] : 0.f; }
        } else if (wave < 4) {
#pragma unroll
            for (int ks = 0; ks < 4; ++ks) acc = __builtin_amdgcn_mfma_f32_32x32x16_bf16(frag_lds(qd + r * 68 + 16 * ks + 8 * h), pf[ks], acc, 0, 0, 0);
        }
        __syncthreads();
        if (wave < 4) {
#pragma unroll
            for (int ks = 0; ks < 2; ++ks) acc = __builtin_amdgcn_mfma_f32_32x32x16_bf16(frag_lds(att + r * 36 + 16 * ks + 8 * h), frag_lds(vT + (32 * wave + r) * 36 + 16 * ks + 8 * h), acc, 0, 0, 0);
#pragma unroll
            for (int i = 0; i < 16; ++i) { float ss = acc[i] * acc[i];
                ss += __shfl_xor(ss, 1); ss += __shfl_xor(ss, 2); ss += __shfl_xor(ss, 4); ss += __shfl_xor(ss, 8); ss += __shfl_xor(ss, 16);
                if (r == 0) red[wave * 32 + (i & 3) + 8 * (i >> 2) + 4 * h] = ss; }
        }
        __syncthreads();
        if (wave < 4) {
            const int dv = 32 * wave + r; const float og = a.in[I_L1_OGAIN][dv];
#pragma unroll
            for (int i = 0; i < 16; ++i) { const int c = (i & 3) + 8 * (i >> 2) + 4 * h;
                const float tot = red[c] + red[32 + c] + red[64 + c] + red[96 + c];
                const float rstd = 1.0f / sqrtf(tot * (1.f / 128.f) + 1e-6f);
                const float rv = bf2f(rv16[i]);
                CAT[(m0 + c) * 1024 + 512 + hh * 128 + dv] = (bf16_t)f2bf(acc[i] * rstd * og * rv * sigmoidf_(rv)); }
        }
        __syncthreads();
    }
}
__global__ void __launch_bounds__(NTHREADS, 2) mk_fwd(Args args) {
    extern __shared__ __attribute__((aligned(16))) unsigned char lds_raw[];
    cg::grid_group grid = cg::this_grid();
    Frame F; F.lds = (LAS unsigned char*)lds_raw; F.tid = threadIdx.x; F.lane = F.tid & 63; F.wave = __builtin_amdgcn_readfirstlane(F.tid >> 6); F.G = gridDim.x; F.bid = blockIdx.x;
    unsigned char* ws = args.ws;
    const int lo = args.ph_lo, hi = args.ph_hi;
#ifndef KEEPMASK
#define KEEPMASK 0xFFFFFFFFu
#endif
#define IN(k) (((KEEPMASK >> (k)) & 1u) && lo <= (k) && (k) < hi)
#define BOTH(k) (IN(k) && IN((k) + 1))
#ifndef TMODE
#define TMODE 0
#endif
#ifndef REPMASK
#define REPMASK 0u
#endif
#define PH(k, ...) if (IN(k)) { { const int rep = 0; (void)rep; __VA_ARGS__; } if ((REPMASK >> (k)) & 1u) { xcd_barrier(xbar); { const int rep = 1; (void)rep; __VA_ARGS__; } } }
#ifdef TS_A
#define STAMP(k) do { if (F.bid == 0 && F.tid == 0) ((unsigned long long*)(ws + WS_CTL + 65536))[(k)] = __builtin_amdgcn_s_memrealtime(); } while (0)
#else
#define STAMP(k) do { } while (0)
#endif
#define GRID_BAR(k) do { if (BOTH(k)) { if ((k) == 0) grid.sync(); else xcd_barrier(xbar); } STAMP((k) + 1); } while (0)
    const float* x = args.in[I_X];
    float* out = args.out;
    volatile LAS unsigned* xst = (volatile LAS unsigned*)(F.lds + LDS_BYTES - 64);
    if (F.tid < 16) xst[F.tid] = 0u;
    __syncthreads();
    XcdBarrier xbar = xcd_barrier_post((unsigned*)(ws + WS_CTL) + 4096, xst);

    STAMP(0);
    PH(0, int base = 0; transpose_all(F, base, args.in[I_L0_WIN], 1024, 1864, (bf16_t*)(ws + WS_W_IN0), 1024, MapIn0()); transpose_all(F, base, args.in[I_L0_WGLU], 512, 512, (bf16_t*)(ws + WS_W_GLU), 512, MapId()); transpose_all(F, base, args.in[I_L0_WOUT], 1024, 1024, (bf16_t*)(ws + WS_W_OUT0), 1024, MapId()); transpose_all(F, base, args.in[I_L0_WQ], 1024, 2048, (bf16_t*)(ws + WS_WQ0), 1024, MapId()); transpose_all(F, base, args.in[I_L1_WIN], 1024, 2856, (bf16_t*)(ws + WS_W_IN1), 1024, MapIn1()); transpose_all(F, base, args.in[I_L1_KW1], 2048, 256, (bf16_t*)(ws + WS_KW1), 2048, MapId()); transpose_all(F, base, args.in[I_L1_VW1], 2048, 256, (bf16_t*)(ws + WS_VW1), 2048, MapId()); transpose_all(F, base, args.in[I_L1_KW2], 256, 64, (bf16_t*)(ws + WS_KW2), 256, MapId()); transpose_all(F, base, args.in[I_L1_VW2], 256, 64, (bf16_t*)(ws + WS_VW2), 256, MapId()); transpose_all(F, base, args.in[I_L1_WOUT], 1024, 1024, (bf16_t*)(ws + WS_W_OUT1), 1024, MapId()); transpose_all(F, base, args.in[I_L1_WQ], 1024, 2048, (bf16_t*)(ws + WS_WQ1), 1024, MapId()); zero_bytes(F, ws + WS_W_IN0 + (size_t)1864 * 1024 * 2, (size_t)(2048 - 1864) * 1024 * 2); zero_bytes(F, ws + WS_W_IN1 + (size_t)2856 * 1024 * 2, (size_t)(3072 - 2856) * 1024 * 2); zero_bytes(F, ws + WS_KW2 + (size_t)64 * 256 * 2, (size_t)192 * 256 * 2); zero_bytes(F, ws + WS_VW2 + (size_t)64 * 256 * 2, (size_t)192 * 256 * 2); cvt_f32_bf16(F, args.in[I_L0_SK], (bf16_t*)(ws + WS_SK0), (size_t)16 * 128 * 128); cvt_f32_bf16(F, args.in[I_L1_SK], (bf16_t*)(ws + WS_SK1), (size_t)16 * 128 * 128); cvt_table_i8(F, args.in[I_L0_U], ws + WS_TAB8U, (float*)(ws + WS_TABSU)); cvt_table_fp8(F, args.in[I_L0_V], ws + WS_TAB8V, (float*)(ws + WS_TABSV)); p_rope_table(F, (f32x2*)(ws + WS_ROPE)); __syncthreads(); for (int g = F.bid; g < 32; g += F.G) s5_build_group(F, args, ws, g); for (int j = (F.bid + F.G - (32 % F.G)) % F.G; j < 64; j += F.G) cmp_bias(F, args, (float*)(ws + WS_CMPB), j); p_rmsnorm(F, x, args.in[I_L0_MIXN], (bf16_t*)(ws + WS_XN));)
    GRID_BAR(0);
    PH(1, pg8::Gemm g{(const bf16_t*)(ws + WS_XN), (const bf16_t*)(ws + WS_W_IN0), T, N_IN0, 1024, 1024, 1024}; pg8::StaticOrder S; S.init(T, N_IN0, F.G, F.bid); pg8::EpiStoreBf16 E{(bf16_t*)(ws + WS_PROJ), N_IN0}; pg8::gemm_phase(F.lds, g, S, E);)
    GRID_BAR(1);
    PH(2, p_l0_prep(F, args, ws);)
    GRID_BAR(2);
    PH(3, p_dsa_index(F, ws);)
    GRID_BAR(3);
    PH(4, p_dsa_attn(F, args, ws);)
    GRID_BAR(4);
    PH(5, pg8::Gemm g{(const bf16_t*)(ws + L0_UA), (const bf16_t*)(ws + WS_S5B1), 65536, 8192, 256, 384, 256}; pg8::GroupedOrder S; S.init(256, 8, F.G, F.bid); pg8::EpiS5State E{(float*)(ws + L0_SLOC)}; pg8::gemm_phase(F.lds, g, S, E);)
    GRID_BAR(5);
    PH(6, p_s5_scan(F, args, ws);)
    GRID_BAR(6);
    PH(7, pg8::Gemm g{(const bf16_t*)(ws + L0_UA), (const bf16_t*)(ws + WS_S5B2), 65536, 8192, 384, 384, 384}; pg8::GroupedOrder S; S.init(256, 8, F.G, F.bid); pg8::EpiS5Out E{(bf16_t*)(ws + L0_YB)}; pg8::gemm_phase(F.lds, g, S, E);)
    GRID_BAR(7);
    PH(8, pg8::Gemm g{(const bf16_t*)(ws + L0_YB), (const bf16_t*)(ws + WS_W_GLU), T, 512, 512, 512, 512}; pg8::StaticOrder S; S.init(T, 512, F.G, F.bid); pg8::EpiGlu E{(const bf16_t*)(ws + L0_YB), args.in[I_L0_BGLU], (bf16_t*)(ws + L0_CAT)}; pg8::gemm_phase(F.lds, g, S, E);)
    GRID_BAR(8);
    PH(9, pg8::Gemm g{(const bf16_t*)(ws + L0_CAT), (const bf16_t*)(ws + WS_W_OUT0), T, 1024, 1024, 1024, 1024}; pg8::StaticOrder S; S.init(T, 1024, F.G, F.bid); pg8::EpiResidF32 E{x, out, 1024}; pg8::gemm_phase(F.lds, g, S, E);)
    GRID_BAR(9);
    PH(10, p_rmsnorm(F, out, args.in[I_L0_FFNN], (bf16_t*)(ws + WS_XN));)
    GRID_BAR(10);
    PH(11, pg8::Gemm g{(const bf16_t*)(ws + WS_XN), (const bf16_t*)(ws + WS_WQ0), T, 2048, 1024, 1024, 1024}; pg8::StaticOrder S; S.init(T, 2048, F.G, F.bid); pg8::EpiStoreBf16 E{(bf16_t*)(ws + PE_Q2), 2048}; pg8::gemm_phase(F.lds, g, S, E);)
    GRID_BAR(11);
    PH(12, p_peer_route(F, ws, (const bf16_t*)(ws + WS_SK0));)
    GRID_BAR(12);
    PH(13, p_peer_expert5(F, ws, out, rep ? 0.f : 1.f, xbar, rep ? TMODE : 0);)
    GRID_BAR(13);
    PH(14, p_rmsnorm(F, out, args.in[I_L1_MIXN], (bf16_t*)(ws + WS_XN));)
    GRID_BAR(14);
    PH(15, pg8::Gemm g{(const bf16_t*)(ws + WS_XN), (const bf16_t*)(ws + WS_W_IN1), T, N_IN1, 1024, 1024, 1024}; pg8::StaticOrder S; S.init(T, N_IN1, F.G, F.bid); pg8::EpiStoreBf16 E{(bf16_t*)(ws + WS_PROJ), N_IN1}; pg8::gemm_phase(F.lds, g, S, E);)
    GRID_BAR(15);
    PH(16, p_l1_prep(F, args, ws);)
    GRID_BAR(16);
    PH(17, pg8::Gemm g{(const bf16_t*)(ws + L1_KCR), (const bf16_t*)(ws + WS_KW1), 8192, 512, 2048, 1024, 2048}; pg8::GroupedOrder S; S.init(32, 16, F.G, F.bid); pg8::EpiCmp1 E{(bf16_t*)(ws + L1_H1), (const float*)(ws + WS_CMPB)}; pg8::gemm_phase(F.lds, g, S, E);)
    GRID_BAR(17);
    PH(18, pg8::Gemm g{(const bf16_t*)(ws + L1_H1), (const bf16_t*)(ws + WS_KW2), 8192, 512, 256, 256, 256}; pg8::GroupedOrder S; S.init(32, 16, F.G, F.bid); pg8::EpiCmp2 E{(float*)(ws + L1_CMPO)}; pg8::gemm_phase(F.lds, g, S, E);)
    GRID_BAR(18);
    PH(19, p_cmp_final(F, args, ws);)
    GRID_BAR(19);
    PH(20, p_cmp_attn(F, args, ws);)
    GRID_BAR(20);
    PH(21, if (rep) { p_cmp_attn(F, args, ws); xcd_barrier(xbar); } p_nsa_attn(F, args, ws);)
    GRID_BAR(21);
    PH(22, p_gla_a(F, args, ws); cvt_table_i8(F, args.in[I_L1_U], ws + WS_TAB8U, (float*)(ws + WS_TABSU)); cvt_table_fp8(F, args.in[I_L1_V], ws + WS_TAB8V, (float*)(ws + WS_TABSV));)
    GRID_BAR(22);
    PH(23, if (rep) { p_gla_a(F, args, ws); xcd_barrier(xbar); } p_gla_b(F, ws);)
    GRID_BAR(23);
    PH(24, p_gla_c(F, args, ws);)
    GRID_BAR(24);
    PH(25, pg8::Gemm g{(const bf16_t*)(ws + L1_CAT), (const bf16_t*)(ws + WS_W_OUT1), T, 1024, 1024, 1024, 1024}; pg8::StaticOrder S; S.init(T, 1024, F.G, F.bid); pg8::EpiResidF32 E{out, out, 1024}; pg8::gemm_phase(F.lds, g, S, E);)
    GRID_BAR(25);
    PH(26, p_rmsnorm(F, out, args.in[I_L1_FFNN], (bf16_t*)(ws + WS_XN));)
    GRID_BAR(26);
    PH(27, pg8::Gemm g{(const bf16_t*)(ws + WS_XN), (const bf16_t*)(ws + WS_WQ1), T, 2048, 1024, 1024, 1024}; pg8::StaticOrder S; S.init(T, 2048, F.G, F.bid); pg8::EpiStoreBf16 E{(bf16_t*)(ws + PE_Q2), 2048}; pg8::gemm_phase(F.lds, g, S, E);)
    GRID_BAR(27);
    PH(28, p_peer_route(F, ws, (const bf16_t*)(ws + WS_SK1));)
    GRID_BAR(28);
    PH(29, p_peer_expert5(F, ws, out, rep ? 0.f : 1.f, xbar, rep ? TMODE : 0);)
#undef IN
#undef BOTH
}

extern "C" void kernel_launch(void* const* d_in, const int* in_sizes, int n_in, void* d_out, int out_size, void* d_ws, size_t ws_size, hipStream_t stream) {
    static int grid = 0;
    if (grid == 0) {
        if (n_in != 39 || ws_size < WS_END) { fprintf(stderr, "kernel_launch: unexpected n_in %d or ws_size %zu (< %zu)\n", n_in, ws_size, (size_t)WS_END); grid = -1; return; }
        int dev = 0, cus = 0, per_cu = 0;
        (void)hipGetDevice(&dev); (void)hipDeviceGetAttribute(&cus, hipDeviceAttributeMultiprocessorCount, dev);
        if (hipFuncSetAttribute((const void*)mk_fwd, hipFuncAttributeMaxDynamicSharedMemorySize, LDS_BYTES) != hipSuccess) { fprintf(stderr, "kernel_launch: hipFuncSetAttribute failed\n"); grid = -1; return; }
        if (hipOccupancyMaxActiveBlocksPerMultiprocessor(&per_cu, (const void*)mk_fwd, NTHREADS, LDS_BYTES) != hipSuccess || per_cu < 1) { fprintf(stderr, "kernel_launch: occupancy query failed (%d)\n", per_cu); (void)hipGetLastError(); grid = -1; return; }
        grid = cus;
    }
    if (grid < 0) return;
    (void)hipMemsetAsync((char*)d_ws + WS_CTL, 0, 1 * MiB, stream);
    Args a{};
    for (int i = 0; i < 39; ++i) a.in[i] = (const float*)d_in[i];
    a.out = (float*)d_out; a.ws = (unsigned char*)d_ws; a.ph_lo = 0; a.ph_hi = 1000;
    void* kargs[] = {&a};
    hipError_t e = hipLaunchCooperativeKernel((const void*)mk_fwd, dim3(grid), dim3(NTHREADS), kargs, LDS_BYTES, stream);
    if (e != hipSuccess) fprintf(stderr, "kernel_launch: cooperative launch failed: %s\n", hipGetErrorString(e));
}
```

```cpp
#include <hip/hip_runtime.h>
#include <hip/hip_cooperative_groups.h>
#include <cstdio>
#include <cstdint>
namespace cg = cooperative_groups;

#define LAS __attribute__((address_space(3)))
typedef unsigned short bf16_t;
typedef short bf16x8 __attribute__((ext_vector_type(8)));
typedef float f32x4 __attribute__((ext_vector_type(4)));
typedef float f32x2 __attribute__((ext_vector_type(2)));
typedef float f32x16 __attribute__((ext_vector_type(16)));
typedef unsigned u32x4 __attribute__((ext_vector_type(4)));
typedef unsigned u32x2 __attribute__((ext_vector_type(2)));
typedef unsigned long long u64;

constexpr int NB = 8, SEQ = 4096, DM = 1024, T = NB * SEQ;
constexpr int NTHREADS = 512, NWAVES = 8;
constexpr int LDS_BYTES = 147456;
constexpr int N_IN0 = 2048, N_IN1 = 3072;
constexpr int C0_Q = 0, C0_K = 512, C0_V = 640, C0_IQ = 768, C0_U = 1280, C0_IK = 1792, C0_IW = 1856;
constexpr int C1_Q = 0, C1_KC = 512, C1_VC = 640, C1_KS = 768, C1_VS = 896, C1_KW = 1024, C1_VW = 1152, C1_GQ = 1280, C1_GK = 1536, C1_GV = 1792, C1_GR = 2304, C1_GL = 2816, C1_GLOW = 2840;

constexpr size_t MiB = 1u << 20;
constexpr size_t WS_CTL = 0;
constexpr size_t WS_ROPE = 1 * MiB;
constexpr size_t WS_W_IN0 = 2 * MiB;
constexpr size_t WS_W_GLU = 6 * MiB;
constexpr size_t WS_SK0 = 6 * MiB + 512 * 1024;
constexpr size_t WS_W_OUT0 = 7 * MiB;
constexpr size_t WS_WQ0 = 9 * MiB;
constexpr size_t WS_W_IN1 = 13 * MiB;
constexpr size_t WS_KW1 = 19 * MiB;
constexpr size_t WS_VW1 = 20 * MiB;
constexpr size_t WS_KW2 = 21 * MiB;
constexpr size_t WS_VW2 = 21 * MiB + 128 * 1024;
constexpr size_t WS_SK1 = 21 * MiB + 512 * 1024;
constexpr size_t WS_W_OUT1 = 22 * MiB;
constexpr size_t WS_WQ1 = 24 * MiB;
constexpr size_t WS_S5B1 = 28 * MiB;
constexpr size_t WS_S5B2 = 32 * MiB;
constexpr size_t WS_CMPB = 38 * MiB;
constexpr size_t WS_TABU = 48 * MiB;
constexpr size_t WS_TABV = 80 * MiB;
constexpr size_t WS_XN = 112 * MiB;
constexpr size_t WS_PROJ = 176 * MiB;
constexpr size_t WS_R3 = 368 * MiB;
constexpr size_t WS_END = 506 * MiB;

__device__ __forceinline__ unsigned f2bf(float f) { unsigned u = __builtin_bit_cast(unsigned, f); return (u + 0x7fffu + ((u >> 16) & 1u)) >> 16; }
__device__ __forceinline__ unsigned pk2(float lo, float hi) { return f2bf(lo) | (f2bf(hi) << 16); }
__device__ __forceinline__ float bf_lo(unsigned u) { return __builtin_bit_cast(float, u << 16); }
__device__ __forceinline__ float bf_hi(unsigned u) { return __builtin_bit_cast(float, u & 0xffff0000u); }
__device__ __forceinline__ float bf2f(bf16_t b) { return __builtin_bit_cast(float, ((unsigned)b) << 16); }
__device__ __forceinline__ float wave_sum(float v) {
#pragma unroll
    for (int o = 1; o < 64; o <<= 1) v += __shfl_xor(v, o);
    return v;
}
__device__ __forceinline__ float gelu_tanh(float x) {
    const float y = 0.7978845608028654f * (x + 0.044715f * x * x * x);
    const float e = __expf(2.0f * y);
    const float th = 1.0f - 2.0f / (e + 1.0f);
    return 0.5f * x * (1.0f + th);
}
__device__ __forceinline__ float sigmoidf_(float x) { return 1.0f / (1.0f + __expf(-x)); }
#define LDS_WAIT() asm volatile("s_waitcnt lgkmcnt(0)" ::: "memory")
#define VM_WAIT() asm volatile("s_waitcnt vmcnt(0)" ::: "memory")

#define XB_TMO      128
#define XB_XCNT(j)  (256  + 64 * (j))
#define XB_XSUB(j)  (1280 + 64 * (j))
#define XB_XGEN(j)  (2304 + 64 * (j))
#define XB_TOP      3328
#define XB_TOPGEN   3392
#define XCD_BAR_WORDS 3456
#define XB_SPIN_CAP (1u << 22)
__device__ __forceinline__ unsigned xb_ld(unsigned* p)              { return __hip_atomic_load(p, __ATOMIC_RELAXED, __HIP_MEMORY_SCOPE_AGENT); }
__device__ __forceinline__ unsigned xb_add(unsigned* p, unsigned v) { return __hip_atomic_fetch_add(p, v, __ATOMIC_RELAXED, __HIP_MEMORY_SCOPE_AGENT); }
__device__ __forceinline__ unsigned xb_xcc_id() { return (unsigned)__builtin_amdgcn_s_getreg((3 << 11) | 20) & 0xFu; }
#define XB_SPIN(cond, bar) do { unsigned _sp = 0; while (cond) { __builtin_amdgcn_s_sleep(1); \
    if ((++_sp & 255u) == 0u) { if (xb_ld(&(bar)[XB_TMO])) break; if (_sp > XB_SPIN_CAP) { atomicAdd(&(bar)[XB_TMO], 1u); break; } } } } while (0)
struct XcdBarrier { unsigned* bar; unsigned x; volatile LAS unsigned* st; };
__device__ __forceinline__ XcdBarrier xcd_barrier_post(unsigned* bar, volatile LAS unsigned* st) {
    XcdBarrier b; b.bar = bar; b.x = xb_xcc_id(); b.st = st;
    if (threadIdx.x == 0) (void)xb_add(&bar[XB_XCNT(b.x)], 1u);
    return b;
}
__device__ __forceinline__ void xcd_barrier_complete(unsigned* bar, unsigned x, unsigned& nloc, unsigned& nx) {
    const unsigned G = gridDim.x * gridDim.y * gridDim.z;
    unsigned sum, cnt, mine, sp = 0u;
    for (;;) {
        sum = 0u; cnt = 0u; mine = 0u;
#pragma unroll
        for (unsigned j = 0; j < 16; ++j) { const unsigned c = xb_ld(&bar[XB_XCNT(j)]); sum += c; cnt += (c > 0u) ? 1u : 0u; mine = (j == x) ? c : mine; }
        if (sum == G) break;
        __builtin_amdgcn_s_sleep(1);
        if ((++sp & 255u) == 0u) { if (xb_ld(&bar[XB_TMO])) break; if (sp > XB_SPIN_CAP) { atomicAdd(&bar[XB_TMO], 1u); break; } }
    }
    nloc = mine > 0u ? mine : 1u; nx = cnt > 0u ? cnt : 1u;
}
__device__ __forceinline__ void xcd_barrier(const XcdBarrier& b) {
    asm volatile("s_waitcnt vmcnt(0)" ::: "memory");
    __syncthreads();
    if (threadIdx.x == 0) {
        unsigned* bar = b.bar;
        __builtin_amdgcn_s_waitcnt(0);
        unsigned nloc = b.st[0], nx = b.st[1];
        if (nloc == 0u) { xcd_barrier_complete(bar, b.x, nloc, nx); b.st[0] = nloc; b.st[1] = nx; }
        const unsigned old = xb_add(&bar[XB_XSUB(b.x)], 1u);
        const unsigned gen = old / nloc;
        if (old + 1u == (gen + 1u) * nloc) {
            __builtin_amdgcn_fence(__ATOMIC_RELEASE, "agent");
            asm volatile("s_waitcnt vmcnt(0)" ::: "memory");
            const unsigned og = xb_add(&bar[XB_TOP], 1u);
            const unsigned tg = og / nx;
            if (og + 1u == (tg + 1u) * nx) xb_add(&bar[XB_TOPGEN], 1u);
            else XB_SPIN(xb_ld(&bar[XB_TOPGEN]) == tg, bar);
            __builtin_amdgcn_fence(__ATOMIC_ACQUIRE, "agent");
            xb_add(&bar[XB_XGEN(b.x)], 1u);
            asm volatile("s_waitcnt vmcnt(0)" ::: "memory");
        } else {
            XB_SPIN(xb_ld(&bar[XB_XGEN(b.x)]) == gen, bar);
            __builtin_amdgcn_fence(__ATOMIC_ACQUIRE, "agent");
            asm volatile("s_waitcnt vmcnt(0)" ::: "memory");
        }
    }
    __syncthreads();
}

namespace pg8 {
constexpr int BM = 256, BK = 64, HALF = 128, HTB = HALF * BK * 2, STAGE_BYTES = 8 * HTB, NXCD = 8, WGM = 8;
__device__ __forceinline__ int lds_byte(int r, int c) { const int st = (r >> 4) * 2 + (c >> 5), rr = r & 15, cc = c & 31, ob = rr * 64 + cc * 2; return st * 1024 + (ob ^ (((ob >> 9) & 1) << 5)); }
__device__ __forceinline__ void stage_rc(int b, int& R, int& C) { const int st = b / 1024, sb = b % 1024, swz = sb ^ (((sb >> 9) & 1) << 5); R = (st >> 1) * 16 + swz / 64; C = (st & 1) * 32 + (swz % 64) / 2; }
__device__ __forceinline__ int perm32(int rho) { const int n = rho >> 4, i = rho & 15; return 8 * (i >> 2) + 4 * n + (i & 3); }
struct Unit { int pm, pn; };
struct Gemm { const bf16_t* A; const bf16_t* Bt; int M, N, K, lda, ldb; };
struct StaticOrder {
    int nM, nN, nwg, G, c;
    __device__ void init(int M, int N, int G_, int c_) { nM = M / BM; nN = N / BM; nwg = nM * nN; G = G_; c = c_; }
    __device__ bool next(int i, Unit& u) const {
        const long L = (long)i * G + c; if (L >= nwg) return false;
        int wgid = (int)L; { const int q = nwg / NXCD, r = nwg % NXCD, xcd = wgid % NXCD, off = wgid / NXCD; wgid = (xcd < r ? xcd * (q + 1) : r * (q + 1) + (xcd - r) * q) + off; }
        const int nig = WGM * nN, gid = wgid / nig, fm = gid * WGM, gsz = (nM - fm) < WGM ? (nM - fm) : WGM;
        u.pm = fm + ((wgid % nig) % gsz); u.pn = (wgid % nig) / gsz; return true;
    }
};
struct GroupedOrder {
    int nwg, G, c, tpg;
    __device__ void init(int ntiles, int tiles_per_group, int G_, int c_) { nwg = ntiles; tpg = tiles_per_group; G = G_; c = c_; }
    __device__ bool next(int i, Unit& u) const { const long L = (long)i * G + c; if (L >= nwg) return false; u.pm = (int)L; u.pn = (int)L / tpg; return true; }
};
__device__ __forceinline__ unsigned cvt_pk_bf16(float lo, float hi) { unsigned r; asm volatile("v_cvt_pk_bf16_f32 %0, %1, %2" : "=v"(r) : "v"(lo), "v"(hi)); return r; }

template <class Epi, class Sched>
__device__ __forceinline__ void gemm_phase(LAS unsigned char* lds, const Gemm g, const Sched& S, const Epi& E) {
    const int tid = threadIdx.x, wid = __builtin_amdgcn_readfirstlane(tid >> 6), lane = tid & 63, wr = wid >> 2, wc = wid & 3, fr = lane & 15, fq = lane >> 4;
    int K = g.K; asm volatile("" : "+s"(K));
    const int nt = K / BK;
    unsigned voffA[2], voffB[2];
#pragma unroll
    for (int i = 0; i < 2; ++i) { int R, C; stage_rc(tid * 16 + i * 8192, R, C); const int Rb = Epi::PERM ? ((R & ~31) + perm32(R & 31)) : R;
        voffA[i] = (unsigned)(R * g.lda + C) * 2u; voffB[i] = (unsigned)(Rb * g.ldb + C) * 2u; }
    const size_t kstep = (size_t)(BK * 2);
    const size_t hstepA = (size_t)HALF * g.lda * 2, hstepB = (size_t)HALF * g.ldb * 2;
    const size_t tstepA = 2 * hstepA, tstepB = 2 * hstepB;
    const unsigned ldsw = (unsigned)wid * 1024u;
    const int aoff = lds_byte(wr * 64 + fr, fq * 8), boff = lds_byte(wc * 32 + fr, fq * 8);
#define PG8_SA(b, h) (((b) * 2 + (h)) * HTB)
#define PG8_SB(b, h) ((4 + (b) * 2 + (h)) * HTB)
#define PG8_STAGE(bufoff, gbase, voff) do { _Pragma("unroll") for (int _i = 0; _i < 2; ++_i) \
        __builtin_amdgcn_global_load_lds((const unsigned*)((const char*)(gbase) + (voff)[_i]), (LAS unsigned*)(lds + (bufoff) + ldsw + _i * 8192), 16, 0, 0); } while (0)
#define PG8_LDA(dst, b, h) do { _Pragma("unroll") for (int m = 0; m < 4; ++m) _Pragma("unroll") for (int k = 0; k < 2; ++k) dst[m][k] = *(const LAS bf16x8*)(lds + PG8_SA(b, h) + aoff + m * 2048 + k * 1024); } while (0)
#define PG8_LDB(dst, b, h) do { _Pragma("unroll") for (int n = 0; n < 2; ++n) _Pragma("unroll") for (int k = 0; k < 2; ++k) dst[n][k] = *(const LAS bf16x8*)(lds + PG8_SB(b, h) + boff + n * 2048 + k * 1024); } while (0)
#define PG8_MMA(ai, bj, At, Bt) do { __builtin_amdgcn_s_setprio(1); _Pragma("unroll") for (int m = 0; m < 4; ++m) _Pragma("unroll") for (int n = 0; n < 2; ++n) _Pragma("unroll") for (int k = 0; k < 2; ++k) \
        acc[ai][bj][m][n] = __builtin_amdgcn_mfma_f32_16x16x32_bf16(Bt[n][k], At[m][k], acc[ai][bj][m][n], 0, 0, 0); __builtin_amdgcn_s_setprio(0); } while (0)
#define PG8_WAIT_V(n) asm volatile("s_waitcnt vmcnt(" #n ")" ::: "memory")
#define PG8_WAIT_L(n) asm volatile("s_waitcnt lgkmcnt(" #n ")" ::: "memory")
#define PG8_BAR __builtin_amdgcn_s_barrier()
#define PG8_SCHED __builtin_amdgcn_sched_barrier(0)
    Unit cur, nxt; int ui = 0;
    if (!S.next(0, cur)) return;
    f32x4 acc[2][2][4][2];
#pragma unroll
    for (int a = 0; a < 2; ++a)
#pragma unroll
        for (int b = 0; b < 2; ++b)
#pragma unroll
            for (int m = 0; m < 4; ++m)
#pragma unroll
                for (int n = 0; n < 2; ++n) acc[a][b][m][n] = (f32x4){0.f, 0.f, 0.f, 0.f};
    bf16x8 At[4][2], B0[2][2], B1[2][2];
    const char* cA = (const char*)g.A + (size_t)cur.pm * tstepA; const char* cB = (const char*)g.Bt + (size_t)cur.pn * tstepB;
    PG8_STAGE(PG8_SB(0, 0), cB, voffB); PG8_STAGE(PG8_SA(0, 0), cA, voffA); PG8_STAGE(PG8_SB(0, 1), cB + hstepB, voffB); PG8_STAGE(PG8_SA(0, 1), cA + hstepA, voffA);
    if (wr == 1) PG8_BAR;
    PG8_WAIT_V(4); PG8_BAR;
    PG8_STAGE(PG8_SB(1, 0), cB + kstep, voffB); PG8_STAGE(PG8_SA(1, 0), cA + kstep, voffA); PG8_STAGE(PG8_SB(1, 1), cB + hstepB + kstep, voffB);
    PG8_WAIT_V(6); PG8_BAR;
    for (;;) {
        const bool has_next = S.next(ui + 1, nxt);
        const char* nA = has_next ? (const char*)g.A + (size_t)nxt.pm * tstepA : cA; const char* nB = has_next ? (const char*)g.Bt + (size_t)nxt.pn * tstepB : cB;
        for (int t = 0; t < nt; t += 2) {
            const bool last = (t == nt - 2);
            const char* a1 = cA + (size_t)(t + 1) * kstep;
            const char* a2 = last ? nA : cA + (size_t)(t + 2) * kstep; const char* b2 = last ? nB : cB + (size_t)(t + 2) * kstep;
            const char* a3 = a2 + kstep; const char* b3 = b2 + kstep;
            PG8_LDB(B0, 0, 0); PG8_SCHED; PG8_LDA(At, 0, 0); PG8_STAGE(PG8_SA(1, 1), a1 + hstepA, voffA);
            PG8_WAIT_L(8); PG8_BAR; PG8_WAIT_L(0); PG8_MMA(0, 0, At, B0); PG8_BAR; PG8_SCHED;
            PG8_LDB(B1, 0, 1); PG8_STAGE(PG8_SB(0, 0), b2, voffB);
            PG8_BAR; PG8_WAIT_L(0); PG8_MMA(0, 1, At, B1); PG8_BAR;
            PG8_LDA(At, 0, 1); PG8_STAGE(PG8_SA(0, 0), a2, voffA);
            PG8_BAR; PG8_WAIT_L(0); PG8_MMA(1, 0, At, B0); PG8_BAR; PG8_SCHED;
            PG8_STAGE(PG8_SB(0, 1), b2 + hstepB, voffB);
            PG8_WAIT_V(6); PG8_BAR; PG8_MMA(1, 1, At, B1); PG8_BAR;
            PG8_LDB(B0, 1, 0); PG8_SCHED; PG8_LDA(At, 1, 0); PG8_STAGE(PG8_SA(0, 1), a2 + hstepA, voffA);
            PG8_WAIT_L(8); PG8_BAR; PG8_WAIT_L(0); PG8_MMA(0, 0, At, B0); PG8_BAR; PG8_SCHED;
            PG8_LDB(B1, 1, 1); PG8_STAGE(PG8_SB(1, 0), b3, voffB);
            PG8_BAR; PG8_WAIT_L(0); PG8_MMA(0, 1, At, B1); PG8_BAR;
            PG8_LDA(At, 1, 1); PG8_STAGE(PG8_SA(1, 0), a3, voffA);
            PG8_BAR; PG8_WAIT_L(0); PG8_MMA(1, 0, At, B0); PG8_BAR; PG8_SCHED;
            PG8_STAGE(PG8_SB(1, 1), b3 + hstepB, voffB);
            PG8_WAIT_V(6); PG8_BAR; PG8_MMA(1, 1, At, B1); PG8_BAR;
        }
        E(acc, cur, wr, wc, fr, fq);
        if (!has_next) break;
#pragma unroll
        for (int a = 0; a < 2; ++a)
#pragma unroll
            for (int b = 0; b < 2; ++b)
#pragma unroll
                for (int m = 0; m < 4; ++m)
#pragma unroll
                    for (int n = 0; n < 2; ++n) acc[a][b][m][n] = (f32x4){0.f, 0.f, 0.f, 0.f};
        cur = nxt; cA = nA; cB = nB; ++ui;
    }
    PG8_WAIT_V(0);
    if (wr == 0) PG8_BAR;
    PG8_BAR;
#undef PG8_SA
#undef PG8_SB
#undef PG8_STAGE
#undef PG8_LDA
#undef PG8_LDB
#undef PG8_MMA
#undef PG8_WAIT_V
#undef PG8_WAIT_L
#undef PG8_BAR
#undef PG8_SCHED
}

struct EpiStoreBf16 {
    static constexpr bool PERM = true;
    bf16_t* O; int ldc;
    __device__ __forceinline__ void operator()(const f32x4 (&acc)[2][2][4][2], const Unit& u, int wr, int wc, int fr, int fq) const {
        const int row0 = u.pm * BM + wr * 64 + fr, col0 = u.pn * BM + wc * 32 + 8 * fq;
#pragma unroll
        for (int ai = 0; ai < 2; ++ai)
#pragma unroll
            for (int m = 0; m < 4; ++m) { bf16_t* rowp = O + (size_t)(row0 + ai * HALF + m * 16) * ldc + col0;
#pragma unroll
                for (int bj = 0; bj < 2; ++bj) { const f32x4 v0 = acc[ai][bj][m][0], v1 = acc[ai][bj][m][1];
                    u32x4 w; w.x = cvt_pk_bf16(v0[0], v0[1]); w.y = cvt_pk_bf16(v0[2], v0[3]); w.z = cvt_pk_bf16(v1[0], v1[1]); w.w = cvt_pk_bf16(v1[2], v1[3]);
                    *(u32x4*)(rowp + bj * HALF) = w; } }
    }
};
struct EpiResidF32 {
    static constexpr bool PERM = false;
    const float* R; float* C; int ldc;
    __device__ __forceinline__ void operator()(const f32x4 (&acc)[2][2][4][2], const Unit& u, int wr, int wc, int fr, int fq) const {
        const int row0 = u.pm * BM + wr * 64 + fr, col0 = u.pn * BM + wc * 32 + 4 * fq;
#pragma unroll
        for (int ai = 0; ai < 2; ++ai)
#pragma unroll
            for (int m = 0; m < 4; ++m) { const size_t off = (size_t)(row0 + ai * HALF + m * 16) * ldc + col0;
#pragma unroll
                for (int bj = 0; bj < 2; ++bj)
#pragma unroll
                    for (int n = 0; n < 2; ++n) { const f32x4 r = *(const f32x4*)(R + off + bj * HALF + n * 16); *(f32x4*)(C + off + bj * HALF + n * 16) = r + acc[ai][bj][m][n]; } }
    }
};
}

struct Args {
    const float* in[39];
    float* out;
    unsigned char* ws;
    int ph_lo, ph_hi;
};
enum { I_X = 0, I_L0_MIXN, I_L0_WIN, I_L0_QG, I_L0_KG, I_L0_LOGDT, I_L0_ARE, I_L0_AIM, I_L0_BRE, I_L0_BIM, I_L0_CRE, I_L0_CIM, I_L0_D, I_L0_WGLU, I_L0_BGLU, I_L0_WOUT,
       I_L0_FFNN, I_L0_WQ, I_L0_SK, I_L0_U, I_L0_V,
       I_L1_MIXN, I_L1_WIN, I_L1_QG, I_L1_KG, I_L1_CMPPOS, I_L1_KW1, I_L1_KW2, I_L1_VW1, I_L1_VW2, I_L1_WGATE, I_L1_BGATE, I_L1_OGAIN, I_L1_WOUT,
       I_L1_FFNN, I_L1_WQ, I_L1_SK, I_L1_U, I_L1_V };

struct Frame {
    LAS unsigned char* lds;
    int tid, lane, wave, G, bid;
};

constexpr size_t L0_QA = WS_R3;
constexpr size_t L0_IQ = WS_R3 + 32 * MiB;
constexpr size_t L0_KA = WS_R3 + 64 * MiB;
constexpr size_t L0_VAT = WS_R3 + 72 * MiB;
constexpr size_t L0_IK = WS_R3 + 80 * MiB;
constexpr size_t L0_IW = WS_R3 + 84 * MiB;
constexpr size_t L0_UA = WS_R3 + 88 * MiB;
constexpr size_t L0_SELT = WS_PROJ;
constexpr size_t L0_CAT = WS_PROJ + 16 * MiB;
constexpr size_t L0_SLOC = WS_PROJ + 80 * MiB;
constexpr size_t L0_YB = WS_PROJ + 112 * MiB;
constexpr size_t PE_Q2 = WS_PROJ;
constexpr size_t PE_EID = WS_PROJ + 128 * MiB;
constexpr size_t PE_GATE = WS_PROJ + 136 * MiB;

template <class Map>
__device__ __forceinline__ void transpose_item(const float* W, int K, int N, bf16_t* WT, int ldk, LAS float* scr, int item, int lane, const Map& map) {
    const int nblk = (N + 31) / 32, kb = item / nblk, nb = item % nblk, k0 = 64 * kb, n0 = 32 * nb;
    const int ncol = n0 + (lane & 31);
#pragma unroll 8
    for (int i = 0; i < 32; ++i) { const int kk = 2 * i + (lane >> 5); scr[kk * 33 + (lane & 31)] = (ncol < N) ? W[(size_t)(k0 + kk) * N + ncol] : 0.f; }
    LDS_WAIT(); asm volatile("" ::: "memory");
    const int c = lane & 7;
#pragma unroll
    for (int j = 0; j < 4; ++j) { const int n = (lane >> 3) + 8 * j; const LAS float* s = scr + (8 * c) * 33 + n;
        u32x4 o; o.x = pk2(s[0 * 33], s[1 * 33]); o.y = pk2(s[2 * 33], s[3 * 33]); o.z = pk2(s[4 * 33], s[5 * 33]); o.w = pk2(s[6 * 33], s[7 * 33]);
        if (n0 + n < N) *(u32x4*)(WT + (size_t)map(n0 + n) * ldk + k0 + 8 * c) = o; }
    LDS_WAIT(); asm volatile("" ::: "memory");
}
struct MapId { __device__ __forceinline__ int operator()(int n) const { return n; } };
struct MapIn0 { __device__ __forceinline__ int operator()(int n) const { return n < 1280 ? n : (n < 1344 ? n - 1280 + C0_IK : (n < 1352 ? n - 1344 + C0_IW : n - 1352 + C0_U)); } };
struct MapIn1 { __device__ __forceinline__ int operator()(int n) const {
    if (n < 1280) return n; if (n < 1304) return n - 1280 + C1_GL; if (n < 1560) return n - 1304 + C1_GQ; if (n < 1816) return n - 1560 + C1_GK;
    if (n < 2328) return n - 1816 + C1_GV; if (n < 2344) return n - 2328 + C1_GLOW; return n - 2344 + C1_GR; } };

template <class Map>
__device__ __forceinline__ void transpose_all(const Frame& F, int& base, const float* W, int K, int N, bf16_t* WT, int ldk, const Map& map) {
    LAS float* scr = (LAS float*)(F.lds + F.wave * 16384);
    const int gw = F.bid * NWAVES + F.wave, NGW = F.G * NWAVES;
    const int nit = (K / 64) * ((N + 31) / 32);
    for (int it = (gw + NGW - (base % NGW)) % NGW; it < nit; it += NGW) transpose_item(W, K, N, WT, ldk, scr, it, F.lane, map);
    base += nit;
}
__device__ __forceinline__ void zero_bytes(const Frame& F, unsigned char* p, size_t nbytes) {
    const size_t n16 = nbytes / 16;
    for (size_t i = (size_t)F.bid * NTHREADS + F.tid; i < n16; i += (size_t)F.G * NTHREADS) ((u32x4*)p)[i] = (u32x4){0u, 0u, 0u, 0u};
}
__device__ __forceinline__ void cvt_f32_bf16(const Frame& F, const float* src, bf16_t* dst, size_t n) {
    const size_t n8 = n / 8;
    for (size_t i = (size_t)F.bid * NTHREADS + F.tid; i < n8; i += (size_t)F.G * NTHREADS) {
        const f32x4 a = ((const f32x4*)src)[2 * i], b = ((const f32x4*)src)[2 * i + 1];
        u32x4 o; o.x = pk2(a.x, a.y); o.y = pk2(a.z, a.w); o.z = pk2(b.x, b.y); o.w = pk2(b.z, b.w);
        ((u32x4*)dst)[i] = o;
    }
}

__device__ __forceinline__ void rms_row_to_bf16(const float* xrow, const float* gain, bf16_t* orow, int lane) {
    const f32x4* xr = (const f32x4*)xrow + lane; const f32x4* gr = (const f32x4*)gain + lane;
    f32x4 v[4]; float s = 0.f;
#pragma unroll
    for (int j = 0; j < 4; ++j) { v[j] = xr[64 * j]; s += (v[j].x * v[j].x + v[j].y * v[j].y) + (v[j].z * v[j].z + v[j].w * v[j].w); }
    const float rstd = 1.0f / sqrtf(wave_sum(s) * (1.f / DM) + 1e-6f);
    u64* o8 = (u64*)orow + lane;
#pragma unroll
    for (int j = 0; j < 4; ++j) { const f32x4 g4 = gr[64 * j]; o8[64 * j] = (u64)pk2(v[j].x * rstd * g4.x, v[j].y * rstd * g4.y) | ((u64)pk2(v[j].z * rstd * g4.z, v[j].w * rstd * g4.w) << 32); }
}
__device__ __forceinline__ void p_rmsnorm(const Frame& F, const float* x, const float* gain, bf16_t* XN) {
    const int gw = F.bid * NWAVES + F.wave, NGW = F.G * NWAVES;
    for (int m = gw; m < T; m += NGW) rms_row_to_bf16(x + (size_t)m * DM, gain, XN + (size_t)m * DM, F.lane);
}

__device__ __forceinline__ void p_rope_table(const Frame& F, f32x2* rope) {
    for (int i = F.bid * NTHREADS + F.tid; i < SEQ * 32; i += F.G * NTHREADS) {
        const int pos = i >> 5, k = i & 31;
        const float inv = powf(10000.0f, -(float)k / 32.0f);
        const float ang = (float)pos * inv;
        float s, c; sincosf(ang, &s, &c);
        rope[i] = (f32x2){c, s};
    }
}

__device__ __forceinline__ void s5_build_group(const Frame& F, const Args& a, unsigned char* ws, int g) {
    LAS f32x2* abp = (LAS f32x2*)F.lds;
    LAS f32x2* bb = abp + 17 * 64;
    LAS f32x2* Cc = bb + 64 * 16;
    LAS float* KT = (LAS float*)(Cc + 16 * 64);
    const float dt = expf(a.in[I_L0_LOGDT][g]);
    for (int idx = F.tid; idx < 17 * 64; idx += NTHREADS) {
        const int tau = idx >> 6, p = idx & 63;
        const float lr = a.in[I_L0_ARE][g * 64 + p], li = a.in[I_L0_AIM][g * 64 + p];
        const float mag = expf((float)tau * dt * lr); float s, c; sincosf((float)tau * dt * li, &s, &c);
        abp[idx] = (f32x2){mag * c, mag * s};
    }
    for (int idx = F.tid; idx < 64 * 16; idx += NTHREADS) {
        const int p = idx >> 4, c = idx & 15;
        const float lr = a.in[I_L0_ARE][g * 64 + p], li = a.in[I_L0_AIM][g * 64 + p];
        const float mag = expf(dt * lr); float s, co; sincosf(dt * li, &s, &co);
        const float abr = mag * co, abi = mag * s, den = lr * lr + li * li;
        const float fr = ((abr - 1.0f) * lr + abi * li) / den, fi = (abi * lr - (abr - 1.0f) * li) / den;
        const float br = a.in[I_L0_BRE][(size_t)(g * 64 + p) * 16 + c], bi = a.in[I_L0_BIM][(size_t)(g * 64 + p) * 16 + c];
        bb[idx] = (f32x2){fr * br - fi * bi, fr * bi + fi * br};
    }
    for (int idx = F.tid; idx < 16 * 64; idx += NTHREADS) Cc[idx] = (f32x2){a.in[I_L0_CRE][(size_t)g * 1024 + idx], a.in[I_L0_CIM][(size_t)g * 1024 + idx]};
    __syncthreads();
    for (int idx = F.tid; idx < 16 * 256; idx += NTHREADS) {
        const int tau = idx >> 8, co = (idx >> 4) & 15, ci = idx & 15;
        float acc = 0.f;
        for (int p = 0; p < 64; ++p) {
            const f32x2 c = Cc[co * 64 + p], e = abp[tau * 64 + p], b = bb[p * 16 + ci];
            const float er = c.x * e.x - c.y * e.y, ei = c.x * e.y + c.y * e.x;
            acc += er * b.x - ei * b.y;
        }
        if (tau == 0 && co == ci) acc += a.in[I_L0_D][g * 16 + co];
        KT[idx] = acc;
    }
    __syncthreads();
    bf16_t* B1 = (bf16_t*)(ws + WS_S5B1) + (size_t)g * 256 * 256;
    bf16_t* B2 = (bf16_t*)(ws + WS_S5B2) + (size_t)g * 256 * 384;
    for (int idx = F.tid; idx < 256 * 128; idx += NTHREADS) {
        const int n = idx >> 7, k = (idx & 127) * 2;
        float v0 = 0.f, v1 = 0.f;
        if (n < 128) { const int p = n & 63, j = k >> 4, ci = k & 15; const f32x2 e = abp[(15 - j) * 64 + p], b0 = bb[p * 16 + ci], b1 = bb[p * 16 + ci + 1];
            if (n < 64) { v0 = e.x * b0.x - e.y * b0.y; v1 = e.x * b1.x - e.y * b1.y; } else { v0 = e.x * b0.y + e.y * b0.x; v1 = e.x * b1.y + e.y * b1.x; } }
        *(unsigned*)(B1 + (size_t)n * 256 + k) = pk2(v0, v1);
    }
    for (int idx = F.tid; idx < 256 * 192; idx += NTHREADS) {
        const int n = idx / 192, k = (idx % 192) * 2, i = n >> 4, co = n & 15;
        float v0 = 0.f, v1 = 0.f;
        if (k < 256) { const int j = k >> 4, ci = k & 15; if (j <= i) { v0 = KT[((i - j) * 16 + co) * 16 + ci]; v1 = KT[((i - j) * 16 + co) * 16 + ci + 1]; } }
        else { const int p = (k - 256) & 63; const bool im = k >= 320;
            const f32x2 c0 = Cc[co * 64 + p], e0 = abp[(i + 1) * 64 + p], c1 = Cc[co * 64 + p + 1], e1 = abp[(i + 1) * 64 + p + 1];
            if (!im) { v0 = c0.x * e0.x - c0.y * e0.y; v1 = c1.x * e1.x - c1.y * e1.y; } else { v0 = -(c0.x * e0.y + c0.y * e0.x); v1 = -(c1.x * e1.y + c1.y * e1.x); } }
        *(unsigned*)(B2 + (size_t)n * 384 + k) = pk2(v0, v1);
    }
    __syncthreads();
}

__device__ __forceinline__ void cmp_bias(const Frame& F, const Args& a, float* out, int j) {
    const int w = j >> 5, n0 = (j & 31) * 8;
    const float* w1 = a.in[w ? I_L1_VW1 : I_L1_KW1]; const float* pos = a.in[I_L1_CMPPOS];
    LAS float* red = (LAS float*)(F.lds + 65536);
    float acc[8];
#pragma unroll
    for (int i = 0; i < 8; ++i) acc[i] = 0.f;
#pragma unroll
    for (int kk = 0; kk < 4; ++kk) { const int k = F.tid * 4 + kk; const float p = pos[k];
        const f32x4 wa = *(const f32x4*)(w1 + (size_t)k * 256 + n0), wb = *(const f32x4*)(w1 + (size_t)k * 256 + n0 + 4);
        acc[0] += p * wa.x; acc[1] += p * wa.y; acc[2] += p * wa.z; acc[3] += p * wa.w; acc[4] += p * wb.x; acc[5] += p * wb.y; acc[6] += p * wb.z; acc[7] += p * wb.w; }
#pragma unroll
    for (int i = 0; i < 8; ++i) { const float sv = wave_sum(acc[i]); if (F.lane == 0) red[F.wave * 8 + i] = sv; }
    __syncthreads();
    if (F.tid < 8) { float t = 0.f; for (int wv = 0; wv < 8; ++wv) t += red[wv * 8 + F.tid]; out[w * 256 + n0 + F.tid] = t; }
    __syncthreads();
}

__device__ __forceinline__ float rope_apply(float v, const f32x2 cs, int lane) {
    const float partner = __shfl_xor(v, 32);
    return lane < 32 ? v * cs.x - partner * cs.y : partner * cs.y + v * cs.x;
}
__device__ __forceinline__ void head8_load(const bf16_t* p, float (&v)[8]) {
    const u32x4 q = *(const u32x4*)p;
    v[0] = bf_lo(q.x); v[1] = bf_hi(q.x); v[2] = bf_lo(q.y); v[3] = bf_hi(q.y); v[4] = bf_lo(q.z); v[5] = bf_hi(q.z); v[6] = bf_lo(q.w); v[7] = bf_hi(q.w);
}
__device__ __forceinline__ void head8_store(bf16_t* p, const float (&v)[8], const float sc) {
    u32x4 q; q.x = pk2(v[0] * sc, v[1] * sc); q.y = pk2(v[2] * sc, v[3] * sc); q.z = pk2(v[4] * sc, v[5] * sc); q.w = pk2(v[6] * sc, v[7] * sc);
    *(u32x4*)p = q;
}
__device__ __forceinline__ void head8_norm(float (&v)[8], const float (&g)[8]) {
    float ss = 0.f;
#pragma unroll
    for (int j = 0; j < 8; ++j) ss += v[j] * v[j];
    ss += __shfl_xor(ss, 1); ss += __shfl_xor(ss, 2); ss += __shfl_xor(ss, 4);
    const float r = 1.0f / sqrtf(ss * (1.f / 64.f) + 1e-6f);
#pragma unroll
    for (int j = 0; j < 8; ++j) v[j] = v[j] * r * g[j];
}
__device__ __forceinline__ void head8_rope(float (&v)[8], const f32x2 (&cs)[8], const bool upper) {
#pragma unroll
    for (int j = 0; j < 8; ++j) { const float partner = __shfl_xor(v[j], 4); v[j] = upper ? partner * cs[j].y + v[j] * cs[j].x : v[j] * cs[j].x - partner * cs[j].y; }
}
__device__ __forceinline__ void p_l0_prep(const Frame& F, const Args& a, unsigned char* ws) {
    const bf16_t* P = (const bf16_t*)(ws + WS_PROJ);
    const f32x2* rope = (const f32x2*)(ws + WS_ROPE);
    bf16_t* QA = (bf16_t*)(ws + L0_QA); bf16_t* IQ = (bf16_t*)(ws + L0_IQ); bf16_t* KA = (bf16_t*)(ws + L0_KA); bf16_t* VAT = (bf16_t*)(ws + L0_VAT);
    bf16_t* IK = (bf16_t*)(ws + L0_IK); float* IW = (float*)(ws + L0_IW); bf16_t* UA = (bf16_t*)(ws + L0_UA);
    const int gw = F.bid * NWAVES + F.wave, NGW = F.G * NWAVES, lane = F.lane, hs = lane >> 3, sub = lane & 7;
    float qg[8], kg[8];
#pragma unroll
    for (int j = 0; j < 8; ++j) { qg[j] = a.in[I_L0_QG][sub * 8 + j]; kg[j] = a.in[I_L0_KG][sub * 8 + j]; }
    for (int m = gw; m < T; m += NGW) {
        const int b = m >> 12, t = m & 4095;
        const bf16_t* row = P + (size_t)m * N_IN0;
        f32x2 cs[8];
#pragma unroll
        for (int j = 0; j < 4; ++j) { const f32x4 c4 = *(const f32x4*)(rope + t * 32 + (sub & 3) * 8 + 2 * j); cs[2 * j] = (f32x2){c4.x, c4.y}; cs[2 * j + 1] = (f32x2){c4.z, c4.w}; }
        float v[8];
        head8_load(row + C0_Q + lane * 8, v); head8_norm(v, qg); head8_rope(v, cs, sub >= 4); head8_store(QA + (size_t)m * 512 + lane * 8, v, 0.125f);
        head8_load(row + C0_IQ + lane * 8, v); head8_rope(v, cs, sub >= 4); head8_store(IQ + (size_t)m * 512 + lane * 8, v, 0.125f);
        {
            const int hh = hs < 3 ? hs : 2;
            head8_load(row + (hh < 2 ? C0_K + hh * 64 : C0_IK) + sub * 8, v);
            float vn[8];
#pragma unroll
            for (int j = 0; j < 8; ++j) vn[j] = v[j];
            head8_norm(vn, kg);
#pragma unroll
            for (int j = 0; j < 8; ++j) v[j] = (hh < 2) ? vn[j] : v[j];
            head8_rope(v, cs, sub >= 4);
            if (hs < 2) head8_store(KA + ((size_t)(b * 2 + hs) * 4096 + t) * 64 + sub * 8, v, 1.0f);
            else if (hs == 2) head8_store(IK + (size_t)m * 64 + sub * 8, v, 1.0f);
        }
        if (lane < 8) IW[(size_t)m * 8 + lane] = bf2f(row[C0_IW + lane]) * 0.35355339059327373f;
        { const u32x4 uv = *(const u32x4*)(row + C0_U + lane * 8); const int g = lane >> 1;
          *(u32x4*)(UA + ((size_t)g * 2048 + (m >> 4)) * 384 + (m & 15) * 16 + (lane & 1) * 8) = uv; }
    }
    for (int it = gw; it < NB * 2 * 64; it += NGW) {
        const int tb = it & 63, g = (it >> 6) & 1, b = it >> 7;
        const size_t m = (size_t)b * 4096 + tb * 64 + lane;
        unsigned r[32];
#pragma unroll
        for (int j = 0; j < 8; ++j) { const u32x4 q = *(const u32x4*)(P + m * N_IN0 + C0_V + g * 64 + j * 8); r[4 * j] = q.x; r[4 * j + 1] = q.y; r[4 * j + 2] = q.z; r[4 * j + 3] = q.w; }
        bf16_t* dst = VAT + ((size_t)(b * 2 + g) * 64) * 4096 + tb * 64 + lane;
#pragma unroll
        for (int d = 0; d < 64; ++d) dst[(size_t)d * 4096] = (bf16_t)((d & 1) ? (r[d >> 1] >> 16) : (r[d >> 1] & 0xffffu));
    }
}

__device__ __forceinline__ unsigned f16key(unsigned raw) { return (raw & 0x8000u) ? (~raw & 0xFFFFu) : (raw | 0x8000u); }
template <int NREG>
__device__ __forceinline__ int topk_count_ge(const unsigned (&kk)[NREG], const unsigned cm1pk) {
    unsigned acc = 0u; const unsigned ones = 0x00010001u;
#pragma unroll
    for (int jj = 0; jj < NREG; ++jj) {
        unsigned d;
        asm("v_pk_sub_u16 %0, %1, %2 clamp" : "=v"(d) : "v"(kk[jj]), "v"(cm1pk));
        asm("v_pk_min_u16 %0, %1, %2" : "=v"(d) : "v"(d), "v"(ones));
        asm("v_pk_add_u16 %0, %1, %2" : "=v"(acc) : "v"(acc), "v"(d));
    }
    int c = (int)((acc & 0xffffu) + (acc >> 16));
    c += __builtin_amdgcn_update_dpp(0, c, 0xB1, 0xF, 0xF, true);
    c += __builtin_amdgcn_update_dpp(0, c, 0x4E, 0xF, 0xF, true);
    c += __builtin_amdgcn_update_dpp(0, c, 0x141, 0xF, 0xF, true);
    c += __builtin_amdgcn_update_dpp(0, c, 0x140, 0xF, 0xF, true);
    return __builtin_amdgcn_readlane(c, 0) + __builtin_amdgcn_readlane(c, 16) + __builtin_amdgcn_readlane(c, 32) + __builtin_amdgcn_readlane(c, 48);
}
template <int NREG>
__device__ __forceinline__ u64 topk_query(const LAS unsigned short* scq, const int t, const int lane) {
    unsigned kk[NREG];
#pragma unroll
    for (int jj = 0; jj < NREG; ++jj) {
        const int e0 = (2 * jj) * 64 + lane, e1 = e0 + 64;
        const unsigned r0 = scq[e0], r1 = scq[e1];
        kk[jj] = ((e0 <= t) ? f16key(r0) : 0u) | (((e1 <= t) ? f16key(r1) : 0u) << 16);
    }
    unsigned prefix = 0u; bool exact = false;
#pragma unroll 1
    for (int bit = 15; bit >= 0; --bit) {
        const unsigned cand = prefix | (1u << bit), cm1 = cand - 1u;
        const int cnt = topk_count_ge<NREG>(kk, cm1 | (cm1 << 16));
        if (cnt >= 256) prefix = cand;
        if (cnt == 256) { exact = true; break; }
    }
    unsigned mylo = 0u, myhi = 0u;
    if (exact) {
#pragma unroll
        for (int i = 0; i < 2 * NREG; ++i) {
            const unsigned k = (i & 1) ? (kk[i >> 1] >> 16) : (kk[i >> 1] & 0xffffu);
            const u64 w = __ballot(k >= prefix);
            asm("s_nop 4\n\tv_writelane_b32 %0, %2, %4\n\tv_writelane_b32 %1, %3, %4" : "+v"(mylo), "+v"(myhi) : "s"((unsigned)w), "s"((unsigned)(w >> 32)), "n"(i));
        }
    } else {
        const unsigned Tk = prefix;
        const int cgt = (Tk >= 0xFFFFu) ? 0 : topk_count_ge<NREG>(kk, Tk | (Tk << 16));
        const int need = 256 - cgt;
        int run = 0;
#pragma unroll
        for (int i = 0; i < 2 * NREG; ++i) {
            const unsigned k = (i & 1) ? (kk[i >> 1] >> 16) : (kk[i >> 1] & 0xffffu);
            const u64 gt = __ballot(k > Tk); u64 eq = __ballot(k == Tk);
            const int pe = __builtin_popcountll(eq);
            if (run + pe > need) { int kq = need - run; kq = kq < 0 ? 0 : kq;
                const bool keep = ((eq >> lane) & 1ull) && (__builtin_popcountll(eq & ((1ull << lane) - 1ull)) < kq); eq = __ballot(keep); }
            run += pe;
            const u64 w = gt | eq;
            asm("s_nop 4\n\tv_writelane_b32 %0, %2, %4\n\tv_writelane_b32 %1, %3, %4" : "+v"(mylo), "+v"(myhi) : "s"((unsigned)w), "s"((unsigned)(w >> 32)), "n"(i));
        }
    }
    return (u64)mylo | ((u64)myhi << 32);
}
__device__ __forceinline__ void p_dsa_index(const Frame& F, unsigned char* ws, u64* SELT, const int mode) {
    const bf16_t* IQ = (const bf16_t*)(ws + L0_IQ); const bf16_t* IK = (const bf16_t*)(ws + L0_IK); const float* IW = (const float*)(ws + L0_IW);
    LAS _Float16* sc = (LAS _Float16*)F.lds;
    LAS unsigned short* scu = (LAS unsigned short*)F.lds;
    LAS u64* mk = (LAS u64*)(F.lds + 131072);
    LAS float* wl = (LAS float*)(F.lds + 131072 + 8192);
    const int lane = F.lane, wave = F.wave, h = lane >> 5, r = lane & 31;
    const int rq = ((r >> 4) & 1) + 2 * ((r >> 2) & 1), rh = 4 * ((r >> 3) & 1) + (r & 3);
    for (int u = F.bid; u < 2048; u += F.G) {
        const int idx = u & 255, b = u >> 8;
        const int j = (b & 1) ? 255 - idx : idx;
        const int t0 = j * 16; const size_t mb = (size_t)b * 4096;
        if (F.tid < 128) wl[F.tid] = IW[(mb + t0) * 8 + F.tid];
        const int nkb = (t0 + 15) / 32 + 1;
        bf16x8 Af[4][4];
#pragma unroll
        for (int rt = 0; rt < 4; ++rt)
#pragma unroll
            for (int ks = 0; ks < 4; ++ks) Af[rt][ks] = *(const bf16x8*)(IQ + (mb + t0 + 4 * rt + rq) * 512 + rh * 64 + ks * 16 + 8 * h);
        __syncthreads();
        if (mode != 2) for (int kb = wave; kb < nkb; kb += NWAVES) {
            bf16x8 Bf[4];
#pragma unroll
            for (int ks = 0; ks < 4; ++ks) Bf[ks] = *(const bf16x8*)(IK + (mb + kb * 32 + r) * 64 + ks * 16 + 8 * h);
#pragma unroll
            for (int rt = 0; rt < 4; ++rt) {
                f32x16 acc = {0.f, 0.f, 0.f, 0.f, 0.f, 0.f, 0.f, 0.f, 0.f, 0.f, 0.f, 0.f, 0.f, 0.f, 0.f, 0.f};
#pragma unroll
                for (int ks = 0; ks < 4; ++ks) acc = __builtin_amdgcn_mfma_f32_32x32x16_bf16(Af[rt][ks], Bf[ks], acc, 0, 0, 0);
                const int qa = 4 * rt + 2 * h;
                const f32x4 wa0 = *(const LAS f32x4*)(wl + qa * 8), wa1 = *(const LAS f32x4*)(wl + qa * 8 + 4), wb0 = *(const LAS f32x4*)(wl + qa * 8 + 8), wb1 = *(const LAS f32x4*)(wl + qa * 8 + 12);
                float sa = 0.f, sb = 0.f;
#pragma unroll
                for (int i = 0; i < 4; ++i) { sa += wa0[i] * fmaxf(acc[i], 0.f); sa += wa1[i] * fmaxf(acc[4 + i], 0.f); sb += wb0[i] * fmaxf(acc[8 + i], 0.f); sb += wb1[i] * fmaxf(acc[12 + i], 0.f); }
                sc[qa * 4096 + kb * 32 + r] = (_Float16)sa;
                sc[(qa + 1) * 4096 + kb * 32 + r] = (_Float16)sb;
            }
        }
        __syncthreads();
#pragma unroll 1
        for (int qq = 0; qq < (mode == 1 ? 0 : 2); ++qq) {
            const int q = wave * 2 + qq, t = t0 + q, n = t + 1;
            unsigned mylo = 0u, myhi = 0u;
            if (n <= 256) {
                const int base = lane * 64;
                const u64 word = (base + 63 <= t) ? ~0ull : (base > t ? 0ull : ((1ull << (t - base + 1)) - 1ull));
                mylo = (unsigned)word; myhi = (unsigned)(word >> 32);
            } else {
                const int nreg = (((n + 63) >> 6) + 1) >> 1;
                const LAS unsigned short* scq = scu + q * 4096;
                u64 w;
                if (nreg <= 4) w = topk_query<4>(scq, t, lane);
                else if (nreg <= 8) w = topk_query<8>(scq, t, lane);
                else if (nreg <= 12) w = topk_query<12>(scq, t, lane);
                else if (nreg <= 16) w = topk_query<16>(scq, t, lane);
                else if (nreg <= 20) w = topk_query<20>(scq, t, lane);
                else if (nreg <= 24) w = topk_query<24>(scq, t, lane);
                else if (nreg <= 28) w = topk_query<28>(scq, t, lane);
                else w = topk_query<32>(scq, t, lane);
                mylo = (unsigned)w; myhi = (unsigned)(w >> 32);
            }
            mk[lane * 16 + q] = (u64)mylo | ((u64)myhi << 32);
        }
        __syncthreads();
        { const int w = F.tid >> 3, part = F.tid & 7;
          u64* dst = SELT + ((size_t)(b * 64 + w) * 4096) + t0 + part * 2;
          dst[0] = mk[w * 16 + part * 2]; dst[1] = mk[w * 16 + part * 2 + 1]; }
        __syncthreads();
    }
}

constexpr int AT_KB = 9216, AT_VB = 8704, AT_BUF = AT_KB + AT_VB;
struct AttStage { u32x4 kreg, vreg; };
__device__ __forceinline__ void att_load(AttStage& s, const bf16_t* Kg, const bf16_t* Vtg, int key0, int tid) {
    s.kreg = *(const u32x4*)(Kg + (size_t)(key0 + (tid >> 3)) * 64 + (tid & 7) * 8);
    s.vreg = *(const u32x4*)(Vtg + (size_t)(tid >> 3) * 4096 + key0 + (tid & 7) * 8);
}
__device__ __forceinline__ void att_store(const AttStage& s, LAS unsigned char* buf, int tid) {
    *(LAS u32x4*)(buf + (tid >> 3) * 144 + (tid & 7) * 16) = s.kreg;
    LAS unsigned char* v = buf + AT_KB + (tid >> 3) * 136 + (tid & 7) * 16;
    *(LAS u32x2*)(v) = (u32x2){s.vreg.x, s.vreg.y}; *(LAS u32x2*)(v + 8) = (u32x2){s.vreg.z, s.vreg.w};
}
__device__ __forceinline__ bf16x8 pack8(float a0, float a1, float a2, float a3, float a4, float a5, float a6, float a7) {
    u32x4 w; w.x = pg8::cvt_pk_bf16(a0, a1); w.y = pg8::cvt_pk_bf16(a2, a3); w.z = pg8::cvt_pk_bf16(a4, a5); w.w = pg8::cvt_pk_bf16(a6, a7);
    return __builtin_bit_cast(bf16x8, w);
}
__device__ __forceinline__ f32x16 att_qk(const LAS unsigned char* buf, int sub, const bf16x8 (&Qf)[4], int lane) {
    f32x16 S = {0.f, 0.f, 0.f, 0.f, 0.f, 0.f, 0.f, 0.f, 0.f, 0.f, 0.f, 0.f, 0.f, 0.f, 0.f, 0.f};
    const LAS unsigned char* kp = buf + (sub * 32 + (lane & 31)) * 144 + (lane >> 5) * 16;
#pragma unroll
    for (int ks = 0; ks < 4; ++ks) { const bf16x8 kf = *(const LAS bf16x8*)(kp + ks * 32); S = __builtin_amdgcn_mfma_f32_32x32x16_bf16(kf, Qf[ks], S, 0, 0, 0); }
    return S;
}
__device__ __forceinline__ void att_pv2(const LAS unsigned char* buf, int sub, const bf16x8 P0, const bf16x8 P1, f32x16 (&O)[2], int lane) {
    const int h = lane >> 5;
#pragma unroll
    for (int dt = 0; dt < 2; ++dt) {
        const LAS unsigned char* vp = buf + AT_KB + (dt * 32 + (lane & 31)) * 136 + (sub * 32 + 4 * h) * 2;
        const u32x2 a0 = *(const LAS u32x2*)(vp), a1 = *(const LAS u32x2*)(vp + 16), b0 = *(const LAS u32x2*)(vp + 32), b1 = *(const LAS u32x2*)(vp + 48);
        const bf16x8 V0 = __builtin_bit_cast(bf16x8, ((u32x4){a0.x, a0.y, a1.x, a1.y}));
        const bf16x8 V1 = __builtin_bit_cast(bf16x8, ((u32x4){b0.x, b0.y, b1.x, b1.y}));
        O[dt] = __builtin_amdgcn_mfma_f32_32x32x16_bf16(V0, P0, O[dt], 0, 0, 0);
        O[dt] = __builtin_amdgcn_mfma_f32_32x32x16_bf16(V1, P1, O[dt], 0, 0, 0);
    }
}
__device__ __forceinline__ void att_pv(const LAS unsigned char* buf, int sub, const float (&p)[16], f32x16 (&O)[2], int lane) {
    const bf16x8 P0 = pack8(p[0], p[1], p[2], p[3], p[4], p[5], p[6], p[7]);
    const bf16x8 P1 = pack8(p[8], p[9], p[10], p[11], p[12], p[13], p[14], p[15]);
    att_pv2(buf, sub, P0, P1, O, lane);
}

__device__ __forceinline__ void p_dsa_attn(const Frame& F, const Args& a, unsigned char* ws) {
    const bf16_t* QA = (const bf16_t*)(ws + L0_QA); const bf16_t* KA = (const bf16_t*)(ws + L0_KA); const bf16_t* VAT = (const bf16_t*)(ws + L0_VAT);
    const u64* SELT = (const u64*)(ws + L0_SELT); bf16_t* CAT = (bf16_t*)(ws + L0_CAT);
    const int lane = F.lane, wave = F.wave, h = lane >> 5, c = lane & 31, tid = F.tid;
    float mq = 0.f, mk_ = 0.f;
    for (int i = 0; i < 64; ++i) { mq = fmaxf(mq, fabsf(a.in[I_L0_QG][i])); mk_ = fmaxf(mk_, fabsf(a.in[I_L0_KG][i])); }
    const float c2 = (8.0f * mq * mk_ + 0.5f) * 1.4426950408889634f, c1 = 1.4426950408889634f;
    for (int u = F.bid; u < 512; u += F.G) {
        const int idx = u & 255, g = u >> 8, b = idx >> 5, qtr = idx & 31, qt = g ? 31 - qtr : qtr, q0 = qt * 128;
        const size_t mb = (size_t)b * 4096;
        const bf16_t* Kg = KA + (size_t)(b * 2 + g) * 4096 * 64; const bf16_t* Vtg = VAT + (size_t)(b * 2 + g) * 64 * 4096;
        bf16x8 Qf[2][4]; int qidx[2];
#pragma unroll
        for (int ct = 0; ct < 2; ++ct) { qidx[ct] = q0 + wave * 16 + ct * 8 + (c >> 2);
#pragma unroll
            for (int ks = 0; ks < 4; ++ks) Qf[ct][ks] = *(const bf16x8*)(QA + (mb + qidx[ct]) * 512 + (g * 4 + (c & 3)) * 64 + ks * 16 + 8 * h); }
        f32x16 O[2][2]; float l[2] = {0.f, 0.f};
#pragma unroll
        for (int ct = 0; ct < 2; ++ct)
#pragma unroll
            for (int dt = 0; dt < 2; ++dt)
#pragma unroll
                for (int i = 0; i < 16; ++i) O[ct][dt][i] = 0.f;
        const int nkt = 2 * qt + 2;
        AttStage st; att_load(st, Kg, Vtg, 0, tid);
        __syncthreads();
        att_store(st, F.lds, tid);
        __syncthreads();
        for (int kt = 0; kt < nkt; ++kt) {
            LAS unsigned char* buf = F.lds + (kt & 1) * AT_BUF;
            if (kt + 1 < nkt) att_load(st, Kg, Vtg, (kt + 1) * 64, tid);
            u64 mw[2];
#pragma unroll
            for (int ct = 0; ct < 2; ++ct) mw[ct] = SELT[(size_t)(b * 64 + kt) * 4096 + qidx[ct]];
#pragma unroll 1
            for (int sub = 0; sub < 2; ++sub) {
#pragma unroll
                for (int ct = 0; ct < 2; ++ct) {
                    __builtin_amdgcn_sched_barrier(0);
                    const f32x16 S = att_qk(buf, sub, Qf[ct], lane);
                    const unsigned mbits = (unsigned)(mw[ct] >> (sub * 32 + 4 * h));
                    float p[16];
#pragma unroll
                    for (int i = 0; i < 16; ++i) {
                        const float e = __builtin_amdgcn_exp2f(S[i] * c1 - c2);
                        const int bitpos = (i & 3) + 8 * (i >> 2);
                        p[i] = __builtin_bit_cast(float, __builtin_bit_cast(int, e) & __builtin_amdgcn_sbfe((int)mbits, bitpos, 1));
                        l[ct] += p[i];
                    }
                    att_pv(buf, sub, p, O[ct], lane);
                }
            }
            if (kt + 1 < nkt) att_store(st, F.lds + ((kt + 1) & 1) * AT_BUF, tid);
            __syncthreads();
        }
#pragma unroll
        for (int ct = 0; ct < 2; ++ct) {
            const float lt = l[ct] + __shfl_xor(l[ct], 32);
            const float inv = 1.0f / fmaxf(lt, 1e-30f);
            bf16_t* orow = CAT + (mb + qidx[ct]) * 1024 + (g * 4 + (c & 3)) * 64;
#pragma unroll
            for (int dt = 0; dt < 2; ++dt)
#pragma unroll
                for (int i4 = 0; i4 < 4; ++i4) {
                    const int d = dt * 32 + 8 * i4 + 4 * h;
                    u32x2 w; w.x = pk2(O[ct][dt][4 * i4] * inv, O[ct][dt][4 * i4 + 1] * inv); w.y = pk2(O[ct][dt][4 * i4 + 2] * inv, O[ct][dt][4 * i4 + 3] * inv);
                    *(u32x2*)(orow + d) = w;
                }
        }
    }
}

__device__ __forceinline__ void p_s5_scan(const Frame& F, const Args& a, unsigned char* ws) {
    const float* SLOC = (const float*)(ws + L0_SLOC); bf16_t* UA = (bf16_t*)(ws + L0_UA);
    const int gw = F.bid * NWAVES + F.wave, NGW = F.G * NWAVES, p = F.lane;
    for (int it = gw; it < 32 * NB; it += NGW) {
        const int g = it >> 3, b = it & 7;
        const float dt = expf(a.in[I_L0_LOGDT][g]);
        const float lr = a.in[I_L0_ARE][g * 64 + p], li = a.in[I_L0_AIM][g * 64 + p];
        const float mag = expf(16.0f * dt * lr); float s, c; sincosf(16.0f * dt * li, &s, &c);
        const float ar = mag * c, ai = mag * s;
        float hr = 0.f, hi = 0.f;
        const float* sl = SLOC + ((size_t)g * 2048 + b * 256) * 128;
        bf16_t* ua = UA + ((size_t)g * 2048 + b * 256) * 384 + 256;
        for (int ch = 0; ch < 256; ++ch) {
            ua[(size_t)ch * 384 + p] = (bf16_t)f2bf(hr); ua[(size_t)ch * 384 + 64 + p] = (bf16_t)f2bf(hi);
            const float xr = sl[(size_t)ch * 128 + p], xi = sl[(size_t)ch * 128 + 64 + p];
            const float nr = ar * hr - ai * hi + xr, ni = ar * hi + ai * hr + xi;
            hr = nr; hi = ni;
        }
    }
}
namespace pg8 {
struct EpiS5State {
    static constexpr bool PERM = false;
    float* C;
    __device__ __forceinline__ void operator()(const f32x4 (&acc)[2][2][4][2], const Unit& u, int wr, int wc, int fr, int fq) const {
        const int row0 = u.pm * BM + wr * 64 + fr, col0 = wc * 32 + 4 * fq;
#pragma unroll
        for (int ai = 0; ai < 2; ++ai)
#pragma unroll
            for (int m = 0; m < 4; ++m)
#pragma unroll
                for (int n = 0; n < 2; ++n) *(f32x4*)(C + (size_t)(row0 + ai * HALF + m * 16) * 128 + col0 + n * 16) = acc[ai][0][m][n];
    }
};
struct EpiS5Out {
    static constexpr bool PERM = false;
    bf16_t* YB;
    __device__ __forceinline__ void operator()(const f32x4 (&acc)[2][2][4][2], const Unit& u, int wr, int wc, int fr, int fq) const {
        const int g = u.pn;
        const int row0 = u.pm * BM + wr * 64 + fr - g * 2048;
        const int col0 = wc * 32 + 4 * fq;
#pragma unroll
        for (int ai = 0; ai < 2; ++ai)
#pragma unroll
            for (int m = 0; m < 4; ++m) { const int chunk = row0 + ai * HALF + m * 16;
#pragma unroll
                for (int bj = 0; bj < 2; ++bj)
#pragma unroll
                    for (int n = 0; n < 2; ++n) { const int col = col0 + bj * HALF + n * 16, i = col >> 4, co = col & 15;
                        const f32x4 v = acc[ai][bj][m][n];
                        u32x2 w; w.x = pk2(gelu_tanh(v[0]), gelu_tanh(v[1])); w.y = pk2(gelu_tanh(v[2]), gelu_tanh(v[3]));
                        *(u32x2*)(YB + ((size_t)chunk * 16 + i) * 512 + g * 16 + co) = w; }
                asm volatile("" ::: "memory"); __builtin_amdgcn_sched_barrier(0); }
    }
};
struct EpiGlu {
    static constexpr bool PERM = true;
    const bf16_t* YB; const float* bias; bf16_t* CAT;
    __device__ __forceinline__ void operator()(const f32x4 (&acc)[2][2][4][2], const Unit& u, int wr, int wc, int fr, int fq) const {
        const int row0 = u.pm * BM + wr * 64 + fr, col0 = u.pn * BM + wc * 32 + 8 * fq;
#pragma unroll
        for (int ai = 0; ai < 2; ++ai)
#pragma unroll
            for (int m = 0; m < 4; ++m) { const size_t row = row0 + ai * HALF + m * 16;
#pragma unroll
                for (int bj = 0; bj < 2; ++bj) { const int col = col0 + bj * HALF;
                    const u32x4 yv = *(const u32x4*)(YB + row * 512 + col);
                    const f32x4 b0 = *(const f32x4*)(bias + col), b1 = *(const f32x4*)(bias + col + 4);
                    const f32x4 z0 = acc[ai][bj][m][0] + b0, z1 = acc[ai][bj][m][1] + b1;
                    u32x4 w;
                    w.x = pk2(bf_lo(yv.x) * sigmoidf_(z0[0]), bf_hi(yv.x) * sigmoidf_(z0[1])); w.y = pk2(bf_lo(yv.y) * sigmoidf_(z0[2]), bf_hi(yv.y) * sigmoidf_(z0[3]));
                    w.z = pk2(bf_lo(yv.z) * sigmoidf_(z1[0]), bf_hi(yv.z) * sigmoidf_(z1[1])); w.w = pk2(bf_lo(yv.w) * sigmoidf_(z1[2]), bf_hi(yv.w) * sigmoidf_(z1[3]));
                    *(u32x4*)(CAT + row * 1024 + 512 + col) = w; }
                asm volatile("" ::: "memory"); __builtin_amdgcn_sched_barrier(0); }
    }
};
}
__device__ __forceinline__ unsigned mono_u32(float f) { const unsigned u = __builtin_bit_cast(unsigned, f); return u ^ ((u >> 31) ? 0xFFFFFFFFu : 0x80000000u); }
#define CE_DESC(x, y) do { const unsigned _hi = (x) > (y) ? (x) : (y), _lo = (x) > (y) ? (y) : (x); (x) = _hi; (y) = _lo; } while (0)
__device__ __forceinline__ void sort16_desc(unsigned (&a)[16]) {
#pragma unroll
    for (int k = 2; k <= 16; k <<= 1)
#pragma unroll
        for (int j = k >> 1; j > 0; j >>= 1)
#pragma unroll
            for (int i = 0; i < 16; ++i) { const int l = i ^ j; if (l > i) { if ((i & k) == 0) CE_DESC(a[i], a[l]); else CE_DESC(a[l], a[i]); } }
}
__device__ __forceinline__ void merge16_desc(unsigned (&a)[16], const unsigned (&b)[16]) {
#pragma unroll
    for (int i = 0; i < 16; ++i) a[i] = a[i] > b[15 - i] ? a[i] : b[15 - i];
#pragma unroll
    for (int j = 8; j > 0; j >>= 1)
#pragma unroll
        for (int i = 0; i < 16; ++i) { const int l = i ^ j; if (l > i) CE_DESC(a[i], a[l]); }
}
__device__ __forceinline__ void merge16_xlane(unsigned (&a)[16]) {
    unsigned b[16];
#pragma unroll
    for (int i = 0; i < 16; ++i) b[i] = (unsigned)__shfl_xor((int)a[i], 32);
    merge16_desc(a, b);
}
struct PeerCand { int a[50], b[50]; };
__host__ __device__ constexpr PeerCand peer_cands() { PeerCand c{}; int n = 0; for (int a = 0; a < 16; ++a) for (int b = 0; b < 16; ++b) if ((a + 1) * (b + 1) <= 16) { c.a[n] = a; c.b[n] = b; ++n; } return c; }
__device__ __forceinline__ void p_peer_route(const Frame& F, unsigned char* ws, const bf16_t* SK) {
    const bf16_t* Q2 = (const bf16_t*)(ws + PE_Q2); unsigned short* EID = (unsigned short*)(ws + PE_EID); float* GATE = (float*)(ws + PE_GATE);
    LAS float* sc0 = (LAS float*)F.lds;
    const int lane = F.lane, wave = F.wave, h5 = lane >> 5, r = lane & 31, tid = F.tid;
    constexpr PeerCand PC = peer_cands();
    for (int u = F.bid; u < 2048; u += F.G) {
        const int hd = u & 7, mt = u >> 3; const size_t m0 = (size_t)mt * 128;
        {
            const int p = wave >> 2, rt = wave & 3;
            bf16x8 Af[8];
#pragma unroll
            for (int ks = 0; ks < 8; ++ks) Af[ks] = *(const bf16x8*)(Q2 + (m0 + rt * 32 + r) * 2048 + (hd * 2 + p) * 128 + ks * 16 + 8 * h5);
            LAS float* scp = sc0 + p * 128 * 129;
#pragma unroll 1
            for (int ct = 0; ct < 4; ++ct) {
                f32x16 acc = {0.f, 0.f, 0.f, 0.f, 0.f, 0.f, 0.f, 0.f, 0.f, 0.f, 0.f, 0.f, 0.f, 0.f, 0.f, 0.f};
#pragma unroll
                for (int ks = 0; ks < 8; ++ks) { const bf16x8 Bf = *(const bf16x8*)(SK + ((size_t)(hd * 2 + p) * 128 + ct * 32 + r) * 128 + ks * 16 + 8 * h5);
                    acc = __builtin_amdgcn_mfma_f32_32x32x16_bf16(Af[ks], Bf, acc, 0, 0, 0); }
#pragma unroll
                for (int i = 0; i < 16; ++i) scp[(rt * 32 + (i & 3) + 8 * (i >> 2) + 4 * h5) * 129 + ct * 32 + r] = acc[i];
            }
        }
        __syncthreads();
        {
            const int pp = wave >> 2, row = (wave & 3) * 32 + r, half = h5; LAS float* rowp = sc0 + pp * 128 * 129 + row * 129;
            unsigned top[16];
#pragma unroll
            for (int blk = 0; blk < 4; ++blk) {
                unsigned k16[16];
#pragma unroll
                for (int i = 0; i < 16; ++i) { const int j = half * 64 + blk * 16 + i; k16[i] = (mono_u32(rowp[j]) & ~0x7Fu) | (unsigned)(127 - j); }
                sort16_desc(k16);
                if (blk == 0) {
#pragma unroll
                    for (int i = 0; i < 16; ++i) top[i] = k16[i];
                } else merge16_desc(top, k16);
            }
            merge16_xlane(top);
            float vals[16]; int ids[16];
#pragma unroll
            for (int k = 0; k < 16; ++k) { ids[k] = 127 - (int)(top[k] & 127u); vals[k] = rowp[ids[k]]; }
            if (half == 0) {
#pragma unroll
                for (int k = 0; k < 16; ++k) { rowp[k] = vals[k]; rowp[16 + k] = __int_as_float(ids[k]); }
            }
        }
        __syncthreads();
        if (tid < 256) {
            const int row = (wave & 3) * 32 + r, half = h5; const LAS float* s1 = sc0 + row * 129; const LAS float* s2 = sc0 + 128 * 129 + row * 129;
            float v1[16], v2[16];
#pragma unroll
            for (int k = 0; k < 16; ++k) { v1[k] = s1[k]; v2[k] = s2[k]; }
            unsigned top[16], k16[16];
#pragma unroll
            for (int i = 0; i < 16; ++i) { const int c0 = 2 * i, c1 = 2 * i + 1;
                const unsigned ka = (mono_u32(v1[PC.a[c0]] + v2[PC.b[c0]]) & ~0xFFu) | (unsigned)(255 - (PC.a[c0] * 16 + PC.b[c0]));
                const unsigned kb = (mono_u32(v1[PC.a[c1]] + v2[PC.b[c1]]) & ~0xFFu) | (unsigned)(255 - (PC.a[c1] * 16 + PC.b[c1]));
                top[i] = half ? kb : ka; }
#pragma unroll
            for (int i = 0; i < 16; ++i) { if (i < 9) { const int c0 = 32 + 2 * i, c1 = 32 + 2 * i + 1;
                    const unsigned ka = (mono_u32(v1[PC.a[c0]] + v2[PC.b[c0]]) & ~0xFFu) | (unsigned)(255 - (PC.a[c0] * 16 + PC.b[c0]));
                    const unsigned kb = (mono_u32(v1[PC.a[c1]] + v2[PC.b[c1]]) & ~0xFFu) | (unsigned)(255 - (PC.a[c1] * 16 + PC.b[c1]));
                    k16[i] = half ? kb : ka; } else k16[i] = 0u; }
            sort16_desc(top); sort16_desc(k16); merge16_desc(top, k16);
            merge16_xlane(top);
            if (half == 0) {
                float mx = -3.0e38f; float sv[16]; int eid[16];
#pragma unroll
                for (int k = 0; k < 16; ++k) { const int fl = 255 - (int)(top[k] & 255u), a = fl >> 4, b = fl & 15;
                    sv[k] = s1[a] + s2[b]; eid[k] = __float_as_int(s1[16 + a]) * 128 + __float_as_int(s2[16 + b]); mx = fmaxf(mx, sv[k]); }
                float den = 0.f;
#pragma unroll
                for (int k = 0; k < 16; ++k) { sv[k] = __expf(sv[k] - mx); den += sv[k]; }
                const float inv = 1.0f / den;
                unsigned short* ep = EID + (m0 + row) * 128 + hd * 16; float* gp = GATE + (m0 + row) * 128 + hd * 16;
#pragma unroll
                for (int k = 0; k < 16; ++k) { ep[k] = (unsigned short)eid[k]; gp[k] = sv[k] * inv; }
            }
        }
        __syncthreads();
    }
}

__device__ __forceinline__ float rdlane_f(float v, int l) { return __builtin_bit_cast(float, __builtin_amdgcn_readlane(__builtin_bit_cast(int, v), l)); }
__device__ __forceinline__ void p_peer_expert(const Frame& F, unsigned char* ws, float* xres) {
    const bf16_t* XN = (const bf16_t*)(ws + WS_XN); const bf16_t* TU = (const bf16_t*)(ws + WS_TABU); const bf16_t* TV = (const bf16_t*)(ws + WS_TABV);
    const unsigned short* EID = (const unsigned short*)(ws + PE_EID); const float* GATE = (const float*)(ws + PE_GATE);
    const int gw = F.bid * NWAVES + F.wave, NGW = F.G * NWAVES, lane = F.lane;
    for (int m = gw; m < T; m += NGW) {
        float xf[16];
        { const u32x4 xa = *(const u32x4*)(XN + (size_t)m * 1024 + lane * 8), xb = *(const u32x4*)(XN + (size_t)m * 1024 + 512 + lane * 8);
          xf[0] = bf_lo(xa.x); xf[1] = bf_hi(xa.x); xf[2] = bf_lo(xa.y); xf[3] = bf_hi(xa.y); xf[4] = bf_lo(xa.z); xf[5] = bf_hi(xa.z); xf[6] = bf_lo(xa.w); xf[7] = bf_hi(xa.w);
          xf[8] = bf_lo(xb.x); xf[9] = bf_hi(xb.x); xf[10] = bf_lo(xb.y); xf[11] = bf_hi(xb.y); xf[12] = bf_lo(xb.z); xf[13] = bf_hi(xb.z); xf[14] = bf_lo(xb.w); xf[15] = bf_hi(xb.w); }
        const int id0 = EID[(size_t)m * 128 + lane], id1 = EID[(size_t)m * 128 + 64 + lane];
        const float g0 = GATE[(size_t)m * 128 + lane], g1 = GATE[(size_t)m * 128 + 64 + lane];
        float outv[16];
#pragma unroll
        for (int i = 0; i < 16; ++i) outv[i] = 0.f;
#pragma unroll 1
        for (int k = 0; k < 16; ++k) {
            const int idreg = (k < 8) ? id0 : id1; const float greg = (k < 8) ? g0 : g1; const int lbase = (k & 7) * 8;
            int e[8];
#pragma unroll
            for (int i = 0; i < 8; ++i) e[i] = __builtin_amdgcn_readlane(idreg, lbase + i);
            float pr[8];
            {
                u32x4 ua[8], ub[8];
#pragma unroll
                for (int i = 0; i < 8; ++i) { ua[i] = *(const u32x4*)(TU + (size_t)e[i] * 1024 + lane * 8); ub[i] = *(const u32x4*)(TU + (size_t)e[i] * 1024 + 512 + lane * 8); }
#pragma unroll
                for (int i = 0; i < 8; ++i) {
                    float s = xf[0] * bf_lo(ua[i].x); s += xf[1] * bf_hi(ua[i].x); s += xf[2] * bf_lo(ua[i].y); s += xf[3] * bf_hi(ua[i].y);
                    s += xf[4] * bf_lo(ua[i].z); s += xf[5] * bf_hi(ua[i].z); s += xf[6] * bf_lo(ua[i].w); s += xf[7] * bf_hi(ua[i].w);
                    s += xf[8] * bf_lo(ub[i].x); s += xf[9] * bf_hi(ub[i].x); s += xf[10] * bf_lo(ub[i].y); s += xf[11] * bf_hi(ub[i].y);
                    s += xf[12] * bf_lo(ub[i].z); s += xf[13] * bf_hi(ub[i].z); s += xf[14] * bf_lo(ub[i].w); s += xf[15] * bf_hi(ub[i].w);
                    pr[i] = s;
                }
            }
            float r4[4], r2[2], r1;
            { const bool up = (lane & 32) != 0;
#pragma unroll
              for (int i = 0; i < 4; ++i) { const float keep = up ? pr[i + 4] : pr[i], send = up ? pr[i] : pr[i + 4]; r4[i] = keep + __shfl_xor(send, 32); } }
            { const bool up = (lane & 16) != 0;
#pragma unroll
              for (int i = 0; i < 2; ++i) { const float keep = up ? r4[i + 2] : r4[i], send = up ? r4[i] : r4[i + 2]; r2[i] = keep + __shfl_xor(send, 16); } }
            { const bool up = (lane & 8) != 0; const float keep = up ? r2[1] : r2[0], send = up ? r2[0] : r2[1]; r1 = keep + __shfl_xor(send, 8); }
            r1 += __shfl_xor(r1, 4); r1 += __shfl_xor(r1, 2); r1 += __shfl_xor(r1, 1);
            const float gv = __shfl(greg, lbase + (lane >> 3));
            const float coef = gv * gelu_tanh(r1);
            {
                u32x4 va[8], vb[8];
#pragma unroll
                for (int i = 0; i < 8; ++i) { va[i] = *(const u32x4*)(TV + (size_t)e[i] * 1024 + lane * 8); vb[i] = *(const u32x4*)(TV + (size_t)e[i] * 1024 + 512 + lane * 8); }
#pragma unroll
                for (int i = 0; i < 8; ++i) {
                    const float ci = rdlane_f(coef, i * 8);
                    outv[0] += ci * bf_lo(va[i].x); outv[1] += ci * bf_hi(va[i].x); outv[2] += ci * bf_lo(va[i].y); outv[3] += ci * bf_hi(va[i].y);
                    outv[4] += ci * bf_lo(va[i].z); outv[5] += ci * bf_hi(va[i].z); outv[6] += ci * bf_lo(va[i].w); outv[7] += ci * bf_hi(va[i].w);
                    outv[8] += ci * bf_lo(vb[i].x); outv[9] += ci * bf_hi(vb[i].x); outv[10] += ci * bf_lo(vb[i].y); outv[11] += ci * bf_hi(vb[i].y);
                    outv[12] += ci * bf_lo(vb[i].z); outv[13] += ci * bf_hi(vb[i].z); outv[14] += ci * bf_lo(vb[i].w); outv[15] += ci * bf_hi(vb[i].w);
                }
            }
        }
        f32x4* o = (f32x4*)(xres + (size_t)m * 1024 + lane * 8);
        f32x4 a0 = o[0], a1 = o[1], b0 = o[128], b1 = o[129];
        a0 += (f32x4){outv[0], outv[1], outv[2], outv[3]}; a1 += (f32x4){outv[4], outv[5], outv[6], outv[7]};
        b0 += (f32x4){outv[8], outv[9], outv[10], outv[11]}; b1 += (f32x4){outv[12], outv[13], outv[14], outv[15]};
        o[0] = a0; o[1] = a1; o[128] = b0; o[129] = b1;
    }
}

typedef __bf16 bf16x2_t __attribute__((ext_vector_type(2)));
__device__ __forceinline__ float dot2bf(unsigned a, unsigned b, float c) { return __builtin_amdgcn_fdot2_f32_bf16(__builtin_bit_cast(bf16x2_t, a), __builtin_bit_cast(bf16x2_t, b), c, false); }
__device__ __forceinline__ void peer_slot_range(const unsigned (&xp)[8], float (&outv)[16], int id0, int id1, float g0, float g1, int r,
                                                const bf16_t* TU, const bf16_t* TV, int lane) {
    u64 m0 = __ballot((id0 >> 9) == r), m1 = __ballot((id1 >> 9) == r);
    while (m0 | m1) {
        int e[8]; float gt[8];
#pragma unroll
        for (int i = 0; i < 8; ++i) {
            if (m0) { const int l = __builtin_ctzll(m0); m0 &= m0 - 1ull; e[i] = __builtin_amdgcn_readlane(id0, l); gt[i] = rdlane_f(g0, l); }
            else if (m1) { const int l = __builtin_ctzll(m1); m1 &= m1 - 1ull; e[i] = __builtin_amdgcn_readlane(id1, l); gt[i] = rdlane_f(g1, l); }
            else { e[i] = -1; gt[i] = 0.f; }
        }
        float pr[8];
        {
            u32x4 ua[8], ub[8];
#pragma unroll
            for (int i = 0; i < 8; ++i) {
                if (e[i] >= 0) { ua[i] = *(const u32x4*)(TU + (size_t)e[i] * 1024 + lane * 8); ub[i] = *(const u32x4*)(TU + (size_t)e[i] * 1024 + 512 + lane * 8); }
                else { ua[i] = (u32x4){0u, 0u, 0u, 0u}; ub[i] = (u32x4){0u, 0u, 0u, 0u}; }
            }
#pragma unroll
            for (int i = 0; i < 8; ++i) {
                float s = dot2bf(xp[0], ua[i].x, 0.f); s = dot2bf(xp[1], ua[i].y, s); s = dot2bf(xp[2], ua[i].z, s); s = dot2bf(xp[3], ua[i].w, s);
                s = dot2bf(xp[4], ub[i].x, s); s = dot2bf(xp[5], ub[i].y, s); s = dot2bf(xp[6], ub[i].z, s); s = dot2bf(xp[7], ub[i].w, s);
                pr[i] = s;
            }
        }
        float r4[4], r2[2], r1;
        { const bool up = (lane & 32) != 0;
#pragma unroll
          for (int i = 0; i < 4; ++i) { const float keep = up ? pr[i + 4] : pr[i], send = up ? pr[i] : pr[i + 4]; r4[i] = keep + __shfl_xor(send, 32); } }
        { const bool up = (lane & 16) != 0;
#pragma unroll
          for (int i = 0; i < 2; ++i) { const float keep = up ? r4[i + 2] : r4[i], send = up ? r4[i] : r4[i + 2]; r2[i] = keep + __shfl_xor(send, 16); } }
        { const bool up = (lane & 8) != 0; const float keep = up ? r2[1] : r2[0], send = up ? r2[0] : r2[1]; r1 = keep + __shfl_xor(send, 8); }
        r1 += __shfl_xor(r1, 4); r1 += __shfl_xor(r1, 2); r1 += __shfl_xor(r1, 1);
        const int grp = lane >> 3;
        float gsel = gt[0];
#pragma unroll
        for (int i = 1; i < 8; ++i) gsel = (grp == i) ? gt[i] : gsel;
        const float coef = gsel * gelu_tanh(r1);
        {
            u32x4 va[8], vb[8];
#pragma unroll
            for (int i = 0; i < 8; ++i) {
                if (e[i] >= 0) { va[i] = *(const u32x4*)(TV + (size_t)e[i] * 1024 + lane * 8); vb[i] = *(const u32x4*)(TV + (size_t)e[i] * 1024 + 512 + lane * 8); }
                else { va[i] = (u32x4){0u, 0u, 0u, 0u}; vb[i] = (u32x4){0u, 0u, 0u, 0u}; }
            }
#pragma unroll
            for (int i = 0; i < 8; ++i) {
                if (e[i] >= 0) {
                    const float ci = rdlane_f(coef, i * 8);
                    outv[0] += ci * bf_lo(va[i].x); outv[1] += ci * bf_hi(va[i].x); outv[2] += ci * bf_lo(va[i].y); outv[3] += ci * bf_hi(va[i].y);
                    outv[4] += ci * bf_lo(va[i].z); outv[5] += ci * bf_hi(va[i].z); outv[6] += ci * bf_lo(va[i].w); outv[7] += ci * bf_hi(va[i].w);
                    outv[8] += ci * bf_lo(vb[i].x); outv[9] += ci * bf_hi(vb[i].x); outv[10] += ci * bf_lo(vb[i].y); outv[11] += ci * bf_hi(vb[i].y);
                    outv[12] += ci * bf_lo(vb[i].z); outv[13] += ci * bf_hi(vb[i].z); outv[14] += ci * bf_lo(vb[i].w); outv[15] += ci * bf_hi(vb[i].w);
                }
            }
        }
    }
}
__device__ __forceinline__ void p_peer_expert2(const Frame& F, unsigned char* ws, float* xres, const float oscale) {
    const bf16_t* XN = (const bf16_t*)(ws + WS_XN); const bf16_t* TU = (const bf16_t*)(ws + WS_TABU); const bf16_t* TV = (const bf16_t*)(ws + WS_TABV);
    const unsigned short* EID = (const unsigned short*)(ws + PE_EID); const float* GATE = (const float*)(ws + PE_GATE);
    const int gw = F.bid * NWAVES + F.wave, NGW = F.G * NWAVES, lane = F.lane;
    int rnd = 0;
    for (int m4 = gw * 4; m4 < T; m4 += NGW * 4, ++rnd) {
        unsigned xp[4][8]; float outv[4][16]; int id[4][2]; float gg[4][2];
#pragma unroll
        for (int s = 0; s < 4; ++s) {
            const size_t m = (size_t)(m4 + s);
            const u32x4 xa = *(const u32x4*)(XN + m * 1024 + lane * 8), xb = *(const u32x4*)(XN + m * 1024 + 512 + lane * 8);
            xp[s][0] = xa.x; xp[s][1] = xa.y; xp[s][2] = xa.z; xp[s][3] = xa.w; xp[s][4] = xb.x; xp[s][5] = xb.y; xp[s][6] = xb.z; xp[s][7] = xb.w;
            id[s][0] = EID[m * 128 + lane]; id[s][1] = EID[m * 128 + 64 + lane]; gg[s][0] = GATE[m * 128 + lane]; gg[s][1] = GATE[m * 128 + 64 + lane];
#pragma unroll
            for (int i = 0; i < 16; ++i) outv[s][i] = 0.f;
        }
#pragma unroll 1
        for (int k = 0; k < 32; ++k) {
            const int r = (rnd & 1) ? 31 - k : k;
#pragma unroll
            for (int s = 0; s < 4; ++s) peer_slot_range(xp[s], outv[s], id[s][0], id[s][1], gg[s][0], gg[s][1], r, TU, TV, lane);
        }
#pragma unroll
        for (int s = 0; s < 4; ++s) {
            f32x4* o = (f32x4*)(xres + (size_t)(m4 + s) * 1024 + lane * 8);
            f32x4 a0 = o[0], a1 = o[1], b0 = o[128], b1 = o[129];
            a0 += (f32x4){outv[s][0], outv[s][1], outv[s][2], outv[s][3]} * oscale; a1 += (f32x4){outv[s][4], outv[s][5], outv[s][6], outv[s][7]} * oscale;
            b0 += (f32x4){outv[s][8], outv[s][9], outv[s][10], outv[s][11]} * oscale; b1 += (f32x4){outv[s][12], outv[s][13], outv[s][14], outv[s][15]} * oscale;
            o[0] = a0; o[1] = a1; o[128] = b0; o[129] = b1;
        }
    }
}

struct RowBuf { u32x4 a[8], b[8]; };
__device__ __forceinline__ void peer_load8(RowBuf& rb, const bf16_t* TAB, const LAS unsigned* ent, int b, int lane) {
#pragma unroll
    for (int i = 0; i < 8; ++i) {
        const unsigned e = (unsigned)__builtin_amdgcn_readfirstlane((int)ent[b * 8 + i]) & 0x3FFFu;
        const bf16_t* rp = TAB + (size_t)e * 1024 + lane * 8;
        rb.a[i] = *(const u32x4*)rp; rb.b[i] = *(const u32x4*)(rp + 512);
    }
}
__device__ __forceinline__ float peer_dot(const unsigned (&xp)[8], const u32x4 a, const u32x4 b) {
    float s = dot2bf(xp[0], a.x, 0.f); s = dot2bf(xp[1], a.y, s); s = dot2bf(xp[2], a.z, s); s = dot2bf(xp[3], a.w, s);
    s = dot2bf(xp[4], b.x, s); s = dot2bf(xp[5], b.y, s); s = dot2bf(xp[6], b.z, s); s = dot2bf(xp[7], b.w, s);
    return s;
}
__device__ __forceinline__ void peer_u8(const RowBuf& rb, const unsigned (&xp)[4][8], const LAS unsigned* ent, LAS float* cf, int b, int lane) {
    float pr[8];
#pragma unroll
    for (int i = 0; i < 8; ++i) {
        const int slot = (__builtin_amdgcn_readfirstlane((int)ent[b * 8 + i]) >> 21) & 3;
        if (slot == 0) pr[i] = peer_dot(xp[0], rb.a[i], rb.b[i]);
        else if (slot == 1) pr[i] = peer_dot(xp[1], rb.a[i], rb.b[i]);
        else if (slot == 2) pr[i] = peer_dot(xp[2], rb.a[i], rb.b[i]);
        else pr[i] = peer_dot(xp[3], rb.a[i], rb.b[i]);
    }
    float r4[4], r2[2], r1;
    { const bool up = (lane & 32) != 0;
#pragma unroll
      for (int i = 0; i < 4; ++i) { const float keep = up ? pr[i + 4] : pr[i], send = up ? pr[i] : pr[i + 4]; r4[i] = keep + __shfl_xor(send, 32); } }
    { const bool up = (lane & 16) != 0;
#pragma unroll
      for (int i = 0; i < 2; ++i) { const float keep = up ? r4[i + 2] : r4[i], send = up ? r4[i] : r4[i + 2]; r2[i] = keep + __shfl_xor(send, 16); } }
    { const bool up = (lane & 8) != 0; const float keep = up ? r2[1] : r2[0], send = up ? r2[0] : r2[1]; r1 = keep + __shfl_xor(send, 8); }
    r1 += __shfl_xor(r1, 4); r1 += __shfl_xor(r1, 2); r1 += __shfl_xor(r1, 1);
    const float gate = cf[b * 8 + (lane >> 3)];
    const float coef = gate * gelu_tanh(r1);
    if ((lane & 7) == 0) cf[b * 8 + (lane >> 3)] = coef;
}
__device__ __forceinline__ void peer_acc(float (&o)[16], const float c, const u32x4 a, const u32x4 b) {
    o[0] += c * bf_lo(a.x); o[1] += c * bf_hi(a.x); o[2] += c * bf_lo(a.y); o[3] += c * bf_hi(a.y);
    o[4] += c * bf_lo(a.z); o[5] += c * bf_hi(a.z); o[6] += c * bf_lo(a.w); o[7] += c * bf_hi(a.w);
    o[8] += c * bf_lo(b.x); o[9] += c * bf_hi(b.x); o[10] += c * bf_lo(b.y); o[11] += c * bf_hi(b.y);
    o[12] += c * bf_lo(b.z); o[13] += c * bf_hi(b.z); o[14] += c * bf_lo(b.w); o[15] += c * bf_hi(b.w);
}
__device__ __forceinline__ void peer_v8(const RowBuf& rb, float (&outv)[4][16], const LAS unsigned* ent, const LAS float* cf, int b) {
#pragma unroll
    for (int i = 0; i < 8; ++i) {
        const int slot = (__builtin_amdgcn_readfirstlane((int)ent[b * 8 + i]) >> 21) & 3;
        const float c = cf[b * 8 + i];
        if (slot == 0) peer_acc(outv[0], c, rb.a[i], rb.b[i]);
        else if (slot == 1) peer_acc(outv[1], c, rb.a[i], rb.b[i]);
        else if (slot == 2) peer_acc(outv[2], c, rb.a[i], rb.b[i]);
        else peer_acc(outv[3], c, rb.a[i], rb.b[i]);
    }
}
__device__ __forceinline__ void p_peer_expert3(const Frame& F, unsigned char* ws, float* xres, const float oscale, const XcdBarrier& xbar) {
    const bf16_t* XN = (const bf16_t*)(ws + WS_XN); const bf16_t* TU = (const bf16_t*)(ws + WS_TABU); const bf16_t* TV = (const bf16_t*)(ws + WS_TABV);
    const unsigned short* EID = (const unsigned short*)(ws + PE_EID); const float* GATE = (const float*)(ws + PE_GATE);
    const int gw = F.bid * NWAVES + F.wave, NGW = F.G * NWAVES, lane = F.lane;
    LAS unsigned* ent = (LAS unsigned*)(F.lds + F.wave * 4096);
    LAS float* cf = (LAS float*)(F.lds + F.wave * 4096 + 2048);
    const int nrounds = (T + NGW * 4 - 1) / (NGW * 4);
    for (int rnd = 0; rnd < nrounds; ++rnd) {
        const int m4 = (rnd * NGW + gw) * 4;
        if (m4 < T) {
            unsigned xp[4][8];
            {
                int id[4][2]; float gg[4][2];
#pragma unroll
                for (int s = 0; s < 4; ++s) {
                    const size_t m = (size_t)(m4 + s);
                    const u32x4 xa = *(const u32x4*)(XN + m * 1024 + lane * 8), xb = *(const u32x4*)(XN + m * 1024 + 512 + lane * 8);
                    xp[s][0] = xa.x; xp[s][1] = xa.y; xp[s][2] = xa.z; xp[s][3] = xa.w; xp[s][4] = xb.x; xp[s][5] = xb.y; xp[s][6] = xb.z; xp[s][7] = xb.w;
                    id[s][0] = EID[m * 128 + lane]; id[s][1] = EID[m * 128 + 64 + lane]; gg[s][0] = GATE[m * 128 + lane]; gg[s][1] = GATE[m * 128 + 64 + lane];
                }
                int base = 0;
#pragma unroll 1
                for (int k = 0; k < 32; ++k) {
                    const int r = (rnd & 1) ? 31 - k : k;
#pragma unroll
                    for (int s = 0; s < 4; ++s)
#pragma unroll
                        for (int w = 0; w < 2; ++w) {
                            const bool hit = (id[s][w] >> 9) == r;
                            const u64 m = __ballot(hit);
                            if (hit) { const int pos = base + (int)__builtin_amdgcn_mbcnt_hi((unsigned)(m >> 32), __builtin_amdgcn_mbcnt_lo((unsigned)m, 0u));
                                ent[pos] = ((unsigned)s << 21) | ((unsigned)(w * 64 + lane) << 14) | (unsigned)id[s][w]; cf[pos] = gg[s][w]; }
                            base += __builtin_popcountll(m);
                        }
                }
            }
            LDS_WAIT();
            {
                RowBuf A, B;
                peer_load8(A, TU, ent, 0, lane);
#pragma unroll 1
                for (int b = 0; b < 64; b += 2) {
                    peer_load8(B, TU, ent, b + 1, lane);
                    peer_u8(A, xp, ent, cf, b, lane);
                    if (b + 2 < 64) peer_load8(A, TU, ent, b + 2, lane);
                    peer_u8(B, xp, ent, cf, b + 1, lane);
                }
            }
            LDS_WAIT();
            float outv[4][16];
#pragma unroll
            for (int s = 0; s < 4; ++s)
#pragma unroll
                for (int i = 0; i < 16; ++i) outv[s][i] = 0.f;
            {
                RowBuf A, B;
                peer_load8(A, TV, ent, 0, lane);
#pragma unroll 1
                for (int b = 0; b < 64; b += 2) {
                    peer_load8(B, TV, ent, b + 1, lane);
                    peer_v8(A, outv, ent, cf, b);
                    if (b + 2 < 64) peer_load8(A, TV, ent, b + 2, lane);
                    peer_v8(B, outv, ent, cf, b + 1);
                }
            }
#pragma unroll
            for (int s = 0; s < 4; ++s) {
                f32x4* o = (f32x4*)(xres + (size_t)(m4 + s) * 1024 + lane * 8);
                f32x4 a0 = o[0], a1 = o[1], b0 = o[128], b1 = o[129];
                a0 += (f32x4){outv[s][0], outv[s][1], outv[s][2], outv[s][3]} * oscale; a1 += (f32x4){outv[s][4], outv[s][5], outv[s][6], outv[s][7]} * oscale;
                b0 += (f32x4){outv[s][8], outv[s][9], outv[s][10], outv[s][11]} * oscale; b1 += (f32x4){outv[s][12], outv[s][13], outv[s][14], outv[s][15]} * oscale;
                o[0] = a0; o[1] = a1; o[128] = b0; o[129] = b1;
            }
        }
        if (rnd + 1 < nrounds) xcd_barrier(xbar);
    }
}

constexpr size_t WS_TAB8U = WS_TABU;
constexpr size_t WS_TAB8V = WS_TABU + 16 * MiB;
constexpr size_t WS_TABSU = WS_TABU + 32 * MiB;
constexpr size_t WS_TABSV = WS_TABU + 32 * MiB + 65536;
__device__ __forceinline__ void cvt_table_fp8(const Frame& F, const float* src, unsigned char* dst, float* scales) {
    const int gw = F.bid * NWAVES + F.wave, NGW = F.G * NWAVES, lane = F.lane;
    for (int r = gw; r < 16384; r += NGW) {
        const f32x4* p = (const f32x4*)(src + (size_t)r * 1024 + lane * 16);
        f32x4 v[4]; float am = 0.f;
#pragma unroll
        for (int j = 0; j < 4; ++j) { v[j] = p[j]; am = fmaxf(am, fmaxf(fmaxf(fabsf(v[j].x), fabsf(v[j].y)), fmaxf(fabsf(v[j].z), fabsf(v[j].w)))); }
#pragma unroll
        for (int o = 1; o < 64; o <<= 1) am = fmaxf(am, __shfl_xor(am, o));
        const float sc = am > 0.f ? am * (1.0f / 448.0f) : 1.0f, inv = 1.0f / sc;
        u32x4 q;
#pragma unroll
        for (int j = 0; j < 4; ++j) { int w = 0; w = __builtin_amdgcn_cvt_pk_fp8_f32(v[j].x * inv, v[j].y * inv, w, false); w = __builtin_amdgcn_cvt_pk_fp8_f32(v[j].z * inv, v[j].w * inv, w, true); q[j] = (unsigned)w; }
        *(u32x4*)(dst + (size_t)r * 1024 + lane * 16) = q;
        if (lane == 0) scales[r] = sc;
    }
}
template <int NR> struct RowBufN { u32x4 a[NR]; };
template <int NR>
__device__ __forceinline__ void peer_loadN(RowBufN<NR>& rb, const unsigned char* TAB, const LAS unsigned* ent, int b, int lane) {
    const int ev = (int)ent[b * NR + (lane & (NR - 1))];
#pragma unroll
    for (int i = 0; i < NR; ++i) {
        const unsigned e = (unsigned)__builtin_amdgcn_readlane(ev, i) & 0x3FFFu;
        rb.a[i] = *(const u32x4*)(TAB + (size_t)e * 1024 + lane * 16);
    }
}
__device__ __forceinline__ float peer_dot8x(const u32x4 xa, const u32x4 xb, const u32x4 q) {
    float s = 0.f;
#pragma unroll
    for (int j = 0; j < 4; ++j) {
        const f32x2 lo = __builtin_amdgcn_cvt_pk_f32_fp8((int)q[j], false), hi = __builtin_amdgcn_cvt_pk_f32_fp8((int)q[j], true);
        const unsigned x0 = (j < 2) ? xa[2 * j] : xb[2 * j - 4], x1 = (j < 2) ? xa[2 * j + 1] : xb[2 * j - 3];
        s += bf_lo(x0) * lo.x; s += bf_hi(x0) * lo.y; s += bf_lo(x1) * hi.x; s += bf_hi(x1) * hi.y;
    }
    return s;
}
template <int NR>
__device__ __forceinline__ void peer_u8x(const RowBufN<NR>& rb, int r0, const LAS unsigned char* xl, const LAS unsigned* ent, LAS float* cf, const LAS float* sul, int e0, int lane) {
    float pr[8];
    const int ev = (int)ent[e0 + (lane & 7)];
#pragma unroll
    for (int i = 0; i < 8; ++i) {
        const int slot = (__builtin_amdgcn_readlane(ev, i) >> 21) & 3;
        const LAS unsigned char* xp = xl + slot * 2048 + lane * 32;
        const u32x4 xa = *(const LAS u32x4*)xp, xb = *(const LAS u32x4*)(xp + 16);
        pr[i] = peer_dot8x(xa, xb, rb.a[r0 + i]);
    }
    float r4[4], r2[2], r1;
    { const bool up = (lane & 32) != 0;
#pragma unroll
      for (int i = 0; i < 4; ++i) { const float keep = up ? pr[i + 4] : pr[i], send = up ? pr[i] : pr[i + 4]; r4[i] = keep + __shfl_xor(send, 32); } }
    { const bool up = (lane & 16) != 0;
#pragma unroll
      for (int i = 0; i < 2; ++i) { const float keep = up ? r4[i + 2] : r4[i], send = up ? r4[i] : r4[i + 2]; r2[i] = keep + __shfl_xor(send, 16); } }
    { const bool up = (lane & 8) != 0; const float keep = up ? r2[1] : r2[0], send = up ? r2[0] : r2[1]; r1 = keep + __shfl_xor(send, 8); }
    r1 += __shfl_xor(r1, 4); r1 += __shfl_xor(r1, 2); r1 += __shfl_xor(r1, 1);
    const float gate = cf[e0 + (lane >> 3)];
    const float coef = gate * gelu_tanh(r1 * sul[e0 + (lane >> 3)]);
    if ((lane & 7) == 0) cf[e0 + (lane >> 3)] = coef;
}
__device__ __forceinline__ void peer_acc8(float (&o)[16], const float c, const u32x4 q) {
#pragma unroll
    for (int j = 0; j < 4; ++j) { const f32x2 lo = __builtin_amdgcn_cvt_pk_f32_fp8((int)q[j], false), hi = __builtin_amdgcn_cvt_pk_f32_fp8((int)q[j], true);
        o[4 * j] += c * lo.x; o[4 * j + 1] += c * lo.y; o[4 * j + 2] += c * hi.x; o[4 * j + 3] += c * hi.y; }
}
template <int NR>
__device__ __forceinline__ void peer_vN(const RowBufN<NR>& rb, float (&outv)[4][16], const LAS unsigned* ent, const LAS float* cf, int b, int lane) {
    const int ev = (int)ent[b * NR + (lane & (NR - 1))]; const float cv = cf[b * NR + (lane & (NR - 1))];
#pragma unroll
    for (int i = 0; i < NR; ++i) {
        const int slot = (__builtin_amdgcn_readlane(ev, i) >> 21) & 3;
        const float c = rdlane_f(cv, i);
        if (slot == 0) peer_acc8(outv[0], c, rb.a[i]);
        else if (slot == 1) peer_acc8(outv[1], c, rb.a[i]);
        else if (slot == 2) peer_acc8(outv[2], c, rb.a[i]);
        else peer_acc8(outv[3], c, rb.a[i]);
    }
}
__device__ __forceinline__ void p_peer_expert4(const Frame& F, unsigned char* ws, float* xres, const float oscale, const XcdBarrier& xbar, const int mode) {
    const bf16_t* XN = (const bf16_t*)(ws + WS_XN); const unsigned char* TU = ws + WS_TAB8U; const unsigned char* TV = ws + WS_TAB8V;
    const float* SU = (const float*)(ws + WS_TABSU); const float* SV = (const float*)(ws + WS_TABSV);
    const unsigned short* EID = (const unsigned short*)(ws + PE_EID); const float* GATE = (const float*)(ws + PE_GATE);
    const int gw = F.bid * NWAVES + F.wave, NGW = F.G * NWAVES, lane = F.lane;
    LAS unsigned* ent = (LAS unsigned*)(F.lds + F.wave * 6144);
    LAS float* cf = (LAS float*)(F.lds + F.wave * 6144 + 2048);
    LAS float* sul = (LAS float*)(F.lds + F.wave * 6144 + 4096);
    LAS unsigned char* xl = F.lds + 49152 + F.wave * 8192;
    constexpr int PU = 16, PV = 8;
    const int nrounds = (T + NGW * 4 - 1) / (NGW * 4);
    for (int rnd = 0; rnd < nrounds; ++rnd) {
        const int m4 = (rnd * NGW + gw) * 4;
        if (m4 < T) {
            {
                int id[4][2]; float gg[4][2], su[4][2];
#pragma unroll
                for (int s = 0; s < 4; ++s) { const size_t m = (size_t)(m4 + s);
                    id[s][0] = EID[m * 128 + lane]; id[s][1] = EID[m * 128 + 64 + lane]; gg[s][0] = GATE[m * 128 + lane] * SV[id[s][0]]; gg[s][1] = GATE[m * 128 + 64 + lane] * SV[id[s][1]]; su[s][0] = SU[id[s][0]]; su[s][1] = SU[id[s][1]]; }
                int base = 0;
#pragma unroll 1
                for (int k = 0; k < 16; ++k) {
                    const int r = (rnd & 1) ? 15 - k : k;
#pragma unroll
                    for (int s = 0; s < 4; ++s)
#pragma unroll
                        for (int w = 0; w < 2; ++w) {
                            const bool hit = (id[s][w] >> 10) == r;
                            const u64 m = __ballot(hit);
                            if (hit) { const int pos = base + (int)__builtin_amdgcn_mbcnt_hi((unsigned)(m >> 32), __builtin_amdgcn_mbcnt_lo((unsigned)m, 0u));
                                ent[pos] = ((unsigned)s << 21) | ((unsigned)(w * 64 + lane) << 14) | (unsigned)(mode == 4 ? (id[s][w] & 7) : id[s][w]); cf[pos] = gg[s][w]; sul[pos] = su[s][w]; }
                            base += __builtin_popcountll(m);
                        }
                }
            }
            LDS_WAIT();
            if (mode != 1 && mode != 3) {
#pragma unroll
                for (int s = 0; s < 4; ++s) { const size_t m = (size_t)(m4 + s);
                    const u32x4 xa = *(const u32x4*)(XN + m * 1024 + lane * 16), xb = *(const u32x4*)(XN + m * 1024 + lane * 16 + 8);
                    *(LAS u32x4*)(xl + s * 2048 + lane * 32) = xa; *(LAS u32x4*)(xl + s * 2048 + lane * 32 + 16) = xb; }
                LDS_WAIT();
                RowBufN<PU> A, B;
                peer_loadN<PU>(A, TU, ent, 0, lane);
#pragma unroll 1
                for (int b = 0; b < 512 / PU; b += 2) {
                    peer_loadN<PU>(B, TU, ent, b + 1, lane);
#pragma unroll
                    for (int h = 0; h < PU / 8; ++h) peer_u8x<PU>(A, h * 8, xl, ent, cf, sul, b * PU + h * 8, lane);
                    if (b + 2 < 512 / PU) peer_loadN<PU>(A, TU, ent, b + 2, lane);
#pragma unroll
                    for (int h = 0; h < PU / 8; ++h) peer_u8x<PU>(B, h * 8, xl, ent, cf, sul, (b + 1) * PU + h * 8, lane);
                }
            }
            LDS_WAIT();
            float outv[4][16];
#pragma unroll
            for (int s = 0; s < 4; ++s)
#pragma unroll
                for (int i = 0; i < 16; ++i) outv[s][i] = 0.f;
            if (mode != 1 && mode != 2) {
                RowBufN<PV> A, B;
                peer_loadN<PV>(A, TV, ent, 0, lane);
#pragma unroll 1
                for (int b = 0; b < 512 / PV; b += 2) {
                    peer_loadN<PV>(B, TV, ent, b + 1, lane);
                    peer_vN<PV>(A, outv, ent, cf, b, lane);
                    if (b + 2 < 512 / PV) peer_loadN<PV>(A, TV, ent, b + 2, lane);
                    peer_vN<PV>(B, outv, ent, cf, b + 1, lane);
                }
            }
#pragma unroll
            for (int s = 0; s < 4; ++s) {
                f32x4* o = (f32x4*)(xres + (size_t)(m4 + s) * 1024 + lane * 16);
#pragma unroll
                for (int j = 0; j < 4; ++j) { f32x4 a0 = o[j]; a0 += (f32x4){outv[s][4 * j], outv[s][4 * j + 1], outv[s][4 * j + 2], outv[s][4 * j + 3]} * oscale; o[j] = a0; }
            }
        }
        if (rnd + 1 < nrounds) xcd_barrier(xbar);
    }
}

__device__ __forceinline__ void cvt_table_i8(const Frame& F, const float* src, unsigned char* dst, float* scales) {
    const int gw = F.bid * NWAVES + F.wave, NGW = F.G * NWAVES, lane = F.lane;
    for (int r = gw; r < 16384; r += NGW) {
        const f32x4* p = (const f32x4*)(src + (size_t)r * 1024 + lane * 16);
        f32x4 v[4]; float am = 0.f;
#pragma unroll
        for (int j = 0; j < 4; ++j) { v[j] = p[j]; am = fmaxf(am, fmaxf(fmaxf(fabsf(v[j].x), fabsf(v[j].y)), fmaxf(fabsf(v[j].z), fabsf(v[j].w)))); }
#pragma unroll
        for (int o = 1; o < 64; o <<= 1) am = fmaxf(am, __shfl_xor(am, o));
        const float sc = am > 0.f ? am * (1.0f / 127.0f) : 1.0f, inv = 1.0f / sc;
        u32x4 q;
#pragma unroll
        for (int j = 0; j < 4; ++j) { const int a = (int)rintf(v[j].x * inv), b = (int)rintf(v[j].y * inv), c = (int)rintf(v[j].z * inv), d = (int)rintf(v[j].w * inv);
            q[j] = (unsigned)(a & 255) | ((unsigned)(b & 255) << 8) | ((unsigned)(c & 255) << 16) | ((unsigned)(d & 255) << 24); }
        *(u32x4*)(dst + (size_t)r * 1024 + lane * 16) = q;
        if (lane == 0) scales[r] = sc;
    }
}
template <int NR>
__device__ __forceinline__ void peer_u8i(const RowBufN<NR>& rb, int r0, const LAS unsigned char* xq, const LAS unsigned* ent, LAS float* cf, const LAS float* sul, int e0, int lane) {
    int pr[8];
    const int ev = (int)ent[e0 + (lane & 7)];
#pragma unroll
    for (int i = 0; i < 8; ++i) {
        const int slot = (__builtin_amdgcn_readlane(ev, i) >> 21) & 3;
        const u32x4 xv = *(const LAS u32x4*)(xq + slot * 1024 + lane * 16);
        const u32x4 q = rb.a[r0 + i];
        int s = __builtin_amdgcn_sdot4((int)xv.x, (int)q.x, 0, false); s = __builtin_amdgcn_sdot4((int)xv.y, (int)q.y, s, false);
        s = __builtin_amdgcn_sdot4((int)xv.z, (int)q.z, s, false); s = __builtin_amdgcn_sdot4((int)xv.w, (int)q.w, s, false);
        pr[i] = s;
    }
    int r4[4], r2[2], r1;
    { const bool up = (lane & 32) != 0;
#pragma unroll
      for (int i = 0; i < 4; ++i) { const int keep = up ? pr[i + 4] : pr[i], send = up ? pr[i] : pr[i + 4]; r4[i] = keep + __shfl_xor(send, 32); } }
    { const bool up = (lane & 16) != 0;
#pragma unroll
      for (int i = 0; i < 2; ++i) { const int keep = up ? r4[i + 2] : r4[i], send = up ? r4[i] : r4[i + 2]; r2[i] = keep + __shfl_xor(send, 16); } }
    { const bool up = (lane & 8) != 0; const int keep = up ? r2[1] : r2[0], send = up ? r2[0] : r2[1]; r1 = keep + __shfl_xor(send, 8); }
    r1 += __shfl_xor(r1, 4); r1 += __shfl_xor(r1, 2); r1 += __shfl_xor(r1, 1);
    const float gate = cf[e0 + (lane >> 3)];
    const float coef = gate * gelu_tanh((float)r1 * sul[e0 + (lane >> 3)]);
    if ((lane & 7) == 0) cf[e0 + (lane >> 3)] = coef;
}
template <bool FAKE>
__device__ __forceinline__ f32x2 cvt8(unsigned w, bool hi) {
    if (FAKE) { const unsigned t = hi ? (w >> 16) : w; return (f32x2){__builtin_bit_cast(float, (t << 23) | 0x30000000u), __builtin_bit_cast(float, ((t >> 8) << 23) | 0x30000000u)}; }
    return hi ? __builtin_amdgcn_cvt_pk_f32_fp8((int)w, true) : __builtin_amdgcn_cvt_pk_f32_fp8((int)w, false);
}
template <bool FAKE = false>
__device__ __forceinline__ void peer_acc8p(f32x2 (&o)[8], const float c, const u32x4 q) {
    const f32x2 c2 = {c, c};
#pragma unroll
    for (int j = 0; j < 4; ++j) { const f32x2 lo = cvt8<FAKE>(q[j], false), hi = cvt8<FAKE>(q[j], true);
        o[2 * j] += c2 * lo; o[2 * j + 1] += c2 * hi; }
}
template <int NR, bool FAKE>
__device__ __forceinline__ void peer_vNp(const RowBufN<NR>& rb, f32x2 (&outv)[4][8], const LAS unsigned* ent, const LAS float* cf, int b, int lane) {
    const int ev = (int)ent[b * NR + (lane & (NR - 1))]; const float cv = cf[b * NR + (lane & (NR - 1))];
    int slot[NR]; float c[NR];
#pragma unroll
    for (int i = 0; i < NR; ++i) { slot[i] = (__builtin_amdgcn_readlane(ev, i) >> 21) & 3; c[i] = rdlane_f(cv, i); }
#pragma unroll
    for (int s = 0; s < 4; ++s) {
#pragma unroll
        for (int i = 0; i < NR; ++i) if (slot[i] == s) peer_acc8p<FAKE>(outv[s], c[i], rb.a[i]);
        __builtin_amdgcn_sched_barrier(0);
    }
}
template <int PV, bool FAKE>
__device__ __forceinline__ void peer_passv(f32x2 (&outv)[4][8], const unsigned char* TV, const LAS unsigned* ent, const LAS float* cf, int lane) {
    RowBufN<PV> A, B, C;
    constexpr int NBV = 512 / PV;
    peer_loadN<PV>(A, TV, ent, 0, lane); peer_loadN<PV>(B, TV, ent, 1, lane);
#pragma unroll 1
    for (int b = 0; b + 2 < NBV; b += 3) {
        peer_loadN<PV>(C, TV, ent, b + 2, lane);
        peer_vNp<PV, FAKE>(A, outv, ent, cf, b, lane);
        if (b + 3 < NBV) peer_loadN<PV>(A, TV, ent, b + 3, lane);
        peer_vNp<PV, FAKE>(B, outv, ent, cf, b + 1, lane);
        if (b + 4 < NBV) peer_loadN<PV>(B, TV, ent, b + 4, lane);
        peer_vNp<PV, FAKE>(C, outv, ent, cf, b + 2, lane);
    }
    peer_vNp<PV, FAKE>(A, outv, ent, cf, NBV - 1, lane);
}
__device__ __forceinline__ void p_peer_expert5(const Frame& F, unsigned char* ws, float* xres, const float oscale, const XcdBarrier& xbar, const int mode) {
    const bf16_t* XN = (const bf16_t*)(ws + WS_XN); const unsigned char* TU = ws + WS_TAB8U; const unsigned char* TV = ws + WS_TAB8V;
    const float* SU = (const float*)(ws + WS_TABSU); const float* SV = (const float*)(ws + WS_TABSV);
    const unsigned short* EID = (const unsigned short*)(ws + PE_EID); const float* GATE = (const float*)(ws + PE_GATE);
    const int gw = F.bid * NWAVES + F.wave, NGW = F.G * NWAVES, lane = F.lane;
    LAS unsigned* ent = (LAS unsigned*)(F.lds + F.wave * 6144);
    LAS float* cf = (LAS float*)(F.lds + F.wave * 6144 + 2048);
    LAS float* sul = (LAS float*)(F.lds + F.wave * 6144 + 4096);
    LAS unsigned char* xq = F.lds + 49152 + F.wave * 4096;
    constexpr int PU = 16, PV = 8;
    const int nrounds = (T + NGW * 4 - 1) / (NGW * 4);
    for (int rnd = 0; rnd < nrounds; ++rnd) {
        const int m4 = (rnd * NGW + gw) * 4;
        if (m4 < T) {
            {
                float sx[4];
#pragma unroll
                for (int s = 0; s < 4; ++s) { const size_t m = (size_t)(m4 + s);
                    const u32x4 xa = *(const u32x4*)(XN + m * 1024 + lane * 16), xb = *(const u32x4*)(XN + m * 1024 + lane * 16 + 8);
                    float xf[16] = {bf_lo(xa.x), bf_hi(xa.x), bf_lo(xa.y), bf_hi(xa.y), bf_lo(xa.z), bf_hi(xa.z), bf_lo(xa.w), bf_hi(xa.w),
                                    bf_lo(xb.x), bf_hi(xb.x), bf_lo(xb.y), bf_hi(xb.y), bf_lo(xb.z), bf_hi(xb.z), bf_lo(xb.w), bf_hi(xb.w)};
                    float am = 0.f;
#pragma unroll
                    for (int i = 0; i < 16; ++i) am = fmaxf(am, fabsf(xf[i]));
#pragma unroll
                    for (int o = 1; o < 64; o <<= 1) am = fmaxf(am, __shfl_xor(am, o));
                    sx[s] = am > 0.f ? am * (1.0f / 127.0f) : 1.0f; const float inv = 1.0f / sx[s];
                    u32x4 q;
#pragma unroll
                    for (int j = 0; j < 4; ++j) { const int a = (int)rintf(xf[4 * j] * inv), b = (int)rintf(xf[4 * j + 1] * inv), c = (int)rintf(xf[4 * j + 2] * inv), d = (int)rintf(xf[4 * j + 3] * inv);
                        q[j] = (unsigned)(a & 255) | ((unsigned)(b & 255) << 8) | ((unsigned)(c & 255) << 16) | ((unsigned)(d & 255) << 24); }
                    *(LAS u32x4*)(xq + s * 1024 + lane * 16) = q; }
                int id[4][2]; float gg[4][2], su[4][2];
#pragma unroll
                for (int s = 0; s < 4; ++s) { const size_t m = (size_t)(m4 + s);
                    id[s][0] = EID[m * 128 + lane]; id[s][1] = EID[m * 128 + 64 + lane];
                    gg[s][0] = GATE[m * 128 + lane] * SV[id[s][0]]; gg[s][1] = GATE[m * 128 + 64 + lane] * SV[id[s][1]];
                    su[s][0] = SU[id[s][0]] * sx[s]; su[s][1] = SU[id[s][1]] * sx[s]; }
                int base = 0;
#pragma unroll 1
                for (int k = 0; k < 16; ++k) {
                    const int r = (rnd & 1) ? 15 - k : k;
#pragma unroll
                    for (int s = 0; s < 4; ++s)
#pragma unroll
                        for (int w = 0; w < 2; ++w) {
                            const bool hit = (id[s][w] >> 10) == r;
                            const u64 m = __ballot(hit);
                            if (hit) { const int pos = base + (int)__builtin_amdgcn_mbcnt_hi((unsigned)(m >> 32), __builtin_amdgcn_mbcnt_lo((unsigned)m, 0u));
                                ent[pos] = ((unsigned)s << 21) | ((unsigned)(w * 64 + lane) << 14) | (unsigned)(mode == 4 ? (id[s][w] & 7) : id[s][w]); cf[pos] = gg[s][w]; sul[pos] = su[s][w]; }
                            base += __builtin_popcountll(m);
                        }
                }
            }
            LDS_WAIT();
            if (mode != 1 && mode != 3) {
                RowBufN<PU> A, B;
                peer_loadN<PU>(A, TU, ent, 0, lane);
#pragma unroll 1
                for (int b = 0; b < 512 / PU; b += 2) {
                    peer_loadN<PU>(B, TU, ent, b + 1, lane);
#pragma unroll
                    for (int h = 0; h < PU / 8; ++h) peer_u8i<PU>(A, h * 8, xq, ent, cf, sul, b * PU + h * 8, lane);
                    if (b + 2 < 512 / PU) peer_loadN<PU>(A, TU, ent, b + 2, lane);
#pragma unroll
                    for (int h = 0; h < PU / 8; ++h) peer_u8i<PU>(B, h * 8, xq, ent, cf, sul, (b + 1) * PU + h * 8, lane);
                }
            }
            LDS_WAIT();
            f32x2 outv[4][8];
#pragma unroll
            for (int s = 0; s < 4; ++s)
#pragma unroll
                for (int i = 0; i < 8; ++i) outv[s][i] = (f32x2){0.f, 0.f};
            if (mode != 1 && mode != 2) {
                if (mode == 5) peer_passv<PV, true>(outv, TV, ent, cf, lane); else peer_passv<PV, false>(outv, TV, ent, cf, lane);
            }
#pragma unroll
            for (int s = 0; s < 4; ++s) {
                f32x4* o = (f32x4*)(xres + (size_t)(m4 + s) * 1024 + lane * 16);
#pragma unroll
                for (int j = 0; j < 4; ++j) { f32x4 a0 = o[j]; const f32x4 add = (f32x4){outv[s][2 * j].x, outv[s][2 * j].y, outv[s][2 * j + 1].x, outv[s][2 * j + 1].y};
                    if (oscale != 0.f) a0 += add; else asm volatile("" :: "v"(add)); o[j] = a0; }
            }
        }
        if (rnd + 1 < nrounds) xcd_barrier(xbar);
    }
}

struct GBuf { u32x4 a[8]; };
__device__ __forceinline__ void grp_load(GBuf& rb, const unsigned char* TAB, const LAS unsigned* ent, unsigned ginfo, int j, int lane) {
    const int start = (int)(ginfo & 0xFFFFu) + 8 * j, n = (int)(ginfo >> 16) - 8 * j;
    if (n > 0) {
        const int ev = (int)ent[start + (lane & 7)];
#pragma unroll
        for (int i = 0; i < 8; ++i) if (i < n) {
            const unsigned e = (unsigned)__builtin_amdgcn_readlane(ev, i) & 0x3FFFu;
            rb.a[i] = *(const u32x4*)(TAB + (size_t)e * 1024 + lane * 16);
        }
    }
}
__device__ __forceinline__ int dot16i(const u32x4 x, const u32x4 q) {
    int s = __builtin_amdgcn_sdot4((int)x.x, (int)q.x, 0, false); s = __builtin_amdgcn_sdot4((int)x.y, (int)q.y, s, false);
    s = __builtin_amdgcn_sdot4((int)x.z, (int)q.z, s, false); return __builtin_amdgcn_sdot4((int)x.w, (int)q.w, s, false);
}
__device__ __forceinline__ void grp_u(const GBuf& rb, const u32x4 xq, LAS float* cf, const LAS float* sul, unsigned ginfo, int j, int lane) {
    const int start = (int)(ginfo & 0xFFFFu) + 8 * j, n = (int)(ginfo >> 16) - 8 * j;
    if (n > 0) {
        int pr[8];
#pragma unroll
        for (int i = 0; i < 8; ++i) { pr[i] = 0; if (i < n) pr[i] = dot16i(xq, rb.a[i]); }
        int r4[4], r2[2], r1;
        { const bool up = (lane & 32) != 0;
#pragma unroll
          for (int i = 0; i < 4; ++i) { const int keep = up ? pr[i + 4] : pr[i], send = up ? pr[i] : pr[i + 4]; r4[i] = keep + __shfl_xor(send, 32); } }
        { const bool up = (lane & 16) != 0;
#pragma unroll
          for (int i = 0; i < 2; ++i) { const int keep = up ? r4[i + 2] : r4[i], send = up ? r4[i] : r4[i + 2]; r2[i] = keep + __shfl_xor(send, 16); } }
        { const bool up = (lane & 8) != 0; const int keep = up ? r2[1] : r2[0], send = up ? r2[0] : r2[1]; r1 = keep + __shfl_xor(send, 8); }
        r1 += __shfl_xor(r1, 4); r1 += __shfl_xor(r1, 2); r1 += __shfl_xor(r1, 1);
        const int i = lane >> 3;
        if (i < n) { const float coef = cf[start + i] * gelu_tanh((float)r1 * sul[start + i]); if ((lane & 7) == 0) cf[start + i] = coef; }
    }
}
__device__ __forceinline__ void grp_u_over(const u32x4 xq, const unsigned char* TU, const LAS unsigned* ent, LAS float* cf, const LAS float* sul, unsigned ginfo, int lane) {
    const int start = (int)(ginfo & 0xFFFFu), n = (int)(ginfo >> 16);
    for (int i = 16; i < n; ++i) {
        const unsigned e = (unsigned)__builtin_amdgcn_readfirstlane((int)ent[start + i]) & 0x3FFFu;
        const u32x4 q = *(const u32x4*)(TU + (size_t)e * 1024 + lane * 16);
        int r1 = dot16i(xq, q);
#pragma unroll
        for (int o = 32; o >= 1; o >>= 1) r1 += __shfl_xor(r1, o);
        const float coef = cf[start + i] * gelu_tanh((float)r1 * sul[start + i]);
        LDS_WAIT();
        if (lane == 0) cf[start + i] = coef;
        LDS_WAIT();
    }
}
__device__ __forceinline__ void grp_v(const GBuf& rb, f32x2 (&o)[8], const LAS float* cf, unsigned ginfo, int j, int lane) {
    const int start = (int)(ginfo & 0xFFFFu) + 8 * j, n = (int)(ginfo >> 16) - 8 * j;
    if (n > 0) {
        const float cv = cf[start + (lane & 7)];
#pragma unroll
        for (int i = 0; i < 8; ++i) if (i < n) peer_acc8p(o, rdlane_f(cv, i), rb.a[i]);
    }
}
__device__ __forceinline__ void grp_v_over(f32x2 (&o)[8], const unsigned char* TV, const LAS unsigned* ent, const LAS float* cf, unsigned ginfo, int lane) {
    const int start = (int)(ginfo & 0xFFFFu), n = (int)(ginfo >> 16);
    for (int i = 16; i < n; ++i) {
        const unsigned e = (unsigned)__builtin_amdgcn_readfirstlane((int)ent[start + i]) & 0x3FFFu;
        const u32x4 q = *(const u32x4*)(TV + (size_t)e * 1024 + lane * 16);
        peer_acc8p(o, cf[start + i], q);
    }
}
__device__ __forceinline__ void p_peer_expert6(const Frame& F, unsigned char* ws, float* xres, const float oscale, const XcdBarrier& xbar, const int mode) {
    const bf16_t* XN = (const bf16_t*)(ws + WS_XN); const unsigned char* TU = ws + WS_TAB8U; const unsigned char* TV = ws + WS_TAB8V;
    const float* SU = (const float*)(ws + WS_TABSU); const float* SV = (const float*)(ws + WS_TABSV);
    const unsigned short* EID = (const unsigned short*)(ws + PE_EID); const float* GATE = (const float*)(ws + PE_GATE);
    const int gw = F.bid * NWAVES + F.wave, NGW = F.G * NWAVES, lane = F.lane;
    LAS unsigned* ent = (LAS unsigned*)(F.lds + F.wave * 8192);
    LAS float* cf = (LAS float*)(F.lds + F.wave * 8192 + 2304);
    LAS float* sul = (LAS float*)(F.lds + F.wave * 8192 + 4608);
    LAS unsigned* gi = (LAS unsigned*)(F.lds + F.wave * 8192 + 6912);
    const int nrounds = (T + NGW * 4 - 1) / (NGW * 4);
    if (lane < 4) gi[64 + lane] = 0u;
    for (int rnd = 0; rnd < nrounds; ++rnd) {
        const int m4 = (rnd * NGW + gw) * 4;
        if (m4 < T) {
            u32x4 xq[4];
            {
                float sx[4];
#pragma unroll
                for (int s = 0; s < 4; ++s) { const size_t m = (size_t)(m4 + s);
                    const u32x4 xa = *(const u32x4*)(XN + m * 1024 + lane * 16), xb = *(const u32x4*)(XN + m * 1024 + lane * 16 + 8);
                    float xf[16] = {bf_lo(xa.x), bf_hi(xa.x), bf_lo(xa.y), bf_hi(xa.y), bf_lo(xa.z), bf_hi(xa.z), bf_lo(xa.w), bf_hi(xa.w),
                                    bf_lo(xb.x), bf_hi(xb.x), bf_lo(xb.y), bf_hi(xb.y), bf_lo(xb.z), bf_hi(xb.z), bf_lo(xb.w), bf_hi(xb.w)};
                    float am = 0.f;
#pragma unroll
                    for (int i = 0; i < 16; ++i) am = fmaxf(am, fabsf(xf[i]));
#pragma unroll
                    for (int o = 1; o < 64; o <<= 1) am = fmaxf(am, __shfl_xor(am, o));
                    sx[s] = am > 0.f ? am * (1.0f / 127.0f) : 1.0f; const float inv = 1.0f / sx[s];
#pragma unroll
                    for (int j = 0; j < 4; ++j) { const int a = (int)rintf(xf[4 * j] * inv), b = (int)rintf(xf[4 * j + 1] * inv), c = (int)rintf(xf[4 * j + 2] * inv), d = (int)rintf(xf[4 * j + 3] * inv);
                        xq[s][j] = (unsigned)(a & 255) | ((unsigned)(b & 255) << 8) | ((unsigned)(c & 255) << 16) | ((unsigned)(d & 255) << 24); } }
                int id[4][2]; float gg[4][2], su[4][2];
#pragma unroll
                for (int s = 0; s < 4; ++s) { const size_t m = (size_t)(m4 + s);
                    id[s][0] = EID[m * 128 + lane]; id[s][1] = EID[m * 128 + 64 + lane];
                    gg[s][0] = GATE[m * 128 + lane] * SV[id[s][0]]; gg[s][1] = GATE[m * 128 + 64 + lane] * SV[id[s][1]];
                    su[s][0] = SU[id[s][0]] * sx[s]; su[s][1] = SU[id[s][1]] * sx[s]; }
                int base = 0;
#pragma unroll 1
                for (int k = 0; k < 16; ++k) {
                    const int r = (rnd & 1) ? 15 - k : k;
#pragma unroll
                    for (int s = 0; s < 4; ++s) {
                        const int gstart = base;
#pragma unroll
                        for (int w = 0; w < 2; ++w) {
                            const bool hit = (id[s][w] >> 10) == r;
                            const u64 m = __ballot(hit);
                            if (hit) { const int pos = base + (int)__builtin_amdgcn_mbcnt_hi((unsigned)(m >> 32), __builtin_amdgcn_mbcnt_lo((unsigned)m, 0u));
                                ent[pos] = (unsigned)(mode == 4 ? (id[s][w] & 7) : id[s][w]); cf[pos] = gg[s][w]; sul[pos] = su[s][w]; }
                            base += __builtin_popcountll(m);
                        }
                        if (lane == 0) gi[k * 4 + s] = (unsigned)gstart | ((unsigned)(base - gstart) << 16);
                    }
                }
            }
            LDS_WAIT();
#define GI(g) ((unsigned)__builtin_amdgcn_readfirstlane((int)gi[(g)]))
#define SB() __builtin_amdgcn_sched_barrier(0)
            if (mode != 1 && mode != 3) {
                GBuf A, B;
                { const unsigned g0 = GI(0); grp_load(A, TU, ent, g0, 0, lane); grp_load(B, TU, ent, g0, 1, lane); }
#pragma unroll 1
                for (int k = 0; k < 16; ++k) {
                    const unsigned g0 = GI(k * 4), g1 = GI(k * 4 + 1), g2 = GI(k * 4 + 2), g3 = GI(k * 4 + 3), g4 = GI(k * 4 + 4);
                    grp_u(A, xq[0], cf, sul, g0, 0, lane); SB(); grp_load(A, TU, ent, g1, 0, lane); SB(); grp_u(B, xq[0], cf, sul, g0, 1, lane); SB(); grp_load(B, TU, ent, g1, 1, lane); SB();
                    grp_u(A, xq[1], cf, sul, g1, 0, lane); SB(); grp_load(A, TU, ent, g2, 0, lane); SB(); grp_u(B, xq[1], cf, sul, g1, 1, lane); SB(); grp_load(B, TU, ent, g2, 1, lane); SB();
                    grp_u(A, xq[2], cf, sul, g2, 0, lane); SB(); grp_load(A, TU, ent, g3, 0, lane); SB(); grp_u(B, xq[2], cf, sul, g2, 1, lane); SB(); grp_load(B, TU, ent, g3, 1, lane); SB();
                    grp_u(A, xq[3], cf, sul, g3, 0, lane); SB(); grp_load(A, TU, ent, g4, 0, lane); SB(); grp_u(B, xq[3], cf, sul, g3, 1, lane); SB(); grp_load(B, TU, ent, g4, 1, lane); SB();
                    grp_u_over(xq[0], TU, ent, cf, sul, g0, lane); grp_u_over(xq[1], TU, ent, cf, sul, g1, lane); grp_u_over(xq[2], TU, ent, cf, sul, g2, lane); grp_u_over(xq[3], TU, ent, cf, sul, g3, lane);
                }
            }
            LDS_WAIT();
            f32x2 outv[4][8];
#pragma unroll
            for (int s = 0; s < 4; ++s)
#pragma unroll
                for (int i = 0; i < 8; ++i) outv[s][i] = (f32x2){0.f, 0.f};
            if (mode != 1 && mode != 2) {
                GBuf A, B;
                { const unsigned g0 = GI(0); grp_load(A, TV, ent, g0, 0, lane); grp_load(B, TV, ent, g0, 1, lane); }
#pragma unroll 1
                for (int k = 0; k < 16; ++k) {
                    const unsigned g0 = GI(k * 4), g1 = GI(k * 4 + 1), g2 = GI(k * 4 + 2), g3 = GI(k * 4 + 3), g4 = GI(k * 4 + 4);
                    grp_v(A, outv[0], cf, g0, 0, lane); SB(); grp_load(A, TV, ent, g1, 0, lane); SB(); grp_v(B, outv[0], cf, g0, 1, lane); SB(); grp_load(B, TV, ent, g1, 1, lane); SB();
                    grp_v(A, outv[1], cf, g1, 0, lane); SB(); grp_load(A, TV, ent, g2, 0, lane); SB(); grp_v(B, outv[1], cf, g1, 1, lane); SB(); grp_load(B, TV, ent, g2, 1, lane); SB();
                    grp_v(A, outv[2], cf, g2, 0, lane); SB(); grp_load(A, TV, ent, g3, 0, lane); SB(); grp_v(B, outv[2], cf, g2, 1, lane); SB(); grp_load(B, TV, ent, g3, 1, lane); SB();
                    grp_v(A, outv[3], cf, g3, 0, lane); SB(); grp_load(A, TV, ent, g4, 0, lane); SB(); grp_v(B, outv[3], cf, g3, 1, lane); SB(); grp_load(B, TV, ent, g4, 1, lane); SB();
                    grp_v_over(outv[0], TV, ent, cf, g0, lane); grp_v_over(outv[1], TV, ent, cf, g1, lane); grp_v_over(outv[2], TV, ent, cf, g2, lane); grp_v_over(outv[3], TV, ent, cf, g3, lane);
                }
            }
#undef GI
#undef SB
#pragma unroll
            for (int s = 0; s < 4; ++s) {
                f32x4* o = (f32x4*)(xres + (size_t)(m4 + s) * 1024 + lane * 16);
#pragma unroll
                for (int j = 0; j < 4; ++j) { f32x4 a0 = o[j]; const f32x4 add = (f32x4){outv[s][2 * j].x, outv[s][2 * j].y, outv[s][2 * j + 1].x, outv[s][2 * j + 1].y};
                    if (oscale != 0.f) a0 += add; else asm volatile("" :: "v"(add)); o[j] = a0; }
            }
        }
        if (rnd + 1 < nrounds) xcd_barrier(xbar);
    }
}
constexpr size_t L1_QN = WS_R3;
constexpr size_t L1_KS = WS_R3 + 32 * MiB;
constexpr size_t L1_KW = WS_R3 + 40 * MiB;
constexpr size_t L1_VST = WS_R3 + 48 * MiB;
constexpr size_t L1_VWT = WS_R3 + 56 * MiB;
constexpr size_t L1_KCR = WS_R3 + 64 * MiB;
constexpr size_t L1_VCR = WS_R3 + 72 * MiB;
constexpr size_t L1_GATES = WS_R3 + 81 * MiB;
constexpr size_t L1_H1 = WS_R3 + 84 * MiB;
constexpr size_t L1_CMPO = WS_R3 + 88 * MiB;
constexpr size_t L1_KC = WS_R3 + 90 * MiB;
constexpr size_t L1_VCT = WS_R3 + 91 * MiB;
constexpr size_t L1_SELB = WS_R3 + 92 * MiB;
constexpr size_t L1_OC = WS_TABU;
constexpr size_t L1_CAT = WS_XN;
constexpr size_t L1_UPD = WS_R3;
constexpr size_t L1_DECAY = WS_R3 + 128 * MiB;

__device__ __forceinline__ void p_l1_prep(const Frame& F, const Args& a, unsigned char* ws) {
    const bf16_t* P = (const bf16_t*)(ws + WS_PROJ);
    const f32x2* rope = (const f32x2*)(ws + WS_ROPE);
    bf16_t* QN = (bf16_t*)(ws + L1_QN); bf16_t* KS = (bf16_t*)(ws + L1_KS); bf16_t* KW = (bf16_t*)(ws + L1_KW);
    bf16_t* KCR = (bf16_t*)(ws + L1_KCR); bf16_t* VCR = (bf16_t*)(ws + L1_VCR); float* GATES = (float*)(ws + L1_GATES);
    const int gw = F.bid * NWAVES + F.wave, NGW = F.G * NWAVES, lane = F.lane, hs = lane >> 3, sub = lane & 7;
    float qg[8], kg[8];
#pragma unroll
    for (int j = 0; j < 8; ++j) { qg[j] = a.in[I_L1_QG][sub * 8 + j]; kg[j] = a.in[I_L1_KG][sub * 8 + j]; }
    const int srccol = (hs < 2) ? C1_KS + hs * 64 : (hs < 4) ? C1_KW + (hs - 2) * 64 : (hs < 6) ? C1_KC + (hs - 4) * 64 : C1_VC + (hs - 6) * 64;
    bf16_t* dstbuf = (hs < 2) ? KS : (hs < 4) ? KW : (hs < 6) ? KCR : VCR;
    const int g2 = hs & 1;
    for (int m = gw; m < T; m += NGW) {
        const int b = m >> 12, t = m & 4095;
        const bf16_t* row = P + (size_t)m * N_IN1;
        f32x2 cs[8];
#pragma unroll
        for (int j = 0; j < 4; ++j) { const f32x4 c4 = *(const f32x4*)(rope + t * 32 + (sub & 3) * 8 + 2 * j); cs[2 * j] = (f32x2){c4.x, c4.y}; cs[2 * j + 1] = (f32x2){c4.z, c4.w}; }
        float v[8];
        head8_load(row + C1_Q + lane * 8, v); head8_norm(v, qg); head8_rope(v, cs, sub >= 4); head8_store(QN + (size_t)m * 512 + lane * 8, v, 0.125f);
        {
            const u32x4 raw = *(const u32x4*)(row + srccol + sub * 8);
            v[0] = bf_lo(raw.x); v[1] = bf_hi(raw.x); v[2] = bf_lo(raw.y); v[3] = bf_hi(raw.y); v[4] = bf_lo(raw.z); v[5] = bf_hi(raw.z); v[6] = bf_lo(raw.w); v[7] = bf_hi(raw.w);
            head8_norm(v, kg); head8_rope(v, cs, sub >= 4);
            u32x4 q; q.x = pk2(v[0], v[1]); q.y = pk2(v[2], v[3]); q.z = pk2(v[4], v[5]); q.w = pk2(v[6], v[7]);
            if (hs >= 4) q = raw;
            *(u32x4*)(dstbuf + ((size_t)(b * 2 + g2) * 4096 + t) * 64 + sub * 8) = q;
        }
        if (lane < 24) GATES[(size_t)m * 24 + lane] = sigmoidf_(bf2f(row[C1_GL + lane]));
    }
    for (int it = gw; it < 2 * NB * 2 * 64; it += NGW) {
        const int tb = it & 63, g = (it >> 6) & 1, b = (it >> 7) & 7, w = it >> 10;
        const size_t m = (size_t)b * 4096 + tb * 64 + lane;
        unsigned r[32];
#pragma unroll
        for (int j = 0; j < 8; ++j) { const u32x4 q = *(const u32x4*)(P + m * N_IN1 + (w ? C1_VW : C1_VS) + g * 64 + j * 8); r[4 * j] = q.x; r[4 * j + 1] = q.y; r[4 * j + 2] = q.z; r[4 * j + 3] = q.w; }
        bf16_t* dst = (bf16_t*)(ws + (w ? L1_VWT : L1_VST)) + ((size_t)(b * 2 + g) * 64) * 4096 + tb * 64 + lane;
#pragma unroll
        for (int d = 0; d < 64; ++d) dst[(size_t)d * 4096] = (bf16_t)((d & 1) ? (r[d >> 1] >> 16) : (r[d >> 1] & 0xffffu));
    }
}

namespace pg8 {
struct EpiCmp1 {
    static constexpr bool PERM = true;
    bf16_t* O; const float* bias;
    __device__ __forceinline__ void operator()(const f32x4 (&acc)[2][2][4][2], const Unit& u, int wr, int wc, int fr, int fq) const {
        const int row0 = u.pm * BM + wr * 64 + fr, col0 = wc * 32 + 8 * fq;
#pragma unroll
        for (int ai = 0; ai < 2; ++ai)
#pragma unroll
            for (int m = 0; m < 4; ++m) { bf16_t* rowp = O + (size_t)(row0 + ai * HALF + m * 16) * 256 + col0;
#pragma unroll
                for (int bj = 0; bj < 2; ++bj) { const float* bp = bias + u.pn * 256 + col0 + bj * HALF;
                    const f32x4 v0 = acc[ai][bj][m][0] + *(const f32x4*)bp, v1 = acc[ai][bj][m][1] + *(const f32x4*)(bp + 4);
                    u32x4 w; w.x = pk2(gelu_tanh(v0[0]), gelu_tanh(v0[1])); w.y = pk2(gelu_tanh(v0[2]), gelu_tanh(v0[3]));
                    w.z = pk2(gelu_tanh(v1[0]), gelu_tanh(v1[1])); w.w = pk2(gelu_tanh(v1[2]), gelu_tanh(v1[3]));
                    *(u32x4*)(rowp + bj * HALF) = w; }
                asm volatile("" ::: "memory"); __builtin_amdgcn_sched_barrier(0); }
    }
};
struct EpiCmp2 {
    static constexpr bool PERM = false;
    float* C;
    __device__ __forceinline__ void operator()(const f32x4 (&acc)[2][2][4][2], const Unit& u, int wr, int wc, int fr, int fq) const {
        if (wc >= 2) return;
        const int row0 = u.pm * BM + wr * 64 + fr, col0 = wc * 32 + 4 * fq;
#pragma unroll
        for (int ai = 0; ai < 2; ++ai)
#pragma unroll
            for (int m = 0; m < 4; ++m)
#pragma unroll
                for (int n = 0; n < 2; ++n) *(f32x4*)(C + (size_t)(row0 + ai * HALF + m * 16) * 64 + col0 + n * 16) = acc[ai][0][m][n];
    }
};
}

__device__ __forceinline__ void p_cmp_final(const Frame& F, const Args& a, unsigned char* ws) {
    const float* CMPO = (const float*)(ws + L1_CMPO); const f32x2* rope = (const f32x2*)(ws + WS_ROPE);
    bf16_t* KC = (bf16_t*)(ws + L1_KC); bf16_t* VCT = (bf16_t*)(ws + L1_VCT);
    const int gw = F.bid * NWAVES + F.wave, NGW = F.G * NWAVES, lane = F.lane;
    const float kg = a.in[I_L1_KG][lane];
    for (int r = gw; r < 8192; r += NGW) {
        float v = CMPO[(size_t)r * 64 + lane];
        const int rr = r & 4095, bg = rr >> 8, c = rr & 255;
        if (r < 4096) {
            const float ss = wave_sum(v * v);
            v = v * (1.0f / sqrtf(ss * (1.f / 64.f) + 1e-6f)) * kg;
            const int pos = (c < 255) ? 16 * c + 31 : 0;
            v = rope_apply(v, rope[pos * 32 + (lane & 31)], lane);
            KC[((size_t)bg * 256 + c) * 64 + lane] = (c < 255) ? (bf16_t)f2bf(v) : (bf16_t)0;
        } else {
            VCT[((size_t)bg * 64 + lane) * 256 + c] = (c < 255) ? (bf16_t)f2bf(v) : (bf16_t)0;
        }
    }
}

__device__ __forceinline__ void att_load2(AttStage& s, const bf16_t* Kg, const bf16_t* Vtg, int vstride, int key0, int tid) {
    s.kreg = *(const u32x4*)(Kg + (size_t)(key0 + (tid >> 3)) * 64 + (tid & 7) * 8);
    s.vreg = *(const u32x4*)(Vtg + (size_t)(tid >> 3) * vstride + key0 + (tid & 7) * 8);
}
__device__ __forceinline__ float score_bound_c2(const float* qg, const float* kg) {
    float mq = 0.f, mk_ = 0.f;
    for (int i = 0; i < 64; ++i) { mq = fmaxf(mq, fabsf(qg[i])); mk_ = fmaxf(mk_, fabsf(kg[i])); }
    return (8.0f * mq * mk_ + 0.5f) * 1.4426950408889634f;
}

__device__ __forceinline__ void p_cmp_attn(const Frame& F, const Args& a, unsigned char* ws) {
    const bf16_t* QN = (const bf16_t*)(ws + L1_QN); const bf16_t* KC = (const bf16_t*)(ws + L1_KC); const bf16_t* VCT = (const bf16_t*)(ws + L1_VCT);
    float* OC = (float*)(ws + L1_OC); u64* SELB = (u64*)(ws + L1_SELB);
    LAS float* impL = (LAS float*)(F.lds + 36864);
    const int lane = F.lane, wave = F.wave, h = lane >> 5, c = lane & 31, tid = F.tid;
    const float c2 = score_bound_c2(a.in[I_L1_QG], a.in[I_L1_KG]), c1 = 1.4426950408889634f;
    for (int u = F.bid; u < 1024; u += F.G) {
        const int b = (u >> 7) & 7, g = (u >> 6) & 1, rnd = u >> 8, qt = (rnd & 1) ? 63 - (u & 63) : (u & 63), q0 = qt * 64;
        const int bg = b * 2 + g; const size_t mb = (size_t)b * 4096;
        const int t = q0 + wave * 8 + (c >> 2), head = g * 4 + (c & 3);
        bf16x8 Qf[4];
#pragma unroll
        for (int ks = 0; ks < 4; ++ks) Qf[ks] = *(const bf16x8*)(QN + (mb + t) * 512 + head * 64 + ks * 16 + 8 * h);
        const int L = (t >= 31) ? (((t - 31) >> 4) < 254 ? ((t - 31) >> 4) : 254) : -1;
        const int tmax = q0 + 63; const int Lmax = (tmax >= 31) ? (((tmax - 31) >> 4) < 254 ? ((tmax - 31) >> 4) : 254) : -1;
        const int nkt = (Lmax >= 0) ? (Lmax >> 6) + 1 : 0;
        f32x16 O[2], IMP[2]; float l = 0.f;
#pragma unroll
        for (int i = 0; i < 16; ++i) { O[0][i] = 0.f; O[1][i] = 0.f; IMP[0][i] = 0.f; IMP[1][i] = 0.f; }
        const bf16_t* Kg = KC + (size_t)bg * 256 * 64; const bf16_t* Vtg = VCT + (size_t)bg * 64 * 256;
        __syncthreads();
        for (int kt = 0; kt < nkt; ++kt) {
            AttStage st; att_load2(st, Kg, Vtg, 256, kt * 64, tid);
            __syncthreads();
            att_store(st, F.lds, tid);
            __syncthreads();
#pragma unroll 1
            for (int sub = 0; sub < 2; ++sub) {
                const f32x16 S = att_qk(F.lds, sub, Qf, lane);
                float p[16];
#pragma unroll
                for (int i = 0; i < 16; ++i) {
                    const int cidx = kt * 64 + sub * 32 + (i & 3) + 8 * (i >> 2) + 4 * h;
                    const float e = __builtin_amdgcn_exp2f(S[i] * c1 - c2);
                    p[i] = (cidx <= L) ? e : 0.f; l += p[i];
                }
                const bf16x8 P0 = pack8(p[0], p[1], p[2], p[3], p[4], p[5], p[6], p[7]);
                const bf16x8 P1 = pack8(p[8], p[9], p[10], p[11], p[12], p[13], p[14], p[15]);
                att_pv2(F.lds, sub, P0, P1, O, lane);
#pragma unroll
                for (int jt = 0; jt < 2; ++jt)
#pragma unroll
                    for (int s = 0; s < 2; ++s) {
                        unsigned wv[4];
#pragma unroll
                        for (int e2 = 0; e2 < 4; ++e2) {
                            unsigned pr = 0u;
#pragma unroll
                            for (int q = 0; q < 2; ++q) { const int jj = 2 * e2 + q; const int kap = 16 * s + 8 * (jj >> 2) + 4 * h + (jj & 3);
                                const int off = kt * 64 + sub * 32 + kap - 4 * (32 * jt + c);
                                const unsigned wbits = (off == 0 || off == 4) ? 0x3F80u : ((off >= 1 && off <= 3) ? 0x4000u : 0u);
                                pr |= wbits << (16 * q); }
                            wv[e2] = pr;
                        }
                        const bf16x8 Wf = __builtin_bit_cast(bf16x8, ((u32x4){wv[0], wv[1], wv[2], wv[3]}));
                        IMP[jt] = __builtin_amdgcn_mfma_f32_32x32x16_bf16(Wf, s ? P1 : P0, IMP[jt], 0, 0, 0);
                    }
            }
        }
        const float lt = l + __shfl_xor(l, 32);
        const float inv = 1.0f / fmaxf(lt, 1e-30f);
        { float* orow = OC + (mb + t) * 512 + head * 64;
#pragma unroll
          for (int dt = 0; dt < 2; ++dt)
#pragma unroll
            for (int i4 = 0; i4 < 4; ++i4) { const int d = dt * 32 + 8 * i4 + 4 * h;
                *(f32x4*)(orow + d) = (f32x4){O[dt][4 * i4] * inv, O[dt][4 * i4 + 1] * inv, O[dt][4 * i4 + 2] * inv, O[dt][4 * i4 + 3] * inv}; } }
#pragma unroll
        for (int jt = 0; jt < 2; ++jt)
#pragma unroll
            for (int i = 0; i < 16; ++i) {
                float v = IMP[jt][i] * inv; v += __shfl_xor(v, 1); v += __shfl_xor(v, 2);
                if ((c & 3) == 0) impL[(wave * 8 + (c >> 2)) * 65 + 32 * jt + (i & 3) + 8 * (i >> 2) + 4 * h] = v;
            }
        __syncthreads();
        if (tid < 64) {
            const int tq = q0 + tid, cur = tq >> 6;
            u64 mask;
            if (cur + 1 <= 16) mask = (1ull << (cur + 1)) - 1ull;
            else {
                float v[64];
#pragma unroll
                for (int j = 0; j < 64; ++j) { const float x = impL[tid * 65 + j]; v[j] = (j > cur) ? -3.0e38f : ((j == 0 || j == cur) ? 1.0e9f : x); }
                mask = 0ull;
#pragma unroll 1
                for (int k = 0; k < 16; ++k) {
                    float best = -3.0e38f; int bi = 0;
#pragma unroll
                    for (int j = 0; j < 64; ++j) { const bool taken = (mask >> j) & 1ull; if (!taken && v[j] > best) { best = v[j]; bi = j; } }
                    mask |= 1ull << bi;
                }
            }
            SELB[(size_t)bg * 4096 + tq] = mask;
        }
        __syncthreads();
    }
}

__device__ __forceinline__ void p_nsa_attn(const Frame& F, const Args& a, unsigned char* ws) {
    const bf16_t* QN = (const bf16_t*)(ws + L1_QN);
    const u64* SELB = (const u64*)(ws + L1_SELB); float* OC = (float*)(ws + L1_OC); const float* GATES = (const float*)(ws + L1_GATES);
    bf16_t* CAT = (bf16_t*)(ws + L1_CAT);
    const int lane = F.lane, wave = F.wave, h = lane >> 5, c = lane & 31, tid = F.tid;
    const float c2 = score_bound_c2(a.in[I_L1_QG], a.in[I_L1_KG]), c1 = 1.4426950408889634f;
    for (int u = F.bid; u < 512; u += F.G) {
        const int idx = u & 255, g = u >> 8, b = idx >> 5, qtr = idx & 31, qt = g ? 31 - qtr : qtr, q0 = qt * 128;
        const int bg = b * 2 + g; const size_t mb = (size_t)b * 4096;
        bf16x8 Qf[2][4]; int qidx[2];
#pragma unroll
        for (int ct = 0; ct < 2; ++ct) { qidx[ct] = q0 + wave * 16 + ct * 8 + (c >> 2);
#pragma unroll
            for (int ks = 0; ks < 4; ++ks) Qf[ct][ks] = *(const bf16x8*)(QN + (mb + qidx[ct]) * 512 + (g * 4 + (c & 3)) * 64 + ks * 16 + 8 * h); }
        const int head = g * 4 + (c & 3);
#pragma unroll 1
        for (int pass = 0; pass < 2; ++pass) {
            const bf16_t* Kg = (const bf16_t*)(ws + (pass ? L1_KW : L1_KS)) + (size_t)bg * 4096 * 64;
            const bf16_t* Vtg = (const bf16_t*)(ws + (pass ? L1_VWT : L1_VST)) + (size_t)bg * 64 * 4096;
            u64 selw[2];
#pragma unroll
            for (int ct = 0; ct < 2; ++ct) selw[ct] = pass ? ~0ull : SELB[(size_t)bg * 4096 + qidx[ct]];
            const int wlen = pass ? 512 : 0x7fffffff;
            f32x16 O[2][2]; float l[2] = {0.f, 0.f};
#pragma unroll
            for (int ct = 0; ct < 2; ++ct)
#pragma unroll
                for (int dt = 0; dt < 2; ++dt)
#pragma unroll
                    for (int i = 0; i < 16; ++i) O[ct][dt][i] = 0.f;
            const int kt_lo = pass ? ((2 * qt - 8) > 0 ? 2 * qt - 8 : 0) : 0, kt_hi = 2 * qt + 2;
            AttStage st; att_load(st, Kg, Vtg, kt_lo * 64, tid);
            __syncthreads();
            att_store(st, F.lds + (kt_lo & 1) * AT_BUF, tid);
            __syncthreads();
            for (int kt = kt_lo; kt < kt_hi; ++kt) {
                LAS unsigned char* buf = F.lds + (kt & 1) * AT_BUF;
                if (kt + 1 < kt_hi) att_load(st, Kg, Vtg, (kt + 1) * 64, tid);
#pragma unroll 1
                for (int sub = 0; sub < 2; ++sub) {
#pragma unroll
                    for (int ct = 0; ct < 2; ++ct) {
                        __builtin_amdgcn_sched_barrier(0);
                        const f32x16 S = att_qk(buf, sub, Qf[ct], lane);
                        const bool flag = (selw[ct] >> kt) & 1ull;
                        const int tq = qidx[ct];
                        const float c2e = flag ? c2 : 3.0e30f;
                        float p[16];
                        const int dbase = tq - (kt * 64 + sub * 32 + 4 * h);
#pragma unroll
                        for (int i = 0; i < 16; ++i) {
                            const float e = __builtin_amdgcn_exp2f(S[i] * c1 - c2e);
                            p[i] = ((unsigned)(dbase - ((i & 3) + 8 * (i >> 2))) < (unsigned)wlen) ? e : 0.f; l[ct] += p[i];
                        }
                        const bf16x8 P0 = pack8(p[0], p[1], p[2], p[3], p[4], p[5], p[6], p[7]);
                        const bf16x8 P1 = pack8(p[8], p[9], p[10], p[11], p[12], p[13], p[14], p[15]);
                        att_pv2(buf, sub, P0, P1, O[ct], lane);
                    }
                }
                if (kt + 1 < kt_hi) att_store(st, F.lds + ((kt + 1) & 1) * AT_BUF, tid);
                __syncthreads();
            }
#pragma unroll
            for (int ct = 0; ct < 2; ++ct) {
                const float lt = l[ct] + __shfl_xor(l[ct], 32);
                const float inv = 1.0f / fmaxf(lt, 1e-30f);
                const size_t m = mb + qidx[ct];
                const float gcv = GATES[m * 24 + head * 3 + 0], gsv = GATES[m * 24 + head * 3 + 1], gwv = GATES[m * 24 + head * 3 + 2];
                float* orow = OC + m * 512 + head * 64; bf16_t* crow = CAT + m * 1024 + head * 64;
#pragma unroll
                for (int dt = 0; dt < 2; ++dt)
#pragma unroll
                    for (int i4 = 0; i4 < 4; ++i4) {
                        const int d = dt * 32 + 8 * i4 + 4 * h;
                        const f32x4 prev = *(const f32x4*)(orow + d);
                        const f32x4 ov = (f32x4){O[ct][dt][4 * i4] * inv, O[ct][dt][4 * i4 + 1] * inv, O[ct][dt][4 * i4 + 2] * inv, O[ct][dt][4 * i4 + 3] * inv};
                        if (pass == 0) *(f32x4*)(orow + d) = prev * gcv + ov * gsv;
                        else { const f32x4 r = prev + ov * gwv; u32x2 w; w.x = pk2(r[0], r[1]); w.y = pk2(r[2], r[3]); *(u32x2*)(crow + d) = w; }
                    }
            }
        }
    }
}

__device__ __forceinline__ float logsigmoidf_(float x) { return fminf(x, 0.f) - log1pf(__expf(-fabsf(x))); }
__device__ __forceinline__ bf16x8 frag_lds(const LAS float* p) { const f32x4 a = *(const LAS f32x4*)p, b = *(const LAS f32x4*)(p + 4); return pack8(a[0], a[1], a[2], a[3], b[0], b[1], b[2], b[3]); }
__device__ __forceinline__ bf16x8 frag_glb(const float* p) { const f32x4 a = *(const f32x4*)p, b = *(const f32x4*)(p + 4); return pack8(a[0], a[1], a[2], a[3], b[0], b[1], b[2], b[3]); }
struct GlaRaw { u32x4 ga[4], gb[4]; unsigned short k[4], q[4], v8[8]; };
template <bool WITHQ>
__device__ __forceinline__ void gla_fetch(GlaRaw& R, const Frame& F, const bf16_t* P, size_t m0, int hh) {
    const int dk = F.tid & 63, cq = F.tid >> 6, dv = F.tid & 127, cv = F.tid >> 7;
#pragma unroll
    for (int i = 0; i < 4; ++i) { const bf16_t* row = P + (m0 + 4 * cq + i) * N_IN1;
        R.ga[i] = *(const u32x4*)(row + C1_GLOW); R.gb[i] = *(const u32x4*)(row + C1_GLOW + 8);
        R.k[i] = row[C1_GK + hh * 64 + dk]; if (WITHQ) R.q[i] = row[C1_GQ + hh * 64 + dk]; }
#pragma unroll
    for (int i = 0; i < 8; ++i) R.v8[i] = P[(m0 + 8 * cv + i) * N_IN1 + C1_GV + hh * 128 + dv];
}
__device__ __forceinline__ void gla_bcum3(const Frame& F, const GlaRaw& R, const float (&wg)[16], const float bgv, LAS float* seg, float (&bc)[4], float& blast) {
    const int dk = F.tid & 63, cq = F.tid >> 6;
    float run = 0.f;
#pragma unroll
    for (int i = 0; i < 4; ++i) {
        const u32x4 ga = R.ga[i], gb = R.gb[i];
        float acc = bgv;
        acc += wg[0] * bf_lo(ga.x); acc += wg[1] * bf_hi(ga.x); acc += wg[2] * bf_lo(ga.y); acc += wg[3] * bf_hi(ga.y); acc += wg[4] * bf_lo(ga.z); acc += wg[5] * bf_hi(ga.z); acc += wg[6] * bf_lo(ga.w); acc += wg[7] * bf_hi(ga.w);
        acc += wg[8] * bf_lo(gb.x); acc += wg[9] * bf_hi(gb.x); acc += wg[10] * bf_lo(gb.y); acc += wg[11] * bf_hi(gb.y); acc += wg[12] * bf_lo(gb.z); acc += wg[13] * bf_hi(gb.z); acc += wg[14] * bf_lo(gb.w); acc += wg[15] * bf_hi(gb.w);
        run += logsigmoidf_(acc) * 0.0625f; bc[i] = run;
    }
    seg[cq * 64 + dk] = run;
    __syncthreads();
    float off = 0.f, tot = 0.f;
#pragma unroll
    for (int q = 0; q < 8; ++q) { const float sv = seg[q * 64 + dk]; tot += sv; off += (q < cq) ? sv : 0.f; }
#pragma unroll
    for (int i = 0; i < 4; ++i) bc[i] += off;
    blast = tot;
}
__device__ __forceinline__ void gla_put_vT(const Frame& F, const GlaRaw& R, LAS float* vT) {
    const int dv = F.tid & 127, cv = F.tid >> 7;
    *(LAS f32x4*)(vT + dv * 36 + 8 * cv) = (f32x4){bf2f(R.v8[0]), bf2f(R.v8[1]), bf2f(R.v8[2]), bf2f(R.v8[3])};
    *(LAS f32x4*)(vT + dv * 36 + 8 * cv + 4) = (f32x4){bf2f(R.v8[4]), bf2f(R.v8[5]), bf2f(R.v8[6]), bf2f(R.v8[7])};
}
__device__ __forceinline__ void p_gla_a(const Frame& F, const Args& a, unsigned char* ws) {
    const bf16_t* P = (const bf16_t*)(ws + WS_PROJ); float* UPD = (float*)(ws + L1_UPD); float* DECAY = (float*)(ws + L1_DECAY);
    LAS float* seg = (LAS float*)F.lds; LAS float* kdT = seg + 512; LAS float* vT = kdT + 64 * 36;
    const int tid = F.tid, lane = F.lane, wave = F.wave, r = lane & 31, h = lane >> 5;
    const int UPW = (4096 + F.G - 1) / F.G, u0 = F.bid * UPW, u1 = (u0 + UPW < 4096) ? u0 + UPW : 4096;
    if (u0 >= u1) return;
    GlaRaw R; gla_fetch<false>(R, F, P, (size_t)(u0 >> 9) * 4096 + (u0 & 127) * 32, (u0 >> 7) & 3);
    for (int u = u0; u < u1; ++u) {
        const int hh = (u >> 7) & 3;
        float wg[16];
#pragma unroll
        for (int q = 0; q < 16; ++q) wg[q] = a.in[I_L1_WGATE][q * 256 + hh * 64 + (tid & 63)];
        const float bgv = a.in[I_L1_BGATE][hh * 64 + (tid & 63)];
        float bc[4], blast;
        gla_bcum3(F, R, wg, bgv, seg, bc, blast);
        { const int dk = tid & 63, cq = tid >> 6;
          *(LAS f32x4*)(kdT + dk * 36 + 4 * cq) = (f32x4){bf2f(R.k[0]) * __expf(blast - bc[0]), bf2f(R.k[1]) * __expf(blast - bc[1]), bf2f(R.k[2]) * __expf(blast - bc[2]), bf2f(R.k[3]) * __expf(blast - bc[3])};
          if (cq == 0) DECAY[(size_t)u * 64 + dk] = __expf(blast); }
        gla_put_vT(F, R, vT);
        if (u + 1 < u1) { const int un = u + 1; gla_fetch<false>(R, F, P, (size_t)(un >> 9) * 4096 + (un & 127) * 32, (un >> 7) & 3); }
        __syncthreads();
        {
            const int mt = wave >> 1, nt = wave & 1;
            f32x16 acc = {0.f, 0.f, 0.f, 0.f, 0.f, 0.f, 0.f, 0.f, 0.f, 0.f, 0.f, 0.f, 0.f, 0.f, 0.f, 0.f};
#pragma unroll
            for (int ks = 0; ks < 2; ++ks) acc = __builtin_amdgcn_mfma_f32_32x32x16_bf16(frag_lds(vT + (32 * mt + r) * 36 + 16 * ks + 8 * h), frag_lds(kdT + (32 * nt + r) * 36 + 16 * ks + 8 * h), acc, 0, 0, 0);
            float* up = UPD + (size_t)u * 8192 + 32 * nt + r;
#pragma unroll
            for (int i = 0; i < 16; ++i) up[(size_t)(32 * mt + (i & 3) + 8 * (i >> 2) + 4 * h) * 64] = acc[i];
        }
        __syncthreads();
    }
}
__device__ __forceinline__ void p_gla_b(const Frame& F, unsigned char* ws) {
    float* UPD = (float*)(ws + L1_UPD); const float* DECAY = (const float*)(ws + L1_DECAY);
    for (int e = F.bid * NTHREADS + F.tid; e < 32 * 8192; e += F.G * NTHREADS) {
        const int bh = e >> 13, rem = e & 8191, dk = rem & 63;
        float state = 0.f;
        float* up = UPD + (size_t)bh * 128 * 8192 + rem; const float* dp = DECAY + (size_t)bh * 128 * 64 + dk;
#pragma unroll 8
        for (int n = 0; n < 128; ++n) { const float uv = up[(size_t)n * 8192], dc = dp[n * 64]; up[(size_t)n * 8192] = state; state = dc * state + uv; }
    }
}
__device__ __forceinline__ void p_gla_c(const Frame& F, const Args& a, unsigned char* ws) {
    const bf16_t* P = (const bf16_t*)(ws + WS_PROJ); const float* PREV = (const float*)(ws + L1_UPD); bf16_t* CAT = (bf16_t*)(ws + L1_CAT);
    LAS float* seg = (LAS float*)F.lds; LAS float* qd = seg + 512; LAS float* ki = qd + 32 * 68; LAS float* vT = ki + 32 * 68; LAS float* att = vT + 128 * 36; LAS float* red = att + 32 * 36;
    const int tid = F.tid, lane = F.lane, wave = F.wave, r = lane & 31, h = lane >> 5;
    const int UPW = (4096 + F.G - 1) / F.G, u0 = F.bid * UPW, u1 = (u0 + UPW < 4096) ? u0 + UPW : 4096;
    if (u0 >= u1) return;
    GlaRaw R; gla_fetch<true>(R, F, P, (size_t)(u0 >> 9) * 4096 + (u0 & 127) * 32, (u0 >> 7) & 3);
    for (int u = u0; u < u1; ++u) {
        const int b = u >> 9, hh = (u >> 7) & 3, n = u & 127; const size_t m0 = (size_t)b * 4096 + n * 32;
        bf16x8 pf[4]; unsigned short rv16[16];
        if (wave < 4) {
            const float* pp = PREV + (size_t)u * 8192 + (size_t)(32 * wave + r) * 64;
#pragma unroll
            for (int ks = 0; ks < 4; ++ks) pf[ks] = frag_glb(pp + 16 * ks + 8 * h);
#pragma unroll
            for (int i = 0; i < 16; ++i) rv16[i] = P[(m0 + (i & 3) + 8 * (i >> 2) + 4 * h) * N_IN1 + C1_GR + hh * 128 + 32 * wave + r];
        }
        float wg[16];
#pragma unroll
        for (int q = 0; q < 16; ++q) wg[q] = a.in[I_L1_WGATE][q * 256 + hh * 64 + (tid & 63)];
        const float bgv = a.in[I_L1_BGATE][hh * 64 + (tid & 63)];
        float bc[4], blast;
        gla_bcum3(F, R, wg, bgv, seg, bc, blast);
        { const int dk = tid & 63, cq = tid >> 6;
#pragma unroll
          for (int i = 0; i < 4; ++i) { ki[(4 * cq + i) * 68 + dk] = bf2f(R.k[i]) * __expf(-bc[i]); qd[(4 * cq + i) * 68 + dk] = bf2f(R.q[i]) * 0.125f * __expf(bc[i]); } }
        gla_put_vT(F, R, vT);
        if (u + 1 < u1) { const int un = u + 1; gla_fetch<true>(R, F, P, (size_t)(un >> 9) * 4096 + (un & 127) * 32, (un >> 7) & 3); }
        __syncthreads();
        f32x16 acc = {0.f, 0.f, 0.f, 0.f, 0.f, 0.f, 0.f, 0.f, 0.f, 0.f, 0.f, 0.f, 0.f, 0.f, 0.f, 0.f};
        if (wave == 4) {
            f32x16 at = {0.f, 0.f, 0.f, 0.f, 0.f, 0.f, 0.f, 0.f, 0.f, 0.f, 0.f, 0.f, 0.f, 0.f, 0.f, 0.f};
#pragma unroll
            for (int ks = 0; ks < 4; ++ks) at = __builtin_amdgcn_mfma_f32_32x32x16_bf16(frag_lds(qd + r * 68 + 16 * ks + 8 * h), frag_lds(ki + r * 68 + 16 * ks + 8 * h), at, 0, 0, 0);
#pragma unroll
            for (int i = 0; i < 16; ++i) { const int c = (i & 3) + 8 * (i >> 2) + 4 * h; att[c * 36 + r] = (r <= c) ? at[i] : 0.f; }
        } else if (wave < 4) {
#pragma unroll
            for (int ks = 0; ks < 4; ++ks) acc = __builtin_amdgcn_mfma_f32_32x32x16_bf16(frag_lds(qd + r * 68 + 16 * ks + 8 * h), pf[ks], acc, 0, 0, 0);
        }
        __syncthreads();
        if (wave < 4) {
#pragma unroll
            for (int ks = 0; ks < 2; ++ks) acc = __builtin_amdgcn_mfma_f32_32x32x16_bf16(frag_lds(att + r * 36 + 16 * ks + 8 * h), frag_lds(vT + (32 * wave + r) * 36 + 16 * ks + 8 * h), acc, 0, 0, 0);
#pragma unroll
            for (int i = 0; i < 16; ++i) { float ss = acc[i] * acc[i];
                ss += __shfl_xor(ss, 1); ss += __shfl_xor(ss, 2); ss += __shfl_xor(ss, 4); ss += __shfl_xor(ss, 8); ss += __shfl_xor(ss, 16);
                if (r == 0) red[wave * 32 + (i & 3) + 8 * (i >> 2) + 4 * h] = ss; }
        }
        __syncthreads();
        if (wave < 4) {
            const int dv = 32 * wave + r; const float og = a.in[I_L1_OGAIN][dv];
#pragma unroll
            for (int i = 0; i < 16; ++i) { const int c = (i & 3) + 8 * (i >> 2) + 4 * h;
                const float tot = red[c] + red[32 + c] + red[64 + c] + red[96 + c];
                const float rstd = 1.0f / sqrtf(tot * (1.f / 128.f) + 1e-6f);
                const float rv = bf2f(rv16[i]);
                CAT[(m0 + c) * 1024 + 512 + hh * 128 + dv] = (bf16_t)f2bf(acc[i] * rstd * og * rv * sigmoidf_(rv)); }
        }
        __syncthreads();
    }
}
__global__ void __launch_bounds__(NTHREADS, 2) mk_fwd(Args args) {
    extern __shared__ __attribute__((aligned(16))) unsigned char lds_raw[];
    cg::grid_group grid = cg::this_grid();
    Frame F; F.lds = (LAS unsigned char*)lds_raw; F.tid = threadIdx.x; F.lane = F.tid & 63; F.wave = __builtin_amdgcn_readfirstlane(F.tid >> 6); F.G = gridDim.x; F.bid = blockIdx.x;
    unsigned char* ws = args.ws;
    const int lo = args.ph_lo, hi = args.ph_hi;
#ifndef KEEPMASK
#define KEEPMASK 0xFFFFFFFFu
#endif
#define IN(k) (((KEEPMASK >> (k)) & 1u) && lo <= (k) && (k) < hi)
#define BOTH(k) (IN(k) && IN((k) + 1))
#ifndef TMODE
#define TMODE 0
#endif
#ifndef REPMASK
#define REPMASK 0u
#endif
#define PH(k, ...) if (IN(k)) { { const int rep = 0; (void)rep; __VA_ARGS__; } if ((REPMASK >> (k)) & 1u) { xcd_barrier(xbar); { const int rep = 1; (void)rep; __VA_ARGS__; } } }
#ifdef TS_A
#define STAMP(k) do { if (F.bid == 0 && F.tid == 0) ((unsigned long long*)(ws + WS_CTL + 65536))[(k)] = __builtin_amdgcn_s_memrealtime(); } while (0)
#else
#define STAMP(k) do { } while (0)
#endif
#define GRID_BAR(k) do { if (BOTH(k)) { if ((k) == 0) grid.sync(); else xcd_barrier(xbar); } STAMP((k) + 1); } while (0)
    const float* x = args.in[I_X];
    float* out = args.out;
    volatile LAS unsigned* xst = (volatile LAS unsigned*)(F.lds + LDS_BYTES - 64);
    if (F.tid < 16) xst[F.tid] = 0u;
    __syncthreads();
    XcdBarrier xbar = xcd_barrier_post((unsigned*)(ws + WS_CTL) + 4096, xst);

    STAMP(0);
    PH(0, int base = 0; transpose_all(F, base, args.in[I_L0_WIN], 1024, 1864, (bf16_t*)(ws + WS_W_IN0), 1024, MapIn0()); transpose_all(F, base, args.in[I_L0_WGLU], 512, 512, (bf16_t*)(ws + WS_W_GLU), 512, MapId()); transpose_all(F, base, args.in[I_L0_WOUT], 1024, 1024, (bf16_t*)(ws + WS_W_OUT0), 1024, MapId()); transpose_all(F, base, args.in[I_L0_WQ], 1024, 2048, (bf16_t*)(ws + WS_WQ0), 1024, MapId()); transpose_all(F, base, args.in[I_L1_WIN], 1024, 2856, (bf16_t*)(ws + WS_W_IN1), 1024, MapIn1()); transpose_all(F, base, args.in[I_L1_KW1], 2048, 256, (bf16_t*)(ws + WS_KW1), 2048, MapId()); transpose_all(F, base, args.in[I_L1_VW1], 2048, 256, (bf16_t*)(ws + WS_VW1), 2048, MapId()); transpose_all(F, base, args.in[I_L1_KW2], 256, 64, (bf16_t*)(ws + WS_KW2), 256, MapId()); transpose_all(F, base, args.in[I_L1_VW2], 256, 64, (bf16_t*)(ws + WS_VW2), 256, MapId()); transpose_all(F, base, args.in[I_L1_WOUT], 1024, 1024, (bf16_t*)(ws + WS_W_OUT1), 1024, MapId()); transpose_all(F, base, args.in[I_L1_WQ], 1024, 2048, (bf16_t*)(ws + WS_WQ1), 1024, MapId()); zero_bytes(F, ws + WS_W_IN0 + (size_t)1864 * 1024 * 2, (size_t)(2048 - 1864) * 1024 * 2); zero_bytes(F, ws + WS_W_IN1 + (size_t)2856 * 1024 * 2, (size_t)(3072 - 2856) * 1024 * 2); zero_bytes(F, ws + WS_KW2 + (size_t)64 * 256 * 2, (size_t)192 * 256 * 2); zero_bytes(F, ws + WS_VW2 + (size_t)64 * 256 * 2, (size_t)192 * 256 * 2); cvt_f32_bf16(F, args.in[I_L0_SK], (bf16_t*)(ws + WS_SK0), (size_t)16 * 128 * 128); cvt_f32_bf16(F, args.in[I_L1_SK], (bf16_t*)(ws + WS_SK1), (size_t)16 * 128 * 128); cvt_table_i8(F, args.in[I_L0_U], ws + WS_TAB8U, (float*)(ws + WS_TABSU)); cvt_table_fp8(F, args.in[I_L0_V], ws + WS_TAB8V, (float*)(ws + WS_TABSV)); p_rope_table(F, (f32x2*)(ws + WS_ROPE)); __syncthreads(); for (int g = F.bid; g < 32; g += F.G) s5_build_group(F, args, ws, g); for (int j = (F.bid + F.G - (32 % F.G)) % F.G; j < 64; j += F.G) cmp_bias(F, args, (float*)(ws + WS_CMPB), j); p_rmsnorm(F, x, args.in[I_L0_MIXN], (bf16_t*)(ws + WS_XN));)
    GRID_BAR(0);
    PH(1, pg8::Gemm g{(const bf16_t*)(ws + WS_XN), (const bf16_t*)(ws + WS_W_IN0), T, N_IN0, 1024, 1024, 1024}; pg8::StaticOrder S; S.init(T, N_IN0, F.G, F.bid); pg8::EpiStoreBf16 E{(bf16_t*)(ws + WS_PROJ), N_IN0}; pg8::gemm_phase(F.lds, g, S, E);)
    GRID_BAR(1);
    PH(2, p_l0_prep(F, args, ws);)
    GRID_BAR(2);
    PH(3, p_dsa_index(F, ws, (u64*)(ws + (rep ? L0_CAT : L0_SELT)), rep ? TMODE : 0);)
    GRID_BAR(3);
    PH(4, p_dsa_attn(F, args, ws);)
    GRID_BAR(4);
    PH(5, pg8::Gemm g{(const bf16_t*)(ws + L0_UA), (const bf16_t*)(ws + WS_S5B1), 65536, 8192, 256, 384, 256}; pg8::GroupedOrder S; S.init(256, 8, F.G, F.bid); pg8::EpiS5State E{(float*)(ws + L0_SLOC)}; pg8::gemm_phase(F.lds, g, S, E);)
    GRID_BAR(5);
    PH(6, p_s5_scan(F, args, ws);)
    GRID_BAR(6);
    PH(7, pg8::Gemm g{(const bf16_t*)(ws + L0_UA), (const bf16_t*)(ws + WS_S5B2), 65536, 8192, 384, 384, 384}; pg8::GroupedOrder S; S.init(256, 8, F.G, F.bid); pg8::EpiS5Out E{(bf16_t*)(ws + L0_YB)}; pg8::gemm_phase(F.lds, g, S, E);)
    GRID_BAR(7);
    PH(8, pg8::Gemm g{(const bf16_t*)(ws + L0_YB), (const bf16_t*)(ws + WS_W_GLU), T, 512, 512, 512, 512}; pg8::StaticOrder S; S.init(T, 512, F.G, F.bid); pg8::EpiGlu E{(const bf16_t*)(ws + L0_YB), args.in[I_L0_BGLU], (bf16_t*)(ws + L0_CAT)}; pg8::gemm_phase(F.lds, g, S, E);)
    GRID_BAR(8);
    PH(9, pg8::Gemm g{(const bf16_t*)(ws + L0_CAT), (const bf16_t*)(ws + WS_W_OUT0), T, 1024, 1024, 1024, 1024}; pg8::StaticOrder S; S.init(T, 1024, F.G, F.bid); pg8::EpiResidF32 E{x, out, 1024}; pg8::gemm_phase(F.lds, g, S, E);)
    GRID_BAR(9);
    PH(10, p_rmsnorm(F, out, args.in[I_L0_FFNN], (bf16_t*)(ws + WS_XN));)
    GRID_BAR(10);
    PH(11, pg8::Gemm g{(const bf16_t*)(ws + WS_XN), (const bf16_t*)(ws + WS_WQ0), T, 2048, 1024, 1024, 1024}; pg8::StaticOrder S; S.init(T, 2048, F.G, F.bid); pg8::EpiStoreBf16 E{(bf16_t*)(ws + PE_Q2), 2048}; pg8::gemm_phase(F.lds, g, S, E);)
    GRID_BAR(11);
    PH(12, p_peer_route(F, ws, (const bf16_t*)(ws + WS_SK0));)
    GRID_BAR(12);
    PH(13, p_peer_expert5(F, ws, out, rep ? 0.f : 1.f, xbar, rep ? TMODE : 0);)
    GRID_BAR(13);
    PH(14, p_rmsnorm(F, out, args.in[I_L1_MIXN], (bf16_t*)(ws + WS_XN));)
    GRID_BAR(14);
    PH(15, pg8::Gemm g{(const bf16_t*)(ws + WS_XN), (const bf16_t*)(ws + WS_W_IN1), T, N_IN1, 1024, 1024, 1024}; pg8::StaticOrder S; S.init(T, N_IN1, F.G, F.bid); pg8::EpiStoreBf16 E{(bf16_t*)(ws + WS_PROJ), N_IN1}; pg8::gemm_phase(F.lds, g, S, E);)
    GRID_BAR(15);
    PH(16, p_l1_prep(F, args, ws);)
    GRID_BAR(16);
    PH(17, pg8::Gemm g{(const bf16_t*)(ws + L1_KCR), (const bf16_t*)(ws + WS_KW1), 8192, 512, 2048, 1024, 2048}; pg8::GroupedOrder S; S.init(32, 16, F.G, F.bid); pg8::EpiCmp1 E{(bf16_t*)(ws + L1_H1), (const float*)(ws + WS_CMPB)}; pg8::gemm_phase(F.lds, g, S, E);)
    GRID_BAR(17);
    PH(18, pg8::Gemm g{(const bf16_t*)(ws + L1_H1), (const bf16_t*)(ws + WS_KW2), 8192, 512, 256, 256, 256}; pg8::GroupedOrder S; S.init(32, 16, F.G, F.bid); pg8::EpiCmp2 E{(float*)(ws + L1_CMPO)}; pg8::gemm_phase(F.lds, g, S, E);)
    GRID_BAR(18);
    PH(19, p_cmp_final(F, args, ws);)
    GRID_BAR(19);
    PH(20, p_cmp_attn(F, args, ws);)
    GRID_BAR(20);
    PH(21, if (rep) { p_cmp_attn(F, args, ws); xcd_barrier(xbar); } p_nsa_attn(F, args, ws);)
    GRID_BAR(21);
    PH(22, p_gla_a(F, args, ws); cvt_table_i8(F, args.in[I_L1_U], ws + WS_TAB8U, (float*)(ws + WS_TABSU)); cvt_table_fp8(F, args.in[I_L1_V], ws + WS_TAB8V, (float*)(ws + WS_TABSV));)
    GRID_BAR(22);
    PH(23, if (rep) { p_gla_a(F, args, ws); xcd_barrier(xbar); } p_gla_b(F, ws);)
    GRID_BAR(23);
    PH(24, p_gla_c(F, args, ws);)
    GRID_BAR(24);
    PH(25, pg8::Gemm g{(const bf16_t*)(ws + L1_CAT), (const bf16_t*)(ws + WS_W_OUT1), T, 1024, 1024, 1024, 1024}; pg8::StaticOrder S; S.init(T, 1024, F.G, F.bid); pg8::EpiResidF32 E{out, out, 1024}; pg8::gemm_phase(F.lds, g, S, E);)
    GRID_BAR(25);
    PH(26, p_rmsnorm(F, out, args.in[I_L1_FFNN], (bf16_t*)(ws + WS_XN));)
    GRID_BAR(26);
    PH(27, pg8::Gemm g{(const bf16_t*)(ws + WS_XN), (const bf16_t*)(ws + WS_WQ1), T, 2048, 1024, 1024, 1024}; pg8::StaticOrder S; S.init(T, 2048, F.G, F.bid); pg8::EpiStoreBf16 E{(bf16_t*)(ws + PE_Q2), 2048}; pg8::gemm_phase(F.lds, g, S, E);)
    GRID_BAR(27);
    PH(28, p_peer_route(F, ws, (const bf16_t*)(ws + WS_SK1));)
    GRID_BAR(28);
    PH(29, p_peer_expert5(F, ws, out, rep ? 0.f : 1.f, xbar, rep ? TMODE : 0);)
#undef IN
#undef BOTH
}

extern "C" void kernel_launch(void* const* d_in, const int* in_sizes, int n_in, void* d_out, int out_size, void* d_ws, size_t ws_size, hipStream_t stream) {
    static int grid = 0;
    if (grid == 0) {
        if (n_in != 39 || ws_size < WS_END) { fprintf(stderr, "kernel_launch: unexpected n_in %d or ws_size %zu (< %zu)\n", n_in, ws_size, (size_t)WS_END); grid = -1; return; }
        int dev = 0, cus = 0, per_cu = 0;
        (void)hipGetDevice(&dev); (void)hipDeviceGetAttribute(&cus, hipDeviceAttributeMultiprocessorCount, dev);
        if (hipFuncSetAttribute((const void*)mk_fwd, hipFuncAttributeMaxDynamicSharedMemorySize, LDS_BYTES) != hipSuccess) { fprintf(stderr, "kernel_launch: hipFuncSetAttribute failed\n"); grid = -1; return; }
        if (hipOccupancyMaxActiveBlocksPerMultiprocessor(&per_cu, (const void*)mk_fwd, NTHREADS, LDS_BYTES) != hipSuccess || per_cu < 1) { fprintf(stderr, "kernel_launch: occupancy query failed (%d)\n", per_cu); (void)hipGetLastError(); grid = -1; return; }
        grid = cus;
    }
    if (grid < 0) return;
    (void)hipMemsetAsync((char*)d_ws + WS_CTL, 0, 1 * MiB, stream);
    Args a{};
    for (int i = 0; i < 39; ++i) a.in[i] = (const float*)d_in[i];
    a.out = (float*)d_out; a.ws = (unsigned char*)d_ws; a.ph_lo = 0; a.ph_hi = 1000;
    void* kargs[] = {&a};
    hipError_t e = hipLaunchCooperativeKernel((const void*)mk_fwd, dim3(grid), dim3(NTHREADS), kargs, LDS_BYTES, stream);
    if (e != hipSuccess) fprintf(stderr, "kernel_launch: cooperative launch failed: %s\n", hipGetErrorString(e));
}
```

```cpp
#include <hip/hip_runtime.h>
#include <hip/hip_cooperative_groups.h>
#include <cstdio>
#include <cstdint>
namespace cg = cooperative_groups;

#define LAS __attribute__((address_space(3)))
typedef unsigned short bf16_t;
typedef short bf16x8 __attribute__((ext_vector_type(8)));
typedef float f32x4 __attribute__((ext_vector_type(4)));
typedef float f32x2 __attribute__((ext_vector_type(2)));
typedef float f32x16 __attribute__((ext_vector_type(16)));
typedef unsigned u32x4 __attribute__((ext_vector_type(4)));
typedef unsigned u32x2 __attribute__((ext_vector_type(2)));
typedef unsigned long long u64;

constexpr int NB = 8, SEQ = 4096, DM = 1024, T = NB * SEQ;
constexpr int NTHREADS = 512, NWAVES = 8;
constexpr int LDS_BYTES = 147456;
constexpr int N_IN0 = 2048, N_IN1 = 3072;
constexpr int C0_Q = 0, C0_K = 512, C0_V = 640, C0_IQ = 768, C0_U = 1280, C0_IK = 1792, C0_IW = 1856;
constexpr int C1_Q = 0, C1_KC = 512, C1_VC = 640, C1_KS = 768, C1_VS = 896, C1_KW = 1024, C1_VW = 1152, C1_GQ = 1280, C1_GK = 1536, C1_GV = 1792, C1_GR = 2304, C1_GL = 2816, C1_GLOW = 2840;

constexpr size_t MiB = 1u << 20;
constexpr size_t WS_CTL = 0;
constexpr size_t WS_ROPE = 1 * MiB;
constexpr size_t WS_W_IN0 = 2 * MiB;
constexpr size_t WS_W_GLU = 6 * MiB;
constexpr size_t WS_SK0 = 6 * MiB + 512 * 1024;
constexpr size_t WS_W_OUT0 = 7 * MiB;
constexpr size_t WS_WQ0 = 9 * MiB;
constexpr size_t WS_W_IN1 = 13 * MiB;
constexpr size_t WS_KW1 = 19 * MiB;
constexpr size_t WS_VW1 = 20 * MiB;
constexpr size_t WS_KW2 = 21 * MiB;
constexpr size_t WS_VW2 = 21 * MiB + 128 * 1024;
constexpr size_t WS_SK1 = 21 * MiB + 512 * 1024;
constexpr size_t WS_W_OUT1 = 22 * MiB;
constexpr size_t WS_WQ1 = 24 * MiB;
constexpr size_t WS_S5B1 = 28 * MiB;
constexpr size_t WS_S5B2 = 32 * MiB;
constexpr size_t WS_CMPB = 38 * MiB;
constexpr size_t WS_TABU = 48 * MiB;
constexpr size_t WS_TABV = 80 * MiB;
constexpr size_t WS_XN = 112 * MiB;
constexpr size_t WS_PROJ = 176 * MiB;
constexpr size_t WS_R3 = 368 * MiB;
constexpr size_t WS_END = 506 * MiB;

__device__ __forceinline__ unsigned f2bf(float f) { unsigned u = __builtin_bit_cast(unsigned, f); return (u + 0x7fffu + ((u >> 16) & 1u)) >> 16; }
__device__ __forceinline__ unsigned pk2(float lo, float hi) { return f2bf(lo) | (f2bf(hi) << 16); }
__device__ __forceinline__ float bf_lo(unsigned u) { return __builtin_bit_cast(float, u << 16); }
__device__ __forceinline__ float bf_hi(unsigned u) { return __builtin_bit_cast(float, u & 0xffff0000u); }
__device__ __forceinline__ float bf2f(bf16_t b) { return __builtin_bit_cast(float, ((unsigned)b) << 16); }
__device__ __forceinline__ float wave_sum(float v) {
#pragma unroll
    for (int o = 1; o < 64; o <<= 1) v += __shfl_xor(v, o);
    return v;
}
__device__ __forceinline__ float gelu_tanh(float x) {
    const float y = 0.7978845608028654f * (x + 0.044715f * x * x * x);
    const float e = __expf(2.0f * y);
    const float th = 1.0f - 2.0f / (e + 1.0f);
    return 0.5f * x * (1.0f + th);
}
__device__ __forceinline__ float sigmoidf_(float x) { return 1.0f / (1.0f + __expf(-x)); }
#define LDS_WAIT() asm volatile("s_waitcnt lgkmcnt(0)" ::: "memory")
#define VM_WAIT() asm volatile("s_waitcnt vmcnt(0)" ::: "memory")

#define XB_TMO      128
#define XB_XCNT(j)  (256  + 64 * (j))
#define XB_XSUB(j)  (1280 + 64 * (j))
#define XB_XGEN(j)  (2304 + 64 * (j))
#define XB_TOP      3328
#define XB_TOPGEN   3392
#define XCD_BAR_WORDS 3456
#define XB_SPIN_CAP (1u << 22)
__device__ __forceinline__ unsigned xb_ld(unsigned* p)              { return __hip_atomic_load(p, __ATOMIC_RELAXED, __HIP_MEMORY_SCOPE_AGENT); }
__device__ __forceinline__ unsigned xb_add(unsigned* p, unsigned v) { return __hip_atomic_fetch_add(p, v, __ATOMIC_RELAXED, __HIP_MEMORY_SCOPE_AGENT); }
__device__ __forceinline__ unsigned xb_xcc_id() { return (unsigned)__builtin_amdgcn_s_getreg((3 << 11) | 20) & 0xFu; }
#define XB_SPIN(cond, bar) do { unsigned _sp = 0; while (cond) { __builtin_amdgcn_s_sleep(1); \
    if ((++_sp & 255u) == 0u) { if (xb_ld(&(bar)[XB_TMO])) break; if (_sp > XB_SPIN_CAP) { atomicAdd(&(bar)[XB_TMO], 1u); break; } } } } while (0)
struct XcdBarrier { unsigned* bar; unsigned x; volatile LAS unsigned* st; };
__device__ __forceinline__ XcdBarrier xcd_barrier_post(unsigned* bar, volatile LAS unsigned* st) {
    XcdBarrier b; b.bar = bar; b.x = xb_xcc_id(); b.st = st;
    if (threadIdx.x == 0) (void)xb_add(&bar[XB_XCNT(b.x)], 1u);
    return b;
}
__device__ __forceinline__ void xcd_barrier_complete(unsigned* bar, unsigned x, unsigned& nloc, unsigned& nx) {
    const unsigned G = gridDim.x * gridDim.y * gridDim.z;
    unsigned sum, cnt, mine, sp = 0u;
    for (;;) {
        sum = 0u; cnt = 0u; mine = 0u;
#pragma unroll
        for (unsigned j = 0; j < 16; ++j) { const unsigned c = xb_ld(&bar[XB_XCNT(j)]); sum += c; cnt += (c > 0u) ? 1u : 0u; mine = (j == x) ? c : mine; }
        if (sum == G) break;
        __builtin_amdgcn_s_sleep(1);
        if ((++sp & 255u) == 0u) { if (xb_ld(&bar[XB_TMO])) break; if (sp > XB_SPIN_CAP) { atomicAdd(&bar[XB_TMO], 1u); break; } }
    }
    nloc = mine > 0u ? mine : 1u; nx = cnt > 0u ? cnt : 1u;
}
__device__ __forceinline__ void xcd_barrier(const XcdBarrier& b) {
    asm volatile("s_waitcnt vmcnt(0)" ::: "memory");
    __syncthreads();
    if (threadIdx.x == 0) {
        unsigned* bar = b.bar;
        __builtin_amdgcn_s_waitcnt(0);
        unsigned nloc = b.st[0], nx = b.st[1];
        if (nloc == 0u) { xcd_barrier_complete(bar, b.x, nloc, nx); b.st[0] = nloc; b.st[1] = nx; }
        const unsigned old = xb_add(&bar[XB_XSUB(b.x)], 1u);
        const unsigned gen = old / nloc;
        if (old + 1u == (gen + 1u) * nloc) {
            __builtin_amdgcn_fence(__ATOMIC_RELEASE, "agent");
            asm volatile("s_waitcnt vmcnt(0)" ::: "memory");
            const unsigned og = xb_add(&bar[XB_TOP], 1u);
            const unsigned tg = og / nx;
            if (og + 1u == (tg + 1u) * nx) xb_add(&bar[XB_TOPGEN], 1u);
            else XB_SPIN(xb_ld(&bar[XB_TOPGEN]) == tg, bar);
            __builtin_amdgcn_fence(__ATOMIC_ACQUIRE, "agent");
            xb_add(&bar[XB_XGEN(b.x)], 1u);
            asm volatile("s_waitcnt vmcnt(0)" ::: "memory");
        } else {
            XB_SPIN(xb_ld(&bar[XB_XGEN(b.x)]) == gen, bar);
            __builtin_amdgcn_fence(__ATOMIC_ACQUIRE, "agent");
            asm volatile("s_waitcnt vmcnt(0)" ::: "memory");
        }
    }
    __syncthreads();
}

namespace pg8 {
constexpr int BM = 256, BK = 64, HALF = 128, HTB = HALF * BK * 2, STAGE_BYTES = 8 * HTB, NXCD = 8, WGM = 8;
__device__ __forceinline__ int lds_byte(int r, int c) { const int st = (r >> 4) * 2 + (c >> 5), rr = r & 15, cc = c & 31, ob = rr * 64 + cc * 2; return st * 1024 + (ob ^ (((ob >> 9) & 1) << 5)); }
__device__ __forceinline__ void stage_rc(int b, int& R, int& C) { const int st = b / 1024, sb = b % 1024, swz = sb ^ (((sb >> 9) & 1) << 5); R = (st >> 1) * 16 + swz / 64; C = (st & 1) * 32 + (swz % 64) / 2; }
__device__ __forceinline__ int perm32(int rho) { const int n = rho >> 4, i = rho & 15; return 8 * (i >> 2) + 4 * n + (i & 3); }
struct Unit { int pm, pn; };
struct Gemm { const bf16_t* A; const bf16_t* Bt; int M, N, K, lda, ldb; };
struct StaticOrder {
    int nM, nN, nwg, G, c;
    __device__ void init(int M, int N, int G_, int c_) { nM = M / BM; nN = N / BM; nwg = nM * nN; G = G_; c = c_; }
    __device__ bool next(int i, Unit& u) const {
        const long L = (long)i * G + c; if (L >= nwg) return false;
        int wgid = (int)L; { const int q = nwg / NXCD, r = nwg % NXCD, xcd = wgid % NXCD, off = wgid / NXCD; wgid = (xcd < r ? xcd * (q + 1) : r * (q + 1) + (xcd - r) * q) + off; }
        const int nig = WGM * nN, gid = wgid / nig, fm = gid * WGM, gsz = (nM - fm) < WGM ? (nM - fm) : WGM;
        u.pm = fm + ((wgid % nig) % gsz); u.pn = (wgid % nig) / gsz; return true;
    }
};
struct GroupedOrder {
    int nwg, G, c, tpg;
    __device__ void init(int ntiles, int tiles_per_group, int G_, int c_) { nwg = ntiles; tpg = tiles_per_group; G = G_; c = c_; }
    __device__ bool next(int i, Unit& u) const { const long L = (long)i * G + c; if (L >= nwg) return false; u.pm = (int)L; u.pn = (int)L / tpg; return true; }
};
__device__ __forceinline__ unsigned cvt_pk_bf16(float lo, float hi) { unsigned r; asm volatile("v_cvt_pk_bf16_f32 %0, %1, %2" : "=v"(r) : "v"(lo), "v"(hi)); return r; }

template <class Epi, class Sched>
__device__ __forceinline__ void gemm_phase(LAS unsigned char* lds, const Gemm g, const Sched& S, const Epi& E) {
    const int tid = threadIdx.x, wid = __builtin_amdgcn_readfirstlane(tid >> 6), lane = tid & 63, wr = wid >> 2, wc = wid & 3, fr = lane & 15, fq = lane >> 4;
    int K = g.K; asm volatile("" : "+s"(K));
    const int nt = K / BK;
    unsigned voffA[2], voffB[2];
#pragma unroll
    for (int i = 0; i < 2; ++i) { int R, C; stage_rc(tid * 16 + i * 8192, R, C); const int Rb = Epi::PERM ? ((R & ~31) + perm32(R & 31)) : R;
        voffA[i] = (unsigned)(R * g.lda + C) * 2u; voffB[i] = (unsigned)(Rb * g.ldb + C) * 2u; }
    const size_t kstep = (size_t)(BK * 2);
    const size_t hstepA = (size_t)HALF * g.lda * 2, hstepB = (size_t)HALF * g.ldb * 2;
    const size_t tstepA = 2 * hstepA, tstepB = 2 * hstepB;
    const unsigned ldsw = (unsigned)wid * 1024u;
    const int aoff = lds_byte(wr * 64 + fr, fq * 8), boff = lds_byte(wc * 32 + fr, fq * 8);
#define PG8_SA(b, h) (((b) * 2 + (h)) * HTB)
#define PG8_SB(b, h) ((4 + (b) * 2 + (h)) * HTB)
#define PG8_STAGE(bufoff, gbase, voff) do { _Pragma("unroll") for (int _i = 0; _i < 2; ++_i) \
        __builtin_amdgcn_global_load_lds((const unsigned*)((const char*)(gbase) + (voff)[_i]), (LAS unsigned*)(lds + (bufoff) + ldsw + _i * 8192), 16, 0, 0); } while (0)
#define PG8_LDA(dst, b, h) do { _Pragma("unroll") for (int m = 0; m < 4; ++m) _Pragma("unroll") for (int k = 0; k < 2; ++k) dst[m][k] = *(const LAS bf16x8*)(lds + PG8_SA(b, h) + aoff + m * 2048 + k * 1024); } while (0)
#define PG8_LDB(dst, b, h) do { _Pragma("unroll") for (int n = 0; n < 2; ++n) _Pragma("unroll") for (int k = 0; k < 2; ++k) dst[n][k] = *(const LAS bf16x8*)(lds + PG8_SB(b, h) + boff + n * 2048 + k * 1024); } while (0)
#define PG8_MMA(ai, bj, At, Bt) do { __builtin_amdgcn_s_setprio(1); _Pragma("unroll") for (int m = 0; m < 4; ++m) _Pragma("unroll") for (int n = 0; n < 2; ++n) _Pragma("unroll") for (int k = 0; k < 2; ++k) \
        acc[ai][bj][m][n] = __builtin_amdgcn_mfma_f32_16x16x32_bf16(Bt[n][k], At[m][k], acc[ai][bj][m][n], 0, 0, 0); __builtin_amdgcn_s_setprio(0); } while (0)
#define PG8_WAIT_V(n) asm volatile("s_waitcnt vmcnt(" #n ")" ::: "memory")
#define PG8_WAIT_L(n) asm volatile("s_waitcnt lgkmcnt(" #n ")" ::: "memory")
#define PG8_BAR __builtin_amdgcn_s_barrier()
#define PG8_SCHED __builtin_amdgcn_sched_barrier(0)
    Unit cur, nxt; int ui = 0;
    if (!S.next(0, cur)) return;
    f32x4 acc[2][2][4][2];
#pragma unroll
    for (int a = 0; a < 2; ++a)
#pragma unroll
        for (int b = 0; b < 2; ++b)
#pragma unroll
            for (int m = 0; m < 4; ++m)
#pragma unroll
                for (int n = 0; n < 2; ++n) acc[a][b][m][n] = (f32x4){0.f, 0.f, 0.f, 0.f};
    bf16x8 At[4][2], B0[2][2], B1[2][2];
    const char* cA = (const char*)g.A + (size_t)cur.pm * tstepA; const char* cB = (const char*)g.Bt + (size_t)cur.pn * tstepB;
    PG8_STAGE(PG8_SB(0, 0), cB, voffB); PG8_STAGE(PG8_SA(0, 0), cA, voffA); PG8_STAGE(PG8_SB(0, 1), cB + hstepB, voffB); PG8_STAGE(PG8_SA(0, 1), cA + hstepA, voffA);
    if (wr == 1) PG8_BAR;
    PG8_WAIT_V(4); PG8_BAR;
    PG8_STAGE(PG8_SB(1, 0), cB + kstep, voffB); PG8_STAGE(PG8_SA(1, 0), cA + kstep, voffA); PG8_STAGE(PG8_SB(1, 1), cB + hstepB + kstep, voffB);
    PG8_WAIT_V(6); PG8_BAR;
    for (;;) {
        const bool has_next = S.next(ui + 1, nxt);
        const char* nA = has_next ? (const char*)g.A + (size_t)nxt.pm * tstepA : cA; const char* nB = has_next ? (const char*)g.Bt + (size_t)nxt.pn * tstepB : cB;
        for (int t = 0; t < nt; t += 2) {
            const bool last = (t == nt - 2);
            const char* a1 = cA + (size_t)(t + 1) * kstep;
            const char* a2 = last ? nA : cA + (size_t)(t + 2) * kstep; const char* b2 = last ? nB : cB + (size_t)(t + 2) * kstep;
            const char* a3 = a2 + kstep; const char* b3 = b2 + kstep;
            PG8_LDB(B0, 0, 0); PG8_SCHED; PG8_LDA(At, 0, 0); PG8_STAGE(PG8_SA(1, 1), a1 + hstepA, voffA);
            PG8_WAIT_L(8); PG8_BAR; PG8_WAIT_L(0); PG8_MMA(0, 0, At, B0); PG8_BAR; PG8_SCHED;
            PG8_LDB(B1, 0, 1); PG8_STAGE(PG8_SB(0, 0), b2, voffB);
            PG8_BAR; PG8_WAIT_L(0); PG8_MMA(0, 1, At, B1); PG8_BAR;
            PG8_LDA(At, 0, 1); PG8_STAGE(PG8_SA(0, 0), a2, voffA);
            PG8_BAR; PG8_WAIT_L(0); PG8_MMA(1, 0, At, B0); PG8_BAR; PG8_SCHED;
            PG8_STAGE(PG8_SB(0, 1), b2 + hstepB, voffB);
            PG8_WAIT_V(6); PG8_BAR; PG8_MMA(1, 1, At, B1); PG8_BAR;
            PG8_LDB(B0, 1, 0); PG8_SCHED; PG8_LDA(At, 1, 0); PG8_STAGE(PG8_SA(0, 1), a2 + hstepA, voffA);
            PG8_WAIT_L(8); PG8_BAR; PG8_WAIT_L(0); PG8_MMA(0, 0, At, B0); PG8_BAR; PG8_SCHED;
            PG8_LDB(B1, 1, 1); PG8_STAGE(PG8_SB(1, 0), b3, voffB);
            PG8_BAR; PG8_WAIT_L(0); PG8_MMA(0, 1, At, B1); PG8_BAR;
            PG8_LDA(At, 1, 1); PG8_STAGE(PG8_SA(1, 0), a3, voffA);
            PG8_BAR; PG8_WAIT_L(0); PG8_MMA(1, 0, At, B0); PG8_BAR; PG8_SCHED;
            PG8_STAGE(PG8_SB(1, 1), b3 + hstepB, voffB);
            PG8_WAIT_V(6); PG8_BAR; PG8_MMA(1, 1, At, B1); PG8_BAR;
        }
        E(acc, cur, wr, wc, fr, fq);
        if (!has_next) break;
#pragma unroll
        for (int a = 0; a < 2; ++a)
#pragma unroll
            for (int b = 0; b < 2; ++b)
#pragma unroll
                for (int m = 0; m < 4; ++m)
#pragma unroll
                    for (int n = 0; n < 2; ++n) acc[a][b][m][n] = (f32x4){0.f, 0.f, 0.f, 0.f};
        cur = nxt; cA = nA; cB = nB; ++ui;
    }
    PG8_WAIT_V(0);
    if (wr == 0) PG8_BAR;
    PG8_BAR;
#undef PG8_SA
#undef PG8_SB
#undef PG8_STAGE
#undef PG8_LDA
#undef PG8_LDB
#undef PG8_MMA
#undef PG8_WAIT_V
#undef PG8_WAIT_L
#undef PG8_BAR
#undef PG8_SCHED
}

struct EpiStoreBf16 {
    static constexpr bool PERM = true;
    bf16_t* O; int ldc;
    __device__ __forceinline__ void operator()(const f32x4 (&acc)[2][2][4][2], const Unit& u, int wr, int wc, int fr, int fq) const {
        const int row0 = u.pm * BM + wr * 64 + fr, col0 = u.pn * BM + wc * 32 + 8 * fq;
#pragma unroll
        for (int ai = 0; ai < 2; ++ai)
#pragma unroll
            for (int m = 0; m < 4; ++m) { bf16_t* rowp = O + (size_t)(row0 + ai * HALF + m * 16) * ldc + col0;
#pragma unroll
                for (int bj = 0; bj < 2; ++bj) { const f32x4 v0 = acc[ai][bj][m][0], v1 = acc[ai][bj][m][1];
                    u32x4 w; w.x = cvt_pk_bf16(v0[0], v0[1]); w.y = cvt_pk_bf16(v0[2], v0[3]); w.z = cvt_pk_bf16(v1[0], v1[1]); w.w = cvt_pk_bf16(v1[2], v1[3]);
                    *(u32x4*)(rowp + bj * HALF) = w; } }
    }
};
struct EpiResidF32 {
    static constexpr bool PERM = false;
    const float* R; float* C; int ldc;
    __device__ __forceinline__ void operator()(const f32x4 (&acc)[2][2][4][2], const Unit& u, int wr, int wc, int fr, int fq) const {
        const int row0 = u.pm * BM + wr * 64 + fr, col0 = u.pn * BM + wc * 32 + 4 * fq;
#pragma unroll
        for (int ai = 0; ai < 2; ++ai)
#pragma unroll
            for (int m = 0; m < 4; ++m) { const size_t off = (size_t)(row0 + ai * HALF + m * 16) * ldc + col0;
#pragma unroll
                for (int bj = 0; bj < 2; ++bj)
#pragma unroll
                    for (int n = 0; n < 2; ++n) { const f32x4 r = *(const f32x4*)(R + off + bj * HALF + n * 16); *(f32x4*)(C + off + bj * HALF + n * 16) = r + acc[ai][bj][m][n]; } }
    }
};
}

struct Args {
    const float* in[39];
    float* out;
    unsigned char* ws;
    int ph_lo, ph_hi;
};
enum { I_X = 0, I_L0_MIXN, I_L0_WIN, I_L0_QG, I_L0_KG, I_L0_LOGDT, I_L0_ARE, I_L0_AIM, I_L0_BRE, I_L0_BIM, I_L0_CRE, I_L0_CIM, I_L0_D, I_L0_WGLU, I_L0_BGLU, I_L0_WOUT,
       I_L0_FFNN, I_L0_WQ, I_L0_SK, I_L0_U, I_L0_V,
       I_L1_MIXN, I_L1_WIN, I_L1_QG, I_L1_KG, I_L1_CMPPOS, I_L1_KW1, I_L1_KW2, I_L1_VW1, I_L1_VW2, I_L1_WGATE, I_L1_BGATE, I_L1_OGAIN, I_L1_WOUT,
       I_L1_FFNN, I_L1_WQ, I_L1_SK, I_L1_U, I_L1_V };

struct Frame {
    LAS unsigned char* lds;
    int tid, lane, wave, G, bid;
};

constexpr size_t L0_QA = WS_R3;
constexpr size_t L0_IQ = WS_R3 + 32 * MiB;
constexpr size_t L0_KA = WS_R3 + 64 * MiB;
constexpr size_t L0_VAT = WS_R3 + 72 * MiB;
constexpr size_t L0_IK = WS_R3 + 80 * MiB;
constexpr size_t L0_IW = WS_R3 + 84 * MiB;
constexpr size_t L0_UA = WS_R3 + 88 * MiB;
constexpr size_t L0_SELT = WS_PROJ;
constexpr size_t L0_CAT = WS_PROJ + 16 * MiB;
constexpr size_t L0_SLOC = WS_PROJ + 80 * MiB;
constexpr size_t L0_YB = WS_PROJ + 112 * MiB;
constexpr size_t PE_Q2 = WS_PROJ;
constexpr size_t PE_EID = WS_PROJ + 128 * MiB;
constexpr size_t PE_GATE = WS_PROJ + 136 * MiB;

template <class Map>
__device__ __forceinline__ void transpose_item(const float* W, int K, int N, bf16_t* WT, int ldk, LAS float* scr, int item, int lane, const Map& map) {
    const int nblk = (N + 31) / 32, kb = item / nblk, nb = item % nblk, k0 = 64 * kb, n0 = 32 * nb;
    const int ncol = n0 + (lane & 31);
#pragma unroll 8
    for (int i = 0; i < 32; ++i) { const int kk = 2 * i + (lane >> 5); scr[kk * 33 + (lane & 31)] = (ncol < N) ? W[(size_t)(k0 + kk) * N + ncol] : 0.f; }
    LDS_WAIT(); asm volatile("" ::: "memory");
    const int c = lane & 7;
#pragma unroll
    for (int j = 0; j < 4; ++j) { const int n = (lane >> 3) + 8 * j; const LAS float* s = scr + (8 * c) * 33 + n;
        u32x4 o; o.x = pk2(s[0 * 33], s[1 * 33]); o.y = pk2(s[2 * 33], s[3 * 33]); o.z = pk2(s[4 * 33], s[5 * 33]); o.w = pk2(s[6 * 33], s[7 * 33]);
        if (n0 + n < N) *(u32x4*)(WT + (size_t)map(n0 + n) * ldk + k0 + 8 * c) = o; }
    LDS_WAIT(); asm volatile("" ::: "memory");
}
struct MapId { __device__ __forceinline__ int operator()(int n) const { return n; } };
struct MapIn0 { __device__ __forceinline__ int operator()(int n) const { return n < 1280 ? n : (n < 1344 ? n - 1280 + C0_IK : (n < 1352 ? n - 1344 + C0_IW : n - 1352 + C0_U)); } };
struct MapIn1 { __device__ __forceinline__ int operator()(int n) const {
    if (n < 1280) return n; if (n < 1304) return n - 1280 + C1_GL; if (n < 1560) return n - 1304 + C1_GQ; if (n < 1816) return n - 1560 + C1_GK;
    if (n < 2328) return n - 1816 + C1_GV; if (n < 2344) return n - 2328 + C1_GLOW; return n - 2344 + C1_GR; } };

template <class Map>
__device__ __forceinline__ void transpose_all(const Frame& F, int& base, const float* W, int K, int N, bf16_t* WT, int ldk, const Map& map) {
    LAS float* scr = (LAS float*)(F.lds + F.wave * 16384);
    const int gw = F.bid * NWAVES + F.wave, NGW = F.G * NWAVES;
    const int nit = (K / 64) * ((N + 31) / 32);
    for (int it = (gw + NGW - (base % NGW)) % NGW; it < nit; it += NGW) transpose_item(W, K, N, WT, ldk, scr, it, F.lane, map);
    base += nit;
}
__device__ __forceinline__ void zero_bytes(const Frame& F, unsigned char* p, size_t nbytes) {
    const size_t n16 = nbytes / 16;
    for (size_t i = (size_t)F.bid * NTHREADS + F.tid; i < n16; i += (size_t)F.G * NTHREADS) ((u32x4*)p)[i] = (u32x4){0u, 0u, 0u, 0u};
}
__device__ __forceinline__ void cvt_f32_bf16(const Frame& F, const float* src, bf16_t* dst, size_t n) {
    const size_t n8 = n / 8;
    for (size_t i = (size_t)F.bid * NTHREADS + F.tid; i < n8; i += (size_t)F.G * NTHREADS) {
        const f32x4 a = ((const f32x4*)src)[2 * i], b = ((const f32x4*)src)[2 * i + 1];
        u32x4 o; o.x = pk2(a.x, a.y); o.y = pk2(a.z, a.w); o.z = pk2(b.x, b.y); o.w = pk2(b.z, b.w);
        ((u32x4*)dst)[i] = o;
    }
}

__device__ __forceinline__ void rms_row_to_bf16(const float* xrow, const float* gain, bf16_t* orow, int lane) {
    const f32x4* xr = (const f32x4*)xrow + lane; const f32x4* gr = (const f32x4*)gain + lane;
    f32x4 v[4]; float s = 0.f;
#pragma unroll
    for (int j = 0; j < 4; ++j) { v[j] = xr[64 * j]; s += (v[j].x * v[j].x + v[j].y * v[j].y) + (v[j].z * v[j].z + v[j].w * v[j].w); }
    const float rstd = 1.0f / sqrtf(wave_sum(s) * (1.f / DM) + 1e-6f);
    u64* o8 = (u64*)orow + lane;
#pragma unroll
    for (int j = 0; j < 4; ++j) { const f32x4 g4 = gr[64 * j]; o8[64 * j] = (u64)pk2(v[j].x * rstd * g4.x, v[j].y * rstd * g4.y) | ((u64)pk2(v[j].z * rstd * g4.z, v[j].w * rstd * g4.w) << 32); }
}
__device__ __forceinline__ void p_rmsnorm(const Frame& F, const float* x, const float* gain, bf16_t* XN) {
    const int gw = F.bid * NWAVES + F.wave, NGW = F.G * NWAVES;
    for (int m = gw; m < T; m += NGW) rms_row_to_bf16(x + (size_t)m * DM, gain, XN + (size_t)m * DM, F.lane);
}

__device__ __forceinline__ void p_rope_table(const Frame& F, f32x2* rope) {
    for (int i = F.bid * NTHREADS + F.tid; i < SEQ * 32; i += F.G * NTHREADS) {
        const int pos = i >> 5, k = i & 31;
        const float inv = powf(10000.0f, -(float)k / 32.0f);
        const float ang = (float)pos * inv;
        float s, c; sincosf(ang, &s, &c);
        rope[i] = (f32x2){c, s};
    }
}

__device__ __forceinline__ void s5_build_group(const Frame& F, const Args& a, unsigned char* ws, int g) {
    LAS f32x2* abp = (LAS f32x2*)F.lds;
    LAS f32x2* bb = abp + 17 * 64;
    LAS f32x2* Cc = bb + 64 * 16;
    LAS float* KT = (LAS float*)(Cc + 16 * 64);
    const float dt = expf(a.in[I_L0_LOGDT][g]);
    for (int idx = F.tid; idx < 17 * 64; idx += NTHREADS) {
        const int tau = idx >> 6, p = idx & 63;
        const float lr = a.in[I_L0_ARE][g * 64 + p], li = a.in[I_L0_AIM][g * 64 + p];
        const float mag = expf((float)tau * dt * lr); float s, c; sincosf((float)tau * dt * li, &s, &c);
        abp[idx] = (f32x2){mag * c, mag * s};
    }
    for (int idx = F.tid; idx < 64 * 16; idx += NTHREADS) {
        const int p = idx >> 4, c = idx & 15;
        const float lr = a.in[I_L0_ARE][g * 64 + p], li = a.in[I_L0_AIM][g * 64 + p];
        const float mag = expf(dt * lr); float s, co; sincosf(dt * li, &s, &co);
        const float abr = mag * co, abi = mag * s, den = lr * lr + li * li;
        const float fr = ((abr - 1.0f) * lr + abi * li) / den, fi = (abi * lr - (abr - 1.0f) * li) / den;
        const float br = a.in[I_L0_BRE][(size_t)(g * 64 + p) * 16 + c], bi = a.in[I_L0_BIM][(size_t)(g * 64 + p) * 16 + c];
        bb[idx] = (f32x2){fr * br - fi * bi, fr * bi + fi * br};
    }
    for (int idx = F.tid; idx < 16 * 64; idx += NTHREADS) Cc[idx] = (f32x2){a.in[I_L0_CRE][(size_t)g * 1024 + idx], a.in[I_L0_CIM][(size_t)g * 1024 + idx]};
    __syncthreads();
    for (int idx = F.tid; idx < 16 * 256; idx += NTHREADS) {
        const int tau = idx >> 8, co = (idx >> 4) & 15, ci = idx & 15;
        float acc = 0.f;
        for (int p = 0; p < 64; ++p) {
            const f32x2 c = Cc[co * 64 + p], e = abp[tau * 64 + p], b = bb[p * 16 + ci];
            const float er = c.x * e.x - c.y * e.y, ei = c.x * e.y + c.y * e.x;
            acc += er * b.x - ei * b.y;
        }
        if (tau == 0 && co == ci) acc += a.in[I_L0_D][g * 16 + co];
        KT[idx] = acc;
    }
    __syncthreads();
    bf16_t* B1 = (bf16_t*)(ws + WS_S5B1) + (size_t)g * 256 * 256;
    bf16_t* B2 = (bf16_t*)(ws + WS_S5B2) + (size_t)g * 256 * 384;
    for (int idx = F.tid; idx < 256 * 128; idx += NTHREADS) {
        const int n = idx >> 7, k = (idx & 127) * 2;
        float v0 = 0.f, v1 = 0.f;
        if (n < 128) { const int p = n & 63, j = k >> 4, ci = k & 15; const f32x2 e = abp[(15 - j) * 64 + p], b0 = bb[p * 16 + ci], b1 = bb[p * 16 + ci + 1];
            if (n < 64) { v0 = e.x * b0.x - e.y * b0.y; v1 = e.x * b1.x - e.y * b1.y; } else { v0 = e.x * b0.y + e.y * b0.x; v1 = e.x * b1.y + e.y * b1.x; } }
        *(unsigned*)(B1 + (size_t)n * 256 + k) = pk2(v0, v1);
    }
    for (int idx = F.tid; idx < 256 * 192; idx += NTHREADS) {
        const int n = idx / 192, k = (idx % 192) * 2, i = n >> 4, co = n & 15;
        float v0 = 0.f, v1 = 0.f;
        if (k < 256) { const int j = k >> 4, ci = k & 15; if (j <= i) { v0 = KT[((i - j) * 16 + co) * 16 + ci]; v1 = KT[((i - j) * 16 + co) * 16 + ci + 1]; } }
        else { const int p = (k - 256) & 63; const bool im = k >= 320;
            const f32x2 c0 = Cc[co * 64 + p], e0 = abp[(i + 1) * 64 + p], c1 = Cc[co * 64 + p + 1], e1 = abp[(i + 1) * 64 + p + 1];
            if (!im) { v0 = c0.x * e0.x - c0.y * e0.y; v1 = c1.x * e1.x - c1.y * e1.y; } else { v0 = -(c0.x * e0.y + c0.y * e0.x); v1 = -(c1.x * e1.y + c1.y * e1.x); } }
        *(unsigned*)(B2 + (size_t)n * 384 + k) = pk2(v0, v1);
    }
    __syncthreads();
}

__device__ __forceinline__ void cmp_bias(const Frame& F, const Args& a, float* out, int j) {
    const int w = j >> 5, n0 = (j & 31) * 8;
    const float* w1 = a.in[w ? I_L1_VW1 : I_L1_KW1]; const float* pos = a.in[I_L1_CMPPOS];
    LAS float* red = (LAS float*)(F.lds + 65536);
    float acc[8];
#pragma unroll
    for (int i = 0; i < 8; ++i) acc[i] = 0.f;
#pragma unroll
    for (int kk = 0; kk < 4; ++kk) { const int k = F.tid * 4 + kk; const float p = pos[k];
        const f32x4 wa = *(const f32x4*)(w1 + (size_t)k * 256 + n0), wb = *(const f32x4*)(w1 + (size_t)k * 256 + n0 + 4);
        acc[0] += p * wa.x; acc[1] += p * wa.y; acc[2] += p * wa.z; acc[3] += p * wa.w; acc[4] += p * wb.x; acc[5] += p * wb.y; acc[6] += p * wb.z; acc[7] += p * wb.w; }
#pragma unroll
    for (int i = 0; i < 8; ++i) { const float sv = wave_sum(acc[i]); if (F.lane == 0) red[F.wave * 8 + i] = sv; }
    __syncthreads();
    if (F.tid < 8) { float t = 0.f; for (int wv = 0; wv < 8; ++wv) t += red[wv * 8 + F.tid]; out[w * 256 + n0 + F.tid] = t; }
    __syncthreads();
}

__device__ __forceinline__ float rope_apply(float v, const f32x2 cs, int lane) {
    const float partner = __shfl_xor(v, 32);
    return lane < 32 ? v * cs.x - partner * cs.y : partner * cs.y + v * cs.x;
}
__device__ __forceinline__ void head8_load(const bf16_t* p, float (&v)[8]) {
    const u32x4 q = *(const u32x4*)p;
    v[0] = bf_lo(q.x); v[1] = bf_hi(q.x); v[2] = bf_lo(q.y); v[3] = bf_hi(q.y); v[4] = bf_lo(q.z); v[5] = bf_hi(q.z); v[6] = bf_lo(q.w); v[7] = bf_hi(q.w);
}
__device__ __forceinline__ void head8_store(bf16_t* p, const float (&v)[8], const float sc) {
    u32x4 q; q.x = pk2(v[0] * sc, v[1] * sc); q.y = pk2(v[2] * sc, v[3] * sc); q.z = pk2(v[4] * sc, v[5] * sc); q.w = pk2(v[6] * sc, v[7] * sc);
    *(u32x4*)p = q;
}
__device__ __forceinline__ void head8_norm(float (&v)[8], const float (&g)[8]) {
    float ss = 0.f;
#pragma unroll
    for (int j = 0; j < 8; ++j) ss += v[j] * v[j];
    ss += __shfl_xor(ss, 1); ss += __shfl_xor(ss, 2); ss += __shfl_xor(ss, 4);
    const float r = 1.0f / sqrtf(ss * (1.f / 64.f) + 1e-6f);
#pragma unroll
    for (int j = 0; j < 8; ++j) v[j] = v[j] * r * g[j];
}
__device__ __forceinline__ void head8_rope(float (&v)[8], const f32x2 (&cs)[8], const bool upper) {
#pragma unroll
    for (int j = 0; j < 8; ++j) { const float partner = __shfl_xor(v[j], 4); v[j] = upper ? partner * cs[j].y + v[j] * cs[j].x : v[j] * cs[j].x - partner * cs[j].y; }
}
__device__ __forceinline__ void p_l0_prep(const Frame& F, const Args& a, unsigned char* ws) {
    const bf16_t* P = (const bf16_t*)(ws + WS_PROJ);
    const f32x2* rope = (const f32x2*)(ws + WS_ROPE);
    bf16_t* QA = (bf16_t*)(ws + L0_QA); bf16_t* IQ = (bf16_t*)(ws + L0_IQ); bf16_t* KA = (bf16_t*)(ws + L0_KA); bf16_t* VAT = (bf16_t*)(ws + L0_VAT);
    bf16_t* IK = (bf16_t*)(ws + L0_IK); float* IW = (float*)(ws + L0_IW); bf16_t* UA = (bf16_t*)(ws + L0_UA);
    const int gw = F.bid * NWAVES + F.wave, NGW = F.G * NWAVES, lane = F.lane, hs = lane >> 3, sub = lane & 7;
    float qg[8], kg[8];
#pragma unroll
    for (int j = 0; j < 8; ++j) { qg[j] = a.in[I_L0_QG][sub * 8 + j]; kg[j] = a.in[I_L0_KG][sub * 8 + j]; }
    for (int m = gw; m < T; m += NGW) {
        const int b = m >> 12, t = m & 4095;
        const bf16_t* row = P + (size_t)m * N_IN0;
        f32x2 cs[8];
#pragma unroll
        for (int j = 0; j < 4; ++j) { const f32x4 c4 = *(const f32x4*)(rope + t * 32 + (sub & 3) * 8 + 2 * j); cs[2 * j] = (f32x2){c4.x, c4.y}; cs[2 * j + 1] = (f32x2){c4.z, c4.w}; }
        float v[8];
        head8_load(row + C0_Q + lane * 8, v); head8_norm(v, qg); head8_rope(v, cs, sub >= 4); head8_store(QA + (size_t)m * 512 + lane * 8, v, 0.125f);
        head8_load(row + C0_IQ + lane * 8, v); head8_rope(v, cs, sub >= 4); head8_store(IQ + (size_t)m * 512 + lane * 8, v, 0.125f);
        {
            const int hh = hs < 3 ? hs : 2;
            head8_load(row + (hh < 2 ? C0_K + hh * 64 : C0_IK) + sub * 8, v);
            float vn[8];
#pragma unroll
            for (int j = 0; j < 8; ++j) vn[j] = v[j];
            head8_norm(vn, kg);
#pragma unroll
            for (int j = 0; j < 8; ++j) v[j] = (hh < 2) ? vn[j] : v[j];
            head8_rope(v, cs, sub >= 4);
            if (hs < 2) head8_store(KA + ((size_t)(b * 2 + hs) * 4096 + t) * 64 + sub * 8, v, 1.0f);
            else if (hs == 2) head8_store(IK + (size_t)m * 64 + sub * 8, v, 1.0f);
        }
        if (lane < 8) IW[(size_t)m * 8 + lane] = bf2f(row[C0_IW + lane]) * 0.35355339059327373f;
        { const u32x4 uv = *(const u32x4*)(row + C0_U + lane * 8); const int g = lane >> 1;
          *(u32x4*)(UA + ((size_t)g * 2048 + (m >> 4)) * 384 + (m & 15) * 16 + (lane & 1) * 8) = uv; }
    }
    for (int it = gw; it < NB * 2 * 64; it += NGW) {
        const int tb = it & 63, g = (it >> 6) & 1, b = it >> 7;
        const size_t m = (size_t)b * 4096 + tb * 64 + lane;
        unsigned r[32];
#pragma unroll
        for (int j = 0; j < 8; ++j) { const u32x4 q = *(const u32x4*)(P + m * N_IN0 + C0_V + g * 64 + j * 8); r[4 * j] = q.x; r[4 * j + 1] = q.y; r[4 * j + 2] = q.z; r[4 * j + 3] = q.w; }
        bf16_t* dst = VAT + ((size_t)(b * 2 + g) * 64) * 4096 + tb * 64 + lane;
#pragma unroll
        for (int d = 0; d < 64; ++d) dst[(size_t)d * 4096] = (bf16_t)((d & 1) ? (r[d >> 1] >> 16) : (r[d >> 1] & 0xffffu));
    }
}

__device__ __forceinline__ unsigned f16key(unsigned raw) { return (raw & 0x8000u) ? (~raw & 0xFFFFu) : (raw | 0x8000u); }
template <int NREG>
__device__ __forceinline__ int topk_count_ge(const unsigned (&kk)[NREG], const unsigned cm1pk) {
    unsigned acc = 0u; const unsigned ones = 0x00010001u;
#pragma unroll
    for (int jj = 0; jj < NREG; ++jj) {
        unsigned d;
        asm("v_pk_sub_u16 %0, %1, %2 clamp" : "=v"(d) : "v"(kk[jj]), "v"(cm1pk));
        asm("v_pk_min_u16 %0, %1, %2" : "=v"(d) : "v"(d), "v"(ones));
        asm("v_pk_add_u16 %0, %1, %2" : "=v"(acc) : "v"(acc), "v"(d));
    }
    int c = (int)((acc & 0xffffu) + (acc >> 16));
    c += __builtin_amdgcn_update_dpp(0, c, 0xB1, 0xF, 0xF, true);
    c += __builtin_amdgcn_update_dpp(0, c, 0x4E, 0xF, 0xF, true);
    c += __builtin_amdgcn_update_dpp(0, c, 0x141, 0xF, 0xF, true);
    c += __builtin_amdgcn_update_dpp(0, c, 0x140, 0xF, 0xF, true);
    return __builtin_amdgcn_readlane(c, 0) + __builtin_amdgcn_readlane(c, 16) + __builtin_amdgcn_readlane(c, 32) + __builtin_amdgcn_readlane(c, 48);
}
template <int NREG>
__device__ __forceinline__ u64 topk_query(const LAS unsigned short* scq, const int t, const int lane) {
    unsigned kk[NREG];
#pragma unroll
    for (int jj = 0; jj < NREG; ++jj) {
        const int e0 = (2 * jj) * 64 + lane, e1 = e0 + 64;
        const unsigned r0 = scq[e0], r1 = scq[e1];
        kk[jj] = ((e0 <= t) ? f16key(r0) : 0u) | (((e1 <= t) ? f16key(r1) : 0u) << 16);
        if ((jj & 3) == 3) __builtin_amdgcn_sched_barrier(0);
    }
    unsigned prefix = 0u; bool exact = false;
#pragma unroll 1
    for (int bit = 15; bit >= 0; --bit) {
        const unsigned cand = prefix | (1u << bit), cm1 = cand - 1u;
        const int cnt = topk_count_ge<NREG>(kk, cm1 | (cm1 << 16));
        if (cnt >= 256) prefix = cand;
        if (cnt == 256) { exact = true; break; }
    }
    unsigned mylo = 0u, myhi = 0u;
    if (exact) {
#pragma unroll
        for (int i = 0; i < 2 * NREG; ++i) {
            const unsigned k = (i & 1) ? (kk[i >> 1] >> 16) : (kk[i >> 1] & 0xffffu);
            const u64 w = __ballot(k >= prefix);
            asm("s_nop 4\n\tv_writelane_b32 %0, %2, %4\n\tv_writelane_b32 %1, %3, %4" : "+v"(mylo), "+v"(myhi) : "s"((unsigned)w), "s"((unsigned)(w >> 32)), "n"(i));
        }
    } else {
        const unsigned Tk = prefix;
        const int cgt = (Tk >= 0xFFFFu) ? 0 : topk_count_ge<NREG>(kk, Tk | (Tk << 16));
        const int need = 256 - cgt;
        int run = 0;
#pragma unroll
        for (int i = 0; i < 2 * NREG; ++i) {
            const unsigned k = (i & 1) ? (kk[i >> 1] >> 16) : (kk[i >> 1] & 0xffffu);
            const u64 gt = __ballot(k > Tk); u64 eq = __ballot(k == Tk);
            const int pe = __builtin_popcountll(eq);
            if (run + pe > need) { int kq = need - run; kq = kq < 0 ? 0 : kq;
                const bool keep = ((eq >> lane) & 1ull) && (__builtin_popcountll(eq & ((1ull << lane) - 1ull)) < kq); eq = __ballot(keep); }
            run += pe;
            const u64 w = gt | eq;
            asm("s_nop 4\n\tv_writelane_b32 %0, %2, %4\n\tv_writelane_b32 %1, %3, %4" : "+v"(mylo), "+v"(myhi) : "s"((unsigned)w), "s"((unsigned)(w >> 32)), "n"(i));
        }
    }
    return (u64)mylo | ((u64)myhi << 32);
}
__device__ __forceinline__ void p_dsa_index(const Frame& F, unsigned char* ws, u64* SELT, const int mode) {
    const bf16_t* IQ = (const bf16_t*)(ws + L0_IQ); const bf16_t* IK = (const bf16_t*)(ws + L0_IK); const float* IW = (const float*)(ws + L0_IW);
    LAS _Float16* sc = (LAS _Float16*)F.lds;
    LAS unsigned short* scu = (LAS unsigned short*)F.lds;
    LAS u64* mk = (LAS u64*)(F.lds + 131072);
    LAS float* wl = (LAS float*)(F.lds + 131072 + 8192);
    const int lane = F.lane, wave = F.wave, h = lane >> 5, r = lane & 31;
    const int rq = ((r >> 4) & 1) + 2 * ((r >> 2) & 1), rh = 4 * ((r >> 3) & 1) + (r & 3);
    for (int u = F.bid; u < 2048; u += F.G) {
        const int idx = u & 255, b = u >> 8;
        const int j = (b & 1) ? 255 - idx : idx;
        const int t0 = j * 16; const size_t mb = (size_t)b * 4096;
        if (F.tid < 128) wl[F.tid] = IW[(mb + t0) * 8 + F.tid];
        const int nkb = (t0 + 15) / 32 + 1;
        bf16x8 Af[4][4];
#pragma unroll
        for (int rt = 0; rt < 4; ++rt)
#pragma unroll
            for (int ks = 0; ks < 4; ++ks) Af[rt][ks] = *(const bf16x8*)(IQ + (mb + t0 + 4 * rt + rq) * 512 + rh * 64 + ks * 16 + 8 * h);
        __syncthreads();
        if (mode != 2) for (int kb = wave; kb < nkb; kb += NWAVES) {
            bf16x8 Bf[4];
#pragma unroll
            for (int ks = 0; ks < 4; ++ks) Bf[ks] = *(const bf16x8*)(IK + (mb + kb * 32 + r) * 64 + ks * 16 + 8 * h);
#pragma unroll
            for (int rt = 0; rt < 4; ++rt) {
                f32x16 acc = {0.f, 0.f, 0.f, 0.f, 0.f, 0.f, 0.f, 0.f, 0.f, 0.f, 0.f, 0.f, 0.f, 0.f, 0.f, 0.f};
#pragma unroll
                for (int ks = 0; ks < 4; ++ks) acc = __builtin_amdgcn_mfma_f32_32x32x16_bf16(Af[rt][ks], Bf[ks], acc, 0, 0, 0);
                const int qa = 4 * rt + 2 * h;
                const f32x4 wa0 = *(const LAS f32x4*)(wl + qa * 8), wa1 = *(const LAS f32x4*)(wl + qa * 8 + 4), wb0 = *(const LAS f32x4*)(wl + qa * 8 + 8), wb1 = *(const LAS f32x4*)(wl + qa * 8 + 12);
                float sa = 0.f, sb = 0.f;
#pragma unroll
                for (int i = 0; i < 4; ++i) { sa += wa0[i] * fmaxf(acc[i], 0.f); sa += wa1[i] * fmaxf(acc[4 + i], 0.f); sb += wb0[i] * fmaxf(acc[8 + i], 0.f); sb += wb1[i] * fmaxf(acc[12 + i], 0.f); }
                sc[qa * 4096 + kb * 32 + r] = (_Float16)sa;
                sc[(qa + 1) * 4096 + kb * 32 + r] = (_Float16)sb;
                __builtin_amdgcn_sched_barrier(0);
            }
        }
        __syncthreads();
#pragma unroll 1
        for (int qq = 0; qq < (mode == 1 ? 0 : 2); ++qq) {
            const int q = wave * 2 + qq, t = t0 + q, n = t + 1;
            unsigned mylo = 0u, myhi = 0u;
            if (n <= 256) {
                const int base = lane * 64;
                const u64 word = (base + 63 <= t) ? ~0ull : (base > t ? 0ull : ((1ull << (t - base + 1)) - 1ull));
                mylo = (unsigned)word; myhi = (unsigned)(word >> 32);
            } else {
                const int nreg = (((n + 63) >> 6) + 1) >> 1;
                const LAS unsigned short* scq = scu + q * 4096;
                u64 w;
                if (nreg <= 4) w = topk_query<4>(scq, t, lane);
                else if (nreg <= 8) w = topk_query<8>(scq, t, lane);
                else if (nreg <= 12) w = topk_query<12>(scq, t, lane);
                else if (nreg <= 16) w = topk_query<16>(scq, t, lane);
                else if (nreg <= 20) w = topk_query<20>(scq, t, lane);
                else if (nreg <= 24) w = topk_query<24>(scq, t, lane);
                else if (nreg <= 28) w = topk_query<28>(scq, t, lane);
                else w = topk_query<32>(scq, t, lane);
                mylo = (unsigned)w; myhi = (unsigned)(w >> 32);
            }
            mk[lane * 16 + q] = (u64)mylo | ((u64)myhi << 32);
        }
        __syncthreads();
        { const int w = F.tid >> 3, part = F.tid & 7;
          u64* dst = SELT + ((size_t)(b * 64 + w) * 4096) + t0 + part * 2;
          dst[0] = mk[w * 16 + part * 2]; dst[1] = mk[w * 16 + part * 2 + 1]; }
        __syncthreads();
    }
}

constexpr int AT_KB = 9216, AT_VB = 8704, AT_BUF = AT_KB + AT_VB;
struct AttStage { u32x4 kreg, vreg; };
__device__ __forceinline__ void att_load(AttStage& s, const bf16_t* Kg, const bf16_t* Vtg, int key0, int tid) {
    s.kreg = *(const u32x4*)(Kg + (size_t)(key0 + (tid >> 3)) * 64 + (tid & 7) * 8);
    s.vreg = *(const u32x4*)(Vtg + (size_t)(tid >> 3) * 4096 + key0 + (tid & 7) * 8);
}
__device__ __forceinline__ void att_store(const AttStage& s, LAS unsigned char* buf, int tid) {
    *(LAS u32x4*)(buf + (tid >> 3) * 144 + (tid & 7) * 16) = s.kreg;
    LAS unsigned char* v = buf + AT_KB + (tid >> 3) * 136 + (tid & 7) * 16;
    *(LAS u32x2*)(v) = (u32x2){s.vreg.x, s.vreg.y}; *(LAS u32x2*)(v + 8) = (u32x2){s.vreg.z, s.vreg.w};
}
__device__ __forceinline__ bf16x8 pack8(float a0, float a1, float a2, float a3, float a4, float a5, float a6, float a7) {
    u32x4 w; w.x = pg8::cvt_pk_bf16(a0, a1); w.y = pg8::cvt_pk_bf16(a2, a3); w.z = pg8::cvt_pk_bf16(a4, a5); w.w = pg8::cvt_pk_bf16(a6, a7);
    return __builtin_bit_cast(bf16x8, w);
}
__device__ __forceinline__ f32x16 att_qk(const LAS unsigned char* buf, int sub, const bf16x8 (&Qf)[4], int lane) {
    f32x16 S = {0.f, 0.f, 0.f, 0.f, 0.f, 0.f, 0.f, 0.f, 0.f, 0.f, 0.f, 0.f, 0.f, 0.f, 0.f, 0.f};
    const LAS unsigned char* kp = buf + (sub * 32 + (lane & 31)) * 144 + (lane >> 5) * 16;
#pragma unroll
    for (int ks = 0; ks < 4; ++ks) { const bf16x8 kf = *(const LAS bf16x8*)(kp + ks * 32); S = __builtin_amdgcn_mfma_f32_32x32x16_bf16(kf, Qf[ks], S, 0, 0, 0); }
    return S;
}
__device__ __forceinline__ void att_pv2(const LAS unsigned char* buf, int sub, const bf16x8 P0, const bf16x8 P1, f32x16 (&O)[2], int lane) {
    const int h = lane >> 5;
#pragma unroll
    for (int dt = 0; dt < 2; ++dt) {
        const LAS unsigned char* vp = buf + AT_KB + (dt * 32 + (lane & 31)) * 136 + (sub * 32 + 4 * h) * 2;
        const u32x2 a0 = *(const LAS u32x2*)(vp), a1 = *(const LAS u32x2*)(vp + 16), b0 = *(const LAS u32x2*)(vp + 32), b1 = *(const LAS u32x2*)(vp + 48);
        const bf16x8 V0 = __builtin_bit_cast(bf16x8, ((u32x4){a0.x, a0.y, a1.x, a1.y}));
        const bf16x8 V1 = __builtin_bit_cast(bf16x8, ((u32x4){b0.x, b0.y, b1.x, b1.y}));
        O[dt] = __builtin_amdgcn_mfma_f32_32x32x16_bf16(V0, P0, O[dt], 0, 0, 0);
        O[dt] = __builtin_amdgcn_mfma_f32_32x32x16_bf16(V1, P1, O[dt], 0, 0, 0);
    }
}
__device__ __forceinline__ void att_pv(const LAS unsigned char* buf, int sub, const float (&p)[16], f32x16 (&O)[2], int lane) {
    const bf16x8 P0 = pack8(p[0], p[1], p[2], p[3], p[4], p[5], p[6], p[7]);
    const bf16x8 P1 = pack8(p[8], p[9], p[10], p[11], p[12], p[13], p[14], p[15]);
    att_pv2(buf, sub, P0, P1, O, lane);
}

__device__ __forceinline__ void att_kfrags(const LAS unsigned char* buf, int sub, bf16x8 (&Kf)[4], int lane) {
    const LAS unsigned char* kp = buf + (sub * 32 + (lane & 31)) * 144 + (lane >> 5) * 16;
#pragma unroll
    for (int ks = 0; ks < 4; ++ks) Kf[ks] = *(const LAS bf16x8*)(kp + ks * 32);
}
__device__ __forceinline__ void att_vfrags(const LAS unsigned char* buf, int sub, bf16x8 (&Vf)[2][2], int lane) {
    const int h = lane >> 5;
#pragma unroll
    for (int dt = 0; dt < 2; ++dt) {
        const LAS unsigned char* vp = buf + AT_KB + (dt * 32 + (lane & 31)) * 136 + (sub * 32 + 4 * h) * 2;
        const u32x2 a0 = *(const LAS u32x2*)(vp), a1 = *(const LAS u32x2*)(vp + 16), b0 = *(const LAS u32x2*)(vp + 32), b1 = *(const LAS u32x2*)(vp + 48);
        Vf[dt][0] = __builtin_bit_cast(bf16x8, ((u32x4){a0.x, a0.y, a1.x, a1.y}));
        Vf[dt][1] = __builtin_bit_cast(bf16x8, ((u32x4){b0.x, b0.y, b1.x, b1.y}));
    }
}
__device__ __forceinline__ f32x16 att_qk_f(const bf16x8 (&Kf)[4], const bf16x8 (&Qf)[4]) {
    f32x16 S = {0.f, 0.f, 0.f, 0.f, 0.f, 0.f, 0.f, 0.f, 0.f, 0.f, 0.f, 0.f, 0.f, 0.f, 0.f, 0.f};
#pragma unroll
    for (int ks = 0; ks < 4; ++ks) S = __builtin_amdgcn_mfma_f32_32x32x16_bf16(Kf[ks], Qf[ks], S, 0, 0, 0);
    return S;
}
__device__ __forceinline__ void att_pv_f(const bf16x8 (&Vf)[2][2], const bf16x8 P0, const bf16x8 P1, f32x16 (&O)[2]) {
#pragma unroll
    for (int dt = 0; dt < 2; ++dt) { O[dt] = __builtin_amdgcn_mfma_f32_32x32x16_bf16(Vf[dt][0], P0, O[dt], 0, 0, 0); O[dt] = __builtin_amdgcn_mfma_f32_32x32x16_bf16(Vf[dt][1], P1, O[dt], 0, 0, 0); }
}

__device__ __forceinline__ void p_dsa_attn(const Frame& F, const Args& a, unsigned char* ws) {
    const bf16_t* QA = (const bf16_t*)(ws + L0_QA); const bf16_t* KA = (const bf16_t*)(ws + L0_KA); const bf16_t* VAT = (const bf16_t*)(ws + L0_VAT);
    const u64* SELT = (const u64*)(ws + L0_SELT); bf16_t* CAT = (bf16_t*)(ws + L0_CAT);
    const int lane = F.lane, wave = F.wave, h = lane >> 5, c = lane & 31, tid = F.tid;
    float mq = 0.f, mk_ = 0.f;
    for (int i = 0; i < 64; ++i) { mq = fmaxf(mq, fabsf(a.in[I_L0_QG][i])); mk_ = fmaxf(mk_, fabsf(a.in[I_L0_KG][i])); }
    const float c2 = (8.0f * mq * mk_ + 0.5f) * 1.4426950408889634f, c1 = 1.4426950408889634f;
    for (int u = F.bid; u < 512; u += F.G) {
        const int idx = u & 255, g = u >> 8, b = idx >> 5, qtr = idx & 31, qt = g ? 31 - qtr : qtr, q0 = qt * 128;
        const size_t mb = (size_t)b * 4096;
        const bf16_t* Kg = KA + (size_t)(b * 2 + g) * 4096 * 64; const bf16_t* Vtg = VAT + (size_t)(b * 2 + g) * 64 * 4096;
        bf16x8 Qf[2][4]; int qidx[2];
#pragma unroll
        for (int ct = 0; ct < 2; ++ct) { qidx[ct] = q0 + wave * 16 + ct * 8 + (c >> 2);
#pragma unroll
            for (int ks = 0; ks < 4; ++ks) Qf[ct][ks] = *(const bf16x8*)(QA + (mb + qidx[ct]) * 512 + (g * 4 + (c & 3)) * 64 + ks * 16 + 8 * h); }
        f32x16 O[2][2]; float l[2] = {0.f, 0.f};
#pragma unroll
        for (int ct = 0; ct < 2; ++ct)
#pragma unroll
            for (int dt = 0; dt < 2; ++dt)
#pragma unroll
                for (int i = 0; i < 16; ++i) O[ct][dt][i] = 0.f;
        const int nkt = 2 * qt + 2;
        AttStage st; att_load(st, Kg, Vtg, 0, tid);
        __syncthreads();
        att_store(st, F.lds, tid);
        __syncthreads();
        for (int kt = 0; kt < nkt; ++kt) {
            LAS unsigned char* buf = F.lds + (kt & 1) * AT_BUF;
            if (kt + 1 < nkt) att_load(st, Kg, Vtg, (kt + 1) * 64, tid);
            u64 mw[2];
#pragma unroll
            for (int ct = 0; ct < 2; ++ct) mw[ct] = SELT[(size_t)(b * 64 + kt) * 4096 + qidx[ct]];
#pragma unroll 1
            for (int sub = 0; sub < 2; ++sub) {
                bf16x8 Kf[4], Vf[2][2];
                att_kfrags(buf, sub, Kf, lane); att_vfrags(buf, sub, Vf, lane);
#pragma unroll
                for (int ct = 0; ct < 2; ++ct) {
                    __builtin_amdgcn_sched_barrier(0);
                    const f32x16 S = att_qk_f(Kf, Qf[ct]);
                    const unsigned mbits = (unsigned)(mw[ct] >> (sub * 32 + 4 * h));
                    float p[16];
#pragma unroll
                    for (int i = 0; i < 16; ++i) {
                        const float e = __builtin_amdgcn_exp2f(S[i] * c1 - c2);
                        const int bitpos = (i & 3) + 8 * (i >> 2);
                        p[i] = __builtin_bit_cast(float, __builtin_bit_cast(int, e) & __builtin_amdgcn_sbfe((int)mbits, bitpos, 1));
                        l[ct] += p[i];
                    }
                    att_pv_f(Vf, pack8(p[0], p[1], p[2], p[3], p[4], p[5], p[6], p[7]), pack8(p[8], p[9], p[10], p[11], p[12], p[13], p[14], p[15]), O[ct]);
                }
            }
            if (kt + 1 < nkt) att_store(st, F.lds + ((kt + 1) & 1) * AT_BUF, tid);
            __syncthreads();
        }
#pragma unroll
        for (int ct = 0; ct < 2; ++ct) {
            const float lt = l[ct] + __shfl_xor(l[ct], 32);
            const float inv = 1.0f / fmaxf(lt, 1e-30f);
            bf16_t* orow = CAT + (mb + qidx[ct]) * 1024 + (g * 4 + (c & 3)) * 64;
#pragma unroll
            for (int dt = 0; dt < 2; ++dt)
#pragma unroll
                for (int i4 = 0; i4 < 4; ++i4) {
                    const int d = dt * 32 + 8 * i4 + 4 * h;
                    u32x2 w; w.x = pk2(O[ct][dt][4 * i4] * inv, O[ct][dt][4 * i4 + 1] * inv); w.y = pk2(O[ct][dt][4 * i4 + 2] * inv, O[ct][dt][4 * i4 + 3] * inv);
                    *(u32x2*)(orow + d) = w;
                }
        }
    }
}

__device__ __forceinline__ void p_s5_scan(const Frame& F, const Args& a, unsigned char* ws) {
    const float* SLOC = (const float*)(ws + L0_SLOC); bf16_t* UA = (bf16_t*)(ws + L0_UA);
    const int gw = F.bid * NWAVES + F.wave, NGW = F.G * NWAVES, p = F.lane;
    for (int it = gw; it < 32 * NB; it += NGW) {
        const int g = it >> 3, b = it & 7;
        const float dt = expf(a.in[I_L0_LOGDT][g]);
        const float lr = a.in[I_L0_ARE][g * 64 + p], li = a.in[I_L0_AIM][g * 64 + p];
        const float mag = expf(16.0f * dt * lr); float s, c; sincosf(16.0f * dt * li, &s, &c);
        const float ar = mag * c, ai = mag * s;
        float hr = 0.f, hi = 0.f;
        const float* sl = SLOC + ((size_t)g * 2048 + b * 256) * 128;
        bf16_t* ua = UA + ((size_t)g * 2048 + b * 256) * 384 + 256;
        for (int ch = 0; ch < 256; ++ch) {
            ua[(size_t)ch * 384 + p] = (bf16_t)f2bf(hr); ua[(size_t)ch * 384 + 64 + p] = (bf16_t)f2bf(hi);
            const float xr = sl[(size_t)ch * 128 + p], xi = sl[(size_t)ch * 128 + 64 + p];
            const float nr = ar * hr - ai * hi + xr, ni = ar * hi + ai * hr + xi;
            hr = nr; hi = ni;
        }
    }
}
namespace pg8 {
struct EpiS5State {
    static constexpr bool PERM = false;
    float* C;
    __device__ __forceinline__ void operator()(const f32x4 (&acc)[2][2][4][2], const Unit& u, int wr, int wc, int fr, int fq) const {
        const int row0 = u.pm * BM + wr * 64 + fr, col0 = wc * 32 + 4 * fq;
#pragma unroll
        for (int ai = 0; ai < 2; ++ai)
#pragma unroll
            for (int m = 0; m < 4; ++m)
#pragma unroll
                for (int n = 0; n < 2; ++n) *(f32x4*)(C + (size_t)(row0 + ai * HALF + m * 16) * 128 + col0 + n * 16) = acc[ai][0][m][n];
    }
};
struct EpiS5Out {
    static constexpr bool PERM = false;
    bf16_t* YB;
    __device__ __forceinline__ void operator()(const f32x4 (&acc)[2][2][4][2], const Unit& u, int wr, int wc, int fr, int fq) const {
        const int g = u.pn;
        const int row0 = u.pm * BM + wr * 64 + fr - g * 2048;
        const int col0 = wc * 32 + 4 * fq;
#pragma unroll
        for (int ai = 0; ai < 2; ++ai)
#pragma unroll
            for (int m = 0; m < 4; ++m) { const int chunk = row0 + ai * HALF + m * 16;
#pragma unroll
                for (int bj = 0; bj < 2; ++bj)
#pragma unroll
                    for (int n = 0; n < 2; ++n) { const int col = col0 + bj * HALF + n * 16, i = col >> 4, co = col & 15;
                        const f32x4 v = acc[ai][bj][m][n];
                        u32x2 w; w.x = pk2(gelu_tanh(v[0]), gelu_tanh(v[1])); w.y = pk2(gelu_tanh(v[2]), gelu_tanh(v[3]));
                        *(u32x2*)(YB + ((size_t)chunk * 16 + i) * 512 + g * 16 + co) = w; }
                asm volatile("" ::: "memory"); __builtin_amdgcn_sched_barrier(0); }
    }
};
struct EpiGlu {
    static constexpr bool PERM = true;
    const bf16_t* YB; const float* bias; bf16_t* CAT;
    __device__ __forceinline__ void operator()(const f32x4 (&acc)[2][2][4][2], const Unit& u, int wr, int wc, int fr, int fq) const {
        const int row0 = u.pm * BM + wr * 64 + fr, col0 = u.pn * BM + wc * 32 + 8 * fq;
#pragma unroll
        for (int ai = 0; ai < 2; ++ai)
#pragma unroll
            for (int m = 0; m < 4; ++m) { const size_t row = row0 + ai * HALF + m * 16;
#pragma unroll
                for (int bj = 0; bj < 2; ++bj) { const int col = col0 + bj * HALF;
                    const u32x4 yv = *(const u32x4*)(YB + row * 512 + col);
                    const f32x4 b0 = *(const f32x4*)(bias + col), b1 = *(const f32x4*)(bias + col + 4);
                    const f32x4 z0 = acc[ai][bj][m][0] + b0, z1 = acc[ai][bj][m][1] + b1;
                    u32x4 w;
                    w.x = pk2(bf_lo(yv.x) * sigmoidf_(z0[0]), bf_hi(yv.x) * sigmoidf_(z0[1])); w.y = pk2(bf_lo(yv.y) * sigmoidf_(z0[2]), bf_hi(yv.y) * sigmoidf_(z0[3]));
                    w.z = pk2(bf_lo(yv.z) * sigmoidf_(z1[0]), bf_hi(yv.z) * sigmoidf_(z1[1])); w.w = pk2(bf_lo(yv.w) * sigmoidf_(z1[2]), bf_hi(yv.w) * sigmoidf_(z1[3]));
                    *(u32x4*)(CAT + row * 1024 + 512 + col) = w; }
                asm volatile("" ::: "memory"); __builtin_amdgcn_sched_barrier(0); }
    }
};
}
__device__ __forceinline__ unsigned mono_u32(float f) { const unsigned u = __builtin_bit_cast(unsigned, f); return u ^ ((u >> 31) ? 0xFFFFFFFFu : 0x80000000u); }
#define CE_DESC(x, y) do { const unsigned _hi = (x) > (y) ? (x) : (y), _lo = (x) > (y) ? (y) : (x); (x) = _hi; (y) = _lo; } while (0)
__device__ __forceinline__ void sort16_desc(unsigned (&a)[16]) {
#pragma unroll
    for (int k = 2; k <= 16; k <<= 1)
#pragma unroll
        for (int j = k >> 1; j > 0; j >>= 1)
#pragma unroll
            for (int i = 0; i < 16; ++i) { const int l = i ^ j; if (l > i) { if ((i & k) == 0) CE_DESC(a[i], a[l]); else CE_DESC(a[l], a[i]); } }
}
__device__ __forceinline__ void merge16_desc(unsigned (&a)[16], const unsigned (&b)[16]) {
#pragma unroll
    for (int i = 0; i < 16; ++i) a[i] = a[i] > b[15 - i] ? a[i] : b[15 - i];
#pragma unroll
    for (int j = 8; j > 0; j >>= 1)
#pragma unroll
        for (int i = 0; i < 16; ++i) { const int l = i ^ j; if (l > i) CE_DESC(a[i], a[l]); }
}
__device__ __forceinline__ void merge16_xlane(unsigned (&a)[16]) {
    unsigned b[16];
#pragma unroll
    for (int i = 0; i < 16; ++i) b[i] = (unsigned)__shfl_xor((int)a[i], 32);
    merge16_desc(a, b);
}
struct PeerCand { int a[50], b[50]; };
__host__ __device__ constexpr PeerCand peer_cands() { PeerCand c{}; int n = 0; for (int a = 0; a < 16; ++a) for (int b = 0; b < 16; ++b) if ((a + 1) * (b + 1) <= 16) { c.a[n] = a; c.b[n] = b; ++n; } return c; }
__device__ __forceinline__ void p_peer_route(const Frame& F, unsigned char* ws, const bf16_t* SK) {
    const bf16_t* Q2 = (const bf16_t*)(ws + PE_Q2); unsigned short* EID = (unsigned short*)(ws + PE_EID); float* GATE = (float*)(ws + PE_GATE);
    LAS float* sc0 = (LAS float*)F.lds;
    const int lane = F.lane, wave = F.wave, h5 = lane >> 5, r = lane & 31, tid = F.tid;
    constexpr PeerCand PC = peer_cands();
    for (int u = F.bid; u < 2048; u += F.G) {
        const int hd = u & 7, mt = u >> 3; const size_t m0 = (size_t)mt * 128;
        {
            const int p = wave >> 2, rt = wave & 3;
            bf16x8 Af[8];
#pragma unroll
            for (int ks = 0; ks < 8; ++ks) Af[ks] = *(const bf16x8*)(Q2 + (m0 + rt * 32 + r) * 2048 + (hd * 2 + p) * 128 + ks * 16 + 8 * h5);
            LAS float* scp = sc0 + p * 128 * 129;
#pragma unroll 1
            for (int ct = 0; ct < 4; ++ct) {
                f32x16 acc = {0.f, 0.f, 0.f, 0.f, 0.f, 0.f, 0.f, 0.f, 0.f, 0.f, 0.f, 0.f, 0.f, 0.f, 0.f, 0.f};
#pragma unroll
                for (int ks = 0; ks < 8; ++ks) { const bf16x8 Bf = *(const bf16x8*)(SK + ((size_t)(hd * 2 + p) * 128 + ct * 32 + r) * 128 + ks * 16 + 8 * h5);
                    acc = __builtin_amdgcn_mfma_f32_32x32x16_bf16(Af[ks], Bf, acc, 0, 0, 0); }
#pragma unroll
                for (int i = 0; i < 16; ++i) scp[(rt * 32 + (i & 3) + 8 * (i >> 2) + 4 * h5) * 129 + ct * 32 + r] = acc[i];
            }
        }
        __syncthreads();
        {
            const int pp = wave >> 2, row = (wave & 3) * 32 + r, half = h5; LAS float* rowp = sc0 + pp * 128 * 129 + row * 129;
            unsigned top[16];
#pragma unroll
            for (int blk = 0; blk < 4; ++blk) {
                unsigned k16[16];
#pragma unroll
                for (int i = 0; i < 16; ++i) { const int j = half * 64 + blk * 16 + i; k16[i] = (mono_u32(rowp[j]) & ~0x7Fu) | (unsigned)(127 - j); }
                sort16_desc(k16);
                if (blk == 0) {
#pragma unroll
                    for (int i = 0; i < 16; ++i) top[i] = k16[i];
                } else merge16_desc(top, k16);
            }
            merge16_xlane(top);
            float vals[16]; int ids[16];
#pragma unroll
            for (int k = 0; k < 16; ++k) { ids[k] = 127 - (int)(top[k] & 127u); vals[k] = rowp[ids[k]]; }
            if (half == 0) {
#pragma unroll
                for (int k = 0; k < 16; ++k) { rowp[k] = vals[k]; rowp[16 + k] = __int_as_float(ids[k]); }
            }
        }
        __syncthreads();
        if (tid < 256) {
            const int row = (wave & 3) * 32 + r, half = h5; const LAS float* s1 = sc0 + row * 129; const LAS float* s2 = sc0 + 128 * 129 + row * 129;
            float v1[16], v2[16];
#pragma unroll
            for (int k = 0; k < 16; ++k) { v1[k] = s1[k]; v2[k] = s2[k]; }
            unsigned top[16], k16[16];
#pragma unroll
            for (int i = 0; i < 16; ++i) { const int c0 = 2 * i, c1 = 2 * i + 1;
                const unsigned ka = (mono_u32(v1[PC.a[c0]] + v2[PC.b[c0]]) & ~0xFFu) | (unsigned)(255 - (PC.a[c0] * 16 + PC.b[c0]));
                const unsigned kb = (mono_u32(v1[PC.a[c1]] + v2[PC.b[c1]]) & ~0xFFu) | (unsigned)(255 - (PC.a[c1] * 16 + PC.b[c1]));
                top[i] = half ? kb : ka; }
#pragma unroll
            for (int i = 0; i < 16; ++i) { if (i < 9) { const int c0 = 32 + 2 * i, c1 = 32 + 2 * i + 1;
                    const unsigned ka = (mono_u32(v1[PC.a[c0]] + v2[PC.b[c0]]) & ~0xFFu) | (unsigned)(255 - (PC.a[c0] * 16 + PC.b[c0]));
                    const unsigned kb = (mono_u32(v1[PC.a[c1]] + v2[PC.b[c1]]) & ~0xFFu) | (unsigned)(255 - (PC.a[c1] * 16 + PC.b[c1]));
                    k16[i] = half ? kb : ka; } else k16[i] = 0u; }
            sort16_desc(top); sort16_desc(k16); merge16_desc(top, k16);
            merge16_xlane(top);
            if (half == 0) {
                float mx = -3.0e38f; float sv[16]; int eid[16];
#pragma unroll
                for (int k = 0; k < 16; ++k) { const int fl = 255 - (int)(top[k] & 255u), a = fl >> 4, b = fl & 15;
                    sv[k] = s1[a] + s2[b]; eid[k] = __float_as_int(s1[16 + a]) * 128 + __float_as_int(s2[16 + b]); mx = fmaxf(mx, sv[k]); }
                float den = 0.f;
#pragma unroll
                for (int k = 0; k < 16; ++k) { sv[k] = __expf(sv[k] - mx); den += sv[k]; }
                const float inv = 1.0f / den;
                unsigned short* ep = EID + (m0 + row) * 128 + hd * 16; float* gp = GATE + (m0 + row) * 128 + hd * 16;
#pragma unroll
                for (int k = 0; k < 16; ++k) { ep[k] = (unsigned short)eid[k]; gp[k] = sv[k] * inv; }
            }
        }
        __syncthreads();
    }
}

__device__ __forceinline__ float rdlane_f(float v, int l) { return __builtin_bit_cast(float, __builtin_amdgcn_readlane(__builtin_bit_cast(int, v), l)); }
__device__ __forceinline__ void p_peer_expert(const Frame& F, unsigned char* ws, float* xres) {
    const bf16_t* XN = (const bf16_t*)(ws + WS_XN); const bf16_t* TU = (const bf16_t*)(ws + WS_TABU); const bf16_t* TV = (const bf16_t*)(ws + WS_TABV);
    const unsigned short* EID = (const unsigned short*)(ws + PE_EID); const float* GATE = (const float*)(ws + PE_GATE);
    const int gw = F.bid * NWAVES + F.wave, NGW = F.G * NWAVES, lane = F.lane;
    for (int m = gw; m < T; m += NGW) {
        float xf[16];
        { const u32x4 xa = *(const u32x4*)(XN + (size_t)m * 1024 + lane * 8), xb = *(const u32x4*)(XN + (size_t)m * 1024 + 512 + lane * 8);
          xf[0] = bf_lo(xa.x); xf[1] = bf_hi(xa.x); xf[2] = bf_lo(xa.y); xf[3] = bf_hi(xa.y); xf[4] = bf_lo(xa.z); xf[5] = bf_hi(xa.z); xf[6] = bf_lo(xa.w); xf[7] = bf_hi(xa.w);
          xf[8] = bf_lo(xb.x); xf[9] = bf_hi(xb.x); xf[10] = bf_lo(xb.y); xf[11] = bf_hi(xb.y); xf[12] = bf_lo(xb.z); xf[13] = bf_hi(xb.z); xf[14] = bf_lo(xb.w); xf[15] = bf_hi(xb.w); }
        const int id0 = EID[(size_t)m * 128 + lane], id1 = EID[(size_t)m * 128 + 64 + lane];
        const float g0 = GATE[(size_t)m * 128 + lane], g1 = GATE[(size_t)m * 128 + 64 + lane];
        float outv[16];
#pragma unroll
        for (int i = 0; i < 16; ++i) outv[i] = 0.f;
#pragma unroll 1
        for (int k = 0; k < 16; ++k) {
            const int idreg = (k < 8) ? id0 : id1; const float greg = (k < 8) ? g0 : g1; const int lbase = (k & 7) * 8;
            int e[8];
#pragma unroll
            for (int i = 0; i < 8; ++i) e[i] = __builtin_amdgcn_readlane(idreg, lbase + i);
            float pr[8];
            {
                u32x4 ua[8], ub[8];
#pragma unroll
                for (int i = 0; i < 8; ++i) { ua[i] = *(const u32x4*)(TU + (size_t)e[i] * 1024 + lane * 8); ub[i] = *(const u32x4*)(TU + (size_t)e[i] * 1024 + 512 + lane * 8); }
#pragma unroll
                for (int i = 0; i < 8; ++i) {
                    float s = xf[0] * bf_lo(ua[i].x); s += xf[1] * bf_hi(ua[i].x); s += xf[2] * bf_lo(ua[i].y); s += xf[3] * bf_hi(ua[i].y);
                    s += xf[4] * bf_lo(ua[i].z); s += xf[5] * bf_hi(ua[i].z); s += xf[6] * bf_lo(ua[i].w); s += xf[7] * bf_hi(ua[i].w);
                    s += xf[8] * bf_lo(ub[i].x); s += xf[9] * bf_hi(ub[i].x); s += xf[10] * bf_lo(ub[i].y); s += xf[11] * bf_hi(ub[i].y);
                    s += xf[12] * bf_lo(ub[i].z); s += xf[13] * bf_hi(ub[i].z); s += xf[14] * bf_lo(ub[i].w); s += xf[15] * bf_hi(ub[i].w);
                    pr[i] = s;
                }
            }
            float r4[4], r2[2], r1;
            { const bool up = (lane & 32) != 0;
#pragma unroll
              for (int i = 0; i < 4; ++i) { const float keep = up ? pr[i + 4] : pr[i], send = up ? pr[i] : pr[i + 4]; r4[i] = keep + __shfl_xor(send, 32); } }
            { const bool up = (lane & 16) != 0;
#pragma unroll
              for (int i = 0; i < 2; ++i) { const float keep = up ? r4[i + 2] : r4[i], send = up ? r4[i] : r4[i + 2]; r2[i] = keep + __shfl_xor(send, 16); } }
            { const bool up = (lane & 8) != 0; const float keep = up ? r2[1] : r2[0], send = up ? r2[0] : r2[1]; r1 = keep + __shfl_xor(send, 8); }
            r1 += __shfl_xor(r1, 4); r1 += __shfl_xor(r1, 2); r1 += __shfl_xor(r1, 1);
            const float gv = __shfl(greg, lbase + (lane >> 3));
            const float coef = gv * gelu_tanh(r1);
            {
                u32x4 va[8], vb[8];
#pragma unroll
                for (int i = 0; i < 8; ++i) { va[i] = *(const u32x4*)(TV + (size_t)e[i] * 1024 + lane * 8); vb[i] = *(const u32x4*)(TV + (size_t)e[i] * 1024 + 512 + lane * 8); }
#pragma unroll
                for (int i = 0; i < 8; ++i) {
                    const float ci = rdlane_f(coef, i * 8);
                    outv[0] += ci * bf_lo(va[i].x); outv[1] += ci * bf_hi(va[i].x); outv[2] += ci * bf_lo(va[i].y); outv[3] += ci * bf_hi(va[i].y);
                    outv[4] += ci * bf_lo(va[i].z); outv[5] += ci * bf_hi(va[i].z); outv[6] += ci * bf_lo(va[i].w); outv[7] += ci * bf_hi(va[i].w);
                    outv[8] += ci * bf_lo(vb[i].x); outv[9] += ci * bf_hi(vb[i].x); outv[10] += ci * bf_lo(vb[i].y); outv[11] += ci * bf_hi(vb[i].y);
                    outv[12] += ci * bf_lo(vb[i].z); outv[13] += ci * bf_hi(vb[i].z); outv[14] += ci * bf_lo(vb[i].w); outv[15] += ci * bf_hi(vb[i].w);
                }
            }
        }
        f32x4* o = (f32x4*)(xres + (size_t)m * 1024 + lane * 8);
        f32x4 a0 = o[0], a1 = o[1], b0 = o[128], b1 = o[129];
        a0 += (f32x4){outv[0], outv[1], outv[2], outv[3]}; a1 += (f32x4){outv[4], outv[5], outv[6], outv[7]};
        b0 += (f32x4){outv[8], outv[9], outv[10], outv[11]}; b1 += (f32x4){outv[12], outv[13], outv[14], outv[15]};
        o[0] = a0; o[1] = a1; o[128] = b0; o[129] = b1;
    }
}

typedef __bf16 bf16x2_t __attribute__((ext_vector_type(2)));
__device__ __forceinline__ float dot2bf(unsigned a, unsigned b, float c) { return __builtin_amdgcn_fdot2_f32_bf16(__builtin_bit_cast(bf16x2_t, a), __builtin_bit_cast(bf16x2_t, b), c, false); }
__device__ __forceinline__ void peer_slot_range(const unsigned (&xp)[8], float (&outv)[16], int id0, int id1, float g0, float g1, int r,
                                                const bf16_t* TU, const bf16_t* TV, int lane) {
    u64 m0 = __ballot((id0 >> 9) == r), m1 = __ballot((id1 >> 9) == r);
    while (m0 | m1) {
        int e[8]; float gt[8];
#pragma unroll
        for (int i = 0; i < 8; ++i) {
            if (m0) { const int l = __builtin_ctzll(m0); m0 &= m0 - 1ull; e[i] = __builtin_amdgcn_readlane(id0, l); gt[i] = rdlane_f(g0, l); }
            else if (m1) { const int l = __builtin_ctzll(m1); m1 &= m1 - 1ull; e[i] = __builtin_amdgcn_readlane(id1, l); gt[i] = rdlane_f(g1, l); }
            else { e[i] = -1; gt[i] = 0.f; }
        }
        float pr[8];
        {
            u32x4 ua[8], ub[8];
#pragma unroll
            for (int i = 0; i < 8; ++i) {
                if (e[i] >= 0) { ua[i] = *(const u32x4*)(TU + (size_t)e[i] * 1024 + lane * 8); ub[i] = *(const u32x4*)(TU + (size_t)e[i] * 1024 + 512 + lane * 8); }
                else { ua[i] = (u32x4){0u, 0u, 0u, 0u}; ub[i] = (u32x4){0u, 0u, 0u, 0u}; }
            }
#pragma unroll
            for (int i = 0; i < 8; ++i) {
                float s = dot2bf(xp[0], ua[i].x, 0.f); s = dot2bf(xp[1], ua[i].y, s); s = dot2bf(xp[2], ua[i].z, s); s = dot2bf(xp[3], ua[i].w, s);
                s = dot2bf(xp[4], ub[i].x, s); s = dot2bf(xp[5], ub[i].y, s); s = dot2bf(xp[6], ub[i].z, s); s = dot2bf(xp[7], ub[i].w, s);
                pr[i] = s;
            }
        }
        float r4[4], r2[2], r1;
        { const bool up = (lane & 32) != 0;
#pragma unroll
          for (int i = 0; i < 4; ++i) { const float keep = up ? pr[i + 4] : pr[i], send = up ? pr[i] : pr[i + 4]; r4[i] = keep + __shfl_xor(send, 32); } }
        { const bool up = (lane & 16) != 0;
#pragma unroll
          for (int i = 0; i < 2; ++i) { const float keep = up ? r4[i + 2] : r4[i], send = up ? r4[i] : r4[i + 2]; r2[i] = keep + __shfl_xor(send, 16); } }
        { const bool up = (lane & 8) != 0; const float keep = up ? r2[1] : r2[0], send = up ? r2[0] : r2[1]; r1 = keep + __shfl_xor(send, 8); }
        r1 += __shfl_xor(r1, 4); r1 += __shfl_xor(r1, 2); r1 += __shfl_xor(r1, 1);
        const int grp = lane >> 3;
        float gsel = gt[0];
#pragma unroll
        for (int i = 1; i < 8; ++i) gsel = (grp == i) ? gt[i] : gsel;
        const float coef = gsel * gelu_tanh(r1);
        {
            u32x4 va[8], vb[8];
#pragma unroll
            for (int i = 0; i < 8; ++i) {
                if (e[i] >= 0) { va[i] = *(const u32x4*)(TV + (size_t)e[i] * 1024 + lane * 8); vb[i] = *(const u32x4*)(TV + (size_t)e[i] * 1024 + 512 + lane * 8); }
                else { va[i] = (u32x4){0u, 0u, 0u, 0u}; vb[i] = (u32x4){0u, 0u, 0u, 0u}; }
            }
#pragma unroll
            for (int i = 0; i < 8; ++i) {
                if (e[i] >= 0) {
                    const float ci = rdlane_f(coef, i * 8);
                    outv[0] += ci * bf_lo(va[i].x); outv[1] += ci * bf_hi(va[i].x); outv[2] += ci * bf_lo(va[i].y); outv[3] += ci * bf_hi(va[i].y);
                    outv[4] += ci * bf_lo(va[i].z); outv[5] += ci * bf_hi(va[i].z); outv[6] += ci * bf_lo(va[i].w); outv[7] += ci * bf_hi(va[i].w);
                    outv[8] += ci * bf_lo(vb[i].x); outv[9] += ci * bf_hi(vb[i].x); outv[10] += ci * bf_lo(vb[i].y); outv[11] += ci * bf_hi(vb[i].y);
                    outv[12] += ci * bf_lo(vb[i].z); outv[13] += ci * bf_hi(vb[i].z); outv[14] += ci * bf_lo(vb[i].w); outv[15] += ci * bf_hi(vb[i].w);
                }
            }
        }
    }
}
__device__ __forceinline__ void p_peer_expert2(const Frame& F, unsigned char* ws, float* xres, const float oscale) {
    const bf16_t* XN = (const bf16_t*)(ws + WS_XN); const bf16_t* TU = (const bf16_t*)(ws + WS_TABU); const bf16_t* TV = (const bf16_t*)(ws + WS_TABV);
    const unsigned short* EID = (const unsigned short*)(ws + PE_EID); const float* GATE = (const float*)(ws + PE_GATE);
    const int gw = F.bid * NWAVES + F.wave, NGW = F.G * NWAVES, lane = F.lane;
    int rnd = 0;
    for (int m4 = gw * 4; m4 < T; m4 += NGW * 4, ++rnd) {
        unsigned xp[4][8]; float outv[4][16]; int id[4][2]; float gg[4][2];
#pragma unroll
        for (int s = 0; s < 4; ++s) {
            const size_t m = (size_t)(m4 + s);
            const u32x4 xa = *(const u32x4*)(XN + m * 1024 + lane * 8), xb = *(const u32x4*)(XN + m * 1024 + 512 + lane * 8);
            xp[s][0] = xa.x; xp[s][1] = xa.y; xp[s][2] = xa.z; xp[s][3] = xa.w; xp[s][4] = xb.x; xp[s][5] = xb.y; xp[s][6] = xb.z; xp[s][7] = xb.w;
            id[s][0] = EID[m * 128 + lane]; id[s][1] = EID[m * 128 + 64 + lane]; gg[s][0] = GATE[m * 128 + lane]; gg[s][1] = GATE[m * 128 + 64 + lane];
#pragma unroll
            for (int i = 0; i < 16; ++i) outv[s][i] = 0.f;
        }
#pragma unroll 1
        for (int k = 0; k < 32; ++k) {
            const int r = (rnd & 1) ? 31 - k : k;
#pragma unroll
            for (int s = 0; s < 4; ++s) peer_slot_range(xp[s], outv[s], id[s][0], id[s][1], gg[s][0], gg[s][1], r, TU, TV, lane);
        }
#pragma unroll
        for (int s = 0; s < 4; ++s) {
            f32x4* o = (f32x4*)(xres + (size_t)(m4 + s) * 1024 + lane * 8);
            f32x4 a0 = o[0], a1 = o[1], b0 = o[128], b1 = o[129];
            a0 += (f32x4){outv[s][0], outv[s][1], outv[s][2], outv[s][3]} * oscale; a1 += (f32x4){outv[s][4], outv[s][5], outv[s][6], outv[s][7]} * oscale;
            b0 += (f32x4){outv[s][8], outv[s][9], outv[s][10], outv[s][11]} * oscale; b1 += (f32x4){outv[s][12], outv[s][13], outv[s][14], outv[s][15]} * oscale;
            o[0] = a0; o[1] = a1; o[128] = b0; o[129] = b1;
        }
    }
}

struct RowBuf { u32x4 a[8], b[8]; };
__device__ __forceinline__ void peer_load8(RowBuf& rb, const bf16_t* TAB, const LAS unsigned* ent, int b, int lane) {
#pragma unroll
    for (int i = 0; i < 8; ++i) {
        const unsigned e = (unsigned)__builtin_amdgcn_readfirstlane((int)ent[b * 8 + i]) & 0x3FFFu;
        const bf16_t* rp = TAB + (size_t)e * 1024 + lane * 8;
        rb.a[i] = *(const u32x4*)rp; rb.b[i] = *(const u32x4*)(rp + 512);
    }
}
__device__ __forceinline__ float peer_dot(const unsigned (&xp)[8], const u32x4 a, const u32x4 b) {
    float s = dot2bf(xp[0], a.x, 0.f); s = dot2bf(xp[1], a.y, s); s = dot2bf(xp[2], a.z, s); s = dot2bf(xp[3], a.w, s);
    s = dot2bf(xp[4], b.x, s); s = dot2bf(xp[5], b.y, s); s = dot2bf(xp[6], b.z, s); s = dot2bf(xp[7], b.w, s);
    return s;
}
__device__ __forceinline__ void peer_u8(const RowBuf& rb, const unsigned (&xp)[4][8], const LAS unsigned* ent, LAS float* cf, int b, int lane) {
    float pr[8];
#pragma unroll
    for (int i = 0; i < 8; ++i) {
        const int slot = (__builtin_amdgcn_readfirstlane((int)ent[b * 8 + i]) >> 21) & 3;
        if (slot == 0) pr[i] = peer_dot(xp[0], rb.a[i], rb.b[i]);
        else if (slot == 1) pr[i] = peer_dot(xp[1], rb.a[i], rb.b[i]);
        else if (slot == 2) pr[i] = peer_dot(xp[2], rb.a[i], rb.b[i]);
        else pr[i] = peer_dot(xp[3], rb.a[i], rb.b[i]);
    }
    float r4[4], r2[2], r1;
    { const bool up = (lane & 32) != 0;
#pragma unroll
      for (int i = 0; i < 4; ++i) { const float keep = up ? pr[i + 4] : pr[i], send = up ? pr[i] : pr[i + 4]; r4[i] = keep + __shfl_xor(send, 32); } }
    { const bool up = (lane & 16) != 0;
#pragma unroll
      for (int i = 0; i < 2; ++i) { const float keep = up ? r4[i + 2] : r4[i], send = up ? r4[i] : r4[i + 2]; r2[i] = keep + __shfl_xor(send, 16); } }
    { const bool up = (lane & 8) != 0; const float keep = up ? r2[1] : r2[0], send = up ? r2[0] : r2[1]; r1 = keep + __shfl_xor(send, 8); }
    r1 += __shfl_xor(r1, 4); r1 += __shfl_xor(r1, 2); r1 += __shfl_xor(r1, 1);
    const float gate = cf[b * 8 + (lane >> 3)];
    const float coef = gate * gelu_tanh(r1);
    if ((lane & 7) == 0) cf[b * 8 + (lane >> 3)] = coef;
}
__device__ __forceinline__ void peer_acc(float (&o)[16], const float c, const u32x4 a, const u32x4 b) {
    o[0] += c * bf_lo(a.x); o[1] += c * bf_hi(a.x); o[2] += c * bf_lo(a.y); o[3] += c * bf_hi(a.y);
    o[4] += c * bf_lo(a.z); o[5] += c * bf_hi(a.z); o[6] += c * bf_lo(a.w); o[7] += c * bf_hi(a.w);
    o[8] += c * bf_lo(b.x); o[9] += c * bf_hi(b.x); o[10] += c * bf_lo(b.y); o[11] += c * bf_hi(b.y);
    o[12] += c * bf_lo(b.z); o[13] += c * bf_hi(b.z); o[14] += c * bf_lo(b.w); o[15] += c * bf_hi(b.w);
}
__device__ __forceinline__ void peer_v8(const RowBuf& rb, float (&outv)[4][16], const LAS unsigned* ent, const LAS float* cf, int b) {
#pragma unroll
    for (int i = 0; i < 8; ++i) {
        const int slot = (__builtin_amdgcn_readfirstlane((int)ent[b * 8 + i]) >> 21) & 3;
        const float c = cf[b * 8 + i];
        if (slot == 0) peer_acc(outv[0], c, rb.a[i], rb.b[i]);
        else if (slot == 1) peer_acc(outv[1], c, rb.a[i], rb.b[i]);
        else if (slot == 2) peer_acc(outv[2], c, rb.a[i], rb.b[i]);
        else peer_acc(outv[3], c, rb.a[i], rb.b[i]);
    }
}
__device__ __forceinline__ void p_peer_expert3(const Frame& F, unsigned char* ws, float* xres, const float oscale, const XcdBarrier& xbar) {
    const bf16_t* XN = (const bf16_t*)(ws + WS_XN); const bf16_t* TU = (const bf16_t*)(ws + WS_TABU); const bf16_t* TV = (const bf16_t*)(ws + WS_TABV);
    const unsigned short* EID = (const unsigned short*)(ws + PE_EID); const float* GATE = (const float*)(ws + PE_GATE);
    const int gw = F.bid * NWAVES + F.wave, NGW = F.G * NWAVES, lane = F.lane;
    LAS unsigned* ent = (LAS unsigned*)(F.lds + F.wave * 4096);
    LAS float* cf = (LAS float*)(F.lds + F.wave * 4096 + 2048);
    const int nrounds = (T + NGW * 4 - 1) / (NGW * 4);
    for (int rnd = 0; rnd < nrounds; ++rnd) {
        const int m4 = (rnd * NGW + gw) * 4;
        if (m4 < T) {
            unsigned xp[4][8];
            {
                int id[4][2]; float gg[4][2];
#pragma unroll
                for (int s = 0; s < 4; ++s) {
                    const size_t m = (size_t)(m4 + s);
                    const u32x4 xa = *(const u32x4*)(XN + m * 1024 + lane * 8), xb = *(const u32x4*)(XN + m * 1024 + 512 + lane * 8);
                    xp[s][0] = xa.x; xp[s][1] = xa.y; xp[s][2] = xa.z; xp[s][3] = xa.w; xp[s][4] = xb.x; xp[s][5] = xb.y; xp[s][6] = xb.z; xp[s][7] = xb.w;
                    id[s][0] = EID[m * 128 + lane]; id[s][1] = EID[m * 128 + 64 + lane]; gg[s][0] = GATE[m * 128 + lane]; gg[s][1] = GATE[m * 128 + 64 + lane];
                }
                int base = 0;
#pragma unroll 1
                for (int k = 0; k < 32; ++k) {
                    const int r = (rnd & 1) ? 31 - k : k;
#pragma unroll
                    for (int s = 0; s < 4; ++s)
#pragma unroll
                        for (int w = 0; w < 2; ++w) {
                            const bool hit = (id[s][w] >> 9) == r;
                            const u64 m = __ballot(hit);
                            if (hit) { const int pos = base + (int)__builtin_amdgcn_mbcnt_hi((unsigned)(m >> 32), __builtin_amdgcn_mbcnt_lo((unsigned)m, 0u));
                                ent[pos] = ((unsigned)s << 21) | ((unsigned)(w * 64 + lane) << 14) | (unsigned)id[s][w]; cf[pos] = gg[s][w]; }
                            base += __builtin_popcountll(m);
                        }
                }
            }
            LDS_WAIT();
            {
                RowBuf A, B;
                peer_load8(A, TU, ent, 0, lane);
#pragma unroll 1
                for (int b = 0; b < 64; b += 2) {
                    peer_load8(B, TU, ent, b + 1, lane);
                    peer_u8(A, xp, ent, cf, b, lane);
                    if (b + 2 < 64) peer_load8(A, TU, ent, b + 2, lane);
                    peer_u8(B, xp, ent, cf, b + 1, lane);
                }
            }
            LDS_WAIT();
            float outv[4][16];
#pragma unroll
            for (int s = 0; s < 4; ++s)
#pragma unroll
                for (int i = 0; i < 16; ++i) outv[s][i] = 0.f;
            {
                RowBuf A, B;
                peer_load8(A, TV, ent, 0, lane);
#pragma unroll 1
                for (int b = 0; b < 64; b += 2) {
                    peer_load8(B, TV, ent, b + 1, lane);
                    peer_v8(A, outv, ent, cf, b);
                    if (b + 2 < 64) peer_load8(A, TV, ent, b + 2, lane);
                    peer_v8(B, outv, ent, cf, b + 1);
                }
            }
#pragma unroll
            for (int s = 0; s < 4; ++s) {
                f32x4* o = (f32x4*)(xres + (size_t)(m4 + s) * 1024 + lane * 8);
                f32x4 a0 = o[0], a1 = o[1], b0 = o[128], b1 = o[129];
                a0 += (f32x4){outv[s][0], outv[s][1], outv[s][2], outv[s][3]} * oscale; a1 += (f32x4){outv[s][4], outv[s][5], outv[s][6], outv[s][7]} * oscale;
                b0 += (f32x4){outv[s][8], outv[s][9], outv[s][10], outv[s][11]} * oscale; b1 += (f32x4){outv[s][12], outv[s][13], outv[s][14], outv[s][15]} * oscale;
                o[0] = a0; o[1] = a1; o[128] = b0; o[129] = b1;
            }
        }
        if (rnd + 1 < nrounds) xcd_barrier(xbar);
    }
}

constexpr size_t WS_TAB8U = WS_TABU;
constexpr size_t WS_TAB8V = WS_TABU + 16 * MiB;
constexpr size_t WS_TABSU = WS_TABU + 32 * MiB;
constexpr size_t WS_TABSV = WS_TABU + 32 * MiB + 65536;
__device__ __forceinline__ void cvt_table_fp8(const Frame& F, const float* src, unsigned char* dst, float* scales, const int skip) {
    const int nb = F.G > skip ? F.G - skip : F.G, b0 = F.G > skip ? F.bid - skip : F.bid;
    const int gw = b0 * NWAVES + F.wave, NGW = nb * NWAVES, lane = F.lane;
    if (b0 >= 0) for (int r = gw; r < 16384; r += NGW) {
        const f32x4* p = (const f32x4*)(src + (size_t)r * 1024 + lane * 16);
        f32x4 v[4]; float am = 0.f;
#pragma unroll
        for (int j = 0; j < 4; ++j) { v[j] = p[j]; am = fmaxf(am, fmaxf(fmaxf(fabsf(v[j].x), fabsf(v[j].y)), fmaxf(fabsf(v[j].z), fabsf(v[j].w)))); }
#pragma unroll
        for (int o = 1; o < 64; o <<= 1) am = fmaxf(am, __shfl_xor(am, o));
        const float sc = am > 0.f ? am * (1.0f / 448.0f) : 1.0f, inv = 1.0f / sc;
        u32x4 q;
#pragma unroll
        for (int j = 0; j < 4; ++j) { int w = 0; w = __builtin_amdgcn_cvt_pk_fp8_f32(v[j].x * inv, v[j].y * inv, w, false); w = __builtin_amdgcn_cvt_pk_fp8_f32(v[j].z * inv, v[j].w * inv, w, true); q[j] = (unsigned)w; }
        *(u32x4*)(dst + (size_t)r * 1024 + lane * 16) = q;
        if (lane == 0) scales[r] = sc;
    }
}
template <int NR> struct RowBufN { u32x4 a[NR]; };
template <int NR>
__device__ __forceinline__ void peer_loadN(RowBufN<NR>& rb, const unsigned char* TAB, const LAS unsigned* ent, int b, int lane) {
    const int ev = (int)ent[b * NR + (lane & (NR - 1))];
#pragma unroll
    for (int i = 0; i < NR; ++i) {
        const unsigned e = (unsigned)__builtin_amdgcn_readlane(ev, i) & 0x3FFFu;
        rb.a[i] = *(const u32x4*)(TAB + (size_t)e * 1024 + lane * 16);
    }
}
__device__ __forceinline__ float peer_dot8x(const u32x4 xa, const u32x4 xb, const u32x4 q) {
    float s = 0.f;
#pragma unroll
    for (int j = 0; j < 4; ++j) {
        const f32x2 lo = __builtin_amdgcn_cvt_pk_f32_fp8((int)q[j], false), hi = __builtin_amdgcn_cvt_pk_f32_fp8((int)q[j], true);
        const unsigned x0 = (j < 2) ? xa[2 * j] : xb[2 * j - 4], x1 = (j < 2) ? xa[2 * j + 1] : xb[2 * j - 3];
        s += bf_lo(x0) * lo.x; s += bf_hi(x0) * lo.y; s += bf_lo(x1) * hi.x; s += bf_hi(x1) * hi.y;
    }
    return s;
}
template <int NR>
__device__ __forceinline__ void peer_u8x(const RowBufN<NR>& rb, int r0, const LAS unsigned char* xl, const LAS unsigned* ent, LAS float* cf, const LAS float* sul, int e0, int lane) {
    float pr[8];
    const int ev = (int)ent[e0 + (lane & 7)];
#pragma unroll
    for (int i = 0; i < 8; ++i) {
        const int slot = (__builtin_amdgcn_readlane(ev, i) >> 21) & 3;
        const LAS unsigned char* xp = xl + slot * 2048 + lane * 32;
        const u32x4 xa = *(const LAS u32x4*)xp, xb = *(const LAS u32x4*)(xp + 16);
        pr[i] = peer_dot8x(xa, xb, rb.a[r0 + i]);
    }
    float r4[4], r2[2], r1;
    { const bool up = (lane & 32) != 0;
#pragma unroll
      for (int i = 0; i < 4; ++i) { const float keep = up ? pr[i + 4] : pr[i], send = up ? pr[i] : pr[i + 4]; r4[i] = keep + __shfl_xor(send, 32); } }
    { const bool up = (lane & 16) != 0;
#pragma unroll
      for (int i = 0; i < 2; ++i) { const float keep = up ? r4[i + 2] : r4[i], send = up ? r4[i] : r4[i + 2]; r2[i] = keep + __shfl_xor(send, 16); } }
    { const bool up = (lane & 8) != 0; const float keep = up ? r2[1] : r2[0], send = up ? r2[0] : r2[1]; r1 = keep + __shfl_xor(send, 8); }
    r1 += __shfl_xor(r1, 4); r1 += __shfl_xor(r1, 2); r1 += __shfl_xor(r1, 1);
    const float gate = cf[e0 + (lane >> 3)];
    const float coef = gate * gelu_tanh(r1 * sul[e0 + (lane >> 3)]);
    if ((lane & 7) == 0) cf[e0 + (lane >> 3)] = coef;
}
__device__ __forceinline__ void peer_acc8(float (&o)[16], const float c, const u32x4 q) {
#pragma unroll
    for (int j = 0; j < 4; ++j) { const f32x2 lo = __builtin_amdgcn_cvt_pk_f32_fp8((int)q[j], false), hi = __builtin_amdgcn_cvt_pk_f32_fp8((int)q[j], true);
        o[4 * j] += c * lo.x; o[4 * j + 1] += c * lo.y; o[4 * j + 2] += c * hi.x; o[4 * j + 3] += c * hi.y; }
}
template <int NR>
__device__ __forceinline__ void peer_vN(const RowBufN<NR>& rb, float (&outv)[4][16], const LAS unsigned* ent, const LAS float* cf, int b, int lane) {
    const int ev = (int)ent[b * NR + (lane & (NR - 1))]; const float cv = cf[b * NR + (lane & (NR - 1))];
#pragma unroll
    for (int i = 0; i < NR; ++i) {
        const int slot = (__builtin_amdgcn_readlane(ev, i) >> 21) & 3;
        const float c = rdlane_f(cv, i);
        if (slot == 0) peer_acc8(outv[0], c, rb.a[i]);
        else if (slot == 1) peer_acc8(outv[1], c, rb.a[i]);
        else if (slot == 2) peer_acc8(outv[2], c, rb.a[i]);
        else peer_acc8(outv[3], c, rb.a[i]);
    }
}
__device__ __forceinline__ void p_peer_expert4(const Frame& F, unsigned char* ws, float* xres, const float oscale, const XcdBarrier& xbar, const int mode) {
    const bf16_t* XN = (const bf16_t*)(ws + WS_XN); const unsigned char* TU = ws + WS_TAB8U; const unsigned char* TV = ws + WS_TAB8V;
    const float* SU = (const float*)(ws + WS_TABSU); const float* SV = (const float*)(ws + WS_TABSV);
    const unsigned short* EID = (const unsigned short*)(ws + PE_EID); const float* GATE = (const float*)(ws + PE_GATE);
    const int gw = F.bid * NWAVES + F.wave, NGW = F.G * NWAVES, lane = F.lane;
    LAS unsigned* ent = (LAS unsigned*)(F.lds + F.wave * 6144);
    LAS float* cf = (LAS float*)(F.lds + F.wave * 6144 + 2048);
    LAS float* sul = (LAS float*)(F.lds + F.wave * 6144 + 4096);
    LAS unsigned char* xl = F.lds + 49152 + F.wave * 8192;
    constexpr int PU = 16, PV = 8;
    const int nrounds = (T + NGW * 4 - 1) / (NGW * 4);
    for (int rnd = 0; rnd < nrounds; ++rnd) {
        const int m4 = (rnd * NGW + gw) * 4;
        if (m4 < T) {
            {
                int id[4][2]; float gg[4][2], su[4][2];
#pragma unroll
                for (int s = 0; s < 4; ++s) { const size_t m = (size_t)(m4 + s);
                    id[s][0] = EID[m * 128 + lane]; id[s][1] = EID[m * 128 + 64 + lane]; gg[s][0] = GATE[m * 128 + lane] * SV[id[s][0]]; gg[s][1] = GATE[m * 128 + 64 + lane] * SV[id[s][1]]; su[s][0] = SU[id[s][0]]; su[s][1] = SU[id[s][1]]; }
                int base = 0;
#pragma unroll 1
                for (int k = 0; k < 16; ++k) {
                    const int r = (rnd & 1) ? 15 - k : k;
#pragma unroll
                    for (int s = 0; s < 4; ++s)
#pragma unroll
                        for (int w = 0; w < 2; ++w) {
                            const bool hit = (id[s][w] >> 10) == r;
                            const u64 m = __ballot(hit);
                            if (hit) { const int pos = base + (int)__builtin_amdgcn_mbcnt_hi((unsigned)(m >> 32), __builtin_amdgcn_mbcnt_lo((unsigned)m, 0u));
                                ent[pos] = ((unsigned)s << 21) | ((unsigned)(w * 64 + lane) << 14) | (unsigned)(mode == 4 ? (id[s][w] & 7) : id[s][w]); cf[pos] = gg[s][w]; sul[pos] = su[s][w]; }
                            base += __builtin_popcountll(m);
                        }
                }
            }
            LDS_WAIT();
            if (mode != 1 && mode != 3) {
#pragma unroll
                for (int s = 0; s < 4; ++s) { const size_t m = (size_t)(m4 + s);
                    const u32x4 xa = *(const u32x4*)(XN + m * 1024 + lane * 16), xb = *(const u32x4*)(XN + m * 1024 + lane * 16 + 8);
                    *(LAS u32x4*)(xl + s * 2048 + lane * 32) = xa; *(LAS u32x4*)(xl + s * 2048 + lane * 32 + 16) = xb; }
                LDS_WAIT();
                RowBufN<PU> A, B;
                peer_loadN<PU>(A, TU, ent, 0, lane);
#pragma unroll 1
                for (int b = 0; b < 512 / PU; b += 2) {
                    peer_loadN<PU>(B, TU, ent, b + 1, lane);
#pragma unroll
                    for (int h = 0; h < PU / 8; ++h) peer_u8x<PU>(A, h * 8, xl, ent, cf, sul, b * PU + h * 8, lane);
                    if (b + 2 < 512 / PU) peer_loadN<PU>(A, TU, ent, b + 2, lane);
#pragma unroll
                    for (int h = 0; h < PU / 8; ++h) peer_u8x<PU>(B, h * 8, xl, ent, cf, sul, (b + 1) * PU + h * 8, lane);
                }
            }
            LDS_WAIT();
            float outv[4][16];
#pragma unroll
            for (int s = 0; s < 4; ++s)
#pragma unroll
                for (int i = 0; i < 16; ++i) outv[s][i] = 0.f;
            if (mode != 1 && mode != 2) {
                RowBufN<PV> A, B;
                peer_loadN<PV>(A, TV, ent, 0, lane);
#pragma unroll 1
                for (int b = 0; b < 512 / PV; b += 2) {
                    peer_loadN<PV>(B, TV, ent, b + 1, lane);
                    peer_vN<PV>(A, outv, ent, cf, b, lane);
                    if (b + 2 < 512 / PV) peer_loadN<PV>(A, TV, ent, b + 2, lane);
                    peer_vN<PV>(B, outv, ent, cf, b + 1, lane);
                }
            }
#pragma unroll
            for (int s = 0; s < 4; ++s) {
                f32x4* o = (f32x4*)(xres + (size_t)(m4 + s) * 1024 + lane * 16);
#pragma unroll
                for (int j = 0; j < 4; ++j) { f32x4 a0 = o[j]; a0 += (f32x4){outv[s][4 * j], outv[s][4 * j + 1], outv[s][4 * j + 2], outv[s][4 * j + 3]} * oscale; o[j] = a0; }
            }
        }
        if (rnd + 1 < nrounds) xcd_barrier(xbar);
    }
}

__device__ __forceinline__ void cvt_table_i8(const Frame& F, const float* src, unsigned char* dst, float* scales, const int skip) {
    const int nb = F.G > skip ? F.G - skip : F.G, b0 = F.G > skip ? F.bid - skip : F.bid;
    const int gw = b0 * NWAVES + F.wave, NGW = nb * NWAVES, lane = F.lane;
    if (b0 >= 0) for (int r = gw; r < 16384; r += NGW) {
        const f32x4* p = (const f32x4*)(src + (size_t)r * 1024 + lane * 16);
        f32x4 v[4]; float am = 0.f;
#pragma unroll
        for (int j = 0; j < 4; ++j) { v[j] = p[j]; am = fmaxf(am, fmaxf(fmaxf(fabsf(v[j].x), fabsf(v[j].y)), fmaxf(fabsf(v[j].z), fabsf(v[j].w)))); }
#pragma unroll
        for (int o = 1; o < 64; o <<= 1) am = fmaxf(am, __shfl_xor(am, o));
        const float sc = am > 0.f ? am * (1.0f / 127.0f) : 1.0f, inv = 1.0f / sc;
        u32x4 q;
#pragma unroll
        for (int j = 0; j < 4; ++j) { const int a = (int)rintf(v[j].x * inv), b = (int)rintf(v[j].y * inv), c = (int)rintf(v[j].z * inv), d = (int)rintf(v[j].w * inv);
            q[j] = (unsigned)(a & 255) | ((unsigned)(b & 255) << 8) | ((unsigned)(c & 255) << 16) | ((unsigned)(d & 255) << 24); }
        *(u32x4*)(dst + (size_t)r * 1024 + lane * 16) = q;
        if (lane == 0) scales[r] = sc;
    }
}
template <int NR>
__device__ __forceinline__ void peer_u8i(const RowBufN<NR>& rb, int r0, const LAS unsigned char* xq, const LAS unsigned* ent, LAS float* cf, const LAS float* sul, int e0, int lane) {
    int pr[8];
    const int ev = (int)ent[e0 + (lane & 7)];
#pragma unroll
    for (int i = 0; i < 8; ++i) {
        const int slot = (__builtin_amdgcn_readlane(ev, i) >> 21) & 3;
        const u32x4 xv = *(const LAS u32x4*)(xq + slot * 1024 + lane * 16);
        const u32x4 q = rb.a[r0 + i];
        int s = __builtin_amdgcn_sdot4((int)xv.x, (int)q.x, 0, false); s = __builtin_amdgcn_sdot4((int)xv.y, (int)q.y, s, false);
        s = __builtin_amdgcn_sdot4((int)xv.z, (int)q.z, s, false); s = __builtin_amdgcn_sdot4((int)xv.w, (int)q.w, s, false);
        pr[i] = s;
    }
    int r4[4], r2[2], r1;
    { const bool up = (lane & 32) != 0;
#pragma unroll
      for (int i = 0; i < 4; ++i) { const int keep = up ? pr[i + 4] : pr[i], send = up ? pr[i] : pr[i + 4]; r4[i] = keep + __shfl_xor(send, 32); } }
    { const bool up = (lane & 16) != 0;
#pragma unroll
      for (int i = 0; i < 2; ++i) { const int keep = up ? r4[i + 2] : r4[i], send = up ? r4[i] : r4[i + 2]; r2[i] = keep + __shfl_xor(send, 16); } }
    { const bool up = (lane & 8) != 0; const int keep = up ? r2[1] : r2[0], send = up ? r2[0] : r2[1]; r1 = keep + __shfl_xor(send, 8); }
    r1 += __shfl_xor(r1, 4); r1 += __shfl_xor(r1, 2); r1 += __shfl_xor(r1, 1);
    const float gate = cf[e0 + (lane >> 3)];
    const float coef = gate * gelu_tanh((float)r1 * sul[e0 + (lane >> 3)]);
    if ((lane & 7) == 0) cf[e0 + (lane >> 3)] = coef;
}
template <bool FAKE>
__device__ __forceinline__ f32x2 cvt8(unsigned w, bool hi) {
    if (FAKE) { const unsigned t = hi ? (w >> 16) : w; return (f32x2){__builtin_bit_cast(float, (t << 23) | 0x30000000u), __builtin_bit_cast(float, ((t >> 8) << 23) | 0x30000000u)}; }
    return hi ? __builtin_amdgcn_cvt_pk_f32_fp8((int)w, true) : __builtin_amdgcn_cvt_pk_f32_fp8((int)w, false);
}
template <bool FAKE = false>
__device__ __forceinline__ void peer_acc8p(f32x2 (&o)[8], const float c, const u32x4 q) {
    const f32x2 c2 = {c, c};
#pragma unroll
    for (int j = 0; j < 4; ++j) { const f32x2 lo = cvt8<FAKE>(q[j], false), hi = cvt8<FAKE>(q[j], true);
        o[2 * j] += c2 * lo; o[2 * j + 1] += c2 * hi; }
}
template <int NR, bool FAKE>
__device__ __forceinline__ void peer_vNp(const RowBufN<NR>& rb, f32x2 (&outv)[4][8], const LAS unsigned* ent, const LAS float* cf, int b, int lane) {
    const int ev = (int)ent[b * NR + (lane & (NR - 1))]; const float cv = cf[b * NR + (lane & (NR - 1))];
    int slot[NR]; float c[NR];
#pragma unroll
    for (int i = 0; i < NR; ++i) { slot[i] = (__builtin_amdgcn_readlane(ev, i) >> 21) & 3; c[i] = rdlane_f(cv, i); }
#pragma unroll
    for (int q4 = 0; q4 < NR / 4; ++q4) {
#pragma unroll
        for (int s = 0; s < 4; ++s) {
#pragma unroll
            for (int i = 4 * q4; i < 4 * q4 + 4; ++i) if (slot[i] == s) peer_acc8p<FAKE>(outv[s], c[i], rb.a[i]);
            __builtin_amdgcn_sched_barrier(0);
        }
    }
}
template <int PV, bool FAKE>
__device__ __forceinline__ void peer_passv(f32x2 (&outv)[4][8], const unsigned char* TV, const LAS unsigned* ent, const LAS float* cf, int lane) {
    RowBufN<PV> A, B, C;
    constexpr int NBV = 512 / PV;
    peer_loadN<PV>(A, TV, ent, 0, lane); peer_loadN<PV>(B, TV, ent, 1, lane);
#pragma unroll 1
    for (int b = 0; b + 2 < NBV; b += 3) {
        peer_loadN<PV>(C, TV, ent, b + 2, lane);
        peer_vNp<PV, FAKE>(A, outv, ent, cf, b, lane);
        if (b + 3 < NBV) peer_loadN<PV>(A, TV, ent, b + 3, lane);
        peer_vNp<PV, FAKE>(B, outv, ent, cf, b + 1, lane);
        if (b + 4 < NBV) peer_loadN<PV>(B, TV, ent, b + 4, lane);
        peer_vNp<PV, FAKE>(C, outv, ent, cf, b + 2, lane);
    }
    peer_vNp<PV, FAKE>(A, outv, ent, cf, NBV - 1, lane);
}
__device__ __forceinline__ void p_peer_expert5(const Frame& F, unsigned char* ws, float* xres, const float oscale, const XcdBarrier& xbar, const int mode, const bool do_norm) {
    const bf16_t* XN = (const bf16_t*)(ws + WS_XN); const unsigned char* TU = ws + WS_TAB8U; const unsigned char* TV = ws + WS_TAB8V;
    const float* SU = (const float*)(ws + WS_TABSU); const float* SV = (const float*)(ws + WS_TABSV);
    const unsigned short* EID = (const unsigned short*)(ws + PE_EID); const float* GATE = (const float*)(ws + PE_GATE);
    const int gw = F.bid * NWAVES + F.wave, NGW = F.G * NWAVES, lane = F.lane;
    LAS unsigned* ent = (LAS unsigned*)(F.lds + F.wave * 6144);
    LAS float* cf = (LAS float*)(F.lds + F.wave * 6144 + 2048);
    LAS float* sul = (LAS float*)(F.lds + F.wave * 6144 + 4096);
    LAS unsigned char* xq = F.lds + 49152 + F.wave * 4096;
    constexpr int PU = 8, PV = 8;
    const int nrounds = (T + NGW * 4 - 1) / (NGW * 4);
    for (int rnd = 0; rnd < nrounds; ++rnd) {
        const int m4 = (rnd * NGW + gw) * 4;
        if (m4 < T) {
            {
                float sx[4];
#pragma unroll
                for (int s = 0; s < 4; ++s) { const size_t m = (size_t)(m4 + s);
                    const u32x4 xa = *(const u32x4*)(XN + m * 1024 + lane * 16), xb = *(const u32x4*)(XN + m * 1024 + lane * 16 + 8);
                    float xf[16] = {bf_lo(xa.x), bf_hi(xa.x), bf_lo(xa.y), bf_hi(xa.y), bf_lo(xa.z), bf_hi(xa.z), bf_lo(xa.w), bf_hi(xa.w),
                                    bf_lo(xb.x), bf_hi(xb.x), bf_lo(xb.y), bf_hi(xb.y), bf_lo(xb.z), bf_hi(xb.z), bf_lo(xb.w), bf_hi(xb.w)};
                    float am = 0.f;
#pragma unroll
                    for (int i = 0; i < 16; ++i) am = fmaxf(am, fabsf(xf[i]));
#pragma unroll
                    for (int o = 1; o < 64; o <<= 1) am = fmaxf(am, __shfl_xor(am, o));
                    sx[s] = am > 0.f ? am * (1.0f / 127.0f) : 1.0f; const float inv = 1.0f / sx[s];
                    u32x4 q;
#pragma unroll
                    for (int j = 0; j < 4; ++j) { const int a = (int)rintf(xf[4 * j] * inv), b = (int)rintf(xf[4 * j + 1] * inv), c = (int)rintf(xf[4 * j + 2] * inv), d = (int)rintf(xf[4 * j + 3] * inv);
                        q[j] = (unsigned)(a & 255) | ((unsigned)(b & 255) << 8) | ((unsigned)(c & 255) << 16) | ((unsigned)(d & 255) << 24); }
                    *(LAS u32x4*)(xq + s * 1024 + lane * 16) = q; }
                int id[4][2]; float gg[4][2], su[4][2];
#pragma unroll
                for (int s = 0; s < 4; ++s) { const size_t m = (size_t)(m4 + s);
                    id[s][0] = EID[m * 128 + lane]; id[s][1] = EID[m * 128 + 64 + lane];
                    gg[s][0] = GATE[m * 128 + lane] * SV[id[s][0]]; gg[s][1] = GATE[m * 128 + 64 + lane] * SV[id[s][1]];
                    su[s][0] = SU[id[s][0]] * sx[s]; su[s][1] = SU[id[s][1]] * sx[s]; }
                int base = 0;
#pragma unroll 1
                for (int k = 0; k < 16; ++k) {
                    const int r = (rnd & 1) ? 15 - k : k;
#pragma unroll
                    for (int s = 0; s < 4; ++s)
#pragma unroll
                        for (int w = 0; w < 2; ++w) {
                            const bool hit = (id[s][w] >> 10) == r;
                            const u64 m = __ballot(hit);
                            if (hit) { const int pos = base + (int)__builtin_amdgcn_mbcnt_hi((unsigned)(m >> 32), __builtin_amdgcn_mbcnt_lo((unsigned)m, 0u));
                                ent[pos] = ((unsigned)s << 21) | ((unsigned)(w * 64 + lane) << 14) | (unsigned)(mode == 4 ? (id[s][w] & 7) : id[s][w]); cf[pos] = gg[s][w]; sul[pos] = su[s][w]; }
                            base += __builtin_popcountll(m);
                        }
                }
            }
            LDS_WAIT();
            if (mode != 1 && mode != 3) {
                RowBufN<PU> A, B, C;
                constexpr int NBU = 512 / PU;
                peer_loadN<PU>(A, TU, ent, 0, lane); peer_loadN<PU>(B, TU, ent, 1, lane);
#pragma unroll 1
                for (int b = 0; b + 2 < NBU; b += 3) {
                    peer_loadN<PU>(C, TU, ent, b + 2, lane);
                    peer_u8i<PU>(A, 0, xq, ent, cf, sul, b * PU, lane);
                    if (b + 3 < NBU) peer_loadN<PU>(A, TU, ent, b + 3, lane);
                    peer_u8i<PU>(B, 0, xq, ent, cf, sul, (b + 1) * PU, lane);
                    if (b + 4 < NBU) peer_loadN<PU>(B, TU, ent, b + 4, lane);
                    peer_u8i<PU>(C, 0, xq, ent, cf, sul, (b + 2) * PU, lane);
                }
                peer_u8i<PU>(A, 0, xq, ent, cf, sul, (NBU - 1) * PU, lane);
            }
            LDS_WAIT();
            f32x2 outv[4][8];
#pragma unroll
            for (int s = 0; s < 4; ++s)
#pragma unroll
                for (int i = 0; i < 8; ++i) outv[s][i] = (f32x2){0.f, 0.f};
            if (mode != 1 && mode != 2) {
                if (mode == 5) peer_passv<PV, true>(outv, TV, ent, cf, lane); else peer_passv<PV, false>(outv, TV, ent, cf, lane);
            }
            asm volatile("" ::: "memory"); __builtin_amdgcn_sched_barrier(0);
#pragma unroll
            for (int s = 0; s < 4; ++s) {
                f32x4* o = (f32x4*)(xres + (size_t)(m4 + s) * 1024 + lane * 16);
                f32x4 nv[4]; float ss = 0.f;
#pragma unroll
                for (int j = 0; j < 4; ++j) { f32x4 a0 = o[j]; const f32x4 add = (f32x4){outv[s][2 * j].x, outv[s][2 * j].y, outv[s][2 * j + 1].x, outv[s][2 * j + 1].y};
                    if (oscale != 0.f) a0 += add; else asm volatile("" :: "v"(add)); o[j] = a0; nv[j] = a0;
                    ss += (a0.x * a0.x + a0.y * a0.y) + (a0.z * a0.z + a0.w * a0.w); }
                if (do_norm && oscale != 0.f) {
                    const float rstd = 1.0f / sqrtf(wave_sum(ss) * (1.f / DM) + 1e-6f);
                    const f32x4* gp = (const f32x4*)((const float*)(ws + WS_CMPB + 4096) + lane * 16);
                    u32x4 w0, w1;
                    { const f32x4 g0 = gp[0], g1 = gp[1], g2 = gp[2], g3 = gp[3];
                      w0.x = pk2(nv[0].x * rstd * g0.x, nv[0].y * rstd * g0.y); w0.y = pk2(nv[0].z * rstd * g0.z, nv[0].w * rstd * g0.w);
                      w0.z = pk2(nv[1].x * rstd * g1.x, nv[1].y * rstd * g1.y); w0.w = pk2(nv[1].z * rstd * g1.z, nv[1].w * rstd * g1.w);
                      w1.x = pk2(nv[2].x * rstd * g2.x, nv[2].y * rstd * g2.y); w1.y = pk2(nv[2].z * rstd * g2.z, nv[2].w * rstd * g2.w);
                      w1.z = pk2(nv[3].x * rstd * g3.x, nv[3].y * rstd * g3.y); w1.w = pk2(nv[3].z * rstd * g3.z, nv[3].w * rstd * g3.w); }
                    u32x4* xo = (u32x4*)((bf16_t*)(ws + WS_XN) + (size_t)(m4 + s) * 1024 + lane * 16);
                    xo[0] = w0; xo[1] = w1;
                }
                asm volatile("" ::: "memory"); __builtin_amdgcn_sched_barrier(0);
            }
        }
    }
}

constexpr size_t L1_QN = WS_R3;
constexpr size_t L1_KS = WS_R3 + 32 * MiB;
constexpr size_t L1_KW = WS_R3 + 40 * MiB;
constexpr size_t L1_VST = WS_R3 + 48 * MiB;
constexpr size_t L1_VWT = WS_R3 + 56 * MiB;
constexpr size_t L1_KCR = WS_R3 + 64 * MiB;
constexpr size_t L1_VCR = WS_R3 + 72 * MiB;
constexpr size_t L1_GATES = WS_R3 + 81 * MiB;
constexpr size_t L1_H1 = WS_R3 + 84 * MiB;
constexpr size_t L1_CMPO = WS_R3 + 88 * MiB;
constexpr size_t L1_KC = WS_R3 + 90 * MiB;
constexpr size_t L1_VCT = WS_R3 + 91 * MiB;
constexpr size_t L1_SELB = WS_R3 + 92 * MiB;
constexpr size_t L1_OC = WS_TABU;
constexpr size_t L1_CAT = WS_XN;
constexpr size_t L1_UPD = WS_R3;
constexpr size_t L1_DECAY = WS_R3 + 128 * MiB;

__device__ __forceinline__ void p_l1_prep(const Frame& F, const Args& a, unsigned char* ws) {
    const bf16_t* P = (const bf16_t*)(ws + WS_PROJ);
    const f32x2* rope = (const f32x2*)(ws + WS_ROPE);
    bf16_t* QN = (bf16_t*)(ws + L1_QN); bf16_t* KS = (bf16_t*)(ws + L1_KS); bf16_t* KW = (bf16_t*)(ws + L1_KW);
    bf16_t* KCR = (bf16_t*)(ws + L1_KCR); bf16_t* VCR = (bf16_t*)(ws + L1_VCR); float* GATES = (float*)(ws + L1_GATES);
    const int gw = F.bid * NWAVES + F.wave, NGW = F.G * NWAVES, lane = F.lane, hs = lane >> 3, sub = lane & 7;
    float qg[8], kg[8];
#pragma unroll
    for (int j = 0; j < 8; ++j) { qg[j] = a.in[I_L1_QG][sub * 8 + j]; kg[j] = a.in[I_L1_KG][sub * 8 + j]; }
    const int srccol = (hs < 2) ? C1_KS + hs * 64 : (hs < 4) ? C1_KW + (hs - 2) * 64 : (hs < 6) ? C1_KC + (hs - 4) * 64 : C1_VC + (hs - 6) * 64;
    bf16_t* dstbuf = (hs < 2) ? KS : (hs < 4) ? KW : (hs < 6) ? KCR : VCR;
    const int g2 = hs & 1;
    for (int m = gw; m < T; m += NGW) {
        const int b = m >> 12, t = m & 4095;
        const bf16_t* row = P + (size_t)m * N_IN1;
        f32x2 cs[8];
#pragma unroll
        for (int j = 0; j < 4; ++j) { const f32x4 c4 = *(const f32x4*)(rope + t * 32 + (sub & 3) * 8 + 2 * j); cs[2 * j] = (f32x2){c4.x, c4.y}; cs[2 * j + 1] = (f32x2){c4.z, c4.w}; }
        float v[8];
        head8_load(row + C1_Q + lane * 8, v); head8_norm(v, qg); head8_rope(v, cs, sub >= 4); head8_store(QN + (size_t)m * 512 + lane * 8, v, 0.125f);
        {
            const u32x4 raw = *(const u32x4*)(row + srccol + sub * 8);
            v[0] = bf_lo(raw.x); v[1] = bf_hi(raw.x); v[2] = bf_lo(raw.y); v[3] = bf_hi(raw.y); v[4] = bf_lo(raw.z); v[5] = bf_hi(raw.z); v[6] = bf_lo(raw.w); v[7] = bf_hi(raw.w);
            head8_norm(v, kg); head8_rope(v, cs, sub >= 4);
            u32x4 q; q.x = pk2(v[0], v[1]); q.y = pk2(v[2], v[3]); q.z = pk2(v[4], v[5]); q.w = pk2(v[6], v[7]);
            if (hs >= 4) q = raw;
            *(u32x4*)(dstbuf + ((size_t)(b * 2 + g2) * 4096 + t) * 64 + sub * 8) = q;
        }
        if (lane < 24) GATES[(size_t)m * 24 + lane] = sigmoidf_(bf2f(row[C1_GL + lane]));
    }
    for (int it = gw; it < 2 * NB * 2 * 64; it += NGW) {
        const int tb = it & 63, g = (it >> 6) & 1, b = (it >> 7) & 7, w = it >> 10;
        const size_t m = (size_t)b * 4096 + tb * 64 + lane;
        unsigned r[32];
#pragma unroll
        for (int j = 0; j < 8; ++j) { const u32x4 q = *(const u32x4*)(P + m * N_IN1 + (w ? C1_VW : C1_VS) + g * 64 + j * 8); r[4 * j] = q.x; r[4 * j + 1] = q.y; r[4 * j + 2] = q.z; r[4 * j + 3] = q.w; }
        bf16_t* dst = (bf16_t*)(ws + (w ? L1_VWT : L1_VST)) + ((size_t)(b * 2 + g) * 64) * 4096 + tb * 64 + lane;
#pragma unroll
        for (int d = 0; d < 64; ++d) dst[(size_t)d * 4096] = (bf16_t)((d & 1) ? (r[d >> 1] >> 16) : (r[d >> 1] & 0xffffu));
    }
}

namespace pg8 {
struct EpiCmp1 {
    static constexpr bool PERM = true;
    bf16_t* O; const float* bias;
    __device__ __forceinline__ void operator()(const f32x4 (&acc)[2][2][4][2], const Unit& u, int wr, int wc, int fr, int fq) const {
        const int row0 = u.pm * BM + wr * 64 + fr, col0 = wc * 32 + 8 * fq;
#pragma unroll
        for (int ai = 0; ai < 2; ++ai)
#pragma unroll
            for (int m = 0; m < 4; ++m) { bf16_t* rowp = O + (size_t)(row0 + ai * HALF + m * 16) * 256 + col0;
#pragma unroll
                for (int bj = 0; bj < 2; ++bj) { const float* bp = bias + u.pn * 256 + col0 + bj * HALF;
                    const f32x4 v0 = acc[ai][bj][m][0] + *(const f32x4*)bp, v1 = acc[ai][bj][m][1] + *(const f32x4*)(bp + 4);
                    u32x4 w; w.x = pk2(gelu_tanh(v0[0]), gelu_tanh(v0[1])); w.y = pk2(gelu_tanh(v0[2]), gelu_tanh(v0[3]));
                    w.z = pk2(gelu_tanh(v1[0]), gelu_tanh(v1[1])); w.w = pk2(gelu_tanh(v1[2]), gelu_tanh(v1[3]));
                    *(u32x4*)(rowp + bj * HALF) = w; }
                asm volatile("" ::: "memory"); __builtin_amdgcn_sched_barrier(0); }
    }
};
struct EpiCmp2 {
    static constexpr bool PERM = false;
    float* C;
    __device__ __forceinline__ void operator()(const f32x4 (&acc)[2][2][4][2], const Unit& u, int wr, int wc, int fr, int fq) const {
        if (wc >= 2) return;
        const int row0 = u.pm * BM + wr * 64 + fr, col0 = wc * 32 + 4 * fq;
#pragma unroll
        for (int ai = 0; ai < 2; ++ai)
#pragma unroll
            for (int m = 0; m < 4; ++m)
#pragma unroll
                for (int n = 0; n < 2; ++n) *(f32x4*)(C + (size_t)(row0 + ai * HALF + m * 16) * 64 + col0 + n * 16) = acc[ai][0][m][n];
    }
};
}

__device__ __forceinline__ void p_cmp_final(const Frame& F, const Args& a, unsigned char* ws) {
    const float* CMPO = (const float*)(ws + L1_CMPO); const f32x2* rope = (const f32x2*)(ws + WS_ROPE);
    bf16_t* KC = (bf16_t*)(ws + L1_KC); bf16_t* VCT = (bf16_t*)(ws + L1_VCT);
    const int gw = F.bid * NWAVES + F.wave, NGW = F.G * NWAVES, lane = F.lane;
    const float kg = a.in[I_L1_KG][lane];
    for (int r = gw; r < 8192; r += NGW) {
        float v = CMPO[(size_t)r * 64 + lane];
        const int rr = r & 4095, bg = rr >> 8, c = rr & 255;
        if (r < 4096) {
            const float ss = wave_sum(v * v);
            v = v * (1.0f / sqrtf(ss * (1.f / 64.f) + 1e-6f)) * kg;
            const int pos = (c < 255) ? 16 * c + 31 : 0;
            v = rope_apply(v, rope[pos * 32 + (lane & 31)], lane);
            KC[((size_t)bg * 256 + c) * 64 + lane] = (c < 255) ? (bf16_t)f2bf(v) : (bf16_t)0;
        } else {
            VCT[((size_t)bg * 64 + lane) * 256 + c] = (c < 255) ? (bf16_t)f2bf(v) : (bf16_t)0;
        }
    }
}

__device__ __forceinline__ void att_load2(AttStage& s, const bf16_t* Kg, const bf16_t* Vtg, int vstride, int key0, int tid) {
    s.kreg = *(const u32x4*)(Kg + (size_t)(key0 + (tid >> 3)) * 64 + (tid & 7) * 8);
    s.vreg = *(const u32x4*)(Vtg + (size_t)(tid >> 3) * vstride + key0 + (tid & 7) * 8);
}
__device__ __forceinline__ float score_bound_c2(const float* qg, const float* kg) {
    float mq = 0.f, mk_ = 0.f;
    for (int i = 0; i < 64; ++i) { mq = fmaxf(mq, fabsf(qg[i])); mk_ = fmaxf(mk_, fabsf(kg[i])); }
    return (8.0f * mq * mk_ + 0.5f) * 1.4426950408889634f;
}

__device__ __forceinline__ void p_cmp_attn(const Frame& F, const Args& a, unsigned char* ws) {
    const bf16_t* QN = (const bf16_t*)(ws + L1_QN); const bf16_t* KC = (const bf16_t*)(ws + L1_KC); const bf16_t* VCT = (const bf16_t*)(ws + L1_VCT);
    float* OC = (float*)(ws + L1_OC); u64* SELB = (u64*)(ws + L1_SELB);
    LAS float* impL = (LAS float*)(F.lds + 36864);
    const int lane = F.lane, wave = F.wave, h = lane >> 5, c = lane & 31, tid = F.tid;
    const float c2 = score_bound_c2(a.in[I_L1_QG], a.in[I_L1_KG]), c1 = 1.4426950408889634f;
    for (int u = F.bid; u < 1024; u += F.G) {
        const int b = (u >> 7) & 7, g = (u >> 6) & 1, rnd = u >> 8, qt = (rnd & 1) ? 63 - (u & 63) : (u & 63), q0 = qt * 64;
        const int bg = b * 2 + g; const size_t mb = (size_t)b * 4096;
        const int t = q0 + wave * 8 + (c >> 2), head = g * 4 + (c & 3);
        bf16x8 Qf[4];
#pragma unroll
        for (int ks = 0; ks < 4; ++ks) Qf[ks] = *(const bf16x8*)(QN + (mb + t) * 512 + head * 64 + ks * 16 + 8 * h);
        const int L = (t >= 31) ? (((t - 31) >> 4) < 254 ? ((t - 31) >> 4) : 254) : -1;
        const int tmax = q0 + 63; const int Lmax = (tmax >= 31) ? (((tmax - 31) >> 4) < 254 ? ((tmax - 31) >> 4) : 254) : -1;
        const int nkt = (Lmax >= 0) ? (Lmax >> 6) + 1 : 0;
        f32x16 O[2], IMP[2]; float l = 0.f;
#pragma unroll
        for (int i = 0; i < 16; ++i) { O[0][i] = 0.f; O[1][i] = 0.f; IMP[0][i] = 0.f; IMP[1][i] = 0.f; }
        const bf16_t* Kg = KC + (size_t)bg * 256 * 64; const bf16_t* Vtg = VCT + (size_t)bg * 64 * 256;
        __syncthreads();
        for (int kt = 0; kt < nkt; ++kt) {
            AttStage st; att_load2(st, Kg, Vtg, 256, kt * 64, tid);
            __syncthreads();
            att_store(st, F.lds, tid);
            __syncthreads();
#pragma unroll 1
            for (int sub = 0; sub < 2; ++sub) {
                const f32x16 S = att_qk(F.lds, sub, Qf, lane);
                float p[16];
#pragma unroll
                for (int i = 0; i < 16; ++i) {
                    const int cidx = kt * 64 + sub * 32 + (i & 3) + 8 * (i >> 2) + 4 * h;
                    const float e = __builtin_amdgcn_exp2f(S[i] * c1 - c2);
                    p[i] = (cidx <= L) ? e : 0.f; l += p[i];
                }
                const bf16x8 P0 = pack8(p[0], p[1], p[2], p[3], p[4], p[5], p[6], p[7]);
                const bf16x8 P1 = pack8(p[8], p[9], p[10], p[11], p[12], p[13], p[14], p[15]);
                att_pv2(F.lds, sub, P0, P1, O, lane);
#pragma unroll
                for (int jt = 0; jt < 2; ++jt)
#pragma unroll
                    for (int s = 0; s < 2; ++s) {
                        unsigned wv[4];
#pragma unroll
                        for (int e2 = 0; e2 < 4; ++e2) {
                            unsigned pr = 0u;
#pragma unroll
                            for (int q = 0; q < 2; ++q) { const int jj = 2 * e2 + q; const int kap = 16 * s + 8 * (jj >> 2) + 4 * h + (jj & 3);
                                const int off = kt * 64 + sub * 32 + kap - 4 * (32 * jt + c);
                                const unsigned wbits = (off == 0 || off == 4) ? 0x3F80u : ((off >= 1 && off <= 3) ? 0x4000u : 0u);
                                pr |= wbits << (16 * q); }
                            wv[e2] = pr;
                        }
                        const bf16x8 Wf = __builtin_bit_cast(bf16x8, ((u32x4){wv[0], wv[1], wv[2], wv[3]}));
                        IMP[jt] = __builtin_amdgcn_mfma_f32_32x32x16_bf16(Wf, s ? P1 : P0, IMP[jt], 0, 0, 0);
                    }
            }
        }
        const float lt = l + __shfl_xor(l, 32);
        const float inv = 1.0f / fmaxf(lt, 1e-30f);
        { float* orow = OC + (mb + t) * 512 + head * 64;
#pragma unroll
          for (int dt = 0; dt < 2; ++dt)
#pragma unroll
            for (int i4 = 0; i4 < 4; ++i4) { const int d = dt * 32 + 8 * i4 + 4 * h;
                *(f32x4*)(orow + d) = (f32x4){O[dt][4 * i4] * inv, O[dt][4 * i4 + 1] * inv, O[dt][4 * i4 + 2] * inv, O[dt][4 * i4 + 3] * inv}; } }
#pragma unroll
        for (int jt = 0; jt < 2; ++jt)
#pragma unroll
            for (int i = 0; i < 16; ++i) {
                float v = IMP[jt][i] * inv; v += __shfl_xor(v, 1); v += __shfl_xor(v, 2);
                if ((c & 3) == 0) impL[(wave * 8 + (c >> 2)) * 65 + 32 * jt + (i & 3) + 8 * (i >> 2) + 4 * h] = v;
            }
        __syncthreads();
        if (tid < 64) {
            const int tq = q0 + tid, cur = tq >> 6;
            u64 mask;
            if (cur + 1 <= 16) mask = (1ull << (cur + 1)) - 1ull;
            else {
                float v[64];
#pragma unroll
                for (int j = 0; j < 64; ++j) { const float x = impL[tid * 65 + j]; v[j] = (j > cur) ? -3.0e38f : ((j == 0 || j == cur) ? 1.0e9f : x); }
                mask = 0ull;
#pragma unroll 1
                for (int k = 0; k < 16; ++k) {
                    float best = -3.0e38f; int bi = 0;
#pragma unroll
                    for (int j = 0; j < 64; ++j) { const bool taken = (mask >> j) & 1ull; if (!taken && v[j] > best) { best = v[j]; bi = j; } }
                    mask |= 1ull << bi;
                }
            }
            SELB[(size_t)bg * 4096 + tq] = mask;
        }
        __syncthreads();
    }
}

__device__ __forceinline__ void p_nsa_attn(const Frame& F, const Args& a, unsigned char* ws) {
    const bf16_t* QN = (const bf16_t*)(ws + L1_QN);
    const u64* SELB = (const u64*)(ws + L1_SELB); float* OC = (float*)(ws + L1_OC); const float* GATES = (const float*)(ws + L1_GATES);
    bf16_t* CAT = (bf16_t*)(ws + L1_CAT);
    const int lane = F.lane, wave = F.wave, h = lane >> 5, c = lane & 31, tid = F.tid;
    const float c2 = score_bound_c2(a.in[I_L1_QG], a.in[I_L1_KG]), c1 = 1.4426950408889634f;
    for (int u = F.bid; u < 512; u += F.G) {
        const int idx = u & 255, g = u >> 8, b = idx >> 5, qtr = idx & 31, qt = g ? 31 - qtr : qtr, q0 = qt * 128;
        const int bg = b * 2 + g; const size_t mb = (size_t)b * 4096;
        bf16x8 Qf[2][4]; int qidx[2];
#pragma unroll
        for (int ct = 0; ct < 2; ++ct) { qidx[ct] = q0 + wave * 16 + ct * 8 + (c >> 2);
#pragma unroll
            for (int ks = 0; ks < 4; ++ks) Qf[ct][ks] = *(const bf16x8*)(QN + (mb + qidx[ct]) * 512 + (g * 4 + (c & 3)) * 64 + ks * 16 + 8 * h); }
        const int head = g * 4 + (c & 3);
#pragma unroll 1
        for (int pass = 0; pass < 2; ++pass) {
            const bf16_t* Kg = (const bf16_t*)(ws + (pass ? L1_KW : L1_KS)) + (size_t)bg * 4096 * 64;
            const bf16_t* Vtg = (const bf16_t*)(ws + (pass ? L1_VWT : L1_VST)) + (size_t)bg * 64 * 4096;
            u64 selw[2];
#pragma unroll
            for (int ct = 0; ct < 2; ++ct) selw[ct] = pass ? ~0ull : SELB[(size_t)bg * 4096 + qidx[ct]];
            const int wlen = pass ? 512 : 0x7fffffff;
            f32x16 O[2][2]; float l[2] = {0.f, 0.f};
#pragma unroll
            for (int ct = 0; ct < 2; ++ct)
#pragma unroll
                for (int dt = 0; dt < 2; ++dt)
#pragma unroll
                    for (int i = 0; i < 16; ++i) O[ct][dt][i] = 0.f;
            const int kt_lo = pass ? ((2 * qt - 8) > 0 ? 2 * qt - 8 : 0) : 0, kt_hi = 2 * qt + 2;
            AttStage st; att_load(st, Kg, Vtg, kt_lo * 64, tid);
            __syncthreads();
            att_store(st, F.lds + (kt_lo & 1) * AT_BUF, tid);
            __syncthreads();
            for (int kt = kt_lo; kt < kt_hi; ++kt) {
                LAS unsigned char* buf = F.lds + (kt & 1) * AT_BUF;
                if (kt + 1 < kt_hi) att_load(st, Kg, Vtg, (kt + 1) * 64, tid);
#pragma unroll 1
                for (int sub = 0; sub < 2; ++sub) {
                    bf16x8 Kf[4];
                    att_kfrags(buf, sub, Kf, lane);
#pragma unroll
                    for (int ct = 0; ct < 2; ++ct) {
                        __builtin_amdgcn_sched_barrier(0);
                        const f32x16 S = att_qk_f(Kf, Qf[ct]);
                        const bool flag = (selw[ct] >> kt) & 1ull;
                        const int tq = qidx[ct];
                        const float c2e = flag ? c2 : 3.0e30f;
                        float p[16];
                        const int dbase = tq - (kt * 64 + sub * 32 + 4 * h);
#pragma unroll
                        for (int i = 0; i < 16; ++i) {
                            const float e = __builtin_amdgcn_exp2f(S[i] * c1 - c2e);
                            p[i] = ((unsigned)(dbase - ((i & 3) + 8 * (i >> 2))) < (unsigned)wlen) ? e : 0.f; l[ct] += p[i];
                        }
                        const bf16x8 P0 = pack8(p[0], p[1], p[2], p[3], p[4], p[5], p[6], p[7]);
                        const bf16x8 P1 = pack8(p[8], p[9], p[10], p[11], p[12], p[13], p[14], p[15]);
                        att_pv2(buf, sub, P0, P1, O[ct], lane);
                    }
                }
                if (kt + 1 < kt_hi) att_store(st, F.lds + ((kt + 1) & 1) * AT_BUF, tid);
                __syncthreads();
            }
#pragma unroll
            for (int ct = 0; ct < 2; ++ct) {
                const float lt = l[ct] + __shfl_xor(l[ct], 32);
                const float inv = 1.0f / fmaxf(lt, 1e-30f);
                const size_t m = mb + qidx[ct];
                const float gcv = GATES[m * 24 + head * 3 + 0], gsv = GATES[m * 24 + head * 3 + 1], gwv = GATES[m * 24 + head * 3 + 2];
                float* orow = OC + m * 512 + head * 64; bf16_t* crow = CAT + m * 1024 + head * 64;
#pragma unroll
                for (int dt = 0; dt < 2; ++dt)
#pragma unroll
                    for (int i4 = 0; i4 < 4; ++i4) {
                        const int d = dt * 32 + 8 * i4 + 4 * h;
                        const f32x4 prev = *(const f32x4*)(orow + d);
                        const f32x4 ov = (f32x4){O[ct][dt][4 * i4] * inv, O[ct][dt][4 * i4 + 1] * inv, O[ct][dt][4 * i4 + 2] * inv, O[ct][dt][4 * i4 + 3] * inv};
                        if (pass == 0) *(f32x4*)(orow + d) = prev * gcv + ov * gsv;
                        else { const f32x4 r = prev + ov * gwv; u32x2 w; w.x = pk2(r[0], r[1]); w.y = pk2(r[2], r[3]); *(u32x2*)(crow + d) = w; }
                    }
            }
        }
    }
}

__device__ __forceinline__ float logsigmoidf_(float x) { return fminf(x, 0.f) - log1pf(__expf(-fabsf(x))); }
__device__ __forceinline__ bf16x8 frag_lds(const LAS float* p) { const f32x4 a = *(const LAS f32x4*)p, b = *(const LAS f32x4*)(p + 4); return pack8(a[0], a[1], a[2], a[3], b[0], b[1], b[2], b[3]); }
__device__ __forceinline__ bf16x8 frag_glb(const float* p) { const f32x4 a = *(const f32x4*)p, b = *(const f32x4*)(p + 4); return pack8(a[0], a[1], a[2], a[3], b[0], b[1], b[2], b[3]); }
struct GlaRaw { u32x4 ga[4], gb[4]; unsigned short k[4], q[4], v8[8]; };
template <bool WITHQ>
__device__ __forceinline__ void gla_fetch(GlaRaw& R, const Frame& F, const bf16_t* P, size_t m0, int hh) {
    const int dk = F.tid & 63, cq = F.tid >> 6, dv = F.tid & 127, cv = F.tid >> 7;
#pragma unroll
    for (int i = 0; i < 4; ++i) { const bf16_t* row = P + (m0 + 4 * cq + i) * N_IN1;
        R.ga[i] = *(const u32x4*)(row + C1_GLOW); R.gb[i] = *(const u32x4*)(row + C1_GLOW + 8);
        R.k[i] = row[C1_GK + hh * 64 + dk]; if (WITHQ) R.q[i] = row[C1_GQ + hh * 64 + dk]; }
#pragma unroll
    for (int i = 0; i < 8; ++i) R.v8[i] = P[(m0 + 8 * cv + i) * N_IN1 + C1_GV + hh * 128 + dv];
}
__device__ __forceinline__ void gla_bcum3(const Frame& F, const GlaRaw& R, const float (&wg)[16], const float bgv, LAS float* seg, float (&bc)[4], float& blast) {
    const int dk = F.tid & 63, cq = F.tid >> 6;
    float run = 0.f;
#pragma unroll
    for (int i = 0; i < 4; ++i) {
        const u32x4 ga = R.ga[i], gb = R.gb[i];
        float acc = bgv;
        acc += wg[0] * bf_lo(ga.x); acc += wg[1] * bf_hi(ga.x); acc += wg[2] * bf_lo(ga.y); acc += wg[3] * bf_hi(ga.y); acc += wg[4] * bf_lo(ga.z); acc += wg[5] * bf_hi(ga.z); acc += wg[6] * bf_lo(ga.w); acc += wg[7] * bf_hi(ga.w);
        acc += wg[8] * bf_lo(gb.x); acc += wg[9] * bf_hi(gb.x); acc += wg[10] * bf_lo(gb.y); acc += wg[11] * bf_hi(gb.y); acc += wg[12] * bf_lo(gb.z); acc += wg[13] * bf_hi(gb.z); acc += wg[14] * bf_lo(gb.w); acc += wg[15] * bf_hi(gb.w);
        run += logsigmoidf_(acc) * 0.0625f; bc[i] = run;
    }
    seg[cq * 64 + dk] = run;
    __syncthreads();
    float off = 0.f, tot = 0.f;
#pragma unroll
    for (int q = 0; q < 8; ++q) { const float sv = seg[q * 64 + dk]; tot += sv; off += (q < cq) ? sv : 0.f; }
#pragma unroll
    for (int i = 0; i < 4; ++i) bc[i] += off;
    blast = tot;
}
__device__ __forceinline__ void gla_put_vT(const Frame& F, const GlaRaw& R, LAS float* vT) {
    const int dv = F.tid & 127, cv = F.tid >> 7;
    *(LAS f32x4*)(vT + dv * 36 + 8 * cv) = (f32x4){bf2f(R.v8[0]), bf2f(R.v8[1]), bf2f(R.v8[2]), bf2f(R.v8[3])};
    *(LAS f32x4*)(vT + dv * 36 + 8 * cv + 4) = (f32x4){bf2f(R.v8[4]), bf2f(R.v8[5]), bf2f(R.v8[6]), bf2f(R.v8[7])};
}
__device__ __forceinline__ void p_gla_a(const Frame& F, const Args& a, unsigned char* ws) {
    const bf16_t* P = (const bf16_t*)(ws + WS_PROJ); float* UPD = (float*)(ws + L1_UPD); float* DECAY = (float*)(ws + L1_DECAY);
    LAS float* seg = (LAS float*)F.lds; LAS float* kdT = seg + 512; LAS float* vT = kdT + 64 * 36;
    const int tid = F.tid, lane = F.lane, wave = F.wave, r = lane & 31, h = lane >> 5;
    const int UPW = (4096 + F.G - 1) / F.G, u0 = F.bid * UPW, u1 = (u0 + UPW < 4096) ? u0 + UPW : 4096;
    if (u0 >= u1) return;
    GlaRaw R; gla_fetch<false>(R, F, P, (size_t)(u0 >> 9) * 4096 + (u0 & 127) * 32, (u0 >> 7) & 3);
    for (int u = u0; u < u1; ++u) {
        const int hh = (u >> 7) & 3;
        float wg[16];
#pragma unroll
        for (int q = 0; q < 16; ++q) wg[q] = a.in[I_L1_WGATE][q * 256 + hh * 64 + (tid & 63)];
        const float bgv = a.in[I_L1_BGATE][hh * 64 + (tid & 63)];
        float bc[4], blast;
        gla_bcum3(F, R, wg, bgv, seg, bc, blast);
        { const int dk = tid & 63, cq = tid >> 6;
          *(LAS f32x4*)(kdT + dk * 36 + 4 * cq) = (f32x4){bf2f(R.k[0]) * __expf(blast - bc[0]), bf2f(R.k[1]) * __expf(blast - bc[1]), bf2f(R.k[2]) * __expf(blast - bc[2]), bf2f(R.k[3]) * __expf(blast - bc[3])};
          if (cq == 0) DECAY[(size_t)u * 64 + dk] = __expf(blast); }
        gla_put_vT(F, R, vT);
        if (u + 1 < u1) { const int un = u + 1; gla_fetch<false>(R, F, P, (size_t)(un >> 9) * 4096 + (un & 127) * 32, (un >> 7) & 3); }
        __syncthreads();
        {
            const int mt = wave >> 1, nt = wave & 1;
            f32x16 acc = {0.f, 0.f, 0.f, 0.f, 0.f, 0.f, 0.f, 0.f, 0.f, 0.f, 0.f, 0.f, 0.f, 0.f, 0.f, 0.f};
#pragma unroll
            for (int ks = 0; ks < 2; ++ks) acc = __builtin_amdgcn_mfma_f32_32x32x16_bf16(frag_lds(vT + (32 * mt + r) * 36 + 16 * ks + 8 * h), frag_lds(kdT + (32 * nt + r) * 36 + 16 * ks + 8 * h), acc, 0, 0, 0);
            float* up = UPD + (size_t)u * 8192 + 32 * nt + r;
#pragma unroll
            for (int i = 0; i < 16; ++i) up[(size_t)(32 * mt + (i & 3) + 8 * (i >> 2) + 4 * h) * 64] = acc[i];
        }
        __syncthreads();
    }
}
__device__ __forceinline__ void p_gla_b(const Frame& F, unsigned char* ws) {
    float* UPD = (float*)(ws + L1_UPD); const float* DECAY = (const float*)(ws + L1_DECAY);
    for (int e = F.bid * NTHREADS + F.tid; e < 32 * 8192; e += F.G * NTHREADS) {
        const int bh = e >> 13, rem = e & 8191, dk = rem & 63;
        float state = 0.f;
        float* up = UPD + (size_t)bh * 128 * 8192 + rem; const float* dp = DECAY + (size_t)bh * 128 * 64 + dk;
#pragma unroll 8
        for (int n = 0; n < 128; ++n) { const float uv = up[(size_t)n * 8192], dc = dp[n * 64]; up[(size_t)n * 8192] = state; state = dc * state + uv; }
    }
}
__device__ __forceinline__ void p_gla_c(const Frame& F, const Args& a, unsigned char* ws) {
    const bf16_t* P = (const bf16_t*)(ws + WS_PROJ); const float* PREV = (const float*)(ws + L1_UPD); bf16_t* CAT = (bf16_t*)(ws + L1_CAT);
    LAS float* seg = (LAS float*)F.lds; LAS float* qd = seg + 512; LAS float* ki = qd + 32 * 68; LAS float* vT = ki + 32 * 68; LAS float* att = vT + 128 * 36; LAS float* red = att + 32 * 36;
    const int tid = F.tid, lane = F.lane, wave = F.wave, r = lane & 31, h = lane >> 5;
    const int UPW = (4096 + F.G - 1) / F.G, u0 = F.bid * UPW, u1 = (u0 + UPW < 4096) ? u0 + UPW : 4096;
    if (u0 >= u1) return;
    GlaRaw R; gla_fetch<true>(R, F, P, (size_t)(u0 >> 9) * 4096 + (u0 & 127) * 32, (u0 >> 7) & 3);
    for (int u = u0; u < u1; ++u) {
        const int b = u >> 9, hh = (u >> 7) & 3, n = u & 127; const size_t m0 = (size_t)b * 4096 + n * 32;
        bf16x8 pf[4]; unsigned short rv16[16];
        if (wave < 4) {
            const float* pp = PREV + (size_t)u * 8192 + (size_t)(32 * wave + r) * 64;
#pragma unroll
            for (int ks = 0; ks < 4; ++ks) pf[ks] = frag_glb(pp + 16 * ks + 8 * h);
#pragma unroll
            for (int i = 0; i < 16; ++i) rv16[i] = P[(m0 + (i & 3) + 8 * (i >> 2) + 4 * h) * N_IN1 + C1_GR + hh * 128 + 32 * wave + r];
        }
        float wg[16];
#pragma unroll
        for (int q = 0; q < 16; ++q) wg[q] = a.in[I_L1_WGATE][q * 256 + hh * 64 + (tid & 63)];
        const float bgv = a.in[I_L1_BGATE][hh * 64 + (tid & 63)];
        float bc[4], blast;
        gla_bcum3(F, R, wg, bgv, seg, bc, blast);
        { const int dk = tid & 63, cq = tid >> 6;
#pragma unroll
          for (int i = 0; i < 4; ++i) { ki[(4 * cq + i) * 68 + dk] = bf2f(R.k[i]) * __expf(-bc[i]); qd[(4 * cq + i) * 68 + dk] = bf2f(R.q[i]) * 0.125f * __expf(bc[i]); } }
        gla_put_vT(F, R, vT);
        if (u + 1 < u1) { const int un = u + 1; gla_fetch<true>(R, F, P, (size_t)(un >> 9) * 4096 + (un & 127) * 32, (un >> 7) & 3); }
        __syncthreads();
        f32x16 acc = {0.f, 0.f, 0.f, 0.f, 0.f, 0.f, 0.f, 0.f, 0.f, 0.f, 0.f, 0.f, 0.f, 0.f, 0.f, 0.f};
        if (wave == 4) {
            f32x16 at = {0.f, 0.f, 0.f, 0.f, 0.f, 0.f, 0.f, 0.f, 0.f, 0.f, 0.f, 0.f, 0.f, 0.f, 0.f, 0.f};
#pragma unroll
            for (int ks = 0; ks < 4; ++ks) at = __builtin_amdgcn_mfma_f32_32x32x16_bf16(frag_lds(qd + r * 68 + 16 * ks + 8 * h), frag_lds(ki + r * 68 + 16 * ks + 8 * h), at, 0, 0, 0);
#pragma unroll
            for (int i = 0; i < 16; ++i) { const int c = (i & 3) + 8 * (i >> 2) + 4 * h; att[c * 36 + r] = (r <= c) ? at[i] : 0.f; }
        } else if (wave < 4) {
#pragma unroll
            for (int ks = 0; ks < 4; ++ks) acc = __builtin_amdgcn_mfma_f32_32x32x16_bf16(frag_lds(qd + r * 68 + 16 * ks + 8 * h), pf[ks], acc, 0, 0, 0);
        }
        __syncthreads();
        if (wave < 4) {
#pragma unroll
            for (int ks = 0; ks < 2; ++ks) acc = __builtin_amdgcn_mfma_f32_32x32x16_bf16(frag_lds(att + r * 36 + 16 * ks + 8 * h), frag_lds(vT + (32 * wave + r) * 36 + 16 * ks + 8 * h), acc, 0, 0, 0);
#pragma unroll
            for (int i = 0; i < 16; ++i) { float ss = acc[i] * acc[i];
                ss += __shfl_xor(ss, 1); ss += __shfl_xor(ss, 2); ss += __shfl_xor(ss, 4); ss += __shfl_xor(ss, 8); ss += __shfl_xor(ss, 16);
                if (r == 0) red[wave * 32 + (i & 3) + 8 * (i >> 2) + 4 * h] = ss; }
        }
        __syncthreads();
        if (wave < 4) {
            const int dv = 32 * wave + r; const float og = a.in[I_L1_OGAIN][dv];
#pragma unroll
            for (int i = 0; i < 16; ++i) { const int c = (i & 3) + 8 * (i >> 2) + 4 * h;
                const float tot = red[c] + red[32 + c] + red[64 + c] + red[96 + c];
                const float rstd = 1.0f / sqrtf(tot * (1.f / 128.f) + 1e-6f);
                const float rv = bf2f(rv16[i]);
                CAT[(m0 + c) * 1024 + 512 + hh * 128 + dv] = (bf16_t)f2bf(acc[i] * rstd * og * rv * sigmoidf_(rv)); }
        }
        __syncthreads();
    }
}
__global__ void __launch_bounds__(NTHREADS, 2) mk_fwd(Args args) {
    extern __shared__ __attribute__((aligned(16))) unsigned char lds_raw[];
    cg::grid_group grid = cg::this_grid();
    Frame F; F.lds = (LAS unsigned char*)lds_raw; F.tid = threadIdx.x; F.lane = F.tid & 63; F.wave = __builtin_amdgcn_readfirstlane(F.tid >> 6); F.G = gridDim.x; F.bid = blockIdx.x;
    unsigned char* ws = args.ws;
    const int lo = args.ph_lo, hi = args.ph_hi;
#ifndef KEEPMASK
#define KEEPMASK 0xFFFFFFFFu
#endif
#define IN(k) (((KEEPMASK >> (k)) & 1u) && lo <= (k) && (k) < hi)
#define BOTH(k) (IN(k) && IN((k) + 1))
#ifndef TMODE
#define TMODE 0
#endif
#ifndef REPMASK
#define REPMASK 0u
#endif
#define PH(k, ...) if (IN(k)) { { const int rep = 0; (void)rep; __VA_ARGS__; } if ((REPMASK >> (k)) & 1u) { xcd_barrier(xbar); { const int rep = 1; (void)rep; __VA_ARGS__; } } }
#ifdef TS_A
#define STAMP(k) do { if (F.bid == 0 && F.tid == 0) ((unsigned long long*)(ws + WS_CTL + 65536))[(k)] = __builtin_amdgcn_s_memrealtime(); } while (0)
#else
#define STAMP(k) do { } while (0)
#endif
#define GRID_BAR(k) do { if (BOTH(k)) { if ((k) == 0) grid.sync(); else xcd_barrier(xbar); } STAMP((k) + 1); } while (0)
    const float* x = args.in[I_X];
    float* out = args.out;
    volatile LAS unsigned* xst = (volatile LAS unsigned*)(F.lds + LDS_BYTES - 64);
    if (F.tid < 16) xst[F.tid] = 0u;
    __syncthreads();
    XcdBarrier xbar = xcd_barrier_post((unsigned*)(ws + WS_CTL) + 4096, xst);

    STAMP(0);
    PH(0, int base = 0; transpose_all(F, base, args.in[I_L0_WIN], 1024, 1864, (bf16_t*)(ws + WS_W_IN0), 1024, MapIn0()); transpose_all(F, base, args.in[I_L0_WGLU], 512, 512, (bf16_t*)(ws + WS_W_GLU), 512, MapId()); transpose_all(F, base, args.in[I_L0_WOUT], 1024, 1024, (bf16_t*)(ws + WS_W_OUT0), 1024, MapId()); transpose_all(F, base, args.in[I_L0_WQ], 1024, 2048, (bf16_t*)(ws + WS_WQ0), 1024, MapId()); transpose_all(F, base, args.in[I_L1_WIN], 1024, 2856, (bf16_t*)(ws + WS_W_IN1), 1024, MapIn1()); transpose_all(F, base, args.in[I_L1_KW1], 2048, 256, (bf16_t*)(ws + WS_KW1), 2048, MapId()); transpose_all(F, base, args.in[I_L1_VW1], 2048, 256, (bf16_t*)(ws + WS_VW1), 2048, MapId()); transpose_all(F, base, args.in[I_L1_KW2], 256, 64, (bf16_t*)(ws + WS_KW2), 256, MapId()); transpose_all(F, base, args.in[I_L1_VW2], 256, 64, (bf16_t*)(ws + WS_VW2), 256, MapId()); transpose_all(F, base, args.in[I_L1_WOUT], 1024, 1024, (bf16_t*)(ws + WS_W_OUT1), 1024, MapId()); transpose_all(F, base, args.in[I_L1_WQ], 1024, 2048, (bf16_t*)(ws + WS_WQ1), 1024, MapId()); zero_bytes(F, ws + WS_W_IN0 + (size_t)1864 * 1024 * 2, (size_t)(2048 - 1864) * 1024 * 2); zero_bytes(F, ws + WS_W_IN1 + (size_t)2856 * 1024 * 2, (size_t)(3072 - 2856) * 1024 * 2); zero_bytes(F, ws + WS_KW2 + (size_t)64 * 256 * 2, (size_t)192 * 256 * 2); zero_bytes(F, ws + WS_VW2 + (size_t)64 * 256 * 2, (size_t)192 * 256 * 2); cvt_f32_bf16(F, args.in[I_L0_SK], (bf16_t*)(ws + WS_SK0), (size_t)16 * 128 * 128); cvt_f32_bf16(F, args.in[I_L1_SK], (bf16_t*)(ws + WS_SK1), (size_t)16 * 128 * 128); cvt_table_i8(F, args.in[I_L0_U], ws + WS_TAB8U, (float*)(ws + WS_TABSU), 32); cvt_table_fp8(F, args.in[I_L0_V], ws + WS_TAB8V, (float*)(ws + WS_TABSV), 32); p_rope_table(F, (f32x2*)(ws + WS_ROPE)); if (F.bid == F.G - 1) { for (int i = F.tid; i < 1024; i += NTHREADS) ((float*)(ws + WS_CMPB + 4096))[i] = args.in[I_L1_MIXN][i]; } __syncthreads(); for (int g = F.bid; g < 32; g += F.G) s5_build_group(F, args, ws, g); for (int j = (F.bid + F.G - (32 % F.G)) % F.G; j < 64; j += F.G) cmp_bias(F, args, (float*)(ws + WS_CMPB), j); p_rmsnorm(F, x, args.in[I_L0_MIXN], (bf16_t*)(ws + WS_XN));)
    GRID_BAR(0);
    PH(1, pg8::Gemm g{(const bf16_t*)(ws + WS_XN), (const bf16_t*)(ws + WS_W_IN0), T, N_IN0, 1024, 1024, 1024}; pg8::StaticOrder S; S.init(T, N_IN0, F.G, F.bid); pg8::EpiStoreBf16 E{(bf16_t*)(ws + WS_PROJ), N_IN0}; pg8::gemm_phase(F.lds, g, S, E);)
    GRID_BAR(1);
    PH(2, p_l0_prep(F, args, ws);)
    GRID_BAR(2);
    PH(3, p_dsa_index(F, ws, (u64*)(ws + (rep ? L0_CAT : L0_SELT)), rep ? TMODE : 0);)
    GRID_BAR(3);
    PH(4, p_dsa_attn(F, args, ws);)
    GRID_BAR(4);
    PH(5, pg8::Gemm g{(const bf16_t*)(ws + L0_UA), (const bf16_t*)(ws + WS_S5B1), 65536, 8192, 256, 384, 256}; pg8::GroupedOrder S; S.init(256, 8, F.G, F.bid); pg8::EpiS5State E{(float*)(ws + L0_SLOC)}; pg8::gemm_phase(F.lds, g, S, E);)
    GRID_BAR(5);
    PH(6, p_s5_scan(F, args, ws);)
    GRID_BAR(6);
    PH(7, pg8::Gemm g{(const bf16_t*)(ws + L0_UA), (const bf16_t*)(ws + WS_S5B2), 65536, 8192, 384, 384, 384}; pg8::GroupedOrder S; S.init(256, 8, F.G, F.bid); pg8::EpiS5Out E{(bf16_t*)(ws + L0_YB)}; pg8::gemm_phase(F.lds, g, S, E);)
    GRID_BAR(7);
    PH(8, pg8::Gemm g{(const bf16_t*)(ws + L0_YB), (const bf16_t*)(ws + WS_W_GLU), T, 512, 512, 512, 512}; pg8::StaticOrder S; S.init(T, 512, F.G, F.bid); pg8::EpiGlu E{(const bf16_t*)(ws + L0_YB), args.in[I_L0_BGLU], (bf16_t*)(ws + L0_CAT)}; pg8::gemm_phase(F.lds, g, S, E);)
    GRID_BAR(8);
    PH(9, pg8::Gemm g{(const bf16_t*)(ws + L0_CAT), (const bf16_t*)(ws + WS_W_OUT0), T, 1024, 1024, 1024, 1024}; pg8::StaticOrder S; S.init(T, 1024, F.G, F.bid); pg8::EpiResidF32 E{x, out, 1024}; pg8::gemm_phase(F.lds, g, S, E);)
    GRID_BAR(9);
    PH(10, p_rmsnorm(F, out, args.in[I_L0_FFNN], (bf16_t*)(ws + WS_XN));)
    GRID_BAR(10);
    PH(11, pg8::Gemm g{(const bf16_t*)(ws + WS_XN), (const bf16_t*)(ws + WS_WQ0), T, 2048, 1024, 1024, 1024}; pg8::StaticOrder S; S.init(T, 2048, F.G, F.bid); pg8::EpiStoreBf16 E{(bf16_t*)(ws + PE_Q2), 2048}; pg8::gemm_phase(F.lds, g, S, E);)
    GRID_BAR(11);
    PH(12, p_peer_route(F, ws, (const bf16_t*)(ws + WS_SK0));)
    GRID_BAR(12);
    PH(13, p_peer_expert5(F, ws, out, rep ? 0.f : 1.f, xbar, rep ? TMODE : 0, true);)
    GRID_BAR(13);
    PH(15, pg8::Gemm g{(const bf16_t*)(ws + WS_XN), (const bf16_t*)(ws + WS_W_IN1), T, N_IN1, 1024, 1024, 1024}; pg8::StaticOrder S; S.init(T, N_IN1, F.G, F.bid); pg8::EpiStoreBf16 E{(bf16_t*)(ws + WS_PROJ), N_IN1}; pg8::gemm_phase(F.lds, g, S, E);)
    GRID_BAR(15);
    PH(16, p_l1_prep(F, args, ws);)
    GRID_BAR(16);
    PH(17, pg8::Gemm g{(const bf16_t*)(ws + L1_KCR), (const bf16_t*)(ws + WS_KW1), 8192, 512, 2048, 1024, 2048}; pg8::GroupedOrder S; S.init(32, 16, F.G, F.bid); pg8::EpiCmp1 E{(bf16_t*)(ws + L1_H1), (const float*)(ws + WS_CMPB)}; pg8::gemm_phase(F.lds, g, S, E);)
    GRID_BAR(17);
    PH(18, pg8::Gemm g{(const bf16_t*)(ws + L1_H1), (const bf16_t*)(ws + WS_KW2), 8192, 512, 256, 256, 256}; pg8::GroupedOrder S; S.init(32, 16, F.G, F.bid); pg8::EpiCmp2 E{(float*)(ws + L1_CMPO)}; pg8::gemm_phase(F.lds, g, S, E);)
    GRID_BAR(18);
    PH(19, p_cmp_final(F, args, ws);)
    GRID_BAR(19);
    PH(20, p_cmp_attn(F, args, ws);)
    GRID_BAR(20);
    PH(21, if (rep) { p_cmp_attn(F, args, ws); xcd_barrier(xbar); } p_nsa_attn(F, args, ws);)
    GRID_BAR(21);
    PH(22, p_gla_a(F, args, ws); cvt_table_i8(F, args.in[I_L1_U], ws + WS_TAB8U, (float*)(ws + WS_TABSU), 0); cvt_table_fp8(F, args.in[I_L1_V], ws + WS_TAB8V, (float*)(ws + WS_TABSV), 0);)
    GRID_BAR(22);
    PH(23, if (rep) { p_gla_a(F, args, ws); xcd_barrier(xbar); } p_gla_b(F, ws);)
    GRID_BAR(23);
    PH(24, p_gla_c(F, args, ws);)
    GRID_BAR(24);
    PH(25, pg8::Gemm g{(const bf16_t*)(ws + L1_CAT), (const bf16_t*)(ws + WS_W_OUT1), T, 1024, 1024, 1024, 1024}; pg8::StaticOrder S; S.init(T, 1024, F.G, F.bid); pg8::EpiResidF32 E{out, out, 1024}; pg8::gemm_phase(F.lds, g, S, E);)
    GRID_BAR(25);
    PH(26, p_rmsnorm(F, out, args.in[I_L1_FFNN], (bf16_t*)(ws + WS_XN));)
    GRID_BAR(26);
    PH(27, pg8::Gemm g{(const bf16_t*)(ws + WS_XN), (const bf16_t*)(ws + WS_WQ1), T, 2048, 1024, 1024, 1024}; pg8::StaticOrder S; S.init(T, 2048, F.G, F.bid); pg8::EpiStoreBf16 E{(bf16_t*)(ws + PE_Q2), 2048}; pg8::gemm_phase(F.lds, g, S, E);)
    GRID_BAR(27);
    PH(28, p_peer_route(F, ws, (const bf16_t*)(ws + WS_SK1));)
    GRID_BAR(28);
    PH(29, p_peer_expert5(F, ws, out, rep ? 0.f : 1.f, xbar, rep ? TMODE : 0, false);)
#undef IN
#undef BOTH
}

extern "C" void kernel_launch(void* const* d_in, const int* in_sizes, int n_in, void* d_out, int out_size, void* d_ws, size_t ws_size, hipStream_t stream) {
    static int grid = 0;
    if (grid == 0) {
        if (n_in != 39 || ws_size < WS_END) { fprintf(stderr, "kernel_launch: unexpected n_in %d or ws_size %zu (< %zu)\n", n_in, ws_size, (size_t)WS_END); grid = -1; return; }
        int dev = 0, cus = 0, per_cu = 0;
        (void)hipGetDevice(&dev); (void)hipDeviceGetAttribute(&cus, hipDeviceAttributeMultiprocessorCount, dev);
        if (hipFuncSetAttribute((const void*)mk_fwd, hipFuncAttributeMaxDynamicSharedMemorySize, LDS_BYTES) != hipSuccess) { fprintf(stderr, "kernel_launch: hipFuncSetAttribute failed\n"); grid = -1; return; }
        if (hipOccupancyMaxActiveBlocksPerMultiprocessor(&per_cu, (const void*)mk_fwd, NTHREADS, LDS_BYTES) != hipSuccess || per_cu < 1) { fprintf(stderr, "kernel_launch: occupancy query failed (%d)\n", per_cu); (void)hipGetLastError(); grid = -1; return; }
        grid = cus;
    }
    if (grid < 0) return;
    (void)hipMemsetAsync((char*)d_ws + WS_CTL, 0, 1 * MiB, stream);
    Args a{};
    for (int i = 0; i < 39; ++i) a.in[i] = (const float*)d_in[i];
    a.out = (float*)d_out; a.ws = (unsigned char*)d_ws; a.ph_lo = 0; a.ph_hi = 1000;
    void* kargs[] = {&a};
    hipError_t e = hipLaunchCooperativeKernel((const void*)mk_fwd, dim3(grid), dim3(NTHREADS), kargs, LDS_BYTES, stream);
    if (e != hipSuccess) fprintf(stderr, "kernel_launch: cooperative launch failed: %s\n", hipGetErrorString(e));
}
```

```cpp
#include <hip/hip_runtime.h>
#include <hip/hip_cooperative_groups.h>
#include <cstdio>
#include <cstdint>
namespace cg = cooperative_groups;

#define LAS __attribute__((address_space(3)))
typedef unsigned short bf16_t;
typedef short bf16x8 __attribute__((ext_vector_type(8)));
typedef float f32x4 __attribute__((ext_vector_type(4)));
typedef float f32x2 __attribute__((ext_vector_type(2)));
typedef float f32x16 __attribute__((ext_vector_type(16)));
typedef unsigned u32x4 __attribute__((ext_vector_type(4)));
typedef unsigned u32x2 __attribute__((ext_vector_type(2)));
typedef unsigned long long u64;

constexpr int NB = 8, SEQ = 4096, DM = 1024, T = NB * SEQ;
constexpr int NTHREADS = 512, NWAVES = 8;
constexpr int LDS_BYTES = 147456;
constexpr int N_IN0 = 2048, N_IN1 = 3072;
constexpr int C0_Q = 0, C0_K = 512, C0_V = 640, C0_IQ = 768, C0_U = 1280, C0_IK = 1792, C0_IW = 1856;
constexpr int C1_Q = 0, C1_KC = 512, C1_VC = 640, C1_KS = 768, C1_VS = 896, C1_KW = 1024, C1_VW = 1152, C1_GQ = 1280, C1_GK = 1536, C1_GV = 1792, C1_GR = 2304, C1_GL = 2816, C1_GLOW = 2840;

constexpr size_t MiB = 1u << 20;
constexpr size_t WS_CTL = 0;
constexpr size_t WS_ROPE = 1 * MiB;
constexpr size_t WS_W_IN0 = 2 * MiB;
constexpr size_t WS_W_GLU = 6 * MiB;
constexpr size_t WS_SK0 = 6 * MiB + 512 * 1024;
constexpr size_t WS_W_OUT0 = 7 * MiB;
constexpr size_t WS_WQ0 = 9 * MiB;
constexpr size_t WS_W_IN1 = 13 * MiB;
constexpr size_t WS_KW1 = 19 * MiB;
constexpr size_t WS_VW1 = 20 * MiB;
constexpr size_t WS_KW2 = 21 * MiB;
constexpr size_t WS_VW2 = 21 * MiB + 128 * 1024;
constexpr size_t WS_SK1 = 21 * MiB + 512 * 1024;
constexpr size_t WS_W_OUT1 = 22 * MiB;
constexpr size_t WS_WQ1 = 24 * MiB;
constexpr size_t WS_S5B1 = 28 * MiB;
constexpr size_t WS_S5B2 = 32 * MiB;
constexpr size_t WS_CMPB = 38 * MiB;
constexpr size_t WS_TABU = 48 * MiB;
constexpr size_t WS_TABV = 80 * MiB;
constexpr size_t WS_XN = 112 * MiB;
constexpr size_t WS_PROJ = 176 * MiB;
constexpr size_t WS_R3 = 368 * MiB;
constexpr size_t WS_END = 506 * MiB;

__device__ __forceinline__ unsigned f2bf(float f) { unsigned u = __builtin_bit_cast(unsigned, f); return (u + 0x7fffu + ((u >> 16) & 1u)) >> 16; }
__device__ __forceinline__ unsigned pk2(float lo, float hi) { return f2bf(lo) | (f2bf(hi) << 16); }
__device__ __forceinline__ float bf_lo(unsigned u) { return __builtin_bit_cast(float, u << 16); }
__device__ __forceinline__ float bf_hi(unsigned u) { return __builtin_bit_cast(float, u & 0xffff0000u); }
__device__ __forceinline__ float bf2f(bf16_t b) { return __builtin_bit_cast(float, ((unsigned)b) << 16); }
__device__ __forceinline__ float wave_sum(float v) {
#pragma unroll
    for (int o = 1; o < 64; o <<= 1) v += __shfl_xor(v, o);
    return v;
}
__device__ __forceinline__ float gelu_tanh(float x) {
    const float y = 0.7978845608028654f * (x + 0.044715f * x * x * x);
    const float e = __expf(2.0f * y);
    const float th = 1.0f - 2.0f / (e + 1.0f);
    return 0.5f * x * (1.0f + th);
}
__device__ __forceinline__ float sigmoidf_(float x) { return 1.0f / (1.0f + __expf(-x)); }
#define LDS_WAIT() asm volatile("s_waitcnt lgkmcnt(0)" ::: "memory")
#define VM_WAIT() asm volatile("s_waitcnt vmcnt(0)" ::: "memory")

#define XB_TMO      128
#define XB_XCNT(j)  (256  + 64 * (j))
#define XB_XSUB(j)  (1280 + 64 * (j))
#define XB_XGEN(j)  (2304 + 64 * (j))
#define XB_TOP      3328
#define XB_TOPGEN   3392
#define XCD_BAR_WORDS 3456
#define XB_SPIN_CAP (1u << 22)
__device__ __forceinline__ unsigned xb_ld(unsigned* p)              { return __hip_atomic_load(p, __ATOMIC_RELAXED, __HIP_MEMORY_SCOPE_AGENT); }
__device__ __forceinline__ unsigned xb_add(unsigned* p, unsigned v) { return __hip_atomic_fetch_add(p, v, __ATOMIC_RELAXED, __HIP_MEMORY_SCOPE_AGENT); }
__device__ __forceinline__ unsigned xb_xcc_id() { return (unsigned)__builtin_amdgcn_s_getreg((3 << 11) | 20) & 0xFu; }
#define XB_SPIN(cond, bar) do { unsigned _sp = 0; while (cond) { __builtin_amdgcn_s_sleep(1); \
    if ((++_sp & 255u) == 0u) { if (xb_ld(&(bar)[XB_TMO])) break; if (_sp > XB_SPIN_CAP) { atomicAdd(&(bar)[XB_TMO], 1u); break; } } } } while (0)
struct XcdBarrier { unsigned* bar; unsigned x; volatile LAS unsigned* st; };
__device__ __forceinline__ XcdBarrier xcd_barrier_post(unsigned* bar, volatile LAS unsigned* st) {
    XcdBarrier b; b.bar = bar; b.x = xb_xcc_id(); b.st = st;
    if (threadIdx.x == 0) (void)xb_add(&bar[XB_XCNT(b.x)], 1u);
    return b;
}
__device__ __forceinline__ void xcd_barrier_complete(unsigned* bar, unsigned x, unsigned& nloc, unsigned& nx) {
    const unsigned G = gridDim.x * gridDim.y * gridDim.z;
    unsigned sum, cnt, mine, sp = 0u;
    for (;;) {
        sum = 0u; cnt = 0u; mine = 0u;
#pragma unroll
        for (unsigned j = 0; j < 16; ++j) { const unsigned c = xb_ld(&bar[XB_XCNT(j)]); sum += c; cnt += (c > 0u) ? 1u : 0u; mine = (j == x) ? c : mine; }
        if (sum == G) break;
        __builtin_amdgcn_s_sleep(1);
        if ((++sp & 255u) == 0u) { if (xb_ld(&bar[XB_TMO])) break; if (sp > XB_SPIN_CAP) { atomicAdd(&bar[XB_TMO], 1u); break; } }
    }
    nloc = mine > 0u ? mine : 1u; nx = cnt > 0u ? cnt : 1u;
}
__device__ __forceinline__ void xcd_barrier(const XcdBarrier& b) {
    asm volatile("s_waitcnt vmcnt(0)" ::: "memory");
    __syncthreads();
    if (threadIdx.x == 0) {
        unsigned* bar = b.bar;
        __builtin_amdgcn_s_waitcnt(0);
        unsigned nloc = b.st[0], nx = b.st[1];
        if (nloc == 0u) { xcd_barrier_complete(bar, b.x, nloc, nx); b.st[0] = nloc; b.st[1] = nx; }
        const unsigned old = xb_add(&bar[XB_XSUB(b.x)], 1u);
        const unsigned gen = old / nloc;
        if (old + 1u == (gen + 1u) * nloc) {
            __builtin_amdgcn_fence(__ATOMIC_RELEASE, "agent");
            asm volatile("s_waitcnt vmcnt(0)" ::: "memory");
            const unsigned og = xb_add(&bar[XB_TOP], 1u);
            const unsigned tg = og / nx;
            if (og + 1u == (tg + 1u) * nx) xb_add(&bar[XB_TOPGEN], 1u);
            else XB_SPIN(xb_ld(&bar[XB_TOPGEN]) == tg, bar);
            __builtin_amdgcn_fence(__ATOMIC_ACQUIRE, "agent");
            xb_add(&bar[XB_XGEN(b.x)], 1u);
            asm volatile("s_waitcnt vmcnt(0)" ::: "memory");
        } else {
            XB_SPIN(xb_ld(&bar[XB_XGEN(b.x)]) == gen, bar);
            __builtin_amdgcn_fence(__ATOMIC_ACQUIRE, "agent");
            asm volatile("s_waitcnt vmcnt(0)" ::: "memory");
        }
    }
    __syncthreads();
}

namespace pg8 {
constexpr int BM = 256, BK = 64, HALF = 128, HTB = HALF * BK * 2, STAGE_BYTES = 8 * HTB, NXCD = 8, WGM = 8;
__device__ __forceinline__ int lds_byte(int r, int c) { const int st = (r >> 4) * 2 + (c >> 5), rr = r & 15, cc = c & 31, ob = rr * 64 + cc * 2; return st * 1024 + (ob ^ (((ob >> 9) & 1) << 5)); }
__device__ __forceinline__ void stage_rc(int b, int& R, int& C) { const int st = b / 1024, sb = b % 1024, swz = sb ^ (((sb >> 9) & 1) << 5); R = (st >> 1) * 16 + swz / 64; C = (st & 1) * 32 + (swz % 64) / 2; }
__device__ __forceinline__ int perm32(int rho) { const int n = rho >> 4, i = rho & 15; return 8 * (i >> 2) + 4 * n + (i & 3); }
struct Unit { int pm, pn; };
struct Gemm { const bf16_t* A; const bf16_t* Bt; int M, N, K, lda, ldb; };
struct StaticOrder {
    int nM, nN, nwg, G, c;
    __device__ void init(int M, int N, int G_, int c_) { nM = M / BM; nN = N / BM; nwg = nM * nN; G = G_; c = c_; }
    __device__ bool next(int i, Unit& u) const {
        const long L = (long)i * G + c; if (L >= nwg) return false;
        int wgid = (int)L; { const int q = nwg / NXCD, r = nwg % NXCD, xcd = wgid % NXCD, off = wgid / NXCD; wgid = (xcd < r ? xcd * (q + 1) : r * (q + 1) + (xcd - r) * q) + off; }
        const int nig = WGM * nN, gid = wgid / nig, fm = gid * WGM, gsz = (nM - fm) < WGM ? (nM - fm) : WGM;
        u.pm = fm + ((wgid % nig) % gsz); u.pn = (wgid % nig) / gsz; return true;
    }
};
struct GroupedOrder {
    int nwg, G, c, tpg;
    __device__ void init(int ntiles, int tiles_per_group, int G_, int c_) { nwg = ntiles; tpg = tiles_per_group; G = G_; c = c_; }
    __device__ bool next(int i, Unit& u) const { const long L = (long)i * G + c; if (L >= nwg) return false; u.pm = (int)L; u.pn = (int)L / tpg; return true; }
};
__device__ __forceinline__ unsigned cvt_pk_bf16(float lo, float hi) { unsigned r; asm volatile("v_cvt_pk_bf16_f32 %0, %1, %2" : "=v"(r) : "v"(lo), "v"(hi)); return r; }

template <class Epi, class Sched>
__device__ __forceinline__ void gemm_phase(LAS unsigned char* lds, const Gemm g, const Sched& S, const Epi& E) {
    const int tid = threadIdx.x, wid = __builtin_amdgcn_readfirstlane(tid >> 6), lane = tid & 63, wr = wid >> 2, wc = wid & 3, fr = lane & 15, fq = lane >> 4;
    int K = g.K; asm volatile("" : "+s"(K));
    const int nt = K / BK;
    unsigned voffA[2], voffB[2];
#pragma unroll
    for (int i = 0; i < 2; ++i) { int R, C; stage_rc(tid * 16 + i * 8192, R, C); const int Rb = Epi::PERM ? ((R & ~31) + perm32(R & 31)) : R;
        voffA[i] = (unsigned)(R * g.lda + C) * 2u; voffB[i] = (unsigned)(Rb * g.ldb + C) * 2u; }
    const size_t kstep = (size_t)(BK * 2);
    const size_t hstepA = (size_t)HALF * g.lda * 2, hstepB = (size_t)HALF * g.ldb * 2;
    const size_t tstepA = 2 * hstepA, tstepB = 2 * hstepB;
    const unsigned ldsw = (unsigned)wid * 1024u;
    const int aoff = lds_byte(wr * 64 + fr, fq * 8), boff = lds_byte(wc * 32 + fr, fq * 8);
#define PG8_SA(b, h) (((b) * 2 + (h)) * HTB)
#define PG8_SB(b, h) ((4 + (b) * 2 + (h)) * HTB)
#define PG8_STAGE(bufoff, gbase, voff) do { _Pragma("unroll") for (int _i = 0; _i < 2; ++_i) \
        __builtin_amdgcn_global_load_lds((const unsigned*)((const char*)(gbase) + (voff)[_i]), (LAS unsigned*)(lds + (bufoff) + ldsw + _i * 8192), 16, 0, 0); } while (0)
#define PG8_LDA(dst, b, h) do { _Pragma("unroll") for (int m = 0; m < 4; ++m) _Pragma("unroll") for (int k = 0; k < 2; ++k) dst[m][k] = *(const LAS bf16x8*)(lds + PG8_SA(b, h) + aoff + m * 2048 + k * 1024); } while (0)
#define PG8_LDB(dst, b, h) do { _Pragma("unroll") for (int n = 0; n < 2; ++n) _Pragma("unroll") for (int k = 0; k < 2; ++k) dst[n][k] = *(const LAS bf16x8*)(lds + PG8_SB(b, h) + boff + n * 2048 + k * 1024); } while (0)
#define PG8_MMA(ai, bj, At, Bt) do { __builtin_amdgcn_s_setprio(1); _Pragma("unroll") for (int m = 0; m < 4; ++m) _Pragma("unroll") for (int n = 0; n < 2; ++n) _Pragma("unroll") for (int k = 0; k < 2; ++k) \
        acc[ai][bj][m][n] = __builtin_amdgcn_mfma_f32_16x16x32_bf16(Bt[n][k], At[m][k], acc[ai][bj][m][n], 0, 0, 0); __builtin_amdgcn_s_setprio(0); } while (0)
#define PG8_WAIT_V(n) asm volatile("s_waitcnt vmcnt(" #n ")" ::: "memory")
#define PG8_WAIT_L(n) asm volatile("s_waitcnt lgkmcnt(" #n ")" ::: "memory")
#define PG8_BAR __builtin_amdgcn_s_barrier()
#define PG8_SCHED __builtin_amdgcn_sched_barrier(0)
    Unit cur, nxt; int ui = 0;
    if (!S.next(0, cur)) return;
    f32x4 acc[2][2][4][2];
#pragma unroll
    for (int a = 0; a < 2; ++a)
#pragma unroll
        for (int b = 0; b < 2; ++b)
#pragma unroll
            for (int m = 0; m < 4; ++m)
#pragma unroll
                for (int n = 0; n < 2; ++n) acc[a][b][m][n] = (f32x4){0.f, 0.f, 0.f, 0.f};
    bf16x8 At[4][2], B0[2][2], B1[2][2];
    const char* cA = (const char*)g.A + (size_t)cur.pm * tstepA; const char* cB = (const char*)g.Bt + (size_t)cur.pn * tstepB;
    PG8_STAGE(PG8_SB(0, 0), cB, voffB); PG8_STAGE(PG8_SA(0, 0), cA, voffA); PG8_STAGE(PG8_SB(0, 1), cB + hstepB, voffB); PG8_STAGE(PG8_SA(0, 1), cA + hstepA, voffA);
    if (wr == 1) PG8_BAR;
    PG8_WAIT_V(4); PG8_BAR;
    PG8_STAGE(PG8_SB(1, 0), cB + kstep, voffB); PG8_STAGE(PG8_SA(1, 0), cA + kstep, voffA); PG8_STAGE(PG8_SB(1, 1), cB + hstepB + kstep, voffB);
    PG8_WAIT_V(6); PG8_BAR;
    for (;;) {
        const bool has_next = S.next(ui + 1, nxt);
        const char* nA = has_next ? (const char*)g.A + (size_t)nxt.pm * tstepA : cA; const char* nB = has_next ? (const char*)g.Bt + (size_t)nxt.pn * tstepB : cB;
        for (int t = 0; t < nt; t += 2) {
            const bool last = (t == nt - 2);
            const char* a1 = cA + (size_t)(t + 1) * kstep;
            const char* a2 = last ? nA : cA + (size_t)(t + 2) * kstep; const char* b2 = last ? nB : cB + (size_t)(t + 2) * kstep;
            const char* a3 = a2 + kstep; const char* b3 = b2 + kstep;
            PG8_LDB(B0, 0, 0); PG8_SCHED; PG8_LDA(At, 0, 0); PG8_STAGE(PG8_SA(1, 1), a1 + hstepA, voffA);
            PG8_WAIT_L(8); PG8_BAR; PG8_WAIT_L(0); PG8_MMA(0, 0, At, B0); PG8_BAR; PG8_SCHED;
            PG8_LDB(B1, 0, 1); PG8_STAGE(PG8_SB(0, 0), b2, voffB);
            PG8_BAR; PG8_WAIT_L(0); PG8_MMA(0, 1, At, B1); PG8_BAR;
            PG8_LDA(At, 0, 1); PG8_STAGE(PG8_SA(0, 0), a2, voffA);
            PG8_BAR; PG8_WAIT_L(0); PG8_MMA(1, 0, At, B0); PG8_BAR; PG8_SCHED;
            PG8_STAGE(PG8_SB(0, 1), b2 + hstepB, voffB);
            PG8_WAIT_V(6); PG8_BAR; PG8_MMA(1, 1, At, B1); PG8_BAR;
            PG8_LDB(B0, 1, 0); PG8_SCHED; PG8_LDA(At, 1, 0); PG8_STAGE(PG8_SA(0, 1), a2 + hstepA, voffA);
            PG8_WAIT_L(8); PG8_BAR; PG8_WAIT_L(0); PG8_MMA(0, 0, At, B0); PG8_BAR; PG8_SCHED;
            PG8_LDB(B1, 1, 1); PG8_STAGE(PG8_SB(1, 0), b3, voffB);
            PG8_BAR; PG8_WAIT_L(0); PG8_MMA(0, 1, At, B1); PG8_BAR;
            PG8_LDA(At, 1, 1); PG8_STAGE(PG8_SA(1, 0), a3, voffA);
            PG8_BAR; PG8_WAIT_L(0); PG8_MMA(1, 0, At, B0); PG8_BAR; PG8_SCHED;
            PG8_STAGE(PG8_SB(1, 1), b3 + hstepB, voffB);
            PG8_WAIT_V(6); PG8_BAR; PG8_MMA(1, 1, At, B1); PG8_BAR;
        }
        E(acc, cur, wr, wc, fr, fq);
        if (!has_next) break;
#pragma unroll
        for (int a = 0; a < 2; ++a)
#pragma unroll
            for (int b = 0; b < 2; ++b)
#pragma unroll
                for (int m = 0; m < 4; ++m)
#pragma unroll
                    for (int n = 0; n < 2; ++n) acc[a][b][m][n] = (f32x4){0.f, 0.f, 0.f, 0.f};
        cur = nxt; cA = nA; cB = nB; ++ui;
    }
    PG8_WAIT_V(0);
    if (wr == 0) PG8_BAR;
    PG8_BAR;
#undef PG8_SA
#undef PG8_SB
#undef PG8_STAGE
#undef PG8_LDA
#undef PG8_LDB
#undef PG8_MMA
#undef PG8_WAIT_V
#undef PG8_WAIT_L
#undef PG8_BAR
#undef PG8_SCHED
}

struct EpiStoreBf16 {
    static constexpr bool PERM = true;
    bf16_t* O; int ldc;
    __device__ __forceinline__ void operator()(const f32x4 (&acc)[2][2][4][2], const Unit& u, int wr, int wc, int fr, int fq) const {
        const int row0 = u.pm * BM + wr * 64 + fr, col0 = u.pn * BM + wc * 32 + 8 * fq;
#pragma unroll
        for (int ai = 0; ai < 2; ++ai)
#pragma unroll
            for (int m = 0; m < 4; ++m) { bf16_t* rowp = O + (size_t)(row0 + ai * HALF + m * 16) * ldc + col0;
#pragma unroll
                for (int bj = 0; bj < 2; ++bj) { const f32x4 v0 = acc[ai][bj][m][0], v1 = acc[ai][bj][m][1];
                    u32x4 w; w.x = cvt_pk_bf16(v0[0], v0[1]); w.y = cvt_pk_bf16(v0[2], v0[3]); w.z = cvt_pk_bf16(v1[0], v1[1]); w.w = cvt_pk_bf16(v1[2], v1[3]);
                    *(u32x4*)(rowp + bj * HALF) = w; } }
    }
};
struct EpiResidF32 {
    static constexpr bool PERM = false;
    const float* R; float* C; int ldc;
    __device__ __forceinline__ void operator()(const f32x4 (&acc)[2][2][4][2], const Unit& u, int wr, int wc, int fr, int fq) const {
        const int row0 = u.pm * BM + wr * 64 + fr, col0 = u.pn * BM + wc * 32 + 4 * fq;
#pragma unroll
        for (int ai = 0; ai < 2; ++ai)
#pragma unroll
            for (int m = 0; m < 4; ++m) { const size_t off = (size_t)(row0 + ai * HALF + m * 16) * ldc + col0;
#pragma unroll
                for (int bj = 0; bj < 2; ++bj)
#pragma unroll
                    for (int n = 0; n < 2; ++n) { const f32x4 r = *(const f32x4*)(R + off + bj * HALF + n * 16); *(f32x4*)(C + off + bj * HALF + n * 16) = r + acc[ai][bj][m][n]; } }
    }
};
}

struct Args {
    const float* in[39];
    float* out;
    unsigned char* ws;
    int ph_lo, ph_hi;
};
enum { I_X = 0, I_L0_MIXN, I_L0_WIN, I_L0_QG, I_L0_KG, I_L0_LOGDT, I_L0_ARE, I_L0_AIM, I_L0_BRE, I_L0_BIM, I_L0_CRE, I_L0_CIM, I_L0_D, I_L0_WGLU, I_L0_BGLU, I_L0_WOUT,
       I_L0_FFNN, I_L0_WQ, I_L0_SK, I_L0_U, I_L0_V,
       I_L1_MIXN, I_L1_WIN, I_L1_QG, I_L1_KG, I_L1_CMPPOS, I_L1_KW1, I_L1_KW2, I_L1_VW1, I_L1_VW2, I_L1_WGATE, I_L1_BGATE, I_L1_OGAIN, I_L1_WOUT,
       I_L1_FFNN, I_L1_WQ, I_L1_SK, I_L1_U, I_L1_V };

struct Frame {
    LAS unsigned char* lds;
    int tid, lane, wave, G, bid;
};

constexpr size_t L0_QA = WS_R3;
constexpr size_t L0_IQ = WS_R3 + 32 * MiB;
constexpr size_t L0_KA = WS_R3 + 64 * MiB;
constexpr size_t L0_VAT = WS_R3 + 72 * MiB;
constexpr size_t L0_IK = WS_R3 + 80 * MiB;
constexpr size_t L0_IW = WS_R3 + 84 * MiB;
constexpr size_t L0_UA = WS_R3 + 88 * MiB;
constexpr size_t L0_SELT = WS_PROJ;
constexpr size_t L0_CAT = WS_PROJ + 16 * MiB;
constexpr size_t L0_SLOC = WS_PROJ + 80 * MiB;
constexpr size_t L0_YB = WS_PROJ + 112 * MiB;
constexpr size_t PE_Q2 = WS_PROJ;
constexpr size_t PE_EID = WS_PROJ + 128 * MiB;
constexpr size_t PE_GATE = WS_PROJ + 136 * MiB;

template <class Map>
__device__ __forceinline__ void transpose_item(const float* W, int K, int N, bf16_t* WT, int ldk, LAS float* scr, int item, int lane, const Map& map) {
    const int nblk = (N + 31) / 32, kb = item / nblk, nb = item % nblk, k0 = 64 * kb, n0 = 32 * nb;
    const int ncol = n0 + (lane & 31);
#pragma unroll 8
    for (int i = 0; i < 32; ++i) { const int kk = 2 * i + (lane >> 5); scr[kk * 33 + (lane & 31)] = (ncol < N) ? W[(size_t)(k0 + kk) * N + ncol] : 0.f; }
    LDS_WAIT(); asm volatile("" ::: "memory");
    const int c = lane & 7;
#pragma unroll
    for (int j = 0; j < 4; ++j) { const int n = (lane >> 3) + 8 * j; const LAS float* s = scr + (8 * c) * 33 + n;
        u32x4 o; o.x = pk2(s[0 * 33], s[1 * 33]); o.y = pk2(s[2 * 33], s[3 * 33]); o.z = pk2(s[4 * 33], s[5 * 33]); o.w = pk2(s[6 * 33], s[7 * 33]);
        if (n0 + n < N) *(u32x4*)(WT + (size_t)map(n0 + n) * ldk + k0 + 8 * c) = o; }
    LDS_WAIT(); asm volatile("" ::: "memory");
}
struct MapId { __device__ __forceinline__ int operator()(int n) const { return n; } };
struct MapIn0 { __device__ __forceinline__ int operator()(int n) const { return n < 1280 ? n : (n < 1344 ? n - 1280 + C0_IK : (n < 1352 ? n - 1344 + C0_IW : n - 1352 + C0_U)); } };
struct MapIn1 { __device__ __forceinline__ int operator()(int n) const {
    if (n < 1280) return n; if (n < 1304) return n - 1280 + C1_GL; if (n < 1560) return n - 1304 + C1_GQ; if (n < 1816) return n - 1560 + C1_GK;
    if (n < 2328) return n - 1816 + C1_GV; if (n < 2344) return n - 2328 + C1_GLOW; return n - 2344 + C1_GR; } };

template <class Map>
__device__ __forceinline__ void transpose_all(const Frame& F, int& base, const float* W, int K, int N, bf16_t* WT, int ldk, const Map& map) {
    LAS float* scr = (LAS float*)(F.lds + F.wave * 16384);
    const int gw = F.bid * NWAVES + F.wave, NGW = F.G * NWAVES;
    const int nit = (K / 64) * ((N + 31) / 32);
    for (int it = (gw + NGW - (base % NGW)) % NGW; it < nit; it += NGW) transpose_item(W, K, N, WT, ldk, scr, it, F.lane, map);
    base += nit;
}
__device__ __forceinline__ void zero_bytes(const Frame& F, unsigned char* p, size_t nbytes) {
    const size_t n16 = nbytes / 16;
    for (size_t i = (size_t)F.bid * NTHREADS + F.tid; i < n16; i += (size_t)F.G * NTHREADS) ((u32x4*)p)[i] = (u32x4){0u, 0u, 0u, 0u};
}
__device__ __forceinline__ void cvt_f32_bf16(const Frame& F, const float* src, bf16_t* dst, size_t n) {
    const size_t n8 = n / 8;
    for (size_t i = (size_t)F.bid * NTHREADS + F.tid; i < n8; i += (size_t)F.G * NTHREADS) {
        const f32x4 a = ((const f32x4*)src)[2 * i], b = ((const f32x4*)src)[2 * i + 1];
        u32x4 o; o.x = pk2(a.x, a.y); o.y = pk2(a.z, a.w); o.z = pk2(b.x, b.y); o.w = pk2(b.z, b.w);
        ((u32x4*)dst)[i] = o;
    }
}

__device__ __forceinline__ void rms_row_to_bf16(const float* xrow, const float* gain, bf16_t* orow, int lane) {
    const f32x4* xr = (const f32x4*)xrow + lane; const f32x4* gr = (const f32x4*)gain + lane;
    f32x4 v[4]; float s = 0.f;
#pragma unroll
    for (int j = 0; j < 4; ++j) { v[j] = xr[64 * j]; s += (v[j].x * v[j].x + v[j].y * v[j].y) + (v[j].z * v[j].z + v[j].w * v[j].w); }
    const float rstd = 1.0f / sqrtf(wave_sum(s) * (1.f / DM) + 1e-6f);
    u64* o8 = (u64*)orow + lane;
#pragma unroll
    for (int j = 0; j < 4; ++j) { const f32x4 g4 = gr[64 * j]; o8[64 * j] = (u64)pk2(v[j].x * rstd * g4.x, v[j].y * rstd * g4.y) | ((u64)pk2(v[j].z * rstd * g4.z, v[j].w * rstd * g4.w) << 32); }
}
__device__ __forceinline__ void p_rmsnorm(const Frame& F, const float* x, const float* gain, bf16_t* XN) {
    const int gw = F.bid * NWAVES + F.wave, NGW = F.G * NWAVES;
    for (int m = gw; m < T; m += NGW) rms_row_to_bf16(x + (size_t)m * DM, gain, XN + (size_t)m * DM, F.lane);
}

__device__ __forceinline__ void p_rope_table(const Frame& F, f32x2* rope) {
    for (int i = F.bid * NTHREADS + F.tid; i < SEQ * 32; i += F.G * NTHREADS) {
        const int pos = i >> 5, k = i & 31;
        const float inv = powf(10000.0f, -(float)k / 32.0f);
        const float ang = (float)pos * inv;
        float s, c; sincosf(ang, &s, &c);
        rope[i] = (f32x2){c, s};
    }
}

__device__ __forceinline__ void s5_build_group(const Frame& F, const Args& a, unsigned char* ws, int g) {
    LAS f32x2* abp = (LAS f32x2*)F.lds;
    LAS f32x2* bb = abp + 17 * 64;
    LAS f32x2* Cc = bb + 64 * 16;
    LAS float* KT = (LAS float*)(Cc + 16 * 64);
    const float dt = expf(a.in[I_L0_LOGDT][g]);
    for (int idx = F.tid; idx < 17 * 64; idx += NTHREADS) {
        const int tau = idx >> 6, p = idx & 63;
        const float lr = a.in[I_L0_ARE][g * 64 + p], li = a.in[I_L0_AIM][g * 64 + p];
        const float mag = expf((float)tau * dt * lr); float s, c; sincosf((float)tau * dt * li, &s, &c);
        abp[idx] = (f32x2){mag * c, mag * s};
    }
    for (int idx = F.tid; idx < 64 * 16; idx += NTHREADS) {
        const int p = idx >> 4, c = idx & 15;
        const float lr = a.in[I_L0_ARE][g * 64 + p], li = a.in[I_L0_AIM][g * 64 + p];
        const float mag = expf(dt * lr); float s, co; sincosf(dt * li, &s, &co);
        const float abr = mag * co, abi = mag * s, den = lr * lr + li * li;
        const float fr = ((abr - 1.0f) * lr + abi * li) / den, fi = (abi * lr - (abr - 1.0f) * li) / den;
        const float br = a.in[I_L0_BRE][(size_t)(g * 64 + p) * 16 + c], bi = a.in[I_L0_BIM][(size_t)(g * 64 + p) * 16 + c];
        bb[idx] = (f32x2){fr * br - fi * bi, fr * bi + fi * br};
    }
    for (int idx = F.tid; idx < 16 * 64; idx += NTHREADS) Cc[idx] = (f32x2){a.in[I_L0_CRE][(size_t)g * 1024 + idx], a.in[I_L0_CIM][(size_t)g * 1024 + idx]};
    __syncthreads();
    for (int idx = F.tid; idx < 16 * 256; idx += NTHREADS) {
        const int tau = idx >> 8, co = (idx >> 4) & 15, ci = idx & 15;
        float acc = 0.f;
        for (int p = 0; p < 64; ++p) {
            const f32x2 c = Cc[co * 64 + p], e = abp[tau * 64 + p], b = bb[p * 16 + ci];
            const float er = c.x * e.x - c.y * e.y, ei = c.x * e.y + c.y * e.x;
            acc += er * b.x - ei * b.y;
        }
        if (tau == 0 && co == ci) acc += a.in[I_L0_D][g * 16 + co];
        KT[idx] = acc;
    }
    __syncthreads();
    bf16_t* B1 = (bf16_t*)(ws + WS_S5B1) + (size_t)g * 256 * 256;
    bf16_t* B2 = (bf16_t*)(ws + WS_S5B2) + (size_t)g * 256 * 384;
    for (int idx = F.tid; idx < 256 * 128; idx += NTHREADS) {
        const int n = idx >> 7, k = (idx & 127) * 2;
        float v0 = 0.f, v1 = 0.f;
        if (n < 128) { const int p = n & 63, j = k >> 4, ci = k & 15; const f32x2 e = abp[(15 - j) * 64 + p], b0 = bb[p * 16 + ci], b1 = bb[p * 16 + ci + 1];
            if (n < 64) { v0 = e.x * b0.x - e.y * b0.y; v1 = e.x * b1.x - e.y * b1.y; } else { v0 = e.x * b0.y + e.y * b0.x; v1 = e.x * b1.y + e.y * b1.x; } }
        *(unsigned*)(B1 + (size_t)n * 256 + k) = pk2(v0, v1);
    }
    for (int idx = F.tid; idx < 256 * 192; idx += NTHREADS) {
        const int n = idx / 192, k = (idx % 192) * 2, i = n >> 4, co = n & 15;
        float v0 = 0.f, v1 = 0.f;
        if (k < 256) { const int j = k >> 4, ci = k & 15; if (j <= i) { v0 = KT[((i - j) * 16 + co) * 16 + ci]; v1 = KT[((i - j) * 16 + co) * 16 + ci + 1]; } }
        else { const int p = (k - 256) & 63; const bool im = k >= 320;
            const f32x2 c0 = Cc[co * 64 + p], e0 = abp[(i + 1) * 64 + p], c1 = Cc[co * 64 + p + 1], e1 = abp[(i + 1) * 64 + p + 1];
            if (!im) { v0 = c0.x * e0.x - c0.y * e0.y; v1 = c1.x * e1.x - c1.y * e1.y; } else { v0 = -(c0.x * e0.y + c0.y * e0.x); v1 = -(c1.x * e1.y + c1.y * e1.x); } }
        *(unsigned*)(B2 + (size_t)n * 384 + k) = pk2(v0, v1);
    }
    __syncthreads();
}

__device__ __forceinline__ void cmp_bias(const Frame& F, const Args& a, float* out, int j) {
    const int w = j >> 5, n0 = (j & 31) * 8;
    const float* w1 = a.in[w ? I_L1_VW1 : I_L1_KW1]; const float* pos = a.in[I_L1_CMPPOS];
    LAS float* red = (LAS float*)(F.lds + 65536);
    float acc[8];
#pragma unroll
    for (int i = 0; i < 8; ++i) acc[i] = 0.f;
#pragma unroll
    for (int kk = 0; kk < 4; ++kk) { const int k = F.tid * 4 + kk; const float p = pos[k];
        const f32x4 wa = *(const f32x4*)(w1 + (size_t)k * 256 + n0), wb = *(const f32x4*)(w1 + (size_t)k * 256 + n0 + 4);
        acc[0] += p * wa.x; acc[1] += p * wa.y; acc[2] += p * wa.z; acc[3] += p * wa.w; acc[4] += p * wb.x; acc[5] += p * wb.y; acc[6] += p * wb.z; acc[7] += p * wb.w; }
#pragma unroll
    for (int i = 0; i < 8; ++i) { const float sv = wave_sum(acc[i]); if (F.lane == 0) red[F.wave * 8 + i] = sv; }
    __syncthreads();
    if (F.tid < 8) { float t = 0.f; for (int wv = 0; wv < 8; ++wv) t += red[wv * 8 + F.tid]; out[w * 256 + n0 + F.tid] = t; }
    __syncthreads();
}

__device__ __forceinline__ float rope_apply(float v, const f32x2 cs, int lane) {
    const float partner = __shfl_xor(v, 32);
    return lane < 32 ? v * cs.x - partner * cs.y : partner * cs.y + v * cs.x;
}
__device__ __forceinline__ void head8_load(const bf16_t* p, float (&v)[8]) {
    const u32x4 q = *(const u32x4*)p;
    v[0] = bf_lo(q.x); v[1] = bf_hi(q.x); v[2] = bf_lo(q.y); v[3] = bf_hi(q.y); v[4] = bf_lo(q.z); v[5] = bf_hi(q.z); v[6] = bf_lo(q.w); v[7] = bf_hi(q.w);
}
__device__ __forceinline__ void head8_store(bf16_t* p, const float (&v)[8], const float sc) {
    u32x4 q; q.x = pk2(v[0] * sc, v[1] * sc); q.y = pk2(v[2] * sc, v[3] * sc); q.z = pk2(v[4] * sc, v[5] * sc); q.w = pk2(v[6] * sc, v[7] * sc);
    *(u32x4*)p = q;
}
__device__ __forceinline__ void head8_norm(float (&v)[8], const float (&g)[8]) {
    float ss = 0.f;
#pragma unroll
    for (int j = 0; j < 8; ++j) ss += v[j] * v[j];
    ss += __shfl_xor(ss, 1); ss += __shfl_xor(ss, 2); ss += __shfl_xor(ss, 4);
    const float r = 1.0f / sqrtf(ss * (1.f / 64.f) + 1e-6f);
#pragma unroll
    for (int j = 0; j < 8; ++j) v[j] = v[j] * r * g[j];
}
__device__ __forceinline__ void head8_rope(float (&v)[8], const f32x2 (&cs)[8], const bool upper) {
#pragma unroll
    for (int j = 0; j < 8; ++j) { const float partner = __shfl_xor(v[j], 4); v[j] = upper ? partner * cs[j].y + v[j] * cs[j].x : v[j] * cs[j].x - partner * cs[j].y; }
}
__device__ __forceinline__ void p_l0_prep(const Frame& F, const Args& a, unsigned char* ws) {
    const bf16_t* P = (const bf16_t*)(ws + WS_PROJ);
    const f32x2* rope = (const f32x2*)(ws + WS_ROPE);
    bf16_t* QA = (bf16_t*)(ws + L0_QA); bf16_t* IQ = (bf16_t*)(ws + L0_IQ); bf16_t* KA = (bf16_t*)(ws + L0_KA); bf16_t* VAT = (bf16_t*)(ws + L0_VAT);
    bf16_t* IK = (bf16_t*)(ws + L0_IK); float* IW = (float*)(ws + L0_IW); bf16_t* UA = (bf16_t*)(ws + L0_UA);
    const int gw = F.bid * NWAVES + F.wave, NGW = F.G * NWAVES, lane = F.lane, hs = lane >> 3, sub = lane & 7;
    float qg[8], kg[8];
#pragma unroll
    for (int j = 0; j < 8; ++j) { qg[j] = a.in[I_L0_QG][sub * 8 + j]; kg[j] = a.in[I_L0_KG][sub * 8 + j]; }
    for (int m = gw; m < T; m += NGW) {
        const int b = m >> 12, t = m & 4095;
        const bf16_t* row = P + (size_t)m * N_IN0;
        f32x2 cs[8];
#pragma unroll
        for (int j = 0; j < 4; ++j) { const f32x4 c4 = *(const f32x4*)(rope + t * 32 + (sub & 3) * 8 + 2 * j); cs[2 * j] = (f32x2){c4.x, c4.y}; cs[2 * j + 1] = (f32x2){c4.z, c4.w}; }
        float v[8];
        head8_load(row + C0_Q + lane * 8, v); head8_norm(v, qg); head8_rope(v, cs, sub >= 4); head8_store(QA + (size_t)m * 512 + lane * 8, v, 0.125f);
        head8_load(row + C0_IQ + lane * 8, v); head8_rope(v, cs, sub >= 4); head8_store(IQ + (size_t)m * 512 + lane * 8, v, 0.125f);
        {
            const int hh = hs < 3 ? hs : 2;
            head8_load(row + (hh < 2 ? C0_K + hh * 64 : C0_IK) + sub * 8, v);
            float vn[8];
#pragma unroll
            for (int j = 0; j < 8; ++j) vn[j] = v[j];
            head8_norm(vn, kg);
#pragma unroll
            for (int j = 0; j < 8; ++j) v[j] = (hh < 2) ? vn[j] : v[j];
            head8_rope(v, cs, sub >= 4);
            if (hs < 2) head8_store(KA + ((size_t)(b * 2 + hs) * 4096 + t) * 64 + sub * 8, v, 1.0f);
            else if (hs == 2) head8_store(IK + (size_t)m * 64 + sub * 8, v, 1.0f);
        }
        if (lane < 8) IW[(size_t)m * 8 + lane] = bf2f(row[C0_IW + lane]) * 0.35355339059327373f;
        { const u32x4 uv = *(const u32x4*)(row + C0_U + lane * 8); const int g = lane >> 1;
          *(u32x4*)(UA + ((size_t)g * 2048 + (m >> 4)) * 384 + (m & 15) * 16 + (lane & 1) * 8) = uv; }
    }
    for (int it = gw; it < NB * 2 * 64; it += NGW) {
        const int tb = it & 63, g = (it >> 6) & 1, b = it >> 7;
        const size_t m = (size_t)b * 4096 + tb * 64 + lane;
        unsigned r[32];
#pragma unroll
        for (int j = 0; j < 8; ++j) { const u32x4 q = *(const u32x4*)(P + m * N_IN0 + C0_V + g * 64 + j * 8); r[4 * j] = q.x; r[4 * j + 1] = q.y; r[4 * j + 2] = q.z; r[4 * j + 3] = q.w; }
        bf16_t* dst = VAT + ((size_t)(b * 2 + g) * 64) * 4096 + tb * 64 + lane;
#pragma unroll
        for (int d = 0; d < 64; ++d) dst[(size_t)d * 4096] = (bf16_t)((d & 1) ? (r[d >> 1] >> 16) : (r[d >> 1] & 0xffffu));
    }
}

__device__ __forceinline__ unsigned f16key(unsigned raw) { return (raw & 0x8000u) ? (~raw & 0xFFFFu) : (raw | 0x8000u); }
template <int NREG>
__device__ __forceinline__ int topk_count_ge(const unsigned (&kk)[NREG], const unsigned cm1pk) {
    unsigned acc = 0u; const unsigned ones = 0x00010001u;
#pragma unroll
    for (int jj = 0; jj < NREG; ++jj) {
        unsigned d;
        asm("v_pk_sub_u16 %0, %1, %2 clamp" : "=v"(d) : "v"(kk[jj]), "v"(cm1pk));
        asm("v_pk_min_u16 %0, %1, %2" : "=v"(d) : "v"(d), "v"(ones));
        asm("v_pk_add_u16 %0, %1, %2" : "=v"(acc) : "v"(acc), "v"(d));
    }
    int c = (int)((acc & 0xffffu) + (acc >> 16));
    c += __builtin_amdgcn_update_dpp(0, c, 0xB1, 0xF, 0xF, true);
    c += __builtin_amdgcn_update_dpp(0, c, 0x4E, 0xF, 0xF, true);
    c += __builtin_amdgcn_update_dpp(0, c, 0x141, 0xF, 0xF, true);
    c += __builtin_amdgcn_update_dpp(0, c, 0x140, 0xF, 0xF, true);
    return __builtin_amdgcn_readlane(c, 0) + __builtin_amdgcn_readlane(c, 16) + __builtin_amdgcn_readlane(c, 32) + __builtin_amdgcn_readlane(c, 48);
}
template <int NREG>
__device__ __forceinline__ u64 topk_query(const LAS unsigned short* scq, const int t, const int lane) {
    unsigned kk[NREG];
#pragma unroll
    for (int jj = 0; jj < NREG; ++jj) {
        const int e0 = (2 * jj) * 64 + lane, e1 = e0 + 64;
        const unsigned r0 = scq[e0], r1 = scq[e1];
        kk[jj] = ((e0 <= t) ? f16key(r0) : 0u) | (((e1 <= t) ? f16key(r1) : 0u) << 16);
        if ((jj & 3) == 3) __builtin_amdgcn_sched_barrier(0);
    }
    unsigned prefix = 0u; bool exact = false;
#pragma unroll 1
    for (int bit = 15; bit >= 0; --bit) {
        const unsigned cand = prefix | (1u << bit), cm1 = cand - 1u;
        const int cnt = topk_count_ge<NREG>(kk, cm1 | (cm1 << 16));
        if (cnt >= 256) prefix = cand;
        if (cnt == 256) { exact = true; break; }
    }
    unsigned mylo = 0u, myhi = 0u;
    if (exact) {
#pragma unroll
        for (int i = 0; i < 2 * NREG; ++i) {
            const unsigned k = (i & 1) ? (kk[i >> 1] >> 16) : (kk[i >> 1] & 0xffffu);
            const u64 w = __ballot(k >= prefix);
            asm("s_nop 4\n\tv_writelane_b32 %0, %2, %4\n\tv_writelane_b32 %1, %3, %4" : "+v"(mylo), "+v"(myhi) : "s"((unsigned)w), "s"((unsigned)(w >> 32)), "n"(i));
        }
    } else {
        const unsigned Tk = prefix;
        const int cgt = (Tk >= 0xFFFFu) ? 0 : topk_count_ge<NREG>(kk, Tk | (Tk << 16));
        const int need = 256 - cgt;
        int run = 0;
#pragma unroll
        for (int i = 0; i < 2 * NREG; ++i) {
            const unsigned k = (i & 1) ? (kk[i >> 1] >> 16) : (kk[i >> 1] & 0xffffu);
            const u64 gt = __ballot(k > Tk); u64 eq = __ballot(k == Tk);
            const int pe = __builtin_popcountll(eq);
            if (run + pe > need) { int kq = need - run; kq = kq < 0 ? 0 : kq;
                const bool keep = ((eq >> lane) & 1ull) && (__builtin_popcountll(eq & ((1ull << lane) - 1ull)) < kq); eq = __ballot(keep); }
            run += pe;
            const u64 w = gt | eq;
            asm("s_nop 4\n\tv_writelane_b32 %0, %2, %4\n\tv_writelane_b32 %1, %3, %4" : "+v"(mylo), "+v"(myhi) : "s"((unsigned)w), "s"((unsigned)(w >> 32)), "n"(i));
        }
    }
    return (u64)mylo | ((u64)myhi << 32);
}
__device__ __forceinline__ void p_dsa_index(const Frame& F, unsigned char* ws, u64* SELT, const int mode) {
    const bf16_t* IQ = (const bf16_t*)(ws + L0_IQ); const bf16_t* IK = (const bf16_t*)(ws + L0_IK); const float* IW = (const float*)(ws + L0_IW);
    LAS _Float16* sc = (LAS _Float16*)F.lds;
    LAS unsigned short* scu = (LAS unsigned short*)F.lds;
    LAS u64* mk = (LAS u64*)(F.lds + 131072);
    LAS float* wl = (LAS float*)(F.lds + 131072 + 8192);
    const int lane = F.lane, wave = F.wave, h = lane >> 5, r = lane & 31;
    const int rq = ((r >> 4) & 1) + 2 * ((r >> 2) & 1), rh = 4 * ((r >> 3) & 1) + (r & 3);
    for (int u = F.bid; u < 2048; u += F.G) {
        const int idx = u & 255, b = u >> 8;
        const int j = (b & 1) ? 255 - idx : idx;
        const int t0 = j * 16; const size_t mb = (size_t)b * 4096;
        if (F.tid < 128) wl[F.tid] = IW[(mb + t0) * 8 + F.tid];
        const int nkb = (t0 + 15) / 32 + 1;
        bf16x8 Af[4][4];
#pragma unroll
        for (int rt = 0; rt < 4; ++rt)
#pragma unroll
            for (int ks = 0; ks < 4; ++ks) Af[rt][ks] = *(const bf16x8*)(IQ + (mb + t0 + 4 * rt + rq) * 512 + rh * 64 + ks * 16 + 8 * h);
        __syncthreads();
        if (mode != 2) for (int kb = wave; kb < nkb; kb += NWAVES) {
            bf16x8 Bf[4];
#pragma unroll
            for (int ks = 0; ks < 4; ++ks) Bf[ks] = *(const bf16x8*)(IK + (mb + kb * 32 + r) * 64 + ks * 16 + 8 * h);
#pragma unroll
            for (int rt = 0; rt < 4; ++rt) {
                f32x16 acc = {0.f, 0.f, 0.f, 0.f, 0.f, 0.f, 0.f, 0.f, 0.f, 0.f, 0.f, 0.f, 0.f, 0.f, 0.f, 0.f};
#pragma unroll
                for (int ks = 0; ks < 4; ++ks) acc = __builtin_amdgcn_mfma_f32_32x32x16_bf16(Af[rt][ks], Bf[ks], acc, 0, 0, 0);
                const int qa = 4 * rt + 2 * h;
                const f32x4 wa0 = *(const LAS f32x4*)(wl + qa * 8), wa1 = *(const LAS f32x4*)(wl + qa * 8 + 4), wb0 = *(const LAS f32x4*)(wl + qa * 8 + 8), wb1 = *(const LAS f32x4*)(wl + qa * 8 + 12);
                float sa = 0.f, sb = 0.f;
#pragma unroll
                for (int i = 0; i < 4; ++i) { sa += wa0[i] * fmaxf(acc[i], 0.f); sa += wa1[i] * fmaxf(acc[4 + i], 0.f); sb += wb0[i] * fmaxf(acc[8 + i], 0.f); sb += wb1[i] * fmaxf(acc[12 + i], 0.f); }
                sc[qa * 4096 + kb * 32 + r] = (_Float16)sa;
                sc[(qa + 1) * 4096 + kb * 32 + r] = (_Float16)sb;
                __builtin_amdgcn_sched_barrier(0);
            }
        }
        __syncthreads();
#pragma unroll 1
        for (int qq = 0; qq < (mode == 1 ? 0 : 2); ++qq) {
            const int q = wave * 2 + qq, t = t0 + q, n = t + 1;
            unsigned mylo = 0u, myhi = 0u;
            if (n <= 256) {
                const int base = lane * 64;
                const u64 word = (base + 63 <= t) ? ~0ull : (base > t ? 0ull : ((1ull << (t - base + 1)) - 1ull));
                mylo = (unsigned)word; myhi = (unsigned)(word >> 32);
            } else {
                const int nreg = (((n + 63) >> 6) + 1) >> 1;
                const LAS unsigned short* scq = scu + q * 4096;
                u64 w;
                if (nreg <= 4) w = topk_query<4>(scq, t, lane);
                else if (nreg <= 8) w = topk_query<8>(scq, t, lane);
                else if (nreg <= 12) w = topk_query<12>(scq, t, lane);
                else if (nreg <= 16) w = topk_query<16>(scq, t, lane);
                else if (nreg <= 20) w = topk_query<20>(scq, t, lane);
                else if (nreg <= 24) w = topk_query<24>(scq, t, lane);
                else if (nreg <= 28) w = topk_query<28>(scq, t, lane);
                else w = topk_query<32>(scq, t, lane);
                mylo = (unsigned)w; myhi = (unsigned)(w >> 32);
            }
            mk[lane * 16 + q] = (u64)mylo | ((u64)myhi << 32);
        }
        __syncthreads();
        { const int w = F.tid >> 3, part = F.tid & 7;
          u64* dst = SELT + ((size_t)(b * 64 + w) * 4096) + t0 + part * 2;
          dst[0] = mk[w * 16 + part * 2]; dst[1] = mk[w * 16 + part * 2 + 1]; }
        __syncthreads();
    }
}

constexpr int AT_KB = 9216, AT_VB = 8704, AT_BUF = AT_KB + AT_VB;
struct AttStage { u32x4 kreg, vreg; };
__device__ __forceinline__ void att_load(AttStage& s, const bf16_t* Kg, const bf16_t* Vtg, int key0, int tid) {
    s.kreg = *(const u32x4*)(Kg + (size_t)(key0 + (tid >> 3)) * 64 + (tid & 7) * 8);
    s.vreg = *(const u32x4*)(Vtg + (size_t)(tid >> 3) * 4096 + key0 + (tid & 7) * 8);
}
__device__ __forceinline__ void att_store(const AttStage& s, LAS unsigned char* buf, int tid) {
    *(LAS u32x4*)(buf + (tid >> 3) * 144 + (tid & 7) * 16) = s.kreg;
    LAS unsigned char* v = buf + AT_KB + (tid >> 3) * 136 + (tid & 7) * 16;
    *(LAS u32x2*)(v) = (u32x2){s.vreg.x, s.vreg.y}; *(LAS u32x2*)(v + 8) = (u32x2){s.vreg.z, s.vreg.w};
}
__device__ __forceinline__ bf16x8 pack8(float a0, float a1, float a2, float a3, float a4, float a5, float a6, float a7) {
    u32x4 w; w.x = pg8::cvt_pk_bf16(a0, a1); w.y = pg8::cvt_pk_bf16(a2, a3); w.z = pg8::cvt_pk_bf16(a4, a5); w.w = pg8::cvt_pk_bf16(a6, a7);
    return __builtin_bit_cast(bf16x8, w);
}
__device__ __forceinline__ f32x16 att_qk(const LAS unsigned char* buf, int sub, const bf16x8 (&Qf)[4], int lane) {
    f32x16 S = {0.f, 0.f, 0.f, 0.f, 0.f, 0.f, 0.f, 0.f, 0.f, 0.f, 0.f, 0.f, 0.f, 0.f, 0.f, 0.f};
    const LAS unsigned char* kp = buf + (sub * 32 + (lane & 31)) * 144 + (lane >> 5) * 16;
#pragma unroll
    for (int ks = 0; ks < 4; ++ks) { const bf16x8 kf = *(const LAS bf16x8*)(kp + ks * 32); S = __builtin_amdgcn_mfma_f32_32x32x16_bf16(kf, Qf[ks], S, 0, 0, 0); }
    return S;
}
__device__ __forceinline__ void att_pv2(const LAS unsigned char* buf, int sub, const bf16x8 P0, const bf16x8 P1, f32x16 (&O)[2], int lane) {
    const int h = lane >> 5;
#pragma unroll
    for (int dt = 0; dt < 2; ++dt) {
        const LAS unsigned char* vp = buf + AT_KB + (dt * 32 + (lane & 31)) * 136 + (sub * 32 + 4 * h) * 2;
        const u32x2 a0 = *(const LAS u32x2*)(vp), a1 = *(const LAS u32x2*)(vp + 16), b0 = *(const LAS u32x2*)(vp + 32), b1 = *(const LAS u32x2*)(vp + 48);
        const bf16x8 V0 = __builtin_bit_cast(bf16x8, ((u32x4){a0.x, a0.y, a1.x, a1.y}));
        const bf16x8 V1 = __builtin_bit_cast(bf16x8, ((u32x4){b0.x, b0.y, b1.x, b1.y}));
        O[dt] = __builtin_amdgcn_mfma_f32_32x32x16_bf16(V0, P0, O[dt], 0, 0, 0);
        O[dt] = __builtin_amdgcn_mfma_f32_32x32x16_bf16(V1, P1, O[dt], 0, 0, 0);
    }
}
__device__ __forceinline__ void att_pv(const LAS unsigned char* buf, int sub, const float (&p)[16], f32x16 (&O)[2], int lane) {
    const bf16x8 P0 = pack8(p[0], p[1], p[2], p[3], p[4], p[5], p[6], p[7]);
    const bf16x8 P1 = pack8(p[8], p[9], p[10], p[11], p[12], p[13], p[14], p[15]);
    att_pv2(buf, sub, P0, P1, O, lane);
}

__device__ __forceinline__ void att_kfrags(const LAS unsigned char* buf, int sub, bf16x8 (&Kf)[4], int lane) {
    const LAS unsigned char* kp = buf + (sub * 32 + (lane & 31)) * 144 + (lane >> 5) * 16;
#pragma unroll
    for (int ks = 0; ks < 4; ++ks) Kf[ks] = *(const LAS bf16x8*)(kp + ks * 32);
}
__device__ __forceinline__ void att_vfrags(const LAS unsigned char* buf, int sub, bf16x8 (&Vf)[2][2], int lane) {
    const int h = lane >> 5;
#pragma unroll
    for (int dt = 0; dt < 2; ++dt) {
        const LAS unsigned char* vp = buf + AT_KB + (dt * 32 + (lane & 31)) * 136 + (sub * 32 + 4 * h) * 2;
        const u32x2 a0 = *(const LAS u32x2*)(vp), a1 = *(const LAS u32x2*)(vp + 16), b0 = *(const LAS u32x2*)(vp + 32), b1 = *(const LAS u32x2*)(vp + 48);
        Vf[dt][0] = __builtin_bit_cast(bf16x8, ((u32x4){a0.x, a0.y, a1.x, a1.y}));
        Vf[dt][1] = __builtin_bit_cast(bf16x8, ((u32x4){b0.x, b0.y, b1.x, b1.y}));
    }
}
__device__ __forceinline__ f32x16 att_qk_f(const bf16x8 (&Kf)[4], const bf16x8 (&Qf)[4]) {
    f32x16 S = {0.f, 0.f, 0.f, 0.f, 0.f, 0.f, 0.f, 0.f, 0.f, 0.f, 0.f, 0.f, 0.f, 0.f, 0.f, 0.f};
#pragma unroll
    for (int ks = 0; ks < 4; ++ks) S = __builtin_amdgcn_mfma_f32_32x32x16_bf16(Kf[ks], Qf[ks], S, 0, 0, 0);
    return S;
}
__device__ __forceinline__ void att_pv_f(const bf16x8 (&Vf)[2][2], const bf16x8 P0, const bf16x8 P1, f32x16 (&O)[2]) {
#pragma unroll
    for (int dt = 0; dt < 2; ++dt) { O[dt] = __builtin_amdgcn_mfma_f32_32x32x16_bf16(Vf[dt][0], P0, O[dt], 0, 0, 0); O[dt] = __builtin_amdgcn_mfma_f32_32x32x16_bf16(Vf[dt][1], P1, O[dt], 0, 0, 0); }
}

__device__ __forceinline__ void p_dsa_attn(const Frame& F, const Args& a, unsigned char* ws) {
    const bf16_t* QA = (const bf16_t*)(ws + L0_QA); const bf16_t* KA = (const bf16_t*)(ws + L0_KA); const bf16_t* VAT = (const bf16_t*)(ws + L0_VAT);
    const u64* SELT = (const u64*)(ws + L0_SELT); bf16_t* CAT = (bf16_t*)(ws + L0_CAT);
    const int lane = F.lane, wave = F.wave, h = lane >> 5, c = lane & 31, tid = F.tid;
    float mq = 0.f, mk_ = 0.f;
    for (int i = 0; i < 64; ++i) { mq = fmaxf(mq, fabsf(a.in[I_L0_QG][i])); mk_ = fmaxf(mk_, fabsf(a.in[I_L0_KG][i])); }
    const float c2 = (8.0f * mq * mk_ + 0.5f) * 1.4426950408889634f, c1 = 1.4426950408889634f;
    for (int u = F.bid; u < 512; u += F.G) {
        const int idx = u & 255, g = u >> 8, b = idx >> 5, qtr = idx & 31, qt = g ? 31 - qtr : qtr, q0 = qt * 128;
        const size_t mb = (size_t)b * 4096;
        const bf16_t* Kg = KA + (size_t)(b * 2 + g) * 4096 * 64; const bf16_t* Vtg = VAT + (size_t)(b * 2 + g) * 64 * 4096;
        bf16x8 Qf[2][4]; int qidx[2];
#pragma unroll
        for (int ct = 0; ct < 2; ++ct) { qidx[ct] = q0 + wave * 16 + ct * 8 + (c >> 2);
#pragma unroll
            for (int ks = 0; ks < 4; ++ks) Qf[ct][ks] = *(const bf16x8*)(QA + (mb + qidx[ct]) * 512 + (g * 4 + (c & 3)) * 64 + ks * 16 + 8 * h); }
        f32x16 O[2][2]; float l[2] = {0.f, 0.f};
#pragma unroll
        for (int ct = 0; ct < 2; ++ct)
#pragma unroll
            for (int dt = 0; dt < 2; ++dt)
#pragma unroll
                for (int i = 0; i < 16; ++i) O[ct][dt][i] = 0.f;
        const int nkt = 2 * qt + 2;
        AttStage st; att_load(st, Kg, Vtg, 0, tid);
        __syncthreads();
        att_store(st, F.lds, tid);
        __syncthreads();
        for (int kt = 0; kt < nkt; ++kt) {
            LAS unsigned char* buf = F.lds + (kt & 1) * AT_BUF;
            if (kt + 1 < nkt) att_load(st, Kg, Vtg, (kt + 1) * 64, tid);
            u64 mw[2];
#pragma unroll
            for (int ct = 0; ct < 2; ++ct) mw[ct] = SELT[(size_t)(b * 64 + kt) * 4096 + qidx[ct]];
#pragma unroll 1
            for (int sub = 0; sub < 2; ++sub) {
                bf16x8 Kf[4], Vf[2][2];
                att_kfrags(buf, sub, Kf, lane); att_vfrags(buf, sub, Vf, lane);
#pragma unroll
                for (int ct = 0; ct < 2; ++ct) {
                    __builtin_amdgcn_sched_barrier(0);
                    const f32x16 S = att_qk_f(Kf, Qf[ct]);
                    const unsigned mbits = (unsigned)(mw[ct] >> (sub * 32 + 4 * h));
                    float p[16];
#pragma unroll
                    for (int i = 0; i < 16; ++i) {
                        const float e = __builtin_amdgcn_exp2f(S[i] * c1 - c2);
                        const int bitpos = (i & 3) + 8 * (i >> 2);
                        p[i] = __builtin_bit_cast(float, __builtin_bit_cast(int, e) & __builtin_amdgcn_sbfe((int)mbits, bitpos, 1));
                        l[ct] += p[i];
                    }
                    att_pv_f(Vf, pack8(p[0], p[1], p[2], p[3], p[4], p[5], p[6], p[7]), pack8(p[8], p[9], p[10], p[11], p[12], p[13], p[14], p[15]), O[ct]);
                }
            }
            if (kt + 1 < nkt) att_store(st, F.lds + ((kt + 1) & 1) * AT_BUF, tid);
            __syncthreads();
        }
#pragma unroll
        for (int ct = 0; ct < 2; ++ct) {
            const float lt = l[ct] + __shfl_xor(l[ct], 32);
            const float inv = 1.0f / fmaxf(lt, 1e-30f);
            bf16_t* orow = CAT + (mb + qidx[ct]) * 1024 + (g * 4 + (c & 3)) * 64;
#pragma unroll
            for (int dt = 0; dt < 2; ++dt)
#pragma unroll
                for (int i4 = 0; i4 < 4; ++i4) {
                    const int d = dt * 32 + 8 * i4 + 4 * h;
                    u32x2 w; w.x = pk2(O[ct][dt][4 * i4] * inv, O[ct][dt][4 * i4 + 1] * inv); w.y = pk2(O[ct][dt][4 * i4 + 2] * inv, O[ct][dt][4 * i4 + 3] * inv);
                    *(u32x2*)(orow + d) = w;
                }
        }
    }
}

__device__ __forceinline__ void p_s5_scan(const Frame& F, const Args& a, unsigned char* ws) {
    const float* SLOC = (const float*)(ws + L0_SLOC); bf16_t* UA = (bf16_t*)(ws + L0_UA);
    const int gw = F.bid * NWAVES + F.wave, NGW = F.G * NWAVES, p = F.lane;
    for (int it = gw; it < 32 * NB; it += NGW) {
        const int g = it >> 3, b = it & 7;
        const float dt = expf(a.in[I_L0_LOGDT][g]);
        const float lr = a.in[I_L0_ARE][g * 64 + p], li = a.in[I_L0_AIM][g * 64 + p];
        const float mag = expf(16.0f * dt * lr); float s, c; sincosf(16.0f * dt * li, &s, &c);
        const float ar = mag * c, ai = mag * s;
        float hr = 0.f, hi = 0.f;
        const float* sl = SLOC + ((size_t)g * 2048 + b * 256) * 128;
        bf16_t* ua = UA + ((size_t)g * 2048 + b * 256) * 384 + 256;
        for (int ch = 0; ch < 256; ++ch) {
            ua[(size_t)ch * 384 + p] = (bf16_t)f2bf(hr); ua[(size_t)ch * 384 + 64 + p] = (bf16_t)f2bf(hi);
            const float xr = sl[(size_t)ch * 128 + p], xi = sl[(size_t)ch * 128 + 64 + p];
            const float nr = ar * hr - ai * hi + xr, ni = ar * hi + ai * hr + xi;
            hr = nr; hi = ni;
        }
    }
}
namespace pg8 {
struct EpiS5State {
    static constexpr bool PERM = false;
    float* C;
    __device__ __forceinline__ void operator()(const f32x4 (&acc)[2][2][4][2], const Unit& u, int wr, int wc, int fr, int fq) const {
        const int row0 = u.pm * BM + wr * 64 + fr, col0 = wc * 32 + 4 * fq;
#pragma unroll
        for (int ai = 0; ai < 2; ++ai)
#pragma unroll
            for (int m = 0; m < 4; ++m)
#pragma unroll
                for (int n = 0; n < 2; ++n) *(f32x4*)(C + (size_t)(row0 + ai * HALF + m * 16) * 128 + col0 + n * 16) = acc[ai][0][m][n];
    }
};
struct EpiS5Out {
    static constexpr bool PERM = false;
    bf16_t* YB;
    __device__ __forceinline__ void operator()(const f32x4 (&acc)[2][2][4][2], const Unit& u, int wr, int wc, int fr, int fq) const {
        const int g = u.pn;
        const int row0 = u.pm * BM + wr * 64 + fr - g * 2048;
        const int col0 = wc * 32 + 4 * fq;
#pragma unroll
        for (int ai = 0; ai < 2; ++ai)
#pragma unroll
            for (int m = 0; m < 4; ++m) { const int chunk = row0 + ai * HALF + m * 16;
#pragma unroll
                for (int bj = 0; bj < 2; ++bj)
#pragma unroll
                    for (int n = 0; n < 2; ++n) { const int col = col0 + bj * HALF + n * 16, i = col >> 4, co = col & 15;
                        const f32x4 v = acc[ai][bj][m][n];
                        u32x2 w; w.x = pk2(gelu_tanh(v[0]), gelu_tanh(v[1])); w.y = pk2(gelu_tanh(v[2]), gelu_tanh(v[3]));
                        *(u32x2*)(YB + ((size_t)chunk * 16 + i) * 512 + g * 16 + co) = w; }
                asm volatile("" ::: "memory"); __builtin_amdgcn_sched_barrier(0); }
    }
};
struct EpiGlu {
    static constexpr bool PERM = true;
    const bf16_t* YB; const float* bias; bf16_t* CAT;
    __device__ __forceinline__ void operator()(const f32x4 (&acc)[2][2][4][2], const Unit& u, int wr, int wc, int fr, int fq) const {
        const int row0 = u.pm * BM + wr * 64 + fr, col0 = u.pn * BM + wc * 32 + 8 * fq;
#pragma unroll
        for (int ai = 0; ai < 2; ++ai)
#pragma unroll
            for (int m = 0; m < 4; ++m) { const size_t row = row0 + ai * HALF + m * 16;
#pragma unroll
                for (int bj = 0; bj < 2; ++bj) { const int col = col0 + bj * HALF;
                    const u32x4 yv = *(const u32x4*)(YB + row * 512 + col);
                    const f32x4 b0 = *(const f32x4*)(bias + col), b1 = *(const f32x4*)(bias + col + 4);
                    const f32x4 z0 = acc[ai][bj][m][0] + b0, z1 = acc[ai][bj][m][1] + b1;
                    u32x4 w;
                    w.x = pk2(bf_lo(yv.x) * sigmoidf_(z0[0]), bf_hi(yv.x) * sigmoidf_(z0[1])); w.y = pk2(bf_lo(yv.y) * sigmoidf_(z0[2]), bf_hi(yv.y) * sigmoidf_(z0[3]));
                    w.z = pk2(bf_lo(yv.z) * sigmoidf_(z1[0]), bf_hi(yv.z) * sigmoidf_(z1[1])); w.w = pk2(bf_lo(yv.w) * sigmoidf_(z1[2]), bf_hi(yv.w) * sigmoidf_(z1[3]));
                    *(u32x4*)(CAT + row * 1024 + 512 + col) = w; }
                asm volatile("" ::: "memory"); __builtin_amdgcn_sched_barrier(0); }
    }
};
}
__device__ __forceinline__ unsigned mono_u32(float f) { const unsigned u = __builtin_bit_cast(unsigned, f); return u ^ ((u >> 31) ? 0xFFFFFFFFu : 0x80000000u); }
#define CE_DESC(x, y) do { const unsigned _hi = (x) > (y) ? (x) : (y), _lo = (x) > (y) ? (y) : (x); (x) = _hi; (y) = _lo; } while (0)
__device__ __forceinline__ void sort16_desc(unsigned (&a)[16]) {
#pragma unroll
    for (int k = 2; k <= 16; k <<= 1)
#pragma unroll
        for (int j = k >> 1; j > 0; j >>= 1)
#pragma unroll
            for (int i = 0; i < 16; ++i) { const int l = i ^ j; if (l > i) { if ((i & k) == 0) CE_DESC(a[i], a[l]); else CE_DESC(a[l], a[i]); } }
}
__device__ __forceinline__ void merge16_desc(unsigned (&a)[16], const unsigned (&b)[16]) {
#pragma unroll
    for (int i = 0; i < 16; ++i) a[i] = a[i] > b[15 - i] ? a[i] : b[15 - i];
#pragma unroll
    for (int j = 8; j > 0; j >>= 1)
#pragma unroll
        for (int i = 0; i < 16; ++i) { const int l = i ^ j; if (l > i) CE_DESC(a[i], a[l]); }
}
__device__ __forceinline__ void merge16_xlane(unsigned (&a)[16]) {
    unsigned b[16];
#pragma unroll
    for (int i = 0; i < 16; ++i) b[i] = (unsigned)__shfl_xor((int)a[i], 32);
    merge16_desc(a, b);
}
struct PeerCand { int a[50], b[50]; };
__host__ __device__ constexpr PeerCand peer_cands() { PeerCand c{}; int n = 0; for (int a = 0; a < 16; ++a) for (int b = 0; b < 16; ++b) if ((a + 1) * (b + 1) <= 16) { c.a[n] = a; c.b[n] = b; ++n; } return c; }
__device__ __forceinline__ void p_peer_route(const Frame& F, unsigned char* ws, const bf16_t* SK) {
    const bf16_t* Q2 = (const bf16_t*)(ws + PE_Q2); unsigned short* EID = (unsigned short*)(ws + PE_EID); float* GATE = (float*)(ws + PE_GATE);
    LAS float* sc0 = (LAS float*)F.lds;
    const int lane = F.lane, wave = F.wave, h5 = lane >> 5, r = lane & 31, tid = F.tid;
    constexpr PeerCand PC = peer_cands();
    for (int u = F.bid; u < 2048; u += F.G) {
        const int hd = u & 7, mt = u >> 3; const size_t m0 = (size_t)mt * 128;
        {
            const int p = wave >> 2, rt = wave & 3;
            bf16x8 Af[8];
#pragma unroll
            for (int ks = 0; ks < 8; ++ks) Af[ks] = *(const bf16x8*)(Q2 + (m0 + rt * 32 + r) * 2048 + (hd * 2 + p) * 128 + ks * 16 + 8 * h5);
            LAS float* scp = sc0 + p * 128 * 129;
#pragma unroll 1
            for (int ct = 0; ct < 4; ++ct) {
                f32x16 acc = {0.f, 0.f, 0.f, 0.f, 0.f, 0.f, 0.f, 0.f, 0.f, 0.f, 0.f, 0.f, 0.f, 0.f, 0.f, 0.f};
#pragma unroll
                for (int ks = 0; ks < 8; ++ks) { const bf16x8 Bf = *(const bf16x8*)(SK + ((size_t)(hd * 2 + p) * 128 + ct * 32 + r) * 128 + ks * 16 + 8 * h5);
                    acc = __builtin_amdgcn_mfma_f32_32x32x16_bf16(Af[ks], Bf, acc, 0, 0, 0); }
#pragma unroll
                for (int i = 0; i < 16; ++i) scp[(rt * 32 + (i & 3) + 8 * (i >> 2) + 4 * h5) * 129 + ct * 32 + r] = acc[i];
            }
        }
        __syncthreads();
        {
            const int pp = wave >> 2, row = (wave & 3) * 32 + r, half = h5; LAS float* rowp = sc0 + pp * 128 * 129 + row * 129;
            unsigned top[16];
#pragma unroll
            for (int blk = 0; blk < 4; ++blk) {
                unsigned k16[16];
#pragma unroll
                for (int i = 0; i < 16; ++i) { const int j = half * 64 + blk * 16 + i; k16[i] = (mono_u32(rowp[j]) & ~0x7Fu) | (unsigned)(127 - j); }
                sort16_desc(k16);
                if (blk == 0) {
#pragma unroll
                    for (int i = 0; i < 16; ++i) top[i] = k16[i];
                } else merge16_desc(top, k16);
            }
            merge16_xlane(top);
            float vals[16]; int ids[16];
#pragma unroll
            for (int k = 0; k < 16; ++k) { ids[k] = 127 - (int)(top[k] & 127u); vals[k] = rowp[ids[k]]; }
            if (half == 0) {
#pragma unroll
                for (int k = 0; k < 16; ++k) { rowp[k] = vals[k]; rowp[16 + k] = __int_as_float(ids[k]); }
            }
        }
        __syncthreads();
        if (tid < 256) {
            const int row = (wave & 3) * 32 + r, half = h5; const LAS float* s1 = sc0 + row * 129; const LAS float* s2 = sc0 + 128 * 129 + row * 129;
            float v1[16], v2[16];
#pragma unroll
            for (int k = 0; k < 16; ++k) { v1[k] = s1[k]; v2[k] = s2[k]; }
            unsigned top[16], k16[16];
#pragma unroll
            for (int i = 0; i < 16; ++i) { const int c0 = 2 * i, c1 = 2 * i + 1;
                const unsigned ka = (mono_u32(v1[PC.a[c0]] + v2[PC.b[c0]]) & ~0xFFu) | (unsigned)(255 - (PC.a[c0] * 16 + PC.b[c0]));
                const unsigned kb = (mono_u32(v1[PC.a[c1]] + v2[PC.b[c1]]) & ~0xFFu) | (unsigned)(255 - (PC.a[c1] * 16 + PC.b[c1]));
                top[i] = half ? kb : ka; }
#pragma unroll
            for (int i = 0; i < 16; ++i) { if (i < 9) { const int c0 = 32 + 2 * i, c1 = 32 + 2 * i + 1;
                    const unsigned ka = (mono_u32(v1[PC.a[c0]] + v2[PC.b[c0]]) & ~0xFFu) | (unsigned)(255 - (PC.a[c0] * 16 + PC.b[c0]));
                    const unsigned kb = (mono_u32(v1[PC.a[c1]] + v2[PC.b[c1]]) & ~0xFFu) | (unsigned)(255 - (PC.a[c1] * 16 + PC.b[c1]));
                    k16[i] = half ? kb : ka; } else k16[i] = 0u; }
            sort16_desc(top); sort16_desc(k16); merge16_desc(top, k16);
            merge16_xlane(top);
            if (half == 0) {
                float mx = -3.0e38f; float sv[16]; int eid[16];
#pragma unroll
                for (int k = 0; k < 16; ++k) { const int fl = 255 - (int)(top[k] & 255u), a = fl >> 4, b = fl & 15;
                    sv[k] = s1[a] + s2[b]; eid[k] = __float_as_int(s1[16 + a]) * 128 + __float_as_int(s2[16 + b]); mx = fmaxf(mx, sv[k]); }
                float den = 0.f;
#pragma unroll
                for (int k = 0; k < 16; ++k) { sv[k] = __expf(sv[k] - mx); den += sv[k]; }
                const float inv = 1.0f / den;
                unsigned short* ep = EID + (m0 + row) * 128 + hd * 16; float* gp = GATE + (m0 + row) * 128 + hd * 16;
#pragma unroll
                for (int k = 0; k < 16; ++k) { ep[k] = (unsigned short)eid[k]; gp[k] = sv[k] * inv; }
            }
        }
        __syncthreads();
    }
}

__device__ __forceinline__ float rdlane_f(float v, int l) { return __builtin_bit_cast(float, __builtin_amdgcn_readlane(__builtin_bit_cast(int, v), l)); }
__device__ __forceinline__ void p_peer_expert(const Frame& F, unsigned char* ws, float* xres) {
    const bf16_t* XN = (const bf16_t*)(ws + WS_XN); const bf16_t* TU = (const bf16_t*)(ws + WS_TABU); const bf16_t* TV = (const bf16_t*)(ws + WS_TABV);
    const unsigned short* EID = (const unsigned short*)(ws + PE_EID); const float* GATE = (const float*)(ws + PE_GATE);
    const int gw = F.bid * NWAVES + F.wave, NGW = F.G * NWAVES, lane = F.lane;
    for (int m = gw; m < T; m += NGW) {
        float xf[16];
        { const u32x4 xa = *(const u32x4*)(XN + (size_t)m * 1024 + lane * 8), xb = *(const u32x4*)(XN + (size_t)m * 1024 + 512 + lane * 8);
          xf[0] = bf_lo(xa.x); xf[1] = bf_hi(xa.x); xf[2] = bf_lo(xa.y); xf[3] = bf_hi(xa.y); xf[4] = bf_lo(xa.z); xf[5] = bf_hi(xa.z); xf[6] = bf_lo(xa.w); xf[7] = bf_hi(xa.w);
          xf[8] = bf_lo(xb.x); xf[9] = bf_hi(xb.x); xf[10] = bf_lo(xb.y); xf[11] = bf_hi(xb.y); xf[12] = bf_lo(xb.z); xf[13] = bf_hi(xb.z); xf[14] = bf_lo(xb.w); xf[15] = bf_hi(xb.w); }
        const int id0 = EID[(size_t)m * 128 + lane], id1 = EID[(size_t)m * 128 + 64 + lane];
        const float g0 = GATE[(size_t)m * 128 + lane], g1 = GATE[(size_t)m * 128 + 64 + lane];
        float outv[16];
#pragma unroll
        for (int i = 0; i < 16; ++i) outv[i] = 0.f;
#pragma unroll 1
        for (int k = 0; k < 16; ++k) {
            const int idreg = (k < 8) ? id0 : id1; const float greg = (k < 8) ? g0 : g1; const int lbase = (k & 7) * 8;
            int e[8];
#pragma unroll
            for (int i = 0; i < 8; ++i) e[i] = __builtin_amdgcn_readlane(idreg, lbase + i);
            float pr[8];
            {
                u32x4 ua[8], ub[8];
#pragma unroll
                for (int i = 0; i < 8; ++i) { ua[i] = *(const u32x4*)(TU + (size_t)e[i] * 1024 + lane * 8); ub[i] = *(const u32x4*)(TU + (size_t)e[i] * 1024 + 512 + lane * 8); }
#pragma unroll
                for (int i = 0; i < 8; ++i) {
                    float s = xf[0] * bf_lo(ua[i].x); s += xf[1] * bf_hi(ua[i].x); s += xf[2] * bf_lo(ua[i].y); s += xf[3] * bf_hi(ua[i].y);
                    s += xf[4] * bf_lo(ua[i].z); s += xf[5] * bf_hi(ua[i].z); s += xf[6] * bf_lo(ua[i].w); s += xf[7] * bf_hi(ua[i].w);
                    s += xf[8] * bf_lo(ub[i].x); s += xf[9] * bf_hi(ub[i].x); s += xf[10] * bf_lo(ub[i].y); s += xf[11] * bf_hi(ub[i].y);
                    s += xf[12] * bf_lo(ub[i].z); s += xf[13] * bf_hi(ub[i].z); s += xf[14] * bf_lo(ub[i].w); s += xf[15] * bf_hi(ub[i].w);
                    pr[i] = s;
                }
            }
            float r4[4], r2[2], r1;
            { const bool up = (lane & 32) != 0;
#pragma unroll
              for (int i = 0; i < 4; ++i) { const float keep = up ? pr[i + 4] : pr[i], send = up ? pr[i] : pr[i + 4]; r4[i] = keep + __shfl_xor(send, 32); } }
            { const bool up = (lane & 16) != 0;
#pragma unroll
              for (int i = 0; i < 2; ++i) { const float keep = up ? r4[i + 2] : r4[i], send = up ? r4[i] : r4[i + 2]; r2[i] = keep + __shfl_xor(send, 16); } }
            { const bool up = (lane & 8) != 0; const float keep = up ? r2[1] : r2[0], send = up ? r2[0] : r2[1]; r1 = keep + __shfl_xor(send, 8); }
            r1 += __shfl_xor(r1, 4); r1 += __shfl_xor(r1, 2); r1 += __shfl_xor(r1, 1);
            const float gv = __shfl(greg, lbase + (lane >> 3));
            const float coef = gv * gelu_tanh(r1);
            {
                u32x4 va[8], vb[8];
#pragma unroll
                for (int i = 0; i < 8; ++i) { va[i] = *(const u32x4*)(TV + (size_t)e[i] * 1024 + lane * 8); vb[i] = *(const u32x4*)(TV + (size_t)e[i] * 1024 + 512 + lane * 8); }
#pragma unroll
                for (int i = 0; i < 8; ++i) {
                    const float ci = rdlane_f(coef, i * 8);
                    outv[0] += ci * bf_lo(va[i].x); outv[1] += ci * bf_hi(va[i].x); outv[2] += ci * bf_lo(va[i].y); outv[3] += ci * bf_hi(va[i].y);
                    outv[4] += ci * bf_lo(va[i].z); outv[5] += ci * bf_hi(va[i].z); outv[6] += ci * bf_lo(va[i].w); outv[7] += ci * bf_hi(va[i].w);
                    outv[8] += ci * bf_lo(vb[i].x); outv[9] += ci * bf_hi(vb[i].x); outv[10] += ci * bf_lo(vb[i].y); outv[11] += ci * bf_hi(vb[i].y);
                    outv[12] += ci * bf_lo(vb[i].z); outv[13] += ci * bf_hi(vb[i].z); outv[14] += ci * bf_lo(vb[i].w); outv[15] += ci * bf_hi(vb[i].w);
                }
            }
        }
        f32x4* o = (f32x4*)(xres + (size_t)m * 1024 + lane * 8);
        f32x4 a0 = o[0], a1 = o[1], b0 = o[128], b1 = o[129];
        a0 += (f32x4){outv[0], outv[1], outv[2], outv[3]}; a1 += (f32x4){outv[4], outv[5], outv[6], outv[7]};
        b0 += (f32x4){outv[8], outv[9], outv[10], outv[11]}; b1 += (f32x4){outv[12], outv[13], outv[14], outv[15]};
        o[0] = a0; o[1] = a1; o[128] = b0; o[129] = b1;
    }
}

typedef __bf16 bf16x2_t __attribute__((ext_vector_type(2)));
__device__ __forceinline__ float dot2bf(unsigned a, unsigned b, float c) { return __builtin_amdgcn_fdot2_f32_bf16(__builtin_bit_cast(bf16x2_t, a), __builtin_bit_cast(bf16x2_t, b), c, false); }
__device__ __forceinline__ void peer_slot_range(const unsigned (&xp)[8], float (&outv)[16], int id0, int id1, float g0, float g1, int r,
                                                const bf16_t* TU, const bf16_t* TV, int lane) {
    u64 m0 = __ballot((id0 >> 9) == r), m1 = __ballot((id1 >> 9) == r);
    while (m0 | m1) {
        int e[8]; float gt[8];
#pragma unroll
        for (int i = 0; i < 8; ++i) {
            if (m0) { const int l = __builtin_ctzll(m0); m0 &= m0 - 1ull; e[i] = __builtin_amdgcn_readlane(id0, l); gt[i] = rdlane_f(g0, l); }
            else if (m1) { const int l = __builtin_ctzll(m1); m1 &= m1 - 1ull; e[i] = __builtin_amdgcn_readlane(id1, l); gt[i] = rdlane_f(g1, l); }
            else { e[i] = -1; gt[i] = 0.f; }
        }
        float pr[8];
        {
            u32x4 ua[8], ub[8];
#pragma unroll
            for (int i = 0; i < 8; ++i) {
                if (e[i] >= 0) { ua[i] = *(const u32x4*)(TU + (size_t)e[i] * 1024 + lane * 8); ub[i] = *(const u32x4*)(TU + (size_t)e[i] * 1024 + 512 + lane * 8); }
                else { ua[i] = (u32x4){0u, 0u, 0u, 0u}; ub[i] = (u32x4){0u, 0u, 0u, 0u}; }
            }
#pragma unroll
            for (int i = 0; i < 8; ++i) {
                float s = dot2bf(xp[0], ua[i].x, 0.f); s = dot2bf(xp[1], ua[i].y, s); s = dot2bf(xp[2], ua[i].z, s); s = dot2bf(xp[3], ua[i].w, s);
                s = dot2bf(xp[4], ub[i].x, s); s = dot2bf(xp[5], ub[i].y, s); s = dot2bf(xp[6], ub[i].z, s); s = dot2bf(xp[7], ub[i].w, s);
                pr[i] = s;
            }
        }
        float r4[4], r2[2], r1;
        { const bool up = (lane & 32) != 0;
#pragma unroll
          for (int i = 0; i < 4; ++i) { const float keep = up ? pr[i + 4] : pr[i], send = up ? pr[i] : pr[i + 4]; r4[i] = keep + __shfl_xor(send, 32); } }
        { const bool up = (lane & 16) != 0;
#pragma unroll
          for (int i = 0; i < 2; ++i) { const float keep = up ? r4[i + 2] : r4[i], send = up ? r4[i] : r4[i + 2]; r2[i] = keep + __shfl_xor(send, 16); } }
        { const bool up = (lane & 8) != 0; const float keep = up ? r2[1] : r2[0], send = up ? r2[0] : r2[1]; r1 = keep + __shfl_xor(send, 8); }
        r1 += __shfl_xor(r1, 4); r1 += __shfl_xor(r1, 2); r1 += __shfl_xor(r1, 1);
        const int grp = lane >> 3;
        float gsel = gt[0];
#pragma unroll
        for (int i = 1; i < 8; ++i) gsel = (grp == i) ? gt[i] : gsel;
        const float coef = gsel * gelu_tanh(r1);
        {
            u32x4 va[8], vb[8];
#pragma unroll
            for (int i = 0; i < 8; ++i) {
                if (e[i] >= 0) { va[i] = *(const u32x4*)(TV + (size_t)e[i] * 1024 + lane * 8); vb[i] = *(const u32x4*)(TV + (size_t)e[i] * 1024 + 512 + lane * 8); }
                else { va[i] = (u32x4){0u, 0u, 0u, 0u}; vb[i] = (u32x4){0u, 0u, 0u, 0u}; }
            }
#pragma unroll
            for (int i = 0; i < 8; ++i) {
                if (e[i] >= 0) {
                    const float ci = rdlane_f(coef, i * 8);
                    outv[0] += ci * bf_lo(va[i].x); outv[1] += ci * bf_hi(va[i].x); outv[2] += ci * bf_lo(va[i].y); outv[3] += ci * bf_hi(va[i].y);
                    outv[4] += ci * bf_lo(va[i].z); outv[5] += ci * bf_hi(va[i].z); outv[6] += ci * bf_lo(va[i].w); outv[7] += ci * bf_hi(va[i].w);
                    outv[8] += ci * bf_lo(vb[i].x); outv[9] += ci * bf_hi(vb[i].x); outv[10] += ci * bf_lo(vb[i].y); outv[11] += ci * bf_hi(vb[i].y);
                    outv[12] += ci * bf_lo(vb[i].z); outv[13] += ci * bf_hi(vb[i].z); outv[14] += ci * bf_lo(vb[i].w); outv[15] += ci * bf_hi(vb[i].w);
                }
            }
        }
    }
}
__device__ __forceinline__ void p_peer_expert2(const Frame& F, unsigned char* ws, float* xres, const float oscale) {
    const bf16_t* XN = (const bf16_t*)(ws + WS_XN); const bf16_t* TU = (const bf16_t*)(ws + WS_TABU); const bf16_t* TV = (const bf16_t*)(ws + WS_TABV);
    const unsigned short* EID = (const unsigned short*)(ws + PE_EID); const float* GATE = (const float*)(ws + PE_GATE);
    const int gw = F.bid * NWAVES + F.wave, NGW = F.G * NWAVES, lane = F.lane;
    int rnd = 0;
    for (int m4 = gw * 4; m4 < T; m4 += NGW * 4, ++rnd) {
        unsigned xp[4][8]; float outv[4][16]; int id[4][2]; float gg[4][2];
#pragma unroll
        for (int s = 0; s < 4; ++s) {
            const size_t m = (size_t)(m4 + s);
            const u32x4 xa = *(const u32x4*)(XN + m * 1024 + lane * 8), xb = *(const u32x4*)(XN + m * 1024 + 512 + lane * 8);
            xp[s][0] = xa.x; xp[s][1] = xa.y; xp[s][2] = xa.z; xp[s][3] = xa.w; xp[s][4] = xb.x; xp[s][5] = xb.y; xp[s][6] = xb.z; xp[s][7] = xb.w;
            id[s][0] = EID[m * 128 + lane]; id[s][1] = EID[m * 128 + 64 + lane]; gg[s][0] = GATE[m * 128 + lane]; gg[s][1] = GATE[m * 128 + 64 + lane];
#pragma unroll
            for (int i = 0; i < 16; ++i) outv[s][i] = 0.f;
        }
#pragma unroll 1
        for (int k = 0; k < 32; ++k) {
            const int r = (rnd & 1) ? 31 - k : k;
#pragma unroll
            for (int s = 0; s < 4; ++s) peer_slot_range(xp[s], outv[s], id[s][0], id[s][1], gg[s][0], gg[s][1], r, TU, TV, lane);
        }
#pragma unroll
        for (int s = 0; s < 4; ++s) {
            f32x4* o = (f32x4*)(xres + (size_t)(m4 + s) * 1024 + lane * 8);
            f32x4 a0 = o[0], a1 = o[1], b0 = o[128], b1 = o[129];
            a0 += (f32x4){outv[s][0], outv[s][1], outv[s][2], outv[s][3]} * oscale; a1 += (f32x4){outv[s][4], outv[s][5], outv[s][6], outv[s][7]} * oscale;
            b0 += (f32x4){outv[s][8], outv[s][9], outv[s][10], outv[s][11]} * oscale; b1 += (f32x4){outv[s][12], outv[s][13], outv[s][14], outv[s][15]} * oscale;
            o[0] = a0; o[1] = a1; o[128] = b0; o[129] = b1;
        }
    }
}

struct RowBuf { u32x4 a[8], b[8]; };
__device__ __forceinline__ void peer_load8(RowBuf& rb, const bf16_t* TAB, const LAS unsigned* ent, int b, int lane) {
#pragma unroll
    for (int i = 0; i < 8; ++i) {
        const unsigned e = (unsigned)__builtin_amdgcn_readfirstlane((int)ent[b * 8 + i]) & 0x3FFFu;
        const bf16_t* rp = TAB + (size_t)e * 1024 + lane * 8;
        rb.a[i] = *(const u32x4*)rp; rb.b[i] = *(const u32x4*)(rp + 512);
    }
}
__device__ __forceinline__ float peer_dot(const unsigned (&xp)[8], const u32x4 a, const u32x4 b) {
    float s = dot2bf(xp[0], a.x, 0.f); s = dot2bf(xp[1], a.y, s); s = dot2bf(xp[2], a.z, s); s = dot2bf(xp[3], a.w, s);
    s = dot2bf(xp[4], b.x, s); s = dot2bf(xp[5], b.y, s); s = dot2bf(xp[6], b.z, s); s = dot2bf(xp[7], b.w, s);
    return s;
}
__device__ __forceinline__ void peer_u8(const RowBuf& rb, const unsigned (&xp)[4][8], const LAS unsigned* ent, LAS float* cf, int b, int lane) {
    float pr[8];
#pragma unroll
    for (int i = 0; i < 8; ++i) {
        const int slot = (__builtin_amdgcn_readfirstlane((int)ent[b * 8 + i]) >> 21) & 3;
        if (slot == 0) pr[i] = peer_dot(xp[0], rb.a[i], rb.b[i]);
        else if (slot == 1) pr[i] = peer_dot(xp[1], rb.a[i], rb.b[i]);
        else if (slot == 2) pr[i] = peer_dot(xp[2], rb.a[i], rb.b[i]);
        else pr[i] = peer_dot(xp[3], rb.a[i], rb.b[i]);
    }
    float r4[4], r2[2], r1;
    { const bool up = (lane & 32) != 0;
#pragma unroll
      for (int i = 0; i < 4; ++i) { const float keep = up ? pr[i + 4] : pr[i], send = up ? pr[i] : pr[i + 4]; r4[i] = keep + __shfl_xor(send, 32); } }
    { const bool up = (lane & 16) != 0;
#pragma unroll
      for (int i = 0; i < 2; ++i) { const float keep = up ? r4[i + 2] : r4[i], send = up ? r4[i] : r4[i + 2]; r2[i] = keep + __shfl_xor(send, 16); } }
    { const bool up = (lane & 8) != 0; const float keep = up ? r2[1] : r2[0], send = up ? r2[0] : r2[1]; r1 = keep + __shfl_xor(send, 8); }
    r1 += __shfl_xor(r1, 4); r1 += __shfl_xor(r1, 2); r1 += __shfl_xor(r1, 1);
    const float gate = cf[b * 8 + (lane >> 3)];
    const float coef = gate * gelu_tanh(r1);
    if ((lane & 7) == 0) cf[b * 8 + (lane >> 3)] = coef;
}
__device__ __forceinline__ void peer_acc(float (&o)[16], const float c, const u32x4 a, const u32x4 b) {
    o[0] += c * bf_lo(a.x); o[1] += c * bf_hi(a.x); o[2] += c * bf_lo(a.y); o[3] += c * bf_hi(a.y);
    o[4] += c * bf_lo(a.z); o[5] += c * bf_hi(a.z); o[6] += c * bf_lo(a.w); o[7] += c * bf_hi(a.w);
    o[8] += c * bf_lo(b.x); o[9] += c * bf_hi(b.x); o[10] += c * bf_lo(b.y); o[11] += c * bf_hi(b.y);
    o[12] += c * bf_lo(b.z); o[13] += c * bf_hi(b.z); o[14] += c * bf_lo(b.w); o[15] += c * bf_hi(b.w);
}
__device__ __forceinline__ void peer_v8(const RowBuf& rb, float (&outv)[4][16], const LAS unsigned* ent, const LAS float* cf, int b) {
#pragma unroll
    for (int i = 0; i < 8; ++i) {
        const int slot = (__builtin_amdgcn_readfirstlane((int)ent[b * 8 + i]) >> 21) & 3;
        const float c = cf[b * 8 + i];
        if (slot == 0) peer_acc(outv[0], c, rb.a[i], rb.b[i]);
        else if (slot == 1) peer_acc(outv[1], c, rb.a[i], rb.b[i]);
        else if (slot == 2) peer_acc(outv[2], c, rb.a[i], rb.b[i]);
        else peer_acc(outv[3], c, rb.a[i], rb.b[i]);
    }
}
__device__ __forceinline__ void p_peer_expert3(const Frame& F, unsigned char* ws, float* xres, const float oscale, const XcdBarrier& xbar) {
    const bf16_t* XN = (const bf16_t*)(ws + WS_XN); const bf16_t* TU = (const bf16_t*)(ws + WS_TABU); const bf16_t* TV = (const bf16_t*)(ws + WS_TABV);
    const unsigned short* EID = (const unsigned short*)(ws + PE_EID); const float* GATE = (const float*)(ws + PE_GATE);
    const int gw = F.bid * NWAVES + F.wave, NGW = F.G * NWAVES, lane = F.lane;
    LAS unsigned* ent = (LAS unsigned*)(F.lds + F.wave * 4096);
    LAS float* cf = (LAS float*)(F.lds + F.wave * 4096 + 2048);
    const int nrounds = (T + NGW * 4 - 1) / (NGW * 4);
    for (int rnd = 0; rnd < nrounds; ++rnd) {
        const int m4 = (rnd * NGW + gw) * 4;
        if (m4 < T) {
            unsigned xp[4][8];
            {
                int id[4][2]; float gg[4][2];
#pragma unroll
                for (int s = 0; s < 4; ++s) {
                    const size_t m = (size_t)(m4 + s);
                    const u32x4 xa = *(const u32x4*)(XN + m * 1024 + lane * 8), xb = *(const u32x4*)(XN + m * 1024 + 512 + lane * 8);
                    xp[s][0] = xa.x; xp[s][1] = xa.y; xp[s][2] = xa.z; xp[s][3] = xa.w; xp[s][4] = xb.x; xp[s][5] = xb.y; xp[s][6] = xb.z; xp[s][7] = xb.w;
                    id[s][0] = EID[m * 128 + lane]; id[s][1] = EID[m * 128 + 64 + lane]; gg[s][0] = GATE[m * 128 + lane]; gg[s][1] = GATE[m * 128 + 64 + lane];
                }
                int base = 0;
#pragma unroll 1
                for (int k = 0; k < 32; ++k) {
                    const int r = (rnd & 1) ? 31 - k : k;
#pragma unroll
                    for (int s = 0; s < 4; ++s)
#pragma unroll
                        for (int w = 0; w < 2; ++w) {
                            const bool hit = (id[s][w] >> 9) == r;
                            const u64 m = __ballot(hit);
                            if (hit) { const int pos = base + (int)__builtin_amdgcn_mbcnt_hi((unsigned)(m >> 32), __builtin_amdgcn_mbcnt_lo((unsigned)m, 0u));
                                ent[pos] = ((unsigned)s << 21) | ((unsigned)(w * 64 + lane) << 14) | (unsigned)id[s][w]; cf[pos] = gg[s][w]; }
                            base += __builtin_popcountll(m);
                        }
                }
            }
            LDS_WAIT();
            {
                RowBuf A, B;
                peer_load8(A, TU, ent, 0, lane);
#pragma unroll 1
                for (int b = 0; b < 64; b += 2) {
                    peer_load8(B, TU, ent, b + 1, lane);
                    peer_u8(A, xp, ent, cf, b, lane);
                    if (b + 2 < 64) peer_load8(A, TU, ent, b + 2, lane);
                    peer_u8(B, xp, ent, cf, b + 1, lane);
                }
            }
            LDS_WAIT();
            float outv[4][16];
#pragma unroll
            for (int s = 0; s < 4; ++s)
#pragma unroll
                for (int i = 0; i < 16; ++i) outv[s][i] = 0.f;
            {
                RowBuf A, B;
                peer_load8(A, TV, ent, 0, lane);
#pragma unroll 1
                for (int b = 0; b < 64; b += 2) {
                    peer_load8(B, TV, ent, b + 1, lane);
                    peer_v8(A, outv, ent, cf, b);
                    if (b + 2 < 64) peer_load8(A, TV, ent, b + 2, lane);
                    peer_v8(B, outv, ent, cf, b + 1);
                }
            }
#pragma unroll
            for (int s = 0; s < 4; ++s) {
                f32x4* o = (f32x4*)(xres + (size_t)(m4 + s) * 1024 + lane * 8);
                f32x4 a0 = o[0], a1 = o[1], b0 = o[128], b1 = o[129];
                a0 += (f32x4){outv[s][0], outv[s][1], outv[s][2], outv[s][3]} * oscale; a1 += (f32x4){outv[s][4], outv[s][5], outv[s][6], outv[s][7]} * oscale;
                b0 += (f32x4){outv[s][8], outv[s][9], outv[s][10], outv[s][11]} * oscale; b1 += (f32x4){outv[s][12], outv[s][13], outv[s][14], outv[s][15]} * oscale;
                o[0] = a0; o[1] = a1; o[128] = b0; o[129] = b1;
            }
        }
        if (rnd + 1 < nrounds) xcd_barrier(xbar);
    }
}

constexpr size_t WS_TAB8U = WS_TABU;
constexpr size_t WS_TAB8V = WS_TABU + 16 * MiB;
constexpr size_t WS_TABSU = WS_TABU + 32 * MiB;
constexpr size_t WS_TABSV = WS_TABU + 32 * MiB + 65536;
__device__ __forceinline__ void cvt_table_fp8(const Frame& F, const float* src, unsigned char* dst, float* scales, const int skip) {
    const int nb = F.G > skip ? F.G - skip : F.G, b0 = F.G > skip ? F.bid - skip : F.bid;
    const int gw = b0 * NWAVES + F.wave, NGW = nb * NWAVES, lane = F.lane;
    if (b0 >= 0) for (int r = gw; r < 16384; r += NGW) {
        const f32x4* p = (const f32x4*)(src + (size_t)r * 1024 + lane * 16);
        f32x4 v[4]; float am = 0.f;
#pragma unroll
        for (int j = 0; j < 4; ++j) { v[j] = p[j]; am = fmaxf(am, fmaxf(fmaxf(fabsf(v[j].x), fabsf(v[j].y)), fmaxf(fabsf(v[j].z), fabsf(v[j].w)))); }
#pragma unroll
        for (int o = 1; o < 64; o <<= 1) am = fmaxf(am, __shfl_xor(am, o));
        const float sc = am > 0.f ? am * (1.0f / 448.0f) : 1.0f, inv = 1.0f / sc;
        u32x4 q;
#pragma unroll
        for (int j = 0; j < 4; ++j) { int w = 0; w = __builtin_amdgcn_cvt_pk_fp8_f32(v[j].x * inv, v[j].y * inv, w, false); w = __builtin_amdgcn_cvt_pk_fp8_f32(v[j].z * inv, v[j].w * inv, w, true); q[j] = (unsigned)w; }
        *(u32x4*)(dst + (size_t)r * 1024 + lane * 16) = q;
        if (lane == 0) scales[r] = sc;
    }
}
template <int NR> struct RowBufN { u32x4 a[NR]; };
template <int NR>
__device__ __forceinline__ void peer_loadN(RowBufN<NR>& rb, const unsigned char* TAB, const LAS unsigned* ent, int b, int lane) {
    const int ev = (int)ent[b * NR + (lane & (NR - 1))];
#pragma unroll
    for (int i = 0; i < NR; ++i) {
        const unsigned e = (unsigned)__builtin_amdgcn_readlane(ev, i) & 0x3FFFu;
        rb.a[i] = *(const u32x4*)(TAB + (size_t)e * 1024 + lane * 16);
    }
}
__device__ __forceinline__ float peer_dot8x(const u32x4 xa, const u32x4 xb, const u32x4 q) {
    float s = 0.f;
#pragma unroll
    for (int j = 0; j < 4; ++j) {
        const f32x2 lo = __builtin_amdgcn_cvt_pk_f32_fp8((int)q[j], false), hi = __builtin_amdgcn_cvt_pk_f32_fp8((int)q[j], true);
        const unsigned x0 = (j < 2) ? xa[2 * j] : xb[2 * j - 4], x1 = (j < 2) ? xa[2 * j + 1] : xb[2 * j - 3];
        s += bf_lo(x0) * lo.x; s += bf_hi(x0) * lo.y; s += bf_lo(x1) * hi.x; s += bf_hi(x1) * hi.y;
    }
    return s;
}
template <int NR>
__device__ __forceinline__ void peer_u8x(const RowBufN<NR>& rb, int r0, const LAS unsigned char* xl, const LAS unsigned* ent, LAS float* cf, const LAS float* sul, int e0, int lane) {
    float pr[8];
    const int ev = (int)ent[e0 + (lane & 7)];
#pragma unroll
    for (int i = 0; i < 8; ++i) {
        const int slot = (__builtin_amdgcn_readlane(ev, i) >> 21) & 3;
        const LAS unsigned char* xp = xl + slot * 2048 + lane * 32;
        const u32x4 xa = *(const LAS u32x4*)xp, xb = *(const LAS u32x4*)(xp + 16);
        pr[i] = peer_dot8x(xa, xb, rb.a[r0 + i]);
    }
    float r4[4], r2[2], r1;
    { const bool up = (lane & 32) != 0;
#pragma unroll
      for (int i = 0; i < 4; ++i) { const float keep = up ? pr[i + 4] : pr[i], send = up ? pr[i] : pr[i + 4]; r4[i] = keep + __shfl_xor(send, 32); } }
    { const bool up = (lane & 16) != 0;
#pragma unroll
      for (int i = 0; i < 2; ++i) { const float keep = up ? r4[i + 2] : r4[i], send = up ? r4[i] : r4[i + 2]; r2[i] = keep + __shfl_xor(send, 16); } }
    { const bool up = (lane & 8) != 0; const float keep = up ? r2[1] : r2[0], send = up ? r2[0] : r2[1]; r1 = keep + __shfl_xor(send, 8); }
    r1 += __shfl_xor(r1, 4); r1 += __shfl_xor(r1, 2); r1 += __shfl_xor(r1, 1);
    const float gate = cf[e0 + (lane >> 3)];
    const float coef = gate * gelu_tanh(r1 * sul[e0 + (lane >> 3)]);
    if ((lane & 7) == 0) cf[e0 + (lane >> 3)] = coef;
}
__device__ __forceinline__ void peer_acc8(float (&o)[16], const float c, const u32x4 q) {
#pragma unroll
    for (int j = 0; j < 4; ++j) { const f32x2 lo = __builtin_amdgcn_cvt_pk_f32_fp8((int)q[j], false), hi = __builtin_amdgcn_cvt_pk_f32_fp8((int)q[j], true);
        o[4 * j] += c * lo.x; o[4 * j + 1] += c * lo.y; o[4 * j + 2] += c * hi.x; o[4 * j + 3] += c * hi.y; }
}
template <int NR>
__device__ __forceinline__ void peer_vN(const RowBufN<NR>& rb, float (&outv)[4][16], const LAS unsigned* ent, const LAS float* cf, int b, int lane) {
    const int ev = (int)ent[b * NR + (lane & (NR - 1))]; const float cv = cf[b * NR + (lane & (NR - 1))];
#pragma unroll
    for (int i = 0; i < NR; ++i) {
        const int slot = (__builtin_amdgcn_readlane(ev, i) >> 21) & 3;
        const float c = rdlane_f(cv, i);
        if (slot == 0) peer_acc8(outv[0], c, rb.a[i]);
        else if (slot == 1) peer_acc8(outv[1], c, rb.a[i]);
        else if (slot == 2) peer_acc8(outv[2], c, rb.a[i]);
        else peer_acc8(outv[3], c, rb.a[i]);
    }
}
__device__ __forceinline__ void p_peer_expert4(const Frame& F, unsigned char* ws, float* xres, const float oscale, const XcdBarrier& xbar, const int mode) {
    const bf16_t* XN = (const bf16_t*)(ws + WS_XN); const unsigned char* TU = ws + WS_TAB8U; const unsigned char* TV = ws + WS_TAB8V;
    const float* SU = (const float*)(ws + WS_TABSU); const float* SV = (const float*)(ws + WS_TABSV);
    const unsigned short* EID = (const unsigned short*)(ws + PE_EID); const float* GATE = (const float*)(ws + PE_GATE);
    const int gw = F.bid * NWAVES + F.wave, NGW = F.G * NWAVES, lane = F.lane;
    LAS unsigned* ent = (LAS unsigned*)(F.lds + F.wave * 6144);
    LAS float* cf = (LAS float*)(F.lds + F.wave * 6144 + 2048);
    LAS float* sul = (LAS float*)(F.lds + F.wave * 6144 + 4096);
    LAS unsigned char* xl = F.lds + 49152 + F.wave * 8192;
    constexpr int PU = 16, PV = 8;
    const int nrounds = (T + NGW * 4 - 1) / (NGW * 4);
    for (int rnd = 0; rnd < nrounds; ++rnd) {
        const int m4 = (rnd * NGW + gw) * 4;
        if (m4 < T) {
            {
                int id[4][2]; float gg[4][2], su[4][2];
#pragma unroll
                for (int s = 0; s < 4; ++s) { const size_t m = (size_t)(m4 + s);
                    id[s][0] = EID[m * 128 + lane]; id[s][1] = EID[m * 128 + 64 + lane]; gg[s][0] = GATE[m * 128 + lane] * SV[id[s][0]]; gg[s][1] = GATE[m * 128 + 64 + lane] * SV[id[s][1]]; su[s][0] = SU[id[s][0]]; su[s][1] = SU[id[s][1]]; }
                int base = 0;
#pragma unroll 1
                for (int k = 0; k < 16; ++k) {
                    const int r = (rnd & 1) ? 15 - k : k;
#pragma unroll
                    for (int s = 0; s < 4; ++s)
#pragma unroll
                        for (int w = 0; w < 2; ++w) {
                            const bool hit = (id[s][w] >> 10) == r;
                            const u64 m = __ballot(hit);
                            if (hit) { const int pos = base + (int)__builtin_amdgcn_mbcnt_hi((unsigned)(m >> 32), __builtin_amdgcn_mbcnt_lo((unsigned)m, 0u));
                                ent[pos] = ((unsigned)s << 21) | ((unsigned)(w * 64 + lane) << 14) | (unsigned)(mode == 4 ? (id[s][w] & 7) : id[s][w]); cf[pos] = gg[s][w]; sul[pos] = su[s][w]; }
                            base += __builtin_popcountll(m);
                        }
                }
            }
            LDS_WAIT();
            if (mode != 1 && mode != 3) {
#pragma unroll
                for (int s = 0; s < 4; ++s) { const size_t m = (size_t)(m4 + s);
                    const u32x4 xa = *(const u32x4*)(XN + m * 1024 + lane * 16), xb = *(const u32x4*)(XN + m * 1024 + lane * 16 + 8);
                    *(LAS u32x4*)(xl + s * 2048 + lane * 32) = xa; *(LAS u32x4*)(xl + s * 2048 + lane * 32 + 16) = xb; }
                LDS_WAIT();
                RowBufN<PU> A, B;
                peer_loadN<PU>(A, TU, ent, 0, lane);
#pragma unroll 1
                for (int b = 0; b < 512 / PU; b += 2) {
                    peer_loadN<PU>(B, TU, ent, b + 1, lane);
#pragma unroll
                    for (int h = 0; h < PU / 8; ++h) peer_u8x<PU>(A, h * 8, xl, ent, cf, sul, b * PU + h * 8, lane);
                    if (b + 2 < 512 / PU) peer_loadN<PU>(A, TU, ent, b + 2, lane);
#pragma unroll
                    for (int h = 0; h < PU / 8; ++h) peer_u8x<PU>(B, h * 8, xl, ent, cf, sul, (b + 1) * PU + h * 8, lane);
                }
            }
            LDS_WAIT();
            float outv[4][16];
#pragma unroll
            for (int s = 0; s < 4; ++s)
#pragma unroll
                for (int i = 0; i < 16; ++i) outv[s][i] = 0.f;
            if (mode != 1 && mode != 2) {
                RowBufN<PV> A, B;
                peer_loadN<PV>(A, TV, ent, 0, lane);
#pragma unroll 1
                for (int b = 0; b < 512 / PV; b += 2) {
                    peer_loadN<PV>(B, TV, ent, b + 1, lane);
                    peer_vN<PV>(A, outv, ent, cf, b, lane);
                    if (b + 2 < 512 / PV) peer_loadN<PV>(A, TV, ent, b + 2, lane);
                    peer_vN<PV>(B, outv, ent, cf, b + 1, lane);
                }
            }
#pragma unroll
            for (int s = 0; s < 4; ++s) {
                f32x4* o = (f32x4*)(xres + (size_t)(m4 + s) * 1024 + lane * 16);
#pragma unroll
                for (int j = 0; j < 4; ++j) { f32x4 a0 = o[j]; a0 += (f32x4){outv[s][4 * j], outv[s][4 * j + 1], outv[s][4 * j + 2], outv[s][4 * j + 3]} * oscale; o[j] = a0; }
            }
        }
        if (rnd + 1 < nrounds) xcd_barrier(xbar);
    }
}

__device__ __forceinline__ void cvt_table_i8(const Frame& F, const float* src, unsigned char* dst, float* scales, const int skip) {
    const int nb = F.G > skip ? F.G - skip : F.G, b0 = F.G > skip ? F.bid - skip : F.bid;
    const int gw = b0 * NWAVES + F.wave, NGW = nb * NWAVES, lane = F.lane;
    if (b0 >= 0) for (int r = gw; r < 16384; r += NGW) {
        const f32x4* p = (const f32x4*)(src + (size_t)r * 1024 + lane * 16);
        f32x4 v[4]; float am = 0.f;
#pragma unroll
        for (int j = 0; j < 4; ++j) { v[j] = p[j]; am = fmaxf(am, fmaxf(fmaxf(fabsf(v[j].x), fabsf(v[j].y)), fmaxf(fabsf(v[j].z), fabsf(v[j].w)))); }
#pragma unroll
        for (int o = 1; o < 64; o <<= 1) am = fmaxf(am, __shfl_xor(am, o));
        const float sc = am > 0.f ? am * (1.0f / 127.0f) : 1.0f, inv = 1.0f / sc;
        u32x4 q;
#pragma unroll
        for (int j = 0; j < 4; ++j) { const int a = (int)rintf(v[j].x * inv), b = (int)rintf(v[j].y * inv), c = (int)rintf(v[j].z * inv), d = (int)rintf(v[j].w * inv);
            q[j] = (unsigned)(a & 255) | ((unsigned)(b & 255) << 8) | ((unsigned)(c & 255) << 16) | ((unsigned)(d & 255) << 24); }
        *(u32x4*)(dst + (size_t)r * 1024 + lane * 16) = q;
        if (lane == 0) scales[r] = sc;
    }
}
template <int NR>
__device__ __forceinline__ void peer_u8i(const RowBufN<NR>& rb, int r0, const LAS unsigned char* xq, const LAS unsigned* ent, LAS float* cf, const LAS float* sul, int e0, int lane) {
    int pr[8];
    const int ev = (int)ent[e0 + (lane & 7)];
#pragma unroll
    for (int i = 0; i < 8; ++i) {
        const int slot = (__builtin_amdgcn_readlane(ev, i) >> 21) & 3;
        const u32x4 xv = *(const LAS u32x4*)(xq + slot * 1024 + lane * 16);
        const u32x4 q = rb.a[r0 + i];
        int s = __builtin_amdgcn_sdot4((int)xv.x, (int)q.x, 0, false); s = __builtin_amdgcn_sdot4((int)xv.y, (int)q.y, s, false);
        s = __builtin_amdgcn_sdot4((int)xv.z, (int)q.z, s, false); s = __builtin_amdgcn_sdot4((int)xv.w, (int)q.w, s, false);
        pr[i] = s;
    }
    int r4[4], r2[2], r1;
    { const bool up = (lane & 32) != 0;
#pragma unroll
      for (int i = 0; i < 4; ++i) { const int keep = up ? pr[i + 4] : pr[i], send = up ? pr[i] : pr[i + 4]; r4[i] = keep + __shfl_xor(send, 32); } }
    { const bool up = (lane & 16) != 0;
#pragma unroll
      for (int i = 0; i < 2; ++i) { const int keep = up ? r4[i + 2] : r4[i], send = up ? r4[i] : r4[i + 2]; r2[i] = keep + __shfl_xor(send, 16); } }
    { const bool up = (lane & 8) != 0; const int keep = up ? r2[1] : r2[0], send = up ? r2[0] : r2[1]; r1 = keep + __shfl_xor(send, 8); }
    r1 += __shfl_xor(r1, 4); r1 += __shfl_xor(r1, 2); r1 += __shfl_xor(r1, 1);
    const float gate = cf[e0 + (lane >> 3)];
    const float coef = gate * gelu_tanh((float)r1 * sul[e0 + (lane >> 3)]);
    if ((lane & 7) == 0) cf[e0 + (lane >> 3)] = coef;
}
template <bool FAKE>
__device__ __forceinline__ f32x2 cvt8(unsigned w, bool hi) {
    if (FAKE) { const unsigned t = hi ? (w >> 16) : w; return (f32x2){__builtin_bit_cast(float, (t << 23) | 0x30000000u), __builtin_bit_cast(float, ((t >> 8) << 23) | 0x30000000u)}; }
    return hi ? __builtin_amdgcn_cvt_pk_f32_fp8((int)w, true) : __builtin_amdgcn_cvt_pk_f32_fp8((int)w, false);
}
template <bool FAKE = false>
__device__ __forceinline__ void peer_acc8p(f32x2 (&o)[8], const float c, const u32x4 q) {
    const f32x2 c2 = {c, c};
#pragma unroll
    for (int j = 0; j < 4; ++j) { const f32x2 lo = cvt8<FAKE>(q[j], false), hi = cvt8<FAKE>(q[j], true);
        o[2 * j] += c2 * lo; o[2 * j + 1] += c2 * hi; }
}
template <int NR, bool FAKE>
__device__ __forceinline__ void peer_vNp(const RowBufN<NR>& rb, f32x2 (&outv)[4][8], const LAS unsigned* ent, const LAS float* cf, int b, int lane) {
    const int ev = (int)ent[b * NR + (lane & (NR - 1))]; const float cv = cf[b * NR + (lane & (NR - 1))];
    int slot[NR]; float c[NR];
#pragma unroll
    for (int i = 0; i < NR; ++i) { slot[i] = (__builtin_amdgcn_readlane(ev, i) >> 21) & 3; c[i] = rdlane_f(cv, i); }
#pragma unroll
    for (int q4 = 0; q4 < NR / 4; ++q4) {
#pragma unroll
        for (int s = 0; s < 4; ++s) {
#pragma unroll
            for (int i = 4 * q4; i < 4 * q4 + 4; ++i) if (slot[i] == s) peer_acc8p<FAKE>(outv[s], c[i], rb.a[i]);
            __builtin_amdgcn_sched_barrier(0);
        }
    }
}
template <int PV, bool FAKE>
__device__ __forceinline__ void peer_passv(f32x2 (&outv)[4][8], const unsigned char* TV, const LAS unsigned* ent, const LAS float* cf, int lane) {
    RowBufN<PV> A, B, C;
    constexpr int NBV = 512 / PV;
    peer_loadN<PV>(A, TV, ent, 0, lane); peer_loadN<PV>(B, TV, ent, 1, lane);
#pragma unroll 1
    for (int b = 0; b + 2 < NBV; b += 3) {
        peer_loadN<PV>(C, TV, ent, b + 2, lane);
        peer_vNp<PV, FAKE>(A, outv, ent, cf, b, lane);
        if (b + 3 < NBV) peer_loadN<PV>(A, TV, ent, b + 3, lane);
        peer_vNp<PV, FAKE>(B, outv, ent, cf, b + 1, lane);
        if (b + 4 < NBV) peer_loadN<PV>(B, TV, ent, b + 4, lane);
        peer_vNp<PV, FAKE>(C, outv, ent, cf, b + 2, lane);
    }
    peer_vNp<PV, FAKE>(A, outv, ent, cf, NBV - 1, lane);
}
__device__ __forceinline__ void p_peer_expert5(const Frame& F, unsigned char* ws, float* xres, const float oscale, const XcdBarrier& xbar, const int mode, const bool do_norm) {
    const bf16_t* XN = (const bf16_t*)(ws + WS_XN); const unsigned char* TU = ws + WS_TAB8U; const unsigned char* TV = ws + WS_TAB8V;
    const float* SU = (const float*)(ws + WS_TABSU); const float* SV = (const float*)(ws + WS_TABSV);
    const unsigned short* EID = (const unsigned short*)(ws + PE_EID); const float* GATE = (const float*)(ws + PE_GATE);
    const int gw = F.bid * NWAVES + F.wave, NGW = F.G * NWAVES, lane = F.lane;
    LAS unsigned* ent = (LAS unsigned*)(F.lds + F.wave * 6144);
    LAS float* cf = (LAS float*)(F.lds + F.wave * 6144 + 2048);
    LAS float* sul = (LAS float*)(F.lds + F.wave * 6144 + 4096);
    LAS unsigned char* xq = F.lds + 49152 + F.wave * 4096;
    constexpr int PU = 8, PV = 8;
    const int nrounds = (T + NGW * 4 - 1) / (NGW * 4);
    for (int rnd = 0; rnd < nrounds; ++rnd) {
        const int m4 = (rnd * NGW + gw) * 4;
        if (m4 < T) {
            {
                float sx[4];
#pragma unroll
                for (int s = 0; s < 4; ++s) { const size_t m = (size_t)(m4 + s);
                    const u32x4 xa = *(const u32x4*)(XN + m * 1024 + lane * 16), xb = *(const u32x4*)(XN + m * 1024 + lane * 16 + 8);
                    float xf[16] = {bf_lo(xa.x), bf_hi(xa.x), bf_lo(xa.y), bf_hi(xa.y), bf_lo(xa.z), bf_hi(xa.z), bf_lo(xa.w), bf_hi(xa.w),
                                    bf_lo(xb.x), bf_hi(xb.x), bf_lo(xb.y), bf_hi(xb.y), bf_lo(xb.z), bf_hi(xb.z), bf_lo(xb.w), bf_hi(xb.w)};
                    float am = 0.f;
#pragma unroll
                    for (int i = 0; i < 16; ++i) am = fmaxf(am, fabsf(xf[i]));
#pragma unroll
                    for (int o = 1; o < 64; o <<= 1) am = fmaxf(am, __shfl_xor(am, o));
                    sx[s] = am > 0.f ? am * (1.0f / 127.0f) : 1.0f; const float inv = 1.0f / sx[s];
                    u32x4 q;
#pragma unroll
                    for (int j = 0; j < 4; ++j) { const int a = (int)rintf(xf[4 * j] * inv), b = (int)rintf(xf[4 * j + 1] * inv), c = (int)rintf(xf[4 * j + 2] * inv), d = (int)rintf(xf[4 * j + 3] * inv);
                        q[j] = (unsigned)(a & 255) | ((unsigned)(b & 255) << 8) | ((unsigned)(c & 255) << 16) | ((unsigned)(d & 255) << 24); }
                    *(LAS u32x4*)(xq + s * 1024 + lane * 16) = q; }
                int id[4][2]; float gg[4][2], su[4][2];
#pragma unroll
                for (int s = 0; s < 4; ++s) { const size_t m = (size_t)(m4 + s);
                    id[s][0] = EID[m * 128 + lane]; id[s][1] = EID[m * 128 + 64 + lane];
                    gg[s][0] = GATE[m * 128 + lane] * SV[id[s][0]]; gg[s][1] = GATE[m * 128 + 64 + lane] * SV[id[s][1]];
                    su[s][0] = SU[id[s][0]] * sx[s]; su[s][1] = SU[id[s][1]] * sx[s]; }
                int base = 0;
#pragma unroll 1
                for (int k = 0; k < 16; ++k) {
                    const int r = (rnd & 1) ? 15 - k : k;
#pragma unroll
                    for (int s = 0; s < 4; ++s)
#pragma unroll
                        for (int w = 0; w < 2; ++w) {
                            const bool hit = (id[s][w] >> 10) == r;
                            const u64 m = __ballot(hit);
                            if (hit) { const int pos = base + (int)__builtin_amdgcn_mbcnt_hi((unsigned)(m >> 32), __builtin_amdgcn_mbcnt_lo((unsigned)m, 0u));
                                ent[pos] = ((unsigned)s << 21) | ((unsigned)(w * 64 + lane) << 14) | (unsigned)(mode == 4 ? (id[s][w] & 7) : id[s][w]); cf[pos] = gg[s][w]; sul[pos] = su[s][w]; }
                            base += __builtin_popcountll(m);
                        }
                }
            }
            LDS_WAIT();
            if (mode != 1 && mode != 3) {
                RowBufN<PU> A, B, C;
                constexpr int NBU = 512 / PU;
                peer_loadN<PU>(A, TU, ent, 0, lane); peer_loadN<PU>(B, TU, ent, 1, lane);
#pragma unroll 1
                for (int b = 0; b + 2 < NBU; b += 3) {
                    peer_loadN<PU>(C, TU, ent, b + 2, lane);
                    peer_u8i<PU>(A, 0, xq, ent, cf, sul, b * PU, lane);
                    if (b + 3 < NBU) peer_loadN<PU>(A, TU, ent, b + 3, lane);
                    peer_u8i<PU>(B, 0, xq, ent, cf, sul, (b + 1) * PU, lane);
                    if (b + 4 < NBU) peer_loadN<PU>(B, TU, ent, b + 4, lane);
                    peer_u8i<PU>(C, 0, xq, ent, cf, sul, (b + 2) * PU, lane);
                }
                peer_u8i<PU>(A, 0, xq, ent, cf, sul, (NBU - 1) * PU, lane);
            }
            LDS_WAIT();
            f32x2 outv[4][8];
#pragma unroll
            for (int s = 0; s < 4; ++s)
#pragma unroll
                for (int i = 0; i < 8; ++i) outv[s][i] = (f32x2){0.f, 0.f};
            if (mode != 1 && mode != 2) {
                if (mode == 5) peer_passv<PV, true>(outv, TV, ent, cf, lane); else peer_passv<PV, false>(outv, TV, ent, cf, lane);
            }
            asm volatile("" ::: "memory"); __builtin_amdgcn_sched_barrier(0);
#pragma unroll
            for (int s = 0; s < 4; ++s) {
                f32x4* o = (f32x4*)(xres + (size_t)(m4 + s) * 1024 + lane * 16);
                f32x4 nv[4]; float ss = 0.f;
#pragma unroll
                for (int j = 0; j < 4; ++j) { f32x4 a0 = o[j]; const f32x4 add = (f32x4){outv[s][2 * j].x, outv[s][2 * j].y, outv[s][2 * j + 1].x, outv[s][2 * j + 1].y};
                    if (oscale != 0.f) a0 += add; else asm volatile("" :: "v"(add)); o[j] = a0; nv[j] = a0;
                    ss += (a0.x * a0.x + a0.y * a0.y) + (a0.z * a0.z + a0.w * a0.w); }
                if (do_norm && oscale != 0.f) {
                    const float rstd = 1.0f / sqrtf(wave_sum(ss) * (1.f / DM) + 1e-6f);
                    const f32x4* gp = (const f32x4*)((const float*)(ws + WS_CMPB + 4096) + lane * 16);
                    u32x4 w0, w1;
                    { const f32x4 g0 = gp[0], g1 = gp[1], g2 = gp[2], g3 = gp[3];
                      w0.x = pk2(nv[0].x * rstd * g0.x, nv[0].y * rstd * g0.y); w0.y = pk2(nv[0].z * rstd * g0.z, nv[0].w * rstd * g0.w);
                      w0.z = pk2(nv[1].x * rstd * g1.x, nv[1].y * rstd * g1.y); w0.w = pk2(nv[1].z * rstd * g1.z, nv[1].w * rstd * g1.w);
                      w1.x = pk2(nv[2].x * rstd * g2.x, nv[2].y * rstd * g2.y); w1.y = pk2(nv[2].z * rstd * g2.z, nv[2].w * rstd * g2.w);
                      w1.z = pk2(nv[3].x * rstd * g3.x, nv[3].y * rstd * g3.y); w1.w = pk2(nv[3].z * rstd * g3.z, nv[3].w * rstd * g3.w); }
                    u32x4* xo = (u32x4*)((bf16_t*)(ws + WS_XN) + (size_t)(m4 + s) * 1024 + lane * 16);
                    xo[0] = w0; xo[1] = w1;
                }
                asm volatile("" ::: "memory"); __builtin_amdgcn_sched_barrier(0);
            }
        }
    }
}

constexpr size_t L1_QN = WS_R3;
constexpr size_t L1_KS = WS_R3 + 32 * MiB;
constexpr size_t L1_KW = WS_R3 + 40 * MiB;
constexpr size_t L1_VST = WS_R3 + 48 * MiB;
constexpr size_t L1_VWT = WS_R3 + 56 * MiB;
constexpr size_t L1_KCR = WS_R3 + 64 * MiB;
constexpr size_t L1_VCR = WS_R3 + 72 * MiB;
constexpr size_t L1_GATES = WS_R3 + 81 * MiB;
constexpr size_t L1_H1 = WS_R3 + 84 * MiB;
constexpr size_t L1_CMPO = WS_R3 + 88 * MiB;
constexpr size_t L1_KC = WS_R3 + 90 * MiB;
constexpr size_t L1_VCT = WS_R3 + 91 * MiB;
constexpr size_t L1_SELB = WS_R3 + 92 * MiB;
constexpr size_t L1_OC = WS_TABU;
constexpr size_t L1_CAT = WS_XN;
constexpr size_t L1_UPD = WS_R3;
constexpr size_t L1_DECAY = WS_R3 + 128 * MiB;

__device__ __forceinline__ void p_l1_prep(const Frame& F, const Args& a, unsigned char* ws) {
    const bf16_t* P = (const bf16_t*)(ws + WS_PROJ);
    const f32x2* rope = (const f32x2*)(ws + WS_ROPE);
    bf16_t* QN = (bf16_t*)(ws + L1_QN); bf16_t* KS = (bf16_t*)(ws + L1_KS); bf16_t* KW = (bf16_t*)(ws + L1_KW);
    bf16_t* KCR = (bf16_t*)(ws + L1_KCR); bf16_t* VCR = (bf16_t*)(ws + L1_VCR); float* GATES = (float*)(ws + L1_GATES);
    const int gw = F.bid * NWAVES + F.wave, NGW = F.G * NWAVES, lane = F.lane, hs = lane >> 3, sub = lane & 7;
    float qg[8], kg[8];
#pragma unroll
    for (int j = 0; j < 8; ++j) { qg[j] = a.in[I_L1_QG][sub * 8 + j]; kg[j] = a.in[I_L1_KG][sub * 8 + j]; }
    const int srccol = (hs < 2) ? C1_KS + hs * 64 : (hs < 4) ? C1_KW + (hs - 2) * 64 : (hs < 6) ? C1_KC + (hs - 4) * 64 : C1_VC + (hs - 6) * 64;
    bf16_t* dstbuf = (hs < 2) ? KS : (hs < 4) ? KW : (hs < 6) ? KCR : VCR;
    const int g2 = hs & 1;
    for (int m = gw; m < T; m += NGW) {
        const int b = m >> 12, t = m & 4095;
        const bf16_t* row = P + (size_t)m * N_IN1;
        f32x2 cs[8];
#pragma unroll
        for (int j = 0; j < 4; ++j) { const f32x4 c4 = *(const f32x4*)(rope + t * 32 + (sub & 3) * 8 + 2 * j); cs[2 * j] = (f32x2){c4.x, c4.y}; cs[2 * j + 1] = (f32x2){c4.z, c4.w}; }
        float v[8];
        head8_load(row + C1_Q + lane * 8, v); head8_norm(v, qg); head8_rope(v, cs, sub >= 4); head8_store(QN + (size_t)m * 512 + lane * 8, v, 0.125f);
        {
            const u32x4 raw = *(const u32x4*)(row + srccol + sub * 8);
            v[0] = bf_lo(raw.x); v[1] = bf_hi(raw.x); v[2] = bf_lo(raw.y); v[3] = bf_hi(raw.y); v[4] = bf_lo(raw.z); v[5] = bf_hi(raw.z); v[6] = bf_lo(raw.w); v[7] = bf_hi(raw.w);
            head8_norm(v, kg); head8_rope(v, cs, sub >= 4);
            u32x4 q; q.x = pk2(v[0], v[1]); q.y = pk2(v[2], v[3]); q.z = pk2(v[4], v[5]); q.w = pk2(v[6], v[7]);
            if (hs >= 4) q = raw;
            *(u32x4*)(dstbuf + ((size_t)(b * 2 + g2) * 4096 + t) * 64 + sub * 8) = q;
        }
        if (lane < 24) GATES[(size_t)m * 24 + lane] = sigmoidf_(bf2f(row[C1_GL + lane]));
    }
    for (int it = gw; it < 2 * NB * 2 * 64; it += NGW) {
        const int tb = it & 63, g = (it >> 6) & 1, b = (it >> 7) & 7, w = it >> 10;
        const size_t m = (size_t)b * 4096 + tb * 64 + lane;
        unsigned r[32];
#pragma unroll
        for (int j = 0; j < 8; ++j) { const u32x4 q = *(const u32x4*)(P + m * N_IN1 + (w ? C1_VW : C1_VS) + g * 64 + j * 8); r[4 * j] = q.x; r[4 * j + 1] = q.y; r[4 * j + 2] = q.z; r[4 * j + 3] = q.w; }
        bf16_t* dst = (bf16_t*)(ws + (w ? L1_VWT : L1_VST)) + ((size_t)(b * 2 + g) * 64) * 4096 + tb * 64 + lane;
#pragma unroll
        for (int d = 0; d < 64; ++d) dst[(size_t)d * 4096] = (bf16_t)((d & 1) ? (r[d >> 1] >> 16) : (r[d >> 1] & 0xffffu));
    }
}

namespace pg8 {
struct EpiCmp1 {
    static constexpr bool PERM = true;
    bf16_t* O; const float* bias;
    __device__ __forceinline__ void operator()(const f32x4 (&acc)[2][2][4][2], const Unit& u, int wr, int wc, int fr, int fq) const {
        const int row0 = u.pm * BM + wr * 64 + fr, col0 = wc * 32 + 8 * fq;
#pragma unroll
        for (int ai = 0; ai < 2; ++ai)
#pragma unroll
            for (int m = 0; m < 4; ++m) { bf16_t* rowp = O + (size_t)(row0 + ai * HALF + m * 16) * 256 + col0;
#pragma unroll
                for (int bj = 0; bj < 2; ++bj) { const float* bp = bias + u.pn * 256 + col0 + bj * HALF;
                    const f32x4 v0 = acc[ai][bj][m][0] + *(const f32x4*)bp, v1 = acc[ai][bj][m][1] + *(const f32x4*)(bp + 4);
                    u32x4 w; w.x = pk2(gelu_tanh(v0[0]), gelu_tanh(v0[1])); w.y = pk2(gelu_tanh(v0[2]), gelu_tanh(v0[3]));
                    w.z = pk2(gelu_tanh(v1[0]), gelu_tanh(v1[1])); w.w = pk2(gelu_tanh(v1[2]), gelu_tanh(v1[3]));
                    *(u32x4*)(rowp + bj * HALF) = w; }
                asm volatile("" ::: "memory"); __builtin_amdgcn_sched_barrier(0); }
    }
};
struct EpiCmp2 {
    static constexpr bool PERM = false;
    float* C;
    __device__ __forceinline__ void operator()(const f32x4 (&acc)[2][2][4][2], const Unit& u, int wr, int wc, int fr, int fq) const {
        if (wc >= 2) return;
        const int row0 = u.pm * BM + wr * 64 + fr, col0 = wc * 32 + 4 * fq;
#pragma unroll
        for (int ai = 0; ai < 2; ++ai)
#pragma unroll
            for (int m = 0; m < 4; ++m)
#pragma unroll
                for (int n = 0; n < 2; ++n) *(f32x4*)(C + (size_t)(row0 + ai * HALF + m * 16) * 64 + col0 + n * 16) = acc[ai][0][m][n];
    }
};
}

__device__ __forceinline__ void p_cmp_final(const Frame& F, const Args& a, unsigned char* ws) {
    const float* CMPO = (const float*)(ws + L1_CMPO); const f32x2* rope = (const f32x2*)(ws + WS_ROPE);
    bf16_t* KC = (bf16_t*)(ws + L1_KC); bf16_t* VCT = (bf16_t*)(ws + L1_VCT);
    const int gw = F.bid * NWAVES + F.wave, NGW = F.G * NWAVES, lane = F.lane;
    const float kg = a.in[I_L1_KG][lane];
    for (int r = gw; r < 8192; r += NGW) {
        float v = CMPO[(size_t)r * 64 + lane];
        const int rr = r & 4095, bg = rr >> 8, c = rr & 255;
        if (r < 4096) {
            const float ss = wave_sum(v * v);
            v = v * (1.0f / sqrtf(ss * (1.f / 64.f) + 1e-6f)) * kg;
            const int pos = (c < 255) ? 16 * c + 31 : 0;
            v = rope_apply(v, rope[pos * 32 + (lane & 31)], lane);
            KC[((size_t)bg * 256 + c) * 64 + lane] = (c < 255) ? (bf16_t)f2bf(v) : (bf16_t)0;
        } else {
            VCT[((size_t)bg * 64 + lane) * 256 + c] = (c < 255) ? (bf16_t)f2bf(v) : (bf16_t)0;
        }
    }
}

__device__ __forceinline__ void att_load2(AttStage& s, const bf16_t* Kg, const bf16_t* Vtg, int vstride, int key0, int tid) {
    s.kreg = *(const u32x4*)(Kg + (size_t)(key0 + (tid >> 3)) * 64 + (tid & 7) * 8);
    s.vreg = *(const u32x4*)(Vtg + (size_t)(tid >> 3) * vstride + key0 + (tid & 7) * 8);
}
__device__ __forceinline__ float score_bound_c2(const float* qg, const float* kg) {
    float mq = 0.f, mk_ = 0.f;
    for (int i = 0; i < 64; ++i) { mq = fmaxf(mq, fabsf(qg[i])); mk_ = fmaxf(mk_, fabsf(kg[i])); }
    return (8.0f * mq * mk_ + 0.5f) * 1.4426950408889634f;
}

constexpr int CA_KB = 256 * 144, CA_VSTR = 528, CA_VB = 64 * CA_VSTR, CA_IMP = CA_KB + CA_VB;
__device__ __forceinline__ void p_cmp_attn(const Frame& F, const Args& a, unsigned char* ws) {
    const bf16_t* QN = (const bf16_t*)(ws + L1_QN); const bf16_t* KC = (const bf16_t*)(ws + L1_KC); const bf16_t* VCT = (const bf16_t*)(ws + L1_VCT);
    float* OC = (float*)(ws + L1_OC); u64* SELB = (u64*)(ws + L1_SELB);
    LAS float* impL = (LAS float*)(F.lds + CA_IMP);
    const int lane = F.lane, wave = F.wave, h = lane >> 5, c = lane & 31, tid = F.tid;
    const float c2 = score_bound_c2(a.in[I_L1_QG], a.in[I_L1_KG]), c1 = 1.4426950408889634f;
    for (int u = F.bid; u < 1024; u += F.G) {
        const int b = (u >> 7) & 7, g = (u >> 6) & 1, rnd = u >> 8, qt = (rnd & 1) ? 63 - (u & 63) : (u & 63), q0 = qt * 64;
        const int bg = b * 2 + g; const size_t mb = (size_t)b * 4096;
        const int t = q0 + wave * 8 + (c >> 2), head = g * 4 + (c & 3);
        bf16x8 Qf[4];
#pragma unroll
        for (int ks = 0; ks < 4; ++ks) Qf[ks] = *(const bf16x8*)(QN + (mb + t) * 512 + head * 64 + ks * 16 + 8 * h);
        const int L = (t >= 31) ? (((t - 31) >> 4) < 254 ? ((t - 31) >> 4) : 254) : -1;
        const int tmax = q0 + 63; const int Lmax = (tmax >= 31) ? (((tmax - 31) >> 4) < 254 ? ((tmax - 31) >> 4) : 254) : -1;
        const int nkt = (Lmax >= 0) ? (Lmax >> 6) + 1 : 0;
        const bf16_t* Kg = KC + (size_t)bg * 256 * 64; const bf16_t* Vtg = VCT + (size_t)bg * 64 * 256;
        __syncthreads();
        for (int i = tid; i < nkt * 512; i += NTHREADS) {
            const int key = i >> 3, ch = i & 7;
            *(LAS u32x4*)(F.lds + key * 144 + ch * 16) = *(const u32x4*)(Kg + (size_t)key * 64 + ch * 8);
        }
        for (int i = tid; i < 64 * nkt * 8; i += NTHREADS) {
            const int d = i / (nkt * 8), ch = i % (nkt * 8);
            const u32x4 v = *(const u32x4*)(Vtg + (size_t)d * 256 + ch * 8);
            LAS unsigned char* p = F.lds + CA_KB + d * CA_VSTR + ch * 16;
            *(LAS u32x2*)p = (u32x2){v.x, v.y}; *(LAS u32x2*)(p + 8) = (u32x2){v.z, v.w};
        }
        __syncthreads();
        f32x16 O[2], IMP[2]; float l = 0.f;
#pragma unroll
        for (int i = 0; i < 16; ++i) { O[0][i] = 0.f; O[1][i] = 0.f; IMP[0][i] = 0.f; IMP[1][i] = 0.f; }
        for (int st = 0; st < nkt * 2; ++st) {
            f32x16 S = {0.f, 0.f, 0.f, 0.f, 0.f, 0.f, 0.f, 0.f, 0.f, 0.f, 0.f, 0.f, 0.f, 0.f, 0.f, 0.f};
            { const LAS unsigned char* kp = F.lds + (st * 32 + c) * 144 + h * 16;
#pragma unroll
              for (int ks = 0; ks < 4; ++ks) S = __builtin_amdgcn_mfma_f32_32x32x16_bf16(*(const LAS bf16x8*)(kp + ks * 32), Qf[ks], S, 0, 0, 0); }
            float p[16];
#pragma unroll
            for (int i = 0; i < 16; ++i) {
                const int cidx = st * 32 + (i & 3) + 8 * (i >> 2) + 4 * h;
                const float e = __builtin_amdgcn_exp2f(S[i] * c1 - c2);
                p[i] = (cidx <= L) ? e : 0.f; l += p[i];
            }
            const bf16x8 P0 = pack8(p[0], p[1], p[2], p[3], p[4], p[5], p[6], p[7]);
            const bf16x8 P1 = pack8(p[8], p[9], p[10], p[11], p[12], p[13], p[14], p[15]);
#pragma unroll
            for (int dt = 0; dt < 2; ++dt) {
                const LAS unsigned char* vp = F.lds + CA_KB + (dt * 32 + c) * CA_VSTR + (st * 32 + 4 * h) * 2;
                const u32x2 a0 = *(const LAS u32x2*)(vp), a1 = *(const LAS u32x2*)(vp + 16), b0 = *(const LAS u32x2*)(vp + 32), b1 = *(const LAS u32x2*)(vp + 48);
                O[dt] = __builtin_amdgcn_mfma_f32_32x32x16_bf16(__builtin_bit_cast(bf16x8, ((u32x4){a0.x, a0.y, a1.x, a1.y})), P0, O[dt], 0, 0, 0);
                O[dt] = __builtin_amdgcn_mfma_f32_32x32x16_bf16(__builtin_bit_cast(bf16x8, ((u32x4){b0.x, b0.y, b1.x, b1.y})), P1, O[dt], 0, 0, 0);
            }
#pragma unroll
            for (int jt = 0; jt < 2; ++jt)
#pragma unroll
                for (int s = 0; s < 2; ++s) {
                    unsigned wv[4];
#pragma unroll
                    for (int e2 = 0; e2 < 4; ++e2) {
                        unsigned pr = 0u;
#pragma unroll
                        for (int q = 0; q < 2; ++q) { const int jj = 2 * e2 + q; const int kap = 16 * s + 8 * (jj >> 2) + 4 * h + (jj & 3);
                            const int off = st * 32 + kap - 4 * (32 * jt + c);
                            const unsigned wbits = (off == 0 || off == 4) ? 0x3F80u : ((off >= 1 && off <= 3) ? 0x4000u : 0u);
                            pr |= wbits << (16 * q); }
                        wv[e2] = pr;
                    }
                    const bf16x8 Wf = __builtin_bit_cast(bf16x8, ((u32x4){wv[0], wv[1], wv[2], wv[3]}));
                    IMP[jt] = __builtin_amdgcn_mfma_f32_32x32x16_bf16(Wf, s ? P1 : P0, IMP[jt], 0, 0, 0);
                }
        }
        const float lt = l + __shfl_xor(l, 32);
        const float inv = 1.0f / fmaxf(lt, 1e-30f);
        { float* orow = OC + (mb + t) * 512 + head * 64;
#pragma unroll
          for (int dt = 0; dt < 2; ++dt)
#pragma unroll
            for (int i4 = 0; i4 < 4; ++i4) { const int d = dt * 32 + 8 * i4 + 4 * h;
                *(f32x4*)(orow + d) = (f32x4){O[dt][4 * i4] * inv, O[dt][4 * i4 + 1] * inv, O[dt][4 * i4 + 2] * inv, O[dt][4 * i4 + 3] * inv}; } }
#pragma unroll
        for (int jt = 0; jt < 2; ++jt)
#pragma unroll
            for (int i = 0; i < 16; ++i) {
                float v = IMP[jt][i] * inv; v += __shfl_xor(v, 1); v += __shfl_xor(v, 2);
                if ((c & 3) == 0) impL[(wave * 8 + (c >> 2)) * 65 + 32 * jt + (i & 3) + 8 * (i >> 2) + 4 * h] = v;
            }
        __syncthreads();
        if (tid < 64) {
            const int tq = q0 + tid, cur = tq >> 6;
            u64 mask;
            if (cur + 1 <= 16) mask = (1ull << (cur + 1)) - 1ull;
            else {
                unsigned top[16];
#pragma unroll
                for (int blk = 0; blk < 4; ++blk) {
                    unsigned k16[16];
#pragma unroll
                    for (int i = 0; i < 16; ++i) { const int j = blk * 16 + i; const float x = impL[tid * 65 + j];
                        const unsigned key = (j > cur) ? 0u : ((j == 0 || j == cur) ? 0xFFFFFFC0u : (mono_u32(x) & ~0x3Fu)) | (unsigned)(63 - j);
                        k16[i] = (j > cur) ? 0u : key; }
                    sort16_desc(k16);
                    if (blk == 0) {
#pragma unroll
                        for (int i = 0; i < 16; ++i) top[i] = k16[i];
                    } else merge16_desc(top, k16);
                }
                mask = 0ull;
#pragma unroll
                for (int i = 0; i < 16; ++i) mask |= 1ull << (63 - (int)(top[i] & 63u));
            }
            SELB[(size_t)bg * 4096 + tq] = mask;
        }
    }
}

__device__ __forceinline__ void p_nsa_attn(const Frame& F, const Args& a, unsigned char* ws) {
    const bf16_t* QN = (const bf16_t*)(ws + L1_QN);
    const u64* SELB = (const u64*)(ws + L1_SELB); float* OC = (float*)(ws + L1_OC); const float* GATES = (const float*)(ws + L1_GATES);
    bf16_t* CAT = (bf16_t*)(ws + L1_CAT);
    const int lane = F.lane, wave = F.wave, h = lane >> 5, c = lane & 31, tid = F.tid;
    const float c2 = score_bound_c2(a.in[I_L1_QG], a.in[I_L1_KG]), c1 = 1.4426950408889634f;
    for (int u = F.bid; u < 512; u += F.G) {
        const int idx = u & 255, g = u >> 8, b = idx >> 5, qtr = idx & 31, qt = g ? 31 - qtr : qtr, q0 = qt * 128;
        const int bg = b * 2 + g; const size_t mb = (size_t)b * 4096;
        bf16x8 Qf[2][4]; int qidx[2];
#pragma unroll
        for (int ct = 0; ct < 2; ++ct) { qidx[ct] = q0 + wave * 16 + ct * 8 + (c >> 2);
#pragma unroll
            for (int ks = 0; ks < 4; ++ks) Qf[ct][ks] = *(const bf16x8*)(QN + (mb + qidx[ct]) * 512 + (g * 4 + (c & 3)) * 64 + ks * 16 + 8 * h); }
        const int head = g * 4 + (c & 3);
#pragma unroll 1
        for (int pass = 0; pass < 2; ++pass) {
            const bf16_t* Kg = (const bf16_t*)(ws + (pass ? L1_KW : L1_KS)) + (size_t)bg * 4096 * 64;
            const bf16_t* Vtg = (const bf16_t*)(ws + (pass ? L1_VWT : L1_VST)) + (size_t)bg * 64 * 4096;
            u64 selw[2];
#pragma unroll
            for (int ct = 0; ct < 2; ++ct) selw[ct] = pass ? ~0ull : SELB[(size_t)bg * 4096 + qidx[ct]];
            const int wlen = pass ? 512 : 0x7fffffff;
            f32x16 O[2][2]; float l[2] = {0.f, 0.f};
#pragma unroll
            for (int ct = 0; ct < 2; ++ct)
#pragma unroll
                for (int dt = 0; dt < 2; ++dt)
#pragma unroll
                    for (int i = 0; i < 16; ++i) O[ct][dt][i] = 0.f;
            const int kt_lo = pass ? ((2 * qt - 8) > 0 ? 2 * qt - 8 : 0) : 0, kt_hi = 2 * qt + 2;
            AttStage st; att_load(st, Kg, Vtg, kt_lo * 64, tid);
            __syncthreads();
            att_store(st, F.lds + (kt_lo & 1) * AT_BUF, tid);
            __syncthreads();
            for (int kt = kt_lo; kt < kt_hi; ++kt) {
                LAS unsigned char* buf = F.lds + (kt & 1) * AT_BUF;
                if (kt + 1 < kt_hi) att_load(st, Kg, Vtg, (kt + 1) * 64, tid);
#pragma unroll 1
                for (int sub = 0; sub < 2; ++sub) {
                    bf16x8 Kf[4];
                    att_kfrags(buf, sub, Kf, lane);
#pragma unroll
                    for (int ct = 0; ct < 2; ++ct) {
                        __builtin_amdgcn_sched_barrier(0);
                        const f32x16 S = att_qk_f(Kf, Qf[ct]);
                        const bool flag = (selw[ct] >> kt) & 1ull;
                        const int tq = qidx[ct];
                        const float c2e = flag ? c2 : 3.0e30f;
                        float p[16];
                        const int dbase = tq - (kt * 64 + sub * 32 + 4 * h);
#pragma unroll
                        for (int i = 0; i < 16; ++i) {
                            const float e = __builtin_amdgcn_exp2f(S[i] * c1 - c2e);
                            p[i] = ((unsigned)(dbase - ((i & 3) + 8 * (i >> 2))) < (unsigned)wlen) ? e : 0.f; l[ct] += p[i];
                        }
                        const bf16x8 P0 = pack8(p[0], p[1], p[2], p[3], p[4], p[5], p[6], p[7]);
                        const bf16x8 P1 = pack8(p[8], p[9], p[10], p[11], p[12], p[13], p[14], p[15]);
                        att_pv2(buf, sub, P0, P1, O[ct], lane);
                    }
                }
                if (kt + 1 < kt_hi) att_store(st, F.lds + ((kt + 1) & 1) * AT_BUF, tid);
                __syncthreads();
            }
#pragma unroll
            for (int ct = 0; ct < 2; ++ct) {
                const float lt = l[ct] + __shfl_xor(l[ct], 32);
                const float inv = 1.0f / fmaxf(lt, 1e-30f);
                const size_t m = mb + qidx[ct];
                const float gcv = GATES[m * 24 + head * 3 + 0], gsv = GATES[m * 24 + head * 3 + 1], gwv = GATES[m * 24 + head * 3 + 2];
                float* orow = OC + m * 512 + head * 64; bf16_t* crow = CAT + m * 1024 + head * 64;
#pragma unroll
                for (int dt = 0; dt < 2; ++dt)
#pragma unroll
                    for (int i4 = 0; i4 < 4; ++i4) {
                        const int d = dt * 32 + 8 * i4 + 4 * h;
                        const f32x4 prev = *(const f32x4*)(orow + d);
                        const f32x4 ov = (f32x4){O[ct][dt][4 * i4] * inv, O[ct][dt][4 * i4 + 1] * inv, O[ct][dt][4 * i4 + 2] * inv, O[ct][dt][4 * i4 + 3] * inv};
                        if (pass == 0) *(f32x4*)(orow + d) = prev * gcv + ov * gsv;
                        else { const f32x4 r = prev + ov * gwv; u32x2 w; w.x = pk2(r[0], r[1]); w.y = pk2(r[2], r[3]); *(u32x2*)(crow + d) = w; }
                    }
            }
        }
    }
}

__device__ __forceinline__ float logsigmoidf_(float x) { return fminf(x, 0.f) - log1pf(__expf(-fabsf(x))); }
__device__ __forceinline__ bf16x8 frag_lds(const LAS float* p) { const f32x4 a = *(const LAS f32x4*)p, b = *(const LAS f32x4*)(p + 4); return pack8(a[0], a[1], a[2], a[3], b[0], b[1], b[2], b[3]); }
__device__ __forceinline__ bf16x8 frag_glb(const float* p) { const f32x4 a = *(const f32x4*)p, b = *(const f32x4*)(p + 4); return pack8(a[0], a[1], a[2], a[3], b[0], b[1], b[2], b[3]); }
struct GlaRaw { u32x4 ga[4], gb[4]; unsigned short k[4], q[4], v8[8]; };
template <bool WITHQ>
__device__ __forceinline__ void gla_fetch(GlaRaw& R, const Frame& F, const bf16_t* P, size_t m0, int hh) {
    const int dk = F.tid & 63, cq = F.tid >> 6, dv = F.tid & 127, cv = F.tid >> 7;
#pragma unroll
    for (int i = 0; i < 4; ++i) { const bf16_t* row = P + (m0 + 4 * cq + i) * N_IN1;
        R.ga[i] = *(const u32x4*)(row + C1_GLOW); R.gb[i] = *(const u32x4*)(row + C1_GLOW + 8);
        R.k[i] = row[C1_GK + hh * 64 + dk]; if (WITHQ) R.q[i] = row[C1_GQ + hh * 64 + dk]; }
#pragma unroll
    for (int i = 0; i < 8; ++i) R.v8[i] = P[(m0 + 8 * cv + i) * N_IN1 + C1_GV + hh * 128 + dv];
}
__device__ __forceinline__ void gla_bcum3(const Frame& F, const GlaRaw& R, const float (&wg)[16], const float bgv, LAS float* seg, float (&bc)[4], float& blast) {
    const int dk = F.tid & 63, cq = F.tid >> 6;
    float run = 0.f;
#pragma unroll
    for (int i = 0; i < 4; ++i) {
        const u32x4 ga = R.ga[i], gb = R.gb[i];
        float acc = bgv;
        acc += wg[0] * bf_lo(ga.x); acc += wg[1] * bf_hi(ga.x); acc += wg[2] * bf_lo(ga.y); acc += wg[3] * bf_hi(ga.y); acc += wg[4] * bf_lo(ga.z); acc += wg[5] * bf_hi(ga.z); acc += wg[6] * bf_lo(ga.w); acc += wg[7] * bf_hi(ga.w);
        acc += wg[8] * bf_lo(gb.x); acc += wg[9] * bf_hi(gb.x); acc += wg[10] * bf_lo(gb.y); acc += wg[11] * bf_hi(gb.y); acc += wg[12] * bf_lo(gb.z); acc += wg[13] * bf_hi(gb.z); acc += wg[14] * bf_lo(gb.w); acc += wg[15] * bf_hi(gb.w);
        run += logsigmoidf_(acc) * 0.0625f; bc[i] = run;
    }
    seg[cq * 64 + dk] = run;
    __syncthreads();
    float off = 0.f, tot = 0.f;
#pragma unroll
    for (int q = 0; q < 8; ++q) { const float sv = seg[q * 64 + dk]; tot += sv; off += (q < cq) ? sv : 0.f; }
#pragma unroll
    for (int i = 0; i < 4; ++i) bc[i] += off;
    blast = tot;
}
__device__ __forceinline__ void gla_put_vT(const Frame& F, const GlaRaw& R, LAS float* vT) {
    const int dv = F.tid & 127, cv = F.tid >> 7;
    *(LAS f32x4*)(vT + dv * 36 + 8 * cv) = (f32x4){bf2f(R.v8[0]), bf2f(R.v8[1]), bf2f(R.v8[2]), bf2f(R.v8[3])};
    *(LAS f32x4*)(vT + dv * 36 + 8 * cv + 4) = (f32x4){bf2f(R.v8[4]), bf2f(R.v8[5]), bf2f(R.v8[6]), bf2f(R.v8[7])};
}
__device__ __forceinline__ void p_gla_a(const Frame& F, const Args& a, unsigned char* ws) {
    const bf16_t* P = (const bf16_t*)(ws + WS_PROJ); float* UPD = (float*)(ws + L1_UPD); float* DECAY = (float*)(ws + L1_DECAY);
    LAS float* seg = (LAS float*)F.lds; LAS float* kdT = seg + 512; LAS float* vT = kdT + 64 * 36;
    const int tid = F.tid, lane = F.lane, wave = F.wave, r = lane & 31, h = lane >> 5;
    const int UPW = (4096 + F.G - 1) / F.G, u0 = F.bid * UPW, u1 = (u0 + UPW < 4096) ? u0 + UPW : 4096;
    if (u0 >= u1) return;
    GlaRaw R; gla_fetch<false>(R, F, P, (size_t)(u0 >> 9) * 4096 + (u0 & 127) * 32, (u0 >> 7) & 3);
    for (int u = u0; u < u1; ++u) {
        const int hh = (u >> 7) & 3;
        float wg[16];
#pragma unroll
        for (int q = 0; q < 16; ++q) wg[q] = a.in[I_L1_WGATE][q * 256 + hh * 64 + (tid & 63)];
        const float bgv = a.in[I_L1_BGATE][hh * 64 + (tid & 63)];
        float bc[4], blast;
        gla_bcum3(F, R, wg, bgv, seg, bc, blast);
        { const int dk = tid & 63, cq = tid >> 6;
          *(LAS f32x4*)(kdT + dk * 36 + 4 * cq) = (f32x4){bf2f(R.k[0]) * __expf(blast - bc[0]), bf2f(R.k[1]) * __expf(blast - bc[1]), bf2f(R.k[2]) * __expf(blast - bc[2]), bf2f(R.k[3]) * __expf(blast - bc[3])};
          if (cq == 0) DECAY[(size_t)u * 64 + dk] = __expf(blast); }
        gla_put_vT(F, R, vT);
        if (u + 1 < u1) { const int un = u + 1; gla_fetch<false>(R, F, P, (size_t)(un >> 9) * 4096 + (un & 127) * 32, (un >> 7) & 3); }
        __syncthreads();
        {
            const int mt = wave >> 1, nt = wave & 1;
            f32x16 acc = {0.f, 0.f, 0.f, 0.f, 0.f, 0.f, 0.f, 0.f, 0.f, 0.f, 0.f, 0.f, 0.f, 0.f, 0.f, 0.f};
#pragma unroll
            for (int ks = 0; ks < 2; ++ks) acc = __builtin_amdgcn_mfma_f32_32x32x16_bf16(frag_lds(vT + (32 * mt + r) * 36 + 16 * ks + 8 * h), frag_lds(kdT + (32 * nt + r) * 36 + 16 * ks + 8 * h), acc, 0, 0, 0);
            float* up = UPD + (size_t)u * 8192 + 32 * nt + r;
#pragma unroll
            for (int i = 0; i < 16; ++i) up[(size_t)(32 * mt + (i & 3) + 8 * (i >> 2) + 4 * h) * 64] = acc[i];
        }
        __syncthreads();
    }
}
__device__ __forceinline__ void p_gla_b(const Frame& F, unsigned char* ws) {
    float* UPD = (float*)(ws + L1_UPD); const float* DECAY = (const float*)(ws + L1_DECAY);
    for (int e = F.bid * NTHREADS + F.tid; e < 32 * 8192; e += F.G * NTHREADS) {
        const int bh = e >> 13, rem = e & 8191, dk = rem & 63;
        float state = 0.f;
        float* up = UPD + (size_t)bh * 128 * 8192 + rem; const float* dp = DECAY + (size_t)bh * 128 * 64 + dk;
#pragma unroll 8
        for (int n = 0; n < 128; ++n) { const float uv = up[(size_t)n * 8192], dc = dp[n * 64]; up[(size_t)n * 8192] = state; state = dc * state + uv; }
    }
}
__device__ __forceinline__ void p_gla_c(const Frame& F, const Args& a, unsigned char* ws) {
    const bf16_t* P = (const bf16_t*)(ws + WS_PROJ); const float* PREV = (const float*)(ws + L1_UPD); bf16_t* CAT = (bf16_t*)(ws + L1_CAT);
    LAS float* seg = (LAS float*)F.lds; LAS float* qd = seg + 512; LAS float* ki = qd + 32 * 68; LAS float* vT = ki + 32 * 68; LAS float* att = vT + 128 * 36; LAS float* red = att + 32 * 36;
    const int tid = F.tid, lane = F.lane, wave = F.wave, r = lane & 31, h = lane >> 5;
    const int UPW = (4096 + F.G - 1) / F.G, u0 = F.bid * UPW, u1 = (u0 + UPW < 4096) ? u0 + UPW : 4096;
    if (u0 >= u1) return;
    GlaRaw R; gla_fetch<true>(R, F, P, (size_t)(u0 >> 9) * 4096 + (u0 & 127) * 32, (u0 >> 7) & 3);
    for (int u = u0; u < u1; ++u) {
        const int b = u >> 9, hh = (u >> 7) & 3, n = u & 127; const size_t m0 = (size_t)b * 4096 + n * 32;
        bf16x8 pf[4]; unsigned short rv16[16];
        if (wave < 4) {
            const float* pp = PREV + (size_t)u * 8192 + (size_t)(32 * wave + r) * 64;
#pragma unroll
            for (int ks = 0; ks < 4; ++ks) pf[ks] = frag_glb(pp + 16 * ks + 8 * h);
#pragma unroll
            for (int i = 0; i < 16; ++i) rv16[i] = P[(m0 + (i & 3) + 8 * (i >> 2) + 4 * h) * N_IN1 + C1_GR + hh * 128 + 32 * wave + r];
        }
        float wg[16];
#pragma unroll
        for (int q = 0; q < 16; ++q) wg[q] = a.in[I_L1_WGATE][q * 256 + hh * 64 + (tid & 63)];
        const float bgv = a.in[I_L1_BGATE][hh * 64 + (tid & 63)];
        float bc[4], blast;
        gla_bcum3(F, R, wg, bgv, seg, bc, blast);
        { const int dk = tid & 63, cq = tid >> 6;
#pragma unroll
          for (int i = 0; i < 4; ++i) { ki[(4 * cq + i) * 68 + dk] = bf2f(R.k[i]) * __expf(-bc[i]); qd[(4 * cq + i) * 68 + dk] = bf2f(R.q[i]) * 0.125f * __expf(bc[i]); } }
        gla_put_vT(F, R, vT);
        if (u + 1 < u1) { const int un = u + 1; gla_fetch<true>(R, F, P, (size_t)(un >> 9) * 4096 + (un & 127) * 32, (un >> 7) & 3); }
        __syncthreads();
        f32x16 acc = {0.f, 0.f, 0.f, 0.f, 0.f, 0.f, 0.f, 0.f, 0.f, 0.f, 0.f, 0.f, 0.f, 0.f, 0.f, 0.f};
        if (wave == 4) {
            f32x16 at = {0.f, 0.f, 0.f, 0.f, 0.f, 0.f, 0.f, 0.f, 0.f, 0.f, 0.f, 0.f, 0.f, 0.f, 0.f, 0.f};
#pragma unroll
            for (int ks = 0; ks < 4; ++ks) at = __builtin_amdgcn_mfma_f32_32x32x16_bf16(frag_lds(qd + r * 68 + 16 * ks + 8 * h), frag_lds(ki + r * 68 + 16 * ks + 8 * h), at, 0, 0, 0);
#pragma unroll
            for (int i = 0; i < 16; ++i) { const int c = (i & 3) + 8 * (i >> 2) + 4 * h; att[c * 36 + r] = (r <= c) ? at[i] : 0.f; }
        } else if (wave < 4) {
#pragma unroll
            for (int ks = 0; ks < 4; ++ks) acc = __builtin_amdgcn_mfma_f32_32x32x16_bf16(frag_lds(qd + r * 68 + 16 * ks + 8 * h), pf[ks], acc, 0, 0, 0);
        }
        __syncthreads();
        if (wave < 4) {
#pragma unroll
            for (int ks = 0; ks < 2; ++ks) acc = __builtin_amdgcn_mfma_f32_32x32x16_bf16(frag_lds(att + r * 36 + 16 * ks + 8 * h), frag_lds(vT + (32 * wave + r) * 36 + 16 * ks + 8 * h), acc, 0, 0, 0);
#pragma unroll
            for (int i = 0; i < 16; ++i) { float ss = acc[i] * acc[i];
                ss += __shfl_xor(ss, 1); ss += __shfl_xor(ss, 2); ss += __shfl_xor(ss, 4); ss += __shfl_xor(ss, 8); ss += __shfl_xor(ss, 16);
                if (r == 0) red[wave * 32 + (i & 3) + 8 * (i >> 2) + 4 * h] = ss; }
        }
        __syncthreads();
        if (wave < 4) {
            const int dv = 32 * wave + r; const float og = a.in[I_L1_OGAIN][dv];
#pragma unroll
            for (int i = 0; i < 16; ++i) { const int c = (i & 3) + 8 * (i >> 2) + 4 * h;
                const float tot = red[c] + red[32 + c] + red[64 + c] + red[96 + c];
                const float rstd = 1.0f / sqrtf(tot * (1.f / 128.f) + 1e-6f);
                const float rv = bf2f(rv16[i]);
                CAT[(m0 + c) * 1024 + 512 + hh * 128 + dv] = (bf16_t)f2bf(acc[i] * rstd * og * rv * sigmoidf_(rv)); }
        }
        __syncthreads();
    }
}
__global__ void __launch_bounds__(NTHREADS, 2) mk_fwd(Args args) {
    extern __shared__ __attribute__((aligned(16))) unsigned char lds_raw[];
    cg::grid_group grid = cg::this_grid();
    Frame F; F.lds = (LAS unsigned char*)lds_raw; F.tid = threadIdx.x; F.lane = F.tid & 63; F.wave = __builtin_amdgcn_readfirstlane(F.tid >> 6); F.G = gridDim.x; F.bid = blockIdx.x;
    unsigned char* ws = args.ws;
    const int lo = args.ph_lo, hi = args.ph_hi;
#ifndef KEEPMASK
#define KEEPMASK 0xFFFFFFFFu
#endif
#define IN(k) (((KEEPMASK >> (k)) & 1u) && lo <= (k) && (k) < hi)
#define BOTH(k) (IN(k) && IN((k) + 1))
#ifndef TMODE
#define TMODE 0
#endif
#ifndef REPMASK
#define REPMASK 0u
#endif
#define PH(k, ...) if (IN(k)) { { const int rep = 0; (void)rep; __VA_ARGS__; } if ((REPMASK >> (k)) & 1u) { xcd_barrier(xbar); { const int rep = 1; (void)rep; __VA_ARGS__; } } }
#ifdef TS_A
#define STAMP(k) do { if (F.bid == 0 && F.tid == 0) ((unsigned long long*)(ws + WS_CTL + 65536))[(k)] = __builtin_amdgcn_s_memrealtime(); } while (0)
#else
#define STAMP(k) do { } while (0)
#endif
#define GRID_BAR(k) do { if (BOTH(k)) { if ((k) == 0) grid.sync(); else xcd_barrier(xbar); } STAMP((k) + 1); } while (0)
    const float* x = args.in[I_X];
    float* out = args.out;
    volatile LAS unsigned* xst = (volatile LAS unsigned*)(F.lds + LDS_BYTES - 64);
    if (F.tid < 16) xst[F.tid] = 0u;
    __syncthreads();
    XcdBarrier xbar = xcd_barrier_post((unsigned*)(ws + WS_CTL) + 4096, xst);

    STAMP(0);
    PH(0, int base = 0; transpose_all(F, base, args.in[I_L0_WIN], 1024, 1864, (bf16_t*)(ws + WS_W_IN0), 1024, MapIn0()); transpose_all(F, base, args.in[I_L0_WGLU], 512, 512, (bf16_t*)(ws + WS_W_GLU), 512, MapId()); transpose_all(F, base, args.in[I_L0_WOUT], 1024, 1024, (bf16_t*)(ws + WS_W_OUT0), 1024, MapId()); transpose_all(F, base, args.in[I_L0_WQ], 1024, 2048, (bf16_t*)(ws + WS_WQ0), 1024, MapId()); transpose_all(F, base, args.in[I_L1_WIN], 1024, 2856, (bf16_t*)(ws + WS_W_IN1), 1024, MapIn1()); transpose_all(F, base, args.in[I_L1_KW1], 2048, 256, (bf16_t*)(ws + WS_KW1), 2048, MapId()); transpose_all(F, base, args.in[I_L1_VW1], 2048, 256, (bf16_t*)(ws + WS_VW1), 2048, MapId()); transpose_all(F, base, args.in[I_L1_KW2], 256, 64, (bf16_t*)(ws + WS_KW2), 256, MapId()); transpose_all(F, base, args.in[I_L1_VW2], 256, 64, (bf16_t*)(ws + WS_VW2), 256, MapId()); transpose_all(F, base, args.in[I_L1_WOUT], 1024, 1024, (bf16_t*)(ws + WS_W_OUT1), 1024, MapId()); transpose_all(F, base, args.in[I_L1_WQ], 1024, 2048, (bf16_t*)(ws + WS_WQ1), 1024, MapId()); zero_bytes(F, ws + WS_W_IN0 + (size_t)1864 * 1024 * 2, (size_t)(2048 - 1864) * 1024 * 2); zero_bytes(F, ws + WS_W_IN1 + (size_t)2856 * 1024 * 2, (size_t)(3072 - 2856) * 1024 * 2); zero_bytes(F, ws + WS_KW2 + (size_t)64 * 256 * 2, (size_t)192 * 256 * 2); zero_bytes(F, ws + WS_VW2 + (size_t)64 * 256 * 2, (size_t)192 * 256 * 2); cvt_f32_bf16(F, args.in[I_L0_SK], (bf16_t*)(ws + WS_SK0), (size_t)16 * 128 * 128); cvt_f32_bf16(F, args.in[I_L1_SK], (bf16_t*)(ws + WS_SK1), (size_t)16 * 128 * 128); cvt_table_i8(F, args.in[I_L0_U], ws + WS_TAB8U, (float*)(ws + WS_TABSU), 32); cvt_table_fp8(F, args.in[I_L0_V], ws + WS_TAB8V, (float*)(ws + WS_TABSV), 32); p_rope_table(F, (f32x2*)(ws + WS_ROPE)); if (F.bid == F.G - 1) { for (int i = F.tid; i < 1024; i += NTHREADS) ((float*)(ws + WS_CMPB + 4096))[i] = args.in[I_L1_MIXN][i]; } __syncthreads(); for (int g = F.bid; g < 32; g += F.G) s5_build_group(F, args, ws, g); for (int j = (F.bid + F.G - (32 % F.G)) % F.G; j < 64; j += F.G) cmp_bias(F, args, (float*)(ws + WS_CMPB), j); p_rmsnorm(F, x, args.in[I_L0_MIXN], (bf16_t*)(ws + WS_XN));)
    GRID_BAR(0);
    PH(1, pg8::Gemm g{(const bf16_t*)(ws + WS_XN), (const bf16_t*)(ws + WS_W_IN0), T, N_IN0, 1024, 1024, 1024}; pg8::StaticOrder S; S.init(T, N_IN0, F.G, F.bid); pg8::EpiStoreBf16 E{(bf16_t*)(ws + WS_PROJ), N_IN0}; pg8::gemm_phase(F.lds, g, S, E);)
    GRID_BAR(1);
    PH(2, p_l0_prep(F, args, ws);)
    GRID_BAR(2);
    PH(3, p_dsa_index(F, ws, (u64*)(ws + (rep ? L0_CAT : L0_SELT)), rep ? TMODE : 0);)
    GRID_BAR(3);
    PH(4, p_dsa_attn(F, args, ws);)
    GRID_BAR(4);
    PH(5, pg8::Gemm g{(const bf16_t*)(ws + L0_UA), (const bf16_t*)(ws + WS_S5B1), 65536, 8192, 256, 384, 256}; pg8::GroupedOrder S; S.init(256, 8, F.G, F.bid); pg8::EpiS5State E{(float*)(ws + L0_SLOC)}; pg8::gemm_phase(F.lds, g, S, E);)
    GRID_BAR(5);
    PH(6, p_s5_scan(F, args, ws);)
    GRID_BAR(6);
    PH(7, pg8::Gemm g{(const bf16_t*)(ws + L0_UA), (const bf16_t*)(ws + WS_S5B2), 65536, 8192, 384, 384, 384}; pg8::GroupedOrder S; S.init(256, 8, F.G, F.bid); pg8::EpiS5Out E{(bf16_t*)(ws + L0_YB)}; pg8::gemm_phase(F.lds, g, S, E);)
    GRID_BAR(7);
    PH(8, pg8::Gemm g{(const bf16_t*)(ws + L0_YB), (const bf16_t*)(ws + WS_W_GLU), T, 512, 512, 512, 512}; pg8::StaticOrder S; S.init(T, 512, F.G, F.bid); pg8::EpiGlu E{(const bf16_t*)(ws + L0_YB), args.in[I_L0_BGLU], (bf16_t*)(ws + L0_CAT)}; pg8::gemm_phase(F.lds, g, S, E);)
    GRID_BAR(8);
    PH(9, pg8::Gemm g{(const bf16_t*)(ws + L0_CAT), (const bf16_t*)(ws + WS_W_OUT0), T, 1024, 1024, 1024, 1024}; pg8::StaticOrder S; S.init(T, 1024, F.G, F.bid); pg8::EpiResidF32 E{x, out, 1024}; pg8::gemm_phase(F.lds, g, S, E);)
    GRID_BAR(9);
    PH(10, p_rmsnorm(F, out, args.in[I_L0_FFNN], (bf16_t*)(ws + WS_XN));)
    GRID_BAR(10);
    PH(11, pg8::Gemm g{(const bf16_t*)(ws + WS_XN), (const bf16_t*)(ws + WS_WQ0), T, 2048, 1024, 1024, 1024}; pg8::StaticOrder S; S.init(T, 2048, F.G, F.bid); pg8::EpiStoreBf16 E{(bf16_t*)(ws + PE_Q2), 2048}; pg8::gemm_phase(F.lds, g, S, E);)
    GRID_BAR(11);
    PH(12, p_peer_route(F, ws, (const bf16_t*)(ws + WS_SK0));)
    GRID_BAR(12);
    PH(13, p_peer_expert5(F, ws, out, rep ? 0.f : 1.f, xbar, rep ? TMODE : 0, true);)
    GRID_BAR(13);
    PH(15, pg8::Gemm g{(const bf16_t*)(ws + WS_XN), (const bf16_t*)(ws + WS_W_IN1), T, N_IN1, 1024, 1024, 1024}; pg8::StaticOrder S; S.init(T, N_IN1, F.G, F.bid); pg8::EpiStoreBf16 E{(bf16_t*)(ws + WS_PROJ), N_IN1}; pg8::gemm_phase(F.lds, g, S, E);)
    GRID_BAR(15);
    PH(16, p_l1_prep(F, args, ws);)
    GRID_BAR(16);
    PH(17, pg8::Gemm g{(const bf16_t*)(ws + L1_KCR), (const bf16_t*)(ws + WS_KW1), 8192, 512, 2048, 1024, 2048}; pg8::GroupedOrder S; S.init(32, 16, F.G, F.bid); pg8::EpiCmp1 E{(bf16_t*)(ws + L1_H1), (const float*)(ws + WS_CMPB)}; pg8::gemm_phase(F.lds, g, S, E);)
    GRID_BAR(17);
    PH(18, pg8::Gemm g{(const bf16_t*)(ws + L1_H1), (const bf16_t*)(ws + WS_KW2), 8192, 512, 256, 256, 256}; pg8::GroupedOrder S; S.init(32, 16, F.G, F.bid); pg8::EpiCmp2 E{(float*)(ws + L1_CMPO)}; pg8::gemm_phase(F.lds, g, S, E);)
    GRID_BAR(18);
    PH(19, p_cmp_final(F, args, ws);)
    GRID_BAR(19);
    PH(20, p_cmp_attn(F, args, ws);)
    GRID_BAR(20);
    PH(21, if (rep) { p_cmp_attn(F, args, ws); xcd_barrier(xbar); } p_nsa_attn(F, args, ws);)
    GRID_BAR(21);
    PH(22, p_gla_a(F, args, ws); cvt_table_i8(F, args.in[I_L1_U], ws + WS_TAB8U, (float*)(ws + WS_TABSU), 0); cvt_table_fp8(F, args.in[I_L1_V], ws + WS_TAB8V, (float*)(ws + WS_TABSV), 0);)
    GRID_BAR(22);
    PH(23, if (rep) { p_gla_a(F, args, ws); xcd_barrier(xbar); } p_gla_b(F, ws);)
    GRID_BAR(23);
    PH(24, p_gla_c(F, args, ws);)
    GRID_BAR(24);
    PH(25, pg8::Gemm g{(const bf16_t*)(ws + L1_CAT), (const bf16_t*)(ws + WS_W_OUT1), T, 1024, 1024, 1024, 1024}; pg8::StaticOrder S; S.init(T, 1024, F.G, F.bid); pg8::EpiResidF32 E{out, out, 1024}; pg8::gemm_phase(F.lds, g, S, E);)
    GRID_BAR(25);
    PH(26, p_rmsnorm(F, out, args.in[I_L1_FFNN], (bf16_t*)(ws + WS_XN));)
    GRID_BAR(26);
    PH(27, pg8::Gemm g{(const bf16_t*)(ws + WS_XN), (const bf16_t*)(ws + WS_WQ1), T, 2048, 1024, 1024, 1024}; pg8::StaticOrder S; S.init(T, 2048, F.G, F.bid); pg8::EpiStoreBf16 E{(bf16_t*)(ws + PE_Q2), 2048}; pg8::gemm_phase(F.lds, g, S, E);)
    GRID_BAR(27);
    PH(28, p_peer_route(F, ws, (const bf16_t*)(ws + WS_SK1));)
    GRID_BAR(28);
    PH(29, p_peer_expert5(F, ws, out, rep ? 0.f : 1.f, xbar, rep ? TMODE : 0, false);)
#undef IN
#undef BOTH
}

extern "C" void kernel_launch(void* const* d_in, const int* in_sizes, int n_in, void* d_out, int out_size, void* d_ws, size_t ws_size, hipStream_t stream) {
    static int grid = 0;
    if (grid == 0) {
        if (n_in != 39 || ws_size < WS_END) { fprintf(stderr, "kernel_launch: unexpected n_in %d or ws_size %zu (< %zu)\n", n_in, ws_size, (size_t)WS_END); grid = -1; return; }
        int dev = 0, cus = 0, per_cu = 0;
        (void)hipGetDevice(&dev); (void)hipDeviceGetAttribute(&cus, hipDeviceAttributeMultiprocessorCount, dev);
        if (hipFuncSetAttribute((const void*)mk_fwd, hipFuncAttributeMaxDynamicSharedMemorySize, LDS_BYTES) != hipSuccess) { fprintf(stderr, "kernel_launch: hipFuncSetAttribute failed\n"); grid = -1; return; }
        if (hipOccupancyMaxActiveBlocksPerMultiprocessor(&per_cu, (const void*)mk_fwd, NTHREADS, LDS_BYTES) != hipSuccess || per_cu < 1) { fprintf(stderr, "kernel_launch: occupancy query failed (%d)\n", per_cu); (void)hipGetLastError(); grid = -1; return; }
        grid = cus;
    }
    if (grid < 0) return;
    (void)hipMemsetAsync((char*)d_ws + WS_CTL, 0, 1 * MiB, stream);
    Args a{};
    for (int i = 0; i < 39; ++i) a.in[i] = (const float*)d_in[i];
    a.out = (float*)d_out; a.ws = (unsigned char*)d_ws; a.ph_lo = 0; a.ph_hi = 1000;
    void* kargs[] = {&a};
    hipError_t e = hipLaunchCooperativeKernel((const void*)mk_fwd, dim3(grid), dim3(NTHREADS), kargs, LDS_BYTES, stream);
    if (e != hipSuccess) fprintf(stderr, "kernel_launch: cooperative launch failed: %s\n", hipGetErrorString(e));
}
```

```cpp
#include <hip/hip_runtime.h>
#include <hip/hip_cooperative_groups.h>
#include <cstdio>
#include <cstdint>
namespace cg = cooperative_groups;

#define LAS __attribute__((address_space(3)))
typedef unsigned short bf16_t;
typedef short bf16x8 __attribute__((ext_vector_type(8)));
typedef float f32x4 __attribute__((ext_vector_type(4)));
typedef float f32x2 __attribute__((ext_vector_type(2)));
typedef float f32x16 __attribute__((ext_vector_type(16)));
typedef unsigned u32x4 __attribute__((ext_vector_type(4)));
typedef unsigned u32x2 __attribute__((ext_vector_type(2)));
typedef unsigned long long u64;

constexpr int NB = 8, SEQ = 4096, DM = 1024, T = NB * SEQ;
constexpr int NTHREADS = 512, NWAVES = 8;
constexpr int LDS_BYTES = 147456;
constexpr int N_IN0 = 2048, N_IN1 = 3072;
constexpr int C0_Q = 0, C0_K = 512, C0_V = 640, C0_IQ = 768, C0_U = 1280, C0_IK = 1792, C0_IW = 1856;
constexpr int C1_Q = 0, C1_KC = 512, C1_VC = 640, C1_KS = 768, C1_VS = 896, C1_KW = 1024, C1_VW = 1152, C1_GQ = 1280, C1_GK = 1536, C1_GV = 1792, C1_GR = 2304, C1_GL = 2816, C1_GLOW = 2840;

constexpr size_t MiB = 1u << 20;
constexpr size_t WS_CTL = 0;
constexpr size_t WS_ROPE = 1 * MiB;
constexpr size_t WS_W_IN0 = 2 * MiB;
constexpr size_t WS_W_GLU = 6 * MiB;
constexpr size_t WS_SK0 = 6 * MiB + 512 * 1024;
constexpr size_t WS_W_OUT0 = 7 * MiB;
constexpr size_t WS_WQ0 = 9 * MiB;
constexpr size_t WS_W_IN1 = 13 * MiB;
constexpr size_t WS_KW1 = 19 * MiB;
constexpr size_t WS_VW1 = 20 * MiB;
constexpr size_t WS_KW2 = 21 * MiB;
constexpr size_t WS_VW2 = 21 * MiB + 128 * 1024;
constexpr size_t WS_SK1 = 21 * MiB + 512 * 1024;
constexpr size_t WS_W_OUT1 = 22 * MiB;
constexpr size_t WS_WQ1 = 24 * MiB;
constexpr size_t WS_S5B1 = 28 * MiB;
constexpr size_t WS_S5B2 = 32 * MiB;
constexpr size_t WS_CMPB = 38 * MiB;
constexpr size_t WS_TABU = 48 * MiB;
constexpr size_t WS_TABV = 80 * MiB;
constexpr size_t WS_XN = 112 * MiB;
constexpr size_t WS_PROJ = 176 * MiB;
constexpr size_t WS_R3 = 368 * MiB;
constexpr size_t WS_END = 506 * MiB;

__device__ __forceinline__ unsigned f2bf(float f) { unsigned u = __builtin_bit_cast(unsigned, f); return (u + 0x7fffu + ((u >> 16) & 1u)) >> 16; }
__device__ __forceinline__ unsigned pk2(float lo, float hi) { return f2bf(lo) | (f2bf(hi) << 16); }
__device__ __forceinline__ float bf_lo(unsigned u) { return __builtin_bit_cast(float, u << 16); }
__device__ __forceinline__ float bf_hi(unsigned u) { return __builtin_bit_cast(float, u & 0xffff0000u); }
__device__ __forceinline__ float bf2f(bf16_t b) { return __builtin_bit_cast(float, ((unsigned)b) << 16); }
__device__ __forceinline__ float wave_sum(float v) {
#pragma unroll
    for (int o = 1; o < 64; o <<= 1) v += __shfl_xor(v, o);
    return v;
}
__device__ __forceinline__ float gelu_tanh(float x) {
    const float y = 0.7978845608028654f * (x + 0.044715f * x * x * x);
    const float e = __expf(2.0f * y);
    const float th = 1.0f - 2.0f / (e + 1.0f);
    return 0.5f * x * (1.0f + th);
}
__device__ __forceinline__ float sigmoidf_(float x) { return 1.0f / (1.0f + __expf(-x)); }
#define LDS_WAIT() asm volatile("s_waitcnt lgkmcnt(0)" ::: "memory")
#define VM_WAIT() asm volatile("s_waitcnt vmcnt(0)" ::: "memory")

#define XB_TMO      128
#define XB_XCNT(j)  (256  + 64 * (j))
#define XB_XSUB(j)  (1280 + 64 * (j))
#define XB_XGEN(j)  (2304 + 64 * (j))
#define XB_TOP      3328
#define XB_TOPGEN   3392
#define XCD_BAR_WORDS 3456
#define XB_SPIN_CAP (1u << 22)
__device__ __forceinline__ unsigned xb_ld(unsigned* p)              { return __hip_atomic_load(p, __ATOMIC_RELAXED, __HIP_MEMORY_SCOPE_AGENT); }
__device__ __forceinline__ unsigned xb_add(unsigned* p, unsigned v) { return __hip_atomic_fetch_add(p, v, __ATOMIC_RELAXED, __HIP_MEMORY_SCOPE_AGENT); }
__device__ __forceinline__ unsigned xb_xcc_id() { return (unsigned)__builtin_amdgcn_s_getreg((3 << 11) | 20) & 0xFu; }
#define XB_SPIN(cond, bar) do { unsigned _sp = 0; while (cond) { __builtin_amdgcn_s_sleep(1); \
    if ((++_sp & 255u) == 0u) { if (xb_ld(&(bar)[XB_TMO])) break; if (_sp > XB_SPIN_CAP) { atomicAdd(&(bar)[XB_TMO], 1u); break; } } } } while (0)
struct XcdBarrier { unsigned* bar; unsigned x; volatile LAS unsigned* st; };
__device__ __forceinline__ XcdBarrier xcd_barrier_post(unsigned* bar, volatile LAS unsigned* st) {
    XcdBarrier b; b.bar = bar; b.x = xb_xcc_id(); b.st = st;
    if (threadIdx.x == 0) (void)xb_add(&bar[XB_XCNT(b.x)], 1u);
    return b;
}
__device__ __forceinline__ void xcd_barrier_complete(unsigned* bar, unsigned x, unsigned& nloc, unsigned& nx) {
    const unsigned G = gridDim.x * gridDim.y * gridDim.z;
    unsigned sum, cnt, mine, sp = 0u;
    for (;;) {
        sum = 0u; cnt = 0u; mine = 0u;
#pragma unroll
        for (unsigned j = 0; j < 16; ++j) { const unsigned c = xb_ld(&bar[XB_XCNT(j)]); sum += c; cnt += (c > 0u) ? 1u : 0u; mine = (j == x) ? c : mine; }
        if (sum == G) break;
        __builtin_amdgcn_s_sleep(1);
        if ((++sp & 255u) == 0u) { if (xb_ld(&bar[XB_TMO])) break; if (sp > XB_SPIN_CAP) { atomicAdd(&bar[XB_TMO], 1u); break; } }
    }
    nloc = mine > 0u ? mine : 1u; nx = cnt > 0u ? cnt : 1u;
}
__device__ __forceinline__ void xcd_barrier(const XcdBarrier& b) {
    asm volatile("s_waitcnt vmcnt(0)" ::: "memory");
    __syncthreads();
    if (threadIdx.x == 0) {
        unsigned* bar = b.bar;
        __builtin_amdgcn_s_waitcnt(0);
        unsigned nloc = b.st[0], nx = b.st[1];
        if (nloc == 0u) { xcd_barrier_complete(bar, b.x, nloc, nx); b.st[0] = nloc; b.st[1] = nx; }
        const unsigned old = xb_add(&bar[XB_XSUB(b.x)], 1u);
        const unsigned gen = old / nloc;
        if (old + 1u == (gen + 1u) * nloc) {
            __builtin_amdgcn_fence(__ATOMIC_RELEASE, "agent");
            asm volatile("s_waitcnt vmcnt(0)" ::: "memory");
            const unsigned og = xb_add(&bar[XB_TOP], 1u);
            const unsigned tg = og / nx;
            if (og + 1u == (tg + 1u) * nx) xb_add(&bar[XB_TOPGEN], 1u);
            else XB_SPIN(xb_ld(&bar[XB_TOPGEN]) == tg, bar);
            __builtin_amdgcn_fence(__ATOMIC_ACQUIRE, "agent");
            xb_add(&bar[XB_XGEN(b.x)], 1u);
            asm volatile("s_waitcnt vmcnt(0)" ::: "memory");
        } else {
            XB_SPIN(xb_ld(&bar[XB_XGEN(b.x)]) == gen, bar);
            __builtin_amdgcn_fence(__ATOMIC_ACQUIRE, "agent");
            asm volatile("s_waitcnt vmcnt(0)" ::: "memory");
        }
    }
    __syncthreads();
}

namespace pg8 {
constexpr int BM = 256, BK = 64, HALF = 128, HTB = HALF * BK * 2, STAGE_BYTES = 8 * HTB, NXCD = 8, WGM = 8;
__device__ __forceinline__ int lds_byte(int r, int c) { const int st = (r >> 4) * 2 + (c >> 5), rr = r & 15, cc = c & 31, ob = rr * 64 + cc * 2; return st * 1024 + (ob ^ (((ob >> 9) & 1) << 5)); }
__device__ __forceinline__ void stage_rc(int b, int& R, int& C) { const int st = b / 1024, sb = b % 1024, swz = sb ^ (((sb >> 9) & 1) << 5); R = (st >> 1) * 16 + swz / 64; C = (st & 1) * 32 + (swz % 64) / 2; }
__device__ __forceinline__ int perm32(int rho) { const int n = rho >> 4, i = rho & 15; return 8 * (i >> 2) + 4 * n + (i & 3); }
struct Unit { int pm, pn; };
struct Gemm { const bf16_t* A; const bf16_t* Bt; int M, N, K, lda, ldb; };
struct StaticOrder {
    int nM, nN, nwg, G, c;
    __device__ void init(int M, int N, int G_, int c_) { nM = M / BM; nN = N / BM; nwg = nM * nN; G = G_; c = c_; }
    __device__ bool next(int i, Unit& u) const {
        const long L = (long)i * G + c; if (L >= nwg) return false;
        int wgid = (int)L; { const int q = nwg / NXCD, r = nwg % NXCD, xcd = wgid % NXCD, off = wgid / NXCD; wgid = (xcd < r ? xcd * (q + 1) : r * (q + 1) + (xcd - r) * q) + off; }
        const int nig = WGM * nN, gid = wgid / nig, fm = gid * WGM, gsz = (nM - fm) < WGM ? (nM - fm) : WGM;
        u.pm = fm + ((wgid % nig) % gsz); u.pn = (wgid % nig) / gsz; return true;
    }
};
struct GroupedOrder {
    int nwg, G, c, tpg;
    __device__ void init(int ntiles, int tiles_per_group, int G_, int c_) { nwg = ntiles; tpg = tiles_per_group; G = G_; c = c_; }
    __device__ bool next(int i, Unit& u) const { const long L = (long)i * G + c; if (L >= nwg) return false; u.pm = (int)L; u.pn = (int)L / tpg; return true; }
};
__device__ __forceinline__ unsigned cvt_pk_bf16(float lo, float hi) { unsigned r; asm volatile("v_cvt_pk_bf16_f32 %0, %1, %2" : "=v"(r) : "v"(lo), "v"(hi)); return r; }

template <class Epi, class Sched>
__device__ __forceinline__ void gemm_phase(LAS unsigned char* lds, const Gemm g, const Sched& S, const Epi& E) {
    const int tid = threadIdx.x, wid = __builtin_amdgcn_readfirstlane(tid >> 6), lane = tid & 63, wr = wid >> 2, wc = wid & 3, fr = lane & 15, fq = lane >> 4;
    int K = g.K; asm volatile("" : "+s"(K));
    const int nt = K / BK;
    unsigned voffA[2], voffB[2];
#pragma unroll
    for (int i = 0; i < 2; ++i) { int R, C; stage_rc(tid * 16 + i * 8192, R, C); const int Rb = Epi::PERM ? ((R & ~31) + perm32(R & 31)) : R;
        voffA[i] = (unsigned)(R * g.lda + C) * 2u; voffB[i] = (unsigned)(Rb * g.ldb + C) * 2u; }
    const size_t kstep = (size_t)(BK * 2);
    const size_t hstepA = (size_t)HALF * g.lda * 2, hstepB = (size_t)HALF * g.ldb * 2;
    const size_t tstepA = 2 * hstepA, tstepB = 2 * hstepB;
    const unsigned ldsw = (unsigned)wid * 1024u;
    const int aoff = lds_byte(wr * 64 + fr, fq * 8), boff = lds_byte(wc * 32 + fr, fq * 8);
#define PG8_SA(b, h) (((b) * 2 + (h)) * HTB)
#define PG8_SB(b, h) ((4 + (b) * 2 + (h)) * HTB)
#define PG8_STAGE(bufoff, gbase, voff) do { _Pragma("unroll") for (int _i = 0; _i < 2; ++_i) \
        __builtin_amdgcn_global_load_lds((const unsigned*)((const char*)(gbase) + (voff)[_i]), (LAS unsigned*)(lds + (bufoff) + ldsw + _i * 8192), 16, 0, 0); } while (0)
#define PG8_LDA(dst, b, h) do { _Pragma("unroll") for (int m = 0; m < 4; ++m) _Pragma("unroll") for (int k = 0; k < 2; ++k) dst[m][k] = *(const LAS bf16x8*)(lds + PG8_SA(b, h) + aoff + m * 2048 + k * 1024); } while (0)
#define PG8_LDB(dst, b, h) do { _Pragma("unroll") for (int n = 0; n < 2; ++n) _Pragma("unroll") for (int k = 0; k < 2; ++k) dst[n][k] = *(const LAS bf16x8*)(lds + PG8_SB(b, h) + boff + n * 2048 + k * 1024); } while (0)
#define PG8_MMA(ai, bj, At, Bt) do { __builtin_amdgcn_s_setprio(1); _Pragma("unroll") for (int m = 0; m < 4; ++m) _Pragma("unroll") for (int n = 0; n < 2; ++n) _Pragma("unroll") for (int k = 0; k < 2; ++k) \
        acc[ai][bj][m][n] = __builtin_amdgcn_mfma_f32_16x16x32_bf16(Bt[n][k], At[m][k], acc[ai][bj][m][n], 0, 0, 0); __builtin_amdgcn_s_setprio(0); } while (0)
#define PG8_WAIT_V(n) asm volatile("s_waitcnt vmcnt(" #n ")" ::: "memory")
#define PG8_WAIT_L(n) asm volatile("s_waitcnt lgkmcnt(" #n ")" ::: "memory")
#define PG8_BAR __builtin_amdgcn_s_barrier()
#define PG8_SCHED __builtin_amdgcn_sched_barrier(0)
    Unit cur, nxt; int ui = 0;
    if (!S.next(0, cur)) return;
    f32x4 acc[2][2][4][2];
#pragma unroll
    for (int a = 0; a < 2; ++a)
#pragma unroll
        for (int b = 0; b < 2; ++b)
#pragma unroll
            for (int m = 0; m < 4; ++m)
#pragma unroll
                for (int n = 0; n < 2; ++n) acc[a][b][m][n] = (f32x4){0.f, 0.f, 0.f, 0.f};
    bf16x8 At[4][2], B0[2][2], B1[2][2];
    const char* cA = (const char*)g.A + (size_t)cur.pm * tstepA; const char* cB = (const char*)g.Bt + (size_t)cur.pn * tstepB;
    PG8_STAGE(PG8_SB(0, 0), cB, voffB); PG8_STAGE(PG8_SA(0, 0), cA, voffA); PG8_STAGE(PG8_SB(0, 1), cB + hstepB, voffB); PG8_STAGE(PG8_SA(0, 1), cA + hstepA, voffA);
    if (wr == 1) PG8_BAR;
    PG8_WAIT_V(4); PG8_BAR;
    PG8_STAGE(PG8_SB(1, 0), cB + kstep, voffB); PG8_STAGE(PG8_SA(1, 0), cA + kstep, voffA); PG8_STAGE(PG8_SB(1, 1), cB + hstepB + kstep, voffB);
    PG8_WAIT_V(6); PG8_BAR;
    for (;;) {
        const bool has_next = S.next(ui + 1, nxt);
        const char* nA = has_next ? (const char*)g.A + (size_t)nxt.pm * tstepA : cA; const char* nB = has_next ? (const char*)g.Bt + (size_t)nxt.pn * tstepB : cB;
        for (int t = 0; t < nt; t += 2) {
            const bool last = (t == nt - 2);
            const char* a1 = cA + (size_t)(t + 1) * kstep;
            const char* a2 = last ? nA : cA + (size_t)(t + 2) * kstep; const char* b2 = last ? nB : cB + (size_t)(t + 2) * kstep;
            const char* a3 = a2 + kstep; const char* b3 = b2 + kstep;
            PG8_LDB(B0, 0, 0); PG8_SCHED; PG8_LDA(At, 0, 0); PG8_STAGE(PG8_SA(1, 1), a1 + hstepA, voffA);
            PG8_WAIT_L(8); PG8_BAR; PG8_WAIT_L(0); PG8_MMA(0, 0, At, B0); PG8_BAR; PG8_SCHED;
            PG8_LDB(B1, 0, 1); PG8_STAGE(PG8_SB(0, 0), b2, voffB);
            PG8_BAR; PG8_WAIT_L(0); PG8_MMA(0, 1, At, B1); PG8_BAR;
            PG8_LDA(At, 0, 1); PG8_STAGE(PG8_SA(0, 0), a2, voffA);
            PG8_BAR; PG8_WAIT_L(0); PG8_MMA(1, 0, At, B0); PG8_BAR; PG8_SCHED;
            PG8_STAGE(PG8_SB(0, 1), b2 + hstepB, voffB);
            PG8_WAIT_V(6); PG8_BAR; PG8_MMA(1, 1, At, B1); PG8_BAR;
            PG8_LDB(B0, 1, 0); PG8_SCHED; PG8_LDA(At, 1, 0); PG8_STAGE(PG8_SA(0, 1), a2 + hstepA, voffA);
            PG8_WAIT_L(8); PG8_BAR; PG8_WAIT_L(0); PG8_MMA(0, 0, At, B0); PG8_BAR; PG8_SCHED;
            PG8_LDB(B1, 1, 1); PG8_STAGE(PG8_SB(1, 0), b3, voffB);
            PG8_BAR; PG8_WAIT_L(0); PG8_MMA(0, 1, At, B1); PG8_BAR;
            PG8_LDA(At, 1, 1); PG8_STAGE(PG8_SA(1, 0), a3, voffA);
            PG8_BAR; PG8_WAIT_L(0); PG8_MMA(1, 0, At, B0); PG8_BAR; PG8_SCHED;
            PG8_STAGE(PG8_SB(1, 1), b3 + hstepB, voffB);
            PG8_WAIT_V(6); PG8_BAR; PG8_MMA(1, 1, At, B1); PG8_BAR;
        }
        E(acc, cur, wr, wc, fr, fq);
        if (!has_next) break;
#pragma unroll
        for (int a = 0; a < 2; ++a)
#pragma unroll
            for (int b = 0; b < 2; ++b)
#pragma unroll
                for (int m = 0; m < 4; ++m)
#pragma unroll
                    for (int n = 0; n < 2; ++n) acc[a][b][m][n] = (f32x4){0.f, 0.f, 0.f, 0.f};
        cur = nxt; cA = nA; cB = nB; ++ui;
    }
    PG8_WAIT_V(0);
    if (wr == 0) PG8_BAR;
    PG8_BAR;
#undef PG8_SA
#undef PG8_SB
#undef PG8_STAGE
#undef PG8_LDA
#undef PG8_LDB
#undef PG8_MMA
#undef PG8_WAIT_V
#undef PG8_WAIT_L
#undef PG8_BAR
#undef PG8_SCHED
}

struct EpiStoreBf16 {
    static constexpr bool PERM = true;
    bf16_t* O; int ldc;
    __device__ __forceinline__ void operator()(const f32x4 (&acc)[2][2][4][2], const Unit& u, int wr, int wc, int fr, int fq) const {
        const int row0 = u.pm * BM + wr * 64 + fr, col0 = u.pn * BM + wc * 32 + 8 * fq;
#pragma unroll
        for (int ai = 0; ai < 2; ++ai)
#pragma unroll
            for (int m = 0; m < 4; ++m) { bf16_t* rowp = O + (size_t)(row0 + ai * HALF + m * 16) * ldc + col0;
#pragma unroll
                for (int bj = 0; bj < 2; ++bj) { const f32x4 v0 = acc[ai][bj][m][0], v1 = acc[ai][bj][m][1];
                    u32x4 w; w.x = cvt_pk_bf16(v0[0], v0[1]); w.y = cvt_pk_bf16(v0[2], v0[3]); w.z = cvt_pk_bf16(v1[0], v1[1]); w.w = cvt_pk_bf16(v1[2], v1[3]);
                    *(u32x4*)(rowp + bj * HALF) = w; } }
    }
};
struct EpiResidF32 {
    static constexpr bool PERM = false;
    const float* R; float* C; int ldc;
    __device__ __forceinline__ void operator()(const f32x4 (&acc)[2][2][4][2], const Unit& u, int wr, int wc, int fr, int fq) const {
        const int row0 = u.pm * BM + wr * 64 + fr, col0 = u.pn * BM + wc * 32 + 4 * fq;
#pragma unroll
        for (int ai = 0; ai < 2; ++ai)
#pragma unroll
            for (int m = 0; m < 4; ++m) { const size_t off = (size_t)(row0 + ai * HALF + m * 16) * ldc + col0;
#pragma unroll
                for (int bj = 0; bj < 2; ++bj)
#pragma unroll
                    for (int n = 0; n < 2; ++n) { const f32x4 r = *(const f32x4*)(R + off + bj * HALF + n * 16); *(f32x4*)(C + off + bj * HALF + n * 16) = r + acc[ai][bj][m][n]; } }
    }
};
}

struct Args {
    const float* in[39];
    float* out;
    unsigned char* ws;
    int ph_lo, ph_hi;
};
enum { I_X = 0, I_L0_MIXN, I_L0_WIN, I_L0_QG, I_L0_KG, I_L0_LOGDT, I_L0_ARE, I_L0_AIM, I_L0_BRE, I_L0_BIM, I_L0_CRE, I_L0_CIM, I_L0_D, I_L0_WGLU, I_L0_BGLU, I_L0_WOUT,
       I_L0_FFNN, I_L0_WQ, I_L0_SK, I_L0_U, I_L0_V,
       I_L1_MIXN, I_L1_WIN, I_L1_QG, I_L1_KG, I_L1_CMPPOS, I_L1_KW1, I_L1_KW2, I_L1_VW1, I_L1_VW2, I_L1_WGATE, I_L1_BGATE, I_L1_OGAIN, I_L1_WOUT,
       I_L1_FFNN, I_L1_WQ, I_L1_SK, I_L1_U, I_L1_V };

struct Frame {
    LAS unsigned char* lds;
    int tid, lane, wave, G, bid;
};

constexpr size_t L0_QA = WS_R3;
constexpr size_t L0_IQ = WS_R3 + 32 * MiB;
constexpr size_t L0_KA = WS_R3 + 64 * MiB;
constexpr size_t L0_VAT = WS_R3 + 72 * MiB;
constexpr size_t L0_IK = WS_R3 + 80 * MiB;
constexpr size_t L0_IW = WS_R3 + 84 * MiB;
constexpr size_t L0_UA = WS_R3 + 88 * MiB;
constexpr size_t L0_SELT = WS_PROJ;
constexpr size_t L0_CAT = WS_PROJ + 16 * MiB;
constexpr size_t L0_SLOC = WS_PROJ + 80 * MiB;
constexpr size_t L0_YB = WS_PROJ + 112 * MiB;
constexpr size_t PE_Q2 = WS_PROJ;
constexpr size_t PE_EID = WS_PROJ + 128 * MiB;
constexpr size_t PE_GATE = WS_PROJ + 136 * MiB;

template <class Map>
__device__ __forceinline__ void transpose_item(const float* W, int K, int N, bf16_t* WT, int ldk, LAS float* scr, int item, int lane, const Map& map) {
    const int nblk = (N + 31) / 32, kb = item / nblk, nb = item % nblk, k0 = 64 * kb, n0 = 32 * nb;
    const int ncol = n0 + (lane & 31);
#pragma unroll 8
    for (int i = 0; i < 32; ++i) { const int kk = 2 * i + (lane >> 5); scr[kk * 33 + (lane & 31)] = (ncol < N) ? W[(size_t)(k0 + kk) * N + ncol] : 0.f; }
    LDS_WAIT(); asm volatile("" ::: "memory");
    const int c = lane & 7;
#pragma unroll
    for (int j = 0; j < 4; ++j) { const int n = (lane >> 3) + 8 * j; const LAS float* s = scr + (8 * c) * 33 + n;
        u32x4 o; o.x = pk2(s[0 * 33], s[1 * 33]); o.y = pk2(s[2 * 33], s[3 * 33]); o.z = pk2(s[4 * 33], s[5 * 33]); o.w = pk2(s[6 * 33], s[7 * 33]);
        if (n0 + n < N) *(u32x4*)(WT + (size_t)map(n0 + n) * ldk + k0 + 8 * c) = o; }
    LDS_WAIT(); asm volatile("" ::: "memory");
}
struct MapId { __device__ __forceinline__ int operator()(int n) const { return n; } };
struct MapIn0 { __device__ __forceinline__ int operator()(int n) const { return n < 1280 ? n : (n < 1344 ? n - 1280 + C0_IK : (n < 1352 ? n - 1344 + C0_IW : n - 1352 + C0_U)); } };
struct MapIn1 { __device__ __forceinline__ int operator()(int n) const {
    if (n < 1280) return n; if (n < 1304) return n - 1280 + C1_GL; if (n < 1560) return n - 1304 + C1_GQ; if (n < 1816) return n - 1560 + C1_GK;
    if (n < 2328) return n - 1816 + C1_GV; if (n < 2344) return n - 2328 + C1_GLOW; return n - 2344 + C1_GR; } };

template <class Map>
__device__ __forceinline__ void transpose_all(const Frame& F, int& base, const float* W, int K, int N, bf16_t* WT, int ldk, const Map& map) {
    LAS float* scr = (LAS float*)(F.lds + F.wave * 16384);
    const int gw = F.bid * NWAVES + F.wave, NGW = F.G * NWAVES;
    const int nit = (K / 64) * ((N + 31) / 32);
    for (int it = (gw + NGW - (base % NGW)) % NGW; it < nit; it += NGW) transpose_item(W, K, N, WT, ldk, scr, it, F.lane, map);
    base += nit;
}
__device__ __forceinline__ void zero_bytes(const Frame& F, unsigned char* p, size_t nbytes) {
    const size_t n16 = nbytes / 16;
    for (size_t i = (size_t)F.bid * NTHREADS + F.tid; i < n16; i += (size_t)F.G * NTHREADS) ((u32x4*)p)[i] = (u32x4){0u, 0u, 0u, 0u};
}
__device__ __forceinline__ void cvt_f32_bf16(const Frame& F, const float* src, bf16_t* dst, size_t n) {
    const size_t n8 = n / 8;
    for (size_t i = (size_t)F.bid * NTHREADS + F.tid; i < n8; i += (size_t)F.G * NTHREADS) {
        const f32x4 a = ((const f32x4*)src)[2 * i], b = ((const f32x4*)src)[2 * i + 1];
        u32x4 o; o.x = pk2(a.x, a.y); o.y = pk2(a.z, a.w); o.z = pk2(b.x, b.y); o.w = pk2(b.z, b.w);
        ((u32x4*)dst)[i] = o;
    }
}

__device__ __forceinline__ void rms_row_to_bf16(const float* xrow, const float* gain, bf16_t* orow, int lane) {
    const f32x4* xr = (const f32x4*)xrow + lane; const f32x4* gr = (const f32x4*)gain + lane;
    f32x4 v[4]; float s = 0.f;
#pragma unroll
    for (int j = 0; j < 4; ++j) { v[j] = xr[64 * j]; s += (v[j].x * v[j].x + v[j].y * v[j].y) + (v[j].z * v[j].z + v[j].w * v[j].w); }
    const float rstd = 1.0f / sqrtf(wave_sum(s) * (1.f / DM) + 1e-6f);
    u64* o8 = (u64*)orow + lane;
#pragma unroll
    for (int j = 0; j < 4; ++j) { const f32x4 g4 = gr[64 * j]; o8[64 * j] = (u64)pk2(v[j].x * rstd * g4.x, v[j].y * rstd * g4.y) | ((u64)pk2(v[j].z * rstd * g4.z, v[j].w * rstd * g4.w) << 32); }
}
__device__ __forceinline__ void p_rmsnorm(const Frame& F, const float* x, const float* gain, bf16_t* XN) {
    const int gw = F.bid * NWAVES + F.wave, NGW = F.G * NWAVES;
    for (int m = gw; m < T; m += NGW) rms_row_to_bf16(x + (size_t)m * DM, gain, XN + (size_t)m * DM, F.lane);
}

__device__ __forceinline__ void p_rope_table(const Frame& F, f32x2* rope) {
    for (int i = F.bid * NTHREADS + F.tid; i < SEQ * 32; i += F.G * NTHREADS) {
        const int pos = i >> 5, k = i & 31;
        const float inv = powf(10000.0f, -(float)k / 32.0f);
        const float ang = (float)pos * inv;
        float s, c; sincosf(ang, &s, &c);
        rope[i] = (f32x2){c, s};
    }
}

__device__ __forceinline__ void s5_build_group(const Frame& F, const Args& a, unsigned char* ws, int g) {
    LAS f32x2* abp = (LAS f32x2*)F.lds;
    LAS f32x2* bb = abp + 17 * 64;
    LAS f32x2* Cc = bb + 64 * 16;
    LAS float* KT = (LAS float*)(Cc + 16 * 64);
    const float dt = expf(a.in[I_L0_LOGDT][g]);
    for (int idx = F.tid; idx < 17 * 64; idx += NTHREADS) {
        const int tau = idx >> 6, p = idx & 63;
        const float lr = a.in[I_L0_ARE][g * 64 + p], li = a.in[I_L0_AIM][g * 64 + p];
        const float mag = expf((float)tau * dt * lr); float s, c; sincosf((float)tau * dt * li, &s, &c);
        abp[idx] = (f32x2){mag * c, mag * s};
    }
    for (int idx = F.tid; idx < 64 * 16; idx += NTHREADS) {
        const int p = idx >> 4, c = idx & 15;
        const float lr = a.in[I_L0_ARE][g * 64 + p], li = a.in[I_L0_AIM][g * 64 + p];
        const float mag = expf(dt * lr); float s, co; sincosf(dt * li, &s, &co);
        const float abr = mag * co, abi = mag * s, den = lr * lr + li * li;
        const float fr = ((abr - 1.0f) * lr + abi * li) / den, fi = (abi * lr - (abr - 1.0f) * li) / den;
        const float br = a.in[I_L0_BRE][(size_t)(g * 64 + p) * 16 + c], bi = a.in[I_L0_BIM][(size_t)(g * 64 + p) * 16 + c];
        bb[idx] = (f32x2){fr * br - fi * bi, fr * bi + fi * br};
    }
    for (int idx = F.tid; idx < 16 * 64; idx += NTHREADS) Cc[idx] = (f32x2){a.in[I_L0_CRE][(size_t)g * 1024 + idx], a.in[I_L0_CIM][(size_t)g * 1024 + idx]};
    __syncthreads();
    for (int idx = F.tid; idx < 16 * 256; idx += NTHREADS) {
        const int tau = idx >> 8, co = (idx >> 4) & 15, ci = idx & 15;
        float acc = 0.f;
        for (int p = 0; p < 64; ++p) {
            const f32x2 c = Cc[co * 64 + p], e = abp[tau * 64 + p], b = bb[p * 16 + ci];
            const float er = c.x * e.x - c.y * e.y, ei = c.x * e.y + c.y * e.x;
            acc += er * b.x - ei * b.y;
        }
        if (tau == 0 && co == ci) acc += a.in[I_L0_D][g * 16 + co];
        KT[idx] = acc;
    }
    __syncthreads();
    bf16_t* B1 = (bf16_t*)(ws + WS_S5B1) + (size_t)g * 256 * 256;
    bf16_t* B2 = (bf16_t*)(ws + WS_S5B2) + (size_t)g * 256 * 384;
    for (int idx = F.tid; idx < 256 * 128; idx += NTHREADS) {
        const int n = idx >> 7, k = (idx & 127) * 2;
        float v0 = 0.f, v1 = 0.f;
        if (n < 128) { const int p = n & 63, j = k >> 4, ci = k & 15; const f32x2 e = abp[(15 - j) * 64 + p], b0 = bb[p * 16 + ci], b1 = bb[p * 16 + ci + 1];
            if (n < 64) { v0 = e.x * b0.x - e.y * b0.y; v1 = e.x * b1.x - e.y * b1.y; } else { v0 = e.x * b0.y + e.y * b0.x; v1 = e.x * b1.y + e.y * b1.x; } }
        *(unsigned*)(B1 + (size_t)n * 256 + k) = pk2(v0, v1);
    }
    for (int idx = F.tid; idx < 256 * 192; idx += NTHREADS) {
        const int n = idx / 192, k = (idx % 192) * 2, i = n >> 4, co = n & 15;
        float v0 = 0.f, v1 = 0.f;
        if (k < 256) { const int j = k >> 4, ci = k & 15; if (j <= i) { v0 = KT[((i - j) * 16 + co) * 16 + ci]; v1 = KT[((i - j) * 16 + co) * 16 + ci + 1]; } }
        else { const int p = (k - 256) & 63; const bool im = k >= 320;
            const f32x2 c0 = Cc[co * 64 + p], e0 = abp[(i + 1) * 64 + p], c1 = Cc[co * 64 + p + 1], e1 = abp[(i + 1) * 64 + p + 1];
            if (!im) { v0 = c0.x * e0.x - c0.y * e0.y; v1 = c1.x * e1.x - c1.y * e1.y; } else { v0 = -(c0.x * e0.y + c0.y * e0.x); v1 = -(c1.x * e1.y + c1.y * e1.x); } }
        *(unsigned*)(B2 + (size_t)n * 384 + k) = pk2(v0, v1);
    }
    __syncthreads();
}

__device__ __forceinline__ void cmp_bias(const Frame& F, const Args& a, float* out, int j) {
    const int w = j >> 5, n0 = (j & 31) * 8;
    const float* w1 = a.in[w ? I_L1_VW1 : I_L1_KW1]; const float* pos = a.in[I_L1_CMPPOS];
    LAS float* red = (LAS float*)(F.lds + 65536);
    float acc[8];
#pragma unroll
    for (int i = 0; i < 8; ++i) acc[i] = 0.f;
#pragma unroll
    for (int kk = 0; kk < 4; ++kk) { const int k = F.tid * 4 + kk; const float p = pos[k];
        const f32x4 wa = *(const f32x4*)(w1 + (size_t)k * 256 + n0), wb = *(const f32x4*)(w1 + (size_t)k * 256 + n0 + 4);
        acc[0] += p * wa.x; acc[1] += p * wa.y; acc[2] += p * wa.z; acc[3] += p * wa.w; acc[4] += p * wb.x; acc[5] += p * wb.y; acc[6] += p * wb.z; acc[7] += p * wb.w; }
#pragma unroll
    for (int i = 0; i < 8; ++i) { const float sv = wave_sum(acc[i]); if (F.lane == 0) red[F.wave * 8 + i] = sv; }
    __syncthreads();
    if (F.tid < 8) { float t = 0.f; for (int wv = 0; wv < 8; ++wv) t += red[wv * 8 + F.tid]; out[w * 256 + n0 + F.tid] = t; }
    __syncthreads();
}

__device__ __forceinline__ float rope_apply(float v, const f32x2 cs, int lane) {
    const float partner = __shfl_xor(v, 32);
    return lane < 32 ? v * cs.x - partner * cs.y : partner * cs.y + v * cs.x;
}
__device__ __forceinline__ void head8_load(const bf16_t* p, float (&v)[8]) {
    const u32x4 q = *(const u32x4*)p;
    v[0] = bf_lo(q.x); v[1] = bf_hi(q.x); v[2] = bf_lo(q.y); v[3] = bf_hi(q.y); v[4] = bf_lo(q.z); v[5] = bf_hi(q.z); v[6] = bf_lo(q.w); v[7] = bf_hi(q.w);
}
__device__ __forceinline__ void head8_store(bf16_t* p, const float (&v)[8], const float sc) {
    u32x4 q; q.x = pk2(v[0] * sc, v[1] * sc); q.y = pk2(v[2] * sc, v[3] * sc); q.z = pk2(v[4] * sc, v[5] * sc); q.w = pk2(v[6] * sc, v[7] * sc);
    *(u32x4*)p = q;
}
__device__ __forceinline__ void head8_norm(float (&v)[8], const float (&g)[8]) {
    float ss = 0.f;
#pragma unroll
    for (int j = 0; j < 8; ++j) ss += v[j] * v[j];
    ss += __shfl_xor(ss, 1); ss += __shfl_xor(ss, 2); ss += __shfl_xor(ss, 4);
    const float r = 1.0f / sqrtf(ss * (1.f / 64.f) + 1e-6f);
#pragma unroll
    for (int j = 0; j < 8; ++j) v[j] = v[j] * r * g[j];
}
__device__ __forceinline__ void head8_rope(float (&v)[8], const f32x2 (&cs)[8], const bool upper) {
#pragma unroll
    for (int j = 0; j < 8; ++j) { const float partner = __shfl_xor(v[j], 4); v[j] = upper ? partner * cs[j].y + v[j] * cs[j].x : v[j] * cs[j].x - partner * cs[j].y; }
}
__device__ __forceinline__ void p_l0_prep(const Frame& F, const Args& a, unsigned char* ws) {
    const bf16_t* P = (const bf16_t*)(ws + WS_PROJ);
    const f32x2* rope = (const f32x2*)(ws + WS_ROPE);
    bf16_t* QA = (bf16_t*)(ws + L0_QA); bf16_t* IQ = (bf16_t*)(ws + L0_IQ); bf16_t* KA = (bf16_t*)(ws + L0_KA); bf16_t* VAT = (bf16_t*)(ws + L0_VAT);
    bf16_t* IK = (bf16_t*)(ws + L0_IK); float* IW = (float*)(ws + L0_IW); bf16_t* UA = (bf16_t*)(ws + L0_UA);
    const int gw = F.bid * NWAVES + F.wave, NGW = F.G * NWAVES, lane = F.lane, hs = lane >> 3, sub = lane & 7;
    float qg[8], kg[8];
#pragma unroll
    for (int j = 0; j < 8; ++j) { qg[j] = a.in[I_L0_QG][sub * 8 + j]; kg[j] = a.in[I_L0_KG][sub * 8 + j]; }
    for (int m = gw; m < T; m += NGW) {
        const int b = m >> 12, t = m & 4095;
        const bf16_t* row = P + (size_t)m * N_IN0;
        f32x2 cs[8];
#pragma unroll
        for (int j = 0; j < 4; ++j) { const f32x4 c4 = *(const f32x4*)(rope + t * 32 + (sub & 3) * 8 + 2 * j); cs[2 * j] = (f32x2){c4.x, c4.y}; cs[2 * j + 1] = (f32x2){c4.z, c4.w}; }
        float v[8];
        head8_load(row + C0_Q + lane * 8, v); head8_norm(v, qg); head8_rope(v, cs, sub >= 4); head8_store(QA + (size_t)m * 512 + lane * 8, v, 0.125f);
        head8_load(row + C0_IQ + lane * 8, v); head8_rope(v, cs, sub >= 4); head8_store(IQ + (size_t)m * 512 + lane * 8, v, 0.125f);
        {
            const int hh = hs < 3 ? hs : 2;
            head8_load(row + (hh < 2 ? C0_K + hh * 64 : C0_IK) + sub * 8, v);
            float vn[8];
#pragma unroll
            for (int j = 0; j < 8; ++j) vn[j] = v[j];
            head8_norm(vn, kg);
#pragma unroll
            for (int j = 0; j < 8; ++j) v[j] = (hh < 2) ? vn[j] : v[j];
            head8_rope(v, cs, sub >= 4);
            if (hs < 2) head8_store(KA + ((size_t)(b * 2 + hs) * 4096 + t) * 64 + sub * 8, v, 1.0f);
            else if (hs == 2) head8_store(IK + (size_t)m * 64 + sub * 8, v, 1.0f);
        }
        if (lane < 8) IW[(size_t)m * 8 + lane] = bf2f(row[C0_IW + lane]) * 0.35355339059327373f;
        { const u32x4 uv = *(const u32x4*)(row + C0_U + lane * 8); const int g = lane >> 1;
          *(u32x4*)(UA + ((size_t)g * 2048 + (m >> 4)) * 384 + (m & 15) * 16 + (lane & 1) * 8) = uv; }
    }
    for (int it = gw; it < NB * 2 * 64; it += NGW) {
        const int tb = it & 63, g = (it >> 6) & 1, b = it >> 7;
        const size_t m = (size_t)b * 4096 + tb * 64 + lane;
        unsigned r[32];
#pragma unroll
        for (int j = 0; j < 8; ++j) { const u32x4 q = *(const u32x4*)(P + m * N_IN0 + C0_V + g * 64 + j * 8); r[4 * j] = q.x; r[4 * j + 1] = q.y; r[4 * j + 2] = q.z; r[4 * j + 3] = q.w; }
        bf16_t* dst = VAT + ((size_t)(b * 2 + g) * 64) * 4096 + tb * 64 + lane;
#pragma unroll
        for (int d = 0; d < 64; ++d) dst[(size_t)d * 4096] = (bf16_t)((d & 1) ? (r[d >> 1] >> 16) : (r[d >> 1] & 0xffffu));
    }
}

__device__ __forceinline__ unsigned f16key(unsigned raw) { return (raw & 0x8000u) ? (~raw & 0xFFFFu) : (raw | 0x8000u); }
template <int NREG>
__device__ __forceinline__ int topk_count_ge(const unsigned (&kk)[NREG], const unsigned cm1pk) {
    unsigned acc = 0u; const unsigned ones = 0x00010001u;
#pragma unroll
    for (int jj = 0; jj < NREG; ++jj) {
        unsigned d;
        asm("v_pk_sub_u16 %0, %1, %2 clamp" : "=v"(d) : "v"(kk[jj]), "v"(cm1pk));
        asm("v_pk_min_u16 %0, %1, %2" : "=v"(d) : "v"(d), "v"(ones));
        asm("v_pk_add_u16 %0, %1, %2" : "=v"(acc) : "v"(acc), "v"(d));
    }
    int c = (int)((acc & 0xffffu) + (acc >> 16));
    c += __builtin_amdgcn_update_dpp(0, c, 0xB1, 0xF, 0xF, true);
    c += __builtin_amdgcn_update_dpp(0, c, 0x4E, 0xF, 0xF, true);
    c += __builtin_amdgcn_update_dpp(0, c, 0x141, 0xF, 0xF, true);
    c += __builtin_amdgcn_update_dpp(0, c, 0x140, 0xF, 0xF, true);
    return __builtin_amdgcn_readlane(c, 0) + __builtin_amdgcn_readlane(c, 16) + __builtin_amdgcn_readlane(c, 32) + __builtin_amdgcn_readlane(c, 48);
}
template <int NREG>
__device__ __forceinline__ u64 topk_query(const LAS unsigned short* scq, const int t, const int lane) {
    unsigned kk[NREG];
#pragma unroll
    for (int jj = 0; jj < NREG; ++jj) {
        const int e0 = (2 * jj) * 64 + lane, e1 = e0 + 64;
        const unsigned r0 = scq[e0], r1 = scq[e1];
        kk[jj] = ((e0 <= t) ? f16key(r0) : 0u) | (((e1 <= t) ? f16key(r1) : 0u) << 16);
        if ((jj & 3) == 3) __builtin_amdgcn_sched_barrier(0);
    }
    unsigned prefix = 0u; bool exact = false;
#pragma unroll 1
    for (int bit = 15; bit >= 0; --bit) {
        const unsigned cand = prefix | (1u << bit), cm1 = cand - 1u;
        const int cnt = topk_count_ge<NREG>(kk, cm1 | (cm1 << 16));
        if (cnt >= 256) prefix = cand;
        if (cnt == 256) { exact = true; break; }
    }
    unsigned mylo = 0u, myhi = 0u;
    if (exact) {
#pragma unroll
        for (int i = 0; i < 2 * NREG; ++i) {
            const unsigned k = (i & 1) ? (kk[i >> 1] >> 16) : (kk[i >> 1] & 0xffffu);
            const u64 w = __ballot(k >= prefix);
            asm("s_nop 4\n\tv_writelane_b32 %0, %2, %4\n\tv_writelane_b32 %1, %3, %4" : "+v"(mylo), "+v"(myhi) : "s"((unsigned)w), "s"((unsigned)(w >> 32)), "n"(i));
        }
    } else {
        const unsigned Tk = prefix;
        const int cgt = (Tk >= 0xFFFFu) ? 0 : topk_count_ge<NREG>(kk, Tk | (Tk << 16));
        const int need = 256 - cgt;
        int run = 0;
#pragma unroll
        for (int i = 0; i < 2 * NREG; ++i) {
            const unsigned k = (i & 1) ? (kk[i >> 1] >> 16) : (kk[i >> 1] & 0xffffu);
            const u64 gt = __ballot(k > Tk); u64 eq = __ballot(k == Tk);
            const int pe = __builtin_popcountll(eq);
            if (run + pe > need) { int kq = need - run; kq = kq < 0 ? 0 : kq;
                const bool keep = ((eq >> lane) & 1ull) && (__builtin_popcountll(eq & ((1ull << lane) - 1ull)) < kq); eq = __ballot(keep); }
            run += pe;
            const u64 w = gt | eq;
            asm("s_nop 4\n\tv_writelane_b32 %0, %2, %4\n\tv_writelane_b32 %1, %3, %4" : "+v"(mylo), "+v"(myhi) : "s"((unsigned)w), "s"((unsigned)(w >> 32)), "n"(i));
        }
    }
    return (u64)mylo | ((u64)myhi << 32);
}
__device__ __forceinline__ void p_dsa_index(const Frame& F, unsigned char* ws, u64* SELT, const int mode) {
    const bf16_t* IQ = (const bf16_t*)(ws + L0_IQ); const bf16_t* IK = (const bf16_t*)(ws + L0_IK); const float* IW = (const float*)(ws + L0_IW);
    LAS _Float16* sc = (LAS _Float16*)F.lds;
    LAS unsigned short* scu = (LAS unsigned short*)F.lds;
    LAS u64* mk = (LAS u64*)(F.lds + 131072);
    LAS float* wl = (LAS float*)(F.lds + 131072 + 8192);
    const int lane = F.lane, wave = F.wave, h = lane >> 5, r = lane & 31;
    const int rq = ((r >> 4) & 1) + 2 * ((r >> 2) & 1), rh = 4 * ((r >> 3) & 1) + (r & 3);
    for (int u = F.bid; u < 2048; u += F.G) {
        const int idx = u & 255, b = u >> 8;
        const int j = (b & 1) ? 255 - idx : idx;
        const int t0 = j * 16; const size_t mb = (size_t)b * 4096;
        if (F.tid < 128) wl[F.tid] = IW[(mb + t0) * 8 + F.tid];
        const int nkb = (t0 + 15) / 32 + 1;
        bf16x8 Af[4][4];
#pragma unroll
        for (int rt = 0; rt < 4; ++rt)
#pragma unroll
            for (int ks = 0; ks < 4; ++ks) Af[rt][ks] = *(const bf16x8*)(IQ + (mb + t0 + 4 * rt + rq) * 512 + rh * 64 + ks * 16 + 8 * h);
        __syncthreads();
        if (mode != 2) for (int kb = wave; kb < nkb; kb += NWAVES) {
            bf16x8 Bf[4];
#pragma unroll
            for (int ks = 0; ks < 4; ++ks) Bf[ks] = *(const bf16x8*)(IK + (mb + kb * 32 + r) * 64 + ks * 16 + 8 * h);
#pragma unroll
            for (int rt = 0; rt < 4; ++rt) {
                f32x16 acc = {0.f, 0.f, 0.f, 0.f, 0.f, 0.f, 0.f, 0.f, 0.f, 0.f, 0.f, 0.f, 0.f, 0.f, 0.f, 0.f};
#pragma unroll
                for (int ks = 0; ks < 4; ++ks) acc = __builtin_amdgcn_mfma_f32_32x32x16_bf16(Af[rt][ks], Bf[ks], acc, 0, 0, 0);
                const int qa = 4 * rt + 2 * h;
                const f32x4 wa0 = *(const LAS f32x4*)(wl + qa * 8), wa1 = *(const LAS f32x4*)(wl + qa * 8 + 4), wb0 = *(const LAS f32x4*)(wl + qa * 8 + 8), wb1 = *(const LAS f32x4*)(wl + qa * 8 + 12);
                float sa = 0.f, sb = 0.f;
#pragma unroll
                for (int i = 0; i < 4; ++i) { sa += wa0[i] * fmaxf(acc[i], 0.f); sa += wa1[i] * fmaxf(acc[4 + i], 0.f); sb += wb0[i] * fmaxf(acc[8 + i], 0.f); sb += wb1[i] * fmaxf(acc[12 + i], 0.f); }
                sc[qa * 4096 + kb * 32 + r] = (_Float16)sa;
                sc[(qa + 1) * 4096 + kb * 32 + r] = (_Float16)sb;
                __builtin_amdgcn_sched_barrier(0);
            }
        }
        __syncthreads();
#pragma unroll 1
        for (int qq = 0; qq < (mode == 1 ? 0 : 2); ++qq) {
            const int q = wave * 2 + qq, t = t0 + q, n = t + 1;
            unsigned mylo = 0u, myhi = 0u;
            if (n <= 256) {
                const int base = lane * 64;
                const u64 word = (base + 63 <= t) ? ~0ull : (base > t ? 0ull : ((1ull << (t - base + 1)) - 1ull));
                mylo = (unsigned)word; myhi = (unsigned)(word >> 32);
            } else {
                const int nreg = (((n + 63) >> 6) + 1) >> 1;
                const LAS unsigned short* scq = scu + q * 4096;
                u64 w;
                if (nreg <= 4) w = topk_query<4>(scq, t, lane);
                else if (nreg <= 8) w = topk_query<8>(scq, t, lane);
                else if (nreg <= 12) w = topk_query<12>(scq, t, lane);
                else if (nreg <= 16) w = topk_query<16>(scq, t, lane);
                else if (nreg <= 20) w = topk_query<20>(scq, t, lane);
                else if (nreg <= 24) w = topk_query<24>(scq, t, lane);
                else if (nreg <= 28) w = topk_query<28>(scq, t, lane);
                else w = topk_query<32>(scq, t, lane);
                mylo = (unsigned)w; myhi = (unsigned)(w >> 32);
            }
            mk[lane * 16 + q] = (u64)mylo | ((u64)myhi << 32);
        }
        __syncthreads();
        { const int w = F.tid >> 3, part = F.tid & 7;
          u64* dst = SELT + ((size_t)(b * 64 + w) * 4096) + t0 + part * 2;
          dst[0] = mk[w * 16 + part * 2]; dst[1] = mk[w * 16 + part * 2 + 1]; }
        __syncthreads();
    }
}

constexpr int AT_KB = 9216, AT_VB = 8704, AT_BUF = AT_KB + AT_VB;
struct AttStage { u32x4 kreg, vreg; };
__device__ __forceinline__ void att_load(AttStage& s, const bf16_t* Kg, const bf16_t* Vtg, int key0, int tid) {
    s.kreg = *(const u32x4*)(Kg + (size_t)(key0 + (tid >> 3)) * 64 + (tid & 7) * 8);
    s.vreg = *(const u32x4*)(Vtg + (size_t)(tid >> 3) * 4096 + key0 + (tid & 7) * 8);
}
__device__ __forceinline__ void att_store(const AttStage& s, LAS unsigned char* buf, int tid) {
    *(LAS u32x4*)(buf + (tid >> 3) * 144 + (tid & 7) * 16) = s.kreg;
    LAS unsigned char* v = buf + AT_KB + (tid >> 3) * 136 + (tid & 7) * 16;
    *(LAS u32x2*)(v) = (u32x2){s.vreg.x, s.vreg.y}; *(LAS u32x2*)(v + 8) = (u32x2){s.vreg.z, s.vreg.w};
}
__device__ __forceinline__ bf16x8 pack8(float a0, float a1, float a2, float a3, float a4, float a5, float a6, float a7) {
    u32x4 w; w.x = pg8::cvt_pk_bf16(a0, a1); w.y = pg8::cvt_pk_bf16(a2, a3); w.z = pg8::cvt_pk_bf16(a4, a5); w.w = pg8::cvt_pk_bf16(a6, a7);
    return __builtin_bit_cast(bf16x8, w);
}
__device__ __forceinline__ f32x16 att_qk(const LAS unsigned char* buf, int sub, const bf16x8 (&Qf)[4], int lane) {
    f32x16 S = {0.f, 0.f, 0.f, 0.f, 0.f, 0.f, 0.f, 0.f, 0.f, 0.f, 0.f, 0.f, 0.f, 0.f, 0.f, 0.f};
    const LAS unsigned char* kp = buf + (sub * 32 + (lane & 31)) * 144 + (lane >> 5) * 16;
#pragma unroll
    for (int ks = 0; ks < 4; ++ks) { const bf16x8 kf = *(const LAS bf16x8*)(kp + ks * 32); S = __builtin_amdgcn_mfma_f32_32x32x16_bf16(kf, Qf[ks], S, 0, 0, 0); }
    return S;
}
__device__ __forceinline__ void att_pv2(const LAS unsigned char* buf, int sub, const bf16x8 P0, const bf16x8 P1, f32x16 (&O)[2], int lane) {
    const int h = lane >> 5;
#pragma unroll
    for (int dt = 0; dt < 2; ++dt) {
        const LAS unsigned char* vp = buf + AT_KB + (dt * 32 + (lane & 31)) * 136 + (sub * 32 + 4 * h) * 2;
        const u32x2 a0 = *(const LAS u32x2*)(vp), a1 = *(const LAS u32x2*)(vp + 16), b0 = *(const LAS u32x2*)(vp + 32), b1 = *(const LAS u32x2*)(vp + 48);
        const bf16x8 V0 = __builtin_bit_cast(bf16x8, ((u32x4){a0.x, a0.y, a1.x, a1.y}));
        const bf16x8 V1 = __builtin_bit_cast(bf16x8, ((u32x4){b0.x, b0.y, b1.x, b1.y}));
        O[dt] = __builtin_amdgcn_mfma_f32_32x32x16_bf16(V0, P0, O[dt], 0, 0, 0);
        O[dt] = __builtin_amdgcn_mfma_f32_32x32x16_bf16(V1, P1, O[dt], 0, 0, 0);
    }
}
__device__ __forceinline__ void att_pv(const LAS unsigned char* buf, int sub, const float (&p)[16], f32x16 (&O)[2], int lane) {
    const bf16x8 P0 = pack8(p[0], p[1], p[2], p[3], p[4], p[5], p[6], p[7]);
    const bf16x8 P1 = pack8(p[8], p[9], p[10], p[11], p[12], p[13], p[14], p[15]);
    att_pv2(buf, sub, P0, P1, O, lane);
}

__device__ __forceinline__ void att_kfrags(const LAS unsigned char* buf, int sub, bf16x8 (&Kf)[4], int lane) {
    const LAS unsigned char* kp = buf + (sub * 32 + (lane & 31)) * 144 + (lane >> 5) * 16;
#pragma unroll
    for (int ks = 0; ks < 4; ++ks) Kf[ks] = *(const LAS bf16x8*)(kp + ks * 32);
}
__device__ __forceinline__ void att_vfrags(const LAS unsigned char* buf, int sub, bf16x8 (&Vf)[2][2], int lane) {
    const int h = lane >> 5;
#pragma unroll
    for (int dt = 0; dt < 2; ++dt) {
        const LAS unsigned char* vp = buf + AT_KB + (dt * 32 + (lane & 31)) * 136 + (sub * 32 + 4 * h) * 2;
        const u32x2 a0 = *(const LAS u32x2*)(vp), a1 = *(const LAS u32x2*)(vp + 16), b0 = *(const LAS u32x2*)(vp + 32), b1 = *(const LAS u32x2*)(vp + 48);
        Vf[dt][0] = __builtin_bit_cast(bf16x8, ((u32x4){a0.x, a0.y, a1.x, a1.y}));
        Vf[dt][1] = __builtin_bit_cast(bf16x8, ((u32x4){b0.x, b0.y, b1.x, b1.y}));
    }
}
__device__ __forceinline__ f32x16 att_qk_f(const bf16x8 (&Kf)[4], const bf16x8 (&Qf)[4]) {
    f32x16 S = {0.f, 0.f, 0.f, 0.f, 0.f, 0.f, 0.f, 0.f, 0.f, 0.f, 0.f, 0.f, 0.f, 0.f, 0.f, 0.f};
#pragma unroll
    for (int ks = 0; ks < 4; ++ks) S = __builtin_amdgcn_mfma_f32_32x32x16_bf16(Kf[ks], Qf[ks], S, 0, 0, 0);
    return S;
}
__device__ __forceinline__ void att_pv_f(const bf16x8 (&Vf)[2][2], const bf16x8 P0, const bf16x8 P1, f32x16 (&O)[2]) {
#pragma unroll
    for (int dt = 0; dt < 2; ++dt) { O[dt] = __builtin_amdgcn_mfma_f32_32x32x16_bf16(Vf[dt][0], P0, O[dt], 0, 0, 0); O[dt] = __builtin_amdgcn_mfma_f32_32x32x16_bf16(Vf[dt][1], P1, O[dt], 0, 0, 0); }
}

__device__ __forceinline__ void p_dsa_attn(const Frame& F, const Args& a, unsigned char* ws) {
    const bf16_t* QA = (const bf16_t*)(ws + L0_QA); const bf16_t* KA = (const bf16_t*)(ws + L0_KA); const bf16_t* VAT = (const bf16_t*)(ws + L0_VAT);
    const u64* SELT = (const u64*)(ws + L0_SELT); bf16_t* CAT = (bf16_t*)(ws + L0_CAT);
    const int lane = F.lane, wave = F.wave, h = lane >> 5, c = lane & 31, tid = F.tid;
    float mq = 0.f, mk_ = 0.f;
    for (int i = 0; i < 64; ++i) { mq = fmaxf(mq, fabsf(a.in[I_L0_QG][i])); mk_ = fmaxf(mk_, fabsf(a.in[I_L0_KG][i])); }
    const float c2 = (8.0f * mq * mk_ + 0.5f) * 1.4426950408889634f, c1 = 1.4426950408889634f;
    for (int u = F.bid; u < 512; u += F.G) {
        const int idx = u & 255, g = u >> 8, b = idx >> 5, qtr = idx & 31, qt = g ? 31 - qtr : qtr, q0 = qt * 128;
        const size_t mb = (size_t)b * 4096;
        const bf16_t* Kg = KA + (size_t)(b * 2 + g) * 4096 * 64; const bf16_t* Vtg = VAT + (size_t)(b * 2 + g) * 64 * 4096;
        bf16x8 Qf[2][4]; int qidx[2];
#pragma unroll
        for (int ct = 0; ct < 2; ++ct) { qidx[ct] = q0 + wave * 16 + ct * 8 + (c >> 2);
#pragma unroll
            for (int ks = 0; ks < 4; ++ks) Qf[ct][ks] = *(const bf16x8*)(QA + (mb + qidx[ct]) * 512 + (g * 4 + (c & 3)) * 64 + ks * 16 + 8 * h); }
        f32x16 O[2][2]; float l[2] = {0.f, 0.f};
#pragma unroll
        for (int ct = 0; ct < 2; ++ct)
#pragma unroll
            for (int dt = 0; dt < 2; ++dt)
#pragma unroll
                for (int i = 0; i < 16; ++i) O[ct][dt][i] = 0.f;
        const int nkt = 2 * qt + 2;
        AttStage st; att_load(st, Kg, Vtg, 0, tid);
        __syncthreads();
        att_store(st, F.lds, tid);
        __syncthreads();
        for (int kt = 0; kt < nkt; ++kt) {
            LAS unsigned char* buf = F.lds + (kt & 1) * AT_BUF;
            if (kt + 1 < nkt) att_load(st, Kg, Vtg, (kt + 1) * 64, tid);
            u64 mw[2];
#pragma unroll
            for (int ct = 0; ct < 2; ++ct) mw[ct] = SELT[(size_t)(b * 64 + kt) * 4096 + qidx[ct]];
#pragma unroll 1
            for (int sub = 0; sub < 2; ++sub) {
                bf16x8 Kf[4], Vf[2][2];
                att_kfrags(buf, sub, Kf, lane); att_vfrags(buf, sub, Vf, lane);
#pragma unroll
                for (int ct = 0; ct < 2; ++ct) {
                    __builtin_amdgcn_sched_barrier(0);
                    const f32x16 S = att_qk_f(Kf, Qf[ct]);
                    const unsigned mbits = (unsigned)(mw[ct] >> (sub * 32 + 4 * h));
                    float p[16];
#pragma unroll
                    for (int i = 0; i < 16; ++i) {
                        const float e = __builtin_amdgcn_exp2f(S[i] * c1 - c2);
                        const int bitpos = (i & 3) + 8 * (i >> 2);
                        p[i] = __builtin_bit_cast(float, __builtin_bit_cast(int, e) & __builtin_amdgcn_sbfe((int)mbits, bitpos, 1));
                        l[ct] += p[i];
                    }
                    att_pv_f(Vf, pack8(p[0], p[1], p[2], p[3], p[4], p[5], p[6], p[7]), pack8(p[8], p[9], p[10], p[11], p[12], p[13], p[14], p[15]), O[ct]);
                }
            }
            if (kt + 1 < nkt) att_store(st, F.lds + ((kt + 1) & 1) * AT_BUF, tid);
            __syncthreads();
        }
#pragma unroll
        for (int ct = 0; ct < 2; ++ct) {
            const float lt = l[ct] + __shfl_xor(l[ct], 32);
            const float inv = 1.0f / fmaxf(lt, 1e-30f);
            bf16_t* orow = CAT + (mb + qidx[ct]) * 1024 + (g * 4 + (c & 3)) * 64;
#pragma unroll
            for (int dt = 0; dt < 2; ++dt)
#pragma unroll
                for (int i4 = 0; i4 < 4; ++i4) {
                    const int d = dt * 32 + 8 * i4 + 4 * h;
                    u32x2 w; w.x = pk2(O[ct][dt][4 * i4] * inv, O[ct][dt][4 * i4 + 1] * inv); w.y = pk2(O[ct][dt][4 * i4 + 2] * inv, O[ct][dt][4 * i4 + 3] * inv);
                    *(u32x2*)(orow + d) = w;
                }
        }
    }
}

__device__ __forceinline__ void p_s5_scan(const Frame& F, const Args& a, unsigned char* ws) {
    const float* SLOC = (const float*)(ws + L0_SLOC); bf16_t* UA = (bf16_t*)(ws + L0_UA);
    const int p = F.lane;
    if (F.wave == 0) for (int it = F.bid; it < 32 * NB; it += F.G) {
        const int g = it >> 3, b = it & 7;
        const float dt = expf(a.in[I_L0_LOGDT][g]);
        const float lr = a.in[I_L0_ARE][g * 64 + p], li = a.in[I_L0_AIM][g * 64 + p];
        const float mag = expf(16.0f * dt * lr); float s, c; sincosf(16.0f * dt * li, &s, &c);
        const float ar = mag * c, ai = mag * s;
        float hr = 0.f, hi = 0.f;
        const float* sl = SLOC + ((size_t)g * 2048 + b * 256) * 128;
        bf16_t* ua = UA + ((size_t)g * 2048 + b * 256) * 384 + 256;
        for (int ch = 0; ch < 256; ++ch) {
            ua[(size_t)ch * 384 + p] = (bf16_t)f2bf(hr); ua[(size_t)ch * 384 + 64 + p] = (bf16_t)f2bf(hi);
            const float xr = sl[(size_t)ch * 128 + p], xi = sl[(size_t)ch * 128 + 64 + p];
            const float nr = ar * hr - ai * hi + xr, ni = ar * hi + ai * hr + xi;
            hr = nr; hi = ni;
        }
    }
}
namespace pg8 {
struct EpiS5State {
    static constexpr bool PERM = false;
    float* C;
    __device__ __forceinline__ void operator()(const f32x4 (&acc)[2][2][4][2], const Unit& u, int wr, int wc, int fr, int fq) const {
        const int row0 = u.pm * BM + wr * 64 + fr, col0 = wc * 32 + 4 * fq;
#pragma unroll
        for (int ai = 0; ai < 2; ++ai)
#pragma unroll
            for (int m = 0; m < 4; ++m)
#pragma unroll
                for (int n = 0; n < 2; ++n) *(f32x4*)(C + (size_t)(row0 + ai * HALF + m * 16) * 128 + col0 + n * 16) = acc[ai][0][m][n];
    }
};
struct EpiS5Out {
    static constexpr bool PERM = false;
    bf16_t* YB;
    __device__ __forceinline__ void operator()(const f32x4 (&acc)[2][2][4][2], const Unit& u, int wr, int wc, int fr, int fq) const {
        const int g = u.pn;
        const int row0 = u.pm * BM + wr * 64 + fr - g * 2048;
        const int col0 = wc * 32 + 4 * fq;
#pragma unroll
        for (int ai = 0; ai < 2; ++ai)
#pragma unroll
            for (int m = 0; m < 4; ++m) { const int chunk = row0 + ai * HALF + m * 16;
#pragma unroll
                for (int bj = 0; bj < 2; ++bj)
#pragma unroll
                    for (int n = 0; n < 2; ++n) { const int col = col0 + bj * HALF + n * 16, i = col >> 4, co = col & 15;
                        const f32x4 v = acc[ai][bj][m][n];
                        u32x2 w; w.x = pk2(gelu_tanh(v[0]), gelu_tanh(v[1])); w.y = pk2(gelu_tanh(v[2]), gelu_tanh(v[3]));
                        *(u32x2*)(YB + ((size_t)chunk * 16 + i) * 512 + g * 16 + co) = w; }
                asm volatile("" ::: "memory"); __builtin_amdgcn_sched_barrier(0); }
    }
};
struct EpiGlu {
    static constexpr bool PERM = true;
    const bf16_t* YB; const float* bias; bf16_t* CAT;
    __device__ __forceinline__ void operator()(const f32x4 (&acc)[2][2][4][2], const Unit& u, int wr, int wc, int fr, int fq) const {
        const int row0 = u.pm * BM + wr * 64 + fr, col0 = u.pn * BM + wc * 32 + 8 * fq;
#pragma unroll
        for (int ai = 0; ai < 2; ++ai)
#pragma unroll
            for (int m = 0; m < 4; ++m) { const size_t row = row0 + ai * HALF + m * 16;
#pragma unroll
                for (int bj = 0; bj < 2; ++bj) { const int col = col0 + bj * HALF;
                    const u32x4 yv = *(const u32x4*)(YB + row * 512 + col);
                    const f32x4 b0 = *(const f32x4*)(bias + col), b1 = *(const f32x4*)(bias + col + 4);
                    const f32x4 z0 = acc[ai][bj][m][0] + b0, z1 = acc[ai][bj][m][1] + b1;
                    u32x4 w;
                    w.x = pk2(bf_lo(yv.x) * sigmoidf_(z0[0]), bf_hi(yv.x) * sigmoidf_(z0[1])); w.y = pk2(bf_lo(yv.y) * sigmoidf_(z0[2]), bf_hi(yv.y) * sigmoidf_(z0[3]));
                    w.z = pk2(bf_lo(yv.z) * sigmoidf_(z1[0]), bf_hi(yv.z) * sigmoidf_(z1[1])); w.w = pk2(bf_lo(yv.w) * sigmoidf_(z1[2]), bf_hi(yv.w) * sigmoidf_(z1[3]));
                    *(u32x4*)(CAT + row * 1024 + 512 + col) = w; }
                asm volatile("" ::: "memory"); __builtin_amdgcn_sched_barrier(0); }
    }
};
}
__device__ __forceinline__ unsigned mono_u32(float f) { const unsigned u = __builtin_bit_cast(unsigned, f); return u ^ ((u >> 31) ? 0xFFFFFFFFu : 0x80000000u); }
#define CE_DESC(x, y) do { const unsigned _hi = (x) > (y) ? (x) : (y), _lo = (x) > (y) ? (y) : (x); (x) = _hi; (y) = _lo; } while (0)
__device__ __forceinline__ void sort16_desc(unsigned (&a)[16]) {
#pragma unroll
    for (int k = 2; k <= 16; k <<= 1)
#pragma unroll
        for (int j = k >> 1; j > 0; j >>= 1)
#pragma unroll
            for (int i = 0; i < 16; ++i) { const int l = i ^ j; if (l > i) { if ((i & k) == 0) CE_DESC(a[i], a[l]); else CE_DESC(a[l], a[i]); } }
}
__device__ __forceinline__ void merge16_desc(unsigned (&a)[16], const unsigned (&b)[16]) {
#pragma unroll
    for (int i = 0; i < 16; ++i) a[i] = a[i] > b[15 - i] ? a[i] : b[15 - i];
#pragma unroll
    for (int j = 8; j > 0; j >>= 1)
#pragma unroll
        for (int i = 0; i < 16; ++i) { const int l = i ^ j; if (l > i) CE_DESC(a[i], a[l]); }
}
__device__ __forceinline__ void merge16_xlane(unsigned (&a)[16]) {
    unsigned b[16];
#pragma unroll
    for (int i = 0; i < 16; ++i) b[i] = (unsigned)__shfl_xor((int)a[i], 32);
    merge16_desc(a, b);
}
struct PeerCand { int a[50], b[50]; };
__host__ __device__ constexpr PeerCand peer_cands() { PeerCand c{}; int n = 0; for (int a = 0; a < 16; ++a) for (int b = 0; b < 16; ++b) if ((a + 1) * (b + 1) <= 16) { c.a[n] = a; c.b[n] = b; ++n; } return c; }
__device__ __forceinline__ void p_peer_route(const Frame& F, unsigned char* ws, const bf16_t* SK) {
    const bf16_t* Q2 = (const bf16_t*)(ws + PE_Q2); unsigned short* EID = (unsigned short*)(ws + PE_EID); float* GATE = (float*)(ws + PE_GATE);
    LAS float* sc0 = (LAS float*)F.lds;
    const int lane = F.lane, wave = F.wave, h5 = lane >> 5, r = lane & 31, tid = F.tid;
    constexpr PeerCand PC = peer_cands();
    for (int u = F.bid; u < 2048; u += F.G) {
        const int hd = u & 7, mt = u >> 3; const size_t m0 = (size_t)mt * 128;
        {
            const int p = wave >> 2, rt = wave & 3;
            bf16x8 Af[8];
#pragma unroll
            for (int ks = 0; ks < 8; ++ks) Af[ks] = *(const bf16x8*)(Q2 + (m0 + rt * 32 + r) * 2048 + (hd * 2 + p) * 128 + ks * 16 + 8 * h5);
            LAS float* scp = sc0 + p * 128 * 129;
#pragma unroll 1
            for (int ct = 0; ct < 4; ++ct) {
                f32x16 acc = {0.f, 0.f, 0.f, 0.f, 0.f, 0.f, 0.f, 0.f, 0.f, 0.f, 0.f, 0.f, 0.f, 0.f, 0.f, 0.f};
#pragma unroll
                for (int ks = 0; ks < 8; ++ks) { const bf16x8 Bf = *(const bf16x8*)(SK + ((size_t)(hd * 2 + p) * 128 + ct * 32 + r) * 128 + ks * 16 + 8 * h5);
                    acc = __builtin_amdgcn_mfma_f32_32x32x16_bf16(Af[ks], Bf, acc, 0, 0, 0); }
#pragma unroll
                for (int i = 0; i < 16; ++i) scp[(rt * 32 + (i & 3) + 8 * (i >> 2) + 4 * h5) * 129 + ct * 32 + r] = acc[i];
            }
        }
        __syncthreads();
        {
            const int pp = wave >> 2, row = (wave & 3) * 32 + r, half = h5; LAS float* rowp = sc0 + pp * 128 * 129 + row * 129;
            unsigned top[16];
#pragma unroll
            for (int blk = 0; blk < 4; ++blk) {
                unsigned k16[16];
#pragma unroll
                for (int i = 0; i < 16; ++i) { const int j = half * 64 + blk * 16 + i; k16[i] = (mono_u32(rowp[j]) & ~0x7Fu) | (unsigned)(127 - j); }
                sort16_desc(k16);
                if (blk == 0) {
#pragma unroll
                    for (int i = 0; i < 16; ++i) top[i] = k16[i];
                } else merge16_desc(top, k16);
            }
            merge16_xlane(top);
            float vals[16]; int ids[16];
#pragma unroll
            for (int k = 0; k < 16; ++k) { ids[k] = 127 - (int)(top[k] & 127u); vals[k] = rowp[ids[k]]; }
            if (half == 0) {
#pragma unroll
                for (int k = 0; k < 16; ++k) { rowp[k] = vals[k]; rowp[16 + k] = __int_as_float(ids[k]); }
            }
        }
        __syncthreads();
        if (tid < 256) {
            const int row = (wave & 3) * 32 + r, half = h5; const LAS float* s1 = sc0 + row * 129; const LAS float* s2 = sc0 + 128 * 129 + row * 129;
            float v1[16], v2[16];
#pragma unroll
            for (int k = 0; k < 16; ++k) { v1[k] = s1[k]; v2[k] = s2[k]; }
            unsigned top[16], k16[16];
#pragma unroll
            for (int i = 0; i < 16; ++i) { const int c0 = 2 * i, c1 = 2 * i + 1;
                const unsigned ka = (mono_u32(v1[PC.a[c0]] + v2[PC.b[c0]]) & ~0xFFu) | (unsigned)(255 - (PC.a[c0] * 16 + PC.b[c0]));
                const unsigned kb = (mono_u32(v1[PC.a[c1]] + v2[PC.b[c1]]) & ~0xFFu) | (unsigned)(255 - (PC.a[c1] * 16 + PC.b[c1]));
                top[i] = half ? kb : ka; }
#pragma unroll
            for (int i = 0; i < 16; ++i) { if (i < 9) { const int c0 = 32 + 2 * i, c1 = 32 + 2 * i + 1;
                    const unsigned ka = (mono_u32(v1[PC.a[c0]] + v2[PC.b[c0]]) & ~0xFFu) | (unsigned)(255 - (PC.a[c0] * 16 + PC.b[c0]));
                    const unsigned kb = (mono_u32(v1[PC.a[c1]] + v2[PC.b[c1]]) & ~0xFFu) | (unsigned)(255 - (PC.a[c1] * 16 + PC.b[c1]));
                    k16[i] = half ? kb : ka; } else k16[i] = 0u; }
            sort16_desc(top); sort16_desc(k16); merge16_desc(top, k16);
            merge16_xlane(top);
            if (half == 0) {
                float mx = -3.0e38f; float sv[16]; int eid[16];
#pragma unroll
                for (int k = 0; k < 16; ++k) { const int fl = 255 - (int)(top[k] & 255u), a = fl >> 4, b = fl & 15;
                    sv[k] = s1[a] + s2[b]; eid[k] = __float_as_int(s1[16 + a]) * 128 + __float_as_int(s2[16 + b]); mx = fmaxf(mx, sv[k]); }
                float den = 0.f;
#pragma unroll
                for (int k = 0; k < 16; ++k) { sv[k] = __expf(sv[k] - mx); den += sv[k]; }
                const float inv = 1.0f / den;
                unsigned short* ep = EID + (m0 + row) * 128 + hd * 16; float* gp = GATE + (m0 + row) * 128 + hd * 16;
#pragma unroll
                for (int k = 0; k < 16; ++k) { ep[k] = (unsigned short)eid[k]; gp[k] = sv[k] * inv; }
            }
        }
        __syncthreads();
    }
}

__device__ __forceinline__ float rdlane_f(float v, int l) { return __builtin_bit_cast(float, __builtin_amdgcn_readlane(__builtin_bit_cast(int, v), l)); }
__device__ __forceinline__ void p_peer_expert(const Frame& F, unsigned char* ws, float* xres) {
    const bf16_t* XN = (const bf16_t*)(ws + WS_XN); const bf16_t* TU = (const bf16_t*)(ws + WS_TABU); const bf16_t* TV = (const bf16_t*)(ws + WS_TABV);
    const unsigned short* EID = (const unsigned short*)(ws + PE_EID); const float* GATE = (const float*)(ws + PE_GATE);
    const int gw = F.bid * NWAVES + F.wave, NGW = F.G * NWAVES, lane = F.lane;
    for (int m = gw; m < T; m += NGW) {
        float xf[16];
        { const u32x4 xa = *(const u32x4*)(XN + (size_t)m * 1024 + lane * 8), xb = *(const u32x4*)(XN + (size_t)m * 1024 + 512 + lane * 8);
          xf[0] = bf_lo(xa.x); xf[1] = bf_hi(xa.x); xf[2] = bf_lo(xa.y); xf[3] = bf_hi(xa.y); xf[4] = bf_lo(xa.z); xf[5] = bf_hi(xa.z); xf[6] = bf_lo(xa.w); xf[7] = bf_hi(xa.w);
          xf[8] = bf_lo(xb.x); xf[9] = bf_hi(xb.x); xf[10] = bf_lo(xb.y); xf[11] = bf_hi(xb.y); xf[12] = bf_lo(xb.z); xf[13] = bf_hi(xb.z); xf[14] = bf_lo(xb.w); xf[15] = bf_hi(xb.w); }
        const int id0 = EID[(size_t)m * 128 + lane], id1 = EID[(size_t)m * 128 + 64 + lane];
        const float g0 = GATE[(size_t)m * 128 + lane], g1 = GATE[(size_t)m * 128 + 64 + lane];
        float outv[16];
#pragma unroll
        for (int i = 0; i < 16; ++i) outv[i] = 0.f;
#pragma unroll 1
        for (int k = 0; k < 16; ++k) {
            const int idreg = (k < 8) ? id0 : id1; const float greg = (k < 8) ? g0 : g1; const int lbase = (k & 7) * 8;
            int e[8];
#pragma unroll
            for (int i = 0; i < 8; ++i) e[i] = __builtin_amdgcn_readlane(idreg, lbase + i);
            float pr[8];
            {
                u32x4 ua[8], ub[8];
#pragma unroll
                for (int i = 0; i < 8; ++i) { ua[i] = *(const u32x4*)(TU + (size_t)e[i] * 1024 + lane * 8); ub[i] = *(const u32x4*)(TU + (size_t)e[i] * 1024 + 512 + lane * 8); }
#pragma unroll
                for (int i = 0; i < 8; ++i) {
                    float s = xf[0] * bf_lo(ua[i].x); s += xf[1] * bf_hi(ua[i].x); s += xf[2] * bf_lo(ua[i].y); s += xf[3] * bf_hi(ua[i].y);
                    s += xf[4] * bf_lo(ua[i].z); s += xf[5] * bf_hi(ua[i].z); s += xf[6] * bf_lo(ua[i].w); s += xf[7] * bf_hi(ua[i].w);
                    s += xf[8] * bf_lo(ub[i].x); s += xf[9] * bf_hi(ub[i].x); s += xf[10] * bf_lo(ub[i].y); s += xf[11] * bf_hi(ub[i].y);
                    s += xf[12] * bf_lo(ub[i].z); s += xf[13] * bf_hi(ub[i].z); s += xf[14] * bf_lo(ub[i].w); s += xf[15] * bf_hi(ub[i].w);
                    pr[i] = s;
                }
            }
            float r4[4], r2[2], r1;
            { const bool up = (lane & 32) != 0;
#pragma unroll
              for (int i = 0; i < 4; ++i) { const float keep = up ? pr[i + 4] : pr[i], send = up ? pr[i] : pr[i + 4]; r4[i] = keep + __shfl_xor(send, 32); } }
            { const bool up = (lane & 16) != 0;
#pragma unroll
              for (int i = 0; i < 2; ++i) { const float keep = up ? r4[i + 2] : r4[i], send = up ? r4[i] : r4[i + 2]; r2[i] = keep + __shfl_xor(send, 16); } }
            { const bool up = (lane & 8) != 0; const float keep = up ? r2[1] : r2[0], send = up ? r2[0] : r2[1]; r1 = keep + __shfl_xor(send, 8); }
            r1 += __shfl_xor(r1, 4); r1 += __shfl_xor(r1, 2); r1 += __shfl_xor(r1, 1);
            const float gv = __shfl(greg, lbase + (lane >> 3));
            const float coef = gv * gelu_tanh(r1);
            {
                u32x4 va[8], vb[8];
#pragma unroll
                for (int i = 0; i < 8; ++i) { va[i] = *(const u32x4*)(TV + (size_t)e[i] * 1024 + lane * 8); vb[i] = *(const u32x4*)(TV + (size_t)e[i] * 1024 + 512 + lane * 8); }
#pragma unroll
                for (int i = 0; i < 8; ++i) {
                    const float ci = rdlane_f(coef, i * 8);
                    outv[0] += ci * bf_lo(va[i].x); outv[1] += ci * bf_hi(va[i].x); outv[2] += ci * bf_lo(va[i].y); outv[3] += ci * bf_hi(va[i].y);
                    outv[4] += ci * bf_lo(va[i].z); outv[5] += ci * bf_hi(va[i].z); outv[6] += ci * bf_lo(va[i].w); outv[7] += ci * bf_hi(va[i].w);
                    outv[8] += ci * bf_lo(vb[i].x); outv[9] += ci * bf_hi(vb[i].x); outv[10] += ci * bf_lo(vb[i].y); outv[11] += ci * bf_hi(vb[i].y);
                    outv[12] += ci * bf_lo(vb[i].z); outv[13] += ci * bf_hi(vb[i].z); outv[14] += ci * bf_lo(vb[i].w); outv[15] += ci * bf_hi(vb[i].w);
                }
            }
        }
        f32x4* o = (f32x4*)(xres + (size_t)m * 1024 + lane * 8);
        f32x4 a0 = o[0], a1 = o[1], b0 = o[128], b1 = o[129];
        a0 += (f32x4){outv[0], outv[1], outv[2], outv[3]}; a1 += (f32x4){outv[4], outv[5], outv[6], outv[7]};
        b0 += (f32x4){outv[8], outv[9], outv[10], outv[11]}; b1 += (f32x4){outv[12], outv[13], outv[14], outv[15]};
        o[0] = a0; o[1] = a1; o[128] = b0; o[129] = b1;
    }
}

typedef __bf16 bf16x2_t __attribute__((ext_vector_type(2)));
__device__ __forceinline__ float dot2bf(unsigned a, unsigned b, float c) { return __builtin_amdgcn_fdot2_f32_bf16(__builtin_bit_cast(bf16x2_t, a), __builtin_bit_cast(bf16x2_t, b), c, false); }
__device__ __forceinline__ void peer_slot_range(const unsigned (&xp)[8], float (&outv)[16], int id0, int id1, float g0, float g1, int r,
                                                const bf16_t* TU, const bf16_t* TV, int lane) {
    u64 m0 = __ballot((id0 >> 9) == r), m1 = __ballot((id1 >> 9) == r);
    while (m0 | m1) {
        int e[8]; float gt[8];
#pragma unroll
        for (int i = 0; i < 8; ++i) {
            if (m0) { const int l = __builtin_ctzll(m0); m0 &= m0 - 1ull; e[i] = __builtin_amdgcn_readlane(id0, l); gt[i] = rdlane_f(g0, l); }
            else if (m1) { const int l = __builtin_ctzll(m1); m1 &= m1 - 1ull; e[i] = __builtin_amdgcn_readlane(id1, l); gt[i] = rdlane_f(g1, l); }
            else { e[i] = -1; gt[i] = 0.f; }
        }
        float pr[8];
        {
            u32x4 ua[8], ub[8];
#pragma unroll
            for (int i = 0; i < 8; ++i) {
                if (e[i] >= 0) { ua[i] = *(const u32x4*)(TU + (size_t)e[i] * 1024 + lane * 8); ub[i] = *(const u32x4*)(TU + (size_t)e[i] * 1024 + 512 + lane * 8); }
                else { ua[i] = (u32x4){0u, 0u, 0u, 0u}; ub[i] = (u32x4){0u, 0u, 0u, 0u}; }
            }
#pragma unroll
            for (int i = 0; i < 8; ++i) {
                float s = dot2bf(xp[0], ua[i].x, 0.f); s = dot2bf(xp[1], ua[i].y, s); s = dot2bf(xp[2], ua[i].z, s); s = dot2bf(xp[3], ua[i].w, s);
                s = dot2bf(xp[4], ub[i].x, s); s = dot2bf(xp[5], ub[i].y, s); s = dot2bf(xp[6], ub[i].z, s); s = dot2bf(xp[7], ub[i].w, s);
                pr[i] = s;
            }
        }
        float r4[4], r2[2], r1;
        { const bool up = (lane & 32) != 0;
#pragma unroll
          for (int i = 0; i < 4; ++i) { const float keep = up ? pr[i + 4] : pr[i], send = up ? pr[i] : pr[i + 4]; r4[i] = keep + __shfl_xor(send, 32); } }
        { const bool up = (lane & 16) != 0;
#pragma unroll
          for (int i = 0; i < 2; ++i) { const float keep = up ? r4[i + 2] : r4[i], send = up ? r4[i] : r4[i + 2]; r2[i] = keep + __shfl_xor(send, 16); } }
        { const bool up = (lane & 8) != 0; const float keep = up ? r2[1] : r2[0], send = up ? r2[0] : r2[1]; r1 = keep + __shfl_xor(send, 8); }
        r1 += __shfl_xor(r1, 4); r1 += __shfl_xor(r1, 2); r1 += __shfl_xor(r1, 1);
        const int grp = lane >> 3;
        float gsel = gt[0];
#pragma unroll
        for (int i = 1; i < 8; ++i) gsel = (grp == i) ? gt[i] : gsel;
        const float coef = gsel * gelu_tanh(r1);
        {
            u32x4 va[8], vb[8];
#pragma unroll
            for (int i = 0; i < 8; ++i) {
                if (e[i] >= 0) { va[i] = *(const u32x4*)(TV + (size_t)e[i] * 1024 + lane * 8); vb[i] = *(const u32x4*)(TV + (size_t)e[i] * 1024 + 512 + lane * 8); }
                else { va[i] = (u32x4){0u, 0u, 0u, 0u}; vb[i] = (u32x4){0u, 0u, 0u, 0u}; }
            }
#pragma unroll
            for (int i = 0; i < 8; ++i) {
                if (e[i] >= 0) {
                    const float ci = rdlane_f(coef, i * 8);
                    outv[0] += ci * bf_lo(va[i].x); outv[1] += ci * bf_hi(va[i].x); outv[2] += ci * bf_lo(va[i].y); outv[3] += ci * bf_hi(va[i].y);
                    outv[4] += ci * bf_lo(va[i].z); outv[5] += ci * bf_hi(va[i].z); outv[6] += ci * bf_lo(va[i].w); outv[7] += ci * bf_hi(va[i].w);
                    outv[8] += ci * bf_lo(vb[i].x); outv[9] += ci * bf_hi(vb[i].x); outv[10] += ci * bf_lo(vb[i].y); outv[11] += ci * bf_hi(vb[i].y);
                    outv[12] += ci * bf_lo(vb[i].z); outv[13] += ci * bf_hi(vb[i].z); outv[14] += ci * bf_lo(vb[i].w); outv[15] += ci * bf_hi(vb[i].w);
                }
            }
        }
    }
}
__device__ __forceinline__ void p_peer_expert2(const Frame& F, unsigned char* ws, float* xres, const float oscale) {
    const bf16_t* XN = (const bf16_t*)(ws + WS_XN); const bf16_t* TU = (const bf16_t*)(ws + WS_TABU); const bf16_t* TV = (const bf16_t*)(ws + WS_TABV);
    const unsigned short* EID = (const unsigned short*)(ws + PE_EID); const float* GATE = (const float*)(ws + PE_GATE);
    const int gw = F.bid * NWAVES + F.wave, NGW = F.G * NWAVES, lane = F.lane;
    int rnd = 0;
    for (int m4 = gw * 4; m4 < T; m4 += NGW * 4, ++rnd) {
        unsigned xp[4][8]; float outv[4][16]; int id[4][2]; float gg[4][2];
#pragma unroll
        for (int s = 0; s < 4; ++s) {
            const size_t m = (size_t)(m4 + s);
            const u32x4 xa = *(const u32x4*)(XN + m * 1024 + lane * 8), xb = *(const u32x4*)(XN + m * 1024 + 512 + lane * 8);
            xp[s][0] = xa.x; xp[s][1] = xa.y; xp[s][2] = xa.z; xp[s][3] = xa.w; xp[s][4] = xb.x; xp[s][5] = xb.y; xp[s][6] = xb.z; xp[s][7] = xb.w;
            id[s][0] = EID[m * 128 + lane]; id[s][1] = EID[m * 128 + 64 + lane]; gg[s][0] = GATE[m * 128 + lane]; gg[s][1] = GATE[m * 128 + 64 + lane];
#pragma unroll
            for (int i = 0; i < 16; ++i) outv[s][i] = 0.f;
        }
#pragma unroll 1
        for (int k = 0; k < 32; ++k) {
            const int r = (rnd & 1) ? 31 - k : k;
#pragma unroll
            for (int s = 0; s < 4; ++s) peer_slot_range(xp[s], outv[s], id[s][0], id[s][1], gg[s][0], gg[s][1], r, TU, TV, lane);
        }
#pragma unroll
        for (int s = 0; s < 4; ++s) {
            f32x4* o = (f32x4*)(xres + (size_t)(m4 + s) * 1024 + lane * 8);
            f32x4 a0 = o[0], a1 = o[1], b0 = o[128], b1 = o[129];
            a0 += (f32x4){outv[s][0], outv[s][1], outv[s][2], outv[s][3]} * oscale; a1 += (f32x4){outv[s][4], outv[s][5], outv[s][6], outv[s][7]} * oscale;
            b0 += (f32x4){outv[s][8], outv[s][9], outv[s][10], outv[s][11]} * oscale; b1 += (f32x4){outv[s][12], outv[s][13], outv[s][14], outv[s][15]} * oscale;
            o[0] = a0; o[1] = a1; o[128] = b0; o[129] = b1;
        }
    }
}

struct RowBuf { u32x4 a[8], b[8]; };
__device__ __forceinline__ void peer_load8(RowBuf& rb, const bf16_t* TAB, const LAS unsigned* ent, int b, int lane) {
#pragma unroll
    for (int i = 0; i < 8; ++i) {
        const unsigned e = (unsigned)__builtin_amdgcn_readfirstlane((int)ent[b * 8 + i]) & 0x3FFFu;
        const bf16_t* rp = TAB + (size_t)e * 1024 + lane * 8;
        rb.a[i] = *(const u32x4*)rp; rb.b[i] = *(const u32x4*)(rp + 512);
    }
}
__device__ __forceinline__ float peer_dot(const unsigned (&xp)[8], const u32x4 a, const u32x4 b) {
    float s = dot2bf(xp[0], a.x, 0.f); s = dot2bf(xp[1], a.y, s); s = dot2bf(xp[2], a.z, s); s = dot2bf(xp[3], a.w, s);
    s = dot2bf(xp[4], b.x, s); s = dot2bf(xp[5], b.y, s); s = dot2bf(xp[6], b.z, s); s = dot2bf(xp[7], b.w, s);
    return s;
}
__device__ __forceinline__ void peer_u8(const RowBuf& rb, const unsigned (&xp)[4][8], const LAS unsigned* ent, LAS float* cf, int b, int lane) {
    float pr[8];
#pragma unroll
    for (int i = 0; i < 8; ++i) {
        const int slot = (__builtin_amdgcn_readfirstlane((int)ent[b * 8 + i]) >> 21) & 3;
        if (slot == 0) pr[i] = peer_dot(xp[0], rb.a[i], rb.b[i]);
        else if (slot == 1) pr[i] = peer_dot(xp[1], rb.a[i], rb.b[i]);
        else if (slot == 2) pr[i] = peer_dot(xp[2], rb.a[i], rb.b[i]);
        else pr[i] = peer_dot(xp[3], rb.a[i], rb.b[i]);
    }
    float r4[4], r2[2], r1;
    { const bool up = (lane & 32) != 0;
#pragma unroll
      for (int i = 0; i < 4; ++i) { const float keep = up ? pr[i + 4] : pr[i], send = up ? pr[i] : pr[i + 4]; r4[i] = keep + __shfl_xor(send, 32); } }
    { const bool up = (lane & 16) != 0;
#pragma unroll
      for (int i = 0; i < 2; ++i) { const float keep = up ? r4[i + 2] : r4[i], send = up ? r4[i] : r4[i + 2]; r2[i] = keep + __shfl_xor(send, 16); } }
    { const bool up = (lane & 8) != 0; const float keep = up ? r2[1] : r2[0], send = up ? r2[0] : r2[1]; r1 = keep + __shfl_xor(send, 8); }
    r1 += __shfl_xor(r1, 4); r1 += __shfl_xor(r1, 2); r1 += __shfl_xor(r1, 1);
    const float gate = cf[b * 8 + (lane >> 3)];
    const float coef = gate * gelu_tanh(r1);
    if ((lane & 7) == 0) cf[b * 8 + (lane >> 3)] = coef;
}
__device__ __forceinline__ void peer_acc(float (&o)[16], const float c, const u32x4 a, const u32x4 b) {
    o[0] += c * bf_lo(a.x); o[1] += c * bf_hi(a.x); o[2] += c * bf_lo(a.y); o[3] += c * bf_hi(a.y);
    o[4] += c * bf_lo(a.z); o[5] += c * bf_hi(a.z); o[6] += c * bf_lo(a.w); o[7] += c * bf_hi(a.w);
    o[8] += c * bf_lo(b.x); o[9] += c * bf_hi(b.x); o[10] += c * bf_lo(b.y); o[11] += c * bf_hi(b.y);
    o[12] += c * bf_lo(b.z); o[13] += c * bf_hi(b.z); o[14] += c * bf_lo(b.w); o[15] += c * bf_hi(b.w);
}
__device__ __forceinline__ void peer_v8(const RowBuf& rb, float (&outv)[4][16], const LAS unsigned* ent, const LAS float* cf, int b) {
#pragma unroll
    for (int i = 0; i < 8; ++i) {
        const int slot = (__builtin_amdgcn_readfirstlane((int)ent[b * 8 + i]) >> 21) & 3;
        const float c = cf[b * 8 + i];
        if (slot == 0) peer_acc(outv[0], c, rb.a[i], rb.b[i]);
        else if (slot == 1) peer_acc(outv[1], c, rb.a[i], rb.b[i]);
        else if (slot == 2) peer_acc(outv[2], c, rb.a[i], rb.b[i]);
        else peer_acc(outv[3], c, rb.a[i], rb.b[i]);
    }
}
__device__ __forceinline__ void p_peer_expert3(const Frame& F, unsigned char* ws, float* xres, const float oscale, const XcdBarrier& xbar) {
    const bf16_t* XN = (const bf16_t*)(ws + WS_XN); const bf16_t* TU = (const bf16_t*)(ws + WS_TABU); const bf16_t* TV = (const bf16_t*)(ws + WS_TABV);
    const unsigned short* EID = (const unsigned short*)(ws + PE_EID); const float* GATE = (const float*)(ws + PE_GATE);
    const int gw = F.bid * NWAVES + F.wave, NGW = F.G * NWAVES, lane = F.lane;
    LAS unsigned* ent = (LAS unsigned*)(F.lds + F.wave * 4096);
    LAS float* cf = (LAS float*)(F.lds + F.wave * 4096 + 2048);
    const int nrounds = (T + NGW * 4 - 1) / (NGW * 4);
    for (int rnd = 0; rnd < nrounds; ++rnd) {
        const int m4 = (rnd * NGW + gw) * 4;
        if (m4 < T) {
            unsigned xp[4][8];
            {
                int id[4][2]; float gg[4][2];
#pragma unroll
                for (int s = 0; s < 4; ++s) {
                    const size_t m = (size_t)(m4 + s);
                    const u32x4 xa = *(const u32x4*)(XN + m * 1024 + lane * 8), xb = *(const u32x4*)(XN + m * 1024 + 512 + lane * 8);
                    xp[s][0] = xa.x; xp[s][1] = xa.y; xp[s][2] = xa.z; xp[s][3] = xa.w; xp[s][4] = xb.x; xp[s][5] = xb.y; xp[s][6] = xb.z; xp[s][7] = xb.w;
                    id[s][0] = EID[m * 128 + lane]; id[s][1] = EID[m * 128 + 64 + lane]; gg[s][0] = GATE[m * 128 + lane]; gg[s][1] = GATE[m * 128 + 64 + lane];
                }
                int base = 0;
#pragma unroll 1
                for (int k = 0; k < 32; ++k) {
                    const int r = (rnd & 1) ? 31 - k : k;
#pragma unroll
                    for (int s = 0; s < 4; ++s)
#pragma unroll
                        for (int w = 0; w < 2; ++w) {
                            const bool hit = (id[s][w] >> 9) == r;
                            const u64 m = __ballot(hit);
                            if (hit) { const int pos = base + (int)__builtin_amdgcn_mbcnt_hi((unsigned)(m >> 32), __builtin_amdgcn_mbcnt_lo((unsigned)m, 0u));
                                ent[pos] = ((unsigned)s << 21) | ((unsigned)(w * 64 + lane) << 14) | (unsigned)id[s][w]; cf[pos] = gg[s][w]; }
                            base += __builtin_popcountll(m);
                        }
                }
            }
            LDS_WAIT();
            {
                RowBuf A, B;
                peer_load8(A, TU, ent, 0, lane);
#pragma unroll 1
                for (int b = 0; b < 64; b += 2) {
                    peer_load8(B, TU, ent, b + 1, lane);
                    peer_u8(A, xp, ent, cf, b, lane);
                    if (b + 2 < 64) peer_load8(A, TU, ent, b + 2, lane);
                    peer_u8(B, xp, ent, cf, b + 1, lane);
                }
            }
            LDS_WAIT();
            float outv[4][16];
#pragma unroll
            for (int s = 0; s < 4; ++s)
#pragma unroll
                for (int i = 0; i < 16; ++i) outv[s][i] = 0.f;
            {
                RowBuf A, B;
                peer_load8(A, TV, ent, 0, lane);
#pragma unroll 1
                for (int b = 0; b < 64; b += 2) {
                    peer_load8(B, TV, ent, b + 1, lane);
                    peer_v8(A, outv, ent, cf, b);
                    if (b + 2 < 64) peer_load8(A, TV, ent, b + 2, lane);
                    peer_v8(B, outv, ent, cf, b + 1);
                }
            }
#pragma unroll
            for (int s = 0; s < 4; ++s) {
                f32x4* o = (f32x4*)(xres + (size_t)(m4 + s) * 1024 + lane * 8);
                f32x4 a0 = o[0], a1 = o[1], b0 = o[128], b1 = o[129];
                a0 += (f32x4){outv[s][0], outv[s][1], outv[s][2], outv[s][3]} * oscale; a1 += (f32x4){outv[s][4], outv[s][5], outv[s][6], outv[s][7]} * oscale;
                b0 += (f32x4){outv[s][8], outv[s][9], outv[s][10], outv[s][11]} * oscale; b1 += (f32x4){outv[s][12], outv[s][13], outv[s][14], outv[s][15]} * oscale;
                o[0] = a0; o[1] = a1; o[128] = b0; o[129] = b1;
            }
        }
        if (rnd + 1 < nrounds) xcd_barrier(xbar);
    }
}

constexpr size_t WS_TAB8U = WS_TABU;
constexpr size_t WS_TAB8V = WS_TABU + 16 * MiB;
constexpr size_t WS_TABSU = WS_TABU + 32 * MiB;
constexpr size_t WS_TABSV = WS_TABU + 32 * MiB + 65536;
__device__ __forceinline__ void cvt_table_fp8(const Frame& F, const float* src, unsigned char* dst, float* scales, const int skip) {
    const int nb = F.G > skip ? F.G - skip : F.G, b0 = F.G > skip ? F.bid - skip : F.bid;
    const int gw = b0 * NWAVES + F.wave, NGW = nb * NWAVES, lane = F.lane;
    if (b0 >= 0) for (int r = gw; r < 16384; r += NGW) {
        const f32x4* p = (const f32x4*)(src + (size_t)r * 1024 + lane * 16);
        f32x4 v[4]; float am = 0.f;
#pragma unroll
        for (int j = 0; j < 4; ++j) { v[j] = p[j]; am = fmaxf(am, fmaxf(fmaxf(fabsf(v[j].x), fabsf(v[j].y)), fmaxf(fabsf(v[j].z), fabsf(v[j].w)))); }
#pragma unroll
        for (int o = 1; o < 64; o <<= 1) am = fmaxf(am, __shfl_xor(am, o));
        const float sc = am > 0.f ? am * (1.0f / 448.0f) : 1.0f, inv = 1.0f / sc;
        u32x4 q;
#pragma unroll
        for (int j = 0; j < 4; ++j) { int w = 0; w = __builtin_amdgcn_cvt_pk_fp8_f32(v[j].x * inv, v[j].y * inv, w, false); w = __builtin_amdgcn_cvt_pk_fp8_f32(v[j].z * inv, v[j].w * inv, w, true); q[j] = (unsigned)w; }
        *(u32x4*)(dst + (size_t)r * 1024 + lane * 16) = q;
        if (lane == 0) scales[r] = sc;
    }
}
template <int NR> struct RowBufN { u32x4 a[NR]; };
template <int NR>
__device__ __forceinline__ void peer_loadN(RowBufN<NR>& rb, const unsigned char* TAB, const LAS unsigned* ent, int b, int lane) {
    const int ev = (int)ent[b * NR + (lane & (NR - 1))];
#pragma unroll
    for (int i = 0; i < NR; ++i) {
        const unsigned e = (unsigned)__builtin_amdgcn_readlane(ev, i) & 0x3FFFu;
        rb.a[i] = *(const u32x4*)(TAB + (size_t)e * 1024 + lane * 16);
    }
}
__device__ __forceinline__ float peer_dot8x(const u32x4 xa, const u32x4 xb, const u32x4 q) {
    float s = 0.f;
#pragma unroll
    for (int j = 0; j < 4; ++j) {
        const f32x2 lo = __builtin_amdgcn_cvt_pk_f32_fp8((int)q[j], false), hi = __builtin_amdgcn_cvt_pk_f32_fp8((int)q[j], true);
        const unsigned x0 = (j < 2) ? xa[2 * j] : xb[2 * j - 4], x1 = (j < 2) ? xa[2 * j + 1] : xb[2 * j - 3];
        s += bf_lo(x0) * lo.x; s += bf_hi(x0) * lo.y; s += bf_lo(x1) * hi.x; s += bf_hi(x1) * hi.y;
    }
    return s;
}
template <int NR>
__device__ __forceinline__ void peer_u8x(const RowBufN<NR>& rb, int r0, const LAS unsigned char* xl, const LAS unsigned* ent, LAS float* cf, const LAS float* sul, int e0, int lane) {
    float pr[8];
    const int ev = (int)ent[e0 + (lane & 7)];
#pragma unroll
    for (int i = 0; i < 8; ++i) {
        const int slot = (__builtin_amdgcn_readlane(ev, i) >> 21) & 3;
        const LAS unsigned char* xp = xl + slot * 2048 + lane * 32;
        const u32x4 xa = *(const LAS u32x4*)xp, xb = *(const LAS u32x4*)(xp + 16);
        pr[i] = peer_dot8x(xa, xb, rb.a[r0 + i]);
    }
    float r4[4], r2[2], r1;
    { const bool up = (lane & 32) != 0;
#pragma unroll
      for (int i = 0; i < 4; ++i) { const float keep = up ? pr[i + 4] : pr[i], send = up ? pr[i] : pr[i + 4]; r4[i] = keep + __shfl_xor(send, 32); } }
    { const bool up = (lane & 16) != 0;
#pragma unroll
      for (int i = 0; i < 2; ++i) { const float keep = up ? r4[i + 2] : r4[i], send = up ? r4[i] : r4[i + 2]; r2[i] = keep + __shfl_xor(send, 16); } }
    { const bool up = (lane & 8) != 0; const float keep = up ? r2[1] : r2[0], send = up ? r2[0] : r2[1]; r1 = keep + __shfl_xor(send, 8); }
    r1 += __shfl_xor(r1, 4); r1 += __shfl_xor(r1, 2); r1 += __shfl_xor(r1, 1);
    const float gate = cf[e0 + (lane >> 3)];
    const float coef = gate * gelu_tanh(r1 * sul[e0 + (lane >> 3)]);
    if ((lane & 7) == 0) cf[e0 + (lane >> 3)] = coef;
}
__device__ __forceinline__ void peer_acc8(float (&o)[16], const float c, const u32x4 q) {
#pragma unroll
    for (int j = 0; j < 4; ++j) { const f32x2 lo = __builtin_amdgcn_cvt_pk_f32_fp8((int)q[j], false), hi = __builtin_amdgcn_cvt_pk_f32_fp8((int)q[j], true);
        o[4 * j] += c * lo.x; o[4 * j + 1] += c * lo.y; o[4 * j + 2] += c * hi.x; o[4 * j + 3] += c * hi.y; }
}
template <int NR>
__device__ __forceinline__ void peer_vN(const RowBufN<NR>& rb, float (&outv)[4][16], const LAS unsigned* ent, const LAS float* cf, int b, int lane) {
    const int ev = (int)ent[b * NR + (lane & (NR - 1))]; const float cv = cf[b * NR + (lane & (NR - 1))];
#pragma unroll
    for (int i = 0; i < NR; ++i) {
        const int slot = (__builtin_amdgcn_readlane(ev, i) >> 21) & 3;
        const float c = rdlane_f(cv, i);
        if (slot == 0) peer_acc8(outv[0], c, rb.a[i]);
        else if (slot == 1) peer_acc8(outv[1], c, rb.a[i]);
        else if (slot == 2) peer_acc8(outv[2], c, rb.a[i]);
        else peer_acc8(outv[3], c, rb.a[i]);
    }
}
__device__ __forceinline__ void p_peer_expert4(const Frame& F, unsigned char* ws, float* xres, const float oscale, const XcdBarrier& xbar, const int mode) {
    const bf16_t* XN = (const bf16_t*)(ws + WS_XN); const unsigned char* TU = ws + WS_TAB8U; const unsigned char* TV = ws + WS_TAB8V;
    const float* SU = (const float*)(ws + WS_TABSU); const float* SV = (const float*)(ws + WS_TABSV);
    const unsigned short* EID = (const unsigned short*)(ws + PE_EID); const float* GATE = (const float*)(ws + PE_GATE);
    const int gw = F.bid * NWAVES + F.wave, NGW = F.G * NWAVES, lane = F.lane;
    LAS unsigned* ent = (LAS unsigned*)(F.lds + F.wave * 6144);
    LAS float* cf = (LAS float*)(F.lds + F.wave * 6144 + 2048);
    LAS float* sul = (LAS float*)(F.lds + F.wave * 6144 + 4096);
    LAS unsigned char* xl = F.lds + 49152 + F.wave * 8192;
    constexpr int PU = 16, PV = 8;
    const int nrounds = (T + NGW * 4 - 1) / (NGW * 4);
    for (int rnd = 0; rnd < nrounds; ++rnd) {
        const int m4 = (rnd * NGW + gw) * 4;
        if (m4 < T) {
            {
                int id[4][2]; float gg[4][2], su[4][2];
#pragma unroll
                for (int s = 0; s < 4; ++s) { const size_t m = (size_t)(m4 + s);
                    id[s][0] = EID[m * 128 + lane]; id[s][1] = EID[m * 128 + 64 + lane]; gg[s][0] = GATE[m * 128 + lane] * SV[id[s][0]]; gg[s][1] = GATE[m * 128 + 64 + lane] * SV[id[s][1]]; su[s][0] = SU[id[s][0]]; su[s][1] = SU[id[s][1]]; }
                int base = 0;
#pragma unroll 1
                for (int k = 0; k < 16; ++k) {
                    const int r = (rnd & 1) ? 15 - k : k;
#pragma unroll
                    for (int s = 0; s < 4; ++s)
#pragma unroll
                        for (int w = 0; w < 2; ++w) {
                            const bool hit = (id[s][w] >> 10) == r;
                            const u64 m = __ballot(hit);
                            if (hit) { const int pos = base + (int)__builtin_amdgcn_mbcnt_hi((unsigned)(m >> 32), __builtin_amdgcn_mbcnt_lo((unsigned)m, 0u));
                                ent[pos] = ((unsigned)s << 21) | ((unsigned)(w * 64 + lane) << 14) | (unsigned)(mode == 4 ? (id[s][w] & 7) : id[s][w]); cf[pos] = gg[s][w]; sul[pos] = su[s][w]; }
                            base += __builtin_popcountll(m);
                        }
                }
            }
            LDS_WAIT();
            if (mode != 1 && mode != 3) {
#pragma unroll
                for (int s = 0; s < 4; ++s) { const size_t m = (size_t)(m4 + s);
                    const u32x4 xa = *(const u32x4*)(XN + m * 1024 + lane * 16), xb = *(const u32x4*)(XN + m * 1024 + lane * 16 + 8);
                    *(LAS u32x4*)(xl + s * 2048 + lane * 32) = xa; *(LAS u32x4*)(xl + s * 2048 + lane * 32 + 16) = xb; }
                LDS_WAIT();
                RowBufN<PU> A, B;
                peer_loadN<PU>(A, TU, ent, 0, lane);
#pragma unroll 1
                for (int b = 0; b < 512 / PU; b += 2) {
                    peer_loadN<PU>(B, TU, ent, b + 1, lane);
#pragma unroll
                    for (int h = 0; h < PU / 8; ++h) peer_u8x<PU>(A, h * 8, xl, ent, cf, sul, b * PU + h * 8, lane);
                    if (b + 2 < 512 / PU) peer_loadN<PU>(A, TU, ent, b + 2, lane);
#pragma unroll
                    for (int h = 0; h < PU / 8; ++h) peer_u8x<PU>(B, h * 8, xl, ent, cf, sul, (b + 1) * PU + h * 8, lane);
                }
            }
            LDS_WAIT();
            float outv[4][16];
#pragma unroll
            for (int s = 0; s < 4; ++s)
#pragma unroll
                for (int i = 0; i < 16; ++i) outv[s][i] = 0.f;
            if (mode != 1 && mode != 2) {
                RowBufN<PV> A, B;
                peer_loadN<PV>(A, TV, ent, 0, lane);
#pragma unroll 1
                for (int b = 0; b < 512 / PV; b += 2) {
                    peer_loadN<PV>(B, TV, ent, b + 1, lane);
                    peer_vN<PV>(A, outv, ent, cf, b, lane);
                    if (b + 2 < 512 / PV) peer_loadN<PV>(A, TV, ent, b + 2, lane);
                    peer_vN<PV>(B, outv, ent, cf, b + 1, lane);
                }
            }
#pragma unroll
            for (int s = 0; s < 4; ++s) {
                f32x4* o = (f32x4*)(xres + (size_t)(m4 + s) * 1024 + lane * 16);
#pragma unroll
                for (int j = 0; j < 4; ++j) { f32x4 a0 = o[j]; a0 += (f32x4){outv[s][4 * j], outv[s][4 * j + 1], outv[s][4 * j + 2], outv[s][4 * j + 3]} * oscale; o[j] = a0; }
            }
        }
        if (rnd + 1 < nrounds) xcd_barrier(xbar);
    }
}

__device__ __forceinline__ void cvt_table_i8(const Frame& F, const float* src, unsigned char* dst, float* scales, const int skip) {
    const int nb = F.G > skip ? F.G - skip : F.G, b0 = F.G > skip ? F.bid - skip : F.bid;
    const int gw = b0 * NWAVES + F.wave, NGW = nb * NWAVES, lane = F.lane;
    if (b0 >= 0) for (int r = gw; r < 16384; r += NGW) {
        const f32x4* p = (const f32x4*)(src + (size_t)r * 1024 + lane * 16);
        f32x4 v[4]; float am = 0.f;
#pragma unroll
        for (int j = 0; j < 4; ++j) { v[j] = p[j]; am = fmaxf(am, fmaxf(fmaxf(fabsf(v[j].x), fabsf(v[j].y)), fmaxf(fabsf(v[j].z), fabsf(v[j].w)))); }
#pragma unroll
        for (int o = 1; o < 64; o <<= 1) am = fmaxf(am, __shfl_xor(am, o));
        const float sc = am > 0.f ? am * (1.0f / 127.0f) : 1.0f, inv = 1.0f / sc;
        u32x4 q;
#pragma unroll
        for (int j = 0; j < 4; ++j) { const int a = (int)rintf(v[j].x * inv), b = (int)rintf(v[j].y * inv), c = (int)rintf(v[j].z * inv), d = (int)rintf(v[j].w * inv);
            q[j] = (unsigned)(a & 255) | ((unsigned)(b & 255) << 8) | ((unsigned)(c & 255) << 16) | ((unsigned)(d & 255) << 24); }
        *(u32x4*)(dst + (size_t)r * 1024 + lane * 16) = q;
        if (lane == 0) scales[r] = sc;
    }
}
template <int NR>
__device__ __forceinline__ void peer_u8i(const RowBufN<NR>& rb, int r0, const LAS unsigned char* xq, const LAS unsigned* ent, LAS float* cf, const LAS float* sul, int e0, int lane) {
    int pr[8];
    const int ev = (int)ent[e0 + (lane & 7)];
#pragma unroll
    for (int i = 0; i < 8; ++i) {
        const int slot = (__builtin_amdgcn_readlane(ev, i) >> 21) & 3;
        const u32x4 xv = *(const LAS u32x4*)(xq + slot * 1024 + lane * 16);
        const u32x4 q = rb.a[r0 + i];
        int s = __builtin_amdgcn_sdot4((int)xv.x, (int)q.x, 0, false); s = __builtin_amdgcn_sdot4((int)xv.y, (int)q.y, s, false);
        s = __builtin_amdgcn_sdot4((int)xv.z, (int)q.z, s, false); s = __builtin_amdgcn_sdot4((int)xv.w, (int)q.w, s, false);
        pr[i] = s;
    }
    int r4[4], r2[2], r1;
    { const bool up = (lane & 32) != 0;
#pragma unroll
      for (int i = 0; i < 4; ++i) { const int keep = up ? pr[i + 4] : pr[i], send = up ? pr[i] : pr[i + 4]; r4[i] = keep + __shfl_xor(send, 32); } }
    { const bool up = (lane & 16) != 0;
#pragma unroll
      for (int i = 0; i < 2; ++i) { const int keep = up ? r4[i + 2] : r4[i], send = up ? r4[i] : r4[i + 2]; r2[i] = keep + __shfl_xor(send, 16); } }
    { const bool up = (lane & 8) != 0; const int keep = up ? r2[1] : r2[0], send = up ? r2[0] : r2[1]; r1 = keep + __shfl_xor(send, 8); }
    r1 += __shfl_xor(r1, 4); r1 += __shfl_xor(r1, 2); r1 += __shfl_xor(r1, 1);
    const float gate = cf[e0 + (lane >> 3)];
    const float coef = gate * gelu_tanh((float)r1 * sul[e0 + (lane >> 3)]);
    if ((lane & 7) == 0) cf[e0 + (lane >> 3)] = coef;
}
template <bool FAKE>
__device__ __forceinline__ f32x2 cvt8(unsigned w, bool hi) {
    if (FAKE) { const unsigned t = hi ? (w >> 16) : w; return (f32x2){__builtin_bit_cast(float, (t << 23) | 0x30000000u), __builtin_bit_cast(float, ((t >> 8) << 23) | 0x30000000u)}; }
    return hi ? __builtin_amdgcn_cvt_pk_f32_fp8((int)w, true) : __builtin_amdgcn_cvt_pk_f32_fp8((int)w, false);
}
template <bool FAKE = false>
__device__ __forceinline__ void peer_acc8p(f32x2 (&o)[8], const float c, const u32x4 q) {
    const f32x2 c2 = {c, c};
#pragma unroll
    for (int j = 0; j < 4; ++j) { const f32x2 lo = cvt8<FAKE>(q[j], false), hi = cvt8<FAKE>(q[j], true);
        o[2 * j] += c2 * lo; o[2 * j + 1] += c2 * hi; }
}
template <int NR, bool FAKE>
__device__ __forceinline__ void peer_vNp(const RowBufN<NR>& rb, f32x2 (&outv)[4][8], const LAS unsigned* ent, const LAS float* cf, int b, int lane) {
    const int ev = (int)ent[b * NR + (lane & (NR - 1))]; const float cv = cf[b * NR + (lane & (NR - 1))];
    int slot[NR]; float c[NR];
#pragma unroll
    for (int i = 0; i < NR; ++i) { slot[i] = (__builtin_amdgcn_readlane(ev, i) >> 21) & 3; c[i] = rdlane_f(cv, i); }
#pragma unroll
    for (int q4 = 0; q4 < NR / 4; ++q4) {
#pragma unroll
        for (int s = 0; s < 4; ++s) {
#pragma unroll
            for (int i = 4 * q4; i < 4 * q4 + 4; ++i) if (slot[i] == s) peer_acc8p<FAKE>(outv[s], c[i], rb.a[i]);
            __builtin_amdgcn_sched_barrier(0);
        }
    }
}
template <int PV, bool FAKE>
__device__ __forceinline__ void peer_passv(f32x2 (&outv)[4][8], const unsigned char* TV, const LAS unsigned* ent, const LAS float* cf, int lane) {
    RowBufN<PV> A, B, C;
    constexpr int NBV = 512 / PV;
    peer_loadN<PV>(A, TV, ent, 0, lane); peer_loadN<PV>(B, TV, ent, 1, lane);
#pragma unroll 1
    for (int b = 0; b + 2 < NBV; b += 3) {
        peer_loadN<PV>(C, TV, ent, b + 2, lane);
        peer_vNp<PV, FAKE>(A, outv, ent, cf, b, lane);
        if (b + 3 < NBV) peer_loadN<PV>(A, TV, ent, b + 3, lane);
        peer_vNp<PV, FAKE>(B, outv, ent, cf, b + 1, lane);
        if (b + 4 < NBV) peer_loadN<PV>(B, TV, ent, b + 4, lane);
        peer_vNp<PV, FAKE>(C, outv, ent, cf, b + 2, lane);
    }
    peer_vNp<PV, FAKE>(A, outv, ent, cf, NBV - 1, lane);
}
__device__ __forceinline__ void p_peer_expert5(const Frame& F, unsigned char* ws, float* xres, const float oscale, const XcdBarrier& xbar, const int mode, const bool do_norm) {
    const bf16_t* XN = (const bf16_t*)(ws + WS_XN); const unsigned char* TU = ws + WS_TAB8U; const unsigned char* TV = ws + WS_TAB8V;
    const float* SU = (const float*)(ws + WS_TABSU); const float* SV = (const float*)(ws + WS_TABSV);
    const unsigned short* EID = (const unsigned short*)(ws + PE_EID); const float* GATE = (const float*)(ws + PE_GATE);
    const int gw = F.bid * NWAVES + F.wave, NGW = F.G * NWAVES, lane = F.lane;
    LAS unsigned* ent = (LAS unsigned*)(F.lds + F.wave * 6144);
    LAS float* cf = (LAS float*)(F.lds + F.wave * 6144 + 2048);
    LAS float* sul = (LAS float*)(F.lds + F.wave * 6144 + 4096);
    LAS unsigned char* xq = F.lds + 49152 + F.wave * 4096;
    constexpr int PU = 8, PV = 8;
    const int nrounds = (T + NGW * 4 - 1) / (NGW * 4);
    for (int rnd = 0; rnd < nrounds; ++rnd) {
        const int m4 = (rnd * NGW + gw) * 4;
        if (m4 < T) {
            {
                float sx[4];
#pragma unroll
                for (int s = 0; s < 4; ++s) { const size_t m = (size_t)(m4 + s);
                    const u32x4 xa = *(const u32x4*)(XN + m * 1024 + lane * 16), xb = *(const u32x4*)(XN + m * 1024 + lane * 16 + 8);
                    float xf[16] = {bf_lo(xa.x), bf_hi(xa.x), bf_lo(xa.y), bf_hi(xa.y), bf_lo(xa.z), bf_hi(xa.z), bf_lo(xa.w), bf_hi(xa.w),
                                    bf_lo(xb.x), bf_hi(xb.x), bf_lo(xb.y), bf_hi(xb.y), bf_lo(xb.z), bf_hi(xb.z), bf_lo(xb.w), bf_hi(xb.w)};
                    float am = 0.f;
#pragma unroll
                    for (int i = 0; i < 16; ++i) am = fmaxf(am, fabsf(xf[i]));
#pragma unroll
                    for (int o = 1; o < 64; o <<= 1) am = fmaxf(am, __shfl_xor(am, o));
                    sx[s] = am > 0.f ? am * (1.0f / 127.0f) : 1.0f; const float inv = 1.0f / sx[s];
                    u32x4 q;
#pragma unroll
                    for (int j = 0; j < 4; ++j) { const int a = (int)rintf(xf[4 * j] * inv), b = (int)rintf(xf[4 * j + 1] * inv), c = (int)rintf(xf[4 * j + 2] * inv), d = (int)rintf(xf[4 * j + 3] * inv);
                        q[j] = (unsigned)(a & 255) | ((unsigned)(b & 255) << 8) | ((unsigned)(c & 255) << 16) | ((unsigned)(d & 255) << 24); }
                    *(LAS u32x4*)(xq + s * 1024 + lane * 16) = q; }
                int id[4][2]; float gg[4][2], su[4][2];
#pragma unroll
                for (int s = 0; s < 4; ++s) { const size_t m = (size_t)(m4 + s);
                    id[s][0] = EID[m * 128 + lane]; id[s][1] = EID[m * 128 + 64 + lane];
                    gg[s][0] = GATE[m * 128 + lane] * SV[id[s][0]]; gg[s][1] = GATE[m * 128 + 64 + lane] * SV[id[s][1]];
                    su[s][0] = SU[id[s][0]] * sx[s]; su[s][1] = SU[id[s][1]] * sx[s]; }
                int base = 0;
#pragma unroll 1
                for (int k = 0; k < 16; ++k) {
                    const int r = (rnd & 1) ? 15 - k : k;
#pragma unroll
                    for (int s = 0; s < 4; ++s)
#pragma unroll
                        for (int w = 0; w < 2; ++w) {
                            const bool hit = (id[s][w] >> 10) == r;
                            const u64 m = __ballot(hit);
                            if (hit) { const int pos = base + (int)__builtin_amdgcn_mbcnt_hi((unsigned)(m >> 32), __builtin_amdgcn_mbcnt_lo((unsigned)m, 0u));
                                ent[pos] = ((unsigned)s << 21) | ((unsigned)(w * 64 + lane) << 14) | (unsigned)(mode == 4 ? (id[s][w] & 7) : id[s][w]); cf[pos] = gg[s][w]; sul[pos] = su[s][w]; }
                            base += __builtin_popcountll(m);
                        }
                }
            }
            LDS_WAIT();
            if (mode != 1 && mode != 3) {
                RowBufN<PU> A, B, C;
                constexpr int NBU = 512 / PU;
                peer_loadN<PU>(A, TU, ent, 0, lane); peer_loadN<PU>(B, TU, ent, 1, lane);
#pragma unroll 1
                for (int b = 0; b + 2 < NBU; b += 3) {
                    peer_loadN<PU>(C, TU, ent, b + 2, lane);
                    peer_u8i<PU>(A, 0, xq, ent, cf, sul, b * PU, lane);
                    if (b + 3 < NBU) peer_loadN<PU>(A, TU, ent, b + 3, lane);
                    peer_u8i<PU>(B, 0, xq, ent, cf, sul, (b + 1) * PU, lane);
                    if (b + 4 < NBU) peer_loadN<PU>(B, TU, ent, b + 4, lane);
                    peer_u8i<PU>(C, 0, xq, ent, cf, sul, (b + 2) * PU, lane);
                }
                peer_u8i<PU>(A, 0, xq, ent, cf, sul, (NBU - 1) * PU, lane);
            }
            LDS_WAIT();
            f32x2 outv[4][8];
#pragma unroll
            for (int s = 0; s < 4; ++s)
#pragma unroll
                for (int i = 0; i < 8; ++i) outv[s][i] = (f32x2){0.f, 0.f};
            if (mode != 1 && mode != 2) {
                if (mode == 5) peer_passv<PV, true>(outv, TV, ent, cf, lane); else peer_passv<PV, false>(outv, TV, ent, cf, lane);
            }
            asm volatile("" ::: "memory"); __builtin_amdgcn_sched_barrier(0);
#pragma unroll
            for (int s = 0; s < 4; ++s) {
                f32x4* o = (f32x4*)(xres + (size_t)(m4 + s) * 1024 + lane * 16);
                f32x4 nv[4]; float ss = 0.f;
#pragma unroll
                for (int j = 0; j < 4; ++j) { f32x4 a0 = o[j]; const f32x4 add = (f32x4){outv[s][2 * j].x, outv[s][2 * j].y, outv[s][2 * j + 1].x, outv[s][2 * j + 1].y};
                    if (oscale != 0.f) a0 += add; else asm volatile("" :: "v"(add)); o[j] = a0; nv[j] = a0;
                    ss += (a0.x * a0.x + a0.y * a0.y) + (a0.z * a0.z + a0.w * a0.w); }
                if (do_norm && oscale != 0.f) {
                    const float rstd = 1.0f / sqrtf(wave_sum(ss) * (1.f / DM) + 1e-6f);
                    const f32x4* gp = (const f32x4*)((const float*)(ws + WS_CMPB + 4096) + lane * 16);
                    u32x4 w0, w1;
                    { const f32x4 g0 = gp[0], g1 = gp[1], g2 = gp[2], g3 = gp[3];
                      w0.x = pk2(nv[0].x * rstd * g0.x, nv[0].y * rstd * g0.y); w0.y = pk2(nv[0].z * rstd * g0.z, nv[0].w * rstd * g0.w);
                      w0.z = pk2(nv[1].x * rstd * g1.x, nv[1].y * rstd * g1.y); w0.w = pk2(nv[1].z * rstd * g1.z, nv[1].w * rstd * g1.w);
                      w1.x = pk2(nv[2].x * rstd * g2.x, nv[2].y * rstd * g2.y); w1.y = pk2(nv[2].z * rstd * g2.z, nv[2].w * rstd * g2.w);
                      w1.z = pk2(nv[3].x * rstd * g3.x, nv[3].y * rstd * g3.y); w1.w = pk2(nv[3].z * rstd * g3.z, nv[3].w * rstd * g3.w); }
                    u32x4* xo = (u32x4*)((bf16_t*)(ws + WS_XN) + (size_t)(m4 + s) * 1024 + lane * 16);
                    xo[0] = w0; xo[1] = w1;
                }
                asm volatile("" ::: "memory"); __builtin_amdgcn_sched_barrier(0);
            }
        }
    }
}

constexpr size_t L1_QN = WS_R3;
constexpr size_t L1_KS = WS_R3 + 32 * MiB;
constexpr size_t L1_KW = WS_R3 + 40 * MiB;
constexpr size_t L1_VST = WS_R3 + 48 * MiB;
constexpr size_t L1_VWT = WS_R3 + 56 * MiB;
constexpr size_t L1_KCR = WS_R3 + 64 * MiB;
constexpr size_t L1_VCR = WS_R3 + 72 * MiB;
constexpr size_t L1_GATES = WS_R3 + 81 * MiB;
constexpr size_t L1_H1 = WS_R3 + 84 * MiB;
constexpr size_t L1_CMPO = WS_R3 + 88 * MiB;
constexpr size_t L1_KC = WS_R3 + 90 * MiB;
constexpr size_t L1_VCT = WS_R3 + 91 * MiB;
constexpr size_t L1_SELB = WS_R3 + 92 * MiB;
constexpr size_t L1_OC = WS_TABU;
constexpr size_t L1_CAT = WS_XN;
constexpr size_t L1_UPD = WS_R3;
constexpr size_t L1_DECAY = WS_R3 + 128 * MiB;

__device__ __forceinline__ void p_l1_prep(const Frame& F, const Args& a, unsigned char* ws) {
    const bf16_t* P = (const bf16_t*)(ws + WS_PROJ);
    const f32x2* rope = (const f32x2*)(ws + WS_ROPE);
    bf16_t* QN = (bf16_t*)(ws + L1_QN); bf16_t* KS = (bf16_t*)(ws + L1_KS); bf16_t* KW = (bf16_t*)(ws + L1_KW);
    bf16_t* KCR = (bf16_t*)(ws + L1_KCR); bf16_t* VCR = (bf16_t*)(ws + L1_VCR); float* GATES = (float*)(ws + L1_GATES);
    const int gw = F.bid * NWAVES + F.wave, NGW = F.G * NWAVES, lane = F.lane, hs = lane >> 3, sub = lane & 7;
    float qg[8], kg[8];
#pragma unroll
    for (int j = 0; j < 8; ++j) { qg[j] = a.in[I_L1_QG][sub * 8 + j]; kg[j] = a.in[I_L1_KG][sub * 8 + j]; }
    const int srccol = (hs < 2) ? C1_KS + hs * 64 : (hs < 4) ? C1_KW + (hs - 2) * 64 : (hs < 6) ? C1_KC + (hs - 4) * 64 : C1_VC + (hs - 6) * 64;
    bf16_t* dstbuf = (hs < 2) ? KS : (hs < 4) ? KW : (hs < 6) ? KCR : VCR;
    const int g2 = hs & 1;
    for (int m = gw; m < T; m += NGW) {
        const int b = m >> 12, t = m & 4095;
        const bf16_t* row = P + (size_t)m * N_IN1;
        f32x2 cs[8];
#pragma unroll
        for (int j = 0; j < 4; ++j) { const f32x4 c4 = *(const f32x4*)(rope + t * 32 + (sub & 3) * 8 + 2 * j); cs[2 * j] = (f32x2){c4.x, c4.y}; cs[2 * j + 1] = (f32x2){c4.z, c4.w}; }
        float v[8];
        head8_load(row + C1_Q + lane * 8, v); head8_norm(v, qg); head8_rope(v, cs, sub >= 4); head8_store(QN + (size_t)m * 512 + lane * 8, v, 0.125f);
        {
            const u32x4 raw = *(const u32x4*)(row + srccol + sub * 8);
            v[0] = bf_lo(raw.x); v[1] = bf_hi(raw.x); v[2] = bf_lo(raw.y); v[3] = bf_hi(raw.y); v[4] = bf_lo(raw.z); v[5] = bf_hi(raw.z); v[6] = bf_lo(raw.w); v[7] = bf_hi(raw.w);
            head8_norm(v, kg); head8_rope(v, cs, sub >= 4);
            u32x4 q; q.x = pk2(v[0], v[1]); q.y = pk2(v[2], v[3]); q.z = pk2(v[4], v[5]); q.w = pk2(v[6], v[7]);
            if (hs >= 4) q = raw;
            *(u32x4*)(dstbuf + ((size_t)(b * 2 + g2) * 4096 + t) * 64 + sub * 8) = q;
        }
        if (lane < 24) GATES[(size_t)m * 24 + lane] = sigmoidf_(bf2f(row[C1_GL + lane]));
    }
    for (int it = gw; it < 2 * NB * 2 * 64; it += NGW) {
        const int tb = it & 63, g = (it >> 6) & 1, b = (it >> 7) & 7, w = it >> 10;
        const size_t m = (size_t)b * 4096 + tb * 64 + lane;
        unsigned r[32];
#pragma unroll
        for (int j = 0; j < 8; ++j) { const u32x4 q = *(const u32x4*)(P + m * N_IN1 + (w ? C1_VW : C1_VS) + g * 64 + j * 8); r[4 * j] = q.x; r[4 * j + 1] = q.y; r[4 * j + 2] = q.z; r[4 * j + 3] = q.w; }
        bf16_t* dst = (bf16_t*)(ws + (w ? L1_VWT : L1_VST)) + ((size_t)(b * 2 + g) * 64) * 4096 + tb * 64 + lane;
#pragma unroll
        for (int d = 0; d < 64; ++d) dst[(size_t)d * 4096] = (bf16_t)((d & 1) ? (r[d >> 1] >> 16) : (r[d >> 1] & 0xffffu));
    }
}

namespace pg8 {
struct EpiCmp1 {
    static constexpr bool PERM = true;
    bf16_t* O; const float* bias;
    __device__ __forceinline__ void operator()(const f32x4 (&acc)[2][2][4][2], const Unit& u, int wr, int wc, int fr, int fq) const {
        const int row0 = u.pm * BM + wr * 64 + fr, col0 = wc * 32 + 8 * fq;
#pragma unroll
        for (int ai = 0; ai < 2; ++ai)
#pragma unroll
            for (int m = 0; m < 4; ++m) { bf16_t* rowp = O + (size_t)(row0 + ai * HALF + m * 16) * 256 + col0;
#pragma unroll
                for (int bj = 0; bj < 2; ++bj) { const float* bp = bias + u.pn * 256 + col0 + bj * HALF;
                    const f32x4 v0 = acc[ai][bj][m][0] + *(const f32x4*)bp, v1 = acc[ai][bj][m][1] + *(const f32x4*)(bp + 4);
                    u32x4 w; w.x = pk2(gelu_tanh(v0[0]), gelu_tanh(v0[1])); w.y = pk2(gelu_tanh(v0[2]), gelu_tanh(v0[3]));
                    w.z = pk2(gelu_tanh(v1[0]), gelu_tanh(v1[1])); w.w = pk2(gelu_tanh(v1[2]), gelu_tanh(v1[3]));
                    *(u32x4*)(rowp + bj * HALF) = w; }
                asm volatile("" ::: "memory"); __builtin_amdgcn_sched_barrier(0); }
    }
};
struct EpiCmp2 {
    static constexpr bool PERM = false;
    float* C;
    __device__ __forceinline__ void operator()(const f32x4 (&acc)[2][2][4][2], const Unit& u, int wr, int wc, int fr, int fq) const {
        if (wc >= 2) return;
        const int row0 = u.pm * BM + wr * 64 + fr, col0 = wc * 32 + 4 * fq;
#pragma unroll
        for (int ai = 0; ai < 2; ++ai)
#pragma unroll
            for (int m = 0; m < 4; ++m)
#pragma unroll
                for (int n = 0; n < 2; ++n) *(f32x4*)(C + (size_t)(row0 + ai * HALF + m * 16) * 64 + col0 + n * 16) = acc[ai][0][m][n];
    }
};
}

__device__ __forceinline__ void p_cmp_final(const Frame& F, const Args& a, unsigned char* ws) {
    const float* CMPO = (const float*)(ws + L1_CMPO); const f32x2* rope = (const f32x2*)(ws + WS_ROPE);
    bf16_t* KC = (bf16_t*)(ws + L1_KC); bf16_t* VCT = (bf16_t*)(ws + L1_VCT);
    const int gw = F.bid * NWAVES + F.wave, NGW = F.G * NWAVES, lane = F.lane;
    const float kg = a.in[I_L1_KG][lane];
    for (int r = gw; r < 8192; r += NGW) {
        float v = CMPO[(size_t)r * 64 + lane];
        const int rr = r & 4095, bg = rr >> 8, c = rr & 255;
        if (r < 4096) {
            const float ss = wave_sum(v * v);
            v = v * (1.0f / sqrtf(ss * (1.f / 64.f) + 1e-6f)) * kg;
            const int pos = (c < 255) ? 16 * c + 31 : 0;
            v = rope_apply(v, rope[pos * 32 + (lane & 31)], lane);
            KC[((size_t)bg * 256 + c) * 64 + lane] = (c < 255) ? (bf16_t)f2bf(v) : (bf16_t)0;
        } else {
            VCT[((size_t)bg * 64 + lane) * 256 + c] = (c < 255) ? (bf16_t)f2bf(v) : (bf16_t)0;
        }
    }
}

__device__ __forceinline__ void att_load2(AttStage& s, const bf16_t* Kg, const bf16_t* Vtg, int vstride, int key0, int tid) {
    s.kreg = *(const u32x4*)(Kg + (size_t)(key0 + (tid >> 3)) * 64 + (tid & 7) * 8);
    s.vreg = *(const u32x4*)(Vtg + (size_t)(tid >> 3) * vstride + key0 + (tid & 7) * 8);
}
__device__ __forceinline__ float score_bound_c2(const float* qg, const float* kg) {
    float mq = 0.f, mk_ = 0.f;
    for (int i = 0; i < 64; ++i) { mq = fmaxf(mq, fabsf(qg[i])); mk_ = fmaxf(mk_, fabsf(kg[i])); }
    return (8.0f * mq * mk_ + 0.5f) * 1.4426950408889634f;
}

constexpr int CA_KB = 256 * 144, CA_VSTR = 528, CA_VB = 64 * CA_VSTR, CA_IMP = CA_KB + CA_VB;
__device__ __forceinline__ void p_cmp_attn(const Frame& F, const Args& a, unsigned char* ws) {
    const bf16_t* QN = (const bf16_t*)(ws + L1_QN); const bf16_t* KC = (const bf16_t*)(ws + L1_KC); const bf16_t* VCT = (const bf16_t*)(ws + L1_VCT);
    float* OC = (float*)(ws + L1_OC); u64* SELB = (u64*)(ws + L1_SELB);
    LAS float* impL = (LAS float*)(F.lds + CA_IMP);
    const int lane = F.lane, wave = F.wave, h = lane >> 5, c = lane & 31, tid = F.tid;
    const float c2 = score_bound_c2(a.in[I_L1_QG], a.in[I_L1_KG]), c1 = 1.4426950408889634f;
    for (int u = F.bid; u < 1024; u += F.G) {
        const int b = (u >> 7) & 7, g = (u >> 6) & 1, rnd = u >> 8, qt = (rnd & 1) ? 63 - (u & 63) : (u & 63), q0 = qt * 64;
        const int bg = b * 2 + g; const size_t mb = (size_t)b * 4096;
        const int t = q0 + wave * 8 + (c >> 2), head = g * 4 + (c & 3);
        bf16x8 Qf[4];
#pragma unroll
        for (int ks = 0; ks < 4; ++ks) Qf[ks] = *(const bf16x8*)(QN + (mb + t) * 512 + head * 64 + ks * 16 + 8 * h);
        const int L = (t >= 31) ? (((t - 31) >> 4) < 254 ? ((t - 31) >> 4) : 254) : -1;
        const int tmax = q0 + 63; const int Lmax = (tmax >= 31) ? (((tmax - 31) >> 4) < 254 ? ((tmax - 31) >> 4) : 254) : -1;
        const int nkt = (Lmax >= 0) ? (Lmax >> 6) + 1 : 0;
        const bf16_t* Kg = KC + (size_t)bg * 256 * 64; const bf16_t* Vtg = VCT + (size_t)bg * 64 * 256;
        __syncthreads();
        for (int i = tid; i < nkt * 512; i += NTHREADS) {
            const int key = i >> 3, ch = i & 7;
            *(LAS u32x4*)(F.lds + key * 144 + ch * 16) = *(const u32x4*)(Kg + (size_t)key * 64 + ch * 8);
        }
        for (int i = tid; i < 64 * nkt * 8; i += NTHREADS) {
            const int d = i / (nkt * 8), ch = i % (nkt * 8);
            const u32x4 v = *(const u32x4*)(Vtg + (size_t)d * 256 + ch * 8);
            LAS unsigned char* p = F.lds + CA_KB + d * CA_VSTR + ch * 16;
            *(LAS u32x2*)p = (u32x2){v.x, v.y}; *(LAS u32x2*)(p + 8) = (u32x2){v.z, v.w};
        }
        __syncthreads();
        f32x16 O[2], IMP[2]; float l = 0.f;
#pragma unroll
        for (int i = 0; i < 16; ++i) { O[0][i] = 0.f; O[1][i] = 0.f; IMP[0][i] = 0.f; IMP[1][i] = 0.f; }
        for (int st = 0; st < nkt * 2; ++st) {
            f32x16 S = {0.f, 0.f, 0.f, 0.f, 0.f, 0.f, 0.f, 0.f, 0.f, 0.f, 0.f, 0.f, 0.f, 0.f, 0.f, 0.f};
            { const LAS unsigned char* kp = F.lds + (st * 32 + c) * 144 + h * 16;
#pragma unroll
              for (int ks = 0; ks < 4; ++ks) S = __builtin_amdgcn_mfma_f32_32x32x16_bf16(*(const LAS bf16x8*)(kp + ks * 32), Qf[ks], S, 0, 0, 0); }
            float p[16];
#pragma unroll
            for (int i = 0; i < 16; ++i) {
                const int cidx = st * 32 + (i & 3) + 8 * (i >> 2) + 4 * h;
                const float e = __builtin_amdgcn_exp2f(S[i] * c1 - c2);
                p[i] = (cidx <= L) ? e : 0.f; l += p[i];
            }
            const bf16x8 P0 = pack8(p[0], p[1], p[2], p[3], p[4], p[5], p[6], p[7]);
            const bf16x8 P1 = pack8(p[8], p[9], p[10], p[11], p[12], p[13], p[14], p[15]);
#pragma unroll
            for (int dt = 0; dt < 2; ++dt) {
                const LAS unsigned char* vp = F.lds + CA_KB + (dt * 32 + c) * CA_VSTR + (st * 32 + 4 * h) * 2;
                const u32x2 a0 = *(const LAS u32x2*)(vp), a1 = *(const LAS u32x2*)(vp + 16), b0 = *(const LAS u32x2*)(vp + 32), b1 = *(const LAS u32x2*)(vp + 48);
                O[dt] = __builtin_amdgcn_mfma_f32_32x32x16_bf16(__builtin_bit_cast(bf16x8, ((u32x4){a0.x, a0.y, a1.x, a1.y})), P0, O[dt], 0, 0, 0);
                O[dt] = __builtin_amdgcn_mfma_f32_32x32x16_bf16(__builtin_bit_cast(bf16x8, ((u32x4){b0.x, b0.y, b1.x, b1.y})), P1, O[dt], 0, 0, 0);
            }
#pragma unroll
            for (int jt = 0; jt < 2; ++jt)
#pragma unroll
                for (int s = 0; s < 2; ++s) {
                    unsigned wv[4];
#pragma unroll
                    for (int e2 = 0; e2 < 4; ++e2) {
                        unsigned pr = 0u;
#pragma unroll
                        for (int q = 0; q < 2; ++q) { const int jj = 2 * e2 + q; const int kap = 16 * s + 8 * (jj >> 2) + 4 * h + (jj & 3);
                            const int off = st * 32 + kap - 4 * (32 * jt + c);
                            const unsigned wbits = (off == 0 || off == 4) ? 0x3F80u : ((off >= 1 && off <= 3) ? 0x4000u : 0u);
                            pr |= wbits << (16 * q); }
                        wv[e2] = pr;
                    }
                    const bf16x8 Wf = __builtin_bit_cast(bf16x8, ((u32x4){wv[0], wv[1], wv[2], wv[3]}));
                    IMP[jt] = __builtin_amdgcn_mfma_f32_32x32x16_bf16(Wf, s ? P1 : P0, IMP[jt], 0, 0, 0);
                }
        }
        const float lt = l + __shfl_xor(l, 32);
        const float inv = 1.0f / fmaxf(lt, 1e-30f);
        { float* orow = OC + (mb + t) * 512 + head * 64;
#pragma unroll
          for (int dt = 0; dt < 2; ++dt)
#pragma unroll
            for (int i4 = 0; i4 < 4; ++i4) { const int d = dt * 32 + 8 * i4 + 4 * h;
                *(f32x4*)(orow + d) = (f32x4){O[dt][4 * i4] * inv, O[dt][4 * i4 + 1] * inv, O[dt][4 * i4 + 2] * inv, O[dt][4 * i4 + 3] * inv}; } }
#pragma unroll
        for (int jt = 0; jt < 2; ++jt)
#pragma unroll
            for (int i = 0; i < 16; ++i) {
                float v = IMP[jt][i] * inv; v += __shfl_xor(v, 1); v += __shfl_xor(v, 2);
                if ((c & 3) == 0) impL[(wave * 8 + (c >> 2)) * 65 + 32 * jt + (i & 3) + 8 * (i >> 2) + 4 * h] = v;
            }
        __syncthreads();
        if (tid < 64) {
            const int tq = q0 + tid, cur = tq >> 6;
            u64 mask;
            if (cur + 1 <= 16) mask = (1ull << (cur + 1)) - 1ull;
            else {
                unsigned top[16];
#pragma unroll
                for (int blk = 0; blk < 4; ++blk) {
                    unsigned k16[16];
#pragma unroll
                    for (int i = 0; i < 16; ++i) { const int j = blk * 16 + i; const float x = impL[tid * 65 + j];
                        const unsigned key = (j > cur) ? 0u : ((j == 0 || j == cur) ? 0xFFFFFFC0u : (mono_u32(x) & ~0x3Fu)) | (unsigned)(63 - j);
                        k16[i] = (j > cur) ? 0u : key; }
                    sort16_desc(k16);
                    if (blk == 0) {
#pragma unroll
                        for (int i = 0; i < 16; ++i) top[i] = k16[i];
                    } else merge16_desc(top, k16);
                }
                mask = 0ull;
#pragma unroll
                for (int i = 0; i < 16; ++i) mask |= 1ull << (63 - (int)(top[i] & 63u));
            }
            SELB[(size_t)bg * 4096 + tq] = mask;
        }
    }
}

__device__ __forceinline__ void p_nsa_attn(const Frame& F, const Args& a, unsigned char* ws) {
    const bf16_t* QN = (const bf16_t*)(ws + L1_QN);
    const u64* SELB = (const u64*)(ws + L1_SELB); float* OC = (float*)(ws + L1_OC); const float* GATES = (const float*)(ws + L1_GATES);
    bf16_t* CAT = (bf16_t*)(ws + L1_CAT);
    const int lane = F.lane, wave = F.wave, h = lane >> 5, c = lane & 31, tid = F.tid;
    const float c2 = score_bound_c2(a.in[I_L1_QG], a.in[I_L1_KG]), c1 = 1.4426950408889634f;
    for (int u = F.bid; u < 512; u += F.G) {
        const int idx = u & 255, g = u >> 8, b = idx >> 5, qtr = idx & 31, qt = g ? 31 - qtr : qtr, q0 = qt * 128;
        const int bg = b * 2 + g; const size_t mb = (size_t)b * 4096;
        bf16x8 Qf[2][4]; int qidx[2];
#pragma unroll
        for (int ct = 0; ct < 2; ++ct) { qidx[ct] = q0 + wave * 16 + ct * 8 + (c >> 2);
#pragma unroll
            for (int ks = 0; ks < 4; ++ks) Qf[ct][ks] = *(const bf16x8*)(QN + (mb + qidx[ct]) * 512 + (g * 4 + (c & 3)) * 64 + ks * 16 + 8 * h); }
        const int head = g * 4 + (c & 3);
#pragma unroll 1
        for (int pass = 0; pass < 2; ++pass) {
            const bf16_t* Kg = (const bf16_t*)(ws + (pass ? L1_KW : L1_KS)) + (size_t)bg * 4096 * 64;
            const bf16_t* Vtg = (const bf16_t*)(ws + (pass ? L1_VWT : L1_VST)) + (size_t)bg * 64 * 4096;
            u64 selw[2];
#pragma unroll
            for (int ct = 0; ct < 2; ++ct) selw[ct] = pass ? ~0ull : SELB[(size_t)bg * 4096 + qidx[ct]];
            const int wlen = pass ? 512 : 0x7fffffff;
            f32x16 O[2][2]; float l[2] = {0.f, 0.f};
#pragma unroll
            for (int ct = 0; ct < 2; ++ct)
#pragma unroll
                for (int dt = 0; dt < 2; ++dt)
#pragma unroll
                    for (int i = 0; i < 16; ++i) O[ct][dt][i] = 0.f;
            const int kt_lo = pass ? ((2 * qt - 8) > 0 ? 2 * qt - 8 : 0) : 0, kt_hi = 2 * qt + 2;
            AttStage st; att_load(st, Kg, Vtg, kt_lo * 64, tid);
            __syncthreads();
            att_store(st, F.lds + (kt_lo & 1) * AT_BUF, tid);
            __syncthreads();
            for (int kt = kt_lo; kt < kt_hi; ++kt) {
                LAS unsigned char* buf = F.lds + (kt & 1) * AT_BUF;
                if (kt + 1 < kt_hi) att_load(st, Kg, Vtg, (kt + 1) * 64, tid);
#pragma unroll 1
                for (int sub = 0; sub < 2; ++sub) {
                    bf16x8 Kf[4];
                    att_kfrags(buf, sub, Kf, lane);
#pragma unroll
                    for (int ct = 0; ct < 2; ++ct) {
                        __builtin_amdgcn_sched_barrier(0);
                        const f32x16 S = att_qk_f(Kf, Qf[ct]);
                        const bool flag = (selw[ct] >> kt) & 1ull;
                        const int tq = qidx[ct];
                        const float c2e = flag ? c2 : 3.0e30f;
                        float p[16];
                        const int dbase = tq - (kt * 64 + sub * 32 + 4 * h);
#pragma unroll
                        for (int i = 0; i < 16; ++i) {
                            const float e = __builtin_amdgcn_exp2f(S[i] * c1 - c2e);
                            p[i] = ((unsigned)(dbase - ((i & 3) + 8 * (i >> 2))) < (unsigned)wlen) ? e : 0.f; l[ct] += p[i];
                        }
                        const bf16x8 P0 = pack8(p[0], p[1], p[2], p[3], p[4], p[5], p[6], p[7]);
                        const bf16x8 P1 = pack8(p[8], p[9], p[10], p[11], p[12], p[13], p[14], p[15]);
                        att_pv2(buf, sub, P0, P1, O[ct], lane);
                    }
                }
                if (kt + 1 < kt_hi) att_store(st, F.lds + ((kt + 1) & 1) * AT_BUF, tid);
                __syncthreads();
            }
#pragma unroll
            for (int ct = 0; ct < 2; ++ct) {
                const float lt = l[ct] + __shfl_xor(l[ct], 32);
                const float inv = 1.0f / fmaxf(lt, 1e-30f);
                const size_t m = mb + qidx[ct];
                const float gcv = GATES[m * 24 + head * 3 + 0], gsv = GATES[m * 24 + head * 3 + 1], gwv = GATES[m * 24 + head * 3 + 2];
                float* orow = OC + m * 512 + head * 64; bf16_t* crow = CAT + m * 1024 + head * 64;
#pragma unroll
                for (int dt = 0; dt < 2; ++dt)
#pragma unroll
                    for (int i4 = 0; i4 < 4; ++i4) {
                        const int d = dt * 32 + 8 * i4 + 4 * h;
                        const f32x4 prev = *(const f32x4*)(orow + d);
                        const f32x4 ov = (f32x4){O[ct][dt][4 * i4] * inv, O[ct][dt][4 * i4 + 1] * inv, O[ct][dt][4 * i4 + 2] * inv, O[ct][dt][4 * i4 + 3] * inv};
                        if (pass == 0) *(f32x4*)(orow + d) = prev * gcv + ov * gsv;
                        else { const f32x4 r = prev + ov * gwv; u32x2 w; w.x = pk2(r[0], r[1]); w.y = pk2(r[2], r[3]); *(u32x2*)(crow + d) = w; }
                    }
            }
        }
    }
}

__device__ __forceinline__ float logsigmoidf_(float x) { return fminf(x, 0.f) - log1pf(__expf(-fabsf(x))); }
__device__ __forceinline__ bf16x8 frag_lds(const LAS float* p) { const f32x4 a = *(const LAS f32x4*)p, b = *(const LAS f32x4*)(p + 4); return pack8(a[0], a[1], a[2], a[3], b[0], b[1], b[2], b[3]); }
__device__ __forceinline__ bf16x8 frag_glb(const float* p) { const f32x4 a = *(const f32x4*)p, b = *(const f32x4*)(p + 4); return pack8(a[0], a[1], a[2], a[3], b[0], b[1], b[2], b[3]); }
__device__ __forceinline__ void gla_wave_bcum(const Args& a, const bf16_t* P, size_t m0, int hh, int lane, float (&bc)[32]) {
    float wg[16];
#pragma unroll
    for (int r = 0; r < 16; ++r) wg[r] = a.in[I_L1_WGATE][r * 256 + hh * 64 + lane];
    const float bgv = a.in[I_L1_BGATE][hh * 64 + lane];
    float run = 0.f;
#pragma unroll
    for (int c = 0; c < 32; ++c) {
        const bf16_t* grow = P + (m0 + c) * N_IN1 + C1_GLOW;
        const u32x4 ga = *(const u32x4*)grow, gb = *(const u32x4*)(grow + 8);
        float acc = bgv;
        acc += wg[0] * bf_lo(ga.x); acc += wg[1] * bf_hi(ga.x); acc += wg[2] * bf_lo(ga.y); acc += wg[3] * bf_hi(ga.y); acc += wg[4] * bf_lo(ga.z); acc += wg[5] * bf_hi(ga.z); acc += wg[6] * bf_lo(ga.w); acc += wg[7] * bf_hi(ga.w);
        acc += wg[8] * bf_lo(gb.x); acc += wg[9] * bf_hi(gb.x); acc += wg[10] * bf_lo(gb.y); acc += wg[11] * bf_hi(gb.y); acc += wg[12] * bf_lo(gb.z); acc += wg[13] * bf_hi(gb.z); acc += wg[14] * bf_lo(gb.w); acc += wg[15] * bf_hi(gb.w);
        run += logsigmoidf_(acc) * 0.0625f; bc[c] = run;
    }
}
__device__ __forceinline__ bf16x8 gla_vfrag(const bf16_t* vbase, int s0) {
    unsigned short e[8];
#pragma unroll
    for (int j = 0; j < 8; ++j) e[j] = vbase[(size_t)(s0 + j) * N_IN1];
    u32x4 w; w.x = (unsigned)e[0] | ((unsigned)e[1] << 16); w.y = (unsigned)e[2] | ((unsigned)e[3] << 16); w.z = (unsigned)e[4] | ((unsigned)e[5] << 16); w.w = (unsigned)e[6] | ((unsigned)e[7] << 16);
    return __builtin_bit_cast(bf16x8, w);
}
__device__ __forceinline__ void p_gla_a(const Frame& F, const Args& a, unsigned char* ws) {
    const bf16_t* P = (const bf16_t*)(ws + WS_PROJ); float* UPD = (float*)(ws + L1_UPD); float* DECAY = (float*)(ws + L1_DECAY);
    const int lane = F.lane, r = lane & 31, h = lane >> 5;
    LAS bf16_t* kdT = (LAS bf16_t*)(F.lds + F.wave * 5120);
    const int gw = F.bid * NWAVES + F.wave, NGW = F.G * NWAVES;
    for (int u = gw; u < 4096; u += NGW) {
        const int b = u >> 9, hh = (u >> 7) & 3, n = u & 127; const size_t m0 = (size_t)b * 4096 + n * 32;
        float bc[32];
        gla_wave_bcum(a, P, m0, hh, lane, bc);
        const float blast = bc[31];
#pragma unroll
        for (int c = 0; c < 32; c += 2) {
            const float k0 = bf2f(P[(m0 + c) * N_IN1 + C1_GK + hh * 64 + lane]) * __expf(blast - bc[c]);
            const float k1 = bf2f(P[(m0 + c + 1) * N_IN1 + C1_GK + hh * 64 + lane]) * __expf(blast - bc[c + 1]);
            *(LAS unsigned*)(kdT + lane * 40 + c) = pk2(k0, k1);
        }
        DECAY[(size_t)u * 64 + lane] = __expf(blast);
        LDS_WAIT();
        bf16x8 Bf[2][2];
#pragma unroll
        for (int nt = 0; nt < 2; ++nt)
#pragma unroll
            for (int ks = 0; ks < 2; ++ks) Bf[nt][ks] = *(const LAS bf16x8*)(kdT + (32 * nt + r) * 40 + 16 * ks + 8 * h);
#pragma unroll
        for (int mt = 0; mt < 4; ++mt) {
            const bf16_t* vb = P + m0 * N_IN1 + C1_GV + hh * 128 + 32 * mt + r;
            const bf16x8 A0 = gla_vfrag(vb, 8 * h), A1 = gla_vfrag(vb, 16 + 8 * h);
#pragma unroll
            for (int nt = 0; nt < 2; ++nt) {
                f32x16 acc = {0.f, 0.f, 0.f, 0.f, 0.f, 0.f, 0.f, 0.f, 0.f, 0.f, 0.f, 0.f, 0.f, 0.f, 0.f, 0.f};
                acc = __builtin_amdgcn_mfma_f32_32x32x16_bf16(A0, Bf[nt][0], acc, 0, 0, 0);
                acc = __builtin_amdgcn_mfma_f32_32x32x16_bf16(A1, Bf[nt][1], acc, 0, 0, 0);
                float* up = UPD + (size_t)u * 8192 + 32 * nt + r;
#pragma unroll
                for (int i = 0; i < 16; ++i) up[(size_t)(32 * mt + (i & 3) + 8 * (i >> 2) + 4 * h) * 64] = acc[i];
            }
        }
        LDS_WAIT();
    }
}
__device__ __forceinline__ void p_gla_b(const Frame& F, unsigned char* ws) {
    float* UPD = (float*)(ws + L1_UPD); const float* DECAY = (const float*)(ws + L1_DECAY);
    for (int e = F.bid * NTHREADS + F.tid; e < 32 * 8192; e += F.G * NTHREADS) {
        const int bh = e >> 13, rem = e & 8191, dk = rem & 63;
        float state = 0.f;
        float* up = UPD + (size_t)bh * 128 * 8192 + rem; const float* dp = DECAY + (size_t)bh * 128 * 64 + dk;
#pragma unroll 8
        for (int n = 0; n < 128; ++n) { const float uv = up[(size_t)n * 8192], dc = dp[n * 64]; up[(size_t)n * 8192] = state; state = dc * state + uv; }
    }
}
__device__ __forceinline__ void p_gla_c(const Frame& F, const Args& a, unsigned char* ws, const int mode) {
    const bf16_t* P = (const bf16_t*)(ws + WS_PROJ); const float* PREV = (const float*)(ws + L1_UPD); bf16_t* CAT = (bf16_t*)(ws + L1_CAT);
    const int lane = F.lane, r = lane & 31, h = lane >> 5;
    LAS bf16_t* qd = (LAS bf16_t*)(F.lds + F.wave * 9472);
    LAS bf16_t* ki = qd + 32 * 72;
    const int gw = F.bid * NWAVES + F.wave, NGW = F.G * NWAVES;
    for (int u = gw; u < 4096; u += NGW) {
        const int b = u >> 9, hh = (u >> 7) & 3, n = u & 127; const size_t m0 = (size_t)b * 4096 + n * 32;
        f32x4 pr_[8]; unsigned short vr_[16];
#define GLA_FETCH(ct_) do { const float* pp_ = PREV + (size_t)u * 8192 + (size_t)(32 * (ct_) + r) * 64 + 8 * h; \
            _Pragma("unroll") for (int ks_ = 0; ks_ < 4; ++ks_) { pr_[2 * ks_] = *(const f32x4*)(pp_ + 16 * ks_); pr_[2 * ks_ + 1] = *(const f32x4*)(pp_ + 16 * ks_ + 4); } \
            const bf16_t* vb_ = P + m0 * N_IN1 + C1_GV + hh * 128 + 32 * (ct_) + r; \
            _Pragma("unroll") for (int j_ = 0; j_ < 16; ++j_) vr_[j_] = vb_[(size_t)(8 * h + (j_ & 7) + 16 * (j_ >> 3)) * N_IN1]; } while (0)
        GLA_FETCH(0);
        {
            float bc[32];
            if (mode == 1) {
#pragma unroll
                for (int c = 0; c < 32; ++c) bc[c] = -0.01f * (float)c;
            } else gla_wave_bcum(a, P, m0, hh, lane, bc);
#pragma unroll
            for (int c = 0; c < 32; ++c) {
                const float kv = bf2f(P[(m0 + c) * N_IN1 + C1_GK + hh * 64 + lane]) * __expf(-bc[c]);
                const float qv = bf2f(P[(m0 + c) * N_IN1 + C1_GQ + hh * 64 + lane]) * 0.125f * __expf(bc[c]);
                ki[c * 72 + lane] = (bf16_t)f2bf(kv); qd[c * 72 + lane] = (bf16_t)f2bf(qv);
            }
        }
        LDS_WAIT();
        bf16x8 Qa[4];
#pragma unroll
        for (int ks = 0; ks < 4; ++ks) Qa[ks] = *(const LAS bf16x8*)(qd + r * 72 + 16 * ks + 8 * h);
        {
            f32x16 at = {0.f, 0.f, 0.f, 0.f, 0.f, 0.f, 0.f, 0.f, 0.f, 0.f, 0.f, 0.f, 0.f, 0.f, 0.f, 0.f};
#pragma unroll
            for (int ks = 0; ks < 4; ++ks) at = __builtin_amdgcn_mfma_f32_32x32x16_bf16(Qa[ks], *(const LAS bf16x8*)(ki + r * 72 + 16 * ks + 8 * h), at, 0, 0, 0);
            LDS_WAIT();
#pragma unroll
            for (int i = 0; i < 16; ++i) { const int c = (i & 3) + 8 * (i >> 2) + 4 * h; ki[c * 40 + r] = (bf16_t)f2bf((r <= c) ? at[i] : 0.f); }
        }
        LDS_WAIT();
        bf16x8 Aa[2];
#pragma unroll
        for (int ks = 0; ks < 2; ++ks) Aa[ks] = *(const LAS bf16x8*)(ki + r * 40 + 16 * ks + 8 * h);
        f32x16 acc[4];
#pragma unroll
        for (int ct = 0; ct < 4; ++ct) {
            bf16x8 Bp[4], Bv[2];
#pragma unroll
            for (int ks = 0; ks < 4; ++ks) Bp[ks] = pack8(pr_[2 * ks][0], pr_[2 * ks][1], pr_[2 * ks][2], pr_[2 * ks][3], pr_[2 * ks + 1][0], pr_[2 * ks + 1][1], pr_[2 * ks + 1][2], pr_[2 * ks + 1][3]);
#pragma unroll
            for (int ks = 0; ks < 2; ++ks) { u32x4 w; w.x = (unsigned)vr_[8 * ks] | ((unsigned)vr_[8 * ks + 1] << 16); w.y = (unsigned)vr_[8 * ks + 2] | ((unsigned)vr_[8 * ks + 3] << 16);
                w.z = (unsigned)vr_[8 * ks + 4] | ((unsigned)vr_[8 * ks + 5] << 16); w.w = (unsigned)vr_[8 * ks + 6] | ((unsigned)vr_[8 * ks + 7] << 16); Bv[ks] = __builtin_bit_cast(bf16x8, w); }
            if (ct < 3) GLA_FETCH(ct + 1);
#pragma unroll
            for (int i = 0; i < 16; ++i) acc[ct][i] = 0.f;
#pragma unroll
            for (int ks = 0; ks < 4; ++ks) acc[ct] = __builtin_amdgcn_mfma_f32_32x32x16_bf16(Qa[ks], Bp[ks], acc[ct], 0, 0, 0);
#pragma unroll
            for (int ks = 0; ks < 2; ++ks) acc[ct] = __builtin_amdgcn_mfma_f32_32x32x16_bf16(Aa[ks], Bv[ks], acc[ct], 0, 0, 0);
        }
#undef GLA_FETCH
#pragma unroll
        for (int i = 0; i < 16; ++i) {
            float ss = acc[0][i] * acc[0][i] + acc[1][i] * acc[1][i] + acc[2][i] * acc[2][i] + acc[3][i] * acc[3][i];
            ss += __shfl_xor(ss, 1); ss += __shfl_xor(ss, 2); ss += __shfl_xor(ss, 4); ss += __shfl_xor(ss, 8); ss += __shfl_xor(ss, 16);
            const float rstd = 1.0f / sqrtf(ss * (1.f / 128.f) + 1e-6f);
            const int c = (i & 3) + 8 * (i >> 2) + 4 * h; const size_t m = m0 + c;
#pragma unroll
            for (int ct = 0; ct < 4; ++ct) { const int dv = 32 * ct + r;
                const float rv = bf2f(P[m * N_IN1 + C1_GR + hh * 128 + dv]);
                const bf16_t ov = (bf16_t)f2bf(acc[ct][i] * rstd * a.in[I_L1_OGAIN][dv] * rv * sigmoidf_(rv));
                if (mode == 0) CAT[m * 1024 + 512 + hh * 128 + dv] = ov; else asm volatile("" :: "v"((unsigned)ov)); }
        }
        LDS_WAIT();
    }
}
__global__ void __launch_bounds__(NTHREADS, 2) mk_fwd(Args args) {
    extern __shared__ __attribute__((aligned(16))) unsigned char lds_raw[];
    cg::grid_group grid = cg::this_grid();
    Frame F; F.lds = (LAS unsigned char*)lds_raw; F.tid = threadIdx.x; F.lane = F.tid & 63; F.wave = __builtin_amdgcn_readfirstlane(F.tid >> 6); F.G = gridDim.x; F.bid = blockIdx.x;
    unsigned char* ws = args.ws;
    const int lo = args.ph_lo, hi = args.ph_hi;
#ifndef KEEPMASK
#define KEEPMASK 0xFFFFFFFFu
#endif
#define IN(k) (((KEEPMASK >> (k)) & 1u) && lo <= (k) && (k) < hi)
#define BOTH(k) (IN(k) && IN((k) + 1))
#ifndef TMODE
#define TMODE 0
#endif
#ifndef REPMASK
#define REPMASK 0u
#endif
#define PH(k, ...) if (IN(k)) { { const int rep = 0; (void)rep; __VA_ARGS__; } if ((REPMASK >> (k)) & 1u) { xcd_barrier(xbar); { const int rep = 1; (void)rep; __VA_ARGS__; } } }
#ifdef TS_A
#define STAMP(k) do { if (F.bid == 0 && F.tid == 0) ((unsigned long long*)(ws + WS_CTL + 65536))[(k)] = __builtin_amdgcn_s_memrealtime(); } while (0)
#else
#define STAMP(k) do { } while (0)
#endif
#define GRID_BAR(k) do { if (BOTH(k)) { if ((k) == 0) grid.sync(); else xcd_barrier(xbar); } STAMP((k) + 1); } while (0)
    const float* x = args.in[I_X];
    float* out = args.out;
    volatile LAS unsigned* xst = (volatile LAS unsigned*)(F.lds + LDS_BYTES - 64);
    if (F.tid < 16) xst[F.tid] = 0u;
    __syncthreads();
    XcdBarrier xbar = xcd_barrier_post((unsigned*)(ws + WS_CTL) + 4096, xst);

    STAMP(0);
    PH(0, int base = 0; transpose_all(F, base, args.in[I_L0_WIN], 1024, 1864, (bf16_t*)(ws + WS_W_IN0), 1024, MapIn0()); transpose_all(F, base, args.in[I_L0_WGLU], 512, 512, (bf16_t*)(ws + WS_W_GLU), 512, MapId()); transpose_all(F, base, args.in[I_L0_WOUT], 1024, 1024, (bf16_t*)(ws + WS_W_OUT0), 1024, MapId()); transpose_all(F, base, args.in[I_L0_WQ], 1024, 2048, (bf16_t*)(ws + WS_WQ0), 1024, MapId()); transpose_all(F, base, args.in[I_L1_WIN], 1024, 2856, (bf16_t*)(ws + WS_W_IN1), 1024, MapIn1()); transpose_all(F, base, args.in[I_L1_KW1], 2048, 256, (bf16_t*)(ws + WS_KW1), 2048, MapId()); transpose_all(F, base, args.in[I_L1_VW1], 2048, 256, (bf16_t*)(ws + WS_VW1), 2048, MapId()); transpose_all(F, base, args.in[I_L1_KW2], 256, 64, (bf16_t*)(ws + WS_KW2), 256, MapId()); transpose_all(F, base, args.in[I_L1_VW2], 256, 64, (bf16_t*)(ws + WS_VW2), 256, MapId()); transpose_all(F, base, args.in[I_L1_WOUT], 1024, 1024, (bf16_t*)(ws + WS_W_OUT1), 1024, MapId()); transpose_all(F, base, args.in[I_L1_WQ], 1024, 2048, (bf16_t*)(ws + WS_WQ1), 1024, MapId()); zero_bytes(F, ws + WS_W_IN0 + (size_t)1864 * 1024 * 2, (size_t)(2048 - 1864) * 1024 * 2); zero_bytes(F, ws + WS_W_IN1 + (size_t)2856 * 1024 * 2, (size_t)(3072 - 2856) * 1024 * 2); zero_bytes(F, ws + WS_KW2 + (size_t)64 * 256 * 2, (size_t)192 * 256 * 2); zero_bytes(F, ws + WS_VW2 + (size_t)64 * 256 * 2, (size_t)192 * 256 * 2); cvt_f32_bf16(F, args.in[I_L0_SK], (bf16_t*)(ws + WS_SK0), (size_t)16 * 128 * 128); cvt_f32_bf16(F, args.in[I_L1_SK], (bf16_t*)(ws + WS_SK1), (size_t)16 * 128 * 128); cvt_table_i8(F, args.in[I_L0_U], ws + WS_TAB8U, (float*)(ws + WS_TABSU), 32); cvt_table_fp8(F, args.in[I_L0_V], ws + WS_TAB8V, (float*)(ws + WS_TABSV), 32); p_rope_table(F, (f32x2*)(ws + WS_ROPE)); if (F.bid == F.G - 1) { for (int i = F.tid; i < 1024; i += NTHREADS) ((float*)(ws + WS_CMPB + 4096))[i] = args.in[I_L1_MIXN][i]; } __syncthreads(); for (int g = F.bid; g < 32; g += F.G) s5_build_group(F, args, ws, g); for (int j = (F.bid + F.G - (32 % F.G)) % F.G; j < 64; j += F.G) cmp_bias(F, args, (float*)(ws + WS_CMPB), j); p_rmsnorm(F, x, args.in[I_L0_MIXN], (bf16_t*)(ws + WS_XN));)
    GRID_BAR(0);
    PH(1, pg8::Gemm g{(const bf16_t*)(ws + WS_XN), (const bf16_t*)(ws + WS_W_IN0), T, N_IN0, 1024, 1024, 1024}; pg8::StaticOrder S; S.init(T, N_IN0, F.G, F.bid); pg8::EpiStoreBf16 E{(bf16_t*)(ws + WS_PROJ), N_IN0}; pg8::gemm_phase(F.lds, g, S, E);)
    GRID_BAR(1);
    PH(2, p_l0_prep(F, args, ws);)
    GRID_BAR(2);
    PH(3, p_dsa_index(F, ws, (u64*)(ws + (rep ? L0_CAT : L0_SELT)), rep ? TMODE : 0); { pg8::Gemm g{(const bf16_t*)(ws + L0_UA), (const bf16_t*)(ws + WS_S5B1), 65536, 8192, 256, 384, 256}; pg8::GroupedOrder S; S.init(256, 8, F.G, F.bid); pg8::EpiS5State E{(float*)(ws + L0_SLOC)}; pg8::gemm_phase(F.lds, g, S, E); })
    GRID_BAR(3);
    PH(4, p_s5_scan(F, args, ws); p_dsa_attn(F, args, ws);)
    GRID_BAR(4);
    PH(7, pg8::Gemm g{(const bf16_t*)(ws + L0_UA), (const bf16_t*)(ws + WS_S5B2), 65536, 8192, 384, 384, 384}; pg8::GroupedOrder S; S.init(256, 8, F.G, F.bid); pg8::EpiS5Out E{(bf16_t*)(ws + L0_YB)}; pg8::gemm_phase(F.lds, g, S, E);)
    GRID_BAR(7);
    PH(8, pg8::Gemm g{(const bf16_t*)(ws + L0_YB), (const bf16_t*)(ws + WS_W_GLU), T, 512, 512, 512, 512}; pg8::StaticOrder S; S.init(T, 512, F.G, F.bid); pg8::EpiGlu E{(const bf16_t*)(ws + L0_YB), args.in[I_L0_BGLU], (bf16_t*)(ws + L0_CAT)}; pg8::gemm_phase(F.lds, g, S, E);)
    GRID_BAR(8);
    PH(9, pg8::Gemm g{(const bf16_t*)(ws + L0_CAT), (const bf16_t*)(ws + WS_W_OUT0), T, 1024, 1024, 1024, 1024}; pg8::StaticOrder S; S.init(T, 1024, F.G, F.bid); pg8::EpiResidF32 E{x, out, 1024}; pg8::gemm_phase(F.lds, g, S, E);)
    GRID_BAR(9);
    PH(10, p_rmsnorm(F, out, args.in[I_L0_FFNN], (bf16_t*)(ws + WS_XN));)
    GRID_BAR(10);
    PH(11, pg8::Gemm g{(const bf16_t*)(ws + WS_XN), (const bf16_t*)(ws + WS_WQ0), T, 2048, 1024, 1024, 1024}; pg8::StaticOrder S; S.init(T, 2048, F.G, F.bid); pg8::EpiStoreBf16 E{(bf16_t*)(ws + PE_Q2), 2048}; pg8::gemm_phase(F.lds, g, S, E);)
    GRID_BAR(11);
    PH(12, p_peer_route(F, ws, (const bf16_t*)(ws + WS_SK0));)
    GRID_BAR(12);
    PH(13, p_peer_expert5(F, ws, out, rep ? 0.f : 1.f, xbar, rep ? TMODE : 0, true);)
    GRID_BAR(13);
    PH(15, pg8::Gemm g{(const bf16_t*)(ws + WS_XN), (const bf16_t*)(ws + WS_W_IN1), T, N_IN1, 1024, 1024, 1024}; pg8::StaticOrder S; S.init(T, N_IN1, F.G, F.bid); pg8::EpiStoreBf16 E{(bf16_t*)(ws + WS_PROJ), N_IN1}; pg8::gemm_phase(F.lds, g, S, E);)
    GRID_BAR(15);
    PH(16, p_l1_prep(F, args, ws);)
    GRID_BAR(16);
    PH(17, pg8::Gemm g{(const bf16_t*)(ws + L1_KCR), (const bf16_t*)(ws + WS_KW1), 8192, 512, 2048, 1024, 2048}; pg8::GroupedOrder S; S.init(32, 16, F.G, F.bid); pg8::EpiCmp1 E{(bf16_t*)(ws + L1_H1), (const float*)(ws + WS_CMPB)}; pg8::gemm_phase(F.lds, g, S, E);)
    GRID_BAR(17);
    PH(18, pg8::Gemm g{(const bf16_t*)(ws + L1_H1), (const bf16_t*)(ws + WS_KW2), 8192, 512, 256, 256, 256}; pg8::GroupedOrder S; S.init(32, 16, F.G, F.bid); pg8::EpiCmp2 E{(float*)(ws + L1_CMPO)}; pg8::gemm_phase(F.lds, g, S, E);)
    GRID_BAR(18);
    PH(19, p_cmp_final(F, args, ws);)
    GRID_BAR(19);
    PH(20, p_cmp_attn(F, args, ws);)
    GRID_BAR(20);
    PH(21, if (rep) { p_cmp_attn(F, args, ws); xcd_barrier(xbar); } p_nsa_attn(F, args, ws);)
    GRID_BAR(21);
    PH(22, p_gla_a(F, args, ws); cvt_table_i8(F, args.in[I_L1_U], ws + WS_TAB8U, (float*)(ws + WS_TABSU), 0); cvt_table_fp8(F, args.in[I_L1_V], ws + WS_TAB8V, (float*)(ws + WS_TABSV), 0);)
    GRID_BAR(22);
    PH(23, if (rep) { p_gla_a(F, args, ws); xcd_barrier(xbar); } p_gla_b(F, ws);)
    GRID_BAR(23);
    PH(24, p_gla_c(F, args, ws, rep ? TMODE : 0);)
    GRID_BAR(24);
    PH(25, pg8::Gemm g{(const bf16_t*)(ws + L1_CAT), (const bf16_t*)(ws + WS_W_OUT1), T, 1024, 1024, 1024, 1024}; pg8::StaticOrder S; S.init(T, 1024, F.G, F.bid); pg8::EpiResidF32 E{out, out, 1024}; pg8::gemm_phase(F.lds, g, S, E);)
    GRID_BAR(25);
    PH(26, p_rmsnorm(F, out, args.in[I_L1_FFNN], (bf16_t*)(ws + WS_XN));)
    GRID_BAR(26);
    PH(27, pg8::Gemm g{(const bf16_t*)(ws + WS_XN), (const bf16_t*)(ws + WS_WQ1), T, 2048, 1024, 1024, 1024}; pg8::StaticOrder S; S.init(T, 2048, F.G, F.bid); pg8::EpiStoreBf16 E{(bf16_t*)(ws + PE_Q2), 2048}; pg8::gemm_phase(F.lds, g, S, E);)
    GRID_BAR(27);
    PH(28, p_peer_route(F, ws, (const bf16_t*)(ws + WS_SK1));)
    GRID_BAR(28);
    PH(29, p_peer_expert5(F, ws, out, rep ? 0.f : 1.f, xbar, rep ? TMODE : 0, false);)
#undef IN
#undef BOTH
}

extern "C" void kernel_launch(void* const* d_in, const int* in_sizes, int n_in, void* d_out, int out_size, void* d_ws, size_t ws_size, hipStream_t stream) {
    static int grid = 0;
    if (grid == 0) {
        if (n_in != 39 || ws_size < WS_END) { fprintf(stderr, "kernel_launch: unexpected n_in %d or ws_size %zu (< %zu)\n", n_in, ws_size, (size_t)WS_END); grid = -1; return; }
        int dev = 0, cus = 0, per_cu = 0;
        (void)hipGetDevice(&dev); (void)hipDeviceGetAttribute(&cus, hipDeviceAttributeMultiprocessorCount, dev);
        if (hipFuncSetAttribute((const void*)mk_fwd, hipFuncAttributeMaxDynamicSharedMemorySize, LDS_BYTES) != hipSuccess) { fprintf(stderr, "kernel_launch: hipFuncSetAttribute failed\n"); grid = -1; return; }
        if (hipOccupancyMaxActiveBlocksPerMultiprocessor(&per_cu, (const void*)mk_fwd, NTHREADS, LDS_BYTES) != hipSuccess || per_cu < 1) { fprintf(stderr, "kernel_launch: occupancy query failed (%d)\n", per_cu); (void)hipGetLastError(); grid = -1; return; }
        grid = cus;
    }
    if (grid < 0) return;
    (void)hipMemsetAsync((char*)d_ws + WS_CTL, 0, 1 * MiB, stream);
    Args a{};
    for (int i = 0; i < 39; ++i) a.in[i] = (const float*)d_in[i];
    a.out = (float*)d_out; a.ws = (unsigned char*)d_ws; a.ph_lo = 0; a.ph_hi = 1000;
    void* kargs[] = {&a};
    hipError_t e = hipLaunchCooperativeKernel((const void*)mk_fwd, dim3(grid), dim3(NTHREADS), kargs, LDS_BYTES, stream);
    if (e != hipSuccess) fprintf(stderr, "kernel_launch: cooperative launch failed: %s\n", hipGetErrorString(e));
}
```

```cpp
#include <hip/hip_runtime.h>
#include <hip/hip_cooperative_groups.h>
#include <cstdio>
#include <cstdint>
namespace cg = cooperative_groups;

#define LAS __attribute__((address_space(3)))
typedef unsigned short bf16_t;
typedef short bf16x8 __attribute__((ext_vector_type(8)));
typedef float f32x4 __attribute__((ext_vector_type(4)));
typedef float f32x2 __attribute__((ext_vector_type(2)));
typedef float f32x16 __attribute__((ext_vector_type(16)));
typedef unsigned u32x4 __attribute__((ext_vector_type(4)));
typedef unsigned u32x2 __attribute__((ext_vector_type(2)));
typedef unsigned long long u64;

constexpr int NB = 8, SEQ = 4096, DM = 1024, T = NB * SEQ;
constexpr int NTHREADS = 512, NWAVES = 8;
constexpr int LDS_BYTES = 147456;
constexpr int N_IN0 = 2048, N_IN1 = 3072;
constexpr int C0_Q = 0, C0_K = 512, C0_V = 640, C0_IQ = 768, C0_U = 1280, C0_IK = 1792, C0_IW = 1856;
constexpr int C1_Q = 0, C1_KC = 512, C1_VC = 640, C1_KS = 768, C1_VS = 896, C1_KW = 1024, C1_VW = 1152, C1_GQ = 1280, C1_GK = 1536, C1_GV = 1792, C1_GR = 2304, C1_GL = 2816, C1_GLOW = 2840;

constexpr size_t MiB = 1u << 20;
constexpr size_t WS_CTL = 0;
constexpr size_t WS_ROPE = 1 * MiB;
constexpr size_t WS_W_IN0 = 2 * MiB;
constexpr size_t WS_W_GLU = 6 * MiB;
constexpr size_t WS_SK0 = 6 * MiB + 512 * 1024;
constexpr size_t WS_W_OUT0 = 7 * MiB;
constexpr size_t WS_WQ0 = 9 * MiB;
constexpr size_t WS_W_IN1 = 13 * MiB;
constexpr size_t WS_KW1 = 19 * MiB;
constexpr size_t WS_VW1 = 20 * MiB;
constexpr size_t WS_KW2 = 21 * MiB;
constexpr size_t WS_VW2 = 21 * MiB + 128 * 1024;
constexpr size_t WS_SK1 = 21 * MiB + 512 * 1024;
constexpr size_t WS_W_OUT1 = 22 * MiB;
constexpr size_t WS_WQ1 = 24 * MiB;
constexpr size_t WS_S5B1 = 28 * MiB;
constexpr size_t WS_S5B2 = 32 * MiB;
constexpr size_t WS_CMPB = 38 * MiB;
constexpr size_t WS_TABU = 48 * MiB;
constexpr size_t WS_TABV = 80 * MiB;
constexpr size_t WS_XN = 112 * MiB;
constexpr size_t WS_PROJ = 176 * MiB;
constexpr size_t WS_R3 = 368 * MiB;
constexpr size_t WS_END = 506 * MiB;

__device__ __forceinline__ unsigned f2bf(float f) { unsigned u = __builtin_bit_cast(unsigned, f); return (u + 0x7fffu + ((u >> 16) & 1u)) >> 16; }
__device__ __forceinline__ unsigned pk2(float lo, float hi) { return f2bf(lo) | (f2bf(hi) << 16); }
__device__ __forceinline__ float bf_lo(unsigned u) { return __builtin_bit_cast(float, u << 16); }
__device__ __forceinline__ float bf_hi(unsigned u) { return __builtin_bit_cast(float, u & 0xffff0000u); }
__device__ __forceinline__ float bf2f(bf16_t b) { return __builtin_bit_cast(float, ((unsigned)b) << 16); }
__device__ __forceinline__ float wave_sum(float v) {
#pragma unroll
    for (int o = 1; o < 64; o <<= 1) v += __shfl_xor(v, o);
    return v;
}
__device__ __forceinline__ float gelu_tanh(float x) {
    const float y = 0.7978845608028654f * (x + 0.044715f * x * x * x);
    const float e = __expf(2.0f * y);
    const float th = 1.0f - 2.0f / (e + 1.0f);
    return 0.5f * x * (1.0f + th);
}
__device__ __forceinline__ float sigmoidf_(float x) { return 1.0f / (1.0f + __expf(-x)); }
#define LDS_WAIT() asm volatile("s_waitcnt lgkmcnt(0)" ::: "memory")
#define VM_WAIT() asm volatile("s_waitcnt vmcnt(0)" ::: "memory")

#define XB_TMO      128
#define XB_XCNT(j)  (256  + 64 * (j))
#define XB_XSUB(j)  (1280 + 64 * (j))
#define XB_XGEN(j)  (2304 + 64 * (j))
#define XB_TOP      3328
#define XB_TOPGEN   3392
#define XCD_BAR_WORDS 3456
#define XB_SPIN_CAP (1u << 22)
__device__ __forceinline__ unsigned xb_ld(unsigned* p)              { return __hip_atomic_load(p, __ATOMIC_RELAXED, __HIP_MEMORY_SCOPE_AGENT); }
__device__ __forceinline__ unsigned xb_add(unsigned* p, unsigned v) { return __hip_atomic_fetch_add(p, v, __ATOMIC_RELAXED, __HIP_MEMORY_SCOPE_AGENT); }
__device__ __forceinline__ unsigned xb_xcc_id() { return (unsigned)__builtin_amdgcn_s_getreg((3 << 11) | 20) & 0xFu; }
#define XB_SPIN(cond, bar) do { unsigned _sp = 0; while (cond) { __builtin_amdgcn_s_sleep(1); \
    if ((++_sp & 255u) == 0u) { if (xb_ld(&(bar)[XB_TMO])) break; if (_sp > XB_SPIN_CAP) { atomicAdd(&(bar)[XB_TMO], 1u); break; } } } } while (0)
struct XcdBarrier { unsigned* bar; unsigned x; volatile LAS unsigned* st; };
__device__ __forceinline__ XcdBarrier xcd_barrier_post(unsigned* bar, volatile LAS unsigned* st) {
    XcdBarrier b; b.bar = bar; b.x = xb_xcc_id(); b.st = st;
    if (threadIdx.x == 0) (void)xb_add(&bar[XB_XCNT(b.x)], 1u);
    return b;
}
__device__ __forceinline__ void xcd_barrier_complete(unsigned* bar, unsigned x, unsigned& nloc, unsigned& nx) {
    const unsigned G = gridDim.x * gridDim.y * gridDim.z;
    unsigned sum, cnt, mine, sp = 0u;
    for (;;) {
        sum = 0u; cnt = 0u; mine = 0u;
#pragma unroll
        for (unsigned j = 0; j < 16; ++j) { const unsigned c = xb_ld(&bar[XB_XCNT(j)]); sum += c; cnt += (c > 0u) ? 1u : 0u; mine = (j == x) ? c : mine; }
        if (sum == G) break;
        __builtin_amdgcn_s_sleep(1);
        if ((++sp & 255u) == 0u) { if (xb_ld(&bar[XB_TMO])) break; if (sp > XB_SPIN_CAP) { atomicAdd(&bar[XB_TMO], 1u); break; } }
    }
    nloc = mine > 0u ? mine : 1u; nx = cnt > 0u ? cnt : 1u;
}
__device__ __forceinline__ void xcd_barrier(const XcdBarrier& b) {
    asm volatile("s_waitcnt vmcnt(0)" ::: "memory");
    __syncthreads();
    if (threadIdx.x == 0) {
        unsigned* bar = b.bar;
        __builtin_amdgcn_s_waitcnt(0);
        unsigned nloc = b.st[0], nx = b.st[1];
        if (nloc == 0u) { xcd_barrier_complete(bar, b.x, nloc, nx); b.st[0] = nloc; b.st[1] = nx; }
        const unsigned old = xb_add(&bar[XB_XSUB(b.x)], 1u);
        const unsigned gen = old / nloc;
        if (old + 1u == (gen + 1u) * nloc) {
            __builtin_amdgcn_fence(__ATOMIC_RELEASE, "agent");
            asm volatile("s_waitcnt vmcnt(0)" ::: "memory");
            const unsigned og = xb_add(&bar[XB_TOP], 1u);
            const unsigned tg = og / nx;
            if (og + 1u == (tg + 1u) * nx) xb_add(&bar[XB_TOPGEN], 1u);
            else XB_SPIN(xb_ld(&bar[XB_TOPGEN]) == tg, bar);
            __builtin_amdgcn_fence(__ATOMIC_ACQUIRE, "agent");
            xb_add(&bar[XB_XGEN(b.x)], 1u);
            asm volatile("s_waitcnt vmcnt(0)" ::: "memory");
        } else {
            XB_SPIN(xb_ld(&bar[XB_XGEN(b.x)]) == gen, bar);
            __builtin_amdgcn_fence(__ATOMIC_ACQUIRE, "agent");
            asm volatile("s_waitcnt vmcnt(0)" ::: "memory");
        }
    }
    __syncthreads();
}

namespace pg8 {
constexpr int BM = 256, BK = 64, HALF = 128, HTB = HALF * BK * 2, STAGE_BYTES = 8 * HTB, NXCD = 8, WGM = 8;
__device__ __forceinline__ int lds_byte(int r, int c) { const int st = (r >> 4) * 2 + (c >> 5), rr = r & 15, cc = c & 31, ob = rr * 64 + cc * 2; return st * 1024 + (ob ^ (((ob >> 9) & 1) << 5)); }
__device__ __forceinline__ void stage_rc(int b, int& R, int& C) { const int st = b / 1024, sb = b % 1024, swz = sb ^ (((sb >> 9) & 1) << 5); R = (st >> 1) * 16 + swz / 64; C = (st & 1) * 32 + (swz % 64) / 2; }
__device__ __forceinline__ int perm32(int rho) { const int n = rho >> 4, i = rho & 15; return 8 * (i >> 2) + 4 * n + (i & 3); }
struct Unit { int pm, pn; };
struct Gemm { const bf16_t* A; const bf16_t* Bt; int M, N, K, lda, ldb; };
struct StaticOrder {
    int nM, nN, nwg, G, c;
    __device__ void init(int M, int N, int G_, int c_) { nM = M / BM; nN = N / BM; nwg = nM * nN; G = G_; c = c_; }
    __device__ bool next(int i, Unit& u) const {
        const long L = (long)i * G + c; if (L >= nwg) return false;
        int wgid = (int)L; { const int q = nwg / NXCD, r = nwg % NXCD, xcd = wgid % NXCD, off = wgid / NXCD; wgid = (xcd < r ? xcd * (q + 1) : r * (q + 1) + (xcd - r) * q) + off; }
        const int nig = WGM * nN, gid = wgid / nig, fm = gid * WGM, gsz = (nM - fm) < WGM ? (nM - fm) : WGM;
        u.pm = fm + ((wgid % nig) % gsz); u.pn = (wgid % nig) / gsz; return true;
    }
};
struct GroupedOrder {
    int nwg, G, c, tpg;
    __device__ void init(int ntiles, int tiles_per_group, int G_, int c_) { nwg = ntiles; tpg = tiles_per_group; G = G_; c = c_; }
    __device__ bool next(int i, Unit& u) const { const long L = (long)i * G + c; if (L >= nwg) return false; u.pm = (int)L; u.pn = (int)L / tpg; return true; }
};
__device__ __forceinline__ unsigned cvt_pk_bf16(float lo, float hi) { unsigned r; asm volatile("v_cvt_pk_bf16_f32 %0, %1, %2" : "=v"(r) : "v"(lo), "v"(hi)); return r; }

template <class Epi, class Sched>
__device__ __forceinline__ void gemm_phase(LAS unsigned char* lds, const Gemm g, const Sched& S, const Epi& E) {
    const int tid = threadIdx.x, wid = __builtin_amdgcn_readfirstlane(tid >> 6), lane = tid & 63, wr = wid >> 2, wc = wid & 3, fr = lane & 15, fq = lane >> 4;
    int K = g.K; asm volatile("" : "+s"(K));
    const int nt = K / BK;
    unsigned voffA[2], voffB[2];
#pragma unroll
    for (int i = 0; i < 2; ++i) { int R, C; stage_rc(tid * 16 + i * 8192, R, C); const int Rb = Epi::PERM ? ((R & ~31) + perm32(R & 31)) : R;
        voffA[i] = (unsigned)(R * g.lda + C) * 2u; voffB[i] = (unsigned)(Rb * g.ldb + C) * 2u; }
    const size_t kstep = (size_t)(BK * 2);
    const size_t hstepA = (size_t)HALF * g.lda * 2, hstepB = (size_t)HALF * g.ldb * 2;
    const size_t tstepA = 2 * hstepA, tstepB = 2 * hstepB;
    const unsigned ldsw = (unsigned)wid * 1024u;
    const int aoff = lds_byte(wr * 64 + fr, fq * 8), boff = lds_byte(wc * 32 + fr, fq * 8);
#define PG8_SA(b, h) (((b) * 2 + (h)) * HTB)
#define PG8_SB(b, h) ((4 + (b) * 2 + (h)) * HTB)
#define PG8_STAGE(bufoff, gbase, voff) do { _Pragma("unroll") for (int _i = 0; _i < 2; ++_i) \
        __builtin_amdgcn_global_load_lds((const unsigned*)((const char*)(gbase) + (voff)[_i]), (LAS unsigned*)(lds + (bufoff) + ldsw + _i * 8192), 16, 0, 0); } while (0)
#define PG8_LDA(dst, b, h) do { _Pragma("unroll") for (int m = 0; m < 4; ++m) _Pragma("unroll") for (int k = 0; k < 2; ++k) dst[m][k] = *(const LAS bf16x8*)(lds + PG8_SA(b, h) + aoff + m * 2048 + k * 1024); } while (0)
#define PG8_LDB(dst, b, h) do { _Pragma("unroll") for (int n = 0; n < 2; ++n) _Pragma("unroll") for (int k = 0; k < 2; ++k) dst[n][k] = *(const LAS bf16x8*)(lds + PG8_SB(b, h) + boff + n * 2048 + k * 1024); } while (0)
#define PG8_MMA(ai, bj, At, Bt) do { __builtin_amdgcn_s_setprio(1); _Pragma("unroll") for (int m = 0; m < 4; ++m) _Pragma("unroll") for (int n = 0; n < 2; ++n) _Pragma("unroll") for (int k = 0; k < 2; ++k) \
        acc[ai][bj][m][n] = __builtin_amdgcn_mfma_f32_16x16x32_bf16(Bt[n][k], At[m][k], acc[ai][bj][m][n], 0, 0, 0); __builtin_amdgcn_s_setprio(0); } while (0)
#define PG8_WAIT_V(n) asm volatile("s_waitcnt vmcnt(" #n ")" ::: "memory")
#define PG8_WAIT_L(n) asm volatile("s_waitcnt lgkmcnt(" #n ")" ::: "memory")
#define PG8_BAR __builtin_amdgcn_s_barrier()
#define PG8_SCHED __builtin_amdgcn_sched_barrier(0)
    Unit cur, nxt; int ui = 0;
    if (!S.next(0, cur)) return;
    f32x4 acc[2][2][4][2];
#pragma unroll
    for (int a = 0; a < 2; ++a)
#pragma unroll
        for (int b = 0; b < 2; ++b)
#pragma unroll
            for (int m = 0; m < 4; ++m)
#pragma unroll
                for (int n = 0; n < 2; ++n) acc[a][b][m][n] = (f32x4){0.f, 0.f, 0.f, 0.f};
    bf16x8 At[4][2], B0[2][2], B1[2][2];
    const char* cA = (const char*)g.A + (size_t)cur.pm * tstepA; const char* cB = (const char*)g.Bt + (size_t)cur.pn * tstepB;
    PG8_STAGE(PG8_SB(0, 0), cB, voffB); PG8_STAGE(PG8_SA(0, 0), cA, voffA); PG8_STAGE(PG8_SB(0, 1), cB + hstepB, voffB); PG8_STAGE(PG8_SA(0, 1), cA + hstepA, voffA);
    if (wr == 1) PG8_BAR;
    PG8_WAIT_V(4); PG8_BAR;
    PG8_STAGE(PG8_SB(1, 0), cB + kstep, voffB); PG8_STAGE(PG8_SA(1, 0), cA + kstep, voffA); PG8_STAGE(PG8_SB(1, 1), cB + hstepB + kstep, voffB);
    PG8_WAIT_V(6); PG8_BAR;
    for (;;) {
        const bool has_next = S.next(ui + 1, nxt);
        const char* nA = has_next ? (const char*)g.A + (size_t)nxt.pm * tstepA : cA; const char* nB = has_next ? (const char*)g.Bt + (size_t)nxt.pn * tstepB : cB;
        for (int t = 0; t < nt; t += 2) {
            const bool last = (t == nt - 2);
            const char* a1 = cA + (size_t)(t + 1) * kstep;
            const char* a2 = last ? nA : cA + (size_t)(t + 2) * kstep; const char* b2 = last ? nB : cB + (size_t)(t + 2) * kstep;
            const char* a3 = a2 + kstep; const char* b3 = b2 + kstep;
            PG8_LDB(B0, 0, 0); PG8_SCHED; PG8_LDA(At, 0, 0); PG8_STAGE(PG8_SA(1, 1), a1 + hstepA, voffA);
            PG8_WAIT_L(8); PG8_BAR; PG8_WAIT_L(0); PG8_MMA(0, 0, At, B0); PG8_BAR; PG8_SCHED;
            PG8_LDB(B1, 0, 1); PG8_STAGE(PG8_SB(0, 0), b2, voffB);
            PG8_BAR; PG8_WAIT_L(0); PG8_MMA(0, 1, At, B1); PG8_BAR;
            PG8_LDA(At, 0, 1); PG8_STAGE(PG8_SA(0, 0), a2, voffA);
            PG8_BAR; PG8_WAIT_L(0); PG8_MMA(1, 0, At, B0); PG8_BAR; PG8_SCHED;
            PG8_STAGE(PG8_SB(0, 1), b2 + hstepB, voffB);
            PG8_WAIT_V(6); PG8_BAR; PG8_MMA(1, 1, At, B1); PG8_BAR;
            PG8_LDB(B0, 1, 0); PG8_SCHED; PG8_LDA(At, 1, 0); PG8_STAGE(PG8_SA(0, 1), a2 + hstepA, voffA);
            PG8_WAIT_L(8); PG8_BAR; PG8_WAIT_L(0); PG8_MMA(0, 0, At, B0); PG8_BAR; PG8_SCHED;
            PG8_LDB(B1, 1, 1); PG8_STAGE(PG8_SB(1, 0), b3, voffB);
            PG8_BAR; PG8_WAIT_L(0); PG8_MMA(0, 1, At, B1); PG8_BAR;
            PG8_LDA(At, 1, 1); PG8_STAGE(PG8_SA(1, 0), a3, voffA);
            PG8_BAR; PG8_WAIT_L(0); PG8_MMA(1, 0, At, B0); PG8_BAR; PG8_SCHED;
            PG8_STAGE(PG8_SB(1, 1), b3 + hstepB, voffB);
            PG8_WAIT_V(6); PG8_BAR; PG8_MMA(1, 1, At, B1); PG8_BAR;
        }
        E(acc, cur, wr, wc, fr, fq);
        if (!has_next) break;
#pragma unroll
        for (int a = 0; a < 2; ++a)
#pragma unroll
            for (int b = 0; b < 2; ++b)
#pragma unroll
                for (int m = 0; m < 4; ++m)
#pragma unroll
                    for (int n = 0; n < 2; ++n) acc[a][b][m][n] = (f32x4){0.f, 0.f, 0.f, 0.f};
        cur = nxt; cA = nA; cB = nB; ++ui;
    }
    PG8_WAIT_V(0);
    if (wr == 0) PG8_BAR;
    PG8_BAR;
#undef PG8_SA
#undef PG8_SB
#undef PG8_STAGE
#undef PG8_LDA
#undef PG8_LDB
#undef PG8_MMA
#undef PG8_WAIT_V
#undef PG8_WAIT_L
#undef PG8_BAR
#undef PG8_SCHED
}

struct EpiStoreBf16 {
    static constexpr bool PERM = true;
    bf16_t* O; int ldc;
    __device__ __forceinline__ void operator()(const f32x4 (&acc)[2][2][4][2], const Unit& u, int wr, int wc, int fr, int fq) const {
        const int row0 = u.pm * BM + wr * 64 + fr, col0 = u.pn * BM + wc * 32 + 8 * fq;
#pragma unroll
        for (int ai = 0; ai < 2; ++ai)
#pragma unroll
            for (int m = 0; m < 4; ++m) { bf16_t* rowp = O + (size_t)(row0 + ai * HALF + m * 16) * ldc + col0;
#pragma unroll
                for (int bj = 0; bj < 2; ++bj) { const f32x4 v0 = acc[ai][bj][m][0], v1 = acc[ai][bj][m][1];
                    u32x4 w; w.x = cvt_pk_bf16(v0[0], v0[1]); w.y = cvt_pk_bf16(v0[2], v0[3]); w.z = cvt_pk_bf16(v1[0], v1[1]); w.w = cvt_pk_bf16(v1[2], v1[3]);
                    *(u32x4*)(rowp + bj * HALF) = w; } }
    }
};
struct EpiResidF32 {
    static constexpr bool PERM = false;
    const float* R; float* C; int ldc;
    __device__ __forceinline__ void operator()(const f32x4 (&acc)[2][2][4][2], const Unit& u, int wr, int wc, int fr, int fq) const {
        const int row0 = u.pm * BM + wr * 64 + fr, col0 = u.pn * BM + wc * 32 + 4 * fq;
#pragma unroll
        for (int ai = 0; ai < 2; ++ai)
#pragma unroll
            for (int m = 0; m < 4; ++m) { const size_t off = (size_t)(row0 + ai * HALF + m * 16) * ldc + col0;
#pragma unroll
                for (int bj = 0; bj < 2; ++bj)
#pragma unroll
                    for (int n = 0; n < 2; ++n) { const f32x4 r = *(const f32x4*)(R + off + bj * HALF + n * 16); *(f32x4*)(C + off + bj * HALF + n * 16) = r + acc[ai][bj][m][n]; } }
    }
};
}

struct Args {
    const float* in[39];
    float* out;
    unsigned char* ws;
    int ph_lo, ph_hi;
};
enum { I_X = 0, I_L0_MIXN, I_L0_WIN, I_L0_QG, I_L0_KG, I_L0_LOGDT, I_L0_ARE, I_L0_AIM, I_L0_BRE, I_L0_BIM, I_L0_CRE, I_L0_CIM, I_L0_D, I_L0_WGLU, I_L0_BGLU, I_L0_WOUT,
       I_L0_FFNN, I_L0_WQ, I_L0_SK, I_L0_U, I_L0_V,
       I_L1_MIXN, I_L1_WIN, I_L1_QG, I_L1_KG, I_L1_CMPPOS, I_L1_KW1, I_L1_KW2, I_L1_VW1, I_L1_VW2, I_L1_WGATE, I_L1_BGATE, I_L1_OGAIN, I_L1_WOUT,
       I_L1_FFNN, I_L1_WQ, I_L1_SK, I_L1_U, I_L1_V };

struct Frame {
    LAS unsigned char* lds;
    int tid, lane, wave, G, bid;
};

constexpr size_t L0_QA = WS_R3;
constexpr size_t L0_IQ = WS_R3 + 32 * MiB;
constexpr size_t L0_KA = WS_R3 + 64 * MiB;
constexpr size_t L0_VAT = WS_R3 + 72 * MiB;
constexpr size_t L0_IK = WS_R3 + 80 * MiB;
constexpr size_t L0_IW = WS_R3 + 84 * MiB;
constexpr size_t L0_UA = WS_R3 + 88 * MiB;
constexpr size_t L0_SELT = WS_PROJ;
constexpr size_t L0_CAT = WS_PROJ + 16 * MiB;
constexpr size_t L0_SLOC = WS_PROJ + 80 * MiB;
constexpr size_t L0_YB = WS_PROJ + 112 * MiB;
constexpr size_t PE_Q2 = WS_PROJ;
constexpr size_t PE_EID = WS_PROJ + 128 * MiB;
constexpr size_t PE_GATE = WS_PROJ + 136 * MiB;

template <class Map>
__device__ __forceinline__ void transpose_item(const float* W, int K, int N, bf16_t* WT, int ldk, LAS float* scr, int item, int lane, const Map& map) {
    const int nblk = (N + 31) / 32, kb = item / nblk, nb = item % nblk, k0 = 64 * kb, n0 = 32 * nb;
    const int ncol = n0 + (lane & 31);
#pragma unroll 8
    for (int i = 0; i < 32; ++i) { const int kk = 2 * i + (lane >> 5); scr[kk * 33 + (lane & 31)] = (ncol < N) ? W[(size_t)(k0 + kk) * N + ncol] : 0.f; }
    LDS_WAIT(); asm volatile("" ::: "memory");
    const int c = lane & 7;
#pragma unroll
    for (int j = 0; j < 4; ++j) { const int n = (lane >> 3) + 8 * j; const LAS float* s = scr + (8 * c) * 33 + n;
        u32x4 o; o.x = pk2(s[0 * 33], s[1 * 33]); o.y = pk2(s[2 * 33], s[3 * 33]); o.z = pk2(s[4 * 33], s[5 * 33]); o.w = pk2(s[6 * 33], s[7 * 33]);
        if (n0 + n < N) *(u32x4*)(WT + (size_t)map(n0 + n) * ldk + k0 + 8 * c) = o; }
    LDS_WAIT(); asm volatile("" ::: "memory");
}
struct MapId { __device__ __forceinline__ int operator()(int n) const { return n; } };
struct MapIn0 { __device__ __forceinline__ int operator()(int n) const { return n < 1280 ? n : (n < 1344 ? n - 1280 + C0_IK : (n < 1352 ? n - 1344 + C0_IW : n - 1352 + C0_U)); } };
struct MapIn1 { __device__ __forceinline__ int operator()(int n) const {
    if (n < 1280) return n; if (n < 1304) return n - 1280 + C1_GL; if (n < 1560) return n - 1304 + C1_GQ; if (n < 1816) return n - 1560 + C1_GK;
    if (n < 2328) return n - 1816 + C1_GV; if (n < 2344) return n - 2328 + C1_GLOW; return n - 2344 + C1_GR; } };

template <class Map>
__device__ __forceinline__ void transpose_all(const Frame& F, int& base, const float* W, int K, int N, bf16_t* WT, int ldk, const Map& map) {
    LAS float* scr = (LAS float*)(F.lds + F.wave * 16384);
    const int gw = F.bid * NWAVES + F.wave, NGW = F.G * NWAVES;
    const int nit = (K / 64) * ((N + 31) / 32);
    for (int it = (gw + NGW - (base % NGW)) % NGW; it < nit; it += NGW) transpose_item(W, K, N, WT, ldk, scr, it, F.lane, map);
    base += nit;
}
__device__ __forceinline__ void zero_bytes(const Frame& F, unsigned char* p, size_t nbytes) {
    const size_t n16 = nbytes / 16;
    for (size_t i = (size_t)F.bid * NTHREADS + F.tid; i < n16; i += (size_t)F.G * NTHREADS) ((u32x4*)p)[i] = (u32x4){0u, 0u, 0u, 0u};
}
__device__ __forceinline__ void cvt_f32_bf16(const Frame& F, const float* src, bf16_t* dst, size_t n) {
    const size_t n8 = n / 8;
    for (size_t i = (size_t)F.bid * NTHREADS + F.tid; i < n8; i += (size_t)F.G * NTHREADS) {
        const f32x4 a = ((const f32x4*)src)[2 * i], b = ((const f32x4*)src)[2 * i + 1];
        u32x4 o; o.x = pk2(a.x, a.y); o.y = pk2(a.z, a.w); o.z = pk2(b.x, b.y); o.w = pk2(b.z, b.w);
        ((u32x4*)dst)[i] = o;
    }
}

__device__ __forceinline__ void rms_row_to_bf16(const float* xrow, const float* gain, bf16_t* orow, int lane) {
    const f32x4* xr = (const f32x4*)xrow + lane; const f32x4* gr = (const f32x4*)gain + lane;
    f32x4 v[4]; float s = 0.f;
#pragma unroll
    for (int j = 0; j < 4; ++j) { v[j] = xr[64 * j]; s += (v[j].x * v[j].x + v[j].y * v[j].y) + (v[j].z * v[j].z + v[j].w * v[j].w); }
    const float rstd = 1.0f / sqrtf(wave_sum(s) * (1.f / DM) + 1e-6f);
    u64* o8 = (u64*)orow + lane;
#pragma unroll
    for (int j = 0; j < 4; ++j) { const f32x4 g4 = gr[64 * j]; o8[64 * j] = (u64)pk2(v[j].x * rstd * g4.x, v[j].y * rstd * g4.y) | ((u64)pk2(v[j].z * rstd * g4.z, v[j].w * rstd * g4.w) << 32); }
}
__device__ __forceinline__ void p_rmsnorm(const Frame& F, const float* x, const float* gain, bf16_t* XN) {
    const int gw = F.bid * NWAVES + F.wave, NGW = F.G * NWAVES;
    for (int m = gw; m < T; m += NGW) rms_row_to_bf16(x + (size_t)m * DM, gain, XN + (size_t)m * DM, F.lane);
}

__device__ __forceinline__ void p_rope_table(const Frame& F, f32x2* rope) {
    for (int i = F.bid * NTHREADS + F.tid; i < SEQ * 32; i += F.G * NTHREADS) {
        const int pos = i >> 5, k = i & 31;
        const float inv = powf(10000.0f, -(float)k / 32.0f);
        const float ang = (float)pos * inv;
        float s, c; sincosf(ang, &s, &c);
        rope[i] = (f32x2){c, s};
    }
}

__device__ __forceinline__ void s5_build_group(const Frame& F, const Args& a, unsigned char* ws, int g) {
    LAS f32x2* abp = (LAS f32x2*)F.lds;
    LAS f32x2* bb = abp + 17 * 64;
    LAS f32x2* Cc = bb + 64 * 16;
    LAS float* KT = (LAS float*)(Cc + 16 * 64);
    const float dt = expf(a.in[I_L0_LOGDT][g]);
    for (int idx = F.tid; idx < 17 * 64; idx += NTHREADS) {
        const int tau = idx >> 6, p = idx & 63;
        const float lr = a.in[I_L0_ARE][g * 64 + p], li = a.in[I_L0_AIM][g * 64 + p];
        const float mag = expf((float)tau * dt * lr); float s, c; sincosf((float)tau * dt * li, &s, &c);
        abp[idx] = (f32x2){mag * c, mag * s};
    }
    for (int idx = F.tid; idx < 64 * 16; idx += NTHREADS) {
        const int p = idx >> 4, c = idx & 15;
        const float lr = a.in[I_L0_ARE][g * 64 + p], li = a.in[I_L0_AIM][g * 64 + p];
        const float mag = expf(dt * lr); float s, co; sincosf(dt * li, &s, &co);
        const float abr = mag * co, abi = mag * s, den = lr * lr + li * li;
        const float fr = ((abr - 1.0f) * lr + abi * li) / den, fi = (abi * lr - (abr - 1.0f) * li) / den;
        const float br = a.in[I_L0_BRE][(size_t)(g * 64 + p) * 16 + c], bi = a.in[I_L0_BIM][(size_t)(g * 64 + p) * 16 + c];
        bb[idx] = (f32x2){fr * br - fi * bi, fr * bi + fi * br};
    }
    for (int idx = F.tid; idx < 16 * 64; idx += NTHREADS) Cc[idx] = (f32x2){a.in[I_L0_CRE][(size_t)g * 1024 + idx], a.in[I_L0_CIM][(size_t)g * 1024 + idx]};
    __syncthreads();
    for (int idx = F.tid; idx < 16 * 256; idx += NTHREADS) {
        const int tau = idx >> 8, co = (idx >> 4) & 15, ci = idx & 15;
        float acc = 0.f;
        for (int p = 0; p < 64; ++p) {
            const f32x2 c = Cc[co * 64 + p], e = abp[tau * 64 + p], b = bb[p * 16 + ci];
            const float er = c.x * e.x - c.y * e.y, ei = c.x * e.y + c.y * e.x;
            acc += er * b.x - ei * b.y;
        }
        if (tau == 0 && co == ci) acc += a.in[I_L0_D][g * 16 + co];
        KT[idx] = acc;
    }
    __syncthreads();
    bf16_t* B1 = (bf16_t*)(ws + WS_S5B1) + (size_t)g * 256 * 256;
    bf16_t* B2 = (bf16_t*)(ws + WS_S5B2) + (size_t)g * 256 * 384;
    for (int idx = F.tid; idx < 256 * 128; idx += NTHREADS) {
        const int n = idx >> 7, k = (idx & 127) * 2;
        float v0 = 0.f, v1 = 0.f;
        if (n < 128) { const int p = n & 63, j = k >> 4, ci = k & 15; const f32x2 e = abp[(15 - j) * 64 + p], b0 = bb[p * 16 + ci], b1 = bb[p * 16 + ci + 1];
            if (n < 64) { v0 = e.x * b0.x - e.y * b0.y; v1 = e.x * b1.x - e.y * b1.y; } else { v0 = e.x * b0.y + e.y * b0.x; v1 = e.x * b1.y + e.y * b1.x; } }
        *(unsigned*)(B1 + (size_t)n * 256 + k) = pk2(v0, v1);
    }
    for (int idx = F.tid; idx < 256 * 192; idx += NTHREADS) {
        const int n = idx / 192, k = (idx % 192) * 2, i = n >> 4, co = n & 15;
        float v0 = 0.f, v1 = 0.f;
        if (k < 256) { const int j = k >> 4, ci = k & 15; if (j <= i) { v0 = KT[((i - j) * 16 + co) * 16 + ci]; v1 = KT[((i - j) * 16 + co) * 16 + ci + 1]; } }
        else { const int p = (k - 256) & 63; const bool im = k >= 320;
            const f32x2 c0 = Cc[co * 64 + p], e0 = abp[(i + 1) * 64 + p], c1 = Cc[co * 64 + p + 1], e1 = abp[(i + 1) * 64 + p + 1];
            if (!im) { v0 = c0.x * e0.x - c0.y * e0.y; v1 = c1.x * e1.x - c1.y * e1.y; } else { v0 = -(c0.x * e0.y + c0.y * e0.x); v1 = -(c1.x * e1.y + c1.y * e1.x); } }
        *(unsigned*)(B2 + (size_t)n * 384 + k) = pk2(v0, v1);
    }
    __syncthreads();
}

__device__ __forceinline__ void cmp_bias(const Frame& F, const Args& a, float* out, int j) {
    const int w = j >> 5, n0 = (j & 31) * 8;
    const float* w1 = a.in[w ? I_L1_VW1 : I_L1_KW1]; const float* pos = a.in[I_L1_CMPPOS];
    LAS float* red = (LAS float*)(F.lds + 65536);
    float acc[8];
#pragma unroll
    for (int i = 0; i < 8; ++i) acc[i] = 0.f;
#pragma unroll
    for (int kk = 0; kk < 4; ++kk) { const int k = F.tid * 4 + kk; const float p = pos[k];
        const f32x4 wa = *(const f32x4*)(w1 + (size_t)k * 256 + n0), wb = *(const f32x4*)(w1 + (size_t)k * 256 + n0 + 4);
        acc[0] += p * wa.x; acc[1] += p * wa.y; acc[2] += p * wa.z; acc[3] += p * wa.w; acc[4] += p * wb.x; acc[5] += p * wb.y; acc[6] += p * wb.z; acc[7] += p * wb.w; }
#pragma unroll
    for (int i = 0; i < 8; ++i) { const float sv = wave_sum(acc[i]); if (F.lane == 0) red[F.wave * 8 + i] = sv; }
    __syncthreads();
    if (F.tid < 8) { float t = 0.f; for (int wv = 0; wv < 8; ++wv) t += red[wv * 8 + F.tid]; out[w * 256 + n0 + F.tid] = t; }
    __syncthreads();
}

__device__ __forceinline__ float rope_apply(float v, const f32x2 cs, int lane) {
    const float partner = __shfl_xor(v, 32);
    return lane < 32 ? v * cs.x - partner * cs.y : partner * cs.y + v * cs.x;
}
__device__ __forceinline__ void head8_load(const bf16_t* p, float (&v)[8]) {
    const u32x4 q = *(const u32x4*)p;
    v[0] = bf_lo(q.x); v[1] = bf_hi(q.x); v[2] = bf_lo(q.y); v[3] = bf_hi(q.y); v[4] = bf_lo(q.z); v[5] = bf_hi(q.z); v[6] = bf_lo(q.w); v[7] = bf_hi(q.w);
}
__device__ __forceinline__ void head8_store(bf16_t* p, const float (&v)[8], const float sc) {
    u32x4 q; q.x = pk2(v[0] * sc, v[1] * sc); q.y = pk2(v[2] * sc, v[3] * sc); q.z = pk2(v[4] * sc, v[5] * sc); q.w = pk2(v[6] * sc, v[7] * sc);
    *(u32x4*)p = q;
}
__device__ __forceinline__ void head8_norm(float (&v)[8], const float (&g)[8]) {
    float ss = 0.f;
#pragma unroll
    for (int j = 0; j < 8; ++j) ss += v[j] * v[j];
    ss += __shfl_xor(ss, 1); ss += __shfl_xor(ss, 2); ss += __shfl_xor(ss, 4);
    const float r = 1.0f / sqrtf(ss * (1.f / 64.f) + 1e-6f);
#pragma unroll
    for (int j = 0; j < 8; ++j) v[j] = v[j] * r * g[j];
}
__device__ __forceinline__ void head8_rope(float (&v)[8], const f32x2 (&cs)[8], const bool upper) {
#pragma unroll
    for (int j = 0; j < 8; ++j) { const float partner = __shfl_xor(v[j], 4); v[j] = upper ? partner * cs[j].y + v[j] * cs[j].x : v[j] * cs[j].x - partner * cs[j].y; }
}
__device__ __forceinline__ void p_l0_prep(const Frame& F, const Args& a, unsigned char* ws) {
    const bf16_t* P = (const bf16_t*)(ws + WS_PROJ);
    const f32x2* rope = (const f32x2*)(ws + WS_ROPE);
    bf16_t* QA = (bf16_t*)(ws + L0_QA); bf16_t* IQ = (bf16_t*)(ws + L0_IQ); bf16_t* KA = (bf16_t*)(ws + L0_KA); bf16_t* VAT = (bf16_t*)(ws + L0_VAT);
    bf16_t* IK = (bf16_t*)(ws + L0_IK); float* IW = (float*)(ws + L0_IW); bf16_t* UA = (bf16_t*)(ws + L0_UA);
    const int gw = F.bid * NWAVES + F.wave, NGW = F.G * NWAVES, lane = F.lane, hs = lane >> 3, sub = lane & 7;
    float qg[8], kg[8];
#pragma unroll
    for (int j = 0; j < 8; ++j) { qg[j] = a.in[I_L0_QG][sub * 8 + j]; kg[j] = a.in[I_L0_KG][sub * 8 + j]; }
    for (int m = gw; m < T; m += NGW) {
        const int b = m >> 12, t = m & 4095;
        const bf16_t* row = P + (size_t)m * N_IN0;
        f32x2 cs[8];
#pragma unroll
        for (int j = 0; j < 4; ++j) { const f32x4 c4 = *(const f32x4*)(rope + t * 32 + (sub & 3) * 8 + 2 * j); cs[2 * j] = (f32x2){c4.x, c4.y}; cs[2 * j + 1] = (f32x2){c4.z, c4.w}; }
        float v[8];
        head8_load(row + C0_Q + lane * 8, v); head8_norm(v, qg); head8_rope(v, cs, sub >= 4); head8_store(QA + (size_t)m * 512 + lane * 8, v, 0.125f);
        head8_load(row + C0_IQ + lane * 8, v); head8_rope(v, cs, sub >= 4); head8_store(IQ + (size_t)m * 512 + lane * 8, v, 0.125f);
        {
            const int hh = hs < 3 ? hs : 2;
            head8_load(row + (hh < 2 ? C0_K + hh * 64 : C0_IK) + sub * 8, v);
            float vn[8];
#pragma unroll
            for (int j = 0; j < 8; ++j) vn[j] = v[j];
            head8_norm(vn, kg);
#pragma unroll
            for (int j = 0; j < 8; ++j) v[j] = (hh < 2) ? vn[j] : v[j];
            head8_rope(v, cs, sub >= 4);
            if (hs < 2) head8_store(KA + ((size_t)(b * 2 + hs) * 4096 + t) * 64 + sub * 8, v, 1.0f);
            else if (hs == 2) head8_store(IK + (size_t)m * 64 + sub * 8, v, 1.0f);
        }
        if (lane < 8) IW[(size_t)m * 8 + lane] = bf2f(row[C0_IW + lane]) * 0.35355339059327373f;
        { const u32x4 uv = *(const u32x4*)(row + C0_U + lane * 8); const int g = lane >> 1;
          *(u32x4*)(UA + ((size_t)g * 2048 + (m >> 4)) * 384 + (m & 15) * 16 + (lane & 1) * 8) = uv; }
    }
    for (int it = gw; it < NB * 2 * 64; it += NGW) {
        const int tb = it & 63, g = (it >> 6) & 1, b = it >> 7;
        const size_t m = (size_t)b * 4096 + tb * 64 + lane;
        unsigned r[32];
#pragma unroll
        for (int j = 0; j < 8; ++j) { const u32x4 q = *(const u32x4*)(P + m * N_IN0 + C0_V + g * 64 + j * 8); r[4 * j] = q.x; r[4 * j + 1] = q.y; r[4 * j + 2] = q.z; r[4 * j + 3] = q.w; }
        bf16_t* dst = VAT + ((size_t)(b * 2 + g) * 64) * 4096 + tb * 64 + lane;
#pragma unroll
        for (int d = 0; d < 64; ++d) dst[(size_t)d * 4096] = (bf16_t)((d & 1) ? (r[d >> 1] >> 16) : (r[d >> 1] & 0xffffu));
    }
}

__device__ __forceinline__ unsigned f16key(unsigned raw) { return (raw & 0x8000u) ? (~raw & 0xFFFFu) : (raw | 0x8000u); }
template <int NREG>
__device__ __forceinline__ int topk_count_ge(const unsigned (&kk)[NREG], const unsigned cm1pk) {
    unsigned acc = 0u; const unsigned ones = 0x00010001u;
#pragma unroll
    for (int jj = 0; jj < NREG; ++jj) {
        unsigned d;
        asm("v_pk_sub_u16 %0, %1, %2 clamp" : "=v"(d) : "v"(kk[jj]), "v"(cm1pk));
        asm("v_pk_min_u16 %0, %1, %2" : "=v"(d) : "v"(d), "v"(ones));
        asm("v_pk_add_u16 %0, %1, %2" : "=v"(acc) : "v"(acc), "v"(d));
    }
    int c = (int)((acc & 0xffffu) + (acc >> 16));
    c += __builtin_amdgcn_update_dpp(0, c, 0xB1, 0xF, 0xF, true);
    c += __builtin_amdgcn_update_dpp(0, c, 0x4E, 0xF, 0xF, true);
    c += __builtin_amdgcn_update_dpp(0, c, 0x141, 0xF, 0xF, true);
    c += __builtin_amdgcn_update_dpp(0, c, 0x140, 0xF, 0xF, true);
    return __builtin_amdgcn_readlane(c, 0) + __builtin_amdgcn_readlane(c, 16) + __builtin_amdgcn_readlane(c, 32) + __builtin_amdgcn_readlane(c, 48);
}
template <int NREG>
__device__ __forceinline__ u64 topk_query(const LAS unsigned short* scq, const int t, const int lane) {
    unsigned kk[NREG];
#pragma unroll
    for (int jj = 0; jj < NREG; ++jj) {
        const int e0 = (2 * jj) * 64 + lane, e1 = e0 + 64;
        const unsigned r0 = scq[e0], r1 = scq[e1];
        kk[jj] = ((e0 <= t) ? f16key(r0) : 0u) | (((e1 <= t) ? f16key(r1) : 0u) << 16);
        if ((jj & 3) == 3) __builtin_amdgcn_sched_barrier(0);
    }
    unsigned prefix = 0u; bool exact = false;
#pragma unroll 1
    for (int bit = 15; bit >= 0; --bit) {
        const unsigned cand = prefix | (1u << bit), cm1 = cand - 1u;
        const int cnt = topk_count_ge<NREG>(kk, cm1 | (cm1 << 16));
        if (cnt >= 256) prefix = cand;
        if (cnt == 256) { exact = true; break; }
    }
    unsigned mylo = 0u, myhi = 0u;
    if (exact) {
#pragma unroll
        for (int i = 0; i < 2 * NREG; ++i) {
            const unsigned k = (i & 1) ? (kk[i >> 1] >> 16) : (kk[i >> 1] & 0xffffu);
            const u64 w = __ballot(k >= prefix);
            asm("s_nop 4\n\tv_writelane_b32 %0, %2, %4\n\tv_writelane_b32 %1, %3, %4" : "+v"(mylo), "+v"(myhi) : "s"((unsigned)w), "s"((unsigned)(w >> 32)), "n"(i));
        }
    } else {
        const unsigned Tk = prefix;
        const int cgt = (Tk >= 0xFFFFu) ? 0 : topk_count_ge<NREG>(kk, Tk | (Tk << 16));
        const int need = 256 - cgt;
        int run = 0;
#pragma unroll
        for (int i = 0; i < 2 * NREG; ++i) {
            const unsigned k = (i & 1) ? (kk[i >> 1] >> 16) : (kk[i >> 1] & 0xffffu);
            const u64 gt = __ballot(k > Tk); u64 eq = __ballot(k == Tk);
            const int pe = __builtin_popcountll(eq);
            if (run + pe > need) { int kq = need - run; kq = kq < 0 ? 0 : kq;
                const bool keep = ((eq >> lane) & 1ull) && (__builtin_popcountll(eq & ((1ull << lane) - 1ull)) < kq); eq = __ballot(keep); }
            run += pe;
            const u64 w = gt | eq;
            asm("s_nop 4\n\tv_writelane_b32 %0, %2, %4\n\tv_writelane_b32 %1, %3, %4" : "+v"(mylo), "+v"(myhi) : "s"((unsigned)w), "s"((unsigned)(w >> 32)), "n"(i));
        }
    }
    return (u64)mylo | ((u64)myhi << 32);
}
__device__ __forceinline__ void p_dsa_index(const Frame& F, unsigned char* ws, u64* SELT, const int mode) {
    const bf16_t* IQ = (const bf16_t*)(ws + L0_IQ); const bf16_t* IK = (const bf16_t*)(ws + L0_IK); const float* IW = (const float*)(ws + L0_IW);
    LAS _Float16* sc = (LAS _Float16*)F.lds;
    LAS unsigned short* scu = (LAS unsigned short*)F.lds;
    LAS u64* mk = (LAS u64*)(F.lds + 131072);
    LAS float* wl = (LAS float*)(F.lds + 131072 + 8192);
    const int lane = F.lane, wave = F.wave, h = lane >> 5, r = lane & 31;
    const int rq = ((r >> 4) & 1) + 2 * ((r >> 2) & 1), rh = 4 * ((r >> 3) & 1) + (r & 3);
    for (int u = F.bid; u < 2048; u += F.G) {
        const int idx = u & 255, b = u >> 8;
        const int j = (b & 1) ? 255 - idx : idx;
        const int t0 = j * 16; const size_t mb = (size_t)b * 4096;
        if (F.tid < 128) wl[F.tid] = IW[(mb + t0) * 8 + F.tid];
        const int nkb = (t0 + 15) / 32 + 1;
        bf16x8 Af[4][4];
#pragma unroll
        for (int rt = 0; rt < 4; ++rt)
#pragma unroll
            for (int ks = 0; ks < 4; ++ks) Af[rt][ks] = *(const bf16x8*)(IQ + (mb + t0 + 4 * rt + rq) * 512 + rh * 64 + ks * 16 + 8 * h);
        __syncthreads();
        if (mode != 2) for (int kb = wave; kb < nkb; kb += NWAVES) {
            bf16x8 Bf[4];
#pragma unroll
            for (int ks = 0; ks < 4; ++ks) Bf[ks] = *(const bf16x8*)(IK + (mb + kb * 32 + r) * 64 + ks * 16 + 8 * h);
#pragma unroll
            for (int rt = 0; rt < 4; ++rt) {
                f32x16 acc = {0.f, 0.f, 0.f, 0.f, 0.f, 0.f, 0.f, 0.f, 0.f, 0.f, 0.f, 0.f, 0.f, 0.f, 0.f, 0.f};
#pragma unroll
                for (int ks = 0; ks < 4; ++ks) acc = __builtin_amdgcn_mfma_f32_32x32x16_bf16(Af[rt][ks], Bf[ks], acc, 0, 0, 0);
                const int qa = 4 * rt + 2 * h;
                const f32x4 wa0 = *(const LAS f32x4*)(wl + qa * 8), wa1 = *(const LAS f32x4*)(wl + qa * 8 + 4), wb0 = *(const LAS f32x4*)(wl + qa * 8 + 8), wb1 = *(const LAS f32x4*)(wl + qa * 8 + 12);
                float sa = 0.f, sb = 0.f;
#pragma unroll
                for (int i = 0; i < 4; ++i) { sa += wa0[i] * fmaxf(acc[i], 0.f); sa += wa1[i] * fmaxf(acc[4 + i], 0.f); sb += wb0[i] * fmaxf(acc[8 + i], 0.f); sb += wb1[i] * fmaxf(acc[12 + i], 0.f); }
                sc[qa * 4096 + kb * 32 + r] = (_Float16)sa;
                sc[(qa + 1) * 4096 + kb * 32 + r] = (_Float16)sb;
                __builtin_amdgcn_sched_barrier(0);
            }
        }
        __syncthreads();
#pragma unroll 1
        for (int qq = 0; qq < (mode == 1 ? 0 : 2); ++qq) {
            const int q = wave * 2 + qq, t = t0 + q, n = t + 1;
            unsigned mylo = 0u, myhi = 0u;
            if (n <= 256) {
                const int base = lane * 64;
                const u64 word = (base + 63 <= t) ? ~0ull : (base > t ? 0ull : ((1ull << (t - base + 1)) - 1ull));
                mylo = (unsigned)word; myhi = (unsigned)(word >> 32);
            } else {
                const int nreg = (((n + 63) >> 6) + 1) >> 1;
                const LAS unsigned short* scq = scu + q * 4096;
                u64 w;
                if (nreg <= 4) w = topk_query<4>(scq, t, lane);
                else if (nreg <= 8) w = topk_query<8>(scq, t, lane);
                else if (nreg <= 12) w = topk_query<12>(scq, t, lane);
                else if (nreg <= 16) w = topk_query<16>(scq, t, lane);
                else if (nreg <= 20) w = topk_query<20>(scq, t, lane);
                else if (nreg <= 24) w = topk_query<24>(scq, t, lane);
                else if (nreg <= 28) w = topk_query<28>(scq, t, lane);
                else w = topk_query<32>(scq, t, lane);
                mylo = (unsigned)w; myhi = (unsigned)(w >> 32);
            }
            mk[lane * 16 + q] = (u64)mylo | ((u64)myhi << 32);
        }
        __syncthreads();
        { const int w = F.tid >> 3, part = F.tid & 7;
          u64* dst = SELT + ((size_t)(b * 64 + w) * 4096) + t0 + part * 2;
          dst[0] = mk[w * 16 + part * 2]; dst[1] = mk[w * 16 + part * 2 + 1]; }
        __syncthreads();
    }
}

constexpr int AT_KB = 9216, AT_VB = 8704, AT_BUF = AT_KB + AT_VB;
struct AttStage { u32x4 kreg, vreg; };
__device__ __forceinline__ void att_load(AttStage& s, const bf16_t* Kg, const bf16_t* Vtg, int key0, int tid) {
    s.kreg = *(const u32x4*)(Kg + (size_t)(key0 + (tid >> 3)) * 64 + (tid & 7) * 8);
    s.vreg = *(const u32x4*)(Vtg + (size_t)(tid >> 3) * 4096 + key0 + (tid & 7) * 8);
}
__device__ __forceinline__ void att_store(const AttStage& s, LAS unsigned char* buf, int tid) {
    *(LAS u32x4*)(buf + (tid >> 3) * 144 + (tid & 7) * 16) = s.kreg;
    LAS unsigned char* v = buf + AT_KB + (tid >> 3) * 136 + (tid & 7) * 16;
    *(LAS u32x2*)(v) = (u32x2){s.vreg.x, s.vreg.y}; *(LAS u32x2*)(v + 8) = (u32x2){s.vreg.z, s.vreg.w};
}
__device__ __forceinline__ bf16x8 pack8(float a0, float a1, float a2, float a3, float a4, float a5, float a6, float a7) {
    u32x4 w; w.x = pg8::cvt_pk_bf16(a0, a1); w.y = pg8::cvt_pk_bf16(a2, a3); w.z = pg8::cvt_pk_bf16(a4, a5); w.w = pg8::cvt_pk_bf16(a6, a7);
    return __builtin_bit_cast(bf16x8, w);
}
__device__ __forceinline__ f32x16 att_qk(const LAS unsigned char* buf, int sub, const bf16x8 (&Qf)[4], int lane) {
    f32x16 S = {0.f, 0.f, 0.f, 0.f, 0.f, 0.f, 0.f, 0.f, 0.f, 0.f, 0.f, 0.f, 0.f, 0.f, 0.f, 0.f};
    const LAS unsigned char* kp = buf + (sub * 32 + (lane & 31)) * 144 + (lane >> 5) * 16;
#pragma unroll
    for (int ks = 0; ks < 4; ++ks) { const bf16x8 kf = *(const LAS bf16x8*)(kp + ks * 32); S = __builtin_amdgcn_mfma_f32_32x32x16_bf16(kf, Qf[ks], S, 0, 0, 0); }
    return S;
}
__device__ __forceinline__ void att_pv2(const LAS unsigned char* buf, int sub, const bf16x8 P0, const bf16x8 P1, f32x16 (&O)[2], int lane) {
    const int h = lane >> 5;
#pragma unroll
    for (int dt = 0; dt < 2; ++dt) {
        const LAS unsigned char* vp = buf + AT_KB + (dt * 32 + (lane & 31)) * 136 + (sub * 32 + 4 * h) * 2;
        const u32x2 a0 = *(const LAS u32x2*)(vp), a1 = *(const LAS u32x2*)(vp + 16), b0 = *(const LAS u32x2*)(vp + 32), b1 = *(const LAS u32x2*)(vp + 48);
        const bf16x8 V0 = __builtin_bit_cast(bf16x8, ((u32x4){a0.x, a0.y, a1.x, a1.y}));
        const bf16x8 V1 = __builtin_bit_cast(bf16x8, ((u32x4){b0.x, b0.y, b1.x, b1.y}));
        O[dt] = __builtin_amdgcn_mfma_f32_32x32x16_bf16(V0, P0, O[dt], 0, 0, 0);
        O[dt] = __builtin_amdgcn_mfma_f32_32x32x16_bf16(V1, P1, O[dt], 0, 0, 0);
    }
}
__device__ __forceinline__ void att_pv(const LAS unsigned char* buf, int sub, const float (&p)[16], f32x16 (&O)[2], int lane) {
    const bf16x8 P0 = pack8(p[0], p[1], p[2], p[3], p[4], p[5], p[6], p[7]);
    const bf16x8 P1 = pack8(p[8], p[9], p[10], p[11], p[12], p[13], p[14], p[15]);
    att_pv2(buf, sub, P0, P1, O, lane);
}

__device__ __forceinline__ void att_kfrags(const LAS unsigned char* buf, int sub, bf16x8 (&Kf)[4], int lane) {
    const LAS unsigned char* kp = buf + (sub * 32 + (lane & 31)) * 144 + (lane >> 5) * 16;
#pragma unroll
    for (int ks = 0; ks < 4; ++ks) Kf[ks] = *(const LAS bf16x8*)(kp + ks * 32);
}
__device__ __forceinline__ void att_vfrags(const LAS unsigned char* buf, int sub, bf16x8 (&Vf)[2][2], int lane) {
    const int h = lane >> 5;
#pragma unroll
    for (int dt = 0; dt < 2; ++dt) {
        const LAS unsigned char* vp = buf + AT_KB + (dt * 32 + (lane & 31)) * 136 + (sub * 32 + 4 * h) * 2;
        const u32x2 a0 = *(const LAS u32x2*)(vp), a1 = *(const LAS u32x2*)(vp + 16), b0 = *(const LAS u32x2*)(vp + 32), b1 = *(const LAS u32x2*)(vp + 48);
        Vf[dt][0] = __builtin_bit_cast(bf16x8, ((u32x4){a0.x, a0.y, a1.x, a1.y}));
        Vf[dt][1] = __builtin_bit_cast(bf16x8, ((u32x4){b0.x, b0.y, b1.x, b1.y}));
    }
}
__device__ __forceinline__ f32x16 att_qk_f(const bf16x8 (&Kf)[4], const bf16x8 (&Qf)[4]) {
    f32x16 S = {0.f, 0.f, 0.f, 0.f, 0.f, 0.f, 0.f, 0.f, 0.f, 0.f, 0.f, 0.f, 0.f, 0.f, 0.f, 0.f};
#pragma unroll
    for (int ks = 0; ks < 4; ++ks) S = __builtin_amdgcn_mfma_f32_32x32x16_bf16(Kf[ks], Qf[ks], S, 0, 0, 0);
    return S;
}
__device__ __forceinline__ void att_pv_f(const bf16x8 (&Vf)[2][2], const bf16x8 P0, const bf16x8 P1, f32x16 (&O)[2]) {
#pragma unroll
    for (int dt = 0; dt < 2; ++dt) { O[dt] = __builtin_amdgcn_mfma_f32_32x32x16_bf16(Vf[dt][0], P0, O[dt], 0, 0, 0); O[dt] = __builtin_amdgcn_mfma_f32_32x32x16_bf16(Vf[dt][1], P1, O[dt], 0, 0, 0); }
}

__device__ __forceinline__ void p_dsa_attn(const Frame& F, const Args& a, unsigned char* ws) {
    const bf16_t* QA = (const bf16_t*)(ws + L0_QA); const bf16_t* KA = (const bf16_t*)(ws + L0_KA); const bf16_t* VAT = (const bf16_t*)(ws + L0_VAT);
    const u64* SELT = (const u64*)(ws + L0_SELT); bf16_t* CAT = (bf16_t*)(ws + L0_CAT);
    const int lane = F.lane, wave = F.wave, h = lane >> 5, c = lane & 31, tid = F.tid;
    float mq = 0.f, mk_ = 0.f;
    for (int i = 0; i < 64; ++i) { mq = fmaxf(mq, fabsf(a.in[I_L0_QG][i])); mk_ = fmaxf(mk_, fabsf(a.in[I_L0_KG][i])); }
    const float c2 = (8.0f * mq * mk_ + 0.5f) * 1.4426950408889634f, c1 = 1.4426950408889634f;
    for (int u = F.bid; u < 512; u += F.G) {
        const int idx = u & 255, g = u >> 8, b = idx >> 5, qtr = idx & 31, qt = g ? 31 - qtr : qtr, q0 = qt * 128;
        const size_t mb = (size_t)b * 4096;
        const bf16_t* Kg = KA + (size_t)(b * 2 + g) * 4096 * 64; const bf16_t* Vtg = VAT + (size_t)(b * 2 + g) * 64 * 4096;
        bf16x8 Qf[2][4]; int qidx[2];
#pragma unroll
        for (int ct = 0; ct < 2; ++ct) { qidx[ct] = q0 + wave * 16 + ct * 8 + (c >> 2);
#pragma unroll
            for (int ks = 0; ks < 4; ++ks) Qf[ct][ks] = *(const bf16x8*)(QA + (mb + qidx[ct]) * 512 + (g * 4 + (c & 3)) * 64 + ks * 16 + 8 * h); }
        f32x16 O[2][2]; float l[2] = {0.f, 0.f};
#pragma unroll
        for (int ct = 0; ct < 2; ++ct)
#pragma unroll
            for (int dt = 0; dt < 2; ++dt)
#pragma unroll
                for (int i = 0; i < 16; ++i) O[ct][dt][i] = 0.f;
        const int nkt = 2 * qt + 2;
        AttStage st; att_load(st, Kg, Vtg, 0, tid);
        __syncthreads();
        att_store(st, F.lds, tid);
        __syncthreads();
        for (int kt = 0; kt < nkt; ++kt) {
            LAS unsigned char* buf = F.lds + (kt & 1) * AT_BUF;
            if (kt + 1 < nkt) att_load(st, Kg, Vtg, (kt + 1) * 64, tid);
            u64 mw[2];
#pragma unroll
            for (int ct = 0; ct < 2; ++ct) mw[ct] = SELT[(size_t)(b * 64 + kt) * 4096 + qidx[ct]];
#pragma unroll 1
            for (int sub = 0; sub < 2; ++sub) {
                bf16x8 Kf[4], Vf[2][2];
                att_kfrags(buf, sub, Kf, lane); att_vfrags(buf, sub, Vf, lane);
#pragma unroll
                for (int ct = 0; ct < 2; ++ct) {
                    __builtin_amdgcn_sched_barrier(0);
                    const f32x16 S = att_qk_f(Kf, Qf[ct]);
                    const unsigned mbits = (unsigned)(mw[ct] >> (sub * 32 + 4 * h));
                    float p[16];
#pragma unroll
                    for (int i = 0; i < 16; ++i) {
                        const float e = __builtin_amdgcn_exp2f(S[i] * c1 - c2);
                        const int bitpos = (i & 3) + 8 * (i >> 2);
                        p[i] = __builtin_bit_cast(float, __builtin_bit_cast(int, e) & __builtin_amdgcn_sbfe((int)mbits, bitpos, 1));
                        l[ct] += p[i];
                    }
                    att_pv_f(Vf, pack8(p[0], p[1], p[2], p[3], p[4], p[5], p[6], p[7]), pack8(p[8], p[9], p[10], p[11], p[12], p[13], p[14], p[15]), O[ct]);
                }
            }
            if (kt + 1 < nkt) att_store(st, F.lds + ((kt + 1) & 1) * AT_BUF, tid);
            __syncthreads();
        }
#pragma unroll
        for (int ct = 0; ct < 2; ++ct) {
            const float lt = l[ct] + __shfl_xor(l[ct], 32);
            const float inv = 1.0f / fmaxf(lt, 1e-30f);
            bf16_t* orow = CAT + (mb + qidx[ct]) * 1024 + (g * 4 + (c & 3)) * 64;
#pragma unroll
            for (int dt = 0; dt < 2; ++dt)
#pragma unroll
                for (int i4 = 0; i4 < 4; ++i4) {
                    const int d = dt * 32 + 8 * i4 + 4 * h;
                    u32x2 w; w.x = pk2(O[ct][dt][4 * i4] * inv, O[ct][dt][4 * i4 + 1] * inv); w.y = pk2(O[ct][dt][4 * i4 + 2] * inv, O[ct][dt][4 * i4 + 3] * inv);
                    *(u32x2*)(orow + d) = w;
                }
        }
    }
}

__device__ __forceinline__ void p_s5_scan(const Frame& F, const Args& a, unsigned char* ws) {
    const float* SLOC = (const float*)(ws + L0_SLOC); bf16_t* UA = (bf16_t*)(ws + L0_UA);
    const int p = F.lane;
    if (F.wave == 0) for (int it = F.bid; it < 32 * NB; it += F.G) {
        const int g = it >> 3, b = it & 7;
        const float dt = expf(a.in[I_L0_LOGDT][g]);
        const float lr = a.in[I_L0_ARE][g * 64 + p], li = a.in[I_L0_AIM][g * 64 + p];
        const float mag = expf(16.0f * dt * lr); float s, c; sincosf(16.0f * dt * li, &s, &c);
        const float ar = mag * c, ai = mag * s;
        float hr = 0.f, hi = 0.f;
        const float* sl = SLOC + ((size_t)g * 2048 + b * 256) * 128;
        bf16_t* ua = UA + ((size_t)g * 2048 + b * 256) * 384 + 256;
        for (int ch = 0; ch < 256; ++ch) {
            ua[(size_t)ch * 384 + p] = (bf16_t)f2bf(hr); ua[(size_t)ch * 384 + 64 + p] = (bf16_t)f2bf(hi);
            const float xr = sl[(size_t)ch * 128 + p], xi = sl[(size_t)ch * 128 + 64 + p];
            const float nr = ar * hr - ai * hi + xr, ni = ar * hi + ai * hr + xi;
            hr = nr; hi = ni;
        }
    }
}
namespace pg8 {
struct EpiS5State {
    static constexpr bool PERM = false;
    float* C;
    __device__ __forceinline__ void operator()(const f32x4 (&acc)[2][2][4][2], const Unit& u, int wr, int wc, int fr, int fq) const {
        const int row0 = u.pm * BM + wr * 64 + fr, col0 = wc * 32 + 4 * fq;
#pragma unroll
        for (int ai = 0; ai < 2; ++ai)
#pragma unroll
            for (int m = 0; m < 4; ++m)
#pragma unroll
                for (int n = 0; n < 2; ++n) *(f32x4*)(C + (size_t)(row0 + ai * HALF + m * 16) * 128 + col0 + n * 16) = acc[ai][0][m][n];
    }
};
struct EpiS5Out {
    static constexpr bool PERM = false;
    bf16_t* YB;
    __device__ __forceinline__ void operator()(const f32x4 (&acc)[2][2][4][2], const Unit& u, int wr, int wc, int fr, int fq) const {
        const int g = u.pn;
        const int row0 = u.pm * BM + wr * 64 + fr - g * 2048;
        const int col0 = wc * 32 + 4 * fq;
#pragma unroll
        for (int ai = 0; ai < 2; ++ai)
#pragma unroll
            for (int m = 0; m < 4; ++m) { const int chunk = row0 + ai * HALF + m * 16;
#pragma unroll
                for (int bj = 0; bj < 2; ++bj)
#pragma unroll
                    for (int n = 0; n < 2; ++n) { const int col = col0 + bj * HALF + n * 16, i = col >> 4, co = col & 15;
                        const f32x4 v = acc[ai][bj][m][n];
                        u32x2 w; w.x = pk2(gelu_tanh(v[0]), gelu_tanh(v[1])); w.y = pk2(gelu_tanh(v[2]), gelu_tanh(v[3]));
                        *(u32x2*)(YB + ((size_t)chunk * 16 + i) * 512 + g * 16 + co) = w; }
                asm volatile("" ::: "memory"); __builtin_amdgcn_sched_barrier(0); }
    }
};
struct EpiGlu {
    static constexpr bool PERM = true;
    const bf16_t* YB; const float* bias; bf16_t* CAT;
    __device__ __forceinline__ void operator()(const f32x4 (&acc)[2][2][4][2], const Unit& u, int wr, int wc, int fr, int fq) const {
        const int row0 = u.pm * BM + wr * 64 + fr, col0 = u.pn * BM + wc * 32 + 8 * fq;
#pragma unroll
        for (int ai = 0; ai < 2; ++ai)
#pragma unroll
            for (int m = 0; m < 4; ++m) { const size_t row = row0 + ai * HALF + m * 16;
#pragma unroll
                for (int bj = 0; bj < 2; ++bj) { const int col = col0 + bj * HALF;
                    const u32x4 yv = *(const u32x4*)(YB + row * 512 + col);
                    const f32x4 b0 = *(const f32x4*)(bias + col), b1 = *(const f32x4*)(bias + col + 4);
                    const f32x4 z0 = acc[ai][bj][m][0] + b0, z1 = acc[ai][bj][m][1] + b1;
                    u32x4 w;
                    w.x = pk2(bf_lo(yv.x) * sigmoidf_(z0[0]), bf_hi(yv.x) * sigmoidf_(z0[1])); w.y = pk2(bf_lo(yv.y) * sigmoidf_(z0[2]), bf_hi(yv.y) * sigmoidf_(z0[3]));
                    w.z = pk2(bf_lo(yv.z) * sigmoidf_(z1[0]), bf_hi(yv.z) * sigmoidf_(z1[1])); w.w = pk2(bf_lo(yv.w) * sigmoidf_(z1[2]), bf_hi(yv.w) * sigmoidf_(z1[3]));
                    *(u32x4*)(CAT + row * 1024 + 512 + col) = w; }
                asm volatile("" ::: "memory"); __builtin_amdgcn_sched_barrier(0); }
    }
};
}
__device__ __forceinline__ unsigned mono_u32(float f) { const unsigned u = __builtin_bit_cast(unsigned, f); return u ^ ((u >> 31) ? 0xFFFFFFFFu : 0x80000000u); }
#define CE_DESC(x, y) do { const unsigned _hi = (x) > (y) ? (x) : (y), _lo = (x) > (y) ? (y) : (x); (x) = _hi; (y) = _lo; } while (0)
__device__ __forceinline__ void sort16_desc(unsigned (&a)[16]) {
#pragma unroll
    for (int k = 2; k <= 16; k <<= 1)
#pragma unroll
        for (int j = k >> 1; j > 0; j >>= 1)
#pragma unroll
            for (int i = 0; i < 16; ++i) { const int l = i ^ j; if (l > i) { if ((i & k) == 0) CE_DESC(a[i], a[l]); else CE_DESC(a[l], a[i]); } }
}
__device__ __forceinline__ void merge16_desc(unsigned (&a)[16], const unsigned (&b)[16]) {
#pragma unroll
    for (int i = 0; i < 16; ++i) a[i] = a[i] > b[15 - i] ? a[i] : b[15 - i];
#pragma unroll
    for (int j = 8; j > 0; j >>= 1)
#pragma unroll
        for (int i = 0; i < 16; ++i) { const int l = i ^ j; if (l > i) CE_DESC(a[i], a[l]); }
}
__device__ __forceinline__ void merge16_xlane(unsigned (&a)[16]) {
    unsigned b[16];
#pragma unroll
    for (int i = 0; i < 16; ++i) b[i] = (unsigned)__shfl_xor((int)a[i], 32);
    merge16_desc(a, b);
}
struct PeerCand { int a[50], b[50]; };
__host__ __device__ constexpr PeerCand peer_cands() { PeerCand c{}; int n = 0; for (int a = 0; a < 16; ++a) for (int b = 0; b < 16; ++b) if ((a + 1) * (b + 1) <= 16) { c.a[n] = a; c.b[n] = b; ++n; } return c; }
__device__ __forceinline__ void p_peer_route(const Frame& F, unsigned char* ws, const bf16_t* SK) {
    const bf16_t* Q2 = (const bf16_t*)(ws + PE_Q2); unsigned short* EID = (unsigned short*)(ws + PE_EID); float* GATE = (float*)(ws + PE_GATE);
    LAS float* sc0 = (LAS float*)F.lds;
    const int lane = F.lane, wave = F.wave, h5 = lane >> 5, r = lane & 31, tid = F.tid;
    constexpr PeerCand PC = peer_cands();
    bf16x8 Af[8];
    { const int u = F.bid; if (u < 2048) { const int hd = u & 7, mt = u >> 3, p = wave >> 2, rt = wave & 3;
#pragma unroll
        for (int ks = 0; ks < 8; ++ks) Af[ks] = *(const bf16x8*)(Q2 + ((size_t)mt * 128 + rt * 32 + r) * 2048 + (hd * 2 + p) * 128 + ks * 16 + 8 * h5); } }
    for (int u = F.bid; u < 2048; u += F.G) {
        const int hd = u & 7, mt = u >> 3; const size_t m0 = (size_t)mt * 128;
        {
            const int p = wave >> 2, rt = wave & 3;
            LAS float* scp = sc0 + p * 128 * 129;
#pragma unroll 1
            for (int ct = 0; ct < 4; ++ct) {
                f32x16 acc = {0.f, 0.f, 0.f, 0.f, 0.f, 0.f, 0.f, 0.f, 0.f, 0.f, 0.f, 0.f, 0.f, 0.f, 0.f, 0.f};
#pragma unroll
                for (int ks = 0; ks < 8; ++ks) { const bf16x8 Bf = *(const bf16x8*)(SK + ((size_t)(hd * 2 + p) * 128 + ct * 32 + r) * 128 + ks * 16 + 8 * h5);
                    acc = __builtin_amdgcn_mfma_f32_32x32x16_bf16(Af[ks], Bf, acc, 0, 0, 0); }
#pragma unroll
                for (int i = 0; i < 16; ++i) scp[(rt * 32 + (i & 3) + 8 * (i >> 2) + 4 * h5) * 129 + ct * 32 + r] = acc[i];
            }
            const int un = u + F.G;
            if (un < 2048) { const int hdn = un & 7, mtn = un >> 3;
#pragma unroll
                for (int ks = 0; ks < 8; ++ks) Af[ks] = *(const bf16x8*)(Q2 + ((size_t)mtn * 128 + rt * 32 + r) * 2048 + (hdn * 2 + p) * 128 + ks * 16 + 8 * h5); }
        }
        __syncthreads();
        {
            const int pp = wave >> 2, row = (wave & 3) * 32 + r, half = h5; LAS float* rowp = sc0 + pp * 128 * 129 + row * 129;
            unsigned top[16];
#pragma unroll
            for (int blk = 0; blk < 4; ++blk) {
                unsigned k16[16];
#pragma unroll
                for (int i = 0; i < 16; ++i) { const int j = half * 64 + blk * 16 + i; k16[i] = (mono_u32(rowp[j]) & ~0x7Fu) | (unsigned)(127 - j); }
                sort16_desc(k16);
                if (blk == 0) {
#pragma unroll
                    for (int i = 0; i < 16; ++i) top[i] = k16[i];
                } else merge16_desc(top, k16);
            }
            merge16_xlane(top);
            float vals[16]; int ids[16];
#pragma unroll
            for (int k = 0; k < 16; ++k) { ids[k] = 127 - (int)(top[k] & 127u); vals[k] = rowp[ids[k]]; }
            if (half == 0) {
#pragma unroll
                for (int k = 0; k < 16; ++k) { rowp[k] = vals[k]; rowp[16 + k] = __int_as_float(ids[k]); }
            }
        }
        __syncthreads();
        if (tid < 256) {
            const int row = (wave & 3) * 32 + r, half = h5; const LAS float* s1 = sc0 + row * 129; const LAS float* s2 = sc0 + 128 * 129 + row * 129;
            float v1[16], v2[16];
#pragma unroll
            for (int k = 0; k < 16; ++k) { v1[k] = s1[k]; v2[k] = s2[k]; }
            unsigned top[16], k16[16];
#pragma unroll
            for (int i = 0; i < 16; ++i) { const int c0 = 2 * i, c1 = 2 * i + 1;
                const unsigned ka = (mono_u32(v1[PC.a[c0]] + v2[PC.b[c0]]) & ~0xFFu) | (unsigned)(255 - (PC.a[c0] * 16 + PC.b[c0]));
                const unsigned kb = (mono_u32(v1[PC.a[c1]] + v2[PC.b[c1]]) & ~0xFFu) | (unsigned)(255 - (PC.a[c1] * 16 + PC.b[c1]));
                top[i] = half ? kb : ka; }
#pragma unroll
            for (int i = 0; i < 16; ++i) { if (i < 9) { const int c0 = 32 + 2 * i, c1 = 32 + 2 * i + 1;
                    const unsigned ka = (mono_u32(v1[PC.a[c0]] + v2[PC.b[c0]]) & ~0xFFu) | (unsigned)(255 - (PC.a[c0] * 16 + PC.b[c0]));
                    const unsigned kb = (mono_u32(v1[PC.a[c1]] + v2[PC.b[c1]]) & ~0xFFu) | (unsigned)(255 - (PC.a[c1] * 16 + PC.b[c1]));
                    k16[i] = half ? kb : ka; } else k16[i] = 0u; }
            sort16_desc(top); sort16_desc(k16); merge16_desc(top, k16);
            merge16_xlane(top);
            if (half == 0) {
                float mx = -3.0e38f; float sv[16]; int eid[16];
#pragma unroll
                for (int k = 0; k < 16; ++k) { const int fl = 255 - (int)(top[k] & 255u), a = fl >> 4, b = fl & 15;
                    sv[k] = s1[a] + s2[b]; eid[k] = __float_as_int(s1[16 + a]) * 128 + __float_as_int(s2[16 + b]); mx = fmaxf(mx, sv[k]); }
                float den = 0.f;
#pragma unroll
                for (int k = 0; k < 16; ++k) { sv[k] = __expf(sv[k] - mx); den += sv[k]; }
                const float inv = 1.0f / den;
                unsigned short* ep = EID + (m0 + row) * 128 + hd * 16; float* gp = GATE + (m0 + row) * 128 + hd * 16;
#pragma unroll
                for (int k = 0; k < 16; ++k) { ep[k] = (unsigned short)eid[k]; gp[k] = sv[k] * inv; }
            }
        }
        __syncthreads();
    }
}

__device__ __forceinline__ float rdlane_f(float v, int l) { return __builtin_bit_cast(float, __builtin_amdgcn_readlane(__builtin_bit_cast(int, v), l)); }
__device__ __forceinline__ void p_peer_expert(const Frame& F, unsigned char* ws, float* xres) {
    const bf16_t* XN = (const bf16_t*)(ws + WS_XN); const bf16_t* TU = (const bf16_t*)(ws + WS_TABU); const bf16_t* TV = (const bf16_t*)(ws + WS_TABV);
    const unsigned short* EID = (const unsigned short*)(ws + PE_EID); const float* GATE = (const float*)(ws + PE_GATE);
    const int gw = F.bid * NWAVES + F.wave, NGW = F.G * NWAVES, lane = F.lane;
    for (int m = gw; m < T; m += NGW) {
        float xf[16];
        { const u32x4 xa = *(const u32x4*)(XN + (size_t)m * 1024 + lane * 8), xb = *(const u32x4*)(XN + (size_t)m * 1024 + 512 + lane * 8);
          xf[0] = bf_lo(xa.x); xf[1] = bf_hi(xa.x); xf[2] = bf_lo(xa.y); xf[3] = bf_hi(xa.y); xf[4] = bf_lo(xa.z); xf[5] = bf_hi(xa.z); xf[6] = bf_lo(xa.w); xf[7] = bf_hi(xa.w);
          xf[8] = bf_lo(xb.x); xf[9] = bf_hi(xb.x); xf[10] = bf_lo(xb.y); xf[11] = bf_hi(xb.y); xf[12] = bf_lo(xb.z); xf[13] = bf_hi(xb.z); xf[14] = bf_lo(xb.w); xf[15] = bf_hi(xb.w); }
        const int id0 = EID[(size_t)m * 128 + lane], id1 = EID[(size_t)m * 128 + 64 + lane];
        const float g0 = GATE[(size_t)m * 128 + lane], g1 = GATE[(size_t)m * 128 + 64 + lane];
        float outv[16];
#pragma unroll
        for (int i = 0; i < 16; ++i) outv[i] = 0.f;
#pragma unroll 1
        for (int k = 0; k < 16; ++k) {
            const int idreg = (k < 8) ? id0 : id1; const float greg = (k < 8) ? g0 : g1; const int lbase = (k & 7) * 8;
            int e[8];
#pragma unroll
            for (int i = 0; i < 8; ++i) e[i] = __builtin_amdgcn_readlane(idreg, lbase + i);
            float pr[8];
            {
                u32x4 ua[8], ub[8];
#pragma unroll
                for (int i = 0; i < 8; ++i) { ua[i] = *(const u32x4*)(TU + (size_t)e[i] * 1024 + lane * 8); ub[i] = *(const u32x4*)(TU + (size_t)e[i] * 1024 + 512 + lane * 8); }
#pragma unroll
                for (int i = 0; i < 8; ++i) {
                    float s = xf[0] * bf_lo(ua[i].x); s += xf[1] * bf_hi(ua[i].x); s += xf[2] * bf_lo(ua[i].y); s += xf[3] * bf_hi(ua[i].y);
                    s += xf[4] * bf_lo(ua[i].z); s += xf[5] * bf_hi(ua[i].z); s += xf[6] * bf_lo(ua[i].w); s += xf[7] * bf_hi(ua[i].w);
                    s += xf[8] * bf_lo(ub[i].x); s += xf[9] * bf_hi(ub[i].x); s += xf[10] * bf_lo(ub[i].y); s += xf[11] * bf_hi(ub[i].y);
                    s += xf[12] * bf_lo(ub[i].z); s += xf[13] * bf_hi(ub[i].z); s += xf[14] * bf_lo(ub[i].w); s += xf[15] * bf_hi(ub[i].w);
                    pr[i] = s;
                }
            }
            float r4[4], r2[2], r1;
            { const bool up = (lane & 32) != 0;
#pragma unroll
              for (int i = 0; i < 4; ++i) { const float keep = up ? pr[i + 4] : pr[i], send = up ? pr[i] : pr[i + 4]; r4[i] = keep + __shfl_xor(send, 32); } }
            { const bool up = (lane & 16) != 0;
#pragma unroll
              for (int i = 0; i < 2; ++i) { const float keep = up ? r4[i + 2] : r4[i], send = up ? r4[i] : r4[i + 2]; r2[i] = keep + __shfl_xor(send, 16); } }
            { const bool up = (lane & 8) != 0; const float keep = up ? r2[1] : r2[0], send = up ? r2[0] : r2[1]; r1 = keep + __shfl_xor(send, 8); }
            r1 += __shfl_xor(r1, 4); r1 += __shfl_xor(r1, 2); r1 += __shfl_xor(r1, 1);
            const float gv = __shfl(greg, lbase + (lane >> 3));
            const float coef = gv * gelu_tanh(r1);
            {
                u32x4 va[8], vb[8];
#pragma unroll
                for (int i = 0; i < 8; ++i) { va[i] = *(const u32x4*)(TV + (size_t)e[i] * 1024 + lane * 8); vb[i] = *(const u32x4*)(TV + (size_t)e[i] * 1024 + 512 + lane * 8); }
#pragma unroll
                for (int i = 0; i < 8; ++i) {
                    const float ci = rdlane_f(coef, i * 8);
                    outv[0] += ci * bf_lo(va[i].x); outv[1] += ci * bf_hi(va[i].x); outv[2] += ci * bf_lo(va[i].y); outv[3] += ci * bf_hi(va[i].y);
                    outv[4] += ci * bf_lo(va[i].z); outv[5] += ci * bf_hi(va[i].z); outv[6] += ci * bf_lo(va[i].w); outv[7] += ci * bf_hi(va[i].w);
                    outv[8] += ci * bf_lo(vb[i].x); outv[9] += ci * bf_hi(vb[i].x); outv[10] += ci * bf_lo(vb[i].y); outv[11] += ci * bf_hi(vb[i].y);
                    outv[12] += ci * bf_lo(vb[i].z); outv[13] += ci * bf_hi(vb[i].z); outv[14] += ci * bf_lo(vb[i].w); outv[15] += ci * bf_hi(vb[i].w);
                }
            }
        }
        f32x4* o = (f32x4*)(xres + (size_t)m * 1024 + lane * 8);
        f32x4 a0 = o[0], a1 = o[1], b0 = o[128], b1 = o[129];
        a0 += (f32x4){outv[0], outv[1], outv[2], outv[3]}; a1 += (f32x4){outv[4], outv[5], outv[6], outv[7]};
        b0 += (f32x4){outv[8], outv[9], outv[10], outv[11]}; b1 += (f32x4){outv[12], outv[13], outv[14], outv[15]};
        o[0] = a0; o[1] = a1; o[128] = b0; o[129] = b1;
    }
}

typedef __bf16 bf16x2_t __attribute__((ext_vector_type(2)));
__device__ __forceinline__ float dot2bf(unsigned a, unsigned b, float c) { return __builtin_amdgcn_fdot2_f32_bf16(__builtin_bit_cast(bf16x2_t, a), __builtin_bit_cast(bf16x2_t, b), c, false); }
__device__ __forceinline__ void peer_slot_range(const unsigned (&xp)[8], float (&outv)[16], int id0, int id1, float g0, float g1, int r,
                                                const bf16_t* TU, const bf16_t* TV, int lane) {
    u64 m0 = __ballot((id0 >> 9) == r), m1 = __ballot((id1 >> 9) == r);
    while (m0 | m1) {
        int e[8]; float gt[8];
#pragma unroll
        for (int i = 0; i < 8; ++i) {
            if (m0) { const int l = __builtin_ctzll(m0); m0 &= m0 - 1ull; e[i] = __builtin_amdgcn_readlane(id0, l); gt[i] = rdlane_f(g0, l); }
            else if (m1) { const int l = __builtin_ctzll(m1); m1 &= m1 - 1ull; e[i] = __builtin_amdgcn_readlane(id1, l); gt[i] = rdlane_f(g1, l); }
            else { e[i] = -1; gt[i] = 0.f; }
        }
        float pr[8];
        {
            u32x4 ua[8], ub[8];
#pragma unroll
            for (int i = 0; i < 8; ++i) {
                if (e[i] >= 0) { ua[i] = *(const u32x4*)(TU + (size_t)e[i] * 1024 + lane * 8); ub[i] = *(const u32x4*)(TU + (size_t)e[i] * 1024 + 512 + lane * 8); }
                else { ua[i] = (u32x4){0u, 0u, 0u, 0u}; ub[i] = (u32x4){0u, 0u, 0u, 0u}; }
            }
#pragma unroll
            for (int i = 0; i < 8; ++i) {
                float s = dot2bf(xp[0], ua[i].x, 0.f); s = dot2bf(xp[1], ua[i].y, s); s = dot2bf(xp[2], ua[i].z, s); s = dot2bf(xp[3], ua[i].w, s);
                s = dot2bf(xp[4], ub[i].x, s); s = dot2bf(xp[5], ub[i].y, s); s = dot2bf(xp[6], ub[i].z, s); s = dot2bf(xp[7], ub[i].w, s);
                pr[i] = s;
            }
        }
        float r4[4], r2[2], r1;
        { const bool up = (lane & 32) != 0;
#pragma unroll
          for (int i = 0; i < 4; ++i) { const float keep = up ? pr[i + 4] : pr[i], send = up ? pr[i] : pr[i + 4]; r4[i] = keep + __shfl_xor(send, 32); } }
        { const bool up = (lane & 16) != 0;
#pragma unroll
          for (int i = 0; i < 2; ++i) { const float keep = up ? r4[i + 2] : r4[i], send = up ? r4[i] : r4[i + 2]; r2[i] = keep + __shfl_xor(send, 16); } }
        { const bool up = (lane & 8) != 0; const float keep = up ? r2[1] : r2[0], send = up ? r2[0] : r2[1]; r1 = keep + __shfl_xor(send, 8); }
        r1 += __shfl_xor(r1, 4); r1 += __shfl_xor(r1, 2); r1 += __shfl_xor(r1, 1);
        const int grp = lane >> 3;
        float gsel = gt[0];
#pragma unroll
        for (int i = 1; i < 8; ++i) gsel = (grp == i) ? gt[i] : gsel;
        const float coef = gsel * gelu_tanh(r1);
        {
            u32x4 va[8], vb[8];
#pragma unroll
            for (int i = 0; i < 8; ++i) {
                if (e[i] >= 0) { va[i] = *(const u32x4*)(TV + (size_t)e[i] * 1024 + lane * 8); vb[i] = *(const u32x4*)(TV + (size_t)e[i] * 1024 + 512 + lane * 8); }
                else { va[i] = (u32x4){0u, 0u, 0u, 0u}; vb[i] = (u32x4){0u, 0u, 0u, 0u}; }
            }
#pragma unroll
            for (int i = 0; i < 8; ++i) {
                if (e[i] >= 0) {
                    const float ci = rdlane_f(coef, i * 8);
                    outv[0] += ci * bf_lo(va[i].x); outv[1] += ci * bf_hi(va[i].x); outv[2] += ci * bf_lo(va[i].y); outv[3] += ci * bf_hi(va[i].y);
                    outv[4] += ci * bf_lo(va[i].z); outv[5] += ci * bf_hi(va[i].z); outv[6] += ci * bf_lo(va[i].w); outv[7] += ci * bf_hi(va[i].w);
                    outv[8] += ci * bf_lo(vb[i].x); outv[9] += ci * bf_hi(vb[i].x); outv[10] += ci * bf_lo(vb[i].y); outv[11] += ci * bf_hi(vb[i].y);
                    outv[12] += ci * bf_lo(vb[i].z); outv[13] += ci * bf_hi(vb[i].z); outv[14] += ci * bf_lo(vb[i].w); outv[15] += ci * bf_hi(vb[i].w);
                }
            }
        }
    }
}
__device__ __forceinline__ void p_peer_expert2(const Frame& F, unsigned char* ws, float* xres, const float oscale) {
    const bf16_t* XN = (const bf16_t*)(ws + WS_XN); const bf16_t* TU = (const bf16_t*)(ws + WS_TABU); const bf16_t* TV = (const bf16_t*)(ws + WS_TABV);
    const unsigned short* EID = (const unsigned short*)(ws + PE_EID); const float* GATE = (const float*)(ws + PE_GATE);
    const int gw = F.bid * NWAVES + F.wave, NGW = F.G * NWAVES, lane = F.lane;
    int rnd = 0;
    for (int m4 = gw * 4; m4 < T; m4 += NGW * 4, ++rnd) {
        unsigned xp[4][8]; float outv[4][16]; int id[4][2]; float gg[4][2];
#pragma unroll
        for (int s = 0; s < 4; ++s) {
            const size_t m = (size_t)(m4 + s);
            const u32x4 xa = *(const u32x4*)(XN + m * 1024 + lane * 8), xb = *(const u32x4*)(XN + m * 1024 + 512 + lane * 8);
            xp[s][0] = xa.x; xp[s][1] = xa.y; xp[s][2] = xa.z; xp[s][3] = xa.w; xp[s][4] = xb.x; xp[s][5] = xb.y; xp[s][6] = xb.z; xp[s][7] = xb.w;
            id[s][0] = EID[m * 128 + lane]; id[s][1] = EID[m * 128 + 64 + lane]; gg[s][0] = GATE[m * 128 + lane]; gg[s][1] = GATE[m * 128 + 64 + lane];
#pragma unroll
            for (int i = 0; i < 16; ++i) outv[s][i] = 0.f;
        }
#pragma unroll 1
        for (int k = 0; k < 32; ++k) {
            const int r = (rnd & 1) ? 31 - k : k;
#pragma unroll
            for (int s = 0; s < 4; ++s) peer_slot_range(xp[s], outv[s], id[s][0], id[s][1], gg[s][0], gg[s][1], r, TU, TV, lane);
        }
#pragma unroll
        for (int s = 0; s < 4; ++s) {
            f32x4* o = (f32x4*)(xres + (size_t)(m4 + s) * 1024 + lane * 8);
            f32x4 a0 = o[0], a1 = o[1], b0 = o[128], b1 = o[129];
            a0 += (f32x4){outv[s][0], outv[s][1], outv[s][2], outv[s][3]} * oscale; a1 += (f32x4){outv[s][4], outv[s][5], outv[s][6], outv[s][7]} * oscale;
            b0 += (f32x4){outv[s][8], outv[s][9], outv[s][10], outv[s][11]} * oscale; b1 += (f32x4){outv[s][12], outv[s][13], outv[s][14], outv[s][15]} * oscale;
            o[0] = a0; o[1] = a1; o[128] = b0; o[129] = b1;
        }
    }
}

struct RowBuf { u32x4 a[8], b[8]; };
__device__ __forceinline__ void peer_load8(RowBuf& rb, const bf16_t* TAB, const LAS unsigned* ent, int b, int lane) {
#pragma unroll
    for (int i = 0; i < 8; ++i) {
        const unsigned e = (unsigned)__builtin_amdgcn_readfirstlane((int)ent[b * 8 + i]) & 0x3FFFu;
        const bf16_t* rp = TAB + (size_t)e * 1024 + lane * 8;
        rb.a[i] = *(const u32x4*)rp; rb.b[i] = *(const u32x4*)(rp + 512);
    }
}
__device__ __forceinline__ float peer_dot(const unsigned (&xp)[8], const u32x4 a, const u32x4 b) {
    float s = dot2bf(xp[0], a.x, 0.f); s = dot2bf(xp[1], a.y, s); s = dot2bf(xp[2], a.z, s); s = dot2bf(xp[3], a.w, s);
    s = dot2bf(xp[4], b.x, s); s = dot2bf(xp[5], b.y, s); s = dot2bf(xp[6], b.z, s); s = dot2bf(xp[7], b.w, s);
    return s;
}
__device__ __forceinline__ void peer_u8(const RowBuf& rb, const unsigned (&xp)[4][8], const LAS unsigned* ent, LAS float* cf, int b, int lane) {
    float pr[8];
#pragma unroll
    for (int i = 0; i < 8; ++i) {
        const int slot = (__builtin_amdgcn_readfirstlane((int)ent[b * 8 + i]) >> 21) & 3;
        if (slot == 0) pr[i] = peer_dot(xp[0], rb.a[i], rb.b[i]);
        else if (slot == 1) pr[i] = peer_dot(xp[1], rb.a[i], rb.b[i]);
        else if (slot == 2) pr[i] = peer_dot(xp[2], rb.a[i], rb.b[i]);
        else pr[i] = peer_dot(xp[3], rb.a[i], rb.b[i]);
    }
    float r4[4], r2[2], r1;
    { const bool up = (lane & 32) != 0;
#pragma unroll
      for (int i = 0; i < 4; ++i) { const float keep = up ? pr[i + 4] : pr[i], send = up ? pr[i] : pr[i + 4]; r4[i] = keep + __shfl_xor(send, 32); } }
    { const bool up = (lane & 16) != 0;
#pragma unroll
      for (int i = 0; i < 2; ++i) { const float keep = up ? r4[i + 2] : r4[i], send = up ? r4[i] : r4[i + 2]; r2[i] = keep + __shfl_xor(send, 16); } }
    { const bool up = (lane & 8) != 0; const float keep = up ? r2[1] : r2[0], send = up ? r2[0] : r2[1]; r1 = keep + __shfl_xor(send, 8); }
    r1 += __shfl_xor(r1, 4); r1 += __shfl_xor(r1, 2); r1 += __shfl_xor(r1, 1);
    const float gate = cf[b * 8 + (lane >> 3)];
    const float coef = gate * gelu_tanh(r1);
    if ((lane & 7) == 0) cf[b * 8 + (lane >> 3)] = coef;
}
__device__ __forceinline__ void peer_acc(float (&o)[16], const float c, const u32x4 a, const u32x4 b) {
    o[0] += c * bf_lo(a.x); o[1] += c * bf_hi(a.x); o[2] += c * bf_lo(a.y); o[3] += c * bf_hi(a.y);
    o[4] += c * bf_lo(a.z); o[5] += c * bf_hi(a.z); o[6] += c * bf_lo(a.w); o[7] += c * bf_hi(a.w);
    o[8] += c * bf_lo(b.x); o[9] += c * bf_hi(b.x); o[10] += c * bf_lo(b.y); o[11] += c * bf_hi(b.y);
    o[12] += c * bf_lo(b.z); o[13] += c * bf_hi(b.z); o[14] += c * bf_lo(b.w); o[15] += c * bf_hi(b.w);
}
__device__ __forceinline__ void peer_v8(const RowBuf& rb, float (&outv)[4][16], const LAS unsigned* ent, const LAS float* cf, int b) {
#pragma unroll
    for (int i = 0; i < 8; ++i) {
        const int slot = (__builtin_amdgcn_readfirstlane((int)ent[b * 8 + i]) >> 21) & 3;
        const float c = cf[b * 8 + i];
        if (slot == 0) peer_acc(outv[0], c, rb.a[i], rb.b[i]);
        else if (slot == 1) peer_acc(outv[1], c, rb.a[i], rb.b[i]);
        else if (slot == 2) peer_acc(outv[2], c, rb.a[i], rb.b[i]);
        else peer_acc(outv[3], c, rb.a[i], rb.b[i]);
    }
}
__device__ __forceinline__ void p_peer_expert3(const Frame& F, unsigned char* ws, float* xres, const float oscale, const XcdBarrier& xbar) {
    const bf16_t* XN = (const bf16_t*)(ws + WS_XN); const bf16_t* TU = (const bf16_t*)(ws + WS_TABU); const bf16_t* TV = (const bf16_t*)(ws + WS_TABV);
    const unsigned short* EID = (const unsigned short*)(ws + PE_EID); const float* GATE = (const float*)(ws + PE_GATE);
    const int gw = F.bid * NWAVES + F.wave, NGW = F.G * NWAVES, lane = F.lane;
    LAS unsigned* ent = (LAS unsigned*)(F.lds + F.wave * 4096);
    LAS float* cf = (LAS float*)(F.lds + F.wave * 4096 + 2048);
    const int nrounds = (T + NGW * 4 - 1) / (NGW * 4);
    for (int rnd = 0; rnd < nrounds; ++rnd) {
        const int m4 = (rnd * NGW + gw) * 4;
        if (m4 < T) {
            unsigned xp[4][8];
            {
                int id[4][2]; float gg[4][2];
#pragma unroll
                for (int s = 0; s < 4; ++s) {
                    const size_t m = (size_t)(m4 + s);
                    const u32x4 xa = *(const u32x4*)(XN + m * 1024 + lane * 8), xb = *(const u32x4*)(XN + m * 1024 + 512 + lane * 8);
                    xp[s][0] = xa.x; xp[s][1] = xa.y; xp[s][2] = xa.z; xp[s][3] = xa.w; xp[s][4] = xb.x; xp[s][5] = xb.y; xp[s][6] = xb.z; xp[s][7] = xb.w;
                    id[s][0] = EID[m * 128 + lane]; id[s][1] = EID[m * 128 + 64 + lane]; gg[s][0] = GATE[m * 128 + lane]; gg[s][1] = GATE[m * 128 + 64 + lane];
                }
                int base = 0;
#pragma unroll 1
                for (int k = 0; k < 32; ++k) {
                    const int r = (rnd & 1) ? 31 - k : k;
#pragma unroll
                    for (int s = 0; s < 4; ++s)
#pragma unroll
                        for (int w = 0; w < 2; ++w) {
                            const bool hit = (id[s][w] >> 9) == r;
                            const u64 m = __ballot(hit);
                            if (hit) { const int pos = base + (int)__builtin_amdgcn_mbcnt_hi((unsigned)(m >> 32), __builtin_amdgcn_mbcnt_lo((unsigned)m, 0u));
                                ent[pos] = ((unsigned)s << 21) | ((unsigned)(w * 64 + lane) << 14) | (unsigned)id[s][w]; cf[pos] = gg[s][w]; }
                            base += __builtin_popcountll(m);
                        }
                }
            }
            LDS_WAIT();
            {
                RowBuf A, B;
                peer_load8(A, TU, ent, 0, lane);
#pragma unroll 1
                for (int b = 0; b < 64; b += 2) {
                    peer_load8(B, TU, ent, b + 1, lane);
                    peer_u8(A, xp, ent, cf, b, lane);
                    if (b + 2 < 64) peer_load8(A, TU, ent, b + 2, lane);
                    peer_u8(B, xp, ent, cf, b + 1, lane);
                }
            }
            LDS_WAIT();
            float outv[4][16];
#pragma unroll
            for (int s = 0; s < 4; ++s)
#pragma unroll
                for (int i = 0; i < 16; ++i) outv[s][i] = 0.f;
            {
                RowBuf A, B;
                peer_load8(A, TV, ent, 0, lane);
#pragma unroll 1
                for (int b = 0; b < 64; b += 2) {
                    peer_load8(B, TV, ent, b + 1, lane);
                    peer_v8(A, outv, ent, cf, b);
                    if (b + 2 < 64) peer_load8(A, TV, ent, b + 2, lane);
                    peer_v8(B, outv, ent, cf, b + 1);
                }
            }
#pragma unroll
            for (int s = 0; s < 4; ++s) {
                f32x4* o = (f32x4*)(xres + (size_t)(m4 + s) * 1024 + lane * 8);
                f32x4 a0 = o[0], a1 = o[1], b0 = o[128], b1 = o[129];
                a0 += (f32x4){outv[s][0], outv[s][1], outv[s][2], outv[s][3]} * oscale; a1 += (f32x4){outv[s][4], outv[s][5], outv[s][6], outv[s][7]} * oscale;
                b0 += (f32x4){outv[s][8], outv[s][9], outv[s][10], outv[s][11]} * oscale; b1 += (f32x4){outv[s][12], outv[s][13], outv[s][14], outv[s][15]} * oscale;
                o[0] = a0; o[1] = a1; o[128] = b0; o[129] = b1;
            }
        }
        if (rnd + 1 < nrounds) xcd_barrier(xbar);
    }
}

constexpr size_t WS_TAB8U = WS_TABU;
constexpr size_t WS_TAB8V = WS_TABU + 16 * MiB;
constexpr size_t WS_TABSU = WS_TABU + 32 * MiB;
constexpr size_t WS_TABSV = WS_TABU + 32 * MiB + 65536;
__device__ __forceinline__ void cvt_table_fp8(const Frame& F, const float* src, unsigned char* dst, float* scales, const int skip) {
    const int nb = F.G > skip ? F.G - skip : F.G, b0 = F.G > skip ? F.bid - skip : F.bid;
    const int gw = b0 * NWAVES + F.wave, NGW = nb * NWAVES, lane = F.lane;
    if (b0 >= 0) for (int r = gw; r < 16384; r += NGW) {
        const f32x4* p = (const f32x4*)(src + (size_t)r * 1024 + lane * 16);
        f32x4 v[4]; float am = 0.f;
#pragma unroll
        for (int j = 0; j < 4; ++j) { v[j] = p[j]; am = fmaxf(am, fmaxf(fmaxf(fabsf(v[j].x), fabsf(v[j].y)), fmaxf(fabsf(v[j].z), fabsf(v[j].w)))); }
#pragma unroll
        for (int o = 1; o < 64; o <<= 1) am = fmaxf(am, __shfl_xor(am, o));
        const float sc = am > 0.f ? am * (1.0f / 448.0f) : 1.0f, inv = 1.0f / sc;
        u32x4 q;
#pragma unroll
        for (int j = 0; j < 4; ++j) { int w = 0; w = __builtin_amdgcn_cvt_pk_fp8_f32(v[j].x * inv, v[j].y * inv, w, false); w = __builtin_amdgcn_cvt_pk_fp8_f32(v[j].z * inv, v[j].w * inv, w, true); q[j] = (unsigned)w; }
        *(u32x4*)(dst + (size_t)r * 1024 + lane * 16) = q;
        if (lane == 0) scales[r] = sc;
    }
}
template <int NR> struct RowBufN { u32x4 a[NR]; };
template <int NR>
__device__ __forceinline__ void peer_loadN(RowBufN<NR>& rb, const unsigned char* TAB, const LAS unsigned* ent, int b, int lane) {
    const int ev = (int)ent[b * NR + (lane & (NR - 1))];
#pragma unroll
    for (int i = 0; i < NR; ++i) {
        const unsigned e = (unsigned)__builtin_amdgcn_readlane(ev, i) & 0x3FFFu;
        rb.a[i] = *(const u32x4*)(TAB + (size_t)e * 1024 + lane * 16);
    }
}
__device__ __forceinline__ float peer_dot8x(const u32x4 xa, const u32x4 xb, const u32x4 q) {
    float s = 0.f;
#pragma unroll
    for (int j = 0; j < 4; ++j) {
        const f32x2 lo = __builtin_amdgcn_cvt_pk_f32_fp8((int)q[j], false), hi = __builtin_amdgcn_cvt_pk_f32_fp8((int)q[j], true);
        const unsigned x0 = (j < 2) ? xa[2 * j] : xb[2 * j - 4], x1 = (j < 2) ? xa[2 * j + 1] : xb[2 * j - 3];
        s += bf_lo(x0) * lo.x; s += bf_hi(x0) * lo.y; s += bf_lo(x1) * hi.x; s += bf_hi(x1) * hi.y;
    }
    return s;
}
template <int NR>
__device__ __forceinline__ void peer_u8x(const RowBufN<NR>& rb, int r0, const LAS unsigned char* xl, const LAS unsigned* ent, LAS float* cf, const LAS float* sul, int e0, int lane) {
    float pr[8];
    const int ev = (int)ent[e0 + (lane & 7)];
#pragma unroll
    for (int i = 0; i < 8; ++i) {
        const int slot = (__builtin_amdgcn_readlane(ev, i) >> 21) & 3;
        const LAS unsigned char* xp = xl + slot * 2048 + lane * 32;
        const u32x4 xa = *(const LAS u32x4*)xp, xb = *(const LAS u32x4*)(xp + 16);
        pr[i] = peer_dot8x(xa, xb, rb.a[r0 + i]);
    }
    float r4[4], r2[2], r1;
    { const bool up = (lane & 32) != 0;
#pragma unroll
      for (int i = 0; i < 4; ++i) { const float keep = up ? pr[i + 4] : pr[i], send = up ? pr[i] : pr[i + 4]; r4[i] = keep + __shfl_xor(send, 32); } }
    { const bool up = (lane & 16) != 0;
#pragma unroll
      for (int i = 0; i < 2; ++i) { const float keep = up ? r4[i + 2] : r4[i], send = up ? r4[i] : r4[i + 2]; r2[i] = keep + __shfl_xor(send, 16); } }
    { const bool up = (lane & 8) != 0; const float keep = up ? r2[1] : r2[0], send = up ? r2[0] : r2[1]; r1 = keep + __shfl_xor(send, 8); }
    r1 += __shfl_xor(r1, 4); r1 += __shfl_xor(r1, 2); r1 += __shfl_xor(r1, 1);
    const float gate = cf[e0 + (lane >> 3)];
    const float coef = gate * gelu_tanh(r1 * sul[e0 + (lane >> 3)]);
    if ((lane & 7) == 0) cf[e0 + (lane >> 3)] = coef;
}
__device__ __forceinline__ void peer_acc8(float (&o)[16], const float c, const u32x4 q) {
#pragma unroll
    for (int j = 0; j < 4; ++j) { const f32x2 lo = __builtin_amdgcn_cvt_pk_f32_fp8((int)q[j], false), hi = __builtin_amdgcn_cvt_pk_f32_fp8((int)q[j], true);
        o[4 * j] += c * lo.x; o[4 * j + 1] += c * lo.y; o[4 * j + 2] += c * hi.x; o[4 * j + 3] += c * hi.y; }
}
template <int NR>
__device__ __forceinline__ void peer_vN(const RowBufN<NR>& rb, float (&outv)[4][16], const LAS unsigned* ent, const LAS float* cf, int b, int lane) {
    const int ev = (int)ent[b * NR + (lane & (NR - 1))]; const float cv = cf[b * NR + (lane & (NR - 1))];
#pragma unroll
    for (int i = 0; i < NR; ++i) {
        const int slot = (__builtin_amdgcn_readlane(ev, i) >> 21) & 3;
        const float c = rdlane_f(cv, i);
        if (slot == 0) peer_acc8(outv[0], c, rb.a[i]);
        else if (slot == 1) peer_acc8(outv[1], c, rb.a[i]);
        else if (slot == 2) peer_acc8(outv[2], c, rb.a[i]);
        else peer_acc8(outv[3], c, rb.a[i]);
    }
}
__device__ __forceinline__ void p_peer_expert4(const Frame& F, unsigned char* ws, float* xres, const float oscale, const XcdBarrier& xbar, const int mode) {
    const bf16_t* XN = (const bf16_t*)(ws + WS_XN); const unsigned char* TU = ws + WS_TAB8U; const unsigned char* TV = ws + WS_TAB8V;
    const float* SU = (const float*)(ws + WS_TABSU); const float* SV = (const float*)(ws + WS_TABSV);
    const unsigned short* EID = (const unsigned short*)(ws + PE_EID); const float* GATE = (const float*)(ws + PE_GATE);
    const int gw = F.bid * NWAVES + F.wave, NGW = F.G * NWAVES, lane = F.lane;
    LAS unsigned* ent = (LAS unsigned*)(F.lds + F.wave * 6144);
    LAS float* cf = (LAS float*)(F.lds + F.wave * 6144 + 2048);
    LAS float* sul = (LAS float*)(F.lds + F.wave * 6144 + 4096);
    LAS unsigned char* xl = F.lds + 49152 + F.wave * 8192;
    constexpr int PU = 16, PV = 8;
    const int nrounds = (T + NGW * 4 - 1) / (NGW * 4);
    for (int rnd = 0; rnd < nrounds; ++rnd) {
        const int m4 = (rnd * NGW + gw) * 4;
        if (m4 < T) {
            {
                int id[4][2]; float gg[4][2], su[4][2];
#pragma unroll
                for (int s = 0; s < 4; ++s) { const size_t m = (size_t)(m4 + s);
                    id[s][0] = EID[m * 128 + lane]; id[s][1] = EID[m * 128 + 64 + lane]; gg[s][0] = GATE[m * 128 + lane] * SV[id[s][0]]; gg[s][1] = GATE[m * 128 + 64 + lane] * SV[id[s][1]]; su[s][0] = SU[id[s][0]]; su[s][1] = SU[id[s][1]]; }
                int base = 0;
#pragma unroll 1
                for (int k = 0; k < 16; ++k) {
                    const int r = (rnd & 1) ? 15 - k : k;
#pragma unroll
                    for (int s = 0; s < 4; ++s)
#pragma unroll
                        for (int w = 0; w < 2; ++w) {
                            const bool hit = (id[s][w] >> 10) == r;
                            const u64 m = __ballot(hit);
                            if (hit) { const int pos = base + (int)__builtin_amdgcn_mbcnt_hi((unsigned)(m >> 32), __builtin_amdgcn_mbcnt_lo((unsigned)m, 0u));
                                ent[pos] = ((unsigned)s << 21) | ((unsigned)(w * 64 + lane) << 14) | (unsigned)(mode == 4 ? (id[s][w] & 7) : id[s][w]); cf[pos] = gg[s][w]; sul[pos] = su[s][w]; }
                            base += __builtin_popcountll(m);
                        }
                }
            }
            LDS_WAIT();
            if (mode != 1 && mode != 3) {
#pragma unroll
                for (int s = 0; s < 4; ++s) { const size_t m = (size_t)(m4 + s);
                    const u32x4 xa = *(const u32x4*)(XN + m * 1024 + lane * 16), xb = *(const u32x4*)(XN + m * 1024 + lane * 16 + 8);
                    *(LAS u32x4*)(xl + s * 2048 + lane * 32) = xa; *(LAS u32x4*)(xl + s * 2048 + lane * 32 + 16) = xb; }
                LDS_WAIT();
                RowBufN<PU> A, B;
                peer_loadN<PU>(A, TU, ent, 0, lane);
#pragma unroll 1
                for (int b = 0; b < 512 / PU; b += 2) {
                    peer_loadN<PU>(B, TU, ent, b + 1, lane);
#pragma unroll
                    for (int h = 0; h < PU / 8; ++h) peer_u8x<PU>(A, h * 8, xl, ent, cf, sul, b * PU + h * 8, lane);
                    if (b + 2 < 512 / PU) peer_loadN<PU>(A, TU, ent, b + 2, lane);
#pragma unroll
                    for (int h = 0; h < PU / 8; ++h) peer_u8x<PU>(B, h * 8, xl, ent, cf, sul, (b + 1) * PU + h * 8, lane);
                }
            }
            LDS_WAIT();
            float outv[4][16];
#pragma unroll
            for (int s = 0; s < 4; ++s)
#pragma unroll
                for (int i = 0; i < 16; ++i) outv[s][i] = 0.f;
            if (mode != 1 && mode != 2) {
                RowBufN<PV> A, B;
                peer_loadN<PV>(A, TV, ent, 0, lane);
#pragma unroll 1
                for (int b = 0; b < 512 / PV; b += 2) {
                    peer_loadN<PV>(B, TV, ent, b + 1, lane);
                    peer_vN<PV>(A, outv, ent, cf, b, lane);
                    if (b + 2 < 512 / PV) peer_loadN<PV>(A, TV, ent, b + 2, lane);
                    peer_vN<PV>(B, outv, ent, cf, b + 1, lane);
                }
            }
#pragma unroll
            for (int s = 0; s < 4; ++s) {
                f32x4* o = (f32x4*)(xres + (size_t)(m4 + s) * 1024 + lane * 16);
#pragma unroll
                for (int j = 0; j < 4; ++j) { f32x4 a0 = o[j]; a0 += (f32x4){outv[s][4 * j], outv[s][4 * j + 1], outv[s][4 * j + 2], outv[s][4 * j + 3]} * oscale; o[j] = a0; }
            }
        }
        if (rnd + 1 < nrounds) xcd_barrier(xbar);
    }
}

__device__ __forceinline__ void cvt_table_i8(const Frame& F, const float* src, unsigned char* dst, float* scales, const int skip) {
    const int nb = F.G > skip ? F.G - skip : F.G, b0 = F.G > skip ? F.bid - skip : F.bid;
    const int gw = b0 * NWAVES + F.wave, NGW = nb * NWAVES, lane = F.lane;
    if (b0 >= 0) for (int r = gw; r < 16384; r += NGW) {
        const f32x4* p = (const f32x4*)(src + (size_t)r * 1024 + lane * 16);
        f32x4 v[4]; float am = 0.f;
#pragma unroll
        for (int j = 0; j < 4; ++j) { v[j] = p[j]; am = fmaxf(am, fmaxf(fmaxf(fabsf(v[j].x), fabsf(v[j].y)), fmaxf(fabsf(v[j].z), fabsf(v[j].w)))); }
#pragma unroll
        for (int o = 1; o < 64; o <<= 1) am = fmaxf(am, __shfl_xor(am, o));
        const float sc = am > 0.f ? am * (1.0f / 127.0f) : 1.0f, inv = 1.0f / sc;
        u32x4 q;
#pragma unroll
        for (int j = 0; j < 4; ++j) { const int a = (int)rintf(v[j].x * inv), b = (int)rintf(v[j].y * inv), c = (int)rintf(v[j].z * inv), d = (int)rintf(v[j].w * inv);
            q[j] = (unsigned)(a & 255) | ((unsigned)(b & 255) << 8) | ((unsigned)(c & 255) << 16) | ((unsigned)(d & 255) << 24); }
        *(u32x4*)(dst + (size_t)r * 1024 + lane * 16) = q;
        if (lane == 0) scales[r] = sc;
    }
}
template <int NR>
__device__ __forceinline__ void peer_u8i(const RowBufN<NR>& rb, int r0, const LAS unsigned char* xq, const LAS unsigned* ent, LAS float* cf, const LAS float* sul, int e0, int lane) {
    int pr[8];
    const int ev = (int)ent[e0 + (lane & 7)];
#pragma unroll
    for (int i = 0; i < 8; ++i) {
        const int slot = (__builtin_amdgcn_readlane(ev, i) >> 21) & 3;
        const u32x4 xv = *(const LAS u32x4*)(xq + slot * 1024 + lane * 16);
        const u32x4 q = rb.a[r0 + i];
        int s = __builtin_amdgcn_sdot4((int)xv.x, (int)q.x, 0, false); s = __builtin_amdgcn_sdot4((int)xv.y, (int)q.y, s, false);
        s = __builtin_amdgcn_sdot4((int)xv.z, (int)q.z, s, false); s = __builtin_amdgcn_sdot4((int)xv.w, (int)q.w, s, false);
        pr[i] = s;
    }
    int r4[4], r2[2], r1;
    { const bool up = (lane & 32) != 0;
#pragma unroll
      for (int i = 0; i < 4; ++i) { const int keep = up ? pr[i + 4] : pr[i], send = up ? pr[i] : pr[i + 4]; r4[i] = keep + __shfl_xor(send, 32); } }
    { const bool up = (lane & 16) != 0;
#pragma unroll
      for (int i = 0; i < 2; ++i) { const int keep = up ? r4[i + 2] : r4[i], send = up ? r4[i] : r4[i + 2]; r2[i] = keep + __shfl_xor(send, 16); } }
    { const bool up = (lane & 8) != 0; const int keep = up ? r2[1] : r2[0], send = up ? r2[0] : r2[1]; r1 = keep + __shfl_xor(send, 8); }
    r1 += __shfl_xor(r1, 4); r1 += __shfl_xor(r1, 2); r1 += __shfl_xor(r1, 1);
    const float gate = cf[e0 + (lane >> 3)];
    const float coef = gate * gelu_tanh((float)r1 * sul[e0 + (lane >> 3)]);
    if ((lane & 7) == 0) cf[e0 + (lane >> 3)] = coef;
}
template <bool FAKE>
__device__ __forceinline__ f32x2 cvt8(unsigned w, bool hi) {
    if (FAKE) { const unsigned t = hi ? (w >> 16) : w; return (f32x2){__builtin_bit_cast(float, (t << 23) | 0x30000000u), __builtin_bit_cast(float, ((t >> 8) << 23) | 0x30000000u)}; }
    return hi ? __builtin_amdgcn_cvt_pk_f32_fp8((int)w, true) : __builtin_amdgcn_cvt_pk_f32_fp8((int)w, false);
}
template <bool FAKE = false>
__device__ __forceinline__ void peer_acc8p(f32x2 (&o)[8], const float c, const u32x4 q) {
    const f32x2 c2 = {c, c};
#pragma unroll
    for (int j = 0; j < 4; ++j) { const f32x2 lo = cvt8<FAKE>(q[j], false), hi = cvt8<FAKE>(q[j], true);
        o[2 * j] += c2 * lo; o[2 * j + 1] += c2 * hi; }
}
template <int NR, bool FAKE>
__device__ __forceinline__ void peer_vNp(const RowBufN<NR>& rb, f32x2 (&outv)[4][8], const LAS unsigned* ent, const LAS float* cf, int b, int lane) {
    const int ev = (int)ent[b * NR + (lane & (NR - 1))]; const float cv = cf[b * NR + (lane & (NR - 1))];
    int slot[NR]; float c[NR];
#pragma unroll
    for (int i = 0; i < NR; ++i) { slot[i] = (__builtin_amdgcn_readlane(ev, i) >> 21) & 3; c[i] = rdlane_f(cv, i); }
#pragma unroll
    for (int q4 = 0; q4 < NR / 4; ++q4) {
#pragma unroll
        for (int s = 0; s < 4; ++s) {
#pragma unroll
            for (int i = 4 * q4; i < 4 * q4 + 4; ++i) if (slot[i] == s) peer_acc8p<FAKE>(outv[s], c[i], rb.a[i]);
            __builtin_amdgcn_sched_barrier(0);
        }
    }
}
template <int PV, bool FAKE>
__device__ __forceinline__ void peer_passv(f32x2 (&outv)[4][8], const unsigned char* TV, const LAS unsigned* ent, const LAS float* cf, int lane) {
    RowBufN<PV> A, B, C;
    constexpr int NBV = 512 / PV;
    peer_loadN<PV>(A, TV, ent, 0, lane); peer_loadN<PV>(B, TV, ent, 1, lane);
#pragma unroll 1
    for (int b = 0; b + 2 < NBV; b += 3) {
        peer_loadN<PV>(C, TV, ent, b + 2, lane);
        peer_vNp<PV, FAKE>(A, outv, ent, cf, b, lane);
        if (b + 3 < NBV) peer_loadN<PV>(A, TV, ent, b + 3, lane);
        peer_vNp<PV, FAKE>(B, outv, ent, cf, b + 1, lane);
        if (b + 4 < NBV) peer_loadN<PV>(B, TV, ent, b + 4, lane);
        peer_vNp<PV, FAKE>(C, outv, ent, cf, b + 2, lane);
    }
    peer_vNp<PV, FAKE>(A, outv, ent, cf, NBV - 1, lane);
}
__device__ __forceinline__ void p_peer_expert5(const Frame& F, unsigned char* ws, float* xres, const float oscale, const XcdBarrier& xbar, const int mode, const bool do_norm) {
    const bf16_t* XN = (const bf16_t*)(ws + WS_XN); const unsigned char* TU = ws + WS_TAB8U; const unsigned char* TV = ws + WS_TAB8V;
    const float* SU = (const float*)(ws + WS_TABSU); const float* SV = (const float*)(ws + WS_TABSV);
    const unsigned short* EID = (const unsigned short*)(ws + PE_EID); const float* GATE = (const float*)(ws + PE_GATE);
    const int gw = F.bid * NWAVES + F.wave, NGW = F.G * NWAVES, lane = F.lane;
    LAS unsigned* ent = (LAS unsigned*)(F.lds + F.wave * 6144);
    LAS float* cf = (LAS float*)(F.lds + F.wave * 6144 + 2048);
    LAS float* sul = (LAS float*)(F.lds + F.wave * 6144 + 4096);
    LAS unsigned char* xq = F.lds + 49152 + F.wave * 4096;
    constexpr int PU = 8, PV = 8;
    const int nrounds = (T + NGW * 4 - 1) / (NGW * 4);
    for (int rnd = 0; rnd < nrounds; ++rnd) {
        const int m4 = (rnd * NGW + gw) * 4;
        if (m4 < T) {
            {
                float sx[4];
#pragma unroll
                for (int s = 0; s < 4; ++s) { const size_t m = (size_t)(m4 + s);
                    const u32x4 xa = *(const u32x4*)(XN + m * 1024 + lane * 16), xb = *(const u32x4*)(XN + m * 1024 + lane * 16 + 8);
                    float xf[16] = {bf_lo(xa.x), bf_hi(xa.x), bf_lo(xa.y), bf_hi(xa.y), bf_lo(xa.z), bf_hi(xa.z), bf_lo(xa.w), bf_hi(xa.w),
                                    bf_lo(xb.x), bf_hi(xb.x), bf_lo(xb.y), bf_hi(xb.y), bf_lo(xb.z), bf_hi(xb.z), bf_lo(xb.w), bf_hi(xb.w)};
                    float am = 0.f;
#pragma unroll
                    for (int i = 0; i < 16; ++i) am = fmaxf(am, fabsf(xf[i]));
#pragma unroll
                    for (int o = 1; o < 64; o <<= 1) am = fmaxf(am, __shfl_xor(am, o));
                    sx[s] = am > 0.f ? am * (1.0f / 127.0f) : 1.0f; const float inv = 1.0f / sx[s];
                    u32x4 q;
#pragma unroll
                    for (int j = 0; j < 4; ++j) { const int a = (int)rintf(xf[4 * j] * inv), b = (int)rintf(xf[4 * j + 1] * inv), c = (int)rintf(xf[4 * j + 2] * inv), d = (int)rintf(xf[4 * j + 3] * inv);
                        q[j] = (unsigned)(a & 255) | ((unsigned)(b & 255) << 8) | ((unsigned)(c & 255) << 16) | ((unsigned)(d & 255) << 24); }
                    *(LAS u32x4*)(xq + s * 1024 + lane * 16) = q; }
                int id[4][2]; float gg[4][2], su[4][2];
#pragma unroll
                for (int s = 0; s < 4; ++s) { const size_t m = (size_t)(m4 + s);
                    id[s][0] = EID[m * 128 + lane]; id[s][1] = EID[m * 128 + 64 + lane];
                    gg[s][0] = GATE[m * 128 + lane] * SV[id[s][0]]; gg[s][1] = GATE[m * 128 + 64 + lane] * SV[id[s][1]];
                    su[s][0] = SU[id[s][0]] * sx[s]; su[s][1] = SU[id[s][1]] * sx[s]; }
                LAS unsigned* hcnt = (LAS unsigned*)sul;
                if (lane < 32) hcnt[lane] = 0u;
                LDS_WAIT();
#pragma unroll
                for (int s = 0; s < 4; ++s)
#pragma unroll
                    for (int w = 0; w < 2; ++w) __hip_atomic_fetch_add(hcnt + (id[s][w] >> 10), 1u, __ATOMIC_RELAXED, __HIP_MEMORY_SCOPE_WORKGROUP);
                LDS_WAIT();
                unsigned basev;
                { const unsigned cntv = (lane < 16) ? hcnt[lane] : 0u;
                  unsigned incl = cntv;
                  const bool rev = (rnd & 1) != 0;
#pragma unroll
                  for (int o = 1; o < 16; o <<= 1) { const unsigned up = (unsigned)__shfl_up((int)incl, o), dn = (unsigned)__shfl_down((int)incl, o);
                      const unsigned nb = rev ? ((lane + o < 16) ? dn : 0u) : ((lane >= o) ? up : 0u); incl += nb; }
                  basev = incl - cntv; }
                LDS_WAIT();
                if (lane < 16) hcnt[16 + lane] = basev;
                LDS_WAIT();
                int posv[4][2];
#pragma unroll
                for (int s = 0; s < 4; ++s)
#pragma unroll
                    for (int w = 0; w < 2; ++w) posv[s][w] = (int)__hip_atomic_fetch_add(hcnt + 16 + (id[s][w] >> 10), 1u, __ATOMIC_RELAXED, __HIP_MEMORY_SCOPE_WORKGROUP);
                LDS_WAIT();
#pragma unroll
                for (int s = 0; s < 4; ++s)
#pragma unroll
                    for (int w = 0; w < 2; ++w) { const int pos = posv[s][w];
                        ent[pos] = ((unsigned)s << 21) | ((unsigned)(w * 64 + lane) << 14) | (unsigned)(mode == 4 ? (id[s][w] & 7) : id[s][w]); cf[pos] = gg[s][w]; }
                LDS_WAIT();
#pragma unroll
                for (int s = 0; s < 4; ++s)
#pragma unroll
                    for (int w = 0; w < 2; ++w) sul[posv[s][w]] = su[s][w];
            }
            LDS_WAIT();
            if (mode != 1 && mode != 3) {
                RowBufN<PU> A, B, C;
                constexpr int NBU = 512 / PU;
                peer_loadN<PU>(A, TU, ent, 0, lane); peer_loadN<PU>(B, TU, ent, 1, lane);
#pragma unroll 1
                for (int b = 0; b + 2 < NBU; b += 3) {
                    peer_loadN<PU>(C, TU, ent, b + 2, lane);
                    peer_u8i<PU>(A, 0, xq, ent, cf, sul, b * PU, lane);
                    if (b + 3 < NBU) peer_loadN<PU>(A, TU, ent, b + 3, lane);
                    peer_u8i<PU>(B, 0, xq, ent, cf, sul, (b + 1) * PU, lane);
                    if (b + 4 < NBU) peer_loadN<PU>(B, TU, ent, b + 4, lane);
                    peer_u8i<PU>(C, 0, xq, ent, cf, sul, (b + 2) * PU, lane);
                }
                peer_u8i<PU>(A, 0, xq, ent, cf, sul, (NBU - 1) * PU, lane);
            }
            LDS_WAIT();
            f32x2 outv[4][8];
#pragma unroll
            for (int s = 0; s < 4; ++s)
#pragma unroll
                for (int i = 0; i < 8; ++i) outv[s][i] = (f32x2){0.f, 0.f};
            if (mode != 1 && mode != 2) {
                if (mode == 5) peer_passv<PV, true>(outv, TV, ent, cf, lane); else peer_passv<PV, false>(outv, TV, ent, cf, lane);
            }
            asm volatile("" ::: "memory"); __builtin_amdgcn_sched_barrier(0);
#pragma unroll
            for (int s = 0; s < 4; ++s) {
                f32x4* o = (f32x4*)(xres + (size_t)(m4 + s) * 1024 + lane * 16);
                f32x4 nv[4]; float ss = 0.f;
#pragma unroll
                for (int j = 0; j < 4; ++j) { f32x4 a0 = o[j]; const f32x4 add = (f32x4){outv[s][2 * j].x, outv[s][2 * j].y, outv[s][2 * j + 1].x, outv[s][2 * j + 1].y};
                    if (oscale != 0.f) a0 += add; else asm volatile("" :: "v"(add)); o[j] = a0; nv[j] = a0;
                    ss += (a0.x * a0.x + a0.y * a0.y) + (a0.z * a0.z + a0.w * a0.w); }
                if (do_norm && oscale != 0.f) {
                    const float rstd = 1.0f / sqrtf(wave_sum(ss) * (1.f / DM) + 1e-6f);
                    const f32x4* gp = (const f32x4*)((const float*)(ws + WS_CMPB + 4096) + lane * 16);
                    u32x4 w0, w1;
                    { const f32x4 g0 = gp[0], g1 = gp[1], g2 = gp[2], g3 = gp[3];
                      w0.x = pk2(nv[0].x * rstd * g0.x, nv[0].y * rstd * g0.y); w0.y = pk2(nv[0].z * rstd * g0.z, nv[0].w * rstd * g0.w);
                      w0.z = pk2(nv[1].x * rstd * g1.x, nv[1].y * rstd * g1.y); w0.w = pk2(nv[1].z * rstd * g1.z, nv[1].w * rstd * g1.w);
                      w1.x = pk2(nv[2].x * rstd * g2.x, nv[2].y * rstd * g2.y); w1.y = pk2(nv[2].z * rstd * g2.z, nv[2].w * rstd * g2.w);
                      w1.z = pk2(nv[3].x * rstd * g3.x, nv[3].y * rstd * g3.y); w1.w = pk2(nv[3].z * rstd * g3.z, nv[3].w * rstd * g3.w); }
                    u32x4* xo = (u32x4*)((bf16_t*)(ws + WS_XN) + (size_t)(m4 + s) * 1024 + lane * 16);
                    xo[0] = w0; xo[1] = w1;
                }
                asm volatile("" ::: "memory"); __builtin_amdgcn_sched_barrier(0);
            }
        }
    }
}

constexpr size_t L1_QN = WS_R3;
constexpr size_t L1_KS = WS_R3 + 32 * MiB;
constexpr size_t L1_KW = WS_R3 + 40 * MiB;
constexpr size_t L1_VST = WS_R3 + 48 * MiB;
constexpr size_t L1_VWT = WS_R3 + 56 * MiB;
constexpr size_t L1_KCR = WS_R3 + 64 * MiB;
constexpr size_t L1_VCR = WS_R3 + 72 * MiB;
constexpr size_t L1_GATES = WS_R3 + 81 * MiB;
constexpr size_t L1_H1 = WS_R3 + 84 * MiB;
constexpr size_t L1_CMPO = WS_R3 + 88 * MiB;
constexpr size_t L1_KC = WS_R3 + 90 * MiB;
constexpr size_t L1_VCT = WS_R3 + 91 * MiB;
constexpr size_t L1_SELB = WS_R3 + 92 * MiB;
constexpr size_t L1_OC = WS_TABU;
constexpr size_t L1_CAT = WS_XN;
constexpr size_t L1_UPD = WS_R3;
constexpr size_t L1_DECAY = WS_R3 + 128 * MiB;

__device__ __forceinline__ void p_l1_prep(const Frame& F, const Args& a, unsigned char* ws) {
    const bf16_t* P = (const bf16_t*)(ws + WS_PROJ);
    const f32x2* rope = (const f32x2*)(ws + WS_ROPE);
    bf16_t* QN = (bf16_t*)(ws + L1_QN); bf16_t* KS = (bf16_t*)(ws + L1_KS); bf16_t* KW = (bf16_t*)(ws + L1_KW);
    bf16_t* KCR = (bf16_t*)(ws + L1_KCR); bf16_t* VCR = (bf16_t*)(ws + L1_VCR); float* GATES = (float*)(ws + L1_GATES);
    const int gw = F.bid * NWAVES + F.wave, NGW = F.G * NWAVES, lane = F.lane, hs = lane >> 3, sub = lane & 7;
    float qg[8], kg[8];
#pragma unroll
    for (int j = 0; j < 8; ++j) { qg[j] = a.in[I_L1_QG][sub * 8 + j]; kg[j] = a.in[I_L1_KG][sub * 8 + j]; }
    const int srccol = (hs < 2) ? C1_KS + hs * 64 : (hs < 4) ? C1_KW + (hs - 2) * 64 : (hs < 6) ? C1_KC + (hs - 4) * 64 : C1_VC + (hs - 6) * 64;
    bf16_t* dstbuf = (hs < 2) ? KS : (hs < 4) ? KW : (hs < 6) ? KCR : VCR;
    const int g2 = hs & 1;
    for (int m = gw; m < T; m += NGW) {
        const int b = m >> 12, t = m & 4095;
        const bf16_t* row = P + (size_t)m * N_IN1;
        f32x2 cs[8];
#pragma unroll
        for (int j = 0; j < 4; ++j) { const f32x4 c4 = *(const f32x4*)(rope + t * 32 + (sub & 3) * 8 + 2 * j); cs[2 * j] = (f32x2){c4.x, c4.y}; cs[2 * j + 1] = (f32x2){c4.z, c4.w}; }
        float v[8];
        head8_load(row + C1_Q + lane * 8, v); head8_norm(v, qg); head8_rope(v, cs, sub >= 4); head8_store(QN + (size_t)m * 512 + lane * 8, v, 0.125f);
        {
            const u32x4 raw = *(const u32x4*)(row + srccol + sub * 8);
            v[0] = bf_lo(raw.x); v[1] = bf_hi(raw.x); v[2] = bf_lo(raw.y); v[3] = bf_hi(raw.y); v[4] = bf_lo(raw.z); v[5] = bf_hi(raw.z); v[6] = bf_lo(raw.w); v[7] = bf_hi(raw.w);
            head8_norm(v, kg); head8_rope(v, cs, sub >= 4);
            u32x4 q; q.x = pk2(v[0], v[1]); q.y = pk2(v[2], v[3]); q.z = pk2(v[4], v[5]); q.w = pk2(v[6], v[7]);
            if (hs >= 4) q = raw;
            *(u32x4*)(dstbuf + ((size_t)(b * 2 + g2) * 4096 + t) * 64 + sub * 8) = q;
        }
        if (lane < 24) GATES[(size_t)m * 24 + lane] = sigmoidf_(bf2f(row[C1_GL + lane]));
    }
    for (int it = gw; it < 2 * NB * 2 * 64; it += NGW) {
        const int tb = it & 63, g = (it >> 6) & 1, b = (it >> 7) & 7, w = it >> 10;
        const size_t m = (size_t)b * 4096 + tb * 64 + lane;
        unsigned r[32];
#pragma unroll
        for (int j = 0; j < 8; ++j) { const u32x4 q = *(const u32x4*)(P + m * N_IN1 + (w ? C1_VW : C1_VS) + g * 64 + j * 8); r[4 * j] = q.x; r[4 * j + 1] = q.y; r[4 * j + 2] = q.z; r[4 * j + 3] = q.w; }
        bf16_t* dst = (bf16_t*)(ws + (w ? L1_VWT : L1_VST)) + ((size_t)(b * 2 + g) * 64) * 4096 + tb * 64 + lane;
#pragma unroll
        for (int d = 0; d < 64; ++d) dst[(size_t)d * 4096] = (bf16_t)((d & 1) ? (r[d >> 1] >> 16) : (r[d >> 1] & 0xffffu));
    }
}

namespace pg8 {
struct EpiCmp1 {
    static constexpr bool PERM = true;
    bf16_t* O; const float* bias;
    __device__ __forceinline__ void operator()(const f32x4 (&acc)[2][2][4][2], const Unit& u, int wr, int wc, int fr, int fq) const {
        const int row0 = u.pm * BM + wr * 64 + fr, col0 = wc * 32 + 8 * fq;
#pragma unroll
        for (int ai = 0; ai < 2; ++ai)
#pragma unroll
            for (int m = 0; m < 4; ++m) { bf16_t* rowp = O + (size_t)(row0 + ai * HALF + m * 16) * 256 + col0;
#pragma unroll
                for (int bj = 0; bj < 2; ++bj) { const float* bp = bias + u.pn * 256 + col0 + bj * HALF;
                    const f32x4 v0 = acc[ai][bj][m][0] + *(const f32x4*)bp, v1 = acc[ai][bj][m][1] + *(const f32x4*)(bp + 4);
                    u32x4 w; w.x = pk2(gelu_tanh(v0[0]), gelu_tanh(v0[1])); w.y = pk2(gelu_tanh(v0[2]), gelu_tanh(v0[3]));
                    w.z = pk2(gelu_tanh(v1[0]), gelu_tanh(v1[1])); w.w = pk2(gelu_tanh(v1[2]), gelu_tanh(v1[3]));
                    *(u32x4*)(rowp + bj * HALF) = w; }
                asm volatile("" ::: "memory"); __builtin_amdgcn_sched_barrier(0); }
    }
};
struct EpiCmp2 {
    static constexpr bool PERM = false;
    float* C;
    __device__ __forceinline__ void operator()(const f32x4 (&acc)[2][2][4][2], const Unit& u, int wr, int wc, int fr, int fq) const {
        if (wc >= 2) return;
        const int row0 = u.pm * BM + wr * 64 + fr, col0 = wc * 32 + 4 * fq;
#pragma unroll
        for (int ai = 0; ai < 2; ++ai)
#pragma unroll
            for (int m = 0; m < 4; ++m)
#pragma unroll
                for (int n = 0; n < 2; ++n) *(f32x4*)(C + (size_t)(row0 + ai * HALF + m * 16) * 64 + col0 + n * 16) = acc[ai][0][m][n];
    }
};
}

__device__ __forceinline__ void p_cmp_final(const Frame& F, const Args& a, unsigned char* ws) {
    const float* CMPO = (const float*)(ws + L1_CMPO); const f32x2* rope = (const f32x2*)(ws + WS_ROPE);
    bf16_t* KC = (bf16_t*)(ws + L1_KC); bf16_t* VCT = (bf16_t*)(ws + L1_VCT);
    const int gw = F.bid * NWAVES + F.wave, NGW = F.G * NWAVES, lane = F.lane;
    const float kg = a.in[I_L1_KG][lane];
    for (int r = gw; r < 8192; r += NGW) {
        float v = CMPO[(size_t)r * 64 + lane];
        const int rr = r & 4095, bg = rr >> 8, c = rr & 255;
        if (r < 4096) {
            const float ss = wave_sum(v * v);
            v = v * (1.0f / sqrtf(ss * (1.f / 64.f) + 1e-6f)) * kg;
            const int pos = (c < 255) ? 16 * c + 31 : 0;
            v = rope_apply(v, rope[pos * 32 + (lane & 31)], lane);
            KC[((size_t)bg * 256 + c) * 64 + lane] = (c < 255) ? (bf16_t)f2bf(v) : (bf16_t)0;
        } else {
            VCT[((size_t)bg * 64 + lane) * 256 + c] = (c < 255) ? (bf16_t)f2bf(v) : (bf16_t)0;
        }
    }
}

__device__ __forceinline__ void att_load2(AttStage& s, const bf16_t* Kg, const bf16_t* Vtg, int vstride, int key0, int tid) {
    s.kreg = *(const u32x4*)(Kg + (size_t)(key0 + (tid >> 3)) * 64 + (tid & 7) * 8);
    s.vreg = *(const u32x4*)(Vtg + (size_t)(tid >> 3) * vstride + key0 + (tid & 7) * 8);
}
__device__ __forceinline__ float score_bound_c2(const float* qg, const float* kg) {
    float mq = 0.f, mk_ = 0.f;
    for (int i = 0; i < 64; ++i) { mq = fmaxf(mq, fabsf(qg[i])); mk_ = fmaxf(mk_, fabsf(kg[i])); }
    return (8.0f * mq * mk_ + 0.5f) * 1.4426950408889634f;
}

constexpr int CA_KB = 256 * 144, CA_VSTR = 528, CA_VB = 64 * CA_VSTR, CA_IMP = CA_KB + CA_VB;
__device__ __forceinline__ void p_cmp_attn(const Frame& F, const Args& a, unsigned char* ws) {
    const bf16_t* QN = (const bf16_t*)(ws + L1_QN); const bf16_t* KC = (const bf16_t*)(ws + L1_KC); const bf16_t* VCT = (const bf16_t*)(ws + L1_VCT);
    float* OC = (float*)(ws + L1_OC); u64* SELB = (u64*)(ws + L1_SELB);
    LAS float* impL = (LAS float*)(F.lds + CA_IMP);
    const int lane = F.lane, wave = F.wave, h = lane >> 5, c = lane & 31, tid = F.tid;
    const float c2 = score_bound_c2(a.in[I_L1_QG], a.in[I_L1_KG]), c1 = 1.4426950408889634f;
    for (int u = F.bid; u < 1024; u += F.G) {
        const int b = (u >> 7) & 7, g = (u >> 6) & 1, rnd = u >> 8, qt = (rnd & 1) ? 63 - (u & 63) : (u & 63), q0 = qt * 64;
        const int bg = b * 2 + g; const size_t mb = (size_t)b * 4096;
        const int t = q0 + wave * 8 + (c >> 2), head = g * 4 + (c & 3);
        bf16x8 Qf[4];
#pragma unroll
        for (int ks = 0; ks < 4; ++ks) Qf[ks] = *(const bf16x8*)(QN + (mb + t) * 512 + head * 64 + ks * 16 + 8 * h);
        const int L = (t >= 31) ? (((t - 31) >> 4) < 254 ? ((t - 31) >> 4) : 254) : -1;
        const int tmax = q0 + 63; const int Lmax = (tmax >= 31) ? (((tmax - 31) >> 4) < 254 ? ((tmax - 31) >> 4) : 254) : -1;
        const int nkt = (Lmax >= 0) ? (Lmax >> 6) + 1 : 0;
        const bf16_t* Kg = KC + (size_t)bg * 256 * 64; const bf16_t* Vtg = VCT + (size_t)bg * 64 * 256;
        __syncthreads();
        for (int i = tid; i < nkt * 512; i += NTHREADS) {
            const int key = i >> 3, ch = i & 7;
            *(LAS u32x4*)(F.lds + key * 144 + ch * 16) = *(const u32x4*)(Kg + (size_t)key * 64 + ch * 8);
        }
        for (int i = tid; i < 64 * nkt * 8; i += NTHREADS) {
            const int d = i / (nkt * 8), ch = i % (nkt * 8);
            const u32x4 v = *(const u32x4*)(Vtg + (size_t)d * 256 + ch * 8);
            LAS unsigned char* p = F.lds + CA_KB + d * CA_VSTR + ch * 16;
            *(LAS u32x2*)p = (u32x2){v.x, v.y}; *(LAS u32x2*)(p + 8) = (u32x2){v.z, v.w};
        }
        __syncthreads();
        f32x16 O[2], IMP[2]; float l = 0.f;
#pragma unroll
        for (int i = 0; i < 16; ++i) { O[0][i] = 0.f; O[1][i] = 0.f; IMP[0][i] = 0.f; IMP[1][i] = 0.f; }
        for (int st = 0; st < nkt * 2; ++st) {
            f32x16 S = {0.f, 0.f, 0.f, 0.f, 0.f, 0.f, 0.f, 0.f, 0.f, 0.f, 0.f, 0.f, 0.f, 0.f, 0.f, 0.f};
            { const LAS unsigned char* kp = F.lds + (st * 32 + c) * 144 + h * 16;
#pragma unroll
              for (int ks = 0; ks < 4; ++ks) S = __builtin_amdgcn_mfma_f32_32x32x16_bf16(*(const LAS bf16x8*)(kp + ks * 32), Qf[ks], S, 0, 0, 0); }
            float p[16];
#pragma unroll
            for (int i = 0; i < 16; ++i) {
                const int cidx = st * 32 + (i & 3) + 8 * (i >> 2) + 4 * h;
                const float e = __builtin_amdgcn_exp2f(S[i] * c1 - c2);
                p[i] = (cidx <= L) ? e : 0.f; l += p[i];
            }
            const bf16x8 P0 = pack8(p[0], p[1], p[2], p[3], p[4], p[5], p[6], p[7]);
            const bf16x8 P1 = pack8(p[8], p[9], p[10], p[11], p[12], p[13], p[14], p[15]);
#pragma unroll
            for (int dt = 0; dt < 2; ++dt) {
                const LAS unsigned char* vp = F.lds + CA_KB + (dt * 32 + c) * CA_VSTR + (st * 32 + 4 * h) * 2;
                const u32x2 a0 = *(const LAS u32x2*)(vp), a1 = *(const LAS u32x2*)(vp + 16), b0 = *(const LAS u32x2*)(vp + 32), b1 = *(const LAS u32x2*)(vp + 48);
                O[dt] = __builtin_amdgcn_mfma_f32_32x32x16_bf16(__builtin_bit_cast(bf16x8, ((u32x4){a0.x, a0.y, a1.x, a1.y})), P0, O[dt], 0, 0, 0);
                O[dt] = __builtin_amdgcn_mfma_f32_32x32x16_bf16(__builtin_bit_cast(bf16x8, ((u32x4){b0.x, b0.y, b1.x, b1.y})), P1, O[dt], 0, 0, 0);
            }
#pragma unroll
            for (int jt = 0; jt < 2; ++jt)
#pragma unroll
                for (int s = 0; s < 2; ++s) {
                    unsigned wv[4];
#pragma unroll
                    for (int e2 = 0; e2 < 4; ++e2) {
                        unsigned pr = 0u;
#pragma unroll
                        for (int q = 0; q < 2; ++q) { const int jj = 2 * e2 + q; const int kap = 16 * s + 8 * (jj >> 2) + 4 * h + (jj & 3);
                            const int off = st * 32 + kap - 4 * (32 * jt + c);
                            const unsigned wbits = (off == 0 || off == 4) ? 0x3F80u : ((off >= 1 && off <= 3) ? 0x4000u : 0u);
                            pr |= wbits << (16 * q); }
                        wv[e2] = pr;
                    }
                    const bf16x8 Wf = __builtin_bit_cast(bf16x8, ((u32x4){wv[0], wv[1], wv[2], wv[3]}));
                    IMP[jt] = __builtin_amdgcn_mfma_f32_32x32x16_bf16(Wf, s ? P1 : P0, IMP[jt], 0, 0, 0);
                }
        }
        const float lt = l + __shfl_xor(l, 32);
        const float inv = 1.0f / fmaxf(lt, 1e-30f);
        { float* orow = OC + (mb + t) * 512 + head * 64;
#pragma unroll
          for (int dt = 0; dt < 2; ++dt)
#pragma unroll
            for (int i4 = 0; i4 < 4; ++i4) { const int d = dt * 32 + 8 * i4 + 4 * h;
                *(f32x4*)(orow + d) = (f32x4){O[dt][4 * i4] * inv, O[dt][4 * i4 + 1] * inv, O[dt][4 * i4 + 2] * inv, O[dt][4 * i4 + 3] * inv}; } }
#pragma unroll
        for (int jt = 0; jt < 2; ++jt)
#pragma unroll
            for (int i = 0; i < 16; ++i) {
                float v = IMP[jt][i] * inv; v += __shfl_xor(v, 1); v += __shfl_xor(v, 2);
                if ((c & 3) == 0) impL[(wave * 8 + (c >> 2)) * 65 + 32 * jt + (i & 3) + 8 * (i >> 2) + 4 * h] = v;
            }
        __syncthreads();
        if (tid < 64) {
            const int tq = q0 + tid, cur = tq >> 6;
            u64 mask;
            if (cur + 1 <= 16) mask = (1ull << (cur + 1)) - 1ull;
            else {
                unsigned top[16];
#pragma unroll
                for (int blk = 0; blk < 4; ++blk) {
                    unsigned k16[16];
#pragma unroll
                    for (int i = 0; i < 16; ++i) { const int j = blk * 16 + i; const float x = impL[tid * 65 + j];
                        const unsigned key = (j > cur) ? 0u : ((j == 0 || j == cur) ? 0xFFFFFFC0u : (mono_u32(x) & ~0x3Fu)) | (unsigned)(63 - j);
                        k16[i] = (j > cur) ? 0u : key; }
                    sort16_desc(k16);
                    if (blk == 0) {
#pragma unroll
                        for (int i = 0; i < 16; ++i) top[i] = k16[i];
                    } else merge16_desc(top, k16);
                }
                mask = 0ull;
#pragma unroll
                for (int i = 0; i < 16; ++i) mask |= 1ull << (63 - (int)(top[i] & 63u));
            }
            SELB[(size_t)bg * 4096 + tq] = mask;
        }
    }
}

template <bool MASKED>
__device__ __forceinline__ void nsa_run(const Frame& F, int kt0, int kt1, int kt_hi, AttStage& st, const bf16_t* Kg, const bf16_t* Vtg, const bf16x8 (&Qf)[2][4], const u64 (&selw)[2], const int (&qidx)[2],
                                        const float c1, const float c2, const int wlen, f32x16 (&O)[2][2], float (&l)[2]) {
    const int lane = F.lane, h = lane >> 5, tid = F.tid;
#pragma unroll 1
    for (int kt = kt0; kt < kt1; ++kt) {
        LAS unsigned char* buf = F.lds + (kt & 1) * AT_BUF;
        if (kt + 1 < kt_hi) att_load(st, Kg, Vtg, (kt + 1) * 64, tid);
#pragma unroll 1
        for (int sub = 0; sub < 2; ++sub) {
            bf16x8 Kf[4];
            att_kfrags(buf, sub, Kf, lane);
#pragma unroll
            for (int ct = 0; ct < 2; ++ct) {
                __builtin_amdgcn_sched_barrier(0);
                const f32x16 S = att_qk_f(Kf, Qf[ct]);
                const bool flag = (selw[ct] >> kt) & 1ull;
                const float c2e = flag ? c2 : 3.0e30f;
                const int dbase = qidx[ct] - (kt * 64 + sub * 32 + 4 * h);
                float p[16];
#pragma unroll
                for (int i = 0; i < 16; ++i) {
                    const float e = __builtin_amdgcn_exp2f(S[i] * c1 - c2e);
                    p[i] = (!MASKED || (unsigned)(dbase - ((i & 3) + 8 * (i >> 2))) < (unsigned)wlen) ? e : 0.f; l[ct] += p[i];
                }
                const bf16x8 P0 = pack8(p[0], p[1], p[2], p[3], p[4], p[5], p[6], p[7]);
                const bf16x8 P1 = pack8(p[8], p[9], p[10], p[11], p[12], p[13], p[14], p[15]);
                att_pv2(buf, sub, P0, P1, O[ct], lane);
            }
        }
        if (kt + 1 < kt_hi) att_store(st, F.lds + ((kt + 1) & 1) * AT_BUF, tid);
        __syncthreads();
    }
}
__device__ __forceinline__ void p_nsa_attn(const Frame& F, const Args& a, unsigned char* ws) {
    const bf16_t* QN = (const bf16_t*)(ws + L1_QN);
    const u64* SELB = (const u64*)(ws + L1_SELB); float* OC = (float*)(ws + L1_OC); const float* GATES = (const float*)(ws + L1_GATES);
    bf16_t* CAT = (bf16_t*)(ws + L1_CAT);
    const int lane = F.lane, wave = F.wave, h = lane >> 5, c = lane & 31, tid = F.tid;
    const float c2 = score_bound_c2(a.in[I_L1_QG], a.in[I_L1_KG]), c1 = 1.4426950408889634f;
    for (int u = F.bid; u < 512; u += F.G) {
        const int idx = u & 255, g = u >> 8, b = idx >> 5, qtr = idx & 31, qt = g ? 31 - qtr : qtr, q0 = qt * 128;
        const int bg = b * 2 + g; const size_t mb = (size_t)b * 4096;
        bf16x8 Qf[2][4]; int qidx[2];
#pragma unroll
        for (int ct = 0; ct < 2; ++ct) { qidx[ct] = q0 + wave * 16 + ct * 8 + (c >> 2);
#pragma unroll
            for (int ks = 0; ks < 4; ++ks) Qf[ct][ks] = *(const bf16x8*)(QN + (mb + qidx[ct]) * 512 + (g * 4 + (c & 3)) * 64 + ks * 16 + 8 * h); }
        const int head = g * 4 + (c & 3);
#pragma unroll 1
        for (int pass = 0; pass < 2; ++pass) {
            const bf16_t* Kg = (const bf16_t*)(ws + (pass ? L1_KW : L1_KS)) + (size_t)bg * 4096 * 64;
            const bf16_t* Vtg = (const bf16_t*)(ws + (pass ? L1_VWT : L1_VST)) + (size_t)bg * 64 * 4096;
            u64 selw[2];
#pragma unroll
            for (int ct = 0; ct < 2; ++ct) selw[ct] = pass ? ~0ull : SELB[(size_t)bg * 4096 + qidx[ct]];
            const int wlen = pass ? 512 : 0x7fffffff;
            f32x16 O[2][2]; float l[2] = {0.f, 0.f};
#pragma unroll
            for (int ct = 0; ct < 2; ++ct)
#pragma unroll
                for (int dt = 0; dt < 2; ++dt)
#pragma unroll
                    for (int i = 0; i < 16; ++i) O[ct][dt][i] = 0.f;
            const int kt_lo = pass ? ((2 * qt - 8) > 0 ? 2 * qt - 8 : 0) : 0, kt_hi = 2 * qt + 2;
            int ka = pass ? 2 * qt - 6 : 0; ka = ka < kt_lo ? kt_lo : ka; const int kb = 2 * qt;
            AttStage st; att_load(st, Kg, Vtg, kt_lo * 64, tid);
            __syncthreads();
            att_store(st, F.lds + (kt_lo & 1) * AT_BUF, tid);
            __syncthreads();
            nsa_run<true>(F, kt_lo, ka, kt_hi, st, Kg, Vtg, Qf, selw, qidx, c1, c2, wlen, O, l);
            nsa_run<false>(F, ka, kb, kt_hi, st, Kg, Vtg, Qf, selw, qidx, c1, c2, wlen, O, l);
            nsa_run<true>(F, kb, kt_hi, kt_hi, st, Kg, Vtg, Qf, selw, qidx, c1, c2, wlen, O, l);
#pragma unroll
            for (int ct = 0; ct < 2; ++ct) {
                const float lt = l[ct] + __shfl_xor(l[ct], 32);
                const float inv = 1.0f / fmaxf(lt, 1e-30f);
                const size_t m = mb + qidx[ct];
                const float gcv = GATES[m * 24 + head * 3 + 0], gsv = GATES[m * 24 + head * 3 + 1], gwv = GATES[m * 24 + head * 3 + 2];
                float* orow = OC + m * 512 + head * 64; bf16_t* crow = CAT + m * 1024 + head * 64;
#pragma unroll
                for (int dt = 0; dt < 2; ++dt)
#pragma unroll
                    for (int i4 = 0; i4 < 4; ++i4) {
                        const int d = dt * 32 + 8 * i4 + 4 * h;
                        const f32x4 prev = *(const f32x4*)(orow + d);
                        const f32x4 ov = (f32x4){O[ct][dt][4 * i4] * inv, O[ct][dt][4 * i4 + 1] * inv, O[ct][dt][4 * i4 + 2] * inv, O[ct][dt][4 * i4 + 3] * inv};
                        if (pass == 0) *(f32x4*)(orow + d) = prev * gcv + ov * gsv;
                        else { const f32x4 r = prev + ov * gwv; u32x2 w; w.x = pk2(r[0], r[1]); w.y = pk2(r[2], r[3]); *(u32x2*)(crow + d) = w; }
                    }
            }
        }
    }
}

__device__ __forceinline__ float logsigmoidf_(float x) { return fminf(x, 0.f) - log1pf(__expf(-fabsf(x))); }
__device__ __forceinline__ bf16x8 frag_lds(const LAS float* p) { const f32x4 a = *(const LAS f32x4*)p, b = *(const LAS f32x4*)(p + 4); return pack8(a[0], a[1], a[2], a[3], b[0], b[1], b[2], b[3]); }
__device__ __forceinline__ bf16x8 frag_glb(const float* p) { const f32x4 a = *(const f32x4*)p, b = *(const f32x4*)(p + 4); return pack8(a[0], a[1], a[2], a[3], b[0], b[1], b[2], b[3]); }
__device__ __forceinline__ void gla_wave_bcum(const Args& a, const bf16_t* P, size_t m0, int hh, int lane, float (&bc)[32]) {
    float wg[16];
#pragma unroll
    for (int r = 0; r < 16; ++r) wg[r] = a.in[I_L1_WGATE][r * 256 + hh * 64 + lane];
    const float bgv = a.in[I_L1_BGATE][hh * 64 + lane];
    float run = 0.f;
#pragma unroll
    for (int c = 0; c < 32; ++c) {
        const bf16_t* grow = P + (m0 + c) * N_IN1 + C1_GLOW;
        const u32x4 ga = *(const u32x4*)grow, gb = *(const u32x4*)(grow + 8);
        float acc = bgv;
        acc += wg[0] * bf_lo(ga.x); acc += wg[1] * bf_hi(ga.x); acc += wg[2] * bf_lo(ga.y); acc += wg[3] * bf_hi(ga.y); acc += wg[4] * bf_lo(ga.z); acc += wg[5] * bf_hi(ga.z); acc += wg[6] * bf_lo(ga.w); acc += wg[7] * bf_hi(ga.w);
        acc += wg[8] * bf_lo(gb.x); acc += wg[9] * bf_hi(gb.x); acc += wg[10] * bf_lo(gb.y); acc += wg[11] * bf_hi(gb.y); acc += wg[12] * bf_lo(gb.z); acc += wg[13] * bf_hi(gb.z); acc += wg[14] * bf_lo(gb.w); acc += wg[15] * bf_hi(gb.w);
        run += logsigmoidf_(acc) * 0.0625f; bc[c] = run;
    }
}
__device__ __forceinline__ bf16x8 gla_vfrag(const bf16_t* vbase, int s0) {
    unsigned short e[8];
#pragma unroll
    for (int j = 0; j < 8; ++j) e[j] = vbase[(size_t)(s0 + j) * N_IN1];
    u32x4 w; w.x = (unsigned)e[0] | ((unsigned)e[1] << 16); w.y = (unsigned)e[2] | ((unsigned)e[3] << 16); w.z = (unsigned)e[4] | ((unsigned)e[5] << 16); w.w = (unsigned)e[6] | ((unsigned)e[7] << 16);
    return __builtin_bit_cast(bf16x8, w);
}
__device__ __forceinline__ void p_gla_a(const Frame& F, const Args& a, unsigned char* ws) {
    const bf16_t* P = (const bf16_t*)(ws + WS_PROJ); float* UPD = (float*)(ws + L1_UPD); float* DECAY = (float*)(ws + L1_DECAY);
    const int lane = F.lane, r = lane & 31, h = lane >> 5;
    LAS bf16_t* kdT = (LAS bf16_t*)(F.lds + F.wave * 5120);
    const int gw = F.bid * NWAVES + F.wave, NGW = F.G * NWAVES;
    for (int u = gw; u < 4096; u += NGW) {
        const int b = u >> 9, hh = (u >> 7) & 3, n = u & 127; const size_t m0 = (size_t)b * 4096 + n * 32;
        float bc[32];
        gla_wave_bcum(a, P, m0, hh, lane, bc);
        const float blast = bc[31];
#pragma unroll
        for (int c = 0; c < 32; c += 2) {
            const float k0 = bf2f(P[(m0 + c) * N_IN1 + C1_GK + hh * 64 + lane]) * __expf(blast - bc[c]);
            const float k1 = bf2f(P[(m0 + c + 1) * N_IN1 + C1_GK + hh * 64 + lane]) * __expf(blast - bc[c + 1]);
            *(LAS unsigned*)(kdT + lane * 40 + c) = pk2(k0, k1);
        }
        DECAY[(size_t)u * 64 + lane] = __expf(blast);
        LDS_WAIT();
        bf16x8 Bf[2][2];
#pragma unroll
        for (int nt = 0; nt < 2; ++nt)
#pragma unroll
            for (int ks = 0; ks < 2; ++ks) Bf[nt][ks] = *(const LAS bf16x8*)(kdT + (32 * nt + r) * 40 + 16 * ks + 8 * h);
#pragma unroll
        for (int mt = 0; mt < 4; ++mt) {
            const bf16_t* vb = P + m0 * N_IN1 + C1_GV + hh * 128 + 32 * mt + r;
            const bf16x8 A0 = gla_vfrag(vb, 8 * h), A1 = gla_vfrag(vb, 16 + 8 * h);
#pragma unroll
            for (int nt = 0; nt < 2; ++nt) {
                f32x16 acc = {0.f, 0.f, 0.f, 0.f, 0.f, 0.f, 0.f, 0.f, 0.f, 0.f, 0.f, 0.f, 0.f, 0.f, 0.f, 0.f};
                acc = __builtin_amdgcn_mfma_f32_32x32x16_bf16(A0, Bf[nt][0], acc, 0, 0, 0);
                acc = __builtin_amdgcn_mfma_f32_32x32x16_bf16(A1, Bf[nt][1], acc, 0, 0, 0);
                float* up = UPD + (size_t)u * 8192 + 32 * nt + r;
#pragma unroll
                for (int i = 0; i < 16; ++i) up[(size_t)(32 * mt + (i & 3) + 8 * (i >> 2) + 4 * h) * 64] = acc[i];
            }
        }
        LDS_WAIT();
    }
}
__device__ __forceinline__ void p_gla_b(const Frame& F, unsigned char* ws) {
    float* UPD = (float*)(ws + L1_UPD); const float* DECAY = (const float*)(ws + L1_DECAY);
    for (int e = F.bid * NTHREADS + F.tid; e < 32 * 8192; e += F.G * NTHREADS) {
        const int bh = e >> 13, rem = e & 8191, dk = rem & 63;
        float state = 0.f;
        float* up = UPD + (size_t)bh * 128 * 8192 + rem; const float* dp = DECAY + (size_t)bh * 128 * 64 + dk;
#pragma unroll 8
        for (int n = 0; n < 128; ++n) { const float uv = up[(size_t)n * 8192], dc = dp[n * 64]; up[(size_t)n * 8192] = state; state = dc * state + uv; }
    }
}
__device__ __forceinline__ void p_gla_c(const Frame& F, const Args& a, unsigned char* ws, const int mode) {
    const bf16_t* P = (const bf16_t*)(ws + WS_PROJ); const float* PREV = (const float*)(ws + L1_UPD); bf16_t* CAT = (bf16_t*)(ws + L1_CAT);
    const int lane = F.lane, r = lane & 31, h = lane >> 5;
    LAS bf16_t* qd = (LAS bf16_t*)(F.lds + F.wave * 9472);
    LAS bf16_t* ki = qd + 32 * 72;
    const int gw = F.bid * NWAVES + F.wave, NGW = F.G * NWAVES;
    for (int u = gw; u < 4096; u += NGW) {
        const int b = u >> 9, hh = (u >> 7) & 3, n = u & 127; const size_t m0 = (size_t)b * 4096 + n * 32;
        f32x4 pr_[8]; unsigned short vr_[16];
#define GLA_FETCH(ct_) do { const float* pp_ = PREV + (size_t)u * 8192 + (size_t)(32 * (ct_) + r) * 64 + 8 * h; \
            _Pragma("unroll") for (int ks_ = 0; ks_ < 4; ++ks_) { pr_[2 * ks_] = *(const f32x4*)(pp_ + 16 * ks_); pr_[2 * ks_ + 1] = *(const f32x4*)(pp_ + 16 * ks_ + 4); } \
            const bf16_t* vb_ = P + m0 * N_IN1 + C1_GV + hh * 128 + 32 * (ct_) + r; \
            _Pragma("unroll") for (int j_ = 0; j_ < 16; ++j_) vr_[j_] = vb_[(size_t)(8 * h + (j_ & 7) + 16 * (j_ >> 3)) * N_IN1]; } while (0)
        GLA_FETCH(0);
        {
            float bc[32];
            if (mode == 1) {
#pragma unroll
                for (int c = 0; c < 32; ++c) bc[c] = -0.01f * (float)c;
            } else gla_wave_bcum(a, P, m0, hh, lane, bc);
#pragma unroll
            for (int c = 0; c < 32; ++c) {
                const float kv = bf2f(P[(m0 + c) * N_IN1 + C1_GK + hh * 64 + lane]) * __expf(-bc[c]);
                const float qv = bf2f(P[(m0 + c) * N_IN1 + C1_GQ + hh * 64 + lane]) * 0.125f * __expf(bc[c]);
                ki[c * 72 + lane] = (bf16_t)f2bf(kv); qd[c * 72 + lane] = (bf16_t)f2bf(qv);
            }
        }
        LDS_WAIT();
        bf16x8 Qa[4];
#pragma unroll
        for (int ks = 0; ks < 4; ++ks) Qa[ks] = *(const LAS bf16x8*)(qd + r * 72 + 16 * ks + 8 * h);
        {
            f32x16 at = {0.f, 0.f, 0.f, 0.f, 0.f, 0.f, 0.f, 0.f, 0.f, 0.f, 0.f, 0.f, 0.f, 0.f, 0.f, 0.f};
#pragma unroll
            for (int ks = 0; ks < 4; ++ks) at = __builtin_amdgcn_mfma_f32_32x32x16_bf16(Qa[ks], *(const LAS bf16x8*)(ki + r * 72 + 16 * ks + 8 * h), at, 0, 0, 0);
            LDS_WAIT();
#pragma unroll
            for (int i = 0; i < 16; ++i) { const int c = (i & 3) + 8 * (i >> 2) + 4 * h; ki[c * 40 + r] = (bf16_t)f2bf((r <= c) ? at[i] : 0.f); }
        }
        LDS_WAIT();
        bf16x8 Aa[2];
#pragma unroll
        for (int ks = 0; ks < 2; ++ks) Aa[ks] = *(const LAS bf16x8*)(ki + r * 40 + 16 * ks + 8 * h);
        f32x16 acc[4];
#pragma unroll
        for (int ct = 0; ct < 4; ++ct) {
            bf16x8 Bp[4], Bv[2];
#pragma unroll
            for (int ks = 0; ks < 4; ++ks) Bp[ks] = pack8(pr_[2 * ks][0], pr_[2 * ks][1], pr_[2 * ks][2], pr_[2 * ks][3], pr_[2 * ks + 1][0], pr_[2 * ks + 1][1], pr_[2 * ks + 1][2], pr_[2 * ks + 1][3]);
#pragma unroll
            for (int ks = 0; ks < 2; ++ks) { u32x4 w; w.x = (unsigned)vr_[8 * ks] | ((unsigned)vr_[8 * ks + 1] << 16); w.y = (unsigned)vr_[8 * ks + 2] | ((unsigned)vr_[8 * ks + 3] << 16);
                w.z = (unsigned)vr_[8 * ks + 4] | ((unsigned)vr_[8 * ks + 5] << 16); w.w = (unsigned)vr_[8 * ks + 6] | ((unsigned)vr_[8 * ks + 7] << 16); Bv[ks] = __builtin_bit_cast(bf16x8, w); }
            if (ct < 3) GLA_FETCH(ct + 1);
#pragma unroll
            for (int i = 0; i < 16; ++i) acc[ct][i] = 0.f;
#pragma unroll
            for (int ks = 0; ks < 4; ++ks) acc[ct] = __builtin_amdgcn_mfma_f32_32x32x16_bf16(Qa[ks], Bp[ks], acc[ct], 0, 0, 0);
#pragma unroll
            for (int ks = 0; ks < 2; ++ks) acc[ct] = __builtin_amdgcn_mfma_f32_32x32x16_bf16(Aa[ks], Bv[ks], acc[ct], 0, 0, 0);
        }
#undef GLA_FETCH
#pragma unroll
        for (int i = 0; i < 16; ++i) {
            float ss = acc[0][i] * acc[0][i] + acc[1][i] * acc[1][i] + acc[2][i] * acc[2][i] + acc[3][i] * acc[3][i];
            ss += __shfl_xor(ss, 1); ss += __shfl_xor(ss, 2); ss += __shfl_xor(ss, 4); ss += __shfl_xor(ss, 8); ss += __shfl_xor(ss, 16);
            const float rstd = 1.0f / sqrtf(ss * (1.f / 128.f) + 1e-6f);
            const int c = (i & 3) + 8 * (i >> 2) + 4 * h; const size_t m = m0 + c;
#pragma unroll
            for (int ct = 0; ct < 4; ++ct) { const int dv = 32 * ct + r;
                const float rv = bf2f(P[m * N_IN1 + C1_GR + hh * 128 + dv]);
                const bf16_t ov = (bf16_t)f2bf(acc[ct][i] * rstd * a.in[I_L1_OGAIN][dv] * rv * sigmoidf_(rv));
                if (mode == 0) CAT[m * 1024 + 512 + hh * 128 + dv] = ov; else asm volatile("" :: "v"((unsigned)ov)); }
        }
        LDS_WAIT();
    }
}
__global__ void __launch_bounds__(NTHREADS, 2) mk_fwd(Args args) {
    extern __shared__ __attribute__((aligned(16))) unsigned char lds_raw[];
    cg::grid_group grid = cg::this_grid();
    Frame F; F.lds = (LAS unsigned char*)lds_raw; F.tid = threadIdx.x; F.lane = F.tid & 63; F.wave = __builtin_amdgcn_readfirstlane(F.tid >> 6); F.G = gridDim.x; F.bid = blockIdx.x;
    unsigned char* ws = args.ws;
    const int lo = args.ph_lo, hi = args.ph_hi;
#ifndef KEEPMASK
#define KEEPMASK 0xFFFFFFFFu
#endif
#define IN(k) (((KEEPMASK >> (k)) & 1u) && lo <= (k) && (k) < hi)
#define BOTH(k) (IN(k) && IN((k) + 1))
#ifndef TMODE
#define TMODE 0
#endif
#ifndef REPMASK
#define REPMASK 0u
#endif
#define PH(k, ...) if (IN(k)) { { const int rep = 0; (void)rep; __VA_ARGS__; } if ((REPMASK >> (k)) & 1u) { xcd_barrier(xbar); { const int rep = 1; (void)rep; __VA_ARGS__; } } }
#ifdef TS_A
#define STAMP(k) do { if (F.bid == 0 && F.tid == 0) ((unsigned long long*)(ws + WS_CTL + 65536))[(k)] = __builtin_amdgcn_s_memrealtime(); } while (0)
#else
#define STAMP(k) do { } while (0)
#endif
#define GRID_BAR(k) do { if (BOTH(k)) { if ((k) == 0) grid.sync(); else xcd_barrier(xbar); } STAMP((k) + 1); } while (0)
    const float* x = args.in[I_X];
    float* out = args.out;
    volatile LAS unsigned* xst = (volatile LAS unsigned*)(F.lds + LDS_BYTES - 64);
    if (F.tid < 16) xst[F.tid] = 0u;
    __syncthreads();
    XcdBarrier xbar = xcd_barrier_post((unsigned*)(ws + WS_CTL) + 4096, xst);

    STAMP(0);
    PH(0, int base = 0; transpose_all(F, base, args.in[I_L0_WIN], 1024, 1864, (bf16_t*)(ws + WS_W_IN0), 1024, MapIn0()); transpose_all(F, base, args.in[I_L0_WGLU], 512, 512, (bf16_t*)(ws + WS_W_GLU), 512, MapId()); transpose_all(F, base, args.in[I_L0_WOUT], 1024, 1024, (bf16_t*)(ws + WS_W_OUT0), 1024, MapId()); transpose_all(F, base, args.in[I_L0_WQ], 1024, 2048, (bf16_t*)(ws + WS_WQ0), 1024, MapId()); transpose_all(F, base, args.in[I_L1_WIN], 1024, 2856, (bf16_t*)(ws + WS_W_IN1), 1024, MapIn1()); transpose_all(F, base, args.in[I_L1_KW1], 2048, 256, (bf16_t*)(ws + WS_KW1), 2048, MapId()); transpose_all(F, base, args.in[I_L1_VW1], 2048, 256, (bf16_t*)(ws + WS_VW1), 2048, MapId()); transpose_all(F, base, args.in[I_L1_KW2], 256, 64, (bf16_t*)(ws + WS_KW2), 256, MapId()); transpose_all(F, base, args.in[I_L1_VW2], 256, 64, (bf16_t*)(ws + WS_VW2), 256, MapId()); transpose_all(F, base, args.in[I_L1_WOUT], 1024, 1024, (bf16_t*)(ws + WS_W_OUT1), 1024, MapId()); transpose_all(F, base, args.in[I_L1_WQ], 1024, 2048, (bf16_t*)(ws + WS_WQ1), 1024, MapId()); zero_bytes(F, ws + WS_W_IN0 + (size_t)1864 * 1024 * 2, (size_t)(2048 - 1864) * 1024 * 2); zero_bytes(F, ws + WS_W_IN1 + (size_t)2856 * 1024 * 2, (size_t)(3072 - 2856) * 1024 * 2); zero_bytes(F, ws + WS_KW2 + (size_t)64 * 256 * 2, (size_t)192 * 256 * 2); zero_bytes(F, ws + WS_VW2 + (size_t)64 * 256 * 2, (size_t)192 * 256 * 2); cvt_f32_bf16(F, args.in[I_L0_SK], (bf16_t*)(ws + WS_SK0), (size_t)16 * 128 * 128); cvt_f32_bf16(F, args.in[I_L1_SK], (bf16_t*)(ws + WS_SK1), (size_t)16 * 128 * 128); cvt_table_i8(F, args.in[I_L0_U], ws + WS_TAB8U, (float*)(ws + WS_TABSU), 32); cvt_table_fp8(F, args.in[I_L0_V], ws + WS_TAB8V, (float*)(ws + WS_TABSV), 32); p_rope_table(F, (f32x2*)(ws + WS_ROPE)); if (F.bid == F.G - 1) { for (int i = F.tid; i < 1024; i += NTHREADS) ((float*)(ws + WS_CMPB + 4096))[i] = args.in[I_L1_MIXN][i]; } __syncthreads(); for (int g = F.bid; g < 32; g += F.G) s5_build_group(F, args, ws, g); for (int j = (F.bid + F.G - (32 % F.G)) % F.G; j < 64; j += F.G) cmp_bias(F, args, (float*)(ws + WS_CMPB), j); p_rmsnorm(F, x, args.in[I_L0_MIXN], (bf16_t*)(ws + WS_XN));)
    GRID_BAR(0);
    PH(1, pg8::Gemm g{(const bf16_t*)(ws + WS_XN), (const bf16_t*)(ws + WS_W_IN0), T, N_IN0, 1024, 1024, 1024}; pg8::StaticOrder S; S.init(T, N_IN0, F.G, F.bid); pg8::EpiStoreBf16 E{(bf16_t*)(ws + WS_PROJ), N_IN0}; pg8::gemm_phase(F.lds, g, S, E);)
    GRID_BAR(1);
    PH(2, p_l0_prep(F, args, ws);)
    GRID_BAR(2);
    PH(3, p_dsa_index(F, ws, (u64*)(ws + (rep ? L0_CAT : L0_SELT)), rep ? TMODE : 0); { pg8::Gemm g{(const bf16_t*)(ws + L0_UA), (const bf16_t*)(ws + WS_S5B1), 65536, 8192, 256, 384, 256}; pg8::GroupedOrder S; S.init(256, 8, F.G, F.bid); pg8::EpiS5State E{(float*)(ws + L0_SLOC)}; pg8::gemm_phase(F.lds, g, S, E); })
    GRID_BAR(3);
    PH(4, p_s5_scan(F, args, ws); p_dsa_attn(F, args, ws);)
    GRID_BAR(4);
    PH(7, pg8::Gemm g{(const bf16_t*)(ws + L0_UA), (const bf16_t*)(ws + WS_S5B2), 65536, 8192, 384, 384, 384}; pg8::GroupedOrder S; S.init(256, 8, F.G, F.bid); pg8::EpiS5Out E{(bf16_t*)(ws + L0_YB)}; pg8::gemm_phase(F.lds, g, S, E);)
    GRID_BAR(7);
    PH(8, pg8::Gemm g{(const bf16_t*)(ws + L0_YB), (const bf16_t*)(ws + WS_W_GLU), T, 512, 512, 512, 512}; pg8::StaticOrder S; S.init(T, 512, F.G, F.bid); pg8::EpiGlu E{(const bf16_t*)(ws + L0_YB), args.in[I_L0_BGLU], (bf16_t*)(ws + L0_CAT)}; pg8::gemm_phase(F.lds, g, S, E);)
    GRID_BAR(8);
    PH(9, pg8::Gemm g{(const bf16_t*)(ws + L0_CAT), (const bf16_t*)(ws + WS_W_OUT0), T, 1024, 1024, 1024, 1024}; pg8::StaticOrder S; S.init(T, 1024, F.G, F.bid); pg8::EpiResidF32 E{x, out, 1024}; pg8::gemm_phase(F.lds, g, S, E);)
    GRID_BAR(9);
    PH(10, p_rmsnorm(F, out, args.in[I_L0_FFNN], (bf16_t*)(ws + WS_XN));)
    GRID_BAR(10);
    PH(11, pg8::Gemm g{(const bf16_t*)(ws + WS_XN), (const bf16_t*)(ws + WS_WQ0), T, 2048, 1024, 1024, 1024}; pg8::StaticOrder S; S.init(T, 2048, F.G, F.bid); pg8::EpiStoreBf16 E{(bf16_t*)(ws + PE_Q2), 2048}; pg8::gemm_phase(F.lds, g, S, E);)
    GRID_BAR(11);
    PH(12, p_peer_route(F, ws, (const bf16_t*)(ws + WS_SK0));)
    GRID_BAR(12);
    PH(13, p_peer_expert5(F, ws, out, rep ? 0.f : 1.f, xbar, rep ? TMODE : 0, true);)
    GRID_BAR(13);
    PH(15, pg8::Gemm g{(const bf16_t*)(ws + WS_XN), (const bf16_t*)(ws + WS_W_IN1), T, N_IN1, 1024, 1024, 1024}; pg8::StaticOrder S; S.init(T, N_IN1, F.G, F.bid); pg8::EpiStoreBf16 E{(bf16_t*)(ws + WS_PROJ), N_IN1}; pg8::gemm_phase(F.lds, g, S, E);)
    GRID_BAR(15);
    PH(16, p_l1_prep(F, args, ws);)
    GRID_BAR(16);
    PH(17, pg8::Gemm g{(const bf16_t*)(ws + L1_KCR), (const bf16_t*)(ws + WS_KW1), 8192, 512, 2048, 1024, 2048}; pg8::GroupedOrder S; S.init(32, 16, F.G, F.bid); pg8::EpiCmp1 E{(bf16_t*)(ws + L1_H1), (const float*)(ws + WS_CMPB)}; pg8::gemm_phase(F.lds, g, S, E);)
    GRID_BAR(17);
    PH(18, pg8::Gemm g{(const bf16_t*)(ws + L1_H1), (const bf16_t*)(ws + WS_KW2), 8192, 512, 256, 256, 256}; pg8::GroupedOrder S; S.init(32, 16, F.G, F.bid); pg8::EpiCmp2 E{(float*)(ws + L1_CMPO)}; pg8::gemm_phase(F.lds, g, S, E);)
    GRID_BAR(18);
    PH(19, p_cmp_final(F, args, ws);)
    GRID_BAR(19);
    PH(20, p_cmp_attn(F, args, ws);)
    GRID_BAR(20);
    PH(21, if (rep) { p_cmp_attn(F, args, ws); xcd_barrier(xbar); } p_nsa_attn(F, args, ws);)
    GRID_BAR(21);
    PH(22, p_gla_a(F, args, ws); cvt_table_i8(F, args.in[I_L1_U], ws + WS_TAB8U, (float*)(ws + WS_TABSU), 0); cvt_table_fp8(F, args.in[I_L1_V], ws + WS_TAB8V, (float*)(ws + WS_TABSV), 0);)
    GRID_BAR(22);
    PH(23, if (rep) { p_gla_a(F, args, ws); xcd_barrier(xbar); } p_gla_b(F, ws);)
    GRID_BAR(23);
    PH(24, p_gla_c(F, args, ws, rep ? TMODE : 0);)
    GRID_BAR(24);
    PH(25, pg8::Gemm g{(const bf16_t*)(ws + L1_CAT), (const bf16_t*)(ws + WS_W_OUT1), T, 1024, 1024, 1024, 1024}; pg8::StaticOrder S; S.init(T, 1024, F.G, F.bid); pg8::EpiResidF32 E{out, out, 1024}; pg8::gemm_phase(F.lds, g, S, E);)
    GRID_BAR(25);
    PH(26, p_rmsnorm(F, out, args.in[I_L1_FFNN], (bf16_t*)(ws + WS_XN));)
    GRID_BAR(26);
    PH(27, pg8::Gemm g{(const bf16_t*)(ws + WS_XN), (const bf16_t*)(ws + WS_WQ1), T, 2048, 1024, 1024, 1024}; pg8::StaticOrder S; S.init(T, 2048, F.G, F.bid); pg8::EpiStoreBf16 E{(bf16_t*)(ws + PE_Q2), 2048}; pg8::gemm_phase(F.lds, g, S, E);)
    GRID_BAR(27);
    PH(28, p_peer_route(F, ws, (const bf16_t*)(ws + WS_SK1));)
    GRID_BAR(28);
    PH(29, p_peer_expert5(F, ws, out, rep ? 0.f : 1.f, xbar, rep ? TMODE : 0, false);)
#undef IN
#undef BOTH
}

extern "C" void kernel_launch(void* const* d_in, const int* in_sizes, int n_in, void* d_out, int out_size, void* d_ws, size_t ws_size, hipStream_t stream) {
    static int grid = 0;
    if (grid == 0) {
        if (n_in != 39 || ws_size < WS_END) { fprintf(stderr, "kernel_launch: unexpected n_in %d or ws_size %zu (< %zu)\n", n_in, ws_size, (size_t)WS_END); grid = -1; return; }
        int dev = 0, cus = 0, per_cu = 0;
        (void)hipGetDevice(&dev); (void)hipDeviceGetAttribute(&cus, hipDeviceAttributeMultiprocessorCount, dev);
        if (hipFuncSetAttribute((const void*)mk_fwd, hipFuncAttributeMaxDynamicSharedMemorySize, LDS_BYTES) != hipSuccess) { fprintf(stderr, "kernel_launch: hipFuncSetAttribute failed\n"); grid = -1; return; }
        if (hipOccupancyMaxActiveBlocksPerMultiprocessor(&per_cu, (const void*)mk_fwd, NTHREADS, LDS_BYTES) != hipSuccess || per_cu < 1) { fprintf(stderr, "kernel_launch: occupancy query failed (%d)\n", per_cu); (void)hipGetLastError(); grid = -1; return; }
        grid = cus;
    }
    if (grid < 0) return;
    (void)hipMemsetAsync((char*)d_ws + WS_CTL, 0, 1 * MiB, stream);
    Args a{};
    for (int i = 0; i < 39; ++i) a.in[i] = (const float*)d_in[i];
    a.out = (float*)d_out; a.ws = (unsigned char*)d_ws; a.ph_lo = 0; a.ph_hi = 1000;
    void* kargs[] = {&a};
    hipError_t e = hipLaunchCooperativeKernel((const void*)mk_fwd, dim3(grid), dim3(NTHREADS), kargs, LDS_BYTES, stream);
    if (e != hipSuccess) fprintf(stderr, "kernel_launch: cooperative launch failed: %s\n", hipGetErrorString(e));
}
```

```cpp
#include <hip/hip_runtime.h>
#include <hip/hip_cooperative_groups.h>
#include <cstdio>
#include <cstdint>
namespace cg = cooperative_groups;

#define LAS __attribute__((address_space(3)))
typedef unsigned short bf16_t;
typedef short bf16x8 __attribute__((ext_vector_type(8)));
typedef float f32x4 __attribute__((ext_vector_type(4)));
typedef float f32x2 __attribute__((ext_vector_type(2)));
typedef float f32x16 __attribute__((ext_vector_type(16)));
typedef unsigned u32x4 __attribute__((ext_vector_type(4)));
typedef unsigned u32x2 __attribute__((ext_vector_type(2)));
typedef unsigned long long u64;

constexpr int NB = 8, SEQ = 4096, DM = 1024, T = NB * SEQ;
constexpr int NTHREADS = 512, NWAVES = 8;
constexpr int LDS_BYTES = 147456;
constexpr int N_IN0 = 2048, N_IN1 = 3072;
constexpr int C0_Q = 0, C0_K = 512, C0_V = 640, C0_IQ = 768, C0_U = 1280, C0_IK = 1792, C0_IW = 1856;
constexpr int C1_Q = 0, C1_KC = 512, C1_VC = 640, C1_KS = 768, C1_VS = 896, C1_KW = 1024, C1_VW = 1152, C1_GQ = 1280, C1_GK = 1536, C1_GV = 1792, C1_GR = 2304, C1_GL = 2816, C1_GLOW = 2840;

constexpr size_t MiB = 1u << 20;
constexpr size_t WS_CTL = 0;
constexpr size_t WS_ROPE = 1 * MiB;
constexpr size_t WS_W_IN0 = 2 * MiB;
constexpr size_t WS_W_GLU = 6 * MiB;
constexpr size_t WS_SK0 = 6 * MiB + 512 * 1024;
constexpr size_t WS_W_OUT0 = 7 * MiB;
constexpr size_t WS_WQ0 = 9 * MiB;
constexpr size_t WS_W_IN1 = 13 * MiB;
constexpr size_t WS_KW1 = 19 * MiB;
constexpr size_t WS_VW1 = 20 * MiB;
constexpr size_t WS_KW2 = 21 * MiB;
constexpr size_t WS_VW2 = 21 * MiB + 128 * 1024;
constexpr size_t WS_SK1 = 21 * MiB + 512 * 1024;
constexpr size_t WS_W_OUT1 = 22 * MiB;
constexpr size_t WS_WQ1 = 24 * MiB;
constexpr size_t WS_S5B1 = 28 * MiB;
constexpr size_t WS_S5B2 = 32 * MiB;
constexpr size_t WS_CMPB = 38 * MiB;
constexpr size_t WS_TABU = 48 * MiB;
constexpr size_t WS_TABV = 80 * MiB;
constexpr size_t WS_XN = 112 * MiB;
constexpr size_t WS_PROJ = 176 * MiB;
constexpr size_t WS_R3 = 368 * MiB;
constexpr size_t WS_END = 506 * MiB;

__device__ __forceinline__ unsigned f2bf(float f) { unsigned u = __builtin_bit_cast(unsigned, f); return (u + 0x7fffu + ((u >> 16) & 1u)) >> 16; }
__device__ __forceinline__ unsigned pk2(float lo, float hi) { return f2bf(lo) | (f2bf(hi) << 16); }
__device__ __forceinline__ float bf_lo(unsigned u) { return __builtin_bit_cast(float, u << 16); }
__device__ __forceinline__ float bf_hi(unsigned u) { return __builtin_bit_cast(float, u & 0xffff0000u); }
__device__ __forceinline__ float bf2f(bf16_t b) { return __builtin_bit_cast(float, ((unsigned)b) << 16); }
__device__ __forceinline__ float wave_sum(float v) {
#pragma unroll
    for (int o = 1; o < 64; o <<= 1) v += __shfl_xor(v, o);
    return v;
}
__device__ __forceinline__ float gelu_tanh(float x) {
    const float y = 0.7978845608028654f * (x + 0.044715f * x * x * x);
    const float e = __expf(2.0f * y);
    const float th = 1.0f - 2.0f / (e + 1.0f);
    return 0.5f * x * (1.0f + th);
}
__device__ __forceinline__ float sigmoidf_(float x) { return 1.0f / (1.0f + __expf(-x)); }
#define LDS_WAIT() asm volatile("s_waitcnt lgkmcnt(0)" ::: "memory")
#define VM_WAIT() asm volatile("s_waitcnt vmcnt(0)" ::: "memory")

#define XB_TMO      128
#define XB_XCNT(j)  (256  + 64 * (j))
#define XB_XSUB(j)  (1280 + 64 * (j))
#define XB_XGEN(j)  (2304 + 64 * (j))
#define XB_TOP      3328
#define XB_TOPGEN   3392
#define XCD_BAR_WORDS 3456
#define XB_SPIN_CAP (1u << 22)
__device__ __forceinline__ unsigned xb_ld(unsigned* p)              { return __hip_atomic_load(p, __ATOMIC_RELAXED, __HIP_MEMORY_SCOPE_AGENT); }
__device__ __forceinline__ unsigned xb_add(unsigned* p, unsigned v) { return __hip_atomic_fetch_add(p, v, __ATOMIC_RELAXED, __HIP_MEMORY_SCOPE_AGENT); }
__device__ __forceinline__ unsigned xb_xcc_id() { return (unsigned)__builtin_amdgcn_s_getreg((3 << 11) | 20) & 0xFu; }
#define XB_SPIN(cond, bar) do { unsigned _sp = 0; while (cond) { __builtin_amdgcn_s_sleep(1); \
    if ((++_sp & 255u) == 0u) { if (xb_ld(&(bar)[XB_TMO])) break; if (_sp > XB_SPIN_CAP) { atomicAdd(&(bar)[XB_TMO], 1u); break; } } } } while (0)
struct XcdBarrier { unsigned* bar; unsigned x; volatile LAS unsigned* st; };
__device__ __forceinline__ XcdBarrier xcd_barrier_post(unsigned* bar, volatile LAS unsigned* st) {
    XcdBarrier b; b.bar = bar; b.x = xb_xcc_id(); b.st = st;
    if (threadIdx.x == 0) (void)xb_add(&bar[XB_XCNT(b.x)], 1u);
    return b;
}
__device__ __forceinline__ void xcd_barrier_complete(unsigned* bar, unsigned x, unsigned& nloc, unsigned& nx) {
    const unsigned G = gridDim.x * gridDim.y * gridDim.z;
    unsigned sum, cnt, mine, sp = 0u;
    for (;;) {
        sum = 0u; cnt = 0u; mine = 0u;
#pragma unroll
        for (unsigned j = 0; j < 16; ++j) { const unsigned c = xb_ld(&bar[XB_XCNT(j)]); sum += c; cnt += (c > 0u) ? 1u : 0u; mine = (j == x) ? c : mine; }
        if (sum == G) break;
        __builtin_amdgcn_s_sleep(1);
        if ((++sp & 255u) == 0u) { if (xb_ld(&bar[XB_TMO])) break; if (sp > XB_SPIN_CAP) { atomicAdd(&bar[XB_TMO], 1u); break; } }
    }
    nloc = mine > 0u ? mine : 1u; nx = cnt > 0u ? cnt : 1u;
}
__device__ __forceinline__ void xcd_barrier(const XcdBarrier& b) {
    asm volatile("s_waitcnt vmcnt(0)" ::: "memory");
    __syncthreads();
    if (threadIdx.x == 0) {
        unsigned* bar = b.bar;
        __builtin_amdgcn_s_waitcnt(0);
        unsigned nloc = b.st[0], nx = b.st[1];
        if (nloc == 0u) { xcd_barrier_complete(bar, b.x, nloc, nx); b.st[0] = nloc; b.st[1] = nx; }
        const unsigned old = xb_add(&bar[XB_XSUB(b.x)], 1u);
        const unsigned gen = old / nloc;
        if (old + 1u == (gen + 1u) * nloc) {
            __builtin_amdgcn_fence(__ATOMIC_RELEASE, "agent");
            asm volatile("s_waitcnt vmcnt(0)" ::: "memory");
            const unsigned og = xb_add(&bar[XB_TOP], 1u);
            const unsigned tg = og / nx;
            if (og + 1u == (tg + 1u) * nx) xb_add(&bar[XB_TOPGEN], 1u);
            else XB_SPIN(xb_ld(&bar[XB_TOPGEN]) == tg, bar);
            __builtin_amdgcn_fence(__ATOMIC_ACQUIRE, "agent");
            xb_add(&bar[XB_XGEN(b.x)], 1u);
            asm volatile("s_waitcnt vmcnt(0)" ::: "memory");
        } else {
            XB_SPIN(xb_ld(&bar[XB_XGEN(b.x)]) == gen, bar);
            __builtin_amdgcn_fence(__ATOMIC_ACQUIRE, "agent");
            asm volatile("s_waitcnt vmcnt(0)" ::: "memory");
        }
    }
    __syncthreads();
}

namespace pg8 {
constexpr int BM = 256, BK = 64, HALF = 128, HTB = HALF * BK * 2, STAGE_BYTES = 8 * HTB, NXCD = 8, WGM = 8;
__device__ __forceinline__ int lds_byte(int r, int c) { const int st = (r >> 4) * 2 + (c >> 5), rr = r & 15, cc = c & 31, ob = rr * 64 + cc * 2; return st * 1024 + (ob ^ (((ob >> 9) & 1) << 5)); }
__device__ __forceinline__ void stage_rc(int b, int& R, int& C) { const int st = b / 1024, sb = b % 1024, swz = sb ^ (((sb >> 9) & 1) << 5); R = (st >> 1) * 16 + swz / 64; C = (st & 1) * 32 + (swz % 64) / 2; }
__device__ __forceinline__ int perm32(int rho) { const int n = rho >> 4, i = rho & 15; return 8 * (i >> 2) + 4 * n + (i & 3); }
struct Unit { int pm, pn; };
struct Gemm { const bf16_t* A; const bf16_t* Bt; int M, N, K, lda, ldb; };
struct StaticOrder {
    int nM, nN, nwg, G, c;
    __device__ void init(int M, int N, int G_, int c_) { nM = M / BM; nN = N / BM; nwg = nM * nN; G = G_; c = c_; }
    __device__ bool next(int i, Unit& u) const {
        const long L = (long)i * G + c; if (L >= nwg) return false;
        int wgid = (int)L; { const int q = nwg / NXCD, r = nwg % NXCD, xcd = wgid % NXCD, off = wgid / NXCD; wgid = (xcd < r ? xcd * (q + 1) : r * (q + 1) + (xcd - r) * q) + off; }
        const int nig = WGM * nN, gid = wgid / nig, fm = gid * WGM, gsz = (nM - fm) < WGM ? (nM - fm) : WGM;
        u.pm = fm + ((wgid % nig) % gsz); u.pn = (wgid % nig) / gsz; return true;
    }
};
struct GroupedOrder {
    int nwg, G, c, tpg;
    __device__ void init(int ntiles, int tiles_per_group, int G_, int c_) { nwg = ntiles; tpg = tiles_per_group; G = G_; c = c_; }
    __device__ bool next(int i, Unit& u) const { const long L = (long)i * G + c; if (L >= nwg) return false; u.pm = (int)L; u.pn = (int)L / tpg; return true; }
};
__device__ __forceinline__ unsigned cvt_pk_bf16(float lo, float hi) { unsigned r; asm volatile("v_cvt_pk_bf16_f32 %0, %1, %2" : "=v"(r) : "v"(lo), "v"(hi)); return r; }

template <class Epi, class Sched>
__device__ __forceinline__ void gemm_phase(LAS unsigned char* lds, const Gemm g, const Sched& S, const Epi& E) {
    const int tid = threadIdx.x, wid = __builtin_amdgcn_readfirstlane(tid >> 6), lane = tid & 63, wr = wid >> 2, wc = wid & 3, fr = lane & 15, fq = lane >> 4;
    int K = g.K; asm volatile("" : "+s"(K));
    const int nt = K / BK;
    unsigned voffA[2], voffB[2];
#pragma unroll
    for (int i = 0; i < 2; ++i) { int R, C; stage_rc(tid * 16 + i * 8192, R, C); const int Rb = Epi::PERM ? ((R & ~31) + perm32(R & 31)) : R;
        voffA[i] = (unsigned)(R * g.lda + C) * 2u; voffB[i] = (unsigned)(Rb * g.ldb + C) * 2u; }
    const size_t kstep = (size_t)(BK * 2);
    const size_t hstepA = (size_t)HALF * g.lda * 2, hstepB = (size_t)HALF * g.ldb * 2;
    const size_t tstepA = 2 * hstepA, tstepB = 2 * hstepB;
    const unsigned ldsw = (unsigned)wid * 1024u;
    const int aoff = lds_byte(wr * 64 + fr, fq * 8), boff = lds_byte(wc * 32 + fr, fq * 8);
#define PG8_SA(b, h) (((b) * 2 + (h)) * HTB)
#define PG8_SB(b, h) ((4 + (b) * 2 + (h)) * HTB)
#define PG8_STAGE(bufoff, gbase, voff) do { _Pragma("unroll") for (int _i = 0; _i < 2; ++_i) \
        __builtin_amdgcn_global_load_lds((const unsigned*)((const char*)(gbase) + (voff)[_i]), (LAS unsigned*)(lds + (bufoff) + ldsw + _i * 8192), 16, 0, 0); } while (0)
#define PG8_LDA(dst, b, h) do { _Pragma("unroll") for (int m = 0; m < 4; ++m) _Pragma("unroll") for (int k = 0; k < 2; ++k) dst[m][k] = *(const LAS bf16x8*)(lds + PG8_SA(b, h) + aoff + m * 2048 + k * 1024); } while (0)
#define PG8_LDB(dst, b, h) do { _Pragma("unroll") for (int n = 0; n < 2; ++n) _Pragma("unroll") for (int k = 0; k < 2; ++k) dst[n][k] = *(const LAS bf16x8*)(lds + PG8_SB(b, h) + boff + n * 2048 + k * 1024); } while (0)
#define PG8_MMA(ai, bj, At, Bt) do { __builtin_amdgcn_s_setprio(1); _Pragma("unroll") for (int m = 0; m < 4; ++m) _Pragma("unroll") for (int n = 0; n < 2; ++n) _Pragma("unroll") for (int k = 0; k < 2; ++k) \
        acc[ai][bj][m][n] = __builtin_amdgcn_mfma_f32_16x16x32_bf16(Bt[n][k], At[m][k], acc[ai][bj][m][n], 0, 0, 0); __builtin_amdgcn_s_setprio(0); } while (0)
#define PG8_WAIT_V(n) asm volatile("s_waitcnt vmcnt(" #n ")" ::: "memory")
#define PG8_WAIT_L(n) asm volatile("s_waitcnt lgkmcnt(" #n ")" ::: "memory")
#define PG8_BAR __builtin_amdgcn_s_barrier()
#define PG8_SCHED __builtin_amdgcn_sched_barrier(0)
    Unit cur, nxt; int ui = 0;
    if (!S.next(0, cur)) return;
    f32x4 acc[2][2][4][2];
#pragma unroll
    for (int a = 0; a < 2; ++a)
#pragma unroll
        for (int b = 0; b < 2; ++b)
#pragma unroll
            for (int m = 0; m < 4; ++m)
#pragma unroll
                for (int n = 0; n < 2; ++n) acc[a][b][m][n] = (f32x4){0.f, 0.f, 0.f, 0.f};
    bf16x8 At[4][2], B0[2][2], B1[2][2];
    const char* cA = (const char*)g.A + (size_t)cur.pm * tstepA; const char* cB = (const char*)g.Bt + (size_t)cur.pn * tstepB;
    PG8_STAGE(PG8_SB(0, 0), cB, voffB); PG8_STAGE(PG8_SA(0, 0), cA, voffA); PG8_STAGE(PG8_SB(0, 1), cB + hstepB, voffB); PG8_STAGE(PG8_SA(0, 1), cA + hstepA, voffA);
    if (wr == 1) PG8_BAR;
    PG8_WAIT_V(4); PG8_BAR;
    PG8_STAGE(PG8_SB(1, 0), cB + kstep, voffB); PG8_STAGE(PG8_SA(1, 0), cA + kstep, voffA); PG8_STAGE(PG8_SB(1, 1), cB + hstepB + kstep, voffB);
    PG8_WAIT_V(6); PG8_BAR;
    for (;;) {
        const bool has_next = S.next(ui + 1, nxt);
        const char* nA = has_next ? (const char*)g.A + (size_t)nxt.pm * tstepA : cA; const char* nB = has_next ? (const char*)g.Bt + (size_t)nxt.pn * tstepB : cB;
        for (int t = 0; t < nt; t += 2) {
            const bool last = (t == nt - 2);
            const char* a1 = cA + (size_t)(t + 1) * kstep;
            const char* a2 = last ? nA : cA + (size_t)(t + 2) * kstep; const char* b2 = last ? nB : cB + (size_t)(t + 2) * kstep;
            const char* a3 = a2 + kstep; const char* b3 = b2 + kstep;
            PG8_LDB(B0, 0, 0); PG8_SCHED; PG8_LDA(At, 0, 0); PG8_STAGE(PG8_SA(1, 1), a1 + hstepA, voffA);
            PG8_WAIT_L(8); PG8_BAR; PG8_WAIT_L(0); PG8_MMA(0, 0, At, B0); PG8_BAR; PG8_SCHED;
            PG8_LDB(B1, 0, 1); PG8_STAGE(PG8_SB(0, 0), b2, voffB);
            PG8_BAR; PG8_WAIT_L(0); PG8_MMA(0, 1, At, B1); PG8_BAR;
            PG8_LDA(At, 0, 1); PG8_STAGE(PG8_SA(0, 0), a2, voffA);
            PG8_BAR; PG8_WAIT_L(0); PG8_MMA(1, 0, At, B0); PG8_BAR; PG8_SCHED;
            PG8_STAGE(PG8_SB(0, 1), b2 + hstepB, voffB);
            PG8_WAIT_V(6); PG8_BAR; PG8_MMA(1, 1, At, B1); PG8_BAR;
            PG8_LDB(B0, 1, 0); PG8_SCHED; PG8_LDA(At, 1, 0); PG8_STAGE(PG8_SA(0, 1), a2 + hstepA, voffA);
            PG8_WAIT_L(8); PG8_BAR; PG8_WAIT_L(0); PG8_MMA(0, 0, At, B0); PG8_BAR; PG8_SCHED;
            PG8_LDB(B1, 1, 1); PG8_STAGE(PG8_SB(1, 0), b3, voffB);
            PG8_BAR; PG8_WAIT_L(0); PG8_MMA(0, 1, At, B1); PG8_BAR;
            PG8_LDA(At, 1, 1); PG8_STAGE(PG8_SA(1, 0), a3, voffA);
            PG8_BAR; PG8_WAIT_L(0); PG8_MMA(1, 0, At, B0); PG8_BAR; PG8_SCHED;
            PG8_STAGE(PG8_SB(1, 1), b3 + hstepB, voffB);
            PG8_WAIT_V(6); PG8_BAR; PG8_MMA(1, 1, At, B1); PG8_BAR;
        }
        E(acc, cur, wr, wc, fr, fq);
        if (!has_next) break;
#pragma unroll
        for (int a = 0; a < 2; ++a)
#pragma unroll
            for (int b = 0; b < 2; ++b)
#pragma unroll
                for (int m = 0; m < 4; ++m)
#pragma unroll
                    for (int n = 0; n < 2; ++n) acc[a][b][m][n] = (f32x4){0.f, 0.f, 0.f, 0.f};
        cur = nxt; cA = nA; cB = nB; ++ui;
    }
    PG8_WAIT_V(0);
    if (wr == 0) PG8_BAR;
    PG8_BAR;
#undef PG8_SA
#undef PG8_SB
#undef PG8_STAGE
#undef PG8_LDA
#undef PG8_LDB
#undef PG8_MMA
#undef PG8_WAIT_V
#undef PG8_WAIT_L
#undef PG8_BAR
#undef PG8_SCHED
}

struct EpiStoreBf16 {
    static constexpr bool PERM = true;
    bf16_t* O; int ldc;
    __device__ __forceinline__ void operator()(const f32x4 (&acc)[2][2][4][2], const Unit& u, int wr, int wc, int fr, int fq) const {
        const int row0 = u.pm * BM + wr * 64 + fr, col0 = u.pn * BM + wc * 32 + 8 * fq;
#pragma unroll
        for (int ai = 0; ai < 2; ++ai)
#pragma unroll
            for (int m = 0; m < 4; ++m) { bf16_t* rowp = O + (size_t)(row0 + ai * HALF + m * 16) * ldc + col0;
#pragma unroll
                for (int bj = 0; bj < 2; ++bj) { const f32x4 v0 = acc[ai][bj][m][0], v1 = acc[ai][bj][m][1];
                    u32x4 w; w.x = cvt_pk_bf16(v0[0], v0[1]); w.y = cvt_pk_bf16(v0[2], v0[3]); w.z = cvt_pk_bf16(v1[0], v1[1]); w.w = cvt_pk_bf16(v1[2], v1[3]);
                    *(u32x4*)(rowp + bj * HALF) = w; } }
    }
};
struct EpiStoreF16 {
    static constexpr bool PERM = true;
    _Float16* O; int ldc;
    __device__ __forceinline__ void operator()(const f32x4 (&acc)[2][2][4][2], const Unit& u, int wr, int wc, int fr, int fq) const {
        const int row0 = u.pm * BM + wr * 64 + fr, col0 = u.pn * BM + wc * 32 + 8 * fq;
#pragma unroll
        for (int ai = 0; ai < 2; ++ai)
#pragma unroll
            for (int m = 0; m < 4; ++m) { _Float16* rowp = O + (size_t)(row0 + ai * HALF + m * 16) * ldc + col0;
#pragma unroll
                for (int bj = 0; bj < 2; ++bj) { const f32x4 v0 = acc[ai][bj][m][0], v1 = acc[ai][bj][m][1];
                    typedef _Float16 h8 __attribute__((ext_vector_type(8)));
                    const h8 hv = {(_Float16)v0[0], (_Float16)v0[1], (_Float16)v0[2], (_Float16)v0[3], (_Float16)v1[0], (_Float16)v1[1], (_Float16)v1[2], (_Float16)v1[3]};
                    *(h8*)(rowp + bj * HALF) = hv; } }
    }
};
struct EpiResidF32 {
    static constexpr bool PERM = false;
    const float* R; float* C; int ldc;
    __device__ __forceinline__ void operator()(const f32x4 (&acc)[2][2][4][2], const Unit& u, int wr, int wc, int fr, int fq) const {
        const int row0 = u.pm * BM + wr * 64 + fr, col0 = u.pn * BM + wc * 32 + 4 * fq;
#pragma unroll
        for (int ai = 0; ai < 2; ++ai)
#pragma unroll
            for (int m = 0; m < 4; ++m) { const size_t off = (size_t)(row0 + ai * HALF + m * 16) * ldc + col0;
#pragma unroll
                for (int bj = 0; bj < 2; ++bj)
#pragma unroll
                    for (int n = 0; n < 2; ++n) { const f32x4 r = *(const f32x4*)(R + off + bj * HALF + n * 16); *(f32x4*)(C + off + bj * HALF + n * 16) = r + acc[ai][bj][m][n]; } }
    }
};
}

struct Args {
    const float* in[39];
    float* out;
    unsigned char* ws;
    int ph_lo, ph_hi;
};
enum { I_X = 0, I_L0_MIXN, I_L0_WIN, I_L0_QG, I_L0_KG, I_L0_LOGDT, I_L0_ARE, I_L0_AIM, I_L0_BRE, I_L0_BIM, I_L0_CRE, I_L0_CIM, I_L0_D, I_L0_WGLU, I_L0_BGLU, I_L0_WOUT,
       I_L0_FFNN, I_L0_WQ, I_L0_SK, I_L0_U, I_L0_V,
       I_L1_MIXN, I_L1_WIN, I_L1_QG, I_L1_KG, I_L1_CMPPOS, I_L1_KW1, I_L1_KW2, I_L1_VW1, I_L1_VW2, I_L1_WGATE, I_L1_BGATE, I_L1_OGAIN, I_L1_WOUT,
       I_L1_FFNN, I_L1_WQ, I_L1_SK, I_L1_U, I_L1_V };

struct Frame {
    LAS unsigned char* lds;
    int tid, lane, wave, G, bid;
};

constexpr size_t L0_QA = WS_R3;
constexpr size_t L0_IQ = WS_R3 + 32 * MiB;
constexpr size_t L0_KA = WS_R3 + 64 * MiB;
constexpr size_t L0_VAT = WS_R3 + 72 * MiB;
constexpr size_t L0_IK = WS_R3 + 80 * MiB;
constexpr size_t L0_IW = WS_R3 + 84 * MiB;
constexpr size_t L0_UA = WS_R3 + 88 * MiB;
constexpr size_t L0_SELT = WS_PROJ;
constexpr size_t L0_CAT = WS_PROJ + 16 * MiB;
constexpr size_t L0_SLOC = WS_PROJ + 80 * MiB;
constexpr size_t L0_YB = WS_PROJ + 112 * MiB;
constexpr size_t PE_Q2 = WS_PROJ;
constexpr size_t PE_EID = WS_PROJ + 128 * MiB;
constexpr size_t PE_GATE = WS_PROJ + 136 * MiB;

template <class Map>
__device__ __forceinline__ void transpose_item(const float* W, int K, int N, bf16_t* WT, int ldk, LAS float* scr, int item, int lane, const Map& map) {
    const int nblk = (N + 31) / 32, kb = item / nblk, nb = item % nblk, k0 = 64 * kb, n0 = 32 * nb;
    const int ncol = n0 + (lane & 31);
#pragma unroll 8
    for (int i = 0; i < 32; ++i) { const int kk = 2 * i + (lane >> 5); scr[kk * 33 + (lane & 31)] = (ncol < N) ? W[(size_t)(k0 + kk) * N + ncol] : 0.f; }
    LDS_WAIT(); asm volatile("" ::: "memory");
    const int c = lane & 7;
#pragma unroll
    for (int j = 0; j < 4; ++j) { const int n = (lane >> 3) + 8 * j; const LAS float* s = scr + (8 * c) * 33 + n;
        u32x4 o; o.x = pk2(s[0 * 33], s[1 * 33]); o.y = pk2(s[2 * 33], s[3 * 33]); o.z = pk2(s[4 * 33], s[5 * 33]); o.w = pk2(s[6 * 33], s[7 * 33]);
        if (n0 + n < N) *(u32x4*)(WT + (size_t)map(n0 + n) * ldk + k0 + 8 * c) = o; }
    LDS_WAIT(); asm volatile("" ::: "memory");
}
struct MapId { __device__ __forceinline__ int operator()(int n) const { return n; } };
struct MapIn0 { __device__ __forceinline__ int operator()(int n) const { return n < 1280 ? n : (n < 1344 ? n - 1280 + C0_IK : (n < 1352 ? n - 1344 + C0_IW : n - 1352 + C0_U)); } };
struct MapIn1 { __device__ __forceinline__ int operator()(int n) const {
    if (n < 1280) return n; if (n < 1304) return n - 1280 + C1_GL; if (n < 1560) return n - 1304 + C1_GQ; if (n < 1816) return n - 1560 + C1_GK;
    if (n < 2328) return n - 1816 + C1_GV; if (n < 2344) return n - 2328 + C1_GLOW; return n - 2344 + C1_GR; } };

template <class Map>
__device__ __forceinline__ void transpose_all(const Frame& F, int& base, const float* W, int K, int N, bf16_t* WT, int ldk, const Map& map) {
    LAS float* scr = (LAS float*)(F.lds + F.wave * 16384);
    const int gw = F.bid * NWAVES + F.wave, NGW = F.G * NWAVES;
    const int nit = (K / 64) * ((N + 31) / 32);
    for (int it = (gw + NGW - (base % NGW)) % NGW; it < nit; it += NGW) transpose_item(W, K, N, WT, ldk, scr, it, F.lane, map);
    base += nit;
}
__device__ __forceinline__ void zero_bytes(const Frame& F, unsigned char* p, size_t nbytes) {
    const size_t n16 = nbytes / 16;
    for (size_t i = (size_t)F.bid * NTHREADS + F.tid; i < n16; i += (size_t)F.G * NTHREADS) ((u32x4*)p)[i] = (u32x4){0u, 0u, 0u, 0u};
}
__device__ __forceinline__ void cvt_f32_bf16(const Frame& F, const float* src, bf16_t* dst, size_t n) {
    const size_t n8 = n / 8;
    for (size_t i = (size_t)F.bid * NTHREADS + F.tid; i < n8; i += (size_t)F.G * NTHREADS) {
        const f32x4 a = ((const f32x4*)src)[2 * i], b = ((const f32x4*)src)[2 * i + 1];
        u32x4 o; o.x = pk2(a.x, a.y); o.y = pk2(a.z, a.w); o.z = pk2(b.x, b.y); o.w = pk2(b.z, b.w);
        ((u32x4*)dst)[i] = o;
    }
}

__device__ __forceinline__ void rms_row_to_bf16(const float* xrow, const float* gain, bf16_t* orow, int lane) {
    const f32x4* xr = (const f32x4*)xrow + lane; const f32x4* gr = (const f32x4*)gain + lane;
    f32x4 v[4]; float s = 0.f;
#pragma unroll
    for (int j = 0; j < 4; ++j) { v[j] = xr[64 * j]; s += (v[j].x * v[j].x + v[j].y * v[j].y) + (v[j].z * v[j].z + v[j].w * v[j].w); }
    const float rstd = 1.0f / sqrtf(wave_sum(s) * (1.f / DM) + 1e-6f);
    u64* o8 = (u64*)orow + lane;
#pragma unroll
    for (int j = 0; j < 4; ++j) { const f32x4 g4 = gr[64 * j]; o8[64 * j] = (u64)pk2(v[j].x * rstd * g4.x, v[j].y * rstd * g4.y) | ((u64)pk2(v[j].z * rstd * g4.z, v[j].w * rstd * g4.w) << 32); }
}
__device__ __forceinline__ void p_rmsnorm(const Frame& F, const float* x, const float* gain, bf16_t* XN) {
    const int gw = F.bid * NWAVES + F.wave, NGW = F.G * NWAVES;
    for (int m = gw; m < T; m += NGW) rms_row_to_bf16(x + (size_t)m * DM, gain, XN + (size_t)m * DM, F.lane);
}

__device__ __forceinline__ void p_rope_table(const Frame& F, f32x2* rope) {
    for (int i = F.bid * NTHREADS + F.tid; i < SEQ * 32; i += F.G * NTHREADS) {
        const int pos = i >> 5, k = i & 31;
        const float inv = powf(10000.0f, -(float)k / 32.0f);
        const float ang = (float)pos * inv;
        float s, c; sincosf(ang, &s, &c);
        rope[i] = (f32x2){c, s};
    }
}

__device__ __forceinline__ void s5_build_group(const Frame& F, const Args& a, unsigned char* ws, int g) {
    LAS f32x2* abp = (LAS f32x2*)F.lds;
    LAS f32x2* bb = abp + 17 * 64;
    LAS f32x2* Cc = bb + 64 * 16;
    LAS float* KT = (LAS float*)(Cc + 16 * 64);
    const float dt = expf(a.in[I_L0_LOGDT][g]);
    for (int idx = F.tid; idx < 17 * 64; idx += NTHREADS) {
        const int tau = idx >> 6, p = idx & 63;
        const float lr = a.in[I_L0_ARE][g * 64 + p], li = a.in[I_L0_AIM][g * 64 + p];
        const float mag = expf((float)tau * dt * lr); float s, c; sincosf((float)tau * dt * li, &s, &c);
        abp[idx] = (f32x2){mag * c, mag * s};
    }
    for (int idx = F.tid; idx < 64 * 16; idx += NTHREADS) {
        const int p = idx >> 4, c = idx & 15;
        const float lr = a.in[I_L0_ARE][g * 64 + p], li = a.in[I_L0_AIM][g * 64 + p];
        const float mag = expf(dt * lr); float s, co; sincosf(dt * li, &s, &co);
        const float abr = mag * co, abi = mag * s, den = lr * lr + li * li;
        const float fr = ((abr - 1.0f) * lr + abi * li) / den, fi = (abi * lr - (abr - 1.0f) * li) / den;
        const float br = a.in[I_L0_BRE][(size_t)(g * 64 + p) * 16 + c], bi = a.in[I_L0_BIM][(size_t)(g * 64 + p) * 16 + c];
        bb[idx] = (f32x2){fr * br - fi * bi, fr * bi + fi * br};
    }
    for (int idx = F.tid; idx < 16 * 64; idx += NTHREADS) Cc[idx] = (f32x2){a.in[I_L0_CRE][(size_t)g * 1024 + idx], a.in[I_L0_CIM][(size_t)g * 1024 + idx]};
    __syncthreads();
    for (int idx = F.tid; idx < 16 * 256; idx += NTHREADS) {
        const int tau = idx >> 8, co = (idx >> 4) & 15, ci = idx & 15;
        float acc = 0.f;
        for (int p = 0; p < 64; ++p) {
            const f32x2 c = Cc[co * 64 + p], e = abp[tau * 64 + p], b = bb[p * 16 + ci];
            const float er = c.x * e.x - c.y * e.y, ei = c.x * e.y + c.y * e.x;
            acc += er * b.x - ei * b.y;
        }
        if (tau == 0 && co == ci) acc += a.in[I_L0_D][g * 16 + co];
        KT[idx] = acc;
    }
    __syncthreads();
    bf16_t* B1 = (bf16_t*)(ws + WS_S5B1) + (size_t)g * 256 * 256;
    bf16_t* B2 = (bf16_t*)(ws + WS_S5B2) + (size_t)g * 256 * 384;
    for (int idx = F.tid; idx < 256 * 128; idx += NTHREADS) {
        const int n = idx >> 7, k = (idx & 127) * 2;
        float v0 = 0.f, v1 = 0.f;
        if (n < 128) { const int p = n & 63, j = k >> 4, ci = k & 15; const f32x2 e = abp[(15 - j) * 64 + p], b0 = bb[p * 16 + ci], b1 = bb[p * 16 + ci + 1];
            if (n < 64) { v0 = e.x * b0.x - e.y * b0.y; v1 = e.x * b1.x - e.y * b1.y; } else { v0 = e.x * b0.y + e.y * b0.x; v1 = e.x * b1.y + e.y * b1.x; } }
        *(unsigned*)(B1 + (size_t)n * 256 + k) = pk2(v0, v1);
    }
    for (int idx = F.tid; idx < 256 * 192; idx += NTHREADS) {
        const int n = idx / 192, k = (idx % 192) * 2, i = n >> 4, co = n & 15;
        float v0 = 0.f, v1 = 0.f;
        if (k < 256) { const int j = k >> 4, ci = k & 15; if (j <= i) { v0 = KT[((i - j) * 16 + co) * 16 + ci]; v1 = KT[((i - j) * 16 + co) * 16 + ci + 1]; } }
        else { const int p = (k - 256) & 63; const bool im = k >= 320;
            const f32x2 c0 = Cc[co * 64 + p], e0 = abp[(i + 1) * 64 + p], c1 = Cc[co * 64 + p + 1], e1 = abp[(i + 1) * 64 + p + 1];
            if (!im) { v0 = c0.x * e0.x - c0.y * e0.y; v1 = c1.x * e1.x - c1.y * e1.y; } else { v0 = -(c0.x * e0.y + c0.y * e0.x); v1 = -(c1.x * e1.y + c1.y * e1.x); } }
        *(unsigned*)(B2 + (size_t)n * 384 + k) = pk2(v0, v1);
    }
    __syncthreads();
}

__device__ __forceinline__ void cmp_bias(const Frame& F, const Args& a, float* out, int j) {
    const int w = j >> 5, n0 = (j & 31) * 8;
    const float* w1 = a.in[w ? I_L1_VW1 : I_L1_KW1]; const float* pos = a.in[I_L1_CMPPOS];
    LAS float* red = (LAS float*)(F.lds + 65536);
    float acc[8];
#pragma unroll
    for (int i = 0; i < 8; ++i) acc[i] = 0.f;
#pragma unroll
    for (int kk = 0; kk < 4; ++kk) { const int k = F.tid * 4 + kk; const float p = pos[k];
        const f32x4 wa = *(const f32x4*)(w1 + (size_t)k * 256 + n0), wb = *(const f32x4*)(w1 + (size_t)k * 256 + n0 + 4);
        acc[0] += p * wa.x; acc[1] += p * wa.y; acc[2] += p * wa.z; acc[3] += p * wa.w; acc[4] += p * wb.x; acc[5] += p * wb.y; acc[6] += p * wb.z; acc[7] += p * wb.w; }
#pragma unroll
    for (int i = 0; i < 8; ++i) { const float sv = wave_sum(acc[i]); if (F.lane == 0) red[F.wave * 8 + i] = sv; }
    __syncthreads();
    if (F.tid < 8) { float t = 0.f; for (int wv = 0; wv < 8; ++wv) t += red[wv * 8 + F.tid]; out[w * 256 + n0 + F.tid] = t; }
    __syncthreads();
}

__device__ __forceinline__ float rope_apply(float v, const f32x2 cs, int lane) {
    const float partner = __shfl_xor(v, 32);
    return lane < 32 ? v * cs.x - partner * cs.y : partner * cs.y + v * cs.x;
}
__device__ __forceinline__ void head8_load(const bf16_t* p, float (&v)[8]) {
    const u32x4 q = *(const u32x4*)p;
    v[0] = bf_lo(q.x); v[1] = bf_hi(q.x); v[2] = bf_lo(q.y); v[3] = bf_hi(q.y); v[4] = bf_lo(q.z); v[5] = bf_hi(q.z); v[6] = bf_lo(q.w); v[7] = bf_hi(q.w);
}
__device__ __forceinline__ void head8_store(bf16_t* p, const float (&v)[8], const float sc) {
    u32x4 q; q.x = pk2(v[0] * sc, v[1] * sc); q.y = pk2(v[2] * sc, v[3] * sc); q.z = pk2(v[4] * sc, v[5] * sc); q.w = pk2(v[6] * sc, v[7] * sc);
    *(u32x4*)p = q;
}
__device__ __forceinline__ void head8_norm(float (&v)[8], const float (&g)[8]) {
    float ss = 0.f;
#pragma unroll
    for (int j = 0; j < 8; ++j) ss += v[j] * v[j];
    ss += __shfl_xor(ss, 1); ss += __shfl_xor(ss, 2); ss += __shfl_xor(ss, 4);
    const float r = 1.0f / sqrtf(ss * (1.f / 64.f) + 1e-6f);
#pragma unroll
    for (int j = 0; j < 8; ++j) v[j] = v[j] * r * g[j];
}
__device__ __forceinline__ void head8_rope(float (&v)[8], const f32x2 (&cs)[8], const bool upper) {
#pragma unroll
    for (int j = 0; j < 8; ++j) { const float partner = __shfl_xor(v[j], 4); v[j] = upper ? partner * cs[j].y + v[j] * cs[j].x : v[j] * cs[j].x - partner * cs[j].y; }
}
__device__ __forceinline__ void p_l0_prep(const Frame& F, const Args& a, unsigned char* ws) {
    const bf16_t* P = (const bf16_t*)(ws + WS_PROJ);
    const f32x2* rope = (const f32x2*)(ws + WS_ROPE);
    bf16_t* QA = (bf16_t*)(ws + L0_QA); bf16_t* IQ = (bf16_t*)(ws + L0_IQ); bf16_t* KA = (bf16_t*)(ws + L0_KA); bf16_t* VAT = (bf16_t*)(ws + L0_VAT);
    bf16_t* IK = (bf16_t*)(ws + L0_IK); float* IW = (float*)(ws + L0_IW); bf16_t* UA = (bf16_t*)(ws + L0_UA);
    const int gw = F.bid * NWAVES + F.wave, NGW = F.G * NWAVES, lane = F.lane, hs = lane >> 3, sub = lane & 7;
    float qg[8], kg[8];
#pragma unroll
    for (int j = 0; j < 8; ++j) { qg[j] = a.in[I_L0_QG][sub * 8 + j]; kg[j] = a.in[I_L0_KG][sub * 8 + j]; }
    for (int m = gw; m < T; m += NGW) {
        const int b = m >> 12, t = m & 4095;
        const bf16_t* row = P + (size_t)m * N_IN0;
        f32x2 cs[8];
#pragma unroll
        for (int j = 0; j < 4; ++j) { const f32x4 c4 = *(const f32x4*)(rope + t * 32 + (sub & 3) * 8 + 2 * j); cs[2 * j] = (f32x2){c4.x, c4.y}; cs[2 * j + 1] = (f32x2){c4.z, c4.w}; }
        float v[8];
        head8_load(row + C0_Q + lane * 8, v); head8_norm(v, qg); head8_rope(v, cs, sub >= 4); head8_store(QA + (size_t)m * 512 + lane * 8, v, 0.125f);
        head8_load(row + C0_IQ + lane * 8, v); head8_rope(v, cs, sub >= 4); head8_store(IQ + (size_t)m * 512 + lane * 8, v, 0.125f);
        {
            const int hh = hs < 3 ? hs : 2;
            head8_load(row + (hh < 2 ? C0_K + hh * 64 : C0_IK) + sub * 8, v);
            float vn[8];
#pragma unroll
            for (int j = 0; j < 8; ++j) vn[j] = v[j];
            head8_norm(vn, kg);
#pragma unroll
            for (int j = 0; j < 8; ++j) v[j] = (hh < 2) ? vn[j] : v[j];
            head8_rope(v, cs, sub >= 4);
            if (hs < 2) head8_store(KA + ((size_t)(b * 2 + hs) * 4096 + t) * 64 + sub * 8, v, 1.0f);
            else if (hs == 2) head8_store(IK + (size_t)m * 64 + sub * 8, v, 1.0f);
        }
        if (lane < 8) IW[(size_t)m * 8 + lane] = bf2f(row[C0_IW + lane]) * 0.35355339059327373f;
        { const u32x4 uv = *(const u32x4*)(row + C0_U + lane * 8); const int g = lane >> 1;
          *(u32x4*)(UA + ((size_t)g * 2048 + (m >> 4)) * 384 + (m & 15) * 16 + (lane & 1) * 8) = uv; }
    }
    for (int it = gw; it < NB * 2 * 64; it += NGW) {
        const int tb = it & 63, g = (it >> 6) & 1, b = it >> 7;
        const size_t m = (size_t)b * 4096 + tb * 64 + lane;
        unsigned r[32];
#pragma unroll
        for (int j = 0; j < 8; ++j) { const u32x4 q = *(const u32x4*)(P + m * N_IN0 + C0_V + g * 64 + j * 8); r[4 * j] = q.x; r[4 * j + 1] = q.y; r[4 * j + 2] = q.z; r[4 * j + 3] = q.w; }
        bf16_t* dst = VAT + ((size_t)(b * 2 + g) * 64) * 4096 + tb * 64 + lane;
#pragma unroll
        for (int d = 0; d < 64; ++d) dst[(size_t)d * 4096] = (bf16_t)((d & 1) ? (r[d >> 1] >> 16) : (r[d >> 1] & 0xffffu));
    }
}

__device__ __forceinline__ unsigned f16key(unsigned raw) { return (raw & 0x8000u) ? (~raw & 0xFFFFu) : (raw | 0x8000u); }
template <int NREG>
__device__ __forceinline__ int topk_count_ge(const unsigned (&kk)[NREG], const unsigned cm1pk) {
    unsigned acc = 0u; const unsigned ones = 0x00010001u;
#pragma unroll
    for (int jj = 0; jj < NREG; ++jj) {
        unsigned d;
        asm("v_pk_sub_u16 %0, %1, %2 clamp" : "=v"(d) : "v"(kk[jj]), "v"(cm1pk));
        asm("v_pk_min_u16 %0, %1, %2" : "=v"(d) : "v"(d), "v"(ones));
        asm("v_pk_add_u16 %0, %1, %2" : "=v"(acc) : "v"(acc), "v"(d));
    }
    int c = (int)((acc & 0xffffu) + (acc >> 16));
    c += __builtin_amdgcn_update_dpp(0, c, 0xB1, 0xF, 0xF, true);
    c += __builtin_amdgcn_update_dpp(0, c, 0x4E, 0xF, 0xF, true);
    c += __builtin_amdgcn_update_dpp(0, c, 0x141, 0xF, 0xF, true);
    c += __builtin_amdgcn_update_dpp(0, c, 0x140, 0xF, 0xF, true);
    return __builtin_amdgcn_readlane(c, 0) + __builtin_amdgcn_readlane(c, 16) + __builtin_amdgcn_readlane(c, 32) + __builtin_amdgcn_readlane(c, 48);
}
template <int NREG>
__device__ __forceinline__ u64 topk_query(const LAS unsigned short* scq, const int t, const int lane) {
    unsigned kk[NREG];
#pragma unroll
    for (int jj = 0; jj < NREG; ++jj) {
        const int e0 = (2 * jj) * 64 + lane, e1 = e0 + 64;
        const unsigned r0 = scq[e0], r1 = scq[e1];
        kk[jj] = ((e0 <= t) ? f16key(r0) : 0u) | (((e1 <= t) ? f16key(r1) : 0u) << 16);
        if ((jj & 3) == 3) __builtin_amdgcn_sched_barrier(0);
    }
    unsigned prefix = 0u; bool exact = false;
#pragma unroll 1
    for (int bit = 15; bit >= 0; --bit) {
        const unsigned cand = prefix | (1u << bit), cm1 = cand - 1u;
        const int cnt = topk_count_ge<NREG>(kk, cm1 | (cm1 << 16));
        if (cnt >= 256) prefix = cand;
        if (cnt == 256) { exact = true; break; }
    }
    unsigned mylo = 0u, myhi = 0u;
    if (exact) {
#pragma unroll
        for (int i = 0; i < 2 * NREG; ++i) {
            const unsigned k = (i & 1) ? (kk[i >> 1] >> 16) : (kk[i >> 1] & 0xffffu);
            const u64 w = __ballot(k >= prefix);
            asm("s_nop 4\n\tv_writelane_b32 %0, %2, %4\n\tv_writelane_b32 %1, %3, %4" : "+v"(mylo), "+v"(myhi) : "s"((unsigned)w), "s"((unsigned)(w >> 32)), "n"(i));
        }
    } else {
        const unsigned Tk = prefix;
        const int cgt = (Tk >= 0xFFFFu) ? 0 : topk_count_ge<NREG>(kk, Tk | (Tk << 16));
        const int need = 256 - cgt;
        int run = 0;
#pragma unroll
        for (int i = 0; i < 2 * NREG; ++i) {
            const unsigned k = (i & 1) ? (kk[i >> 1] >> 16) : (kk[i >> 1] & 0xffffu);
            const u64 gt = __ballot(k > Tk); u64 eq = __ballot(k == Tk);
            const int pe = __builtin_popcountll(eq);
            if (run + pe > need) { int kq = need - run; kq = kq < 0 ? 0 : kq;
                const bool keep = ((eq >> lane) & 1ull) && (__builtin_popcountll(eq & ((1ull << lane) - 1ull)) < kq); eq = __ballot(keep); }
            run += pe;
            const u64 w = gt | eq;
            asm("s_nop 4\n\tv_writelane_b32 %0, %2, %4\n\tv_writelane_b32 %1, %3, %4" : "+v"(mylo), "+v"(myhi) : "s"((unsigned)w), "s"((unsigned)(w >> 32)), "n"(i));
        }
    }
    return (u64)mylo | ((u64)myhi << 32);
}
__device__ __forceinline__ void p_dsa_index(const Frame& F, unsigned char* ws, u64* SELT, const int mode) {
    const bf16_t* IQ = (const bf16_t*)(ws + L0_IQ); const bf16_t* IK = (const bf16_t*)(ws + L0_IK); const float* IW = (const float*)(ws + L0_IW);
    LAS _Float16* sc = (LAS _Float16*)F.lds;
    LAS unsigned short* scu = (LAS unsigned short*)F.lds;
    LAS u64* mk = (LAS u64*)(F.lds + 131072);
    LAS float* wl = (LAS float*)(F.lds + 131072 + 8192);
    const int lane = F.lane, wave = F.wave, h = lane >> 5, r = lane & 31;
    const int rq = ((r >> 4) & 1) + 2 * ((r >> 2) & 1), rh = 4 * ((r >> 3) & 1) + (r & 3);
    for (int u = F.bid; u < 2048; u += F.G) {
        const int idx = u & 255, b = u >> 8;
        const int j = (b & 1) ? 255 - idx : idx;
        const int t0 = j * 16; const size_t mb = (size_t)b * 4096;
        if (F.tid < 128) wl[F.tid] = IW[(mb + t0) * 8 + F.tid];
        const int nkb = (t0 + 15) / 32 + 1;
        bf16x8 Af[4][4];
#pragma unroll
        for (int rt = 0; rt < 4; ++rt)
#pragma unroll
            for (int ks = 0; ks < 4; ++ks) Af[rt][ks] = *(const bf16x8*)(IQ + (mb + t0 + 4 * rt + rq) * 512 + rh * 64 + ks * 16 + 8 * h);
        __syncthreads();
        if (mode != 2) for (int kb = wave; kb < nkb; kb += NWAVES) {
            bf16x8 Bf[4];
#pragma unroll
            for (int ks = 0; ks < 4; ++ks) Bf[ks] = *(const bf16x8*)(IK + (mb + kb * 32 + r) * 64 + ks * 16 + 8 * h);
#pragma unroll
            for (int rt = 0; rt < 4; ++rt) {
                f32x16 acc = {0.f, 0.f, 0.f, 0.f, 0.f, 0.f, 0.f, 0.f, 0.f, 0.f, 0.f, 0.f, 0.f, 0.f, 0.f, 0.f};
#pragma unroll
                for (int ks = 0; ks < 4; ++ks) acc = __builtin_amdgcn_mfma_f32_32x32x16_bf16(Af[rt][ks], Bf[ks], acc, 0, 0, 0);
                const int qa = 4 * rt + 2 * h;
                const f32x4 wa0 = *(const LAS f32x4*)(wl + qa * 8), wa1 = *(const LAS f32x4*)(wl + qa * 8 + 4), wb0 = *(const LAS f32x4*)(wl + qa * 8 + 8), wb1 = *(const LAS f32x4*)(wl + qa * 8 + 12);
                float sa = 0.f, sb = 0.f;
#pragma unroll
                for (int i = 0; i < 4; ++i) { sa += wa0[i] * fmaxf(acc[i], 0.f); sa += wa1[i] * fmaxf(acc[4 + i], 0.f); sb += wb0[i] * fmaxf(acc[8 + i], 0.f); sb += wb1[i] * fmaxf(acc[12 + i], 0.f); }
                sc[qa * 4096 + kb * 32 + r] = (_Float16)sa;
                sc[(qa + 1) * 4096 + kb * 32 + r] = (_Float16)sb;
                __builtin_amdgcn_sched_barrier(0);
            }
        }
        __syncthreads();
#pragma unroll 1
        for (int qq = 0; qq < (mode == 1 ? 0 : 2); ++qq) {
            const int q = wave * 2 + qq, t = t0 + q, n = t + 1;
            unsigned mylo = 0u, myhi = 0u;
            if (n <= 256) {
                const int base = lane * 64;
                const u64 word = (base + 63 <= t) ? ~0ull : (base > t ? 0ull : ((1ull << (t - base + 1)) - 1ull));
                mylo = (unsigned)word; myhi = (unsigned)(word >> 32);
            } else {
                const int nreg = (((n + 63) >> 6) + 1) >> 1;
                const LAS unsigned short* scq = scu + q * 4096;
                u64 w;
                if (nreg <= 4) w = topk_query<4>(scq, t, lane);
                else if (nreg <= 8) w = topk_query<8>(scq, t, lane);
                else if (nreg <= 12) w = topk_query<12>(scq, t, lane);
                else if (nreg <= 16) w = topk_query<16>(scq, t, lane);
                else if (nreg <= 20) w = topk_query<20>(scq, t, lane);
                else if (nreg <= 24) w = topk_query<24>(scq, t, lane);
                else if (nreg <= 28) w = topk_query<28>(scq, t, lane);
                else w = topk_query<32>(scq, t, lane);
                mylo = (unsigned)w; myhi = (unsigned)(w >> 32);
            }
            mk[lane * 16 + q] = (u64)mylo | ((u64)myhi << 32);
        }
        __syncthreads();
        { const int w = F.tid >> 3, part = F.tid & 7;
          u64* dst = SELT + ((size_t)(b * 64 + w) * 4096) + t0 + part * 2;
          dst[0] = mk[w * 16 + part * 2]; dst[1] = mk[w * 16 + part * 2 + 1]; }
        __syncthreads();
    }
}

constexpr int AT_KB = 9216, AT_VB = 8704, AT_BUF = AT_KB + AT_VB;
struct AttStage { u32x4 kreg, vreg; };
__device__ __forceinline__ void att_load(AttStage& s, const bf16_t* Kg, const bf16_t* Vtg, int key0, int tid) {
    s.kreg = *(const u32x4*)(Kg + (size_t)(key0 + (tid >> 3)) * 64 + (tid & 7) * 8);
    s.vreg = *(const u32x4*)(Vtg + (size_t)(tid >> 3) * 4096 + key0 + (tid & 7) * 8);
}
__device__ __forceinline__ void att_store(const AttStage& s, LAS unsigned char* buf, int tid) {
    *(LAS u32x4*)(buf + (tid >> 3) * 144 + (tid & 7) * 16) = s.kreg;
    LAS unsigned char* v = buf + AT_KB + (tid >> 3) * 136 + (tid & 7) * 16;
    *(LAS u32x2*)(v) = (u32x2){s.vreg.x, s.vreg.y}; *(LAS u32x2*)(v + 8) = (u32x2){s.vreg.z, s.vreg.w};
}
__device__ __forceinline__ bf16x8 pack8(float a0, float a1, float a2, float a3, float a4, float a5, float a6, float a7) {
    u32x4 w; w.x = pg8::cvt_pk_bf16(a0, a1); w.y = pg8::cvt_pk_bf16(a2, a3); w.z = pg8::cvt_pk_bf16(a4, a5); w.w = pg8::cvt_pk_bf16(a6, a7);
    return __builtin_bit_cast(bf16x8, w);
}
__device__ __forceinline__ f32x16 att_qk(const LAS unsigned char* buf, int sub, const bf16x8 (&Qf)[4], int lane) {
    f32x16 S = {0.f, 0.f, 0.f, 0.f, 0.f, 0.f, 0.f, 0.f, 0.f, 0.f, 0.f, 0.f, 0.f, 0.f, 0.f, 0.f};
    const LAS unsigned char* kp = buf + (sub * 32 + (lane & 31)) * 144 + (lane >> 5) * 16;
#pragma unroll
    for (int ks = 0; ks < 4; ++ks) { const bf16x8 kf = *(const LAS bf16x8*)(kp + ks * 32); S = __builtin_amdgcn_mfma_f32_32x32x16_bf16(kf, Qf[ks], S, 0, 0, 0); }
    return S;
}
__device__ __forceinline__ void att_pv2(const LAS unsigned char* buf, int sub, const bf16x8 P0, const bf16x8 P1, f32x16 (&O)[2], int lane) {
    const int h = lane >> 5;
#pragma unroll
    for (int dt = 0; dt < 2; ++dt) {
        const LAS unsigned char* vp = buf + AT_KB + (dt * 32 + (lane & 31)) * 136 + (sub * 32 + 4 * h) * 2;
        const u32x2 a0 = *(const LAS u32x2*)(vp), a1 = *(const LAS u32x2*)(vp + 16), b0 = *(const LAS u32x2*)(vp + 32), b1 = *(const LAS u32x2*)(vp + 48);
        const bf16x8 V0 = __builtin_bit_cast(bf16x8, ((u32x4){a0.x, a0.y, a1.x, a1.y}));
        const bf16x8 V1 = __builtin_bit_cast(bf16x8, ((u32x4){b0.x, b0.y, b1.x, b1.y}));
        O[dt] = __builtin_amdgcn_mfma_f32_32x32x16_bf16(V0, P0, O[dt], 0, 0, 0);
        O[dt] = __builtin_amdgcn_mfma_f32_32x32x16_bf16(V1, P1, O[dt], 0, 0, 0);
    }
}
__device__ __forceinline__ void att_pv(const LAS unsigned char* buf, int sub, const float (&p)[16], f32x16 (&O)[2], int lane) {
    const bf16x8 P0 = pack8(p[0], p[1], p[2], p[3], p[4], p[5], p[6], p[7]);
    const bf16x8 P1 = pack8(p[8], p[9], p[10], p[11], p[12], p[13], p[14], p[15]);
    att_pv2(buf, sub, P0, P1, O, lane);
}

__device__ __forceinline__ void att_kfrags(const LAS unsigned char* buf, int sub, bf16x8 (&Kf)[4], int lane) {
    const LAS unsigned char* kp = buf + (sub * 32 + (lane & 31)) * 144 + (lane >> 5) * 16;
#pragma unroll
    for (int ks = 0; ks < 4; ++ks) Kf[ks] = *(const LAS bf16x8*)(kp + ks * 32);
}
__device__ __forceinline__ void att_vfrags(const LAS unsigned char* buf, int sub, bf16x8 (&Vf)[2][2], int lane) {
    const int h = lane >> 5;
#pragma unroll
    for (int dt = 0; dt < 2; ++dt) {
        const LAS unsigned char* vp = buf + AT_KB + (dt * 32 + (lane & 31)) * 136 + (sub * 32 + 4 * h) * 2;
        const u32x2 a0 = *(const LAS u32x2*)(vp), a1 = *(const LAS u32x2*)(vp + 16), b0 = *(const LAS u32x2*)(vp + 32), b1 = *(const LAS u32x2*)(vp + 48);
        Vf[dt][0] = __builtin_bit_cast(bf16x8, ((u32x4){a0.x, a0.y, a1.x, a1.y}));
        Vf[dt][1] = __builtin_bit_cast(bf16x8, ((u32x4){b0.x, b0.y, b1.x, b1.y}));
    }
}
__device__ __forceinline__ f32x16 att_qk_f(const bf16x8 (&Kf)[4], const bf16x8 (&Qf)[4]) {
    f32x16 S = {0.f, 0.f, 0.f, 0.f, 0.f, 0.f, 0.f, 0.f, 0.f, 0.f, 0.f, 0.f, 0.f, 0.f, 0.f, 0.f};
#pragma unroll
    for (int ks = 0; ks < 4; ++ks) S = __builtin_amdgcn_mfma_f32_32x32x16_bf16(Kf[ks], Qf[ks], S, 0, 0, 0);
    return S;
}
__device__ __forceinline__ void att_pv_f(const bf16x8 (&Vf)[2][2], const bf16x8 P0, const bf16x8 P1, f32x16 (&O)[2]) {
#pragma unroll
    for (int dt = 0; dt < 2; ++dt) { O[dt] = __builtin_amdgcn_mfma_f32_32x32x16_bf16(Vf[dt][0], P0, O[dt], 0, 0, 0); O[dt] = __builtin_amdgcn_mfma_f32_32x32x16_bf16(Vf[dt][1], P1, O[dt], 0, 0, 0); }
}

__device__ __forceinline__ void p_dsa_attn(const Frame& F, const Args& a, unsigned char* ws) {
    const bf16_t* QA = (const bf16_t*)(ws + L0_QA); const bf16_t* KA = (const bf16_t*)(ws + L0_KA); const bf16_t* VAT = (const bf16_t*)(ws + L0_VAT);
    const u64* SELT = (const u64*)(ws + L0_SELT); bf16_t* CAT = (bf16_t*)(ws + L0_CAT);
    const int lane = F.lane, wave = F.wave, h = lane >> 5, c = lane & 31, tid = F.tid;
    float mq = 0.f, mk_ = 0.f;
    for (int i = 0; i < 64; ++i) { mq = fmaxf(mq, fabsf(a.in[I_L0_QG][i])); mk_ = fmaxf(mk_, fabsf(a.in[I_L0_KG][i])); }
    const float c2 = (8.0f * mq * mk_ + 0.5f) * 1.4426950408889634f, c1 = 1.4426950408889634f;
    for (int u = F.bid; u < 512; u += F.G) {
        const int idx = u & 255, g = u >> 8, b = idx >> 5, qtr = idx & 31, qt = g ? 31 - qtr : qtr, q0 = qt * 128;
        const size_t mb = (size_t)b * 4096;
        const bf16_t* Kg = KA + (size_t)(b * 2 + g) * 4096 * 64; const bf16_t* Vtg = VAT + (size_t)(b * 2 + g) * 64 * 4096;
        bf16x8 Qf[2][4]; int qidx[2];
#pragma unroll
        for (int ct = 0; ct < 2; ++ct) { qidx[ct] = q0 + wave * 16 + ct * 8 + (c >> 2);
#pragma unroll
            for (int ks = 0; ks < 4; ++ks) Qf[ct][ks] = *(const bf16x8*)(QA + (mb + qidx[ct]) * 512 + (g * 4 + (c & 3)) * 64 + ks * 16 + 8 * h); }
        f32x16 O[2][2]; float l[2] = {0.f, 0.f};
#pragma unroll
        for (int ct = 0; ct < 2; ++ct)
#pragma unroll
            for (int dt = 0; dt < 2; ++dt)
#pragma unroll
                for (int i = 0; i < 16; ++i) O[ct][dt][i] = 0.f;
        const int nkt = 2 * qt + 2;
        AttStage st; att_load(st, Kg, Vtg, 0, tid);
        __syncthreads();
        att_store(st, F.lds, tid);
        __syncthreads();
        for (int kt = 0; kt < nkt; ++kt) {
            LAS unsigned char* buf = F.lds + (kt & 1) * AT_BUF;
            if (kt + 1 < nkt) att_load(st, Kg, Vtg, (kt + 1) * 64, tid);
            u64 mw[2];
#pragma unroll
            for (int ct = 0; ct < 2; ++ct) mw[ct] = SELT[(size_t)(b * 64 + kt) * 4096 + qidx[ct]];
#pragma unroll 1
            for (int sub = 0; sub < 2; ++sub) {
                bf16x8 Kf[4], Vf[2][2];
                att_kfrags(buf, sub, Kf, lane); att_vfrags(buf, sub, Vf, lane);
#pragma unroll
                for (int ct = 0; ct < 2; ++ct) {
                    __builtin_amdgcn_sched_barrier(0);
                    const f32x16 S = att_qk_f(Kf, Qf[ct]);
                    const unsigned mbits = (unsigned)(mw[ct] >> (sub * 32 + 4 * h));
                    float p[16];
#pragma unroll
                    for (int i = 0; i < 16; ++i) {
                        const float e = __builtin_amdgcn_exp2f(S[i] * c1 - c2);
                        const int bitpos = (i & 3) + 8 * (i >> 2);
                        p[i] = __builtin_bit_cast(float, __builtin_bit_cast(int, e) & __builtin_amdgcn_sbfe((int)mbits, bitpos, 1));
                        l[ct] += p[i];
                    }
                    att_pv_f(Vf, pack8(p[0], p[1], p[2], p[3], p[4], p[5], p[6], p[7]), pack8(p[8], p[9], p[10], p[11], p[12], p[13], p[14], p[15]), O[ct]);
                }
            }
            if (kt + 1 < nkt) att_store(st, F.lds + ((kt + 1) & 1) * AT_BUF, tid);
            __syncthreads();
        }
#pragma unroll
        for (int ct = 0; ct < 2; ++ct) {
            const float lt = l[ct] + __shfl_xor(l[ct], 32);
            const float inv = 1.0f / fmaxf(lt, 1e-30f);
            bf16_t* orow = CAT + (mb + qidx[ct]) * 1024 + (g * 4 + (c & 3)) * 64;
#pragma unroll
            for (int dt = 0; dt < 2; ++dt)
#pragma unroll
                for (int i4 = 0; i4 < 4; ++i4) {
                    const int d = dt * 32 + 8 * i4 + 4 * h;
                    u32x2 w; w.x = pk2(O[ct][dt][4 * i4] * inv, O[ct][dt][4 * i4 + 1] * inv); w.y = pk2(O[ct][dt][4 * i4 + 2] * inv, O[ct][dt][4 * i4 + 3] * inv);
                    *(u32x2*)(orow + d) = w;
                }
        }
    }
}

__device__ __forceinline__ void p_s5_scan(const Frame& F, const Args& a, unsigned char* ws) {
    const float* SLOC = (const float*)(ws + L0_SLOC); bf16_t* UA = (bf16_t*)(ws + L0_UA);
    const int p = F.lane;
    if (F.wave == 0) for (int it = F.bid; it < 32 * NB; it += F.G) {
        const int g = it >> 3, b = it & 7;
        const float dt = expf(a.in[I_L0_LOGDT][g]);
        const float lr = a.in[I_L0_ARE][g * 64 + p], li = a.in[I_L0_AIM][g * 64 + p];
        const float mag = expf(16.0f * dt * lr); float s, c; sincosf(16.0f * dt * li, &s, &c);
        const float ar = mag * c, ai = mag * s;
        float hr = 0.f, hi = 0.f;
        const float* sl = SLOC + ((size_t)g * 2048 + b * 256) * 128;
        bf16_t* ua = UA + ((size_t)g * 2048 + b * 256) * 384 + 256;
        for (int ch = 0; ch < 256; ++ch) {
            ua[(size_t)ch * 384 + p] = (bf16_t)f2bf(hr); ua[(size_t)ch * 384 + 64 + p] = (bf16_t)f2bf(hi);
            const float xr = sl[(size_t)ch * 128 + p], xi = sl[(size_t)ch * 128 + 64 + p];
            const float nr = ar * hr - ai * hi + xr, ni = ar * hi + ai * hr + xi;
            hr = nr; hi = ni;
        }
    }
}
namespace pg8 {
struct EpiS5State {
    static constexpr bool PERM = false;
    float* C;
    __device__ __forceinline__ void operator()(const f32x4 (&acc)[2][2][4][2], const Unit& u, int wr, int wc, int fr, int fq) const {
        const int row0 = u.pm * BM + wr * 64 + fr, col0 = wc * 32 + 4 * fq;
#pragma unroll
        for (int ai = 0; ai < 2; ++ai)
#pragma unroll
            for (int m = 0; m < 4; ++m)
#pragma unroll
                for (int n = 0; n < 2; ++n) *(f32x4*)(C + (size_t)(row0 + ai * HALF + m * 16) * 128 + col0 + n * 16) = acc[ai][0][m][n];
    }
};
struct EpiS5Out {
    static constexpr bool PERM = false;
    bf16_t* YB;
    __device__ __forceinline__ void operator()(const f32x4 (&acc)[2][2][4][2], const Unit& u, int wr, int wc, int fr, int fq) const {
        const int g = u.pn;
        const int row0 = u.pm * BM + wr * 64 + fr - g * 2048;
        const int col0 = wc * 32 + 4 * fq;
#pragma unroll
        for (int ai = 0; ai < 2; ++ai)
#pragma unroll
            for (int m = 0; m < 4; ++m) { const int chunk = row0 + ai * HALF + m * 16;
#pragma unroll
                for (int bj = 0; bj < 2; ++bj)
#pragma unroll
                    for (int n = 0; n < 2; ++n) { const int col = col0 + bj * HALF + n * 16, i = col >> 4, co = col & 15;
                        const f32x4 v = acc[ai][bj][m][n];
                        u32x2 w; w.x = pk2(gelu_tanh(v[0]), gelu_tanh(v[1])); w.y = pk2(gelu_tanh(v[2]), gelu_tanh(v[3]));
                        *(u32x2*)(YB + ((size_t)chunk * 16 + i) * 512 + g * 16 + co) = w; }
                asm volatile("" ::: "memory"); __builtin_amdgcn_sched_barrier(0); }
    }
};
struct EpiGlu {
    static constexpr bool PERM = true;
    const bf16_t* YB; const float* bias; bf16_t* CAT;
    __device__ __forceinline__ void operator()(const f32x4 (&acc)[2][2][4][2], const Unit& u, int wr, int wc, int fr, int fq) const {
        const int row0 = u.pm * BM + wr * 64 + fr, col0 = u.pn * BM + wc * 32 + 8 * fq;
#pragma unroll
        for (int ai = 0; ai < 2; ++ai)
#pragma unroll
            for (int m = 0; m < 4; ++m) { const size_t row = row0 + ai * HALF + m * 16;
#pragma unroll
                for (int bj = 0; bj < 2; ++bj) { const int col = col0 + bj * HALF;
                    const u32x4 yv = *(const u32x4*)(YB + row * 512 + col);
                    const f32x4 b0 = *(const f32x4*)(bias + col), b1 = *(const f32x4*)(bias + col + 4);
                    const f32x4 z0 = acc[ai][bj][m][0] + b0, z1 = acc[ai][bj][m][1] + b1;
                    u32x4 w;
                    w.x = pk2(bf_lo(yv.x) * sigmoidf_(z0[0]), bf_hi(yv.x) * sigmoidf_(z0[1])); w.y = pk2(bf_lo(yv.y) * sigmoidf_(z0[2]), bf_hi(yv.y) * sigmoidf_(z0[3]));
                    w.z = pk2(bf_lo(yv.z) * sigmoidf_(z1[0]), bf_hi(yv.z) * sigmoidf_(z1[1])); w.w = pk2(bf_lo(yv.w) * sigmoidf_(z1[2]), bf_hi(yv.w) * sigmoidf_(z1[3]));
                    *(u32x4*)(CAT + row * 1024 + 512 + col) = w; }
                asm volatile("" ::: "memory"); __builtin_amdgcn_sched_barrier(0); }
    }
};
}
__device__ __forceinline__ void peer_fold_wq(const Frame& F, const float* wq, const float* sk, bf16_t* WT) {
    const int gw = F.bid * NWAVES + F.wave, NGW = F.G * NWAVES, lane = F.lane, r = lane & 31, h = lane >> 5;
    for (int it = gw; it < 16 * 4 * 32; it += NGW) {
        const int dt = it & 31, kt = (it >> 5) & 3, hp = it >> 7;
        f32x16 acc = {0.f, 0.f, 0.f, 0.f, 0.f, 0.f, 0.f, 0.f, 0.f, 0.f, 0.f, 0.f, 0.f, 0.f, 0.f, 0.f};
        const float* ap = sk + ((size_t)hp * 128 + 32 * kt + r) * 128 + 8 * h;
        const float* bp = wq + (size_t)(32 * dt + r) * 2048 + hp * 128 + 8 * h;
#pragma unroll
        for (int ks = 0; ks < 8; ++ks) {
            const f32x4 a0 = *(const f32x4*)(ap + 16 * ks), a1 = *(const f32x4*)(ap + 16 * ks + 4), b0 = *(const f32x4*)(bp + 16 * ks), b1 = *(const f32x4*)(bp + 16 * ks + 4);
            acc = __builtin_amdgcn_mfma_f32_32x32x16_bf16(pack8(a0[0], a0[1], a0[2], a0[3], a1[0], a1[1], a1[2], a1[3]), pack8(b0[0], b0[1], b0[2], b0[3], b1[0], b1[1], b1[2], b1[3]), acc, 0, 0, 0);
        }
#pragma unroll
        for (int i = 0; i < 16; ++i) WT[((size_t)hp * 128 + 32 * kt + (i & 3) + 8 * (i >> 2) + 4 * h) * 1024 + 32 * dt + r] = (bf16_t)f2bf(acc[i]);
    }
}
__device__ __forceinline__ unsigned mono_u32(float f) { const unsigned u = __builtin_bit_cast(unsigned, f); return u ^ ((u >> 31) ? 0xFFFFFFFFu : 0x80000000u); }
#define CE_DESC(x, y) do { const unsigned _hi = (x) > (y) ? (x) : (y), _lo = (x) > (y) ? (y) : (x); (x) = _hi; (y) = _lo; } while (0)
__device__ __forceinline__ void sort16_desc(unsigned (&a)[16]) {
#pragma unroll
    for (int k = 2; k <= 16; k <<= 1)
#pragma unroll
        for (int j = k >> 1; j > 0; j >>= 1)
#pragma unroll
            for (int i = 0; i < 16; ++i) { const int l = i ^ j; if (l > i) { if ((i & k) == 0) CE_DESC(a[i], a[l]); else CE_DESC(a[l], a[i]); } }
}
__device__ __forceinline__ void merge16_desc(unsigned (&a)[16], const unsigned (&b)[16]) {
#pragma unroll
    for (int i = 0; i < 16; ++i) a[i] = a[i] > b[15 - i] ? a[i] : b[15 - i];
#pragma unroll
    for (int j = 8; j > 0; j >>= 1)
#pragma unroll
        for (int i = 0; i < 16; ++i) { const int l = i ^ j; if (l > i) CE_DESC(a[i], a[l]); }
}
__device__ __forceinline__ void merge16_xlane(unsigned (&a)[16]) {
    unsigned b[16];
#pragma unroll
    for (int i = 0; i < 16; ++i) b[i] = (unsigned)__shfl_xor((int)a[i], 32);
    merge16_desc(a, b);
}
struct PeerCand { int a[50], b[50]; };
__host__ __device__ constexpr PeerCand peer_cands() { PeerCand c{}; int n = 0; for (int a = 0; a < 16; ++a) for (int b = 0; b < 16; ++b) if ((a + 1) * (b + 1) <= 16) { c.a[n] = a; c.b[n] = b; ++n; } return c; }
__device__ __forceinline__ void p_peer_route(const Frame& F, unsigned char* ws) {
    const _Float16* S16 = (const _Float16*)(ws + PE_Q2); unsigned short* EID = (unsigned short*)(ws + PE_EID); float* GATE = (float*)(ws + PE_GATE);
    LAS float* sc0 = (LAS float*)F.lds;
    const int lane = F.lane, wave = F.wave, h5 = lane >> 5, r = lane & 31, tid = F.tid;
    constexpr PeerCand PC = peer_cands();
    u32x4 pre[8];
    { const int u = F.bid; if (u < 2048) { const int hd = u & 7, mt = u >> 3;
#pragma unroll
        for (int q = 0; q < 8; ++q) pre[q] = *(const u32x4*)(S16 + ((size_t)mt * 128 + (q & 3) * 32 + (tid >> 4)) * 2048 + (hd * 2 + (q >> 2)) * 128 + (tid & 15) * 8); } }
    for (int u = F.bid; u < 2048; u += F.G) {
        const int hd = u & 7, mt = u >> 3; const size_t m0 = (size_t)mt * 128;
#pragma unroll
        for (int q = 0; q < 8; ++q) {
            LAS float* dst = sc0 + (q >> 2) * 128 * 129 + ((q & 3) * 32 + (tid >> 4)) * 129 + (tid & 15) * 8;
            const u32x4 v = pre[q];
#pragma unroll
            for (int j = 0; j < 4; ++j) { const unsigned w = v[j]; dst[2 * j] = (float)__builtin_bit_cast(_Float16, (unsigned short)(w & 0xffffu)); dst[2 * j + 1] = (float)__builtin_bit_cast(_Float16, (unsigned short)(w >> 16)); }
        }
        { const int un = u + F.G; if (un < 2048) { const int hdn = un & 7, mtn = un >> 3;
#pragma unroll
            for (int q = 0; q < 8; ++q) pre[q] = *(const u32x4*)(S16 + ((size_t)mtn * 128 + (q & 3) * 32 + (tid >> 4)) * 2048 + (hdn * 2 + (q >> 2)) * 128 + (tid & 15) * 8); } }
        __syncthreads();
        {
            const int pp = wave >> 2, row = (wave & 3) * 32 + r, half = h5; LAS float* rowp = sc0 + pp * 128 * 129 + row * 129;
            unsigned top[16];
#pragma unroll
            for (int blk = 0; blk < 4; ++blk) {
                unsigned k16[16];
#pragma unroll
                for (int i = 0; i < 16; ++i) { const int j = half * 64 + blk * 16 + i; k16[i] = (mono_u32(rowp[j]) & ~0x7Fu) | (unsigned)(127 - j); }
                sort16_desc(k16);
                if (blk == 0) {
#pragma unroll
                    for (int i = 0; i < 16; ++i) top[i] = k16[i];
                } else merge16_desc(top, k16);
            }
            merge16_xlane(top);
            float vals[16]; int ids[16];
#pragma unroll
            for (int k = 0; k < 16; ++k) { ids[k] = 127 - (int)(top[k] & 127u); vals[k] = rowp[ids[k]]; }
            if (half == 0) {
#pragma unroll
                for (int k = 0; k < 16; ++k) { rowp[k] = vals[k]; rowp[16 + k] = __int_as_float(ids[k]); }
            }
        }
        __syncthreads();
        if (tid < 256) {
            const int row = (wave & 3) * 32 + r, half = h5; const LAS float* s1 = sc0 + row * 129; const LAS float* s2 = sc0 + 128 * 129 + row * 129;
            float v1[16], v2[16];
#pragma unroll
            for (int k = 0; k < 16; ++k) { v1[k] = s1[k]; v2[k] = s2[k]; }
            unsigned top[16], k16[16];
#pragma unroll
            for (int i = 0; i < 16; ++i) { const int c0 = 2 * i, c1 = 2 * i + 1;
                const unsigned ka = (mono_u32(v1[PC.a[c0]] + v2[PC.b[c0]]) & ~0xFFu) | (unsigned)(255 - (PC.a[c0] * 16 + PC.b[c0]));
                const unsigned kb = (mono_u32(v1[PC.a[c1]] + v2[PC.b[c1]]) & ~0xFFu) | (unsigned)(255 - (PC.a[c1] * 16 + PC.b[c1]));
                top[i] = half ? kb : ka; }
#pragma unroll
            for (int i = 0; i < 16; ++i) { if (i < 9) { const int c0 = 32 + 2 * i, c1 = 32 + 2 * i + 1;
                    const unsigned ka = (mono_u32(v1[PC.a[c0]] + v2[PC.b[c0]]) & ~0xFFu) | (unsigned)(255 - (PC.a[c0] * 16 + PC.b[c0]));
                    const unsigned kb = (mono_u32(v1[PC.a[c1]] + v2[PC.b[c1]]) & ~0xFFu) | (unsigned)(255 - (PC.a[c1] * 16 + PC.b[c1]));
                    k16[i] = half ? kb : ka; } else k16[i] = 0u; }
            sort16_desc(top); sort16_desc(k16); merge16_desc(top, k16);
            merge16_xlane(top);
            if (half == 0) {
                float mx = -3.0e38f; float sv[16]; int eid[16];
#pragma unroll
                for (int k = 0; k < 16; ++k) { const int fl = 255 - (int)(top[k] & 255u), a = fl >> 4, b = fl & 15;
                    sv[k] = s1[a] + s2[b]; eid[k] = __float_as_int(s1[16 + a]) * 128 + __float_as_int(s2[16 + b]); mx = fmaxf(mx, sv[k]); }
                float den = 0.f;
#pragma unroll
                for (int k = 0; k < 16; ++k) { sv[k] = __expf(sv[k] - mx); den += sv[k]; }
                const float inv = 1.0f / den;
                unsigned short* ep = EID + (m0 + row) * 128 + hd * 16; float* gp = GATE + (m0 + row) * 128 + hd * 16;
#pragma unroll
                for (int k = 0; k < 16; ++k) { ep[k] = (unsigned short)eid[k]; gp[k] = sv[k] * inv; }
            }
        }
        __syncthreads();
    }
}

__device__ __forceinline__ float rdlane_f(float v, int l) { return __builtin_bit_cast(float, __builtin_amdgcn_readlane(__builtin_bit_cast(int, v), l)); }
__device__ __forceinline__ void p_peer_expert(const Frame& F, unsigned char* ws, float* xres) {
    const bf16_t* XN = (const bf16_t*)(ws + WS_XN); const bf16_t* TU = (const bf16_t*)(ws + WS_TABU); const bf16_t* TV = (const bf16_t*)(ws + WS_TABV);
    const unsigned short* EID = (const unsigned short*)(ws + PE_EID); const float* GATE = (const float*)(ws + PE_GATE);
    const int gw = F.bid * NWAVES + F.wave, NGW = F.G * NWAVES, lane = F.lane;
    for (int m = gw; m < T; m += NGW) {
        float xf[16];
        { const u32x4 xa = *(const u32x4*)(XN + (size_t)m * 1024 + lane * 8), xb = *(const u32x4*)(XN + (size_t)m * 1024 + 512 + lane * 8);
          xf[0] = bf_lo(xa.x); xf[1] = bf_hi(xa.x); xf[2] = bf_lo(xa.y); xf[3] = bf_hi(xa.y); xf[4] = bf_lo(xa.z); xf[5] = bf_hi(xa.z); xf[6] = bf_lo(xa.w); xf[7] = bf_hi(xa.w);
          xf[8] = bf_lo(xb.x); xf[9] = bf_hi(xb.x); xf[10] = bf_lo(xb.y); xf[11] = bf_hi(xb.y); xf[12] = bf_lo(xb.z); xf[13] = bf_hi(xb.z); xf[14] = bf_lo(xb.w); xf[15] = bf_hi(xb.w); }
        const int id0 = EID[(size_t)m * 128 + lane], id1 = EID[(size_t)m * 128 + 64 + lane];
        const float g0 = GATE[(size_t)m * 128 + lane], g1 = GATE[(size_t)m * 128 + 64 + lane];
        float outv[16];
#pragma unroll
        for (int i = 0; i < 16; ++i) outv[i] = 0.f;
#pragma unroll 1
        for (int k = 0; k < 16; ++k) {
            const int idreg = (k < 8) ? id0 : id1; const float greg = (k < 8) ? g0 : g1; const int lbase = (k & 7) * 8;
            int e[8];
#pragma unroll
            for (int i = 0; i < 8; ++i) e[i] = __builtin_amdgcn_readlane(idreg, lbase + i);
            float pr[8];
            {
                u32x4 ua[8], ub[8];
#pragma unroll
                for (int i = 0; i < 8; ++i) { ua[i] = *(const u32x4*)(TU + (size_t)e[i] * 1024 + lane * 8); ub[i] = *(const u32x4*)(TU + (size_t)e[i] * 1024 + 512 + lane * 8); }
#pragma unroll
                for (int i = 0; i < 8; ++i) {
                    float s = xf[0] * bf_lo(ua[i].x); s += xf[1] * bf_hi(ua[i].x); s += xf[2] * bf_lo(ua[i].y); s += xf[3] * bf_hi(ua[i].y);
                    s += xf[4] * bf_lo(ua[i].z); s += xf[5] * bf_hi(ua[i].z); s += xf[6] * bf_lo(ua[i].w); s += xf[7] * bf_hi(ua[i].w);
                    s += xf[8] * bf_lo(ub[i].x); s += xf[9] * bf_hi(ub[i].x); s += xf[10] * bf_lo(ub[i].y); s += xf[11] * bf_hi(ub[i].y);
                    s += xf[12] * bf_lo(ub[i].z); s += xf[13] * bf_hi(ub[i].z); s += xf[14] * bf_lo(ub[i].w); s += xf[15] * bf_hi(ub[i].w);
                    pr[i] = s;
                }
            }
            float r4[4], r2[2], r1;
            { const bool up = (lane & 32) != 0;
#pragma unroll
              for (int i = 0; i < 4; ++i) { const float keep = up ? pr[i + 4] : pr[i], send = up ? pr[i] : pr[i + 4]; r4[i] = keep + __shfl_xor(send, 32); } }
            { const bool up = (lane & 16) != 0;
#pragma unroll
              for (int i = 0; i < 2; ++i) { const float keep = up ? r4[i + 2] : r4[i], send = up ? r4[i] : r4[i + 2]; r2[i] = keep + __shfl_xor(send, 16); } }
            { const bool up = (lane & 8) != 0; const float keep = up ? r2[1] : r2[0], send = up ? r2[0] : r2[1]; r1 = keep + __shfl_xor(send, 8); }
            r1 += __shfl_xor(r1, 4); r1 += __shfl_xor(r1, 2); r1 += __shfl_xor(r1, 1);
            const float gv = __shfl(greg, lbase + (lane >> 3));
            const float coef = gv * gelu_tanh(r1);
            {
                u32x4 va[8], vb[8];
#pragma unroll
                for (int i = 0; i < 8; ++i) { va[i] = *(const u32x4*)(TV + (size_t)e[i] * 1024 + lane * 8); vb[i] = *(const u32x4*)(TV + (size_t)e[i] * 1024 + 512 + lane * 8); }
#pragma unroll
                for (int i = 0; i < 8; ++i) {
                    const float ci = rdlane_f(coef, i * 8);
                    outv[0] += ci * bf_lo(va[i].x); outv[1] += ci * bf_hi(va[i].x); outv[2] += ci * bf_lo(va[i].y); outv[3] += ci * bf_hi(va[i].y);
                    outv[4] += ci * bf_lo(va[i].z); outv[5] += ci * bf_hi(va[i].z); outv[6] += ci * bf_lo(va[i].w); outv[7] += ci * bf_hi(va[i].w);
                    outv[8] += ci * bf_lo(vb[i].x); outv[9] += ci * bf_hi(vb[i].x); outv[10] += ci * bf_lo(vb[i].y); outv[11] += ci * bf_hi(vb[i].y);
                    outv[12] += ci * bf_lo(vb[i].z); outv[13] += ci * bf_hi(vb[i].z); outv[14] += ci * bf_lo(vb[i].w); outv[15] += ci * bf_hi(vb[i].w);
                }
            }
        }
        f32x4* o = (f32x4*)(xres + (size_t)m * 1024 + lane * 8);
        f32x4 a0 = o[0], a1 = o[1], b0 = o[128], b1 = o[129];
        a0 += (f32x4){outv[0], outv[1], outv[2], outv[3]}; a1 += (f32x4){outv[4], outv[5], outv[6], outv[7]};
        b0 += (f32x4){outv[8], outv[9], outv[10], outv[11]}; b1 += (f32x4){outv[12], outv[13], outv[14], outv[15]};
        o[0] = a0; o[1] = a1; o[128] = b0; o[129] = b1;
    }
}

typedef __bf16 bf16x2_t __attribute__((ext_vector_type(2)));
__device__ __forceinline__ float dot2bf(unsigned a, unsigned b, float c) { return __builtin_amdgcn_fdot2_f32_bf16(__builtin_bit_cast(bf16x2_t, a), __builtin_bit_cast(bf16x2_t, b), c, false); }
__device__ __forceinline__ void peer_slot_range(const unsigned (&xp)[8], float (&outv)[16], int id0, int id1, float g0, float g1, int r,
                                                const bf16_t* TU, const bf16_t* TV, int lane) {
    u64 m0 = __ballot((id0 >> 9) == r), m1 = __ballot((id1 >> 9) == r);
    while (m0 | m1) {
        int e[8]; float gt[8];
#pragma unroll
        for (int i = 0; i < 8; ++i) {
            if (m0) { const int l = __builtin_ctzll(m0); m0 &= m0 - 1ull; e[i] = __builtin_amdgcn_readlane(id0, l); gt[i] = rdlane_f(g0, l); }
            else if (m1) { const int l = __builtin_ctzll(m1); m1 &= m1 - 1ull; e[i] = __builtin_amdgcn_readlane(id1, l); gt[i] = rdlane_f(g1, l); }
            else { e[i] = -1; gt[i] = 0.f; }
        }
        float pr[8];
        {
            u32x4 ua[8], ub[8];
#pragma unroll
            for (int i = 0; i < 8; ++i) {
                if (e[i] >= 0) { ua[i] = *(const u32x4*)(TU + (size_t)e[i] * 1024 + lane * 8); ub[i] = *(const u32x4*)(TU + (size_t)e[i] * 1024 + 512 + lane * 8); }
                else { ua[i] = (u32x4){0u, 0u, 0u, 0u}; ub[i] = (u32x4){0u, 0u, 0u, 0u}; }
            }
#pragma unroll
            for (int i = 0; i < 8; ++i) {
                float s = dot2bf(xp[0], ua[i].x, 0.f); s = dot2bf(xp[1], ua[i].y, s); s = dot2bf(xp[2], ua[i].z, s); s = dot2bf(xp[3], ua[i].w, s);
                s = dot2bf(xp[4], ub[i].x, s); s = dot2bf(xp[5], ub[i].y, s); s = dot2bf(xp[6], ub[i].z, s); s = dot2bf(xp[7], ub[i].w, s);
                pr[i] = s;
            }
        }
        float r4[4], r2[2], r1;
        { const bool up = (lane & 32) != 0;
#pragma unroll
          for (int i = 0; i < 4; ++i) { const float keep = up ? pr[i + 4] : pr[i], send = up ? pr[i] : pr[i + 4]; r4[i] = keep + __shfl_xor(send, 32); } }
        { const bool up = (lane & 16) != 0;
#pragma unroll
          for (int i = 0; i < 2; ++i) { const float keep = up ? r4[i + 2] : r4[i], send = up ? r4[i] : r4[i + 2]; r2[i] = keep + __shfl_xor(send, 16); } }
        { const bool up = (lane & 8) != 0; const float keep = up ? r2[1] : r2[0], send = up ? r2[0] : r2[1]; r1 = keep + __shfl_xor(send, 8); }
        r1 += __shfl_xor(r1, 4); r1 += __shfl_xor(r1, 2); r1 += __shfl_xor(r1, 1);
        const int grp = lane >> 3;
        float gsel = gt[0];
#pragma unroll
        for (int i = 1; i < 8; ++i) gsel = (grp == i) ? gt[i] : gsel;
        const float coef = gsel * gelu_tanh(r1);
        {
            u32x4 va[8], vb[8];
#pragma unroll
            for (int i = 0; i < 8; ++i) {
                if (e[i] >= 0) { va[i] = *(const u32x4*)(TV + (size_t)e[i] * 1024 + lane * 8); vb[i] = *(const u32x4*)(TV + (size_t)e[i] * 1024 + 512 + lane * 8); }
                else { va[i] = (u32x4){0u, 0u, 0u, 0u}; vb[i] = (u32x4){0u, 0u, 0u, 0u}; }
            }
#pragma unroll
            for (int i = 0; i < 8; ++i) {
                if (e[i] >= 0) {
                    const float ci = rdlane_f(coef, i * 8);
                    outv[0] += ci * bf_lo(va[i].x); outv[1] += ci * bf_hi(va[i].x); outv[2] += ci * bf_lo(va[i].y); outv[3] += ci * bf_hi(va[i].y);
                    outv[4] += ci * bf_lo(va[i].z); outv[5] += ci * bf_hi(va[i].z); outv[6] += ci * bf_lo(va[i].w); outv[7] += ci * bf_hi(va[i].w);
                    outv[8] += ci * bf_lo(vb[i].x); outv[9] += ci * bf_hi(vb[i].x); outv[10] += ci * bf_lo(vb[i].y); outv[11] += ci * bf_hi(vb[i].y);
                    outv[12] += ci * bf_lo(vb[i].z); outv[13] += ci * bf_hi(vb[i].z); outv[14] += ci * bf_lo(vb[i].w); outv[15] += ci * bf_hi(vb[i].w);
                }
            }
        }
    }
}
__device__ __forceinline__ void p_peer_expert2(const Frame& F, unsigned char* ws, float* xres, const float oscale) {
    const bf16_t* XN = (const bf16_t*)(ws + WS_XN); const bf16_t* TU = (const bf16_t*)(ws + WS_TABU); const bf16_t* TV = (const bf16_t*)(ws + WS_TABV);
    const unsigned short* EID = (const unsigned short*)(ws + PE_EID); const float* GATE = (const float*)(ws + PE_GATE);
    const int gw = F.bid * NWAVES + F.wave, NGW = F.G * NWAVES, lane = F.lane;
    int rnd = 0;
    for (int m4 = gw * 4; m4 < T; m4 += NGW * 4, ++rnd) {
        unsigned xp[4][8]; float outv[4][16]; int id[4][2]; float gg[4][2];
#pragma unroll
        for (int s = 0; s < 4; ++s) {
            const size_t m = (size_t)(m4 + s);
            const u32x4 xa = *(const u32x4*)(XN + m * 1024 + lane * 8), xb = *(const u32x4*)(XN + m * 1024 + 512 + lane * 8);
            xp[s][0] = xa.x; xp[s][1] = xa.y; xp[s][2] = xa.z; xp[s][3] = xa.w; xp[s][4] = xb.x; xp[s][5] = xb.y; xp[s][6] = xb.z; xp[s][7] = xb.w;
            id[s][0] = EID[m * 128 + lane]; id[s][1] = EID[m * 128 + 64 + lane]; gg[s][0] = GATE[m * 128 + lane]; gg[s][1] = GATE[m * 128 + 64 + lane];
#pragma unroll
            for (int i = 0; i < 16; ++i) outv[s][i] = 0.f;
        }
#pragma unroll 1
        for (int k = 0; k < 32; ++k) {
            const int r = (rnd & 1) ? 31 - k : k;
#pragma unroll
            for (int s = 0; s < 4; ++s) peer_slot_range(xp[s], outv[s], id[s][0], id[s][1], gg[s][0], gg[s][1], r, TU, TV, lane);
        }
#pragma unroll
        for (int s = 0; s < 4; ++s) {
            f32x4* o = (f32x4*)(xres + (size_t)(m4 + s) * 1024 + lane * 8);
            f32x4 a0 = o[0], a1 = o[1], b0 = o[128], b1 = o[129];
            a0 += (f32x4){outv[s][0], outv[s][1], outv[s][2], outv[s][3]} * oscale; a1 += (f32x4){outv[s][4], outv[s][5], outv[s][6], outv[s][7]} * oscale;
            b0 += (f32x4){outv[s][8], outv[s][9], outv[s][10], outv[s][11]} * oscale; b1 += (f32x4){outv[s][12], outv[s][13], outv[s][14], outv[s][15]} * oscale;
            o[0] = a0; o[1] = a1; o[128] = b0; o[129] = b1;
        }
    }
}

struct RowBuf { u32x4 a[8], b[8]; };
__device__ __forceinline__ void peer_load8(RowBuf& rb, const bf16_t* TAB, const LAS unsigned* ent, int b, int lane) {
#pragma unroll
    for (int i = 0; i < 8; ++i) {
        const unsigned e = (unsigned)__builtin_amdgcn_readfirstlane((int)ent[b * 8 + i]) & 0x3FFFu;
        const bf16_t* rp = TAB + (size_t)e * 1024 + lane * 8;
        rb.a[i] = *(const u32x4*)rp; rb.b[i] = *(const u32x4*)(rp + 512);
    }
}
__device__ __forceinline__ float peer_dot(const unsigned (&xp)[8], const u32x4 a, const u32x4 b) {
    float s = dot2bf(xp[0], a.x, 0.f); s = dot2bf(xp[1], a.y, s); s = dot2bf(xp[2], a.z, s); s = dot2bf(xp[3], a.w, s);
    s = dot2bf(xp[4], b.x, s); s = dot2bf(xp[5], b.y, s); s = dot2bf(xp[6], b.z, s); s = dot2bf(xp[7], b.w, s);
    return s;
}
__device__ __forceinline__ void peer_u8(const RowBuf& rb, const unsigned (&xp)[4][8], const LAS unsigned* ent, LAS float* cf, int b, int lane) {
    float pr[8];
#pragma unroll
    for (int i = 0; i < 8; ++i) {
        const int slot = (__builtin_amdgcn_readfirstlane((int)ent[b * 8 + i]) >> 21) & 3;
        if (slot == 0) pr[i] = peer_dot(xp[0], rb.a[i], rb.b[i]);
        else if (slot == 1) pr[i] = peer_dot(xp[1], rb.a[i], rb.b[i]);
        else if (slot == 2) pr[i] = peer_dot(xp[2], rb.a[i], rb.b[i]);
        else pr[i] = peer_dot(xp[3], rb.a[i], rb.b[i]);
    }
    float r4[4], r2[2], r1;
    { const bool up = (lane & 32) != 0;
#pragma unroll
      for (int i = 0; i < 4; ++i) { const float keep = up ? pr[i + 4] : pr[i], send = up ? pr[i] : pr[i + 4]; r4[i] = keep + __shfl_xor(send, 32); } }
    { const bool up = (lane & 16) != 0;
#pragma unroll
      for (int i = 0; i < 2; ++i) { const float keep = up ? r4[i + 2] : r4[i], send = up ? r4[i] : r4[i + 2]; r2[i] = keep + __shfl_xor(send, 16); } }
    { const bool up = (lane & 8) != 0; const float keep = up ? r2[1] : r2[0], send = up ? r2[0] : r2[1]; r1 = keep + __shfl_xor(send, 8); }
    r1 += __shfl_xor(r1, 4); r1 += __shfl_xor(r1, 2); r1 += __shfl_xor(r1, 1);
    const float gate = cf[b * 8 + (lane >> 3)];
    const float coef = gate * gelu_tanh(r1);
    if ((lane & 7) == 0) cf[b * 8 + (lane >> 3)] = coef;
}
__device__ __forceinline__ void peer_acc(float (&o)[16], const float c, const u32x4 a, const u32x4 b) {
    o[0] += c * bf_lo(a.x); o[1] += c * bf_hi(a.x); o[2] += c * bf_lo(a.y); o[3] += c * bf_hi(a.y);
    o[4] += c * bf_lo(a.z); o[5] += c * bf_hi(a.z); o[6] += c * bf_lo(a.w); o[7] += c * bf_hi(a.w);
    o[8] += c * bf_lo(b.x); o[9] += c * bf_hi(b.x); o[10] += c * bf_lo(b.y); o[11] += c * bf_hi(b.y);
    o[12] += c * bf_lo(b.z); o[13] += c * bf_hi(b.z); o[14] += c * bf_lo(b.w); o[15] += c * bf_hi(b.w);
}
__device__ __forceinline__ void peer_v8(const RowBuf& rb, float (&outv)[4][16], const LAS unsigned* ent, const LAS float* cf, int b) {
#pragma unroll
    for (int i = 0; i < 8; ++i) {
        const int slot = (__builtin_amdgcn_readfirstlane((int)ent[b * 8 + i]) >> 21) & 3;
        const float c = cf[b * 8 + i];
        if (slot == 0) peer_acc(outv[0], c, rb.a[i], rb.b[i]);
        else if (slot == 1) peer_acc(outv[1], c, rb.a[i], rb.b[i]);
        else if (slot == 2) peer_acc(outv[2], c, rb.a[i], rb.b[i]);
        else peer_acc(outv[3], c, rb.a[i], rb.b[i]);
    }
}
__device__ __forceinline__ void p_peer_expert3(const Frame& F, unsigned char* ws, float* xres, const float oscale, const XcdBarrier& xbar) {
    const bf16_t* XN = (const bf16_t*)(ws + WS_XN); const bf16_t* TU = (const bf16_t*)(ws + WS_TABU); const bf16_t* TV = (const bf16_t*)(ws + WS_TABV);
    const unsigned short* EID = (const unsigned short*)(ws + PE_EID); const float* GATE = (const float*)(ws + PE_GATE);
    const int gw = F.bid * NWAVES + F.wave, NGW = F.G * NWAVES, lane = F.lane;
    LAS unsigned* ent = (LAS unsigned*)(F.lds + F.wave * 4096);
    LAS float* cf = (LAS float*)(F.lds + F.wave * 4096 + 2048);
    const int nrounds = (T + NGW * 4 - 1) / (NGW * 4);
    for (int rnd = 0; rnd < nrounds; ++rnd) {
        const int m4 = (rnd * NGW + gw) * 4;
        if (m4 < T) {
            unsigned xp[4][8];
            {
                int id[4][2]; float gg[4][2];
#pragma unroll
                for (int s = 0; s < 4; ++s) {
                    const size_t m = (size_t)(m4 + s);
                    const u32x4 xa = *(const u32x4*)(XN + m * 1024 + lane * 8), xb = *(const u32x4*)(XN + m * 1024 + 512 + lane * 8);
                    xp[s][0] = xa.x; xp[s][1] = xa.y; xp[s][2] = xa.z; xp[s][3] = xa.w; xp[s][4] = xb.x; xp[s][5] = xb.y; xp[s][6] = xb.z; xp[s][7] = xb.w;
                    id[s][0] = EID[m * 128 + lane]; id[s][1] = EID[m * 128 + 64 + lane]; gg[s][0] = GATE[m * 128 + lane]; gg[s][1] = GATE[m * 128 + 64 + lane];
                }
                int base = 0;
#pragma unroll 1
                for (int k = 0; k < 32; ++k) {
                    const int r = (rnd & 1) ? 31 - k : k;
#pragma unroll
                    for (int s = 0; s < 4; ++s)
#pragma unroll
                        for (int w = 0; w < 2; ++w) {
                            const bool hit = (id[s][w] >> 9) == r;
                            const u64 m = __ballot(hit);
                            if (hit) { const int pos = base + (int)__builtin_amdgcn_mbcnt_hi((unsigned)(m >> 32), __builtin_amdgcn_mbcnt_lo((unsigned)m, 0u));
                                ent[pos] = ((unsigned)s << 21) | ((unsigned)(w * 64 + lane) << 14) | (unsigned)id[s][w]; cf[pos] = gg[s][w]; }
                            base += __builtin_popcountll(m);
                        }
                }
            }
            LDS_WAIT();
            {
                RowBuf A, B;
                peer_load8(A, TU, ent, 0, lane);
#pragma unroll 1
                for (int b = 0; b < 64; b += 2) {
                    peer_load8(B, TU, ent, b + 1, lane);
                    peer_u8(A, xp, ent, cf, b, lane);
                    if (b + 2 < 64) peer_load8(A, TU, ent, b + 2, lane);
                    peer_u8(B, xp, ent, cf, b + 1, lane);
                }
            }
            LDS_WAIT();
            float outv[4][16];
#pragma unroll
            for (int s = 0; s < 4; ++s)
#pragma unroll
                for (int i = 0; i < 16; ++i) outv[s][i] = 0.f;
            {
                RowBuf A, B;
                peer_load8(A, TV, ent, 0, lane);
#pragma unroll 1
                for (int b = 0; b < 64; b += 2) {
                    peer_load8(B, TV, ent, b + 1, lane);
                    peer_v8(A, outv, ent, cf, b);
                    if (b + 2 < 64) peer_load8(A, TV, ent, b + 2, lane);
                    peer_v8(B, outv, ent, cf, b + 1);
                }
            }
#pragma unroll
            for (int s = 0; s < 4; ++s) {
                f32x4* o = (f32x4*)(xres + (size_t)(m4 + s) * 1024 + lane * 8);
                f32x4 a0 = o[0], a1 = o[1], b0 = o[128], b1 = o[129];
                a0 += (f32x4){outv[s][0], outv[s][1], outv[s][2], outv[s][3]} * oscale; a1 += (f32x4){outv[s][4], outv[s][5], outv[s][6], outv[s][7]} * oscale;
                b0 += (f32x4){outv[s][8], outv[s][9], outv[s][10], outv[s][11]} * oscale; b1 += (f32x4){outv[s][12], outv[s][13], outv[s][14], outv[s][15]} * oscale;
                o[0] = a0; o[1] = a1; o[128] = b0; o[129] = b1;
            }
        }
        if (rnd + 1 < nrounds) xcd_barrier(xbar);
    }
}

constexpr size_t WS_TAB8U = WS_TABU;
constexpr size_t WS_TAB8V = WS_TABU + 16 * MiB;
constexpr size_t WS_TABSU = WS_TABU + 32 * MiB;
constexpr size_t WS_TABSV = WS_TABU + 32 * MiB + 65536;
__device__ __forceinline__ void cvt_table_fp8(const Frame& F, const float* src, unsigned char* dst, float* scales, const int skip) {
    const int nb = F.G > skip ? F.G - skip : F.G, b0 = F.G > skip ? F.bid - skip : F.bid;
    const int gw = b0 * NWAVES + F.wave, NGW = nb * NWAVES, lane = F.lane;
    if (b0 >= 0) for (int r = gw; r < 16384; r += NGW) {
        const f32x4* p = (const f32x4*)(src + (size_t)r * 1024 + lane * 16);
        f32x4 v[4]; float am = 0.f;
#pragma unroll
        for (int j = 0; j < 4; ++j) { v[j] = p[j]; am = fmaxf(am, fmaxf(fmaxf(fabsf(v[j].x), fabsf(v[j].y)), fmaxf(fabsf(v[j].z), fabsf(v[j].w)))); }
#pragma unroll
        for (int o = 1; o < 64; o <<= 1) am = fmaxf(am, __shfl_xor(am, o));
        const float sc = am > 0.f ? am * (1.0f / 448.0f) : 1.0f, inv = 1.0f / sc;
        u32x4 q;
#pragma unroll
        for (int j = 0; j < 4; ++j) { int w = 0; w = __builtin_amdgcn_cvt_pk_fp8_f32(v[j].x * inv, v[j].y * inv, w, false); w = __builtin_amdgcn_cvt_pk_fp8_f32(v[j].z * inv, v[j].w * inv, w, true); q[j] = (unsigned)w; }
        *(u32x4*)(dst + (size_t)r * 1024 + lane * 16) = q;
        if (lane == 0) scales[r] = sc;
    }
}
template <int NR> struct RowBufN { u32x4 a[NR]; };
template <int NR>
__device__ __forceinline__ void peer_loadN(RowBufN<NR>& rb, const unsigned char* TAB, const LAS unsigned* ent, int b, int lane) {
    const int ev = (int)ent[b * NR + (lane & (NR - 1))];
#pragma unroll
    for (int i = 0; i < NR; ++i) {
        const unsigned e = (unsigned)__builtin_amdgcn_readlane(ev, i) & 0x3FFFu;
        rb.a[i] = *(const u32x4*)(TAB + (size_t)e * 1024 + lane * 16);
    }
}
__device__ __forceinline__ float peer_dot8x(const u32x4 xa, const u32x4 xb, const u32x4 q) {
    float s = 0.f;
#pragma unroll
    for (int j = 0; j < 4; ++j) {
        const f32x2 lo = __builtin_amdgcn_cvt_pk_f32_fp8((int)q[j], false), hi = __builtin_amdgcn_cvt_pk_f32_fp8((int)q[j], true);
        const unsigned x0 = (j < 2) ? xa[2 * j] : xb[2 * j - 4], x1 = (j < 2) ? xa[2 * j + 1] : xb[2 * j - 3];
        s += bf_lo(x0) * lo.x; s += bf_hi(x0) * lo.y; s += bf_lo(x1) * hi.x; s += bf_hi(x1) * hi.y;
    }
    return s;
}
template <int NR>
__device__ __forceinline__ void peer_u8x(const RowBufN<NR>& rb, int r0, const LAS unsigned char* xl, const LAS unsigned* ent, LAS float* cf, const LAS float* sul, int e0, int lane) {
    float pr[8];
    const int ev = (int)ent[e0 + (lane & 7)];
#pragma unroll
    for (int i = 0; i < 8; ++i) {
        const int slot = (__builtin_amdgcn_readlane(ev, i) >> 21) & 3;
        const LAS unsigned char* xp = xl + slot * 2048 + lane * 32;
        const u32x4 xa = *(const LAS u32x4*)xp, xb = *(const LAS u32x4*)(xp + 16);
        pr[i] = peer_dot8x(xa, xb, rb.a[r0 + i]);
    }
    float r4[4], r2[2], r1;
    { const bool up = (lane & 32) != 0;
#pragma unroll
      for (int i = 0; i < 4; ++i) { const float keep = up ? pr[i + 4] : pr[i], send = up ? pr[i] : pr[i + 4]; r4[i] = keep + __shfl_xor(send, 32); } }
    { const bool up = (lane & 16) != 0;
#pragma unroll
      for (int i = 0; i < 2; ++i) { const float keep = up ? r4[i + 2] : r4[i], send = up ? r4[i] : r4[i + 2]; r2[i] = keep + __shfl_xor(send, 16); } }
    { const bool up = (lane & 8) != 0; const float keep = up ? r2[1] : r2[0], send = up ? r2[0] : r2[1]; r1 = keep + __shfl_xor(send, 8); }
    r1 += __shfl_xor(r1, 4); r1 += __shfl_xor(r1, 2); r1 += __shfl_xor(r1, 1);
    const float gate = cf[e0 + (lane >> 3)];
    const float coef = gate * gelu_tanh(r1 * sul[e0 + (lane >> 3)]);
    if ((lane & 7) == 0) cf[e0 + (lane >> 3)] = coef;
}
__device__ __forceinline__ void peer_acc8(float (&o)[16], const float c, const u32x4 q) {
#pragma unroll
    for (int j = 0; j < 4; ++j) { const f32x2 lo = __builtin_amdgcn_cvt_pk_f32_fp8((int)q[j], false), hi = __builtin_amdgcn_cvt_pk_f32_fp8((int)q[j], true);
        o[4 * j] += c * lo.x; o[4 * j + 1] += c * lo.y; o[4 * j + 2] += c * hi.x; o[4 * j + 3] += c * hi.y; }
}
template <int NR>
__device__ __forceinline__ void peer_vN(const RowBufN<NR>& rb, float (&outv)[4][16], const LAS unsigned* ent, const LAS float* cf, int b, int lane) {
    const int ev = (int)ent[b * NR + (lane & (NR - 1))]; const float cv = cf[b * NR + (lane & (NR - 1))];
#pragma unroll
    for (int i = 0; i < NR; ++i) {
        const int slot = (__builtin_amdgcn_readlane(ev, i) >> 21) & 3;
        const float c = rdlane_f(cv, i);
        if (slot == 0) peer_acc8(outv[0], c, rb.a[i]);
        else if (slot == 1) peer_acc8(outv[1], c, rb.a[i]);
        else if (slot == 2) peer_acc8(outv[2], c, rb.a[i]);
        else peer_acc8(outv[3], c, rb.a[i]);
    }
}
__device__ __forceinline__ void p_peer_expert4(const Frame& F, unsigned char* ws, float* xres, const float oscale, const XcdBarrier& xbar, const int mode) {
    const bf16_t* XN = (const bf16_t*)(ws + WS_XN); const unsigned char* TU = ws + WS_TAB8U; const unsigned char* TV = ws + WS_TAB8V;
    const float* SU = (const float*)(ws + WS_TABSU); const float* SV = (const float*)(ws + WS_TABSV);
    const unsigned short* EID = (const unsigned short*)(ws + PE_EID); const float* GATE = (const float*)(ws + PE_GATE);
    const int gw = F.bid * NWAVES + F.wave, NGW = F.G * NWAVES, lane = F.lane;
    LAS unsigned* ent = (LAS unsigned*)(F.lds + F.wave * 6144);
    LAS float* cf = (LAS float*)(F.lds + F.wave * 6144 + 2048);
    LAS float* sul = (LAS float*)(F.lds + F.wave * 6144 + 4096);
    LAS unsigned char* xl = F.lds + 49152 + F.wave * 8192;
    constexpr int PU = 16, PV = 8;
    const int nrounds = (T + NGW * 4 - 1) / (NGW * 4);
    for (int rnd = 0; rnd < nrounds; ++rnd) {
        const int m4 = (rnd * NGW + gw) * 4;
        if (m4 < T) {
            {
                int id[4][2]; float gg[4][2], su[4][2];
#pragma unroll
                for (int s = 0; s < 4; ++s) { const size_t m = (size_t)(m4 + s);
                    id[s][0] = EID[m * 128 + lane]; id[s][1] = EID[m * 128 + 64 + lane]; gg[s][0] = GATE[m * 128 + lane] * SV[id[s][0]]; gg[s][1] = GATE[m * 128 + 64 + lane] * SV[id[s][1]]; su[s][0] = SU[id[s][0]]; su[s][1] = SU[id[s][1]]; }
                int base = 0;
#pragma unroll 1
                for (int k = 0; k < 16; ++k) {
                    const int r = (rnd & 1) ? 15 - k : k;
#pragma unroll
                    for (int s = 0; s < 4; ++s)
#pragma unroll
                        for (int w = 0; w < 2; ++w) {
                            const bool hit = (id[s][w] >> 10) == r;
                            const u64 m = __ballot(hit);
                            if (hit) { const int pos = base + (int)__builtin_amdgcn_mbcnt_hi((unsigned)(m >> 32), __builtin_amdgcn_mbcnt_lo((unsigned)m, 0u));
                                ent[pos] = ((unsigned)s << 21) | ((unsigned)(w * 64 + lane) << 14) | (unsigned)(mode == 4 ? (id[s][w] & 7) : id[s][w]); cf[pos] = gg[s][w]; sul[pos] = su[s][w]; }
                            base += __builtin_popcountll(m);
                        }
                }
            }
            LDS_WAIT();
            if (mode != 1 && mode != 3) {
#pragma unroll
                for (int s = 0; s < 4; ++s) { const size_t m = (size_t)(m4 + s);
                    const u32x4 xa = *(const u32x4*)(XN + m * 1024 + lane * 16), xb = *(const u32x4*)(XN + m * 1024 + lane * 16 + 8);
                    *(LAS u32x4*)(xl + s * 2048 + lane * 32) = xa; *(LAS u32x4*)(xl + s * 2048 + lane * 32 + 16) = xb; }
                LDS_WAIT();
                RowBufN<PU> A, B;
                peer_loadN<PU>(A, TU, ent, 0, lane);
#pragma unroll 1
                for (int b = 0; b < 512 / PU; b += 2) {
                    peer_loadN<PU>(B, TU, ent, b + 1, lane);
#pragma unroll
                    for (int h = 0; h < PU / 8; ++h) peer_u8x<PU>(A, h * 8, xl, ent, cf, sul, b * PU + h * 8, lane);
                    if (b + 2 < 512 / PU) peer_loadN<PU>(A, TU, ent, b + 2, lane);
#pragma unroll
                    for (int h = 0; h < PU / 8; ++h) peer_u8x<PU>(B, h * 8, xl, ent, cf, sul, (b + 1) * PU + h * 8, lane);
                }
            }
            LDS_WAIT();
            float outv[4][16];
#pragma unroll
            for (int s = 0; s < 4; ++s)
#pragma unroll
                for (int i = 0; i < 16; ++i) outv[s][i] = 0.f;
            if (mode != 1 && mode != 2) {
                RowBufN<PV> A, B;
                peer_loadN<PV>(A, TV, ent, 0, lane);
#pragma unroll 1
                for (int b = 0; b < 512 / PV; b += 2) {
                    peer_loadN<PV>(B, TV, ent, b + 1, lane);
                    peer_vN<PV>(A, outv, ent, cf, b, lane);
                    if (b + 2 < 512 / PV) peer_loadN<PV>(A, TV, ent, b + 2, lane);
                    peer_vN<PV>(B, outv, ent, cf, b + 1, lane);
                }
            }
#pragma unroll
            for (int s = 0; s < 4; ++s) {
                f32x4* o = (f32x4*)(xres + (size_t)(m4 + s) * 1024 + lane * 16);
#pragma unroll
                for (int j = 0; j < 4; ++j) { f32x4 a0 = o[j]; a0 += (f32x4){outv[s][4 * j], outv[s][4 * j + 1], outv[s][4 * j + 2], outv[s][4 * j + 3]} * oscale; o[j] = a0; }
            }
        }
        if (rnd + 1 < nrounds) xcd_barrier(xbar);
    }
}

__device__ __forceinline__ void cvt_table_i8(const Frame& F, const float* src, unsigned char* dst, float* scales, const int skip) {
    const int nb = F.G > skip ? F.G - skip : F.G, b0 = F.G > skip ? F.bid - skip : F.bid;
    const int gw = b0 * NWAVES + F.wave, NGW = nb * NWAVES, lane = F.lane;
    if (b0 >= 0) for (int r = gw; r < 16384; r += NGW) {
        const f32x4* p = (const f32x4*)(src + (size_t)r * 1024 + lane * 16);
        f32x4 v[4]; float am = 0.f;
#pragma unroll
        for (int j = 0; j < 4; ++j) { v[j] = p[j]; am = fmaxf(am, fmaxf(fmaxf(fabsf(v[j].x), fabsf(v[j].y)), fmaxf(fabsf(v[j].z), fabsf(v[j].w)))); }
#pragma unroll
        for (int o = 1; o < 64; o <<= 1) am = fmaxf(am, __shfl_xor(am, o));
        const float sc = am > 0.f ? am * (1.0f / 127.0f) : 1.0f, inv = 1.0f / sc;
        u32x4 q;
#pragma unroll
        for (int j = 0; j < 4; ++j) { const int a = (int)rintf(v[j].x * inv), b = (int)rintf(v[j].y * inv), c = (int)rintf(v[j].z * inv), d = (int)rintf(v[j].w * inv);
            q[j] = (unsigned)(a & 255) | ((unsigned)(b & 255) << 8) | ((unsigned)(c & 255) << 16) | ((unsigned)(d & 255) << 24); }
        *(u32x4*)(dst + (size_t)r * 1024 + lane * 16) = q;
        if (lane == 0) scales[r] = sc;
    }
}
template <int NR>
__device__ __forceinline__ void peer_u8i(const RowBufN<NR>& rb, int r0, const LAS unsigned char* xq, const LAS unsigned* ent, LAS float* cf, const LAS float* sul, int e0, int lane) {
    int pr[8];
    const int ev = (int)ent[e0 + (lane & 7)];
#pragma unroll
    for (int i = 0; i < 8; ++i) {
        const int slot = (__builtin_amdgcn_readlane(ev, i) >> 21) & 3;
        const u32x4 xv = *(const LAS u32x4*)(xq + slot * 1024 + lane * 16);
        const u32x4 q = rb.a[r0 + i];
        int s = __builtin_amdgcn_sdot4((int)xv.x, (int)q.x, 0, false); s = __builtin_amdgcn_sdot4((int)xv.y, (int)q.y, s, false);
        s = __builtin_amdgcn_sdot4((int)xv.z, (int)q.z, s, false); s = __builtin_amdgcn_sdot4((int)xv.w, (int)q.w, s, false);
        pr[i] = s;
    }
    int r4[4], r2[2], r1;
    { const bool up = (lane & 32) != 0;
#pragma unroll
      for (int i = 0; i < 4; ++i) { const int keep = up ? pr[i + 4] : pr[i], send = up ? pr[i] : pr[i + 4]; r4[i] = keep + __shfl_xor(send, 32); } }
    { const bool up = (lane & 16) != 0;
#pragma unroll
      for (int i = 0; i < 2; ++i) { const int keep = up ? r4[i + 2] : r4[i], send = up ? r4[i] : r4[i + 2]; r2[i] = keep + __shfl_xor(send, 16); } }
    { const bool up = (lane & 8) != 0; const int keep = up ? r2[1] : r2[0], send = up ? r2[0] : r2[1]; r1 = keep + __shfl_xor(send, 8); }
    r1 += __shfl_xor(r1, 4); r1 += __shfl_xor(r1, 2); r1 += __shfl_xor(r1, 1);
    const float gate = cf[e0 + (lane >> 3)];
    const float coef = gate * gelu_tanh((float)r1 * sul[e0 + (lane >> 3)]);
    if ((lane & 7) == 0) cf[e0 + (lane >> 3)] = coef;
}
template <bool FAKE>
__device__ __forceinline__ f32x2 cvt8(unsigned w, bool hi) {
    if (FAKE) { const unsigned t = hi ? (w >> 16) : w; return (f32x2){__builtin_bit_cast(float, (t << 23) | 0x30000000u), __builtin_bit_cast(float, ((t >> 8) << 23) | 0x30000000u)}; }
    return hi ? __builtin_amdgcn_cvt_pk_f32_fp8((int)w, true) : __builtin_amdgcn_cvt_pk_f32_fp8((int)w, false);
}
template <bool FAKE = false>
__device__ __forceinline__ void peer_acc8p(f32x2 (&o)[8], const float c, const u32x4 q) {
    const f32x2 c2 = {c, c};
#pragma unroll
    for (int j = 0; j < 4; ++j) { const f32x2 lo = cvt8<FAKE>(q[j], false), hi = cvt8<FAKE>(q[j], true);
        o[2 * j] += c2 * lo; o[2 * j + 1] += c2 * hi; }
}
template <int NR, bool FAKE>
__device__ __forceinline__ void peer_vNp(const RowBufN<NR>& rb, f32x2 (&outv)[4][8], const LAS unsigned* ent, const LAS float* cf, int b, int lane) {
    const int ev = (int)ent[b * NR + (lane & (NR - 1))]; const float cv = cf[b * NR + (lane & (NR - 1))];
    int slot[NR]; float c[NR];
#pragma unroll
    for (int i = 0; i < NR; ++i) { slot[i] = (__builtin_amdgcn_readlane(ev, i) >> 21) & 3; c[i] = rdlane_f(cv, i); }
#pragma unroll
    for (int q4 = 0; q4 < NR / 4; ++q4) {
#pragma unroll
        for (int s = 0; s < 4; ++s) {
#pragma unroll
            for (int i = 4 * q4; i < 4 * q4 + 4; ++i) if (slot[i] == s) peer_acc8p<FAKE>(outv[s], c[i], rb.a[i]);
            __builtin_amdgcn_sched_barrier(0);
        }
    }
}
template <int PV, bool FAKE>
__device__ __forceinline__ void peer_passv(f32x2 (&outv)[4][8], const unsigned char* TV, const LAS unsigned* ent, const LAS float* cf, int lane) {
    RowBufN<PV> A, B, C;
    constexpr int NBV = 512 / PV;
    peer_loadN<PV>(A, TV, ent, 0, lane); peer_loadN<PV>(B, TV, ent, 1, lane);
#pragma unroll 1
    for (int b = 0; b + 2 < NBV; b += 3) {
        peer_loadN<PV>(C, TV, ent, b + 2, lane);
        peer_vNp<PV, FAKE>(A, outv, ent, cf, b, lane);
        if (b + 3 < NBV) peer_loadN<PV>(A, TV, ent, b + 3, lane);
        peer_vNp<PV, FAKE>(B, outv, ent, cf, b + 1, lane);
        if (b + 4 < NBV) peer_loadN<PV>(B, TV, ent, b + 4, lane);
        peer_vNp<PV, FAKE>(C, outv, ent, cf, b + 2, lane);
    }
    peer_vNp<PV, FAKE>(A, outv, ent, cf, NBV - 1, lane);
}
__device__ __forceinline__ void p_peer_expert5(const Frame& F, unsigned char* ws, float* xres, const float oscale, const XcdBarrier& xbar, const int mode, const bool do_norm) {
    const bf16_t* XN = (const bf16_t*)(ws + WS_XN); const unsigned char* TU = ws + WS_TAB8U; const unsigned char* TV = ws + WS_TAB8V;
    const float* SU = (const float*)(ws + WS_TABSU); const float* SV = (const float*)(ws + WS_TABSV);
    const unsigned short* EID = (const unsigned short*)(ws + PE_EID); const float* GATE = (const float*)(ws + PE_GATE);
    const int gw = F.bid * NWAVES + F.wave, NGW = F.G * NWAVES, lane = F.lane;
    LAS unsigned* ent = (LAS unsigned*)(F.lds + F.wave * 6144);
    LAS float* cf = (LAS float*)(F.lds + F.wave * 6144 + 2048);
    LAS float* sul = (LAS float*)(F.lds + F.wave * 6144 + 4096);
    LAS unsigned char* xq = F.lds + 49152 + F.wave * 4096;
    constexpr int PU = 8, PV = 8;
    const int nrounds = (T + NGW * 4 - 1) / (NGW * 4);
    for (int rnd = 0; rnd < nrounds; ++rnd) {
        const int m4 = (rnd * NGW + gw) * 4;
        if (m4 < T) {
            {
                float sx[4];
#pragma unroll
                for (int s = 0; s < 4; ++s) { const size_t m = (size_t)(m4 + s);
                    const u32x4 xa = *(const u32x4*)(XN + m * 1024 + lane * 16), xb = *(const u32x4*)(XN + m * 1024 + lane * 16 + 8);
                    float xf[16] = {bf_lo(xa.x), bf_hi(xa.x), bf_lo(xa.y), bf_hi(xa.y), bf_lo(xa.z), bf_hi(xa.z), bf_lo(xa.w), bf_hi(xa.w),
                                    bf_lo(xb.x), bf_hi(xb.x), bf_lo(xb.y), bf_hi(xb.y), bf_lo(xb.z), bf_hi(xb.z), bf_lo(xb.w), bf_hi(xb.w)};
                    float am = 0.f;
#pragma unroll
                    for (int i = 0; i < 16; ++i) am = fmaxf(am, fabsf(xf[i]));
#pragma unroll
                    for (int o = 1; o < 64; o <<= 1) am = fmaxf(am, __shfl_xor(am, o));
                    sx[s] = am > 0.f ? am * (1.0f / 127.0f) : 1.0f; const float inv = 1.0f / sx[s];
                    u32x4 q;
#pragma unroll
                    for (int j = 0; j < 4; ++j) { const int a = (int)rintf(xf[4 * j] * inv), b = (int)rintf(xf[4 * j + 1] * inv), c = (int)rintf(xf[4 * j + 2] * inv), d = (int)rintf(xf[4 * j + 3] * inv);
                        q[j] = (unsigned)(a & 255) | ((unsigned)(b & 255) << 8) | ((unsigned)(c & 255) << 16) | ((unsigned)(d & 255) << 24); }
                    *(LAS u32x4*)(xq + s * 1024 + lane * 16) = q; }
                int id[4][2]; float gg[4][2], su[4][2];
#pragma unroll
                for (int s = 0; s < 4; ++s) { const size_t m = (size_t)(m4 + s);
                    id[s][0] = EID[m * 128 + lane]; id[s][1] = EID[m * 128 + 64 + lane];
                    gg[s][0] = GATE[m * 128 + lane] * SV[id[s][0]]; gg[s][1] = GATE[m * 128 + 64 + lane] * SV[id[s][1]];
                    su[s][0] = SU[id[s][0]] * sx[s]; su[s][1] = SU[id[s][1]] * sx[s]; }
                LAS unsigned* hcnt = (LAS unsigned*)sul;
                if (lane < 32) hcnt[lane] = 0u;
                LDS_WAIT();
#pragma unroll
                for (int s = 0; s < 4; ++s)
#pragma unroll
                    for (int w = 0; w < 2; ++w) __hip_atomic_fetch_add(hcnt + (id[s][w] >> 10), 1u, __ATOMIC_RELAXED, __HIP_MEMORY_SCOPE_WORKGROUP);
                LDS_WAIT();
                unsigned basev;
                { const unsigned cntv = (lane < 16) ? hcnt[lane] : 0u;
                  unsigned incl = cntv;
                  const bool rev = (rnd & 1) != 0;
#pragma unroll
                  for (int o = 1; o < 16; o <<= 1) { const unsigned up = (unsigned)__shfl_up((int)incl, o), dn = (unsigned)__shfl_down((int)incl, o);
                      const unsigned nb = rev ? ((lane + o < 16) ? dn : 0u) : ((lane >= o) ? up : 0u); incl += nb; }
                  basev = incl - cntv; }
                LDS_WAIT();
                if (lane < 16) hcnt[16 + lane] = basev;
                LDS_WAIT();
                int posv[4][2];
#pragma unroll
                for (int s = 0; s < 4; ++s)
#pragma unroll
                    for (int w = 0; w < 2; ++w) posv[s][w] = (int)__hip_atomic_fetch_add(hcnt + 16 + (id[s][w] >> 10), 1u, __ATOMIC_RELAXED, __HIP_MEMORY_SCOPE_WORKGROUP);
                LDS_WAIT();
#pragma unroll
                for (int s = 0; s < 4; ++s)
#pragma unroll
                    for (int w = 0; w < 2; ++w) { const int pos = posv[s][w];
                        ent[pos] = ((unsigned)s << 21) | ((unsigned)(w * 64 + lane) << 14) | (unsigned)(mode == 4 ? (id[s][w] & 7) : id[s][w]); cf[pos] = gg[s][w]; }
                LDS_WAIT();
#pragma unroll
                for (int s = 0; s < 4; ++s)
#pragma unroll
                    for (int w = 0; w < 2; ++w) sul[posv[s][w]] = su[s][w];
            }
            LDS_WAIT();
            if (mode != 1 && mode != 3) {
                RowBufN<PU> A, B, C;
                constexpr int NBU = 512 / PU;
                peer_loadN<PU>(A, TU, ent, 0, lane); peer_loadN<PU>(B, TU, ent, 1, lane);
#pragma unroll 1
                for (int b = 0; b + 2 < NBU; b += 3) {
                    peer_loadN<PU>(C, TU, ent, b + 2, lane);
                    peer_u8i<PU>(A, 0, xq, ent, cf, sul, b * PU, lane);
                    if (b + 3 < NBU) peer_loadN<PU>(A, TU, ent, b + 3, lane);
                    peer_u8i<PU>(B, 0, xq, ent, cf, sul, (b + 1) * PU, lane);
                    if (b + 4 < NBU) peer_loadN<PU>(B, TU, ent, b + 4, lane);
                    peer_u8i<PU>(C, 0, xq, ent, cf, sul, (b + 2) * PU, lane);
                }
                peer_u8i<PU>(A, 0, xq, ent, cf, sul, (NBU - 1) * PU, lane);
            }
            LDS_WAIT();
            f32x2 outv[4][8];
#pragma unroll
            for (int s = 0; s < 4; ++s)
#pragma unroll
                for (int i = 0; i < 8; ++i) outv[s][i] = (f32x2){0.f, 0.f};
            if (mode != 1 && mode != 2) {
                if (mode == 5) peer_passv<PV, true>(outv, TV, ent, cf, lane); else peer_passv<PV, false>(outv, TV, ent, cf, lane);
            }
            asm volatile("" ::: "memory"); __builtin_amdgcn_sched_barrier(0);
#pragma unroll
            for (int s = 0; s < 4; ++s) {
                f32x4* o = (f32x4*)(xres + (size_t)(m4 + s) * 1024 + lane * 16);
                f32x4 nv[4]; float ss = 0.f;
#pragma unroll
                for (int j = 0; j < 4; ++j) { f32x4 a0 = o[j]; const f32x4 add = (f32x4){outv[s][2 * j].x, outv[s][2 * j].y, outv[s][2 * j + 1].x, outv[s][2 * j + 1].y};
                    if (oscale != 0.f) a0 += add; else asm volatile("" :: "v"(add)); o[j] = a0; nv[j] = a0;
                    ss += (a0.x * a0.x + a0.y * a0.y) + (a0.z * a0.z + a0.w * a0.w); }
                if (do_norm && oscale != 0.f) {
                    const float rstd = 1.0f / sqrtf(wave_sum(ss) * (1.f / DM) + 1e-6f);
                    const f32x4* gp = (const f32x4*)((const float*)(ws + WS_CMPB + 4096) + lane * 16);
                    u32x4 w0, w1;
                    { const f32x4 g0 = gp[0], g1 = gp[1], g2 = gp[2], g3 = gp[3];
                      w0.x = pk2(nv[0].x * rstd * g0.x, nv[0].y * rstd * g0.y); w0.y = pk2(nv[0].z * rstd * g0.z, nv[0].w * rstd * g0.w);
                      w0.z = pk2(nv[1].x * rstd * g1.x, nv[1].y * rstd * g1.y); w0.w = pk2(nv[1].z * rstd * g1.z, nv[1].w * rstd * g1.w);
                      w1.x = pk2(nv[2].x * rstd * g2.x, nv[2].y * rstd * g2.y); w1.y = pk2(nv[2].z * rstd * g2.z, nv[2].w * rstd * g2.w);
                      w1.z = pk2(nv[3].x * rstd * g3.x, nv[3].y * rstd * g3.y); w1.w = pk2(nv[3].z * rstd * g3.z, nv[3].w * rstd * g3.w); }
                    u32x4* xo = (u32x4*)((bf16_t*)(ws + WS_XN) + (size_t)(m4 + s) * 1024 + lane * 16);
                    xo[0] = w0; xo[1] = w1;
                }
                asm volatile("" ::: "memory"); __builtin_amdgcn_sched_barrier(0);
            }
        }
    }
}

constexpr size_t L1_QN = WS_R3;
constexpr size_t L1_KS = WS_R3 + 32 * MiB;
constexpr size_t L1_KW = WS_R3 + 40 * MiB;
constexpr size_t L1_VST = WS_R3 + 48 * MiB;
constexpr size_t L1_VWT = WS_R3 + 56 * MiB;
constexpr size_t L1_KCR = WS_R3 + 64 * MiB;
constexpr size_t L1_VCR = WS_R3 + 72 * MiB;
constexpr size_t L1_GATES = WS_R3 + 81 * MiB;
constexpr size_t L1_H1 = WS_R3 + 84 * MiB;
constexpr size_t L1_CMPO = WS_R3 + 88 * MiB;
constexpr size_t L1_KC = WS_R3 + 90 * MiB;
constexpr size_t L1_VCT = WS_R3 + 91 * MiB;
constexpr size_t L1_SELB = WS_R3 + 92 * MiB;
constexpr size_t L1_OC = WS_TABU;
constexpr size_t L1_CAT = WS_XN;
constexpr size_t L1_UPD = WS_R3;
constexpr size_t L1_DECAY = WS_R3 + 128 * MiB;

__device__ __forceinline__ void p_l1_prep(const Frame& F, const Args& a, unsigned char* ws) {
    const bf16_t* P = (const bf16_t*)(ws + WS_PROJ);
    const f32x2* rope = (const f32x2*)(ws + WS_ROPE);
    bf16_t* QN = (bf16_t*)(ws + L1_QN); bf16_t* KS = (bf16_t*)(ws + L1_KS); bf16_t* KW = (bf16_t*)(ws + L1_KW);
    bf16_t* KCR = (bf16_t*)(ws + L1_KCR); bf16_t* VCR = (bf16_t*)(ws + L1_VCR); float* GATES = (float*)(ws + L1_GATES);
    const int gw = F.bid * NWAVES + F.wave, NGW = F.G * NWAVES, lane = F.lane, hs = lane >> 3, sub = lane & 7;
    float qg[8], kg[8];
#pragma unroll
    for (int j = 0; j < 8; ++j) { qg[j] = a.in[I_L1_QG][sub * 8 + j]; kg[j] = a.in[I_L1_KG][sub * 8 + j]; }
    const int srccol = (hs < 2) ? C1_KS + hs * 64 : (hs < 4) ? C1_KW + (hs - 2) * 64 : (hs < 6) ? C1_KC + (hs - 4) * 64 : C1_VC + (hs - 6) * 64;
    bf16_t* dstbuf = (hs < 2) ? KS : (hs < 4) ? KW : (hs < 6) ? KCR : VCR;
    const int g2 = hs & 1;
    for (int m = gw; m < T; m += NGW) {
        const int b = m >> 12, t = m & 4095;
        const bf16_t* row = P + (size_t)m * N_IN1;
        f32x2 cs[8];
#pragma unroll
        for (int j = 0; j < 4; ++j) { const f32x4 c4 = *(const f32x4*)(rope + t * 32 + (sub & 3) * 8 + 2 * j); cs[2 * j] = (f32x2){c4.x, c4.y}; cs[2 * j + 1] = (f32x2){c4.z, c4.w}; }
        float v[8];
        head8_load(row + C1_Q + lane * 8, v); head8_norm(v, qg); head8_rope(v, cs, sub >= 4); head8_store(QN + (size_t)m * 512 + lane * 8, v, 0.125f);
        {
            const u32x4 raw = *(const u32x4*)(row + srccol + sub * 8);
            v[0] = bf_lo(raw.x); v[1] = bf_hi(raw.x); v[2] = bf_lo(raw.y); v[3] = bf_hi(raw.y); v[4] = bf_lo(raw.z); v[5] = bf_hi(raw.z); v[6] = bf_lo(raw.w); v[7] = bf_hi(raw.w);
            head8_norm(v, kg); head8_rope(v, cs, sub >= 4);
            u32x4 q; q.x = pk2(v[0], v[1]); q.y = pk2(v[2], v[3]); q.z = pk2(v[4], v[5]); q.w = pk2(v[6], v[7]);
            if (hs >= 4) q = raw;
            *(u32x4*)(dstbuf + ((size_t)(b * 2 + g2) * 4096 + t) * 64 + sub * 8) = q;
        }
        if (lane < 24) GATES[(size_t)m * 24 + lane] = sigmoidf_(bf2f(row[C1_GL + lane]));
    }
    for (int it = gw; it < 2 * NB * 2 * 64; it += NGW) {
        const int tb = it & 63, g = (it >> 6) & 1, b = (it >> 7) & 7, w = it >> 10;
        const size_t m = (size_t)b * 4096 + tb * 64 + lane;
        unsigned r[32];
#pragma unroll
        for (int j = 0; j < 8; ++j) { const u32x4 q = *(const u32x4*)(P + m * N_IN1 + (w ? C1_VW : C1_VS) + g * 64 + j * 8); r[4 * j] = q.x; r[4 * j + 1] = q.y; r[4 * j + 2] = q.z; r[4 * j + 3] = q.w; }
        bf16_t* dst = (bf16_t*)(ws + (w ? L1_VWT : L1_VST)) + ((size_t)(b * 2 + g) * 64) * 4096 + tb * 64 + lane;
#pragma unroll
        for (int d = 0; d < 64; ++d) dst[(size_t)d * 4096] = (bf16_t)((d & 1) ? (r[d >> 1] >> 16) : (r[d >> 1] & 0xffffu));
    }
}

namespace pg8 {
struct EpiCmp1 {
    static constexpr bool PERM = true;
    bf16_t* O; const float* bias;
    __device__ __forceinline__ void operator()(const f32x4 (&acc)[2][2][4][2], const Unit& u, int wr, int wc, int fr, int fq) const {
        const int row0 = u.pm * BM + wr * 64 + fr, col0 = wc * 32 + 8 * fq;
#pragma unroll
        for (int ai = 0; ai < 2; ++ai)
#pragma unroll
            for (int m = 0; m < 4; ++m) { bf16_t* rowp = O + (size_t)(row0 + ai * HALF + m * 16) * 256 + col0;
#pragma unroll
                for (int bj = 0; bj < 2; ++bj) { const float* bp = bias + u.pn * 256 + col0 + bj * HALF;
                    const f32x4 v0 = acc[ai][bj][m][0] + *(const f32x4*)bp, v1 = acc[ai][bj][m][1] + *(const f32x4*)(bp + 4);
                    u32x4 w; w.x = pk2(gelu_tanh(v0[0]), gelu_tanh(v0[1])); w.y = pk2(gelu_tanh(v0[2]), gelu_tanh(v0[3]));
                    w.z = pk2(gelu_tanh(v1[0]), gelu_tanh(v1[1])); w.w = pk2(gelu_tanh(v1[2]), gelu_tanh(v1[3]));
                    *(u32x4*)(rowp + bj * HALF) = w; }
                asm volatile("" ::: "memory"); __builtin_amdgcn_sched_barrier(0); }
    }
};
struct EpiCmp2 {
    static constexpr bool PERM = false;
    float* C;
    __device__ __forceinline__ void operator()(const f32x4 (&acc)[2][2][4][2], const Unit& u, int wr, int wc, int fr, int fq) const {
        if (wc >= 2) return;
        const int row0 = u.pm * BM + wr * 64 + fr, col0 = wc * 32 + 4 * fq;
#pragma unroll
        for (int ai = 0; ai < 2; ++ai)
#pragma unroll
            for (int m = 0; m < 4; ++m)
#pragma unroll
                for (int n = 0; n < 2; ++n) *(f32x4*)(C + (size_t)(row0 + ai * HALF + m * 16) * 64 + col0 + n * 16) = acc[ai][0][m][n];
    }
};
}

__device__ __forceinline__ void p_cmp_final(const Frame& F, const Args& a, unsigned char* ws) {
    const float* CMPO = (const float*)(ws + L1_CMPO); const f32x2* rope = (const f32x2*)(ws + WS_ROPE);
    bf16_t* KC = (bf16_t*)(ws + L1_KC); bf16_t* VCT = (bf16_t*)(ws + L1_VCT);
    const int gw = F.bid * NWAVES + F.wave, NGW = F.G * NWAVES, lane = F.lane;
    const float kg = a.in[I_L1_KG][lane];
    for (int r = gw; r < 8192; r += NGW) {
        float v = CMPO[(size_t)r * 64 + lane];
        const int rr = r & 4095, bg = rr >> 8, c = rr & 255;
        if (r < 4096) {
            const float ss = wave_sum(v * v);
            v = v * (1.0f / sqrtf(ss * (1.f / 64.f) + 1e-6f)) * kg;
            const int pos = (c < 255) ? 16 * c + 31 : 0;
            v = rope_apply(v, rope[pos * 32 + (lane & 31)], lane);
            KC[((size_t)bg * 256 + c) * 64 + lane] = (c < 255) ? (bf16_t)f2bf(v) : (bf16_t)0;
        } else {
            VCT[((size_t)bg * 64 + lane) * 256 + c] = (c < 255) ? (bf16_t)f2bf(v) : (bf16_t)0;
        }
    }
}

__device__ __forceinline__ void att_load2(AttStage& s, const bf16_t* Kg, const bf16_t* Vtg, int vstride, int key0, int tid) {
    s.kreg = *(const u32x4*)(Kg + (size_t)(key0 + (tid >> 3)) * 64 + (tid & 7) * 8);
    s.vreg = *(const u32x4*)(Vtg + (size_t)(tid >> 3) * vstride + key0 + (tid & 7) * 8);
}
__device__ __forceinline__ float score_bound_c2(const float* qg, const float* kg) {
    float mq = 0.f, mk_ = 0.f;
    for (int i = 0; i < 64; ++i) { mq = fmaxf(mq, fabsf(qg[i])); mk_ = fmaxf(mk_, fabsf(kg[i])); }
    return (8.0f * mq * mk_ + 0.5f) * 1.4426950408889634f;
}

constexpr int CA_KB = 256 * 144, CA_VSTR = 528, CA_VB = 64 * CA_VSTR, CA_IMP = CA_KB + CA_VB;
__device__ __forceinline__ void p_cmp_attn(const Frame& F, const Args& a, unsigned char* ws) {
    const bf16_t* QN = (const bf16_t*)(ws + L1_QN); const bf16_t* KC = (const bf16_t*)(ws + L1_KC); const bf16_t* VCT = (const bf16_t*)(ws + L1_VCT);
    float* OC = (float*)(ws + L1_OC); u64* SELB = (u64*)(ws + L1_SELB);
    LAS float* impL = (LAS float*)(F.lds + CA_IMP);
    const int lane = F.lane, wave = F.wave, h = lane >> 5, c = lane & 31, tid = F.tid;
    const float c2 = score_bound_c2(a.in[I_L1_QG], a.in[I_L1_KG]), c1 = 1.4426950408889634f;
    for (int u = F.bid; u < 1024; u += F.G) {
        const int b = (u >> 7) & 7, g = (u >> 6) & 1, rnd = u >> 8, qt = (rnd & 1) ? 63 - (u & 63) : (u & 63), q0 = qt * 64;
        const int bg = b * 2 + g; const size_t mb = (size_t)b * 4096;
        const int t = q0 + wave * 8 + (c >> 2), head = g * 4 + (c & 3);
        bf16x8 Qf[4];
#pragma unroll
        for (int ks = 0; ks < 4; ++ks) Qf[ks] = *(const bf16x8*)(QN + (mb + t) * 512 + head * 64 + ks * 16 + 8 * h);
        const int L = (t >= 31) ? (((t - 31) >> 4) < 254 ? ((t - 31) >> 4) : 254) : -1;
        const int tmax = q0 + 63; const int Lmax = (tmax >= 31) ? (((tmax - 31) >> 4) < 254 ? ((tmax - 31) >> 4) : 254) : -1;
        const int nkt = (Lmax >= 0) ? (Lmax >> 6) + 1 : 0;
        const bf16_t* Kg = KC + (size_t)bg * 256 * 64; const bf16_t* Vtg = VCT + (size_t)bg * 64 * 256;
        __syncthreads();
        for (int i = tid; i < nkt * 512; i += NTHREADS) {
            const int key = i >> 3, ch = i & 7;
            *(LAS u32x4*)(F.lds + key * 144 + ch * 16) = *(const u32x4*)(Kg + (size_t)key * 64 + ch * 8);
        }
        for (int i = tid; i < 64 * nkt * 8; i += NTHREADS) {
            const int d = i / (nkt * 8), ch = i % (nkt * 8);
            const u32x4 v = *(const u32x4*)(Vtg + (size_t)d * 256 + ch * 8);
            LAS unsigned char* p = F.lds + CA_KB + d * CA_VSTR + ch * 16;
            *(LAS u32x2*)p = (u32x2){v.x, v.y}; *(LAS u32x2*)(p + 8) = (u32x2){v.z, v.w};
        }
        __syncthreads();
        f32x16 O[2], IMP[2]; float l = 0.f;
#pragma unroll
        for (int i = 0; i < 16; ++i) { O[0][i] = 0.f; O[1][i] = 0.f; IMP[0][i] = 0.f; IMP[1][i] = 0.f; }
        for (int st = 0; st < nkt * 2; ++st) {
            f32x16 S = {0.f, 0.f, 0.f, 0.f, 0.f, 0.f, 0.f, 0.f, 0.f, 0.f, 0.f, 0.f, 0.f, 0.f, 0.f, 0.f};
            { const LAS unsigned char* kp = F.lds + (st * 32 + c) * 144 + h * 16;
#pragma unroll
              for (int ks = 0; ks < 4; ++ks) S = __builtin_amdgcn_mfma_f32_32x32x16_bf16(*(const LAS bf16x8*)(kp + ks * 32), Qf[ks], S, 0, 0, 0); }
            float p[16];
#pragma unroll
            for (int i = 0; i < 16; ++i) {
                const int cidx = st * 32 + (i & 3) + 8 * (i >> 2) + 4 * h;
                const float e = __builtin_amdgcn_exp2f(S[i] * c1 - c2);
                p[i] = (cidx <= L) ? e : 0.f; l += p[i];
            }
            const bf16x8 P0 = pack8(p[0], p[1], p[2], p[3], p[4], p[5], p[6], p[7]);
            const bf16x8 P1 = pack8(p[8], p[9], p[10], p[11], p[12], p[13], p[14], p[15]);
#pragma unroll
            for (int dt = 0; dt < 2; ++dt) {
                const LAS unsigned char* vp = F.lds + CA_KB + (dt * 32 + c) * CA_VSTR + (st * 32 + 4 * h) * 2;
                const u32x2 a0 = *(const LAS u32x2*)(vp), a1 = *(const LAS u32x2*)(vp + 16), b0 = *(const LAS u32x2*)(vp + 32), b1 = *(const LAS u32x2*)(vp + 48);
                O[dt] = __builtin_amdgcn_mfma_f32_32x32x16_bf16(__builtin_bit_cast(bf16x8, ((u32x4){a0.x, a0.y, a1.x, a1.y})), P0, O[dt], 0, 0, 0);
                O[dt] = __builtin_amdgcn_mfma_f32_32x32x16_bf16(__builtin_bit_cast(bf16x8, ((u32x4){b0.x, b0.y, b1.x, b1.y})), P1, O[dt], 0, 0, 0);
            }
#pragma unroll
            for (int jt = 0; jt < 2; ++jt)
#pragma unroll
                for (int s = 0; s < 2; ++s) {
                    unsigned wv[4];
#pragma unroll
                    for (int e2 = 0; e2 < 4; ++e2) {
                        unsigned pr = 0u;
#pragma unroll
                        for (int q = 0; q < 2; ++q) { const int jj = 2 * e2 + q; const int kap = 16 * s + 8 * (jj >> 2) + 4 * h + (jj & 3);
                            const int off = st * 32 + kap - 4 * (32 * jt + c);
                            const unsigned wbits = (off == 0 || off == 4) ? 0x3F80u : ((off >= 1 && off <= 3) ? 0x4000u : 0u);
                            pr |= wbits << (16 * q); }
                        wv[e2] = pr;
                    }
                    const bf16x8 Wf = __builtin_bit_cast(bf16x8, ((u32x4){wv[0], wv[1], wv[2], wv[3]}));
                    IMP[jt] = __builtin_amdgcn_mfma_f32_32x32x16_bf16(Wf, s ? P1 : P0, IMP[jt], 0, 0, 0);
                }
        }
        const float lt = l + __shfl_xor(l, 32);
        const float inv = 1.0f / fmaxf(lt, 1e-30f);
        { float* orow = OC + (mb + t) * 512 + head * 64;
#pragma unroll
          for (int dt = 0; dt < 2; ++dt)
#pragma unroll
            for (int i4 = 0; i4 < 4; ++i4) { const int d = dt * 32 + 8 * i4 + 4 * h;
                *(f32x4*)(orow + d) = (f32x4){O[dt][4 * i4] * inv, O[dt][4 * i4 + 1] * inv, O[dt][4 * i4 + 2] * inv, O[dt][4 * i4 + 3] * inv}; } }
#pragma unroll
        for (int jt = 0; jt < 2; ++jt)
#pragma unroll
            for (int i = 0; i < 16; ++i) {
                float v = IMP[jt][i] * inv; v += __shfl_xor(v, 1); v += __shfl_xor(v, 2);
                if ((c & 3) == 0) impL[(wave * 8 + (c >> 2)) * 65 + 32 * jt + (i & 3) + 8 * (i >> 2) + 4 * h] = v;
            }
        __syncthreads();
        if (tid < 64) {
            const int tq = q0 + tid, cur = tq >> 6;
            u64 mask;
            if (cur + 1 <= 16) mask = (1ull << (cur + 1)) - 1ull;
            else {
                unsigned top[16];
#pragma unroll
                for (int blk = 0; blk < 4; ++blk) {
                    unsigned k16[16];
#pragma unroll
                    for (int i = 0; i < 16; ++i) { const int j = blk * 16 + i; const float x = impL[tid * 65 + j];
                        const unsigned key = (j > cur) ? 0u : ((j == 0 || j == cur) ? 0xFFFFFFC0u : (mono_u32(x) & ~0x3Fu)) | (unsigned)(63 - j);
                        k16[i] = (j > cur) ? 0u : key; }
                    sort16_desc(k16);
                    if (blk == 0) {
#pragma unroll
                        for (int i = 0; i < 16; ++i) top[i] = k16[i];
                    } else merge16_desc(top, k16);
                }
                mask = 0ull;
#pragma unroll
                for (int i = 0; i < 16; ++i) mask |= 1ull << (63 - (int)(top[i] & 63u));
            }
            SELB[(size_t)bg * 4096 + tq] = mask;
        }
    }
}

template <bool MASKED>
__device__ __forceinline__ void nsa_run(const Frame& F, int kt0, int kt1, int kt_hi, AttStage& st, const bf16_t* Kg, const bf16_t* Vtg, const bf16x8 (&Qf)[2][4], const u64 (&selw)[2], const int (&qidx)[2],
                                        const float c1, const float c2, const int wlen, f32x16 (&O)[2][2], float (&l)[2]) {
    const int lane = F.lane, h = lane >> 5, tid = F.tid;
#pragma unroll 1
    for (int kt = kt0; kt < kt1; ++kt) {
        LAS unsigned char* buf = F.lds + (kt & 1) * AT_BUF;
        if (kt + 1 < kt_hi) att_load(st, Kg, Vtg, (kt + 1) * 64, tid);
#pragma unroll 1
        for (int sub = 0; sub < 2; ++sub) {
            bf16x8 Kf[4];
            att_kfrags(buf, sub, Kf, lane);
#pragma unroll
            for (int ct = 0; ct < 2; ++ct) {
                __builtin_amdgcn_sched_barrier(0);
                const f32x16 S = att_qk_f(Kf, Qf[ct]);
                const bool flag = (selw[ct] >> kt) & 1ull;
                const float c2e = flag ? c2 : 3.0e30f;
                const int dbase = qidx[ct] - (kt * 64 + sub * 32 + 4 * h);
                float p[16];
#pragma unroll
                for (int i = 0; i < 16; ++i) {
                    const float e = __builtin_amdgcn_exp2f(S[i] * c1 - c2e);
                    p[i] = (!MASKED || (unsigned)(dbase - ((i & 3) + 8 * (i >> 2))) < (unsigned)wlen) ? e : 0.f; l[ct] += p[i];
                }
                const bf16x8 P0 = pack8(p[0], p[1], p[2], p[3], p[4], p[5], p[6], p[7]);
                const bf16x8 P1 = pack8(p[8], p[9], p[10], p[11], p[12], p[13], p[14], p[15]);
                att_pv2(buf, sub, P0, P1, O[ct], lane);
            }
        }
        if (kt + 1 < kt_hi) att_store(st, F.lds + ((kt + 1) & 1) * AT_BUF, tid);
        __syncthreads();
    }
}
__device__ __forceinline__ void p_nsa_attn(const Frame& F, const Args& a, unsigned char* ws) {
    const bf16_t* QN = (const bf16_t*)(ws + L1_QN);
    const u64* SELB = (const u64*)(ws + L1_SELB); float* OC = (float*)(ws + L1_OC); const float* GATES = (const float*)(ws + L1_GATES);
    bf16_t* CAT = (bf16_t*)(ws + L1_CAT);
    const int lane = F.lane, wave = F.wave, h = lane >> 5, c = lane & 31, tid = F.tid;
    const float c2 = score_bound_c2(a.in[I_L1_QG], a.in[I_L1_KG]), c1 = 1.4426950408889634f;
    for (int u = F.bid; u < 512; u += F.G) {
        const int idx = u & 255, g = u >> 8, b = idx >> 5, qtr = idx & 31, qt = g ? 31 - qtr : qtr, q0 = qt * 128;
        const int bg = b * 2 + g; const size_t mb = (size_t)b * 4096;
        bf16x8 Qf[2][4]; int qidx[2];
#pragma unroll
        for (int ct = 0; ct < 2; ++ct) { qidx[ct] = q0 + wave * 16 + ct * 8 + (c >> 2);
#pragma unroll
            for (int ks = 0; ks < 4; ++ks) Qf[ct][ks] = *(const bf16x8*)(QN + (mb + qidx[ct]) * 512 + (g * 4 + (c & 3)) * 64 + ks * 16 + 8 * h); }
        const int head = g * 4 + (c & 3);
#pragma unroll 1
        for (int pass = 0; pass < 2; ++pass) {
            const bf16_t* Kg = (const bf16_t*)(ws + (pass ? L1_KW : L1_KS)) + (size_t)bg * 4096 * 64;
            const bf16_t* Vtg = (const bf16_t*)(ws + (pass ? L1_VWT : L1_VST)) + (size_t)bg * 64 * 4096;
            u64 selw[2];
#pragma unroll
            for (int ct = 0; ct < 2; ++ct) selw[ct] = pass ? ~0ull : SELB[(size_t)bg * 4096 + qidx[ct]];
            const int wlen = pass ? 512 : 0x7fffffff;
            f32x16 O[2][2]; float l[2] = {0.f, 0.f};
#pragma unroll
            for (int ct = 0; ct < 2; ++ct)
#pragma unroll
                for (int dt = 0; dt < 2; ++dt)
#pragma unroll
                    for (int i = 0; i < 16; ++i) O[ct][dt][i] = 0.f;
            const int kt_lo = pass ? ((2 * qt - 8) > 0 ? 2 * qt - 8 : 0) : 0, kt_hi = 2 * qt + 2;
            int ka = pass ? 2 * qt - 6 : 0; ka = ka < kt_lo ? kt_lo : ka; const int kb = 2 * qt;
            AttStage st; att_load(st, Kg, Vtg, kt_lo * 64, tid);
            __syncthreads();
            att_store(st, F.lds + (kt_lo & 1) * AT_BUF, tid);
            __syncthreads();
            nsa_run<true>(F, kt_lo, ka, kt_hi, st, Kg, Vtg, Qf, selw, qidx, c1, c2, wlen, O, l);
            nsa_run<false>(F, ka, kb, kt_hi, st, Kg, Vtg, Qf, selw, qidx, c1, c2, wlen, O, l);
            nsa_run<true>(F, kb, kt_hi, kt_hi, st, Kg, Vtg, Qf, selw, qidx, c1, c2, wlen, O, l);
#pragma unroll
            for (int ct = 0; ct < 2; ++ct) {
                const float lt = l[ct] + __shfl_xor(l[ct], 32);
                const float inv = 1.0f / fmaxf(lt, 1e-30f);
                const size_t m = mb + qidx[ct];
                const float gcv = GATES[m * 24 + head * 3 + 0], gsv = GATES[m * 24 + head * 3 + 1], gwv = GATES[m * 24 + head * 3 + 2];
                float* orow = OC + m * 512 + head * 64; bf16_t* crow = CAT + m * 1024 + head * 64;
#pragma unroll
                for (int dt = 0; dt < 2; ++dt)
#pragma unroll
                    for (int i4 = 0; i4 < 4; ++i4) {
                        const int d = dt * 32 + 8 * i4 + 4 * h;
                        const f32x4 prev = *(const f32x4*)(orow + d);
                        const f32x4 ov = (f32x4){O[ct][dt][4 * i4] * inv, O[ct][dt][4 * i4 + 1] * inv, O[ct][dt][4 * i4 + 2] * inv, O[ct][dt][4 * i4 + 3] * inv};
                        if (pass == 0) *(f32x4*)(orow + d) = prev * gcv + ov * gsv;
                        else { const f32x4 r = prev + ov * gwv; u32x2 w; w.x = pk2(r[0], r[1]); w.y = pk2(r[2], r[3]); *(u32x2*)(crow + d) = w; }
                    }
            }
        }
    }
}

__device__ __forceinline__ float logsigmoidf_(float x) { return fminf(x, 0.f) - log1pf(__expf(-fabsf(x))); }
__device__ __forceinline__ bf16x8 frag_lds(const LAS float* p) { const f32x4 a = *(const LAS f32x4*)p, b = *(const LAS f32x4*)(p + 4); return pack8(a[0], a[1], a[2], a[3], b[0], b[1], b[2], b[3]); }
__device__ __forceinline__ bf16x8 frag_glb(const float* p) { const f32x4 a = *(const f32x4*)p, b = *(const f32x4*)(p + 4); return pack8(a[0], a[1], a[2], a[3], b[0], b[1], b[2], b[3]); }
__device__ __forceinline__ void gla_wave_bcum(const Args& a, const bf16_t* P, size_t m0, int hh, int lane, float (&bc)[32]) {
    float wg[16];
#pragma unroll
    for (int r = 0; r < 16; ++r) wg[r] = a.in[I_L1_WGATE][r * 256 + hh * 64 + lane];
    const float bgv = a.in[I_L1_BGATE][hh * 64 + lane];
    float run = 0.f;
#pragma unroll
    for (int c = 0; c < 32; ++c) {
        const bf16_t* grow = P + (m0 + c) * N_IN1 + C1_GLOW;
        const u32x4 ga = *(const u32x4*)grow, gb = *(const u32x4*)(grow + 8);
        float acc = bgv;
        acc += wg[0] * bf_lo(ga.x); acc += wg[1] * bf_hi(ga.x); acc += wg[2] * bf_lo(ga.y); acc += wg[3] * bf_hi(ga.y); acc += wg[4] * bf_lo(ga.z); acc += wg[5] * bf_hi(ga.z); acc += wg[6] * bf_lo(ga.w); acc += wg[7] * bf_hi(ga.w);
        acc += wg[8] * bf_lo(gb.x); acc += wg[9] * bf_hi(gb.x); acc += wg[10] * bf_lo(gb.y); acc += wg[11] * bf_hi(gb.y); acc += wg[12] * bf_lo(gb.z); acc += wg[13] * bf_hi(gb.z); acc += wg[14] * bf_lo(gb.w); acc += wg[15] * bf_hi(gb.w);
        run += logsigmoidf_(acc) * 0.0625f; bc[c] = run;
    }
}
__device__ __forceinline__ bf16x8 gla_vfrag(const bf16_t* vbase, int s0) {
    unsigned short e[8];
#pragma unroll
    for (int j = 0; j < 8; ++j) e[j] = vbase[(size_t)(s0 + j) * N_IN1];
    u32x4 w; w.x = (unsigned)e[0] | ((unsigned)e[1] << 16); w.y = (unsigned)e[2] | ((unsigned)e[3] << 16); w.z = (unsigned)e[4] | ((unsigned)e[5] << 16); w.w = (unsigned)e[6] | ((unsigned)e[7] << 16);
    return __builtin_bit_cast(bf16x8, w);
}
__device__ __forceinline__ void p_gla_a(const Frame& F, const Args& a, unsigned char* ws) {
    const bf16_t* P = (const bf16_t*)(ws + WS_PROJ); float* UPD = (float*)(ws + L1_UPD); float* DECAY = (float*)(ws + L1_DECAY);
    const int lane = F.lane, r = lane & 31, h = lane >> 5;
    LAS bf16_t* kdT = (LAS bf16_t*)(F.lds + F.wave * 5120);
    const int gw = F.bid * NWAVES + F.wave, NGW = F.G * NWAVES;
    for (int u = gw; u < 4096; u += NGW) {
        const int b = u >> 9, hh = (u >> 7) & 3, n = u & 127; const size_t m0 = (size_t)b * 4096 + n * 32;
        float bc[32];
        gla_wave_bcum(a, P, m0, hh, lane, bc);
        const float blast = bc[31];
#pragma unroll
        for (int c = 0; c < 32; c += 2) {
            const float k0 = bf2f(P[(m0 + c) * N_IN1 + C1_GK + hh * 64 + lane]) * __expf(blast - bc[c]);
            const float k1 = bf2f(P[(m0 + c + 1) * N_IN1 + C1_GK + hh * 64 + lane]) * __expf(blast - bc[c + 1]);
            *(LAS unsigned*)(kdT + lane * 40 + c) = pk2(k0, k1);
        }
        DECAY[(size_t)u * 64 + lane] = __expf(blast);
        LDS_WAIT();
        bf16x8 Bf[2][2];
#pragma unroll
        for (int nt = 0; nt < 2; ++nt)
#pragma unroll
            for (int ks = 0; ks < 2; ++ks) Bf[nt][ks] = *(const LAS bf16x8*)(kdT + (32 * nt + r) * 40 + 16 * ks + 8 * h);
#pragma unroll
        for (int mt = 0; mt < 4; ++mt) {
            const bf16_t* vb = P + m0 * N_IN1 + C1_GV + hh * 128 + 32 * mt + r;
            const bf16x8 A0 = gla_vfrag(vb, 8 * h), A1 = gla_vfrag(vb, 16 + 8 * h);
#pragma unroll
            for (int nt = 0; nt < 2; ++nt) {
                f32x16 acc = {0.f, 0.f, 0.f, 0.f, 0.f, 0.f, 0.f, 0.f, 0.f, 0.f, 0.f, 0.f, 0.f, 0.f, 0.f, 0.f};
                acc = __builtin_amdgcn_mfma_f32_32x32x16_bf16(A0, Bf[nt][0], acc, 0, 0, 0);
                acc = __builtin_amdgcn_mfma_f32_32x32x16_bf16(A1, Bf[nt][1], acc, 0, 0, 0);
                float* up = UPD + (size_t)u * 8192 + 32 * nt + r;
#pragma unroll
                for (int i = 0; i < 16; ++i) up[(size_t)(32 * mt + (i & 3) + 8 * (i >> 2) + 4 * h) * 64] = acc[i];
            }
        }
        LDS_WAIT();
    }
}
__device__ __forceinline__ void p_gla_b(const Frame& F, unsigned char* ws) {
    float* UPD = (float*)(ws + L1_UPD); const float* DECAY = (const float*)(ws + L1_DECAY);
    for (int e = F.bid * NTHREADS + F.tid; e < 32 * 8192; e += F.G * NTHREADS) {
        const int bh = e >> 13, rem = e & 8191, dk = rem & 63;
        float state = 0.f;
        float* up = UPD + (size_t)bh * 128 * 8192 + rem; const float* dp = DECAY + (size_t)bh * 128 * 64 + dk;
#pragma unroll 8
        for (int n = 0; n < 128; ++n) { const float uv = up[(size_t)n * 8192], dc = dp[n * 64]; up[(size_t)n * 8192] = state; state = dc * state + uv; }
    }
}
__device__ __forceinline__ void p_gla_c(const Frame& F, const Args& a, unsigned char* ws, const int mode) {
    const bf16_t* P = (const bf16_t*)(ws + WS_PROJ); const float* PREV = (const float*)(ws + L1_UPD); bf16_t* CAT = (bf16_t*)(ws + L1_CAT);
    const int lane = F.lane, r = lane & 31, h = lane >> 5;
    LAS bf16_t* qd = (LAS bf16_t*)(F.lds + F.wave * 9472);
    LAS bf16_t* ki = qd + 32 * 72;
    const int gw = F.bid * NWAVES + F.wave, NGW = F.G * NWAVES;
    for (int u = gw; u < 4096; u += NGW) {
        const int b = u >> 9, hh = (u >> 7) & 3, n = u & 127; const size_t m0 = (size_t)b * 4096 + n * 32;
        f32x4 pr_[8]; unsigned short vr_[16];
#define GLA_FETCH(ct_) do { const float* pp_ = PREV + (size_t)u * 8192 + (size_t)(32 * (ct_) + r) * 64 + 8 * h; \
            _Pragma("unroll") for (int ks_ = 0; ks_ < 4; ++ks_) { pr_[2 * ks_] = *(const f32x4*)(pp_ + 16 * ks_); pr_[2 * ks_ + 1] = *(const f32x4*)(pp_ + 16 * ks_ + 4); } \
            const bf16_t* vb_ = P + m0 * N_IN1 + C1_GV + hh * 128 + 32 * (ct_) + r; \
            _Pragma("unroll") for (int j_ = 0; j_ < 16; ++j_) vr_[j_] = vb_[(size_t)(8 * h + (j_ & 7) + 16 * (j_ >> 3)) * N_IN1]; } while (0)
        GLA_FETCH(0);
        {
            float bc[32];
            if (mode == 1) {
#pragma unroll
                for (int c = 0; c < 32; ++c) bc[c] = -0.01f * (float)c;
            } else gla_wave_bcum(a, P, m0, hh, lane, bc);
#pragma unroll
            for (int c = 0; c < 32; ++c) {
                const float kv = bf2f(P[(m0 + c) * N_IN1 + C1_GK + hh * 64 + lane]) * __expf(-bc[c]);
                const float qv = bf2f(P[(m0 + c) * N_IN1 + C1_GQ + hh * 64 + lane]) * 0.125f * __expf(bc[c]);
                ki[c * 72 + lane] = (bf16_t)f2bf(kv); qd[c * 72 + lane] = (bf16_t)f2bf(qv);
            }
        }
        LDS_WAIT();
        bf16x8 Qa[4];
#pragma unroll
        for (int ks = 0; ks < 4; ++ks) Qa[ks] = *(const LAS bf16x8*)(qd + r * 72 + 16 * ks + 8 * h);
        {
            f32x16 at = {0.f, 0.f, 0.f, 0.f, 0.f, 0.f, 0.f, 0.f, 0.f, 0.f, 0.f, 0.f, 0.f, 0.f, 0.f, 0.f};
#pragma unroll
            for (int ks = 0; ks < 4; ++ks) at = __builtin_amdgcn_mfma_f32_32x32x16_bf16(Qa[ks], *(const LAS bf16x8*)(ki + r * 72 + 16 * ks + 8 * h), at, 0, 0, 0);
            LDS_WAIT();
#pragma unroll
            for (int i = 0; i < 16; ++i) { const int c = (i & 3) + 8 * (i >> 2) + 4 * h; ki[c * 40 + r] = (bf16_t)f2bf((r <= c) ? at[i] : 0.f); }
        }
        LDS_WAIT();
        bf16x8 Aa[2];
#pragma unroll
        for (int ks = 0; ks < 2; ++ks) Aa[ks] = *(const LAS bf16x8*)(ki + r * 40 + 16 * ks + 8 * h);
        f32x16 acc[4];
#pragma unroll
        for (int ct = 0; ct < 4; ++ct) {
            bf16x8 Bp[4], Bv[2];
#pragma unroll
            for (int ks = 0; ks < 4; ++ks) Bp[ks] = pack8(pr_[2 * ks][0], pr_[2 * ks][1], pr_[2 * ks][2], pr_[2 * ks][3], pr_[2 * ks + 1][0], pr_[2 * ks + 1][1], pr_[2 * ks + 1][2], pr_[2 * ks + 1][3]);
#pragma unroll
            for (int ks = 0; ks < 2; ++ks) { u32x4 w; w.x = (unsigned)vr_[8 * ks] | ((unsigned)vr_[8 * ks + 1] << 16); w.y = (unsigned)vr_[8 * ks + 2] | ((unsigned)vr_[8 * ks + 3] << 16);
                w.z = (unsigned)vr_[8 * ks + 4] | ((unsigned)vr_[8 * ks + 5] << 16); w.w = (unsigned)vr_[8 * ks + 6] | ((unsigned)vr_[8 * ks + 7] << 16); Bv[ks] = __builtin_bit_cast(bf16x8, w); }
            if (ct < 3) GLA_FETCH(ct + 1);
#pragma unroll
            for (int i = 0; i < 16; ++i) acc[ct][i] = 0.f;
#pragma unroll
            for (int ks = 0; ks < 4; ++ks) acc[ct] = __builtin_amdgcn_mfma_f32_32x32x16_bf16(Qa[ks], Bp[ks], acc[ct], 0, 0, 0);
#pragma unroll
            for (int ks = 0; ks < 2; ++ks) acc[ct] = __builtin_amdgcn_mfma_f32_32x32x16_bf16(Aa[ks], Bv[ks], acc[ct], 0, 0, 0);
        }
#undef GLA_FETCH
#pragma unroll
        for (int i = 0; i < 16; ++i) {
            float ss = acc[0][i] * acc[0][i] + acc[1][i] * acc[1][i] + acc[2][i] * acc[2][i] + acc[3][i] * acc[3][i];
            ss += __shfl_xor(ss, 1); ss += __shfl_xor(ss, 2); ss += __shfl_xor(ss, 4); ss += __shfl_xor(ss, 8); ss += __shfl_xor(ss, 16);
            const float rstd = 1.0f / sqrtf(ss * (1.f / 128.f) + 1e-6f);
            const int c = (i & 3) + 8 * (i >> 2) + 4 * h; const size_t m = m0 + c;
#pragma unroll
            for (int ct = 0; ct < 4; ++ct) { const int dv = 32 * ct + r;
                const float rv = bf2f(P[m * N_IN1 + C1_GR + hh * 128 + dv]);
                const bf16_t ov = (bf16_t)f2bf(acc[ct][i] * rstd * a.in[I_L1_OGAIN][dv] * rv * sigmoidf_(rv));
                if (mode == 0) CAT[m * 1024 + 512 + hh * 128 + dv] = ov; else asm volatile("" :: "v"((unsigned)ov)); }
        }
        LDS_WAIT();
    }
}
__global__ void __launch_bounds__(NTHREADS, 2) mk_fwd(Args args) {
    extern __shared__ __attribute__((aligned(16))) unsigned char lds_raw[];
    cg::grid_group grid = cg::this_grid();
    Frame F; F.lds = (LAS unsigned char*)lds_raw; F.tid = threadIdx.x; F.lane = F.tid & 63; F.wave = __builtin_amdgcn_readfirstlane(F.tid >> 6); F.G = gridDim.x; F.bid = blockIdx.x;
    unsigned char* ws = args.ws;
    const int lo = args.ph_lo, hi = args.ph_hi;
#ifndef KEEPMASK
#define KEEPMASK 0xFFFFFFFFu
#endif
#define IN(k) (((KEEPMASK >> (k)) & 1u) && lo <= (k) && (k) < hi)
#define BOTH(k) (IN(k) && IN((k) + 1))
#ifndef TMODE
#define TMODE 0
#endif
#ifndef REPMASK
#define REPMASK 0u
#endif
#define PH(k, ...) if (IN(k)) { { const int rep = 0; (void)rep; __VA_ARGS__; } if ((REPMASK >> (k)) & 1u) { xcd_barrier(xbar); { const int rep = 1; (void)rep; __VA_ARGS__; } } }
#ifdef TS_A
#define STAMP(k) do { if (F.bid == 0 && F.tid == 0) ((unsigned long long*)(ws + WS_CTL + 65536))[(k)] = __builtin_amdgcn_s_memrealtime(); } while (0)
#else
#define STAMP(k) do { } while (0)
#endif
#define GRID_BAR(k) do { if (BOTH(k)) { if ((k) == 0) grid.sync(); else xcd_barrier(xbar); } STAMP((k) + 1); } while (0)
    const float* x = args.in[I_X];
    float* out = args.out;
    volatile LAS unsigned* xst = (volatile LAS unsigned*)(F.lds + LDS_BYTES - 64);
    if (F.tid < 16) xst[F.tid] = 0u;
    __syncthreads();
    XcdBarrier xbar = xcd_barrier_post((unsigned*)(ws + WS_CTL) + 4096, xst);

    STAMP(0);
    PH(0, int base = 0; transpose_all(F, base, args.in[I_L0_WIN], 1024, 1864, (bf16_t*)(ws + WS_W_IN0), 1024, MapIn0()); transpose_all(F, base, args.in[I_L0_WGLU], 512, 512, (bf16_t*)(ws + WS_W_GLU), 512, MapId()); transpose_all(F, base, args.in[I_L0_WOUT], 1024, 1024, (bf16_t*)(ws + WS_W_OUT0), 1024, MapId()); peer_fold_wq(F, args.in[I_L0_WQ], args.in[I_L0_SK], (bf16_t*)(ws + WS_WQ0)); transpose_all(F, base, args.in[I_L1_WIN], 1024, 2856, (bf16_t*)(ws + WS_W_IN1), 1024, MapIn1()); transpose_all(F, base, args.in[I_L1_KW1], 2048, 256, (bf16_t*)(ws + WS_KW1), 2048, MapId()); transpose_all(F, base, args.in[I_L1_VW1], 2048, 256, (bf16_t*)(ws + WS_VW1), 2048, MapId()); transpose_all(F, base, args.in[I_L1_KW2], 256, 64, (bf16_t*)(ws + WS_KW2), 256, MapId()); transpose_all(F, base, args.in[I_L1_VW2], 256, 64, (bf16_t*)(ws + WS_VW2), 256, MapId()); transpose_all(F, base, args.in[I_L1_WOUT], 1024, 1024, (bf16_t*)(ws + WS_W_OUT1), 1024, MapId()); peer_fold_wq(F, args.in[I_L1_WQ], args.in[I_L1_SK], (bf16_t*)(ws + WS_WQ1)); zero_bytes(F, ws + WS_W_IN0 + (size_t)1864 * 1024 * 2, (size_t)(2048 - 1864) * 1024 * 2); zero_bytes(F, ws + WS_W_IN1 + (size_t)2856 * 1024 * 2, (size_t)(3072 - 2856) * 1024 * 2); zero_bytes(F, ws + WS_KW2 + (size_t)64 * 256 * 2, (size_t)192 * 256 * 2); zero_bytes(F, ws + WS_VW2 + (size_t)64 * 256 * 2, (size_t)192 * 256 * 2);   cvt_table_i8(F, args.in[I_L0_U], ws + WS_TAB8U, (float*)(ws + WS_TABSU), 32); cvt_table_fp8(F, args.in[I_L0_V], ws + WS_TAB8V, (float*)(ws + WS_TABSV), 32); p_rope_table(F, (f32x2*)(ws + WS_ROPE)); if (F.bid == F.G - 1) { for (int i = F.tid; i < 1024; i += NTHREADS) ((float*)(ws + WS_CMPB + 4096))[i] = args.in[I_L1_MIXN][i]; } __syncthreads(); for (int g = F.bid; g < 32; g += F.G) s5_build_group(F, args, ws, g); for (int j = (F.bid + F.G - (32 % F.G)) % F.G; j < 64; j += F.G) cmp_bias(F, args, (float*)(ws + WS_CMPB), j); p_rmsnorm(F, x, args.in[I_L0_MIXN], (bf16_t*)(ws + WS_XN));)
    GRID_BAR(0);
    PH(1, pg8::Gemm g{(const bf16_t*)(ws + WS_XN), (const bf16_t*)(ws + WS_W_IN0), T, N_IN0, 1024, 1024, 1024}; pg8::StaticOrder S; S.init(T, N_IN0, F.G, F.bid); pg8::EpiStoreBf16 E{(bf16_t*)(ws + WS_PROJ), N_IN0}; pg8::gemm_phase(F.lds, g, S, E);)
    GRID_BAR(1);
    PH(2, p_l0_prep(F, args, ws);)
    GRID_BAR(2);
    PH(3, p_dsa_index(F, ws, (u64*)(ws + (rep ? L0_CAT : L0_SELT)), rep ? TMODE : 0); { pg8::Gemm g{(const bf16_t*)(ws + L0_UA), (const bf16_t*)(ws + WS_S5B1), 65536, 8192, 256, 384, 256}; pg8::GroupedOrder S; S.init(256, 8, F.G, F.bid); pg8::EpiS5State E{(float*)(ws + L0_SLOC)}; pg8::gemm_phase(F.lds, g, S, E); })
    GRID_BAR(3);
    PH(4, p_s5_scan(F, args, ws); p_dsa_attn(F, args, ws);)
    GRID_BAR(4);
    PH(7, pg8::Gemm g{(const bf16_t*)(ws + L0_UA), (const bf16_t*)(ws + WS_S5B2), 65536, 8192, 384, 384, 384}; pg8::GroupedOrder S; S.init(256, 8, F.G, F.bid); pg8::EpiS5Out E{(bf16_t*)(ws + L0_YB)}; pg8::gemm_phase(F.lds, g, S, E);)
    GRID_BAR(7);
    PH(8, pg8::Gemm g{(const bf16_t*)(ws + L0_YB), (const bf16_t*)(ws + WS_W_GLU), T, 512, 512, 512, 512}; pg8::StaticOrder S; S.init(T, 512, F.G, F.bid); pg8::EpiGlu E{(const bf16_t*)(ws + L0_YB), args.in[I_L0_BGLU], (bf16_t*)(ws + L0_CAT)}; pg8::gemm_phase(F.lds, g, S, E);)
    GRID_BAR(8);
    PH(9, pg8::Gemm g{(const bf16_t*)(ws + L0_CAT), (const bf16_t*)(ws + WS_W_OUT0), T, 1024, 1024, 1024, 1024}; pg8::StaticOrder S; S.init(T, 1024, F.G, F.bid); pg8::EpiResidF32 E{x, out, 1024}; pg8::gemm_phase(F.lds, g, S, E);)
    GRID_BAR(9);
    PH(10, p_rmsnorm(F, out, args.in[I_L0_FFNN], (bf16_t*)(ws + WS_XN));)
    GRID_BAR(10);
    PH(11, pg8::Gemm g{(const bf16_t*)(ws + WS_XN), (const bf16_t*)(ws + WS_WQ0), T, 2048, 1024, 1024, 1024}; pg8::StaticOrder S; S.init(T, 2048, F.G, F.bid); pg8::EpiStoreF16 E{(_Float16*)(ws + PE_Q2), 2048}; pg8::gemm_phase(F.lds, g, S, E);)
    GRID_BAR(11);
    PH(12, p_peer_route(F, ws);)
    GRID_BAR(12);
    PH(13, p_peer_expert5(F, ws, out, rep ? 0.f : 1.f, xbar, rep ? TMODE : 0, true);)
    GRID_BAR(13);
    PH(15, pg8::Gemm g{(const bf16_t*)(ws + WS_XN), (const bf16_t*)(ws + WS_W_IN1), T, N_IN1, 1024, 1024, 1024}; pg8::StaticOrder S; S.init(T, N_IN1, F.G, F.bid); pg8::EpiStoreBf16 E{(bf16_t*)(ws + WS_PROJ), N_IN1}; pg8::gemm_phase(F.lds, g, S, E);)
    GRID_BAR(15);
    PH(16, p_l1_prep(F, args, ws);)
    GRID_BAR(16);
    PH(17, pg8::Gemm g{(const bf16_t*)(ws + L1_KCR), (const bf16_t*)(ws + WS_KW1), 8192, 512, 2048, 1024, 2048}; pg8::GroupedOrder S; S.init(32, 16, F.G, F.bid); pg8::EpiCmp1 E{(bf16_t*)(ws + L1_H1), (const float*)(ws + WS_CMPB)}; pg8::gemm_phase(F.lds, g, S, E);)
    GRID_BAR(17);
    PH(18, pg8::Gemm g{(const bf16_t*)(ws + L1_H1), (const bf16_t*)(ws + WS_KW2), 8192, 512, 256, 256, 256}; pg8::GroupedOrder S; S.init(32, 16, F.G, F.bid); pg8::EpiCmp2 E{(float*)(ws + L1_CMPO)}; pg8::gemm_phase(F.lds, g, S, E);)
    GRID_BAR(18);
    PH(19, p_cmp_final(F, args, ws);)
    GRID_BAR(19);
    PH(20, p_cmp_attn(F, args, ws);)
    GRID_BAR(20);
    PH(21, if (rep) { p_cmp_attn(F, args, ws); xcd_barrier(xbar); } p_nsa_attn(F, args, ws);)
    GRID_BAR(21);
    PH(22, p_gla_a(F, args, ws); cvt_table_i8(F, args.in[I_L1_U], ws + WS_TAB8U, (float*)(ws + WS_TABSU), 0); cvt_table_fp8(F, args.in[I_L1_V], ws + WS_TAB8V, (float*)(ws + WS_TABSV), 0);)
    GRID_BAR(22);
    PH(23, if (rep) { p_gla_a(F, args, ws); xcd_barrier(xbar); } p_gla_b(F, ws);)
    GRID_BAR(23);
    PH(24, p_gla_c(F, args, ws, rep ? TMODE : 0);)
    GRID_BAR(24);
    PH(25, pg8::Gemm g{(const bf16_t*)(ws + L1_CAT), (const bf16_t*)(ws + WS_W_OUT1), T, 1024, 1024, 1024, 1024}; pg8::StaticOrder S; S.init(T, 1024, F.G, F.bid); pg8::EpiResidF32 E{out, out, 1024}; pg8::gemm_phase(F.lds, g, S, E);)
    GRID_BAR(25);
    PH(26, p_rmsnorm(F, out, args.in[I_L1_FFNN], (bf16_t*)(ws + WS_XN));)
    GRID_BAR(26);
    PH(27, pg8::Gemm g{(const bf16_t*)(ws + WS_XN), (const bf16_t*)(ws + WS_WQ1), T, 2048, 1024, 1024, 1024}; pg8::StaticOrder S; S.init(T, 2048, F.G, F.bid); pg8::EpiStoreF16 E{(_Float16*)(ws + PE_Q2), 2048}; pg8::gemm_phase(F.lds, g, S, E);)
    GRID_BAR(27);
    PH(28, p_peer_route(F, ws);)
    GRID_BAR(28);
    PH(29, p_peer_expert5(F, ws, out, rep ? 0.f : 1.f, xbar, rep ? TMODE : 0, false);)
#undef IN
#undef BOTH
}

extern "C" void kernel_launch(void* const* d_in, const int* in_sizes, int n_in, void* d_out, int out_size, void* d_ws, size_t ws_size, hipStream_t stream) {
    static int grid = 0;
    if (grid == 0) {
        if (n_in != 39 || ws_size < WS_END) { fprintf(stderr, "kernel_launch: unexpected n_in %d or ws_size %zu (< %zu)\n", n_in, ws_size, (size_t)WS_END); grid = -1; return; }
        int dev = 0, cus = 0, per_cu = 0;
        (void)hipGetDevice(&dev); (void)hipDeviceGetAttribute(&cus, hipDeviceAttributeMultiprocessorCount, dev);
        if (hipFuncSetAttribute((const void*)mk_fwd, hipFuncAttributeMaxDynamicSharedMemorySize, LDS_BYTES) != hipSuccess) { fprintf(stderr, "kernel_launch: hipFuncSetAttribute failed\n"); grid = -1; return; }
        if (hipOccupancyMaxActiveBlocksPerMultiprocessor(&per_cu, (const void*)mk_fwd, NTHREADS, LDS_BYTES) != hipSuccess || per_cu < 1) { fprintf(stderr, "kernel_launch: occupancy query failed (%d)\n", per_cu); (void)hipGetLastError(); grid = -1; return; }
        grid = cus;
    }
    if (grid < 0) return;
    (void)hipMemsetAsync((char*)d_ws + WS_CTL, 0, 32768, stream);
    Args a{};
    for (int i = 0; i < 39; ++i) a.in[i] = (const float*)d_in[i];
    a.out = (float*)d_out; a.ws = (unsigned char*)d_ws; a.ph_lo = 0; a.ph_hi = 1000;
    void* kargs[] = {&a};
    hipError_t e = hipLaunchCooperativeKernel((const void*)mk_fwd, dim3(grid), dim3(NTHREADS), kargs, LDS_BYTES, stream);
    if (e != hipSuccess) fprintf(stderr, "kernel_launch: cooperative launch failed: %s\n", hipGetErrorString(e));
}
```

```cpp
#include <hip/hip_runtime.h>
#include <hip/hip_cooperative_groups.h>
#include <cstdio>
#include <cstdint>
namespace cg = cooperative_groups;

#define LAS __attribute__((address_space(3)))
typedef unsigned short bf16_t;
typedef short bf16x8 __attribute__((ext_vector_type(8)));
typedef float f32x4 __attribute__((ext_vector_type(4)));
typedef float f32x2 __attribute__((ext_vector_type(2)));
typedef float f32x16 __attribute__((ext_vector_type(16)));
typedef unsigned u32x4 __attribute__((ext_vector_type(4)));
typedef unsigned u32x2 __attribute__((ext_vector_type(2)));
typedef unsigned long long u64;

constexpr int NB = 8, SEQ = 4096, DM = 1024, T = NB * SEQ;
constexpr int NTHREADS = 512, NWAVES = 8;
constexpr int LDS_BYTES = 147456;
constexpr int N_IN0 = 2048, N_IN1 = 3072;
constexpr int C0_Q = 0, C0_K = 512, C0_V = 640, C0_IQ = 768, C0_U = 1280, C0_IK = 1792, C0_IW = 1856;
constexpr int C1_Q = 0, C1_KC = 512, C1_VC = 640, C1_KS = 768, C1_VS = 896, C1_KW = 1024, C1_VW = 1152, C1_GQ = 1280, C1_GK = 1536, C1_GV = 1792, C1_GR = 2304, C1_GL = 2816, C1_GLOW = 2840;

constexpr size_t MiB = 1u << 20;
constexpr size_t WS_CTL = 0;
constexpr size_t WS_ROPE = 1 * MiB;
constexpr size_t WS_W_IN0 = 2 * MiB;
constexpr size_t WS_W_GLU = 6 * MiB;
constexpr size_t WS_SK0 = 6 * MiB + 512 * 1024;
constexpr size_t WS_W_OUT0 = 7 * MiB;
constexpr size_t WS_WQ0 = 9 * MiB;
constexpr size_t WS_W_IN1 = 13 * MiB;
constexpr size_t WS_KW1 = 19 * MiB;
constexpr size_t WS_VW1 = 20 * MiB;
constexpr size_t WS_KW2 = 21 * MiB;
constexpr size_t WS_VW2 = 21 * MiB + 128 * 1024;
constexpr size_t WS_SK1 = 21 * MiB + 512 * 1024;
constexpr size_t WS_W_OUT1 = 22 * MiB;
constexpr size_t WS_WQ1 = 24 * MiB;
constexpr size_t WS_S5B1 = 28 * MiB;
constexpr size_t WS_S5B2 = 32 * MiB;
constexpr size_t WS_CMPB = 38 * MiB;
constexpr size_t WS_TABU = 48 * MiB;
constexpr size_t WS_TABV = 80 * MiB;
constexpr size_t WS_XN = 112 * MiB;
constexpr size_t WS_PROJ = 176 * MiB;
constexpr size_t WS_R3 = 368 * MiB;
constexpr size_t WS_END = 506 * MiB;

__device__ __forceinline__ unsigned f2bf(float f) { unsigned u = __builtin_bit_cast(unsigned, f); return (u + 0x7fffu + ((u >> 16) & 1u)) >> 16; }
__device__ __forceinline__ unsigned pk2(float lo, float hi) { return f2bf(lo) | (f2bf(hi) << 16); }
__device__ __forceinline__ float bf_lo(unsigned u) { return __builtin_bit_cast(float, u << 16); }
__device__ __forceinline__ float bf_hi(unsigned u) { return __builtin_bit_cast(float, u & 0xffff0000u); }
__device__ __forceinline__ float bf2f(bf16_t b) { return __builtin_bit_cast(float, ((unsigned)b) << 16); }
__device__ __forceinline__ float wave_sum(float v) {
#pragma unroll
    for (int o = 1; o < 64; o <<= 1) v += __shfl_xor(v, o);
    return v;
}
__device__ __forceinline__ float gelu_tanh(float x) {
    const float y = 0.7978845608028654f * (x + 0.044715f * x * x * x);
    const float e = __expf(2.0f * y);
    const float th = 1.0f - 2.0f / (e + 1.0f);
    return 0.5f * x * (1.0f + th);
}
__device__ __forceinline__ float sigmoidf_(float x) { return 1.0f / (1.0f + __expf(-x)); }
#define LDS_WAIT() asm volatile("s_waitcnt lgkmcnt(0)" ::: "memory")
#define VM_WAIT() asm volatile("s_waitcnt vmcnt(0)" ::: "memory")

#define XB_TMO      128
#define XB_XCNT(j)  (256  + 64 * (j))
#define XB_XSUB(j)  (1280 + 64 * (j))
#define XB_XGEN(j)  (2304 + 64 * (j))
#define XB_TOP      3328
#define XB_TOPGEN   3392
#define XCD_BAR_WORDS 3456
#define XB_SPIN_CAP (1u << 22)
__device__ __forceinline__ unsigned xb_ld(unsigned* p)              { return __hip_atomic_load(p, __ATOMIC_RELAXED, __HIP_MEMORY_SCOPE_AGENT); }
__device__ __forceinline__ unsigned xb_add(unsigned* p, unsigned v) { return __hip_atomic_fetch_add(p, v, __ATOMIC_RELAXED, __HIP_MEMORY_SCOPE_AGENT); }
__device__ __forceinline__ unsigned xb_xcc_id() { return (unsigned)__builtin_amdgcn_s_getreg((3 << 11) | 20) & 0xFu; }
#define XB_SPIN(cond, bar) do { unsigned _sp = 0; while (cond) { __builtin_amdgcn_s_sleep(1); \
    if ((++_sp & 255u) == 0u) { if (xb_ld(&(bar)[XB_TMO])) break; if (_sp > XB_SPIN_CAP) { atomicAdd(&(bar)[XB_TMO], 1u); break; } } } } while (0)
struct XcdBarrier { unsigned* bar; unsigned x; volatile LAS unsigned* st; };
__device__ __forceinline__ XcdBarrier xcd_barrier_post(unsigned* bar, volatile LAS unsigned* st) {
    XcdBarrier b; b.bar = bar; b.x = xb_xcc_id(); b.st = st;
    if (threadIdx.x == 0) (void)xb_add(&bar[XB_XCNT(b.x)], 1u);
    return b;
}
__device__ __forceinline__ void xcd_barrier_complete(unsigned* bar, unsigned x, unsigned& nloc, unsigned& nx) {
    const unsigned G = gridDim.x * gridDim.y * gridDim.z;
    unsigned sum, cnt, mine, sp = 0u;
    for (;;) {
        sum = 0u; cnt = 0u; mine = 0u;
#pragma unroll
        for (unsigned j = 0; j < 16; ++j) { const unsigned c = xb_ld(&bar[XB_XCNT(j)]); sum += c; cnt += (c > 0u) ? 1u : 0u; mine = (j == x) ? c : mine; }
        if (sum == G) break;
        __builtin_amdgcn_s_sleep(1);
        if ((++sp & 255u) == 0u) { if (xb_ld(&bar[XB_TMO])) break; if (sp > XB_SPIN_CAP) { atomicAdd(&bar[XB_TMO], 1u); break; } }
    }
    nloc = mine > 0u ? mine : 1u; nx = cnt > 0u ? cnt : 1u;
}
__device__ __forceinline__ void xcd_barrier(const XcdBarrier& b) {
    asm volatile("s_waitcnt vmcnt(0)" ::: "memory");
    __syncthreads();
    if (threadIdx.x == 0) {
        unsigned* bar = b.bar;
        __builtin_amdgcn_s_waitcnt(0);
        unsigned nloc = b.st[0], nx = b.st[1];
        if (nloc == 0u) { xcd_barrier_complete(bar, b.x, nloc, nx); b.st[0] = nloc; b.st[1] = nx; }
        const unsigned old = xb_add(&bar[XB_XSUB(b.x)], 1u);
        const unsigned gen = old / nloc;
        if (old + 1u == (gen + 1u) * nloc) {
            __builtin_amdgcn_fence(__ATOMIC_RELEASE, "agent");
            asm volatile("s_waitcnt vmcnt(0)" ::: "memory");
            const unsigned og = xb_add(&bar[XB_TOP], 1u);
            const unsigned tg = og / nx;
            if (og + 1u == (tg + 1u) * nx) xb_add(&bar[XB_TOPGEN], 1u);
            else XB_SPIN(xb_ld(&bar[XB_TOPGEN]) == tg, bar);
            __builtin_amdgcn_fence(__ATOMIC_ACQUIRE, "agent");
            xb_add(&bar[XB_XGEN(b.x)], 1u);
            asm volatile("s_waitcnt vmcnt(0)" ::: "memory");
        } else {
            XB_SPIN(xb_ld(&bar[XB_XGEN(b.x)]) == gen, bar);
            __builtin_amdgcn_fence(__ATOMIC_ACQUIRE, "agent");
            asm volatile("s_waitcnt vmcnt(0)" ::: "memory");
        }
    }
    __syncthreads();
}

namespace pg8 {
constexpr int BM = 256, BK = 64, HALF = 128, HTB = HALF * BK * 2, STAGE_BYTES = 8 * HTB, NXCD = 8, WGM = 8;
__device__ __forceinline__ int lds_byte(int r, int c) { const int st = (r >> 4) * 2 + (c >> 5), rr = r & 15, cc = c & 31, ob = rr * 64 + cc * 2; return st * 1024 + (ob ^ (((ob >> 9) & 1) << 5)); }
__device__ __forceinline__ void stage_rc(int b, int& R, int& C) { const int st = b / 1024, sb = b % 1024, swz = sb ^ (((sb >> 9) & 1) << 5); R = (st >> 1) * 16 + swz / 64; C = (st & 1) * 32 + (swz % 64) / 2; }
__device__ __forceinline__ int perm32(int rho) { const int n = rho >> 4, i = rho & 15; return 8 * (i >> 2) + 4 * n + (i & 3); }
struct Unit { int pm, pn; };
struct Gemm { const bf16_t* A; const bf16_t* Bt; int M, N, K, lda, ldb; };
struct StaticOrder {
    int nM, nN, nwg, G, c;
    __device__ void init(int M, int N, int G_, int c_) { nM = M / BM; nN = N / BM; nwg = nM * nN; G = G_; c = c_; }
    __device__ bool next(int i, Unit& u) const {
        const long L = (long)i * G + c; if (L >= nwg) return false;
        int wgid = (int)L; { const int q = nwg / NXCD, r = nwg % NXCD, xcd = wgid % NXCD, off = wgid / NXCD; wgid = (xcd < r ? xcd * (q + 1) : r * (q + 1) + (xcd - r) * q) + off; }
        const int nig = WGM * nN, gid = wgid / nig, fm = gid * WGM, gsz = (nM - fm) < WGM ? (nM - fm) : WGM;
        u.pm = fm + ((wgid % nig) % gsz); u.pn = (wgid % nig) / gsz; return true;
    }
};
struct GroupedOrder {
    int nwg, G, c, tpg;
    __device__ void init(int ntiles, int tiles_per_group, int G_, int c_) { nwg = ntiles; tpg = tiles_per_group; G = G_; c = c_; }
    __device__ bool next(int i, Unit& u) const { const long L = (long)i * G + c; if (L >= nwg) return false; u.pm = (int)L; u.pn = (int)L / tpg; return true; }
};
__device__ __forceinline__ unsigned cvt_pk_bf16(float lo, float hi) { unsigned r; asm volatile("v_cvt_pk_bf16_f32 %0, %1, %2" : "=v"(r) : "v"(lo), "v"(hi)); return r; }

template <class Epi, class Sched>
__device__ __forceinline__ void gemm_phase(LAS unsigned char* lds, const Gemm g, const Sched& S, const Epi& E) {
    const int tid = threadIdx.x, wid = __builtin_amdgcn_readfirstlane(tid >> 6), lane = tid & 63, wr = wid >> 2, wc = wid & 3, fr = lane & 15, fq = lane >> 4;
    int K = g.K; asm volatile("" : "+s"(K));
    const int nt = K / BK;
    unsigned voffA[2], voffB[2];
#pragma unroll
    for (int i = 0; i < 2; ++i) { int R, C; stage_rc(tid * 16 + i * 8192, R, C); const int Rb = Epi::PERM ? ((R & ~31) + perm32(R & 31)) : R;
        voffA[i] = (unsigned)(R * g.lda + C) * 2u; voffB[i] = (unsigned)(Rb * g.ldb + C) * 2u; }
    const size_t kstep = (size_t)(BK * 2);
    const size_t hstepA = (size_t)HALF * g.lda * 2, hstepB = (size_t)HALF * g.ldb * 2;
    const size_t tstepA = 2 * hstepA, tstepB = 2 * hstepB;
    const unsigned ldsw = (unsigned)wid * 1024u;
    const int aoff = lds_byte(wr * 64 + fr, fq * 8), boff = lds_byte(wc * 32 + fr, fq * 8);
#define PG8_SA(b, h) (((b) * 2 + (h)) * HTB)
#define PG8_SB(b, h) ((4 + (b) * 2 + (h)) * HTB)
#define PG8_STAGE(bufoff, gbase, voff) do { _Pragma("unroll") for (int _i = 0; _i < 2; ++_i) \
        __builtin_amdgcn_global_load_lds((const unsigned*)((const char*)(gbase) + (voff)[_i]), (LAS unsigned*)(lds + (bufoff) + ldsw + _i * 8192), 16, 0, 0); } while (0)
#define PG8_LDA(dst, b, h) do { _Pragma("unroll") for (int m = 0; m < 4; ++m) _Pragma("unroll") for (int k = 0; k < 2; ++k) dst[m][k] = *(const LAS bf16x8*)(lds + PG8_SA(b, h) + aoff + m * 2048 + k * 1024); } while (0)
#define PG8_LDB(dst, b, h) do { _Pragma("unroll") for (int n = 0; n < 2; ++n) _Pragma("unroll") for (int k = 0; k < 2; ++k) dst[n][k] = *(const LAS bf16x8*)(lds + PG8_SB(b, h) + boff + n * 2048 + k * 1024); } while (0)
#define PG8_MMA(ai, bj, At, Bt) do { __builtin_amdgcn_s_setprio(1); _Pragma("unroll") for (int m = 0; m < 4; ++m) _Pragma("unroll") for (int n = 0; n < 2; ++n) _Pragma("unroll") for (int k = 0; k < 2; ++k) \
        acc[ai][bj][m][n] = __builtin_amdgcn_mfma_f32_16x16x32_bf16(Bt[n][k], At[m][k], acc[ai][bj][m][n], 0, 0, 0); __builtin_amdgcn_s_setprio(0); } while (0)
#define PG8_WAIT_V(n) asm volatile("s_waitcnt vmcnt(" #n ")" ::: "memory")
#define PG8_WAIT_L(n) asm volatile("s_waitcnt lgkmcnt(" #n ")" ::: "memory")
#define PG8_BAR __builtin_amdgcn_s_barrier()
#define PG8_SCHED __builtin_amdgcn_sched_barrier(0)
    Unit cur, nxt; int ui = 0;
    if (!S.next(0, cur)) return;
    f32x4 acc[2][2][4][2];
#pragma unroll
    for (int a = 0; a < 2; ++a)
#pragma unroll
        for (int b = 0; b < 2; ++b)
#pragma unroll
            for (int m = 0; m < 4; ++m)
#pragma unroll
                for (int n = 0; n < 2; ++n) acc[a][b][m][n] = (f32x4){0.f, 0.f, 0.f, 0.f};
    bf16x8 At[4][2], B0[2][2], B1[2][2];
    const char* cA = (const char*)g.A + (size_t)cur.pm * tstepA; const char* cB = (const char*)g.Bt + (size_t)cur.pn * tstepB;
    PG8_STAGE(PG8_SB(0, 0), cB, voffB); PG8_STAGE(PG8_SA(0, 0), cA, voffA); PG8_STAGE(PG8_SB(0, 1), cB + hstepB, voffB); PG8_STAGE(PG8_SA(0, 1), cA + hstepA, voffA);
    if (wr == 1) PG8_BAR;
    PG8_WAIT_V(4); PG8_BAR;
    PG8_STAGE(PG8_SB(1, 0), cB + kstep, voffB); PG8_STAGE(PG8_SA(1, 0), cA + kstep, voffA); PG8_STAGE(PG8_SB(1, 1), cB + hstepB + kstep, voffB);
    PG8_WAIT_V(6); PG8_BAR;
    for (;;) {
        const bool has_next = S.next(ui + 1, nxt);
        const char* nA = has_next ? (const char*)g.A + (size_t)nxt.pm * tstepA : cA; const char* nB = has_next ? (const char*)g.Bt + (size_t)nxt.pn * tstepB : cB;
        for (int t = 0; t < nt; t += 2) {
            const bool last = (t == nt - 2);
            const char* a1 = cA + (size_t)(t + 1) * kstep;
            const char* a2 = last ? nA : cA + (size_t)(t + 2) * kstep; const char* b2 = last ? nB : cB + (size_t)(t + 2) * kstep;
            const char* a3 = a2 + kstep; const char* b3 = b2 + kstep;
            PG8_LDB(B0, 0, 0); PG8_SCHED; PG8_LDA(At, 0, 0); PG8_STAGE(PG8_SA(1, 1), a1 + hstepA, voffA);
            PG8_WAIT_L(8); PG8_BAR; PG8_WAIT_L(0); PG8_MMA(0, 0, At, B0); PG8_BAR; PG8_SCHED;
            PG8_LDB(B1, 0, 1); PG8_STAGE(PG8_SB(0, 0), b2, voffB);
            PG8_BAR; PG8_WAIT_L(0); PG8_MMA(0, 1, At, B1); PG8_BAR;
            PG8_LDA(At, 0, 1); PG8_STAGE(PG8_SA(0, 0), a2, voffA);
            PG8_BAR; PG8_WAIT_L(0); PG8_MMA(1, 0, At, B0); PG8_BAR; PG8_SCHED;
            PG8_STAGE(PG8_SB(0, 1), b2 + hstepB, voffB);
            PG8_WAIT_V(6); PG8_BAR; PG8_MMA(1, 1, At, B1); PG8_BAR;
            PG8_LDB(B0, 1, 0); PG8_SCHED; PG8_LDA(At, 1, 0); PG8_STAGE(PG8_SA(0, 1), a2 + hstepA, voffA);
            PG8_WAIT_L(8); PG8_BAR; PG8_WAIT_L(0); PG8_MMA(0, 0, At, B0); PG8_BAR; PG8_SCHED;
            PG8_LDB(B1, 1, 1); PG8_STAGE(PG8_SB(1, 0), b3, voffB);
            PG8_BAR; PG8_WAIT_L(0); PG8_MMA(0, 1, At, B1); PG8_BAR;
            PG8_LDA(At, 1, 1); PG8_STAGE(PG8_SA(1, 0), a3, voffA);
            PG8_BAR; PG8_WAIT_L(0); PG8_MMA(1, 0, At, B0); PG8_BAR; PG8_SCHED;
            PG8_STAGE(PG8_SB(1, 1), b3 + hstepB, voffB);
            PG8_WAIT_V(6); PG8_BAR; PG8_MMA(1, 1, At, B1); PG8_BAR;
        }
        E(acc, cur, wr, wc, fr, fq);
        if (!has_next) break;
#pragma unroll
        for (int a = 0; a < 2; ++a)
#pragma unroll
            for (int b = 0; b < 2; ++b)
#pragma unroll
                for (int m = 0; m < 4; ++m)
#pragma unroll
                    for (int n = 0; n < 2; ++n) acc[a][b][m][n] = (f32x4){0.f, 0.f, 0.f, 0.f};
        cur = nxt; cA = nA; cB = nB; ++ui;
    }
    PG8_WAIT_V(0);
    if (wr == 0) PG8_BAR;
    PG8_BAR;
#undef PG8_SA
#undef PG8_SB
#undef PG8_STAGE
#undef PG8_LDA
#undef PG8_LDB
#undef PG8_MMA
#undef PG8_WAIT_V
#undef PG8_WAIT_L
#undef PG8_BAR
#undef PG8_SCHED
}

struct EpiStoreBf16 {
    static constexpr bool PERM = true;
    bf16_t* O; int ldc;
    __device__ __forceinline__ void operator()(const f32x4 (&acc)[2][2][4][2], const Unit& u, int wr, int wc, int fr, int fq) const {
        const int row0 = u.pm * BM + wr * 64 + fr, col0 = u.pn * BM + wc * 32 + 8 * fq;
#pragma unroll
        for (int ai = 0; ai < 2; ++ai)
#pragma unroll
            for (int m = 0; m < 4; ++m) { bf16_t* rowp = O + (size_t)(row0 + ai * HALF + m * 16) * ldc + col0;
#pragma unroll
                for (int bj = 0; bj < 2; ++bj) { const f32x4 v0 = acc[ai][bj][m][0], v1 = acc[ai][bj][m][1];
                    u32x4 w; w.x = cvt_pk_bf16(v0[0], v0[1]); w.y = cvt_pk_bf16(v0[2], v0[3]); w.z = cvt_pk_bf16(v1[0], v1[1]); w.w = cvt_pk_bf16(v1[2], v1[3]);
                    *(u32x4*)(rowp + bj * HALF) = w; } }
    }
};
struct EpiStoreF16 {
    static constexpr bool PERM = true;
    _Float16* O; int ldc;
    __device__ __forceinline__ void operator()(const f32x4 (&acc)[2][2][4][2], const Unit& u, int wr, int wc, int fr, int fq) const {
        const int row0 = u.pm * BM + wr * 64 + fr, col0 = u.pn * BM + wc * 32 + 8 * fq;
#pragma unroll
        for (int ai = 0; ai < 2; ++ai)
#pragma unroll
            for (int m = 0; m < 4; ++m) { _Float16* rowp = O + (size_t)(row0 + ai * HALF + m * 16) * ldc + col0;
#pragma unroll
                for (int bj = 0; bj < 2; ++bj) { const f32x4 v0 = acc[ai][bj][m][0], v1 = acc[ai][bj][m][1];
                    typedef _Float16 h8 __attribute__((ext_vector_type(8)));
                    const h8 hv = {(_Float16)v0[0], (_Float16)v0[1], (_Float16)v0[2], (_Float16)v0[3], (_Float16)v1[0], (_Float16)v1[1], (_Float16)v1[2], (_Float16)v1[3]};
                    *(h8*)(rowp + bj * HALF) = hv; } }
    }
};
struct EpiResidF32 {
    static constexpr bool PERM = false;
    const float* R; float* C; int ldc;
    __device__ __forceinline__ void operator()(const f32x4 (&acc)[2][2][4][2], const Unit& u, int wr, int wc, int fr, int fq) const {
        const int row0 = u.pm * BM + wr * 64 + fr, col0 = u.pn * BM + wc * 32 + 4 * fq;
#pragma unroll
        for (int ai = 0; ai < 2; ++ai)
#pragma unroll
            for (int m = 0; m < 4; ++m) { const size_t off = (size_t)(row0 + ai * HALF + m * 16) * ldc + col0;
#pragma unroll
                for (int bj = 0; bj < 2; ++bj)
#pragma unroll
                    for (int n = 0; n < 2; ++n) { const f32x4 r = *(const f32x4*)(R + off + bj * HALF + n * 16); *(f32x4*)(C + off + bj * HALF + n * 16) = r + acc[ai][bj][m][n]; } }
    }
};
struct EpiResidNorm {
    static constexpr bool PERM = false;
    const float* R; float* C; const float* gain; bf16_t* XNp; float* SSQ;
    __device__ __forceinline__ void operator()(const f32x4 (&acc)[2][2][4][2], const Unit& u, int wr, int wc, int fr, int fq) const {
        const int row0 = u.pm * BM + wr * 64 + fr, col0 = u.pn * BM + wc * 32 + 4 * fq;
        f32x4 g4[2][2];
#pragma unroll
        for (int bj = 0; bj < 2; ++bj)
#pragma unroll
            for (int n = 0; n < 2; ++n) g4[bj][n] = *(const f32x4*)(gain + col0 + bj * HALF + n * 16);
#pragma unroll
        for (int ai = 0; ai < 2; ++ai)
#pragma unroll
            for (int m = 0; m < 4; ++m) { const int row = row0 + ai * HALF + m * 16; const size_t off = (size_t)row * 1024 + col0;
                float ss = 0.f;
#pragma unroll
                for (int bj = 0; bj < 2; ++bj)
#pragma unroll
                    for (int n = 0; n < 2; ++n) { const f32x4 o = *(const f32x4*)(R + off + bj * HALF + n * 16) + acc[ai][bj][m][n];
                        *(f32x4*)(C + off + bj * HALF + n * 16) = o;
                        ss += (o[0] * o[0] + o[1] * o[1]) + (o[2] * o[2] + o[3] * o[3]);
                        const f32x4 og = o * g4[bj][n];
                        u32x2 w; w.x = cvt_pk_bf16(og[0], og[1]); w.y = cvt_pk_bf16(og[2], og[3]);
                        *(u32x2*)(XNp + off + bj * HALF + n * 16) = w; }
                ss += __shfl_xor(ss, 16); ss += __shfl_xor(ss, 32);
                if (fq == 0) SSQ[(size_t)row * 16 + u.pn * 4 + wc] = ss;
                asm volatile("" ::: "memory"); __builtin_amdgcn_sched_barrier(0); }
    }
};
struct EpiStoreF16Rs {
    static constexpr bool PERM = true;
    _Float16* O; int ldc; const float* SSQ;
    __device__ __forceinline__ void operator()(const f32x4 (&acc)[2][2][4][2], const Unit& u, int wr, int wc, int fr, int fq) const {
        const int row0 = u.pm * BM + wr * 64 + fr, col0 = u.pn * BM + wc * 32 + 8 * fq;
#pragma unroll
        for (int ai = 0; ai < 2; ++ai)
#pragma unroll
            for (int m = 0; m < 4; ++m) { const int row = row0 + ai * HALF + m * 16; _Float16* rowp = O + (size_t)row * ldc + col0;
                const f32x4* sp = (const f32x4*)(SSQ + (size_t)row * 16);
                const f32x4 s0 = sp[0], s1 = sp[1], s2 = sp[2], s3 = sp[3];
                const float tot = ((s0[0] + s0[1]) + (s0[2] + s0[3])) + ((s1[0] + s1[1]) + (s1[2] + s1[3])) + ((s2[0] + s2[1]) + (s2[2] + s2[3])) + ((s3[0] + s3[1]) + (s3[2] + s3[3]));
                const float rstd = 1.0f / sqrtf(tot * (1.0f / 1024.0f) + 1e-6f);
#pragma unroll
                for (int bj = 0; bj < 2; ++bj) { const f32x4 v0 = acc[ai][bj][m][0] * rstd, v1 = acc[ai][bj][m][1] * rstd;
                    typedef _Float16 h8 __attribute__((ext_vector_type(8)));
                    const h8 hv = {(_Float16)v0[0], (_Float16)v0[1], (_Float16)v0[2], (_Float16)v0[3], (_Float16)v1[0], (_Float16)v1[1], (_Float16)v1[2], (_Float16)v1[3]};
                    *(h8*)(rowp + bj * HALF) = hv; }
                asm volatile("" ::: "memory"); __builtin_amdgcn_sched_barrier(0); }
    }
};
}

struct Args {
    const float* in[39];
    float* out;
    unsigned char* ws;
    int ph_lo, ph_hi;
};
enum { I_X = 0, I_L0_MIXN, I_L0_WIN, I_L0_QG, I_L0_KG, I_L0_LOGDT, I_L0_ARE, I_L0_AIM, I_L0_BRE, I_L0_BIM, I_L0_CRE, I_L0_CIM, I_L0_D, I_L0_WGLU, I_L0_BGLU, I_L0_WOUT,
       I_L0_FFNN, I_L0_WQ, I_L0_SK, I_L0_U, I_L0_V,
       I_L1_MIXN, I_L1_WIN, I_L1_QG, I_L1_KG, I_L1_CMPPOS, I_L1_KW1, I_L1_KW2, I_L1_VW1, I_L1_VW2, I_L1_WGATE, I_L1_BGATE, I_L1_OGAIN, I_L1_WOUT,
       I_L1_FFNN, I_L1_WQ, I_L1_SK, I_L1_U, I_L1_V };

struct Frame {
    LAS unsigned char* lds;
    int tid, lane, wave, G, bid;
};

constexpr size_t L0_QA = WS_R3;
constexpr size_t L0_IQ = WS_R3 + 32 * MiB;
constexpr size_t L0_KA = WS_R3 + 64 * MiB;
constexpr size_t L0_VAT = WS_R3 + 72 * MiB;
constexpr size_t L0_IK = WS_R3 + 80 * MiB;
constexpr size_t L0_IW = WS_R3 + 84 * MiB;
constexpr size_t L0_UA = WS_R3 + 88 * MiB;
constexpr size_t L0_SELT = WS_PROJ;
constexpr size_t L0_CAT = WS_PROJ + 16 * MiB;
constexpr size_t L0_SLOC = WS_PROJ + 80 * MiB;
constexpr size_t L0_YB = WS_PROJ + 112 * MiB;
constexpr size_t PE_Q2 = WS_PROJ;
constexpr size_t PE_EID = WS_PROJ + 128 * MiB;
constexpr size_t PE_GATE = WS_PROJ + 136 * MiB;
constexpr size_t PE_SSQ = WS_PROJ + 152 * MiB;

template <class Map>
__device__ __forceinline__ void transpose_item(const float* W, int K, int N, bf16_t* WT, int ldk, LAS float* scr, int item, int lane, const Map& map) {
    const int nblk = (N + 31) / 32, kb = item / nblk, nb = item % nblk, k0 = 64 * kb, n0 = 32 * nb;
    const int ncol = n0 + (lane & 31);
#pragma unroll 8
    for (int i = 0; i < 32; ++i) { const int kk = 2 * i + (lane >> 5); scr[kk * 33 + (lane & 31)] = (ncol < N) ? W[(size_t)(k0 + kk) * N + ncol] : 0.f; }
    LDS_WAIT(); asm volatile("" ::: "memory");
    const int c = lane & 7;
#pragma unroll
    for (int j = 0; j < 4; ++j) { const int n = (lane >> 3) + 8 * j; const LAS float* s = scr + (8 * c) * 33 + n;
        u32x4 o; o.x = pk2(s[0 * 33], s[1 * 33]); o.y = pk2(s[2 * 33], s[3 * 33]); o.z = pk2(s[4 * 33], s[5 * 33]); o.w = pk2(s[6 * 33], s[7 * 33]);
        if (n0 + n < N) *(u32x4*)(WT + (size_t)map(n0 + n) * ldk + k0 + 8 * c) = o; }
    LDS_WAIT(); asm volatile("" ::: "memory");
}
struct MapId { __device__ __forceinline__ int operator()(int n) const { return n; } };
struct MapIn0 { __device__ __forceinline__ int operator()(int n) const { return n < 1280 ? n : (n < 1344 ? n - 1280 + C0_IK : (n < 1352 ? n - 1344 + C0_IW : n - 1352 + C0_U)); } };
struct MapIn1 { __device__ __forceinline__ int operator()(int n) const {
    if (n < 1280) return n; if (n < 1304) return n - 1280 + C1_GL; if (n < 1560) return n - 1304 + C1_GQ; if (n < 1816) return n - 1560 + C1_GK;
    if (n < 2328) return n - 1816 + C1_GV; if (n < 2344) return n - 2328 + C1_GLOW; return n - 2344 + C1_GR; } };

template <class Map>
__device__ __forceinline__ void transpose_all(const Frame& F, int& base, const float* W, int K, int N, bf16_t* WT, int ldk, const Map& map) {
    LAS float* scr = (LAS float*)(F.lds + F.wave * 16384);
    const int gw = F.bid * NWAVES + F.wave, NGW = F.G * NWAVES;
    const int nit = (K / 64) * ((N + 31) / 32);
    for (int it = (gw + NGW - (base % NGW)) % NGW; it < nit; it += NGW) transpose_item(W, K, N, WT, ldk, scr, it, F.lane, map);
    base += nit;
}
__device__ __forceinline__ void zero_bytes(const Frame& F, unsigned char* p, size_t nbytes) {
    const size_t n16 = nbytes / 16;
    for (size_t i = (size_t)F.bid * NTHREADS + F.tid; i < n16; i += (size_t)F.G * NTHREADS) ((u32x4*)p)[i] = (u32x4){0u, 0u, 0u, 0u};
}
__device__ __forceinline__ void cvt_f32_bf16(const Frame& F, const float* src, bf16_t* dst, size_t n) {
    const size_t n8 = n / 8;
    for (size_t i = (size_t)F.bid * NTHREADS + F.tid; i < n8; i += (size_t)F.G * NTHREADS) {
        const f32x4 a = ((const f32x4*)src)[2 * i], b = ((const f32x4*)src)[2 * i + 1];
        u32x4 o; o.x = pk2(a.x, a.y); o.y = pk2(a.z, a.w); o.z = pk2(b.x, b.y); o.w = pk2(b.z, b.w);
        ((u32x4*)dst)[i] = o;
    }
}

__device__ __forceinline__ void rms_row_to_bf16(const float* xrow, const float* gain, bf16_t* orow, int lane) {
    const f32x4* xr = (const f32x4*)xrow + lane; const f32x4* gr = (const f32x4*)gain + lane;
    f32x4 v[4]; float s = 0.f;
#pragma unroll
    for (int j = 0; j < 4; ++j) { v[j] = xr[64 * j]; s += (v[j].x * v[j].x + v[j].y * v[j].y) + (v[j].z * v[j].z + v[j].w * v[j].w); }
    const float rstd = 1.0f / sqrtf(wave_sum(s) * (1.f / DM) + 1e-6f);
    u64* o8 = (u64*)orow + lane;
#pragma unroll
    for (int j = 0; j < 4; ++j) { const f32x4 g4 = gr[64 * j]; o8[64 * j] = (u64)pk2(v[j].x * rstd * g4.x, v[j].y * rstd * g4.y) | ((u64)pk2(v[j].z * rstd * g4.z, v[j].w * rstd * g4.w) << 32); }
}
__device__ __forceinline__ void p_rmsnorm(const Frame& F, const float* x, const float* gain, bf16_t* XN) {
    const int gw = F.bid * NWAVES + F.wave, NGW = F.G * NWAVES;
    for (int m = gw; m < T; m += NGW) rms_row_to_bf16(x + (size_t)m * DM, gain, XN + (size_t)m * DM, F.lane);
}

__device__ __forceinline__ void p_rope_table(const Frame& F, f32x2* rope) {
    for (int i = F.bid * NTHREADS + F.tid; i < SEQ * 32; i += F.G * NTHREADS) {
        const int pos = i >> 5, k = i & 31;
        const float inv = powf(10000.0f, -(float)k / 32.0f);
        const float ang = (float)pos * inv;
        float s, c; sincosf(ang, &s, &c);
        rope[i] = (f32x2){c, s};
    }
}

__device__ __forceinline__ void s5_build_group(const Frame& F, const Args& a, unsigned char* ws, int g) {
    LAS f32x2* abp = (LAS f32x2*)F.lds;
    LAS f32x2* bb = abp + 17 * 64;
    LAS f32x2* Cc = bb + 64 * 16;
    LAS float* KT = (LAS float*)(Cc + 16 * 64);
    const float dt = expf(a.in[I_L0_LOGDT][g]);
    for (int idx = F.tid; idx < 17 * 64; idx += NTHREADS) {
        const int tau = idx >> 6, p = idx & 63;
        const float lr = a.in[I_L0_ARE][g * 64 + p], li = a.in[I_L0_AIM][g * 64 + p];
        const float mag = expf((float)tau * dt * lr); float s, c; sincosf((float)tau * dt * li, &s, &c);
        abp[idx] = (f32x2){mag * c, mag * s};
    }
    for (int idx = F.tid; idx < 64 * 16; idx += NTHREADS) {
        const int p = idx >> 4, c = idx & 15;
        const float lr = a.in[I_L0_ARE][g * 64 + p], li = a.in[I_L0_AIM][g * 64 + p];
        const float mag = expf(dt * lr); float s, co; sincosf(dt * li, &s, &co);
        const float abr = mag * co, abi = mag * s, den = lr * lr + li * li;
        const float fr = ((abr - 1.0f) * lr + abi * li) / den, fi = (abi * lr - (abr - 1.0f) * li) / den;
        const float br = a.in[I_L0_BRE][(size_t)(g * 64 + p) * 16 + c], bi = a.in[I_L0_BIM][(size_t)(g * 64 + p) * 16 + c];
        bb[idx] = (f32x2){fr * br - fi * bi, fr * bi + fi * br};
    }
    for (int idx = F.tid; idx < 16 * 64; idx += NTHREADS) Cc[idx] = (f32x2){a.in[I_L0_CRE][(size_t)g * 1024 + idx], a.in[I_L0_CIM][(size_t)g * 1024 + idx]};
    __syncthreads();
    for (int idx = F.tid; idx < 16 * 256; idx += NTHREADS) {
        const int tau = idx >> 8, co = (idx >> 4) & 15, ci = idx & 15;
        float acc = 0.f;
        for (int p = 0; p < 64; ++p) {
            const f32x2 c = Cc[co * 64 + p], e = abp[tau * 64 + p], b = bb[p * 16 + ci];
            const float er = c.x * e.x - c.y * e.y, ei = c.x * e.y + c.y * e.x;
            acc += er * b.x - ei * b.y;
        }
        if (tau == 0 && co == ci) acc += a.in[I_L0_D][g * 16 + co];
        KT[idx] = acc;
    }
    __syncthreads();
    bf16_t* B1 = (bf16_t*)(ws + WS_S5B1) + (size_t)g * 256 * 256;
    bf16_t* B2 = (bf16_t*)(ws + WS_S5B2) + (size_t)g * 256 * 384;
    for (int idx = F.tid; idx < 256 * 128; idx += NTHREADS) {
        const int n = idx >> 7, k = (idx & 127) * 2;
        float v0 = 0.f, v1 = 0.f;
        if (n < 128) { const int p = n & 63, j = k >> 4, ci = k & 15; const f32x2 e = abp[(15 - j) * 64 + p], b0 = bb[p * 16 + ci], b1 = bb[p * 16 + ci + 1];
            if (n < 64) { v0 = e.x * b0.x - e.y * b0.y; v1 = e.x * b1.x - e.y * b1.y; } else { v0 = e.x * b0.y + e.y * b0.x; v1 = e.x * b1.y + e.y * b1.x; } }
        *(unsigned*)(B1 + (size_t)n * 256 + k) = pk2(v0, v1);
    }
    for (int idx = F.tid; idx < 256 * 192; idx += NTHREADS) {
        const int n = idx / 192, k = (idx % 192) * 2, i = n >> 4, co = n & 15;
        float v0 = 0.f, v1 = 0.f;
        if (k < 256) { const int j = k >> 4, ci = k & 15; if (j <= i) { v0 = KT[((i - j) * 16 + co) * 16 + ci]; v1 = KT[((i - j) * 16 + co) * 16 + ci + 1]; } }
        else { const int p = (k - 256) & 63; const bool im = k >= 320;
            const f32x2 c0 = Cc[co * 64 + p], e0 = abp[(i + 1) * 64 + p], c1 = Cc[co * 64 + p + 1], e1 = abp[(i + 1) * 64 + p + 1];
            if (!im) { v0 = c0.x * e0.x - c0.y * e0.y; v1 = c1.x * e1.x - c1.y * e1.y; } else { v0 = -(c0.x * e0.y + c0.y * e0.x); v1 = -(c1.x * e1.y + c1.y * e1.x); } }
        *(unsigned*)(B2 + (size_t)n * 384 + k) = pk2(v0, v1);
    }
    __syncthreads();
}

__device__ __forceinline__ void cmp_bias(const Frame& F, const Args& a, float* out, int j) {
    const int w = j >> 5, n0 = (j & 31) * 8;
    const float* w1 = a.in[w ? I_L1_VW1 : I_L1_KW1]; const float* pos = a.in[I_L1_CMPPOS];
    LAS float* red = (LAS float*)(F.lds + 65536);
    float acc[8];
#pragma unroll
    for (int i = 0; i < 8; ++i) acc[i] = 0.f;
#pragma unroll
    for (int kk = 0; kk < 4; ++kk) { const int k = F.tid * 4 + kk; const float p = pos[k];
        const f32x4 wa = *(const f32x4*)(w1 + (size_t)k * 256 + n0), wb = *(const f32x4*)(w1 + (size_t)k * 256 + n0 + 4);
        acc[0] += p * wa.x; acc[1] += p * wa.y; acc[2] += p * wa.z; acc[3] += p * wa.w; acc[4] += p * wb.x; acc[5] += p * wb.y; acc[6] += p * wb.z; acc[7] += p * wb.w; }
#pragma unroll
    for (int i = 0; i < 8; ++i) { const float sv = wave_sum(acc[i]); if (F.lane == 0) red[F.wave * 8 + i] = sv; }
    __syncthreads();
    if (F.tid < 8) { float t = 0.f; for (int wv = 0; wv < 8; ++wv) t += red[wv * 8 + F.tid]; out[w * 256 + n0 + F.tid] = t; }
    __syncthreads();
}

__device__ __forceinline__ float rope_apply(float v, const f32x2 cs, int lane) {
    const float partner = __shfl_xor(v, 32);
    return lane < 32 ? v * cs.x - partner * cs.y : partner * cs.y + v * cs.x;
}
__device__ __forceinline__ void head8_load(const bf16_t* p, float (&v)[8]) {
    const u32x4 q = *(const u32x4*)p;
    v[0] = bf_lo(q.x); v[1] = bf_hi(q.x); v[2] = bf_lo(q.y); v[3] = bf_hi(q.y); v[4] = bf_lo(q.z); v[5] = bf_hi(q.z); v[6] = bf_lo(q.w); v[7] = bf_hi(q.w);
}
__device__ __forceinline__ void head8_store(bf16_t* p, const float (&v)[8], const float sc) {
    u32x4 q; q.x = pk2(v[0] * sc, v[1] * sc); q.y = pk2(v[2] * sc, v[3] * sc); q.z = pk2(v[4] * sc, v[5] * sc); q.w = pk2(v[6] * sc, v[7] * sc);
    *(u32x4*)p = q;
}
__device__ __forceinline__ void head8_norm(float (&v)[8], const float (&g)[8]) {
    float ss = 0.f;
#pragma unroll
    for (int j = 0; j < 8; ++j) ss += v[j] * v[j];
    ss += __shfl_xor(ss, 1); ss += __shfl_xor(ss, 2); ss += __shfl_xor(ss, 4);
    const float r = 1.0f / sqrtf(ss * (1.f / 64.f) + 1e-6f);
#pragma unroll
    for (int j = 0; j < 8; ++j) v[j] = v[j] * r * g[j];
}
__device__ __forceinline__ void head8_rope(float (&v)[8], const f32x2 (&cs)[8], const bool upper) {
#pragma unroll
    for (int j = 0; j < 8; ++j) { const float partner = __shfl_xor(v[j], 4); v[j] = upper ? partner * cs[j].y + v[j] * cs[j].x : v[j] * cs[j].x - partner * cs[j].y; }
}
__device__ __forceinline__ void p_l0_prep(const Frame& F, const Args& a, unsigned char* ws) {
    const bf16_t* P = (const bf16_t*)(ws + WS_PROJ);
    const f32x2* rope = (const f32x2*)(ws + WS_ROPE);
    bf16_t* QA = (bf16_t*)(ws + L0_QA); bf16_t* IQ = (bf16_t*)(ws + L0_IQ); bf16_t* KA = (bf16_t*)(ws + L0_KA); bf16_t* VAT = (bf16_t*)(ws + L0_VAT);
    bf16_t* IK = (bf16_t*)(ws + L0_IK); float* IW = (float*)(ws + L0_IW); bf16_t* UA = (bf16_t*)(ws + L0_UA);
    const int gw = F.bid * NWAVES + F.wave, NGW = F.G * NWAVES, lane = F.lane, hs = lane >> 3, sub = lane & 7;
    float qg[8], kg[8];
#pragma unroll
    for (int j = 0; j < 8; ++j) { qg[j] = a.in[I_L0_QG][sub * 8 + j]; kg[j] = a.in[I_L0_KG][sub * 8 + j]; }
    for (int m = gw; m < T; m += NGW) {
        const int b = m >> 12, t = m & 4095;
        const bf16_t* row = P + (size_t)m * N_IN0;
        f32x2 cs[8];
#pragma unroll
        for (int j = 0; j < 4; ++j) { const f32x4 c4 = *(const f32x4*)(rope + t * 32 + (sub & 3) * 8 + 2 * j); cs[2 * j] = (f32x2){c4.x, c4.y}; cs[2 * j + 1] = (f32x2){c4.z, c4.w}; }
        float v[8];
        head8_load(row + C0_Q + lane * 8, v); head8_norm(v, qg); head8_rope(v, cs, sub >= 4); head8_store(QA + (size_t)m * 512 + lane * 8, v, 0.125f);
        head8_load(row + C0_IQ + lane * 8, v); head8_rope(v, cs, sub >= 4); head8_store(IQ + (size_t)m * 512 + lane * 8, v, 0.125f);
        {
            const int hh = hs < 3 ? hs : 2;
            head8_load(row + (hh < 2 ? C0_K + hh * 64 : C0_IK) + sub * 8, v);
            float vn[8];
#pragma unroll
            for (int j = 0; j < 8; ++j) vn[j] = v[j];
            head8_norm(vn, kg);
#pragma unroll
            for (int j = 0; j < 8; ++j) v[j] = (hh < 2) ? vn[j] : v[j];
            head8_rope(v, cs, sub >= 4);
            if (hs < 2) head8_store(KA + ((size_t)(b * 2 + hs) * 4096 + t) * 64 + sub * 8, v, 1.0f);
            else if (hs == 2) head8_store(IK + (size_t)m * 64 + sub * 8, v, 1.0f);
        }
        if (lane < 8) IW[(size_t)m * 8 + lane] = bf2f(row[C0_IW + lane]) * 0.35355339059327373f;
        { const u32x4 uv = *(const u32x4*)(row + C0_U + lane * 8); const int g = lane >> 1;
          *(u32x4*)(UA + ((size_t)g * 2048 + (m >> 4)) * 384 + (m & 15) * 16 + (lane & 1) * 8) = uv; }
    }
    for (int it = gw; it < NB * 2 * 64; it += NGW) {
        const int tb = it & 63, g = (it >> 6) & 1, b = it >> 7;
        const size_t m = (size_t)b * 4096 + tb * 64 + lane;
        unsigned r[32];
#pragma unroll
        for (int j = 0; j < 8; ++j) { const u32x4 q = *(const u32x4*)(P + m * N_IN0 + C0_V + g * 64 + j * 8); r[4 * j] = q.x; r[4 * j + 1] = q.y; r[4 * j + 2] = q.z; r[4 * j + 3] = q.w; }
        bf16_t* dst = VAT + ((size_t)(b * 2 + g) * 64) * 4096 + tb * 64 + lane;
#pragma unroll
        for (int d = 0; d < 64; ++d) dst[(size_t)d * 4096] = (bf16_t)((d & 1) ? (r[d >> 1] >> 16) : (r[d >> 1] & 0xffffu));
    }
}

__device__ __forceinline__ unsigned f16key(unsigned raw) { return (raw & 0x8000u) ? (~raw & 0xFFFFu) : (raw | 0x8000u); }
template <int NREG>
__device__ __forceinline__ int topk_count_ge(const unsigned (&kk)[NREG], const unsigned cm1pk) {
    unsigned acc = 0u; const unsigned ones = 0x00010001u;
#pragma unroll
    for (int jj = 0; jj < NREG; ++jj) {
        unsigned d;
        asm("v_pk_sub_u16 %0, %1, %2 clamp" : "=v"(d) : "v"(kk[jj]), "v"(cm1pk));
        asm("v_pk_min_u16 %0, %1, %2" : "=v"(d) : "v"(d), "v"(ones));
        asm("v_pk_add_u16 %0, %1, %2" : "=v"(acc) : "v"(acc), "v"(d));
    }
    int c = (int)((acc & 0xffffu) + (acc >> 16));
    c += __builtin_amdgcn_update_dpp(0, c, 0xB1, 0xF, 0xF, true);
    c += __builtin_amdgcn_update_dpp(0, c, 0x4E, 0xF, 0xF, true);
    c += __builtin_amdgcn_update_dpp(0, c, 0x141, 0xF, 0xF, true);
    c += __builtin_amdgcn_update_dpp(0, c, 0x140, 0xF, 0xF, true);
    return __builtin_amdgcn_readlane(c, 0) + __builtin_amdgcn_readlane(c, 16) + __builtin_amdgcn_readlane(c, 32) + __builtin_amdgcn_readlane(c, 48);
}
template <int NREG>
__device__ __forceinline__ u64 topk_query(const LAS unsigned short* scq, const int t, const int lane) {
    unsigned kk[NREG];
#pragma unroll
    for (int jj = 0; jj < NREG; ++jj) {
        const int e0 = (2 * jj) * 64 + lane, e1 = e0 + 64;
        const unsigned r0 = scq[e0], r1 = scq[e1];
        kk[jj] = ((e0 <= t) ? f16key(r0) : 0u) | (((e1 <= t) ? f16key(r1) : 0u) << 16);
        if ((jj & 3) == 3) __builtin_amdgcn_sched_barrier(0);
    }
    unsigned prefix = 0u; bool exact = false;
#pragma unroll 1
    for (int bit = 15; bit >= 0; --bit) {
        const unsigned cand = prefix | (1u << bit), cm1 = cand - 1u;
        const int cnt = topk_count_ge<NREG>(kk, cm1 | (cm1 << 16));
        if (cnt >= 256) prefix = cand;
        if (cnt == 256) { exact = true; break; }
    }
    unsigned mylo = 0u, myhi = 0u;
    if (exact) {
#pragma unroll
        for (int i = 0; i < 2 * NREG; ++i) {
            const unsigned k = (i & 1) ? (kk[i >> 1] >> 16) : (kk[i >> 1] & 0xffffu);
            const u64 w = __ballot(k >= prefix);
            asm("s_nop 4\n\tv_writelane_b32 %0, %2, %4\n\tv_writelane_b32 %1, %3, %4" : "+v"(mylo), "+v"(myhi) : "s"((unsigned)w), "s"((unsigned)(w >> 32)), "n"(i));
        }
    } else {
        const unsigned Tk = prefix;
        const int cgt = (Tk >= 0xFFFFu) ? 0 : topk_count_ge<NREG>(kk, Tk | (Tk << 16));
        const int need = 256 - cgt;
        int run = 0;
#pragma unroll
        for (int i = 0; i < 2 * NREG; ++i) {
            const unsigned k = (i & 1) ? (kk[i >> 1] >> 16) : (kk[i >> 1] & 0xffffu);
            const u64 gt = __ballot(k > Tk); u64 eq = __ballot(k == Tk);
            const int pe = __builtin_popcountll(eq);
            if (run + pe > need) { int kq = need - run; kq = kq < 0 ? 0 : kq;
                const bool keep = ((eq >> lane) & 1ull) && (__builtin_popcountll(eq & ((1ull << lane) - 1ull)) < kq); eq = __ballot(keep); }
            run += pe;
            const u64 w = gt | eq;
            asm("s_nop 4\n\tv_writelane_b32 %0, %2, %4\n\tv_writelane_b32 %1, %3, %4" : "+v"(mylo), "+v"(myhi) : "s"((unsigned)w), "s"((unsigned)(w >> 32)), "n"(i));
        }
    }
    return (u64)mylo | ((u64)myhi << 32);
}
__device__ __forceinline__ void p_dsa_index(const Frame& F, unsigned char* ws, u64* SELT, const int mode) {
    const bf16_t* IQ = (const bf16_t*)(ws + L0_IQ); const bf16_t* IK = (const bf16_t*)(ws + L0_IK); const float* IW = (const float*)(ws + L0_IW);
    LAS _Float16* sc = (LAS _Float16*)F.lds;
    LAS unsigned short* scu = (LAS unsigned short*)F.lds;
    LAS u64* mk = (LAS u64*)(F.lds + 131072);
    LAS float* wl = (LAS float*)(F.lds + 131072 + 8192);
    const int lane = F.lane, wave = F.wave, h = lane >> 5, r = lane & 31;
    const int rq = ((r >> 4) & 1) + 2 * ((r >> 2) & 1), rh = 4 * ((r >> 3) & 1) + (r & 3);
    for (int u = F.bid; u < 2048; u += F.G) {
        const int idx = u & 255, b = u >> 8;
        const int j = (b & 1) ? 255 - idx : idx;
        const int t0 = j * 16; const size_t mb = (size_t)b * 4096;
        if (F.tid < 128) wl[F.tid] = IW[(mb + t0) * 8 + F.tid];
        const int nkb = (t0 + 15) / 32 + 1;
        bf16x8 Af[4][4];
#pragma unroll
        for (int rt = 0; rt < 4; ++rt)
#pragma unroll
            for (int ks = 0; ks < 4; ++ks) Af[rt][ks] = *(const bf16x8*)(IQ + (mb + t0 + 4 * rt + rq) * 512 + rh * 64 + ks * 16 + 8 * h);
        __syncthreads();
        if (mode != 2) for (int kb = wave; kb < nkb; kb += NWAVES) {
            bf16x8 Bf[4];
#pragma unroll
            for (int ks = 0; ks < 4; ++ks) Bf[ks] = *(const bf16x8*)(IK + (mb + kb * 32 + r) * 64 + ks * 16 + 8 * h);
#pragma unroll
            for (int rt = 0; rt < 4; ++rt) {
                f32x16 acc = {0.f, 0.f, 0.f, 0.f, 0.f, 0.f, 0.f, 0.f, 0.f, 0.f, 0.f, 0.f, 0.f, 0.f, 0.f, 0.f};
#pragma unroll
                for (int ks = 0; ks < 4; ++ks) acc = __builtin_amdgcn_mfma_f32_32x32x16_bf16(Af[rt][ks], Bf[ks], acc, 0, 0, 0);
                const int qa = 4 * rt + 2 * h;
                const f32x4 wa0 = *(const LAS f32x4*)(wl + qa * 8), wa1 = *(const LAS f32x4*)(wl + qa * 8 + 4), wb0 = *(const LAS f32x4*)(wl + qa * 8 + 8), wb1 = *(const LAS f32x4*)(wl + qa * 8 + 12);
                float sa = 0.f, sb = 0.f;
#pragma unroll
                for (int i = 0; i < 4; ++i) { sa += wa0[i] * fmaxf(acc[i], 0.f); sa += wa1[i] * fmaxf(acc[4 + i], 0.f); sb += wb0[i] * fmaxf(acc[8 + i], 0.f); sb += wb1[i] * fmaxf(acc[12 + i], 0.f); }
                sc[qa * 4096 + kb * 32 + r] = (_Float16)sa;
                sc[(qa + 1) * 4096 + kb * 32 + r] = (_Float16)sb;
                __builtin_amdgcn_sched_barrier(0);
            }
        }
        __syncthreads();
#pragma unroll 1
        for (int qq = 0; qq < (mode == 1 ? 0 : 2); ++qq) {
            const int q = wave * 2 + qq, t = t0 + q, n = t + 1;
            unsigned mylo = 0u, myhi = 0u;
            if (n <= 256) {
                const int base = lane * 64;
                const u64 word = (base + 63 <= t) ? ~0ull : (base > t ? 0ull : ((1ull << (t - base + 1)) - 1ull));
                mylo = (unsigned)word; myhi = (unsigned)(word >> 32);
            } else {
                const int nreg = (((n + 63) >> 6) + 1) >> 1;
                const LAS unsigned short* scq = scu + q * 4096;
                u64 w;
                if (nreg <= 4) w = topk_query<4>(scq, t, lane);
                else if (nreg <= 8) w = topk_query<8>(scq, t, lane);
                else if (nreg <= 12) w = topk_query<12>(scq, t, lane);
                else if (nreg <= 16) w = topk_query<16>(scq, t, lane);
                else if (nreg <= 20) w = topk_query<20>(scq, t, lane);
                else if (nreg <= 24) w = topk_query<24>(scq, t, lane);
                else if (nreg <= 28) w = topk_query<28>(scq, t, lane);
                else w = topk_query<32>(scq, t, lane);
                mylo = (unsigned)w; myhi = (unsigned)(w >> 32);
            }
            mk[lane * 16 + q] = (u64)mylo | ((u64)myhi << 32);
        }
        __syncthreads();
        { const int w = F.tid >> 3, part = F.tid & 7;
          u64* dst = SELT + ((size_t)(b * 64 + w) * 4096) + t0 + part * 2;
          dst[0] = mk[w * 16 + part * 2]; dst[1] = mk[w * 16 + part * 2 + 1]; }
        __syncthreads();
    }
}

constexpr int AT_KB = 9216, AT_VB = 8704, AT_BUF = AT_KB + AT_VB;
struct AttStage { u32x4 kreg, vreg; };
__device__ __forceinline__ void att_load(AttStage& s, const bf16_t* Kg, const bf16_t* Vtg, int key0, int tid) {
    s.kreg = *(const u32x4*)(Kg + (size_t)(key0 + (tid >> 3)) * 64 + (tid & 7) * 8);
    s.vreg = *(const u32x4*)(Vtg + (size_t)(tid >> 3) * 4096 + key0 + (tid & 7) * 8);
}
__device__ __forceinline__ void att_store(const AttStage& s, LAS unsigned char* buf, int tid) {
    *(LAS u32x4*)(buf + (tid >> 3) * 144 + (tid & 7) * 16) = s.kreg;
    LAS unsigned char* v = buf + AT_KB + (tid >> 3) * 136 + (tid & 7) * 16;
    *(LAS u32x2*)(v) = (u32x2){s.vreg.x, s.vreg.y}; *(LAS u32x2*)(v + 8) = (u32x2){s.vreg.z, s.vreg.w};
}
__device__ __forceinline__ bf16x8 pack8(float a0, float a1, float a2, float a3, float a4, float a5, float a6, float a7) {
    u32x4 w; w.x = pg8::cvt_pk_bf16(a0, a1); w.y = pg8::cvt_pk_bf16(a2, a3); w.z = pg8::cvt_pk_bf16(a4, a5); w.w = pg8::cvt_pk_bf16(a6, a7);
    return __builtin_bit_cast(bf16x8, w);
}
__device__ __forceinline__ f32x16 att_qk(const LAS unsigned char* buf, int sub, const bf16x8 (&Qf)[4], int lane) {
    f32x16 S = {0.f, 0.f, 0.f, 0.f, 0.f, 0.f, 0.f, 0.f, 0.f, 0.f, 0.f, 0.f, 0.f, 0.f, 0.f, 0.f};
    const LAS unsigned char* kp = buf + (sub * 32 + (lane & 31)) * 144 + (lane >> 5) * 16;
#pragma unroll
    for (int ks = 0; ks < 4; ++ks) { const bf16x8 kf = *(const LAS bf16x8*)(kp + ks * 32); S = __builtin_amdgcn_mfma_f32_32x32x16_bf16(kf, Qf[ks], S, 0, 0, 0); }
    return S;
}
__device__ __forceinline__ void att_pv2(const LAS unsigned char* buf, int sub, const bf16x8 P0, const bf16x8 P1, f32x16 (&O)[2], int lane) {
    const int h = lane >> 5;
#pragma unroll
    for (int dt = 0; dt < 2; ++dt) {
        const LAS unsigned char* vp = buf + AT_KB + (dt * 32 + (lane & 31)) * 136 + (sub * 32 + 4 * h) * 2;
        const u32x2 a0 = *(const LAS u32x2*)(vp), a1 = *(const LAS u32x2*)(vp + 16), b0 = *(const LAS u32x2*)(vp + 32), b1 = *(const LAS u32x2*)(vp + 48);
        const bf16x8 V0 = __builtin_bit_cast(bf16x8, ((u32x4){a0.x, a0.y, a1.x, a1.y}));
        const bf16x8 V1 = __builtin_bit_cast(bf16x8, ((u32x4){b0.x, b0.y, b1.x, b1.y}));
        O[dt] = __builtin_amdgcn_mfma_f32_32x32x16_bf16(V0, P0, O[dt], 0, 0, 0);
        O[dt] = __builtin_amdgcn_mfma_f32_32x32x16_bf16(V1, P1, O[dt], 0, 0, 0);
    }
}
__device__ __forceinline__ void att_pv(const LAS unsigned char* buf, int sub, const float (&p)[16], f32x16 (&O)[2], int lane) {
    const bf16x8 P0 = pack8(p[0], p[1], p[2], p[3], p[4], p[5], p[6], p[7]);
    const bf16x8 P1 = pack8(p[8], p[9], p[10], p[11], p[12], p[13], p[14], p[15]);
    att_pv2(buf, sub, P0, P1, O, lane);
}

__device__ __forceinline__ void att_kfrags(const LAS unsigned char* buf, int sub, bf16x8 (&Kf)[4], int lane) {
    const LAS unsigned char* kp = buf + (sub * 32 + (lane & 31)) * 144 + (lane >> 5) * 16;
#pragma unroll
    for (int ks = 0; ks < 4; ++ks) Kf[ks] = *(const LAS bf16x8*)(kp + ks * 32);
}
__device__ __forceinline__ void att_vfrags(const LAS unsigned char* buf, int sub, bf16x8 (&Vf)[2][2], int lane) {
    const int h = lane >> 5;
#pragma unroll
    for (int dt = 0; dt < 2; ++dt) {
        const LAS unsigned char* vp = buf + AT_KB + (dt * 32 + (lane & 31)) * 136 + (sub * 32 + 4 * h) * 2;
        const u32x2 a0 = *(const LAS u32x2*)(vp), a1 = *(const LAS u32x2*)(vp + 16), b0 = *(const LAS u32x2*)(vp + 32), b1 = *(const LAS u32x2*)(vp + 48);
        Vf[dt][0] = __builtin_bit_cast(bf16x8, ((u32x4){a0.x, a0.y, a1.x, a1.y}));
        Vf[dt][1] = __builtin_bit_cast(bf16x8, ((u32x4){b0.x, b0.y, b1.x, b1.y}));
    }
}
__device__ __forceinline__ f32x16 att_qk_f(const bf16x8 (&Kf)[4], const bf16x8 (&Qf)[4]) {
    f32x16 S = {0.f, 0.f, 0.f, 0.f, 0.f, 0.f, 0.f, 0.f, 0.f, 0.f, 0.f, 0.f, 0.f, 0.f, 0.f, 0.f};
#pragma unroll
    for (int ks = 0; ks < 4; ++ks) S = __builtin_amdgcn_mfma_f32_32x32x16_bf16(Kf[ks], Qf[ks], S, 0, 0, 0);
    return S;
}
__device__ __forceinline__ void att_pv_f(const bf16x8 (&Vf)[2][2], const bf16x8 P0, const bf16x8 P1, f32x16 (&O)[2]) {
#pragma unroll
    for (int dt = 0; dt < 2; ++dt) { O[dt] = __builtin_amdgcn_mfma_f32_32x32x16_bf16(Vf[dt][0], P0, O[dt], 0, 0, 0); O[dt] = __builtin_amdgcn_mfma_f32_32x32x16_bf16(Vf[dt][1], P1, O[dt], 0, 0, 0); }
}

__device__ __forceinline__ void p_dsa_attn(const Frame& F, const Args& a, unsigned char* ws) {
    const bf16_t* QA = (const bf16_t*)(ws + L0_QA); const bf16_t* KA = (const bf16_t*)(ws + L0_KA); const bf16_t* VAT = (const bf16_t*)(ws + L0_VAT);
    const u64* SELT = (const u64*)(ws + L0_SELT); bf16_t* CAT = (bf16_t*)(ws + L0_CAT);
    const int lane = F.lane, wave = F.wave, h = lane >> 5, c = lane & 31, tid = F.tid;
    float mq = 0.f, mk_ = 0.f;
    for (int i = 0; i < 64; ++i) { mq = fmaxf(mq, fabsf(a.in[I_L0_QG][i])); mk_ = fmaxf(mk_, fabsf(a.in[I_L0_KG][i])); }
    const float c2 = (8.0f * mq * mk_ + 0.5f) * 1.4426950408889634f, c1 = 1.4426950408889634f;
    for (int u = F.bid; u < 512; u += F.G) {
        const int idx = u & 255, g = u >> 8, b = idx >> 5, qtr = idx & 31, qt = g ? 31 - qtr : qtr, q0 = qt * 128;
        const size_t mb = (size_t)b * 4096;
        const bf16_t* Kg = KA + (size_t)(b * 2 + g) * 4096 * 64; const bf16_t* Vtg = VAT + (size_t)(b * 2 + g) * 64 * 4096;
        bf16x8 Qf[2][4]; int qidx[2];
#pragma unroll
        for (int ct = 0; ct < 2; ++ct) { qidx[ct] = q0 + wave * 16 + ct * 8 + (c >> 2);
#pragma unroll
            for (int ks = 0; ks < 4; ++ks) Qf[ct][ks] = *(const bf16x8*)(QA + (mb + qidx[ct]) * 512 + (g * 4 + (c & 3)) * 64 + ks * 16 + 8 * h); }
        f32x16 O[2][2]; float l[2] = {0.f, 0.f};
#pragma unroll
        for (int ct = 0; ct < 2; ++ct)
#pragma unroll
            for (int dt = 0; dt < 2; ++dt)
#pragma unroll
                for (int i = 0; i < 16; ++i) O[ct][dt][i] = 0.f;
        const int nkt = 2 * qt + 2;
        AttStage st; att_load(st, Kg, Vtg, 0, tid);
        __syncthreads();
        att_store(st, F.lds, tid);
        __syncthreads();
        for (int kt = 0; kt < nkt; ++kt) {
            LAS unsigned char* buf = F.lds + (kt & 1) * AT_BUF;
            if (kt + 1 < nkt) att_load(st, Kg, Vtg, (kt + 1) * 64, tid);
            u64 mw[2];
#pragma unroll
            for (int ct = 0; ct < 2; ++ct) mw[ct] = SELT[(size_t)(b * 64 + kt) * 4096 + qidx[ct]];
#pragma unroll 1
            for (int sub = 0; sub < 2; ++sub) {
                bf16x8 Kf[4], Vf[2][2];
                att_kfrags(buf, sub, Kf, lane); att_vfrags(buf, sub, Vf, lane);
#pragma unroll
                for (int ct = 0; ct < 2; ++ct) {
                    __builtin_amdgcn_sched_barrier(0);
                    const f32x16 S = att_qk_f(Kf, Qf[ct]);
                    const unsigned mbits = (unsigned)(mw[ct] >> (sub * 32 + 4 * h));
                    float p[16];
#pragma unroll
                    for (int i = 0; i < 16; ++i) {
                        const float e = __builtin_amdgcn_exp2f(S[i] * c1 - c2);
                        const int bitpos = (i & 3) + 8 * (i >> 2);
                        p[i] = __builtin_bit_cast(float, __builtin_bit_cast(int, e) & __builtin_amdgcn_sbfe((int)mbits, bitpos, 1));
                        l[ct] += p[i];
                    }
                    att_pv_f(Vf, pack8(p[0], p[1], p[2], p[3], p[4], p[5], p[6], p[7]), pack8(p[8], p[9], p[10], p[11], p[12], p[13], p[14], p[15]), O[ct]);
                }
            }
            if (kt + 1 < nkt) att_store(st, F.lds + ((kt + 1) & 1) * AT_BUF, tid);
            __syncthreads();
        }
#pragma unroll
        for (int ct = 0; ct < 2; ++ct) {
            const float lt = l[ct] + __shfl_xor(l[ct], 32);
            const float inv = 1.0f / fmaxf(lt, 1e-30f);
            bf16_t* orow = CAT + (mb + qidx[ct]) * 1024 + (g * 4 + (c & 3)) * 64;
#pragma unroll
            for (int dt = 0; dt < 2; ++dt)
#pragma unroll
                for (int i4 = 0; i4 < 4; ++i4) {
                    const int d = dt * 32 + 8 * i4 + 4 * h;
                    u32x2 w; w.x = pk2(O[ct][dt][4 * i4] * inv, O[ct][dt][4 * i4 + 1] * inv); w.y = pk2(O[ct][dt][4 * i4 + 2] * inv, O[ct][dt][4 * i4 + 3] * inv);
                    *(u32x2*)(orow + d) = w;
                }
        }
    }
}

__device__ __forceinline__ void p_s5_scan(const Frame& F, const Args& a, unsigned char* ws) {
    const float* SLOC = (const float*)(ws + L0_SLOC); bf16_t* UA = (bf16_t*)(ws + L0_UA);
    const int p = F.lane;
    if (F.wave == 0) for (int it = F.bid; it < 32 * NB; it += F.G) {
        const int g = it >> 3, b = it & 7;
        const float dt = expf(a.in[I_L0_LOGDT][g]);
        const float lr = a.in[I_L0_ARE][g * 64 + p], li = a.in[I_L0_AIM][g * 64 + p];
        const float mag = expf(16.0f * dt * lr); float s, c; sincosf(16.0f * dt * li, &s, &c);
        const float ar = mag * c, ai = mag * s;
        float hr = 0.f, hi = 0.f;
        const float* sl = SLOC + ((size_t)g * 2048 + b * 256) * 128;
        bf16_t* ua = UA + ((size_t)g * 2048 + b * 256) * 384 + 256;
        for (int ch = 0; ch < 256; ++ch) {
            ua[(size_t)ch * 384 + p] = (bf16_t)f2bf(hr); ua[(size_t)ch * 384 + 64 + p] = (bf16_t)f2bf(hi);
            const float xr = sl[(size_t)ch * 128 + p], xi = sl[(size_t)ch * 128 + 64 + p];
            const float nr = ar * hr - ai * hi + xr, ni = ar * hi + ai * hr + xi;
            hr = nr; hi = ni;
        }
    }
}
namespace pg8 {
struct EpiS5State {
    static constexpr bool PERM = false;
    float* C;
    __device__ __forceinline__ void operator()(const f32x4 (&acc)[2][2][4][2], const Unit& u, int wr, int wc, int fr, int fq) const {
        const int row0 = u.pm * BM + wr * 64 + fr, col0 = wc * 32 + 4 * fq;
#pragma unroll
        for (int ai = 0; ai < 2; ++ai)
#pragma unroll
            for (int m = 0; m < 4; ++m)
#pragma unroll
                for (int n = 0; n < 2; ++n) *(f32x4*)(C + (size_t)(row0 + ai * HALF + m * 16) * 128 + col0 + n * 16) = acc[ai][0][m][n];
    }
};
struct EpiS5Out {
    static constexpr bool PERM = false;
    bf16_t* YB;
    __device__ __forceinline__ void operator()(const f32x4 (&acc)[2][2][4][2], const Unit& u, int wr, int wc, int fr, int fq) const {
        const int g = u.pn;
        const int row0 = u.pm * BM + wr * 64 + fr - g * 2048;
        const int col0 = wc * 32 + 4 * fq;
#pragma unroll
        for (int ai = 0; ai < 2; ++ai)
#pragma unroll
            for (int m = 0; m < 4; ++m) { const int chunk = row0 + ai * HALF + m * 16;
#pragma unroll
                for (int bj = 0; bj < 2; ++bj)
#pragma unroll
                    for (int n = 0; n < 2; ++n) { const int col = col0 + bj * HALF + n * 16, i = col >> 4, co = col & 15;
                        const f32x4 v = acc[ai][bj][m][n];
                        u32x2 w; w.x = pk2(gelu_tanh(v[0]), gelu_tanh(v[1])); w.y = pk2(gelu_tanh(v[2]), gelu_tanh(v[3]));
                        *(u32x2*)(YB + ((size_t)chunk * 16 + i) * 512 + g * 16 + co) = w; }
                asm volatile("" ::: "memory"); __builtin_amdgcn_sched_barrier(0); }
    }
};
struct EpiGlu {
    static constexpr bool PERM = true;
    const bf16_t* YB; const float* bias; bf16_t* CAT;
    __device__ __forceinline__ void operator()(const f32x4 (&acc)[2][2][4][2], const Unit& u, int wr, int wc, int fr, int fq) const {
        const int row0 = u.pm * BM + wr * 64 + fr, col0 = u.pn * BM + wc * 32 + 8 * fq;
#pragma unroll
        for (int ai = 0; ai < 2; ++ai)
#pragma unroll
            for (int m = 0; m < 4; ++m) { const size_t row = row0 + ai * HALF + m * 16;
#pragma unroll
                for (int bj = 0; bj < 2; ++bj) { const int col = col0 + bj * HALF;
                    const u32x4 yv = *(const u32x4*)(YB + row * 512 + col);
                    const f32x4 b0 = *(const f32x4*)(bias + col), b1 = *(const f32x4*)(bias + col + 4);
                    const f32x4 z0 = acc[ai][bj][m][0] + b0, z1 = acc[ai][bj][m][1] + b1;
                    u32x4 w;
                    w.x = pk2(bf_lo(yv.x) * sigmoidf_(z0[0]), bf_hi(yv.x) * sigmoidf_(z0[1])); w.y = pk2(bf_lo(yv.y) * sigmoidf_(z0[2]), bf_hi(yv.y) * sigmoidf_(z0[3]));
                    w.z = pk2(bf_lo(yv.z) * sigmoidf_(z1[0]), bf_hi(yv.z) * sigmoidf_(z1[1])); w.w = pk2(bf_lo(yv.w) * sigmoidf_(z1[2]), bf_hi(yv.w) * sigmoidf_(z1[3]));
                    *(u32x4*)(CAT + row * 1024 + 512 + col) = w; }
                asm volatile("" ::: "memory"); __builtin_amdgcn_sched_barrier(0); }
    }
};
}
__device__ __forceinline__ void peer_fold_wq(const Frame& F, const float* wq, const float* sk, bf16_t* WT) {
    const int gw = F.bid * NWAVES + F.wave, NGW = F.G * NWAVES, lane = F.lane, r = lane & 31, h = lane >> 5;
    for (int it = gw; it < 16 * 4 * 32; it += NGW) {
        const int dt = it & 31, kt = (it >> 5) & 3, hp = it >> 7;
        f32x16 acc = {0.f, 0.f, 0.f, 0.f, 0.f, 0.f, 0.f, 0.f, 0.f, 0.f, 0.f, 0.f, 0.f, 0.f, 0.f, 0.f};
        const float* ap = sk + ((size_t)hp * 128 + 32 * kt + r) * 128 + 8 * h;
        const float* bp = wq + (size_t)(32 * dt + r) * 2048 + hp * 128 + 8 * h;
#pragma unroll
        for (int ks = 0; ks < 8; ++ks) {
            const f32x4 a0 = *(const f32x4*)(ap + 16 * ks), a1 = *(const f32x4*)(ap + 16 * ks + 4), b0 = *(const f32x4*)(bp + 16 * ks), b1 = *(const f32x4*)(bp + 16 * ks + 4);
            acc = __builtin_amdgcn_mfma_f32_32x32x16_bf16(pack8(a0[0], a0[1], a0[2], a0[3], a1[0], a1[1], a1[2], a1[3]), pack8(b0[0], b0[1], b0[2], b0[3], b1[0], b1[1], b1[2], b1[3]), acc, 0, 0, 0);
        }
#pragma unroll
        for (int i = 0; i < 16; ++i) WT[((size_t)hp * 128 + 32 * kt + (i & 3) + 8 * (i >> 2) + 4 * h) * 1024 + 32 * dt + r] = (bf16_t)f2bf(acc[i]);
    }
}
__device__ __forceinline__ unsigned mono_u32(float f) { const unsigned u = __builtin_bit_cast(unsigned, f); return u ^ ((u >> 31) ? 0xFFFFFFFFu : 0x80000000u); }
#define CE_DESC(x, y) do { const unsigned _hi = (x) > (y) ? (x) : (y), _lo = (x) > (y) ? (y) : (x); (x) = _hi; (y) = _lo; } while (0)
__device__ __forceinline__ void sort16_desc(unsigned (&a)[16]) {
#pragma unroll
    for (int k = 2; k <= 16; k <<= 1)
#pragma unroll
        for (int j = k >> 1; j > 0; j >>= 1)
#pragma unroll
            for (int i = 0; i < 16; ++i) { const int l = i ^ j; if (l > i) { if ((i & k) == 0) CE_DESC(a[i], a[l]); else CE_DESC(a[l], a[i]); } }
}
__device__ __forceinline__ void merge16_desc(unsigned (&a)[16], const unsigned (&b)[16]) {
#pragma unroll
    for (int i = 0; i < 16; ++i) a[i] = a[i] > b[15 - i] ? a[i] : b[15 - i];
#pragma unroll
    for (int j = 8; j > 0; j >>= 1)
#pragma unroll
        for (int i = 0; i < 16; ++i) { const int l = i ^ j; if (l > i) CE_DESC(a[i], a[l]); }
}
__device__ __forceinline__ void merge16_xlane(unsigned (&a)[16]) {
    unsigned b[16];
#pragma unroll
    for (int i = 0; i < 16; ++i) b[i] = (unsigned)__shfl_xor((int)a[i], 32);
    merge16_desc(a, b);
}
struct PeerCand { int a[50], b[50]; };
__host__ __device__ constexpr PeerCand peer_cands() { PeerCand c{}; int n = 0; for (int a = 0; a < 16; ++a) for (int b = 0; b < 16; ++b) if ((a + 1) * (b + 1) <= 16) { c.a[n] = a; c.b[n] = b; ++n; } return c; }
__device__ __forceinline__ void p_peer_route(const Frame& F, unsigned char* ws) {
    const _Float16* S16 = (const _Float16*)(ws + PE_Q2); unsigned short* EID = (unsigned short*)(ws + PE_EID); float* GATE = (float*)(ws + PE_GATE);
    LAS float* sc0 = (LAS float*)F.lds;
    const int lane = F.lane, wave = F.wave, h5 = lane >> 5, r = lane & 31, tid = F.tid;
    constexpr PeerCand PC = peer_cands();
    u32x4 pre[8];
    { const int u = F.bid; if (u < 2048) { const int hd = u & 7, mt = u >> 3;
#pragma unroll
        for (int q = 0; q < 8; ++q) pre[q] = *(const u32x4*)(S16 + ((size_t)mt * 128 + (q & 3) * 32 + (tid >> 4)) * 2048 + (hd * 2 + (q >> 2)) * 128 + (tid & 15) * 8); } }
    for (int u = F.bid; u < 2048; u += F.G) {
        const int hd = u & 7, mt = u >> 3; const size_t m0 = (size_t)mt * 128;
#pragma unroll
        for (int q = 0; q < 8; ++q) {
            LAS float* dst = sc0 + (q >> 2) * 128 * 129 + ((q & 3) * 32 + (tid >> 4)) * 129 + (tid & 15) * 8;
            const u32x4 v = pre[q];
#pragma unroll
            for (int j = 0; j < 4; ++j) { const unsigned w = v[j]; dst[2 * j] = (float)__builtin_bit_cast(_Float16, (unsigned short)(w & 0xffffu)); dst[2 * j + 1] = (float)__builtin_bit_cast(_Float16, (unsigned short)(w >> 16)); }
        }
        { const int un = u + F.G; if (un < 2048) { const int hdn = un & 7, mtn = un >> 3;
#pragma unroll
            for (int q = 0; q < 8; ++q) pre[q] = *(const u32x4*)(S16 + ((size_t)mtn * 128 + (q & 3) * 32 + (tid >> 4)) * 2048 + (hdn * 2 + (q >> 2)) * 128 + (tid & 15) * 8); } }
        __syncthreads();
        {
            const int pp = wave >> 2, row = (wave & 3) * 32 + r, half = h5; LAS float* rowp = sc0 + pp * 128 * 129 + row * 129;
            unsigned top[16];
#pragma unroll
            for (int blk = 0; blk < 4; ++blk) {
                unsigned k16[16];
#pragma unroll
                for (int i = 0; i < 16; ++i) { const int j = half * 64 + blk * 16 + i; k16[i] = (mono_u32(rowp[j]) & ~0x7Fu) | (unsigned)(127 - j); }
                sort16_desc(k16);
                if (blk == 0) {
#pragma unroll
                    for (int i = 0; i < 16; ++i) top[i] = k16[i];
                } else merge16_desc(top, k16);
            }
            merge16_xlane(top);
            float vals[16]; int ids[16];
#pragma unroll
            for (int k = 0; k < 16; ++k) { ids[k] = 127 - (int)(top[k] & 127u); vals[k] = rowp[ids[k]]; }
            if (half == 0) {
#pragma unroll
                for (int k = 0; k < 16; ++k) { rowp[k] = vals[k]; rowp[16 + k] = __int_as_float(ids[k]); }
            }
        }
        __syncthreads();
        if (tid < 256) {
            const int row = (wave & 3) * 32 + r, half = h5; const LAS float* s1 = sc0 + row * 129; const LAS float* s2 = sc0 + 128 * 129 + row * 129;
            float v1[16], v2[16];
#pragma unroll
            for (int k = 0; k < 16; ++k) { v1[k] = s1[k]; v2[k] = s2[k]; }
            unsigned top[16], k16[16];
#pragma unroll
            for (int i = 0; i < 16; ++i) { const int c0 = 2 * i, c1 = 2 * i + 1;
                const unsigned ka = (mono_u32(v1[PC.a[c0]] + v2[PC.b[c0]]) & ~0xFFu) | (unsigned)(255 - (PC.a[c0] * 16 + PC.b[c0]));
                const unsigned kb = (mono_u32(v1[PC.a[c1]] + v2[PC.b[c1]]) & ~0xFFu) | (unsigned)(255 - (PC.a[c1] * 16 + PC.b[c1]));
                top[i] = half ? kb : ka; }
#pragma unroll
            for (int i = 0; i < 16; ++i) { if (i < 9) { const int c0 = 32 + 2 * i, c1 = 32 + 2 * i + 1;
                    const unsigned ka = (mono_u32(v1[PC.a[c0]] + v2[PC.b[c0]]) & ~0xFFu) | (unsigned)(255 - (PC.a[c0] * 16 + PC.b[c0]));
                    const unsigned kb = (mono_u32(v1[PC.a[c1]] + v2[PC.b[c1]]) & ~0xFFu) | (unsigned)(255 - (PC.a[c1] * 16 + PC.b[c1]));
                    k16[i] = half ? kb : ka; } else k16[i] = 0u; }
            sort16_desc(top); sort16_desc(k16); merge16_desc(top, k16);
            merge16_xlane(top);
            if (half == 0) {
                float mx = -3.0e38f; float sv[16]; int eid[16];
#pragma unroll
                for (int k = 0; k < 16; ++k) { const int fl = 255 - (int)(top[k] & 255u), a = fl >> 4, b = fl & 15;
                    sv[k] = s1[a] + s2[b]; eid[k] = __float_as_int(s1[16 + a]) * 128 + __float_as_int(s2[16 + b]); mx = fmaxf(mx, sv[k]); }
                float den = 0.f;
#pragma unroll
                for (int k = 0; k < 16; ++k) { sv[k] = __expf(sv[k] - mx); den += sv[k]; }
                const float inv = 1.0f / den;
                unsigned short* ep = EID + (m0 + row) * 128 + hd * 16; float* gp = GATE + (m0 + row) * 128 + hd * 16;
#pragma unroll
                for (int k = 0; k < 16; ++k) { ep[k] = (unsigned short)eid[k]; gp[k] = sv[k] * inv; }
            }
        }
        __syncthreads();
    }
}

__device__ __forceinline__ float rdlane_f(float v, int l) { return __builtin_bit_cast(float, __builtin_amdgcn_readlane(__builtin_bit_cast(int, v), l)); }
__device__ __forceinline__ void p_peer_expert(const Frame& F, unsigned char* ws, float* xres) {
    const bf16_t* XN = (const bf16_t*)(ws + WS_XN); const bf16_t* TU = (const bf16_t*)(ws + WS_TABU); const bf16_t* TV = (const bf16_t*)(ws + WS_TABV);
    const unsigned short* EID = (const unsigned short*)(ws + PE_EID); const float* GATE = (const float*)(ws + PE_GATE);
    const int gw = F.bid * NWAVES + F.wave, NGW = F.G * NWAVES, lane = F.lane;
    for (int m = gw; m < T; m += NGW) {
        float xf[16];
        { const u32x4 xa = *(const u32x4*)(XN + (size_t)m * 1024 + lane * 8), xb = *(const u32x4*)(XN + (size_t)m * 1024 + 512 + lane * 8);
          xf[0] = bf_lo(xa.x); xf[1] = bf_hi(xa.x); xf[2] = bf_lo(xa.y); xf[3] = bf_hi(xa.y); xf[4] = bf_lo(xa.z); xf[5] = bf_hi(xa.z); xf[6] = bf_lo(xa.w); xf[7] = bf_hi(xa.w);
          xf[8] = bf_lo(xb.x); xf[9] = bf_hi(xb.x); xf[10] = bf_lo(xb.y); xf[11] = bf_hi(xb.y); xf[12] = bf_lo(xb.z); xf[13] = bf_hi(xb.z); xf[14] = bf_lo(xb.w); xf[15] = bf_hi(xb.w); }
        const int id0 = EID[(size_t)m * 128 + lane], id1 = EID[(size_t)m * 128 + 64 + lane];
        const float g0 = GATE[(size_t)m * 128 + lane], g1 = GATE[(size_t)m * 128 + 64 + lane];
        float outv[16];
#pragma unroll
        for (int i = 0; i < 16; ++i) outv[i] = 0.f;
#pragma unroll 1
        for (int k = 0; k < 16; ++k) {
            const int idreg = (k < 8) ? id0 : id1; const float greg = (k < 8) ? g0 : g1; const int lbase = (k & 7) * 8;
            int e[8];
#pragma unroll
            for (int i = 0; i < 8; ++i) e[i] = __builtin_amdgcn_readlane(idreg, lbase + i);
            float pr[8];
            {
                u32x4 ua[8], ub[8];
#pragma unroll
                for (int i = 0; i < 8; ++i) { ua[i] = *(const u32x4*)(TU + (size_t)e[i] * 1024 + lane * 8); ub[i] = *(const u32x4*)(TU + (size_t)e[i] * 1024 + 512 + lane * 8); }
#pragma unroll
                for (int i = 0; i < 8; ++i) {
                    float s = xf[0] * bf_lo(ua[i].x); s += xf[1] * bf_hi(ua[i].x); s += xf[2] * bf_lo(ua[i].y); s += xf[3] * bf_hi(ua[i].y);
                    s += xf[4] * bf_lo(ua[i].z); s += xf[5] * bf_hi(ua[i].z); s += xf[6] * bf_lo(ua[i].w); s += xf[7] * bf_hi(ua[i].w);
                    s += xf[8] * bf_lo(ub[i].x); s += xf[9] * bf_hi(ub[i].x); s += xf[10] * bf_lo(ub[i].y); s += xf[11] * bf_hi(ub[i].y);
                    s += xf[12] * bf_lo(ub[i].z); s += xf[13] * bf_hi(ub[i].z); s += xf[14] * bf_lo(ub[i].w); s += xf[15] * bf_hi(ub[i].w);
                    pr[i] = s;
                }
            }
            float r4[4], r2[2], r1;
            { const bool up = (lane & 32) != 0;
#pragma unroll
              for (int i = 0; i < 4; ++i) { const float keep = up ? pr[i + 4] : pr[i], send = up ? pr[i] : pr[i + 4]; r4[i] = keep + __shfl_xor(send, 32); } }
            { const bool up = (lane & 16) != 0;
#pragma unroll
              for (int i = 0; i < 2; ++i) { const float keep = up ? r4[i + 2] : r4[i], send = up ? r4[i] : r4[i + 2]; r2[i] = keep + __shfl_xor(send, 16); } }
            { const bool up = (lane & 8) != 0; const float keep = up ? r2[1] : r2[0], send = up ? r2[0] : r2[1]; r1 = keep + __shfl_xor(send, 8); }
            r1 += __shfl_xor(r1, 4); r1 += __shfl_xor(r1, 2); r1 += __shfl_xor(r1, 1);
            const float gv = __shfl(greg, lbase + (lane >> 3));
            const float coef = gv * gelu_tanh(r1);
            {
                u32x4 va[8], vb[8];
#pragma unroll
                for (int i = 0; i < 8; ++i) { va[i] = *(const u32x4*)(TV + (size_t)e[i] * 1024 + lane * 8); vb[i] = *(const u32x4*)(TV + (size_t)e[i] * 1024 + 512 + lane * 8); }
#pragma unroll
                for (int i = 0; i < 8; ++i) {
                    const float ci = rdlane_f(coef, i * 8);
                    outv[0] += ci * bf_lo(va[i].x); outv[1] += ci * bf_hi(va[i].x); outv[2] += ci * bf_lo(va[i].y); outv[3] += ci * bf_hi(va[i].y);
                    outv[4] += ci * bf_lo(va[i].z); outv[5] += ci * bf_hi(va[i].z); outv[6] += ci * bf_lo(va[i].w); outv[7] += ci * bf_hi(va[i].w);
                    outv[8] += ci * bf_lo(vb[i].x); outv[9] += ci * bf_hi(vb[i].x); outv[10] += ci * bf_lo(vb[i].y); outv[11] += ci * bf_hi(vb[i].y);
                    outv[12] += ci * bf_lo(vb[i].z); outv[13] += ci * bf_hi(vb[i].z); outv[14] += ci * bf_lo(vb[i].w); outv[15] += ci * bf_hi(vb[i].w);
                }
            }
        }
        f32x4* o = (f32x4*)(xres + (size_t)m * 1024 + lane * 8);
        f32x4 a0 = o[0], a1 = o[1], b0 = o[128], b1 = o[129];
        a0 += (f32x4){outv[0], outv[1], outv[2], outv[3]}; a1 += (f32x4){outv[4], outv[5], outv[6], outv[7]};
        b0 += (f32x4){outv[8], outv[9], outv[10], outv[11]}; b1 += (f32x4){outv[12], outv[13], outv[14], outv[15]};
        o[0] = a0; o[1] = a1; o[128] = b0; o[129] = b1;
    }
}

typedef __bf16 bf16x2_t __attribute__((ext_vector_type(2)));
__device__ __forceinline__ float dot2bf(unsigned a, unsigned b, float c) { return __builtin_amdgcn_fdot2_f32_bf16(__builtin_bit_cast(bf16x2_t, a), __builtin_bit_cast(bf16x2_t, b), c, false); }
__device__ __forceinline__ void peer_slot_range(const unsigned (&xp)[8], float (&outv)[16], int id0, int id1, float g0, float g1, int r,
                                                const bf16_t* TU, const bf16_t* TV, int lane) {
    u64 m0 = __ballot((id0 >> 9) == r), m1 = __ballot((id1 >> 9) == r);
    while (m0 | m1) {
        int e[8]; float gt[8];
#pragma unroll
        for (int i = 0; i < 8; ++i) {
            if (m0) { const int l = __builtin_ctzll(m0); m0 &= m0 - 1ull; e[i] = __builtin_amdgcn_readlane(id0, l); gt[i] = rdlane_f(g0, l); }
            else if (m1) { const int l = __builtin_ctzll(m1); m1 &= m1 - 1ull; e[i] = __builtin_amdgcn_readlane(id1, l); gt[i] = rdlane_f(g1, l); }
            else { e[i] = -1; gt[i] = 0.f; }
        }
        float pr[8];
        {
            u32x4 ua[8], ub[8];
#pragma unroll
            for (int i = 0; i < 8; ++i) {
                if (e[i] >= 0) { ua[i] = *(const u32x4*)(TU + (size_t)e[i] * 1024 + lane * 8); ub[i] = *(const u32x4*)(TU + (size_t)e[i] * 1024 + 512 + lane * 8); }
                else { ua[i] = (u32x4){0u, 0u, 0u, 0u}; ub[i] = (u32x4){0u, 0u, 0u, 0u}; }
            }
#pragma unroll
            for (int i = 0; i < 8; ++i) {
                float s = dot2bf(xp[0], ua[i].x, 0.f); s = dot2bf(xp[1], ua[i].y, s); s = dot2bf(xp[2], ua[i].z, s); s = dot2bf(xp[3], ua[i].w, s);
                s = dot2bf(xp[4], ub[i].x, s); s = dot2bf(xp[5], ub[i].y, s); s = dot2bf(xp[6], ub[i].z, s); s = dot2bf(xp[7], ub[i].w, s);
                pr[i] = s;
            }
        }
        float r4[4], r2[2], r1;
        { const bool up = (lane & 32) != 0;
#pragma unroll
          for (int i = 0; i < 4; ++i) { const float keep = up ? pr[i + 4] : pr[i], send = up ? pr[i] : pr[i + 4]; r4[i] = keep + __shfl_xor(send, 32); } }
        { const bool up = (lane & 16) != 0;
#pragma unroll
          for (int i = 0; i < 2; ++i) { const float keep = up ? r4[i + 2] : r4[i], send = up ? r4[i] : r4[i + 2]; r2[i] = keep + __shfl_xor(send, 16); } }
        { const bool up = (lane & 8) != 0; const float keep = up ? r2[1] : r2[0], send = up ? r2[0] : r2[1]; r1 = keep + __shfl_xor(send, 8); }
        r1 += __shfl_xor(r1, 4); r1 += __shfl_xor(r1, 2); r1 += __shfl_xor(r1, 1);
        const int grp = lane >> 3;
        float gsel = gt[0];
#pragma unroll
        for (int i = 1; i < 8; ++i) gsel = (grp == i) ? gt[i] : gsel;
        const float coef = gsel * gelu_tanh(r1);
        {
            u32x4 va[8], vb[8];
#pragma unroll
            for (int i = 0; i < 8; ++i) {
                if (e[i] >= 0) { va[i] = *(const u32x4*)(TV + (size_t)e[i] * 1024 + lane * 8); vb[i] = *(const u32x4*)(TV + (size_t)e[i] * 1024 + 512 + lane * 8); }
                else { va[i] = (u32x4){0u, 0u, 0u, 0u}; vb[i] = (u32x4){0u, 0u, 0u, 0u}; }
            }
#pragma unroll
            for (int i = 0; i < 8; ++i) {
                if (e[i] >= 0) {
                    const float ci = rdlane_f(coef, i * 8);
                    outv[0] += ci * bf_lo(va[i].x); outv[1] += ci * bf_hi(va[i].x); outv[2] += ci * bf_lo(va[i].y); outv[3] += ci * bf_hi(va[i].y);
                    outv[4] += ci * bf_lo(va[i].z); outv[5] += ci * bf_hi(va[i].z); outv[6] += ci * bf_lo(va[i].w); outv[7] += ci * bf_hi(va[i].w);
                    outv[8] += ci * bf_lo(vb[i].x); outv[9] += ci * bf_hi(vb[i].x); outv[10] += ci * bf_lo(vb[i].y); outv[11] += ci * bf_hi(vb[i].y);
                    outv[12] += ci * bf_lo(vb[i].z); outv[13] += ci * bf_hi(vb[i].z); outv[14] += ci * bf_lo(vb[i].w); outv[15] += ci * bf_hi(vb[i].w);
                }
            }
        }
    }
}
__device__ __forceinline__ void p_peer_expert2(const Frame& F, unsigned char* ws, float* xres, const float oscale) {
    const bf16_t* XN = (const bf16_t*)(ws + WS_XN); const bf16_t* TU = (const bf16_t*)(ws + WS_TABU); const bf16_t* TV = (const bf16_t*)(ws + WS_TABV);
    const unsigned short* EID = (const unsigned short*)(ws + PE_EID); const float* GATE = (const float*)(ws + PE_GATE);
    const int gw = F.bid * NWAVES + F.wave, NGW = F.G * NWAVES, lane = F.lane;
    int rnd = 0;
    for (int m4 = gw * 4; m4 < T; m4 += NGW * 4, ++rnd) {
        unsigned xp[4][8]; float outv[4][16]; int id[4][2]; float gg[4][2];
#pragma unroll
        for (int s = 0; s < 4; ++s) {
            const size_t m = (size_t)(m4 + s);
            const u32x4 xa = *(const u32x4*)(XN + m * 1024 + lane * 8), xb = *(const u32x4*)(XN + m * 1024 + 512 + lane * 8);
            xp[s][0] = xa.x; xp[s][1] = xa.y; xp[s][2] = xa.z; xp[s][3] = xa.w; xp[s][4] = xb.x; xp[s][5] = xb.y; xp[s][6] = xb.z; xp[s][7] = xb.w;
            id[s][0] = EID[m * 128 + lane]; id[s][1] = EID[m * 128 + 64 + lane]; gg[s][0] = GATE[m * 128 + lane]; gg[s][1] = GATE[m * 128 + 64 + lane];
#pragma unroll
            for (int i = 0; i < 16; ++i) outv[s][i] = 0.f;
        }
#pragma unroll 1
        for (int k = 0; k < 32; ++k) {
            const int r = (rnd & 1) ? 31 - k : k;
#pragma unroll
            for (int s = 0; s < 4; ++s) peer_slot_range(xp[s], outv[s], id[s][0], id[s][1], gg[s][0], gg[s][1], r, TU, TV, lane);
        }
#pragma unroll
        for (int s = 0; s < 4; ++s) {
            f32x4* o = (f32x4*)(xres + (size_t)(m4 + s) * 1024 + lane * 8);
            f32x4 a0 = o[0], a1 = o[1], b0 = o[128], b1 = o[129];
            a0 += (f32x4){outv[s][0], outv[s][1], outv[s][2], outv[s][3]} * oscale; a1 += (f32x4){outv[s][4], outv[s][5], outv[s][6], outv[s][7]} * oscale;
            b0 += (f32x4){outv[s][8], outv[s][9], outv[s][10], outv[s][11]} * oscale; b1 += (f32x4){outv[s][12], outv[s][13], outv[s][14], outv[s][15]} * oscale;
            o[0] = a0; o[1] = a1; o[128] = b0; o[129] = b1;
        }
    }
}

struct RowBuf { u32x4 a[8], b[8]; };
__device__ __forceinline__ void peer_load8(RowBuf& rb, const bf16_t* TAB, const LAS unsigned* ent, int b, int lane) {
#pragma unroll
    for (int i = 0; i < 8; ++i) {
        const unsigned e = (unsigned)__builtin_amdgcn_readfirstlane((int)ent[b * 8 + i]) & 0x3FFFu;
        const bf16_t* rp = TAB + (size_t)e * 1024 + lane * 8;
        rb.a[i] = *(const u32x4*)rp; rb.b[i] = *(const u32x4*)(rp + 512);
    }
}
__device__ __forceinline__ float peer_dot(const unsigned (&xp)[8], const u32x4 a, const u32x4 b) {
    float s = dot2bf(xp[0], a.x, 0.f); s = dot2bf(xp[1], a.y, s); s = dot2bf(xp[2], a.z, s); s = dot2bf(xp[3], a.w, s);
    s = dot2bf(xp[4], b.x, s); s = dot2bf(xp[5], b.y, s); s = dot2bf(xp[6], b.z, s); s = dot2bf(xp[7], b.w, s);
    return s;
}
__device__ __forceinline__ void peer_u8(const RowBuf& rb, const unsigned (&xp)[4][8], const LAS unsigned* ent, LAS float* cf, int b, int lane) {
    float pr[8];
#pragma unroll
    for (int i = 0; i < 8; ++i) {
        const int slot = (__builtin_amdgcn_readfirstlane((int)ent[b * 8 + i]) >> 21) & 3;
        if (slot == 0) pr[i] = peer_dot(xp[0], rb.a[i], rb.b[i]);
        else if (slot == 1) pr[i] = peer_dot(xp[1], rb.a[i], rb.b[i]);
        else if (slot == 2) pr[i] = peer_dot(xp[2], rb.a[i], rb.b[i]);
        else pr[i] = peer_dot(xp[3], rb.a[i], rb.b[i]);
    }
    float r4[4], r2[2], r1;
    { const bool up = (lane & 32) != 0;
#pragma unroll
      for (int i = 0; i < 4; ++i) { const float keep = up ? pr[i + 4] : pr[i], send = up ? pr[i] : pr[i + 4]; r4[i] = keep + __shfl_xor(send, 32); } }
    { const bool up = (lane & 16) != 0;
#pragma unroll
      for (int i = 0; i < 2; ++i) { const float keep = up ? r4[i + 2] : r4[i], send = up ? r4[i] : r4[i + 2]; r2[i] = keep + __shfl_xor(send, 16); } }
    { const bool up = (lane & 8) != 0; const float keep = up ? r2[1] : r2[0], send = up ? r2[0] : r2[1]; r1 = keep + __shfl_xor(send, 8); }
    r1 += __shfl_xor(r1, 4); r1 += __shfl_xor(r1, 2); r1 += __shfl_xor(r1, 1);
    const float gate = cf[b * 8 + (lane >> 3)];
    const float coef = gate * gelu_tanh(r1);
    if ((lane & 7) == 0) cf[b * 8 + (lane >> 3)] = coef;
}
__device__ __forceinline__ void peer_acc(float (&o)[16], const float c, const u32x4 a, const u32x4 b) {
    o[0] += c * bf_lo(a.x); o[1] += c * bf_hi(a.x); o[2] += c * bf_lo(a.y); o[3] += c * bf_hi(a.y);
    o[4] += c * bf_lo(a.z); o[5] += c * bf_hi(a.z); o[6] += c * bf_lo(a.w); o[7] += c * bf_hi(a.w);
    o[8] += c * bf_lo(b.x); o[9] += c * bf_hi(b.x); o[10] += c * bf_lo(b.y); o[11] += c * bf_hi(b.y);
    o[12] += c * bf_lo(b.z); o[13] += c * bf_hi(b.z); o[14] += c * bf_lo(b.w); o[15] += c * bf_hi(b.w);
}
__device__ __forceinline__ void peer_v8(const RowBuf& rb, float (&outv)[4][16], const LAS unsigned* ent, const LAS float* cf, int b) {
#pragma unroll
    for (int i = 0; i < 8; ++i) {
        const int slot = (__builtin_amdgcn_readfirstlane((int)ent[b * 8 + i]) >> 21) & 3;
        const float c = cf[b * 8 + i];
        if (slot == 0) peer_acc(outv[0], c, rb.a[i], rb.b[i]);
        else if (slot == 1) peer_acc(outv[1], c, rb.a[i], rb.b[i]);
        else if (slot == 2) peer_acc(outv[2], c, rb.a[i], rb.b[i]);
        else peer_acc(outv[3], c, rb.a[i], rb.b[i]);
    }
}
__device__ __forceinline__ void p_peer_expert3(const Frame& F, unsigned char* ws, float* xres, const float oscale, const XcdBarrier& xbar) {
    const bf16_t* XN = (const bf16_t*)(ws + WS_XN); const bf16_t* TU = (const bf16_t*)(ws + WS_TABU); const bf16_t* TV = (const bf16_t*)(ws + WS_TABV);
    const unsigned short* EID = (const unsigned short*)(ws + PE_EID); const float* GATE = (const float*)(ws + PE_GATE);
    const int gw = F.bid * NWAVES + F.wave, NGW = F.G * NWAVES, lane = F.lane;
    LAS unsigned* ent = (LAS unsigned*)(F.lds + F.wave * 4096);
    LAS float* cf = (LAS float*)(F.lds + F.wave * 4096 + 2048);
    const int nrounds = (T + NGW * 4 - 1) / (NGW * 4);
    for (int rnd = 0; rnd < nrounds; ++rnd) {
        const int m4 = (rnd * NGW + gw) * 4;
        if (m4 < T) {
            unsigned xp[4][8];
            {
                int id[4][2]; float gg[4][2];
#pragma unroll
                for (int s = 0; s < 4; ++s) {
                    const size_t m = (size_t)(m4 + s);
                    const u32x4 xa = *(const u32x4*)(XN + m * 1024 + lane * 8), xb = *(const u32x4*)(XN + m * 1024 + 512 + lane * 8);
                    xp[s][0] = xa.x; xp[s][1] = xa.y; xp[s][2] = xa.z; xp[s][3] = xa.w; xp[s][4] = xb.x; xp[s][5] = xb.y; xp[s][6] = xb.z; xp[s][7] = xb.w;
                    id[s][0] = EID[m * 128 + lane]; id[s][1] = EID[m * 128 + 64 + lane]; gg[s][0] = GATE[m * 128 + lane]; gg[s][1] = GATE[m * 128 + 64 + lane];
                }
                int base = 0;
#pragma unroll 1
                for (int k = 0; k < 32; ++k) {
                    const int r = (rnd & 1) ? 31 - k : k;
#pragma unroll
                    for (int s = 0; s < 4; ++s)
#pragma unroll
                        for (int w = 0; w < 2; ++w) {
                            const bool hit = (id[s][w] >> 9) == r;
                            const u64 m = __ballot(hit);
                            if (hit) { const int pos = base + (int)__builtin_amdgcn_mbcnt_hi((unsigned)(m >> 32), __builtin_amdgcn_mbcnt_lo((unsigned)m, 0u));
                                ent[pos] = ((unsigned)s << 21) | ((unsigned)(w * 64 + lane) << 14) | (unsigned)id[s][w]; cf[pos] = gg[s][w]; }
                            base += __builtin_popcountll(m);
                        }
                }
            }
            LDS_WAIT();
            {
                RowBuf A, B;
                peer_load8(A, TU, ent, 0, lane);
#pragma unroll 1
                for (int b = 0; b < 64; b += 2) {
                    peer_load8(B, TU, ent, b + 1, lane);
                    peer_u8(A, xp, ent, cf, b, lane);
                    if (b + 2 < 64) peer_load8(A, TU, ent, b + 2, lane);
                    peer_u8(B, xp, ent, cf, b + 1, lane);
                }
            }
            LDS_WAIT();
            float outv[4][16];
#pragma unroll
            for (int s = 0; s < 4; ++s)
#pragma unroll
                for (int i = 0; i < 16; ++i) outv[s][i] = 0.f;
            {
                RowBuf A, B;
                peer_load8(A, TV, ent, 0, lane);
#pragma unroll 1
                for (int b = 0; b < 64; b += 2) {
                    peer_load8(B, TV, ent, b + 1, lane);
                    peer_v8(A, outv, ent, cf, b);
                    if (b + 2 < 64) peer_load8(A, TV, ent, b + 2, lane);
                    peer_v8(B, outv, ent, cf, b + 1);
                }
            }
#pragma unroll
            for (int s = 0; s < 4; ++s) {
                f32x4* o = (f32x4*)(xres + (size_t)(m4 + s) * 1024 + lane * 8);
                f32x4 a0 = o[0], a1 = o[1], b0 = o[128], b1 = o[129];
                a0 += (f32x4){outv[s][0], outv[s][1], outv[s][2], outv[s][3]} * oscale; a1 += (f32x4){outv[s][4], outv[s][5], outv[s][6], outv[s][7]} * oscale;
                b0 += (f32x4){outv[s][8], outv[s][9], outv[s][10], outv[s][11]} * oscale; b1 += (f32x4){outv[s][12], outv[s][13], outv[s][14], outv[s][15]} * oscale;
                o[0] = a0; o[1] = a1; o[128] = b0; o[129] = b1;
            }
        }
        if (rnd + 1 < nrounds) xcd_barrier(xbar);
    }
}

constexpr size_t WS_TAB8U = WS_TABU;
constexpr size_t WS_TAB8V = WS_TABU + 16 * MiB;
constexpr size_t WS_TABSU = WS_TABU + 32 * MiB;
constexpr size_t WS_TABSV = WS_TABU + 32 * MiB + 65536;
__device__ __forceinline__ void cvt_table_fp8(const Frame& F, const float* src, unsigned char* dst, float* scales, const int skip) {
    const int nb = F.G > skip ? F.G - skip : F.G, b0 = F.G > skip ? F.bid - skip : F.bid;
    const int gw = b0 * NWAVES + F.wave, NGW = nb * NWAVES, lane = F.lane;
    if (b0 >= 0) for (int r = gw; r < 16384; r += NGW) {
        const f32x4* p = (const f32x4*)(src + (size_t)r * 1024 + lane * 16);
        f32x4 v[4]; float am = 0.f;
#pragma unroll
        for (int j = 0; j < 4; ++j) { v[j] = p[j]; am = fmaxf(am, fmaxf(fmaxf(fabsf(v[j].x), fabsf(v[j].y)), fmaxf(fabsf(v[j].z), fabsf(v[j].w)))); }
#pragma unroll
        for (int o = 1; o < 64; o <<= 1) am = fmaxf(am, __shfl_xor(am, o));
        const float sc = am > 0.f ? am * (1.0f / 448.0f) : 1.0f, inv = 1.0f / sc;
        u32x4 q;
#pragma unroll
        for (int j = 0; j < 4; ++j) { int w = 0; w = __builtin_amdgcn_cvt_pk_fp8_f32(v[j].x * inv, v[j].y * inv, w, false); w = __builtin_amdgcn_cvt_pk_fp8_f32(v[j].z * inv, v[j].w * inv, w, true); q[j] = (unsigned)w; }
        *(u32x4*)(dst + (size_t)r * 1024 + lane * 16) = q;
        if (lane == 0) scales[r] = sc;
    }
}
template <int NR> struct RowBufN { u32x4 a[NR]; };
template <int NR>
__device__ __forceinline__ void peer_loadN(RowBufN<NR>& rb, const unsigned char* TAB, const LAS unsigned* ent, int b, int lane) {
    const int ev = (int)ent[b * NR + (lane & (NR - 1))];
#pragma unroll
    for (int i = 0; i < NR; ++i) {
        const unsigned e = (unsigned)__builtin_amdgcn_readlane(ev, i) & 0x3FFFu;
        rb.a[i] = *(const u32x4*)(TAB + (size_t)e * 1024 + lane * 16);
    }
}
__device__ __forceinline__ float peer_dot8x(const u32x4 xa, const u32x4 xb, const u32x4 q) {
    float s = 0.f;
#pragma unroll
    for (int j = 0; j < 4; ++j) {
        const f32x2 lo = __builtin_amdgcn_cvt_pk_f32_fp8((int)q[j], false), hi = __builtin_amdgcn_cvt_pk_f32_fp8((int)q[j], true);
        const unsigned x0 = (j < 2) ? xa[2 * j] : xb[2 * j - 4], x1 = (j < 2) ? xa[2 * j + 1] : xb[2 * j - 3];
        s += bf_lo(x0) * lo.x; s += bf_hi(x0) * lo.y; s += bf_lo(x1) * hi.x; s += bf_hi(x1) * hi.y;
    }
    return s;
}
template <int NR>
__device__ __forceinline__ void peer_u8x(const RowBufN<NR>& rb, int r0, const LAS unsigned char* xl, const LAS unsigned* ent, LAS float* cf, const LAS float* sul, int e0, int lane) {
    float pr[8];
    const int ev = (int)ent[e0 + (lane & 7)];
#pragma unroll
    for (int i = 0; i < 8; ++i) {
        const int slot = (__builtin_amdgcn_readlane(ev, i) >> 21) & 3;
        const LAS unsigned char* xp = xl + slot * 2048 + lane * 32;
        const u32x4 xa = *(const LAS u32x4*)xp, xb = *(const LAS u32x4*)(xp + 16);
        pr[i] = peer_dot8x(xa, xb, rb.a[r0 + i]);
    }
    float r4[4], r2[2], r1;
    { const bool up = (lane & 32) != 0;
#pragma unroll
      for (int i = 0; i < 4; ++i) { const float keep = up ? pr[i + 4] : pr[i], send = up ? pr[i] : pr[i + 4]; r4[i] = keep + __shfl_xor(send, 32); } }
    { const bool up = (lane & 16) != 0;
#pragma unroll
      for (int i = 0; i < 2; ++i) { const float keep = up ? r4[i + 2] : r4[i], send = up ? r4[i] : r4[i + 2]; r2[i] = keep + __shfl_xor(send, 16); } }
    { const bool up = (lane & 8) != 0; const float keep = up ? r2[1] : r2[0], send = up ? r2[0] : r2[1]; r1 = keep + __shfl_xor(send, 8); }
    r1 += __shfl_xor(r1, 4); r1 += __shfl_xor(r1, 2); r1 += __shfl_xor(r1, 1);
    const float gate = cf[e0 + (lane >> 3)];
    const float coef = gate * gelu_tanh(r1 * sul[e0 + (lane >> 3)]);
    if ((lane & 7) == 0) cf[e0 + (lane >> 3)] = coef;
}
__device__ __forceinline__ void peer_acc8(float (&o)[16], const float c, const u32x4 q) {
#pragma unroll
    for (int j = 0; j < 4; ++j) { const f32x2 lo = __builtin_amdgcn_cvt_pk_f32_fp8((int)q[j], false), hi = __builtin_amdgcn_cvt_pk_f32_fp8((int)q[j], true);
        o[4 * j] += c * lo.x; o[4 * j + 1] += c * lo.y; o[4 * j + 2] += c * hi.x; o[4 * j + 3] += c * hi.y; }
}
template <int NR>
__device__ __forceinline__ void peer_vN(const RowBufN<NR>& rb, float (&outv)[4][16], const LAS unsigned* ent, const LAS float* cf, int b, int lane) {
    const int ev = (int)ent[b * NR + (lane & (NR - 1))]; const float cv = cf[b * NR + (lane & (NR - 1))];
#pragma unroll
    for (int i = 0; i < NR; ++i) {
        const int slot = (__builtin_amdgcn_readlane(ev, i) >> 21) & 3;
        const float c = rdlane_f(cv, i);
        if (slot == 0) peer_acc8(outv[0], c, rb.a[i]);
        else if (slot == 1) peer_acc8(outv[1], c, rb.a[i]);
        else if (slot == 2) peer_acc8(outv[2], c, rb.a[i]);
        else peer_acc8(outv[3], c, rb.a[i]);
    }
}
__device__ __forceinline__ void p_peer_expert4(const Frame& F, unsigned char* ws, float* xres, const float oscale, const XcdBarrier& xbar, const int mode) {
    const bf16_t* XN = (const bf16_t*)(ws + WS_XN); const unsigned char* TU = ws + WS_TAB8U; const unsigned char* TV = ws + WS_TAB8V;
    const float* SU = (const float*)(ws + WS_TABSU); const float* SV = (const float*)(ws + WS_TABSV);
    const unsigned short* EID = (const unsigned short*)(ws + PE_EID); const float* GATE = (const float*)(ws + PE_GATE);
    const int gw = F.bid * NWAVES + F.wave, NGW = F.G * NWAVES, lane = F.lane;
    LAS unsigned* ent = (LAS unsigned*)(F.lds + F.wave * 6144);
    LAS float* cf = (LAS float*)(F.lds + F.wave * 6144 + 2048);
    LAS float* sul = (LAS float*)(F.lds + F.wave * 6144 + 4096);
    LAS unsigned char* xl = F.lds + 49152 + F.wave * 8192;
    constexpr int PU = 16, PV = 8;
    const int nrounds = (T + NGW * 4 - 1) / (NGW * 4);
    for (int rnd = 0; rnd < nrounds; ++rnd) {
        const int m4 = (rnd * NGW + gw) * 4;
        if (m4 < T) {
            {
                int id[4][2]; float gg[4][2], su[4][2];
#pragma unroll
                for (int s = 0; s < 4; ++s) { const size_t m = (size_t)(m4 + s);
                    id[s][0] = EID[m * 128 + lane]; id[s][1] = EID[m * 128 + 64 + lane]; gg[s][0] = GATE[m * 128 + lane] * SV[id[s][0]]; gg[s][1] = GATE[m * 128 + 64 + lane] * SV[id[s][1]]; su[s][0] = SU[id[s][0]]; su[s][1] = SU[id[s][1]]; }
                int base = 0;
#pragma unroll 1
                for (int k = 0; k < 16; ++k) {
                    const int r = (rnd & 1) ? 15 - k : k;
#pragma unroll
                    for (int s = 0; s < 4; ++s)
#pragma unroll
                        for (int w = 0; w < 2; ++w) {
                            const bool hit = (id[s][w] >> 10) == r;
                            const u64 m = __ballot(hit);
                            if (hit) { const int pos = base + (int)__builtin_amdgcn_mbcnt_hi((unsigned)(m >> 32), __builtin_amdgcn_mbcnt_lo((unsigned)m, 0u));
                                ent[pos] = ((unsigned)s << 21) | ((unsigned)(w * 64 + lane) << 14) | (unsigned)(mode == 4 ? (id[s][w] & 7) : id[s][w]); cf[pos] = gg[s][w]; sul[pos] = su[s][w]; }
                            base += __builtin_popcountll(m);
                        }
                }
            }
            LDS_WAIT();
            if (mode != 1 && mode != 3) {
#pragma unroll
                for (int s = 0; s < 4; ++s) { const size_t m = (size_t)(m4 + s);
                    const u32x4 xa = *(const u32x4*)(XN + m * 1024 + lane * 16), xb = *(const u32x4*)(XN + m * 1024 + lane * 16 + 8);
                    *(LAS u32x4*)(xl + s * 2048 + lane * 32) = xa; *(LAS u32x4*)(xl + s * 2048 + lane * 32 + 16) = xb; }
                LDS_WAIT();
                RowBufN<PU> A, B;
                peer_loadN<PU>(A, TU, ent, 0, lane);
#pragma unroll 1
                for (int b = 0; b < 512 / PU; b += 2) {
                    peer_loadN<PU>(B, TU, ent, b + 1, lane);
#pragma unroll
                    for (int h = 0; h < PU / 8; ++h) peer_u8x<PU>(A, h * 8, xl, ent, cf, sul, b * PU + h * 8, lane);
                    if (b + 2 < 512 / PU) peer_loadN<PU>(A, TU, ent, b + 2, lane);
#pragma unroll
                    for (int h = 0; h < PU / 8; ++h) peer_u8x<PU>(B, h * 8, xl, ent, cf, sul, (b + 1) * PU + h * 8, lane);
                }
            }
            LDS_WAIT();
            float outv[4][16];
#pragma unroll
            for (int s = 0; s < 4; ++s)
#pragma unroll
                for (int i = 0; i < 16; ++i) outv[s][i] = 0.f;
            if (mode != 1 && mode != 2) {
                RowBufN<PV> A, B;
                peer_loadN<PV>(A, TV, ent, 0, lane);
#pragma unroll 1
                for (int b = 0; b < 512 / PV; b += 2) {
                    peer_loadN<PV>(B, TV, ent, b + 1, lane);
                    peer_vN<PV>(A, outv, ent, cf, b, lane);
                    if (b + 2 < 512 / PV) peer_loadN<PV>(A, TV, ent, b + 2, lane);
                    peer_vN<PV>(B, outv, ent, cf, b + 1, lane);
                }
            }
#pragma unroll
            for (int s = 0; s < 4; ++s) {
                f32x4* o = (f32x4*)(xres + (size_t)(m4 + s) * 1024 + lane * 16);
#pragma unroll
                for (int j = 0; j < 4; ++j) { f32x4 a0 = o[j]; a0 += (f32x4){outv[s][4 * j], outv[s][4 * j + 1], outv[s][4 * j + 2], outv[s][4 * j + 3]} * oscale; o[j] = a0; }
            }
        }
        if (rnd + 1 < nrounds) xcd_barrier(xbar);
    }
}

__device__ __forceinline__ void cvt_table_i8(const Frame& F, const float* src, unsigned char* dst, float* scales, const int skip) {
    const int nb = F.G > skip ? F.G - skip : F.G, b0 = F.G > skip ? F.bid - skip : F.bid;
    const int gw = b0 * NWAVES + F.wave, NGW = nb * NWAVES, lane = F.lane;
    if (b0 >= 0) for (int r = gw; r < 16384; r += NGW) {
        const f32x4* p = (const f32x4*)(src + (size_t)r * 1024 + lane * 16);
        f32x4 v[4]; float am = 0.f;
#pragma unroll
        for (int j = 0; j < 4; ++j) { v[j] = p[j]; am = fmaxf(am, fmaxf(fmaxf(fabsf(v[j].x), fabsf(v[j].y)), fmaxf(fabsf(v[j].z), fabsf(v[j].w)))); }
#pragma unroll
        for (int o = 1; o < 64; o <<= 1) am = fmaxf(am, __shfl_xor(am, o));
        const float sc = am > 0.f ? am * (1.0f / 127.0f) : 1.0f, inv = 1.0f / sc;
        u32x4 q;
#pragma unroll
        for (int j = 0; j < 4; ++j) { const int a = (int)rintf(v[j].x * inv), b = (int)rintf(v[j].y * inv), c = (int)rintf(v[j].z * inv), d = (int)rintf(v[j].w * inv);
            q[j] = (unsigned)(a & 255) | ((unsigned)(b & 255) << 8) | ((unsigned)(c & 255) << 16) | ((unsigned)(d & 255) << 24); }
        *(u32x4*)(dst + (size_t)r * 1024 + lane * 16) = q;
        if (lane == 0) scales[r] = sc;
    }
}
template <int NR>
__device__ __forceinline__ void peer_u8i(const RowBufN<NR>& rb, int r0, const LAS unsigned char* xq, const LAS unsigned* ent, LAS float* cf, const LAS float* sul, int e0, int lane) {
    int pr[8];
    const int ev = (int)ent[e0 + (lane & 7)];
#pragma unroll
    for (int i = 0; i < 8; ++i) {
        const int slot = (__builtin_amdgcn_readlane(ev, i) >> 21) & 3;
        const u32x4 xv = *(const LAS u32x4*)(xq + slot * 1024 + lane * 16);
        const u32x4 q = rb.a[r0 + i];
        int s = __builtin_amdgcn_sdot4((int)xv.x, (int)q.x, 0, false); s = __builtin_amdgcn_sdot4((int)xv.y, (int)q.y, s, false);
        s = __builtin_amdgcn_sdot4((int)xv.z, (int)q.z, s, false); s = __builtin_amdgcn_sdot4((int)xv.w, (int)q.w, s, false);
        pr[i] = s;
    }
    int r4[4], r2[2], r1;
    { const bool up = (lane & 32) != 0;
#pragma unroll
      for (int i = 0; i < 4; ++i) { const int keep = up ? pr[i + 4] : pr[i], send = up ? pr[i] : pr[i + 4]; r4[i] = keep + __shfl_xor(send, 32); } }
    { const bool up = (lane & 16) != 0;
#pragma unroll
      for (int i = 0; i < 2; ++i) { const int keep = up ? r4[i + 2] : r4[i], send = up ? r4[i] : r4[i + 2]; r2[i] = keep + __shfl_xor(send, 16); } }
    { const bool up = (lane & 8) != 0; const int keep = up ? r2[1] : r2[0], send = up ? r2[0] : r2[1]; r1 = keep + __shfl_xor(send, 8); }
    r1 += __shfl_xor(r1, 4); r1 += __shfl_xor(r1, 2); r1 += __shfl_xor(r1, 1);
    const float gate = cf[e0 + (lane >> 3)];
    const float coef = gate * gelu_tanh((float)r1 * sul[e0 + (lane >> 3)]);
    if ((lane & 7) == 0) cf[e0 + (lane >> 3)] = coef;
}
template <bool FAKE>
__device__ __forceinline__ f32x2 cvt8(unsigned w, bool hi) {
    if (FAKE) { const unsigned t = hi ? (w >> 16) : w; return (f32x2){__builtin_bit_cast(float, (t << 23) | 0x30000000u), __builtin_bit_cast(float, ((t >> 8) << 23) | 0x30000000u)}; }
    return hi ? __builtin_amdgcn_cvt_pk_f32_fp8((int)w, true) : __builtin_amdgcn_cvt_pk_f32_fp8((int)w, false);
}
template <bool FAKE = false>
__device__ __forceinline__ void peer_acc8p(f32x2 (&o)[8], const float c, const u32x4 q) {
    const f32x2 c2 = {c, c};
#pragma unroll
    for (int j = 0; j < 4; ++j) { const f32x2 lo = cvt8<FAKE>(q[j], false), hi = cvt8<FAKE>(q[j], true);
        o[2 * j] += c2 * lo; o[2 * j + 1] += c2 * hi; }
}
template <int NR, bool FAKE>
__device__ __forceinline__ void peer_vNp(const RowBufN<NR>& rb, f32x2 (&outv)[4][8], const LAS unsigned* ent, const LAS float* cf, int b, int lane) {
    const int ev = (int)ent[b * NR + (lane & (NR - 1))]; const float cv = cf[b * NR + (lane & (NR - 1))];
    int slot[NR]; float c[NR];
#pragma unroll
    for (int i = 0; i < NR; ++i) { slot[i] = (__builtin_amdgcn_readlane(ev, i) >> 21) & 3; c[i] = rdlane_f(cv, i); }
#pragma unroll
    for (int q4 = 0; q4 < NR / 4; ++q4) {
#pragma unroll
        for (int s = 0; s < 4; ++s) {
#pragma unroll
            for (int i = 4 * q4; i < 4 * q4 + 4; ++i) if (slot[i] == s) peer_acc8p<FAKE>(outv[s], c[i], rb.a[i]);
            __builtin_amdgcn_sched_barrier(0);
        }
    }
}
template <int PV, bool FAKE>
__device__ __forceinline__ void peer_passv(f32x2 (&outv)[4][8], const unsigned char* TV, const LAS unsigned* ent, const LAS float* cf, int lane) {
    RowBufN<PV> A, B, C;
    constexpr int NBV = 512 / PV;
    peer_loadN<PV>(A, TV, ent, 0, lane); peer_loadN<PV>(B, TV, ent, 1, lane);
#pragma unroll 1
    for (int b = 0; b + 2 < NBV; b += 3) {
        peer_loadN<PV>(C, TV, ent, b + 2, lane);
        peer_vNp<PV, FAKE>(A, outv, ent, cf, b, lane);
        if (b + 3 < NBV) peer_loadN<PV>(A, TV, ent, b + 3, lane);
        peer_vNp<PV, FAKE>(B, outv, ent, cf, b + 1, lane);
        if (b + 4 < NBV) peer_loadN<PV>(B, TV, ent, b + 4, lane);
        peer_vNp<PV, FAKE>(C, outv, ent, cf, b + 2, lane);
    }
    peer_vNp<PV, FAKE>(A, outv, ent, cf, NBV - 1, lane);
}
__device__ __forceinline__ void p_peer_expert5(const Frame& F, unsigned char* ws, float* xres, const float oscale, const XcdBarrier& xbar, const int mode, const bool do_norm, const size_t xn_off) {
    const bf16_t* XN = (const bf16_t*)(ws + xn_off); const unsigned char* TU = ws + WS_TAB8U; const unsigned char* TV = ws + WS_TAB8V;
    const float* SU = (const float*)(ws + WS_TABSU); const float* SV = (const float*)(ws + WS_TABSV);
    const unsigned short* EID = (const unsigned short*)(ws + PE_EID); const float* GATE = (const float*)(ws + PE_GATE); const float* SSQ = (const float*)(ws + PE_SSQ);
    const int gw = F.bid * NWAVES + F.wave, NGW = F.G * NWAVES, lane = F.lane;
    LAS unsigned* ent = (LAS unsigned*)(F.lds + F.wave * 6144);
    LAS float* cf = (LAS float*)(F.lds + F.wave * 6144 + 2048);
    LAS float* sul = (LAS float*)(F.lds + F.wave * 6144 + 4096);
    LAS unsigned char* xq = F.lds + 49152 + F.wave * 4096;
    constexpr int PU = 8, PV = 8;
    const int nrounds = (T + NGW * 4 - 1) / (NGW * 4);
    for (int rnd = 0; rnd < nrounds; ++rnd) {
        const int m4 = (rnd * NGW + gw) * 4;
        if (m4 < T) {
            {
                float sx[4];
#pragma unroll
                for (int s = 0; s < 4; ++s) { const size_t m = (size_t)(m4 + s);
                    const u32x4 xa = *(const u32x4*)(XN + m * 1024 + lane * 16), xb = *(const u32x4*)(XN + m * 1024 + lane * 16 + 8);
                    float xf[16] = {bf_lo(xa.x), bf_hi(xa.x), bf_lo(xa.y), bf_hi(xa.y), bf_lo(xa.z), bf_hi(xa.z), bf_lo(xa.w), bf_hi(xa.w),
                                    bf_lo(xb.x), bf_hi(xb.x), bf_lo(xb.y), bf_hi(xb.y), bf_lo(xb.z), bf_hi(xb.z), bf_lo(xb.w), bf_hi(xb.w)};
                    float am = 0.f;
#pragma unroll
                    for (int i = 0; i < 16; ++i) am = fmaxf(am, fabsf(xf[i]));
#pragma unroll
                    for (int o = 1; o < 64; o <<= 1) am = fmaxf(am, __shfl_xor(am, o));
                    sx[s] = am > 0.f ? am * (1.0f / 127.0f) : 1.0f; const float inv = 1.0f / sx[s];
                    { const float pq = (lane < 16) ? SSQ[m * 16 + lane] : 0.f; sx[s] *= 1.0f / sqrtf(wave_sum(pq) * (1.0f / 1024.0f) + 1e-6f); }
                    u32x4 q;
#pragma unroll
                    for (int j = 0; j < 4; ++j) { const int a = (int)rintf(xf[4 * j] * inv), b = (int)rintf(xf[4 * j + 1] * inv), c = (int)rintf(xf[4 * j + 2] * inv), d = (int)rintf(xf[4 * j + 3] * inv);
                        q[j] = (unsigned)(a & 255) | ((unsigned)(b & 255) << 8) | ((unsigned)(c & 255) << 16) | ((unsigned)(d & 255) << 24); }
                    *(LAS u32x4*)(xq + s * 1024 + lane * 16) = q; }
                int id[4][2]; float gg[4][2], su[4][2];
#pragma unroll
                for (int s = 0; s < 4; ++s) { const size_t m = (size_t)(m4 + s);
                    id[s][0] = EID[m * 128 + lane]; id[s][1] = EID[m * 128 + 64 + lane];
                    gg[s][0] = GATE[m * 128 + lane] * SV[id[s][0]]; gg[s][1] = GATE[m * 128 + 64 + lane] * SV[id[s][1]];
                    su[s][0] = SU[id[s][0]] * sx[s]; su[s][1] = SU[id[s][1]] * sx[s]; }
                LAS unsigned* hcnt = (LAS unsigned*)sul;
                if (lane < 32) hcnt[lane] = 0u;
                LDS_WAIT();
#pragma unroll
                for (int s = 0; s < 4; ++s)
#pragma unroll
                    for (int w = 0; w < 2; ++w) __hip_atomic_fetch_add(hcnt + (id[s][w] >> 10), 1u, __ATOMIC_RELAXED, __HIP_MEMORY_SCOPE_WORKGROUP);
                LDS_WAIT();
                unsigned basev;
                { const unsigned cntv = (lane < 16) ? hcnt[lane] : 0u;
                  unsigned incl = cntv;
                  const bool rev = (rnd & 1) != 0;
#pragma unroll
                  for (int o = 1; o < 16; o <<= 1) { const unsigned up = (unsigned)__shfl_up((int)incl, o), dn = (unsigned)__shfl_down((int)incl, o);
                      const unsigned nb = rev ? ((lane + o < 16) ? dn : 0u) : ((lane >= o) ? up : 0u); incl += nb; }
                  basev = incl - cntv; }
                LDS_WAIT();
                if (lane < 16) hcnt[16 + lane] = basev;
                LDS_WAIT();
                int posv[4][2];
#pragma unroll
                for (int s = 0; s < 4; ++s)
#pragma unroll
                    for (int w = 0; w < 2; ++w) posv[s][w] = (int)__hip_atomic_fetch_add(hcnt + 16 + (id[s][w] >> 10), 1u, __ATOMIC_RELAXED, __HIP_MEMORY_SCOPE_WORKGROUP);
                LDS_WAIT();
#pragma unroll
                for (int s = 0; s < 4; ++s)
#pragma unroll
                    for (int w = 0; w < 2; ++w) { const int pos = posv[s][w];
                        ent[pos] = ((unsigned)s << 21) | ((unsigned)(w * 64 + lane) << 14) | (unsigned)(mode == 4 ? (id[s][w] & 7) : id[s][w]); cf[pos] = gg[s][w]; }
                LDS_WAIT();
#pragma unroll
                for (int s = 0; s < 4; ++s)
#pragma unroll
                    for (int w = 0; w < 2; ++w) sul[posv[s][w]] = su[s][w];
            }
            LDS_WAIT();
            if (mode != 1 && mode != 3) {
                RowBufN<PU> A, B, C;
                constexpr int NBU = 512 / PU;
                peer_loadN<PU>(A, TU, ent, 0, lane); peer_loadN<PU>(B, TU, ent, 1, lane);
#pragma unroll 1
                for (int b = 0; b + 2 < NBU; b += 3) {
                    peer_loadN<PU>(C, TU, ent, b + 2, lane);
                    peer_u8i<PU>(A, 0, xq, ent, cf, sul, b * PU, lane);
                    if (b + 3 < NBU) peer_loadN<PU>(A, TU, ent, b + 3, lane);
                    peer_u8i<PU>(B, 0, xq, ent, cf, sul, (b + 1) * PU, lane);
                    if (b + 4 < NBU) peer_loadN<PU>(B, TU, ent, b + 4, lane);
                    peer_u8i<PU>(C, 0, xq, ent, cf, sul, (b + 2) * PU, lane);
                }
                peer_u8i<PU>(A, 0, xq, ent, cf, sul, (NBU - 1) * PU, lane);
            }
            LDS_WAIT();
            f32x2 outv[4][8];
#pragma unroll
            for (int s = 0; s < 4; ++s)
#pragma unroll
                for (int i = 0; i < 8; ++i) outv[s][i] = (f32x2){0.f, 0.f};
            if (mode != 1 && mode != 2) {
                if (mode == 5) peer_passv<PV, true>(outv, TV, ent, cf, lane); else peer_passv<PV, false>(outv, TV, ent, cf, lane);
            }
            asm volatile("" ::: "memory"); __builtin_amdgcn_sched_barrier(0);
#pragma unroll
            for (int s = 0; s < 4; ++s) {
                f32x4* o = (f32x4*)(xres + (size_t)(m4 + s) * 1024 + lane * 16);
                f32x4 nv[4]; float ss = 0.f;
#pragma unroll
                for (int j = 0; j < 4; ++j) { f32x4 a0 = o[j]; const f32x4 add = (f32x4){outv[s][2 * j].x, outv[s][2 * j].y, outv[s][2 * j + 1].x, outv[s][2 * j + 1].y};
                    if (oscale != 0.f) a0 += add; else asm volatile("" :: "v"(add)); o[j] = a0; nv[j] = a0;
                    ss += (a0.x * a0.x + a0.y * a0.y) + (a0.z * a0.z + a0.w * a0.w); }
                if (do_norm && oscale != 0.f) {
                    const float rstd = 1.0f / sqrtf(wave_sum(ss) * (1.f / DM) + 1e-6f);
                    const f32x4* gp = (const f32x4*)((const float*)(ws + WS_CMPB + 4096) + lane * 16);
                    u32x4 w0, w1;
                    { const f32x4 g0 = gp[0], g1 = gp[1], g2 = gp[2], g3 = gp[3];
                      w0.x = pk2(nv[0].x * rstd * g0.x, nv[0].y * rstd * g0.y); w0.y = pk2(nv[0].z * rstd * g0.z, nv[0].w * rstd * g0.w);
                      w0.z = pk2(nv[1].x * rstd * g1.x, nv[1].y * rstd * g1.y); w0.w = pk2(nv[1].z * rstd * g1.z, nv[1].w * rstd * g1.w);
                      w1.x = pk2(nv[2].x * rstd * g2.x, nv[2].y * rstd * g2.y); w1.y = pk2(nv[2].z * rstd * g2.z, nv[2].w * rstd * g2.w);
                      w1.z = pk2(nv[3].x * rstd * g3.x, nv[3].y * rstd * g3.y); w1.w = pk2(nv[3].z * rstd * g3.z, nv[3].w * rstd * g3.w); }
                    u32x4* xo = (u32x4*)((bf16_t*)(ws + WS_XN) + (size_t)(m4 + s) * 1024 + lane * 16);
                    xo[0] = w0; xo[1] = w1;
                }
                asm volatile("" ::: "memory"); __builtin_amdgcn_sched_barrier(0);
            }
        }
    }
}

constexpr size_t L1_QN = WS_R3;
constexpr size_t L1_KS = WS_R3 + 32 * MiB;
constexpr size_t L1_KW = WS_R3 + 40 * MiB;
constexpr size_t L1_VST = WS_R3 + 48 * MiB;
constexpr size_t L1_VWT = WS_R3 + 56 * MiB;
constexpr size_t L1_KCR = WS_R3 + 64 * MiB;
constexpr size_t L1_VCR = WS_R3 + 72 * MiB;
constexpr size_t L1_GATES = WS_R3 + 81 * MiB;
constexpr size_t L1_H1 = WS_R3 + 84 * MiB;
constexpr size_t L1_CMPO = WS_R3 + 88 * MiB;
constexpr size_t L1_KC = WS_R3 + 90 * MiB;
constexpr size_t L1_VCT = WS_R3 + 91 * MiB;
constexpr size_t L1_SELB = WS_R3 + 92 * MiB;
constexpr size_t L1_OC = WS_TABU;
constexpr size_t L1_CAT = WS_XN;
constexpr size_t L1_UPD = WS_R3;
constexpr size_t L1_DECAY = WS_R3 + 128 * MiB;

__device__ __forceinline__ void p_l1_prep(const Frame& F, const Args& a, unsigned char* ws) {
    const bf16_t* P = (const bf16_t*)(ws + WS_PROJ);
    const f32x2* rope = (const f32x2*)(ws + WS_ROPE);
    bf16_t* QN = (bf16_t*)(ws + L1_QN); bf16_t* KS = (bf16_t*)(ws + L1_KS); bf16_t* KW = (bf16_t*)(ws + L1_KW);
    bf16_t* KCR = (bf16_t*)(ws + L1_KCR); bf16_t* VCR = (bf16_t*)(ws + L1_VCR); float* GATES = (float*)(ws + L1_GATES);
    const int gw = F.bid * NWAVES + F.wave, NGW = F.G * NWAVES, lane = F.lane, hs = lane >> 3, sub = lane & 7;
    float qg[8], kg[8];
#pragma unroll
    for (int j = 0; j < 8; ++j) { qg[j] = a.in[I_L1_QG][sub * 8 + j]; kg[j] = a.in[I_L1_KG][sub * 8 + j]; }
    const int srccol = (hs < 2) ? C1_KS + hs * 64 : (hs < 4) ? C1_KW + (hs - 2) * 64 : (hs < 6) ? C1_KC + (hs - 4) * 64 : C1_VC + (hs - 6) * 64;
    bf16_t* dstbuf = (hs < 2) ? KS : (hs < 4) ? KW : (hs < 6) ? KCR : VCR;
    const int g2 = hs & 1;
    for (int m = gw; m < T; m += NGW) {
        const int b = m >> 12, t = m & 4095;
        const bf16_t* row = P + (size_t)m * N_IN1;
        f32x2 cs[8];
#pragma unroll
        for (int j = 0; j < 4; ++j) { const f32x4 c4 = *(const f32x4*)(rope + t * 32 + (sub & 3) * 8 + 2 * j); cs[2 * j] = (f32x2){c4.x, c4.y}; cs[2 * j + 1] = (f32x2){c4.z, c4.w}; }
        float v[8];
        head8_load(row + C1_Q + lane * 8, v); head8_norm(v, qg); head8_rope(v, cs, sub >= 4); head8_store(QN + (size_t)m * 512 + lane * 8, v, 0.125f);
        {
            const u32x4 raw = *(const u32x4*)(row + srccol + sub * 8);
            v[0] = bf_lo(raw.x); v[1] = bf_hi(raw.x); v[2] = bf_lo(raw.y); v[3] = bf_hi(raw.y); v[4] = bf_lo(raw.z); v[5] = bf_hi(raw.z); v[6] = bf_lo(raw.w); v[7] = bf_hi(raw.w);
            head8_norm(v, kg); head8_rope(v, cs, sub >= 4);
            u32x4 q; q.x = pk2(v[0], v[1]); q.y = pk2(v[2], v[3]); q.z = pk2(v[4], v[5]); q.w = pk2(v[6], v[7]);
            if (hs >= 4) q = raw;
            *(u32x4*)(dstbuf + ((size_t)(b * 2 + g2) * 4096 + t) * 64 + sub * 8) = q;
        }
        if (lane < 24) GATES[(size_t)m * 24 + lane] = sigmoidf_(bf2f(row[C1_GL + lane]));
    }
    for (int it = gw; it < 2 * NB * 2 * 64; it += NGW) {
        const int tb = it & 63, g = (it >> 6) & 1, b = (it >> 7) & 7, w = it >> 10;
        const size_t m = (size_t)b * 4096 + tb * 64 + lane;
        unsigned r[32];
#pragma unroll
        for (int j = 0; j < 8; ++j) { const u32x4 q = *(const u32x4*)(P + m * N_IN1 + (w ? C1_VW : C1_VS) + g * 64 + j * 8); r[4 * j] = q.x; r[4 * j + 1] = q.y; r[4 * j + 2] = q.z; r[4 * j + 3] = q.w; }
        bf16_t* dst = (bf16_t*)(ws + (w ? L1_VWT : L1_VST)) + ((size_t)(b * 2 + g) * 64) * 4096 + tb * 64 + lane;
#pragma unroll
        for (int d = 0; d < 64; ++d) dst[(size_t)d * 4096] = (bf16_t)((d & 1) ? (r[d >> 1] >> 16) : (r[d >> 1] & 0xffffu));
    }
}

namespace pg8 {
struct EpiCmp1 {
    static constexpr bool PERM = true;
    bf16_t* O; const float* bias;
    __device__ __forceinline__ void operator()(const f32x4 (&acc)[2][2][4][2], const Unit& u, int wr, int wc, int fr, int fq) const {
        const int row0 = u.pm * BM + wr * 64 + fr, col0 = wc * 32 + 8 * fq;
#pragma unroll
        for (int ai = 0; ai < 2; ++ai)
#pragma unroll
            for (int m = 0; m < 4; ++m) { bf16_t* rowp = O + (size_t)(row0 + ai * HALF + m * 16) * 256 + col0;
#pragma unroll
                for (int bj = 0; bj < 2; ++bj) { const float* bp = bias + u.pn * 256 + col0 + bj * HALF;
                    const f32x4 v0 = acc[ai][bj][m][0] + *(const f32x4*)bp, v1 = acc[ai][bj][m][1] + *(const f32x4*)(bp + 4);
                    u32x4 w; w.x = pk2(gelu_tanh(v0[0]), gelu_tanh(v0[1])); w.y = pk2(gelu_tanh(v0[2]), gelu_tanh(v0[3]));
                    w.z = pk2(gelu_tanh(v1[0]), gelu_tanh(v1[1])); w.w = pk2(gelu_tanh(v1[2]), gelu_tanh(v1[3]));
                    *(u32x4*)(rowp + bj * HALF) = w; }
                asm volatile("" ::: "memory"); __builtin_amdgcn_sched_barrier(0); }
    }
};
struct EpiCmp2 {
    static constexpr bool PERM = false;
    float* C;
    __device__ __forceinline__ void operator()(const f32x4 (&acc)[2][2][4][2], const Unit& u, int wr, int wc, int fr, int fq) const {
        if (wc >= 2) return;
        const int row0 = u.pm * BM + wr * 64 + fr, col0 = wc * 32 + 4 * fq;
#pragma unroll
        for (int ai = 0; ai < 2; ++ai)
#pragma unroll
            for (int m = 0; m < 4; ++m)
#pragma unroll
                for (int n = 0; n < 2; ++n) *(f32x4*)(C + (size_t)(row0 + ai * HALF + m * 16) * 64 + col0 + n * 16) = acc[ai][0][m][n];
    }
};
}

__device__ __forceinline__ void p_cmp_final(const Frame& F, const Args& a, unsigned char* ws) {
    const float* CMPO = (const float*)(ws + L1_CMPO); const f32x2* rope = (const f32x2*)(ws + WS_ROPE);
    bf16_t* KC = (bf16_t*)(ws + L1_KC); bf16_t* VCT = (bf16_t*)(ws + L1_VCT);
    const int gw = F.bid * NWAVES + F.wave, NGW = F.G * NWAVES, lane = F.lane;
    const float kg = a.in[I_L1_KG][lane];
    for (int r = gw; r < 8192; r += NGW) {
        float v = CMPO[(size_t)r * 64 + lane];
        const int rr = r & 4095, bg = rr >> 8, c = rr & 255;
        if (r < 4096) {
            const float ss = wave_sum(v * v);
            v = v * (1.0f / sqrtf(ss * (1.f / 64.f) + 1e-6f)) * kg;
            const int pos = (c < 255) ? 16 * c + 31 : 0;
            v = rope_apply(v, rope[pos * 32 + (lane & 31)], lane);
            KC[((size_t)bg * 256 + c) * 64 + lane] = (c < 255) ? (bf16_t)f2bf(v) : (bf16_t)0;
        } else {
            VCT[((size_t)bg * 64 + lane) * 256 + c] = (c < 255) ? (bf16_t)f2bf(v) : (bf16_t)0;
        }
    }
}

__device__ __forceinline__ void att_load2(AttStage& s, const bf16_t* Kg, const bf16_t* Vtg, int vstride, int key0, int tid) {
    s.kreg = *(const u32x4*)(Kg + (size_t)(key0 + (tid >> 3)) * 64 + (tid & 7) * 8);
    s.vreg = *(const u32x4*)(Vtg + (size_t)(tid >> 3) * vstride + key0 + (tid & 7) * 8);
}
__device__ __forceinline__ float score_bound_c2(const float* qg, const float* kg) {
    float mq = 0.f, mk_ = 0.f;
    for (int i = 0; i < 64; ++i) { mq = fmaxf(mq, fabsf(qg[i])); mk_ = fmaxf(mk_, fabsf(kg[i])); }
    return (8.0f * mq * mk_ + 0.5f) * 1.4426950408889634f;
}

constexpr int CA_KB = 256 * 144, CA_VSTR = 528, CA_VB = 64 * CA_VSTR, CA_IMP = CA_KB + CA_VB;
__device__ __forceinline__ void p_cmp_attn(const Frame& F, const Args& a, unsigned char* ws) {
    const bf16_t* QN = (const bf16_t*)(ws + L1_QN); const bf16_t* KC = (const bf16_t*)(ws + L1_KC); const bf16_t* VCT = (const bf16_t*)(ws + L1_VCT);
    float* OC = (float*)(ws + L1_OC); u64* SELB = (u64*)(ws + L1_SELB);
    LAS float* impL = (LAS float*)(F.lds + CA_IMP);
    const int lane = F.lane, wave = F.wave, h = lane >> 5, c = lane & 31, tid = F.tid;
    const float c2 = score_bound_c2(a.in[I_L1_QG], a.in[I_L1_KG]), c1 = 1.4426950408889634f;
    for (int u = F.bid; u < 1024; u += F.G) {
        const int b = (u >> 7) & 7, g = (u >> 6) & 1, rnd = u >> 8, qt = (rnd & 1) ? 63 - (u & 63) : (u & 63), q0 = qt * 64;
        const int bg = b * 2 + g; const size_t mb = (size_t)b * 4096;
        const int t = q0 + wave * 8 + (c >> 2), head = g * 4 + (c & 3);
        bf16x8 Qf[4];
#pragma unroll
        for (int ks = 0; ks < 4; ++ks) Qf[ks] = *(const bf16x8*)(QN + (mb + t) * 512 + head * 64 + ks * 16 + 8 * h);
        const int L = (t >= 31) ? (((t - 31) >> 4) < 254 ? ((t - 31) >> 4) : 254) : -1;
        const int tmax = q0 + 63; const int Lmax = (tmax >= 31) ? (((tmax - 31) >> 4) < 254 ? ((tmax - 31) >> 4) : 254) : -1;
        const int nkt = (Lmax >= 0) ? (Lmax >> 6) + 1 : 0;
        const bf16_t* Kg = KC + (size_t)bg * 256 * 64; const bf16_t* Vtg = VCT + (size_t)bg * 64 * 256;
        __syncthreads();
        for (int i = tid; i < nkt * 512; i += NTHREADS) {
            const int key = i >> 3, ch = i & 7;
            *(LAS u32x4*)(F.lds + key * 144 + ch * 16) = *(const u32x4*)(Kg + (size_t)key * 64 + ch * 8);
        }
        for (int i = tid; i < 64 * nkt * 8; i += NTHREADS) {
            const int d = i / (nkt * 8), ch = i % (nkt * 8);
            const u32x4 v = *(const u32x4*)(Vtg + (size_t)d * 256 + ch * 8);
            LAS unsigned char* p = F.lds + CA_KB + d * CA_VSTR + ch * 16;
            *(LAS u32x2*)p = (u32x2){v.x, v.y}; *(LAS u32x2*)(p + 8) = (u32x2){v.z, v.w};
        }
        __syncthreads();
        f32x16 O[2], IMP[2]; float l = 0.f;
#pragma unroll
        for (int i = 0; i < 16; ++i) { O[0][i] = 0.f; O[1][i] = 0.f; IMP[0][i] = 0.f; IMP[1][i] = 0.f; }
        for (int st = 0; st < nkt * 2; ++st) {
            f32x16 S = {0.f, 0.f, 0.f, 0.f, 0.f, 0.f, 0.f, 0.f, 0.f, 0.f, 0.f, 0.f, 0.f, 0.f, 0.f, 0.f};
            { const LAS unsigned char* kp = F.lds + (st * 32 + c) * 144 + h * 16;
#pragma unroll
              for (int ks = 0; ks < 4; ++ks) S = __builtin_amdgcn_mfma_f32_32x32x16_bf16(*(const LAS bf16x8*)(kp + ks * 32), Qf[ks], S, 0, 0, 0); }
            float p[16];
#pragma unroll
            for (int i = 0; i < 16; ++i) {
                const int cidx = st * 32 + (i & 3) + 8 * (i >> 2) + 4 * h;
                const float e = __builtin_amdgcn_exp2f(S[i] * c1 - c2);
                p[i] = (cidx <= L) ? e : 0.f; l += p[i];
            }
            const bf16x8 P0 = pack8(p[0], p[1], p[2], p[3], p[4], p[5], p[6], p[7]);
            const bf16x8 P1 = pack8(p[8], p[9], p[10], p[11], p[12], p[13], p[14], p[15]);
#pragma unroll
            for (int dt = 0; dt < 2; ++dt) {
                const LAS unsigned char* vp = F.lds + CA_KB + (dt * 32 + c) * CA_VSTR + (st * 32 + 4 * h) * 2;
                const u32x2 a0 = *(const LAS u32x2*)(vp), a1 = *(const LAS u32x2*)(vp + 16), b0 = *(const LAS u32x2*)(vp + 32), b1 = *(const LAS u32x2*)(vp + 48);
                O[dt] = __builtin_amdgcn_mfma_f32_32x32x16_bf16(__builtin_bit_cast(bf16x8, ((u32x4){a0.x, a0.y, a1.x, a1.y})), P0, O[dt], 0, 0, 0);
                O[dt] = __builtin_amdgcn_mfma_f32_32x32x16_bf16(__builtin_bit_cast(bf16x8, ((u32x4){b0.x, b0.y, b1.x, b1.y})), P1, O[dt], 0, 0, 0);
            }
#pragma unroll
            for (int jt = 0; jt < 2; ++jt)
#pragma unroll
                for (int s = 0; s < 2; ++s) {
                    unsigned wv[4];
#pragma unroll
                    for (int e2 = 0; e2 < 4; ++e2) {
                        unsigned pr = 0u;
#pragma unroll
                        for (int q = 0; q < 2; ++q) { const int jj = 2 * e2 + q; const int kap = 16 * s + 8 * (jj >> 2) + 4 * h + (jj & 3);
                            const int off = st * 32 + kap - 4 * (32 * jt + c);
                            const unsigned wbits = (off == 0 || off == 4) ? 0x3F80u : ((off >= 1 && off <= 3) ? 0x4000u : 0u);
                            pr |= wbits << (16 * q); }
                        wv[e2] = pr;
                    }
                    const bf16x8 Wf = __builtin_bit_cast(bf16x8, ((u32x4){wv[0], wv[1], wv[2], wv[3]}));
                    IMP[jt] = __builtin_amdgcn_mfma_f32_32x32x16_bf16(Wf, s ? P1 : P0, IMP[jt], 0, 0, 0);
                }
        }
        const float lt = l + __shfl_xor(l, 32);
        const float inv = 1.0f / fmaxf(lt, 1e-30f);
        { float* orow = OC + (mb + t) * 512 + head * 64;
#pragma unroll
          for (int dt = 0; dt < 2; ++dt)
#pragma unroll
            for (int i4 = 0; i4 < 4; ++i4) { const int d = dt * 32 + 8 * i4 + 4 * h;
                *(f32x4*)(orow + d) = (f32x4){O[dt][4 * i4] * inv, O[dt][4 * i4 + 1] * inv, O[dt][4 * i4 + 2] * inv, O[dt][4 * i4 + 3] * inv}; } }
#pragma unroll
        for (int jt = 0; jt < 2; ++jt)
#pragma unroll
            for (int i = 0; i < 16; ++i) {
                float v = IMP[jt][i] * inv; v += __shfl_xor(v, 1); v += __shfl_xor(v, 2);
                if ((c & 3) == 0) impL[(wave * 8 + (c >> 2)) * 65 + 32 * jt + (i & 3) + 8 * (i >> 2) + 4 * h] = v;
            }
        __syncthreads();
        if (tid < 64) {
            const int tq = q0 + tid, cur = tq >> 6;
            u64 mask;
            if (cur + 1 <= 16) mask = (1ull << (cur + 1)) - 1ull;
            else {
                unsigned top[16];
#pragma unroll
                for (int blk = 0; blk < 4; ++blk) {
                    unsigned k16[16];
#pragma unroll
                    for (int i = 0; i < 16; ++i) { const int j = blk * 16 + i; const float x = impL[tid * 65 + j];
                        const unsigned key = (j > cur) ? 0u : ((j == 0 || j == cur) ? 0xFFFFFFC0u : (mono_u32(x) & ~0x3Fu)) | (unsigned)(63 - j);
                        k16[i] = (j > cur) ? 0u : key; }
                    sort16_desc(k16);
                    if (blk == 0) {
#pragma unroll
                        for (int i = 0; i < 16; ++i) top[i] = k16[i];
                    } else merge16_desc(top, k16);
                }
                mask = 0ull;
#pragma unroll
                for (int i = 0; i < 16; ++i) mask |= 1ull << (63 - (int)(top[i] & 63u));
            }
            SELB[(size_t)bg * 4096 + tq] = mask;
        }
    }
}

template <bool MASKED>
__device__ __forceinline__ void nsa_run(const Frame& F, int kt0, int kt1, int kt_hi, AttStage& st, const bf16_t* Kg, const bf16_t* Vtg, const bf16x8 (&Qf)[2][4], const u64 (&selw)[2], const int (&qidx)[2],
                                        const float c1, const float c2, const int wlen, f32x16 (&O)[2][2], float (&l)[2]) {
    const int lane = F.lane, h = lane >> 5, tid = F.tid;
#pragma unroll 1
    for (int kt = kt0; kt < kt1; ++kt) {
        LAS unsigned char* buf = F.lds + (kt & 1) * AT_BUF;
        if (kt + 1 < kt_hi) att_load(st, Kg, Vtg, (kt + 1) * 64, tid);
#pragma unroll 1
        for (int sub = 0; sub < 2; ++sub) {
            bf16x8 Kf[4];
            att_kfrags(buf, sub, Kf, lane);
#pragma unroll
            for (int ct = 0; ct < 2; ++ct) {
                __builtin_amdgcn_sched_barrier(0);
                const f32x16 S = att_qk_f(Kf, Qf[ct]);
                const bool flag = (selw[ct] >> kt) & 1ull;
                const float c2e = flag ? c2 : 3.0e30f;
                const int dbase = qidx[ct] - (kt * 64 + sub * 32 + 4 * h);
                float p[16];
#pragma unroll
                for (int i = 0; i < 16; ++i) {
                    const float e = __builtin_amdgcn_exp2f(S[i] * c1 - c2e);
                    p[i] = (!MASKED || (unsigned)(dbase - ((i & 3) + 8 * (i >> 2))) < (unsigned)wlen) ? e : 0.f; l[ct] += p[i];
                }
                const bf16x8 P0 = pack8(p[0], p[1], p[2], p[3], p[4], p[5], p[6], p[7]);
                const bf16x8 P1 = pack8(p[8], p[9], p[10], p[11], p[12], p[13], p[14], p[15]);
                att_pv2(buf, sub, P0, P1, O[ct], lane);
            }
        }
        if (kt + 1 < kt_hi) att_store(st, F.lds + ((kt + 1) & 1) * AT_BUF, tid);
        __syncthreads();
    }
}
__device__ __forceinline__ void p_nsa_attn(const Frame& F, const Args& a, unsigned char* ws) {
    const bf16_t* QN = (const bf16_t*)(ws + L1_QN);
    const u64* SELB = (const u64*)(ws + L1_SELB); float* OC = (float*)(ws + L1_OC); const float* GATES = (const float*)(ws + L1_GATES);
    bf16_t* CAT = (bf16_t*)(ws + L1_CAT);
    const int lane = F.lane, wave = F.wave, h = lane >> 5, c = lane & 31, tid = F.tid;
    const float c2 = score_bound_c2(a.in[I_L1_QG], a.in[I_L1_KG]), c1 = 1.4426950408889634f;
    for (int u = F.bid; u < 512; u += F.G) {
        const int idx = u & 255, g = u >> 8, b = idx >> 5, qtr = idx & 31, qt = g ? 31 - qtr : qtr, q0 = qt * 128;
        const int bg = b * 2 + g; const size_t mb = (size_t)b * 4096;
        bf16x8 Qf[2][4]; int qidx[2];
#pragma unroll
        for (int ct = 0; ct < 2; ++ct) { qidx[ct] = q0 + wave * 16 + ct * 8 + (c >> 2);
#pragma unroll
            for (int ks = 0; ks < 4; ++ks) Qf[ct][ks] = *(const bf16x8*)(QN + (mb + qidx[ct]) * 512 + (g * 4 + (c & 3)) * 64 + ks * 16 + 8 * h); }
        const int head = g * 4 + (c & 3);
#pragma unroll 1
        for (int pass = 0; pass < 2; ++pass) {
            const bf16_t* Kg = (const bf16_t*)(ws + (pass ? L1_KW : L1_KS)) + (size_t)bg * 4096 * 64;
            const bf16_t* Vtg = (const bf16_t*)(ws + (pass ? L1_VWT : L1_VST)) + (size_t)bg * 64 * 4096;
            u64 selw[2];
#pragma unroll
            for (int ct = 0; ct < 2; ++ct) selw[ct] = pass ? ~0ull : SELB[(size_t)bg * 4096 + qidx[ct]];
            const int wlen = pass ? 512 : 0x7fffffff;
            f32x16 O[2][2]; float l[2] = {0.f, 0.f};
#pragma unroll
            for (int ct = 0; ct < 2; ++ct)
#pragma unroll
                for (int dt = 0; dt < 2; ++dt)
#pragma unroll
                    for (int i = 0; i < 16; ++i) O[ct][dt][i] = 0.f;
            const int kt_lo = pass ? ((2 * qt - 8) > 0 ? 2 * qt - 8 : 0) : 0, kt_hi = 2 * qt + 2;
            int ka = pass ? 2 * qt - 6 : 0; ka = ka < kt_lo ? kt_lo : ka; const int kb = 2 * qt;
            AttStage st; att_load(st, Kg, Vtg, kt_lo * 64, tid);
            __syncthreads();
            att_store(st, F.lds + (kt_lo & 1) * AT_BUF, tid);
            __syncthreads();
            nsa_run<true>(F, kt_lo, ka, kt_hi, st, Kg, Vtg, Qf, selw, qidx, c1, c2, wlen, O, l);
            nsa_run<false>(F, ka, kb, kt_hi, st, Kg, Vtg, Qf, selw, qidx, c1, c2, wlen, O, l);
            nsa_run<true>(F, kb, kt_hi, kt_hi, st, Kg, Vtg, Qf, selw, qidx, c1, c2, wlen, O, l);
#pragma unroll
            for (int ct = 0; ct < 2; ++ct) {
                const float lt = l[ct] + __shfl_xor(l[ct], 32);
                const float inv = 1.0f / fmaxf(lt, 1e-30f);
                const size_t m = mb + qidx[ct];
                const float gcv = GATES[m * 24 + head * 3 + 0], gsv = GATES[m * 24 + head * 3 + 1], gwv = GATES[m * 24 + head * 3 + 2];
                float* orow = OC + m * 512 + head * 64; bf16_t* crow = CAT + m * 1024 + head * 64;
#pragma unroll
                for (int dt = 0; dt < 2; ++dt)
#pragma unroll
                    for (int i4 = 0; i4 < 4; ++i4) {
                        const int d = dt * 32 + 8 * i4 + 4 * h;
                        const f32x4 prev = *(const f32x4*)(orow + d);
                        const f32x4 ov = (f32x4){O[ct][dt][4 * i4] * inv, O[ct][dt][4 * i4 + 1] * inv, O[ct][dt][4 * i4 + 2] * inv, O[ct][dt][4 * i4 + 3] * inv};
                        if (pass == 0) *(f32x4*)(orow + d) = prev * gcv + ov * gsv;
                        else { const f32x4 r = prev + ov * gwv; u32x2 w; w.x = pk2(r[0], r[1]); w.y = pk2(r[2], r[3]); *(u32x2*)(crow + d) = w; }
                    }
            }
        }
    }
}

__device__ __forceinline__ float logsigmoidf_(float x) { return fminf(x, 0.f) - log1pf(__expf(-fabsf(x))); }
__device__ __forceinline__ bf16x8 frag_lds(const LAS float* p) { const f32x4 a = *(const LAS f32x4*)p, b = *(const LAS f32x4*)(p + 4); return pack8(a[0], a[1], a[2], a[3], b[0], b[1], b[2], b[3]); }
__device__ __forceinline__ bf16x8 frag_glb(const float* p) { const f32x4 a = *(const f32x4*)p, b = *(const f32x4*)(p + 4); return pack8(a[0], a[1], a[2], a[3], b[0], b[1], b[2], b[3]); }
__device__ __forceinline__ void gla_wave_bcum(const Args& a, const bf16_t* P, size_t m0, int hh, int lane, float (&bc)[32]) {
    float wg[16];
#pragma unroll
    for (int r = 0; r < 16; ++r) wg[r] = a.in[I_L1_WGATE][r * 256 + hh * 64 + lane];
    const float bgv = a.in[I_L1_BGATE][hh * 64 + lane];
    float run = 0.f;
#pragma unroll
    for (int c = 0; c < 32; ++c) {
        const bf16_t* grow = P + (m0 + c) * N_IN1 + C1_GLOW;
        const u32x4 ga = *(const u32x4*)grow, gb = *(const u32x4*)(grow + 8);
        float acc = bgv;
        acc += wg[0] * bf_lo(ga.x); acc += wg[1] * bf_hi(ga.x); acc += wg[2] * bf_lo(ga.y); acc += wg[3] * bf_hi(ga.y); acc += wg[4] * bf_lo(ga.z); acc += wg[5] * bf_hi(ga.z); acc += wg[6] * bf_lo(ga.w); acc += wg[7] * bf_hi(ga.w);
        acc += wg[8] * bf_lo(gb.x); acc += wg[9] * bf_hi(gb.x); acc += wg[10] * bf_lo(gb.y); acc += wg[11] * bf_hi(gb.y); acc += wg[12] * bf_lo(gb.z); acc += wg[13] * bf_hi(gb.z); acc += wg[14] * bf_lo(gb.w); acc += wg[15] * bf_hi(gb.w);
        run += logsigmoidf_(acc) * 0.0625f; bc[c] = run;
    }
}
__device__ __forceinline__ bf16x8 gla_vfrag(const bf16_t* vbase, int s0) {
    unsigned short e[8];
#pragma unroll
    for (int j = 0; j < 8; ++j) e[j] = vbase[(size_t)(s0 + j) * N_IN1];
    u32x4 w; w.x = (unsigned)e[0] | ((unsigned)e[1] << 16); w.y = (unsigned)e[2] | ((unsigned)e[3] << 16); w.z = (unsigned)e[4] | ((unsigned)e[5] << 16); w.w = (unsigned)e[6] | ((unsigned)e[7] << 16);
    return __builtin_bit_cast(bf16x8, w);
}
__device__ __forceinline__ void p_gla_a(const Frame& F, const Args& a, unsigned char* ws) {
    const bf16_t* P = (const bf16_t*)(ws + WS_PROJ); float* UPD = (float*)(ws + L1_UPD); float* DECAY = (float*)(ws + L1_DECAY);
    const int lane = F.lane, r = lane & 31, h = lane >> 5;
    LAS bf16_t* kdT = (LAS bf16_t*)(F.lds + F.wave * 5120);
    const int gw = F.bid * NWAVES + F.wave, NGW = F.G * NWAVES;
    for (int u = gw; u < 4096; u += NGW) {
        const int b = u >> 9, hh = (u >> 7) & 3, n = u & 127; const size_t m0 = (size_t)b * 4096 + n * 32;
        float bc[32];
        gla_wave_bcum(a, P, m0, hh, lane, bc);
        const float blast = bc[31];
#pragma unroll
        for (int c = 0; c < 32; c += 2) {
            const float k0 = bf2f(P[(m0 + c) * N_IN1 + C1_GK + hh * 64 + lane]) * __expf(blast - bc[c]);
            const float k1 = bf2f(P[(m0 + c + 1) * N_IN1 + C1_GK + hh * 64 + lane]) * __expf(blast - bc[c + 1]);
            *(LAS unsigned*)(kdT + lane * 40 + c) = pk2(k0, k1);
        }
        DECAY[(size_t)u * 64 + lane] = __expf(blast);
        LDS_WAIT();
        bf16x8 Bf[2][2];
#pragma unroll
        for (int nt = 0; nt < 2; ++nt)
#pragma unroll
            for (int ks = 0; ks < 2; ++ks) Bf[nt][ks] = *(const LAS bf16x8*)(kdT + (32 * nt + r) * 40 + 16 * ks + 8 * h);
#pragma unroll
        for (int mt = 0; mt < 4; ++mt) {
            const bf16_t* vb = P + m0 * N_IN1 + C1_GV + hh * 128 + 32 * mt + r;
            const bf16x8 A0 = gla_vfrag(vb, 8 * h), A1 = gla_vfrag(vb, 16 + 8 * h);
#pragma unroll
            for (int nt = 0; nt < 2; ++nt) {
                f32x16 acc = {0.f, 0.f, 0.f, 0.f, 0.f, 0.f, 0.f, 0.f, 0.f, 0.f, 0.f, 0.f, 0.f, 0.f, 0.f, 0.f};
                acc = __builtin_amdgcn_mfma_f32_32x32x16_bf16(A0, Bf[nt][0], acc, 0, 0, 0);
                acc = __builtin_amdgcn_mfma_f32_32x32x16_bf16(A1, Bf[nt][1], acc, 0, 0, 0);
                float* up = UPD + (size_t)u * 8192 + 32 * nt + r;
#pragma unroll
                for (int i = 0; i < 16; ++i) up[(size_t)(32 * mt + (i & 3) + 8 * (i >> 2) + 4 * h) * 64] = acc[i];
            }
        }
        LDS_WAIT();
    }
}
__device__ __forceinline__ void p_gla_b(const Frame& F, unsigned char* ws) {
    float* UPD = (float*)(ws + L1_UPD); const float* DECAY = (const float*)(ws + L1_DECAY);
    for (int e = F.bid * NTHREADS + F.tid; e < 32 * 8192; e += F.G * NTHREADS) {
        const int bh = e >> 13, rem = e & 8191, dk = rem & 63;
        float state = 0.f;
        float* up = UPD + (size_t)bh * 128 * 8192 + rem; const float* dp = DECAY + (size_t)bh * 128 * 64 + dk;
#pragma unroll 8
        for (int n = 0; n < 128; ++n) { const float uv = up[(size_t)n * 8192], dc = dp[n * 64]; up[(size_t)n * 8192] = state; state = dc * state + uv; }
    }
}
__device__ __forceinline__ void p_gla_c(const Frame& F, const Args& a, unsigned char* ws, const int mode) {
    const bf16_t* P = (const bf16_t*)(ws + WS_PROJ); const float* PREV = (const float*)(ws + L1_UPD); bf16_t* CAT = (bf16_t*)(ws + L1_CAT);
    const int lane = F.lane, r = lane & 31, h = lane >> 5;
    LAS bf16_t* qd = (LAS bf16_t*)(F.lds + F.wave * 9472);
    LAS bf16_t* ki = qd + 32 * 72;
    const int gw = F.bid * NWAVES + F.wave, NGW = F.G * NWAVES;
    for (int u = gw; u < 4096; u += NGW) {
        const int b = u >> 9, hh = (u >> 7) & 3, n = u & 127; const size_t m0 = (size_t)b * 4096 + n * 32;
        f32x4 pr_[8]; unsigned short vr_[16];
#define GLA_FETCH(ct_) do { const float* pp_ = PREV + (size_t)u * 8192 + (size_t)(32 * (ct_) + r) * 64 + 8 * h; \
            _Pragma("unroll") for (int ks_ = 0; ks_ < 4; ++ks_) { pr_[2 * ks_] = *(const f32x4*)(pp_ + 16 * ks_); pr_[2 * ks_ + 1] = *(const f32x4*)(pp_ + 16 * ks_ + 4); } \
            const bf16_t* vb_ = P + m0 * N_IN1 + C1_GV + hh * 128 + 32 * (ct_) + r; \
            _Pragma("unroll") for (int j_ = 0; j_ < 16; ++j_) vr_[j_] = vb_[(size_t)(8 * h + (j_ & 7) + 16 * (j_ >> 3)) * N_IN1]; } while (0)
        GLA_FETCH(0);
        {
            float bc[32];
            if (mode == 1) {
#pragma unroll
                for (int c = 0; c < 32; ++c) bc[c] = -0.01f * (float)c;
            } else gla_wave_bcum(a, P, m0, hh, lane, bc);
#pragma unroll
            for (int c = 0; c < 32; ++c) {
                const float kv = bf2f(P[(m0 + c) * N_IN1 + C1_GK + hh * 64 + lane]) * __expf(-bc[c]);
                const float qv = bf2f(P[(m0 + c) * N_IN1 + C1_GQ + hh * 64 + lane]) * 0.125f * __expf(bc[c]);
                ki[c * 72 + lane] = (bf16_t)f2bf(kv); qd[c * 72 + lane] = (bf16_t)f2bf(qv);
            }
        }
        LDS_WAIT();
        bf16x8 Qa[4];
#pragma unroll
        for (int ks = 0; ks < 4; ++ks) Qa[ks] = *(const LAS bf16x8*)(qd + r * 72 + 16 * ks + 8 * h);
        {
            f32x16 at = {0.f, 0.f, 0.f, 0.f, 0.f, 0.f, 0.f, 0.f, 0.f, 0.f, 0.f, 0.f, 0.f, 0.f, 0.f, 0.f};
#pragma unroll
            for (int ks = 0; ks < 4; ++ks) at = __builtin_amdgcn_mfma_f32_32x32x16_bf16(Qa[ks], *(const LAS bf16x8*)(ki + r * 72 + 16 * ks + 8 * h), at, 0, 0, 0);
            LDS_WAIT();
#pragma unroll
            for (int i = 0; i < 16; ++i) { const int c = (i & 3) + 8 * (i >> 2) + 4 * h; ki[c * 40 + r] = (bf16_t)f2bf((r <= c) ? at[i] : 0.f); }
        }
        LDS_WAIT();
        bf16x8 Aa[2];
#pragma unroll
        for (int ks = 0; ks < 2; ++ks) Aa[ks] = *(const LAS bf16x8*)(ki + r * 40 + 16 * ks + 8 * h);
        f32x16 acc[4];
#pragma unroll
        for (int ct = 0; ct < 4; ++ct) {
            bf16x8 Bp[4], Bv[2];
#pragma unroll
            for (int ks = 0; ks < 4; ++ks) Bp[ks] = pack8(pr_[2 * ks][0], pr_[2 * ks][1], pr_[2 * ks][2], pr_[2 * ks][3], pr_[2 * ks + 1][0], pr_[2 * ks + 1][1], pr_[2 * ks + 1][2], pr_[2 * ks + 1][3]);
#pragma unroll
            for (int ks = 0; ks < 2; ++ks) { u32x4 w; w.x = (unsigned)vr_[8 * ks] | ((unsigned)vr_[8 * ks + 1] << 16); w.y = (unsigned)vr_[8 * ks + 2] | ((unsigned)vr_[8 * ks + 3] << 16);
                w.z = (unsigned)vr_[8 * ks + 4] | ((unsigned)vr_[8 * ks + 5] << 16); w.w = (unsigned)vr_[8 * ks + 6] | ((unsigned)vr_[8 * ks + 7] << 16); Bv[ks] = __builtin_bit_cast(bf16x8, w); }
            if (ct < 3) GLA_FETCH(ct + 1);
#pragma unroll
            for (int i = 0; i < 16; ++i) acc[ct][i] = 0.f;
#pragma unroll
            for (int ks = 0; ks < 4; ++ks) acc[ct] = __builtin_amdgcn_mfma_f32_32x32x16_bf16(Qa[ks], Bp[ks], acc[ct], 0, 0, 0);
#pragma unroll
            for (int ks = 0; ks < 2; ++ks) acc[ct] = __builtin_amdgcn_mfma_f32_32x32x16_bf16(Aa[ks], Bv[ks], acc[ct], 0, 0, 0);
        }
#undef GLA_FETCH
#pragma unroll
        for (int i = 0; i < 16; ++i) {
            float ss = acc[0][i] * acc[0][i] + acc[1][i] * acc[1][i] + acc[2][i] * acc[2][i] + acc[3][i] * acc[3][i];
            ss += __shfl_xor(ss, 1); ss += __shfl_xor(ss, 2); ss += __shfl_xor(ss, 4); ss += __shfl_xor(ss, 8); ss += __shfl_xor(ss, 16);
            const float rstd = 1.0f / sqrtf(ss * (1.f / 128.f) + 1e-6f);
            const int c = (i & 3) + 8 * (i >> 2) + 4 * h; const size_t m = m0 + c;
#pragma unroll
            for (int ct = 0; ct < 4; ++ct) { const int dv = 32 * ct + r;
                const float rv = bf2f(P[m * N_IN1 + C1_GR + hh * 128 + dv]);
                const bf16_t ov = (bf16_t)f2bf(acc[ct][i] * rstd * a.in[I_L1_OGAIN][dv] * rv * sigmoidf_(rv));
                if (mode == 0) CAT[m * 1024 + 512 + hh * 128 + dv] = ov; else asm volatile("" :: "v"((unsigned)ov)); }
        }
        LDS_WAIT();
    }
}
__global__ void __launch_bounds__(NTHREADS, 2) mk_fwd(Args args) {
    extern __shared__ __attribute__((aligned(16))) unsigned char lds_raw[];
    cg::grid_group grid = cg::this_grid();
    Frame F; F.lds = (LAS unsigned char*)lds_raw; F.tid = threadIdx.x; F.lane = F.tid & 63; F.wave = __builtin_amdgcn_readfirstlane(F.tid >> 6); F.G = gridDim.x; F.bid = blockIdx.x;
    unsigned char* ws = args.ws;
    const int lo = args.ph_lo, hi = args.ph_hi;
#ifndef KEEPMASK
#define KEEPMASK 0xFFFFFFFFu
#endif
#define IN(k) (((KEEPMASK >> (k)) & 1u) && lo <= (k) && (k) < hi)
#define BOTH(k) (IN(k) && IN((k) + 1))
#ifndef TMODE
#define TMODE 0
#endif
#ifndef REPMASK
#define REPMASK 0u
#endif
#define PH(k, ...) if (IN(k)) { { const int rep = 0; (void)rep; __VA_ARGS__; } if ((REPMASK >> (k)) & 1u) { xcd_barrier(xbar); { const int rep = 1; (void)rep; __VA_ARGS__; } } }
#ifdef TS_A
#define STAMP(k) do { if (F.bid == 0 && F.tid == 0) ((unsigned long long*)(ws + WS_CTL + 65536))[(k)] = __builtin_amdgcn_s_memrealtime(); } while (0)
#else
#define STAMP(k) do { } while (0)
#endif
#define GRID_BAR(k) do { if (BOTH(k)) { if ((k) == 0) grid.sync(); else xcd_barrier(xbar); } STAMP((k) + 1); } while (0)
    const float* x = args.in[I_X];
    float* out = args.out;
    volatile LAS unsigned* xst = (volatile LAS unsigned*)(F.lds + LDS_BYTES - 64);
    if (F.tid < 16) xst[F.tid] = 0u;
    __syncthreads();
    XcdBarrier xbar = xcd_barrier_post((unsigned*)(ws + WS_CTL) + 4096, xst);

    STAMP(0);
    PH(0, int base = 0; transpose_all(F, base, args.in[I_L0_WIN], 1024, 1864, (bf16_t*)(ws + WS_W_IN0), 1024, MapIn0()); transpose_all(F, base, args.in[I_L0_WGLU], 512, 512, (bf16_t*)(ws + WS_W_GLU), 512, MapId()); transpose_all(F, base, args.in[I_L0_WOUT], 1024, 1024, (bf16_t*)(ws + WS_W_OUT0), 1024, MapId()); peer_fold_wq(F, args.in[I_L0_WQ], args.in[I_L0_SK], (bf16_t*)(ws + WS_WQ0)); transpose_all(F, base, args.in[I_L1_WIN], 1024, 2856, (bf16_t*)(ws + WS_W_IN1), 1024, MapIn1()); transpose_all(F, base, args.in[I_L1_KW1], 2048, 256, (bf16_t*)(ws + WS_KW1), 2048, MapId()); transpose_all(F, base, args.in[I_L1_VW1], 2048, 256, (bf16_t*)(ws + WS_VW1), 2048, MapId()); transpose_all(F, base, args.in[I_L1_KW2], 256, 64, (bf16_t*)(ws + WS_KW2), 256, MapId()); transpose_all(F, base, args.in[I_L1_VW2], 256, 64, (bf16_t*)(ws + WS_VW2), 256, MapId()); transpose_all(F, base, args.in[I_L1_WOUT], 1024, 1024, (bf16_t*)(ws + WS_W_OUT1), 1024, MapId()); peer_fold_wq(F, args.in[I_L1_WQ], args.in[I_L1_SK], (bf16_t*)(ws + WS_WQ1)); zero_bytes(F, ws + WS_W_IN0 + (size_t)1864 * 1024 * 2, (size_t)(2048 - 1864) * 1024 * 2); zero_bytes(F, ws + WS_W_IN1 + (size_t)2856 * 1024 * 2, (size_t)(3072 - 2856) * 1024 * 2); zero_bytes(F, ws + WS_KW2 + (size_t)64 * 256 * 2, (size_t)192 * 256 * 2); zero_bytes(F, ws + WS_VW2 + (size_t)64 * 256 * 2, (size_t)192 * 256 * 2);   cvt_table_i8(F, args.in[I_L0_U], ws + WS_TAB8U, (float*)(ws + WS_TABSU), 32); cvt_table_fp8(F, args.in[I_L0_V], ws + WS_TAB8V, (float*)(ws + WS_TABSV), 32); p_rope_table(F, (f32x2*)(ws + WS_ROPE)); if (F.bid == F.G - 1) { for (int i = F.tid; i < 1024; i += NTHREADS) ((float*)(ws + WS_CMPB + 4096))[i] = args.in[I_L1_MIXN][i]; } __syncthreads(); for (int g = F.bid; g < 32; g += F.G) s5_build_group(F, args, ws, g); for (int j = (F.bid + F.G - (32 % F.G)) % F.G; j < 64; j += F.G) cmp_bias(F, args, (float*)(ws + WS_CMPB), j); p_rmsnorm(F, x, args.in[I_L0_MIXN], (bf16_t*)(ws + WS_XN));)
    GRID_BAR(0);
    PH(1, pg8::Gemm g{(const bf16_t*)(ws + WS_XN), (const bf16_t*)(ws + WS_W_IN0), T, N_IN0, 1024, 1024, 1024}; pg8::StaticOrder S; S.init(T, N_IN0, F.G, F.bid); pg8::EpiStoreBf16 E{(bf16_t*)(ws + WS_PROJ), N_IN0}; pg8::gemm_phase(F.lds, g, S, E);)
    GRID_BAR(1);
    PH(2, p_l0_prep(F, args, ws);)
    GRID_BAR(2);
    PH(3, p_dsa_index(F, ws, (u64*)(ws + (rep ? L0_CAT : L0_SELT)), rep ? TMODE : 0); { pg8::Gemm g{(const bf16_t*)(ws + L0_UA), (const bf16_t*)(ws + WS_S5B1), 65536, 8192, 256, 384, 256}; pg8::GroupedOrder S; S.init(256, 8, F.G, F.bid); pg8::EpiS5State E{(float*)(ws + L0_SLOC)}; pg8::gemm_phase(F.lds, g, S, E); })
    GRID_BAR(3);
    PH(4, p_s5_scan(F, args, ws); p_dsa_attn(F, args, ws);)
    GRID_BAR(4);
    PH(7, pg8::Gemm g{(const bf16_t*)(ws + L0_UA), (const bf16_t*)(ws + WS_S5B2), 65536, 8192, 384, 384, 384}; pg8::GroupedOrder S; S.init(256, 8, F.G, F.bid); pg8::EpiS5Out E{(bf16_t*)(ws + L0_YB)}; pg8::gemm_phase(F.lds, g, S, E);)
    GRID_BAR(7);
    PH(8, pg8::Gemm g{(const bf16_t*)(ws + L0_YB), (const bf16_t*)(ws + WS_W_GLU), T, 512, 512, 512, 512}; pg8::StaticOrder S; S.init(T, 512, F.G, F.bid); pg8::EpiGlu E{(const bf16_t*)(ws + L0_YB), args.in[I_L0_BGLU], (bf16_t*)(ws + L0_CAT)}; pg8::gemm_phase(F.lds, g, S, E);)
    GRID_BAR(8);
    PH(9, pg8::Gemm g{(const bf16_t*)(ws + L0_CAT), (const bf16_t*)(ws + WS_W_OUT0), T, 1024, 1024, 1024, 1024}; pg8::StaticOrder S; S.init(T, 1024, F.G, F.bid); pg8::EpiResidNorm E{x, out, args.in[I_L0_FFNN], (bf16_t*)(ws + WS_XN), (float*)(ws + PE_SSQ)}; pg8::gemm_phase(F.lds, g, S, E);)
    GRID_BAR(9);
    PH(11, pg8::Gemm g{(const bf16_t*)(ws + WS_XN), (const bf16_t*)(ws + WS_WQ0), T, 2048, 1024, 1024, 1024}; pg8::StaticOrder S; S.init(T, 2048, F.G, F.bid); pg8::EpiStoreF16Rs E{(_Float16*)(ws + PE_Q2), 2048, (const float*)(ws + PE_SSQ)}; pg8::gemm_phase(F.lds, g, S, E);)
    GRID_BAR(11);
    PH(12, p_peer_route(F, ws);)
    GRID_BAR(12);
    PH(13, p_peer_expert5(F, ws, out, rep ? 0.f : 1.f, xbar, rep ? TMODE : 0, true, WS_XN);)
    GRID_BAR(13);
    PH(15, pg8::Gemm g{(const bf16_t*)(ws + WS_XN), (const bf16_t*)(ws + WS_W_IN1), T, N_IN1, 1024, 1024, 1024}; pg8::StaticOrder S; S.init(T, N_IN1, F.G, F.bid); pg8::EpiStoreBf16 E{(bf16_t*)(ws + WS_PROJ), N_IN1}; pg8::gemm_phase(F.lds, g, S, E);)
    GRID_BAR(15);
    PH(16, p_l1_prep(F, args, ws);)
    GRID_BAR(16);
    PH(17, pg8::Gemm g{(const bf16_t*)(ws + L1_KCR), (const bf16_t*)(ws + WS_KW1), 8192, 512, 2048, 1024, 2048}; pg8::GroupedOrder S; S.init(32, 16, F.G, F.bid); pg8::EpiCmp1 E{(bf16_t*)(ws + L1_H1), (const float*)(ws + WS_CMPB)}; pg8::gemm_phase(F.lds, g, S, E);)
    GRID_BAR(17);
    PH(18, pg8::Gemm g{(const bf16_t*)(ws + L1_H1), (const bf16_t*)(ws + WS_KW2), 8192, 512, 256, 256, 256}; pg8::GroupedOrder S; S.init(32, 16, F.G, F.bid); pg8::EpiCmp2 E{(float*)(ws + L1_CMPO)}; pg8::gemm_phase(F.lds, g, S, E);)
    GRID_BAR(18);
    PH(19, p_cmp_final(F, args, ws);)
    GRID_BAR(19);
    PH(20, p_cmp_attn(F, args, ws);)
    GRID_BAR(20);
    PH(21, if (rep) { p_cmp_attn(F, args, ws); xcd_barrier(xbar); } p_nsa_attn(F, args, ws);)
    GRID_BAR(21);
    PH(22, p_gla_a(F, args, ws); cvt_table_i8(F, args.in[I_L1_U], ws + WS_TAB8U, (float*)(ws + WS_TABSU), 0); cvt_table_fp8(F, args.in[I_L1_V], ws + WS_TAB8V, (float*)(ws + WS_TABSV), 0);)
    GRID_BAR(22);
    PH(23, if (rep) { p_gla_a(F, args, ws); xcd_barrier(xbar); } p_gla_b(F, ws);)
    GRID_BAR(23);
    PH(24, p_gla_c(F, args, ws, rep ? TMODE : 0);)
    GRID_BAR(24);
    PH(25, pg8::Gemm g{(const bf16_t*)(ws + L1_CAT), (const bf16_t*)(ws + WS_W_OUT1), T, 1024, 1024, 1024, 1024}; pg8::StaticOrder S; S.init(T, 1024, F.G, F.bid); pg8::EpiResidNorm E{out, out, args.in[I_L1_FFNN], (bf16_t*)(ws + WS_R3), (float*)(ws + PE_SSQ)}; pg8::gemm_phase(F.lds, g, S, E);)
    GRID_BAR(25);
    PH(27, pg8::Gemm g{(const bf16_t*)(ws + WS_R3), (const bf16_t*)(ws + WS_WQ1), T, 2048, 1024, 1024, 1024}; pg8::StaticOrder S; S.init(T, 2048, F.G, F.bid); pg8::EpiStoreF16Rs E{(_Float16*)(ws + PE_Q2), 2048, (const float*)(ws + PE_SSQ)}; pg8::gemm_phase(F.lds, g, S, E);)
    GRID_BAR(27);
    PH(28, p_peer_route(F, ws);)
    GRID_BAR(28);
    PH(29, p_peer_expert5(F, ws, out, rep ? 0.f : 1.f, xbar, rep ? TMODE : 0, false, WS_R3);)
#undef IN
#undef BOTH
}

extern "C" void kernel_launch(void* const* d_in, const int* in_sizes, int n_in, void* d_out, int out_size, void* d_ws, size_t ws_size, hipStream_t stream) {
    static int grid = 0;
    if (grid == 0) {
        if (n_in != 39 || ws_size < WS_END) { fprintf(stderr, "kernel_launch: unexpected n_in %d or ws_size %zu (< %zu)\n", n_in, ws_size, (size_t)WS_END); grid = -1; return; }
        int dev = 0, cus = 0, per_cu = 0;
        (void)hipGetDevice(&dev); (void)hipDeviceGetAttribute(&cus, hipDeviceAttributeMultiprocessorCount, dev);
        if (hipFuncSetAttribute((const void*)mk_fwd, hipFuncAttributeMaxDynamicSharedMemorySize, LDS_BYTES) != hipSuccess) { fprintf(stderr, "kernel_launch: hipFuncSetAttribute failed\n"); grid = -1; return; }
        if (hipOccupancyMaxActiveBlocksPerMultiprocessor(&per_cu, (const void*)mk_fwd, NTHREADS, LDS_BYTES) != hipSuccess || per_cu < 1) { fprintf(stderr, "kernel_launch: occupancy query failed (%d)\n", per_cu); (void)hipGetLastError(); grid = -1; return; }
        grid = cus;
    }
    if (grid < 0) return;
    (void)hipMemsetAsync((char*)d_ws + WS_CTL, 0, 32768, stream);
    Args a{};
    for (int i = 0; i < 39; ++i) a.in[i] = (const float*)d_in[i];
    a.out = (float*)d_out; a.ws = (unsigned char*)d_ws; a.ph_lo = 0; a.ph_hi = 1000;
    void* kargs[] = {&a};
    hipError_t e = hipLaunchCooperativeKernel((const void*)mk_fwd, dim3(grid), dim3(NTHREADS), kargs, LDS_BYTES, stream);
    if (e != hipSuccess) fprintf(stderr, "kernel_launch: cooperative launch failed: %s\n", hipGetErrorString(e));
}
```

```cpp
#include <hip/hip_runtime.h>
#include <hip/hip_cooperative_groups.h>
#include <cstdio>
#include <cstdint>
namespace cg = cooperative_groups;

#define LAS __attribute__((address_space(3)))
typedef unsigned short bf16_t;
typedef short bf16x8 __attribute__((ext_vector_type(8)));
typedef float f32x4 __attribute__((ext_vector_type(4)));
typedef float f32x2 __attribute__((ext_vector_type(2)));
typedef float f32x16 __attribute__((ext_vector_type(16)));
typedef unsigned u32x4 __attribute__((ext_vector_type(4)));
typedef unsigned u32x2 __attribute__((ext_vector_type(2)));
typedef unsigned long long u64;

constexpr int NB = 8, SEQ = 4096, DM = 1024, T = NB * SEQ;
constexpr int NTHREADS = 512, NWAVES = 8;
constexpr int LDS_BYTES = 147456;
constexpr int N_IN0 = 2048, N_IN1 = 3072;
constexpr int C0_Q = 0, C0_K = 512, C0_V = 640, C0_IQ = 768, C0_U = 1280, C0_IK = 1792, C0_IW = 1856;
constexpr int C1_Q = 0, C1_KC = 512, C1_VC = 640, C1_KS = 768, C1_VS = 896, C1_KW = 1024, C1_VW = 1152, C1_GQ = 1280, C1_GK = 1536, C1_GV = 1792, C1_GR = 2304, C1_GL = 2816, C1_GLOW = 2840;

constexpr size_t MiB = 1u << 20;
constexpr size_t WS_CTL = 0;
constexpr size_t WS_ROPE = 1 * MiB;
constexpr size_t WS_W_IN0 = 2 * MiB;
constexpr size_t WS_W_GLU = 6 * MiB;
constexpr size_t WS_SK0 = 6 * MiB + 512 * 1024;
constexpr size_t WS_W_OUT0 = 7 * MiB;
constexpr size_t WS_WQ0 = 9 * MiB;
constexpr size_t WS_W_IN1 = 13 * MiB;
constexpr size_t WS_KW1 = 19 * MiB;
constexpr size_t WS_VW1 = 20 * MiB;
constexpr size_t WS_KW2 = 21 * MiB;
constexpr size_t WS_VW2 = 21 * MiB + 128 * 1024;
constexpr size_t WS_SK1 = 21 * MiB + 512 * 1024;
constexpr size_t WS_W_OUT1 = 22 * MiB;
constexpr size_t WS_WQ1 = 24 * MiB;
constexpr size_t WS_S5B1 = 28 * MiB;
constexpr size_t WS_S5B2 = 32 * MiB;
constexpr size_t WS_CMPB = 38 * MiB;
constexpr size_t WS_TABU = 48 * MiB;
constexpr size_t WS_TABV = 80 * MiB;
constexpr size_t WS_XN = 112 * MiB;
constexpr size_t WS_PROJ = 176 * MiB;
constexpr size_t WS_R3 = 368 * MiB;
constexpr size_t WS_END = 506 * MiB;

__device__ __forceinline__ unsigned f2bf(float f) { unsigned u = __builtin_bit_cast(unsigned, f); return (u + 0x7fffu + ((u >> 16) & 1u)) >> 16; }
__device__ __forceinline__ unsigned pk2(float lo, float hi) { return f2bf(lo) | (f2bf(hi) << 16); }
__device__ __forceinline__ float bf_lo(unsigned u) { return __builtin_bit_cast(float, u << 16); }
__device__ __forceinline__ float bf_hi(unsigned u) { return __builtin_bit_cast(float, u & 0xffff0000u); }
__device__ __forceinline__ float bf2f(bf16_t b) { return __builtin_bit_cast(float, ((unsigned)b) << 16); }
typedef unsigned u32x2p __attribute__((ext_vector_type(2)));
__device__ __forceinline__ float dpp_f(float v, const int ctrl) { return v; }
#define DPP_ADD_F(v, ctrl) ((v) + __builtin_bit_cast(float, __builtin_amdgcn_update_dpp(0, __builtin_bit_cast(int, (v)), (ctrl), 0xF, 0xF, true)))
#define DPP_QX1 0xB1
#define DPP_QX2 0x4E
#define DPP_HMIR 0x141
#define DPP_MIR 0x140
#define DPP_ROR8 0x128
__device__ __forceinline__ float sum8_f(float v) { v = DPP_ADD_F(v, DPP_QX1); v = DPP_ADD_F(v, DPP_QX2); v = DPP_ADD_F(v, DPP_HMIR); return v; }
__device__ __forceinline__ float sum16_f(float v) { v = sum8_f(v); v = DPP_ADD_F(v, DPP_MIR); return v; }
__device__ __forceinline__ float rl_f(float v, int l) { return __builtin_bit_cast(float, __builtin_amdgcn_readlane(__builtin_bit_cast(int, v), l)); }
__device__ __forceinline__ float sum32_f(float v) { v = sum16_f(v); const float lo = rl_f(v, 0) + rl_f(v, 16), hi = rl_f(v, 32) + rl_f(v, 48); return (threadIdx.x & 32) ? hi : lo; }
__device__ __forceinline__ float wave_sum(float v) { v = sum16_f(v); return (rl_f(v, 0) + rl_f(v, 16)) + (rl_f(v, 32) + rl_f(v, 48)); }
__device__ __forceinline__ float gelu_tanh(float x) {
    const float y = 0.7978845608028654f * (x + 0.044715f * x * x * x);
    const float e = __expf(2.0f * y);
    const float th = 1.0f - 2.0f / (e + 1.0f);
    return 0.5f * x * (1.0f + th);
}
__device__ __forceinline__ float sigmoidf_(float x) { return 1.0f / (1.0f + __expf(-x)); }
#define LDS_WAIT() asm volatile("s_waitcnt lgkmcnt(0)" ::: "memory")
#define VM_WAIT() asm volatile("s_waitcnt vmcnt(0)" ::: "memory")

#define XB_TMO      128
#define XB_XCNT(j)  (256  + 64 * (j))
#define XB_XSUB(j)  (1280 + 64 * (j))
#define XB_XGEN(j)  (2304 + 64 * (j))
#define XB_TOP      3328
#define XB_TOPGEN   3392
#define XCD_BAR_WORDS 3456
#define XB_SPIN_CAP (1u << 22)
__device__ __forceinline__ unsigned xb_ld(unsigned* p)              { return __hip_atomic_load(p, __ATOMIC_RELAXED, __HIP_MEMORY_SCOPE_AGENT); }
__device__ __forceinline__ unsigned xb_add(unsigned* p, unsigned v) { return __hip_atomic_fetch_add(p, v, __ATOMIC_RELAXED, __HIP_MEMORY_SCOPE_AGENT); }
__device__ __forceinline__ unsigned xb_xcc_id() { return (unsigned)__builtin_amdgcn_s_getreg((3 << 11) | 20) & 0xFu; }
#define XB_SPIN(cond, bar) do { unsigned _sp = 0; while (cond) { __builtin_amdgcn_s_sleep(1); \
    if ((++_sp & 255u) == 0u) { if (xb_ld(&(bar)[XB_TMO])) break; if (_sp > XB_SPIN_CAP) { atomicAdd(&(bar)[XB_TMO], 1u); break; } } } } while (0)
struct XcdBarrier { unsigned* bar; unsigned x; volatile LAS unsigned* st; };
__device__ __forceinline__ XcdBarrier xcd_barrier_post(unsigned* bar, volatile LAS unsigned* st) {
    XcdBarrier b; b.bar = bar; b.x = xb_xcc_id(); b.st = st;
    if (threadIdx.x == 0) (void)xb_add(&bar[XB_XCNT(b.x)], 1u);
    return b;
}
__device__ __forceinline__ void xcd_barrier_complete(unsigned* bar, unsigned x, unsigned& nloc, unsigned& nx) {
    const unsigned G = gridDim.x * gridDim.y * gridDim.z;
    unsigned sum, cnt, mine, sp = 0u;
    for (;;) {
        sum = 0u; cnt = 0u; mine = 0u;
#pragma unroll
        for (unsigned j = 0; j < 16; ++j) { const unsigned c = xb_ld(&bar[XB_XCNT(j)]); sum += c; cnt += (c > 0u) ? 1u : 0u; mine = (j == x) ? c : mine; }
        if (sum == G) break;
        __builtin_amdgcn_s_sleep(1);
        if ((++sp & 255u) == 0u) { if (xb_ld(&bar[XB_TMO])) break; if (sp > XB_SPIN_CAP) { atomicAdd(&bar[XB_TMO], 1u); break; } }
    }
    nloc = mine > 0u ? mine : 1u; nx = cnt > 0u ? cnt : 1u;
}
__device__ __forceinline__ void xcd_barrier(const XcdBarrier& b) {
    asm volatile("s_waitcnt vmcnt(0)" ::: "memory");
    __syncthreads();
    if (threadIdx.x == 0) {
        unsigned* bar = b.bar;
        __builtin_amdgcn_s_waitcnt(0);
        unsigned nloc = b.st[0], nx = b.st[1];
        if (nloc == 0u) { xcd_barrier_complete(bar, b.x, nloc, nx); b.st[0] = nloc; b.st[1] = nx; }
        const unsigned old = xb_add(&bar[XB_XSUB(b.x)], 1u);
        const unsigned gen = old / nloc;
        if (old + 1u == (gen + 1u) * nloc) {
            __builtin_amdgcn_fence(__ATOMIC_RELEASE, "agent");
            asm volatile("s_waitcnt vmcnt(0)" ::: "memory");
            const unsigned og = xb_add(&bar[XB_TOP], 1u);
            const unsigned tg = og / nx;
            if (og + 1u == (tg + 1u) * nx) xb_add(&bar[XB_TOPGEN], 1u);
            else XB_SPIN(xb_ld(&bar[XB_TOPGEN]) == tg, bar);
            __builtin_amdgcn_fence(__ATOMIC_ACQUIRE, "agent");
            xb_add(&bar[XB_XGEN(b.x)], 1u);
            asm volatile("s_waitcnt vmcnt(0)" ::: "memory");
        } else {
            XB_SPIN(xb_ld(&bar[XB_XGEN(b.x)]) == gen, bar);
            __builtin_amdgcn_fence(__ATOMIC_ACQUIRE, "agent");
            asm volatile("s_waitcnt vmcnt(0)" ::: "memory");
        }
    }
    __syncthreads();
}

namespace pg8 {
constexpr int BM = 256, BK = 64, HALF = 128, HTB = HALF * BK * 2, STAGE_BYTES = 8 * HTB, NXCD = 8, WGM = 8;
__device__ __forceinline__ int lds_byte(int r, int c) { const int st = (r >> 4) * 2 + (c >> 5), rr = r & 15, cc = c & 31, ob = rr * 64 + cc * 2; return st * 1024 + (ob ^ (((ob >> 9) & 1) << 5)); }
__device__ __forceinline__ void stage_rc(int b, int& R, int& C) { const int st = b / 1024, sb = b % 1024, swz = sb ^ (((sb >> 9) & 1) << 5); R = (st >> 1) * 16 + swz / 64; C = (st & 1) * 32 + (swz % 64) / 2; }
__device__ __forceinline__ int perm32(int rho) { const int n = rho >> 4, i = rho & 15; return 8 * (i >> 2) + 4 * n + (i & 3); }
struct Unit { int pm, pn; };
struct Gemm { const bf16_t* A; const bf16_t* Bt; int M, N, K, lda, ldb; };
struct StaticOrder {
    int nM, nN, nwg, G, c;
    __device__ void init(int M, int N, int G_, int c_) { nM = M / BM; nN = N / BM; nwg = nM * nN; G = G_; c = c_; }
    __device__ bool next(int i, Unit& u) const {
        const long L = (long)i * G + c; if (L >= nwg) return false;
        int wgid = (int)L; { const int q = nwg / NXCD, r = nwg % NXCD, xcd = wgid % NXCD, off = wgid / NXCD; wgid = (xcd < r ? xcd * (q + 1) : r * (q + 1) + (xcd - r) * q) + off; }
        const int nig = WGM * nN, gid = wgid / nig, fm = gid * WGM, gsz = (nM - fm) < WGM ? (nM - fm) : WGM;
        u.pm = fm + ((wgid % nig) % gsz); u.pn = (wgid % nig) / gsz; return true;
    }
};
struct GroupedOrder {
    int nwg, G, c, tpg;
    __device__ void init(int ntiles, int tiles_per_group, int G_, int c_) { nwg = ntiles; tpg = tiles_per_group; G = G_; c = c_; }
    __device__ bool next(int i, Unit& u) const { const long L = (long)i * G + c; if (L >= nwg) return false; u.pm = (int)L; u.pn = (int)L / tpg; return true; }
};
__device__ __forceinline__ unsigned cvt_pk_bf16(float lo, float hi) { unsigned r; asm volatile("v_cvt_pk_bf16_f32 %0, %1, %2" : "=v"(r) : "v"(lo), "v"(hi)); return r; }

template <class Epi, class Sched>
__device__ __forceinline__ void gemm_phase(LAS unsigned char* lds, const Gemm g, const Sched& S, const Epi& E) {
    const int tid = threadIdx.x, wid = __builtin_amdgcn_readfirstlane(tid >> 6), lane = tid & 63, wr = wid >> 2, wc = wid & 3, fr = lane & 15, fq = lane >> 4;
    int K = g.K; asm volatile("" : "+s"(K));
    const int nt = K / BK;
    unsigned voffA[2], voffB[2];
#pragma unroll
    for (int i = 0; i < 2; ++i) { int R, C; stage_rc(tid * 16 + i * 8192, R, C); const int Rb = Epi::PERM ? ((R & ~31) + perm32(R & 31)) : R;
        voffA[i] = (unsigned)(R * g.lda + C) * 2u; voffB[i] = (unsigned)(Rb * g.ldb + C) * 2u; }
    const size_t kstep = (size_t)(BK * 2);
    const size_t hstepA = (size_t)HALF * g.lda * 2, hstepB = (size_t)HALF * g.ldb * 2;
    const size_t tstepA = 2 * hstepA, tstepB = 2 * hstepB;
    const unsigned ldsw = (unsigned)wid * 1024u;
    const int aoff = lds_byte(wr * 64 + fr, fq * 8), boff = lds_byte(wc * 32 + fr, fq * 8);
#define PG8_SA(b, h) (((b) * 2 + (h)) * HTB)
#define PG8_SB(b, h) ((4 + (b) * 2 + (h)) * HTB)
#define PG8_STAGE(bufoff, gbase, voff) do { _Pragma("unroll") for (int _i = 0; _i < 2; ++_i) \
        __builtin_amdgcn_global_load_lds((const unsigned*)((const char*)(gbase) + (voff)[_i]), (LAS unsigned*)(lds + (bufoff) + ldsw + _i * 8192), 16, 0, 0); } while (0)
#define PG8_LDA(dst, b, h) do { _Pragma("unroll") for (int m = 0; m < 4; ++m) _Pragma("unroll") for (int k = 0; k < 2; ++k) dst[m][k] = *(const LAS bf16x8*)(lds + PG8_SA(b, h) + aoff + m * 2048 + k * 1024); } while (0)
#define PG8_LDB(dst, b, h) do { _Pragma("unroll") for (int n = 0; n < 2; ++n) _Pragma("unroll") for (int k = 0; k < 2; ++k) dst[n][k] = *(const LAS bf16x8*)(lds + PG8_SB(b, h) + boff + n * 2048 + k * 1024); } while (0)
#define PG8_MMA(ai, bj, At, Bt) do { __builtin_amdgcn_s_setprio(1); _Pragma("unroll") for (int m = 0; m < 4; ++m) _Pragma("unroll") for (int n = 0; n < 2; ++n) _Pragma("unroll") for (int k = 0; k < 2; ++k) \
        acc[ai][bj][m][n] = __builtin_amdgcn_mfma_f32_16x16x32_bf16(Bt[n][k], At[m][k], acc[ai][bj][m][n], 0, 0, 0); __builtin_amdgcn_s_setprio(0); } while (0)
#define PG8_WAIT_V(n) asm volatile("s_waitcnt vmcnt(" #n ")" ::: "memory")
#define PG8_WAIT_L(n) asm volatile("s_waitcnt lgkmcnt(" #n ")" ::: "memory")
#define PG8_BAR __builtin_amdgcn_s_barrier()
#define PG8_SCHED __builtin_amdgcn_sched_barrier(0)
    Unit cur, nxt; int ui = 0;
    if (!S.next(0, cur)) return;
    f32x4 acc[2][2][4][2];
#pragma unroll
    for (int a = 0; a < 2; ++a)
#pragma unroll
        for (int b = 0; b < 2; ++b)
#pragma unroll
            for (int m = 0; m < 4; ++m)
#pragma unroll
                for (int n = 0; n < 2; ++n) acc[a][b][m][n] = (f32x4){0.f, 0.f, 0.f, 0.f};
    bf16x8 At[4][2], B0[2][2], B1[2][2];
    const char* cA = (const char*)g.A + (size_t)cur.pm * tstepA; const char* cB = (const char*)g.Bt + (size_t)cur.pn * tstepB;
    PG8_STAGE(PG8_SB(0, 0), cB, voffB); PG8_STAGE(PG8_SA(0, 0), cA, voffA); PG8_STAGE(PG8_SB(0, 1), cB + hstepB, voffB); PG8_STAGE(PG8_SA(0, 1), cA + hstepA, voffA);
    if (wr == 1) PG8_BAR;
    PG8_WAIT_V(4); PG8_BAR;
    PG8_STAGE(PG8_SB(1, 0), cB + kstep, voffB); PG8_STAGE(PG8_SA(1, 0), cA + kstep, voffA); PG8_STAGE(PG8_SB(1, 1), cB + hstepB + kstep, voffB);
    PG8_WAIT_V(6); PG8_BAR;
    for (;;) {
        const bool has_next = S.next(ui + 1, nxt);
        const char* nA = has_next ? (const char*)g.A + (size_t)nxt.pm * tstepA : cA; const char* nB = has_next ? (const char*)g.Bt + (size_t)nxt.pn * tstepB : cB;
        for (int t = 0; t < nt; t += 2) {
            const bool last = (t == nt - 2);
            const char* a1 = cA + (size_t)(t + 1) * kstep;
            const char* a2 = last ? nA : cA + (size_t)(t + 2) * kstep; const char* b2 = last ? nB : cB + (size_t)(t + 2) * kstep;
            const char* a3 = a2 + kstep; const char* b3 = b2 + kstep;
            PG8_LDB(B0, 0, 0); PG8_SCHED; PG8_LDA(At, 0, 0); PG8_STAGE(PG8_SA(1, 1), a1 + hstepA, voffA);
            PG8_WAIT_L(8); PG8_BAR; PG8_WAIT_L(0); PG8_MMA(0, 0, At, B0); PG8_BAR; PG8_SCHED;
            PG8_LDB(B1, 0, 1); PG8_STAGE(PG8_SB(0, 0), b2, voffB);
            PG8_BAR; PG8_WAIT_L(0); PG8_MMA(0, 1, At, B1); PG8_BAR;
            PG8_LDA(At, 0, 1); PG8_STAGE(PG8_SA(0, 0), a2, voffA);
            PG8_BAR; PG8_WAIT_L(0); PG8_MMA(1, 0, At, B0); PG8_BAR; PG8_SCHED;
            PG8_STAGE(PG8_SB(0, 1), b2 + hstepB, voffB);
            PG8_WAIT_V(6); PG8_BAR; PG8_MMA(1, 1, At, B1); PG8_BAR;
            PG8_LDB(B0, 1, 0); PG8_SCHED; PG8_LDA(At, 1, 0); PG8_STAGE(PG8_SA(0, 1), a2 + hstepA, voffA);
            PG8_WAIT_L(8); PG8_BAR; PG8_WAIT_L(0); PG8_MMA(0, 0, At, B0); PG8_BAR; PG8_SCHED;
            PG8_LDB(B1, 1, 1); PG8_STAGE(PG8_SB(1, 0), b3, voffB);
            PG8_BAR; PG8_WAIT_L(0); PG8_MMA(0, 1, At, B1); PG8_BAR;
            PG8_LDA(At, 1, 1); PG8_STAGE(PG8_SA(1, 0), a3, voffA);
            PG8_BAR; PG8_WAIT_L(0); PG8_MMA(1, 0, At, B0); PG8_BAR; PG8_SCHED;
            PG8_STAGE(PG8_SB(1, 1), b3 + hstepB, voffB);
            PG8_WAIT_V(6); PG8_BAR; PG8_MMA(1, 1, At, B1); PG8_BAR;
        }
        E(acc, cur, wr, wc, fr, fq);
        if (!has_next) break;
#pragma unroll
        for (int a = 0; a < 2; ++a)
#pragma unroll
            for (int b = 0; b < 2; ++b)
#pragma unroll
                for (int m = 0; m < 4; ++m)
#pragma unroll
                    for (int n = 0; n < 2; ++n) acc[a][b][m][n] = (f32x4){0.f, 0.f, 0.f, 0.f};
        cur = nxt; cA = nA; cB = nB; ++ui;
    }
    PG8_WAIT_V(0);
    if (wr == 0) PG8_BAR;
    PG8_BAR;
#undef PG8_SA
#undef PG8_SB
#undef PG8_STAGE
#undef PG8_LDA
#undef PG8_LDB
#undef PG8_MMA
#undef PG8_WAIT_V
#undef PG8_WAIT_L
#undef PG8_BAR
#undef PG8_SCHED
}

struct EpiStoreBf16 {
    static constexpr bool PERM = true;
    bf16_t* O; int ldc;
    __device__ __forceinline__ void operator()(const f32x4 (&acc)[2][2][4][2], const Unit& u, int wr, int wc, int fr, int fq) const {
        const int row0 = u.pm * BM + wr * 64 + fr, col0 = u.pn * BM + wc * 32 + 8 * fq;
#pragma unroll
        for (int ai = 0; ai < 2; ++ai)
#pragma unroll
            for (int m = 0; m < 4; ++m) { bf16_t* rowp = O + (size_t)(row0 + ai * HALF + m * 16) * ldc + col0;
#pragma unroll
                for (int bj = 0; bj < 2; ++bj) { const f32x4 v0 = acc[ai][bj][m][0], v1 = acc[ai][bj][m][1];
                    u32x4 w; w.x = cvt_pk_bf16(v0[0], v0[1]); w.y = cvt_pk_bf16(v0[2], v0[3]); w.z = cvt_pk_bf16(v1[0], v1[1]); w.w = cvt_pk_bf16(v1[2], v1[3]);
                    *(u32x4*)(rowp + bj * HALF) = w; } }
    }
};
struct EpiStoreF16 {
    static constexpr bool PERM = true;
    _Float16* O; int ldc;
    __device__ __forceinline__ void operator()(const f32x4 (&acc)[2][2][4][2], const Unit& u, int wr, int wc, int fr, int fq) const {
        const int row0 = u.pm * BM + wr * 64 + fr, col0 = u.pn * BM + wc * 32 + 8 * fq;
#pragma unroll
        for (int ai = 0; ai < 2; ++ai)
#pragma unroll
            for (int m = 0; m < 4; ++m) { _Float16* rowp = O + (size_t)(row0 + ai * HALF + m * 16) * ldc + col0;
#pragma unroll
                for (int bj = 0; bj < 2; ++bj) { const f32x4 v0 = acc[ai][bj][m][0], v1 = acc[ai][bj][m][1];
                    typedef _Float16 h8 __attribute__((ext_vector_type(8)));
                    const h8 hv = {(_Float16)v0[0], (_Float16)v0[1], (_Float16)v0[2], (_Float16)v0[3], (_Float16)v1[0], (_Float16)v1[1], (_Float16)v1[2], (_Float16)v1[3]};
                    *(h8*)(rowp + bj * HALF) = hv; } }
    }
};
struct EpiResidF32 {
    static constexpr bool PERM = false;
    const float* R; float* C; int ldc;
    __device__ __forceinline__ void operator()(const f32x4 (&acc)[2][2][4][2], const Unit& u, int wr, int wc, int fr, int fq) const {
        const int row0 = u.pm * BM + wr * 64 + fr, col0 = u.pn * BM + wc * 32 + 4 * fq;
#pragma unroll
        for (int ai = 0; ai < 2; ++ai)
#pragma unroll
            for (int m = 0; m < 4; ++m) { const size_t off = (size_t)(row0 + ai * HALF + m * 16) * ldc + col0;
#pragma unroll
                for (int bj = 0; bj < 2; ++bj)
#pragma unroll
                    for (int n = 0; n < 2; ++n) { const f32x4 r = *(const f32x4*)(R + off + bj * HALF + n * 16); *(f32x4*)(C + off + bj * HALF + n * 16) = r + acc[ai][bj][m][n]; } }
    }
};
struct EpiResidNorm {
    static constexpr bool PERM = false;
    const float* R; float* C; const float* gain; bf16_t* XNp; float* SSQ;
    __device__ __forceinline__ void operator()(const f32x4 (&acc)[2][2][4][2], const Unit& u, int wr, int wc, int fr, int fq) const {
        const int row0 = u.pm * BM + wr * 64 + fr, col0 = u.pn * BM + wc * 32 + 4 * fq;
        f32x4 g4[2][2];
#pragma unroll
        for (int bj = 0; bj < 2; ++bj)
#pragma unroll
            for (int n = 0; n < 2; ++n) g4[bj][n] = *(const f32x4*)(gain + col0 + bj * HALF + n * 16);
#pragma unroll
        for (int ai = 0; ai < 2; ++ai)
#pragma unroll
            for (int m = 0; m < 4; ++m) { const int row = row0 + ai * HALF + m * 16; const size_t off = (size_t)row * 1024 + col0;
                float ss = 0.f;
#pragma unroll
                for (int bj = 0; bj < 2; ++bj)
#pragma unroll
                    for (int n = 0; n < 2; ++n) { const f32x4 o = *(const f32x4*)(R + off + bj * HALF + n * 16) + acc[ai][bj][m][n];
                        *(f32x4*)(C + off + bj * HALF + n * 16) = o;
                        ss += (o[0] * o[0] + o[1] * o[1]) + (o[2] * o[2] + o[3] * o[3]);
                        const f32x4 og = o * g4[bj][n];
                        u32x2 w; w.x = cvt_pk_bf16(og[0], og[1]); w.y = cvt_pk_bf16(og[2], og[3]);
                        *(u32x2*)(XNp + off + bj * HALF + n * 16) = w; }
                ss += __shfl_xor(ss, 16); ss += __shfl_xor(ss, 32);
                if (fq == 0) SSQ[(size_t)row * 16 + u.pn * 4 + wc] = ss;
                asm volatile("" ::: "memory"); __builtin_amdgcn_sched_barrier(0); }
    }
};
struct EpiStoreF16Rs {
    static constexpr bool PERM = true;
    _Float16* O; int ldc; const float* SSQ;
    __device__ __forceinline__ void operator()(const f32x4 (&acc)[2][2][4][2], const Unit& u, int wr, int wc, int fr, int fq) const {
        const int row0 = u.pm * BM + wr * 64 + fr, col0 = u.pn * BM + wc * 32 + 8 * fq;
#pragma unroll
        for (int ai = 0; ai < 2; ++ai)
#pragma unroll
            for (int m = 0; m < 4; ++m) { const int row = row0 + ai * HALF + m * 16; _Float16* rowp = O + (size_t)row * ldc + col0;
                const f32x4* sp = (const f32x4*)(SSQ + (size_t)row * 16);
                const f32x4 s0 = sp[0], s1 = sp[1], s2 = sp[2], s3 = sp[3];
                const float tot = ((s0[0] + s0[1]) + (s0[2] + s0[3])) + ((s1[0] + s1[1]) + (s1[2] + s1[3])) + ((s2[0] + s2[1]) + (s2[2] + s2[3])) + ((s3[0] + s3[1]) + (s3[2] + s3[3]));
                const float rstd = 1.0f / sqrtf(tot * (1.0f / 1024.0f) + 1e-6f);
#pragma unroll
                for (int bj = 0; bj < 2; ++bj) { const f32x4 v0 = acc[ai][bj][m][0] * rstd, v1 = acc[ai][bj][m][1] * rstd;
                    typedef _Float16 h8 __attribute__((ext_vector_type(8)));
                    const h8 hv = {(_Float16)v0[0], (_Float16)v0[1], (_Float16)v0[2], (_Float16)v0[3], (_Float16)v1[0], (_Float16)v1[1], (_Float16)v1[2], (_Float16)v1[3]};
                    *(h8*)(rowp + bj * HALF) = hv; }
                asm volatile("" ::: "memory"); __builtin_amdgcn_sched_barrier(0); }
    }
};
}

struct Args {
    const float* in[39];
    float* out;
    unsigned char* ws;
    int ph_lo, ph_hi;
};
enum { I_X = 0, I_L0_MIXN, I_L0_WIN, I_L0_QG, I_L0_KG, I_L0_LOGDT, I_L0_ARE, I_L0_AIM, I_L0_BRE, I_L0_BIM, I_L0_CRE, I_L0_CIM, I_L0_D, I_L0_WGLU, I_L0_BGLU, I_L0_WOUT,
       I_L0_FFNN, I_L0_WQ, I_L0_SK, I_L0_U, I_L0_V,
       I_L1_MIXN, I_L1_WIN, I_L1_QG, I_L1_KG, I_L1_CMPPOS, I_L1_KW1, I_L1_KW2, I_L1_VW1, I_L1_VW2, I_L1_WGATE, I_L1_BGATE, I_L1_OGAIN, I_L1_WOUT,
       I_L1_FFNN, I_L1_WQ, I_L1_SK, I_L1_U, I_L1_V };

struct Frame {
    LAS unsigned char* lds;
    int tid, lane, wave, G, bid;
};

constexpr size_t L0_QA = WS_R3;
constexpr size_t L0_IQ = WS_R3 + 32 * MiB;
constexpr size_t L0_KA = WS_R3 + 64 * MiB;
constexpr size_t L0_VAT = WS_R3 + 72 * MiB;
constexpr size_t L0_IK = WS_R3 + 80 * MiB;
constexpr size_t L0_IW = WS_R3 + 84 * MiB;
constexpr size_t L0_UA = WS_R3 + 88 * MiB;
constexpr size_t L0_SELT = WS_PROJ;
constexpr size_t L0_CAT = WS_PROJ + 16 * MiB;
constexpr size_t L0_SLOC = WS_PROJ + 80 * MiB;
constexpr size_t L0_YB = WS_PROJ + 112 * MiB;
constexpr size_t PE_Q2 = WS_PROJ;
constexpr size_t PE_EID = WS_PROJ + 128 * MiB;
constexpr size_t PE_GATE = WS_PROJ + 136 * MiB;
constexpr size_t PE_SSQ = WS_PROJ + 152 * MiB;

template <class Map>
__device__ __forceinline__ void transpose_item(const float* W, int K, int N, bf16_t* WT, int ldk, LAS float* scr, int item, int lane, const Map& map) {
    const int nblk = (N + 31) / 32, kb = item / nblk, nb = item % nblk, k0 = 64 * kb, n0 = 32 * nb;
    const int ncol = n0 + (lane & 31);
#pragma unroll 8
    for (int i = 0; i < 32; ++i) { const int kk = 2 * i + (lane >> 5); scr[kk * 33 + (lane & 31)] = (ncol < N) ? W[(size_t)(k0 + kk) * N + ncol] : 0.f; }
    LDS_WAIT(); asm volatile("" ::: "memory");
    const int c = lane & 7;
#pragma unroll
    for (int j = 0; j < 4; ++j) { const int n = (lane >> 3) + 8 * j; const LAS float* s = scr + (8 * c) * 33 + n;
        u32x4 o; o.x = pk2(s[0 * 33], s[1 * 33]); o.y = pk2(s[2 * 33], s[3 * 33]); o.z = pk2(s[4 * 33], s[5 * 33]); o.w = pk2(s[6 * 33], s[7 * 33]);
        if (n0 + n < N) *(u32x4*)(WT + (size_t)map(n0 + n) * ldk + k0 + 8 * c) = o; }
    LDS_WAIT(); asm volatile("" ::: "memory");
}
struct MapId { __device__ __forceinline__ int operator()(int n) const { return n; } };
struct MapIn0 { __device__ __forceinline__ int operator()(int n) const { return n < 1280 ? n : (n < 1344 ? n - 1280 + C0_IK : (n < 1352 ? n - 1344 + C0_IW : n - 1352 + C0_U)); } };
struct MapIn1 { __device__ __forceinline__ int operator()(int n) const {
    if (n < 1280) return n; if (n < 1304) return n - 1280 + C1_GL; if (n < 1560) return n - 1304 + C1_GQ; if (n < 1816) return n - 1560 + C1_GK;
    if (n < 2328) return n - 1816 + C1_GV; if (n < 2344) return n - 2328 + C1_GLOW; return n - 2344 + C1_GR; } };

template <class Map>
__device__ __forceinline__ void transpose_all(const Frame& F, int& base, const float* W, int K, int N, bf16_t* WT, int ldk, const Map& map) {
    LAS float* scr = (LAS float*)(F.lds + F.wave * 16384);
    const int gw = F.bid * NWAVES + F.wave, NGW = F.G * NWAVES;
    const int nit = (K / 64) * ((N + 31) / 32);
    for (int it = (gw + NGW - (base % NGW)) % NGW; it < nit; it += NGW) transpose_item(W, K, N, WT, ldk, scr, it, F.lane, map);
    base += nit;
}
__device__ __forceinline__ void zero_bytes(const Frame& F, unsigned char* p, size_t nbytes) {
    const size_t n16 = nbytes / 16;
    for (size_t i = (size_t)F.bid * NTHREADS + F.tid; i < n16; i += (size_t)F.G * NTHREADS) ((u32x4*)p)[i] = (u32x4){0u, 0u, 0u, 0u};
}
__device__ __forceinline__ void cvt_f32_bf16(const Frame& F, const float* src, bf16_t* dst, size_t n) {
    const size_t n8 = n / 8;
    for (size_t i = (size_t)F.bid * NTHREADS + F.tid; i < n8; i += (size_t)F.G * NTHREADS) {
        const f32x4 a = ((const f32x4*)src)[2 * i], b = ((const f32x4*)src)[2 * i + 1];
        u32x4 o; o.x = pk2(a.x, a.y); o.y = pk2(a.z, a.w); o.z = pk2(b.x, b.y); o.w = pk2(b.z, b.w);
        ((u32x4*)dst)[i] = o;
    }
}

__device__ __forceinline__ void rms_row_to_bf16(const float* xrow, const float* gain, bf16_t* orow, int lane) {
    const f32x4* xr = (const f32x4*)xrow + lane; const f32x4* gr = (const f32x4*)gain + lane;
    f32x4 v[4]; float s = 0.f;
#pragma unroll
    for (int j = 0; j < 4; ++j) { v[j] = xr[64 * j]; s += (v[j].x * v[j].x + v[j].y * v[j].y) + (v[j].z * v[j].z + v[j].w * v[j].w); }
    const float rstd = 1.0f / sqrtf(wave_sum(s) * (1.f / DM) + 1e-6f);
    u64* o8 = (u64*)orow + lane;
#pragma unroll
    for (int j = 0; j < 4; ++j) { const f32x4 g4 = gr[64 * j]; o8[64 * j] = (u64)pk2(v[j].x * rstd * g4.x, v[j].y * rstd * g4.y) | ((u64)pk2(v[j].z * rstd * g4.z, v[j].w * rstd * g4.w) << 32); }
}
__device__ __forceinline__ void p_rmsnorm(const Frame& F, const float* x, const float* gain, bf16_t* XN) {
    const int gw = F.bid * NWAVES + F.wave, NGW = F.G * NWAVES;
    for (int m = gw; m < T; m += NGW) rms_row_to_bf16(x + (size_t)m * DM, gain, XN + (size_t)m * DM, F.lane);
}

__device__ __forceinline__ void p_rope_table(const Frame& F, f32x2* rope) {
    for (int i = F.bid * NTHREADS + F.tid; i < SEQ * 32; i += F.G * NTHREADS) {
        const int pos = i >> 5, k = i & 31;
        const float inv = powf(10000.0f, -(float)k / 32.0f);
        const float ang = (float)pos * inv;
        float s, c; sincosf(ang, &s, &c);
        rope[i] = (f32x2){c, s};
    }
}

__device__ __forceinline__ void s5_build_group(const Frame& F, const Args& a, unsigned char* ws, int g) {
    LAS f32x2* abp = (LAS f32x2*)F.lds;
    LAS f32x2* bb = abp + 17 * 64;
    LAS f32x2* Cc = bb + 64 * 16;
    LAS float* KT = (LAS float*)(Cc + 16 * 64);
    const float dt = expf(a.in[I_L0_LOGDT][g]);
    for (int idx = F.tid; idx < 17 * 64; idx += NTHREADS) {
        const int tau = idx >> 6, p = idx & 63;
        const float lr = a.in[I_L0_ARE][g * 64 + p], li = a.in[I_L0_AIM][g * 64 + p];
        const float mag = expf((float)tau * dt * lr); float s, c; sincosf((float)tau * dt * li, &s, &c);
        abp[idx] = (f32x2){mag * c, mag * s};
    }
    for (int idx = F.tid; idx < 64 * 16; idx += NTHREADS) {
        const int p = idx >> 4, c = idx & 15;
        const float lr = a.in[I_L0_ARE][g * 64 + p], li = a.in[I_L0_AIM][g * 64 + p];
        const float mag = expf(dt * lr); float s, co; sincosf(dt * li, &s, &co);
        const float abr = mag * co, abi = mag * s, den = lr * lr + li * li;
        const float fr = ((abr - 1.0f) * lr + abi * li) / den, fi = (abi * lr - (abr - 1.0f) * li) / den;
        const float br = a.in[I_L0_BRE][(size_t)(g * 64 + p) * 16 + c], bi = a.in[I_L0_BIM][(size_t)(g * 64 + p) * 16 + c];
        bb[idx] = (f32x2){fr * br - fi * bi, fr * bi + fi * br};
    }
    for (int idx = F.tid; idx < 16 * 64; idx += NTHREADS) Cc[idx] = (f32x2){a.in[I_L0_CRE][(size_t)g * 1024 + idx], a.in[I_L0_CIM][(size_t)g * 1024 + idx]};
    __syncthreads();
    for (int idx = F.tid; idx < 16 * 256; idx += NTHREADS) {
        const int tau = idx >> 8, co = (idx >> 4) & 15, ci = idx & 15;
        float acc = 0.f;
        for (int p = 0; p < 64; ++p) {
            const f32x2 c = Cc[co * 64 + p], e = abp[tau * 64 + p], b = bb[p * 16 + ci];
            const float er = c.x * e.x - c.y * e.y, ei = c.x * e.y + c.y * e.x;
            acc += er * b.x - ei * b.y;
        }
        if (tau == 0 && co == ci) acc += a.in[I_L0_D][g * 16 + co];
        KT[idx] = acc;
    }
    __syncthreads();
    bf16_t* B1 = (bf16_t*)(ws + WS_S5B1) + (size_t)g * 256 * 256;
    bf16_t* B2 = (bf16_t*)(ws + WS_S5B2) + (size_t)g * 256 * 384;
    for (int idx = F.tid; idx < 256 * 128; idx += NTHREADS) {
        const int n = idx >> 7, k = (idx & 127) * 2;
        float v0 = 0.f, v1 = 0.f;
        if (n < 128) { const int p = n & 63, j = k >> 4, ci = k & 15; const f32x2 e = abp[(15 - j) * 64 + p], b0 = bb[p * 16 + ci], b1 = bb[p * 16 + ci + 1];
            if (n < 64) { v0 = e.x * b0.x - e.y * b0.y; v1 = e.x * b1.x - e.y * b1.y; } else { v0 = e.x * b0.y + e.y * b0.x; v1 = e.x * b1.y + e.y * b1.x; } }
        *(unsigned*)(B1 + (size_t)n * 256 + k) = pk2(v0, v1);
    }
    for (int idx = F.tid; idx < 256 * 192; idx += NTHREADS) {
        const int n = idx / 192, k = (idx % 192) * 2, i = n >> 4, co = n & 15;
        float v0 = 0.f, v1 = 0.f;
        if (k < 256) { const int j = k >> 4, ci = k & 15; if (j <= i) { v0 = KT[((i - j) * 16 + co) * 16 + ci]; v1 = KT[((i - j) * 16 + co) * 16 + ci + 1]; } }
        else { const int p = (k - 256) & 63; const bool im = k >= 320;
            const f32x2 c0 = Cc[co * 64 + p], e0 = abp[(i + 1) * 64 + p], c1 = Cc[co * 64 + p + 1], e1 = abp[(i + 1) * 64 + p + 1];
            if (!im) { v0 = c0.x * e0.x - c0.y * e0.y; v1 = c1.x * e1.x - c1.y * e1.y; } else { v0 = -(c0.x * e0.y + c0.y * e0.x); v1 = -(c1.x * e1.y + c1.y * e1.x); } }
        *(unsigned*)(B2 + (size_t)n * 384 + k) = pk2(v0, v1);
    }
    __syncthreads();
}

__device__ __forceinline__ void cmp_bias(const Frame& F, const Args& a, float* out, int j) {
    const int w = j >> 5, n0 = (j & 31) * 8;
    const float* w1 = a.in[w ? I_L1_VW1 : I_L1_KW1]; const float* pos = a.in[I_L1_CMPPOS];
    LAS float* red = (LAS float*)(F.lds + 65536);
    float acc[8];
#pragma unroll
    for (int i = 0; i < 8; ++i) acc[i] = 0.f;
#pragma unroll
    for (int kk = 0; kk < 4; ++kk) { const int k = F.tid * 4 + kk; const float p = pos[k];
        const f32x4 wa = *(const f32x4*)(w1 + (size_t)k * 256 + n0), wb = *(const f32x4*)(w1 + (size_t)k * 256 + n0 + 4);
        acc[0] += p * wa.x; acc[1] += p * wa.y; acc[2] += p * wa.z; acc[3] += p * wa.w; acc[4] += p * wb.x; acc[5] += p * wb.y; acc[6] += p * wb.z; acc[7] += p * wb.w; }
#pragma unroll
    for (int i = 0; i < 8; ++i) { const float sv = wave_sum(acc[i]); if (F.lane == 0) red[F.wave * 8 + i] = sv; }
    __syncthreads();
    if (F.tid < 8) { float t = 0.f; for (int wv = 0; wv < 8; ++wv) t += red[wv * 8 + F.tid]; out[w * 256 + n0 + F.tid] = t; }
    __syncthreads();
}

__device__ __forceinline__ float rope_apply(float v, const f32x2 cs, int lane) {
    const float partner = __shfl_xor(v, 32);
    return lane < 32 ? v * cs.x - partner * cs.y : partner * cs.y + v * cs.x;
}
__device__ __forceinline__ void head8_load(const bf16_t* p, float (&v)[8]) {
    const u32x4 q = *(const u32x4*)p;
    v[0] = bf_lo(q.x); v[1] = bf_hi(q.x); v[2] = bf_lo(q.y); v[3] = bf_hi(q.y); v[4] = bf_lo(q.z); v[5] = bf_hi(q.z); v[6] = bf_lo(q.w); v[7] = bf_hi(q.w);
}
__device__ __forceinline__ void head8_store(bf16_t* p, const float (&v)[8], const float sc) {
    u32x4 q; q.x = pk2(v[0] * sc, v[1] * sc); q.y = pk2(v[2] * sc, v[3] * sc); q.z = pk2(v[4] * sc, v[5] * sc); q.w = pk2(v[6] * sc, v[7] * sc);
    *(u32x4*)p = q;
}
__device__ __forceinline__ void head8_norm(float (&v)[8], const float (&g)[8]) {
    float ss = 0.f;
#pragma unroll
    for (int j = 0; j < 8; ++j) ss += v[j] * v[j];
    ss = sum8_f(ss);
    const float r = 1.0f / sqrtf(ss * (1.f / 64.f) + 1e-6f);
#pragma unroll
    for (int j = 0; j < 8; ++j) v[j] = v[j] * r * g[j];
}
__device__ __forceinline__ void head8_rope(float (&v)[8], const f32x2 (&cs)[8], const bool upper) {
#pragma unroll
    for (int j = 0; j < 8; ++j) { const float partner = __shfl_xor(v[j], 4); v[j] = upper ? partner * cs[j].y + v[j] * cs[j].x : v[j] * cs[j].x - partner * cs[j].y; }
}
__device__ __forceinline__ void p_l0_prep(const Frame& F, const Args& a, unsigned char* ws) {
    const bf16_t* P = (const bf16_t*)(ws + WS_PROJ);
    const f32x2* rope = (const f32x2*)(ws + WS_ROPE);
    bf16_t* QA = (bf16_t*)(ws + L0_QA); bf16_t* IQ = (bf16_t*)(ws + L0_IQ); bf16_t* KA = (bf16_t*)(ws + L0_KA); bf16_t* VAT = (bf16_t*)(ws + L0_VAT);
    bf16_t* IK = (bf16_t*)(ws + L0_IK); float* IW = (float*)(ws + L0_IW); bf16_t* UA = (bf16_t*)(ws + L0_UA);
    const int gw = F.bid * NWAVES + F.wave, NGW = F.G * NWAVES, lane = F.lane, hs = lane >> 3, sub = lane & 7;
    float qg[8], kg[8];
#pragma unroll
    for (int j = 0; j < 8; ++j) { qg[j] = a.in[I_L0_QG][sub * 8 + j]; kg[j] = a.in[I_L0_KG][sub * 8 + j]; }
    for (int m = gw; m < T; m += NGW) {
        const int b = m >> 12, t = m & 4095;
        const bf16_t* row = P + (size_t)m * N_IN0;
        f32x2 cs[8];
#pragma unroll
        for (int j = 0; j < 4; ++j) { const f32x4 c4 = *(const f32x4*)(rope + t * 32 + (sub & 3) * 8 + 2 * j); cs[2 * j] = (f32x2){c4.x, c4.y}; cs[2 * j + 1] = (f32x2){c4.z, c4.w}; }
        float v[8];
        head8_load(row + C0_Q + lane * 8, v); head8_norm(v, qg); head8_rope(v, cs, sub >= 4); head8_store(QA + (size_t)m * 512 + lane * 8, v, 0.125f);
        head8_load(row + C0_IQ + lane * 8, v); head8_rope(v, cs, sub >= 4); head8_store(IQ + (size_t)m * 512 + lane * 8, v, 0.125f);
        {
            const int hh = hs < 3 ? hs : 2;
            head8_load(row + (hh < 2 ? C0_K + hh * 64 : C0_IK) + sub * 8, v);
            float vn[8];
#pragma unroll
            for (int j = 0; j < 8; ++j) vn[j] = v[j];
            head8_norm(vn, kg);
#pragma unroll
            for (int j = 0; j < 8; ++j) v[j] = (hh < 2) ? vn[j] : v[j];
            head8_rope(v, cs, sub >= 4);
            if (hs < 2) head8_store(KA + ((size_t)(b * 2 + hs) * 4096 + t) * 64 + sub * 8, v, 1.0f);
            else if (hs == 2) head8_store(IK + (size_t)m * 64 + sub * 8, v, 1.0f);
        }
        if (lane < 8) IW[(size_t)m * 8 + lane] = bf2f(row[C0_IW + lane]) * 0.35355339059327373f;
        { const u32x4 uv = *(const u32x4*)(row + C0_U + lane * 8); const int g = lane >> 1;
          *(u32x4*)(UA + ((size_t)g * 2048 + (m >> 4)) * 384 + (m & 15) * 16 + (lane & 1) * 8) = uv; }
    }
    for (int it = gw; it < NB * 2 * 64; it += NGW) {
        const int tb = it & 63, g = (it >> 6) & 1, b = it >> 7;
        const size_t m = (size_t)b * 4096 + tb * 64 + lane;
        unsigned r[32];
#pragma unroll
        for (int j = 0; j < 8; ++j) { const u32x4 q = *(const u32x4*)(P + m * N_IN0 + C0_V + g * 64 + j * 8); r[4 * j] = q.x; r[4 * j + 1] = q.y; r[4 * j + 2] = q.z; r[4 * j + 3] = q.w; }
        bf16_t* dst = VAT + ((size_t)(b * 2 + g) * 64) * 4096 + tb * 64 + lane;
#pragma unroll
        for (int d = 0; d < 64; ++d) dst[(size_t)d * 4096] = (bf16_t)((d & 1) ? (r[d >> 1] >> 16) : (r[d >> 1] & 0xffffu));
    }
}

__device__ __forceinline__ unsigned f16key(unsigned raw) { return (raw & 0x8000u) ? (~raw & 0xFFFFu) : (raw | 0x8000u); }
template <int NREG>
__device__ __forceinline__ int topk_count_ge(const unsigned (&kk)[NREG], const unsigned cm1pk) {
    unsigned acc = 0u; const unsigned ones = 0x00010001u;
#pragma unroll
    for (int jj = 0; jj < NREG; ++jj) {
        unsigned d;
        asm("v_pk_sub_u16 %0, %1, %2 clamp" : "=v"(d) : "v"(kk[jj]), "v"(cm1pk));
        asm("v_pk_min_u16 %0, %1, %2" : "=v"(d) : "v"(d), "v"(ones));
        asm("v_pk_add_u16 %0, %1, %2" : "=v"(acc) : "v"(acc), "v"(d));
    }
    int c = (int)((acc & 0xffffu) + (acc >> 16));
    c += __builtin_amdgcn_update_dpp(0, c, 0xB1, 0xF, 0xF, true);
    c += __builtin_amdgcn_update_dpp(0, c, 0x4E, 0xF, 0xF, true);
    c += __builtin_amdgcn_update_dpp(0, c, 0x141, 0xF, 0xF, true);
    c += __builtin_amdgcn_update_dpp(0, c, 0x140, 0xF, 0xF, true);
    return __builtin_amdgcn_readlane(c, 0) + __builtin_amdgcn_readlane(c, 16) + __builtin_amdgcn_readlane(c, 32) + __builtin_amdgcn_readlane(c, 48);
}
template <int NREG>
__device__ __forceinline__ u64 topk_query(const LAS unsigned short* scq, const int t, const int lane) {
    unsigned kk[NREG];
#pragma unroll
    for (int jj = 0; jj < NREG; ++jj) {
        const int e0 = (2 * jj) * 64 + lane, e1 = e0 + 64;
        const unsigned r0 = scq[e0], r1 = scq[e1];
        kk[jj] = ((e0 <= t) ? f16key(r0) : 0u) | (((e1 <= t) ? f16key(r1) : 0u) << 16);
        if ((jj & 3) == 3) __builtin_amdgcn_sched_barrier(0);
    }
    unsigned prefix = 0u; bool exact = false;
#pragma unroll 1
    for (int bit = 15; bit >= 0; --bit) {
        const unsigned cand = prefix | (1u << bit), cm1 = cand - 1u;
        const int cnt = topk_count_ge<NREG>(kk, cm1 | (cm1 << 16));
        if (cnt >= 256) prefix = cand;
        if (cnt == 256) { exact = true; break; }
    }
    unsigned mylo = 0u, myhi = 0u;
    if (exact) {
#pragma unroll
        for (int i = 0; i < 2 * NREG; ++i) {
            const unsigned k = (i & 1) ? (kk[i >> 1] >> 16) : (kk[i >> 1] & 0xffffu);
            const u64 w = __ballot(k >= prefix);
            asm("s_nop 4\n\tv_writelane_b32 %0, %2, %4\n\tv_writelane_b32 %1, %3, %4" : "+v"(mylo), "+v"(myhi) : "s"((unsigned)w), "s"((unsigned)(w >> 32)), "n"(i));
        }
    } else {
        const unsigned Tk = prefix;
        const int cgt = (Tk >= 0xFFFFu) ? 0 : topk_count_ge<NREG>(kk, Tk | (Tk << 16));
        const int need = 256 - cgt;
        int run = 0;
#pragma unroll
        for (int i = 0; i < 2 * NREG; ++i) {
            const unsigned k = (i & 1) ? (kk[i >> 1] >> 16) : (kk[i >> 1] & 0xffffu);
            const u64 gt = __ballot(k > Tk); u64 eq = __ballot(k == Tk);
            const int pe = __builtin_popcountll(eq);
            if (run + pe > need) { int kq = need - run; kq = kq < 0 ? 0 : kq;
                const bool keep = ((eq >> lane) & 1ull) && (__builtin_popcountll(eq & ((1ull << lane) - 1ull)) < kq); eq = __ballot(keep); }
            run += pe;
            const u64 w = gt | eq;
            asm("s_nop 4\n\tv_writelane_b32 %0, %2, %4\n\tv_writelane_b32 %1, %3, %4" : "+v"(mylo), "+v"(myhi) : "s"((unsigned)w), "s"((unsigned)(w >> 32)), "n"(i));
        }
    }
    return (u64)mylo | ((u64)myhi << 32);
}
__device__ __forceinline__ void p_dsa_index(const Frame& F, unsigned char* ws, u64* SELT, const int mode) {
    const bf16_t* IQ = (const bf16_t*)(ws + L0_IQ); const bf16_t* IK = (const bf16_t*)(ws + L0_IK); const float* IW = (const float*)(ws + L0_IW);
    LAS _Float16* sc = (LAS _Float16*)F.lds;
    LAS unsigned short* scu = (LAS unsigned short*)F.lds;
    LAS u64* mk = (LAS u64*)(F.lds + 131072);
    LAS float* wl = (LAS float*)(F.lds + 131072 + 8192);
    const int lane = F.lane, wave = F.wave, h = lane >> 5, r = lane & 31;
    const int rq = ((r >> 4) & 1) + 2 * ((r >> 2) & 1), rh = 4 * ((r >> 3) & 1) + (r & 3);
    for (int u = F.bid; u < 2048; u += F.G) {
        const int idx = u & 255, b = u >> 8;
        const int j = (b & 1) ? 255 - idx : idx;
        const int t0 = j * 16; const size_t mb = (size_t)b * 4096;
        if (F.tid < 128) wl[F.tid] = IW[(mb + t0) * 8 + F.tid];
        const int nkb = (t0 + 15) / 32 + 1;
        bf16x8 Af[4][4];
#pragma unroll
        for (int rt = 0; rt < 4; ++rt)
#pragma unroll
            for (int ks = 0; ks < 4; ++ks) Af[rt][ks] = *(const bf16x8*)(IQ + (mb + t0 + 4 * rt + rq) * 512 + rh * 64 + ks * 16 + 8 * h);
        __syncthreads();
        if (mode != 2) for (int kb = wave; kb < nkb; kb += NWAVES) {
            bf16x8 Bf[4];
#pragma unroll
            for (int ks = 0; ks < 4; ++ks) Bf[ks] = *(const bf16x8*)(IK + (mb + kb * 32 + r) * 64 + ks * 16 + 8 * h);
#pragma unroll
            for (int rt = 0; rt < 4; ++rt) {
                f32x16 acc = {0.f, 0.f, 0.f, 0.f, 0.f, 0.f, 0.f, 0.f, 0.f, 0.f, 0.f, 0.f, 0.f, 0.f, 0.f, 0.f};
#pragma unroll
                for (int ks = 0; ks < 4; ++ks) acc = __builtin_amdgcn_mfma_f32_32x32x16_bf16(Af[rt][ks], Bf[ks], acc, 0, 0, 0);
                const int qa = 4 * rt + 2 * h;
                const f32x4 wa0 = *(const LAS f32x4*)(wl + qa * 8), wa1 = *(const LAS f32x4*)(wl + qa * 8 + 4), wb0 = *(const LAS f32x4*)(wl + qa * 8 + 8), wb1 = *(const LAS f32x4*)(wl + qa * 8 + 12);
                float sa = 0.f, sb = 0.f;
#pragma unroll
                for (int i = 0; i < 4; ++i) { sa += wa0[i] * fmaxf(acc[i], 0.f); sa += wa1[i] * fmaxf(acc[4 + i], 0.f); sb += wb0[i] * fmaxf(acc[8 + i], 0.f); sb += wb1[i] * fmaxf(acc[12 + i], 0.f); }
                sc[qa * 4096 + kb * 32 + r] = (_Float16)sa;
                sc[(qa + 1) * 4096 + kb * 32 + r] = (_Float16)sb;
                __builtin_amdgcn_sched_barrier(0);
            }
        }
        __syncthreads();
#pragma unroll 1
        for (int qq = 0; qq < (mode == 1 ? 0 : 2); ++qq) {
            const int q = wave * 2 + qq, t = t0 + q, n = t + 1;
            unsigned mylo = 0u, myhi = 0u;
            if (n <= 256) {
                const int base = lane * 64;
                const u64 word = (base + 63 <= t) ? ~0ull : (base > t ? 0ull : ((1ull << (t - base + 1)) - 1ull));
                mylo = (unsigned)word; myhi = (unsigned)(word >> 32);
            } else {
                const int nreg = (((n + 63) >> 6) + 1) >> 1;
                const LAS unsigned short* scq = scu + q * 4096;
                u64 w;
                if (nreg <= 4) w = topk_query<4>(scq, t, lane);
                else if (nreg <= 8) w = topk_query<8>(scq, t, lane);
                else if (nreg <= 12) w = topk_query<12>(scq, t, lane);
                else if (nreg <= 16) w = topk_query<16>(scq, t, lane);
                else if (nreg <= 20) w = topk_query<20>(scq, t, lane);
                else if (nreg <= 24) w = topk_query<24>(scq, t, lane);
                else if (nreg <= 28) w = topk_query<28>(scq, t, lane);
                else w = topk_query<32>(scq, t, lane);
                mylo = (unsigned)w; myhi = (unsigned)(w >> 32);
            }
            mk[lane * 16 + q] = (u64)mylo | ((u64)myhi << 32);
        }
        __syncthreads();
        { const int w = F.tid >> 3, part = F.tid & 7;
          u64* dst = SELT + ((size_t)(b * 64 + w) * 4096) + t0 + part * 2;
          dst[0] = mk[w * 16 + part * 2]; dst[1] = mk[w * 16 + part * 2 + 1]; }
        __syncthreads();
    }
}

constexpr int AT_KB = 9216, AT_VB = 8704, AT_BUF = AT_KB + AT_VB;
struct AttStage { u32x4 kreg, vreg; };
__device__ __forceinline__ void att_load(AttStage& s, const bf16_t* Kg, const bf16_t* Vtg, int key0, int tid) {
    s.kreg = *(const u32x4*)(Kg + (size_t)(key0 + (tid >> 3)) * 64 + (tid & 7) * 8);
    s.vreg = *(const u32x4*)(Vtg + (size_t)(tid >> 3) * 4096 + key0 + (tid & 7) * 8);
}
__device__ __forceinline__ void att_store(const AttStage& s, LAS unsigned char* buf, int tid) {
    *(LAS u32x4*)(buf + (tid >> 3) * 144 + (tid & 7) * 16) = s.kreg;
    LAS unsigned char* v = buf + AT_KB + (tid >> 3) * 136 + (tid & 7) * 16;
    *(LAS u32x2*)(v) = (u32x2){s.vreg.x, s.vreg.y}; *(LAS u32x2*)(v + 8) = (u32x2){s.vreg.z, s.vreg.w};
}
__device__ __forceinline__ bf16x8 pack8(float a0, float a1, float a2, float a3, float a4, float a5, float a6, float a7) {
    u32x4 w; w.x = pg8::cvt_pk_bf16(a0, a1); w.y = pg8::cvt_pk_bf16(a2, a3); w.z = pg8::cvt_pk_bf16(a4, a5); w.w = pg8::cvt_pk_bf16(a6, a7);
    return __builtin_bit_cast(bf16x8, w);
}
__device__ __forceinline__ f32x16 att_qk(const LAS unsigned char* buf, int sub, const bf16x8 (&Qf)[4], int lane) {
    f32x16 S = {0.f, 0.f, 0.f, 0.f, 0.f, 0.f, 0.f, 0.f, 0.f, 0.f, 0.f, 0.f, 0.f, 0.f, 0.f, 0.f};
    const LAS unsigned char* kp = buf + (sub * 32 + (lane & 31)) * 144 + (lane >> 5) * 16;
#pragma unroll
    for (int ks = 0; ks < 4; ++ks) { const bf16x8 kf = *(const LAS bf16x8*)(kp + ks * 32); S = __builtin_amdgcn_mfma_f32_32x32x16_bf16(kf, Qf[ks], S, 0, 0, 0); }
    return S;
}
__device__ __forceinline__ void att_pv2(const LAS unsigned char* buf, int sub, const bf16x8 P0, const bf16x8 P1, f32x16 (&O)[2], int lane) {
    const int h = lane >> 5;
#pragma unroll
    for (int dt = 0; dt < 2; ++dt) {
        const LAS unsigned char* vp = buf + AT_KB + (dt * 32 + (lane & 31)) * 136 + (sub * 32 + 4 * h) * 2;
        const u32x2 a0 = *(const LAS u32x2*)(vp), a1 = *(const LAS u32x2*)(vp + 16), b0 = *(const LAS u32x2*)(vp + 32), b1 = *(const LAS u32x2*)(vp + 48);
        const bf16x8 V0 = __builtin_bit_cast(bf16x8, ((u32x4){a0.x, a0.y, a1.x, a1.y}));
        const bf16x8 V1 = __builtin_bit_cast(bf16x8, ((u32x4){b0.x, b0.y, b1.x, b1.y}));
        O[dt] = __builtin_amdgcn_mfma_f32_32x32x16_bf16(V0, P0, O[dt], 0, 0, 0);
        O[dt] = __builtin_amdgcn_mfma_f32_32x32x16_bf16(V1, P1, O[dt], 0, 0, 0);
    }
}
__device__ __forceinline__ void att_pv(const LAS unsigned char* buf, int sub, const float (&p)[16], f32x16 (&O)[2], int lane) {
    const bf16x8 P0 = pack8(p[0], p[1], p[2], p[3], p[4], p[5], p[6], p[7]);
    const bf16x8 P1 = pack8(p[8], p[9], p[10], p[11], p[12], p[13], p[14], p[15]);
    att_pv2(buf, sub, P0, P1, O, lane);
}

__device__ __forceinline__ void att_kfrags(const LAS unsigned char* buf, int sub, bf16x8 (&Kf)[4], int lane) {
    const LAS unsigned char* kp = buf + (sub * 32 + (lane & 31)) * 144 + (lane >> 5) * 16;
#pragma unroll
    for (int ks = 0; ks < 4; ++ks) Kf[ks] = *(const LAS bf16x8*)(kp + ks * 32);
}
__device__ __forceinline__ void att_vfrags(const LAS unsigned char* buf, int sub, bf16x8 (&Vf)[2][2], int lane) {
    const int h = lane >> 5;
#pragma unroll
    for (int dt = 0; dt < 2; ++dt) {
        const LAS unsigned char* vp = buf + AT_KB + (dt * 32 + (lane & 31)) * 136 + (sub * 32 + 4 * h) * 2;
        const u32x2 a0 = *(const LAS u32x2*)(vp), a1 = *(const LAS u32x2*)(vp + 16), b0 = *(const LAS u32x2*)(vp + 32), b1 = *(const LAS u32x2*)(vp + 48);
        Vf[dt][0] = __builtin_bit_cast(bf16x8, ((u32x4){a0.x, a0.y, a1.x, a1.y}));
        Vf[dt][1] = __builtin_bit_cast(bf16x8, ((u32x4){b0.x, b0.y, b1.x, b1.y}));
    }
}
__device__ __forceinline__ f32x16 att_qk_f(const bf16x8 (&Kf)[4], const bf16x8 (&Qf)[4]) {
    f32x16 S = {0.f, 0.f, 0.f, 0.f, 0.f, 0.f, 0.f, 0.f, 0.f, 0.f, 0.f, 0.f, 0.f, 0.f, 0.f, 0.f};
#pragma unroll
    for (int ks = 0; ks < 4; ++ks) S = __builtin_amdgcn_mfma_f32_32x32x16_bf16(Kf[ks], Qf[ks], S, 0, 0, 0);
    return S;
}
__device__ __forceinline__ void att_pv_f(const bf16x8 (&Vf)[2][2], const bf16x8 P0, const bf16x8 P1, f32x16 (&O)[2]) {
#pragma unroll
    for (int dt = 0; dt < 2; ++dt) { O[dt] = __builtin_amdgcn_mfma_f32_32x32x16_bf16(Vf[dt][0], P0, O[dt], 0, 0, 0); O[dt] = __builtin_amdgcn_mfma_f32_32x32x16_bf16(Vf[dt][1], P1, O[dt], 0, 0, 0); }
}

__device__ __forceinline__ void p_dsa_attn(const Frame& F, const Args& a, unsigned char* ws) {
    const bf16_t* QA = (const bf16_t*)(ws + L0_QA); const bf16_t* KA = (const bf16_t*)(ws + L0_KA); const bf16_t* VAT = (const bf16_t*)(ws + L0_VAT);
    const u64* SELT = (const u64*)(ws + L0_SELT); bf16_t* CAT = (bf16_t*)(ws + L0_CAT);
    const int lane = F.lane, wave = F.wave, h = lane >> 5, c = lane & 31, tid = F.tid;
    float mq = 0.f, mk_ = 0.f;
    for (int i = 0; i < 64; ++i) { mq = fmaxf(mq, fabsf(a.in[I_L0_QG][i])); mk_ = fmaxf(mk_, fabsf(a.in[I_L0_KG][i])); }
    const float c2 = (8.0f * mq * mk_ + 0.5f) * 1.4426950408889634f, c1 = 1.4426950408889634f;
    for (int u = F.bid; u < 512; u += F.G) {
        const int idx = u & 255, g = u >> 8, b = idx >> 5, qtr = idx & 31, qt = g ? 31 - qtr : qtr, q0 = qt * 128;
        const size_t mb = (size_t)b * 4096;
        const bf16_t* Kg = KA + (size_t)(b * 2 + g) * 4096 * 64; const bf16_t* Vtg = VAT + (size_t)(b * 2 + g) * 64 * 4096;
        bf16x8 Qf[2][4]; int qidx[2];
#pragma unroll
        for (int ct = 0; ct < 2; ++ct) { qidx[ct] = q0 + wave * 16 + ct * 8 + (c >> 2);
#pragma unroll
            for (int ks = 0; ks < 4; ++ks) Qf[ct][ks] = *(const bf16x8*)(QA + (mb + qidx[ct]) * 512 + (g * 4 + (c & 3)) * 64 + ks * 16 + 8 * h); }
        f32x16 O[2][2]; float l[2] = {0.f, 0.f};
#pragma unroll
        for (int ct = 0; ct < 2; ++ct)
#pragma unroll
            for (int dt = 0; dt < 2; ++dt)
#pragma unroll
                for (int i = 0; i < 16; ++i) O[ct][dt][i] = 0.f;
        const int nkt = 2 * qt + 2;
        AttStage st; att_load(st, Kg, Vtg, 0, tid);
        __syncthreads();
        att_store(st, F.lds, tid);
        __syncthreads();
        for (int kt = 0; kt < nkt; ++kt) {
            LAS unsigned char* buf = F.lds + (kt & 1) * AT_BUF;
            if (kt + 1 < nkt) att_load(st, Kg, Vtg, (kt + 1) * 64, tid);
            u64 mw[2];
#pragma unroll
            for (int ct = 0; ct < 2; ++ct) mw[ct] = SELT[(size_t)(b * 64 + kt) * 4096 + qidx[ct]];
#pragma unroll 1
            for (int sub = 0; sub < 2; ++sub) {
                bf16x8 Kf[4], Vf[2][2];
                att_kfrags(buf, sub, Kf, lane); att_vfrags(buf, sub, Vf, lane);
#pragma unroll
                for (int ct = 0; ct < 2; ++ct) {
                    __builtin_amdgcn_sched_barrier(0);
                    const f32x16 S = att_qk_f(Kf, Qf[ct]);
                    const unsigned mbits = (unsigned)(mw[ct] >> (sub * 32 + 4 * h));
                    float p[16];
#pragma unroll
                    for (int i = 0; i < 16; ++i) {
                        const float e = __builtin_amdgcn_exp2f(S[i] * c1 - c2);
                        const int bitpos = (i & 3) + 8 * (i >> 2);
                        p[i] = __builtin_bit_cast(float, __builtin_bit_cast(int, e) & __builtin_amdgcn_sbfe((int)mbits, bitpos, 1));
                        l[ct] += p[i];
                    }
                    att_pv_f(Vf, pack8(p[0], p[1], p[2], p[3], p[4], p[5], p[6], p[7]), pack8(p[8], p[9], p[10], p[11], p[12], p[13], p[14], p[15]), O[ct]);
                }
            }
            if (kt + 1 < nkt) att_store(st, F.lds + ((kt + 1) & 1) * AT_BUF, tid);
            __syncthreads();
        }
#pragma unroll
        for (int ct = 0; ct < 2; ++ct) {
            const float lt = l[ct] + __shfl_xor(l[ct], 32);
            const float inv = 1.0f / fmaxf(lt, 1e-30f);
            bf16_t* orow = CAT + (mb + qidx[ct]) * 1024 + (g * 4 + (c & 3)) * 64;
#pragma unroll
            for (int dt = 0; dt < 2; ++dt)
#pragma unroll
                for (int i4 = 0; i4 < 4; ++i4) {
                    const int d = dt * 32 + 8 * i4 + 4 * h;
                    u32x2 w; w.x = pk2(O[ct][dt][4 * i4] * inv, O[ct][dt][4 * i4 + 1] * inv); w.y = pk2(O[ct][dt][4 * i4 + 2] * inv, O[ct][dt][4 * i4 + 3] * inv);
                    *(u32x2*)(orow + d) = w;
                }
        }
    }
}

__device__ __forceinline__ void p_s5_scan(const Frame& F, const Args& a, unsigned char* ws) {
    const float* SLOC = (const float*)(ws + L0_SLOC); bf16_t* UA = (bf16_t*)(ws + L0_UA);
    const int p = F.lane;
    if (F.wave == 0) for (int it = F.bid; it < 32 * NB; it += F.G) {
        const int g = it >> 3, b = it & 7;
        const float dt = expf(a.in[I_L0_LOGDT][g]);
        const float lr = a.in[I_L0_ARE][g * 64 + p], li = a.in[I_L0_AIM][g * 64 + p];
        const float mag = expf(16.0f * dt * lr); float s, c; sincosf(16.0f * dt * li, &s, &c);
        const float ar = mag * c, ai = mag * s;
        float hr = 0.f, hi = 0.f;
        const float* sl = SLOC + ((size_t)g * 2048 + b * 256) * 128;
        bf16_t* ua = UA + ((size_t)g * 2048 + b * 256) * 384 + 256;
        for (int ch = 0; ch < 256; ++ch) {
            ua[(size_t)ch * 384 + p] = (bf16_t)f2bf(hr); ua[(size_t)ch * 384 + 64 + p] = (bf16_t)f2bf(hi);
            const float xr = sl[(size_t)ch * 128 + p], xi = sl[(size_t)ch * 128 + 64 + p];
            const float nr = ar * hr - ai * hi + xr, ni = ar * hi + ai * hr + xi;
            hr = nr; hi = ni;
        }
    }
}
namespace pg8 {
struct EpiS5State {
    static constexpr bool PERM = false;
    float* C;
    __device__ __forceinline__ void operator()(const f32x4 (&acc)[2][2][4][2], const Unit& u, int wr, int wc, int fr, int fq) const {
        const int row0 = u.pm * BM + wr * 64 + fr, col0 = wc * 32 + 4 * fq;
#pragma unroll
        for (int ai = 0; ai < 2; ++ai)
#pragma unroll
            for (int m = 0; m < 4; ++m)
#pragma unroll
                for (int n = 0; n < 2; ++n) *(f32x4*)(C + (size_t)(row0 + ai * HALF + m * 16) * 128 + col0 + n * 16) = acc[ai][0][m][n];
    }
};
struct EpiS5Out {
    static constexpr bool PERM = false;
    bf16_t* YB;
    __device__ __forceinline__ void operator()(const f32x4 (&acc)[2][2][4][2], const Unit& u, int wr, int wc, int fr, int fq) const {
        const int g = u.pn;
        const int row0 = u.pm * BM + wr * 64 + fr - g * 2048;
        const int col0 = wc * 32 + 4 * fq;
#pragma unroll
        for (int ai = 0; ai < 2; ++ai)
#pragma unroll
            for (int m = 0; m < 4; ++m) { const int chunk = row0 + ai * HALF + m * 16;
#pragma unroll
                for (int bj = 0; bj < 2; ++bj)
#pragma unroll
                    for (int n = 0; n < 2; ++n) { const int col = col0 + bj * HALF + n * 16, i = col >> 4, co = col & 15;
                        const f32x4 v = acc[ai][bj][m][n];
                        u32x2 w; w.x = pk2(gelu_tanh(v[0]), gelu_tanh(v[1])); w.y = pk2(gelu_tanh(v[2]), gelu_tanh(v[3]));
                        *(u32x2*)(YB + ((size_t)chunk * 16 + i) * 512 + g * 16 + co) = w; }
                asm volatile("" ::: "memory"); __builtin_amdgcn_sched_barrier(0); }
    }
};
struct EpiGlu {
    static constexpr bool PERM = true;
    const bf16_t* YB; const float* bias; bf16_t* CAT;
    __device__ __forceinline__ void operator()(const f32x4 (&acc)[2][2][4][2], const Unit& u, int wr, int wc, int fr, int fq) const {
        const int row0 = u.pm * BM + wr * 64 + fr, col0 = u.pn * BM + wc * 32 + 8 * fq;
#pragma unroll
        for (int ai = 0; ai < 2; ++ai)
#pragma unroll
            for (int m = 0; m < 4; ++m) { const size_t row = row0 + ai * HALF + m * 16;
#pragma unroll
                for (int bj = 0; bj < 2; ++bj) { const int col = col0 + bj * HALF;
                    const u32x4 yv = *(const u32x4*)(YB + row * 512 + col);
                    const f32x4 b0 = *(const f32x4*)(bias + col), b1 = *(const f32x4*)(bias + col + 4);
                    const f32x4 z0 = acc[ai][bj][m][0] + b0, z1 = acc[ai][bj][m][1] + b1;
                    u32x4 w;
                    w.x = pk2(bf_lo(yv.x) * sigmoidf_(z0[0]), bf_hi(yv.x) * sigmoidf_(z0[1])); w.y = pk2(bf_lo(yv.y) * sigmoidf_(z0[2]), bf_hi(yv.y) * sigmoidf_(z0[3]));
                    w.z = pk2(bf_lo(yv.z) * sigmoidf_(z1[0]), bf_hi(yv.z) * sigmoidf_(z1[1])); w.w = pk2(bf_lo(yv.w) * sigmoidf_(z1[2]), bf_hi(yv.w) * sigmoidf_(z1[3]));
                    *(u32x4*)(CAT + row * 1024 + 512 + col) = w; }
                asm volatile("" ::: "memory"); __builtin_amdgcn_sched_barrier(0); }
    }
};
}
__device__ __forceinline__ void peer_fold_wq(const Frame& F, const float* wq, const float* sk, bf16_t* WT) {
    const int gw = F.bid * NWAVES + F.wave, NGW = F.G * NWAVES, lane = F.lane, r = lane & 31, h = lane >> 5;
    for (int it = gw; it < 16 * 4 * 32; it += NGW) {
        const int dt = it & 31, kt = (it >> 5) & 3, hp = it >> 7;
        f32x16 acc = {0.f, 0.f, 0.f, 0.f, 0.f, 0.f, 0.f, 0.f, 0.f, 0.f, 0.f, 0.f, 0.f, 0.f, 0.f, 0.f};
        const float* ap = sk + ((size_t)hp * 128 + 32 * kt + r) * 128 + 8 * h;
        const float* bp = wq + (size_t)(32 * dt + r) * 2048 + hp * 128 + 8 * h;
#pragma unroll
        for (int ks = 0; ks < 8; ++ks) {
            const f32x4 a0 = *(const f32x4*)(ap + 16 * ks), a1 = *(const f32x4*)(ap + 16 * ks + 4), b0 = *(const f32x4*)(bp + 16 * ks), b1 = *(const f32x4*)(bp + 16 * ks + 4);
            acc = __builtin_amdgcn_mfma_f32_32x32x16_bf16(pack8(a0[0], a0[1], a0[2], a0[3], a1[0], a1[1], a1[2], a1[3]), pack8(b0[0], b0[1], b0[2], b0[3], b1[0], b1[1], b1[2], b1[3]), acc, 0, 0, 0);
        }
#pragma unroll
        for (int i = 0; i < 16; ++i) WT[((size_t)hp * 128 + 32 * kt + (i & 3) + 8 * (i >> 2) + 4 * h) * 1024 + 32 * dt + r] = (bf16_t)f2bf(acc[i]);
    }
}
__device__ __forceinline__ unsigned mono_u32(float f) { const unsigned u = __builtin_bit_cast(unsigned, f); return u ^ ((u >> 31) ? 0xFFFFFFFFu : 0x80000000u); }
#define CE_DESC(x, y) do { const unsigned _hi = (x) > (y) ? (x) : (y), _lo = (x) > (y) ? (y) : (x); (x) = _hi; (y) = _lo; } while (0)
__device__ __forceinline__ void sort16_desc(unsigned (&a)[16]) {
#pragma unroll
    for (int k = 2; k <= 16; k <<= 1)
#pragma unroll
        for (int j = k >> 1; j > 0; j >>= 1)
#pragma unroll
            for (int i = 0; i < 16; ++i) { const int l = i ^ j; if (l > i) { if ((i & k) == 0) CE_DESC(a[i], a[l]); else CE_DESC(a[l], a[i]); } }
}
__device__ __forceinline__ void merge16_desc(unsigned (&a)[16], const unsigned (&b)[16]) {
#pragma unroll
    for (int i = 0; i < 16; ++i) a[i] = a[i] > b[15 - i] ? a[i] : b[15 - i];
#pragma unroll
    for (int j = 8; j > 0; j >>= 1)
#pragma unroll
        for (int i = 0; i < 16; ++i) { const int l = i ^ j; if (l > i) CE_DESC(a[i], a[l]); }
}
__device__ __forceinline__ void merge16_xlane(unsigned (&a)[16]) {
    unsigned b[16];
#pragma unroll
    for (int i = 0; i < 16; ++i) b[i] = (unsigned)__shfl_xor((int)a[i], 32);
    merge16_desc(a, b);
}
struct PeerCand { int a[50], b[50]; };
__host__ __device__ constexpr PeerCand peer_cands() { PeerCand c{}; int n = 0; for (int a = 0; a < 16; ++a) for (int b = 0; b < 16; ++b) if ((a + 1) * (b + 1) <= 16) { c.a[n] = a; c.b[n] = b; ++n; } return c; }
__device__ __forceinline__ void p_peer_route(const Frame& F, unsigned char* ws) {
    const _Float16* S16 = (const _Float16*)(ws + PE_Q2); unsigned short* EID = (unsigned short*)(ws + PE_EID); float* GATE = (float*)(ws + PE_GATE);
    LAS float* sc0 = (LAS float*)F.lds;
    const int lane = F.lane, wave = F.wave, h5 = lane >> 5, r = lane & 31, tid = F.tid;
    constexpr PeerCand PC = peer_cands();
    u32x4 pre[8];
    { const int u = F.bid; if (u < 2048) { const int hd = u & 7, mt = u >> 3;
#pragma unroll
        for (int q = 0; q < 8; ++q) pre[q] = *(const u32x4*)(S16 + ((size_t)mt * 128 + (q & 3) * 32 + (tid >> 4)) * 2048 + (hd * 2 + (q >> 2)) * 128 + (tid & 15) * 8); } }
    for (int u = F.bid; u < 2048; u += F.G) {
        const int hd = u & 7, mt = u >> 3; const size_t m0 = (size_t)mt * 128;
#pragma unroll
        for (int q = 0; q < 8; ++q) {
            LAS float* dst = sc0 + (q >> 2) * 128 * 129 + ((q & 3) * 32 + (tid >> 4)) * 129 + (tid & 15) * 8;
            const u32x4 v = pre[q];
#pragma unroll
            for (int j = 0; j < 4; ++j) { const unsigned w = v[j]; dst[2 * j] = (float)__builtin_bit_cast(_Float16, (unsigned short)(w & 0xffffu)); dst[2 * j + 1] = (float)__builtin_bit_cast(_Float16, (unsigned short)(w >> 16)); }
        }
        { const int un = u + F.G; if (un < 2048) { const int hdn = un & 7, mtn = un >> 3;
#pragma unroll
            for (int q = 0; q < 8; ++q) pre[q] = *(const u32x4*)(S16 + ((size_t)mtn * 128 + (q & 3) * 32 + (tid >> 4)) * 2048 + (hdn * 2 + (q >> 2)) * 128 + (tid & 15) * 8); } }
        __syncthreads();
        {
            const int pp = wave >> 2, row = (wave & 3) * 32 + r, half = h5; LAS float* rowp = sc0 + pp * 128 * 129 + row * 129;
            unsigned top[16];
#pragma unroll
            for (int blk = 0; blk < 4; ++blk) {
                unsigned k16[16];
#pragma unroll
                for (int i = 0; i < 16; ++i) { const int j = half * 64 + blk * 16 + i; k16[i] = (mono_u32(rowp[j]) & ~0x7Fu) | (unsigned)(127 - j); }
                sort16_desc(k16);
                if (blk == 0) {
#pragma unroll
                    for (int i = 0; i < 16; ++i) top[i] = k16[i];
                } else merge16_desc(top, k16);
            }
            merge16_xlane(top);
            float vals[16]; int ids[16];
#pragma unroll
            for (int k = 0; k < 16; ++k) { ids[k] = 127 - (int)(top[k] & 127u); vals[k] = rowp[ids[k]]; }
            if (half == 0) {
#pragma unroll
                for (int k = 0; k < 16; ++k) { rowp[k] = vals[k]; rowp[16 + k] = __int_as_float(ids[k]); }
            }
        }
        __syncthreads();
        if (tid < 256) {
            const int row = (wave & 3) * 32 + r, half = h5; const LAS float* s1 = sc0 + row * 129; const LAS float* s2 = sc0 + 128 * 129 + row * 129;
            float v1[16], v2[16];
#pragma unroll
            for (int k = 0; k < 16; ++k) { v1[k] = s1[k]; v2[k] = s2[k]; }
            unsigned top[16], k16[16];
#pragma unroll
            for (int i = 0; i < 16; ++i) { const int c0 = 2 * i, c1 = 2 * i + 1;
                const unsigned ka = (mono_u32(v1[PC.a[c0]] + v2[PC.b[c0]]) & ~0xFFu) | (unsigned)(255 - (PC.a[c0] * 16 + PC.b[c0]));
                const unsigned kb = (mono_u32(v1[PC.a[c1]] + v2[PC.b[c1]]) & ~0xFFu) | (unsigned)(255 - (PC.a[c1] * 16 + PC.b[c1]));
                top[i] = half ? kb : ka; }
#pragma unroll
            for (int i = 0; i < 16; ++i) { if (i < 9) { const int c0 = 32 + 2 * i, c1 = 32 + 2 * i + 1;
                    const unsigned ka = (mono_u32(v1[PC.a[c0]] + v2[PC.b[c0]]) & ~0xFFu) | (unsigned)(255 - (PC.a[c0] * 16 + PC.b[c0]));
                    const unsigned kb = (mono_u32(v1[PC.a[c1]] + v2[PC.b[c1]]) & ~0xFFu) | (unsigned)(255 - (PC.a[c1] * 16 + PC.b[c1]));
                    k16[i] = half ? kb : ka; } else k16[i] = 0u; }
            sort16_desc(top); sort16_desc(k16); merge16_desc(top, k16);
            merge16_xlane(top);
            if (half == 0) {
                float mx = -3.0e38f; float sv[16]; int eid[16];
#pragma unroll
                for (int k = 0; k < 16; ++k) { const int fl = 255 - (int)(top[k] & 255u), a = fl >> 4, b = fl & 15;
                    sv[k] = s1[a] + s2[b]; eid[k] = __float_as_int(s1[16 + a]) * 128 + __float_as_int(s2[16 + b]); mx = fmaxf(mx, sv[k]); }
                float den = 0.f;
#pragma unroll
                for (int k = 0; k < 16; ++k) { sv[k] = __expf(sv[k] - mx); den += sv[k]; }
                const float inv = 1.0f / den;
                unsigned short* ep = EID + (m0 + row) * 128 + hd * 16; float* gp = GATE + (m0 + row) * 128 + hd * 16;
#pragma unroll
                for (int k = 0; k < 16; ++k) { ep[k] = (unsigned short)eid[k]; gp[k] = sv[k] * inv; }
            }
        }
        __syncthreads();
    }
}

__device__ __forceinline__ float rdlane_f(float v, int l) { return __builtin_bit_cast(float, __builtin_amdgcn_readlane(__builtin_bit_cast(int, v), l)); }
__device__ __forceinline__ void p_peer_expert(const Frame& F, unsigned char* ws, float* xres) {
    const bf16_t* XN = (const bf16_t*)(ws + WS_XN); const bf16_t* TU = (const bf16_t*)(ws + WS_TABU); const bf16_t* TV = (const bf16_t*)(ws + WS_TABV);
    const unsigned short* EID = (const unsigned short*)(ws + PE_EID); const float* GATE = (const float*)(ws + PE_GATE);
    const int gw = F.bid * NWAVES + F.wave, NGW = F.G * NWAVES, lane = F.lane;
    for (int m = gw; m < T; m += NGW) {
        float xf[16];
        { const u32x4 xa = *(const u32x4*)(XN + (size_t)m * 1024 + lane * 8), xb = *(const u32x4*)(XN + (size_t)m * 1024 + 512 + lane * 8);
          xf[0] = bf_lo(xa.x); xf[1] = bf_hi(xa.x); xf[2] = bf_lo(xa.y); xf[3] = bf_hi(xa.y); xf[4] = bf_lo(xa.z); xf[5] = bf_hi(xa.z); xf[6] = bf_lo(xa.w); xf[7] = bf_hi(xa.w);
          xf[8] = bf_lo(xb.x); xf[9] = bf_hi(xb.x); xf[10] = bf_lo(xb.y); xf[11] = bf_hi(xb.y); xf[12] = bf_lo(xb.z); xf[13] = bf_hi(xb.z); xf[14] = bf_lo(xb.w); xf[15] = bf_hi(xb.w); }
        const int id0 = EID[(size_t)m * 128 + lane], id1 = EID[(size_t)m * 128 + 64 + lane];
        const float g0 = GATE[(size_t)m * 128 + lane], g1 = GATE[(size_t)m * 128 + 64 + lane];
        float outv[16];
#pragma unroll
        for (int i = 0; i < 16; ++i) outv[i] = 0.f;
#pragma unroll 1
        for (int k = 0; k < 16; ++k) {
            const int idreg = (k < 8) ? id0 : id1; const float greg = (k < 8) ? g0 : g1; const int lbase = (k & 7) * 8;
            int e[8];
#pragma unroll
            for (int i = 0; i < 8; ++i) e[i] = __builtin_amdgcn_readlane(idreg, lbase + i);
            float pr[8];
            {
                u32x4 ua[8], ub[8];
#pragma unroll
                for (int i = 0; i < 8; ++i) { ua[i] = *(const u32x4*)(TU + (size_t)e[i] * 1024 + lane * 8); ub[i] = *(const u32x4*)(TU + (size_t)e[i] * 1024 + 512 + lane * 8); }
#pragma unroll
                for (int i = 0; i < 8; ++i) {
                    float s = xf[0] * bf_lo(ua[i].x); s += xf[1] * bf_hi(ua[i].x); s += xf[2] * bf_lo(ua[i].y); s += xf[3] * bf_hi(ua[i].y);
                    s += xf[4] * bf_lo(ua[i].z); s += xf[5] * bf_hi(ua[i].z); s += xf[6] * bf_lo(ua[i].w); s += xf[7] * bf_hi(ua[i].w);
                    s += xf[8] * bf_lo(ub[i].x); s += xf[9] * bf_hi(ub[i].x); s += xf[10] * bf_lo(ub[i].y); s += xf[11] * bf_hi(ub[i].y);
                    s += xf[12] * bf_lo(ub[i].z); s += xf[13] * bf_hi(ub[i].z); s += xf[14] * bf_lo(ub[i].w); s += xf[15] * bf_hi(ub[i].w);
                    pr[i] = s;
                }
            }
            float r4[4], r2[2], r1;
            { const bool up = (lane & 32) != 0;
#pragma unroll
              for (int i = 0; i < 4; ++i) { const float keep = up ? pr[i + 4] : pr[i], send = up ? pr[i] : pr[i + 4]; r4[i] = keep + __shfl_xor(send, 32); } }
            { const bool up = (lane & 16) != 0;
#pragma unroll
              for (int i = 0; i < 2; ++i) { const float keep = up ? r4[i + 2] : r4[i], send = up ? r4[i] : r4[i + 2]; r2[i] = keep + __shfl_xor(send, 16); } }
            { const bool up = (lane & 8) != 0; const float keep = up ? r2[1] : r2[0], send = up ? r2[0] : r2[1]; r1 = keep + __shfl_xor(send, 8); }
            r1 += __shfl_xor(r1, 4); r1 += __shfl_xor(r1, 2); r1 += __shfl_xor(r1, 1);
            const float gv = __shfl(greg, lbase + (lane >> 3));
            const float coef = gv * gelu_tanh(r1);
            {
                u32x4 va[8], vb[8];
#pragma unroll
                for (int i = 0; i < 8; ++i) { va[i] = *(const u32x4*)(TV + (size_t)e[i] * 1024 + lane * 8); vb[i] = *(const u32x4*)(TV + (size_t)e[i] * 1024 + 512 + lane * 8); }
#pragma unroll
                for (int i = 0; i < 8; ++i) {
                    const float ci = rdlane_f(coef, i * 8);
                    outv[0] += ci * bf_lo(va[i].x); outv[1] += ci * bf_hi(va[i].x); outv[2] += ci * bf_lo(va[i].y); outv[3] += ci * bf_hi(va[i].y);
                    outv[4] += ci * bf_lo(va[i].z); outv[5] += ci * bf_hi(va[i].z); outv[6] += ci * bf_lo(va[i].w); outv[7] += ci * bf_hi(va[i].w);
                    outv[8] += ci * bf_lo(vb[i].x); outv[9] += ci * bf_hi(vb[i].x); outv[10] += ci * bf_lo(vb[i].y); outv[11] += ci * bf_hi(vb[i].y);
                    outv[12] += ci * bf_lo(vb[i].z); outv[13] += ci * bf_hi(vb[i].z); outv[14] += ci * bf_lo(vb[i].w); outv[15] += ci * bf_hi(vb[i].w);
                }
            }
        }
        f32x4* o = (f32x4*)(xres + (size_t)m * 1024 + lane * 8);
        f32x4 a0 = o[0], a1 = o[1], b0 = o[128], b1 = o[129];
        a0 += (f32x4){outv[0], outv[1], outv[2], outv[3]}; a1 += (f32x4){outv[4], outv[5], outv[6], outv[7]};
        b0 += (f32x4){outv[8], outv[9], outv[10], outv[11]}; b1 += (f32x4){outv[12], outv[13], outv[14], outv[15]};
        o[0] = a0; o[1] = a1; o[128] = b0; o[129] = b1;
    }
}

typedef __bf16 bf16x2_t __attribute__((ext_vector_type(2)));
__device__ __forceinline__ float dot2bf(unsigned a, unsigned b, float c) { return __builtin_amdgcn_fdot2_f32_bf16(__builtin_bit_cast(bf16x2_t, a), __builtin_bit_cast(bf16x2_t, b), c, false); }
__device__ __forceinline__ void peer_slot_range(const unsigned (&xp)[8], float (&outv)[16], int id0, int id1, float g0, float g1, int r,
                                                const bf16_t* TU, const bf16_t* TV, int lane) {
    u64 m0 = __ballot((id0 >> 9) == r), m1 = __ballot((id1 >> 9) == r);
    while (m0 | m1) {
        int e[8]; float gt[8];
#pragma unroll
        for (int i = 0; i < 8; ++i) {
            if (m0) { const int l = __builtin_ctzll(m0); m0 &= m0 - 1ull; e[i] = __builtin_amdgcn_readlane(id0, l); gt[i] = rdlane_f(g0, l); }
            else if (m1) { const int l = __builtin_ctzll(m1); m1 &= m1 - 1ull; e[i] = __builtin_amdgcn_readlane(id1, l); gt[i] = rdlane_f(g1, l); }
            else { e[i] = -1; gt[i] = 0.f; }
        }
        float pr[8];
        {
            u32x4 ua[8], ub[8];
#pragma unroll
            for (int i = 0; i < 8; ++i) {
                if (e[i] >= 0) { ua[i] = *(const u32x4*)(TU + (size_t)e[i] * 1024 + lane * 8); ub[i] = *(const u32x4*)(TU + (size_t)e[i] * 1024 + 512 + lane * 8); }
                else { ua[i] = (u32x4){0u, 0u, 0u, 0u}; ub[i] = (u32x4){0u, 0u, 0u, 0u}; }
            }
#pragma unroll
            for (int i = 0; i < 8; ++i) {
                float s = dot2bf(xp[0], ua[i].x, 0.f); s = dot2bf(xp[1], ua[i].y, s); s = dot2bf(xp[2], ua[i].z, s); s = dot2bf(xp[3], ua[i].w, s);
                s = dot2bf(xp[4], ub[i].x, s); s = dot2bf(xp[5], ub[i].y, s); s = dot2bf(xp[6], ub[i].z, s); s = dot2bf(xp[7], ub[i].w, s);
                pr[i] = s;
            }
        }
        float r4[4], r2[2], r1;
        { const bool up = (lane & 32) != 0;
#pragma unroll
          for (int i = 0; i < 4; ++i) { const float keep = up ? pr[i + 4] : pr[i], send = up ? pr[i] : pr[i + 4]; r4[i] = keep + __shfl_xor(send, 32); } }
        { const bool up = (lane & 16) != 0;
#pragma unroll
          for (int i = 0; i < 2; ++i) { const float keep = up ? r4[i + 2] : r4[i], send = up ? r4[i] : r4[i + 2]; r2[i] = keep + __shfl_xor(send, 16); } }
        { const bool up = (lane & 8) != 0; const float keep = up ? r2[1] : r2[0], send = up ? r2[0] : r2[1]; r1 = keep + __shfl_xor(send, 8); }
        r1 += __shfl_xor(r1, 4); r1 += __shfl_xor(r1, 2); r1 += __shfl_xor(r1, 1);
        const int grp = lane >> 3;
        float gsel = gt[0];
#pragma unroll
        for (int i = 1; i < 8; ++i) gsel = (grp == i) ? gt[i] : gsel;
        const float coef = gsel * gelu_tanh(r1);
        {
            u32x4 va[8], vb[8];
#pragma unroll
            for (int i = 0; i < 8; ++i) {
                if (e[i] >= 0) { va[i] = *(const u32x4*)(TV + (size_t)e[i] * 1024 + lane * 8); vb[i] = *(const u32x4*)(TV + (size_t)e[i] * 1024 + 512 + lane * 8); }
                else { va[i] = (u32x4){0u, 0u, 0u, 0u}; vb[i] = (u32x4){0u, 0u, 0u, 0u}; }
            }
#pragma unroll
            for (int i = 0; i < 8; ++i) {
                if (e[i] >= 0) {
                    const float ci = rdlane_f(coef, i * 8);
                    outv[0] += ci * bf_lo(va[i].x); outv[1] += ci * bf_hi(va[i].x); outv[2] += ci * bf_lo(va[i].y); outv[3] += ci * bf_hi(va[i].y);
                    outv[4] += ci * bf_lo(va[i].z); outv[5] += ci * bf_hi(va[i].z); outv[6] += ci * bf_lo(va[i].w); outv[7] += ci * bf_hi(va[i].w);
                    outv[8] += ci * bf_lo(vb[i].x); outv[9] += ci * bf_hi(vb[i].x); outv[10] += ci * bf_lo(vb[i].y); outv[11] += ci * bf_hi(vb[i].y);
                    outv[12] += ci * bf_lo(vb[i].z); outv[13] += ci * bf_hi(vb[i].z); outv[14] += ci * bf_lo(vb[i].w); outv[15] += ci * bf_hi(vb[i].w);
                }
            }
        }
    }
}
__device__ __forceinline__ void p_peer_expert2(const Frame& F, unsigned char* ws, float* xres, const float oscale) {
    const bf16_t* XN = (const bf16_t*)(ws + WS_XN); const bf16_t* TU = (const bf16_t*)(ws + WS_TABU); const bf16_t* TV = (const bf16_t*)(ws + WS_TABV);
    const unsigned short* EID = (const unsigned short*)(ws + PE_EID); const float* GATE = (const float*)(ws + PE_GATE);
    const int gw = F.bid * NWAVES + F.wave, NGW = F.G * NWAVES, lane = F.lane;
    int rnd = 0;
    for (int m4 = gw * 4; m4 < T; m4 += NGW * 4, ++rnd) {
        unsigned xp[4][8]; float outv[4][16]; int id[4][2]; float gg[4][2];
#pragma unroll
        for (int s = 0; s < 4; ++s) {
            const size_t m = (size_t)(m4 + s);
            const u32x4 xa = *(const u32x4*)(XN + m * 1024 + lane * 8), xb = *(const u32x4*)(XN + m * 1024 + 512 + lane * 8);
            xp[s][0] = xa.x; xp[s][1] = xa.y; xp[s][2] = xa.z; xp[s][3] = xa.w; xp[s][4] = xb.x; xp[s][5] = xb.y; xp[s][6] = xb.z; xp[s][7] = xb.w;
            id[s][0] = EID[m * 128 + lane]; id[s][1] = EID[m * 128 + 64 + lane]; gg[s][0] = GATE[m * 128 + lane]; gg[s][1] = GATE[m * 128 + 64 + lane];
#pragma unroll
            for (int i = 0; i < 16; ++i) outv[s][i] = 0.f;
        }
#pragma unroll 1
        for (int k = 0; k < 32; ++k) {
            const int r = (rnd & 1) ? 31 - k : k;
#pragma unroll
            for (int s = 0; s < 4; ++s) peer_slot_range(xp[s], outv[s], id[s][0], id[s][1], gg[s][0], gg[s][1], r, TU, TV, lane);
        }
#pragma unroll
        for (int s = 0; s < 4; ++s) {
            f32x4* o = (f32x4*)(xres + (size_t)(m4 + s) * 1024 + lane * 8);
            f32x4 a0 = o[0], a1 = o[1], b0 = o[128], b1 = o[129];
            a0 += (f32x4){outv[s][0], outv[s][1], outv[s][2], outv[s][3]} * oscale; a1 += (f32x4){outv[s][4], outv[s][5], outv[s][6], outv[s][7]} * oscale;
            b0 += (f32x4){outv[s][8], outv[s][9], outv[s][10], outv[s][11]} * oscale; b1 += (f32x4){outv[s][12], outv[s][13], outv[s][14], outv[s][15]} * oscale;
            o[0] = a0; o[1] = a1; o[128] = b0; o[129] = b1;
        }
    }
}

struct RowBuf { u32x4 a[8], b[8]; };
__device__ __forceinline__ void peer_load8(RowBuf& rb, const bf16_t* TAB, const LAS unsigned* ent, int b, int lane) {
#pragma unroll
    for (int i = 0; i < 8; ++i) {
        const unsigned e = (unsigned)__builtin_amdgcn_readfirstlane((int)ent[b * 8 + i]) & 0x3FFFu;
        const bf16_t* rp = TAB + (size_t)e * 1024 + lane * 8;
        rb.a[i] = *(const u32x4*)rp; rb.b[i] = *(const u32x4*)(rp + 512);
    }
}
__device__ __forceinline__ float peer_dot(const unsigned (&xp)[8], const u32x4 a, const u32x4 b) {
    float s = dot2bf(xp[0], a.x, 0.f); s = dot2bf(xp[1], a.y, s); s = dot2bf(xp[2], a.z, s); s = dot2bf(xp[3], a.w, s);
    s = dot2bf(xp[4], b.x, s); s = dot2bf(xp[5], b.y, s); s = dot2bf(xp[6], b.z, s); s = dot2bf(xp[7], b.w, s);
    return s;
}
__device__ __forceinline__ void peer_u8(const RowBuf& rb, const unsigned (&xp)[4][8], const LAS unsigned* ent, LAS float* cf, int b, int lane) {
    float pr[8];
#pragma unroll
    for (int i = 0; i < 8; ++i) {
        const int slot = (__builtin_amdgcn_readfirstlane((int)ent[b * 8 + i]) >> 21) & 3;
        if (slot == 0) pr[i] = peer_dot(xp[0], rb.a[i], rb.b[i]);
        else if (slot == 1) pr[i] = peer_dot(xp[1], rb.a[i], rb.b[i]);
        else if (slot == 2) pr[i] = peer_dot(xp[2], rb.a[i], rb.b[i]);
        else pr[i] = peer_dot(xp[3], rb.a[i], rb.b[i]);
    }
    float r4[4], r2[2], r1;
    { const bool up = (lane & 32) != 0;
#pragma unroll
      for (int i = 0; i < 4; ++i) { const float keep = up ? pr[i + 4] : pr[i], send = up ? pr[i] : pr[i + 4]; r4[i] = keep + __shfl_xor(send, 32); } }
    { const bool up = (lane & 16) != 0;
#pragma unroll
      for (int i = 0; i < 2; ++i) { const float keep = up ? r4[i + 2] : r4[i], send = up ? r4[i] : r4[i + 2]; r2[i] = keep + __shfl_xor(send, 16); } }
    { const bool up = (lane & 8) != 0; const float keep = up ? r2[1] : r2[0], send = up ? r2[0] : r2[1]; r1 = keep + __shfl_xor(send, 8); }
    r1 += __shfl_xor(r1, 4); r1 += __shfl_xor(r1, 2); r1 += __shfl_xor(r1, 1);
    const float gate = cf[b * 8 + (lane >> 3)];
    const float coef = gate * gelu_tanh(r1);
    if ((lane & 7) == 0) cf[b * 8 + (lane >> 3)] = coef;
}
__device__ __forceinline__ void peer_acc(float (&o)[16], const float c, const u32x4 a, const u32x4 b) {
    o[0] += c * bf_lo(a.x); o[1] += c * bf_hi(a.x); o[2] += c * bf_lo(a.y); o[3] += c * bf_hi(a.y);
    o[4] += c * bf_lo(a.z); o[5] += c * bf_hi(a.z); o[6] += c * bf_lo(a.w); o[7] += c * bf_hi(a.w);
    o[8] += c * bf_lo(b.x); o[9] += c * bf_hi(b.x); o[10] += c * bf_lo(b.y); o[11] += c * bf_hi(b.y);
    o[12] += c * bf_lo(b.z); o[13] += c * bf_hi(b.z); o[14] += c * bf_lo(b.w); o[15] += c * bf_hi(b.w);
}
__device__ __forceinline__ void peer_v8(const RowBuf& rb, float (&outv)[4][16], const LAS unsigned* ent, const LAS float* cf, int b) {
#pragma unroll
    for (int i = 0; i < 8; ++i) {
        const int slot = (__builtin_amdgcn_readfirstlane((int)ent[b * 8 + i]) >> 21) & 3;
        const float c = cf[b * 8 + i];
        if (slot == 0) peer_acc(outv[0], c, rb.a[i], rb.b[i]);
        else if (slot == 1) peer_acc(outv[1], c, rb.a[i], rb.b[i]);
        else if (slot == 2) peer_acc(outv[2], c, rb.a[i], rb.b[i]);
        else peer_acc(outv[3], c, rb.a[i], rb.b[i]);
    }
}
__device__ __forceinline__ void p_peer_expert3(const Frame& F, unsigned char* ws, float* xres, const float oscale, const XcdBarrier& xbar) {
    const bf16_t* XN = (const bf16_t*)(ws + WS_XN); const bf16_t* TU = (const bf16_t*)(ws + WS_TABU); const bf16_t* TV = (const bf16_t*)(ws + WS_TABV);
    const unsigned short* EID = (const unsigned short*)(ws + PE_EID); const float* GATE = (const float*)(ws + PE_GATE);
    const int gw = F.bid * NWAVES + F.wave, NGW = F.G * NWAVES, lane = F.lane;
    LAS unsigned* ent = (LAS unsigned*)(F.lds + F.wave * 4096);
    LAS float* cf = (LAS float*)(F.lds + F.wave * 4096 + 2048);
    const int nrounds = (T + NGW * 4 - 1) / (NGW * 4);
    for (int rnd = 0; rnd < nrounds; ++rnd) {
        const int m4 = (rnd * NGW + gw) * 4;
        if (m4 < T) {
            unsigned xp[4][8];
            {
                int id[4][2]; float gg[4][2];
#pragma unroll
                for (int s = 0; s < 4; ++s) {
                    const size_t m = (size_t)(m4 + s);
                    const u32x4 xa = *(const u32x4*)(XN + m * 1024 + lane * 8), xb = *(const u32x4*)(XN + m * 1024 + 512 + lane * 8);
                    xp[s][0] = xa.x; xp[s][1] = xa.y; xp[s][2] = xa.z; xp[s][3] = xa.w; xp[s][4] = xb.x; xp[s][5] = xb.y; xp[s][6] = xb.z; xp[s][7] = xb.w;
                    id[s][0] = EID[m * 128 + lane]; id[s][1] = EID[m * 128 + 64 + lane]; gg[s][0] = GATE[m * 128 + lane]; gg[s][1] = GATE[m * 128 + 64 + lane];
                }
                int base = 0;
#pragma unroll 1
                for (int k = 0; k < 32; ++k) {
                    const int r = (rnd & 1) ? 31 - k : k;
#pragma unroll
                    for (int s = 0; s < 4; ++s)
#pragma unroll
                        for (int w = 0; w < 2; ++w) {
                            const bool hit = (id[s][w] >> 9) == r;
                            const u64 m = __ballot(hit);
                            if (hit) { const int pos = base + (int)__builtin_amdgcn_mbcnt_hi((unsigned)(m >> 32), __builtin_amdgcn_mbcnt_lo((unsigned)m, 0u));
                                ent[pos] = ((unsigned)s << 21) | ((unsigned)(w * 64 + lane) << 14) | (unsigned)id[s][w]; cf[pos] = gg[s][w]; }
                            base += __builtin_popcountll(m);
                        }
                }
            }
            LDS_WAIT();
            {
                RowBuf A, B;
                peer_load8(A, TU, ent, 0, lane);
#pragma unroll 1
                for (int b = 0; b < 64; b += 2) {
                    peer_load8(B, TU, ent, b + 1, lane);
                    peer_u8(A, xp, ent, cf, b, lane);
                    if (b + 2 < 64) peer_load8(A, TU, ent, b + 2, lane);
                    peer_u8(B, xp, ent, cf, b + 1, lane);
                }
            }
            LDS_WAIT();
            float outv[4][16];
#pragma unroll
            for (int s = 0; s < 4; ++s)
#pragma unroll
                for (int i = 0; i < 16; ++i) outv[s][i] = 0.f;
            {
                RowBuf A, B;
                peer_load8(A, TV, ent, 0, lane);
#pragma unroll 1
                for (int b = 0; b < 64; b += 2) {
                    peer_load8(B, TV, ent, b + 1, lane);
                    peer_v8(A, outv, ent, cf, b);
                    if (b + 2 < 64) peer_load8(A, TV, ent, b + 2, lane);
                    peer_v8(B, outv, ent, cf, b + 1);
                }
            }
#pragma unroll
            for (int s = 0; s < 4; ++s) {
                f32x4* o = (f32x4*)(xres + (size_t)(m4 + s) * 1024 + lane * 8);
                f32x4 a0 = o[0], a1 = o[1], b0 = o[128], b1 = o[129];
                a0 += (f32x4){outv[s][0], outv[s][1], outv[s][2], outv[s][3]} * oscale; a1 += (f32x4){outv[s][4], outv[s][5], outv[s][6], outv[s][7]} * oscale;
                b0 += (f32x4){outv[s][8], outv[s][9], outv[s][10], outv[s][11]} * oscale; b1 += (f32x4){outv[s][12], outv[s][13], outv[s][14], outv[s][15]} * oscale;
                o[0] = a0; o[1] = a1; o[128] = b0; o[129] = b1;
            }
        }
        if (rnd + 1 < nrounds) xcd_barrier(xbar);
    }
}

constexpr size_t WS_TAB8U = WS_TABU;
constexpr size_t WS_TAB8V = WS_TABU + 16 * MiB;
constexpr size_t WS_TABSU = WS_TABU + 32 * MiB;
constexpr size_t WS_TABSV = WS_TABU + 32 * MiB + 65536;
__device__ __forceinline__ void cvt_table_fp8(const Frame& F, const float* src, unsigned char* dst, float* scales, const int skip) {
    const int nb = F.G > skip ? F.G - skip : F.G, b0 = F.G > skip ? F.bid - skip : F.bid;
    const int gw = b0 * NWAVES + F.wave, NGW = nb * NWAVES, lane = F.lane;
    if (b0 >= 0) for (int r = gw; r < 16384; r += NGW) {
        const f32x4* p = (const f32x4*)(src + (size_t)r * 1024 + lane * 16);
        f32x4 v[4]; float am = 0.f;
#pragma unroll
        for (int j = 0; j < 4; ++j) { v[j] = p[j]; am = fmaxf(am, fmaxf(fmaxf(fabsf(v[j].x), fabsf(v[j].y)), fmaxf(fabsf(v[j].z), fabsf(v[j].w)))); }
#pragma unroll
        for (int o = 1; o < 64; o <<= 1) am = fmaxf(am, __shfl_xor(am, o));
        const float sc = am > 0.f ? am * (1.0f / 448.0f) : 1.0f, inv = 1.0f / sc;
        u32x4 q;
#pragma unroll
        for (int j = 0; j < 4; ++j) { int w = 0; w = __builtin_amdgcn_cvt_pk_fp8_f32(v[j].x * inv, v[j].y * inv, w, false); w = __builtin_amdgcn_cvt_pk_fp8_f32(v[j].z * inv, v[j].w * inv, w, true); q[j] = (unsigned)w; }
        *(u32x4*)(dst + (size_t)r * 1024 + lane * 16) = q;
        if (lane == 0) scales[r] = sc;
    }
}
template <int NR> struct RowBufN { u32x4 a[NR]; };
template <int NR>
__device__ __forceinline__ void peer_loadN(RowBufN<NR>& rb, const unsigned char* TAB, const LAS unsigned* ent, int b, int lane) {
    const int ev = (int)ent[b * NR + (lane & (NR - 1))];
#pragma unroll
    for (int i = 0; i < NR; ++i) {
        const unsigned e = (unsigned)__builtin_amdgcn_readlane(ev, i) & 0x3FFFu;
        rb.a[i] = *(const u32x4*)(TAB + (size_t)e * 1024 + lane * 16);
    }
}
__device__ __forceinline__ float peer_dot8x(const u32x4 xa, const u32x4 xb, const u32x4 q) {
    float s = 0.f;
#pragma unroll
    for (int j = 0; j < 4; ++j) {
        const f32x2 lo = __builtin_amdgcn_cvt_pk_f32_fp8((int)q[j], false), hi = __builtin_amdgcn_cvt_pk_f32_fp8((int)q[j], true);
        const unsigned x0 = (j < 2) ? xa[2 * j] : xb[2 * j - 4], x1 = (j < 2) ? xa[2 * j + 1] : xb[2 * j - 3];
        s += bf_lo(x0) * lo.x; s += bf_hi(x0) * lo.y; s += bf_lo(x1) * hi.x; s += bf_hi(x1) * hi.y;
    }
    return s;
}
template <int NR>
__device__ __forceinline__ void peer_u8x(const RowBufN<NR>& rb, int r0, const LAS unsigned char* xl, const LAS unsigned* ent, LAS float* cf, const LAS float* sul, int e0, int lane) {
    float pr[8];
    const int ev = (int)ent[e0 + (lane & 7)];
#pragma unroll
    for (int i = 0; i < 8; ++i) {
        const int slot = (__builtin_amdgcn_readlane(ev, i) >> 21) & 3;
        const LAS unsigned char* xp = xl + slot * 2048 + lane * 32;
        const u32x4 xa = *(const LAS u32x4*)xp, xb = *(const LAS u32x4*)(xp + 16);
        pr[i] = peer_dot8x(xa, xb, rb.a[r0 + i]);
    }
    float r4[4], r2[2], r1;
    { const bool up = (lane & 32) != 0;
#pragma unroll
      for (int i = 0; i < 4; ++i) { const float keep = up ? pr[i + 4] : pr[i], send = up ? pr[i] : pr[i + 4]; r4[i] = keep + __shfl_xor(send, 32); } }
    { const bool up = (lane & 16) != 0;
#pragma unroll
      for (int i = 0; i < 2; ++i) { const float keep = up ? r4[i + 2] : r4[i], send = up ? r4[i] : r4[i + 2]; r2[i] = keep + __shfl_xor(send, 16); } }
    { const bool up = (lane & 8) != 0; const float keep = up ? r2[1] : r2[0], send = up ? r2[0] : r2[1]; r1 = keep + __shfl_xor(send, 8); }
    r1 += __shfl_xor(r1, 4); r1 += __shfl_xor(r1, 2); r1 += __shfl_xor(r1, 1);
    const float gate = cf[e0 + (lane >> 3)];
    const float coef = gate * gelu_tanh(r1 * sul[e0 + (lane >> 3)]);
    if ((lane & 7) == 0) cf[e0 + (lane >> 3)] = coef;
}
__device__ __forceinline__ void peer_acc8(float (&o)[16], const float c, const u32x4 q) {
#pragma unroll
    for (int j = 0; j < 4; ++j) { const f32x2 lo = __builtin_amdgcn_cvt_pk_f32_fp8((int)q[j], false), hi = __builtin_amdgcn_cvt_pk_f32_fp8((int)q[j], true);
        o[4 * j] += c * lo.x; o[4 * j + 1] += c * lo.y; o[4 * j + 2] += c * hi.x; o[4 * j + 3] += c * hi.y; }
}
template <int NR>
__device__ __forceinline__ void peer_vN(const RowBufN<NR>& rb, float (&outv)[4][16], const LAS unsigned* ent, const LAS float* cf, int b, int lane) {
    const int ev = (int)ent[b * NR + (lane & (NR - 1))]; const float cv = cf[b * NR + (lane & (NR - 1))];
#pragma unroll
    for (int i = 0; i < NR; ++i) {
        const int slot = (__builtin_amdgcn_readlane(ev, i) >> 21) & 3;
        const float c = rdlane_f(cv, i);
        if (slot == 0) peer_acc8(outv[0], c, rb.a[i]);
        else if (slot == 1) peer_acc8(outv[1], c, rb.a[i]);
        else if (slot == 2) peer_acc8(outv[2], c, rb.a[i]);
        else peer_acc8(outv[3], c, rb.a[i]);
    }
}
__device__ __forceinline__ void p_peer_expert4(const Frame& F, unsigned char* ws, float* xres, const float oscale, const XcdBarrier& xbar, const int mode) {
    const bf16_t* XN = (const bf16_t*)(ws + WS_XN); const unsigned char* TU = ws + WS_TAB8U; const unsigned char* TV = ws + WS_TAB8V;
    const float* SU = (const float*)(ws + WS_TABSU); const float* SV = (const float*)(ws + WS_TABSV);
    const unsigned short* EID = (const unsigned short*)(ws + PE_EID); const float* GATE = (const float*)(ws + PE_GATE);
    const int gw = F.bid * NWAVES + F.wave, NGW = F.G * NWAVES, lane = F.lane;
    LAS unsigned* ent = (LAS unsigned*)(F.lds + F.wave * 6144);
    LAS float* cf = (LAS float*)(F.lds + F.wave * 6144 + 2048);
    LAS float* sul = (LAS float*)(F.lds + F.wave * 6144 + 4096);
    LAS unsigned char* xl = F.lds + 49152 + F.wave * 8192;
    constexpr int PU = 16, PV = 8;
    const int nrounds = (T + NGW * 4 - 1) / (NGW * 4);
    for (int rnd = 0; rnd < nrounds; ++rnd) {
        const int m4 = (rnd * NGW + gw) * 4;
        if (m4 < T) {
            {
                int id[4][2]; float gg[4][2], su[4][2];
#pragma unroll
                for (int s = 0; s < 4; ++s) { const size_t m = (size_t)(m4 + s);
                    id[s][0] = EID[m * 128 + lane]; id[s][1] = EID[m * 128 + 64 + lane]; gg[s][0] = GATE[m * 128 + lane] * SV[id[s][0]]; gg[s][1] = GATE[m * 128 + 64 + lane] * SV[id[s][1]]; su[s][0] = SU[id[s][0]]; su[s][1] = SU[id[s][1]]; }
                int base = 0;
#pragma unroll 1
                for (int k = 0; k < 16; ++k) {
                    const int r = (rnd & 1) ? 15 - k : k;
#pragma unroll
                    for (int s = 0; s < 4; ++s)
#pragma unroll
                        for (int w = 0; w < 2; ++w) {
                            const bool hit = (id[s][w] >> 10) == r;
                            const u64 m = __ballot(hit);
                            if (hit) { const int pos = base + (int)__builtin_amdgcn_mbcnt_hi((unsigned)(m >> 32), __builtin_amdgcn_mbcnt_lo((unsigned)m, 0u));
                                ent[pos] = ((unsigned)s << 21) | ((unsigned)(w * 64 + lane) << 14) | (unsigned)(mode == 4 ? (id[s][w] & 7) : id[s][w]); cf[pos] = gg[s][w]; sul[pos] = su[s][w]; }
                            base += __builtin_popcountll(m);
                        }
                }
            }
            LDS_WAIT();
            if (mode != 1 && mode != 3) {
#pragma unroll
                for (int s = 0; s < 4; ++s) { const size_t m = (size_t)(m4 + s);
                    const u32x4 xa = *(const u32x4*)(XN + m * 1024 + lane * 16), xb = *(const u32x4*)(XN + m * 1024 + lane * 16 + 8);
                    *(LAS u32x4*)(xl + s * 2048 + lane * 32) = xa; *(LAS u32x4*)(xl + s * 2048 + lane * 32 + 16) = xb; }
                LDS_WAIT();
                RowBufN<PU> A, B;
                peer_loadN<PU>(A, TU, ent, 0, lane);
#pragma unroll 1
                for (int b = 0; b < 512 / PU; b += 2) {
                    peer_loadN<PU>(B, TU, ent, b + 1, lane);
#pragma unroll
                    for (int h = 0; h < PU / 8; ++h) peer_u8x<PU>(A, h * 8, xl, ent, cf, sul, b * PU + h * 8, lane);
                    if (b + 2 < 512 / PU) peer_loadN<PU>(A, TU, ent, b + 2, lane);
#pragma unroll
                    for (int h = 0; h < PU / 8; ++h) peer_u8x<PU>(B, h * 8, xl, ent, cf, sul, (b + 1) * PU + h * 8, lane);
                }
            }
            LDS_WAIT();
            float outv[4][16];
#pragma unroll
            for (int s = 0; s < 4; ++s)
#pragma unroll
                for (int i = 0; i < 16; ++i) outv[s][i] = 0.f;
            if (mode != 1 && mode != 2) {
                RowBufN<PV> A, B;
                peer_loadN<PV>(A, TV, ent, 0, lane);
#pragma unroll 1
                for (int b = 0; b < 512 / PV; b += 2) {
                    peer_loadN<PV>(B, TV, ent, b + 1, lane);
                    peer_vN<PV>(A, outv, ent, cf, b, lane);
                    if (b + 2 < 512 / PV) peer_loadN<PV>(A, TV, ent, b + 2, lane);
                    peer_vN<PV>(B, outv, ent, cf, b + 1, lane);
                }
            }
#pragma unroll
            for (int s = 0; s < 4; ++s) {
                f32x4* o = (f32x4*)(xres + (size_t)(m4 + s) * 1024 + lane * 16);
#pragma unroll
                for (int j = 0; j < 4; ++j) { f32x4 a0 = o[j]; a0 += (f32x4){outv[s][4 * j], outv[s][4 * j + 1], outv[s][4 * j + 2], outv[s][4 * j + 3]} * oscale; o[j] = a0; }
            }
        }
        if (rnd + 1 < nrounds) xcd_barrier(xbar);
    }
}

__device__ __forceinline__ void cvt_table_i8(const Frame& F, const float* src, unsigned char* dst, float* scales, const int skip) {
    const int nb = F.G > skip ? F.G - skip : F.G, b0 = F.G > skip ? F.bid - skip : F.bid;
    const int gw = b0 * NWAVES + F.wave, NGW = nb * NWAVES, lane = F.lane;
    if (b0 >= 0) for (int r = gw; r < 16384; r += NGW) {
        const f32x4* p = (const f32x4*)(src + (size_t)r * 1024 + lane * 16);
        f32x4 v[4]; float am = 0.f;
#pragma unroll
        for (int j = 0; j < 4; ++j) { v[j] = p[j]; am = fmaxf(am, fmaxf(fmaxf(fabsf(v[j].x), fabsf(v[j].y)), fmaxf(fabsf(v[j].z), fabsf(v[j].w)))); }
#pragma unroll
        for (int o = 1; o < 64; o <<= 1) am = fmaxf(am, __shfl_xor(am, o));
        const float sc = am > 0.f ? am * (1.0f / 127.0f) : 1.0f, inv = 1.0f / sc;
        u32x4 q;
#pragma unroll
        for (int j = 0; j < 4; ++j) { const int a = (int)rintf(v[j].x * inv), b = (int)rintf(v[j].y * inv), c = (int)rintf(v[j].z * inv), d = (int)rintf(v[j].w * inv);
            q[j] = (unsigned)(a & 255) | ((unsigned)(b & 255) << 8) | ((unsigned)(c & 255) << 16) | ((unsigned)(d & 255) << 24); }
        *(u32x4*)(dst + (size_t)r * 1024 + lane * 16) = q;
        if (lane == 0) scales[r] = sc;
    }
}
template <int NR>
__device__ __forceinline__ void peer_u8i(const RowBufN<NR>& rb, int r0, const LAS unsigned char* xq, const LAS unsigned* ent, LAS float* cf, const LAS float* sul, int e0, int lane) {
    int pr[8];
    const int ev = (int)ent[e0 + (lane & 7)];
#pragma unroll
    for (int i = 0; i < 8; ++i) {
        const int slot = (__builtin_amdgcn_readlane(ev, i) >> 21) & 3;
        const u32x4 xv = *(const LAS u32x4*)(xq + slot * 1024 + lane * 16);
        const u32x4 q = rb.a[r0 + i];
        int s = __builtin_amdgcn_sdot4((int)xv.x, (int)q.x, 0, false); s = __builtin_amdgcn_sdot4((int)xv.y, (int)q.y, s, false);
        s = __builtin_amdgcn_sdot4((int)xv.z, (int)q.z, s, false); s = __builtin_amdgcn_sdot4((int)xv.w, (int)q.w, s, false);
        pr[i] = s;
    }
    int r4[4], r2[2], r1;
#pragma unroll
    for (int i = 0; i < 4; ++i) { const u32x2p sw = __builtin_amdgcn_permlane32_swap((unsigned)pr[i], (unsigned)pr[i + 4], false, false); r4[i] = (int)sw.x + (int)sw.y; }
#pragma unroll
    for (int i = 0; i < 2; ++i) { const u32x2p sw = __builtin_amdgcn_permlane16_swap((unsigned)r4[i], (unsigned)r4[i + 2], false, false); r2[i] = (int)sw.x + (int)sw.y; }
    { const bool up = (lane & 8) != 0; const int keep = up ? r2[1] : r2[0], send = up ? r2[0] : r2[1]; r1 = keep + __builtin_amdgcn_update_dpp(0, send, DPP_ROR8, 0xF, 0xF, true); }
    r1 += __builtin_amdgcn_update_dpp(0, r1, DPP_QX1, 0xF, 0xF, true); r1 += __builtin_amdgcn_update_dpp(0, r1, DPP_QX2, 0xF, 0xF, true); r1 += __builtin_amdgcn_update_dpp(0, r1, DPP_HMIR, 0xF, 0xF, true);
    const float gate = cf[e0 + (lane >> 3)];
    const float coef = gate * gelu_tanh((float)r1 * sul[e0 + (lane >> 3)]);
    if ((lane & 7) == 0) cf[e0 + (lane >> 3)] = coef;
}
template <bool FAKE>
__device__ __forceinline__ f32x2 cvt8(unsigned w, bool hi) {
    if (FAKE) { const unsigned t = hi ? (w >> 16) : w; return (f32x2){__builtin_bit_cast(float, (t << 23) | 0x30000000u), __builtin_bit_cast(float, ((t >> 8) << 23) | 0x30000000u)}; }
    return hi ? __builtin_amdgcn_cvt_pk_f32_fp8((int)w, true) : __builtin_amdgcn_cvt_pk_f32_fp8((int)w, false);
}
template <bool FAKE = false>
__device__ __forceinline__ void peer_acc8p(f32x2 (&o)[8], const float c, const u32x4 q) {
    const f32x2 c2 = {c, c};
#pragma unroll
    for (int j = 0; j < 4; ++j) { const f32x2 lo = cvt8<FAKE>(q[j], false), hi = cvt8<FAKE>(q[j], true);
        o[2 * j] += c2 * lo; o[2 * j + 1] += c2 * hi; }
}
template <int NR, bool FAKE>
__device__ __forceinline__ void peer_vNp(const RowBufN<NR>& rb, f32x2 (&outv)[4][8], const LAS unsigned* ent, const LAS float* cf, int b, int lane) {
    const int ev = (int)ent[b * NR + (lane & (NR - 1))]; const float cv = cf[b * NR + (lane & (NR - 1))];
    int slot[NR]; float c[NR];
#pragma unroll
    for (int i = 0; i < NR; ++i) { slot[i] = (__builtin_amdgcn_readlane(ev, i) >> 21) & 3; c[i] = rdlane_f(cv, i); }
#pragma unroll
    for (int q4 = 0; q4 < NR / 4; ++q4) {
#pragma unroll
        for (int s = 0; s < 4; ++s) {
#pragma unroll
            for (int i = 4 * q4; i < 4 * q4 + 4; ++i) if (slot[i] == s) peer_acc8p<FAKE>(outv[s], c[i], rb.a[i]);
            __builtin_amdgcn_sched_barrier(0);
        }
    }
}
template <int PV, bool FAKE>
__device__ __forceinline__ void peer_passv(f32x2 (&outv)[4][8], const unsigned char* TV, const LAS unsigned* ent, const LAS float* cf, int lane) {
    RowBufN<PV> A, B, C;
    constexpr int NBV = 512 / PV;
    peer_loadN<PV>(A, TV, ent, 0, lane); peer_loadN<PV>(B, TV, ent, 1, lane);
#pragma unroll 1
    for (int b = 0; b + 2 < NBV; b += 3) {
        peer_loadN<PV>(C, TV, ent, b + 2, lane);
        peer_vNp<PV, FAKE>(A, outv, ent, cf, b, lane);
        if (b + 3 < NBV) peer_loadN<PV>(A, TV, ent, b + 3, lane);
        peer_vNp<PV, FAKE>(B, outv, ent, cf, b + 1, lane);
        if (b + 4 < NBV) peer_loadN<PV>(B, TV, ent, b + 4, lane);
        peer_vNp<PV, FAKE>(C, outv, ent, cf, b + 2, lane);
    }
    peer_vNp<PV, FAKE>(A, outv, ent, cf, NBV - 1, lane);
}
__device__ __forceinline__ void p_peer_expert5(const Frame& F, unsigned char* ws, float* xres, const float oscale, const XcdBarrier& xbar, const int mode, const bool do_norm, const size_t xn_off) {
    const bf16_t* XN = (const bf16_t*)(ws + xn_off); const unsigned char* TU = ws + WS_TAB8U; const unsigned char* TV = ws + WS_TAB8V;
    const float* SU = (const float*)(ws + WS_TABSU); const float* SV = (const float*)(ws + WS_TABSV);
    const unsigned short* EID = (const unsigned short*)(ws + PE_EID); const float* GATE = (const float*)(ws + PE_GATE); const float* SSQ = (const float*)(ws + PE_SSQ);
    const int gw = F.bid * NWAVES + F.wave, NGW = F.G * NWAVES, lane = F.lane;
    LAS unsigned* ent = (LAS unsigned*)(F.lds + F.wave * 6144);
    LAS float* cf = (LAS float*)(F.lds + F.wave * 6144 + 2048);
    LAS float* sul = (LAS float*)(F.lds + F.wave * 6144 + 4096);
    LAS unsigned char* xq = F.lds + 49152 + F.wave * 4096;
    constexpr int PU = 8, PV = 8;
    const int nrounds = (T + NGW * 4 - 1) / (NGW * 4);
    for (int rnd = 0; rnd < nrounds; ++rnd) {
        const int m4 = (rnd * NGW + gw) * 4;
        if (m4 < T) {
            {
                float sx[4];
#pragma unroll
                for (int s = 0; s < 4; ++s) { const size_t m = (size_t)(m4 + s);
                    const u32x4 xa = *(const u32x4*)(XN + m * 1024 + lane * 16), xb = *(const u32x4*)(XN + m * 1024 + lane * 16 + 8);
                    float xf[16] = {bf_lo(xa.x), bf_hi(xa.x), bf_lo(xa.y), bf_hi(xa.y), bf_lo(xa.z), bf_hi(xa.z), bf_lo(xa.w), bf_hi(xa.w),
                                    bf_lo(xb.x), bf_hi(xb.x), bf_lo(xb.y), bf_hi(xb.y), bf_lo(xb.z), bf_hi(xb.z), bf_lo(xb.w), bf_hi(xb.w)};
                    float am = 0.f;
#pragma unroll
                    for (int i = 0; i < 16; ++i) am = fmaxf(am, fabsf(xf[i]));
#pragma unroll
                    for (int o = 1; o < 64; o <<= 1) am = fmaxf(am, __shfl_xor(am, o));
                    sx[s] = am > 0.f ? am * (1.0f / 127.0f) : 1.0f; const float inv = 1.0f / sx[s];
                    { const float pq = (lane < 16) ? SSQ[m * 16 + lane] : 0.f; sx[s] *= 1.0f / sqrtf(wave_sum(pq) * (1.0f / 1024.0f) + 1e-6f); }
                    u32x4 q;
#pragma unroll
                    for (int j = 0; j < 4; ++j) { const int a = (int)rintf(xf[4 * j] * inv), b = (int)rintf(xf[4 * j + 1] * inv), c = (int)rintf(xf[4 * j + 2] * inv), d = (int)rintf(xf[4 * j + 3] * inv);
                        q[j] = (unsigned)(a & 255) | ((unsigned)(b & 255) << 8) | ((unsigned)(c & 255) << 16) | ((unsigned)(d & 255) << 24); }
                    *(LAS u32x4*)(xq + s * 1024 + lane * 16) = q; }
                int id[4][2]; float gg[4][2], su[4][2];
#pragma unroll
                for (int s = 0; s < 4; ++s) { const size_t m = (size_t)(m4 + s);
                    id[s][0] = EID[m * 128 + lane]; id[s][1] = EID[m * 128 + 64 + lane];
                    gg[s][0] = GATE[m * 128 + lane] * SV[id[s][0]]; gg[s][1] = GATE[m * 128 + 64 + lane] * SV[id[s][1]];
                    su[s][0] = SU[id[s][0]] * sx[s]; su[s][1] = SU[id[s][1]] * sx[s]; }
                LAS unsigned* hcnt = (LAS unsigned*)sul;
                if (lane < 32) hcnt[lane] = 0u;
                LDS_WAIT();
#pragma unroll
                for (int s = 0; s < 4; ++s)
#pragma unroll
                    for (int w = 0; w < 2; ++w) __hip_atomic_fetch_add(hcnt + (id[s][w] >> 10), 1u, __ATOMIC_RELAXED, __HIP_MEMORY_SCOPE_WORKGROUP);
                LDS_WAIT();
                unsigned basev;
                { const unsigned cntv = (lane < 16) ? hcnt[lane] : 0u;
                  unsigned incl = cntv;
                  const bool rev = (rnd & 1) != 0;
#pragma unroll
                  for (int o = 1; o < 16; o <<= 1) { const unsigned up = (unsigned)__shfl_up((int)incl, o), dn = (unsigned)__shfl_down((int)incl, o);
                      const unsigned nb = rev ? ((lane + o < 16) ? dn : 0u) : ((lane >= o) ? up : 0u); incl += nb; }
                  basev = incl - cntv; }
                LDS_WAIT();
                if (lane < 16) hcnt[16 + lane] = basev;
                LDS_WAIT();
                int posv[4][2];
#pragma unroll
                for (int s = 0; s < 4; ++s)
#pragma unroll
                    for (int w = 0; w < 2; ++w) posv[s][w] = (int)__hip_atomic_fetch_add(hcnt + 16 + (id[s][w] >> 10), 1u, __ATOMIC_RELAXED, __HIP_MEMORY_SCOPE_WORKGROUP);
                LDS_WAIT();
#pragma unroll
                for (int s = 0; s < 4; ++s)
#pragma unroll
                    for (int w = 0; w < 2; ++w) { const int pos = posv[s][w];
                        ent[pos] = ((unsigned)s << 21) | ((unsigned)(w * 64 + lane) << 14) | (unsigned)(mode == 4 ? (id[s][w] & 7) : id[s][w]); cf[pos] = gg[s][w]; }
                LDS_WAIT();
#pragma unroll
                for (int s = 0; s < 4; ++s)
#pragma unroll
                    for (int w = 0; w < 2; ++w) sul[posv[s][w]] = su[s][w];
            }
            LDS_WAIT();
            if (mode != 1 && mode != 3) {
                RowBufN<PU> A, B, C;
                constexpr int NBU = 512 / PU;
                peer_loadN<PU>(A, TU, ent, 0, lane); peer_loadN<PU>(B, TU, ent, 1, lane);
#pragma unroll 1
                for (int b = 0; b + 2 < NBU; b += 3) {
                    peer_loadN<PU>(C, TU, ent, b + 2, lane);
                    peer_u8i<PU>(A, 0, xq, ent, cf, sul, b * PU, lane);
                    if (b + 3 < NBU) peer_loadN<PU>(A, TU, ent, b + 3, lane);
                    peer_u8i<PU>(B, 0, xq, ent, cf, sul, (b + 1) * PU, lane);
                    if (b + 4 < NBU) peer_loadN<PU>(B, TU, ent, b + 4, lane);
                    peer_u8i<PU>(C, 0, xq, ent, cf, sul, (b + 2) * PU, lane);
                }
                peer_u8i<PU>(A, 0, xq, ent, cf, sul, (NBU - 1) * PU, lane);
            }
            LDS_WAIT();
            f32x2 outv[4][8];
#pragma unroll
            for (int s = 0; s < 4; ++s)
#pragma unroll
                for (int i = 0; i < 8; ++i) outv[s][i] = (f32x2){0.f, 0.f};
            if (mode != 1 && mode != 2) {
                if (mode == 5) peer_passv<PV, true>(outv, TV, ent, cf, lane); else peer_passv<PV, false>(outv, TV, ent, cf, lane);
            }
            asm volatile("" ::: "memory"); __builtin_amdgcn_sched_barrier(0);
#pragma unroll
            for (int s = 0; s < 4; ++s) {
                f32x4* o = (f32x4*)(xres + (size_t)(m4 + s) * 1024 + lane * 16);
                f32x4 nv[4]; float ss = 0.f;
#pragma unroll
                for (int j = 0; j < 4; ++j) { f32x4 a0 = o[j]; const f32x4 add = (f32x4){outv[s][2 * j].x, outv[s][2 * j].y, outv[s][2 * j + 1].x, outv[s][2 * j + 1].y};
                    if (oscale != 0.f) a0 += add; else asm volatile("" :: "v"(add)); o[j] = a0; nv[j] = a0;
                    ss += (a0.x * a0.x + a0.y * a0.y) + (a0.z * a0.z + a0.w * a0.w); }
                if (do_norm && oscale != 0.f) {
                    const float rstd = 1.0f / sqrtf(wave_sum(ss) * (1.f / DM) + 1e-6f);
                    const f32x4* gp = (const f32x4*)((const float*)(ws + WS_CMPB + 4096) + lane * 16);
                    u32x4 w0, w1;
                    { const f32x4 g0 = gp[0], g1 = gp[1], g2 = gp[2], g3 = gp[3];
                      w0.x = pk2(nv[0].x * rstd * g0.x, nv[0].y * rstd * g0.y); w0.y = pk2(nv[0].z * rstd * g0.z, nv[0].w * rstd * g0.w);
                      w0.z = pk2(nv[1].x * rstd * g1.x, nv[1].y * rstd * g1.y); w0.w = pk2(nv[1].z * rstd * g1.z, nv[1].w * rstd * g1.w);
                      w1.x = pk2(nv[2].x * rstd * g2.x, nv[2].y * rstd * g2.y); w1.y = pk2(nv[2].z * rstd * g2.z, nv[2].w * rstd * g2.w);
                      w1.z = pk2(nv[3].x * rstd * g3.x, nv[3].y * rstd * g3.y); w1.w = pk2(nv[3].z * rstd * g3.z, nv[3].w * rstd * g3.w); }
                    u32x4* xo = (u32x4*)((bf16_t*)(ws + WS_XN) + (size_t)(m4 + s) * 1024 + lane * 16);
                    xo[0] = w0; xo[1] = w1;
                }
                asm volatile("" ::: "memory"); __builtin_amdgcn_sched_barrier(0);
            }
        }
    }
}

constexpr size_t L1_QN = WS_R3;
constexpr size_t L1_KS = WS_R3 + 32 * MiB;
constexpr size_t L1_KW = WS_R3 + 40 * MiB;
constexpr size_t L1_VST = WS_R3 + 48 * MiB;
constexpr size_t L1_VWT = WS_R3 + 56 * MiB;
constexpr size_t L1_KCR = WS_R3 + 64 * MiB;
constexpr size_t L1_VCR = WS_R3 + 72 * MiB;
constexpr size_t L1_GATES = WS_R3 + 81 * MiB;
constexpr size_t L1_H1 = WS_R3 + 84 * MiB;
constexpr size_t L1_CMPO = WS_R3 + 88 * MiB;
constexpr size_t L1_KC = WS_R3 + 90 * MiB;
constexpr size_t L1_VCT = WS_R3 + 91 * MiB;
constexpr size_t L1_SELB = WS_R3 + 92 * MiB;
constexpr size_t L1_OC = WS_TABU;
constexpr size_t L1_CAT = WS_XN;
constexpr size_t L1_UPD = WS_R3;
constexpr size_t L1_DECAY = WS_R3 + 128 * MiB;

__device__ __forceinline__ void p_l1_prep(const Frame& F, const Args& a, unsigned char* ws) {
    const bf16_t* P = (const bf16_t*)(ws + WS_PROJ);
    const f32x2* rope = (const f32x2*)(ws + WS_ROPE);
    bf16_t* QN = (bf16_t*)(ws + L1_QN); bf16_t* KS = (bf16_t*)(ws + L1_KS); bf16_t* KW = (bf16_t*)(ws + L1_KW);
    bf16_t* KCR = (bf16_t*)(ws + L1_KCR); bf16_t* VCR = (bf16_t*)(ws + L1_VCR); float* GATES = (float*)(ws + L1_GATES);
    const int gw = F.bid * NWAVES + F.wave, NGW = F.G * NWAVES, lane = F.lane, hs = lane >> 3, sub = lane & 7;
    float qg[8], kg[8];
#pragma unroll
    for (int j = 0; j < 8; ++j) { qg[j] = a.in[I_L1_QG][sub * 8 + j]; kg[j] = a.in[I_L1_KG][sub * 8 + j]; }
    const int srccol = (hs < 2) ? C1_KS + hs * 64 : (hs < 4) ? C1_KW + (hs - 2) * 64 : (hs < 6) ? C1_KC + (hs - 4) * 64 : C1_VC + (hs - 6) * 64;
    bf16_t* dstbuf = (hs < 2) ? KS : (hs < 4) ? KW : (hs < 6) ? KCR : VCR;
    const int g2 = hs & 1;
    for (int m = gw; m < T; m += NGW) {
        const int b = m >> 12, t = m & 4095;
        const bf16_t* row = P + (size_t)m * N_IN1;
        f32x2 cs[8];
#pragma unroll
        for (int j = 0; j < 4; ++j) { const f32x4 c4 = *(const f32x4*)(rope + t * 32 + (sub & 3) * 8 + 2 * j); cs[2 * j] = (f32x2){c4.x, c4.y}; cs[2 * j + 1] = (f32x2){c4.z, c4.w}; }
        float v[8];
        head8_load(row + C1_Q + lane * 8, v); head8_norm(v, qg); head8_rope(v, cs, sub >= 4); head8_store(QN + (size_t)m * 512 + lane * 8, v, 0.125f);
        {
            const u32x4 raw = *(const u32x4*)(row + srccol + sub * 8);
            v[0] = bf_lo(raw.x); v[1] = bf_hi(raw.x); v[2] = bf_lo(raw.y); v[3] = bf_hi(raw.y); v[4] = bf_lo(raw.z); v[5] = bf_hi(raw.z); v[6] = bf_lo(raw.w); v[7] = bf_hi(raw.w);
            head8_norm(v, kg); head8_rope(v, cs, sub >= 4);
            u32x4 q; q.x = pk2(v[0], v[1]); q.y = pk2(v[2], v[3]); q.z = pk2(v[4], v[5]); q.w = pk2(v[6], v[7]);
            if (hs >= 4) q = raw;
            *(u32x4*)(dstbuf + ((size_t)(b * 2 + g2) * 4096 + t) * 64 + sub * 8) = q;
        }
        if (lane < 24) GATES[(size_t)m * 24 + lane] = sigmoidf_(bf2f(row[C1_GL + lane]));
    }
    for (int it = gw; it < 2 * NB * 2 * 64; it += NGW) {
        const int tb = it & 63, g = (it >> 6) & 1, b = (it >> 7) & 7, w = it >> 10;
        const size_t m = (size_t)b * 4096 + tb * 64 + lane;
        unsigned r[32];
#pragma unroll
        for (int j = 0; j < 8; ++j) { const u32x4 q = *(const u32x4*)(P + m * N_IN1 + (w ? C1_VW : C1_VS) + g * 64 + j * 8); r[4 * j] = q.x; r[4 * j + 1] = q.y; r[4 * j + 2] = q.z; r[4 * j + 3] = q.w; }
        bf16_t* dst = (bf16_t*)(ws + (w ? L1_VWT : L1_VST)) + ((size_t)(b * 2 + g) * 64) * 4096 + tb * 64 + lane;
#pragma unroll
        for (int d = 0; d < 64; ++d) dst[(size_t)d * 4096] = (bf16_t)((d & 1) ? (r[d >> 1] >> 16) : (r[d >> 1] & 0xffffu));
    }
}

namespace pg8 {
struct EpiCmp1 {
    static constexpr bool PERM = true;
    bf16_t* O; const float* bias;
    __device__ __forceinline__ void operator()(const f32x4 (&acc)[2][2][4][2], const Unit& u, int wr, int wc, int fr, int fq) const {
        const int row0 = u.pm * BM + wr * 64 + fr, col0 = wc * 32 + 8 * fq;
#pragma unroll
        for (int ai = 0; ai < 2; ++ai)
#pragma unroll
            for (int m = 0; m < 4; ++m) { bf16_t* rowp = O + (size_t)(row0 + ai * HALF + m * 16) * 256 + col0;
#pragma unroll
                for (int bj = 0; bj < 2; ++bj) { const float* bp = bias + u.pn * 256 + col0 + bj * HALF;
                    const f32x4 v0 = acc[ai][bj][m][0] + *(const f32x4*)bp, v1 = acc[ai][bj][m][1] + *(const f32x4*)(bp + 4);
                    u32x4 w; w.x = pk2(gelu_tanh(v0[0]), gelu_tanh(v0[1])); w.y = pk2(gelu_tanh(v0[2]), gelu_tanh(v0[3]));
                    w.z = pk2(gelu_tanh(v1[0]), gelu_tanh(v1[1])); w.w = pk2(gelu_tanh(v1[2]), gelu_tanh(v1[3]));
                    *(u32x4*)(rowp + bj * HALF) = w; }
                asm volatile("" ::: "memory"); __builtin_amdgcn_sched_barrier(0); }
    }
};
struct EpiCmp2 {
    static constexpr bool PERM = false;
    float* C;
    __device__ __forceinline__ void operator()(const f32x4 (&acc)[2][2][4][2], const Unit& u, int wr, int wc, int fr, int fq) const {
        if (wc >= 2) return;
        const int row0 = u.pm * BM + wr * 64 + fr, col0 = wc * 32 + 4 * fq;
#pragma unroll
        for (int ai = 0; ai < 2; ++ai)
#pragma unroll
            for (int m = 0; m < 4; ++m)
#pragma unroll
                for (int n = 0; n < 2; ++n) *(f32x4*)(C + (size_t)(row0 + ai * HALF + m * 16) * 64 + col0 + n * 16) = acc[ai][0][m][n];
    }
};
}

__device__ __forceinline__ void p_cmp_final(const Frame& F, const Args& a, unsigned char* ws) {
    const float* CMPO = (const float*)(ws + L1_CMPO); const f32x2* rope = (const f32x2*)(ws + WS_ROPE);
    bf16_t* KC = (bf16_t*)(ws + L1_KC); bf16_t* VCT = (bf16_t*)(ws + L1_VCT);
    const int gw = F.bid * NWAVES + F.wave, NGW = F.G * NWAVES, lane = F.lane;
    const float kg = a.in[I_L1_KG][lane];
    for (int r = gw; r < 8192; r += NGW) {
        float v = CMPO[(size_t)r * 64 + lane];
        const int rr = r & 4095, bg = rr >> 8, c = rr & 255;
        if (r < 4096) {
            const float ss = wave_sum(v * v);
            v = v * (1.0f / sqrtf(ss * (1.f / 64.f) + 1e-6f)) * kg;
            const int pos = (c < 255) ? 16 * c + 31 : 0;
            v = rope_apply(v, rope[pos * 32 + (lane & 31)], lane);
            KC[((size_t)bg * 256 + c) * 64 + lane] = (c < 255) ? (bf16_t)f2bf(v) : (bf16_t)0;
        } else {
            VCT[((size_t)bg * 64 + lane) * 256 + c] = (c < 255) ? (bf16_t)f2bf(v) : (bf16_t)0;
        }
    }
}

__device__ __forceinline__ void att_load2(AttStage& s, const bf16_t* Kg, const bf16_t* Vtg, int vstride, int key0, int tid) {
    s.kreg = *(const u32x4*)(Kg + (size_t)(key0 + (tid >> 3)) * 64 + (tid & 7) * 8);
    s.vreg = *(const u32x4*)(Vtg + (size_t)(tid >> 3) * vstride + key0 + (tid & 7) * 8);
}
__device__ __forceinline__ float score_bound_c2(const float* qg, const float* kg) {
    float mq = 0.f, mk_ = 0.f;
    for (int i = 0; i < 64; ++i) { mq = fmaxf(mq, fabsf(qg[i])); mk_ = fmaxf(mk_, fabsf(kg[i])); }
    return (8.0f * mq * mk_ + 0.5f) * 1.4426950408889634f;
}

constexpr int CA_KB = 256 * 144, CA_VSTR = 528, CA_VB = 64 * CA_VSTR, CA_IMP = CA_KB + CA_VB;
__device__ __forceinline__ void p_cmp_attn(const Frame& F, const Args& a, unsigned char* ws) {
    const bf16_t* QN = (const bf16_t*)(ws + L1_QN); const bf16_t* KC = (const bf16_t*)(ws + L1_KC); const bf16_t* VCT = (const bf16_t*)(ws + L1_VCT);
    float* OC = (float*)(ws + L1_OC); u64* SELB = (u64*)(ws + L1_SELB);
    LAS float* impL = (LAS float*)(F.lds + CA_IMP);
    const int lane = F.lane, wave = F.wave, h = lane >> 5, c = lane & 31, tid = F.tid;
    const float c2 = score_bound_c2(a.in[I_L1_QG], a.in[I_L1_KG]), c1 = 1.4426950408889634f;
    for (int u = F.bid; u < 1024; u += F.G) {
        const int b = (u >> 7) & 7, g = (u >> 6) & 1, rnd = u >> 8, qt = (rnd & 1) ? 63 - (u & 63) : (u & 63), q0 = qt * 64;
        const int bg = b * 2 + g; const size_t mb = (size_t)b * 4096;
        const int t = q0 + wave * 8 + (c >> 2), head = g * 4 + (c & 3);
        bf16x8 Qf[4];
#pragma unroll
        for (int ks = 0; ks < 4; ++ks) Qf[ks] = *(const bf16x8*)(QN + (mb + t) * 512 + head * 64 + ks * 16 + 8 * h);
        const int L = (t >= 31) ? (((t - 31) >> 4) < 254 ? ((t - 31) >> 4) : 254) : -1;
        const int tmax = q0 + 63; const int Lmax = (tmax >= 31) ? (((tmax - 31) >> 4) < 254 ? ((tmax - 31) >> 4) : 254) : -1;
        const int nkt = (Lmax >= 0) ? (Lmax >> 6) + 1 : 0;
        const bf16_t* Kg = KC + (size_t)bg * 256 * 64; const bf16_t* Vtg = VCT + (size_t)bg * 64 * 256;
        __syncthreads();
        for (int i = tid; i < nkt * 512; i += NTHREADS) {
            const int key = i >> 3, ch = i & 7;
            *(LAS u32x4*)(F.lds + key * 144 + ch * 16) = *(const u32x4*)(Kg + (size_t)key * 64 + ch * 8);
        }
        for (int i = tid; i < 64 * nkt * 8; i += NTHREADS) {
            const int d = i / (nkt * 8), ch = i % (nkt * 8);
            const u32x4 v = *(const u32x4*)(Vtg + (size_t)d * 256 + ch * 8);
            LAS unsigned char* p = F.lds + CA_KB + d * CA_VSTR + ch * 16;
            *(LAS u32x2*)p = (u32x2){v.x, v.y}; *(LAS u32x2*)(p + 8) = (u32x2){v.z, v.w};
        }
        __syncthreads();
        f32x16 O[2], IMP[2]; float l = 0.f;
#pragma unroll
        for (int i = 0; i < 16; ++i) { O[0][i] = 0.f; O[1][i] = 0.f; IMP[0][i] = 0.f; IMP[1][i] = 0.f; }
        for (int st = 0; st < nkt * 2; ++st) {
            f32x16 S = {0.f, 0.f, 0.f, 0.f, 0.f, 0.f, 0.f, 0.f, 0.f, 0.f, 0.f, 0.f, 0.f, 0.f, 0.f, 0.f};
            { const LAS unsigned char* kp = F.lds + (st * 32 + c) * 144 + h * 16;
#pragma unroll
              for (int ks = 0; ks < 4; ++ks) S = __builtin_amdgcn_mfma_f32_32x32x16_bf16(*(const LAS bf16x8*)(kp + ks * 32), Qf[ks], S, 0, 0, 0); }
            float p[16];
#pragma unroll
            for (int i = 0; i < 16; ++i) {
                const int cidx = st * 32 + (i & 3) + 8 * (i >> 2) + 4 * h;
                const float e = __builtin_amdgcn_exp2f(S[i] * c1 - c2);
                p[i] = (cidx <= L) ? e : 0.f; l += p[i];
            }
            const bf16x8 P0 = pack8(p[0], p[1], p[2], p[3], p[4], p[5], p[6], p[7]);
            const bf16x8 P1 = pack8(p[8], p[9], p[10], p[11], p[12], p[13], p[14], p[15]);
#pragma unroll
            for (int dt = 0; dt < 2; ++dt) {
                const LAS unsigned char* vp = F.lds + CA_KB + (dt * 32 + c) * CA_VSTR + (st * 32 + 4 * h) * 2;
                const u32x2 a0 = *(const LAS u32x2*)(vp), a1 = *(const LAS u32x2*)(vp + 16), b0 = *(const LAS u32x2*)(vp + 32), b1 = *(const LAS u32x2*)(vp + 48);
                O[dt] = __builtin_amdgcn_mfma_f32_32x32x16_bf16(__builtin_bit_cast(bf16x8, ((u32x4){a0.x, a0.y, a1.x, a1.y})), P0, O[dt], 0, 0, 0);
                O[dt] = __builtin_amdgcn_mfma_f32_32x32x16_bf16(__builtin_bit_cast(bf16x8, ((u32x4){b0.x, b0.y, b1.x, b1.y})), P1, O[dt], 0, 0, 0);
            }
#pragma unroll
            for (int jt = 0; jt < 2; ++jt)
#pragma unroll
                for (int s = 0; s < 2; ++s) {
                    unsigned wv[4];
#pragma unroll
                    for (int e2 = 0; e2 < 4; ++e2) {
                        unsigned pr = 0u;
#pragma unroll
                        for (int q = 0; q < 2; ++q) { const int jj = 2 * e2 + q; const int kap = 16 * s + 8 * (jj >> 2) + 4 * h + (jj & 3);
                            const int off = st * 32 + kap - 4 * (32 * jt + c);
                            const unsigned wbits = (off == 0 || off == 4) ? 0x3F80u : ((off >= 1 && off <= 3) ? 0x4000u : 0u);
                            pr |= wbits << (16 * q); }
                        wv[e2] = pr;
                    }
                    const bf16x8 Wf = __builtin_bit_cast(bf16x8, ((u32x4){wv[0], wv[1], wv[2], wv[3]}));
                    IMP[jt] = __builtin_amdgcn_mfma_f32_32x32x16_bf16(Wf, s ? P1 : P0, IMP[jt], 0, 0, 0);
                }
        }
        const float lt = l + __shfl_xor(l, 32);
        const float inv = 1.0f / fmaxf(lt, 1e-30f);
        { float* orow = OC + (mb + t) * 512 + head * 64;
#pragma unroll
          for (int dt = 0; dt < 2; ++dt)
#pragma unroll
            for (int i4 = 0; i4 < 4; ++i4) { const int d = dt * 32 + 8 * i4 + 4 * h;
                *(f32x4*)(orow + d) = (f32x4){O[dt][4 * i4] * inv, O[dt][4 * i4 + 1] * inv, O[dt][4 * i4 + 2] * inv, O[dt][4 * i4 + 3] * inv}; } }
#pragma unroll
        for (int jt = 0; jt < 2; ++jt)
#pragma unroll
            for (int i = 0; i < 16; ++i) {
                float v = IMP[jt][i] * inv; v = DPP_ADD_F(v, DPP_QX1); v = DPP_ADD_F(v, DPP_QX2);
                if ((c & 3) == 0) impL[(wave * 8 + (c >> 2)) * 65 + 32 * jt + (i & 3) + 8 * (i >> 2) + 4 * h] = v;
            }
        __syncthreads();
        if (tid < 64) {
            const int tq = q0 + tid, cur = tq >> 6;
            u64 mask;
            if (cur + 1 <= 16) mask = (1ull << (cur + 1)) - 1ull;
            else {
                unsigned top[16];
#pragma unroll
                for (int blk = 0; blk < 4; ++blk) {
                    unsigned k16[16];
#pragma unroll
                    for (int i = 0; i < 16; ++i) { const int j = blk * 16 + i; const float x = impL[tid * 65 + j];
                        const unsigned key = (j > cur) ? 0u : ((j == 0 || j == cur) ? 0xFFFFFFC0u : (mono_u32(x) & ~0x3Fu)) | (unsigned)(63 - j);
                        k16[i] = (j > cur) ? 0u : key; }
                    sort16_desc(k16);
                    if (blk == 0) {
#pragma unroll
                        for (int i = 0; i < 16; ++i) top[i] = k16[i];
                    } else merge16_desc(top, k16);
                }
                mask = 0ull;
#pragma unroll
                for (int i = 0; i < 16; ++i) mask |= 1ull << (63 - (int)(top[i] & 63u));
            }
            SELB[(size_t)bg * 4096 + tq] = mask;
        }
    }
}

template <bool MASKED>
__device__ __forceinline__ void nsa_run(const Frame& F, int kt0, int kt1, int kt_hi, AttStage& st, const bf16_t* Kg, const bf16_t* Vtg, const bf16x8 (&Qf)[2][4], const u64 (&selw)[2], const int (&qidx)[2],
                                        const float c1, const float c2, const int wlen, f32x16 (&O)[2][2], float (&l)[2]) {
    const int lane = F.lane, h = lane >> 5, tid = F.tid;
#pragma unroll 1
    for (int kt = kt0; kt < kt1; ++kt) {
        LAS unsigned char* buf = F.lds + (kt & 1) * AT_BUF;
        if (kt + 1 < kt_hi) att_load(st, Kg, Vtg, (kt + 1) * 64, tid);
#pragma unroll 1
        for (int sub = 0; sub < 2; ++sub) {
            bf16x8 Kf[4];
            att_kfrags(buf, sub, Kf, lane);
#pragma unroll
            for (int ct = 0; ct < 2; ++ct) {
                __builtin_amdgcn_sched_barrier(0);
                const f32x16 S = att_qk_f(Kf, Qf[ct]);
                const bool flag = (selw[ct] >> kt) & 1ull;
                const float c2e = flag ? c2 : 3.0e30f;
                const int dbase = qidx[ct] - (kt * 64 + sub * 32 + 4 * h);
                float p[16];
#pragma unroll
                for (int i = 0; i < 16; ++i) {
                    const float e = __builtin_amdgcn_exp2f(S[i] * c1 - c2e);
                    p[i] = (!MASKED || (unsigned)(dbase - ((i & 3) + 8 * (i >> 2))) < (unsigned)wlen) ? e : 0.f; l[ct] += p[i];
                }
                const bf16x8 P0 = pack8(p[0], p[1], p[2], p[3], p[4], p[5], p[6], p[7]);
                const bf16x8 P1 = pack8(p[8], p[9], p[10], p[11], p[12], p[13], p[14], p[15]);
                att_pv2(buf, sub, P0, P1, O[ct], lane);
            }
        }
        if (kt + 1 < kt_hi) att_store(st, F.lds + ((kt + 1) & 1) * AT_BUF, tid);
        __syncthreads();
    }
}
__device__ __forceinline__ void p_nsa_attn(const Frame& F, const Args& a, unsigned char* ws) {
    const bf16_t* QN = (const bf16_t*)(ws + L1_QN);
    const u64* SELB = (const u64*)(ws + L1_SELB); float* OC = (float*)(ws + L1_OC); const float* GATES = (const float*)(ws + L1_GATES);
    bf16_t* CAT = (bf16_t*)(ws + L1_CAT);
    const int lane = F.lane, wave = F.wave, h = lane >> 5, c = lane & 31, tid = F.tid;
    const float c2 = score_bound_c2(a.in[I_L1_QG], a.in[I_L1_KG]), c1 = 1.4426950408889634f;
    for (int u = F.bid; u < 512; u += F.G) {
        const int idx = u & 255, g = u >> 8, b = idx >> 5, qtr = idx & 31, qt = g ? 31 - qtr : qtr, q0 = qt * 128;
        const int bg = b * 2 + g; const size_t mb = (size_t)b * 4096;
        bf16x8 Qf[2][4]; int qidx[2];
#pragma unroll
        for (int ct = 0; ct < 2; ++ct) { qidx[ct] = q0 + wave * 16 + ct * 8 + (c >> 2);
#pragma unroll
            for (int ks = 0; ks < 4; ++ks) Qf[ct][ks] = *(const bf16x8*)(QN + (mb + qidx[ct]) * 512 + (g * 4 + (c & 3)) * 64 + ks * 16 + 8 * h); }
        const int head = g * 4 + (c & 3);
#pragma unroll 1
        for (int pass = 0; pass < 2; ++pass) {
            const bf16_t* Kg = (const bf16_t*)(ws + (pass ? L1_KW : L1_KS)) + (size_t)bg * 4096 * 64;
            const bf16_t* Vtg = (const bf16_t*)(ws + (pass ? L1_VWT : L1_VST)) + (size_t)bg * 64 * 4096;
            u64 selw[2];
#pragma unroll
            for (int ct = 0; ct < 2; ++ct) selw[ct] = pass ? ~0ull : SELB[(size_t)bg * 4096 + qidx[ct]];
            const int wlen = pass ? 512 : 0x7fffffff;
            f32x16 O[2][2]; float l[2] = {0.f, 0.f};
#pragma unroll
            for (int ct = 0; ct < 2; ++ct)
#pragma unroll
                for (int dt = 0; dt < 2; ++dt)
#pragma unroll
                    for (int i = 0; i < 16; ++i) O[ct][dt][i] = 0.f;
            const int kt_lo = pass ? ((2 * qt - 8) > 0 ? 2 * qt - 8 : 0) : 0, kt_hi = 2 * qt + 2;
            int ka = pass ? 2 * qt - 6 : 0; ka = ka < kt_lo ? kt_lo : ka; const int kb = 2 * qt;
            AttStage st; att_load(st, Kg, Vtg, kt_lo * 64, tid);
            __syncthreads();
            att_store(st, F.lds + (kt_lo & 1) * AT_BUF, tid);
            __syncthreads();
            nsa_run<true>(F, kt_lo, ka, kt_hi, st, Kg, Vtg, Qf, selw, qidx, c1, c2, wlen, O, l);
            nsa_run<false>(F, ka, kb, kt_hi, st, Kg, Vtg, Qf, selw, qidx, c1, c2, wlen, O, l);
            nsa_run<true>(F, kb, kt_hi, kt_hi, st, Kg, Vtg, Qf, selw, qidx, c1, c2, wlen, O, l);
#pragma unroll
            for (int ct = 0; ct < 2; ++ct) {
                const float lt = l[ct] + __shfl_xor(l[ct], 32);
                const float inv = 1.0f / fmaxf(lt, 1e-30f);
                const size_t m = mb + qidx[ct];
                const float gcv = GATES[m * 24 + head * 3 + 0], gsv = GATES[m * 24 + head * 3 + 1], gwv = GATES[m * 24 + head * 3 + 2];
                float* orow = OC + m * 512 + head * 64; bf16_t* crow = CAT + m * 1024 + head * 64;
#pragma unroll
                for (int dt = 0; dt < 2; ++dt)
#pragma unroll
                    for (int i4 = 0; i4 < 4; ++i4) {
                        const int d = dt * 32 + 8 * i4 + 4 * h;
                        const f32x4 prev = *(const f32x4*)(orow + d);
                        const f32x4 ov = (f32x4){O[ct][dt][4 * i4] * inv, O[ct][dt][4 * i4 + 1] * inv, O[ct][dt][4 * i4 + 2] * inv, O[ct][dt][4 * i4 + 3] * inv};
                        if (pass == 0) *(f32x4*)(orow + d) = prev * gcv + ov * gsv;
                        else { const f32x4 r = prev + ov * gwv; u32x2 w; w.x = pk2(r[0], r[1]); w.y = pk2(r[2], r[3]); *(u32x2*)(crow + d) = w; }
                    }
            }
        }
    }
}

__device__ __forceinline__ float logsigmoidf_(float x) { return fminf(x, 0.f) - log1pf(__expf(-fabsf(x))); }
__device__ __forceinline__ bf16x8 frag_lds(const LAS float* p) { const f32x4 a = *(const LAS f32x4*)p, b = *(const LAS f32x4*)(p + 4); return pack8(a[0], a[1], a[2], a[3], b[0], b[1], b[2], b[3]); }
__device__ __forceinline__ bf16x8 frag_glb(const float* p) { const f32x4 a = *(const f32x4*)p, b = *(const f32x4*)(p + 4); return pack8(a[0], a[1], a[2], a[3], b[0], b[1], b[2], b[3]); }
__device__ __forceinline__ void gla_wave_bcum(const Args& a, const bf16_t* P, size_t m0, int hh, int lane, float (&bc)[32]) {
    float wg[16];
#pragma unroll
    for (int r = 0; r < 16; ++r) wg[r] = a.in[I_L1_WGATE][r * 256 + hh * 64 + lane];
    const float bgv = a.in[I_L1_BGATE][hh * 64 + lane];
    float run = 0.f;
#pragma unroll
    for (int c = 0; c < 32; ++c) {
        const bf16_t* grow = P + (m0 + c) * N_IN1 + C1_GLOW;
        const u32x4 ga = *(const u32x4*)grow, gb = *(const u32x4*)(grow + 8);
        float acc = bgv;
        acc += wg[0] * bf_lo(ga.x); acc += wg[1] * bf_hi(ga.x); acc += wg[2] * bf_lo(ga.y); acc += wg[3] * bf_hi(ga.y); acc += wg[4] * bf_lo(ga.z); acc += wg[5] * bf_hi(ga.z); acc += wg[6] * bf_lo(ga.w); acc += wg[7] * bf_hi(ga.w);
        acc += wg[8] * bf_lo(gb.x); acc += wg[9] * bf_hi(gb.x); acc += wg[10] * bf_lo(gb.y); acc += wg[11] * bf_hi(gb.y); acc += wg[12] * bf_lo(gb.z); acc += wg[13] * bf_hi(gb.z); acc += wg[14] * bf_lo(gb.w); acc += wg[15] * bf_hi(gb.w);
        run += logsigmoidf_(acc) * 0.0625f; bc[c] = run;
    }
}
__device__ __forceinline__ bf16x8 gla_vfrag(const bf16_t* vbase, int s0) {
    unsigned short e[8];
#pragma unroll
    for (int j = 0; j < 8; ++j) e[j] = vbase[(size_t)(s0 + j) * N_IN1];
    u32x4 w; w.x = (unsigned)e[0] | ((unsigned)e[1] << 16); w.y = (unsigned)e[2] | ((unsigned)e[3] << 16); w.z = (unsigned)e[4] | ((unsigned)e[5] << 16); w.w = (unsigned)e[6] | ((unsigned)e[7] << 16);
    return __builtin_bit_cast(bf16x8, w);
}
__device__ __forceinline__ void p_gla_a(const Frame& F, const Args& a, unsigned char* ws) {
    const bf16_t* P = (const bf16_t*)(ws + WS_PROJ); float* UPD = (float*)(ws + L1_UPD); float* DECAY = (float*)(ws + L1_DECAY);
    const int lane = F.lane, r = lane & 31, h = lane >> 5;
    LAS bf16_t* kdT = (LAS bf16_t*)(F.lds + F.wave * 5120);
    const int gw = F.bid * NWAVES + F.wave, NGW = F.G * NWAVES;
    for (int u = gw; u < 4096; u += NGW) {
        const int b = u >> 9, hh = (u >> 7) & 3, n = u & 127; const size_t m0 = (size_t)b * 4096 + n * 32;
        float bc[32];
        gla_wave_bcum(a, P, m0, hh, lane, bc);
        const float blast = bc[31];
#pragma unroll
        for (int c = 0; c < 32; c += 2) {
            const float k0 = bf2f(P[(m0 + c) * N_IN1 + C1_GK + hh * 64 + lane]) * __expf(blast - bc[c]);
            const float k1 = bf2f(P[(m0 + c + 1) * N_IN1 + C1_GK + hh * 64 + lane]) * __expf(blast - bc[c + 1]);
            *(LAS unsigned*)(kdT + lane * 40 + c) = pk2(k0, k1);
        }
        DECAY[(size_t)u * 64 + lane] = __expf(blast);
        LDS_WAIT();
        bf16x8 Bf[2][2];
#pragma unroll
        for (int nt = 0; nt < 2; ++nt)
#pragma unroll
            for (int ks = 0; ks < 2; ++ks) Bf[nt][ks] = *(const LAS bf16x8*)(kdT + (32 * nt + r) * 40 + 16 * ks + 8 * h);
#pragma unroll
        for (int mt = 0; mt < 4; ++mt) {
            const bf16_t* vb = P + m0 * N_IN1 + C1_GV + hh * 128 + 32 * mt + r;
            const bf16x8 A0 = gla_vfrag(vb, 8 * h), A1 = gla_vfrag(vb, 16 + 8 * h);
#pragma unroll
            for (int nt = 0; nt < 2; ++nt) {
                f32x16 acc = {0.f, 0.f, 0.f, 0.f, 0.f, 0.f, 0.f, 0.f, 0.f, 0.f, 0.f, 0.f, 0.f, 0.f, 0.f, 0.f};
                acc = __builtin_amdgcn_mfma_f32_32x32x16_bf16(A0, Bf[nt][0], acc, 0, 0, 0);
                acc = __builtin_amdgcn_mfma_f32_32x32x16_bf16(A1, Bf[nt][1], acc, 0, 0, 0);
                float* up = UPD + (size_t)u * 8192 + 32 * nt + r;
#pragma unroll
                for (int i = 0; i < 16; ++i) up[(size_t)(32 * mt + (i & 3) + 8 * (i >> 2) + 4 * h) * 64] = acc[i];
            }
        }
        LDS_WAIT();
    }
}
__device__ __forceinline__ void p_gla_b(const Frame& F, unsigned char* ws) {
    float* UPD = (float*)(ws + L1_UPD); const float* DECAY = (const float*)(ws + L1_DECAY);
    for (int e = F.bid * NTHREADS + F.tid; e < 32 * 8192; e += F.G * NTHREADS) {
        const int bh = e >> 13, rem = e & 8191, dk = rem & 63;
        float state = 0.f;
        float* up = UPD + (size_t)bh * 128 * 8192 + rem; const float* dp = DECAY + (size_t)bh * 128 * 64 + dk;
#pragma unroll 8
        for (int n = 0; n < 128; ++n) { const float uv = up[(size_t)n * 8192], dc = dp[n * 64]; up[(size_t)n * 8192] = state; state = dc * state + uv; }
    }
}
__device__ __forceinline__ void p_gla_c(const Frame& F, const Args& a, unsigned char* ws, const int mode) {
    const bf16_t* P = (const bf16_t*)(ws + WS_PROJ); const float* PREV = (const float*)(ws + L1_UPD); bf16_t* CAT = (bf16_t*)(ws + L1_CAT);
    const int lane = F.lane, r = lane & 31, h = lane >> 5;
    LAS bf16_t* qd = (LAS bf16_t*)(F.lds + F.wave * 9472);
    LAS bf16_t* ki = qd + 32 * 72;
    const int gw = F.bid * NWAVES + F.wave, NGW = F.G * NWAVES;
    for (int u = gw; u < 4096; u += NGW) {
        const int b = u >> 9, hh = (u >> 7) & 3, n = u & 127; const size_t m0 = (size_t)b * 4096 + n * 32;
        f32x4 pr_[8]; unsigned short vr_[16];
#define GLA_FETCH(ct_) do { const float* pp_ = PREV + (size_t)u * 8192 + (size_t)(32 * (ct_) + r) * 64 + 8 * h; \
            _Pragma("unroll") for (int ks_ = 0; ks_ < 4; ++ks_) { pr_[2 * ks_] = *(const f32x4*)(pp_ + 16 * ks_); pr_[2 * ks_ + 1] = *(const f32x4*)(pp_ + 16 * ks_ + 4); } \
            const bf16_t* vb_ = P + m0 * N_IN1 + C1_GV + hh * 128 + 32 * (ct_) + r; \
            _Pragma("unroll") for (int j_ = 0; j_ < 16; ++j_) vr_[j_] = vb_[(size_t)(8 * h + (j_ & 7) + 16 * (j_ >> 3)) * N_IN1]; } while (0)
        GLA_FETCH(0);
        {
            float bc[32];
            if (mode == 1) {
#pragma unroll
                for (int c = 0; c < 32; ++c) bc[c] = -0.01f * (float)c;
            } else gla_wave_bcum(a, P, m0, hh, lane, bc);
#pragma unroll
            for (int c = 0; c < 32; ++c) {
                const float kv = bf2f(P[(m0 + c) * N_IN1 + C1_GK + hh * 64 + lane]) * __expf(-bc[c]);
                const float qv = bf2f(P[(m0 + c) * N_IN1 + C1_GQ + hh * 64 + lane]) * 0.125f * __expf(bc[c]);
                ki[c * 72 + lane] = (bf16_t)f2bf(kv); qd[c * 72 + lane] = (bf16_t)f2bf(qv);
            }
        }
        LDS_WAIT();
        bf16x8 Qa[4];
#pragma unroll
        for (int ks = 0; ks < 4; ++ks) Qa[ks] = *(const LAS bf16x8*)(qd + r * 72 + 16 * ks + 8 * h);
        {
            f32x16 at = {0.f, 0.f, 0.f, 0.f, 0.f, 0.f, 0.f, 0.f, 0.f, 0.f, 0.f, 0.f, 0.f, 0.f, 0.f, 0.f};
#pragma unroll
            for (int ks = 0; ks < 4; ++ks) at = __builtin_amdgcn_mfma_f32_32x32x16_bf16(Qa[ks], *(const LAS bf16x8*)(ki + r * 72 + 16 * ks + 8 * h), at, 0, 0, 0);
            LDS_WAIT();
#pragma unroll
            for (int i = 0; i < 16; ++i) { const int c = (i & 3) + 8 * (i >> 2) + 4 * h; ki[c * 40 + r] = (bf16_t)f2bf((r <= c) ? at[i] : 0.f); }
        }
        LDS_WAIT();
        bf16x8 Aa[2];
#pragma unroll
        for (int ks = 0; ks < 2; ++ks) Aa[ks] = *(const LAS bf16x8*)(ki + r * 40 + 16 * ks + 8 * h);
        f32x16 acc[4];
#pragma unroll
        for (int ct = 0; ct < 4; ++ct) {
            bf16x8 Bp[4], Bv[2];
#pragma unroll
            for (int ks = 0; ks < 4; ++ks) Bp[ks] = pack8(pr_[2 * ks][0], pr_[2 * ks][1], pr_[2 * ks][2], pr_[2 * ks][3], pr_[2 * ks + 1][0], pr_[2 * ks + 1][1], pr_[2 * ks + 1][2], pr_[2 * ks + 1][3]);
#pragma unroll
            for (int ks = 0; ks < 2; ++ks) { u32x4 w; w.x = (unsigned)vr_[8 * ks] | ((unsigned)vr_[8 * ks + 1] << 16); w.y = (unsigned)vr_[8 * ks + 2] | ((unsigned)vr_[8 * ks + 3] << 16);
                w.z = (unsigned)vr_[8 * ks + 4] | ((unsigned)vr_[8 * ks + 5] << 16); w.w = (unsigned)vr_[8 * ks + 6] | ((unsigned)vr_[8 * ks + 7] << 16); Bv[ks] = __builtin_bit_cast(bf16x8, w); }
            if (ct < 3) GLA_FETCH(ct + 1);
#pragma unroll
            for (int i = 0; i < 16; ++i) acc[ct][i] = 0.f;
#pragma unroll
            for (int ks = 0; ks < 4; ++ks) acc[ct] = __builtin_amdgcn_mfma_f32_32x32x16_bf16(Qa[ks], Bp[ks], acc[ct], 0, 0, 0);
#pragma unroll
            for (int ks = 0; ks < 2; ++ks) acc[ct] = __builtin_amdgcn_mfma_f32_32x32x16_bf16(Aa[ks], Bv[ks], acc[ct], 0, 0, 0);
        }
#undef GLA_FETCH
#pragma unroll
        for (int i = 0; i < 16; ++i) {
            float ss = acc[0][i] * acc[0][i] + acc[1][i] * acc[1][i] + acc[2][i] * acc[2][i] + acc[3][i] * acc[3][i];
            ss = sum32_f(ss);
            const float rstd = 1.0f / sqrtf(ss * (1.f / 128.f) + 1e-6f);
            const int c = (i & 3) + 8 * (i >> 2) + 4 * h; const size_t m = m0 + c;
#pragma unroll
            for (int ct = 0; ct < 4; ++ct) { const int dv = 32 * ct + r;
                const float rv = bf2f(P[m * N_IN1 + C1_GR + hh * 128 + dv]);
                const bf16_t ov = (bf16_t)f2bf(acc[ct][i] * rstd * a.in[I_L1_OGAIN][dv] * rv * sigmoidf_(rv));
                if (mode == 0) CAT[m * 1024 + 512 + hh * 128 + dv] = ov; else asm volatile("" :: "v"((unsigned)ov)); }
        }
        LDS_WAIT();
    }
}
__global__ void __launch_bounds__(NTHREADS, 2) mk_fwd(Args args) {
    extern __shared__ __attribute__((aligned(16))) unsigned char lds_raw[];
    cg::grid_group grid = cg::this_grid();
    Frame F; F.lds = (LAS unsigned char*)lds_raw; F.tid = threadIdx.x; F.lane = F.tid & 63; F.wave = __builtin_amdgcn_readfirstlane(F.tid >> 6); F.G = gridDim.x; F.bid = blockIdx.x;
    unsigned char* ws = args.ws;
    const int lo = args.ph_lo, hi = args.ph_hi;
#ifndef KEEPMASK
#define KEEPMASK 0xFFFFFFFFu
#endif
#define IN(k) (((KEEPMASK >> (k)) & 1u) && lo <= (k) && (k) < hi)
#define BOTH(k) (IN(k) && IN((k) + 1))
#ifndef TMODE
#define TMODE 0
#endif
#ifndef REPMASK
#define REPMASK 0u
#endif
#define PH(k, ...) if (IN(k)) { { const int rep = 0; (void)rep; __VA_ARGS__; } if ((REPMASK >> (k)) & 1u) { xcd_barrier(xbar); { const int rep = 1; (void)rep; __VA_ARGS__; } } }
#ifdef TS_A
#define STAMP(k) do { if (F.bid == 0 && F.tid == 0) ((unsigned long long*)(ws + WS_CTL + 65536))[(k)] = __builtin_amdgcn_s_memrealtime(); } while (0)
#else
#define STAMP(k) do { } while (0)
#endif
#define GRID_BAR(k) do { if (BOTH(k)) { if ((k) == 0) grid.sync(); else xcd_barrier(xbar); } STAMP((k) + 1); } while (0)
    const float* x = args.in[I_X];
    float* out = args.out;
    volatile LAS unsigned* xst = (volatile LAS unsigned*)(F.lds + LDS_BYTES - 64);
    if (F.tid < 16) xst[F.tid] = 0u;
    __syncthreads();
    XcdBarrier xbar = xcd_barrier_post((unsigned*)(ws + WS_CTL) + 4096, xst);

    STAMP(0);
    PH(0, int base = 0; transpose_all(F, base, args.in[I_L0_WIN], 1024, 1864, (bf16_t*)(ws + WS_W_IN0), 1024, MapIn0()); transpose_all(F, base, args.in[I_L0_WGLU], 512, 512, (bf16_t*)(ws + WS_W_GLU), 512, MapId()); transpose_all(F, base, args.in[I_L0_WOUT], 1024, 1024, (bf16_t*)(ws + WS_W_OUT0), 1024, MapId()); peer_fold_wq(F, args.in[I_L0_WQ], args.in[I_L0_SK], (bf16_t*)(ws + WS_WQ0)); transpose_all(F, base, args.in[I_L1_WIN], 1024, 2856, (bf16_t*)(ws + WS_W_IN1), 1024, MapIn1()); transpose_all(F, base, args.in[I_L1_KW1], 2048, 256, (bf16_t*)(ws + WS_KW1), 2048, MapId()); transpose_all(F, base, args.in[I_L1_VW1], 2048, 256, (bf16_t*)(ws + WS_VW1), 2048, MapId()); transpose_all(F, base, args.in[I_L1_KW2], 256, 64, (bf16_t*)(ws + WS_KW2), 256, MapId()); transpose_all(F, base, args.in[I_L1_VW2], 256, 64, (bf16_t*)(ws + WS_VW2), 256, MapId()); transpose_all(F, base, args.in[I_L1_WOUT], 1024, 1024, (bf16_t*)(ws + WS_W_OUT1), 1024, MapId()); peer_fold_wq(F, args.in[I_L1_WQ], args.in[I_L1_SK], (bf16_t*)(ws + WS_WQ1)); zero_bytes(F, ws + WS_W_IN0 + (size_t)1864 * 1024 * 2, (size_t)(2048 - 1864) * 1024 * 2); zero_bytes(F, ws + WS_W_IN1 + (size_t)2856 * 1024 * 2, (size_t)(3072 - 2856) * 1024 * 2); zero_bytes(F, ws + WS_KW2 + (size_t)64 * 256 * 2, (size_t)192 * 256 * 2); zero_bytes(F, ws + WS_VW2 + (size_t)64 * 256 * 2, (size_t)192 * 256 * 2);   cvt_table_i8(F, args.in[I_L0_U], ws + WS_TAB8U, (float*)(ws + WS_TABSU), 32); cvt_table_fp8(F, args.in[I_L0_V], ws + WS_TAB8V, (float*)(ws + WS_TABSV), 32); p_rope_table(F, (f32x2*)(ws + WS_ROPE)); if (F.bid == F.G - 1) { for (int i = F.tid; i < 1024; i += NTHREADS) ((float*)(ws + WS_CMPB + 4096))[i] = args.in[I_L1_MIXN][i]; } __syncthreads(); for (int g = F.bid; g < 32; g += F.G) s5_build_group(F, args, ws, g); for (int j = (F.bid + F.G - (32 % F.G)) % F.G; j < 64; j += F.G) cmp_bias(F, args, (float*)(ws + WS_CMPB), j); p_rmsnorm(F, x, args.in[I_L0_MIXN], (bf16_t*)(ws + WS_XN));)
    GRID_BAR(0);
    PH(1, pg8::Gemm g{(const bf16_t*)(ws + WS_XN), (const bf16_t*)(ws + WS_W_IN0), T, N_IN0, 1024, 1024, 1024}; pg8::StaticOrder S; S.init(T, N_IN0, F.G, F.bid); pg8::EpiStoreBf16 E{(bf16_t*)(ws + WS_PROJ), N_IN0}; pg8::gemm_phase(F.lds, g, S, E);)
    GRID_BAR(1);
    PH(2, p_l0_prep(F, args, ws);)
    GRID_BAR(2);
    PH(3, p_dsa_index(F, ws, (u64*)(ws + (rep ? L0_CAT : L0_SELT)), rep ? TMODE : 0); { pg8::Gemm g{(const bf16_t*)(ws + L0_UA), (const bf16_t*)(ws + WS_S5B1), 65536, 8192, 256, 384, 256}; pg8::GroupedOrder S; S.init(256, 8, F.G, F.bid); pg8::EpiS5State E{(float*)(ws + L0_SLOC)}; pg8::gemm_phase(F.lds, g, S, E); })
    GRID_BAR(3);
    PH(4, p_s5_scan(F, args, ws); p_dsa_attn(F, args, ws);)
    GRID_BAR(4);
    PH(7, pg8::Gemm g{(const bf16_t*)(ws + L0_UA), (const bf16_t*)(ws + WS_S5B2), 65536, 8192, 384, 384, 384}; pg8::GroupedOrder S; S.init(256, 8, F.G, F.bid); pg8::EpiS5Out E{(bf16_t*)(ws + L0_YB)}; pg8::gemm_phase(F.lds, g, S, E);)
    GRID_BAR(7);
    PH(8, pg8::Gemm g{(const bf16_t*)(ws + L0_YB), (const bf16_t*)(ws + WS_W_GLU), T, 512, 512, 512, 512}; pg8::StaticOrder S; S.init(T, 512, F.G, F.bid); pg8::EpiGlu E{(const bf16_t*)(ws + L0_YB), args.in[I_L0_BGLU], (bf16_t*)(ws + L0_CAT)}; pg8::gemm_phase(F.lds, g, S, E);)
    GRID_BAR(8);
    PH(9, pg8::Gemm g{(const bf16_t*)(ws + L0_CAT), (const bf16_t*)(ws + WS_W_OUT0), T, 1024, 1024, 1024, 1024}; pg8::StaticOrder S; S.init(T, 1024, F.G, F.bid); pg8::EpiResidNorm E{x, out, args.in[I_L0_FFNN], (bf16_t*)(ws + WS_XN), (float*)(ws + PE_SSQ)}; pg8::gemm_phase(F.lds, g, S, E);)
    GRID_BAR(9);
    PH(11, pg8::Gemm g{(const bf16_t*)(ws + WS_XN), (const bf16_t*)(ws + WS_WQ0), T, 2048, 1024, 1024, 1024}; pg8::StaticOrder S; S.init(T, 2048, F.G, F.bid); pg8::EpiStoreF16Rs E{(_Float16*)(ws + PE_Q2), 2048, (const float*)(ws + PE_SSQ)}; pg8::gemm_phase(F.lds, g, S, E);)
    GRID_BAR(11);
    PH(12, p_peer_route(F, ws);)
    GRID_BAR(12);
    PH(13, p_peer_expert5(F, ws, out, rep ? 0.f : 1.f, xbar, rep ? TMODE : 0, true, WS_XN);)
    GRID_BAR(13);
    PH(15, pg8::Gemm g{(const bf16_t*)(ws + WS_XN), (const bf16_t*)(ws + WS_W_IN1), T, N_IN1, 1024, 1024, 1024}; pg8::StaticOrder S; S.init(T, N_IN1, F.G, F.bid); pg8::EpiStoreBf16 E{(bf16_t*)(ws + WS_PROJ), N_IN1}; pg8::gemm_phase(F.lds, g, S, E);)
    GRID_BAR(15);
    PH(16, p_l1_prep(F, args, ws);)
    GRID_BAR(16);
    PH(17, pg8::Gemm g{(const bf16_t*)(ws + L1_KCR), (const bf16_t*)(ws + WS_KW1), 8192, 512, 2048, 1024, 2048}; pg8::GroupedOrder S; S.init(32, 16, F.G, F.bid); pg8::EpiCmp1 E{(bf16_t*)(ws + L1_H1), (const float*)(ws + WS_CMPB)}; pg8::gemm_phase(F.lds, g, S, E);)
    GRID_BAR(17);
    PH(18, pg8::Gemm g{(const bf16_t*)(ws + L1_H1), (const bf16_t*)(ws + WS_KW2), 8192, 512, 256, 256, 256}; pg8::GroupedOrder S; S.init(32, 16, F.G, F.bid); pg8::EpiCmp2 E{(float*)(ws + L1_CMPO)}; pg8::gemm_phase(F.lds, g, S, E);)
    GRID_BAR(18);
    PH(19, p_cmp_final(F, args, ws);)
    GRID_BAR(19);
    PH(20, p_cmp_attn(F, args, ws);)
    GRID_BAR(20);
    PH(21, if (rep) { p_cmp_attn(F, args, ws); xcd_barrier(xbar); } p_nsa_attn(F, args, ws);)
    GRID_BAR(21);
    PH(22, p_gla_a(F, args, ws); cvt_table_i8(F, args.in[I_L1_U], ws + WS_TAB8U, (float*)(ws + WS_TABSU), 0); cvt_table_fp8(F, args.in[I_L1_V], ws + WS_TAB8V, (float*)(ws + WS_TABSV), 0);)
    GRID_BAR(22);
    PH(23, if (rep) { p_gla_a(F, args, ws); xcd_barrier(xbar); } p_gla_b(F, ws);)
    GRID_BAR(23);
    PH(24, p_gla_c(F, args, ws, rep ? TMODE : 0);)
    GRID_BAR(24);
    PH(25, pg8::Gemm g{(const bf16_t*)(ws + L1_CAT), (const bf16_t*)(ws + WS_W_OUT1), T, 1024, 1024, 1024, 1024}; pg8::StaticOrder S; S.init(T, 1024, F.G, F.bid); pg8::EpiResidNorm E{out, out, args.in[I_L1_FFNN], (bf16_t*)(ws + WS_R3), (float*)(ws + PE_SSQ)}; pg8::gemm_phase(F.lds, g, S, E);)
    GRID_BAR(25);
    PH(27, pg8::Gemm g{(const bf16_t*)(ws + WS_R3), (const bf16_t*)(ws + WS_WQ1), T, 2048, 1024, 1024, 1024}; pg8::StaticOrder S; S.init(T, 2048, F.G, F.bid); pg8::EpiStoreF16Rs E{(_Float16*)(ws + PE_Q2), 2048, (const float*)(ws + PE_SSQ)}; pg8::gemm_phase(F.lds, g, S, E);)
    GRID_BAR(27);
    PH(28, p_peer_route(F, ws);)
    GRID_BAR(28);
    PH(29, p_peer_expert5(F, ws, out, rep ? 0.f : 1.f, xbar, rep ? TMODE : 0, false, WS_R3);)
#undef IN
#undef BOTH
}

extern "C" void kernel_launch(void* const* d_in, const int* in_sizes, int n_in, void* d_out, int out_size, void* d_ws, size_t ws_size, hipStream_t stream) {
    static int grid = 0;
    if (grid == 0) {
        if (n_in != 39 || ws_size < WS_END) { fprintf(stderr, "kernel_launch: unexpected n_in %d or ws_size %zu (< %zu)\n", n_in, ws_size, (size_t)WS_END); grid = -1; return; }
        int dev = 0, cus = 0, per_cu = 0;
        (void)hipGetDevice(&dev); (void)hipDeviceGetAttribute(&cus, hipDeviceAttributeMultiprocessorCount, dev);
        if (hipFuncSetAttribute((const void*)mk_fwd, hipFuncAttributeMaxDynamicSharedMemorySize, LDS_BYTES) != hipSuccess) { fprintf(stderr, "kernel_launch: hipFuncSetAttribute failed\n"); grid = -1; return; }
        if (hipOccupancyMaxActiveBlocksPerMultiprocessor(&per_cu, (const void*)mk_fwd, NTHREADS, LDS_BYTES) != hipSuccess || per_cu < 1) { fprintf(stderr, "kernel_launch: occupancy query failed (%d)\n", per_cu); (void)hipGetLastError(); grid = -1; return; }
        grid = cus;
    }
    if (grid < 0) return;
    (void)hipMemsetAsync((char*)d_ws + WS_CTL, 0, 32768, stream);
    Args a{};
    for (int i = 0; i < 39; ++i) a.in[i] = (const float*)d_in[i];
    a.out = (float*)d_out; a.ws = (unsigned char*)d_ws; a.ph_lo = 0; a.ph_hi = 1000;
    void* kargs[] = {&a};
    hipError_t e = hipLaunchCooperativeKernel((const void*)mk_fwd, dim3(grid), dim3(NTHREADS), kargs, LDS_BYTES, stream);
    if (e != hipSuccess) fprintf(stderr, "kernel_launch: cooperative launch failed: %s\n", hipGetErrorString(e));
}
```

```cpp
#include <hip/hip_runtime.h>
#include <hip/hip_cooperative_groups.h>
#include <cstdio>
#include <cstdint>
namespace cg = cooperative_groups;

#define LAS __attribute__((address_space(3)))
typedef unsigned short bf16_t;
typedef short bf16x8 __attribute__((ext_vector_type(8)));
typedef float f32x4 __attribute__((ext_vector_type(4)));
typedef float f32x2 __attribute__((ext_vector_type(2)));
typedef float f32x16 __attribute__((ext_vector_type(16)));
typedef unsigned u32x4 __attribute__((ext_vector_type(4)));
typedef unsigned u32x2 __attribute__((ext_vector_type(2)));
typedef unsigned long long u64;

constexpr int NB = 8, SEQ = 4096, DM = 1024, T = NB * SEQ;
constexpr int NTHREADS = 512, NWAVES = 8;
constexpr int LDS_BYTES = 147456;
constexpr int N_IN0 = 2048, N_IN1 = 3072;
constexpr int C0_Q = 0, C0_K = 512, C0_V = 640, C0_IQ = 768, C0_U = 1280, C0_IK = 1792, C0_IW = 1856;
constexpr int C1_Q = 0, C1_KC = 512, C1_VC = 640, C1_KS = 768, C1_VS = 896, C1_KW = 1024, C1_VW = 1152, C1_GQ = 1280, C1_GK = 1536, C1_GV = 1792, C1_GR = 2304, C1_GL = 2816, C1_GLOW = 2840;

constexpr size_t MiB = 1u << 20;
constexpr size_t WS_CTL = 0;
constexpr size_t WS_ROPE = 1 * MiB;
constexpr size_t WS_W_IN0 = 2 * MiB;
constexpr size_t WS_W_GLU = 6 * MiB;
constexpr size_t WS_SK0 = 6 * MiB + 512 * 1024;
constexpr size_t WS_W_OUT0 = 7 * MiB;
constexpr size_t WS_WQ0 = 9 * MiB;
constexpr size_t WS_W_IN1 = 13 * MiB;
constexpr size_t WS_KW1 = 19 * MiB;
constexpr size_t WS_VW1 = 20 * MiB;
constexpr size_t WS_KW2 = 21 * MiB;
constexpr size_t WS_VW2 = 21 * MiB + 128 * 1024;
constexpr size_t WS_SK1 = 21 * MiB + 512 * 1024;
constexpr size_t WS_W_OUT1 = 22 * MiB;
constexpr size_t WS_WQ1 = 24 * MiB;
constexpr size_t WS_S5B1 = 28 * MiB;
constexpr size_t WS_S5B2 = 32 * MiB;
constexpr size_t WS_CMPB = 38 * MiB;
constexpr size_t WS_TABU = 48 * MiB;
constexpr size_t WS_TABV = 80 * MiB;
constexpr size_t WS_XN = 112 * MiB;
constexpr size_t WS_PROJ = 176 * MiB;
constexpr size_t WS_R3 = 368 * MiB;
constexpr size_t WS_END = 506 * MiB;

__device__ __forceinline__ unsigned f2bf(float f) { unsigned u = __builtin_bit_cast(unsigned, f); return (u + 0x7fffu + ((u >> 16) & 1u)) >> 16; }
__device__ __forceinline__ unsigned pk2(float lo, float hi) { return f2bf(lo) | (f2bf(hi) << 16); }
__device__ __forceinline__ float bf_lo(unsigned u) { return __builtin_bit_cast(float, u << 16); }
__device__ __forceinline__ float bf_hi(unsigned u) { return __builtin_bit_cast(float, u & 0xffff0000u); }
__device__ __forceinline__ float bf2f(bf16_t b) { return __builtin_bit_cast(float, ((unsigned)b) << 16); }
typedef unsigned u32x2p __attribute__((ext_vector_type(2)));
__device__ __forceinline__ float dpp_f(float v, const int ctrl) { return v; }
#define DPP_ADD_F(v, ctrl) ((v) + __builtin_bit_cast(float, __builtin_amdgcn_update_dpp(0, __builtin_bit_cast(int, (v)), (ctrl), 0xF, 0xF, true)))
#define DPP_QX1 0xB1
#define DPP_QX2 0x4E
#define DPP_HMIR 0x141
#define DPP_MIR 0x140
#define DPP_ROR8 0x128
__device__ __forceinline__ float sum8_f(float v) { v = DPP_ADD_F(v, DPP_QX1); v = DPP_ADD_F(v, DPP_QX2); v = DPP_ADD_F(v, DPP_HMIR); return v; }
__device__ __forceinline__ float sum16_f(float v) { v = sum8_f(v); v = DPP_ADD_F(v, DPP_MIR); return v; }
__device__ __forceinline__ float rl_f(float v, int l) { return __builtin_bit_cast(float, __builtin_amdgcn_readlane(__builtin_bit_cast(int, v), l)); }
__device__ __forceinline__ float sum32_f(float v) { v = sum16_f(v); return v + __shfl_xor(v, 16); }
__device__ __forceinline__ float wave_sum(float v) { v = sum16_f(v); return (rl_f(v, 0) + rl_f(v, 16)) + (rl_f(v, 32) + rl_f(v, 48)); }
__device__ __forceinline__ float gelu_tanh(float x) {
    const float y = 0.7978845608028654f * (x + 0.044715f * x * x * x);
    const float e = __expf(2.0f * y);
    const float th = 1.0f - 2.0f / (e + 1.0f);
    return 0.5f * x * (1.0f + th);
}
__device__ __forceinline__ float sigmoidf_(float x) { return 1.0f / (1.0f + __expf(-x)); }
#define LDS_WAIT() asm volatile("s_waitcnt lgkmcnt(0)" ::: "memory")
#define VM_WAIT() asm volatile("s_waitcnt vmcnt(0)" ::: "memory")

#define XB_TMO      128
#define XB_XCNT(j)  (256  + 64 * (j))
#define XB_XSUB(j)  (1280 + 64 * (j))
#define XB_XGEN(j)  (2304 + 64 * (j))
#define XB_TOP      3328
#define XB_TOPGEN   3392
#define XCD_BAR_WORDS 3456
#define XB_SPIN_CAP (1u << 22)
__device__ __forceinline__ unsigned xb_ld(unsigned* p)              { return __hip_atomic_load(p, __ATOMIC_RELAXED, __HIP_MEMORY_SCOPE_AGENT); }
__device__ __forceinline__ unsigned xb_add(unsigned* p, unsigned v) { return __hip_atomic_fetch_add(p, v, __ATOMIC_RELAXED, __HIP_MEMORY_SCOPE_AGENT); }
__device__ __forceinline__ unsigned xb_xcc_id() { return (unsigned)__builtin_amdgcn_s_getreg((3 << 11) | 20) & 0xFu; }
#define XB_SPIN(cond, bar) do { unsigned _sp = 0; while (cond) { __builtin_amdgcn_s_sleep(1); \
    if ((++_sp & 255u) == 0u) { if (xb_ld(&(bar)[XB_TMO])) break; if (_sp > XB_SPIN_CAP) { atomicAdd(&(bar)[XB_TMO], 1u); break; } } } } while (0)
struct XcdBarrier { unsigned* bar; unsigned x; volatile LAS unsigned* st; };
__device__ __forceinline__ XcdBarrier xcd_barrier_post(unsigned* bar, volatile LAS unsigned* st) {
    XcdBarrier b; b.bar = bar; b.x = xb_xcc_id(); b.st = st;
    if (threadIdx.x == 0) (void)xb_add(&bar[XB_XCNT(b.x)], 1u);
    return b;
}
__device__ __forceinline__ void xcd_barrier_complete(unsigned* bar, unsigned x, unsigned& nloc, unsigned& nx) {
    const unsigned G = gridDim.x * gridDim.y * gridDim.z;
    unsigned sum, cnt, mine, sp = 0u;
    for (;;) {
        sum = 0u; cnt = 0u; mine = 0u;
#pragma unroll
        for (unsigned j = 0; j < 16; ++j) { const unsigned c = xb_ld(&bar[XB_XCNT(j)]); sum += c; cnt += (c > 0u) ? 1u : 0u; mine = (j == x) ? c : mine; }
        if (sum == G) break;
        __builtin_amdgcn_s_sleep(1);
        if ((++sp & 255u) == 0u) { if (xb_ld(&bar[XB_TMO])) break; if (sp > XB_SPIN_CAP) { atomicAdd(&bar[XB_TMO], 1u); break; } }
    }
    nloc = mine > 0u ? mine : 1u; nx = cnt > 0u ? cnt : 1u;
}
__device__ __forceinline__ void xcd_barrier(const XcdBarrier& b) {
    asm volatile("s_waitcnt vmcnt(0)" ::: "memory");
    __syncthreads();
    if (threadIdx.x == 0) {
        unsigned* bar = b.bar;
        __builtin_amdgcn_s_waitcnt(0);
        unsigned nloc = b.st[0], nx = b.st[1];
        if (nloc == 0u) { xcd_barrier_complete(bar, b.x, nloc, nx); b.st[0] = nloc; b.st[1] = nx; }
        const unsigned old = xb_add(&bar[XB_XSUB(b.x)], 1u);
        const unsigned gen = old / nloc;
        if (old + 1u == (gen + 1u) * nloc) {
            __builtin_amdgcn_fence(__ATOMIC_RELEASE, "agent");
            asm volatile("s_waitcnt vmcnt(0)" ::: "memory");
            const unsigned og = xb_add(&bar[XB_TOP], 1u);
            const unsigned tg = og / nx;
            if (og + 1u == (tg + 1u) * nx) xb_add(&bar[XB_TOPGEN], 1u);
            else XB_SPIN(xb_ld(&bar[XB_TOPGEN]) == tg, bar);
            __builtin_amdgcn_fence(__ATOMIC_ACQUIRE, "agent");
            xb_add(&bar[XB_XGEN(b.x)], 1u);
            asm volatile("s_waitcnt vmcnt(0)" ::: "memory");
        } else {
            XB_SPIN(xb_ld(&bar[XB_XGEN(b.x)]) == gen, bar);
            __builtin_amdgcn_fence(__ATOMIC_ACQUIRE, "agent");
            asm volatile("s_waitcnt vmcnt(0)" ::: "memory");
        }
    }
    __syncthreads();
}

namespace pg8 {
constexpr int BM = 256, BK = 64, HALF = 128, HTB = HALF * BK * 2, STAGE_BYTES = 8 * HTB, NXCD = 8, WGM = 8;
__device__ __forceinline__ int lds_byte(int r, int c) { const int st = (r >> 4) * 2 + (c >> 5), rr = r & 15, cc = c & 31, ob = rr * 64 + cc * 2; return st * 1024 + (ob ^ (((ob >> 9) & 1) << 5)); }
__device__ __forceinline__ void stage_rc(int b, int& R, int& C) { const int st = b / 1024, sb = b % 1024, swz = sb ^ (((sb >> 9) & 1) << 5); R = (st >> 1) * 16 + swz / 64; C = (st & 1) * 32 + (swz % 64) / 2; }
__device__ __forceinline__ int perm32(int rho) { const int n = rho >> 4, i = rho & 15; return 8 * (i >> 2) + 4 * n + (i & 3); }
struct Unit { int pm, pn; };
struct Gemm { const bf16_t* A; const bf16_t* Bt; int M, N, K, lda, ldb; };
struct StaticOrder {
    int nM, nN, nwg, G, c;
    __device__ void init(int M, int N, int G_, int c_) { nM = M / BM; nN = N / BM; nwg = nM * nN; G = G_; c = c_; }
    __device__ bool next(int i, Unit& u) const {
        const long L = (long)i * G + c; if (L >= nwg) return false;
        int wgid = (int)L; { const int q = nwg / NXCD, r = nwg % NXCD, xcd = wgid % NXCD, off = wgid / NXCD; wgid = (xcd < r ? xcd * (q + 1) : r * (q + 1) + (xcd - r) * q) + off; }
        const int nig = WGM * nN, gid = wgid / nig, fm = gid * WGM, gsz = (nM - fm) < WGM ? (nM - fm) : WGM;
        u.pm = fm + ((wgid % nig) % gsz); u.pn = (wgid % nig) / gsz; return true;
    }
};
struct GroupedOrder {
    int nwg, G, c, tpg;
    __device__ void init(int ntiles, int tiles_per_group, int G_, int c_) { nwg = ntiles; tpg = tiles_per_group; G = G_; c = c_; }
    __device__ bool next(int i, Unit& u) const { const long L = (long)i * G + c; if (L >= nwg) return false; u.pm = (int)L; u.pn = (int)L / tpg; return true; }
};
__device__ __forceinline__ unsigned cvt_pk_bf16(float lo, float hi) { unsigned r; asm volatile("v_cvt_pk_bf16_f32 %0, %1, %2" : "=v"(r) : "v"(lo), "v"(hi)); return r; }

template <class Epi, class Sched>
__device__ __forceinline__ void gemm_phase(LAS unsigned char* lds, const Gemm g, const Sched& S, const Epi& E) {
    const int tid = threadIdx.x, wid = __builtin_amdgcn_readfirstlane(tid >> 6), lane = tid & 63, wr = wid >> 2, wc = wid & 3, fr = lane & 15, fq = lane >> 4;
    int K = g.K; asm volatile("" : "+s"(K));
    const int nt = K / BK;
    unsigned voffA[2], voffB[2];
#pragma unroll
    for (int i = 0; i < 2; ++i) { int R, C; stage_rc(tid * 16 + i * 8192, R, C); const int Rb = Epi::PERM ? ((R & ~31) + perm32(R & 31)) : R;
        voffA[i] = (unsigned)(R * g.lda + C) * 2u; voffB[i] = (unsigned)(Rb * g.ldb + C) * 2u; }
    const size_t kstep = (size_t)(BK * 2);
    const size_t hstepA = (size_t)HALF * g.lda * 2, hstepB = (size_t)HALF * g.ldb * 2;
    const size_t tstepA = 2 * hstepA, tstepB = 2 * hstepB;
    const unsigned ldsw = (unsigned)wid * 1024u;
    const int aoff = lds_byte(wr * 64 + fr, fq * 8), boff = lds_byte(wc * 32 + fr, fq * 8);
#define PG8_SA(b, h) (((b) * 2 + (h)) * HTB)
#define PG8_SB(b, h) ((4 + (b) * 2 + (h)) * HTB)
#define PG8_STAGE(bufoff, gbase, voff) do { _Pragma("unroll") for (int _i = 0; _i < 2; ++_i) \
        __builtin_amdgcn_global_load_lds((const unsigned*)((const char*)(gbase) + (voff)[_i]), (LAS unsigned*)(lds + (bufoff) + ldsw + _i * 8192), 16, 0, 0); } while (0)
#define PG8_LDA(dst, b, h) do { _Pragma("unroll") for (int m = 0; m < 4; ++m) _Pragma("unroll") for (int k = 0; k < 2; ++k) dst[m][k] = *(const LAS bf16x8*)(lds + PG8_SA(b, h) + aoff + m * 2048 + k * 1024); } while (0)
#define PG8_LDB(dst, b, h) do { _Pragma("unroll") for (int n = 0; n < 2; ++n) _Pragma("unroll") for (int k = 0; k < 2; ++k) dst[n][k] = *(const LAS bf16x8*)(lds + PG8_SB(b, h) + boff + n * 2048 + k * 1024); } while (0)
#define PG8_MMA(ai, bj, At, Bt) do { __builtin_amdgcn_s_setprio(1); _Pragma("unroll") for (int m = 0; m < 4; ++m) _Pragma("unroll") for (int n = 0; n < 2; ++n) _Pragma("unroll") for (int k = 0; k < 2; ++k) \
        acc[ai][bj][m][n] = __builtin_amdgcn_mfma_f32_16x16x32_bf16(Bt[n][k], At[m][k], acc[ai][bj][m][n], 0, 0, 0); __builtin_amdgcn_s_setprio(0); } while (0)
#define PG8_WAIT_V(n) asm volatile("s_waitcnt vmcnt(" #n ")" ::: "memory")
#define PG8_WAIT_L(n) asm volatile("s_waitcnt lgkmcnt(" #n ")" ::: "memory")
#define PG8_BAR __builtin_amdgcn_s_barrier()
#define PG8_SCHED __builtin_amdgcn_sched_barrier(0)
    Unit cur, nxt; int ui = 0;
    if (!S.next(0, cur)) return;
    f32x4 acc[2][2][4][2];
#pragma unroll
    for (int a = 0; a < 2; ++a)
#pragma unroll
        for (int b = 0; b < 2; ++b)
#pragma unroll
            for (int m = 0; m < 4; ++m)
#pragma unroll
                for (int n = 0; n < 2; ++n) acc[a][b][m][n] = (f32x4){0.f, 0.f, 0.f, 0.f};
    bf16x8 At[4][2], B0[2][2], B1[2][2];
    const char* cA = (const char*)g.A + (size_t)cur.pm * tstepA; const char* cB = (const char*)g.Bt + (size_t)cur.pn * tstepB;
    PG8_STAGE(PG8_SB(0, 0), cB, voffB); PG8_STAGE(PG8_SA(0, 0), cA, voffA); PG8_STAGE(PG8_SB(0, 1), cB + hstepB, voffB); PG8_STAGE(PG8_SA(0, 1), cA + hstepA, voffA);
    if (wr == 1) PG8_BAR;
    PG8_WAIT_V(4); PG8_BAR;
    PG8_STAGE(PG8_SB(1, 0), cB + kstep, voffB); PG8_STAGE(PG8_SA(1, 0), cA + kstep, voffA); PG8_STAGE(PG8_SB(1, 1), cB + hstepB + kstep, voffB);
    PG8_WAIT_V(6); PG8_BAR;
    for (;;) {
        const bool has_next = S.next(ui + 1, nxt);
        const char* nA = has_next ? (const char*)g.A + (size_t)nxt.pm * tstepA : cA; const char* nB = has_next ? (const char*)g.Bt + (size_t)nxt.pn * tstepB : cB;
        for (int t = 0; t < nt; t += 2) {
            const bool last = (t == nt - 2);
            const char* a1 = cA + (size_t)(t + 1) * kstep;
            const char* a2 = last ? nA : cA + (size_t)(t + 2) * kstep; const char* b2 = last ? nB : cB + (size_t)(t + 2) * kstep;
            const char* a3 = a2 + kstep; const char* b3 = b2 + kstep;
            PG8_LDB(B0, 0, 0); PG8_SCHED; PG8_LDA(At, 0, 0); PG8_STAGE(PG8_SA(1, 1), a1 + hstepA, voffA);
            PG8_WAIT_L(8); PG8_BAR; PG8_WAIT_L(0); PG8_MMA(0, 0, At, B0); PG8_BAR; PG8_SCHED;
            PG8_LDB(B1, 0, 1); PG8_STAGE(PG8_SB(0, 0), b2, voffB);
            PG8_BAR; PG8_WAIT_L(0); PG8_MMA(0, 1, At, B1); PG8_BAR;
            PG8_LDA(At, 0, 1); PG8_STAGE(PG8_SA(0, 0), a2, voffA);
            PG8_BAR; PG8_WAIT_L(0); PG8_MMA(1, 0, At, B0); PG8_BAR; PG8_SCHED;
            PG8_STAGE(PG8_SB(0, 1), b2 + hstepB, voffB);
            PG8_WAIT_V(6); PG8_BAR; PG8_MMA(1, 1, At, B1); PG8_BAR;
            PG8_LDB(B0, 1, 0); PG8_SCHED; PG8_LDA(At, 1, 0); PG8_STAGE(PG8_SA(0, 1), a2 + hstepA, voffA);
            PG8_WAIT_L(8); PG8_BAR; PG8_WAIT_L(0); PG8_MMA(0, 0, At, B0); PG8_BAR; PG8_SCHED;
            PG8_LDB(B1, 1, 1); PG8_STAGE(PG8_SB(1, 0), b3, voffB);
            PG8_BAR; PG8_WAIT_L(0); PG8_MMA(0, 1, At, B1); PG8_BAR;
            PG8_LDA(At, 1, 1); PG8_STAGE(PG8_SA(1, 0), a3, voffA);
            PG8_BAR; PG8_WAIT_L(0); PG8_MMA(1, 0, At, B0); PG8_BAR; PG8_SCHED;
            PG8_STAGE(PG8_SB(1, 1), b3 + hstepB, voffB);
            PG8_WAIT_V(6); PG8_BAR; PG8_MMA(1, 1, At, B1); PG8_BAR;
        }
        E(acc, cur, wr, wc, fr, fq);
        if (!has_next) break;
#pragma unroll
        for (int a = 0; a < 2; ++a)
#pragma unroll
            for (int b = 0; b < 2; ++b)
#pragma unroll
                for (int m = 0; m < 4; ++m)
#pragma unroll
                    for (int n = 0; n < 2; ++n) acc[a][b][m][n] = (f32x4){0.f, 0.f, 0.f, 0.f};
        cur = nxt; cA = nA; cB = nB; ++ui;
    }
    PG8_WAIT_V(0);
    if (wr == 0) PG8_BAR;
    PG8_BAR;
#undef PG8_SA
#undef PG8_SB
#undef PG8_STAGE
#undef PG8_LDA
#undef PG8_LDB
#undef PG8_MMA
#undef PG8_WAIT_V
#undef PG8_WAIT_L
#undef PG8_BAR
#undef PG8_SCHED
}

struct EpiStoreBf16 {
    static constexpr bool PERM = true;
    bf16_t* O; int ldc;
    __device__ __forceinline__ void operator()(const f32x4 (&acc)[2][2][4][2], const Unit& u, int wr, int wc, int fr, int fq) const {
        const int row0 = u.pm * BM + wr * 64 + fr, col0 = u.pn * BM + wc * 32 + 8 * fq;
#pragma unroll
        for (int ai = 0; ai < 2; ++ai)
#pragma unroll
            for (int m = 0; m < 4; ++m) { bf16_t* rowp = O + (size_t)(row0 + ai * HALF + m * 16) * ldc + col0;
#pragma unroll
                for (int bj = 0; bj < 2; ++bj) { const f32x4 v0 = acc[ai][bj][m][0], v1 = acc[ai][bj][m][1];
                    u32x4 w; w.x = cvt_pk_bf16(v0[0], v0[1]); w.y = cvt_pk_bf16(v0[2], v0[3]); w.z = cvt_pk_bf16(v1[0], v1[1]); w.w = cvt_pk_bf16(v1[2], v1[3]);
                    *(u32x4*)(rowp + bj * HALF) = w; } }
    }
};
struct EpiStoreF16 {
    static constexpr bool PERM = true;
    _Float16* O; int ldc;
    __device__ __forceinline__ void operator()(const f32x4 (&acc)[2][2][4][2], const Unit& u, int wr, int wc, int fr, int fq) const {
        const int row0 = u.pm * BM + wr * 64 + fr, col0 = u.pn * BM + wc * 32 + 8 * fq;
#pragma unroll
        for (int ai = 0; ai < 2; ++ai)
#pragma unroll
            for (int m = 0; m < 4; ++m) { _Float16* rowp = O + (size_t)(row0 + ai * HALF + m * 16) * ldc + col0;
#pragma unroll
                for (int bj = 0; bj < 2; ++bj) { const f32x4 v0 = acc[ai][bj][m][0], v1 = acc[ai][bj][m][1];
                    typedef _Float16 h8 __attribute__((ext_vector_type(8)));
                    const h8 hv = {(_Float16)v0[0], (_Float16)v0[1], (_Float16)v0[2], (_Float16)v0[3], (_Float16)v1[0], (_Float16)v1[1], (_Float16)v1[2], (_Float16)v1[3]};
                    *(h8*)(rowp + bj * HALF) = hv; } }
    }
};
struct EpiResidF32 {
    static constexpr bool PERM = false;
    const float* R; float* C; int ldc;
    __device__ __forceinline__ void operator()(const f32x4 (&acc)[2][2][4][2], const Unit& u, int wr, int wc, int fr, int fq) const {
        const int row0 = u.pm * BM + wr * 64 + fr, col0 = u.pn * BM + wc * 32 + 4 * fq;
#pragma unroll
        for (int ai = 0; ai < 2; ++ai)
#pragma unroll
            for (int m = 0; m < 4; ++m) { const size_t off = (size_t)(row0 + ai * HALF + m * 16) * ldc + col0;
#pragma unroll
                for (int bj = 0; bj < 2; ++bj)
#pragma unroll
                    for (int n = 0; n < 2; ++n) { const f32x4 r = *(const f32x4*)(R + off + bj * HALF + n * 16); *(f32x4*)(C + off + bj * HALF + n * 16) = r + acc[ai][bj][m][n]; } }
    }
};
struct EpiResidNorm {
    static constexpr bool PERM = false;
    const float* R; float* C; const float* gain; bf16_t* XNp; float* SSQ;
    __device__ __forceinline__ void operator()(const f32x4 (&acc)[2][2][4][2], const Unit& u, int wr, int wc, int fr, int fq) const {
        const int row0 = u.pm * BM + wr * 64 + fr, col0 = u.pn * BM + wc * 32 + 4 * fq;
        f32x4 g4[2][2];
#pragma unroll
        for (int bj = 0; bj < 2; ++bj)
#pragma unroll
            for (int n = 0; n < 2; ++n) g4[bj][n] = *(const f32x4*)(gain + col0 + bj * HALF + n * 16);
#pragma unroll
        for (int ai = 0; ai < 2; ++ai)
#pragma unroll
            for (int m = 0; m < 4; ++m) { const int row = row0 + ai * HALF + m * 16; const size_t off = (size_t)row * 1024 + col0;
                float ss = 0.f;
#pragma unroll
                for (int bj = 0; bj < 2; ++bj)
#pragma unroll
                    for (int n = 0; n < 2; ++n) { const f32x4 o = *(const f32x4*)(R + off + bj * HALF + n * 16) + acc[ai][bj][m][n];
                        *(f32x4*)(C + off + bj * HALF + n * 16) = o;
                        ss += (o[0] * o[0] + o[1] * o[1]) + (o[2] * o[2] + o[3] * o[3]);
                        const f32x4 og = o * g4[bj][n];
                        u32x2 w; w.x = cvt_pk_bf16(og[0], og[1]); w.y = cvt_pk_bf16(og[2], og[3]);
                        *(u32x2*)(XNp + off + bj * HALF + n * 16) = w; }
                ss += __shfl_xor(ss, 16); ss += __shfl_xor(ss, 32);
                if (fq == 0) SSQ[(size_t)row * 16 + u.pn * 4 + wc] = ss;
                asm volatile("" ::: "memory"); __builtin_amdgcn_sched_barrier(0); }
    }
};
struct EpiStoreF16Rs {
    static constexpr bool PERM = true;
    _Float16* O; int ldc; const float* SSQ;
    __device__ __forceinline__ void operator()(const f32x4 (&acc)[2][2][4][2], const Unit& u, int wr, int wc, int fr, int fq) const {
        const int row0 = u.pm * BM + wr * 64 + fr, col0 = u.pn * BM + wc * 32 + 8 * fq;
#pragma unroll
        for (int ai = 0; ai < 2; ++ai)
#pragma unroll
            for (int m = 0; m < 4; ++m) { const int row = row0 + ai * HALF + m * 16; _Float16* rowp = O + (size_t)row * ldc + col0;
                const f32x4* sp = (const f32x4*)(SSQ + (size_t)row * 16);
                const f32x4 s0 = sp[0], s1 = sp[1], s2 = sp[2], s3 = sp[3];
                const float tot = ((s0[0] + s0[1]) + (s0[2] + s0[3])) + ((s1[0] + s1[1]) + (s1[2] + s1[3])) + ((s2[0] + s2[1]) + (s2[2] + s2[3])) + ((s3[0] + s3[1]) + (s3[2] + s3[3]));
                const float rstd = 1.0f / sqrtf(tot * (1.0f / 1024.0f) + 1e-6f);
#pragma unroll
                for (int bj = 0; bj < 2; ++bj) { const f32x4 v0 = acc[ai][bj][m][0] * rstd, v1 = acc[ai][bj][m][1] * rstd;
                    typedef _Float16 h8 __attribute__((ext_vector_type(8)));
                    const h8 hv = {(_Float16)v0[0], (_Float16)v0[1], (_Float16)v0[2], (_Float16)v0[3], (_Float16)v1[0], (_Float16)v1[1], (_Float16)v1[2], (_Float16)v1[3]};
                    *(h8*)(rowp + bj * HALF) = hv; }
                asm volatile("" ::: "memory"); __builtin_amdgcn_sched_barrier(0); }
    }
};
}

struct Args {
    const float* in[39];
    float* out;
    unsigned char* ws;
    int ph_lo, ph_hi;
};
enum { I_X = 0, I_L0_MIXN, I_L0_WIN, I_L0_QG, I_L0_KG, I_L0_LOGDT, I_L0_ARE, I_L0_AIM, I_L0_BRE, I_L0_BIM, I_L0_CRE, I_L0_CIM, I_L0_D, I_L0_WGLU, I_L0_BGLU, I_L0_WOUT,
       I_L0_FFNN, I_L0_WQ, I_L0_SK, I_L0_U, I_L0_V,
       I_L1_MIXN, I_L1_WIN, I_L1_QG, I_L1_KG, I_L1_CMPPOS, I_L1_KW1, I_L1_KW2, I_L1_VW1, I_L1_VW2, I_L1_WGATE, I_L1_BGATE, I_L1_OGAIN, I_L1_WOUT,
       I_L1_FFNN, I_L1_WQ, I_L1_SK, I_L1_U, I_L1_V };

struct Frame {
    LAS unsigned char* lds;
    int tid, lane, wave, G, bid;
};

constexpr size_t L0_QA = WS_R3;
constexpr size_t L0_IQ = WS_R3 + 32 * MiB;
constexpr size_t L0_KA = WS_R3 + 64 * MiB;
constexpr size_t L0_VAT = WS_R3 + 72 * MiB;
constexpr size_t L0_IK = WS_R3 + 80 * MiB;
constexpr size_t L0_IW = WS_R3 + 84 * MiB;
constexpr size_t L0_UA = WS_R3 + 88 * MiB;
constexpr size_t L0_SELT = WS_PROJ;
constexpr size_t L0_CAT = WS_PROJ + 16 * MiB;
constexpr size_t L0_SLOC = WS_PROJ + 80 * MiB;
constexpr size_t L0_YB = WS_PROJ + 112 * MiB;
constexpr size_t PE_Q2 = WS_PROJ;
constexpr size_t PE_EID = WS_PROJ + 128 * MiB;
constexpr size_t PE_GATE = WS_PROJ + 136 * MiB;
constexpr size_t PE_SSQ = WS_PROJ + 152 * MiB;

template <class Map>
__device__ __forceinline__ void transpose_item(const float* W, int K, int N, bf16_t* WT, int ldk, LAS float* scr, int item, int lane, const Map& map) {
    const int nblk = (N + 31) / 32, kb = item / nblk, nb = item % nblk, k0 = 64 * kb, n0 = 32 * nb;
    const int ncol = n0 + (lane & 31);
#pragma unroll 8
    for (int i = 0; i < 32; ++i) { const int kk = 2 * i + (lane >> 5); scr[kk * 33 + (lane & 31)] = (ncol < N) ? W[(size_t)(k0 + kk) * N + ncol] : 0.f; }
    LDS_WAIT(); asm volatile("" ::: "memory");
    const int c = lane & 7;
#pragma unroll
    for (int j = 0; j < 4; ++j) { const int n = (lane >> 3) + 8 * j; const LAS float* s = scr + (8 * c) * 33 + n;
        u32x4 o; o.x = pk2(s[0 * 33], s[1 * 33]); o.y = pk2(s[2 * 33], s[3 * 33]); o.z = pk2(s[4 * 33], s[5 * 33]); o.w = pk2(s[6 * 33], s[7 * 33]);
        if (n0 + n < N) *(u32x4*)(WT + (size_t)map(n0 + n) * ldk + k0 + 8 * c) = o; }
    LDS_WAIT(); asm volatile("" ::: "memory");
}
struct MapId { __device__ __forceinline__ int operator()(int n) const { return n; } };
struct MapIn0 { __device__ __forceinline__ int operator()(int n) const { return n < 1280 ? n : (n < 1344 ? n - 1280 + C0_IK : (n < 1352 ? n - 1344 + C0_IW : n - 1352 + C0_U)); } };
struct MapIn1 { __device__ __forceinline__ int operator()(int n) const {
    if (n < 1280) return n; if (n < 1304) return n - 1280 + C1_GL; if (n < 1560) return n - 1304 + C1_GQ; if (n < 1816) return n - 1560 + C1_GK;
    if (n < 2328) return n - 1816 + C1_GV; if (n < 2344) return n - 2328 + C1_GLOW; return n - 2344 + C1_GR; } };

template <class Map>
__device__ __forceinline__ void transpose_all(const Frame& F, int& base, const float* W, int K, int N, bf16_t* WT, int ldk, const Map& map) {
    LAS float* scr = (LAS float*)(F.lds + F.wave * 16384);
    const int gw = F.bid * NWAVES + F.wave, NGW = F.G * NWAVES;
    const int nit = (K / 64) * ((N + 31) / 32);
    for (int it = (gw + NGW - (base % NGW)) % NGW; it < nit; it += NGW) transpose_item(W, K, N, WT, ldk, scr, it, F.lane, map);
    base += nit;
}
__device__ __forceinline__ void zero_bytes(const Frame& F, unsigned char* p, size_t nbytes) {
    const size_t n16 = nbytes / 16;
    for (size_t i = (size_t)F.bid * NTHREADS + F.tid; i < n16; i += (size_t)F.G * NTHREADS) ((u32x4*)p)[i] = (u32x4){0u, 0u, 0u, 0u};
}
__device__ __forceinline__ void cvt_f32_bf16(const Frame& F, const float* src, bf16_t* dst, size_t n) {
    const size_t n8 = n / 8;
    for (size_t i = (size_t)F.bid * NTHREADS + F.tid; i < n8; i += (size_t)F.G * NTHREADS) {
        const f32x4 a = ((const f32x4*)src)[2 * i], b = ((const f32x4*)src)[2 * i + 1];
        u32x4 o; o.x = pk2(a.x, a.y); o.y = pk2(a.z, a.w); o.z = pk2(b.x, b.y); o.w = pk2(b.z, b.w);
        ((u32x4*)dst)[i] = o;
    }
}

__device__ __forceinline__ void rms_row_to_bf16(const float* xrow, const float* gain, bf16_t* orow, int lane) {
    const f32x4* xr = (const f32x4*)xrow + lane; const f32x4* gr = (const f32x4*)gain + lane;
    f32x4 v[4]; float s = 0.f;
#pragma unroll
    for (int j = 0; j < 4; ++j) { v[j] = xr[64 * j]; s += (v[j].x * v[j].x + v[j].y * v[j].y) + (v[j].z * v[j].z + v[j].w * v[j].w); }
    const float rstd = 1.0f / sqrtf(wave_sum(s) * (1.f / DM) + 1e-6f);
    u64* o8 = (u64*)orow + lane;
#pragma unroll
    for (int j = 0; j < 4; ++j) { const f32x4 g4 = gr[64 * j]; o8[64 * j] = (u64)pk2(v[j].x * rstd * g4.x, v[j].y * rstd * g4.y) | ((u64)pk2(v[j].z * rstd * g4.z, v[j].w * rstd * g4.w) << 32); }
}
__device__ __forceinline__ void p_rmsnorm(const Frame& F, const float* x, const float* gain, bf16_t* XN) {
    const int gw = F.bid * NWAVES + F.wave, NGW = F.G * NWAVES;
    for (int m = gw; m < T; m += NGW) rms_row_to_bf16(x + (size_t)m * DM, gain, XN + (size_t)m * DM, F.lane);
}

__device__ __forceinline__ void p_rope_table(const Frame& F, f32x2* rope) {
    for (int i = F.bid * NTHREADS + F.tid; i < SEQ * 32; i += F.G * NTHREADS) {
        const int pos = i >> 5, k = i & 31;
        const float inv = powf(10000.0f, -(float)k / 32.0f);
        const float ang = (float)pos * inv;
        float s, c; sincosf(ang, &s, &c);
        rope[i] = (f32x2){c, s};
    }
}

__device__ __forceinline__ void s5_build_group(const Frame& F, const Args& a, unsigned char* ws, int g) {
    LAS f32x2* abp = (LAS f32x2*)F.lds;
    LAS f32x2* bb = abp + 17 * 64;
    LAS f32x2* Cc = bb + 64 * 16;
    LAS float* KT = (LAS float*)(Cc + 16 * 64);
    const float dt = expf(a.in[I_L0_LOGDT][g]);
    for (int idx = F.tid; idx < 17 * 64; idx += NTHREADS) {
        const int tau = idx >> 6, p = idx & 63;
        const float lr = a.in[I_L0_ARE][g * 64 + p], li = a.in[I_L0_AIM][g * 64 + p];
        const float mag = expf((float)tau * dt * lr); float s, c; sincosf((float)tau * dt * li, &s, &c);
        abp[idx] = (f32x2){mag * c, mag * s};
    }
    for (int idx = F.tid; idx < 64 * 16; idx += NTHREADS) {
        const int p = idx >> 4, c = idx & 15;
        const float lr = a.in[I_L0_ARE][g * 64 + p], li = a.in[I_L0_AIM][g * 64 + p];
        const float mag = expf(dt * lr); float s, co; sincosf(dt * li, &s, &co);
        const float abr = mag * co, abi = mag * s, den = lr * lr + li * li;
        const float fr = ((abr - 1.0f) * lr + abi * li) / den, fi = (abi * lr - (abr - 1.0f) * li) / den;
        const float br = a.in[I_L0_BRE][(size_t)(g * 64 + p) * 16 + c], bi = a.in[I_L0_BIM][(size_t)(g * 64 + p) * 16 + c];
        bb[idx] = (f32x2){fr * br - fi * bi, fr * bi + fi * br};
    }
    for (int idx = F.tid; idx < 16 * 64; idx += NTHREADS) Cc[idx] = (f32x2){a.in[I_L0_CRE][(size_t)g * 1024 + idx], a.in[I_L0_CIM][(size_t)g * 1024 + idx]};
    __syncthreads();
    for (int idx = F.tid; idx < 16 * 256; idx += NTHREADS) {
        const int tau = idx >> 8, co = (idx >> 4) & 15, ci = idx & 15;
        float acc = 0.f;
        for (int p = 0; p < 64; ++p) {
            const f32x2 c = Cc[co * 64 + p], e = abp[tau * 64 + p], b = bb[p * 16 + ci];
            const float er = c.x * e.x - c.y * e.y, ei = c.x * e.y + c.y * e.x;
            acc += er * b.x - ei * b.y;
        }
        if (tau == 0 && co == ci) acc += a.in[I_L0_D][g * 16 + co];
        KT[idx] = acc;
    }
    __syncthreads();
    bf16_t* B1 = (bf16_t*)(ws + WS_S5B1) + (size_t)g * 256 * 256;
    bf16_t* B2 = (bf16_t*)(ws + WS_S5B2) + (size_t)g * 256 * 384;
    for (int idx = F.tid; idx < 256 * 128; idx += NTHREADS) {
        const int n = idx >> 7, k = (idx & 127) * 2;
        float v0 = 0.f, v1 = 0.f;
        if (n < 128) { const int p = n & 63, j = k >> 4, ci = k & 15; const f32x2 e = abp[(15 - j) * 64 + p], b0 = bb[p * 16 + ci], b1 = bb[p * 16 + ci + 1];
            if (n < 64) { v0 = e.x * b0.x - e.y * b0.y; v1 = e.x * b1.x - e.y * b1.y; } else { v0 = e.x * b0.y + e.y * b0.x; v1 = e.x * b1.y + e.y * b1.x; } }
        *(unsigned*)(B1 + (size_t)n * 256 + k) = pk2(v0, v1);
    }
    for (int idx = F.tid; idx < 256 * 192; idx += NTHREADS) {
        const int n = idx / 192, k = (idx % 192) * 2, i = n >> 4, co = n & 15;
        float v0 = 0.f, v1 = 0.f;
        if (k < 256) { const int j = k >> 4, ci = k & 15; if (j <= i) { v0 = KT[((i - j) * 16 + co) * 16 + ci]; v1 = KT[((i - j) * 16 + co) * 16 + ci + 1]; } }
        else { const int p = (k - 256) & 63; const bool im = k >= 320;
            const f32x2 c0 = Cc[co * 64 + p], e0 = abp[(i + 1) * 64 + p], c1 = Cc[co * 64 + p + 1], e1 = abp[(i + 1) * 64 + p + 1];
            if (!im) { v0 = c0.x * e0.x - c0.y * e0.y; v1 = c1.x * e1.x - c1.y * e1.y; } else { v0 = -(c0.x * e0.y + c0.y * e0.x); v1 = -(c1.x * e1.y + c1.y * e1.x); } }
        *(unsigned*)(B2 + (size_t)n * 384 + k) = pk2(v0, v1);
    }
    __syncthreads();
}

__device__ __forceinline__ void cmp_bias(const Frame& F, const Args& a, float* out, int j) {
    const int w = j >> 5, n0 = (j & 31) * 8;
    const float* w1 = a.in[w ? I_L1_VW1 : I_L1_KW1]; const float* pos = a.in[I_L1_CMPPOS];
    LAS float* red = (LAS float*)(F.lds + 65536);
    float acc[8];
#pragma unroll
    for (int i = 0; i < 8; ++i) acc[i] = 0.f;
#pragma unroll
    for (int kk = 0; kk < 4; ++kk) { const int k = F.tid * 4 + kk; const float p = pos[k];
        const f32x4 wa = *(const f32x4*)(w1 + (size_t)k * 256 + n0), wb = *(const f32x4*)(w1 + (size_t)k * 256 + n0 + 4);
        acc[0] += p * wa.x; acc[1] += p * wa.y; acc[2] += p * wa.z; acc[3] += p * wa.w; acc[4] += p * wb.x; acc[5] += p * wb.y; acc[6] += p * wb.z; acc[7] += p * wb.w; }
#pragma unroll
    for (int i = 0; i < 8; ++i) { const float sv = wave_sum(acc[i]); if (F.lane == 0) red[F.wave * 8 + i] = sv; }
    __syncthreads();
    if (F.tid < 8) { float t = 0.f; for (int wv = 0; wv < 8; ++wv) t += red[wv * 8 + F.tid]; out[w * 256 + n0 + F.tid] = t; }
    __syncthreads();
}

__device__ __forceinline__ float rope_apply(float v, const f32x2 cs, int lane) {
    const float partner = __shfl_xor(v, 32);
    return lane < 32 ? v * cs.x - partner * cs.y : partner * cs.y + v * cs.x;
}
__device__ __forceinline__ void head8_load(const bf16_t* p, float (&v)[8]) {
    const u32x4 q = *(const u32x4*)p;
    v[0] = bf_lo(q.x); v[1] = bf_hi(q.x); v[2] = bf_lo(q.y); v[3] = bf_hi(q.y); v[4] = bf_lo(q.z); v[5] = bf_hi(q.z); v[6] = bf_lo(q.w); v[7] = bf_hi(q.w);
}
__device__ __forceinline__ void head8_store(bf16_t* p, const float (&v)[8], const float sc) {
    u32x4 q; q.x = pk2(v[0] * sc, v[1] * sc); q.y = pk2(v[2] * sc, v[3] * sc); q.z = pk2(v[4] * sc, v[5] * sc); q.w = pk2(v[6] * sc, v[7] * sc);
    *(u32x4*)p = q;
}
__device__ __forceinline__ void head8_norm(float (&v)[8], const float (&g)[8]) {
    float ss = 0.f;
#pragma unroll
    for (int j = 0; j < 8; ++j) ss += v[j] * v[j];
    ss = sum8_f(ss);
    const float r = 1.0f / sqrtf(ss * (1.f / 64.f) + 1e-6f);
#pragma unroll
    for (int j = 0; j < 8; ++j) v[j] = v[j] * r * g[j];
}
__device__ __forceinline__ void head8_rope(float (&v)[8], const f32x2 (&cs)[8], const bool upper) {
#pragma unroll
    for (int j = 0; j < 8; ++j) { const float partner = __shfl_xor(v[j], 4); v[j] = upper ? partner * cs[j].y + v[j] * cs[j].x : v[j] * cs[j].x - partner * cs[j].y; }
}
__device__ __forceinline__ void p_l0_prep(const Frame& F, const Args& a, unsigned char* ws) {
    const bf16_t* P = (const bf16_t*)(ws + WS_PROJ);
    const f32x2* rope = (const f32x2*)(ws + WS_ROPE);
    bf16_t* QA = (bf16_t*)(ws + L0_QA); bf16_t* IQ = (bf16_t*)(ws + L0_IQ); bf16_t* KA = (bf16_t*)(ws + L0_KA); bf16_t* VAT = (bf16_t*)(ws + L0_VAT);
    bf16_t* IK = (bf16_t*)(ws + L0_IK); float* IW = (float*)(ws + L0_IW); bf16_t* UA = (bf16_t*)(ws + L0_UA);
    const int gw = F.bid * NWAVES + F.wave, NGW = F.G * NWAVES, lane = F.lane, hs = lane >> 3, sub = lane & 7;
    float qg[8], kg[8];
#pragma unroll
    for (int j = 0; j < 8; ++j) { qg[j] = a.in[I_L0_QG][sub * 8 + j]; kg[j] = a.in[I_L0_KG][sub * 8 + j]; }
    for (int m = gw; m < T; m += NGW) {
        const int b = m >> 12, t = m & 4095;
        const bf16_t* row = P + (size_t)m * N_IN0;
        f32x2 cs[8];
#pragma unroll
        for (int j = 0; j < 4; ++j) { const f32x4 c4 = *(const f32x4*)(rope + t * 32 + (sub & 3) * 8 + 2 * j); cs[2 * j] = (f32x2){c4.x, c4.y}; cs[2 * j + 1] = (f32x2){c4.z, c4.w}; }
        float v[8];
        head8_load(row + C0_Q + lane * 8, v); head8_norm(v, qg); head8_rope(v, cs, sub >= 4); head8_store(QA + (size_t)m * 512 + lane * 8, v, 0.125f);
        head8_load(row + C0_IQ + lane * 8, v); head8_rope(v, cs, sub >= 4); head8_store(IQ + (size_t)m * 512 + lane * 8, v, 0.125f);
        {
            const int hh = hs < 3 ? hs : 2;
            head8_load(row + (hh < 2 ? C0_K + hh * 64 : C0_IK) + sub * 8, v);
            float vn[8];
#pragma unroll
            for (int j = 0; j < 8; ++j) vn[j] = v[j];
            head8_norm(vn, kg);
#pragma unroll
            for (int j = 0; j < 8; ++j) v[j] = (hh < 2) ? vn[j] : v[j];
            head8_rope(v, cs, sub >= 4);
            if (hs < 2) head8_store(KA + ((size_t)(b * 2 + hs) * 4096 + t) * 64 + sub * 8, v, 1.0f);
            else if (hs == 2) head8_store(IK + (size_t)m * 64 + sub * 8, v, 1.0f);
        }
        if (lane < 8) IW[(size_t)m * 8 + lane] = bf2f(row[C0_IW + lane]) * 0.35355339059327373f;
        { const u32x4 uv = *(const u32x4*)(row + C0_U + lane * 8); const int g = lane >> 1;
          *(u32x4*)(UA + ((size_t)g * 2048 + (m >> 4)) * 384 + (m & 15) * 16 + (lane & 1) * 8) = uv; }
    }
    for (int it = gw; it < NB * 2 * 64; it += NGW) {
        const int tb = it & 63, g = (it >> 6) & 1, b = it >> 7;
        const size_t m = (size_t)b * 4096 + tb * 64 + lane;
        unsigned r[32];
#pragma unroll
        for (int j = 0; j < 8; ++j) { const u32x4 q = *(const u32x4*)(P + m * N_IN0 + C0_V + g * 64 + j * 8); r[4 * j] = q.x; r[4 * j + 1] = q.y; r[4 * j + 2] = q.z; r[4 * j + 3] = q.w; }
        bf16_t* dst = VAT + ((size_t)(b * 2 + g) * 64) * 4096 + tb * 64 + lane;
#pragma unroll
        for (int d = 0; d < 64; ++d) dst[(size_t)d * 4096] = (bf16_t)((d & 1) ? (r[d >> 1] >> 16) : (r[d >> 1] & 0xffffu));
    }
}

__device__ __forceinline__ unsigned f16key(unsigned raw) { return (raw & 0x8000u) ? (~raw & 0xFFFFu) : (raw | 0x8000u); }
template <int NREG>
__device__ __forceinline__ int topk_count_ge(const unsigned (&kk)[NREG], const unsigned cm1pk) {
    unsigned acc = 0u; const unsigned ones = 0x00010001u;
#pragma unroll
    for (int jj = 0; jj < NREG; ++jj) {
        unsigned d;
        asm("v_pk_sub_u16 %0, %1, %2 clamp" : "=v"(d) : "v"(kk[jj]), "v"(cm1pk));
        asm("v_pk_min_u16 %0, %1, %2" : "=v"(d) : "v"(d), "v"(ones));
        asm("v_pk_add_u16 %0, %1, %2" : "=v"(acc) : "v"(acc), "v"(d));
    }
    int c = (int)((acc & 0xffffu) + (acc >> 16));
    c += __builtin_amdgcn_update_dpp(0, c, 0xB1, 0xF, 0xF, true);
    c += __builtin_amdgcn_update_dpp(0, c, 0x4E, 0xF, 0xF, true);
    c += __builtin_amdgcn_update_dpp(0, c, 0x141, 0xF, 0xF, true);
    c += __builtin_amdgcn_update_dpp(0, c, 0x140, 0xF, 0xF, true);
    return __builtin_amdgcn_readlane(c, 0) + __builtin_amdgcn_readlane(c, 16) + __builtin_amdgcn_readlane(c, 32) + __builtin_amdgcn_readlane(c, 48);
}
template <int NREG>
__device__ __forceinline__ u64 topk_query(const LAS unsigned short* scq, const int t, const int lane) {
    unsigned kk[NREG];
#pragma unroll
    for (int jj = 0; jj < NREG; ++jj) {
        const int e0 = (2 * jj) * 64 + lane, e1 = e0 + 64;
        const unsigned r0 = scq[e0], r1 = scq[e1];
        kk[jj] = ((e0 <= t) ? f16key(r0) : 0u) | (((e1 <= t) ? f16key(r1) : 0u) << 16);
        if ((jj & 3) == 3) __builtin_amdgcn_sched_barrier(0);
    }
    unsigned prefix = 0u; bool exact = false;
#pragma unroll 1
    for (int bit = 15; bit >= 0; --bit) {
        const unsigned cand = prefix | (1u << bit), cm1 = cand - 1u;
        const int cnt = topk_count_ge<NREG>(kk, cm1 | (cm1 << 16));
        if (cnt >= 256) prefix = cand;
        if (cnt == 256) { exact = true; break; }
    }
    unsigned mylo = 0u, myhi = 0u;
    if (exact) {
#pragma unroll
        for (int i = 0; i < 2 * NREG; ++i) {
            const unsigned k = (i & 1) ? (kk[i >> 1] >> 16) : (kk[i >> 1] & 0xffffu);
            const u64 w = __ballot(k >= prefix);
            asm("s_nop 4\n\tv_writelane_b32 %0, %2, %4\n\tv_writelane_b32 %1, %3, %4" : "+v"(mylo), "+v"(myhi) : "s"((unsigned)w), "s"((unsigned)(w >> 32)), "n"(i));
        }
    } else {
        const unsigned Tk = prefix;
        const int cgt = (Tk >= 0xFFFFu) ? 0 : topk_count_ge<NREG>(kk, Tk | (Tk << 16));
        const int need = 256 - cgt;
        int run = 0;
#pragma unroll
        for (int i = 0; i < 2 * NREG; ++i) {
            const unsigned k = (i & 1) ? (kk[i >> 1] >> 16) : (kk[i >> 1] & 0xffffu);
            const u64 gt = __ballot(k > Tk); u64 eq = __ballot(k == Tk);
            const int pe = __builtin_popcountll(eq);
            if (run + pe > need) { int kq = need - run; kq = kq < 0 ? 0 : kq;
                const bool keep = ((eq >> lane) & 1ull) && (__builtin_popcountll(eq & ((1ull << lane) - 1ull)) < kq); eq = __ballot(keep); }
            run += pe;
            const u64 w = gt | eq;
            asm("s_nop 4\n\tv_writelane_b32 %0, %2, %4\n\tv_writelane_b32 %1, %3, %4" : "+v"(mylo), "+v"(myhi) : "s"((unsigned)w), "s"((unsigned)(w >> 32)), "n"(i));
        }
    }
    return (u64)mylo | ((u64)myhi << 32);
}
__device__ __forceinline__ void p_dsa_index(const Frame& F, unsigned char* ws, u64* SELT, const int mode) {
    const bf16_t* IQ = (const bf16_t*)(ws + L0_IQ); const bf16_t* IK = (const bf16_t*)(ws + L0_IK); const float* IW = (const float*)(ws + L0_IW);
    LAS _Float16* sc = (LAS _Float16*)F.lds;
    LAS unsigned short* scu = (LAS unsigned short*)F.lds;
    LAS u64* mk = (LAS u64*)(F.lds + 131072);
    LAS float* wl = (LAS float*)(F.lds + 131072 + 8192);
    const int lane = F.lane, wave = F.wave, h = lane >> 5, r = lane & 31;
    const int rq = ((r >> 4) & 1) + 2 * ((r >> 2) & 1), rh = 4 * ((r >> 3) & 1) + (r & 3);
    for (int u = F.bid; u < 2048; u += F.G) {
        const int idx = u & 255, b = u >> 8;
        const int j = (b & 1) ? 255 - idx : idx;
        const int t0 = j * 16; const size_t mb = (size_t)b * 4096;
        if (F.tid < 128) wl[F.tid] = IW[(mb + t0) * 8 + F.tid];
        const int nkb = (t0 + 15) / 32 + 1;
        bf16x8 Af[4][4];
#pragma unroll
        for (int rt = 0; rt < 4; ++rt)
#pragma unroll
            for (int ks = 0; ks < 4; ++ks) Af[rt][ks] = *(const bf16x8*)(IQ + (mb + t0 + 4 * rt + rq) * 512 + rh * 64 + ks * 16 + 8 * h);
        __syncthreads();
        if (mode != 2) for (int kb = wave; kb < nkb; kb += NWAVES) {
            bf16x8 Bf[4];
#pragma unroll
            for (int ks = 0; ks < 4; ++ks) Bf[ks] = *(const bf16x8*)(IK + (mb + kb * 32 + r) * 64 + ks * 16 + 8 * h);
#pragma unroll
            for (int rt = 0; rt < 4; ++rt) {
                f32x16 acc = {0.f, 0.f, 0.f, 0.f, 0.f, 0.f, 0.f, 0.f, 0.f, 0.f, 0.f, 0.f, 0.f, 0.f, 0.f, 0.f};
#pragma unroll
                for (int ks = 0; ks < 4; ++ks) acc = __builtin_amdgcn_mfma_f32_32x32x16_bf16(Af[rt][ks], Bf[ks], acc, 0, 0, 0);
                const int qa = 4 * rt + 2 * h;
                const f32x4 wa0 = *(const LAS f32x4*)(wl + qa * 8), wa1 = *(const LAS f32x4*)(wl + qa * 8 + 4), wb0 = *(const LAS f32x4*)(wl + qa * 8 + 8), wb1 = *(const LAS f32x4*)(wl + qa * 8 + 12);
                float sa = 0.f, sb = 0.f;
#pragma unroll
                for (int i = 0; i < 4; ++i) { sa += wa0[i] * fmaxf(acc[i], 0.f); sa += wa1[i] * fmaxf(acc[4 + i], 0.f); sb += wb0[i] * fmaxf(acc[8 + i], 0.f); sb += wb1[i] * fmaxf(acc[12 + i], 0.f); }
                sc[qa * 4096 + kb * 32 + r] = (_Float16)sa;
                sc[(qa + 1) * 4096 + kb * 32 + r] = (_Float16)sb;
                __builtin_amdgcn_sched_barrier(0);
            }
        }
        __syncthreads();
#pragma unroll 1
        for (int qq = 0; qq < (mode == 1 ? 0 : 2); ++qq) {
            const int q = wave * 2 + qq, t = t0 + q, n = t + 1;
            unsigned mylo = 0u, myhi = 0u;
            if (n <= 256) {
                const int base = lane * 64;
                const u64 word = (base + 63 <= t) ? ~0ull : (base > t ? 0ull : ((1ull << (t - base + 1)) - 1ull));
                mylo = (unsigned)word; myhi = (unsigned)(word >> 32);
            } else {
                const int nreg = (((n + 63) >> 6) + 1) >> 1;
                const LAS unsigned short* scq = scu + q * 4096;
                u64 w;
                if (nreg <= 4) w = topk_query<4>(scq, t, lane);
                else if (nreg <= 8) w = topk_query<8>(scq, t, lane);
                else if (nreg <= 12) w = topk_query<12>(scq, t, lane);
                else if (nreg <= 16) w = topk_query<16>(scq, t, lane);
                else if (nreg <= 20) w = topk_query<20>(scq, t, lane);
                else if (nreg <= 24) w = topk_query<24>(scq, t, lane);
                else if (nreg <= 28) w = topk_query<28>(scq, t, lane);
                else w = topk_query<32>(scq, t, lane);
                mylo = (unsigned)w; myhi = (unsigned)(w >> 32);
            }
            mk[lane * 16 + q] = (u64)mylo | ((u64)myhi << 32);
        }
        __syncthreads();
        { const int w = F.tid >> 3, part = F.tid & 7;
          u64* dst = SELT + ((size_t)(b * 64 + w) * 4096) + t0 + part * 2;
          dst[0] = mk[w * 16 + part * 2]; dst[1] = mk[w * 16 + part * 2 + 1]; }
        __syncthreads();
    }
}

constexpr int AT_KB = 9216, AT_VB = 8704, AT_BUF = AT_KB + AT_VB;
struct AttStage { u32x4 kreg, vreg; };
__device__ __forceinline__ void att_load(AttStage& s, const bf16_t* Kg, const bf16_t* Vtg, int key0, int tid) {
    s.kreg = *(const u32x4*)(Kg + (size_t)(key0 + (tid >> 3)) * 64 + (tid & 7) * 8);
    s.vreg = *(const u32x4*)(Vtg + (size_t)(tid >> 3) * 4096 + key0 + (tid & 7) * 8);
}
__device__ __forceinline__ void att_store(const AttStage& s, LAS unsigned char* buf, int tid) {
    *(LAS u32x4*)(buf + (tid >> 3) * 144 + (tid & 7) * 16) = s.kreg;
    LAS unsigned char* v = buf + AT_KB + (tid >> 3) * 136 + (tid & 7) * 16;
    *(LAS u32x2*)(v) = (u32x2){s.vreg.x, s.vreg.y}; *(LAS u32x2*)(v + 8) = (u32x2){s.vreg.z, s.vreg.w};
}
__device__ __forceinline__ bf16x8 pack8(float a0, float a1, float a2, float a3, float a4, float a5, float a6, float a7) {
    u32x4 w; w.x = pg8::cvt_pk_bf16(a0, a1); w.y = pg8::cvt_pk_bf16(a2, a3); w.z = pg8::cvt_pk_bf16(a4, a5); w.w = pg8::cvt_pk_bf16(a6, a7);
    return __builtin_bit_cast(bf16x8, w);
}
__device__ __forceinline__ f32x16 att_qk(const LAS unsigned char* buf, int sub, const bf16x8 (&Qf)[4], int lane) {
    f32x16 S = {0.f, 0.f, 0.f, 0.f, 0.f, 0.f, 0.f, 0.f, 0.f, 0.f, 0.f, 0.f, 0.f, 0.f, 0.f, 0.f};
    const LAS unsigned char* kp = buf + (sub * 32 + (lane & 31)) * 144 + (lane >> 5) * 16;
#pragma unroll
    for (int ks = 0; ks < 4; ++ks) { const bf16x8 kf = *(const LAS bf16x8*)(kp + ks * 32); S = __builtin_amdgcn_mfma_f32_32x32x16_bf16(kf, Qf[ks], S, 0, 0, 0); }
    return S;
}
__device__ __forceinline__ void att_pv2(const LAS unsigned char* buf, int sub, const bf16x8 P0, const bf16x8 P1, f32x16 (&O)[2], int lane) {
    const int h = lane >> 5;
#pragma unroll
    for (int dt = 0; dt < 2; ++dt) {
        const LAS unsigned char* vp = buf + AT_KB + (dt * 32 + (lane & 31)) * 136 + (sub * 32 + 4 * h) * 2;
        const u32x2 a0 = *(const LAS u32x2*)(vp), a1 = *(const LAS u32x2*)(vp + 16), b0 = *(const LAS u32x2*)(vp + 32), b1 = *(const LAS u32x2*)(vp + 48);
        const bf16x8 V0 = __builtin_bit_cast(bf16x8, ((u32x4){a0.x, a0.y, a1.x, a1.y}));
        const bf16x8 V1 = __builtin_bit_cast(bf16x8, ((u32x4){b0.x, b0.y, b1.x, b1.y}));
        O[dt] = __builtin_amdgcn_mfma_f32_32x32x16_bf16(V0, P0, O[dt], 0, 0, 0);
        O[dt] = __builtin_amdgcn_mfma_f32_32x32x16_bf16(V1, P1, O[dt], 0, 0, 0);
    }
}
__device__ __forceinline__ void att_pv(const LAS unsigned char* buf, int sub, const float (&p)[16], f32x16 (&O)[2], int lane) {
    const bf16x8 P0 = pack8(p[0], p[1], p[2], p[3], p[4], p[5], p[6], p[7]);
    const bf16x8 P1 = pack8(p[8], p[9], p[10], p[11], p[12], p[13], p[14], p[15]);
    att_pv2(buf, sub, P0, P1, O, lane);
}

__device__ __forceinline__ void att_kfrags(const LAS unsigned char* buf, int sub, bf16x8 (&Kf)[4], int lane) {
    const LAS unsigned char* kp = buf + (sub * 32 + (lane & 31)) * 144 + (lane >> 5) * 16;
#pragma unroll
    for (int ks = 0; ks < 4; ++ks) Kf[ks] = *(const LAS bf16x8*)(kp + ks * 32);
}
__device__ __forceinline__ void att_vfrags(const LAS unsigned char* buf, int sub, bf16x8 (&Vf)[2][2], int lane) {
    const int h = lane >> 5;
#pragma unroll
    for (int dt = 0; dt < 2; ++dt) {
        const LAS unsigned char* vp = buf + AT_KB + (dt * 32 + (lane & 31)) * 136 + (sub * 32 + 4 * h) * 2;
        const u32x2 a0 = *(const LAS u32x2*)(vp), a1 = *(const LAS u32x2*)(vp + 16), b0 = *(const LAS u32x2*)(vp + 32), b1 = *(const LAS u32x2*)(vp + 48);
        Vf[dt][0] = __builtin_bit_cast(bf16x8, ((u32x4){a0.x, a0.y, a1.x, a1.y}));
        Vf[dt][1] = __builtin_bit_cast(bf16x8, ((u32x4){b0.x, b0.y, b1.x, b1.y}));
    }
}
__device__ __forceinline__ f32x16 att_qk_f(const bf16x8 (&Kf)[4], const bf16x8 (&Qf)[4]) {
    f32x16 S = {0.f, 0.f, 0.f, 0.f, 0.f, 0.f, 0.f, 0.f, 0.f, 0.f, 0.f, 0.f, 0.f, 0.f, 0.f, 0.f};
#pragma unroll
    for (int ks = 0; ks < 4; ++ks) S = __builtin_amdgcn_mfma_f32_32x32x16_bf16(Kf[ks], Qf[ks], S, 0, 0, 0);
    return S;
}
__device__ __forceinline__ void att_pv_f(const bf16x8 (&Vf)[2][2], const bf16x8 P0, const bf16x8 P1, f32x16 (&O)[2]) {
#pragma unroll
    for (int dt = 0; dt < 2; ++dt) { O[dt] = __builtin_amdgcn_mfma_f32_32x32x16_bf16(Vf[dt][0], P0, O[dt], 0, 0, 0); O[dt] = __builtin_amdgcn_mfma_f32_32x32x16_bf16(Vf[dt][1], P1, O[dt], 0, 0, 0); }
}

__device__ __forceinline__ void p_dsa_attn(const Frame& F, const Args& a, unsigned char* ws) {
    const bf16_t* QA = (const bf16_t*)(ws + L0_QA); const bf16_t* KA = (const bf16_t*)(ws + L0_KA); const bf16_t* VAT = (const bf16_t*)(ws + L0_VAT);
    const u64* SELT = (const u64*)(ws + L0_SELT); bf16_t* CAT = (bf16_t*)(ws + L0_CAT);
    const int lane = F.lane, wave = F.wave, h = lane >> 5, c = lane & 31, tid = F.tid;
    float mq = 0.f, mk_ = 0.f;
    for (int i = 0; i < 64; ++i) { mq = fmaxf(mq, fabsf(a.in[I_L0_QG][i])); mk_ = fmaxf(mk_, fabsf(a.in[I_L0_KG][i])); }
    const float c2 = (8.0f * mq * mk_ + 0.5f) * 1.4426950408889634f, c1 = 1.4426950408889634f;
    for (int u = F.bid; u < 512; u += F.G) {
        const int idx = u & 255, g = u >> 8, b = idx >> 5, qtr = idx & 31, qt = g ? 31 - qtr : qtr, q0 = qt * 128;
        const size_t mb = (size_t)b * 4096;
        const bf16_t* Kg = KA + (size_t)(b * 2 + g) * 4096 * 64; const bf16_t* Vtg = VAT + (size_t)(b * 2 + g) * 64 * 4096;
        bf16x8 Qf[2][4]; int qidx[2];
#pragma unroll
        for (int ct = 0; ct < 2; ++ct) { qidx[ct] = q0 + wave * 16 + ct * 8 + (c >> 2);
#pragma unroll
            for (int ks = 0; ks < 4; ++ks) Qf[ct][ks] = *(const bf16x8*)(QA + (mb + qidx[ct]) * 512 + (g * 4 + (c & 3)) * 64 + ks * 16 + 8 * h); }
        f32x16 O[2][2]; float l[2] = {0.f, 0.f};
#pragma unroll
        for (int ct = 0; ct < 2; ++ct)
#pragma unroll
            for (int dt = 0; dt < 2; ++dt)
#pragma unroll
                for (int i = 0; i < 16; ++i) O[ct][dt][i] = 0.f;
        const int nkt = 2 * qt + 2;
        AttStage st; att_load(st, Kg, Vtg, 0, tid);
        __syncthreads();
        att_store(st, F.lds, tid);
        __syncthreads();
        for (int kt = 0; kt < nkt; ++kt) {
            LAS unsigned char* buf = F.lds + (kt & 1) * AT_BUF;
            if (kt + 1 < nkt) att_load(st, Kg, Vtg, (kt + 1) * 64, tid);
            u64 mw[2];
#pragma unroll
            for (int ct = 0; ct < 2; ++ct) mw[ct] = SELT[(size_t)(b * 64 + kt) * 4096 + qidx[ct]];
#pragma unroll 1
            for (int sub = 0; sub < 2; ++sub) {
                bf16x8 Kf[4], Vf[2][2];
                att_kfrags(buf, sub, Kf, lane); att_vfrags(buf, sub, Vf, lane);
#pragma unroll
                for (int ct = 0; ct < 2; ++ct) {
                    __builtin_amdgcn_sched_barrier(0);
                    const f32x16 S = att_qk_f(Kf, Qf[ct]);
                    const unsigned mbits = (unsigned)(mw[ct] >> (sub * 32 + 4 * h));
                    float p[16];
#pragma unroll
                    for (int i = 0; i < 16; ++i) {
                        const float e = __builtin_amdgcn_exp2f(S[i] * c1 - c2);
                        const int bitpos = (i & 3) + 8 * (i >> 2);
                        p[i] = __builtin_bit_cast(float, __builtin_bit_cast(int, e) & __builtin_amdgcn_sbfe((int)mbits, bitpos, 1));
                        l[ct] += p[i];
                    }
                    att_pv_f(Vf, pack8(p[0], p[1], p[2], p[3], p[4], p[5], p[6], p[7]), pack8(p[8], p[9], p[10], p[11], p[12], p[13], p[14], p[15]), O[ct]);
                }
            }
            if (kt + 1 < nkt) att_store(st, F.lds + ((kt + 1) & 1) * AT_BUF, tid);
            __syncthreads();
        }
#pragma unroll
        for (int ct = 0; ct < 2; ++ct) {
            const float lt = l[ct] + __shfl_xor(l[ct], 32);
            const float inv = 1.0f / fmaxf(lt, 1e-30f);
            bf16_t* orow = CAT + (mb + qidx[ct]) * 1024 + (g * 4 + (c & 3)) * 64;
#pragma unroll
            for (int dt = 0; dt < 2; ++dt)
#pragma unroll
                for (int i4 = 0; i4 < 4; ++i4) {
                    const int d = dt * 32 + 8 * i4 + 4 * h;
                    u32x2 w; w.x = pk2(O[ct][dt][4 * i4] * inv, O[ct][dt][4 * i4 + 1] * inv); w.y = pk2(O[ct][dt][4 * i4 + 2] * inv, O[ct][dt][4 * i4 + 3] * inv);
                    *(u32x2*)(orow + d) = w;
                }
        }
    }
}

__device__ __forceinline__ void p_s5_scan(const Frame& F, const Args& a, unsigned char* ws) {
    const float* SLOC = (const float*)(ws + L0_SLOC); bf16_t* UA = (bf16_t*)(ws + L0_UA);
    const int p = F.lane;
    if (F.wave == 0) for (int it = F.bid; it < 32 * NB; it += F.G) {
        const int g = it >> 3, b = it & 7;
        const float dt = expf(a.in[I_L0_LOGDT][g]);
        const float lr = a.in[I_L0_ARE][g * 64 + p], li = a.in[I_L0_AIM][g * 64 + p];
        const float mag = expf(16.0f * dt * lr); float s, c; sincosf(16.0f * dt * li, &s, &c);
        const float ar = mag * c, ai = mag * s;
        float hr = 0.f, hi = 0.f;
        const float* sl = SLOC + ((size_t)g * 2048 + b * 256) * 128;
        bf16_t* ua = UA + ((size_t)g * 2048 + b * 256) * 384 + 256;
        for (int ch = 0; ch < 256; ++ch) {
            ua[(size_t)ch * 384 + p] = (bf16_t)f2bf(hr); ua[(size_t)ch * 384 + 64 + p] = (bf16_t)f2bf(hi);
            const float xr = sl[(size_t)ch * 128 + p], xi = sl[(size_t)ch * 128 + 64 + p];
            const float nr = ar * hr - ai * hi + xr, ni = ar * hi + ai * hr + xi;
            hr = nr; hi = ni;
        }
    }
}
namespace pg8 {
struct EpiS5State {
    static constexpr bool PERM = false;
    float* C;
    __device__ __forceinline__ void operator()(const f32x4 (&acc)[2][2][4][2], const Unit& u, int wr, int wc, int fr, int fq) const {
        const int row0 = u.pm * BM + wr * 64 + fr, col0 = wc * 32 + 4 * fq;
#pragma unroll
        for (int ai = 0; ai < 2; ++ai)
#pragma unroll
            for (int m = 0; m < 4; ++m)
#pragma unroll
                for (int n = 0; n < 2; ++n) *(f32x4*)(C + (size_t)(row0 + ai * HALF + m * 16) * 128 + col0 + n * 16) = acc[ai][0][m][n];
    }
};
struct EpiS5Out {
    static constexpr bool PERM = false;
    bf16_t* YB;
    __device__ __forceinline__ void operator()(const f32x4 (&acc)[2][2][4][2], const Unit& u, int wr, int wc, int fr, int fq) const {
        const int g = u.pn;
        const int row0 = u.pm * BM + wr * 64 + fr - g * 2048;
        const int col0 = wc * 32 + 4 * fq;
#pragma unroll
        for (int ai = 0; ai < 2; ++ai)
#pragma unroll
            for (int m = 0; m < 4; ++m) { const int chunk = row0 + ai * HALF + m * 16;
#pragma unroll
                for (int bj = 0; bj < 2; ++bj)
#pragma unroll
                    for (int n = 0; n < 2; ++n) { const int col = col0 + bj * HALF + n * 16, i = col >> 4, co = col & 15;
                        const f32x4 v = acc[ai][bj][m][n];
                        u32x2 w; w.x = pk2(gelu_tanh(v[0]), gelu_tanh(v[1])); w.y = pk2(gelu_tanh(v[2]), gelu_tanh(v[3]));
                        *(u32x2*)(YB + ((size_t)chunk * 16 + i) * 512 + g * 16 + co) = w; }
                asm volatile("" ::: "memory"); __builtin_amdgcn_sched_barrier(0); }
    }
};
struct EpiGlu {
    static constexpr bool PERM = true;
    const bf16_t* YB; const float* bias; bf16_t* CAT;
    __device__ __forceinline__ void operator()(const f32x4 (&acc)[2][2][4][2], const Unit& u, int wr, int wc, int fr, int fq) const {
        const int row0 = u.pm * BM + wr * 64 + fr, col0 = u.pn * BM + wc * 32 + 8 * fq;
#pragma unroll
        for (int ai = 0; ai < 2; ++ai)
#pragma unroll
            for (int m = 0; m < 4; ++m) { const size_t row = row0 + ai * HALF + m * 16;
#pragma unroll
                for (int bj = 0; bj < 2; ++bj) { const int col = col0 + bj * HALF;
                    const u32x4 yv = *(const u32x4*)(YB + row * 512 + col);
                    const f32x4 b0 = *(const f32x4*)(bias + col), b1 = *(const f32x4*)(bias + col + 4);
                    const f32x4 z0 = acc[ai][bj][m][0] + b0, z1 = acc[ai][bj][m][1] + b1;
                    u32x4 w;
                    w.x = pk2(bf_lo(yv.x) * sigmoidf_(z0[0]), bf_hi(yv.x) * sigmoidf_(z0[1])); w.y = pk2(bf_lo(yv.y) * sigmoidf_(z0[2]), bf_hi(yv.y) * sigmoidf_(z0[3]));
                    w.z = pk2(bf_lo(yv.z) * sigmoidf_(z1[0]), bf_hi(yv.z) * sigmoidf_(z1[1])); w.w = pk2(bf_lo(yv.w) * sigmoidf_(z1[2]), bf_hi(yv.w) * sigmoidf_(z1[3]));
                    *(u32x4*)(CAT + row * 1024 + 512 + col) = w; }
                asm volatile("" ::: "memory"); __builtin_amdgcn_sched_barrier(0); }
    }
};
}
__device__ __forceinline__ void peer_fold_wq(const Frame& F, const float* wq, const float* sk, bf16_t* WT) {
    const int gw = F.bid * NWAVES + F.wave, NGW = F.G * NWAVES, lane = F.lane, r = lane & 31, h = lane >> 5;
    for (int it = gw; it < 16 * 4 * 32; it += NGW) {
        const int dt = it & 31, kt = (it >> 5) & 3, hp = it >> 7;
        f32x16 acc = {0.f, 0.f, 0.f, 0.f, 0.f, 0.f, 0.f, 0.f, 0.f, 0.f, 0.f, 0.f, 0.f, 0.f, 0.f, 0.f};
        const float* ap = sk + ((size_t)hp * 128 + 32 * kt + r) * 128 + 8 * h;
        const float* bp = wq + (size_t)(32 * dt + r) * 2048 + hp * 128 + 8 * h;
#pragma unroll
        for (int ks = 0; ks < 8; ++ks) {
            const f32x4 a0 = *(const f32x4*)(ap + 16 * ks), a1 = *(const f32x4*)(ap + 16 * ks + 4), b0 = *(const f32x4*)(bp + 16 * ks), b1 = *(const f32x4*)(bp + 16 * ks + 4);
            acc = __builtin_amdgcn_mfma_f32_32x32x16_bf16(pack8(a0[0], a0[1], a0[2], a0[3], a1[0], a1[1], a1[2], a1[3]), pack8(b0[0], b0[1], b0[2], b0[3], b1[0], b1[1], b1[2], b1[3]), acc, 0, 0, 0);
        }
#pragma unroll
        for (int i = 0; i < 16; ++i) WT[((size_t)hp * 128 + 32 * kt + (i & 3) + 8 * (i >> 2) + 4 * h) * 1024 + 32 * dt + r] = (bf16_t)f2bf(acc[i]);
    }
}
__device__ __forceinline__ unsigned mono_u32(float f) { const unsigned u = __builtin_bit_cast(unsigned, f); return u ^ ((u >> 31) ? 0xFFFFFFFFu : 0x80000000u); }
#define CE_DESC(x, y) do { const unsigned _hi = (x) > (y) ? (x) : (y), _lo = (x) > (y) ? (y) : (x); (x) = _hi; (y) = _lo; } while (0)
__device__ __forceinline__ void sort16_desc(unsigned (&a)[16]) {
#pragma unroll
    for (int k = 2; k <= 16; k <<= 1)
#pragma unroll
        for (int j = k >> 1; j > 0; j >>= 1)
#pragma unroll
            for (int i = 0; i < 16; ++i) { const int l = i ^ j; if (l > i) { if ((i & k) == 0) CE_DESC(a[i], a[l]); else CE_DESC(a[l], a[i]); } }
}
__device__ __forceinline__ void merge16_desc(unsigned (&a)[16], const unsigned (&b)[16]) {
#pragma unroll
    for (int i = 0; i < 16; ++i) a[i] = a[i] > b[15 - i] ? a[i] : b[15 - i];
#pragma unroll
    for (int j = 8; j > 0; j >>= 1)
#pragma unroll
        for (int i = 0; i < 16; ++i) { const int l = i ^ j; if (l > i) CE_DESC(a[i], a[l]); }
}
__device__ __forceinline__ void merge16_xlane(unsigned (&a)[16]) {
    unsigned b[16];
#pragma unroll
    for (int i = 0; i < 16; ++i) b[i] = (unsigned)__shfl_xor((int)a[i], 32);
    merge16_desc(a, b);
}
struct PeerCand { int a[50], b[50]; };
__host__ __device__ constexpr PeerCand peer_cands() { PeerCand c{}; int n = 0; for (int a = 0; a < 16; ++a) for (int b = 0; b < 16; ++b) if ((a + 1) * (b + 1) <= 16) { c.a[n] = a; c.b[n] = b; ++n; } return c; }
__device__ __forceinline__ void p_peer_route(const Frame& F, unsigned char* ws) {
    const _Float16* S16 = (const _Float16*)(ws + PE_Q2); unsigned short* EID = (unsigned short*)(ws + PE_EID); float* GATE = (float*)(ws + PE_GATE);
    LAS float* sc0 = (LAS float*)F.lds;
    const int lane = F.lane, wave = F.wave, h5 = lane >> 5, r = lane & 31, tid = F.tid;
    constexpr PeerCand PC = peer_cands();
    u32x4 pre[8];
    { const int u = F.bid; if (u < 2048) { const int hd = u & 7, mt = u >> 3;
#pragma unroll
        for (int q = 0; q < 8; ++q) pre[q] = *(const u32x4*)(S16 + ((size_t)mt * 128 + (q & 3) * 32 + (tid >> 4)) * 2048 + (hd * 2 + (q >> 2)) * 128 + (tid & 15) * 8); } }
    for (int u = F.bid; u < 2048; u += F.G) {
        const int hd = u & 7, mt = u >> 3; const size_t m0 = (size_t)mt * 128;
#pragma unroll
        for (int q = 0; q < 8; ++q) {
            LAS float* dst = sc0 + (q >> 2) * 128 * 129 + ((q & 3) * 32 + (tid >> 4)) * 129 + (tid & 15) * 8;
            const u32x4 v = pre[q];
#pragma unroll
            for (int j = 0; j < 4; ++j) { const unsigned w = v[j]; dst[2 * j] = (float)__builtin_bit_cast(_Float16, (unsigned short)(w & 0xffffu)); dst[2 * j + 1] = (float)__builtin_bit_cast(_Float16, (unsigned short)(w >> 16)); }
        }
        { const int un = u + F.G; if (un < 2048) { const int hdn = un & 7, mtn = un >> 3;
#pragma unroll
            for (int q = 0; q < 8; ++q) pre[q] = *(const u32x4*)(S16 + ((size_t)mtn * 128 + (q & 3) * 32 + (tid >> 4)) * 2048 + (hdn * 2 + (q >> 2)) * 128 + (tid & 15) * 8); } }
        __syncthreads();
        {
            const int pp = wave >> 2, row = (wave & 3) * 32 + r, half = h5; LAS float* rowp = sc0 + pp * 128 * 129 + row * 129;
            unsigned top[16];
#pragma unroll
            for (int blk = 0; blk < 4; ++blk) {
                unsigned k16[16];
#pragma unroll
                for (int i = 0; i < 16; ++i) { const int j = half * 64 + blk * 16 + i; k16[i] = (mono_u32(rowp[j]) & ~0x7Fu) | (unsigned)(127 - j); }
                sort16_desc(k16);
                if (blk == 0) {
#pragma unroll
                    for (int i = 0; i < 16; ++i) top[i] = k16[i];
                } else merge16_desc(top, k16);
            }
            merge16_xlane(top);
            float vals[16]; int ids[16];
#pragma unroll
            for (int k = 0; k < 16; ++k) { ids[k] = 127 - (int)(top[k] & 127u); vals[k] = rowp[ids[k]]; }
            if (half == 0) {
#pragma unroll
                for (int k = 0; k < 16; ++k) { rowp[k] = vals[k]; rowp[16 + k] = __int_as_float(ids[k]); }
            }
        }
        __syncthreads();
        if (tid < 256) {
            const int row = (wave & 3) * 32 + r, half = h5; const LAS float* s1 = sc0 + row * 129; const LAS float* s2 = sc0 + 128 * 129 + row * 129;
            float v1[16], v2[16];
#pragma unroll
            for (int k = 0; k < 16; ++k) { v1[k] = s1[k]; v2[k] = s2[k]; }
            unsigned top[16], k16[16];
#pragma unroll
            for (int i = 0; i < 16; ++i) { const int c0 = 2 * i, c1 = 2 * i + 1;
                const unsigned ka = (mono_u32(v1[PC.a[c0]] + v2[PC.b[c0]]) & ~0xFFu) | (unsigned)(255 - (PC.a[c0] * 16 + PC.b[c0]));
                const unsigned kb = (mono_u32(v1[PC.a[c1]] + v2[PC.b[c1]]) & ~0xFFu) | (unsigned)(255 - (PC.a[c1] * 16 + PC.b[c1]));
                top[i] = half ? kb : ka; }
#pragma unroll
            for (int i = 0; i < 16; ++i) { if (i < 9) { const int c0 = 32 + 2 * i, c1 = 32 + 2 * i + 1;
                    const unsigned ka = (mono_u32(v1[PC.a[c0]] + v2[PC.b[c0]]) & ~0xFFu) | (unsigned)(255 - (PC.a[c0] * 16 + PC.b[c0]));
                    const unsigned kb = (mono_u32(v1[PC.a[c1]] + v2[PC.b[c1]]) & ~0xFFu) | (unsigned)(255 - (PC.a[c1] * 16 + PC.b[c1]));
                    k16[i] = half ? kb : ka; } else k16[i] = 0u; }
            sort16_desc(top); sort16_desc(k16); merge16_desc(top, k16);
            merge16_xlane(top);
            if (half == 0) {
                float mx = -3.0e38f; float sv[16]; int eid[16];
#pragma unroll
                for (int k = 0; k < 16; ++k) { const int fl = 255 - (int)(top[k] & 255u), a = fl >> 4, b = fl & 15;
                    sv[k] = s1[a] + s2[b]; eid[k] = __float_as_int(s1[16 + a]) * 128 + __float_as_int(s2[16 + b]); mx = fmaxf(mx, sv[k]); }
                float den = 0.f;
#pragma unroll
                for (int k = 0; k < 16; ++k) { sv[k] = __expf(sv[k] - mx); den += sv[k]; }
                const float inv = 1.0f / den;
                unsigned short* ep = EID + (m0 + row) * 128 + hd * 16; float* gp = GATE + (m0 + row) * 128 + hd * 16;
#pragma unroll
                for (int k = 0; k < 16; ++k) { ep[k] = (unsigned short)eid[k]; gp[k] = sv[k] * inv; }
            }
        }
        __syncthreads();
    }
}

__device__ __forceinline__ float rdlane_f(float v, int l) { return __builtin_bit_cast(float, __builtin_amdgcn_readlane(__builtin_bit_cast(int, v), l)); }
__device__ __forceinline__ void p_peer_expert(const Frame& F, unsigned char* ws, float* xres) {
    const bf16_t* XN = (const bf16_t*)(ws + WS_XN); const bf16_t* TU = (const bf16_t*)(ws + WS_TABU); const bf16_t* TV = (const bf16_t*)(ws + WS_TABV);
    const unsigned short* EID = (const unsigned short*)(ws + PE_EID); const float* GATE = (const float*)(ws + PE_GATE);
    const int gw = F.bid * NWAVES + F.wave, NGW = F.G * NWAVES, lane = F.lane;
    for (int m = gw; m < T; m += NGW) {
        float xf[16];
        { const u32x4 xa = *(const u32x4*)(XN + (size_t)m * 1024 + lane * 8), xb = *(const u32x4*)(XN + (size_t)m * 1024 + 512 + lane * 8);
          xf[0] = bf_lo(xa.x); xf[1] = bf_hi(xa.x); xf[2] = bf_lo(xa.y); xf[3] = bf_hi(xa.y); xf[4] = bf_lo(xa.z); xf[5] = bf_hi(xa.z); xf[6] = bf_lo(xa.w); xf[7] = bf_hi(xa.w);
          xf[8] = bf_lo(xb.x); xf[9] = bf_hi(xb.x); xf[10] = bf_lo(xb.y); xf[11] = bf_hi(xb.y); xf[12] = bf_lo(xb.z); xf[13] = bf_hi(xb.z); xf[14] = bf_lo(xb.w); xf[15] = bf_hi(xb.w); }
        const int id0 = EID[(size_t)m * 128 + lane], id1 = EID[(size_t)m * 128 + 64 + lane];
        const float g0 = GATE[(size_t)m * 128 + lane], g1 = GATE[(size_t)m * 128 + 64 + lane];
        float outv[16];
#pragma unroll
        for (int i = 0; i < 16; ++i) outv[i] = 0.f;
#pragma unroll 1
        for (int k = 0; k < 16; ++k) {
            const int idreg = (k < 8) ? id0 : id1; const float greg = (k < 8) ? g0 : g1; const int lbase = (k & 7) * 8;
            int e[8];
#pragma unroll
            for (int i = 0; i < 8; ++i) e[i] = __builtin_amdgcn_readlane(idreg, lbase + i);
            float pr[8];
            {
                u32x4 ua[8], ub[8];
#pragma unroll
                for (int i = 0; i < 8; ++i) { ua[i] = *(const u32x4*)(TU + (size_t)e[i] * 1024 + lane * 8); ub[i] = *(const u32x4*)(TU + (size_t)e[i] * 1024 + 512 + lane * 8); }
#pragma unroll
                for (int i = 0; i < 8; ++i) {
                    float s = xf[0] * bf_lo(ua[i].x); s += xf[1] * bf_hi(ua[i].x); s += xf[2] * bf_lo(ua[i].y); s += xf[3] * bf_hi(ua[i].y);
                    s += xf[4] * bf_lo(ua[i].z); s += xf[5] * bf_hi(ua[i].z); s += xf[6] * bf_lo(ua[i].w); s += xf[7] * bf_hi(ua[i].w);
                    s += xf[8] * bf_lo(ub[i].x); s += xf[9] * bf_hi(ub[i].x); s += xf[10] * bf_lo(ub[i].y); s += xf[11] * bf_hi(ub[i].y);
                    s += xf[12] * bf_lo(ub[i].z); s += xf[13] * bf_hi(ub[i].z); s += xf[14] * bf_lo(ub[i].w); s += xf[15] * bf_hi(ub[i].w);
                    pr[i] = s;
                }
            }
            float r4[4], r2[2], r1;
            { const bool up = (lane & 32) != 0;
#pragma unroll
              for (int i = 0; i < 4; ++i) { const float keep = up ? pr[i + 4] : pr[i], send = up ? pr[i] : pr[i + 4]; r4[i] = keep + __shfl_xor(send, 32); } }
            { const bool up = (lane & 16) != 0;
#pragma unroll
              for (int i = 0; i < 2; ++i) { const float keep = up ? r4[i + 2] : r4[i], send = up ? r4[i] : r4[i + 2]; r2[i] = keep + __shfl_xor(send, 16); } }
            { const bool up = (lane & 8) != 0; const float keep = up ? r2[1] : r2[0], send = up ? r2[0] : r2[1]; r1 = keep + __shfl_xor(send, 8); }
            r1 += __shfl_xor(r1, 4); r1 += __shfl_xor(r1, 2); r1 += __shfl_xor(r1, 1);
            const float gv = __shfl(greg, lbase + (lane >> 3));
            const float coef = gv * gelu_tanh(r1);
            {
                u32x4 va[8], vb[8];
#pragma unroll
                for (int i = 0; i < 8; ++i) { va[i] = *(const u32x4*)(TV + (size_t)e[i] * 1024 + lane * 8); vb[i] = *(const u32x4*)(TV + (size_t)e[i] * 1024 + 512 + lane * 8); }
#pragma unroll
                for (int i = 0; i < 8; ++i) {
                    const float ci = rdlane_f(coef, i * 8);
                    outv[0] += ci * bf_lo(va[i].x); outv[1] += ci * bf_hi(va[i].x); outv[2] += ci * bf_lo(va[i].y); outv[3] += ci * bf_hi(va[i].y);
                    outv[4] += ci * bf_lo(va[i].z); outv[5] += ci * bf_hi(va[i].z); outv[6] += ci * bf_lo(va[i].w); outv[7] += ci * bf_hi(va[i].w);
                    outv[8] += ci * bf_lo(vb[i].x); outv[9] += ci * bf_hi(vb[i].x); outv[10] += ci * bf_lo(vb[i].y); outv[11] += ci * bf_hi(vb[i].y);
                    outv[12] += ci * bf_lo(vb[i].z); outv[13] += ci * bf_hi(vb[i].z); outv[14] += ci * bf_lo(vb[i].w); outv[15] += ci * bf_hi(vb[i].w);
                }
            }
        }
        f32x4* o = (f32x4*)(xres + (size_t)m * 1024 + lane * 8);
        f32x4 a0 = o[0], a1 = o[1], b0 = o[128], b1 = o[129];
        a0 += (f32x4){outv[0], outv[1], outv[2], outv[3]}; a1 += (f32x4){outv[4], outv[5], outv[6], outv[7]};
        b0 += (f32x4){outv[8], outv[9], outv[10], outv[11]}; b1 += (f32x4){outv[12], outv[13], outv[14], outv[15]};
        o[0] = a0; o[1] = a1; o[128] = b0; o[129] = b1;
    }
}

typedef __bf16 bf16x2_t __attribute__((ext_vector_type(2)));
__device__ __forceinline__ float dot2bf(unsigned a, unsigned b, float c) { return __builtin_amdgcn_fdot2_f32_bf16(__builtin_bit_cast(bf16x2_t, a), __builtin_bit_cast(bf16x2_t, b), c, false); }
__device__ __forceinline__ void peer_slot_range(const unsigned (&xp)[8], float (&outv)[16], int id0, int id1, float g0, float g1, int r,
                                                const bf16_t* TU, const bf16_t* TV, int lane) {
    u64 m0 = __ballot((id0 >> 9) == r), m1 = __ballot((id1 >> 9) == r);
    while (m0 | m1) {
        int e[8]; float gt[8];
#pragma unroll
        for (int i = 0; i < 8; ++i) {
            if (m0) { const int l = __builtin_ctzll(m0); m0 &= m0 - 1ull; e[i] = __builtin_amdgcn_readlane(id0, l); gt[i] = rdlane_f(g0, l); }
            else if (m1) { const int l = __builtin_ctzll(m1); m1 &= m1 - 1ull; e[i] = __builtin_amdgcn_readlane(id1, l); gt[i] = rdlane_f(g1, l); }
            else { e[i] = -1; gt[i] = 0.f; }
        }
        float pr[8];
        {
            u32x4 ua[8], ub[8];
#pragma unroll
            for (int i = 0; i < 8; ++i) {
                if (e[i] >= 0) { ua[i] = *(const u32x4*)(TU + (size_t)e[i] * 1024 + lane * 8); ub[i] = *(const u32x4*)(TU + (size_t)e[i] * 1024 + 512 + lane * 8); }
                else { ua[i] = (u32x4){0u, 0u, 0u, 0u}; ub[i] = (u32x4){0u, 0u, 0u, 0u}; }
            }
#pragma unroll
            for (int i = 0; i < 8; ++i) {
                float s = dot2bf(xp[0], ua[i].x, 0.f); s = dot2bf(xp[1], ua[i].y, s); s = dot2bf(xp[2], ua[i].z, s); s = dot2bf(xp[3], ua[i].w, s);
                s = dot2bf(xp[4], ub[i].x, s); s = dot2bf(xp[5], ub[i].y, s); s = dot2bf(xp[6], ub[i].z, s); s = dot2bf(xp[7], ub[i].w, s);
                pr[i] = s;
            }
        }
        float r4[4], r2[2], r1;
        { const bool up = (lane & 32) != 0;
#pragma unroll
          for (int i = 0; i < 4; ++i) { const float keep = up ? pr[i + 4] : pr[i], send = up ? pr[i] : pr[i + 4]; r4[i] = keep + __shfl_xor(send, 32); } }
        { const bool up = (lane & 16) != 0;
#pragma unroll
          for (int i = 0; i < 2; ++i) { const float keep = up ? r4[i + 2] : r4[i], send = up ? r4[i] : r4[i + 2]; r2[i] = keep + __shfl_xor(send, 16); } }
        { const bool up = (lane & 8) != 0; const float keep = up ? r2[1] : r2[0], send = up ? r2[0] : r2[1]; r1 = keep + __shfl_xor(send, 8); }
        r1 += __shfl_xor(r1, 4); r1 += __shfl_xor(r1, 2); r1 += __shfl_xor(r1, 1);
        const int grp = lane >> 3;
        float gsel = gt[0];
#pragma unroll
        for (int i = 1; i < 8; ++i) gsel = (grp == i) ? gt[i] : gsel;
        const float coef = gsel * gelu_tanh(r1);
        {
            u32x4 va[8], vb[8];
#pragma unroll
            for (int i = 0; i < 8; ++i) {
                if (e[i] >= 0) { va[i] = *(const u32x4*)(TV + (size_t)e[i] * 1024 + lane * 8); vb[i] = *(const u32x4*)(TV + (size_t)e[i] * 1024 + 512 + lane * 8); }
                else { va[i] = (u32x4){0u, 0u, 0u, 0u}; vb[i] = (u32x4){0u, 0u, 0u, 0u}; }
            }
#pragma unroll
            for (int i = 0; i < 8; ++i) {
                if (e[i] >= 0) {
                    const float ci = rdlane_f(coef, i * 8);
                    outv[0] += ci * bf_lo(va[i].x); outv[1] += ci * bf_hi(va[i].x); outv[2] += ci * bf_lo(va[i].y); outv[3] += ci * bf_hi(va[i].y);
                    outv[4] += ci * bf_lo(va[i].z); outv[5] += ci * bf_hi(va[i].z); outv[6] += ci * bf_lo(va[i].w); outv[7] += ci * bf_hi(va[i].w);
                    outv[8] += ci * bf_lo(vb[i].x); outv[9] += ci * bf_hi(vb[i].x); outv[10] += ci * bf_lo(vb[i].y); outv[11] += ci * bf_hi(vb[i].y);
                    outv[12] += ci * bf_lo(vb[i].z); outv[13] += ci * bf_hi(vb[i].z); outv[14] += ci * bf_lo(vb[i].w); outv[15] += ci * bf_hi(vb[i].w);
                }
            }
        }
    }
}
__device__ __forceinline__ void p_peer_expert2(const Frame& F, unsigned char* ws, float* xres, const float oscale) {
    const bf16_t* XN = (const bf16_t*)(ws + WS_XN); const bf16_t* TU = (const bf16_t*)(ws + WS_TABU); const bf16_t* TV = (const bf16_t*)(ws + WS_TABV);
    const unsigned short* EID = (const unsigned short*)(ws + PE_EID); const float* GATE = (const float*)(ws + PE_GATE);
    const int gw = F.bid * NWAVES + F.wave, NGW = F.G * NWAVES, lane = F.lane;
    int rnd = 0;
    for (int m4 = gw * 4; m4 < T; m4 += NGW * 4, ++rnd) {
        unsigned xp[4][8]; float outv[4][16]; int id[4][2]; float gg[4][2];
#pragma unroll
        for (int s = 0; s < 4; ++s) {
            const size_t m = (size_t)(m4 + s);
            const u32x4 xa = *(const u32x4*)(XN + m * 1024 + lane * 8), xb = *(const u32x4*)(XN + m * 1024 + 512 + lane * 8);
            xp[s][0] = xa.x; xp[s][1] = xa.y; xp[s][2] = xa.z; xp[s][3] = xa.w; xp[s][4] = xb.x; xp[s][5] = xb.y; xp[s][6] = xb.z; xp[s][7] = xb.w;
            id[s][0] = EID[m * 128 + lane]; id[s][1] = EID[m * 128 + 64 + lane]; gg[s][0] = GATE[m * 128 + lane]; gg[s][1] = GATE[m * 128 + 64 + lane];
#pragma unroll
            for (int i = 0; i < 16; ++i) outv[s][i] = 0.f;
        }
#pragma unroll 1
        for (int k = 0; k < 32; ++k) {
            const int r = (rnd & 1) ? 31 - k : k;
#pragma unroll
            for (int s = 0; s < 4; ++s) peer_slot_range(xp[s], outv[s], id[s][0], id[s][1], gg[s][0], gg[s][1], r, TU, TV, lane);
        }
#pragma unroll
        for (int s = 0; s < 4; ++s) {
            f32x4* o = (f32x4*)(xres + (size_t)(m4 + s) * 1024 + lane * 8);
            f32x4 a0 = o[0], a1 = o[1], b0 = o[128], b1 = o[129];
            a0 += (f32x4){outv[s][0], outv[s][1], outv[s][2], outv[s][3]} * oscale; a1 += (f32x4){outv[s][4], outv[s][5], outv[s][6], outv[s][7]} * oscale;
            b0 += (f32x4){outv[s][8], outv[s][9], outv[s][10], outv[s][11]} * oscale; b1 += (f32x4){outv[s][12], outv[s][13], outv[s][14], outv[s][15]} * oscale;
            o[0] = a0; o[1] = a1; o[128] = b0; o[129] = b1;
        }
    }
}

struct RowBuf { u32x4 a[8], b[8]; };
__device__ __forceinline__ void peer_load8(RowBuf& rb, const bf16_t* TAB, const LAS unsigned* ent, int b, int lane) {
#pragma unroll
    for (int i = 0; i < 8; ++i) {
        const unsigned e = (unsigned)__builtin_amdgcn_readfirstlane((int)ent[b * 8 + i]) & 0x3FFFu;
        const bf16_t* rp = TAB + (size_t)e * 1024 + lane * 8;
        rb.a[i] = *(const u32x4*)rp; rb.b[i] = *(const u32x4*)(rp + 512);
    }
}
__device__ __forceinline__ float peer_dot(const unsigned (&xp)[8], const u32x4 a, const u32x4 b) {
    float s = dot2bf(xp[0], a.x, 0.f); s = dot2bf(xp[1], a.y, s); s = dot2bf(xp[2], a.z, s); s = dot2bf(xp[3], a.w, s);
    s = dot2bf(xp[4], b.x, s); s = dot2bf(xp[5], b.y, s); s = dot2bf(xp[6], b.z, s); s = dot2bf(xp[7], b.w, s);
    return s;
}
__device__ __forceinline__ void peer_u8(const RowBuf& rb, const unsigned (&xp)[4][8], const LAS unsigned* ent, LAS float* cf, int b, int lane) {
    float pr[8];
#pragma unroll
    for (int i = 0; i < 8; ++i) {
        const int slot = (__builtin_amdgcn_readfirstlane((int)ent[b * 8 + i]) >> 21) & 3;
        if (slot == 0) pr[i] = peer_dot(xp[0], rb.a[i], rb.b[i]);
        else if (slot == 1) pr[i] = peer_dot(xp[1], rb.a[i], rb.b[i]);
        else if (slot == 2) pr[i] = peer_dot(xp[2], rb.a[i], rb.b[i]);
        else pr[i] = peer_dot(xp[3], rb.a[i], rb.b[i]);
    }
    float r4[4], r2[2], r1;
    { const bool up = (lane & 32) != 0;
#pragma unroll
      for (int i = 0; i < 4; ++i) { const float keep = up ? pr[i + 4] : pr[i], send = up ? pr[i] : pr[i + 4]; r4[i] = keep + __shfl_xor(send, 32); } }
    { const bool up = (lane & 16) != 0;
#pragma unroll
      for (int i = 0; i < 2; ++i) { const float keep = up ? r4[i + 2] : r4[i], send = up ? r4[i] : r4[i + 2]; r2[i] = keep + __shfl_xor(send, 16); } }
    { const bool up = (lane & 8) != 0; const float keep = up ? r2[1] : r2[0], send = up ? r2[0] : r2[1]; r1 = keep + __shfl_xor(send, 8); }
    r1 += __shfl_xor(r1, 4); r1 += __shfl_xor(r1, 2); r1 += __shfl_xor(r1, 1);
    const float gate = cf[b * 8 + (lane >> 3)];
    const float coef = gate * gelu_tanh(r1);
    if ((lane & 7) == 0) cf[b * 8 + (lane >> 3)] = coef;
}
__device__ __forceinline__ void peer_acc(float (&o)[16], const float c, const u32x4 a, const u32x4 b) {
    o[0] += c * bf_lo(a.x); o[1] += c * bf_hi(a.x); o[2] += c * bf_lo(a.y); o[3] += c * bf_hi(a.y);
    o[4] += c * bf_lo(a.z); o[5] += c * bf_hi(a.z); o[6] += c * bf_lo(a.w); o[7] += c * bf_hi(a.w);
    o[8] += c * bf_lo(b.x); o[9] += c * bf_hi(b.x); o[10] += c * bf_lo(b.y); o[11] += c * bf_hi(b.y);
    o[12] += c * bf_lo(b.z); o[13] += c * bf_hi(b.z); o[14] += c * bf_lo(b.w); o[15] += c * bf_hi(b.w);
}
__device__ __forceinline__ void peer_v8(const RowBuf& rb, float (&outv)[4][16], const LAS unsigned* ent, const LAS float* cf, int b) {
#pragma unroll
    for (int i = 0; i < 8; ++i) {
        const int slot = (__builtin_amdgcn_readfirstlane((int)ent[b * 8 + i]) >> 21) & 3;
        const float c = cf[b * 8 + i];
        if (slot == 0) peer_acc(outv[0], c, rb.a[i], rb.b[i]);
        else if (slot == 1) peer_acc(outv[1], c, rb.a[i], rb.b[i]);
        else if (slot == 2) peer_acc(outv[2], c, rb.a[i], rb.b[i]);
        else peer_acc(outv[3], c, rb.a[i], rb.b[i]);
    }
}
__device__ __forceinline__ void p_peer_expert3(const Frame& F, unsigned char* ws, float* xres, const float oscale, const XcdBarrier& xbar) {
    const bf16_t* XN = (const bf16_t*)(ws + WS_XN); const bf16_t* TU = (const bf16_t*)(ws + WS_TABU); const bf16_t* TV = (const bf16_t*)(ws + WS_TABV);
    const unsigned short* EID = (const unsigned short*)(ws + PE_EID); const float* GATE = (const float*)(ws + PE_GATE);
    const int gw = F.bid * NWAVES + F.wave, NGW = F.G * NWAVES, lane = F.lane;
    LAS unsigned* ent = (LAS unsigned*)(F.lds + F.wave * 4096);
    LAS float* cf = (LAS float*)(F.lds + F.wave * 4096 + 2048);
    const int nrounds = (T + NGW * 4 - 1) / (NGW * 4);
    for (int rnd = 0; rnd < nrounds; ++rnd) {
        const int m4 = (rnd * NGW + gw) * 4;
        if (m4 < T) {
            unsigned xp[4][8];
            {
                int id[4][2]; float gg[4][2];
#pragma unroll
                for (int s = 0; s < 4; ++s) {
                    const size_t m = (size_t)(m4 + s);
                    const u32x4 xa = *(const u32x4*)(XN + m * 1024 + lane * 8), xb = *(const u32x4*)(XN + m * 1024 + 512 + lane * 8);
                    xp[s][0] = xa.x; xp[s][1] = xa.y; xp[s][2] = xa.z; xp[s][3] = xa.w; xp[s][4] = xb.x; xp[s][5] = xb.y; xp[s][6] = xb.z; xp[s][7] = xb.w;
                    id[s][0] = EID[m * 128 + lane]; id[s][1] = EID[m * 128 + 64 + lane]; gg[s][0] = GATE[m * 128 + lane]; gg[s][1] = GATE[m * 128 + 64 + lane];
                }
                int base = 0;
#pragma unroll 1
                for (int k = 0; k < 32; ++k) {
                    const int r = (rnd & 1) ? 31 - k : k;
#pragma unroll
                    for (int s = 0; s < 4; ++s)
#pragma unroll
                        for (int w = 0; w < 2; ++w) {
                            const bool hit = (id[s][w] >> 9) == r;
                            const u64 m = __ballot(hit);
                            if (hit) { const int pos = base + (int)__builtin_amdgcn_mbcnt_hi((unsigned)(m >> 32), __builtin_amdgcn_mbcnt_lo((unsigned)m, 0u));
                                ent[pos] = ((unsigned)s << 21) | ((unsigned)(w * 64 + lane) << 14) | (unsigned)id[s][w]; cf[pos] = gg[s][w]; }
                            base += __builtin_popcountll(m);
                        }
                }
            }
            LDS_WAIT();
            {
                RowBuf A, B;
                peer_load8(A, TU, ent, 0, lane);
#pragma unroll 1
                for (int b = 0; b < 64; b += 2) {
                    peer_load8(B, TU, ent, b + 1, lane);
                    peer_u8(A, xp, ent, cf, b, lane);
                    if (b + 2 < 64) peer_load8(A, TU, ent, b + 2, lane);
                    peer_u8(B, xp, ent, cf, b + 1, lane);
                }
            }
            LDS_WAIT();
            float outv[4][16];
#pragma unroll
            for (int s = 0; s < 4; ++s)
#pragma unroll
                for (int i = 0; i < 16; ++i) outv[s][i] = 0.f;
            {
                RowBuf A, B;
                peer_load8(A, TV, ent, 0, lane);
#pragma unroll 1
                for (int b = 0; b < 64; b += 2) {
                    peer_load8(B, TV, ent, b + 1, lane);
                    peer_v8(A, outv, ent, cf, b);
                    if (b + 2 < 64) peer_load8(A, TV, ent, b + 2, lane);
                    peer_v8(B, outv, ent, cf, b + 1);
                }
            }
#pragma unroll
            for (int s = 0; s < 4; ++s) {
                f32x4* o = (f32x4*)(xres + (size_t)(m4 + s) * 1024 + lane * 8);
                f32x4 a0 = o[0], a1 = o[1], b0 = o[128], b1 = o[129];
                a0 += (f32x4){outv[s][0], outv[s][1], outv[s][2], outv[s][3]} * oscale; a1 += (f32x4){outv[s][4], outv[s][5], outv[s][6], outv[s][7]} * oscale;
                b0 += (f32x4){outv[s][8], outv[s][9], outv[s][10], outv[s][11]} * oscale; b1 += (f32x4){outv[s][12], outv[s][13], outv[s][14], outv[s][15]} * oscale;
                o[0] = a0; o[1] = a1; o[128] = b0; o[129] = b1;
            }
        }
        if (rnd + 1 < nrounds) xcd_barrier(xbar);
    }
}

constexpr size_t WS_TAB8U = WS_TABU;
constexpr size_t WS_TAB8V = WS_TABU + 16 * MiB;
constexpr size_t WS_TABSU = WS_TABU + 32 * MiB;
constexpr size_t WS_TABSV = WS_TABU + 32 * MiB + 65536;
__device__ __forceinline__ void cvt_table_fp8(const Frame& F, const float* src, unsigned char* dst, float* scales, const int skip) {
    const int nb = F.G > skip ? F.G - skip : F.G, b0 = F.G > skip ? F.bid - skip : F.bid;
    const int gw = b0 * NWAVES + F.wave, NGW = nb * NWAVES, lane = F.lane;
    if (b0 >= 0) for (int r = gw; r < 16384; r += NGW) {
        const f32x4* p = (const f32x4*)(src + (size_t)r * 1024 + lane * 16);
        f32x4 v[4]; float am = 0.f;
#pragma unroll
        for (int j = 0; j < 4; ++j) { v[j] = p[j]; am = fmaxf(am, fmaxf(fmaxf(fabsf(v[j].x), fabsf(v[j].y)), fmaxf(fabsf(v[j].z), fabsf(v[j].w)))); }
#pragma unroll
        for (int o = 1; o < 64; o <<= 1) am = fmaxf(am, __shfl_xor(am, o));
        const float sc = am > 0.f ? am * (1.0f / 448.0f) : 1.0f, inv = 1.0f / sc;
        u32x4 q;
#pragma unroll
        for (int j = 0; j < 4; ++j) { int w = 0; w = __builtin_amdgcn_cvt_pk_fp8_f32(v[j].x * inv, v[j].y * inv, w, false); w = __builtin_amdgcn_cvt_pk_fp8_f32(v[j].z * inv, v[j].w * inv, w, true); q[j] = (unsigned)w; }
        *(u32x4*)(dst + (size_t)r * 1024 + lane * 16) = q;
        if (lane == 0) scales[r] = sc;
    }
}
template <int NR> struct RowBufN { u32x4 a[NR]; };
template <int NR>
__device__ __forceinline__ void peer_loadN(RowBufN<NR>& rb, const unsigned char* TAB, const LAS unsigned* ent, int b, int lane) {
    const int ev = (int)ent[b * NR + (lane & (NR - 1))];
#pragma unroll
    for (int i = 0; i < NR; ++i) {
        const unsigned e = (unsigned)__builtin_amdgcn_readlane(ev, i) & 0x3FFFu;
        rb.a[i] = *(const u32x4*)(TAB + (size_t)e * 1024 + lane * 16);
    }
}
__device__ __forceinline__ float peer_dot8x(const u32x4 xa, const u32x4 xb, const u32x4 q) {
    float s = 0.f;
#pragma unroll
    for (int j = 0; j < 4; ++j) {
        const f32x2 lo = __builtin_amdgcn_cvt_pk_f32_fp8((int)q[j], false), hi = __builtin_amdgcn_cvt_pk_f32_fp8((int)q[j], true);
        const unsigned x0 = (j < 2) ? xa[2 * j] : xb[2 * j - 4], x1 = (j < 2) ? xa[2 * j + 1] : xb[2 * j - 3];
        s += bf_lo(x0) * lo.x; s += bf_hi(x0) * lo.y; s += bf_lo(x1) * hi.x; s += bf_hi(x1) * hi.y;
    }
    return s;
}
template <int NR>
__device__ __forceinline__ void peer_u8x(const RowBufN<NR>& rb, int r0, const LAS unsigned char* xl, const LAS unsigned* ent, LAS float* cf, const LAS float* sul, int e0, int lane) {
    float pr[8];
    const int ev = (int)ent[e0 + (lane & 7)];
#pragma unroll
    for (int i = 0; i < 8; ++i) {
        const int slot = (__builtin_amdgcn_readlane(ev, i) >> 21) & 3;
        const LAS unsigned char* xp = xl + slot * 2048 + lane * 32;
        const u32x4 xa = *(const LAS u32x4*)xp, xb = *(const LAS u32x4*)(xp + 16);
        pr[i] = peer_dot8x(xa, xb, rb.a[r0 + i]);
    }
    float r4[4], r2[2], r1;
    { const bool up = (lane & 32) != 0;
#pragma unroll
      for (int i = 0; i < 4; ++i) { const float keep = up ? pr[i + 4] : pr[i], send = up ? pr[i] : pr[i + 4]; r4[i] = keep + __shfl_xor(send, 32); } }
    { const bool up = (lane & 16) != 0;
#pragma unroll
      for (int i = 0; i < 2; ++i) { const float keep = up ? r4[i + 2] : r4[i], send = up ? r4[i] : r4[i + 2]; r2[i] = keep + __shfl_xor(send, 16); } }
    { const bool up = (lane & 8) != 0; const float keep = up ? r2[1] : r2[0], send = up ? r2[0] : r2[1]; r1 = keep + __shfl_xor(send, 8); }
    r1 += __shfl_xor(r1, 4); r1 += __shfl_xor(r1, 2); r1 += __shfl_xor(r1, 1);
    const float gate = cf[e0 + (lane >> 3)];
    const float coef = gate * gelu_tanh(r1 * sul[e0 + (lane >> 3)]);
    if ((lane & 7) == 0) cf[e0 + (lane >> 3)] = coef;
}
__device__ __forceinline__ void peer_acc8(float (&o)[16], const float c, const u32x4 q) {
#pragma unroll
    for (int j = 0; j < 4; ++j) { const f32x2 lo = __builtin_amdgcn_cvt_pk_f32_fp8((int)q[j], false), hi = __builtin_amdgcn_cvt_pk_f32_fp8((int)q[j], true);
        o[4 * j] += c * lo.x; o[4 * j + 1] += c * lo.y; o[4 * j + 2] += c * hi.x; o[4 * j + 3] += c * hi.y; }
}
template <int NR>
__device__ __forceinline__ void peer_vN(const RowBufN<NR>& rb, float (&outv)[4][16], const LAS unsigned* ent, const LAS float* cf, int b, int lane) {
    const int ev = (int)ent[b * NR + (lane & (NR - 1))]; const float cv = cf[b * NR + (lane & (NR - 1))];
#pragma unroll
    for (int i = 0; i < NR; ++i) {
        const int slot = (__builtin_amdgcn_readlane(ev, i) >> 21) & 3;
        const float c = rdlane_f(cv, i);
        if (slot == 0) peer_acc8(outv[0], c, rb.a[i]);
        else if (slot == 1) peer_acc8(outv[1], c, rb.a[i]);
        else if (slot == 2) peer_acc8(outv[2], c, rb.a[i]);
        else peer_acc8(outv[3], c, rb.a[i]);
    }
}
__device__ __forceinline__ void p_peer_expert4(const Frame& F, unsigned char* ws, float* xres, const float oscale, const XcdBarrier& xbar, const int mode) {
    const bf16_t* XN = (const bf16_t*)(ws + WS_XN); const unsigned char* TU = ws + WS_TAB8U; const unsigned char* TV = ws + WS_TAB8V;
    const float* SU = (const float*)(ws + WS_TABSU); const float* SV = (const float*)(ws + WS_TABSV);
    const unsigned short* EID = (const unsigned short*)(ws + PE_EID); const float* GATE = (const float*)(ws + PE_GATE);
    const int gw = F.bid * NWAVES + F.wave, NGW = F.G * NWAVES, lane = F.lane;
    LAS unsigned* ent = (LAS unsigned*)(F.lds + F.wave * 6144);
    LAS float* cf = (LAS float*)(F.lds + F.wave * 6144 + 2048);
    LAS float* sul = (LAS float*)(F.lds + F.wave * 6144 + 4096);
    LAS unsigned char* xl = F.lds + 49152 + F.wave * 8192;
    constexpr int PU = 16, PV = 8;
    const int nrounds = (T + NGW * 4 - 1) / (NGW * 4);
    for (int rnd = 0; rnd < nrounds; ++rnd) {
        const int m4 = (rnd * NGW + gw) * 4;
        if (m4 < T) {
            {
                int id[4][2]; float gg[4][2], su[4][2];
#pragma unroll
                for (int s = 0; s < 4; ++s) { const size_t m = (size_t)(m4 + s);
                    id[s][0] = EID[m * 128 + lane]; id[s][1] = EID[m * 128 + 64 + lane]; gg[s][0] = GATE[m * 128 + lane] * SV[id[s][0]]; gg[s][1] = GATE[m * 128 + 64 + lane] * SV[id[s][1]]; su[s][0] = SU[id[s][0]]; su[s][1] = SU[id[s][1]]; }
                int base = 0;
#pragma unroll 1
                for (int k = 0; k < 16; ++k) {
                    const int r = (rnd & 1) ? 15 - k : k;
#pragma unroll
                    for (int s = 0; s < 4; ++s)
#pragma unroll
                        for (int w = 0; w < 2; ++w) {
                            const bool hit = (id[s][w] >> 10) == r;
                            const u64 m = __ballot(hit);
                            if (hit) { const int pos = base + (int)__builtin_amdgcn_mbcnt_hi((unsigned)(m >> 32), __builtin_amdgcn_mbcnt_lo((unsigned)m, 0u));
                                ent[pos] = ((unsigned)s << 21) | ((unsigned)(w * 64 + lane) << 14) | (unsigned)(mode == 4 ? (id[s][w] & 7) : id[s][w]); cf[pos] = gg[s][w]; sul[pos] = su[s][w]; }
                            base += __builtin_popcountll(m);
                        }
                }
            }
            LDS_WAIT();
            if (mode != 1 && mode != 3) {
#pragma unroll
                for (int s = 0; s < 4; ++s) { const size_t m = (size_t)(m4 + s);
                    const u32x4 xa = *(const u32x4*)(XN + m * 1024 + lane * 16), xb = *(const u32x4*)(XN + m * 1024 + lane * 16 + 8);
                    *(LAS u32x4*)(xl + s * 2048 + lane * 32) = xa; *(LAS u32x4*)(xl + s * 2048 + lane * 32 + 16) = xb; }
                LDS_WAIT();
                RowBufN<PU> A, B;
                peer_loadN<PU>(A, TU, ent, 0, lane);
#pragma unroll 1
                for (int b = 0; b < 512 / PU; b += 2) {
                    peer_loadN<PU>(B, TU, ent, b + 1, lane);
#pragma unroll
                    for (int h = 0; h < PU / 8; ++h) peer_u8x<PU>(A, h * 8, xl, ent, cf, sul, b * PU + h * 8, lane);
                    if (b + 2 < 512 / PU) peer_loadN<PU>(A, TU, ent, b + 2, lane);
#pragma unroll
                    for (int h = 0; h < PU / 8; ++h) peer_u8x<PU>(B, h * 8, xl, ent, cf, sul, (b + 1) * PU + h * 8, lane);
                }
            }
            LDS_WAIT();
            float outv[4][16];
#pragma unroll
            for (int s = 0; s < 4; ++s)
#pragma unroll
                for (int i = 0; i < 16; ++i) outv[s][i] = 0.f;
            if (mode != 1 && mode != 2) {
                RowBufN<PV> A, B;
                peer_loadN<PV>(A, TV, ent, 0, lane);
#pragma unroll 1
                for (int b = 0; b < 512 / PV; b += 2) {
                    peer_loadN<PV>(B, TV, ent, b + 1, lane);
                    peer_vN<PV>(A, outv, ent, cf, b, lane);
                    if (b + 2 < 512 / PV) peer_loadN<PV>(A, TV, ent, b + 2, lane);
                    peer_vN<PV>(B, outv, ent, cf, b + 1, lane);
                }
            }
#pragma unroll
            for (int s = 0; s < 4; ++s) {
                f32x4* o = (f32x4*)(xres + (size_t)(m4 + s) * 1024 + lane * 16);
#pragma unroll
                for (int j = 0; j < 4; ++j) { f32x4 a0 = o[j]; a0 += (f32x4){outv[s][4 * j], outv[s][4 * j + 1], outv[s][4 * j + 2], outv[s][4 * j + 3]} * oscale; o[j] = a0; }
            }
        }
        if (rnd + 1 < nrounds) xcd_barrier(xbar);
    }
}

__device__ __forceinline__ void cvt_table_i8(const Frame& F, const float* src, unsigned char* dst, float* scales, const int skip) {
    const int nb = F.G > skip ? F.G - skip : F.G, b0 = F.G > skip ? F.bid - skip : F.bid;
    const int gw = b0 * NWAVES + F.wave, NGW = nb * NWAVES, lane = F.lane;
    if (b0 >= 0) for (int r = gw; r < 16384; r += NGW) {
        const f32x4* p = (const f32x4*)(src + (size_t)r * 1024 + lane * 16);
        f32x4 v[4]; float am = 0.f;
#pragma unroll
        for (int j = 0; j < 4; ++j) { v[j] = p[j]; am = fmaxf(am, fmaxf(fmaxf(fabsf(v[j].x), fabsf(v[j].y)), fmaxf(fabsf(v[j].z), fabsf(v[j].w)))); }
#pragma unroll
        for (int o = 1; o < 64; o <<= 1) am = fmaxf(am, __shfl_xor(am, o));
        const float sc = am > 0.f ? am * (1.0f / 127.0f) : 1.0f, inv = 1.0f / sc;
        u32x4 q;
#pragma unroll
        for (int j = 0; j < 4; ++j) { const int a = (int)rintf(v[j].x * inv), b = (int)rintf(v[j].y * inv), c = (int)rintf(v[j].z * inv), d = (int)rintf(v[j].w * inv);
            q[j] = (unsigned)(a & 255) | ((unsigned)(b & 255) << 8) | ((unsigned)(c & 255) << 16) | ((unsigned)(d & 255) << 24); }
        *(u32x4*)(dst + (size_t)r * 1024 + lane * 16) = q;
        if (lane == 0) scales[r] = sc;
    }
}
template <int NR>
__device__ __forceinline__ void peer_u8i(const RowBufN<NR>& rb, int r0, const LAS unsigned char* xq, const LAS unsigned* ent, LAS float* cf, const LAS float* sul, int e0, int lane) {
    int pr[8];
    const int ev = (int)ent[e0 + (lane & 7)];
#pragma unroll
    for (int i = 0; i < 8; ++i) {
        const int slot = (__builtin_amdgcn_readlane(ev, i) >> 21) & 3;
        const u32x4 xv = *(const LAS u32x4*)(xq + slot * 1024 + lane * 16);
        const u32x4 q = rb.a[r0 + i];
        int s = __builtin_amdgcn_sdot4((int)xv.x, (int)q.x, 0, false); s = __builtin_amdgcn_sdot4((int)xv.y, (int)q.y, s, false);
        s = __builtin_amdgcn_sdot4((int)xv.z, (int)q.z, s, false); s = __builtin_amdgcn_sdot4((int)xv.w, (int)q.w, s, false);
        pr[i] = s;
    }
    int r4[4], r2[2], r1;
#pragma unroll
    for (int i = 0; i < 4; ++i) { const u32x2p sw = __builtin_amdgcn_permlane32_swap((unsigned)pr[i], (unsigned)pr[i + 4], false, false); r4[i] = (int)sw.x + (int)sw.y; }
#pragma unroll
    for (int i = 0; i < 2; ++i) { const u32x2p sw = __builtin_amdgcn_permlane16_swap((unsigned)r4[i], (unsigned)r4[i + 2], false, false); r2[i] = (int)sw.x + (int)sw.y; }
    { const bool up = (lane & 8) != 0; const int keep = up ? r2[1] : r2[0], send = up ? r2[0] : r2[1]; r1 = keep + __builtin_amdgcn_update_dpp(0, send, DPP_ROR8, 0xF, 0xF, true); }
    r1 += __builtin_amdgcn_update_dpp(0, r1, DPP_QX1, 0xF, 0xF, true); r1 += __builtin_amdgcn_update_dpp(0, r1, DPP_QX2, 0xF, 0xF, true); r1 += __builtin_amdgcn_update_dpp(0, r1, DPP_HMIR, 0xF, 0xF, true);
    const float gate = cf[e0 + (lane >> 3)];
    const float coef = gate * gelu_tanh((float)r1 * sul[e0 + (lane >> 3)]);
    if ((lane & 7) == 0) cf[e0 + (lane >> 3)] = coef;
}
template <bool FAKE>
__device__ __forceinline__ f32x2 cvt8(unsigned w, bool hi) {
    if (FAKE) { const unsigned t = hi ? (w >> 16) : w; return (f32x2){__builtin_bit_cast(float, (t << 23) | 0x30000000u), __builtin_bit_cast(float, ((t >> 8) << 23) | 0x30000000u)}; }
    return hi ? __builtin_amdgcn_cvt_pk_f32_fp8((int)w, true) : __builtin_amdgcn_cvt_pk_f32_fp8((int)w, false);
}
template <bool FAKE = false>
__device__ __forceinline__ void peer_acc8p(f32x2 (&o)[8], const float c, const u32x4 q) {
    const f32x2 c2 = {c, c};
#pragma unroll
    for (int j = 0; j < 4; ++j) { const f32x2 lo = cvt8<FAKE>(q[j], false), hi = cvt8<FAKE>(q[j], true);
        o[2 * j] += c2 * lo; o[2 * j + 1] += c2 * hi; }
}
template <int NR, bool FAKE>
__device__ __forceinline__ void peer_vNp(const RowBufN<NR>& rb, f32x2 (&outv)[4][8], const LAS unsigned* ent, const LAS float* cf, int b, int lane) {
    const int ev = (int)ent[b * NR + (lane & (NR - 1))]; const float cv = cf[b * NR + (lane & (NR - 1))];
    int slot[NR]; float c[NR];
#pragma unroll
    for (int i = 0; i < NR; ++i) { slot[i] = (__builtin_amdgcn_readlane(ev, i) >> 21) & 3; c[i] = rdlane_f(cv, i); }
#pragma unroll
    for (int q4 = 0; q4 < NR / 4; ++q4) {
#pragma unroll
        for (int s = 0; s < 4; ++s) {
#pragma unroll
            for (int i = 4 * q4; i < 4 * q4 + 4; ++i) if (slot[i] == s) peer_acc8p<FAKE>(outv[s], c[i], rb.a[i]);
            __builtin_amdgcn_sched_barrier(0);
        }
    }
}
template <int PV, bool FAKE>
__device__ __forceinline__ void peer_passv(f32x2 (&outv)[4][8], const unsigned char* TV, const LAS unsigned* ent, const LAS float* cf, int lane) {
    RowBufN<PV> A, B, C;
    constexpr int NBV = 512 / PV;
    peer_loadN<PV>(A, TV, ent, 0, lane); peer_loadN<PV>(B, TV, ent, 1, lane);
#pragma unroll 1
    for (int b = 0; b + 2 < NBV; b += 3) {
        peer_loadN<PV>(C, TV, ent, b + 2, lane);
        peer_vNp<PV, FAKE>(A, outv, ent, cf, b, lane);
        if (b + 3 < NBV) peer_loadN<PV>(A, TV, ent, b + 3, lane);
        peer_vNp<PV, FAKE>(B, outv, ent, cf, b + 1, lane);
        if (b + 4 < NBV) peer_loadN<PV>(B, TV, ent, b + 4, lane);
        peer_vNp<PV, FAKE>(C, outv, ent, cf, b + 2, lane);
    }
    peer_vNp<PV, FAKE>(A, outv, ent, cf, NBV - 1, lane);
}
__device__ __forceinline__ void p_peer_expert5(const Frame& F, unsigned char* ws, float* xres, const float oscale, const XcdBarrier& xbar, const int mode, const bool do_norm, const size_t xn_off) {
    const bf16_t* XN = (const bf16_t*)(ws + xn_off); const unsigned char* TU = ws + WS_TAB8U; const unsigned char* TV = ws + WS_TAB8V;
    const float* SU = (const float*)(ws + WS_TABSU); const float* SV = (const float*)(ws + WS_TABSV);
    const unsigned short* EID = (const unsigned short*)(ws + PE_EID); const float* GATE = (const float*)(ws + PE_GATE); const float* SSQ = (const float*)(ws + PE_SSQ);
    const int gw = F.bid * NWAVES + F.wave, NGW = F.G * NWAVES, lane = F.lane;
    LAS unsigned* ent = (LAS unsigned*)(F.lds + F.wave * 6144);
    LAS float* cf = (LAS float*)(F.lds + F.wave * 6144 + 2048);
    LAS float* sul = (LAS float*)(F.lds + F.wave * 6144 + 4096);
    LAS unsigned char* xq = F.lds + 49152 + F.wave * 4096;
    constexpr int PU = 8, PV = 8;
    const int nrounds = (T + NGW * 4 - 1) / (NGW * 4);
    for (int rnd = 0; rnd < nrounds; ++rnd) {
        const int m4 = (rnd * NGW + gw) * 4;
        if (m4 < T) {
            {
                float sx[4];
#pragma unroll
                for (int s = 0; s < 4; ++s) { const size_t m = (size_t)(m4 + s);
                    const u32x4 xa = *(const u32x4*)(XN + m * 1024 + lane * 16), xb = *(const u32x4*)(XN + m * 1024 + lane * 16 + 8);
                    float xf[16] = {bf_lo(xa.x), bf_hi(xa.x), bf_lo(xa.y), bf_hi(xa.y), bf_lo(xa.z), bf_hi(xa.z), bf_lo(xa.w), bf_hi(xa.w),
                                    bf_lo(xb.x), bf_hi(xb.x), bf_lo(xb.y), bf_hi(xb.y), bf_lo(xb.z), bf_hi(xb.z), bf_lo(xb.w), bf_hi(xb.w)};
                    float am = 0.f;
#pragma unroll
                    for (int i = 0; i < 16; ++i) am = fmaxf(am, fabsf(xf[i]));
#pragma unroll
                    for (int o = 1; o < 64; o <<= 1) am = fmaxf(am, __shfl_xor(am, o));
                    sx[s] = am > 0.f ? am * (1.0f / 127.0f) : 1.0f; const float inv = 1.0f / sx[s];
                    { const float pq = (lane < 16) ? SSQ[m * 16 + lane] : 0.f; sx[s] *= 1.0f / sqrtf(wave_sum(pq) * (1.0f / 1024.0f) + 1e-6f); }
                    u32x4 q;
#pragma unroll
                    for (int j = 0; j < 4; ++j) { const int a = (int)rintf(xf[4 * j] * inv), b = (int)rintf(xf[4 * j + 1] * inv), c = (int)rintf(xf[4 * j + 2] * inv), d = (int)rintf(xf[4 * j + 3] * inv);
                        q[j] = (unsigned)(a & 255) | ((unsigned)(b & 255) << 8) | ((unsigned)(c & 255) << 16) | ((unsigned)(d & 255) << 24); }
                    *(LAS u32x4*)(xq + s * 1024 + lane * 16) = q; }
                int id[4][2]; float gg[4][2], su[4][2];
#pragma unroll
                for (int s = 0; s < 4; ++s) { const size_t m = (size_t)(m4 + s);
                    id[s][0] = EID[m * 128 + lane]; id[s][1] = EID[m * 128 + 64 + lane];
                    gg[s][0] = GATE[m * 128 + lane] * SV[id[s][0]]; gg[s][1] = GATE[m * 128 + 64 + lane] * SV[id[s][1]];
                    su[s][0] = SU[id[s][0]] * sx[s]; su[s][1] = SU[id[s][1]] * sx[s]; }
                LAS unsigned* hcnt = (LAS unsigned*)sul;
                if (lane < 32) hcnt[lane] = 0u;
                LDS_WAIT();
#pragma unroll
                for (int s = 0; s < 4; ++s)
#pragma unroll
                    for (int w = 0; w < 2; ++w) __hip_atomic_fetch_add(hcnt + (id[s][w] >> 10), 1u, __ATOMIC_RELAXED, __HIP_MEMORY_SCOPE_WORKGROUP);
                LDS_WAIT();
                unsigned basev;
                { const unsigned cntv = (lane < 16) ? hcnt[lane] : 0u;
                  unsigned incl = cntv;
                  const bool rev = (rnd & 1) != 0;
#pragma unroll
                  for (int o = 1; o < 16; o <<= 1) { const unsigned up = (unsigned)__shfl_up((int)incl, o), dn = (unsigned)__shfl_down((int)incl, o);
                      const unsigned nb = rev ? ((lane + o < 16) ? dn : 0u) : ((lane >= o) ? up : 0u); incl += nb; }
                  basev = incl - cntv; }
                LDS_WAIT();
                if (lane < 16) hcnt[16 + lane] = basev;
                LDS_WAIT();
                int posv[4][2];
#pragma unroll
                for (int s = 0; s < 4; ++s)
#pragma unroll
                    for (int w = 0; w < 2; ++w) posv[s][w] = (int)__hip_atomic_fetch_add(hcnt + 16 + (id[s][w] >> 10), 1u, __ATOMIC_RELAXED, __HIP_MEMORY_SCOPE_WORKGROUP);
                LDS_WAIT();
#pragma unroll
                for (int s = 0; s < 4; ++s)
#pragma unroll
                    for (int w = 0; w < 2; ++w) { const int pos = posv[s][w];
                        ent[pos] = ((unsigned)s << 21) | ((unsigned)(w * 64 + lane) << 14) | (unsigned)(mode == 4 ? (id[s][w] & 7) : id[s][w]); cf[pos] = gg[s][w]; }
                LDS_WAIT();
#pragma unroll
                for (int s = 0; s < 4; ++s)
#pragma unroll
                    for (int w = 0; w < 2; ++w) sul[posv[s][w]] = su[s][w];
            }
            LDS_WAIT();
            if (mode != 1 && mode != 3) {
                RowBufN<PU> A, B, C;
                constexpr int NBU = 512 / PU;
                peer_loadN<PU>(A, TU, ent, 0, lane); peer_loadN<PU>(B, TU, ent, 1, lane);
#pragma unroll 1
                for (int b = 0; b + 2 < NBU; b += 3) {
                    peer_loadN<PU>(C, TU, ent, b + 2, lane);
                    peer_u8i<PU>(A, 0, xq, ent, cf, sul, b * PU, lane);
                    if (b + 3 < NBU) peer_loadN<PU>(A, TU, ent, b + 3, lane);
                    peer_u8i<PU>(B, 0, xq, ent, cf, sul, (b + 1) * PU, lane);
                    if (b + 4 < NBU) peer_loadN<PU>(B, TU, ent, b + 4, lane);
                    peer_u8i<PU>(C, 0, xq, ent, cf, sul, (b + 2) * PU, lane);
                }
                peer_u8i<PU>(A, 0, xq, ent, cf, sul, (NBU - 1) * PU, lane);
            }
            LDS_WAIT();
            f32x2 outv[4][8];
#pragma unroll
            for (int s = 0; s < 4; ++s)
#pragma unroll
                for (int i = 0; i < 8; ++i) outv[s][i] = (f32x2){0.f, 0.f};
            if (mode != 1 && mode != 2) {
                if (mode == 5) peer_passv<PV, true>(outv, TV, ent, cf, lane); else peer_passv<PV, false>(outv, TV, ent, cf, lane);
            }
            asm volatile("" ::: "memory"); __builtin_amdgcn_sched_barrier(0);
#pragma unroll
            for (int s = 0; s < 4; ++s) {
                f32x4* o = (f32x4*)(xres + (size_t)(m4 + s) * 1024 + lane * 16);
                f32x4 nv[4]; float ss = 0.f;
#pragma unroll
                for (int j = 0; j < 4; ++j) { f32x4 a0 = o[j]; const f32x4 add = (f32x4){outv[s][2 * j].x, outv[s][2 * j].y, outv[s][2 * j + 1].x, outv[s][2 * j + 1].y};
                    if (oscale != 0.f) a0 += add; else asm volatile("" :: "v"(add)); o[j] = a0; nv[j] = a0;
                    ss += (a0.x * a0.x + a0.y * a0.y) + (a0.z * a0.z + a0.w * a0.w); }
                if (do_norm && oscale != 0.f) {
                    const float rstd = 1.0f / sqrtf(wave_sum(ss) * (1.f / DM) + 1e-6f);
                    const f32x4* gp = (const f32x4*)((const float*)(ws + WS_CMPB + 4096) + lane * 16);
                    u32x4 w0, w1;
                    { const f32x4 g0 = gp[0], g1 = gp[1], g2 = gp[2], g3 = gp[3];
                      w0.x = pk2(nv[0].x * rstd * g0.x, nv[0].y * rstd * g0.y); w0.y = pk2(nv[0].z * rstd * g0.z, nv[0].w * rstd * g0.w);
                      w0.z = pk2(nv[1].x * rstd * g1.x, nv[1].y * rstd * g1.y); w0.w = pk2(nv[1].z * rstd * g1.z, nv[1].w * rstd * g1.w);
                      w1.x = pk2(nv[2].x * rstd * g2.x, nv[2].y * rstd * g2.y); w1.y = pk2(nv[2].z * rstd * g2.z, nv[2].w * rstd * g2.w);
                      w1.z = pk2(nv[3].x * rstd * g3.x, nv[3].y * rstd * g3.y); w1.w = pk2(nv[3].z * rstd * g3.z, nv[3].w * rstd * g3.w); }
                    u32x4* xo = (u32x4*)((bf16_t*)(ws + WS_XN) + (size_t)(m4 + s) * 1024 + lane * 16);
                    xo[0] = w0; xo[1] = w1;
                }
                asm volatile("" ::: "memory"); __builtin_amdgcn_sched_barrier(0);
            }
        }
    }
}

constexpr size_t L1_QN = WS_R3;
constexpr size_t L1_KS = WS_R3 + 32 * MiB;
constexpr size_t L1_KW = WS_R3 + 40 * MiB;
constexpr size_t L1_VST = WS_R3 + 48 * MiB;
constexpr size_t L1_VWT = WS_R3 + 56 * MiB;
constexpr size_t L1_KCR = WS_R3 + 64 * MiB;
constexpr size_t L1_VCR = WS_R3 + 72 * MiB;
constexpr size_t L1_GATES = WS_R3 + 81 * MiB;
constexpr size_t L1_H1 = WS_R3 + 84 * MiB;
constexpr size_t L1_CMPO = WS_R3 + 88 * MiB;
constexpr size_t L1_KC = WS_R3 + 90 * MiB;
constexpr size_t L1_VCT = WS_R3 + 91 * MiB;
constexpr size_t L1_SELB = WS_R3 + 92 * MiB;
constexpr size_t L1_OC = WS_TABU;
constexpr size_t L1_CAT = WS_XN;
constexpr size_t L1_UPD = WS_R3;
constexpr size_t L1_DECAY = WS_R3 + 128 * MiB;

__device__ __forceinline__ void p_l1_prep(const Frame& F, const Args& a, unsigned char* ws) {
    const bf16_t* P = (const bf16_t*)(ws + WS_PROJ);
    const f32x2* rope = (const f32x2*)(ws + WS_ROPE);
    bf16_t* QN = (bf16_t*)(ws + L1_QN); bf16_t* KS = (bf16_t*)(ws + L1_KS); bf16_t* KW = (bf16_t*)(ws + L1_KW);
    bf16_t* KCR = (bf16_t*)(ws + L1_KCR); bf16_t* VCR = (bf16_t*)(ws + L1_VCR); float* GATES = (float*)(ws + L1_GATES);
    const int gw = F.bid * NWAVES + F.wave, NGW = F.G * NWAVES, lane = F.lane, hs = lane >> 3, sub = lane & 7;
    float qg[8], kg[8];
#pragma unroll
    for (int j = 0; j < 8; ++j) { qg[j] = a.in[I_L1_QG][sub * 8 + j]; kg[j] = a.in[I_L1_KG][sub * 8 + j]; }
    const int srccol = (hs < 2) ? C1_KS + hs * 64 : (hs < 4) ? C1_KW + (hs - 2) * 64 : (hs < 6) ? C1_KC + (hs - 4) * 64 : C1_VC + (hs - 6) * 64;
    bf16_t* dstbuf = (hs < 2) ? KS : (hs < 4) ? KW : (hs < 6) ? KCR : VCR;
    const int g2 = hs & 1;
    for (int m = gw; m < T; m += NGW) {
        const int b = m >> 12, t = m & 4095;
        const bf16_t* row = P + (size_t)m * N_IN1;
        f32x2 cs[8];
#pragma unroll
        for (int j = 0; j < 4; ++j) { const f32x4 c4 = *(const f32x4*)(rope + t * 32 + (sub & 3) * 8 + 2 * j); cs[2 * j] = (f32x2){c4.x, c4.y}; cs[2 * j + 1] = (f32x2){c4.z, c4.w}; }
        float v[8];
        head8_load(row + C1_Q + lane * 8, v); head8_norm(v, qg); head8_rope(v, cs, sub >= 4); head8_store(QN + (size_t)m * 512 + lane * 8, v, 0.125f);
        {
            const u32x4 raw = *(const u32x4*)(row + srccol + sub * 8);
            v[0] = bf_lo(raw.x); v[1] = bf_hi(raw.x); v[2] = bf_lo(raw.y); v[3] = bf_hi(raw.y); v[4] = bf_lo(raw.z); v[5] = bf_hi(raw.z); v[6] = bf_lo(raw.w); v[7] = bf_hi(raw.w);
            head8_norm(v, kg); head8_rope(v, cs, sub >= 4);
            u32x4 q; q.x = pk2(v[0], v[1]); q.y = pk2(v[2], v[3]); q.z = pk2(v[4], v[5]); q.w = pk2(v[6], v[7]);
            if (hs >= 4) q = raw;
            *(u32x4*)(dstbuf + ((size_t)(b * 2 + g2) * 4096 + t) * 64 + sub * 8) = q;
        }
        if (lane < 24) GATES[(size_t)m * 24 + lane] = sigmoidf_(bf2f(row[C1_GL + lane]));
    }
    for (int it = gw; it < 2 * NB * 2 * 64; it += NGW) {
        const int tb = it & 63, g = (it >> 6) & 1, b = (it >> 7) & 7, w = it >> 10;
        const size_t m = (size_t)b * 4096 + tb * 64 + lane;
        unsigned r[32];
#pragma unroll
        for (int j = 0; j < 8; ++j) { const u32x4 q = *(const u32x4*)(P + m * N_IN1 + (w ? C1_VW : C1_VS) + g * 64 + j * 8); r[4 * j] = q.x; r[4 * j + 1] = q.y; r[4 * j + 2] = q.z; r[4 * j + 3] = q.w; }
        bf16_t* dst = (bf16_t*)(ws + (w ? L1_VWT : L1_VST)) + ((size_t)(b * 2 + g) * 64) * 4096 + tb * 64 + lane;
#pragma unroll
        for (int d = 0; d < 64; ++d) dst[(size_t)d * 4096] = (bf16_t)((d & 1) ? (r[d >> 1] >> 16) : (r[d >> 1] & 0xffffu));
    }
}

namespace pg8 {
struct EpiCmp1 {
    static constexpr bool PERM = true;
    bf16_t* O; const float* bias;
    __device__ __forceinline__ void operator()(const f32x4 (&acc)[2][2][4][2], const Unit& u, int wr, int wc, int fr, int fq) const {
        const int row0 = u.pm * BM + wr * 64 + fr, col0 = wc * 32 + 8 * fq;
#pragma unroll
        for (int ai = 0; ai < 2; ++ai)
#pragma unroll
            for (int m = 0; m < 4; ++m) { bf16_t* rowp = O + (size_t)(row0 + ai * HALF + m * 16) * 256 + col0;
#pragma unroll
                for (int bj = 0; bj < 2; ++bj) { const float* bp = bias + u.pn * 256 + col0 + bj * HALF;
                    const f32x4 v0 = acc[ai][bj][m][0] + *(const f32x4*)bp, v1 = acc[ai][bj][m][1] + *(const f32x4*)(bp + 4);
                    u32x4 w; w.x = pk2(gelu_tanh(v0[0]), gelu_tanh(v0[1])); w.y = pk2(gelu_tanh(v0[2]), gelu_tanh(v0[3]));
                    w.z = pk2(gelu_tanh(v1[0]), gelu_tanh(v1[1])); w.w = pk2(gelu_tanh(v1[2]), gelu_tanh(v1[3]));
                    *(u32x4*)(rowp + bj * HALF) = w; }
                asm volatile("" ::: "memory"); __builtin_amdgcn_sched_barrier(0); }
    }
};
struct EpiCmp2 {
    static constexpr bool PERM = false;
    float* C;
    __device__ __forceinline__ void operator()(const f32x4 (&acc)[2][2][4][2], const Unit& u, int wr, int wc, int fr, int fq) const {
        if (wc >= 2) return;
        const int row0 = u.pm * BM + wr * 64 + fr, col0 = wc * 32 + 4 * fq;
#pragma unroll
        for (int ai = 0; ai < 2; ++ai)
#pragma unroll
            for (int m = 0; m < 4; ++m)
#pragma unroll
                for (int n = 0; n < 2; ++n) *(f32x4*)(C + (size_t)(row0 + ai * HALF + m * 16) * 64 + col0 + n * 16) = acc[ai][0][m][n];
    }
};
}

__device__ __forceinline__ void p_cmp_final(const Frame& F, const Args& a, unsigned char* ws) {
    const float* CMPO = (const float*)(ws + L1_CMPO); const f32x2* rope = (const f32x2*)(ws + WS_ROPE);
    bf16_t* KC = (bf16_t*)(ws + L1_KC); bf16_t* VCT = (bf16_t*)(ws + L1_VCT);
    const int gw = F.bid * NWAVES + F.wave, NGW = F.G * NWAVES, lane = F.lane;
    const float kg = a.in[I_L1_KG][lane];
    for (int r = gw; r < 8192; r += NGW) {
        float v = CMPO[(size_t)r * 64 + lane];
        const int rr = r & 4095, bg = rr >> 8, c = rr & 255;
        if (r < 4096) {
            const float ss = wave_sum(v * v);
            v = v * (1.0f / sqrtf(ss * (1.f / 64.f) + 1e-6f)) * kg;
            const int pos = (c < 255) ? 16 * c + 31 : 0;
            v = rope_apply(v, rope[pos * 32 + (lane & 31)], lane);
            KC[((size_t)bg * 256 + c) * 64 + lane] = (c < 255) ? (bf16_t)f2bf(v) : (bf16_t)0;
        } else {
            VCT[((size_t)bg * 64 + lane) * 256 + c] = (c < 255) ? (bf16_t)f2bf(v) : (bf16_t)0;
        }
    }
}

__device__ __forceinline__ void att_load2(AttStage& s, const bf16_t* Kg, const bf16_t* Vtg, int vstride, int key0, int tid) {
    s.kreg = *(const u32x4*)(Kg + (size_t)(key0 + (tid >> 3)) * 64 + (tid & 7) * 8);
    s.vreg = *(const u32x4*)(Vtg + (size_t)(tid >> 3) * vstride + key0 + (tid & 7) * 8);
}
__device__ __forceinline__ float score_bound_c2(const float* qg, const float* kg) {
    float mq = 0.f, mk_ = 0.f;
    for (int i = 0; i < 64; ++i) { mq = fmaxf(mq, fabsf(qg[i])); mk_ = fmaxf(mk_, fabsf(kg[i])); }
    return (8.0f * mq * mk_ + 0.5f) * 1.4426950408889634f;
}

constexpr int CA_KB = 256 * 144, CA_VSTR = 528, CA_VB = 64 * CA_VSTR, CA_IMP = CA_KB + CA_VB;
__device__ __forceinline__ void p_cmp_attn(const Frame& F, const Args& a, unsigned char* ws) {
    const bf16_t* QN = (const bf16_t*)(ws + L1_QN); const bf16_t* KC = (const bf16_t*)(ws + L1_KC); const bf16_t* VCT = (const bf16_t*)(ws + L1_VCT);
    float* OC = (float*)(ws + L1_OC); u64* SELB = (u64*)(ws + L1_SELB);
    LAS float* impL = (LAS float*)(F.lds + CA_IMP);
    const int lane = F.lane, wave = F.wave, h = lane >> 5, c = lane & 31, tid = F.tid;
    const float c2 = score_bound_c2(a.in[I_L1_QG], a.in[I_L1_KG]), c1 = 1.4426950408889634f;
    for (int u = F.bid; u < 1024; u += F.G) {
        const int b = (u >> 7) & 7, g = (u >> 6) & 1, rnd = u >> 8, qt = (rnd & 1) ? 63 - (u & 63) : (u & 63), q0 = qt * 64;
        const int bg = b * 2 + g; const size_t mb = (size_t)b * 4096;
        const int t = q0 + wave * 8 + (c >> 2), head = g * 4 + (c & 3);
        bf16x8 Qf[4];
#pragma unroll
        for (int ks = 0; ks < 4; ++ks) Qf[ks] = *(const bf16x8*)(QN + (mb + t) * 512 + head * 64 + ks * 16 + 8 * h);
        const int L = (t >= 31) ? (((t - 31) >> 4) < 254 ? ((t - 31) >> 4) : 254) : -1;
        const int tmax = q0 + 63; const int Lmax = (tmax >= 31) ? (((tmax - 31) >> 4) < 254 ? ((tmax - 31) >> 4) : 254) : -1;
        const int nkt = (Lmax >= 0) ? (Lmax >> 6) + 1 : 0;
        const bf16_t* Kg = KC + (size_t)bg * 256 * 64; const bf16_t* Vtg = VCT + (size_t)bg * 64 * 256;
        __syncthreads();
        for (int i = tid; i < nkt * 512; i += NTHREADS) {
            const int key = i >> 3, ch = i & 7;
            *(LAS u32x4*)(F.lds + key * 144 + ch * 16) = *(const u32x4*)(Kg + (size_t)key * 64 + ch * 8);
        }
        for (int i = tid; i < 64 * nkt * 8; i += NTHREADS) {
            const int d = i / (nkt * 8), ch = i % (nkt * 8);
            const u32x4 v = *(const u32x4*)(Vtg + (size_t)d * 256 + ch * 8);
            LAS unsigned char* p = F.lds + CA_KB + d * CA_VSTR + ch * 16;
            *(LAS u32x2*)p = (u32x2){v.x, v.y}; *(LAS u32x2*)(p + 8) = (u32x2){v.z, v.w};
        }
        __syncthreads();
        f32x16 O[2], IMP[2]; float l = 0.f;
#pragma unroll
        for (int i = 0; i < 16; ++i) { O[0][i] = 0.f; O[1][i] = 0.f; IMP[0][i] = 0.f; IMP[1][i] = 0.f; }
        for (int st = 0; st < nkt * 2; ++st) {
            f32x16 S = {0.f, 0.f, 0.f, 0.f, 0.f, 0.f, 0.f, 0.f, 0.f, 0.f, 0.f, 0.f, 0.f, 0.f, 0.f, 0.f};
            { const LAS unsigned char* kp = F.lds + (st * 32 + c) * 144 + h * 16;
#pragma unroll
              for (int ks = 0; ks < 4; ++ks) S = __builtin_amdgcn_mfma_f32_32x32x16_bf16(*(const LAS bf16x8*)(kp + ks * 32), Qf[ks], S, 0, 0, 0); }
            float p[16];
#pragma unroll
            for (int i = 0; i < 16; ++i) {
                const int cidx = st * 32 + (i & 3) + 8 * (i >> 2) + 4 * h;
                const float e = __builtin_amdgcn_exp2f(S[i] * c1 - c2);
                p[i] = (cidx <= L) ? e : 0.f; l += p[i];
            }
            const bf16x8 P0 = pack8(p[0], p[1], p[2], p[3], p[4], p[5], p[6], p[7]);
            const bf16x8 P1 = pack8(p[8], p[9], p[10], p[11], p[12], p[13], p[14], p[15]);
#pragma unroll
            for (int dt = 0; dt < 2; ++dt) {
                const LAS unsigned char* vp = F.lds + CA_KB + (dt * 32 + c) * CA_VSTR + (st * 32 + 4 * h) * 2;
                const u32x2 a0 = *(const LAS u32x2*)(vp), a1 = *(const LAS u32x2*)(vp + 16), b0 = *(const LAS u32x2*)(vp + 32), b1 = *(const LAS u32x2*)(vp + 48);
                O[dt] = __builtin_amdgcn_mfma_f32_32x32x16_bf16(__builtin_bit_cast(bf16x8, ((u32x4){a0.x, a0.y, a1.x, a1.y})), P0, O[dt], 0, 0, 0);
                O[dt] = __builtin_amdgcn_mfma_f32_32x32x16_bf16(__builtin_bit_cast(bf16x8, ((u32x4){b0.x, b0.y, b1.x, b1.y})), P1, O[dt], 0, 0, 0);
            }
#pragma unroll
            for (int jt = 0; jt < 2; ++jt)
#pragma unroll
                for (int s = 0; s < 2; ++s) {
                    unsigned wv[4];
#pragma unroll
                    for (int e2 = 0; e2 < 4; ++e2) {
                        unsigned pr = 0u;
#pragma unroll
                        for (int q = 0; q < 2; ++q) { const int jj = 2 * e2 + q; const int kap = 16 * s + 8 * (jj >> 2) + 4 * h + (jj & 3);
                            const int off = st * 32 + kap - 4 * (32 * jt + c);
                            const unsigned wbits = (off == 0 || off == 4) ? 0x3F80u : ((off >= 1 && off <= 3) ? 0x4000u : 0u);
                            pr |= wbits << (16 * q); }
                        wv[e2] = pr;
                    }
                    const bf16x8 Wf = __builtin_bit_cast(bf16x8, ((u32x4){wv[0], wv[1], wv[2], wv[3]}));
                    IMP[jt] = __builtin_amdgcn_mfma_f32_32x32x16_bf16(Wf, s ? P1 : P0, IMP[jt], 0, 0, 0);
                }
        }
        const float lt = l + __shfl_xor(l, 32);
        const float inv = 1.0f / fmaxf(lt, 1e-30f);
        { float* orow = OC + (mb + t) * 512 + head * 64;
#pragma unroll
          for (int dt = 0; dt < 2; ++dt)
#pragma unroll
            for (int i4 = 0; i4 < 4; ++i4) { const int d = dt * 32 + 8 * i4 + 4 * h;
                *(f32x4*)(orow + d) = (f32x4){O[dt][4 * i4] * inv, O[dt][4 * i4 + 1] * inv, O[dt][4 * i4 + 2] * inv, O[dt][4 * i4 + 3] * inv}; } }
#pragma unroll
        for (int jt = 0; jt < 2; ++jt)
#pragma unroll
            for (int i = 0; i < 16; ++i) {
                float v = IMP[jt][i] * inv; v = DPP_ADD_F(v, DPP_QX1); v = DPP_ADD_F(v, DPP_QX2);
                if ((c & 3) == 0) impL[(wave * 8 + (c >> 2)) * 65 + 32 * jt + (i & 3) + 8 * (i >> 2) + 4 * h] = v;
            }
        __syncthreads();
        if (tid < 64) {
            const int tq = q0 + tid, cur = tq >> 6;
            u64 mask;
            if (cur + 1 <= 16) mask = (1ull << (cur + 1)) - 1ull;
            else {
                unsigned top[16];
#pragma unroll
                for (int blk = 0; blk < 4; ++blk) {
                    unsigned k16[16];
#pragma unroll
                    for (int i = 0; i < 16; ++i) { const int j = blk * 16 + i; const float x = impL[tid * 65 + j];
                        const unsigned key = (j > cur) ? 0u : ((j == 0 || j == cur) ? 0xFFFFFFC0u : (mono_u32(x) & ~0x3Fu)) | (unsigned)(63 - j);
                        k16[i] = (j > cur) ? 0u : key; }
                    sort16_desc(k16);
                    if (blk == 0) {
#pragma unroll
                        for (int i = 0; i < 16; ++i) top[i] = k16[i];
                    } else merge16_desc(top, k16);
                }
                mask = 0ull;
#pragma unroll
                for (int i = 0; i < 16; ++i) mask |= 1ull << (63 - (int)(top[i] & 63u));
            }
            SELB[(size_t)bg * 4096 + tq] = mask;
        }
    }
}

template <bool MASKED>
__device__ __forceinline__ void nsa_run(const Frame& F, int kt0, int kt1, int kt_hi, AttStage& st, const bf16_t* Kg, const bf16_t* Vtg, const bf16x8 (&Qf)[2][4], const u64 (&selw)[2], const int (&qidx)[2],
                                        const float c1, const float c2, const int wlen, f32x16 (&O)[2][2], float (&l)[2]) {
    const int lane = F.lane, h = lane >> 5, tid = F.tid;
#pragma unroll 1
    for (int kt = kt0; kt < kt1; ++kt) {
        LAS unsigned char* buf = F.lds + (kt & 1) * AT_BUF;
        if (kt + 1 < kt_hi) att_load(st, Kg, Vtg, (kt + 1) * 64, tid);
#pragma unroll 1
        for (int sub = 0; sub < 2; ++sub) {
            bf16x8 Kf[4];
            att_kfrags(buf, sub, Kf, lane);
#pragma unroll
            for (int ct = 0; ct < 2; ++ct) {
                __builtin_amdgcn_sched_barrier(0);
                const f32x16 S = att_qk_f(Kf, Qf[ct]);
                const bool flag = (selw[ct] >> kt) & 1ull;
                const float c2e = flag ? c2 : 3.0e30f;
                const int dbase = qidx[ct] - (kt * 64 + sub * 32 + 4 * h);
                float p[16];
#pragma unroll
                for (int i = 0; i < 16; ++i) {
                    const float e = __builtin_amdgcn_exp2f(S[i] * c1 - c2e);
                    p[i] = (!MASKED || (unsigned)(dbase - ((i & 3) + 8 * (i >> 2))) < (unsigned)wlen) ? e : 0.f; l[ct] += p[i];
                }
                const bf16x8 P0 = pack8(p[0], p[1], p[2], p[3], p[4], p[5], p[6], p[7]);
                const bf16x8 P1 = pack8(p[8], p[9], p[10], p[11], p[12], p[13], p[14], p[15]);
                att_pv2(buf, sub, P0, P1, O[ct], lane);
            }
        }
        if (kt + 1 < kt_hi) att_store(st, F.lds + ((kt + 1) & 1) * AT_BUF, tid);
        __syncthreads();
    }
}
__device__ __forceinline__ void p_nsa_attn(const Frame& F, const Args& a, unsigned char* ws) {
    const bf16_t* QN = (const bf16_t*)(ws + L1_QN);
    const u64* SELB = (const u64*)(ws + L1_SELB); float* OC = (float*)(ws + L1_OC); const float* GATES = (const float*)(ws + L1_GATES);
    bf16_t* CAT = (bf16_t*)(ws + L1_CAT);
    const int lane = F.lane, wave = F.wave, h = lane >> 5, c = lane & 31, tid = F.tid;
    const float c2 = score_bound_c2(a.in[I_L1_QG], a.in[I_L1_KG]), c1 = 1.4426950408889634f;
    for (int u = F.bid; u < 512; u += F.G) {
        const int idx = u & 255, g = u >> 8, b = idx >> 5, qtr = idx & 31, qt = g ? 31 - qtr : qtr, q0 = qt * 128;
        const int bg = b * 2 + g; const size_t mb = (size_t)b * 4096;
        bf16x8 Qf[2][4]; int qidx[2];
#pragma unroll
        for (int ct = 0; ct < 2; ++ct) { qidx[ct] = q0 + wave * 16 + ct * 8 + (c >> 2);
#pragma unroll
            for (int ks = 0; ks < 4; ++ks) Qf[ct][ks] = *(const bf16x8*)(QN + (mb + qidx[ct]) * 512 + (g * 4 + (c & 3)) * 64 + ks * 16 + 8 * h); }
        const int head = g * 4 + (c & 3);
#pragma unroll 1
        for (int pass = 0; pass < 2; ++pass) {
            const bf16_t* Kg = (const bf16_t*)(ws + (pass ? L1_KW : L1_KS)) + (size_t)bg * 4096 * 64;
            const bf16_t* Vtg = (const bf16_t*)(ws + (pass ? L1_VWT : L1_VST)) + (size_t)bg * 64 * 4096;
            u64 selw[2];
#pragma unroll
            for (int ct = 0; ct < 2; ++ct) selw[ct] = pass ? ~0ull : SELB[(size_t)bg * 4096 + qidx[ct]];
            const int wlen = pass ? 512 : 0x7fffffff;
            f32x16 O[2][2]; float l[2] = {0.f, 0.f};
#pragma unroll
            for (int ct = 0; ct < 2; ++ct)
#pragma unroll
                for (int dt = 0; dt < 2; ++dt)
#pragma unroll
                    for (int i = 0; i < 16; ++i) O[ct][dt][i] = 0.f;
            const int kt_lo = pass ? ((2 * qt - 8) > 0 ? 2 * qt - 8 : 0) : 0, kt_hi = 2 * qt + 2;
            int ka = pass ? 2 * qt - 6 : 0; ka = ka < kt_lo ? kt_lo : ka; const int kb = 2 * qt;
            AttStage st; att_load(st, Kg, Vtg, kt_lo * 64, tid);
            __syncthreads();
            att_store(st, F.lds + (kt_lo & 1) * AT_BUF, tid);
            __syncthreads();
            nsa_run<true>(F, kt_lo, ka, kt_hi, st, Kg, Vtg, Qf, selw, qidx, c1, c2, wlen, O, l);
            nsa_run<false>(F, ka, kb, kt_hi, st, Kg, Vtg, Qf, selw, qidx, c1, c2, wlen, O, l);
            nsa_run<true>(F, kb, kt_hi, kt_hi, st, Kg, Vtg, Qf, selw, qidx, c1, c2, wlen, O, l);
#pragma unroll
            for (int ct = 0; ct < 2; ++ct) {
                const float lt = l[ct] + __shfl_xor(l[ct], 32);
                const float inv = 1.0f / fmaxf(lt, 1e-30f);
                const size_t m = mb + qidx[ct];
                const float gcv = GATES[m * 24 + head * 3 + 0], gsv = GATES[m * 24 + head * 3 + 1], gwv = GATES[m * 24 + head * 3 + 2];
                float* orow = OC + m * 512 + head * 64; bf16_t* crow = CAT + m * 1024 + head * 64;
#pragma unroll
                for (int dt = 0; dt < 2; ++dt)
#pragma unroll
                    for (int i4 = 0; i4 < 4; ++i4) {
                        const int d = dt * 32 + 8 * i4 + 4 * h;
                        const f32x4 prev = *(const f32x4*)(orow + d);
                        const f32x4 ov = (f32x4){O[ct][dt][4 * i4] * inv, O[ct][dt][4 * i4 + 1] * inv, O[ct][dt][4 * i4 + 2] * inv, O[ct][dt][4 * i4 + 3] * inv};
                        if (pass == 0) *(f32x4*)(orow + d) = prev * gcv + ov * gsv;
                        else { const f32x4 r = prev + ov * gwv; u32x2 w; w.x = pk2(r[0], r[1]); w.y = pk2(r[2], r[3]); *(u32x2*)(crow + d) = w; }
                    }
            }
        }
    }
}

__device__ __forceinline__ float logsigmoidf_(float x) { return fminf(x, 0.f) - log1pf(__expf(-fabsf(x))); }
__device__ __forceinline__ bf16x8 frag_lds(const LAS float* p) { const f32x4 a = *(const LAS f32x4*)p, b = *(const LAS f32x4*)(p + 4); return pack8(a[0], a[1], a[2], a[3], b[0], b[1], b[2], b[3]); }
__device__ __forceinline__ bf16x8 frag_glb(const float* p) { const f32x4 a = *(const f32x4*)p, b = *(const f32x4*)(p + 4); return pack8(a[0], a[1], a[2], a[3], b[0], b[1], b[2], b[3]); }
__device__ __forceinline__ void gla_wave_bcum(const Args& a, const bf16_t* P, size_t m0, int hh, int lane, float (&bc)[32]) {
    float wg[16];
#pragma unroll
    for (int r = 0; r < 16; ++r) wg[r] = a.in[I_L1_WGATE][r * 256 + hh * 64 + lane];
    const float bgv = a.in[I_L1_BGATE][hh * 64 + lane];
    float run = 0.f;
#pragma unroll
    for (int c = 0; c < 32; ++c) {
        const bf16_t* grow = P + (m0 + c) * N_IN1 + C1_GLOW;
        const u32x4 ga = *(const u32x4*)grow, gb = *(const u32x4*)(grow + 8);
        float acc = bgv;
        acc += wg[0] * bf_lo(ga.x); acc += wg[1] * bf_hi(ga.x); acc += wg[2] * bf_lo(ga.y); acc += wg[3] * bf_hi(ga.y); acc += wg[4] * bf_lo(ga.z); acc += wg[5] * bf_hi(ga.z); acc += wg[6] * bf_lo(ga.w); acc += wg[7] * bf_hi(ga.w);
        acc += wg[8] * bf_lo(gb.x); acc += wg[9] * bf_hi(gb.x); acc += wg[10] * bf_lo(gb.y); acc += wg[11] * bf_hi(gb.y); acc += wg[12] * bf_lo(gb.z); acc += wg[13] * bf_hi(gb.z); acc += wg[14] * bf_lo(gb.w); acc += wg[15] * bf_hi(gb.w);
        run += logsigmoidf_(acc) * 0.0625f; bc[c] = run;
    }
}
__device__ __forceinline__ bf16x8 gla_vfrag(const bf16_t* vbase, int s0) {
    unsigned short e[8];
#pragma unroll
    for (int j = 0; j < 8; ++j) e[j] = vbase[(size_t)(s0 + j) * N_IN1];
    u32x4 w; w.x = (unsigned)e[0] | ((unsigned)e[1] << 16); w.y = (unsigned)e[2] | ((unsigned)e[3] << 16); w.z = (unsigned)e[4] | ((unsigned)e[5] << 16); w.w = (unsigned)e[6] | ((unsigned)e[7] << 16);
    return __builtin_bit_cast(bf16x8, w);
}
__device__ __forceinline__ void p_gla_a(const Frame& F, const Args& a, unsigned char* ws) {
    const bf16_t* P = (const bf16_t*)(ws + WS_PROJ); bf16_t* UPD = (bf16_t*)(ws + L1_UPD); float* DECAY = (float*)(ws + L1_DECAY);
    const int lane = F.lane, r = lane & 31, h = lane >> 5;
    LAS bf16_t* kdT = (LAS bf16_t*)(F.lds + F.wave * 5120);
    const int gw = F.bid * NWAVES + F.wave, NGW = F.G * NWAVES;
    for (int u = gw; u < 4096; u += NGW) {
        const int b = u >> 9, hh = (u >> 7) & 3, n = u & 127; const size_t m0 = (size_t)b * 4096 + n * 32;
        float bc[32];
        gla_wave_bcum(a, P, m0, hh, lane, bc);
        const float blast = bc[31];
#pragma unroll
        for (int c = 0; c < 32; c += 2) {
            const float k0 = bf2f(P[(m0 + c) * N_IN1 + C1_GK + hh * 64 + lane]) * __expf(blast - bc[c]);
            const float k1 = bf2f(P[(m0 + c + 1) * N_IN1 + C1_GK + hh * 64 + lane]) * __expf(blast - bc[c + 1]);
            *(LAS unsigned*)(kdT + lane * 40 + c) = pk2(k0, k1);
        }
        DECAY[(size_t)u * 64 + lane] = __expf(blast);
        LDS_WAIT();
        bf16x8 Bf[2][2];
#pragma unroll
        for (int nt = 0; nt < 2; ++nt)
#pragma unroll
            for (int ks = 0; ks < 2; ++ks) Bf[nt][ks] = *(const LAS bf16x8*)(kdT + (32 * nt + r) * 40 + 16 * ks + 8 * h);
#pragma unroll
        for (int mt = 0; mt < 4; ++mt) {
            const bf16_t* vb = P + m0 * N_IN1 + C1_GV + hh * 128 + 32 * mt + r;
            const bf16x8 A0 = gla_vfrag(vb, 8 * h), A1 = gla_vfrag(vb, 16 + 8 * h);
#pragma unroll
            for (int nt = 0; nt < 2; ++nt) {
                f32x16 acc = {0.f, 0.f, 0.f, 0.f, 0.f, 0.f, 0.f, 0.f, 0.f, 0.f, 0.f, 0.f, 0.f, 0.f, 0.f, 0.f};
                acc = __builtin_amdgcn_mfma_f32_32x32x16_bf16(A0, Bf[nt][0], acc, 0, 0, 0);
                acc = __builtin_amdgcn_mfma_f32_32x32x16_bf16(A1, Bf[nt][1], acc, 0, 0, 0);
                bf16_t* up = UPD + (size_t)u * 8192 + 32 * nt + r;
#pragma unroll
                for (int i = 0; i < 16; ++i) up[(size_t)(32 * mt + (i & 3) + 8 * (i >> 2) + 4 * h) * 64] = (bf16_t)f2bf(acc[i]);
            }
        }
        LDS_WAIT();
    }
}
__device__ __forceinline__ void p_gla_b(const Frame& F, unsigned char* ws) {
    bf16_t* UPD = (bf16_t*)(ws + L1_UPD); const float* DECAY = (const float*)(ws + L1_DECAY);
    for (int e = F.bid * NTHREADS + F.tid; e < 32 * 4096; e += F.G * NTHREADS) {
        const int bh = e >> 12, rem = (e & 4095) * 2, dk = rem & 63;
        float s0 = 0.f, s1 = 0.f;
        unsigned* up = (unsigned*)(UPD + (size_t)bh * 128 * 8192 + rem); const float* dp = DECAY + (size_t)bh * 128 * 64 + dk;
#pragma unroll 8
        for (int n = 0; n < 128; ++n) { const unsigned uv = up[(size_t)n * 4096]; const f32x2 dc = *(const f32x2*)(dp + n * 64);
            up[(size_t)n * 4096] = pk2(s0, s1); s0 = dc.x * s0 + bf_lo(uv); s1 = dc.y * s1 + bf_hi(uv); }
    }
}
__device__ __forceinline__ void p_gla_c(const Frame& F, const Args& a, unsigned char* ws, const int mode) {
    const bf16_t* P = (const bf16_t*)(ws + WS_PROJ); const bf16_t* PREV = (const bf16_t*)(ws + L1_UPD); bf16_t* CAT = (bf16_t*)(ws + L1_CAT);
    const int lane = F.lane, r = lane & 31, h = lane >> 5;
    LAS bf16_t* qd = (LAS bf16_t*)(F.lds + F.wave * 9472);
    LAS bf16_t* ki = qd + 32 * 72;
    const int gw = F.bid * NWAVES + F.wave, NGW = F.G * NWAVES;
    for (int u = gw; u < 4096; u += NGW) {
        const int b = u >> 9, hh = (u >> 7) & 3, n = u & 127; const size_t m0 = (size_t)b * 4096 + n * 32;
        bf16x8 pr_[4]; unsigned short vr_[16];
#define GLA_FETCH(ct_) do { const bf16_t* pp_ = PREV + (size_t)u * 8192 + (size_t)(32 * (ct_) + r) * 64 + 8 * h; \
            _Pragma("unroll") for (int ks_ = 0; ks_ < 4; ++ks_) pr_[ks_] = *(const bf16x8*)(pp_ + 16 * ks_); \
            const bf16_t* vb_ = P + m0 * N_IN1 + C1_GV + hh * 128 + 32 * (ct_) + r; \
            _Pragma("unroll") for (int j_ = 0; j_ < 16; ++j_) vr_[j_] = vb_[(size_t)(8 * h + (j_ & 7) + 16 * (j_ >> 3)) * N_IN1]; } while (0)
        GLA_FETCH(0);
        {
            float bc[32];
            if (mode == 1) {
#pragma unroll
                for (int c = 0; c < 32; ++c) bc[c] = -0.01f * (float)c;
            } else gla_wave_bcum(a, P, m0, hh, lane, bc);
#pragma unroll
            for (int c = 0; c < 32; ++c) {
                const float kv = bf2f(P[(m0 + c) * N_IN1 + C1_GK + hh * 64 + lane]) * __expf(-bc[c]);
                const float qv = bf2f(P[(m0 + c) * N_IN1 + C1_GQ + hh * 64 + lane]) * 0.125f * __expf(bc[c]);
                ki[c * 72 + lane] = (bf16_t)f2bf(kv); qd[c * 72 + lane] = (bf16_t)f2bf(qv);
            }
        }
        LDS_WAIT();
        bf16x8 Qa[4];
#pragma unroll
        for (int ks = 0; ks < 4; ++ks) Qa[ks] = *(const LAS bf16x8*)(qd + r * 72 + 16 * ks + 8 * h);
        {
            f32x16 at = {0.f, 0.f, 0.f, 0.f, 0.f, 0.f, 0.f, 0.f, 0.f, 0.f, 0.f, 0.f, 0.f, 0.f, 0.f, 0.f};
#pragma unroll
            for (int ks = 0; ks < 4; ++ks) at = __builtin_amdgcn_mfma_f32_32x32x16_bf16(Qa[ks], *(const LAS bf16x8*)(ki + r * 72 + 16 * ks + 8 * h), at, 0, 0, 0);
            LDS_WAIT();
#pragma unroll
            for (int i = 0; i < 16; ++i) { const int c = (i & 3) + 8 * (i >> 2) + 4 * h; ki[c * 40 + r] = (bf16_t)f2bf((r <= c) ? at[i] : 0.f); }
        }
        LDS_WAIT();
        bf16x8 Aa[2];
#pragma unroll
        for (int ks = 0; ks < 2; ++ks) Aa[ks] = *(const LAS bf16x8*)(ki + r * 40 + 16 * ks + 8 * h);
        f32x16 acc[4];
#pragma unroll
        for (int ct = 0; ct < 4; ++ct) {
            bf16x8 Bp[4], Bv[2];
#pragma unroll
            for (int ks = 0; ks < 4; ++ks) Bp[ks] = pr_[ks];
#pragma unroll
            for (int ks = 0; ks < 2; ++ks) { u32x4 w; w.x = (unsigned)vr_[8 * ks] | ((unsigned)vr_[8 * ks + 1] << 16); w.y = (unsigned)vr_[8 * ks + 2] | ((unsigned)vr_[8 * ks + 3] << 16);
                w.z = (unsigned)vr_[8 * ks + 4] | ((unsigned)vr_[8 * ks + 5] << 16); w.w = (unsigned)vr_[8 * ks + 6] | ((unsigned)vr_[8 * ks + 7] << 16); Bv[ks] = __builtin_bit_cast(bf16x8, w); }
            if (ct < 3) GLA_FETCH(ct + 1);
#pragma unroll
            for (int i = 0; i < 16; ++i) acc[ct][i] = 0.f;
#pragma unroll
            for (int ks = 0; ks < 4; ++ks) acc[ct] = __builtin_amdgcn_mfma_f32_32x32x16_bf16(Qa[ks], Bp[ks], acc[ct], 0, 0, 0);
#pragma unroll
            for (int ks = 0; ks < 2; ++ks) acc[ct] = __builtin_amdgcn_mfma_f32_32x32x16_bf16(Aa[ks], Bv[ks], acc[ct], 0, 0, 0);
        }
#undef GLA_FETCH
#pragma unroll
        for (int i = 0; i < 16; ++i) {
            float ss = acc[0][i] * acc[0][i] + acc[1][i] * acc[1][i] + acc[2][i] * acc[2][i] + acc[3][i] * acc[3][i];
            ss = sum32_f(ss);
            const float rstd = 1.0f / sqrtf(ss * (1.f / 128.f) + 1e-6f);
            const int c = (i & 3) + 8 * (i >> 2) + 4 * h; const size_t m = m0 + c;
#pragma unroll
            for (int ct = 0; ct < 4; ++ct) { const int dv = 32 * ct + r;
                const float rv = bf2f(P[m * N_IN1 + C1_GR + hh * 128 + dv]);
                const bf16_t ov = (bf16_t)f2bf(acc[ct][i] * rstd * a.in[I_L1_OGAIN][dv] * rv * sigmoidf_(rv));
                if (mode == 0) CAT[m * 1024 + 512 + hh * 128 + dv] = ov; else asm volatile("" :: "v"((unsigned)ov)); }
        }
        LDS_WAIT();
    }
}
__global__ void __launch_bounds__(NTHREADS, 2) mk_fwd(Args args) {
    extern __shared__ __attribute__((aligned(16))) unsigned char lds_raw[];
    cg::grid_group grid = cg::this_grid();
    Frame F; F.lds = (LAS unsigned char*)lds_raw; F.tid = threadIdx.x; F.lane = F.tid & 63; F.wave = __builtin_amdgcn_readfirstlane(F.tid >> 6); F.G = gridDim.x; F.bid = blockIdx.x;
    unsigned char* ws = args.ws;
    const int lo = args.ph_lo, hi = args.ph_hi;
#ifndef KEEPMASK
#define KEEPMASK 0xFFFFFFFFu
#endif
#define IN(k) (((KEEPMASK >> (k)) & 1u) && lo <= (k) && (k) < hi)
#define BOTH(k) (IN(k) && IN((k) + 1))
#ifndef TMODE
#define TMODE 0
#endif
#ifndef REPMASK
#define REPMASK 0u
#endif
#define PH(k, ...) if (IN(k)) { { const int rep = 0; (void)rep; __VA_ARGS__; } if ((REPMASK >> (k)) & 1u) { xcd_barrier(xbar); { const int rep = 1; (void)rep; __VA_ARGS__; } } }
#ifdef TS_A
#define STAMP(k) do { if (F.bid == 0 && F.tid == 0) ((unsigned long long*)(ws + WS_CTL + 65536))[(k)] = __builtin_amdgcn_s_memrealtime(); } while (0)
#else
#define STAMP(k) do { } while (0)
#endif
#define GRID_BAR(k) do { if (BOTH(k)) { if ((k) == 0) grid.sync(); else xcd_barrier(xbar); } STAMP((k) + 1); } while (0)
    const float* x = args.in[I_X];
    float* out = args.out;
    volatile LAS unsigned* xst = (volatile LAS unsigned*)(F.lds + LDS_BYTES - 64);
    if (F.tid < 16) xst[F.tid] = 0u;
    __syncthreads();
    XcdBarrier xbar = xcd_barrier_post((unsigned*)(ws + WS_CTL) + 4096, xst);

    STAMP(0);
    PH(0, int base = 0; transpose_all(F, base, args.in[I_L0_WIN], 1024, 1864, (bf16_t*)(ws + WS_W_IN0), 1024, MapIn0()); transpose_all(F, base, args.in[I_L0_WGLU], 512, 512, (bf16_t*)(ws + WS_W_GLU), 512, MapId()); transpose_all(F, base, args.in[I_L0_WOUT], 1024, 1024, (bf16_t*)(ws + WS_W_OUT0), 1024, MapId()); peer_fold_wq(F, args.in[I_L0_WQ], args.in[I_L0_SK], (bf16_t*)(ws + WS_WQ0)); transpose_all(F, base, args.in[I_L1_WIN], 1024, 2856, (bf16_t*)(ws + WS_W_IN1), 1024, MapIn1()); transpose_all(F, base, args.in[I_L1_KW1], 2048, 256, (bf16_t*)(ws + WS_KW1), 2048, MapId()); transpose_all(F, base, args.in[I_L1_VW1], 2048, 256, (bf16_t*)(ws + WS_VW1), 2048, MapId()); transpose_all(F, base, args.in[I_L1_KW2], 256, 64, (bf16_t*)(ws + WS_KW2), 256, MapId()); transpose_all(F, base, args.in[I_L1_VW2], 256, 64, (bf16_t*)(ws + WS_VW2), 256, MapId()); transpose_all(F, base, args.in[I_L1_WOUT], 1024, 1024, (bf16_t*)(ws + WS_W_OUT1), 1024, MapId()); peer_fold_wq(F, args.in[I_L1_WQ], args.in[I_L1_SK], (bf16_t*)(ws + WS_WQ1)); zero_bytes(F, ws + WS_W_IN0 + (size_t)1864 * 1024 * 2, (size_t)(2048 - 1864) * 1024 * 2); zero_bytes(F, ws + WS_W_IN1 + (size_t)2856 * 1024 * 2, (size_t)(3072 - 2856) * 1024 * 2); zero_bytes(F, ws + WS_KW2 + (size_t)64 * 256 * 2, (size_t)192 * 256 * 2); zero_bytes(F, ws + WS_VW2 + (size_t)64 * 256 * 2, (size_t)192 * 256 * 2);   cvt_table_i8(F, args.in[I_L0_U], ws + WS_TAB8U, (float*)(ws + WS_TABSU), 32); cvt_table_fp8(F, args.in[I_L0_V], ws + WS_TAB8V, (float*)(ws + WS_TABSV), 32); p_rope_table(F, (f32x2*)(ws + WS_ROPE)); if (F.bid == F.G - 1) { for (int i = F.tid; i < 1024; i += NTHREADS) ((float*)(ws + WS_CMPB + 4096))[i] = args.in[I_L1_MIXN][i]; } __syncthreads(); for (int g = F.bid; g < 32; g += F.G) s5_build_group(F, args, ws, g); for (int j = (F.bid + F.G - (32 % F.G)) % F.G; j < 64; j += F.G) cmp_bias(F, args, (float*)(ws + WS_CMPB), j); p_rmsnorm(F, x, args.in[I_L0_MIXN], (bf16_t*)(ws + WS_XN));)
    GRID_BAR(0);
    PH(1, pg8::Gemm g{(const bf16_t*)(ws + WS_XN), (const bf16_t*)(ws + WS_W_IN0), T, N_IN0, 1024, 1024, 1024}; pg8::StaticOrder S; S.init(T, N_IN0, F.G, F.bid); pg8::EpiStoreBf16 E{(bf16_t*)(ws + WS_PROJ), N_IN0}; pg8::gemm_phase(F.lds, g, S, E);)
    GRID_BAR(1);
    PH(2, p_l0_prep(F, args, ws);)
    GRID_BAR(2);
    PH(3, p_dsa_index(F, ws, (u64*)(ws + (rep ? L0_CAT : L0_SELT)), rep ? TMODE : 0); { pg8::Gemm g{(const bf16_t*)(ws + L0_UA), (const bf16_t*)(ws + WS_S5B1), 65536, 8192, 256, 384, 256}; pg8::GroupedOrder S; S.init(256, 8, F.G, F.bid); pg8::EpiS5State E{(float*)(ws + L0_SLOC)}; pg8::gemm_phase(F.lds, g, S, E); })
    GRID_BAR(3);
    PH(4, p_s5_scan(F, args, ws); p_dsa_attn(F, args, ws);)
    GRID_BAR(4);
    PH(7, pg8::Gemm g{(const bf16_t*)(ws + L0_UA), (const bf16_t*)(ws + WS_S5B2), 65536, 8192, 384, 384, 384}; pg8::GroupedOrder S; S.init(256, 8, F.G, F.bid); pg8::EpiS5Out E{(bf16_t*)(ws + L0_YB)}; pg8::gemm_phase(F.lds, g, S, E);)
    GRID_BAR(7);
    PH(8, pg8::Gemm g{(const bf16_t*)(ws + L0_YB), (const bf16_t*)(ws + WS_W_GLU), T, 512, 512, 512, 512}; pg8::StaticOrder S; S.init(T, 512, F.G, F.bid); pg8::EpiGlu E{(const bf16_t*)(ws + L0_YB), args.in[I_L0_BGLU], (bf16_t*)(ws + L0_CAT)}; pg8::gemm_phase(F.lds, g, S, E);)
    GRID_BAR(8);
    PH(9, pg8::Gemm g{(const bf16_t*)(ws + L0_CAT), (const bf16_t*)(ws + WS_W_OUT0), T, 1024, 1024, 1024, 1024}; pg8::StaticOrder S; S.init(T, 1024, F.G, F.bid); pg8::EpiResidNorm E{x, out, args.in[I_L0_FFNN], (bf16_t*)(ws + WS_XN), (float*)(ws + PE_SSQ)}; pg8::gemm_phase(F.lds, g, S, E);)
    GRID_BAR(9);
    PH(11, pg8::Gemm g{(const bf16_t*)(ws + WS_XN), (const bf16_t*)(ws + WS_WQ0), T, 2048, 1024, 1024, 1024}; pg8::StaticOrder S; S.init(T, 2048, F.G, F.bid); pg8::EpiStoreF16Rs E{(_Float16*)(ws + PE_Q2), 2048, (const float*)(ws + PE_SSQ)}; pg8::gemm_phase(F.lds, g, S, E);)
    GRID_BAR(11);
    PH(12, p_peer_route(F, ws);)
    GRID_BAR(12);
    PH(13, p_peer_expert5(F, ws, out, rep ? 0.f : 1.f, xbar, rep ? TMODE : 0, true, WS_XN);)
    GRID_BAR(13);
    PH(15, pg8::Gemm g{(const bf16_t*)(ws + WS_XN), (const bf16_t*)(ws + WS_W_IN1), T, N_IN1, 1024, 1024, 1024}; pg8::StaticOrder S; S.init(T, N_IN1, F.G, F.bid); pg8::EpiStoreBf16 E{(bf16_t*)(ws + WS_PROJ), N_IN1}; pg8::gemm_phase(F.lds, g, S, E);)
    GRID_BAR(15);
    PH(16, p_l1_prep(F, args, ws);)
    GRID_BAR(16);
    PH(17, pg8::Gemm g{(const bf16_t*)(ws + L1_KCR), (const bf16_t*)(ws + WS_KW1), 8192, 512, 2048, 1024, 2048}; pg8::GroupedOrder S; S.init(32, 16, F.G, F.bid); pg8::EpiCmp1 E{(bf16_t*)(ws + L1_H1), (const float*)(ws + WS_CMPB)}; pg8::gemm_phase(F.lds, g, S, E);)
    GRID_BAR(17);
    PH(18, pg8::Gemm g{(const bf16_t*)(ws + L1_H1), (const bf16_t*)(ws + WS_KW2), 8192, 512, 256, 256, 256}; pg8::GroupedOrder S; S.init(32, 16, F.G, F.bid); pg8::EpiCmp2 E{(float*)(ws + L1_CMPO)}; pg8::gemm_phase(F.lds, g, S, E);)
    GRID_BAR(18);
    PH(19, p_cmp_final(F, args, ws);)
    GRID_BAR(19);
    PH(20, p_cmp_attn(F, args, ws);)
    GRID_BAR(20);
    PH(21, if (rep) { p_cmp_attn(F, args, ws); xcd_barrier(xbar); } p_nsa_attn(F, args, ws);)
    GRID_BAR(21);
    PH(22, p_gla_a(F, args, ws); cvt_table_i8(F, args.in[I_L1_U], ws + WS_TAB8U, (float*)(ws + WS_TABSU), 0); cvt_table_fp8(F, args.in[I_L1_V], ws + WS_TAB8V, (float*)(ws + WS_TABSV), 0);)
    GRID_BAR(22);
    PH(23, if (rep) { p_gla_a(F, args, ws); xcd_barrier(xbar); } p_gla_b(F, ws);)
    GRID_BAR(23);
    PH(24, p_gla_c(F, args, ws, rep ? TMODE : 0);)
    GRID_BAR(24);
    PH(25, pg8::Gemm g{(const bf16_t*)(ws + L1_CAT), (const bf16_t*)(ws + WS_W_OUT1), T, 1024, 1024, 1024, 1024}; pg8::StaticOrder S; S.init(T, 1024, F.G, F.bid); pg8::EpiResidNorm E{out, out, args.in[I_L1_FFNN], (bf16_t*)(ws + WS_R3), (float*)(ws + PE_SSQ)}; pg8::gemm_phase(F.lds, g, S, E);)
    GRID_BAR(25);
    PH(27, pg8::Gemm g{(const bf16_t*)(ws + WS_R3), (const bf16_t*)(ws + WS_WQ1), T, 2048, 1024, 1024, 1024}; pg8::StaticOrder S; S.init(T, 2048, F.G, F.bid); pg8::EpiStoreF16Rs E{(_Float16*)(ws + PE_Q2), 2048, (const float*)(ws + PE_SSQ)}; pg8::gemm_phase(F.lds, g, S, E);)
    GRID_BAR(27);
    PH(28, p_peer_route(F, ws);)
    GRID_BAR(28);
    PH(29, p_peer_expert5(F, ws, out, rep ? 0.f : 1.f, xbar, rep ? TMODE : 0, false, WS_R3);)
#undef IN
#undef BOTH
}

extern "C" void kernel_launch(void* const* d_in, const int* in_sizes, int n_in, void* d_out, int out_size, void* d_ws, size_t ws_size, hipStream_t stream) {
    static int grid = 0;
    if (grid == 0) {
        if (n_in != 39 || ws_size < WS_END) { fprintf(stderr, "kernel_launch: unexpected n_in %d or ws_size %zu (< %zu)\n", n_in, ws_size, (size_t)WS_END); grid = -1; return; }
        int dev = 0, cus = 0, per_cu = 0;
        (void)hipGetDevice(&dev); (void)hipDeviceGetAttribute(&cus, hipDeviceAttributeMultiprocessorCount, dev);
        if (hipFuncSetAttribute((const void*)mk_fwd, hipFuncAttributeMaxDynamicSharedMemorySize, LDS_BYTES) != hipSuccess) { fprintf(stderr, "kernel_launch: hipFuncSetAttribute failed\n"); grid = -1; return; }
        if (hipOccupancyMaxActiveBlocksPerMultiprocessor(&per_cu, (const void*)mk_fwd, NTHREADS, LDS_BYTES) != hipSuccess || per_cu < 1) { fprintf(stderr, "kernel_launch: occupancy query failed (%d)\n", per_cu); (void)hipGetLastError(); grid = -1; return; }
        grid = cus;
    }
    if (grid < 0) return;
    (void)hipMemsetAsync((char*)d_ws + WS_CTL, 0, 32768, stream);
    Args a{};
    for (int i = 0; i < 39; ++i) a.in[i] = (const float*)d_in[i];
    a.out = (float*)d_out; a.ws = (unsigned char*)d_ws; a.ph_lo = 0; a.ph_hi = 1000;
    void* kargs[] = {&a};
    hipError_t e = hipLaunchCooperativeKernel((const void*)mk_fwd, dim3(grid), dim3(NTHREADS), kargs, LDS_BYTES, stream);
    if (e != hipSuccess) fprintf(stderr, "kernel_launch: cooperative launch failed: %s\n", hipGetErrorString(e));
}
```

```cpp
#include <hip/hip_runtime.h>
#include <hip/hip_cooperative_groups.h>
#include <cstdio>
#include <cstdint>
namespace cg = cooperative_groups;

#define LAS __attribute__((address_space(3)))
typedef unsigned short bf16_t;
typedef short bf16x8 __attribute__((ext_vector_type(8)));
typedef float f32x4 __attribute__((ext_vector_type(4)));
typedef float f32x2 __attribute__((ext_vector_type(2)));
typedef float f32x16 __attribute__((ext_vector_type(16)));
typedef unsigned u32x4 __attribute__((ext_vector_type(4)));
typedef unsigned u32x2 __attribute__((ext_vector_type(2)));
typedef unsigned long long u64;

constexpr int NB = 8, SEQ = 4096, DM = 1024, T = NB * SEQ;
constexpr int NTHREADS = 512, NWAVES = 8;
constexpr int LDS_BYTES = 147456;
constexpr int N_IN0 = 2048, N_IN1 = 3072;
constexpr int C0_Q = 0, C0_K = 512, C0_V = 640, C0_IQ = 768, C0_U = 1280, C0_IK = 1792, C0_IW = 1856;
constexpr int C1_Q = 0, C1_KC = 512, C1_VC = 640, C1_KS = 768, C1_VS = 896, C1_KW = 1024, C1_VW = 1152, C1_GQ = 1280, C1_GK = 1536, C1_GV = 1792, C1_GR = 2304, C1_GL = 2816, C1_GLOW = 2840;

constexpr size_t MiB = 1u << 20;
constexpr size_t WS_CTL = 0;
constexpr size_t WS_ROPE = 1 * MiB;
constexpr size_t WS_W_IN0 = 2 * MiB;
constexpr size_t WS_W_GLU = 6 * MiB;
constexpr size_t WS_SK0 = 6 * MiB + 512 * 1024;
constexpr size_t WS_W_OUT0 = 7 * MiB;
constexpr size_t WS_WQ0 = 9 * MiB;
constexpr size_t WS_W_IN1 = 13 * MiB;
constexpr size_t WS_KW1 = 19 * MiB;
constexpr size_t WS_VW1 = 20 * MiB;
constexpr size_t WS_KW2 = 21 * MiB;
constexpr size_t WS_VW2 = 21 * MiB + 128 * 1024;
constexpr size_t WS_SK1 = 21 * MiB + 512 * 1024;
constexpr size_t WS_W_OUT1 = 22 * MiB;
constexpr size_t WS_WQ1 = 24 * MiB;
constexpr size_t WS_S5B1 = 28 * MiB;
constexpr size_t WS_S5B2 = 32 * MiB;
constexpr size_t WS_CMPB = 38 * MiB;
constexpr size_t WS_TABU = 48 * MiB;
constexpr size_t WS_TABV = 80 * MiB;
constexpr size_t WS_XN = 112 * MiB;
constexpr size_t WS_PROJ = 176 * MiB;
constexpr size_t WS_R3 = 368 * MiB;
constexpr size_t WS_END = 506 * MiB;

__device__ __forceinline__ unsigned f2bf(float f) { unsigned u = __builtin_bit_cast(unsigned, f); return (u + 0x7fffu + ((u >> 16) & 1u)) >> 16; }
__device__ __forceinline__ unsigned pk2(float lo, float hi) { return f2bf(lo) | (f2bf(hi) << 16); }
__device__ __forceinline__ float bf_lo(unsigned u) { return __builtin_bit_cast(float, u << 16); }
__device__ __forceinline__ float bf_hi(unsigned u) { return __builtin_bit_cast(float, u & 0xffff0000u); }
__device__ __forceinline__ float bf2f(bf16_t b) { return __builtin_bit_cast(float, ((unsigned)b) << 16); }
typedef unsigned u32x2p __attribute__((ext_vector_type(2)));
__device__ __forceinline__ float dpp_f(float v, const int ctrl) { return v; }
#define DPP_ADD_F(v, ctrl) ((v) + __builtin_bit_cast(float, __builtin_amdgcn_update_dpp(0, __builtin_bit_cast(int, (v)), (ctrl), 0xF, 0xF, true)))
#define DPP_QX1 0xB1
#define DPP_QX2 0x4E
#define DPP_HMIR 0x141
#define DPP_MIR 0x140
#define DPP_ROR8 0x128
__device__ __forceinline__ float sum8_f(float v) { v = DPP_ADD_F(v, DPP_QX1); v = DPP_ADD_F(v, DPP_QX2); v = DPP_ADD_F(v, DPP_HMIR); return v; }
__device__ __forceinline__ float sum16_f(float v) { v = sum8_f(v); v = DPP_ADD_F(v, DPP_MIR); return v; }
__device__ __forceinline__ float rl_f(float v, int l) { return __builtin_bit_cast(float, __builtin_amdgcn_readlane(__builtin_bit_cast(int, v), l)); }
__device__ __forceinline__ float sum32_f(float v) { v = sum16_f(v); return v + __shfl_xor(v, 16); }
__device__ __forceinline__ float wave_sum(float v) { v = sum16_f(v); return (rl_f(v, 0) + rl_f(v, 16)) + (rl_f(v, 32) + rl_f(v, 48)); }
__device__ __forceinline__ float gelu_tanh(float x) {
    const float y = 0.7978845608028654f * (x + 0.044715f * x * x * x);
    return x * __builtin_amdgcn_rcpf(1.0f + __expf(-2.0f * y));
}
__device__ __forceinline__ float sigmoidf_(float x) { return __builtin_amdgcn_rcpf(1.0f + __expf(-x)); }
#define LDS_WAIT() asm volatile("s_waitcnt lgkmcnt(0)" ::: "memory")
#define VM_WAIT() asm volatile("s_waitcnt vmcnt(0)" ::: "memory")

#define XB_TMO      128
#define XB_XCNT(j)  (256  + 64 * (j))
#define XB_XSUB(j)  (1280 + 64 * (j))
#define XB_XGEN(j)  (2304 + 64 * (j))
#define XB_TOP      3328
#define XB_TOPGEN   3392
#define XCD_BAR_WORDS 3456
#define XB_SPIN_CAP (1u << 22)
__device__ __forceinline__ unsigned xb_ld(unsigned* p)              { return __hip_atomic_load(p, __ATOMIC_RELAXED, __HIP_MEMORY_SCOPE_AGENT); }
__device__ __forceinline__ unsigned xb_add(unsigned* p, unsigned v) { return __hip_atomic_fetch_add(p, v, __ATOMIC_RELAXED, __HIP_MEMORY_SCOPE_AGENT); }
__device__ __forceinline__ unsigned xb_xcc_id() { return (unsigned)__builtin_amdgcn_s_getreg((3 << 11) | 20) & 0xFu; }
#define XB_SPIN(cond, bar) do { unsigned _sp = 0; while (cond) { __builtin_amdgcn_s_sleep(1); \
    if ((++_sp & 255u) == 0u) { if (xb_ld(&(bar)[XB_TMO])) break; if (_sp > XB_SPIN_CAP) { atomicAdd(&(bar)[XB_TMO], 1u); break; } } } } while (0)
struct XcdBarrier { unsigned* bar; unsigned x; volatile LAS unsigned* st; };
__device__ __forceinline__ XcdBarrier xcd_barrier_post(unsigned* bar, volatile LAS unsigned* st) {
    XcdBarrier b; b.bar = bar; b.x = xb_xcc_id(); b.st = st;
    if (threadIdx.x == 0) (void)xb_add(&bar[XB_XCNT(b.x)], 1u);
    return b;
}
__device__ __forceinline__ void xcd_barrier_complete(unsigned* bar, unsigned x, unsigned& nloc, unsigned& nx) {
    const unsigned G = gridDim.x * gridDim.y * gridDim.z;
    unsigned sum, cnt, mine, sp = 0u;
    for (;;) {
        sum = 0u; cnt = 0u; mine = 0u;
#pragma unroll
        for (unsigned j = 0; j < 16; ++j) { const unsigned c = xb_ld(&bar[XB_XCNT(j)]); sum += c; cnt += (c > 0u) ? 1u : 0u; mine = (j == x) ? c : mine; }
        if (sum == G) break;
        __builtin_amdgcn_s_sleep(1);
        if ((++sp & 255u) == 0u) { if (xb_ld(&bar[XB_TMO])) break; if (sp > XB_SPIN_CAP) { atomicAdd(&bar[XB_TMO], 1u); break; } }
    }
    nloc = mine > 0u ? mine : 1u; nx = cnt > 0u ? cnt : 1u;
}
__device__ __forceinline__ void xcd_barrier(const XcdBarrier& b) {
    asm volatile("s_waitcnt vmcnt(0)" ::: "memory");
    __syncthreads();
    if (threadIdx.x == 0) {
        unsigned* bar = b.bar;
        __builtin_amdgcn_s_waitcnt(0);
        unsigned nloc = b.st[0], nx = b.st[1];
        if (nloc == 0u) { xcd_barrier_complete(bar, b.x, nloc, nx); b.st[0] = nloc; b.st[1] = nx; }
        const unsigned old = xb_add(&bar[XB_XSUB(b.x)], 1u);
        const unsigned gen = old / nloc;
        if (old + 1u == (gen + 1u) * nloc) {
            __builtin_amdgcn_fence(__ATOMIC_RELEASE, "agent");
            asm volatile("s_waitcnt vmcnt(0)" ::: "memory");
            const unsigned og = xb_add(&bar[XB_TOP], 1u);
            const unsigned tg = og / nx;
            if (og + 1u == (tg + 1u) * nx) xb_add(&bar[XB_TOPGEN], 1u);
            else XB_SPIN(xb_ld(&bar[XB_TOPGEN]) == tg, bar);
            __builtin_amdgcn_fence(__ATOMIC_ACQUIRE, "agent");
            xb_add(&bar[XB_XGEN(b.x)], 1u);
            asm volatile("s_waitcnt vmcnt(0)" ::: "memory");
        } else {
            XB_SPIN(xb_ld(&bar[XB_XGEN(b.x)]) == gen, bar);
            __builtin_amdgcn_fence(__ATOMIC_ACQUIRE, "agent");
            asm volatile("s_waitcnt vmcnt(0)" ::: "memory");
        }
    }
    __syncthreads();
}

namespace pg8 {
constexpr int BM = 256, BK = 64, HALF = 128, HTB = HALF * BK * 2, STAGE_BYTES = 8 * HTB, NXCD = 8, WGM = 8;
__device__ __forceinline__ int lds_byte(int r, int c) { const int st = (r >> 4) * 2 + (c >> 5), rr = r & 15, cc = c & 31, ob = rr * 64 + cc * 2; return st * 1024 + (ob ^ (((ob >> 9) & 1) << 5)); }
__device__ __forceinline__ void stage_rc(int b, int& R, int& C) { const int st = b / 1024, sb = b % 1024, swz = sb ^ (((sb >> 9) & 1) << 5); R = (st >> 1) * 16 + swz / 64; C = (st & 1) * 32 + (swz % 64) / 2; }
__device__ __forceinline__ int perm32(int rho) { const int n = rho >> 4, i = rho & 15; return 8 * (i >> 2) + 4 * n + (i & 3); }
struct Unit { int pm, pn; };
struct Gemm { const bf16_t* A; const bf16_t* Bt; int M, N, K, lda, ldb; };
struct StaticOrder {
    int nM, nN, nwg, G, c;
    __device__ void init(int M, int N, int G_, int c_) { nM = M / BM; nN = N / BM; nwg = nM * nN; G = G_; c = c_; }
    __device__ bool next(int i, Unit& u) const {
        const long L = (long)i * G + c; if (L >= nwg) return false;
        int wgid = (int)L; { const int q = nwg / NXCD, r = nwg % NXCD, xcd = wgid % NXCD, off = wgid / NXCD; wgid = (xcd < r ? xcd * (q + 1) : r * (q + 1) + (xcd - r) * q) + off; }
        const int nig = WGM * nN, gid = wgid / nig, fm = gid * WGM, gsz = (nM - fm) < WGM ? (nM - fm) : WGM;
        u.pm = fm + ((wgid % nig) % gsz); u.pn = (wgid % nig) / gsz; return true;
    }
};
struct GroupedOrder {
    int nwg, G, c, tpg;
    __device__ void init(int ntiles, int tiles_per_group, int G_, int c_) { nwg = ntiles; tpg = tiles_per_group; G = G_; c = c_; }
    __device__ bool next(int i, Unit& u) const { const long L = (long)i * G + c; if (L >= nwg) return false; u.pm = (int)L; u.pn = (int)L / tpg; return true; }
};
__device__ __forceinline__ unsigned cvt_pk_bf16(float lo, float hi) { unsigned r; asm volatile("v_cvt_pk_bf16_f32 %0, %1, %2" : "=v"(r) : "v"(lo), "v"(hi)); return r; }

template <class Epi, class Sched>
__device__ __forceinline__ void gemm_phase(LAS unsigned char* lds, const Gemm g, const Sched& S, const Epi& E) {
    const int tid = threadIdx.x, wid = __builtin_amdgcn_readfirstlane(tid >> 6), lane = tid & 63, wr = wid >> 2, wc = wid & 3, fr = lane & 15, fq = lane >> 4;
    int K = g.K; asm volatile("" : "+s"(K));
    const int nt = K / BK;
    unsigned voffA[2], voffB[2];
#pragma unroll
    for (int i = 0; i < 2; ++i) { int R, C; stage_rc(tid * 16 + i * 8192, R, C); const int Rb = Epi::PERM ? ((R & ~31) + perm32(R & 31)) : R;
        voffA[i] = (unsigned)(R * g.lda + C) * 2u; voffB[i] = (unsigned)(Rb * g.ldb + C) * 2u; }
    const size_t kstep = (size_t)(BK * 2);
    const size_t hstepA = (size_t)HALF * g.lda * 2, hstepB = (size_t)HALF * g.ldb * 2;
    const size_t tstepA = 2 * hstepA, tstepB = 2 * hstepB;
    const unsigned ldsw = (unsigned)wid * 1024u;
    const int aoff = lds_byte(wr * 64 + fr, fq * 8), boff = lds_byte(wc * 32 + fr, fq * 8);
#define PG8_SA(b, h) (((b) * 2 + (h)) * HTB)
#define PG8_SB(b, h) ((4 + (b) * 2 + (h)) * HTB)
#define PG8_STAGE(bufoff, gbase, voff) do { _Pragma("unroll") for (int _i = 0; _i < 2; ++_i) \
        __builtin_amdgcn_global_load_lds((const unsigned*)((const char*)(gbase) + (voff)[_i]), (LAS unsigned*)(lds + (bufoff) + ldsw + _i * 8192), 16, 0, 0); } while (0)
#define PG8_LDA(dst, b, h) do { _Pragma("unroll") for (int m = 0; m < 4; ++m) _Pragma("unroll") for (int k = 0; k < 2; ++k) dst[m][k] = *(const LAS bf16x8*)(lds + PG8_SA(b, h) + aoff + m * 2048 + k * 1024); } while (0)
#define PG8_LDB(dst, b, h) do { _Pragma("unroll") for (int n = 0; n < 2; ++n) _Pragma("unroll") for (int k = 0; k < 2; ++k) dst[n][k] = *(const LAS bf16x8*)(lds + PG8_SB(b, h) + boff + n * 2048 + k * 1024); } while (0)
#define PG8_MMA(ai, bj, At, Bt) do { __builtin_amdgcn_s_setprio(1); _Pragma("unroll") for (int m = 0; m < 4; ++m) _Pragma("unroll") for (int n = 0; n < 2; ++n) _Pragma("unroll") for (int k = 0; k < 2; ++k) \
        acc[ai][bj][m][n] = __builtin_amdgcn_mfma_f32_16x16x32_bf16(Bt[n][k], At[m][k], acc[ai][bj][m][n], 0, 0, 0); __builtin_amdgcn_s_setprio(0); } while (0)
#define PG8_WAIT_V(n) asm volatile("s_waitcnt vmcnt(" #n ")" ::: "memory")
#define PG8_WAIT_L(n) asm volatile("s_waitcnt lgkmcnt(" #n ")" ::: "memory")
#define PG8_BAR __builtin_amdgcn_s_barrier()
#define PG8_SCHED __builtin_amdgcn_sched_barrier(0)
    Unit cur, nxt; int ui = 0;
    if (!S.next(0, cur)) return;
    f32x4 acc[2][2][4][2];
#pragma unroll
    for (int a = 0; a < 2; ++a)
#pragma unroll
        for (int b = 0; b < 2; ++b)
#pragma unroll
            for (int m = 0; m < 4; ++m)
#pragma unroll
                for (int n = 0; n < 2; ++n) acc[a][b][m][n] = (f32x4){0.f, 0.f, 0.f, 0.f};
    bf16x8 At[4][2], B0[2][2], B1[2][2];
    const char* cA = (const char*)g.A + (size_t)cur.pm * tstepA; const char* cB = (const char*)g.Bt + (size_t)cur.pn * tstepB;
    PG8_STAGE(PG8_SB(0, 0), cB, voffB); PG8_STAGE(PG8_SA(0, 0), cA, voffA); PG8_STAGE(PG8_SB(0, 1), cB + hstepB, voffB); PG8_STAGE(PG8_SA(0, 1), cA + hstepA, voffA);
    if (wr == 1) PG8_BAR;
    PG8_WAIT_V(4); PG8_BAR;
    PG8_STAGE(PG8_SB(1, 0), cB + kstep, voffB); PG8_STAGE(PG8_SA(1, 0), cA + kstep, voffA); PG8_STAGE(PG8_SB(1, 1), cB + hstepB + kstep, voffB);
    PG8_WAIT_V(6); PG8_BAR;
    for (;;) {
        const bool has_next = S.next(ui + 1, nxt);
        const char* nA = has_next ? (const char*)g.A + (size_t)nxt.pm * tstepA : cA; const char* nB = has_next ? (const char*)g.Bt + (size_t)nxt.pn * tstepB : cB;
        for (int t = 0; t < nt; t += 2) {
            const bool last = (t == nt - 2);
            const char* a1 = cA + (size_t)(t + 1) * kstep;
            const char* a2 = last ? nA : cA + (size_t)(t + 2) * kstep; const char* b2 = last ? nB : cB + (size_t)(t + 2) * kstep;
            const char* a3 = a2 + kstep; const char* b3 = b2 + kstep;
            PG8_LDB(B0, 0, 0); PG8_SCHED; PG8_LDA(At, 0, 0); PG8_STAGE(PG8_SA(1, 1), a1 + hstepA, voffA);
            PG8_WAIT_L(8); PG8_BAR; PG8_WAIT_L(0); PG8_MMA(0, 0, At, B0); PG8_BAR; PG8_SCHED;
            PG8_LDB(B1, 0, 1); PG8_STAGE(PG8_SB(0, 0), b2, voffB);
            PG8_BAR; PG8_WAIT_L(0); PG8_MMA(0, 1, At, B1); PG8_BAR;
            PG8_LDA(At, 0, 1); PG8_STAGE(PG8_SA(0, 0), a2, voffA);
            PG8_BAR; PG8_WAIT_L(0); PG8_MMA(1, 0, At, B0); PG8_BAR; PG8_SCHED;
            PG8_STAGE(PG8_SB(0, 1), b2 + hstepB, voffB);
            PG8_WAIT_V(6); PG8_BAR; PG8_MMA(1, 1, At, B1); PG8_BAR;
            PG8_LDB(B0, 1, 0); PG8_SCHED; PG8_LDA(At, 1, 0); PG8_STAGE(PG8_SA(0, 1), a2 + hstepA, voffA);
            PG8_WAIT_L(8); PG8_BAR; PG8_WAIT_L(0); PG8_MMA(0, 0, At, B0); PG8_BAR; PG8_SCHED;
            PG8_LDB(B1, 1, 1); PG8_STAGE(PG8_SB(1, 0), b3, voffB);
            PG8_BAR; PG8_WAIT_L(0); PG8_MMA(0, 1, At, B1); PG8_BAR;
            PG8_LDA(At, 1, 1); PG8_STAGE(PG8_SA(1, 0), a3, voffA);
            PG8_BAR; PG8_WAIT_L(0); PG8_MMA(1, 0, At, B0); PG8_BAR; PG8_SCHED;
            PG8_STAGE(PG8_SB(1, 1), b3 + hstepB, voffB);
            PG8_WAIT_V(6); PG8_BAR; PG8_MMA(1, 1, At, B1); PG8_BAR;
        }
        E(acc, cur, wr, wc, fr, fq);
        if (!has_next) break;
#pragma unroll
        for (int a = 0; a < 2; ++a)
#pragma unroll
            for (int b = 0; b < 2; ++b)
#pragma unroll
                for (int m = 0; m < 4; ++m)
#pragma unroll
                    for (int n = 0; n < 2; ++n) acc[a][b][m][n] = (f32x4){0.f, 0.f, 0.f, 0.f};
        cur = nxt; cA = nA; cB = nB; ++ui;
    }
    PG8_WAIT_V(0);
    if (wr == 0) PG8_BAR;
    PG8_BAR;
#undef PG8_SA
#undef PG8_SB
#undef PG8_STAGE
#undef PG8_LDA
#undef PG8_LDB
#undef PG8_MMA
#undef PG8_WAIT_V
#undef PG8_WAIT_L
#undef PG8_BAR
#undef PG8_SCHED
}

struct EpiStoreBf16 {
    static constexpr bool PERM = true;
    bf16_t* O; int ldc;
    __device__ __forceinline__ void operator()(const f32x4 (&acc)[2][2][4][2], const Unit& u, int wr, int wc, int fr, int fq) const {
        const int row0 = u.pm * BM + wr * 64 + fr, col0 = u.pn * BM + wc * 32 + 8 * fq;
#pragma unroll
        for (int ai = 0; ai < 2; ++ai)
#pragma unroll
            for (int m = 0; m < 4; ++m) { bf16_t* rowp = O + (size_t)(row0 + ai * HALF + m * 16) * ldc + col0;
#pragma unroll
                for (int bj = 0; bj < 2; ++bj) { const f32x4 v0 = acc[ai][bj][m][0], v1 = acc[ai][bj][m][1];
                    u32x4 w; w.x = cvt_pk_bf16(v0[0], v0[1]); w.y = cvt_pk_bf16(v0[2], v0[3]); w.z = cvt_pk_bf16(v1[0], v1[1]); w.w = cvt_pk_bf16(v1[2], v1[3]);
                    *(u32x4*)(rowp + bj * HALF) = w; } }
    }
};
struct EpiStoreF16 {
    static constexpr bool PERM = true;
    _Float16* O; int ldc;
    __device__ __forceinline__ void operator()(const f32x4 (&acc)[2][2][4][2], const Unit& u, int wr, int wc, int fr, int fq) const {
        const int row0 = u.pm * BM + wr * 64 + fr, col0 = u.pn * BM + wc * 32 + 8 * fq;
#pragma unroll
        for (int ai = 0; ai < 2; ++ai)
#pragma unroll
            for (int m = 0; m < 4; ++m) { _Float16* rowp = O + (size_t)(row0 + ai * HALF + m * 16) * ldc + col0;
#pragma unroll
                for (int bj = 0; bj < 2; ++bj) { const f32x4 v0 = acc[ai][bj][m][0], v1 = acc[ai][bj][m][1];
                    typedef _Float16 h8 __attribute__((ext_vector_type(8)));
                    const h8 hv = {(_Float16)v0[0], (_Float16)v0[1], (_Float16)v0[2], (_Float16)v0[3], (_Float16)v1[0], (_Float16)v1[1], (_Float16)v1[2], (_Float16)v1[3]};
                    *(h8*)(rowp + bj * HALF) = hv; } }
    }
};
struct EpiResidF32 {
    static constexpr bool PERM = false;
    const float* R; float* C; int ldc;
    __device__ __forceinline__ void operator()(const f32x4 (&acc)[2][2][4][2], const Unit& u, int wr, int wc, int fr, int fq) const {
        const int row0 = u.pm * BM + wr * 64 + fr, col0 = u.pn * BM + wc * 32 + 4 * fq;
#pragma unroll
        for (int ai = 0; ai < 2; ++ai)
#pragma unroll
            for (int m = 0; m < 4; ++m) { const size_t off = (size_t)(row0 + ai * HALF + m * 16) * ldc + col0;
#pragma unroll
                for (int bj = 0; bj < 2; ++bj)
#pragma unroll
                    for (int n = 0; n < 2; ++n) { const f32x4 r = *(const f32x4*)(R + off + bj * HALF + n * 16); *(f32x4*)(C + off + bj * HALF + n * 16) = r + acc[ai][bj][m][n]; } }
    }
};
struct EpiResidNorm {
    static constexpr bool PERM = false;
    const float* R; float* C; const float* gain; bf16_t* XNp; float* SSQ;
    __device__ __forceinline__ void operator()(const f32x4 (&acc)[2][2][4][2], const Unit& u, int wr, int wc, int fr, int fq) const {
        const int row0 = u.pm * BM + wr * 64 + fr, col0 = u.pn * BM + wc * 32 + 4 * fq;
        f32x4 g4[2][2];
#pragma unroll
        for (int bj = 0; bj < 2; ++bj)
#pragma unroll
            for (int n = 0; n < 2; ++n) g4[bj][n] = *(const f32x4*)(gain + col0 + bj * HALF + n * 16);
#pragma unroll
        for (int ai = 0; ai < 2; ++ai)
#pragma unroll
            for (int m = 0; m < 4; ++m) { const int row = row0 + ai * HALF + m * 16; const size_t off = (size_t)row * 1024 + col0;
                float ss = 0.f;
#pragma unroll
                for (int bj = 0; bj < 2; ++bj)
#pragma unroll
                    for (int n = 0; n < 2; ++n) { const f32x4 o = *(const f32x4*)(R + off + bj * HALF + n * 16) + acc[ai][bj][m][n];
                        *(f32x4*)(C + off + bj * HALF + n * 16) = o;
                        ss += (o[0] * o[0] + o[1] * o[1]) + (o[2] * o[2] + o[3] * o[3]);
                        const f32x4 og = o * g4[bj][n];
                        u32x2 w; w.x = cvt_pk_bf16(og[0], og[1]); w.y = cvt_pk_bf16(og[2], og[3]);
                        *(u32x2*)(XNp + off + bj * HALF + n * 16) = w; }
                ss += __shfl_xor(ss, 16); ss += __shfl_xor(ss, 32);
                if (fq == 0) SSQ[(size_t)row * 16 + u.pn * 4 + wc] = ss;
                asm volatile("" ::: "memory"); __builtin_amdgcn_sched_barrier(0); }
    }
};
struct EpiStoreF16Rs {
    static constexpr bool PERM = true;
    _Float16* O; int ldc; const float* SSQ;
    __device__ __forceinline__ void operator()(const f32x4 (&acc)[2][2][4][2], const Unit& u, int wr, int wc, int fr, int fq) const {
        const int row0 = u.pm * BM + wr * 64 + fr, col0 = u.pn * BM + wc * 32 + 8 * fq;
#pragma unroll
        for (int ai = 0; ai < 2; ++ai)
#pragma unroll
            for (int m = 0; m < 4; ++m) { const int row = row0 + ai * HALF + m * 16; _Float16* rowp = O + (size_t)row * ldc + col0;
                const f32x4* sp = (const f32x4*)(SSQ + (size_t)row * 16);
                const f32x4 s0 = sp[0], s1 = sp[1], s2 = sp[2], s3 = sp[3];
                const float tot = ((s0[0] + s0[1]) + (s0[2] + s0[3])) + ((s1[0] + s1[1]) + (s1[2] + s1[3])) + ((s2[0] + s2[1]) + (s2[2] + s2[3])) + ((s3[0] + s3[1]) + (s3[2] + s3[3]));
                const float rstd = __builtin_amdgcn_rsqf(tot * (1.0f / 1024.0f) + 1e-6f);
#pragma unroll
                for (int bj = 0; bj < 2; ++bj) { const f32x4 v0 = acc[ai][bj][m][0] * rstd, v1 = acc[ai][bj][m][1] * rstd;
                    typedef _Float16 h8 __attribute__((ext_vector_type(8)));
                    const h8 hv = {(_Float16)v0[0], (_Float16)v0[1], (_Float16)v0[2], (_Float16)v0[3], (_Float16)v1[0], (_Float16)v1[1], (_Float16)v1[2], (_Float16)v1[3]};
                    *(h8*)(rowp + bj * HALF) = hv; }
                asm volatile("" ::: "memory"); __builtin_amdgcn_sched_barrier(0); }
    }
};
}

struct Args {
    const float* in[39];
    float* out;
    unsigned char* ws;
    int ph_lo, ph_hi;
};
enum { I_X = 0, I_L0_MIXN, I_L0_WIN, I_L0_QG, I_L0_KG, I_L0_LOGDT, I_L0_ARE, I_L0_AIM, I_L0_BRE, I_L0_BIM, I_L0_CRE, I_L0_CIM, I_L0_D, I_L0_WGLU, I_L0_BGLU, I_L0_WOUT,
       I_L0_FFNN, I_L0_WQ, I_L0_SK, I_L0_U, I_L0_V,
       I_L1_MIXN, I_L1_WIN, I_L1_QG, I_L1_KG, I_L1_CMPPOS, I_L1_KW1, I_L1_KW2, I_L1_VW1, I_L1_VW2, I_L1_WGATE, I_L1_BGATE, I_L1_OGAIN, I_L1_WOUT,
       I_L1_FFNN, I_L1_WQ, I_L1_SK, I_L1_U, I_L1_V };

struct Frame {
    LAS unsigned char* lds;
    int tid, lane, wave, G, bid;
};

constexpr size_t L0_QA = WS_R3;
constexpr size_t L0_IQ = WS_R3 + 32 * MiB;
constexpr size_t L0_KA = WS_R3 + 64 * MiB;
constexpr size_t L0_VAT = WS_R3 + 72 * MiB;
constexpr size_t L0_IK = WS_R3 + 80 * MiB;
constexpr size_t L0_IW = WS_R3 + 84 * MiB;
constexpr size_t L0_UA = WS_R3 + 88 * MiB;
constexpr size_t L0_SELT = WS_PROJ;
constexpr size_t L0_CAT = WS_PROJ + 16 * MiB;
constexpr size_t L0_SLOC = WS_PROJ + 80 * MiB;
constexpr size_t L0_YB = WS_PROJ + 112 * MiB;
constexpr size_t PE_Q2 = WS_PROJ;
constexpr size_t PE_EID = WS_PROJ + 128 * MiB;
constexpr size_t PE_GATE = WS_PROJ + 136 * MiB;
constexpr size_t PE_SSQ = WS_PROJ + 152 * MiB;

template <class Map>
__device__ __forceinline__ void transpose_item(const float* W, int K, int N, bf16_t* WT, int ldk, LAS float* scr, int item, int lane, const Map& map) {
    const int nblk = (N + 31) / 32, kb = item / nblk, nb = item % nblk, k0 = 64 * kb, n0 = 32 * nb;
    const int ncol = n0 + (lane & 31);
#pragma unroll 8
    for (int i = 0; i < 32; ++i) { const int kk = 2 * i + (lane >> 5); scr[kk * 33 + (lane & 31)] = (ncol < N) ? W[(size_t)(k0 + kk) * N + ncol] : 0.f; }
    LDS_WAIT(); asm volatile("" ::: "memory");
    const int c = lane & 7;
#pragma unroll
    for (int j = 0; j < 4; ++j) { const int n = (lane >> 3) + 8 * j; const LAS float* s = scr + (8 * c) * 33 + n;
        u32x4 o; o.x = pk2(s[0 * 33], s[1 * 33]); o.y = pk2(s[2 * 33], s[3 * 33]); o.z = pk2(s[4 * 33], s[5 * 33]); o.w = pk2(s[6 * 33], s[7 * 33]);
        if (n0 + n < N) *(u32x4*)(WT + (size_t)map(n0 + n) * ldk + k0 + 8 * c) = o; }
    LDS_WAIT(); asm volatile("" ::: "memory");
}
struct MapId { __device__ __forceinline__ int operator()(int n) const { return n; } };
struct MapIn0 { __device__ __forceinline__ int operator()(int n) const { return n < 1280 ? n : (n < 1344 ? n - 1280 + C0_IK : (n < 1352 ? n - 1344 + C0_IW : n - 1352 + C0_U)); } };
struct MapIn1 { __device__ __forceinline__ int operator()(int n) const {
    if (n < 1280) return n; if (n < 1304) return n - 1280 + C1_GL; if (n < 1560) return n - 1304 + C1_GQ; if (n < 1816) return n - 1560 + C1_GK;
    if (n < 2328) return n - 1816 + C1_GV; if (n < 2344) return n - 2328 + C1_GLOW; return n - 2344 + C1_GR; } };

template <class Map>
__device__ __forceinline__ void transpose_all(const Frame& F, int& base, const float* W, int K, int N, bf16_t* WT, int ldk, const Map& map) {
    LAS float* scr = (LAS float*)(F.lds + F.wave * 16384);
    const int gw = F.bid * NWAVES + F.wave, NGW = F.G * NWAVES;
    const int nit = (K / 64) * ((N + 31) / 32);
    for (int it = (gw + NGW - (base % NGW)) % NGW; it < nit; it += NGW) transpose_item(W, K, N, WT, ldk, scr, it, F.lane, map);
    base += nit;
}
__device__ __forceinline__ void zero_bytes(const Frame& F, unsigned char* p, size_t nbytes) {
    const size_t n16 = nbytes / 16;
    for (size_t i = (size_t)F.bid * NTHREADS + F.tid; i < n16; i += (size_t)F.G * NTHREADS) ((u32x4*)p)[i] = (u32x4){0u, 0u, 0u, 0u};
}
__device__ __forceinline__ void cvt_f32_bf16(const Frame& F, const float* src, bf16_t* dst, size_t n) {
    const size_t n8 = n / 8;
    for (size_t i = (size_t)F.bid * NTHREADS + F.tid; i < n8; i += (size_t)F.G * NTHREADS) {
        const f32x4 a = ((const f32x4*)src)[2 * i], b = ((const f32x4*)src)[2 * i + 1];
        u32x4 o; o.x = pk2(a.x, a.y); o.y = pk2(a.z, a.w); o.z = pk2(b.x, b.y); o.w = pk2(b.z, b.w);
        ((u32x4*)dst)[i] = o;
    }
}

__device__ __forceinline__ void rms_row_to_bf16(const float* xrow, const float* gain, bf16_t* orow, int lane) {
    const f32x4* xr = (const f32x4*)xrow + lane; const f32x4* gr = (const f32x4*)gain + lane;
    f32x4 v[4]; float s = 0.f;
#pragma unroll
    for (int j = 0; j < 4; ++j) { v[j] = xr[64 * j]; s += (v[j].x * v[j].x + v[j].y * v[j].y) + (v[j].z * v[j].z + v[j].w * v[j].w); }
    const float rstd = __builtin_amdgcn_rsqf(wave_sum(s) * (1.f / DM) + 1e-6f);
    u64* o8 = (u64*)orow + lane;
#pragma unroll
    for (int j = 0; j < 4; ++j) { const f32x4 g4 = gr[64 * j]; o8[64 * j] = (u64)pk2(v[j].x * rstd * g4.x, v[j].y * rstd * g4.y) | ((u64)pk2(v[j].z * rstd * g4.z, v[j].w * rstd * g4.w) << 32); }
}
__device__ __forceinline__ void p_rmsnorm(const Frame& F, const float* x, const float* gain, bf16_t* XN) {
    const int gw = F.bid * NWAVES + F.wave, NGW = F.G * NWAVES;
    for (int m = gw; m < T; m += NGW) rms_row_to_bf16(x + (size_t)m * DM, gain, XN + (size_t)m * DM, F.lane);
}

__device__ __forceinline__ void p_rope_table(const Frame& F, f32x2* rope) {
    for (int i = F.bid * NTHREADS + F.tid; i < SEQ * 32; i += F.G * NTHREADS) {
        const int pos = i >> 5, k = i & 31;
        const float inv = powf(10000.0f, -(float)k / 32.0f);
        const float ang = (float)pos * inv;
        float s, c; sincosf(ang, &s, &c);
        rope[i] = (f32x2){c, s};
    }
}

__device__ __forceinline__ void s5_build_group(const Frame& F, const Args& a, unsigned char* ws, int g) {
    LAS f32x2* abp = (LAS f32x2*)F.lds;
    LAS f32x2* bb = abp + 17 * 64;
    LAS f32x2* Cc = bb + 64 * 16;
    LAS float* KT = (LAS float*)(Cc + 16 * 64);
    const float dt = expf(a.in[I_L0_LOGDT][g]);
    for (int idx = F.tid; idx < 17 * 64; idx += NTHREADS) {
        const int tau = idx >> 6, p = idx & 63;
        const float lr = a.in[I_L0_ARE][g * 64 + p], li = a.in[I_L0_AIM][g * 64 + p];
        const float mag = expf((float)tau * dt * lr); float s, c; sincosf((float)tau * dt * li, &s, &c);
        abp[idx] = (f32x2){mag * c, mag * s};
    }
    for (int idx = F.tid; idx < 64 * 16; idx += NTHREADS) {
        const int p = idx >> 4, c = idx & 15;
        const float lr = a.in[I_L0_ARE][g * 64 + p], li = a.in[I_L0_AIM][g * 64 + p];
        const float mag = expf(dt * lr); float s, co; sincosf(dt * li, &s, &co);
        const float abr = mag * co, abi = mag * s, den = lr * lr + li * li;
        const float fr = ((abr - 1.0f) * lr + abi * li) / den, fi = (abi * lr - (abr - 1.0f) * li) / den;
        const float br = a.in[I_L0_BRE][(size_t)(g * 64 + p) * 16 + c], bi = a.in[I_L0_BIM][(size_t)(g * 64 + p) * 16 + c];
        bb[idx] = (f32x2){fr * br - fi * bi, fr * bi + fi * br};
    }
    for (int idx = F.tid; idx < 16 * 64; idx += NTHREADS) Cc[idx] = (f32x2){a.in[I_L0_CRE][(size_t)g * 1024 + idx], a.in[I_L0_CIM][(size_t)g * 1024 + idx]};
    __syncthreads();
    for (int idx = F.tid; idx < 16 * 256; idx += NTHREADS) {
        const int tau = idx >> 8, co = (idx >> 4) & 15, ci = idx & 15;
        float acc = 0.f;
        for (int p = 0; p < 64; ++p) {
            const f32x2 c = Cc[co * 64 + p], e = abp[tau * 64 + p], b = bb[p * 16 + ci];
            const float er = c.x * e.x - c.y * e.y, ei = c.x * e.y + c.y * e.x;
            acc += er * b.x - ei * b.y;
        }
        if (tau == 0 && co == ci) acc += a.in[I_L0_D][g * 16 + co];
        KT[idx] = acc;
    }
    __syncthreads();
    bf16_t* B1 = (bf16_t*)(ws + WS_S5B1) + (size_t)g * 256 * 256;
    bf16_t* B2 = (bf16_t*)(ws + WS_S5B2) + (size_t)g * 256 * 384;
    for (int idx = F.tid; idx < 256 * 128; idx += NTHREADS) {
        const int n = idx >> 7, k = (idx & 127) * 2;
        float v0 = 0.f, v1 = 0.f;
        if (n < 128) { const int p = n & 63, j = k >> 4, ci = k & 15; const f32x2 e = abp[(15 - j) * 64 + p], b0 = bb[p * 16 + ci], b1 = bb[p * 16 + ci + 1];
            if (n < 64) { v0 = e.x * b0.x - e.y * b0.y; v1 = e.x * b1.x - e.y * b1.y; } else { v0 = e.x * b0.y + e.y * b0.x; v1 = e.x * b1.y + e.y * b1.x; } }
        *(unsigned*)(B1 + (size_t)n * 256 + k) = pk2(v0, v1);
    }
    for (int idx = F.tid; idx < 256 * 192; idx += NTHREADS) {
        const int n = idx / 192, k = (idx % 192) * 2, i = n >> 4, co = n & 15;
        float v0 = 0.f, v1 = 0.f;
        if (k < 256) { const int j = k >> 4, ci = k & 15; if (j <= i) { v0 = KT[((i - j) * 16 + co) * 16 + ci]; v1 = KT[((i - j) * 16 + co) * 16 + ci + 1]; } }
        else { const int p = (k - 256) & 63; const bool im = k >= 320;
            const f32x2 c0 = Cc[co * 64 + p], e0 = abp[(i + 1) * 64 + p], c1 = Cc[co * 64 + p + 1], e1 = abp[(i + 1) * 64 + p + 1];
            if (!im) { v0 = c0.x * e0.x - c0.y * e0.y; v1 = c1.x * e1.x - c1.y * e1.y; } else { v0 = -(c0.x * e0.y + c0.y * e0.x); v1 = -(c1.x * e1.y + c1.y * e1.x); } }
        *(unsigned*)(B2 + (size_t)n * 384 + k) = pk2(v0, v1);
    }
    __syncthreads();
}

__device__ __forceinline__ void cmp_bias(const Frame& F, const Args& a, float* out, int j) {
    const int w = j >> 5, n0 = (j & 31) * 8;
    const float* w1 = a.in[w ? I_L1_VW1 : I_L1_KW1]; const float* pos = a.in[I_L1_CMPPOS];
    LAS float* red = (LAS float*)(F.lds + 65536);
    float acc[8];
#pragma unroll
    for (int i = 0; i < 8; ++i) acc[i] = 0.f;
#pragma unroll
    for (int kk = 0; kk < 4; ++kk) { const int k = F.tid * 4 + kk; const float p = pos[k];
        const f32x4 wa = *(const f32x4*)(w1 + (size_t)k * 256 + n0), wb = *(const f32x4*)(w1 + (size_t)k * 256 + n0 + 4);
        acc[0] += p * wa.x; acc[1] += p * wa.y; acc[2] += p * wa.z; acc[3] += p * wa.w; acc[4] += p * wb.x; acc[5] += p * wb.y; acc[6] += p * wb.z; acc[7] += p * wb.w; }
#pragma unroll
    for (int i = 0; i < 8; ++i) { const float sv = wave_sum(acc[i]); if (F.lane == 0) red[F.wave * 8 + i] = sv; }
    __syncthreads();
    if (F.tid < 8) { float t = 0.f; for (int wv = 0; wv < 8; ++wv) t += red[wv * 8 + F.tid]; out[w * 256 + n0 + F.tid] = t; }
    __syncthreads();
}

__device__ __forceinline__ float rope_apply(float v, const f32x2 cs, int lane) {
    const float partner = __shfl_xor(v, 32);
    return lane < 32 ? v * cs.x - partner * cs.y : partner * cs.y + v * cs.x;
}
__device__ __forceinline__ void head8_load(const bf16_t* p, float (&v)[8]) {
    const u32x4 q = *(const u32x4*)p;
    v[0] = bf_lo(q.x); v[1] = bf_hi(q.x); v[2] = bf_lo(q.y); v[3] = bf_hi(q.y); v[4] = bf_lo(q.z); v[5] = bf_hi(q.z); v[6] = bf_lo(q.w); v[7] = bf_hi(q.w);
}
__device__ __forceinline__ void head8_store(bf16_t* p, const float (&v)[8], const float sc) {
    u32x4 q; q.x = pk2(v[0] * sc, v[1] * sc); q.y = pk2(v[2] * sc, v[3] * sc); q.z = pk2(v[4] * sc, v[5] * sc); q.w = pk2(v[6] * sc, v[7] * sc);
    *(u32x4*)p = q;
}
__device__ __forceinline__ void head8_norm(float (&v)[8], const float (&g)[8]) {
    float ss = 0.f;
#pragma unroll
    for (int j = 0; j < 8; ++j) ss += v[j] * v[j];
    ss = sum8_f(ss);
    const float r = __builtin_amdgcn_rsqf(ss * (1.f / 64.f) + 1e-6f);
#pragma unroll
    for (int j = 0; j < 8; ++j) v[j] = v[j] * r * g[j];
}
__device__ __forceinline__ void head8_rope(float (&v)[8], const f32x2 (&cs)[8], const bool upper) {
#pragma unroll
    for (int j = 0; j < 8; ++j) { const float partner = __shfl_xor(v[j], 4); v[j] = upper ? partner * cs[j].y + v[j] * cs[j].x : v[j] * cs[j].x - partner * cs[j].y; }
}
__device__ __forceinline__ void p_l0_prep(const Frame& F, const Args& a, unsigned char* ws) {
    const bf16_t* P = (const bf16_t*)(ws + WS_PROJ);
    const f32x2* rope = (const f32x2*)(ws + WS_ROPE);
    bf16_t* QA = (bf16_t*)(ws + L0_QA); bf16_t* IQ = (bf16_t*)(ws + L0_IQ); bf16_t* KA = (bf16_t*)(ws + L0_KA); bf16_t* VAT = (bf16_t*)(ws + L0_VAT);
    bf16_t* IK = (bf16_t*)(ws + L0_IK); float* IW = (float*)(ws + L0_IW); bf16_t* UA = (bf16_t*)(ws + L0_UA);
    const int gw = F.bid * NWAVES + F.wave, NGW = F.G * NWAVES, lane = F.lane, hs = lane >> 3, sub = lane & 7;
    float qg[8], kg[8];
#pragma unroll
    for (int j = 0; j < 8; ++j) { qg[j] = a.in[I_L0_QG][sub * 8 + j]; kg[j] = a.in[I_L0_KG][sub * 8 + j]; }
    for (int m = gw; m < T; m += NGW) {
        const int b = m >> 12, t = m & 4095;
        const bf16_t* row = P + (size_t)m * N_IN0;
        f32x2 cs[8];
#pragma unroll
        for (int j = 0; j < 4; ++j) { const f32x4 c4 = *(const f32x4*)(rope + t * 32 + (sub & 3) * 8 + 2 * j); cs[2 * j] = (f32x2){c4.x, c4.y}; cs[2 * j + 1] = (f32x2){c4.z, c4.w}; }
        float v[8];
        head8_load(row + C0_Q + lane * 8, v); head8_norm(v, qg); head8_rope(v, cs, sub >= 4); head8_store(QA + (size_t)m * 512 + lane * 8, v, 0.125f);
        head8_load(row + C0_IQ + lane * 8, v); head8_rope(v, cs, sub >= 4); head8_store(IQ + (size_t)m * 512 + lane * 8, v, 0.125f);
        {
            const int hh = hs < 3 ? hs : 2;
            head8_load(row + (hh < 2 ? C0_K + hh * 64 : C0_IK) + sub * 8, v);
            float vn[8];
#pragma unroll
            for (int j = 0; j < 8; ++j) vn[j] = v[j];
            head8_norm(vn, kg);
#pragma unroll
            for (int j = 0; j < 8; ++j) v[j] = (hh < 2) ? vn[j] : v[j];
            head8_rope(v, cs, sub >= 4);
            if (hs < 2) head8_store(KA + ((size_t)(b * 2 + hs) * 4096 + t) * 64 + sub * 8, v, 1.0f);
            else if (hs == 2) head8_store(IK + (size_t)m * 64 + sub * 8, v, 1.0f);
        }
        if (lane < 8) IW[(size_t)m * 8 + lane] = bf2f(row[C0_IW + lane]) * 0.35355339059327373f;
        { const u32x4 uv = *(const u32x4*)(row + C0_U + lane * 8); const int g = lane >> 1;
          *(u32x4*)(UA + ((size_t)g * 2048 + (m >> 4)) * 384 + (m & 15) * 16 + (lane & 1) * 8) = uv; }
    }
    for (int it = gw; it < NB * 2 * 64; it += NGW) {
        const int tb = it & 63, g = (it >> 6) & 1, b = it >> 7;
        const size_t m = (size_t)b * 4096 + tb * 64 + lane;
        unsigned r[32];
#pragma unroll
        for (int j = 0; j < 8; ++j) { const u32x4 q = *(const u32x4*)(P + m * N_IN0 + C0_V + g * 64 + j * 8); r[4 * j] = q.x; r[4 * j + 1] = q.y; r[4 * j + 2] = q.z; r[4 * j + 3] = q.w; }
        bf16_t* dst = VAT + ((size_t)(b * 2 + g) * 64) * 4096 + tb * 64 + lane;
#pragma unroll
        for (int d = 0; d < 64; ++d) dst[(size_t)d * 4096] = (bf16_t)((d & 1) ? (r[d >> 1] >> 16) : (r[d >> 1] & 0xffffu));
    }
}

__device__ __forceinline__ unsigned f16key(unsigned raw) { return (raw & 0x8000u) ? (~raw & 0xFFFFu) : (raw | 0x8000u); }
template <int NREG>
__device__ __forceinline__ int topk_count_ge(const unsigned (&kk)[NREG], const unsigned cm1pk) {
    unsigned acc = 0u; const unsigned ones = 0x00010001u;
#pragma unroll
    for (int jj = 0; jj < NREG; ++jj) {
        unsigned d;
        asm("v_pk_sub_u16 %0, %1, %2 clamp" : "=v"(d) : "v"(kk[jj]), "v"(cm1pk));
        asm("v_pk_min_u16 %0, %1, %2" : "=v"(d) : "v"(d), "v"(ones));
        asm("v_pk_add_u16 %0, %1, %2" : "=v"(acc) : "v"(acc), "v"(d));
    }
    int c = (int)((acc & 0xffffu) + (acc >> 16));
    c += __builtin_amdgcn_update_dpp(0, c, 0xB1, 0xF, 0xF, true);
    c += __builtin_amdgcn_update_dpp(0, c, 0x4E, 0xF, 0xF, true);
    c += __builtin_amdgcn_update_dpp(0, c, 0x141, 0xF, 0xF, true);
    c += __builtin_amdgcn_update_dpp(0, c, 0x140, 0xF, 0xF, true);
    return __builtin_amdgcn_readlane(c, 0) + __builtin_amdgcn_readlane(c, 16) + __builtin_amdgcn_readlane(c, 32) + __builtin_amdgcn_readlane(c, 48);
}
template <int NREG>
__device__ __forceinline__ u64 topk_query(const LAS unsigned short* scq, const int t, const int lane) {
    unsigned kk[NREG];
#pragma unroll
    for (int jj = 0; jj < NREG; ++jj) {
        const int e0 = (2 * jj) * 64 + lane, e1 = e0 + 64;
        const unsigned r0 = scq[e0], r1 = scq[e1];
        kk[jj] = ((e0 <= t) ? f16key(r0) : 0u) | (((e1 <= t) ? f16key(r1) : 0u) << 16);
        if ((jj & 3) == 3) __builtin_amdgcn_sched_barrier(0);
    }
    unsigned prefix = 0u; bool exact = false;
#pragma unroll 1
    for (int bit = 15; bit >= 0; --bit) {
        const unsigned cand = prefix | (1u << bit), cm1 = cand - 1u;
        const int cnt = topk_count_ge<NREG>(kk, cm1 | (cm1 << 16));
        if (cnt >= 256) prefix = cand;
        if (cnt == 256) { exact = true; break; }
    }
    unsigned mylo = 0u, myhi = 0u;
    if (exact) {
#pragma unroll
        for (int i = 0; i < 2 * NREG; ++i) {
            const unsigned k = (i & 1) ? (kk[i >> 1] >> 16) : (kk[i >> 1] & 0xffffu);
            const u64 w = __ballot(k >= prefix);
            asm("s_nop 4\n\tv_writelane_b32 %0, %2, %4\n\tv_writelane_b32 %1, %3, %4" : "+v"(mylo), "+v"(myhi) : "s"((unsigned)w), "s"((unsigned)(w >> 32)), "n"(i));
        }
    } else {
        const unsigned Tk = prefix;
        const int cgt = (Tk >= 0xFFFFu) ? 0 : topk_count_ge<NREG>(kk, Tk | (Tk << 16));
        const int need = 256 - cgt;
        int run = 0;
#pragma unroll
        for (int i = 0; i < 2 * NREG; ++i) {
            const unsigned k = (i & 1) ? (kk[i >> 1] >> 16) : (kk[i >> 1] & 0xffffu);
            const u64 gt = __ballot(k > Tk); u64 eq = __ballot(k == Tk);
            const int pe = __builtin_popcountll(eq);
            if (run + pe > need) { int kq = need - run; kq = kq < 0 ? 0 : kq;
                const bool keep = ((eq >> lane) & 1ull) && (__builtin_popcountll(eq & ((1ull << lane) - 1ull)) < kq); eq = __ballot(keep); }
            run += pe;
            const u64 w = gt | eq;
            asm("s_nop 4\n\tv_writelane_b32 %0, %2, %4\n\tv_writelane_b32 %1, %3, %4" : "+v"(mylo), "+v"(myhi) : "s"((unsigned)w), "s"((unsigned)(w >> 32)), "n"(i));
        }
    }
    return (u64)mylo | ((u64)myhi << 32);
}
__device__ __forceinline__ void p_dsa_index(const Frame& F, unsigned char* ws, u64* SELT, const int mode) {
    const bf16_t* IQ = (const bf16_t*)(ws + L0_IQ); const bf16_t* IK = (const bf16_t*)(ws + L0_IK); const float* IW = (const float*)(ws + L0_IW);
    LAS _Float16* sc = (LAS _Float16*)F.lds;
    LAS unsigned short* scu = (LAS unsigned short*)F.lds;
    LAS u64* mk = (LAS u64*)(F.lds + 131072);
    LAS float* wl = (LAS float*)(F.lds + 131072 + 8192);
    const int lane = F.lane, wave = F.wave, h = lane >> 5, r = lane & 31;
    const int rq = ((r >> 4) & 1) + 2 * ((r >> 2) & 1), rh = 4 * ((r >> 3) & 1) + (r & 3);
    for (int u = F.bid; u < 2048; u += F.G) {
        const int idx = u & 255, b = u >> 8;
        const int j = (b & 1) ? 255 - idx : idx;
        const int t0 = j * 16; const size_t mb = (size_t)b * 4096;
        if (F.tid < 128) wl[F.tid] = IW[(mb + t0) * 8 + F.tid];
        const int nkb = (t0 + 15) / 32 + 1;
        bf16x8 Af[4][4];
#pragma unroll
        for (int rt = 0; rt < 4; ++rt)
#pragma unroll
            for (int ks = 0; ks < 4; ++ks) Af[rt][ks] = *(const bf16x8*)(IQ + (mb + t0 + 4 * rt + rq) * 512 + rh * 64 + ks * 16 + 8 * h);
        __syncthreads();
        if (mode != 2) for (int kb = wave; kb < nkb; kb += NWAVES) {
            bf16x8 Bf[4];
#pragma unroll
            for (int ks = 0; ks < 4; ++ks) Bf[ks] = *(const bf16x8*)(IK + (mb + kb * 32 + r) * 64 + ks * 16 + 8 * h);
#pragma unroll
            for (int rt = 0; rt < 4; ++rt) {
                f32x16 acc = {0.f, 0.f, 0.f, 0.f, 0.f, 0.f, 0.f, 0.f, 0.f, 0.f, 0.f, 0.f, 0.f, 0.f, 0.f, 0.f};
#pragma unroll
                for (int ks = 0; ks < 4; ++ks) acc = __builtin_amdgcn_mfma_f32_32x32x16_bf16(Af[rt][ks], Bf[ks], acc, 0, 0, 0);
                const int qa = 4 * rt + 2 * h;
                const f32x4 wa0 = *(const LAS f32x4*)(wl + qa * 8), wa1 = *(const LAS f32x4*)(wl + qa * 8 + 4), wb0 = *(const LAS f32x4*)(wl + qa * 8 + 8), wb1 = *(const LAS f32x4*)(wl + qa * 8 + 12);
                float sa = 0.f, sb = 0.f;
#pragma unroll
                for (int i = 0; i < 4; ++i) { sa += wa0[i] * fmaxf(acc[i], 0.f); sa += wa1[i] * fmaxf(acc[4 + i], 0.f); sb += wb0[i] * fmaxf(acc[8 + i], 0.f); sb += wb1[i] * fmaxf(acc[12 + i], 0.f); }
                sc[qa * 4096 + kb * 32 + r] = (_Float16)sa;
                sc[(qa + 1) * 4096 + kb * 32 + r] = (_Float16)sb;
                __builtin_amdgcn_sched_barrier(0);
            }
        }
        __syncthreads();
#pragma unroll 1
        for (int qq = 0; qq < (mode == 1 ? 0 : 2); ++qq) {
            const int q = wave * 2 + qq, t = t0 + q, n = t + 1;
            unsigned mylo = 0u, myhi = 0u;
            if (n <= 256) {
                const int base = lane * 64;
                const u64 word = (base + 63 <= t) ? ~0ull : (base > t ? 0ull : ((1ull << (t - base + 1)) - 1ull));
                mylo = (unsigned)word; myhi = (unsigned)(word >> 32);
            } else {
                const int nreg = (((n + 63) >> 6) + 1) >> 1;
                const LAS unsigned short* scq = scu + q * 4096;
                u64 w;
                if (nreg <= 4) w = topk_query<4>(scq, t, lane);
                else if (nreg <= 8) w = topk_query<8>(scq, t, lane);
                else if (nreg <= 12) w = topk_query<12>(scq, t, lane);
                else if (nreg <= 16) w = topk_query<16>(scq, t, lane);
                else if (nreg <= 20) w = topk_query<20>(scq, t, lane);
                else if (nreg <= 24) w = topk_query<24>(scq, t, lane);
                else if (nreg <= 28) w = topk_query<28>(scq, t, lane);
                else w = topk_query<32>(scq, t, lane);
                mylo = (unsigned)w; myhi = (unsigned)(w >> 32);
            }
            mk[lane * 16 + q] = (u64)mylo | ((u64)myhi << 32);
        }
        __syncthreads();
        { const int w = F.tid >> 3, part = F.tid & 7;
          u64* dst = SELT + ((size_t)(b * 64 + w) * 4096) + t0 + part * 2;
          dst[0] = mk[w * 16 + part * 2]; dst[1] = mk[w * 16 + part * 2 + 1]; }
        __syncthreads();
    }
}

constexpr int AT_KB = 9216, AT_VB = 8704, AT_BUF = AT_KB + AT_VB, AT_MT = 2 * AT_BUF;
__device__ __forceinline__ unsigned cvt_pk_bf16_s(float lo, float hi) { unsigned r; asm("v_cvt_pk_bf16_f32 %0, %1, %2" : "=v"(r) : "v"(lo), "v"(hi)); return r; }
struct AttStage { u32x4 kreg, vreg; };
__device__ __forceinline__ void att_load(AttStage& s, const bf16_t* Kg, const bf16_t* Vtg, int key0, int tid) {
    s.kreg = *(const u32x4*)(Kg + (size_t)(key0 + (tid >> 3)) * 64 + (tid & 7) * 8);
    s.vreg = *(const u32x4*)(Vtg + (size_t)(tid >> 3) * 4096 + key0 + (tid & 7) * 8);
}
__device__ __forceinline__ void att_store(const AttStage& s, LAS unsigned char* buf, int tid) {
    *(LAS u32x4*)(buf + (tid >> 3) * 144 + (tid & 7) * 16) = s.kreg;
    LAS unsigned char* v = buf + AT_KB + (tid >> 3) * 136 + (tid & 7) * 16;
    *(LAS u32x2*)(v) = (u32x2){s.vreg.x, s.vreg.y}; *(LAS u32x2*)(v + 8) = (u32x2){s.vreg.z, s.vreg.w};
}
__device__ __forceinline__ bf16x8 pack8(float a0, float a1, float a2, float a3, float a4, float a5, float a6, float a7) {
    u32x4 w; w.x = pg8::cvt_pk_bf16(a0, a1); w.y = pg8::cvt_pk_bf16(a2, a3); w.z = pg8::cvt_pk_bf16(a4, a5); w.w = pg8::cvt_pk_bf16(a6, a7);
    return __builtin_bit_cast(bf16x8, w);
}
__device__ __forceinline__ bf16x8 pack8s(float a0, float a1, float a2, float a3, float a4, float a5, float a6, float a7) {
    u32x4 w; w.x = cvt_pk_bf16_s(a0, a1); w.y = cvt_pk_bf16_s(a2, a3); w.z = cvt_pk_bf16_s(a4, a5); w.w = cvt_pk_bf16_s(a6, a7);
    return __builtin_bit_cast(bf16x8, w);
}
__device__ __forceinline__ f32x16 att_qk(const LAS unsigned char* buf, int sub, const bf16x8 (&Qf)[4], int lane) {
    f32x16 S = {0.f, 0.f, 0.f, 0.f, 0.f, 0.f, 0.f, 0.f, 0.f, 0.f, 0.f, 0.f, 0.f, 0.f, 0.f, 0.f};
    const LAS unsigned char* kp = buf + (sub * 32 + (lane & 31)) * 144 + (lane >> 5) * 16;
#pragma unroll
    for (int ks = 0; ks < 4; ++ks) { const bf16x8 kf = *(const LAS bf16x8*)(kp + ks * 32); S = __builtin_amdgcn_mfma_f32_32x32x16_bf16(kf, Qf[ks], S, 0, 0, 0); }
    return S;
}
__device__ __forceinline__ void att_pv2(const LAS unsigned char* buf, int sub, const bf16x8 P0, const bf16x8 P1, f32x16 (&O)[2], int lane) {
    const int h = lane >> 5;
#pragma unroll
    for (int dt = 0; dt < 2; ++dt) {
        const LAS unsigned char* vp = buf + AT_KB + (dt * 32 + (lane & 31)) * 136 + (sub * 32 + 4 * h) * 2;
        const u32x2 a0 = *(const LAS u32x2*)(vp), a1 = *(const LAS u32x2*)(vp + 16), b0 = *(const LAS u32x2*)(vp + 32), b1 = *(const LAS u32x2*)(vp + 48);
        const bf16x8 V0 = __builtin_bit_cast(bf16x8, ((u32x4){a0.x, a0.y, a1.x, a1.y}));
        const bf16x8 V1 = __builtin_bit_cast(bf16x8, ((u32x4){b0.x, b0.y, b1.x, b1.y}));
        O[dt] = __builtin_amdgcn_mfma_f32_32x32x16_bf16(V0, P0, O[dt], 0, 0, 0);
        O[dt] = __builtin_amdgcn_mfma_f32_32x32x16_bf16(V1, P1, O[dt], 0, 0, 0);
    }
}
__device__ __forceinline__ void att_pv(const LAS unsigned char* buf, int sub, const float (&p)[16], f32x16 (&O)[2], int lane) {
    const bf16x8 P0 = pack8(p[0], p[1], p[2], p[3], p[4], p[5], p[6], p[7]);
    const bf16x8 P1 = pack8(p[8], p[9], p[10], p[11], p[12], p[13], p[14], p[15]);
    att_pv2(buf, sub, P0, P1, O, lane);
}

__device__ __forceinline__ void att_kfrags(const LAS unsigned char* buf, int sub, bf16x8 (&Kf)[4], int lane) {
    const LAS unsigned char* kp = buf + (sub * 32 + (lane & 31)) * 144 + (lane >> 5) * 16;
#pragma unroll
    for (int ks = 0; ks < 4; ++ks) Kf[ks] = *(const LAS bf16x8*)(kp + ks * 32);
}
__device__ __forceinline__ void att_vfrags(const LAS unsigned char* buf, int sub, bf16x8 (&Vf)[2][2], int lane) {
    const int h = lane >> 5;
#pragma unroll
    for (int dt = 0; dt < 2; ++dt) {
        const LAS unsigned char* vp = buf + AT_KB + (dt * 32 + (lane & 31)) * 136 + (sub * 32 + 4 * h) * 2;
        const u32x2 a0 = *(const LAS u32x2*)(vp), a1 = *(const LAS u32x2*)(vp + 16), b0 = *(const LAS u32x2*)(vp + 32), b1 = *(const LAS u32x2*)(vp + 48);
        Vf[dt][0] = __builtin_bit_cast(bf16x8, ((u32x4){a0.x, a0.y, a1.x, a1.y}));
        Vf[dt][1] = __builtin_bit_cast(bf16x8, ((u32x4){b0.x, b0.y, b1.x, b1.y}));
    }
}
__device__ __forceinline__ f32x16 att_qk_f(const bf16x8 (&Kf)[4], const bf16x8 (&Qf)[4]) {
    f32x16 S = {0.f, 0.f, 0.f, 0.f, 0.f, 0.f, 0.f, 0.f, 0.f, 0.f, 0.f, 0.f, 0.f, 0.f, 0.f, 0.f};
#pragma unroll
    for (int ks = 0; ks < 4; ++ks) S = __builtin_amdgcn_mfma_f32_32x32x16_bf16(Kf[ks], Qf[ks], S, 0, 0, 0);
    return S;
}
__device__ __forceinline__ void att_pv_f(const bf16x8 (&Vf)[2][2], const bf16x8 P0, const bf16x8 P1, f32x16 (&O)[2]) {
#pragma unroll
    for (int dt = 0; dt < 2; ++dt) { O[dt] = __builtin_amdgcn_mfma_f32_32x32x16_bf16(Vf[dt][0], P0, O[dt], 0, 0, 0); O[dt] = __builtin_amdgcn_mfma_f32_32x32x16_bf16(Vf[dt][1], P1, O[dt], 0, 0, 0); }
}

__device__ __forceinline__ void p_dsa_attn(const Frame& F, const Args& a, unsigned char* ws) {
    const bf16_t* QA = (const bf16_t*)(ws + L0_QA); const bf16_t* KA = (const bf16_t*)(ws + L0_KA); const bf16_t* VAT = (const bf16_t*)(ws + L0_VAT);
    const u64* SELT = (const u64*)(ws + L0_SELT); bf16_t* CAT = (bf16_t*)(ws + L0_CAT);
    const int lane = F.lane, wave = F.wave, h = lane >> 5, c = lane & 31, tid = F.tid;
    float mq = 0.f, mk_ = 0.f;
    for (int i = 0; i < 64; ++i) { mq = fmaxf(mq, fabsf(a.in[I_L0_QG][i])); mk_ = fmaxf(mk_, fabsf(a.in[I_L0_KG][i])); }
    const float c2 = (8.0f * mq * mk_ + 0.5f) * 1.4426950408889634f, c1 = 1.4426950408889634f;
    if (tid < 16) { u32x2 e; e.x = ((tid & 1) ? 0xFFFFu : 0u) | ((tid & 2) ? 0xFFFF0000u : 0u); e.y = ((tid & 4) ? 0xFFFFu : 0u) | ((tid & 8) ? 0xFFFF0000u : 0u); *(LAS u32x2*)(F.lds + AT_MT + tid * 8) = e; }
    const bf16x8 ones = __builtin_bit_cast(bf16x8, ((u32x4){0x3F803F80u, 0x3F803F80u, 0x3F803F80u, 0x3F803F80u}));
    for (int u = F.bid; u < 512; u += F.G) {
        const int idx = u & 255, g = u >> 8, b = idx >> 5, qtr = idx & 31, qt = g ? 31 - qtr : qtr, q0 = qt * 128;
        const size_t mb = (size_t)b * 4096;
        const bf16_t* Kg = KA + (size_t)(b * 2 + g) * 4096 * 64; const bf16_t* Vtg = VAT + (size_t)(b * 2 + g) * 64 * 4096;
        bf16x8 Qf[2][4]; int qidx[2];
#pragma unroll
        for (int ct = 0; ct < 2; ++ct) { qidx[ct] = q0 + wave * 16 + ct * 8 + (c >> 2);
#pragma unroll
            for (int ks = 0; ks < 4; ++ks) Qf[ct][ks] = *(const bf16x8*)(QA + (mb + qidx[ct]) * 512 + (g * 4 + (c & 3)) * 64 + ks * 16 + 8 * h); }
        f32x16 O[2][2], Lacc[2];
#pragma unroll
        for (int ct = 0; ct < 2; ++ct) {
#pragma unroll
            for (int i = 0; i < 16; ++i) Lacc[ct][i] = 0.f;
#pragma unroll
            for (int dt = 0; dt < 2; ++dt)
#pragma unroll
                for (int i = 0; i < 16; ++i) O[ct][dt][i] = 0.f;
        }
        const int nkt = 2 * qt + 2;
        AttStage st; att_load(st, Kg, Vtg, 0, tid);
        __syncthreads();
        att_store(st, F.lds, tid);
        __syncthreads();
        for (int kt = 0; kt < nkt; ++kt) {
            LAS unsigned char* buf = F.lds + (kt & 1) * AT_BUF;
            if (kt + 1 < nkt) att_load(st, Kg, Vtg, (kt + 1) * 64, tid);
            u64 mw[2];
#pragma unroll
            for (int ct = 0; ct < 2; ++ct) mw[ct] = SELT[(size_t)(b * 64 + kt) * 4096 + qidx[ct]];
#pragma unroll 1
            for (int sub = 0; sub < 2; ++sub) {
                bf16x8 Kf[4], Vf[2][2];
                att_kfrags(buf, sub, Kf, lane); att_vfrags(buf, sub, Vf, lane);
#pragma unroll
                for (int ct = 0; ct < 2; ++ct) {
                    __builtin_amdgcn_sched_barrier(0);
                    const f32x16 S = att_qk_f(Kf, Qf[ct]);
                    const unsigned mr = (((unsigned)(mw[ct] >> (sub * 32 + 4 * h))) & 0x0F0F0F0Fu) << 3;
                    u32x2 mk[4];
#pragma unroll
                    for (int q4 = 0; q4 < 4; ++q4) mk[q4] = *(const LAS u32x2*)(F.lds + AT_MT + __builtin_amdgcn_ubfe(mr, 8 * q4, 7));
                    unsigned pw[8];
#pragma unroll
                    for (int q4 = 0; q4 < 4; ++q4) {
                        const float e0 = __builtin_amdgcn_exp2f(S[4 * q4] * c1 - c2), e1 = __builtin_amdgcn_exp2f(S[4 * q4 + 1] * c1 - c2);
                        const float e2 = __builtin_amdgcn_exp2f(S[4 * q4 + 2] * c1 - c2), e3 = __builtin_amdgcn_exp2f(S[4 * q4 + 3] * c1 - c2);
                        pw[2 * q4] = cvt_pk_bf16_s(e0, e1) & mk[q4].x; pw[2 * q4 + 1] = cvt_pk_bf16_s(e2, e3) & mk[q4].y;
                    }
                    const bf16x8 P0 = __builtin_bit_cast(bf16x8, ((u32x4){pw[0], pw[1], pw[2], pw[3]})), P1 = __builtin_bit_cast(bf16x8, ((u32x4){pw[4], pw[5], pw[6], pw[7]}));
                    att_pv_f(Vf, P0, P1, O[ct]);
                    Lacc[ct] = __builtin_amdgcn_mfma_f32_32x32x16_bf16(ones, P0, Lacc[ct], 0, 0, 0);
                    Lacc[ct] = __builtin_amdgcn_mfma_f32_32x32x16_bf16(ones, P1, Lacc[ct], 0, 0, 0);
                }
            }
            if (kt + 1 < nkt) att_store(st, F.lds + ((kt + 1) & 1) * AT_BUF, tid);
            __syncthreads();
        }
#pragma unroll
        for (int ct = 0; ct < 2; ++ct) {
            const float lt = Lacc[ct][0];
            const float inv = __builtin_amdgcn_rcpf(fmaxf(lt, 1e-30f));
            bf16_t* orow = CAT + (mb + qidx[ct]) * 1024 + (g * 4 + (c & 3)) * 64;
#pragma unroll
            for (int dt = 0; dt < 2; ++dt)
#pragma unroll
                for (int i4 = 0; i4 < 4; ++i4) {
                    const int d = dt * 32 + 8 * i4 + 4 * h;
                    u32x2 w; w.x = pk2(O[ct][dt][4 * i4] * inv, O[ct][dt][4 * i4 + 1] * inv); w.y = pk2(O[ct][dt][4 * i4 + 2] * inv, O[ct][dt][4 * i4 + 3] * inv);
                    *(u32x2*)(orow + d) = w;
                }
        }
    }
}

__device__ __forceinline__ void p_s5_scan(const Frame& F, const Args& a, unsigned char* ws) {
    const float* SLOC = (const float*)(ws + L0_SLOC); bf16_t* UA = (bf16_t*)(ws + L0_UA);
    const int p = F.lane;
    if (F.wave == 0) for (int it = F.bid; it < 32 * NB; it += F.G) {
        const int g = it >> 3, b = it & 7;
        const float dt = expf(a.in[I_L0_LOGDT][g]);
        const float lr = a.in[I_L0_ARE][g * 64 + p], li = a.in[I_L0_AIM][g * 64 + p];
        const float mag = expf(16.0f * dt * lr); float s, c; sincosf(16.0f * dt * li, &s, &c);
        const float ar = mag * c, ai = mag * s;
        float hr = 0.f, hi = 0.f;
        const float* sl = SLOC + ((size_t)g * 2048 + b * 256) * 128;
        bf16_t* ua = UA + ((size_t)g * 2048 + b * 256) * 384 + 256;
        for (int ch = 0; ch < 256; ++ch) {
            ua[(size_t)ch * 384 + p] = (bf16_t)f2bf(hr); ua[(size_t)ch * 384 + 64 + p] = (bf16_t)f2bf(hi);
            const float xr = sl[(size_t)ch * 128 + p], xi = sl[(size_t)ch * 128 + 64 + p];
            const float nr = ar * hr - ai * hi + xr, ni = ar * hi + ai * hr + xi;
            hr = nr; hi = ni;
        }
    }
}
namespace pg8 {
struct EpiS5State {
    static constexpr bool PERM = false;
    float* C;
    __device__ __forceinline__ void operator()(const f32x4 (&acc)[2][2][4][2], const Unit& u, int wr, int wc, int fr, int fq) const {
        const int row0 = u.pm * BM + wr * 64 + fr, col0 = wc * 32 + 4 * fq;
#pragma unroll
        for (int ai = 0; ai < 2; ++ai)
#pragma unroll
            for (int m = 0; m < 4; ++m)
#pragma unroll
                for (int n = 0; n < 2; ++n) *(f32x4*)(C + (size_t)(row0 + ai * HALF + m * 16) * 128 + col0 + n * 16) = acc[ai][0][m][n];
    }
};
struct EpiS5Out {
    static constexpr bool PERM = false;
    bf16_t* YB;
    __device__ __forceinline__ void operator()(const f32x4 (&acc)[2][2][4][2], const Unit& u, int wr, int wc, int fr, int fq) const {
        const int g = u.pn;
        const int row0 = u.pm * BM + wr * 64 + fr - g * 2048;
        const int col0 = wc * 32 + 4 * fq;
#pragma unroll
        for (int ai = 0; ai < 2; ++ai)
#pragma unroll
            for (int m = 0; m < 4; ++m) { const int chunk = row0 + ai * HALF + m * 16;
#pragma unroll
                for (int bj = 0; bj < 2; ++bj)
#pragma unroll
                    for (int n = 0; n < 2; ++n) { const int col = col0 + bj * HALF + n * 16, i = col >> 4, co = col & 15;
                        const f32x4 v = acc[ai][bj][m][n];
                        u32x2 w; w.x = pk2(gelu_tanh(v[0]), gelu_tanh(v[1])); w.y = pk2(gelu_tanh(v[2]), gelu_tanh(v[3]));
                        *(u32x2*)(YB + ((size_t)chunk * 16 + i) * 512 + g * 16 + co) = w; }
                asm volatile("" ::: "memory"); __builtin_amdgcn_sched_barrier(0); }
    }
};
struct EpiGlu {
    static constexpr bool PERM = true;
    const bf16_t* YB; const float* bias; bf16_t* CAT;
    __device__ __forceinline__ void operator()(const f32x4 (&acc)[2][2][4][2], const Unit& u, int wr, int wc, int fr, int fq) const {
        const int row0 = u.pm * BM + wr * 64 + fr, col0 = u.pn * BM + wc * 32 + 8 * fq;
#pragma unroll
        for (int ai = 0; ai < 2; ++ai)
#pragma unroll
            for (int m = 0; m < 4; ++m) { const size_t row = row0 + ai * HALF + m * 16;
#pragma unroll
                for (int bj = 0; bj < 2; ++bj) { const int col = col0 + bj * HALF;
                    const u32x4 yv = *(const u32x4*)(YB + row * 512 + col);
                    const f32x4 b0 = *(const f32x4*)(bias + col), b1 = *(const f32x4*)(bias + col + 4);
                    const f32x4 z0 = acc[ai][bj][m][0] + b0, z1 = acc[ai][bj][m][1] + b1;
                    u32x4 w;
                    w.x = pk2(bf_lo(yv.x) * sigmoidf_(z0[0]), bf_hi(yv.x) * sigmoidf_(z0[1])); w.y = pk2(bf_lo(yv.y) * sigmoidf_(z0[2]), bf_hi(yv.y) * sigmoidf_(z0[3]));
                    w.z = pk2(bf_lo(yv.z) * sigmoidf_(z1[0]), bf_hi(yv.z) * sigmoidf_(z1[1])); w.w = pk2(bf_lo(yv.w) * sigmoidf_(z1[2]), bf_hi(yv.w) * sigmoidf_(z1[3]));
                    *(u32x4*)(CAT + row * 1024 + 512 + col) = w; }
                asm volatile("" ::: "memory"); __builtin_amdgcn_sched_barrier(0); }
    }
};
}
__device__ __forceinline__ void peer_fold_wq(const Frame& F, const float* wq, const float* sk, bf16_t* WT) {
    const int gw = F.bid * NWAVES + F.wave, NGW = F.G * NWAVES, lane = F.lane, r = lane & 31, h = lane >> 5;
    for (int it = gw; it < 16 * 4 * 32; it += NGW) {
        const int dt = it & 31, kt = (it >> 5) & 3, hp = it >> 7;
        f32x16 acc = {0.f, 0.f, 0.f, 0.f, 0.f, 0.f, 0.f, 0.f, 0.f, 0.f, 0.f, 0.f, 0.f, 0.f, 0.f, 0.f};
        const float* ap = sk + ((size_t)hp * 128 + 32 * kt + r) * 128 + 8 * h;
        const float* bp = wq + (size_t)(32 * dt + r) * 2048 + hp * 128 + 8 * h;
#pragma unroll
        for (int ks = 0; ks < 8; ++ks) {
            const f32x4 a0 = *(const f32x4*)(ap + 16 * ks), a1 = *(const f32x4*)(ap + 16 * ks + 4), b0 = *(const f32x4*)(bp + 16 * ks), b1 = *(const f32x4*)(bp + 16 * ks + 4);
            acc = __builtin_amdgcn_mfma_f32_32x32x16_bf16(pack8(a0[0], a0[1], a0[2], a0[3], a1[0], a1[1], a1[2], a1[3]), pack8(b0[0], b0[1], b0[2], b0[3], b1[0], b1[1], b1[2], b1[3]), acc, 0, 0, 0);
        }
#pragma unroll
        for (int i = 0; i < 16; ++i) WT[((size_t)hp * 128 + 32 * kt + (i & 3) + 8 * (i >> 2) + 4 * h) * 1024 + 32 * dt + r] = (bf16_t)f2bf(acc[i]);
    }
}
__device__ __forceinline__ unsigned mono_u32(float f) { const unsigned u = __builtin_bit_cast(unsigned, f); return u ^ ((u >> 31) ? 0xFFFFFFFFu : 0x80000000u); }
#define CE_DESC(x, y) do { const unsigned _hi = (x) > (y) ? (x) : (y), _lo = (x) > (y) ? (y) : (x); (x) = _hi; (y) = _lo; } while (0)
__device__ __forceinline__ void sort16_desc(unsigned (&a)[16]) {
#pragma unroll
    for (int k = 2; k <= 16; k <<= 1)
#pragma unroll
        for (int j = k >> 1; j > 0; j >>= 1)
#pragma unroll
            for (int i = 0; i < 16; ++i) { const int l = i ^ j; if (l > i) { if ((i & k) == 0) CE_DESC(a[i], a[l]); else CE_DESC(a[l], a[i]); } }
}
__device__ __forceinline__ void merge16_desc(unsigned (&a)[16], const unsigned (&b)[16]) {
#pragma unroll
    for (int i = 0; i < 16; ++i) a[i] = a[i] > b[15 - i] ? a[i] : b[15 - i];
#pragma unroll
    for (int j = 8; j > 0; j >>= 1)
#pragma unroll
        for (int i = 0; i < 16; ++i) { const int l = i ^ j; if (l > i) CE_DESC(a[i], a[l]); }
}
__device__ __forceinline__ void merge16_xlane(unsigned (&a)[16]) {
    unsigned b[16];
#pragma unroll
    for (int i = 0; i < 16; ++i) b[i] = (unsigned)__shfl_xor((int)a[i], 32);
    merge16_desc(a, b);
}
struct PeerCand { int a[50], b[50]; };
__host__ __device__ constexpr PeerCand peer_cands() { PeerCand c{}; int n = 0; for (int a = 0; a < 16; ++a) for (int b = 0; b < 16; ++b) if ((a + 1) * (b + 1) <= 16) { c.a[n] = a; c.b[n] = b; ++n; } return c; }
__device__ __forceinline__ void p_peer_route(const Frame& F, unsigned char* ws) {
    const _Float16* S16 = (const _Float16*)(ws + PE_Q2); unsigned short* EID = (unsigned short*)(ws + PE_EID); float* GATE = (float*)(ws + PE_GATE);
    LAS float* sc0 = (LAS float*)F.lds;
    const int lane = F.lane, wave = F.wave, h5 = lane >> 5, r = lane & 31, tid = F.tid;
    constexpr PeerCand PC = peer_cands();
    u32x4 pre[8];
    { const int u = F.bid; if (u < 2048) { const int hd = u & 7, mt = u >> 3;
#pragma unroll
        for (int q = 0; q < 8; ++q) pre[q] = *(const u32x4*)(S16 + ((size_t)mt * 128 + (q & 3) * 32 + (tid >> 4)) * 2048 + (hd * 2 + (q >> 2)) * 128 + (tid & 15) * 8); } }
    for (int u = F.bid; u < 2048; u += F.G) {
        const int hd = u & 7, mt = u >> 3; const size_t m0 = (size_t)mt * 128;
#pragma unroll
        for (int q = 0; q < 8; ++q) {
            LAS float* dst = sc0 + (q >> 2) * 128 * 129 + ((q & 3) * 32 + (tid >> 4)) * 129 + (tid & 15) * 8;
            const u32x4 v = pre[q];
#pragma unroll
            for (int j = 0; j < 4; ++j) { const unsigned w = v[j]; dst[2 * j] = (float)__builtin_bit_cast(_Float16, (unsigned short)(w & 0xffffu)); dst[2 * j + 1] = (float)__builtin_bit_cast(_Float16, (unsigned short)(w >> 16)); }
        }
        { const int un = u + F.G; if (un < 2048) { const int hdn = un & 7, mtn = un >> 3;
#pragma unroll
            for (int q = 0; q < 8; ++q) pre[q] = *(const u32x4*)(S16 + ((size_t)mtn * 128 + (q & 3) * 32 + (tid >> 4)) * 2048 + (hdn * 2 + (q >> 2)) * 128 + (tid & 15) * 8); } }
        __syncthreads();
        {
            const int pp = wave >> 2, row = (wave & 3) * 32 + r, half = h5; LAS float* rowp = sc0 + pp * 128 * 129 + row * 129;
            unsigned top[16];
#pragma unroll
            for (int blk = 0; blk < 4; ++blk) {
                unsigned k16[16];
#pragma unroll
                for (int i = 0; i < 16; ++i) { const int j = half * 64 + blk * 16 + i; k16[i] = (mono_u32(rowp[j]) & ~0x7Fu) | (unsigned)(127 - j); }
                sort16_desc(k16);
                if (blk == 0) {
#pragma unroll
                    for (int i = 0; i < 16; ++i) top[i] = k16[i];
                } else merge16_desc(top, k16);
            }
            merge16_xlane(top);
            float vals[16]; int ids[16];
#pragma unroll
            for (int k = 0; k < 16; ++k) { ids[k] = 127 - (int)(top[k] & 127u); vals[k] = rowp[ids[k]]; }
            if (half == 0) {
#pragma unroll
                for (int k = 0; k < 16; ++k) { rowp[k] = vals[k]; rowp[16 + k] = __int_as_float(ids[k]); }
            }
        }
        __syncthreads();
        if (tid < 256) {
            const int row = (wave & 3) * 32 + r, half = h5; const LAS float* s1 = sc0 + row * 129; const LAS float* s2 = sc0 + 128 * 129 + row * 129;
            float v1[16], v2[16];
#pragma unroll
            for (int k = 0; k < 16; ++k) { v1[k] = s1[k]; v2[k] = s2[k]; }
            unsigned top[16], k16[16];
#pragma unroll
            for (int i = 0; i < 16; ++i) { const int c0 = 2 * i, c1 = 2 * i + 1;
                const unsigned ka = (mono_u32(v1[PC.a[c0]] + v2[PC.b[c0]]) & ~0xFFu) | (unsigned)(255 - (PC.a[c0] * 16 + PC.b[c0]));
                const unsigned kb = (mono_u32(v1[PC.a[c1]] + v2[PC.b[c1]]) & ~0xFFu) | (unsigned)(255 - (PC.a[c1] * 16 + PC.b[c1]));
                top[i] = half ? kb : ka; }
#pragma unroll
            for (int i = 0; i < 16; ++i) { if (i < 9) { const int c0 = 32 + 2 * i, c1 = 32 + 2 * i + 1;
                    const unsigned ka = (mono_u32(v1[PC.a[c0]] + v2[PC.b[c0]]) & ~0xFFu) | (unsigned)(255 - (PC.a[c0] * 16 + PC.b[c0]));
                    const unsigned kb = (mono_u32(v1[PC.a[c1]] + v2[PC.b[c1]]) & ~0xFFu) | (unsigned)(255 - (PC.a[c1] * 16 + PC.b[c1]));
                    k16[i] = half ? kb : ka; } else k16[i] = 0u; }
            sort16_desc(top); sort16_desc(k16); merge16_desc(top, k16);
            merge16_xlane(top);
            if (half == 0) {
                float mx = -3.0e38f; float sv[16]; int eid[16];
#pragma unroll
                for (int k = 0; k < 16; ++k) { const int fl = 255 - (int)(top[k] & 255u), a = fl >> 4, b = fl & 15;
                    sv[k] = s1[a] + s2[b]; eid[k] = __float_as_int(s1[16 + a]) * 128 + __float_as_int(s2[16 + b]); mx = fmaxf(mx, sv[k]); }
                float den = 0.f;
#pragma unroll
                for (int k = 0; k < 16; ++k) { sv[k] = __expf(sv[k] - mx); den += sv[k]; }
                const float inv = 1.0f / den;
                unsigned short* ep = EID + (m0 + row) * 128 + hd * 16; float* gp = GATE + (m0 + row) * 128 + hd * 16;
#pragma unroll
                for (int k = 0; k < 16; ++k) { ep[k] = (unsigned short)eid[k]; gp[k] = sv[k] * inv; }
            }
        }
        __syncthreads();
    }
}

__device__ __forceinline__ float rdlane_f(float v, int l) { return __builtin_bit_cast(float, __builtin_amdgcn_readlane(__builtin_bit_cast(int, v), l)); }
__device__ __forceinline__ void p_peer_expert(const Frame& F, unsigned char* ws, float* xres) {
    const bf16_t* XN = (const bf16_t*)(ws + WS_XN); const bf16_t* TU = (const bf16_t*)(ws + WS_TABU); const bf16_t* TV = (const bf16_t*)(ws + WS_TABV);
    const unsigned short* EID = (const unsigned short*)(ws + PE_EID); const float* GATE = (const float*)(ws + PE_GATE);
    const int gw = F.bid * NWAVES + F.wave, NGW = F.G * NWAVES, lane = F.lane;
    for (int m = gw; m < T; m += NGW) {
        float xf[16];
        { const u32x4 xa = *(const u32x4*)(XN + (size_t)m * 1024 + lane * 8), xb = *(const u32x4*)(XN + (size_t)m * 1024 + 512 + lane * 8);
          xf[0] = bf_lo(xa.x); xf[1] = bf_hi(xa.x); xf[2] = bf_lo(xa.y); xf[3] = bf_hi(xa.y); xf[4] = bf_lo(xa.z); xf[5] = bf_hi(xa.z); xf[6] = bf_lo(xa.w); xf[7] = bf_hi(xa.w);
          xf[8] = bf_lo(xb.x); xf[9] = bf_hi(xb.x); xf[10] = bf_lo(xb.y); xf[11] = bf_hi(xb.y); xf[12] = bf_lo(xb.z); xf[13] = bf_hi(xb.z); xf[14] = bf_lo(xb.w); xf[15] = bf_hi(xb.w); }
        const int id0 = EID[(size_t)m * 128 + lane], id1 = EID[(size_t)m * 128 + 64 + lane];
        const float g0 = GATE[(size_t)m * 128 + lane], g1 = GATE[(size_t)m * 128 + 64 + lane];
        float outv[16];
#pragma unroll
        for (int i = 0; i < 16; ++i) outv[i] = 0.f;
#pragma unroll 1
        for (int k = 0; k < 16; ++k) {
            const int idreg = (k < 8) ? id0 : id1; const float greg = (k < 8) ? g0 : g1; const int lbase = (k & 7) * 8;
            int e[8];
#pragma unroll
            for (int i = 0; i < 8; ++i) e[i] = __builtin_amdgcn_readlane(idreg, lbase + i);
            float pr[8];
            {
                u32x4 ua[8], ub[8];
#pragma unroll
                for (int i = 0; i < 8; ++i) { ua[i] = *(const u32x4*)(TU + (size_t)e[i] * 1024 + lane * 8); ub[i] = *(const u32x4*)(TU + (size_t)e[i] * 1024 + 512 + lane * 8); }
#pragma unroll
                for (int i = 0; i < 8; ++i) {
                    float s = xf[0] * bf_lo(ua[i].x); s += xf[1] * bf_hi(ua[i].x); s += xf[2] * bf_lo(ua[i].y); s += xf[3] * bf_hi(ua[i].y);
                    s += xf[4] * bf_lo(ua[i].z); s += xf[5] * bf_hi(ua[i].z); s += xf[6] * bf_lo(ua[i].w); s += xf[7] * bf_hi(ua[i].w);
                    s += xf[8] * bf_lo(ub[i].x); s += xf[9] * bf_hi(ub[i].x); s += xf[10] * bf_lo(ub[i].y); s += xf[11] * bf_hi(ub[i].y);
                    s += xf[12] * bf_lo(ub[i].z); s += xf[13] * bf_hi(ub[i].z); s += xf[14] * bf_lo(ub[i].w); s += xf[15] * bf_hi(ub[i].w);
                    pr[i] = s;
                }
            }
            float r4[4], r2[2], r1;
            { const bool up = (lane & 32) != 0;
#pragma unroll
              for (int i = 0; i < 4; ++i) { const float keep = up ? pr[i + 4] : pr[i], send = up ? pr[i] : pr[i + 4]; r4[i] = keep + __shfl_xor(send, 32); } }
            { const bool up = (lane & 16) != 0;
#pragma unroll
              for (int i = 0; i < 2; ++i) { const float keep = up ? r4[i + 2] : r4[i], send = up ? r4[i] : r4[i + 2]; r2[i] = keep + __shfl_xor(send, 16); } }
            { const bool up = (lane & 8) != 0; const float keep = up ? r2[1] : r2[0], send = up ? r2[0] : r2[1]; r1 = keep + __shfl_xor(send, 8); }
            r1 += __shfl_xor(r1, 4); r1 += __shfl_xor(r1, 2); r1 += __shfl_xor(r1, 1);
            const float gv = __shfl(greg, lbase + (lane >> 3));
            const float coef = gv * gelu_tanh(r1);
            {
                u32x4 va[8], vb[8];
#pragma unroll
                for (int i = 0; i < 8; ++i) { va[i] = *(const u32x4*)(TV + (size_t)e[i] * 1024 + lane * 8); vb[i] = *(const u32x4*)(TV + (size_t)e[i] * 1024 + 512 + lane * 8); }
#pragma unroll
                for (int i = 0; i < 8; ++i) {
                    const float ci = rdlane_f(coef, i * 8);
                    outv[0] += ci * bf_lo(va[i].x); outv[1] += ci * bf_hi(va[i].x); outv[2] += ci * bf_lo(va[i].y); outv[3] += ci * bf_hi(va[i].y);
                    outv[4] += ci * bf_lo(va[i].z); outv[5] += ci * bf_hi(va[i].z); outv[6] += ci * bf_lo(va[i].w); outv[7] += ci * bf_hi(va[i].w);
                    outv[8] += ci * bf_lo(vb[i].x); outv[9] += ci * bf_hi(vb[i].x); outv[10] += ci * bf_lo(vb[i].y); outv[11] += ci * bf_hi(vb[i].y);
                    outv[12] += ci * bf_lo(vb[i].z); outv[13] += ci * bf_hi(vb[i].z); outv[14] += ci * bf_lo(vb[i].w); outv[15] += ci * bf_hi(vb[i].w);
                }
            }
        }
        f32x4* o = (f32x4*)(xres + (size_t)m * 1024 + lane * 8);
        f32x4 a0 = o[0], a1 = o[1], b0 = o[128], b1 = o[129];
        a0 += (f32x4){outv[0], outv[1], outv[2], outv[3]}; a1 += (f32x4){outv[4], outv[5], outv[6], outv[7]};
        b0 += (f32x4){outv[8], outv[9], outv[10], outv[11]}; b1 += (f32x4){outv[12], outv[13], outv[14], outv[15]};
        o[0] = a0; o[1] = a1; o[128] = b0; o[129] = b1;
    }
}

typedef __bf16 bf16x2_t __attribute__((ext_vector_type(2)));
__device__ __forceinline__ float dot2bf(unsigned a, unsigned b, float c) { return __builtin_amdgcn_fdot2_f32_bf16(__builtin_bit_cast(bf16x2_t, a), __builtin_bit_cast(bf16x2_t, b), c, false); }
__device__ __forceinline__ void peer_slot_range(const unsigned (&xp)[8], float (&outv)[16], int id0, int id1, float g0, float g1, int r,
                                                const bf16_t* TU, const bf16_t* TV, int lane) {
    u64 m0 = __ballot((id0 >> 9) == r), m1 = __ballot((id1 >> 9) == r);
    while (m0 | m1) {
        int e[8]; float gt[8];
#pragma unroll
        for (int i = 0; i < 8; ++i) {
            if (m0) { const int l = __builtin_ctzll(m0); m0 &= m0 - 1ull; e[i] = __builtin_amdgcn_readlane(id0, l); gt[i] = rdlane_f(g0, l); }
            else if (m1) { const int l = __builtin_ctzll(m1); m1 &= m1 - 1ull; e[i] = __builtin_amdgcn_readlane(id1, l); gt[i] = rdlane_f(g1, l); }
            else { e[i] = -1; gt[i] = 0.f; }
        }
        float pr[8];
        {
            u32x4 ua[8], ub[8];
#pragma unroll
            for (int i = 0; i < 8; ++i) {
                if (e[i] >= 0) { ua[i] = *(const u32x4*)(TU + (size_t)e[i] * 1024 + lane * 8); ub[i] = *(const u32x4*)(TU + (size_t)e[i] * 1024 + 512 + lane * 8); }
                else { ua[i] = (u32x4){0u, 0u, 0u, 0u}; ub[i] = (u32x4){0u, 0u, 0u, 0u}; }
            }
#pragma unroll
            for (int i = 0; i < 8; ++i) {
                float s = dot2bf(xp[0], ua[i].x, 0.f); s = dot2bf(xp[1], ua[i].y, s); s = dot2bf(xp[2], ua[i].z, s); s = dot2bf(xp[3], ua[i].w, s);
                s = dot2bf(xp[4], ub[i].x, s); s = dot2bf(xp[5], ub[i].y, s); s = dot2bf(xp[6], ub[i].z, s); s = dot2bf(xp[7], ub[i].w, s);
                pr[i] = s;
            }
        }
        float r4[4], r2[2], r1;
        { const bool up = (lane & 32) != 0;
#pragma unroll
          for (int i = 0; i < 4; ++i) { const float keep = up ? pr[i + 4] : pr[i], send = up ? pr[i] : pr[i + 4]; r4[i] = keep + __shfl_xor(send, 32); } }
        { const bool up = (lane & 16) != 0;
#pragma unroll
          for (int i = 0; i < 2; ++i) { const float keep = up ? r4[i + 2] : r4[i], send = up ? r4[i] : r4[i + 2]; r2[i] = keep + __shfl_xor(send, 16); } }
        { const bool up = (lane & 8) != 0; const float keep = up ? r2[1] : r2[0], send = up ? r2[0] : r2[1]; r1 = keep + __shfl_xor(send, 8); }
        r1 += __shfl_xor(r1, 4); r1 += __shfl_xor(r1, 2); r1 += __shfl_xor(r1, 1);
        const int grp = lane >> 3;
        float gsel = gt[0];
#pragma unroll
        for (int i = 1; i < 8; ++i) gsel = (grp == i) ? gt[i] : gsel;
        const float coef = gsel * gelu_tanh(r1);
        {
            u32x4 va[8], vb[8];
#pragma unroll
            for (int i = 0; i < 8; ++i) {
                if (e[i] >= 0) { va[i] = *(const u32x4*)(TV + (size_t)e[i] * 1024 + lane * 8); vb[i] = *(const u32x4*)(TV + (size_t)e[i] * 1024 + 512 + lane * 8); }
                else { va[i] = (u32x4){0u, 0u, 0u, 0u}; vb[i] = (u32x4){0u, 0u, 0u, 0u}; }
            }
#pragma unroll
            for (int i = 0; i < 8; ++i) {
                if (e[i] >= 0) {
                    const float ci = rdlane_f(coef, i * 8);
                    outv[0] += ci * bf_lo(va[i].x); outv[1] += ci * bf_hi(va[i].x); outv[2] += ci * bf_lo(va[i].y); outv[3] += ci * bf_hi(va[i].y);
                    outv[4] += ci * bf_lo(va[i].z); outv[5] += ci * bf_hi(va[i].z); outv[6] += ci * bf_lo(va[i].w); outv[7] += ci * bf_hi(va[i].w);
                    outv[8] += ci * bf_lo(vb[i].x); outv[9] += ci * bf_hi(vb[i].x); outv[10] += ci * bf_lo(vb[i].y); outv[11] += ci * bf_hi(vb[i].y);
                    outv[12] += ci * bf_lo(vb[i].z); outv[13] += ci * bf_hi(vb[i].z); outv[14] += ci * bf_lo(vb[i].w); outv[15] += ci * bf_hi(vb[i].w);
                }
            }
        }
    }
}
__device__ __forceinline__ void p_peer_expert2(const Frame& F, unsigned char* ws, float* xres, const float oscale) {
    const bf16_t* XN = (const bf16_t*)(ws + WS_XN); const bf16_t* TU = (const bf16_t*)(ws + WS_TABU); const bf16_t* TV = (const bf16_t*)(ws + WS_TABV);
    const unsigned short* EID = (const unsigned short*)(ws + PE_EID); const float* GATE = (const float*)(ws + PE_GATE);
    const int gw = F.bid * NWAVES + F.wave, NGW = F.G * NWAVES, lane = F.lane;
    int rnd = 0;
    for (int m4 = gw * 4; m4 < T; m4 += NGW * 4, ++rnd) {
        unsigned xp[4][8]; float outv[4][16]; int id[4][2]; float gg[4][2];
#pragma unroll
        for (int s = 0; s < 4; ++s) {
            const size_t m = (size_t)(m4 + s);
            const u32x4 xa = *(const u32x4*)(XN + m * 1024 + lane * 8), xb = *(const u32x4*)(XN + m * 1024 + 512 + lane * 8);
            xp[s][0] = xa.x; xp[s][1] = xa.y; xp[s][2] = xa.z; xp[s][3] = xa.w; xp[s][4] = xb.x; xp[s][5] = xb.y; xp[s][6] = xb.z; xp[s][7] = xb.w;
            id[s][0] = EID[m * 128 + lane]; id[s][1] = EID[m * 128 + 64 + lane]; gg[s][0] = GATE[m * 128 + lane]; gg[s][1] = GATE[m * 128 + 64 + lane];
#pragma unroll
            for (int i = 0; i < 16; ++i) outv[s][i] = 0.f;
        }
#pragma unroll 1
        for (int k = 0; k < 32; ++k) {
            const int r = (rnd & 1) ? 31 - k : k;
#pragma unroll
            for (int s = 0; s < 4; ++s) peer_slot_range(xp[s], outv[s], id[s][0], id[s][1], gg[s][0], gg[s][1], r, TU, TV, lane);
        }
#pragma unroll
        for (int s = 0; s < 4; ++s) {
            f32x4* o = (f32x4*)(xres + (size_t)(m4 + s) * 1024 + lane * 8);
            f32x4 a0 = o[0], a1 = o[1], b0 = o[128], b1 = o[129];
            a0 += (f32x4){outv[s][0], outv[s][1], outv[s][2], outv[s][3]} * oscale; a1 += (f32x4){outv[s][4], outv[s][5], outv[s][6], outv[s][7]} * oscale;
            b0 += (f32x4){outv[s][8], outv[s][9], outv[s][10], outv[s][11]} * oscale; b1 += (f32x4){outv[s][12], outv[s][13], outv[s][14], outv[s][15]} * oscale;
            o[0] = a0; o[1] = a1; o[128] = b0; o[129] = b1;
        }
    }
}

struct RowBuf { u32x4 a[8], b[8]; };
__device__ __forceinline__ void peer_load8(RowBuf& rb, const bf16_t* TAB, const LAS unsigned* ent, int b, int lane) {
#pragma unroll
    for (int i = 0; i < 8; ++i) {
        const unsigned e = (unsigned)__builtin_amdgcn_readfirstlane((int)ent[b * 8 + i]) & 0x3FFFu;
        const bf16_t* rp = TAB + (size_t)e * 1024 + lane * 8;
        rb.a[i] = *(const u32x4*)rp; rb.b[i] = *(const u32x4*)(rp + 512);
    }
}
__device__ __forceinline__ float peer_dot(const unsigned (&xp)[8], const u32x4 a, const u32x4 b) {
    float s = dot2bf(xp[0], a.x, 0.f); s = dot2bf(xp[1], a.y, s); s = dot2bf(xp[2], a.z, s); s = dot2bf(xp[3], a.w, s);
    s = dot2bf(xp[4], b.x, s); s = dot2bf(xp[5], b.y, s); s = dot2bf(xp[6], b.z, s); s = dot2bf(xp[7], b.w, s);
    return s;
}
__device__ __forceinline__ void peer_u8(const RowBuf& rb, const unsigned (&xp)[4][8], const LAS unsigned* ent, LAS float* cf, int b, int lane) {
    float pr[8];
#pragma unroll
    for (int i = 0; i < 8; ++i) {
        const int slot = (__builtin_amdgcn_readfirstlane((int)ent[b * 8 + i]) >> 21) & 3;
        if (slot == 0) pr[i] = peer_dot(xp[0], rb.a[i], rb.b[i]);
        else if (slot == 1) pr[i] = peer_dot(xp[1], rb.a[i], rb.b[i]);
        else if (slot == 2) pr[i] = peer_dot(xp[2], rb.a[i], rb.b[i]);
        else pr[i] = peer_dot(xp[3], rb.a[i], rb.b[i]);
    }
    float r4[4], r2[2], r1;
    { const bool up = (lane & 32) != 0;
#pragma unroll
      for (int i = 0; i < 4; ++i) { const float keep = up ? pr[i + 4] : pr[i], send = up ? pr[i] : pr[i + 4]; r4[i] = keep + __shfl_xor(send, 32); } }
    { const bool up = (lane & 16) != 0;
#pragma unroll
      for (int i = 0; i < 2; ++i) { const float keep = up ? r4[i + 2] : r4[i], send = up ? r4[i] : r4[i + 2]; r2[i] = keep + __shfl_xor(send, 16); } }
    { const bool up = (lane & 8) != 0; const float keep = up ? r2[1] : r2[0], send = up ? r2[0] : r2[1]; r1 = keep + __shfl_xor(send, 8); }
    r1 += __shfl_xor(r1, 4); r1 += __shfl_xor(r1, 2); r1 += __shfl_xor(r1, 1);
    const float gate = cf[b * 8 + (lane >> 3)];
    const float coef = gate * gelu_tanh(r1);
    if ((lane & 7) == 0) cf[b * 8 + (lane >> 3)] = coef;
}
__device__ __forceinline__ void peer_acc(float (&o)[16], const float c, const u32x4 a, const u32x4 b) {
    o[0] += c * bf_lo(a.x); o[1] += c * bf_hi(a.x); o[2] += c * bf_lo(a.y); o[3] += c * bf_hi(a.y);
    o[4] += c * bf_lo(a.z); o[5] += c * bf_hi(a.z); o[6] += c * bf_lo(a.w); o[7] += c * bf_hi(a.w);
    o[8] += c * bf_lo(b.x); o[9] += c * bf_hi(b.x); o[10] += c * bf_lo(b.y); o[11] += c * bf_hi(b.y);
    o[12] += c * bf_lo(b.z); o[13] += c * bf_hi(b.z); o[14] += c * bf_lo(b.w); o[15] += c * bf_hi(b.w);
}
__device__ __forceinline__ void peer_v8(const RowBuf& rb, float (&outv)[4][16], const LAS unsigned* ent, const LAS float* cf, int b) {
#pragma unroll
    for (int i = 0; i < 8; ++i) {
        const int slot = (__builtin_amdgcn_readfirstlane((int)ent[b * 8 + i]) >> 21) & 3;
        const float c = cf[b * 8 + i];
        if (slot == 0) peer_acc(outv[0], c, rb.a[i], rb.b[i]);
        else if (slot == 1) peer_acc(outv[1], c, rb.a[i], rb.b[i]);
        else if (slot == 2) peer_acc(outv[2], c, rb.a[i], rb.b[i]);
        else peer_acc(outv[3], c, rb.a[i], rb.b[i]);
    }
}
__device__ __forceinline__ void p_peer_expert3(const Frame& F, unsigned char* ws, float* xres, const float oscale, const XcdBarrier& xbar) {
    const bf16_t* XN = (const bf16_t*)(ws + WS_XN); const bf16_t* TU = (const bf16_t*)(ws + WS_TABU); const bf16_t* TV = (const bf16_t*)(ws + WS_TABV);
    const unsigned short* EID = (const unsigned short*)(ws + PE_EID); const float* GATE = (const float*)(ws + PE_GATE);
    const int gw = F.bid * NWAVES + F.wave, NGW = F.G * NWAVES, lane = F.lane;
    LAS unsigned* ent = (LAS unsigned*)(F.lds + F.wave * 4096);
    LAS float* cf = (LAS float*)(F.lds + F.wave * 4096 + 2048);
    const int nrounds = (T + NGW * 4 - 1) / (NGW * 4);
    for (int rnd = 0; rnd < nrounds; ++rnd) {
        const int m4 = (rnd * NGW + gw) * 4;
        if (m4 < T) {
            unsigned xp[4][8];
            {
                int id[4][2]; float gg[4][2];
#pragma unroll
                for (int s = 0; s < 4; ++s) {
                    const size_t m = (size_t)(m4 + s);
                    const u32x4 xa = *(const u32x4*)(XN + m * 1024 + lane * 8), xb = *(const u32x4*)(XN + m * 1024 + 512 + lane * 8);
                    xp[s][0] = xa.x; xp[s][1] = xa.y; xp[s][2] = xa.z; xp[s][3] = xa.w; xp[s][4] = xb.x; xp[s][5] = xb.y; xp[s][6] = xb.z; xp[s][7] = xb.w;
                    id[s][0] = EID[m * 128 + lane]; id[s][1] = EID[m * 128 + 64 + lane]; gg[s][0] = GATE[m * 128 + lane]; gg[s][1] = GATE[m * 128 + 64 + lane];
                }
                int base = 0;
#pragma unroll 1
                for (int k = 0; k < 32; ++k) {
                    const int r = (rnd & 1) ? 31 - k : k;
#pragma unroll
                    for (int s = 0; s < 4; ++s)
#pragma unroll
                        for (int w = 0; w < 2; ++w) {
                            const bool hit = (id[s][w] >> 9) == r;
                            const u64 m = __ballot(hit);
                            if (hit) { const int pos = base + (int)__builtin_amdgcn_mbcnt_hi((unsigned)(m >> 32), __builtin_amdgcn_mbcnt_lo((unsigned)m, 0u));
                                ent[pos] = ((unsigned)s << 21) | ((unsigned)(w * 64 + lane) << 14) | (unsigned)id[s][w]; cf[pos] = gg[s][w]; }
                            base += __builtin_popcountll(m);
                        }
                }
            }
            LDS_WAIT();
            {
                RowBuf A, B;
                peer_load8(A, TU, ent, 0, lane);
#pragma unroll 1
                for (int b = 0; b < 64; b += 2) {
                    peer_load8(B, TU, ent, b + 1, lane);
                    peer_u8(A, xp, ent, cf, b, lane);
                    if (b + 2 < 64) peer_load8(A, TU, ent, b + 2, lane);
                    peer_u8(B, xp, ent, cf, b + 1, lane);
                }
            }
            LDS_WAIT();
            float outv[4][16];
#pragma unroll
            for (int s = 0; s < 4; ++s)
#pragma unroll
                for (int i = 0; i < 16; ++i) outv[s][i] = 0.f;
            {
                RowBuf A, B;
                peer_load8(A, TV, ent, 0, lane);
#pragma unroll 1
                for (int b = 0; b < 64; b += 2) {
                    peer_load8(B, TV, ent, b + 1, lane);
                    peer_v8(A, outv, ent, cf, b);
                    if (b + 2 < 64) peer_load8(A, TV, ent, b + 2, lane);
                    peer_v8(B, outv, ent, cf, b + 1);
                }
            }
#pragma unroll
            for (int s = 0; s < 4; ++s) {
                f32x4* o = (f32x4*)(xres + (size_t)(m4 + s) * 1024 + lane * 8);
                f32x4 a0 = o[0], a1 = o[1], b0 = o[128], b1 = o[129];
                a0 += (f32x4){outv[s][0], outv[s][1], outv[s][2], outv[s][3]} * oscale; a1 += (f32x4){outv[s][4], outv[s][5], outv[s][6], outv[s][7]} * oscale;
                b0 += (f32x4){outv[s][8], outv[s][9], outv[s][10], outv[s][11]} * oscale; b1 += (f32x4){outv[s][12], outv[s][13], outv[s][14], outv[s][15]} * oscale;
                o[0] = a0; o[1] = a1; o[128] = b0; o[129] = b1;
            }
        }
        if (rnd + 1 < nrounds) xcd_barrier(xbar);
    }
}

constexpr size_t WS_TAB8U = WS_TABU;
constexpr size_t WS_TAB8V = WS_TABU + 16 * MiB;
constexpr size_t WS_TABSU = WS_TABU + 32 * MiB;
constexpr size_t WS_TABSV = WS_TABU + 32 * MiB + 65536;
__device__ __forceinline__ void cvt_table_fp8(const Frame& F, const float* src, unsigned char* dst, float* scales, const int skip) {
    const int nb = F.G > skip ? F.G - skip : F.G, b0 = F.G > skip ? F.bid - skip : F.bid;
    const int gw = b0 * NWAVES + F.wave, NGW = nb * NWAVES, lane = F.lane;
    if (b0 >= 0) for (int r = gw; r < 16384; r += NGW) {
        const f32x4* p = (const f32x4*)(src + (size_t)r * 1024 + lane * 16);
        f32x4 v[4]; float am = 0.f;
#pragma unroll
        for (int j = 0; j < 4; ++j) { v[j] = p[j]; am = fmaxf(am, fmaxf(fmaxf(fabsf(v[j].x), fabsf(v[j].y)), fmaxf(fabsf(v[j].z), fabsf(v[j].w)))); }
#pragma unroll
        for (int o = 1; o < 64; o <<= 1) am = fmaxf(am, __shfl_xor(am, o));
        const float sc = am > 0.f ? am * (1.0f / 448.0f) : 1.0f, inv = 1.0f / sc;
        u32x4 q;
#pragma unroll
        for (int j = 0; j < 4; ++j) { int w = 0; w = __builtin_amdgcn_cvt_pk_fp8_f32(v[j].x * inv, v[j].y * inv, w, false); w = __builtin_amdgcn_cvt_pk_fp8_f32(v[j].z * inv, v[j].w * inv, w, true); q[j] = (unsigned)w; }
        *(u32x4*)(dst + (size_t)r * 1024 + lane * 16) = q;
        if (lane == 0) scales[r] = sc;
    }
}
template <int NR> struct RowBufN { u32x4 a[NR]; };
template <int NR>
__device__ __forceinline__ void peer_loadN(RowBufN<NR>& rb, const unsigned char* TAB, const LAS unsigned* ent, int b, int lane) {
    const int ev = (int)ent[b * NR + (lane & (NR - 1))];
#pragma unroll
    for (int i = 0; i < NR; ++i) {
        const unsigned e = (unsigned)__builtin_amdgcn_readlane(ev, i) & 0x3FFFu;
        rb.a[i] = *(const u32x4*)(TAB + (size_t)e * 1024 + lane * 16);
    }
}
__device__ __forceinline__ float peer_dot8x(const u32x4 xa, const u32x4 xb, const u32x4 q) {
    float s = 0.f;
#pragma unroll
    for (int j = 0; j < 4; ++j) {
        const f32x2 lo = __builtin_amdgcn_cvt_pk_f32_fp8((int)q[j], false), hi = __builtin_amdgcn_cvt_pk_f32_fp8((int)q[j], true);
        const unsigned x0 = (j < 2) ? xa[2 * j] : xb[2 * j - 4], x1 = (j < 2) ? xa[2 * j + 1] : xb[2 * j - 3];
        s += bf_lo(x0) * lo.x; s += bf_hi(x0) * lo.y; s += bf_lo(x1) * hi.x; s += bf_hi(x1) * hi.y;
    }
    return s;
}
template <int NR>
__device__ __forceinline__ void peer_u8x(const RowBufN<NR>& rb, int r0, const LAS unsigned char* xl, const LAS unsigned* ent, LAS float* cf, const LAS float* sul, int e0, int lane) {
    float pr[8];
    const int ev = (int)ent[e0 + (lane & 7)];
#pragma unroll
    for (int i = 0; i < 8; ++i) {
        const int slot = (__builtin_amdgcn_readlane(ev, i) >> 21) & 3;
        const LAS unsigned char* xp = xl + slot * 2048 + lane * 32;
        const u32x4 xa = *(const LAS u32x4*)xp, xb = *(const LAS u32x4*)(xp + 16);
        pr[i] = peer_dot8x(xa, xb, rb.a[r0 + i]);
    }
    float r4[4], r2[2], r1;
    { const bool up = (lane & 32) != 0;
#pragma unroll
      for (int i = 0; i < 4; ++i) { const float keep = up ? pr[i + 4] : pr[i], send = up ? pr[i] : pr[i + 4]; r4[i] = keep + __shfl_xor(send, 32); } }
    { const bool up = (lane & 16) != 0;
#pragma unroll
      for (int i = 0; i < 2; ++i) { const float keep = up ? r4[i + 2] : r4[i], send = up ? r4[i] : r4[i + 2]; r2[i] = keep + __shfl_xor(send, 16); } }
    { const bool up = (lane & 8) != 0; const float keep = up ? r2[1] : r2[0], send = up ? r2[0] : r2[1]; r1 = keep + __shfl_xor(send, 8); }
    r1 += __shfl_xor(r1, 4); r1 += __shfl_xor(r1, 2); r1 += __shfl_xor(r1, 1);
    const float gate = cf[e0 + (lane >> 3)];
    const float coef = gate * gelu_tanh(r1 * sul[e0 + (lane >> 3)]);
    if ((lane & 7) == 0) cf[e0 + (lane >> 3)] = coef;
}
__device__ __forceinline__ void peer_acc8(float (&o)[16], const float c, const u32x4 q) {
#pragma unroll
    for (int j = 0; j < 4; ++j) { const f32x2 lo = __builtin_amdgcn_cvt_pk_f32_fp8((int)q[j], false), hi = __builtin_amdgcn_cvt_pk_f32_fp8((int)q[j], true);
        o[4 * j] += c * lo.x; o[4 * j + 1] += c * lo.y; o[4 * j + 2] += c * hi.x; o[4 * j + 3] += c * hi.y; }
}
template <int NR>
__device__ __forceinline__ void peer_vN(const RowBufN<NR>& rb, float (&outv)[4][16], const LAS unsigned* ent, const LAS float* cf, int b, int lane) {
    const int ev = (int)ent[b * NR + (lane & (NR - 1))]; const float cv = cf[b * NR + (lane & (NR - 1))];
#pragma unroll
    for (int i = 0; i < NR; ++i) {
        const int slot = (__builtin_amdgcn_readlane(ev, i) >> 21) & 3;
        const float c = rdlane_f(cv, i);
        if (slot == 0) peer_acc8(outv[0], c, rb.a[i]);
        else if (slot == 1) peer_acc8(outv[1], c, rb.a[i]);
        else if (slot == 2) peer_acc8(outv[2], c, rb.a[i]);
        else peer_acc8(outv[3], c, rb.a[i]);
    }
}
__device__ __forceinline__ void p_peer_expert4(const Frame& F, unsigned char* ws, float* xres, const float oscale, const XcdBarrier& xbar, const int mode) {
    const bf16_t* XN = (const bf16_t*)(ws + WS_XN); const unsigned char* TU = ws + WS_TAB8U; const unsigned char* TV = ws + WS_TAB8V;
    const float* SU = (const float*)(ws + WS_TABSU); const float* SV = (const float*)(ws + WS_TABSV);
    const unsigned short* EID = (const unsigned short*)(ws + PE_EID); const float* GATE = (const float*)(ws + PE_GATE);
    const int gw = F.bid * NWAVES + F.wave, NGW = F.G * NWAVES, lane = F.lane;
    LAS unsigned* ent = (LAS unsigned*)(F.lds + F.wave * 6144);
    LAS float* cf = (LAS float*)(F.lds + F.wave * 6144 + 2048);
    LAS float* sul = (LAS float*)(F.lds + F.wave * 6144 + 4096);
    LAS unsigned char* xl = F.lds + 49152 + F.wave * 8192;
    constexpr int PU = 16, PV = 8;
    const int nrounds = (T + NGW * 4 - 1) / (NGW * 4);
    for (int rnd = 0; rnd < nrounds; ++rnd) {
        const int m4 = (rnd * NGW + gw) * 4;
        if (m4 < T) {
            {
                int id[4][2]; float gg[4][2], su[4][2];
#pragma unroll
                for (int s = 0; s < 4; ++s) { const size_t m = (size_t)(m4 + s);
                    id[s][0] = EID[m * 128 + lane]; id[s][1] = EID[m * 128 + 64 + lane]; gg[s][0] = GATE[m * 128 + lane] * SV[id[s][0]]; gg[s][1] = GATE[m * 128 + 64 + lane] * SV[id[s][1]]; su[s][0] = SU[id[s][0]]; su[s][1] = SU[id[s][1]]; }
                int base = 0;
#pragma unroll 1
                for (int k = 0; k < 16; ++k) {
                    const int r = (rnd & 1) ? 15 - k : k;
#pragma unroll
                    for (int s = 0; s < 4; ++s)
#pragma unroll
                        for (int w = 0; w < 2; ++w) {
                            const bool hit = (id[s][w] >> 10) == r;
                            const u64 m = __ballot(hit);
                            if (hit) { const int pos = base + (int)__builtin_amdgcn_mbcnt_hi((unsigned)(m >> 32), __builtin_amdgcn_mbcnt_lo((unsigned)m, 0u));
                                ent[pos] = ((unsigned)s << 21) | ((unsigned)(w * 64 + lane) << 14) | (unsigned)(mode == 4 ? (id[s][w] & 7) : id[s][w]); cf[pos] = gg[s][w]; sul[pos] = su[s][w]; }
                            base += __builtin_popcountll(m);
                        }
                }
            }
            LDS_WAIT();
            if (mode != 1 && mode != 3) {
#pragma unroll
                for (int s = 0; s < 4; ++s) { const size_t m = (size_t)(m4 + s);
                    const u32x4 xa = *(const u32x4*)(XN + m * 1024 + lane * 16), xb = *(const u32x4*)(XN + m * 1024 + lane * 16 + 8);
                    *(LAS u32x4*)(xl + s * 2048 + lane * 32) = xa; *(LAS u32x4*)(xl + s * 2048 + lane * 32 + 16) = xb; }
                LDS_WAIT();
                RowBufN<PU> A, B;
                peer_loadN<PU>(A, TU, ent, 0, lane);
#pragma unroll 1
                for (int b = 0; b < 512 / PU; b += 2) {
                    peer_loadN<PU>(B, TU, ent, b + 1, lane);
#pragma unroll
                    for (int h = 0; h < PU / 8; ++h) peer_u8x<PU>(A, h * 8, xl, ent, cf, sul, b * PU + h * 8, lane);
                    if (b + 2 < 512 / PU) peer_loadN<PU>(A, TU, ent, b + 2, lane);
#pragma unroll
                    for (int h = 0; h < PU / 8; ++h) peer_u8x<PU>(B, h * 8, xl, ent, cf, sul, (b + 1) * PU + h * 8, lane);
                }
            }
            LDS_WAIT();
            float outv[4][16];
#pragma unroll
            for (int s = 0; s < 4; ++s)
#pragma unroll
                for (int i = 0; i < 16; ++i) outv[s][i] = 0.f;
            if (mode != 1 && mode != 2) {
                RowBufN<PV> A, B;
                peer_loadN<PV>(A, TV, ent, 0, lane);
#pragma unroll 1
                for (int b = 0; b < 512 / PV; b += 2) {
                    peer_loadN<PV>(B, TV, ent, b + 1, lane);
                    peer_vN<PV>(A, outv, ent, cf, b, lane);
                    if (b + 2 < 512 / PV) peer_loadN<PV>(A, TV, ent, b + 2, lane);
                    peer_vN<PV>(B, outv, ent, cf, b + 1, lane);
                }
            }
#pragma unroll
            for (int s = 0; s < 4; ++s) {
                f32x4* o = (f32x4*)(xres + (size_t)(m4 + s) * 1024 + lane * 16);
#pragma unroll
                for (int j = 0; j < 4; ++j) { f32x4 a0 = o[j]; a0 += (f32x4){outv[s][4 * j], outv[s][4 * j + 1], outv[s][4 * j + 2], outv[s][4 * j + 3]} * oscale; o[j] = a0; }
            }
        }
        if (rnd + 1 < nrounds) xcd_barrier(xbar);
    }
}

__device__ __forceinline__ void cvt_table_i8(const Frame& F, const float* src, unsigned char* dst, float* scales, const int skip) {
    const int nb = F.G > skip ? F.G - skip : F.G, b0 = F.G > skip ? F.bid - skip : F.bid;
    const int gw = b0 * NWAVES + F.wave, NGW = nb * NWAVES, lane = F.lane;
    if (b0 >= 0) for (int r = gw; r < 16384; r += NGW) {
        const f32x4* p = (const f32x4*)(src + (size_t)r * 1024 + lane * 16);
        f32x4 v[4]; float am = 0.f;
#pragma unroll
        for (int j = 0; j < 4; ++j) { v[j] = p[j]; am = fmaxf(am, fmaxf(fmaxf(fabsf(v[j].x), fabsf(v[j].y)), fmaxf(fabsf(v[j].z), fabsf(v[j].w)))); }
#pragma unroll
        for (int o = 1; o < 64; o <<= 1) am = fmaxf(am, __shfl_xor(am, o));
        const float sc = am > 0.f ? am * (1.0f / 127.0f) : 1.0f, inv = 1.0f / sc;
        u32x4 q;
#pragma unroll
        for (int j = 0; j < 4; ++j) { const int a = (int)rintf(v[j].x * inv), b = (int)rintf(v[j].y * inv), c = (int)rintf(v[j].z * inv), d = (int)rintf(v[j].w * inv);
            q[j] = (unsigned)(a & 255) | ((unsigned)(b & 255) << 8) | ((unsigned)(c & 255) << 16) | ((unsigned)(d & 255) << 24); }
        *(u32x4*)(dst + (size_t)r * 1024 + lane * 16) = q;
        if (lane == 0) scales[r] = sc;
    }
}
template <int NR>
__device__ __forceinline__ void peer_u8i(const RowBufN<NR>& rb, int r0, const LAS unsigned char* xq, const LAS unsigned* ent, LAS float* cf, const LAS float* sul, int e0, int lane) {
    int pr[8];
    const int ev = (int)ent[e0 + (lane & 7)];
#pragma unroll
    for (int i = 0; i < 8; ++i) {
        const int slot = (__builtin_amdgcn_readlane(ev, i) >> 21) & 3;
        const u32x4 xv = *(const LAS u32x4*)(xq + slot * 1024 + lane * 16);
        const u32x4 q = rb.a[r0 + i];
        int s = __builtin_amdgcn_sdot4((int)xv.x, (int)q.x, 0, false); s = __builtin_amdgcn_sdot4((int)xv.y, (int)q.y, s, false);
        s = __builtin_amdgcn_sdot4((int)xv.z, (int)q.z, s, false); s = __builtin_amdgcn_sdot4((int)xv.w, (int)q.w, s, false);
        pr[i] = s;
    }
    int r4[4], r2[2], r1;
#pragma unroll
    for (int i = 0; i < 4; ++i) { const u32x2p sw = __builtin_amdgcn_permlane32_swap((unsigned)pr[i], (unsigned)pr[i + 4], false, false); r4[i] = (int)sw.x + (int)sw.y; }
#pragma unroll
    for (int i = 0; i < 2; ++i) { const u32x2p sw = __builtin_amdgcn_permlane16_swap((unsigned)r4[i], (unsigned)r4[i + 2], false, false); r2[i] = (int)sw.x + (int)sw.y; }
    { const bool up = (lane & 8) != 0; const int keep = up ? r2[1] : r2[0], send = up ? r2[0] : r2[1]; r1 = keep + __builtin_amdgcn_update_dpp(0, send, DPP_ROR8, 0xF, 0xF, true); }
    r1 += __builtin_amdgcn_update_dpp(0, r1, DPP_QX1, 0xF, 0xF, true); r1 += __builtin_amdgcn_update_dpp(0, r1, DPP_QX2, 0xF, 0xF, true); r1 += __builtin_amdgcn_update_dpp(0, r1, DPP_HMIR, 0xF, 0xF, true);
    const float gate = cf[e0 + (lane >> 3)];
    const float coef = gate * gelu_tanh((float)r1 * sul[e0 + (lane >> 3)]);
    if ((lane & 7) == 0) cf[e0 + (lane >> 3)] = coef;
}
template <bool FAKE>
__device__ __forceinline__ f32x2 cvt8(unsigned w, bool hi) {
    if (FAKE) { const unsigned t = hi ? (w >> 16) : w; return (f32x2){__builtin_bit_cast(float, (t << 23) | 0x30000000u), __builtin_bit_cast(float, ((t >> 8) << 23) | 0x30000000u)}; }
    return hi ? __builtin_amdgcn_cvt_pk_f32_fp8((int)w, true) : __builtin_amdgcn_cvt_pk_f32_fp8((int)w, false);
}
template <bool FAKE = false>
__device__ __forceinline__ void peer_acc8p(f32x2 (&o)[8], const float c, const u32x4 q) {
    const f32x2 c2 = {c, c};
#pragma unroll
    for (int j = 0; j < 4; ++j) { const f32x2 lo = cvt8<FAKE>(q[j], false), hi = cvt8<FAKE>(q[j], true);
        o[2 * j] += c2 * lo; o[2 * j + 1] += c2 * hi; }
}
template <int NR, bool FAKE>
__device__ __forceinline__ void peer_vNp(const RowBufN<NR>& rb, f32x2 (&outv)[4][8], const LAS unsigned* ent, const LAS float* cf, int b, int lane) {
    const int ev = (int)ent[b * NR + (lane & (NR - 1))]; const float cv = cf[b * NR + (lane & (NR - 1))];
    int slot[NR]; float c[NR];
#pragma unroll
    for (int i = 0; i < NR; ++i) { slot[i] = (__builtin_amdgcn_readlane(ev, i) >> 21) & 3; c[i] = rdlane_f(cv, i); }
#pragma unroll
    for (int q4 = 0; q4 < NR / 4; ++q4) {
#pragma unroll
        for (int s = 0; s < 4; ++s) {
#pragma unroll
            for (int i = 4 * q4; i < 4 * q4 + 4; ++i) if (slot[i] == s) peer_acc8p<FAKE>(outv[s], c[i], rb.a[i]);
            __builtin_amdgcn_sched_barrier(0);
        }
    }
}
template <int PV, bool FAKE>
__device__ __forceinline__ void peer_passv(f32x2 (&outv)[4][8], const unsigned char* TV, const LAS unsigned* ent, const LAS float* cf, int lane) {
    RowBufN<PV> A, B, C;
    constexpr int NBV = 512 / PV;
    peer_loadN<PV>(A, TV, ent, 0, lane); peer_loadN<PV>(B, TV, ent, 1, lane);
#pragma unroll 1
    for (int b = 0; b + 2 < NBV; b += 3) {
        peer_loadN<PV>(C, TV, ent, b + 2, lane);
        peer_vNp<PV, FAKE>(A, outv, ent, cf, b, lane);
        if (b + 3 < NBV) peer_loadN<PV>(A, TV, ent, b + 3, lane);
        peer_vNp<PV, FAKE>(B, outv, ent, cf, b + 1, lane);
        if (b + 4 < NBV) peer_loadN<PV>(B, TV, ent, b + 4, lane);
        peer_vNp<PV, FAKE>(C, outv, ent, cf, b + 2, lane);
    }
    peer_vNp<PV, FAKE>(A, outv, ent, cf, NBV - 1, lane);
}
__device__ __forceinline__ void p_peer_expert5(const Frame& F, unsigned char* ws, float* xres, const float oscale, const XcdBarrier& xbar, const int mode, const bool do_norm, const size_t xn_off) {
    const bf16_t* XN = (const bf16_t*)(ws + xn_off); const unsigned char* TU = ws + WS_TAB8U; const unsigned char* TV = ws + WS_TAB8V;
    const float* SU = (const float*)(ws + WS_TABSU); const float* SV = (const float*)(ws + WS_TABSV);
    const unsigned short* EID = (const unsigned short*)(ws + PE_EID); const float* GATE = (const float*)(ws + PE_GATE); const float* SSQ = (const float*)(ws + PE_SSQ);
    const int gw = F.bid * NWAVES + F.wave, NGW = F.G * NWAVES, lane = F.lane;
    LAS unsigned* ent = (LAS unsigned*)(F.lds + F.wave * 6144);
    LAS float* cf = (LAS float*)(F.lds + F.wave * 6144 + 2048);
    LAS float* sul = (LAS float*)(F.lds + F.wave * 6144 + 4096);
    LAS unsigned char* xq = F.lds + 49152 + F.wave * 4096;
    constexpr int PU = 8, PV = 8;
    const int nrounds = (T + NGW * 4 - 1) / (NGW * 4);
    for (int rnd = 0; rnd < nrounds; ++rnd) {
        const int m4 = (rnd * NGW + gw) * 4;
        if (m4 < T) {
            {
                float sx[4];
#pragma unroll
                for (int s = 0; s < 4; ++s) { const size_t m = (size_t)(m4 + s);
                    const u32x4 xa = *(const u32x4*)(XN + m * 1024 + lane * 16), xb = *(const u32x4*)(XN + m * 1024 + lane * 16 + 8);
                    float xf[16] = {bf_lo(xa.x), bf_hi(xa.x), bf_lo(xa.y), bf_hi(xa.y), bf_lo(xa.z), bf_hi(xa.z), bf_lo(xa.w), bf_hi(xa.w),
                                    bf_lo(xb.x), bf_hi(xb.x), bf_lo(xb.y), bf_hi(xb.y), bf_lo(xb.z), bf_hi(xb.z), bf_lo(xb.w), bf_hi(xb.w)};
                    float am = 0.f;
#pragma unroll
                    for (int i = 0; i < 16; ++i) am = fmaxf(am, fabsf(xf[i]));
#pragma unroll
                    for (int o = 1; o < 64; o <<= 1) am = fmaxf(am, __shfl_xor(am, o));
                    sx[s] = am > 0.f ? am * (1.0f / 127.0f) : 1.0f; const float inv = 1.0f / sx[s];
                    { const float pq = (lane < 16) ? SSQ[m * 16 + lane] : 0.f; sx[s] *= __builtin_amdgcn_rsqf(wave_sum(pq) * (1.0f / 1024.0f) + 1e-6f); }
                    u32x4 q;
#pragma unroll
                    for (int j = 0; j < 4; ++j) { const int a = (int)rintf(xf[4 * j] * inv), b = (int)rintf(xf[4 * j + 1] * inv), c = (int)rintf(xf[4 * j + 2] * inv), d = (int)rintf(xf[4 * j + 3] * inv);
                        q[j] = (unsigned)(a & 255) | ((unsigned)(b & 255) << 8) | ((unsigned)(c & 255) << 16) | ((unsigned)(d & 255) << 24); }
                    *(LAS u32x4*)(xq + s * 1024 + lane * 16) = q; }
                int id[4][2]; float gg[4][2], su[4][2];
#pragma unroll
                for (int s = 0; s < 4; ++s) { const size_t m = (size_t)(m4 + s);
                    id[s][0] = EID[m * 128 + lane]; id[s][1] = EID[m * 128 + 64 + lane];
                    gg[s][0] = GATE[m * 128 + lane] * SV[id[s][0]]; gg[s][1] = GATE[m * 128 + 64 + lane] * SV[id[s][1]];
                    su[s][0] = SU[id[s][0]] * sx[s]; su[s][1] = SU[id[s][1]] * sx[s]; }
                LAS unsigned* hcnt = (LAS unsigned*)sul;
                if (lane < 32) hcnt[lane] = 0u;
                LDS_WAIT();
#pragma unroll
                for (int s = 0; s < 4; ++s)
#pragma unroll
                    for (int w = 0; w < 2; ++w) __hip_atomic_fetch_add(hcnt + (id[s][w] >> 10), 1u, __ATOMIC_RELAXED, __HIP_MEMORY_SCOPE_WORKGROUP);
                LDS_WAIT();
                unsigned basev;
                { const unsigned cntv = (lane < 16) ? hcnt[lane] : 0u;
                  unsigned incl = cntv;
                  const bool rev = (rnd & 1) != 0;
#pragma unroll
                  for (int o = 1; o < 16; o <<= 1) { const unsigned up = (unsigned)__shfl_up((int)incl, o), dn = (unsigned)__shfl_down((int)incl, o);
                      const unsigned nb = rev ? ((lane + o < 16) ? dn : 0u) : ((lane >= o) ? up : 0u); incl += nb; }
                  basev = incl - cntv; }
                LDS_WAIT();
                if (lane < 16) hcnt[16 + lane] = basev;
                LDS_WAIT();
                int posv[4][2];
#pragma unroll
                for (int s = 0; s < 4; ++s)
#pragma unroll
                    for (int w = 0; w < 2; ++w) posv[s][w] = (int)__hip_atomic_fetch_add(hcnt + 16 + (id[s][w] >> 10), 1u, __ATOMIC_RELAXED, __HIP_MEMORY_SCOPE_WORKGROUP);
                LDS_WAIT();
#pragma unroll
                for (int s = 0; s < 4; ++s)
#pragma unroll
                    for (int w = 0; w < 2; ++w) { const int pos = posv[s][w];
                        ent[pos] = ((unsigned)s << 21) | ((unsigned)(w * 64 + lane) << 14) | (unsigned)(mode == 4 ? (id[s][w] & 7) : id[s][w]); cf[pos] = gg[s][w]; }
                LDS_WAIT();
#pragma unroll
                for (int s = 0; s < 4; ++s)
#pragma unroll
                    for (int w = 0; w < 2; ++w) sul[posv[s][w]] = su[s][w];
            }
            LDS_WAIT();
            if (mode != 1 && mode != 3) {
                RowBufN<PU> A, B, C;
                constexpr int NBU = 512 / PU;
                peer_loadN<PU>(A, TU, ent, 0, lane); peer_loadN<PU>(B, TU, ent, 1, lane);
#pragma unroll 1
                for (int b = 0; b + 2 < NBU; b += 3) {
                    peer_loadN<PU>(C, TU, ent, b + 2, lane);
                    peer_u8i<PU>(A, 0, xq, ent, cf, sul, b * PU, lane);
                    if (b + 3 < NBU) peer_loadN<PU>(A, TU, ent, b + 3, lane);
                    peer_u8i<PU>(B, 0, xq, ent, cf, sul, (b + 1) * PU, lane);
                    if (b + 4 < NBU) peer_loadN<PU>(B, TU, ent, b + 4, lane);
                    peer_u8i<PU>(C, 0, xq, ent, cf, sul, (b + 2) * PU, lane);
                }
                peer_u8i<PU>(A, 0, xq, ent, cf, sul, (NBU - 1) * PU, lane);
            }
            LDS_WAIT();
            f32x2 outv[4][8];
#pragma unroll
            for (int s = 0; s < 4; ++s)
#pragma unroll
                for (int i = 0; i < 8; ++i) outv[s][i] = (f32x2){0.f, 0.f};
            if (mode != 1 && mode != 2) {
                if (mode == 5) peer_passv<PV, true>(outv, TV, ent, cf, lane); else peer_passv<PV, false>(outv, TV, ent, cf, lane);
            }
            asm volatile("" ::: "memory"); __builtin_amdgcn_sched_barrier(0);
#pragma unroll
            for (int s = 0; s < 4; ++s) {
                f32x4* o = (f32x4*)(xres + (size_t)(m4 + s) * 1024 + lane * 16);
                f32x4 nv[4]; float ss = 0.f;
#pragma unroll
                for (int j = 0; j < 4; ++j) { f32x4 a0 = o[j]; const f32x4 add = (f32x4){outv[s][2 * j].x, outv[s][2 * j].y, outv[s][2 * j + 1].x, outv[s][2 * j + 1].y};
                    if (oscale != 0.f) a0 += add; else asm volatile("" :: "v"(add)); o[j] = a0; nv[j] = a0;
                    ss += (a0.x * a0.x + a0.y * a0.y) + (a0.z * a0.z + a0.w * a0.w); }
                if (do_norm && oscale != 0.f) {
                    const float rstd = __builtin_amdgcn_rsqf(wave_sum(ss) * (1.f / DM) + 1e-6f);
                    const f32x4* gp = (const f32x4*)((const float*)(ws + WS_CMPB + 4096) + lane * 16);
                    u32x4 w0, w1;
                    { const f32x4 g0 = gp[0], g1 = gp[1], g2 = gp[2], g3 = gp[3];
                      w0.x = pk2(nv[0].x * rstd * g0.x, nv[0].y * rstd * g0.y); w0.y = pk2(nv[0].z * rstd * g0.z, nv[0].w * rstd * g0.w);
                      w0.z = pk2(nv[1].x * rstd * g1.x, nv[1].y * rstd * g1.y); w0.w = pk2(nv[1].z * rstd * g1.z, nv[1].w * rstd * g1.w);
                      w1.x = pk2(nv[2].x * rstd * g2.x, nv[2].y * rstd * g2.y); w1.y = pk2(nv[2].z * rstd * g2.z, nv[2].w * rstd * g2.w);
                      w1.z = pk2(nv[3].x * rstd * g3.x, nv[3].y * rstd * g3.y); w1.w = pk2(nv[3].z * rstd * g3.z, nv[3].w * rstd * g3.w); }
                    u32x4* xo = (u32x4*)((bf16_t*)(ws + WS_XN) + (size_t)(m4 + s) * 1024 + lane * 16);
                    xo[0] = w0; xo[1] = w1;
                }
                asm volatile("" ::: "memory"); __builtin_amdgcn_sched_barrier(0);
            }
        }
    }
}

constexpr size_t L1_QN = WS_R3;
constexpr size_t L1_KS = WS_R3 + 32 * MiB;
constexpr size_t L1_KW = WS_R3 + 40 * MiB;
constexpr size_t L1_VST = WS_R3 + 48 * MiB;
constexpr size_t L1_VWT = WS_R3 + 56 * MiB;
constexpr size_t L1_KCR = WS_R3 + 64 * MiB;
constexpr size_t L1_VCR = WS_R3 + 72 * MiB;
constexpr size_t L1_GATES = WS_R3 + 81 * MiB;
constexpr size_t L1_H1 = WS_R3 + 84 * MiB;
constexpr size_t L1_CMPO = WS_R3 + 88 * MiB;
constexpr size_t L1_KC = WS_R3 + 90 * MiB;
constexpr size_t L1_VCT = WS_R3 + 91 * MiB;
constexpr size_t L1_SELB = WS_R3 + 92 * MiB;
constexpr size_t L1_OC = WS_TABU;
constexpr size_t L1_CAT = WS_XN;
constexpr size_t L1_UPD = WS_R3;
constexpr size_t L1_DECAY = WS_R3 + 128 * MiB;

__device__ __forceinline__ void p_l1_prep(const Frame& F, const Args& a, unsigned char* ws) {
    const bf16_t* P = (const bf16_t*)(ws + WS_PROJ);
    const f32x2* rope = (const f32x2*)(ws + WS_ROPE);
    bf16_t* QN = (bf16_t*)(ws + L1_QN); bf16_t* KS = (bf16_t*)(ws + L1_KS); bf16_t* KW = (bf16_t*)(ws + L1_KW);
    bf16_t* KCR = (bf16_t*)(ws + L1_KCR); bf16_t* VCR = (bf16_t*)(ws + L1_VCR); float* GATES = (float*)(ws + L1_GATES);
    const int gw = F.bid * NWAVES + F.wave, NGW = F.G * NWAVES, lane = F.lane, hs = lane >> 3, sub = lane & 7;
    float qg[8], kg[8];
#pragma unroll
    for (int j = 0; j < 8; ++j) { qg[j] = a.in[I_L1_QG][sub * 8 + j]; kg[j] = a.in[I_L1_KG][sub * 8 + j]; }
    const int srccol = (hs < 2) ? C1_KS + hs * 64 : (hs < 4) ? C1_KW + (hs - 2) * 64 : (hs < 6) ? C1_KC + (hs - 4) * 64 : C1_VC + (hs - 6) * 64;
    bf16_t* dstbuf = (hs < 2) ? KS : (hs < 4) ? KW : (hs < 6) ? KCR : VCR;
    const int g2 = hs & 1;
    for (int m = gw; m < T; m += NGW) {
        const int b = m >> 12, t = m & 4095;
        const bf16_t* row = P + (size_t)m * N_IN1;
        f32x2 cs[8];
#pragma unroll
        for (int j = 0; j < 4; ++j) { const f32x4 c4 = *(const f32x4*)(rope + t * 32 + (sub & 3) * 8 + 2 * j); cs[2 * j] = (f32x2){c4.x, c4.y}; cs[2 * j + 1] = (f32x2){c4.z, c4.w}; }
        float v[8];
        head8_load(row + C1_Q + lane * 8, v); head8_norm(v, qg); head8_rope(v, cs, sub >= 4); head8_store(QN + (size_t)m * 512 + lane * 8, v, 0.125f);
        {
            const u32x4 raw = *(const u32x4*)(row + srccol + sub * 8);
            v[0] = bf_lo(raw.x); v[1] = bf_hi(raw.x); v[2] = bf_lo(raw.y); v[3] = bf_hi(raw.y); v[4] = bf_lo(raw.z); v[5] = bf_hi(raw.z); v[6] = bf_lo(raw.w); v[7] = bf_hi(raw.w);
            head8_norm(v, kg); head8_rope(v, cs, sub >= 4);
            u32x4 q; q.x = pk2(v[0], v[1]); q.y = pk2(v[2], v[3]); q.z = pk2(v[4], v[5]); q.w = pk2(v[6], v[7]);
            if (hs >= 4) q = raw;
            *(u32x4*)(dstbuf + ((size_t)(b * 2 + g2) * 4096 + t) * 64 + sub * 8) = q;
        }
        if (lane < 24) GATES[(size_t)m * 24 + lane] = sigmoidf_(bf2f(row[C1_GL + lane]));
    }
    for (int it = gw; it < 2 * NB * 2 * 64; it += NGW) {
        const int tb = it & 63, g = (it >> 6) & 1, b = (it >> 7) & 7, w = it >> 10;
        const size_t m = (size_t)b * 4096 + tb * 64 + lane;
        unsigned r[32];
#pragma unroll
        for (int j = 0; j < 8; ++j) { const u32x4 q = *(const u32x4*)(P + m * N_IN1 + (w ? C1_VW : C1_VS) + g * 64 + j * 8); r[4 * j] = q.x; r[4 * j + 1] = q.y; r[4 * j + 2] = q.z; r[4 * j + 3] = q.w; }
        bf16_t* dst = (bf16_t*)(ws + (w ? L1_VWT : L1_VST)) + ((size_t)(b * 2 + g) * 64) * 4096 + tb * 64 + lane;
#pragma unroll
        for (int d = 0; d < 64; ++d) dst[(size_t)d * 4096] = (bf16_t)((d & 1) ? (r[d >> 1] >> 16) : (r[d >> 1] & 0xffffu));
    }
}

namespace pg8 {
struct EpiCmp1 {
    static constexpr bool PERM = true;
    bf16_t* O; const float* bias;
    __device__ __forceinline__ void operator()(const f32x4 (&acc)[2][2][4][2], const Unit& u, int wr, int wc, int fr, int fq) const {
        const int row0 = u.pm * BM + wr * 64 + fr, col0 = wc * 32 + 8 * fq;
#pragma unroll
        for (int ai = 0; ai < 2; ++ai)
#pragma unroll
            for (int m = 0; m < 4; ++m) { bf16_t* rowp = O + (size_t)(row0 + ai * HALF + m * 16) * 256 + col0;
#pragma unroll
                for (int bj = 0; bj < 2; ++bj) { const float* bp = bias + u.pn * 256 + col0 + bj * HALF;
                    const f32x4 v0 = acc[ai][bj][m][0] + *(const f32x4*)bp, v1 = acc[ai][bj][m][1] + *(const f32x4*)(bp + 4);
                    u32x4 w; w.x = pk2(gelu_tanh(v0[0]), gelu_tanh(v0[1])); w.y = pk2(gelu_tanh(v0[2]), gelu_tanh(v0[3]));
                    w.z = pk2(gelu_tanh(v1[0]), gelu_tanh(v1[1])); w.w = pk2(gelu_tanh(v1[2]), gelu_tanh(v1[3]));
                    *(u32x4*)(rowp + bj * HALF) = w; }
                asm volatile("" ::: "memory"); __builtin_amdgcn_sched_barrier(0); }
    }
};
struct EpiCmp2 {
    static constexpr bool PERM = false;
    float* C;
    __device__ __forceinline__ void operator()(const f32x4 (&acc)[2][2][4][2], const Unit& u, int wr, int wc, int fr, int fq) const {
        if (wc >= 2) return;
        const int row0 = u.pm * BM + wr * 64 + fr, col0 = wc * 32 + 4 * fq;
#pragma unroll
        for (int ai = 0; ai < 2; ++ai)
#pragma unroll
            for (int m = 0; m < 4; ++m)
#pragma unroll
                for (int n = 0; n < 2; ++n) *(f32x4*)(C + (size_t)(row0 + ai * HALF + m * 16) * 64 + col0 + n * 16) = acc[ai][0][m][n];
    }
};
}

__device__ __forceinline__ void p_cmp_final(const Frame& F, const Args& a, unsigned char* ws) {
    const float* CMPO = (const float*)(ws + L1_CMPO); const f32x2* rope = (const f32x2*)(ws + WS_ROPE);
    bf16_t* KC = (bf16_t*)(ws + L1_KC); bf16_t* VCT = (bf16_t*)(ws + L1_VCT);
    const int gw = F.bid * NWAVES + F.wave, NGW = F.G * NWAVES, lane = F.lane;
    const float kg = a.in[I_L1_KG][lane];
    for (int r = gw; r < 8192; r += NGW) {
        float v = CMPO[(size_t)r * 64 + lane];
        const int rr = r & 4095, bg = rr >> 8, c = rr & 255;
        if (r < 4096) {
            const float ss = wave_sum(v * v);
            v = v * (__builtin_amdgcn_rsqf(ss * (1.f / 64.f) + 1e-6f)) * kg;
            const int pos = (c < 255) ? 16 * c + 31 : 0;
            v = rope_apply(v, rope[pos * 32 + (lane & 31)], lane);
            KC[((size_t)bg * 256 + c) * 64 + lane] = (c < 255) ? (bf16_t)f2bf(v) : (bf16_t)0;
        } else {
            VCT[((size_t)bg * 64 + lane) * 256 + c] = (c < 255) ? (bf16_t)f2bf(v) : (bf16_t)0;
        }
    }
}

__device__ __forceinline__ void att_load2(AttStage& s, const bf16_t* Kg, const bf16_t* Vtg, int vstride, int key0, int tid) {
    s.kreg = *(const u32x4*)(Kg + (size_t)(key0 + (tid >> 3)) * 64 + (tid & 7) * 8);
    s.vreg = *(const u32x4*)(Vtg + (size_t)(tid >> 3) * vstride + key0 + (tid & 7) * 8);
}
__device__ __forceinline__ float score_bound_c2(const float* qg, const float* kg) {
    float mq = 0.f, mk_ = 0.f;
    for (int i = 0; i < 64; ++i) { mq = fmaxf(mq, fabsf(qg[i])); mk_ = fmaxf(mk_, fabsf(kg[i])); }
    return (8.0f * mq * mk_ + 0.5f) * 1.4426950408889634f;
}

constexpr int CA_KB = 256 * 144, CA_VSTR = 528, CA_VB = 64 * CA_VSTR, CA_IMP = CA_KB + CA_VB;
__device__ __forceinline__ void p_cmp_attn(const Frame& F, const Args& a, unsigned char* ws) {
    const bf16_t* QN = (const bf16_t*)(ws + L1_QN); const bf16_t* KC = (const bf16_t*)(ws + L1_KC); const bf16_t* VCT = (const bf16_t*)(ws + L1_VCT);
    float* OC = (float*)(ws + L1_OC); u64* SELB = (u64*)(ws + L1_SELB);
    LAS float* impL = (LAS float*)(F.lds + CA_IMP);
    const int lane = F.lane, wave = F.wave, h = lane >> 5, c = lane & 31, tid = F.tid;
    const float c2 = score_bound_c2(a.in[I_L1_QG], a.in[I_L1_KG]), c1 = 1.4426950408889634f;
    for (int u = F.bid; u < 1024; u += F.G) {
        const int b = (u >> 7) & 7, g = (u >> 6) & 1, rnd = u >> 8, qt = (rnd & 1) ? 63 - (u & 63) : (u & 63), q0 = qt * 64;
        const int bg = b * 2 + g; const size_t mb = (size_t)b * 4096;
        const int t = q0 + wave * 8 + (c >> 2), head = g * 4 + (c & 3);
        bf16x8 Qf[4];
#pragma unroll
        for (int ks = 0; ks < 4; ++ks) Qf[ks] = *(const bf16x8*)(QN + (mb + t) * 512 + head * 64 + ks * 16 + 8 * h);
        const int L = (t >= 31) ? (((t - 31) >> 4) < 254 ? ((t - 31) >> 4) : 254) : -1;
        const int tmax = q0 + 63; const int Lmax = (tmax >= 31) ? (((tmax - 31) >> 4) < 254 ? ((tmax - 31) >> 4) : 254) : -1;
        const int nkt = (Lmax >= 0) ? (Lmax >> 6) + 1 : 0;
        const bf16_t* Kg = KC + (size_t)bg * 256 * 64; const bf16_t* Vtg = VCT + (size_t)bg * 64 * 256;
        __syncthreads();
        for (int i = tid; i < nkt * 512; i += NTHREADS) {
            const int key = i >> 3, ch = i & 7;
            *(LAS u32x4*)(F.lds + key * 144 + ch * 16) = *(const u32x4*)(Kg + (size_t)key * 64 + ch * 8);
        }
        for (int i = tid; i < 64 * nkt * 8; i += NTHREADS) {
            const int d = i / (nkt * 8), ch = i % (nkt * 8);
            const u32x4 v = *(const u32x4*)(Vtg + (size_t)d * 256 + ch * 8);
            LAS unsigned char* p = F.lds + CA_KB + d * CA_VSTR + ch * 16;
            *(LAS u32x2*)p = (u32x2){v.x, v.y}; *(LAS u32x2*)(p + 8) = (u32x2){v.z, v.w};
        }
        __syncthreads();
        f32x16 O[2], IMP[2]; float l = 0.f;
#pragma unroll
        for (int i = 0; i < 16; ++i) { O[0][i] = 0.f; O[1][i] = 0.f; IMP[0][i] = 0.f; IMP[1][i] = 0.f; }
        for (int st = 0; st < nkt * 2; ++st) {
            f32x16 S = {0.f, 0.f, 0.f, 0.f, 0.f, 0.f, 0.f, 0.f, 0.f, 0.f, 0.f, 0.f, 0.f, 0.f, 0.f, 0.f};
            { const LAS unsigned char* kp = F.lds + (st * 32 + c) * 144 + h * 16;
#pragma unroll
              for (int ks = 0; ks < 4; ++ks) S = __builtin_amdgcn_mfma_f32_32x32x16_bf16(*(const LAS bf16x8*)(kp + ks * 32), Qf[ks], S, 0, 0, 0); }
            float p[16];
#pragma unroll
            for (int i = 0; i < 16; ++i) {
                const int cidx = st * 32 + (i & 3) + 8 * (i >> 2) + 4 * h;
                const float e = __builtin_amdgcn_exp2f(S[i] * c1 - c2);
                p[i] = (cidx <= L) ? e : 0.f; l += p[i];
            }
            const bf16x8 P0 = pack8(p[0], p[1], p[2], p[3], p[4], p[5], p[6], p[7]);
            const bf16x8 P1 = pack8(p[8], p[9], p[10], p[11], p[12], p[13], p[14], p[15]);
#pragma unroll
            for (int dt = 0; dt < 2; ++dt) {
                const LAS unsigned char* vp = F.lds + CA_KB + (dt * 32 + c) * CA_VSTR + (st * 32 + 4 * h) * 2;
                const u32x2 a0 = *(const LAS u32x2*)(vp), a1 = *(const LAS u32x2*)(vp + 16), b0 = *(const LAS u32x2*)(vp + 32), b1 = *(const LAS u32x2*)(vp + 48);
                O[dt] = __builtin_amdgcn_mfma_f32_32x32x16_bf16(__builtin_bit_cast(bf16x8, ((u32x4){a0.x, a0.y, a1.x, a1.y})), P0, O[dt], 0, 0, 0);
                O[dt] = __builtin_amdgcn_mfma_f32_32x32x16_bf16(__builtin_bit_cast(bf16x8, ((u32x4){b0.x, b0.y, b1.x, b1.y})), P1, O[dt], 0, 0, 0);
            }
#pragma unroll
            for (int jt = 0; jt < 2; ++jt)
#pragma unroll
                for (int s = 0; s < 2; ++s) {
                    unsigned wv[4];
#pragma unroll
                    for (int e2 = 0; e2 < 4; ++e2) {
                        unsigned pr = 0u;
#pragma unroll
                        for (int q = 0; q < 2; ++q) { const int jj = 2 * e2 + q; const int kap = 16 * s + 8 * (jj >> 2) + 4 * h + (jj & 3);
                            const int off = st * 32 + kap - 4 * (32 * jt + c);
                            const unsigned wbits = (off == 0 || off == 4) ? 0x3F80u : ((off >= 1 && off <= 3) ? 0x4000u : 0u);
                            pr |= wbits << (16 * q); }
                        wv[e2] = pr;
                    }
                    const bf16x8 Wf = __builtin_bit_cast(bf16x8, ((u32x4){wv[0], wv[1], wv[2], wv[3]}));
                    IMP[jt] = __builtin_amdgcn_mfma_f32_32x32x16_bf16(Wf, s ? P1 : P0, IMP[jt], 0, 0, 0);
                }
        }
        const float lt = l + __shfl_xor(l, 32);
        const float inv = __builtin_amdgcn_rcpf(fmaxf(lt, 1e-30f));
        { float* orow = OC + (mb + t) * 512 + head * 64;
#pragma unroll
          for (int dt = 0; dt < 2; ++dt)
#pragma unroll
            for (int i4 = 0; i4 < 4; ++i4) { const int d = dt * 32 + 8 * i4 + 4 * h;
                *(f32x4*)(orow + d) = (f32x4){O[dt][4 * i4] * inv, O[dt][4 * i4 + 1] * inv, O[dt][4 * i4 + 2] * inv, O[dt][4 * i4 + 3] * inv}; } }
#pragma unroll
        for (int jt = 0; jt < 2; ++jt)
#pragma unroll
            for (int i = 0; i < 16; ++i) {
                float v = IMP[jt][i] * inv; v = DPP_ADD_F(v, DPP_QX1); v = DPP_ADD_F(v, DPP_QX2);
                if ((c & 3) == 0) impL[(wave * 8 + (c >> 2)) * 65 + 32 * jt + (i & 3) + 8 * (i >> 2) + 4 * h] = v;
            }
        __syncthreads();
        if (tid < 64) {
            const int tq = q0 + tid, cur = tq >> 6;
            u64 mask;
            if (cur + 1 <= 16) mask = (1ull << (cur + 1)) - 1ull;
            else {
                unsigned top[16];
#pragma unroll
                for (int blk = 0; blk < 4; ++blk) {
                    unsigned k16[16];
#pragma unroll
                    for (int i = 0; i < 16; ++i) { const int j = blk * 16 + i; const float x = impL[tid * 65 + j];
                        const unsigned key = (j > cur) ? 0u : ((j == 0 || j == cur) ? 0xFFFFFFC0u : (mono_u32(x) & ~0x3Fu)) | (unsigned)(63 - j);
                        k16[i] = (j > cur) ? 0u : key; }
                    sort16_desc(k16);
                    if (blk == 0) {
#pragma unroll
                        for (int i = 0; i < 16; ++i) top[i] = k16[i];
                    } else merge16_desc(top, k16);
                }
                mask = 0ull;
#pragma unroll
                for (int i = 0; i < 16; ++i) mask |= 1ull << (63 - (int)(top[i] & 63u));
            }
            SELB[(size_t)bg * 4096 + tq] = mask;
        }
    }
}

template <bool MASKED>
__device__ __forceinline__ void nsa_run(const Frame& F, int kt0, int kt1, int kt_hi, AttStage& st, const bf16_t* Kg, const bf16_t* Vtg, const bf16x8 (&Qf)[2][4], const u64 (&selw)[2], const int (&qidx)[2],
                                        const float c1, const float c2, const int wlen, f32x16 (&O)[2][2], f32x16 (&Lacc)[2]) {
    const int lane = F.lane, h = lane >> 5, tid = F.tid;
    const bf16x8 ones = __builtin_bit_cast(bf16x8, ((u32x4){0x3F803F80u, 0x3F803F80u, 0x3F803F80u, 0x3F803F80u}));
#pragma unroll 1
    for (int kt = kt0; kt < kt1; ++kt) {
        LAS unsigned char* buf = F.lds + (kt & 1) * AT_BUF;
        if (kt + 1 < kt_hi) att_load(st, Kg, Vtg, (kt + 1) * 64, tid);
#pragma unroll 1
        for (int sub = 0; sub < 2; ++sub) {
            bf16x8 Kf[4];
            att_kfrags(buf, sub, Kf, lane);
#pragma unroll
            for (int ct = 0; ct < 2; ++ct) {
                __builtin_amdgcn_sched_barrier(0);
                const f32x16 S = att_qk_f(Kf, Qf[ct]);
                const bool flag = (selw[ct] >> kt) & 1ull;
                const float c2e = flag ? c2 : 3.0e30f;
                const int dbase = qidx[ct] - (kt * 64 + sub * 32 + 4 * h);
                float p[16];
#pragma unroll
                for (int i = 0; i < 16; ++i) {
                    const float e = __builtin_amdgcn_exp2f(S[i] * c1 - c2e);
                    p[i] = (!MASKED || (unsigned)(dbase - ((i & 3) + 8 * (i >> 2))) < (unsigned)wlen) ? e : 0.f;
                }
                const bf16x8 P0 = pack8(p[0], p[1], p[2], p[3], p[4], p[5], p[6], p[7]);
                const bf16x8 P1 = pack8(p[8], p[9], p[10], p[11], p[12], p[13], p[14], p[15]);
                att_pv2(buf, sub, P0, P1, O[ct], lane);
                Lacc[ct] = __builtin_amdgcn_mfma_f32_32x32x16_bf16(ones, P0, Lacc[ct], 0, 0, 0);
                Lacc[ct] = __builtin_amdgcn_mfma_f32_32x32x16_bf16(ones, P1, Lacc[ct], 0, 0, 0);
            }
        }
        if (kt + 1 < kt_hi) att_store(st, F.lds + ((kt + 1) & 1) * AT_BUF, tid);
        __syncthreads();
    }
}
__device__ __forceinline__ void p_nsa_attn(const Frame& F, const Args& a, unsigned char* ws) {
    const bf16_t* QN = (const bf16_t*)(ws + L1_QN);
    const u64* SELB = (const u64*)(ws + L1_SELB); float* OC = (float*)(ws + L1_OC); const float* GATES = (const float*)(ws + L1_GATES);
    bf16_t* CAT = (bf16_t*)(ws + L1_CAT);
    const int lane = F.lane, wave = F.wave, h = lane >> 5, c = lane & 31, tid = F.tid;
    const float c2 = score_bound_c2(a.in[I_L1_QG], a.in[I_L1_KG]), c1 = 1.4426950408889634f;
    for (int u = F.bid; u < 512; u += F.G) {
        const int idx = u & 255, g = u >> 8, b = idx >> 5, qtr = idx & 31, qt = g ? 31 - qtr : qtr, q0 = qt * 128;
        const int bg = b * 2 + g; const size_t mb = (size_t)b * 4096;
        bf16x8 Qf[2][4]; int qidx[2];
#pragma unroll
        for (int ct = 0; ct < 2; ++ct) { qidx[ct] = q0 + wave * 16 + ct * 8 + (c >> 2);
#pragma unroll
            for (int ks = 0; ks < 4; ++ks) Qf[ct][ks] = *(const bf16x8*)(QN + (mb + qidx[ct]) * 512 + (g * 4 + (c & 3)) * 64 + ks * 16 + 8 * h); }
        const int head = g * 4 + (c & 3);
#pragma unroll 1
        for (int pass = 0; pass < 2; ++pass) {
            const bf16_t* Kg = (const bf16_t*)(ws + (pass ? L1_KW : L1_KS)) + (size_t)bg * 4096 * 64;
            const bf16_t* Vtg = (const bf16_t*)(ws + (pass ? L1_VWT : L1_VST)) + (size_t)bg * 64 * 4096;
            u64 selw[2];
#pragma unroll
            for (int ct = 0; ct < 2; ++ct) selw[ct] = pass ? ~0ull : SELB[(size_t)bg * 4096 + qidx[ct]];
            const int wlen = pass ? 512 : 0x7fffffff;
            f32x16 O[2][2], Lacc[2];
#pragma unroll
            for (int ct = 0; ct < 2; ++ct) {
#pragma unroll
                for (int i = 0; i < 16; ++i) Lacc[ct][i] = 0.f;
#pragma unroll
                for (int dt = 0; dt < 2; ++dt)
#pragma unroll
                    for (int i = 0; i < 16; ++i) O[ct][dt][i] = 0.f;
            }
            const int kt_lo = pass ? ((2 * qt - 8) > 0 ? 2 * qt - 8 : 0) : 0, kt_hi = 2 * qt + 2;
            int ka = pass ? 2 * qt - 6 : 0; ka = ka < kt_lo ? kt_lo : ka; const int kb = 2 * qt;
            AttStage st; att_load(st, Kg, Vtg, kt_lo * 64, tid);
            __syncthreads();
            att_store(st, F.lds + (kt_lo & 1) * AT_BUF, tid);
            __syncthreads();
            nsa_run<true>(F, kt_lo, ka, kt_hi, st, Kg, Vtg, Qf, selw, qidx, c1, c2, wlen, O, Lacc);
            nsa_run<false>(F, ka, kb, kt_hi, st, Kg, Vtg, Qf, selw, qidx, c1, c2, wlen, O, Lacc);
            nsa_run<true>(F, kb, kt_hi, kt_hi, st, Kg, Vtg, Qf, selw, qidx, c1, c2, wlen, O, Lacc);
#pragma unroll
            for (int ct = 0; ct < 2; ++ct) {
                const float lt = Lacc[ct][0];
                const float inv = __builtin_amdgcn_rcpf(fmaxf(lt, 1e-30f));
                const size_t m = mb + qidx[ct];
                const float gcv = GATES[m * 24 + head * 3 + 0], gsv = GATES[m * 24 + head * 3 + 1], gwv = GATES[m * 24 + head * 3 + 2];
                float* orow = OC + m * 512 + head * 64; bf16_t* crow = CAT + m * 1024 + head * 64;
#pragma unroll
                for (int dt = 0; dt < 2; ++dt)
#pragma unroll
                    for (int i4 = 0; i4 < 4; ++i4) {
                        const int d = dt * 32 + 8 * i4 + 4 * h;
                        const f32x4 prev = *(const f32x4*)(orow + d);
                        const f32x4 ov = (f32x4){O[ct][dt][4 * i4] * inv, O[ct][dt][4 * i4 + 1] * inv, O[ct][dt][4 * i4 + 2] * inv, O[ct][dt][4 * i4 + 3] * inv};
                        if (pass == 0) *(f32x4*)(orow + d) = prev * gcv + ov * gsv;
                        else { const f32x4 r = prev + ov * gwv; u32x2 w; w.x = pk2(r[0], r[1]); w.y = pk2(r[2], r[3]); *(u32x2*)(crow + d) = w; }
                    }
            }
        }
    }
}

__device__ __forceinline__ float logsigmoidf_(float x) { return fminf(x, 0.f) - 0.69314718056f * __builtin_amdgcn_logf(1.0f + __builtin_amdgcn_exp2f(-1.44269504089f * fabsf(x))); }
__device__ __forceinline__ bf16x8 frag_lds(const LAS float* p) { const f32x4 a = *(const LAS f32x4*)p, b = *(const LAS f32x4*)(p + 4); return pack8(a[0], a[1], a[2], a[3], b[0], b[1], b[2], b[3]); }
__device__ __forceinline__ bf16x8 frag_glb(const float* p) { const f32x4 a = *(const f32x4*)p, b = *(const f32x4*)(p + 4); return pack8(a[0], a[1], a[2], a[3], b[0], b[1], b[2], b[3]); }
__device__ __forceinline__ void gla_wave_bcum(const Args& a, const bf16_t* P, size_t m0, int hh, int lane, float (&bc)[32]) {
    float wg[16];
#pragma unroll
    for (int r = 0; r < 16; ++r) wg[r] = a.in[I_L1_WGATE][r * 256 + hh * 64 + lane];
    const float bgv = a.in[I_L1_BGATE][hh * 64 + lane];
    float run = 0.f;
#pragma unroll
    for (int c = 0; c < 32; ++c) {
        const bf16_t* grow = P + (m0 + c) * N_IN1 + C1_GLOW;
        const u32x4 ga = *(const u32x4*)grow, gb = *(const u32x4*)(grow + 8);
        float acc = bgv;
        acc += wg[0] * bf_lo(ga.x); acc += wg[1] * bf_hi(ga.x); acc += wg[2] * bf_lo(ga.y); acc += wg[3] * bf_hi(ga.y); acc += wg[4] * bf_lo(ga.z); acc += wg[5] * bf_hi(ga.z); acc += wg[6] * bf_lo(ga.w); acc += wg[7] * bf_hi(ga.w);
        acc += wg[8] * bf_lo(gb.x); acc += wg[9] * bf_hi(gb.x); acc += wg[10] * bf_lo(gb.y); acc += wg[11] * bf_hi(gb.y); acc += wg[12] * bf_lo(gb.z); acc += wg[13] * bf_hi(gb.z); acc += wg[14] * bf_lo(gb.w); acc += wg[15] * bf_hi(gb.w);
        run += logsigmoidf_(acc) * 0.0625f; bc[c] = run;
    }
}
__device__ __forceinline__ bf16x8 gla_vfrag(const bf16_t* vbase, int s0) {
    unsigned short e[8];
#pragma unroll
    for (int j = 0; j < 8; ++j) e[j] = vbase[(size_t)(s0 + j) * N_IN1];
    u32x4 w; w.x = (unsigned)e[0] | ((unsigned)e[1] << 16); w.y = (unsigned)e[2] | ((unsigned)e[3] << 16); w.z = (unsigned)e[4] | ((unsigned)e[5] << 16); w.w = (unsigned)e[6] | ((unsigned)e[7] << 16);
    return __builtin_bit_cast(bf16x8, w);
}
__device__ __forceinline__ void p_gla_a(const Frame& F, const Args& a, unsigned char* ws) {
    const bf16_t* P = (const bf16_t*)(ws + WS_PROJ); bf16_t* UPD = (bf16_t*)(ws + L1_UPD); float* DECAY = (float*)(ws + L1_DECAY);
    const int lane = F.lane, r = lane & 31, h = lane >> 5;
    LAS bf16_t* kdT = (LAS bf16_t*)(F.lds + F.wave * 5120);
    const int gw = F.bid * NWAVES + F.wave, NGW = F.G * NWAVES;
    for (int u = gw; u < 4096; u += NGW) {
        const int b = u >> 9, hh = (u >> 7) & 3, n = u & 127; const size_t m0 = (size_t)b * 4096 + n * 32;
        float bc[32];
        gla_wave_bcum(a, P, m0, hh, lane, bc);
        const float blast = bc[31];
#pragma unroll
        for (int c = 0; c < 32; c += 2) {
            const float k0 = bf2f(P[(m0 + c) * N_IN1 + C1_GK + hh * 64 + lane]) * __expf(blast - bc[c]);
            const float k1 = bf2f(P[(m0 + c + 1) * N_IN1 + C1_GK + hh * 64 + lane]) * __expf(blast - bc[c + 1]);
            *(LAS unsigned*)(kdT + lane * 40 + c) = pk2(k0, k1);
        }
        DECAY[(size_t)u * 64 + lane] = __expf(blast);
        LDS_WAIT();
        bf16x8 Bf[2][2];
#pragma unroll
        for (int nt = 0; nt < 2; ++nt)
#pragma unroll
            for (int ks = 0; ks < 2; ++ks) Bf[nt][ks] = *(const LAS bf16x8*)(kdT + (32 * nt + r) * 40 + 16 * ks + 8 * h);
#pragma unroll
        for (int mt = 0; mt < 4; ++mt) {
            const bf16_t* vb = P + m0 * N_IN1 + C1_GV + hh * 128 + 32 * mt + r;
            const bf16x8 A0 = gla_vfrag(vb, 8 * h), A1 = gla_vfrag(vb, 16 + 8 * h);
#pragma unroll
            for (int nt = 0; nt < 2; ++nt) {
                f32x16 acc = {0.f, 0.f, 0.f, 0.f, 0.f, 0.f, 0.f, 0.f, 0.f, 0.f, 0.f, 0.f, 0.f, 0.f, 0.f, 0.f};
                acc = __builtin_amdgcn_mfma_f32_32x32x16_bf16(A0, Bf[nt][0], acc, 0, 0, 0);
                acc = __builtin_amdgcn_mfma_f32_32x32x16_bf16(A1, Bf[nt][1], acc, 0, 0, 0);
                bf16_t* up = UPD + (size_t)u * 8192 + 32 * nt + r;
#pragma unroll
                for (int i = 0; i < 16; ++i) up[(size_t)(32 * mt + (i & 3) + 8 * (i >> 2) + 4 * h) * 64] = (bf16_t)f2bf(acc[i]);
            }
        }
        LDS_WAIT();
    }
}
__device__ __forceinline__ void p_gla_b(const Frame& F, unsigned char* ws) {
    bf16_t* UPD = (bf16_t*)(ws + L1_UPD); const float* DECAY = (const float*)(ws + L1_DECAY);
    for (int e = F.bid * NTHREADS + F.tid; e < 32 * 4096; e += F.G * NTHREADS) {
        const int bh = e >> 12, rem = (e & 4095) * 2, dk = rem & 63;
        float s0 = 0.f, s1 = 0.f;
        unsigned* up = (unsigned*)(UPD + (size_t)bh * 128 * 8192 + rem); const float* dp = DECAY + (size_t)bh * 128 * 64 + dk;
#pragma unroll 8
        for (int n = 0; n < 128; ++n) { const unsigned uv = up[(size_t)n * 4096]; const f32x2 dc = *(const f32x2*)(dp + n * 64);
            up[(size_t)n * 4096] = pk2(s0, s1); s0 = dc.x * s0 + bf_lo(uv); s1 = dc.y * s1 + bf_hi(uv); }
    }
}
__device__ __forceinline__ void p_gla_c(const Frame& F, const Args& a, unsigned char* ws, const int mode) {
    const bf16_t* P = (const bf16_t*)(ws + WS_PROJ); const bf16_t* PREV = (const bf16_t*)(ws + L1_UPD); bf16_t* CAT = (bf16_t*)(ws + L1_CAT);
    const int lane = F.lane, r = lane & 31, h = lane >> 5;
    LAS bf16_t* qd = (LAS bf16_t*)(F.lds + F.wave * 9472);
    LAS bf16_t* ki = qd + 32 * 72;
    const int gw = F.bid * NWAVES + F.wave, NGW = F.G * NWAVES;
    for (int u = gw; u < 4096; u += NGW) {
        const int b = u >> 9, hh = (u >> 7) & 3, n = u & 127; const size_t m0 = (size_t)b * 4096 + n * 32;
        bf16x8 pr_[4]; unsigned short vr_[16];
#define GLA_FETCH(ct_) do { const bf16_t* pp_ = PREV + (size_t)u * 8192 + (size_t)(32 * (ct_) + r) * 64 + 8 * h; \
            _Pragma("unroll") for (int ks_ = 0; ks_ < 4; ++ks_) pr_[ks_] = *(const bf16x8*)(pp_ + 16 * ks_); \
            const bf16_t* vb_ = P + m0 * N_IN1 + C1_GV + hh * 128 + 32 * (ct_) + r; \
            _Pragma("unroll") for (int j_ = 0; j_ < 16; ++j_) vr_[j_] = vb_[(size_t)(8 * h + (j_ & 7) + 16 * (j_ >> 3)) * N_IN1]; } while (0)
        GLA_FETCH(0);
        {
            float bc[32];
            if (mode == 1) {
#pragma unroll
                for (int c = 0; c < 32; ++c) bc[c] = -0.01f * (float)c;
            } else gla_wave_bcum(a, P, m0, hh, lane, bc);
#pragma unroll
            for (int c = 0; c < 32; ++c) {
                const float kv = bf2f(P[(m0 + c) * N_IN1 + C1_GK + hh * 64 + lane]) * __expf(-bc[c]);
                const float qv = bf2f(P[(m0 + c) * N_IN1 + C1_GQ + hh * 64 + lane]) * 0.125f * __expf(bc[c]);
                ki[c * 72 + lane] = (bf16_t)f2bf(kv); qd[c * 72 + lane] = (bf16_t)f2bf(qv);
            }
        }
        LDS_WAIT();
        bf16x8 Qa[4];
#pragma unroll
        for (int ks = 0; ks < 4; ++ks) Qa[ks] = *(const LAS bf16x8*)(qd + r * 72 + 16 * ks + 8 * h);
        {
            f32x16 at = {0.f, 0.f, 0.f, 0.f, 0.f, 0.f, 0.f, 0.f, 0.f, 0.f, 0.f, 0.f, 0.f, 0.f, 0.f, 0.f};
#pragma unroll
            for (int ks = 0; ks < 4; ++ks) at = __builtin_amdgcn_mfma_f32_32x32x16_bf16(Qa[ks], *(const LAS bf16x8*)(ki + r * 72 + 16 * ks + 8 * h), at, 0, 0, 0);
            LDS_WAIT();
#pragma unroll
            for (int i = 0; i < 16; ++i) { const int c = (i & 3) + 8 * (i >> 2) + 4 * h; ki[c * 40 + r] = (bf16_t)f2bf((r <= c) ? at[i] : 0.f); }
        }
        LDS_WAIT();
        bf16x8 Aa[2];
#pragma unroll
        for (int ks = 0; ks < 2; ++ks) Aa[ks] = *(const LAS bf16x8*)(ki + r * 40 + 16 * ks + 8 * h);
        f32x16 acc[4];
#pragma unroll
        for (int ct = 0; ct < 4; ++ct) {
            bf16x8 Bp[4], Bv[2];
#pragma unroll
            for (int ks = 0; ks < 4; ++ks) Bp[ks] = pr_[ks];
#pragma unroll
            for (int ks = 0; ks < 2; ++ks) { u32x4 w; w.x = (unsigned)vr_[8 * ks] | ((unsigned)vr_[8 * ks + 1] << 16); w.y = (unsigned)vr_[8 * ks + 2] | ((unsigned)vr_[8 * ks + 3] << 16);
                w.z = (unsigned)vr_[8 * ks + 4] | ((unsigned)vr_[8 * ks + 5] << 16); w.w = (unsigned)vr_[8 * ks + 6] | ((unsigned)vr_[8 * ks + 7] << 16); Bv[ks] = __builtin_bit_cast(bf16x8, w); }
            if (ct < 3) GLA_FETCH(ct + 1);
#pragma unroll
            for (int i = 0; i < 16; ++i) acc[ct][i] = 0.f;
#pragma unroll
            for (int ks = 0; ks < 4; ++ks) acc[ct] = __builtin_amdgcn_mfma_f32_32x32x16_bf16(Qa[ks], Bp[ks], acc[ct], 0, 0, 0);
#pragma unroll
            for (int ks = 0; ks < 2; ++ks) acc[ct] = __builtin_amdgcn_mfma_f32_32x32x16_bf16(Aa[ks], Bv[ks], acc[ct], 0, 0, 0);
        }
#undef GLA_FETCH
#pragma unroll
        for (int i = 0; i < 16; ++i) {
            float ss = acc[0][i] * acc[0][i] + acc[1][i] * acc[1][i] + acc[2][i] * acc[2][i] + acc[3][i] * acc[3][i];
            ss = sum32_f(ss);
            const float rstd = __builtin_amdgcn_rsqf(ss * (1.f / 128.f) + 1e-6f);
            const int c = (i & 3) + 8 * (i >> 2) + 4 * h; const size_t m = m0 + c;
#pragma unroll
            for (int ct = 0; ct < 4; ++ct) { const int dv = 32 * ct + r;
                const float rv = bf2f(P[m * N_IN1 + C1_GR + hh * 128 + dv]);
                const bf16_t ov = (bf16_t)f2bf(acc[ct][i] * rstd * a.in[I_L1_OGAIN][dv] * rv * sigmoidf_(rv));
                if (mode == 0) CAT[m * 1024 + 512 + hh * 128 + dv] = ov; else asm volatile("" :: "v"((unsigned)ov)); }
        }
        LDS_WAIT();
    }
}
__global__ void __launch_bounds__(NTHREADS, 2) mk_fwd(Args args) {
    extern __shared__ __attribute__((aligned(16))) unsigned char lds_raw[];
    cg::grid_group grid = cg::this_grid();
    Frame F; F.lds = (LAS unsigned char*)lds_raw; F.tid = threadIdx.x; F.lane = F.tid & 63; F.wave = __builtin_amdgcn_readfirstlane(F.tid >> 6); F.G = gridDim.x; F.bid = blockIdx.x;
    unsigned char* ws = args.ws;
    const int lo = args.ph_lo, hi = args.ph_hi;
#ifndef KEEPMASK
#define KEEPMASK 0xFFFFFFFFu
#endif
#define IN(k) (((KEEPMASK >> (k)) & 1u) && lo <= (k) && (k) < hi)
#define BOTH(k) (IN(k) && IN((k) + 1))
#ifndef TMODE
#define TMODE 0
#endif
#ifndef REPMASK
#define REPMASK 0u
#endif
#define PH(k, ...) if (IN(k)) { { const int rep = 0; (void)rep; __VA_ARGS__; } if ((REPMASK >> (k)) & 1u) { xcd_barrier(xbar); { const int rep = 1; (void)rep; __VA_ARGS__; } } }
#ifdef TS_A
#define STAMP(k) do { if (F.bid == 0 && F.tid == 0) ((unsigned long long*)(ws + WS_CTL + 65536))[(k)] = __builtin_amdgcn_s_memrealtime(); } while (0)
#else
#define STAMP(k) do { } while (0)
#endif
#define GRID_BAR(k) do { if (BOTH(k)) { if ((k) == 0) grid.sync(); else xcd_barrier(xbar); } STAMP((k) + 1); } while (0)
    const float* x = args.in[I_X];
    float* out = args.out;
    volatile LAS unsigned* xst = (volatile LAS unsigned*)(F.lds + LDS_BYTES - 64);
    if (F.tid < 16) xst[F.tid] = 0u;
    __syncthreads();
    XcdBarrier xbar = xcd_barrier_post((unsigned*)(ws + WS_CTL) + 4096, xst);

    STAMP(0);
    PH(0, int base = 0; transpose_all(F, base, args.in[I_L0_WIN], 1024, 1864, (bf16_t*)(ws + WS_W_IN0), 1024, MapIn0()); transpose_all(F, base, args.in[I_L0_WGLU], 512, 512, (bf16_t*)(ws + WS_W_GLU), 512, MapId()); transpose_all(F, base, args.in[I_L0_WOUT], 1024, 1024, (bf16_t*)(ws + WS_W_OUT0), 1024, MapId()); peer_fold_wq(F, args.in[I_L0_WQ], args.in[I_L0_SK], (bf16_t*)(ws + WS_WQ0)); transpose_all(F, base, args.in[I_L1_WIN], 1024, 2856, (bf16_t*)(ws + WS_W_IN1), 1024, MapIn1()); transpose_all(F, base, args.in[I_L1_KW1], 2048, 256, (bf16_t*)(ws + WS_KW1), 2048, MapId()); transpose_all(F, base, args.in[I_L1_VW1], 2048, 256, (bf16_t*)(ws + WS_VW1), 2048, MapId()); transpose_all(F, base, args.in[I_L1_KW2], 256, 64, (bf16_t*)(ws + WS_KW2), 256, MapId()); transpose_all(F, base, args.in[I_L1_VW2], 256, 64, (bf16_t*)(ws + WS_VW2), 256, MapId()); transpose_all(F, base, args.in[I_L1_WOUT], 1024, 1024, (bf16_t*)(ws + WS_W_OUT1), 1024, MapId()); peer_fold_wq(F, args.in[I_L1_WQ], args.in[I_L1_SK], (bf16_t*)(ws + WS_WQ1)); zero_bytes(F, ws + WS_W_IN0 + (size_t)1864 * 1024 * 2, (size_t)(2048 - 1864) * 1024 * 2); zero_bytes(F, ws + WS_W_IN1 + (size_t)2856 * 1024 * 2, (size_t)(3072 - 2856) * 1024 * 2); zero_bytes(F, ws + WS_KW2 + (size_t)64 * 256 * 2, (size_t)192 * 256 * 2); zero_bytes(F, ws + WS_VW2 + (size_t)64 * 256 * 2, (size_t)192 * 256 * 2);   cvt_table_i8(F, args.in[I_L0_U], ws + WS_TAB8U, (float*)(ws + WS_TABSU), 32); cvt_table_fp8(F, args.in[I_L0_V], ws + WS_TAB8V, (float*)(ws + WS_TABSV), 32); p_rope_table(F, (f32x2*)(ws + WS_ROPE)); if (F.bid == F.G - 1) { for (int i = F.tid; i < 1024; i += NTHREADS) ((float*)(ws + WS_CMPB + 4096))[i] = args.in[I_L1_MIXN][i]; } __syncthreads(); for (int g = F.bid; g < 32; g += F.G) s5_build_group(F, args, ws, g); for (int j = (F.bid + F.G - (32 % F.G)) % F.G; j < 64; j += F.G) cmp_bias(F, args, (float*)(ws + WS_CMPB), j); p_rmsnorm(F, x, args.in[I_L0_MIXN], (bf16_t*)(ws + WS_XN));)
    GRID_BAR(0);
    PH(1, pg8::Gemm g{(const bf16_t*)(ws + WS_XN), (const bf16_t*)(ws + WS_W_IN0), T, N_IN0, 1024, 1024, 1024}; pg8::StaticOrder S; S.init(T, N_IN0, F.G, F.bid); pg8::EpiStoreBf16 E{(bf16_t*)(ws + WS_PROJ), N_IN0}; pg8::gemm_phase(F.lds, g, S, E);)
    GRID_BAR(1);
    PH(2, p_l0_prep(F, args, ws);)
    GRID_BAR(2);
    PH(3, p_dsa_index(F, ws, (u64*)(ws + (rep ? L0_CAT : L0_SELT)), rep ? TMODE : 0); { pg8::Gemm g{(const bf16_t*)(ws + L0_UA), (const bf16_t*)(ws + WS_S5B1), 65536, 8192, 256, 384, 256}; pg8::GroupedOrder S; S.init(256, 8, F.G, F.bid); pg8::EpiS5State E{(float*)(ws + L0_SLOC)}; pg8::gemm_phase(F.lds, g, S, E); })
    GRID_BAR(3);
    PH(4, p_s5_scan(F, args, ws); p_dsa_attn(F, args, ws);)
    GRID_BAR(4);
    PH(7, pg8::Gemm g{(const bf16_t*)(ws + L0_UA), (const bf16_t*)(ws + WS_S5B2), 65536, 8192, 384, 384, 384}; pg8::GroupedOrder S; S.init(256, 8, F.G, F.bid); pg8::EpiS5Out E{(bf16_t*)(ws + L0_YB)}; pg8::gemm_phase(F.lds, g, S, E);)
    GRID_BAR(7);
    PH(8, pg8::Gemm g{(const bf16_t*)(ws + L0_YB), (const bf16_t*)(ws + WS_W_GLU), T, 512, 512, 512, 512}; pg8::StaticOrder S; S.init(T, 512, F.G, F.bid); pg8::EpiGlu E{(const bf16_t*)(ws + L0_YB), args.in[I_L0_BGLU], (bf16_t*)(ws + L0_CAT)}; pg8::gemm_phase(F.lds, g, S, E);)
    GRID_BAR(8);
    PH(9, pg8::Gemm g{(const bf16_t*)(ws + L0_CAT), (const bf16_t*)(ws + WS_W_OUT0), T, 1024, 1024, 1024, 1024}; pg8::StaticOrder S; S.init(T, 1024, F.G, F.bid); pg8::EpiResidNorm E{x, out, args.in[I_L0_FFNN], (bf16_t*)(ws + WS_XN), (float*)(ws + PE_SSQ)}; pg8::gemm_phase(F.lds, g, S, E);)
    GRID_BAR(9);
    PH(11, pg8::Gemm g{(const bf16_t*)(ws + WS_XN), (const bf16_t*)(ws + WS_WQ0), T, 2048, 1024, 1024, 1024}; pg8::StaticOrder S; S.init(T, 2048, F.G, F.bid); pg8::EpiStoreF16Rs E{(_Float16*)(ws + PE_Q2), 2048, (const float*)(ws + PE_SSQ)}; pg8::gemm_phase(F.lds, g, S, E);)
    GRID_BAR(11);
    PH(12, p_peer_route(F, ws);)
    GRID_BAR(12);
    PH(13, p_peer_expert5(F, ws, out, rep ? 0.f : 1.f, xbar, rep ? TMODE : 0, true, WS_XN);)
    GRID_BAR(13);
    PH(15, pg8::Gemm g{(const bf16_t*)(ws + WS_XN), (const bf16_t*)(ws + WS_W_IN1), T, N_IN1, 1024, 1024, 1024}; pg8::StaticOrder S; S.init(T, N_IN1, F.G, F.bid); pg8::EpiStoreBf16 E{(bf16_t*)(ws + WS_PROJ), N_IN1}; pg8::gemm_phase(F.lds, g, S, E);)
    GRID_BAR(15);
    PH(16, p_l1_prep(F, args, ws);)
    GRID_BAR(16);
    PH(17, pg8::Gemm g{(const bf16_t*)(ws + L1_KCR), (const bf16_t*)(ws + WS_KW1), 8192, 512, 2048, 1024, 2048}; pg8::GroupedOrder S; S.init(32, 16, F.G, F.bid); pg8::EpiCmp1 E{(bf16_t*)(ws + L1_H1), (const float*)(ws + WS_CMPB)}; pg8::gemm_phase(F.lds, g, S, E);)
    GRID_BAR(17);
    PH(18, pg8::Gemm g{(const bf16_t*)(ws + L1_H1), (const bf16_t*)(ws + WS_KW2), 8192, 512, 256, 256, 256}; pg8::GroupedOrder S; S.init(32, 16, F.G, F.bid); pg8::EpiCmp2 E{(float*)(ws + L1_CMPO)}; pg8::gemm_phase(F.lds, g, S, E);)
    GRID_BAR(18);
    PH(19, p_cmp_final(F, args, ws);)
    GRID_BAR(19);
    PH(20, p_cmp_attn(F, args, ws);)
    GRID_BAR(20);
    PH(21, if (rep) { p_cmp_attn(F, args, ws); xcd_barrier(xbar); } p_nsa_attn(F, args, ws);)
    GRID_BAR(21);
    PH(22, p_gla_a(F, args, ws); cvt_table_i8(F, args.in[I_L1_U], ws + WS_TAB8U, (float*)(ws + WS_TABSU), 0); cvt_table_fp8(F, args.in[I_L1_V], ws + WS_TAB8V, (float*)(ws + WS_TABSV), 0);)
    GRID_BAR(22);
    PH(23, if (rep) { p_gla_a(F, args, ws); xcd_barrier(xbar); } p_gla_b(F, ws);)
    GRID_BAR(23);
    PH(24, p_gla_c(F, args, ws, rep ? TMODE : 0);)
    GRID_BAR(24);
    PH(25, pg8::Gemm g{(const bf16_t*)(ws + L1_CAT), (const bf16_t*)(ws + WS_W_OUT1), T, 1024, 1024, 1024, 1024}; pg8::StaticOrder S; S.init(T, 1024, F.G, F.bid); pg8::EpiResidNorm E{out, out, args.in[I_L1_FFNN], (bf16_t*)(ws + WS_R3), (float*)(ws + PE_SSQ)}; pg8::gemm_phase(F.lds, g, S, E);)
    GRID_BAR(25);
    PH(27, pg8::Gemm g{(const bf16_t*)(ws + WS_R3), (const bf16_t*)(ws + WS_WQ1), T, 2048, 1024, 1024, 1024}; pg8::StaticOrder S; S.init(T, 2048, F.G, F.bid); pg8::EpiStoreF16Rs E{(_Float16*)(ws + PE_Q2), 2048, (const float*)(ws + PE_SSQ)}; pg8::gemm_phase(F.lds, g, S, E);)
    GRID_BAR(27);
    PH(28, p_peer_route(F, ws);)
    GRID_BAR(28);
    PH(29, p_peer_expert5(F, ws, out, rep ? 0.f : 1.f, xbar, rep ? TMODE : 0, false, WS_R3);)
#undef IN
#undef BOTH
}

extern "C" void kernel_launch(void* const* d_in, const int* in_sizes, int n_in, void* d_out, int out_size, void* d_ws, size_t ws_size, hipStream_t stream) {
    static int grid = 0;
    if (grid == 0) {
        if (n_in != 39 || ws_size < WS_END) { fprintf(stderr, "kernel_launch: unexpected n_in %d or ws_size %zu (< %zu)\n", n_in, ws_size, (size_t)WS_END); grid = -1; return; }
        int dev = 0, cus = 0, per_cu = 0;
        (void)hipGetDevice(&dev); (void)hipDeviceGetAttribute(&cus, hipDeviceAttributeMultiprocessorCount, dev);
        if (hipFuncSetAttribute((const void*)mk_fwd, hipFuncAttributeMaxDynamicSharedMemorySize, LDS_BYTES) != hipSuccess) { fprintf(stderr, "kernel_launch: hipFuncSetAttribute failed\n"); grid = -1; return; }
        if (hipOccupancyMaxActiveBlocksPerMultiprocessor(&per_cu, (const void*)mk_fwd, NTHREADS, LDS_BYTES) != hipSuccess || per_cu < 1) { fprintf(stderr, "kernel_launch: occupancy query failed (%d)\n", per_cu); (void)hipGetLastError(); grid = -1; return; }
        grid = cus;
    }
    if (grid < 0) return;
    (void)hipMemsetAsync((char*)d_ws + WS_CTL, 0, 32768, stream);
    Args a{};
    for (int i = 0; i < 39; ++i) a.in[i] = (const float*)d_in[i];
    a.out = (float*)d_out; a.ws = (unsigned char*)d_ws; a.ph_lo = 0; a.ph_hi = 1000;
    void* kargs[] = {&a};
    hipError_t e = hipLaunchCooperativeKernel((const void*)mk_fwd, dim3(grid), dim3(NTHREADS), kargs, LDS_BYTES, stream);
    if (e != hipSuccess) fprintf(stderr, "kernel_launch: cooperative launch failed: %s\n", hipGetErrorString(e));
}
```
